# Optimizing an MI355X kernel written in HIP

```python
import jax, jax.numpy as jnp
from jax import lax
import numpy as np

D_MODEL = 2048
BATCH = 4
SEQ = 2048
DEPTH = 1

GRID_W = 64
CTX_LEN = 256
EPS = 1e-6
N_MOD = 6

MLSTM_WIDTH = D_MODEL // 2
MLSTM_HEADS = 8
MLSTM_HEAD_DIM = MLSTM_WIDTH // MLSTM_HEADS
MLSTM_CHUNK = 64

LRU_WIDTH = D_MODEL // 2
LRU_BLOCKS = 8
LRU_BLOCK_DIM = LRU_WIDTH // LRU_BLOCKS
LRU_C = 8.0
CONV_WIDTH = 4
CONV_PAD = (2, 1)

N_GROUPS = 4
EXPERTS_PER_GROUP = 8
N_EXPERTS = N_GROUPS * EXPERTS_PER_GROUP
TOP_K = 2
D_EXPERT = D_MODEL // 2
MOE_BLOCK = 128

IN_SIZES = (MLSTM_WIDTH,) * 5 + (4 * MLSTM_HEADS, LRU_WIDTH, LRU_WIDTH, D_MODEL, D_MODEL)
IN_DIM = sum(IN_SIZES)
IN_SPLITS = tuple(int(s) for s in np.cumsum(IN_SIZES)[:-1])

kernel_name = 'hybrid_mlstm_rglru_hmoe_dit'


def rmsnorm(x, g):
    xf = x.astype(jnp.float32)
    y = xf * lax.rsqrt(jnp.mean(xf * xf, axis=-1, keepdims=True) + EPS)
    return (y * g).astype(x.dtype)


def prefix_flip(z, n_ctx):
    return jnp.concatenate([jnp.flip(z[:, :n_ctx], 1), jnp.flip(z[:, n_ctx:], 1)], axis=1)


def raster_to_col(z, rows):
    b, s, ch = z.shape
    return z.reshape(b, rows, GRID_W, ch).transpose(0, 2, 1, 3).reshape(b, s, ch)


def col_to_raster(z, rows):
    b, s, ch = z.shape
    return z.reshape(b, GRID_W, rows, ch).transpose(0, 2, 1, 3).reshape(b, s, ch)


def mlstm_scan(q, k, v, i_pre, logf):
    b_, n_, h_, dh = q.shape
    L = MLSTM_CHUNK
    nc = n_ // L

    def chunks(z):
        z = z.reshape((b_, nc, L, h_) + z.shape[3:])
        return jnp.moveaxis(jnp.moveaxis(z, 1, 0), 3, 2)

    causal = jnp.tril(jnp.ones((L, L), dtype=bool))

    def step(carry, inp):
        C, n, m = carry
        qc, kc, vc, ic, fc = inp
        b = jnp.cumsum(fc, axis=-1)
        dmat = jnp.where(causal, b[..., :, None] - b[..., None, :] + ic[..., None, :], -jnp.inf)
        g = b + m[..., None]
        m_t = jnp.maximum(g, dmat.max(-1))
        w_intra = jnp.exp(dmat - m_t[..., None])
        w_inter = jnp.exp(g - m_t)
        a = jnp.einsum('bhtd,bhsd->bhts', qc, kc) * w_intra
        num = jnp.einsum('bhts,bhsd->bhtd', a, vc) + w_inter[..., None] * jnp.einsum('bhtk,bhvk->bhtv', qc, C)
        den = a.sum(-1) + w_inter * jnp.einsum('bhtk,bhk->bht', qc, n)
        h = num / jnp.maximum(jnp.abs(den), jnp.exp(-m_t))[..., None]
        b_last = b[..., -1]
        wlog = b_last[..., None] - b + ic
        m_new = jnp.maximum(b_last + m, wlog.max(-1))
        ws = jnp.exp(wlog - m_new[..., None])
        decay = jnp.exp(b_last + m - m_new)
        C = decay[..., None, None] * C + jnp.einsum('bhs,bhsv,bhsk->bhvk', ws, vc, kc)
        n = decay[..., None] * n + jnp.einsum('bhs,bhsk->bhk', ws, kc)
        return (C, n, m_new), h

    init = (jnp.zeros((b_, h_, dh, dh), jnp.float32), jnp.zeros((b_, h_, dh), jnp.float32),
            jnp.full((b_, h_), -1e30, jnp.float32))
    _, hs = lax.scan(step, init, (chunks(q), chunks(k), chunks(v), chunks(i_pre), chunks(logf)))
    return jnp.swapaxes(jnp.moveaxis(hs, 0, 1), 2, 3).reshape(b_, n_, h_, dh)


def head_rmsnorm(h, g):
    return h * lax.rsqrt(jnp.mean(h * h, axis=-1, keepdims=True) + EPS) * g


def mlstm_branch(q, k, v, o_f, o_b, gates, head_g, n_ctx):
    b_, n_, _ = q.shape
    f32 = jnp.float32
    heads = lambda z: z.astype(f32).reshape(b_, n_, MLSTM_HEADS, MLSTM_HEAD_DIM)
    qh, kh, vh = heads(q), heads(k) * MLSTM_HEAD_DIM ** -0.5, heads(v)
    gt = gates.astype(f32).reshape(b_, n_, 4, MLSTM_HEADS)
    fl = lambda z: prefix_flip(z, n_ctx)
    h_f = head_rmsnorm(mlstm_scan(qh, kh, vh, gt[:, :, 0], jax.nn.log_sigmoid(gt[:, :, 1])), head_g)
    h_b = fl(head_rmsnorm(mlstm_scan(fl(qh), fl(kh), fl(vh), fl(gt[:, :, 2]),
                                     jax.nn.log_sigmoid(fl(gt[:, :, 3]))), head_g))
    y = (jax.nn.sigmoid(o_f.astype(f32)) * h_f.reshape(b_, n_, MLSTM_WIDTH)
         + jax.nn.sigmoid(o_b.astype(f32)) * h_b.reshape(b_, n_, MLSTM_WIDTH))
    return y.astype(q.dtype)


def depthwise_conv(z, w, b):
    out = lax.conv_general_dilated(z, w[:, None, :], window_strides=(1,), padding=[CONV_PAD],
                                   dimension_numbers=('NWC', 'WIO', 'NWC'), feature_group_count=z.shape[-1])
    return out + b


def linear_scan(a, b):
    def combine(l, r):
        return (l[0] * r[0], r[0] * l[1] + r[1])
    _, h = lax.associative_scan(combine, (a, b), axis=1)
    return h


def rglru_direction(z, w_a, b_a, w_x, b_x, lam):
    b_, n_, _ = z.shape
    zb = z.reshape(b_, n_, LRU_BLOCKS, LRU_BLOCK_DIM)
    r = jax.nn.sigmoid(jnp.einsum('bnkc,kcd->bnkd', zb, w_a.astype(jnp.float32)).reshape(b_, n_, LRU_WIDTH) + b_a)
    i = jax.nn.sigmoid(jnp.einsum('bnkc,kcd->bnkd', zb, w_x.astype(jnp.float32)).reshape(b_, n_, LRU_WIDTH) + b_x)
    log_a = -LRU_C * r * jax.nn.softplus(-lam.astype(jnp.float32))
    a = jnp.exp(log_a)
    mult = jnp.sqrt(-jnp.expm1(2.0 * log_a))
    return linear_scan(a, mult * i * z)


def rglru_branch(u_x, u_g, conv_w, conv_b, w_a, b_a, w_x, b_x, lam, n_ctx, rows):
    x_ctx = depthwise_conv(u_x[:, :n_ctx], conv_w, conv_b)
    x_lat = depthwise_conv(raster_to_col(u_x[:, n_ctx:], rows), conv_w, conv_b)
    z = jnp.concatenate([x_ctx, x_lat], axis=1).astype(jnp.float32)
    h_f = rglru_direction(z, w_a[0], b_a[0], w_x[0], b_x[0], lam[0])
    h_b = prefix_flip(rglru_direction(prefix_flip(z, n_ctx), w_a[1], b_a[1], w_x[1], b_x[1], lam[1]), n_ctx)
    h = h_f + h_b
    h = jnp.concatenate([h[:, :n_ctx], col_to_raster(h[:, n_ctx:], rows)], axis=1)
    return (h * jax.nn.gelu(u_g.astype(jnp.float32))).astype(u_x.dtype)


def grouped_experts(h, expert, weight, w1, w3, w2):
    t_, d_ = h.shape
    n_assign = expert.shape[0]
    tok = jnp.arange(n_assign, dtype=jnp.int32) // TOP_K
    order = jnp.argsort(expert)
    e_sorted, tok_sorted, w_sorted = expert[order], tok[order], weight[order]
    counts = jnp.bincount(expert, length=N_EXPERTS)
    padded = (counts + MOE_BLOCK - 1) // MOE_BLOCK * MOE_BLOCK
    start = jnp.cumsum(counts) - counts
    pend = jnp.cumsum(padded)
    pstart = pend - padded
    dest = pstart[e_sorted] + jnp.arange(n_assign, dtype=jnp.int32) - start[e_sorted]
    n_blocks = -(-n_assign // MOE_BLOCK) + N_EXPERTS
    n_slots = n_blocks * MOE_BLOCK
    slot_tok = jnp.full((n_slots,), t_, jnp.int32).at[dest].set(tok_sorted)
    slot_w = jnp.zeros((n_slots,), h.dtype).at[dest].set(w_sorted)
    block_expert = jnp.minimum(jnp.searchsorted(pend, jnp.arange(n_blocks) * MOE_BLOCK, side='right'),
                               N_EXPERTS - 1)
    h_pad = jnp.concatenate([h, jnp.zeros((1, d_), h.dtype)], axis=0)
    xs = h_pad[slot_tok].reshape(n_blocks, MOE_BLOCK, d_)

    def run_block(args):
        xb, e = args
        return (jax.nn.silu(xb @ w1[e]) * (xb @ w3[e])) @ w2[e]

    ys = lax.map(run_block, (xs, block_expert)).reshape(n_slots, d_)
    out = jnp.zeros((t_ + 1, d_), ys.dtype).at[slot_tok].add(ys * slot_w[:, None])
    return out[:t_]


def hier_moe(h, w_rg, w_re, w1, w3, w2):
    t_ = h.shape[0]
    hf = h.astype(jnp.float32)
    g_logits = hf @ w_rg.astype(jnp.float32)
    g_prob = jax.nn.softmax(g_logits, axis=-1)
    p_g, g_sel = lax.top_k(g_prob, 1)
    e_logits = (hf @ w_re.astype(jnp.float32)).reshape(t_, N_GROUPS, EXPERTS_PER_GROUP)
    e_logits = jnp.take_along_axis(e_logits, g_sel[:, :, None], axis=1)[:, 0]
    top_val, top_idx = lax.top_k(e_logits, TOP_K)
    weights = (p_g * jax.nn.softmax(top_val, axis=-1)).astype(h.dtype)
    expert = g_sel * EXPERTS_PER_GROUP + top_idx
    return grouped_experts(h, expert.reshape(-1).astype(jnp.int32), weights.reshape(-1), w1, w3, w2)


def setup_inputs(seed: int = 0) -> dict:
    key = jax.random.key(seed)
    ks = jax.random.split(key, 32)
    L, D, H = DEPTH, D_MODEL, MLSTM_HEADS
    f32 = jnp.float32
    nrm = lambda k, shape: jax.random.normal(k, shape, f32)
    lin = lambda k, shape, fan_in: nrm(k, shape) * fan_in ** -0.5
    u = jax.random.uniform(ks[17], (L, 2, LRU_WIDTH), f32, minval=0.9, maxval=0.999)
    p = u ** (1.0 / LRU_C)
    i_bias = 0.1 * nrm(ks[8], (L, 2, H))
    f_bias = jnp.linspace(3.0, 6.0, H, dtype=f32) + 0.1 * nrm(ks[9], (L, 2, H))
    b_gates = jnp.stack([i_bias[:, 0], f_bias[:, 0], i_bias[:, 1], f_bias[:, 1]], axis=1).reshape(L, 4 * H)
    return {
        'x': nrm(ks[0], (BATCH, SEQ, D)),
        'c': nrm(ks[1], (BATCH, D)),
        'ctx': nrm(ks[2], (BATCH, CTX_LEN, D)),
        'c_ctx': nrm(ks[3], (D,)),
        'w_mod': 0.5 * lin(ks[4], (L, D, N_MOD * D), D),
        'b_mod': 0.01 * nrm(ks[5], (L, N_MOD * D)),
        'norm1_g': 1.0 + 0.05 * nrm(ks[6], (L, D)),
        'w_in': lin(ks[7], (L, D, IN_DIM), D),
        'b_gates': b_gates,
        'mlstm_head_g': 1.0 + 0.05 * nrm(ks[10], (L, H, MLSTM_HEAD_DIM)),
        'conv_w': lin(ks[11], (L, CONV_WIDTH, LRU_WIDTH), CONV_WIDTH),
        'conv_b': 0.01 * nrm(ks[12], (L, LRU_WIDTH)),
        'lru_wa': lin(ks[13], (L, 2, LRU_BLOCKS, LRU_BLOCK_DIM, LRU_BLOCK_DIM), LRU_BLOCK_DIM),
        'lru_ba': 0.01 * nrm(ks[14], (L, 2, LRU_WIDTH)),
        'lru_wx': lin(ks[15], (L, 2, LRU_BLOCKS, LRU_BLOCK_DIM, LRU_BLOCK_DIM), LRU_BLOCK_DIM),
        'lru_bx': 0.01 * nrm(ks[16], (L, 2, LRU_WIDTH)),
        'lru_lam': jnp.log(p) - jnp.log1p(-p),
        'w_pa': lin(ks[18], (L, MLSTM_WIDTH, D), MLSTM_WIDTH),
        'w_pb': lin(ks[19], (L, LRU_WIDTH, D), LRU_WIDTH),
        'w_out': lin(ks[20], (L, D, D), D),
        'norm2_g': 1.0 + 0.05 * nrm(ks[21], (L, D)),
        'w_rg': lin(ks[22], (L, D, N_GROUPS), D),
        'w_re': lin(ks[23], (L, D, N_EXPERTS), D),
        'w1': lin(ks[24], (L, N_EXPERTS, D, D_EXPERT), D),
        'w3': lin(ks[25], (L, N_EXPERTS, D, D_EXPERT), D),
        'w2': lin(ks[26], (L, N_EXPERTS, D_EXPERT, D), D_EXPERT),
        'final_g': 1.0 + 0.05 * nrm(ks[27], (D,)),
    }


def reference(x, c, ctx, c_ctx, w_mod, b_mod, norm1_g, w_in, b_gates, mlstm_head_g, conv_w, conv_b,
              lru_wa, lru_ba, lru_wx, lru_bx, lru_lam, w_pa, w_pb, w_out, norm2_g, w_rg, w_re,
              w1, w3, w2, final_g):
    b_, s_, d_ = x.shape
    n_ctx = ctx.shape[1]
    rows = s_ // GRID_W
    for l in range(DEPTH):
        update_ctx = l < DEPTH - 1
        mod = jax.nn.silu(c) @ w_mod[l] + b_mod[l]
        mod_c = jax.nn.silu(c_ctx) @ w_mod[l] + b_mod[l]
        sh1, sc1, g1, sh2, sc2, g2 = jnp.split(mod[:, None, :], N_MOD, axis=-1)
        csh1, csc1, cg1, csh2, csc2, cg2 = jnp.split(mod_c, N_MOD, axis=-1)

        h = jnp.concatenate([rmsnorm(ctx, norm1_g[l]) * (1 + csc1) + csh1,
                             rmsnorm(x, norm1_g[l]) * (1 + sc1) + sh1], axis=1)
        u = h @ w_in[l]
        q, k, v, o_f, o_b, gates, u_x, u_g, gate_a, gate_b = jnp.split(u, IN_SPLITS, axis=-1)
        y_a = mlstm_branch(q, k, v, o_f, o_b, gates + b_gates[l], mlstm_head_g[l], n_ctx)
        y_b = rglru_branch(u_x, u_g, conv_w[l], conv_b[l], lru_wa[l], lru_ba[l], lru_wx[l], lru_bx[l],
                           lru_lam[l], n_ctx, rows)
        keep = 0 if update_ctx else n_ctx
        mixed = (jax.nn.sigmoid(gate_a[:, keep:]) * (y_a[:, keep:] @ w_pa[l])
                 + jax.nn.sigmoid(gate_b[:, keep:]) * (y_b[:, keep:] @ w_pb[l])) @ w_out[l]
        x = x + g1 * mixed[:, -s_:]
        if update_ctx:
            ctx = ctx + cg1 * mixed[:, :n_ctx]

        h2 = (rmsnorm(x, norm2_g[l]) * (1 + sc2) + sh2).reshape(b_ * s_, d_)
        if update_ctx:
            h2c = (rmsnorm(ctx, norm2_g[l]) * (1 + csc2) + csh2).reshape(b_ * n_ctx, d_)
            y = hier_moe(jnp.concatenate([h2c, h2], axis=0), w_rg[l], w_re[l], w1[l], w3[l], w2[l])
            ctx = ctx + cg2 * y[:b_ * n_ctx].reshape(b_, n_ctx, d_)
            y = y[b_ * n_ctx:]
        else:
            y = hier_moe(h2, w_rg[l], w_re[l], w1[l], w3[l], w2[l])
        x = x + g2 * y.reshape(b_, s_, d_)
    return rmsnorm(x, final_g)
```

```cpp
#include <hip/hip_runtime.h>
#include <cstdio>
#include <cstdint>

#ifndef MK_ONE_LAUNCH
#define MK_ONE_LAUNCH 0
#endif

namespace pg8 {
#define PG8_LAS __attribute__((address_space(3)))
typedef unsigned short bf16_t;
typedef short bf16x8 __attribute__((ext_vector_type(8)));
typedef float f32x4 __attribute__((ext_vector_type(4)));
typedef float f32x2 __attribute__((ext_vector_type(2)));
typedef unsigned u32x4 __attribute__((ext_vector_type(4)));
typedef unsigned u32x2 __attribute__((ext_vector_type(2)));
constexpr int BM = 256, BK = 64, HALF = 128, HTB = HALF * BK * 2  , STAGE_BYTES = 8 * HTB, NXCD = 8, WGM = 8;

__host__ __device__ __forceinline__ int lds_byte(int r, int c) { const int st = (r >> 4) * 2 + (c >> 5), rr = r & 15, cc = c & 31, ob = rr * 64 + cc * 2; return st * 1024 + (ob ^ (((ob >> 9) & 1) << 5)); }
__host__ __device__ __forceinline__ void stage_rc(int b, int& R, int& C) { const int st = b / 1024, sb = b % 1024, swz = sb ^ (((sb >> 9) & 1) << 5); R = (st >> 1) * 16 + swz / 64; C = (st & 1) * 32 + (swz % 64) / 2; }
__host__ __device__ __forceinline__ int perm32(int rho) { const int n = rho >> 4, i = rho & 15; return 8 * (i >> 2) + 4 * n + (i & 3); }

struct Unit { const char* A; const char* B; int pm, pn, aux; };

__host__ __device__ __forceinline__ void tile_order(int L, int nM, int nN, int& pm, int& pn) {
    const int nwg = nM * nN; int wgid = L;
    { const int q = nwg / NXCD, r = nwg % NXCD, xcd = wgid % NXCD, off = wgid / NXCD; wgid = (xcd < r ? xcd * (q + 1) : r * (q + 1) + (xcd - r) * q) + off; }
    const int nig = WGM * nN, gid = wgid / nig, fm = gid * WGM, gsz = (nM - fm) < WGM ? (nM - fm) : WGM;
    pm = fm + ((wgid % nig) % gsz); pn = (wgid % nig) / gsz;
}

__device__ __forceinline__ unsigned cvt_pk_bf16(float lo, float hi) { unsigned r; asm volatile("v_cvt_pk_bf16_f32 %0, %1, %2" : "=v"(r) : "v"(lo), "v"(hi)); return r; }

template <class Epi, class Sched>
__device__ __forceinline__ void gemm_phase(PG8_LAS unsigned char* lds, const int K, const Sched& S, const Epi& E) {
    int tid = threadIdx.x; asm volatile("" : "+v"(tid)); const int wid = __builtin_amdgcn_readfirstlane(tid >> 6), lane = tid & 63, wr = wid >> 2, wc = wid & 3, fr = lane & 15, fq = lane >> 4;
    const int nt = K / BK;
    unsigned voffA[2], voffB[2];
#pragma unroll
    for (int i = 0; i < 2; ++i) { int R, C; stage_rc(tid * 16 + i * 8192, R, C); const int Rb = Epi::PERM ? ((R & ~31) + perm32(R & 31)) : R;
        voffA[i] = (unsigned)(R * K + C) * 2u; voffB[i] = (unsigned)(Rb * K + C) * 2u; }
    const size_t kstep = (size_t)(BK * 2);
    const size_t hstep = (size_t)HALF * K * 2;
    const unsigned ldsw = (unsigned)wid * 1024u;
    const int aoff = lds_byte(wr * 64 + fr, fq * 8), boff = lds_byte(wc * 32 + fr, fq * 8);
#define PG8_SA(b, h) (((b) * 2 + (h)) * HTB)
#define PG8_SB(b, h) ((4 + (b) * 2 + (h)) * HTB)
#define PG8_STAGE(bufoff, gbase, voff) do { _Pragma("unroll") for (int _i = 0; _i < 2; ++_i) \
        __builtin_amdgcn_global_load_lds((const unsigned*)((const char*)(gbase) + (voff)[_i]), (PG8_LAS unsigned*)(lds + (bufoff) + ldsw + _i * 8192), 16, 0, 0); } while (0)
#define PG8_LDA(dst, b, h) do { _Pragma("unroll") for (int m = 0; m < 4; ++m) _Pragma("unroll") for (int k = 0; k < 2; ++k) dst[m][k] = *(const PG8_LAS bf16x8*)(lds + PG8_SA(b, h) + aoff + m * 2048 + k * 1024); } while (0)
#define PG8_LDB(dst, b, h) do { _Pragma("unroll") for (int n = 0; n < 2; ++n) _Pragma("unroll") for (int k = 0; k < 2; ++k) dst[n][k] = *(const PG8_LAS bf16x8*)(lds + PG8_SB(b, h) + boff + n * 2048 + k * 1024); } while (0)
#define PG8_MMA(ai, bj, At, Bt) do { __builtin_amdgcn_s_setprio(1); _Pragma("unroll") for (int m = 0; m < 4; ++m) _Pragma("unroll") for (int n = 0; n < 2; ++n) _Pragma("unroll") for (int k = 0; k < 2; ++k) \
        acc[ai][bj][m][n] = __builtin_amdgcn_mfma_f32_16x16x32_bf16(Bt[n][k], At[m][k], acc[ai][bj][m][n], 0, 0, 0); __builtin_amdgcn_s_setprio(0); } while (0)
#define PG8_WAIT_V(n) asm volatile("s_waitcnt vmcnt(" #n ")" ::: "memory")
#define PG8_WAIT_L(n) asm volatile("s_waitcnt lgkmcnt(" #n ")" ::: "memory")
#define PG8_BAR __builtin_amdgcn_s_barrier()
#define PG8_SCHED __builtin_amdgcn_sched_barrier(0)
    Unit cur, nxt; int ui = 0;
    if (!S.next(0, cur)) return;
    f32x4 acc[2][2][4][2];
#pragma unroll
    for (int a = 0; a < 2; ++a)
#pragma unroll
        for (int b = 0; b < 2; ++b)
#pragma unroll
            for (int m = 0; m < 4; ++m)
#pragma unroll
                for (int n = 0; n < 2; ++n) acc[a][b][m][n] = (f32x4){0.f, 0.f, 0.f, 0.f};
    bf16x8 At[4][2], B0[2][2], B1[2][2];
    const char* cA = cur.A; const char* cB = cur.B;
    PG8_STAGE(PG8_SB(0, 0), cB, voffB); PG8_STAGE(PG8_SB(0, 1), cB + hstep, voffB); PG8_STAGE(PG8_SA(0, 0), cA, voffA); PG8_STAGE(PG8_SA(0, 1), cA + hstep, voffA);
    if (wr == 1) PG8_BAR;
    PG8_WAIT_V(2); PG8_BAR;
    PG8_STAGE(PG8_SB(1, 0), cB + kstep, voffB); PG8_STAGE(PG8_SA(1, 0), cA + kstep, voffA); PG8_STAGE(PG8_SB(1, 1), cB + hstep + kstep, voffB);
    PG8_WAIT_V(6); PG8_BAR;
    for (;;) {
        const bool has_next = S.next(ui + 1, nxt);
        const char* nA = has_next ? nxt.A : cA; const char* nB = has_next ? nxt.B : cB;
        for (int t = 0; t < nt; t += 2) {
            const bool last = (t == nt - 2);
            const char* a1 = cA + (size_t)(t + 1) * kstep;
            const char* a2 = last ? nA : cA + (size_t)(t + 2) * kstep; const char* b2 = last ? nB : cB + (size_t)(t + 2) * kstep;
            const char* a3 = a2 + kstep; const char* b3 = b2 + kstep;
            PG8_LDB(B0, 0, 0); PG8_LDB(B1, 0, 1); PG8_SCHED; PG8_LDA(At, 0, 0); PG8_STAGE(PG8_SA(1, 1), a1 + hstep, voffA);
            PG8_WAIT_V(8); PG8_WAIT_L(0); PG8_BAR; PG8_MMA(0, 0, At, B0); PG8_MMA(0, 1, At, B1); PG8_BAR; PG8_SCHED;
            PG8_LDA(At, 0, 1); PG8_STAGE(PG8_SB(0, 0), b2, voffB); PG8_STAGE(PG8_SB(0, 1), b2 + hstep, voffB); PG8_STAGE(PG8_SA(0, 0), a2, voffA);
            PG8_WAIT_V(8); PG8_WAIT_L(0); PG8_BAR; PG8_MMA(1, 0, At, B0); PG8_MMA(1, 1, At, B1); PG8_BAR; PG8_SCHED;
            PG8_LDB(B0, 1, 0); PG8_LDB(B1, 1, 1); PG8_SCHED; PG8_LDA(At, 1, 0); PG8_STAGE(PG8_SA(0, 1), a2 + hstep, voffA);
            PG8_WAIT_V(8); PG8_WAIT_L(0); PG8_BAR; PG8_MMA(0, 0, At, B0); PG8_MMA(0, 1, At, B1); PG8_BAR; PG8_SCHED;
            PG8_LDA(At, 1, 1); PG8_STAGE(PG8_SB(1, 0), b3, voffB); PG8_STAGE(PG8_SB(1, 1), b3 + hstep, voffB); PG8_STAGE(PG8_SA(1, 0), a3, voffA);
            PG8_WAIT_V(8); PG8_WAIT_L(0); PG8_BAR; PG8_MMA(1, 0, At, B0); PG8_MMA(1, 1, At, B1); PG8_BAR; PG8_SCHED;
        }
        if (wr == 0) PG8_BAR;
        E(acc, cur, wr, wc, fr, fq);
        if (!has_next) break;
#pragma unroll
        for (int a = 0; a < 2; ++a)
#pragma unroll
            for (int b = 0; b < 2; ++b)
#pragma unroll
                for (int m = 0; m < 4; ++m)
#pragma unroll
                    for (int n = 0; n < 2; ++n) acc[a][b][m][n] = (f32x4){0.f, 0.f, 0.f, 0.f};
        cur = nxt; cA = nA; cB = nB; ++ui;
        if (wr == 1) PG8_BAR;
    }
    PG8_WAIT_V(0);
    PG8_BAR;
#undef PG8_SA
#undef PG8_SB
#undef PG8_STAGE
#undef PG8_LDA
#undef PG8_LDB
#undef PG8_MMA
#undef PG8_WAIT_V
#undef PG8_WAIT_L
#undef PG8_BAR
#undef PG8_SCHED
}
}

constexpr int NWAVES = 8, NTHR = 512;
constexpr int D = 2048, NB = 4, SEQ = 2048, CTXL = 256, NCTX = NB * CTXL  , NLAT = NB * SEQ  , NTOK = NCTX + NLAT  ;
constexpr int NSTEP = CTXL + SEQ;
constexpr int HEADS = 8, HD = 128, MW = 1024, LW = 1024;
constexpr int NEXP = 32, DE = 1024;
constexpr int IN_DIM = 11296, NT_IN = 45;
constexpr float EPS = 1e-6f;
constexpr int MAXTILES = 96;
constexpr int NPHASE = 13;

constexpr size_t MiB = 1u << 20;
constexpr size_t WS_CTL = 0, CTL_ZERO_BYTES = 1 * MiB;
constexpr size_t WS_MOD = 1 * MiB;
constexpr size_t WS_GATES = 2 * MiB;
constexpr size_t WS_ASG = 4 * MiB;
constexpr size_t WS_WPA = 8 * MiB, WS_WPB = 12 * MiB, WS_WOUT = 16 * MiB, WS_WIN = 24 * MiB;
constexpr size_t WS_W13 = 72 * MiB, WS_W2 = 328 * MiB;
constexpr size_t WS_H = 456 * MiB;
constexpr size_t WS_K = 492 * MiB, WS_V = 510 * MiB, WS_UX = 528 * MiB;
constexpr size_t WS_Q = 546 * MiB, WS_OF = 562 * MiB, WS_OB = 578 * MiB, WS_UG = 594 * MiB;
constexpr size_t WS_GA = 610 * MiB, WS_GB = 642 * MiB;
constexpr size_t WS_LA = 674 * MiB, WS_LB = 746 * MiB;
constexpr size_t WS_HS = 818 * MiB, WS_TM = 882 * MiB;
constexpr size_t WS_YA = 946 * MiB, WS_YB = 962 * MiB;
constexpr size_t WS_END = 978 * MiB;
constexpr size_t WS_PRE = WS_LA;
constexpr size_t WS_X1 = WS_LB;
constexpr size_t WS_H2 = WS_H;
constexpr size_t WS_XS = WS_K;
constexpr size_t WS_HM = 588 * MiB;
constexpr size_t WS_Y2 = WS_HS;
constexpr int CW_CNT = 64;
constexpr int CW_NT = 128;
constexpr int CW_TILE_E = 192;
constexpr int CW_BAR = 4096;

constexpr int RING_BYTES = 131072;
constexpr int LDSCTL_OFF = RING_BYTES;
constexpr int MISC_OFF = LDSCTL_OFF + 384;
constexpr int LDS_BYTES = 147456;

#define GAS __attribute__((address_space(1)))
#define LAS __attribute__((address_space(3)))
typedef unsigned short bf16;
typedef unsigned v4u __attribute__((ext_vector_type(4)));
typedef float f32x4 __attribute__((ext_vector_type(4)));
#define LDS_WAIT() asm volatile("s_waitcnt lgkmcnt(0)" ::: "memory")

__device__ __forceinline__ unsigned f2bf(float f) { unsigned u = __builtin_bit_cast(unsigned, f); return (u + 0x7fffu + ((u >> 16) & 1u)) >> 16; }
__device__ __forceinline__ unsigned pk2(float lo, float hi) { return f2bf(lo) | (f2bf(hi) << 16); }
__device__ __forceinline__ float bf2f(unsigned h) { return __builtin_bit_cast(float, h << 16); }
__device__ __forceinline__ float bflo(unsigned w) { return __builtin_bit_cast(float, w << 16); }
__device__ __forceinline__ float bfhi(unsigned w) { return __builtin_bit_cast(float, w & 0xffff0000u); }
__device__ __forceinline__ float sigmoidf_(float x) { return 1.f / (1.f + __expf(-x)); }
__device__ __forceinline__ float gelu_tanh(float x) { const float u = 0.7978845608028654f * (x + 0.044715f * x * x * x); return x / (1.f + __expf(-2.f * u)); }
__device__ __forceinline__ float wave_sum(float v) {
#pragma unroll
    for (int o = 1; o < 64; o <<= 1) v += __shfl_xor(v, o);
    return v;
}

#define XB_TMO      128
#define XB_XCNT(j)  (256  + 64 * (j))
#define XB_XSUB(j)  (1280 + 64 * (j))
#define XB_XGEN(j)  (2304 + 64 * (j))
#define XB_TOP      3328
#define XB_TOPGEN   3392
#define XCD_BAR_WORDS 3456
#define XB_SPIN_CAP (1u << 23)
__device__ __forceinline__ unsigned xb_ld(unsigned* p)              { return __hip_atomic_load(p, __ATOMIC_RELAXED, __HIP_MEMORY_SCOPE_AGENT); }
__device__ __forceinline__ unsigned xb_add(unsigned* p, unsigned v) { return __hip_atomic_fetch_add(p, v, __ATOMIC_RELAXED, __HIP_MEMORY_SCOPE_AGENT); }
__device__ __forceinline__ unsigned xb_xcc_id() { return (unsigned)__builtin_amdgcn_s_getreg((3 << 11) | 20) & 0xFu; }
#define XB_SPIN(cond, bar) do { unsigned _sp = 0; while (cond) { __builtin_amdgcn_s_sleep(1); \
    if ((++_sp & 255u) == 0u) { if (xb_ld(&(bar)[XB_TMO])) break; if (_sp > XB_SPIN_CAP) { atomicAdd(&(bar)[XB_TMO], 1u); break; } } } } while (0)
struct XcdBarrier { unsigned* bar; unsigned x; volatile LAS unsigned* st; };
__device__ __forceinline__ XcdBarrier xcd_barrier_post(unsigned* bar, volatile LAS unsigned* st) {
    XcdBarrier b; b.bar = bar; b.x = xb_xcc_id(); b.st = st;
    if (threadIdx.x == 0) (void)xb_add(&bar[XB_XCNT(b.x)], 1u);
    return b;
}
__device__ __forceinline__ void xcd_barrier_complete(unsigned* bar, unsigned x, unsigned& nloc, unsigned& nx) {
    const unsigned G = gridDim.x * gridDim.y * gridDim.z;
    unsigned sum, cnt, mine, sp = 0u;
    for (;;) {
        sum = 0u; cnt = 0u; mine = 0u;
#pragma unroll
        for (unsigned j = 0; j < 16; ++j) { const unsigned c = xb_ld(&bar[XB_XCNT(j)]); sum += c; cnt += (c > 0u) ? 1u : 0u; mine = (j == x) ? c : mine; }
        if (sum == G) break;
        __builtin_amdgcn_s_sleep(1);
        if ((++sp & 255u) == 0u) { if (xb_ld(&bar[XB_TMO])) break; if (sp > XB_SPIN_CAP) { atomicAdd(&bar[XB_TMO], 1u); break; } }
    }
    nloc = mine > 0u ? mine : 1u; nx = cnt > 0u ? cnt : 1u;
}
__device__ __forceinline__ void xcd_barrier(const XcdBarrier& b) {
    asm volatile("s_waitcnt vmcnt(0)" ::: "memory");
    __syncthreads();
    if (threadIdx.x == 0) {
        unsigned* bar = b.bar;
        __builtin_amdgcn_s_waitcnt(0);
        unsigned nloc = b.st[0], nx = b.st[1];
        if (nloc == 0u) { xcd_barrier_complete(bar, b.x, nloc, nx); b.st[0] = nloc; b.st[1] = nx; }
        const unsigned old = xb_add(&bar[XB_XSUB(b.x)], 1u);
        const unsigned gen = old / nloc;
        if (old + 1u == (gen + 1u) * nloc) {
            __builtin_amdgcn_fence(__ATOMIC_RELEASE, "agent");
            asm volatile("s_waitcnt vmcnt(0)" ::: "memory");
            const unsigned og = xb_add(&bar[XB_TOP], 1u);
            const unsigned tg = og / nx;
            if (og + 1u == (tg + 1u) * nx) xb_add(&bar[XB_TOPGEN], 1u);
            else XB_SPIN(xb_ld(&bar[XB_TOPGEN]) == tg, bar);
            __builtin_amdgcn_fence(__ATOMIC_ACQUIRE, "agent");
            xb_add(&bar[XB_XGEN(b.x)], 1u);
            asm volatile("s_waitcnt vmcnt(0)" ::: "memory");
        } else {
            XB_SPIN(xb_ld(&bar[XB_XGEN(b.x)]) == gen, bar);
            __builtin_amdgcn_fence(__ATOMIC_ACQUIRE, "agent");
            asm volatile("s_waitcnt vmcnt(0)" ::: "memory");
        }
    }
    __syncthreads();
}

__device__ __forceinline__ int fresh_tid() { int t = threadIdx.x; asm volatile("" : "+v"(t)); return t; }
struct Args { const float* in[27]; float* out; unsigned char* ws; int ph_lo, ph_hi; };
enum { I_X = 0, I_C, I_CTX, I_CCTX, I_WMOD, I_BMOD, I_N1G, I_WIN, I_BGATES, I_HEADG, I_CONVW, I_CONVB, I_LWA, I_LBA, I_LWX, I_LBX, I_LAM, I_WPA, I_WPB, I_WOUT, I_N2G, I_WRG, I_WRE, I_W1, I_W3, I_W2, I_FG };

__device__ __forceinline__ void tr_item(const float* __restrict__ W, size_t ldw, int k0, int n0, bf16* dst, size_t ldd, float scale, LAS float* scr, int lane) {
#pragma unroll 16
    for (int i = 0; i < 32; ++i) { const int kk = 2 * i + (lane >> 5); scr[kk * 33 + (lane & 31)] = W[(size_t)(k0 + kk) * ldw + n0 + (lane & 31)]; }
    LDS_WAIT(); asm volatile("" ::: "memory");
    const int c = lane & 7;
#pragma unroll
    for (int j = 0; j < 4; ++j) { const int n = (lane >> 3) + 8 * j; const LAS float* s = scr + (8 * c) * 33 + n;
        v4u o; o.x = pk2(s[0 * 33] * scale, s[1 * 33] * scale); o.y = pk2(s[2 * 33] * scale, s[3 * 33] * scale); o.z = pk2(s[4 * 33] * scale, s[5 * 33] * scale); o.w = pk2(s[6 * 33] * scale, s[7 * 33] * scale);
        *(GAS v4u*)(dst + (size_t)n * ldd + 8 * c) = o; }
    LDS_WAIT(); asm volatile("" ::: "memory");
}
__device__ __forceinline__ int win_row(int n0, float& scale) {
    scale = 1.f;
    if (n0 < 1024) return 13 * 256 + n0;
    if (n0 < 2048) { scale = 0.08838834764831845f; return n0 - 1024; }
    if (n0 < 3072) return 4 * 256 + (n0 - 2048);
    if (n0 < 4096) return 17 * 256 + (n0 - 3072);
    if (n0 < 5120) return 21 * 256 + (n0 - 4096);
    if (n0 < 5152) return 12 * 256 + (n0 - 5120);
    if (n0 < 6176) return 8 * 256 + (n0 - 5152);
    if (n0 < 7200) return 25 * 256 + (n0 - 6176);
    if (n0 < 9248) return 29 * 256 + (n0 - 7200);
    return 37 * 256 + (n0 - 9248);
}

__device__ __forceinline__ void phase0(const Args& a, unsigned char* lds_g, int tid, int lane, int wave) {
    unsigned char* ws = a.ws;
    {
        float* sl = (float*)lds_g;
        float* red = sl + 5 * 2048;
        for (int i = tid; i < 5 * 2048; i += NTHR) { const int r = i >> 11, k = i & 2047; const float v = r < 4 ? a.in[I_C][r * 2048 + k] : a.in[I_CCTX][k]; sl[i] = v / (1.f + __expf(-v)); }
        __syncthreads();
        const float* wm = a.in[I_WMOD]; const float* bm = a.in[I_BMOD]; float* MOD = (float*)(ws + WS_MOD);
        for (int cb = blockIdx.x; cb < 256; cb += gridDim.x) {
            const int n0 = cb * 48;
            if (tid < 504) {
                const int kq = tid / 12, cg = tid % 12;
                f32x4 acc[5];
#pragma unroll
                for (int r = 0; r < 5; ++r) acc[r] = (f32x4){0.f, 0.f, 0.f, 0.f};
#pragma unroll 7
                for (int k = kq; k < 2048; k += 42) {
                    const f32x4 w = *(const f32x4*)(wm + (size_t)k * 12288 + n0 + 4 * cg);
#pragma unroll
                    for (int r = 0; r < 5; ++r) acc[r] += w * sl[r * 2048 + k];
                }
#pragma unroll
                for (int r = 0; r < 5; ++r) *(f32x4*)(red + tid * 20 + r * 4) = acc[r];
            }
            __syncthreads();
            if (tid < 240) {
                const int cg = tid / 20, rj = tid % 20; float s = 0.f;
                for (int kq = 0; kq < 42; ++kq) s += red[(kq * 12 + cg) * 20 + rj];
                const int r = rj >> 2, j = rj & 3, n = n0 + 4 * cg + j;
                MOD[r * 12288 + n] = s + bm[n];
            }
            __syncthreads();
        }
    }
    {
        LAS float* scr = (LAS float*)((LAS unsigned char*)lds_g) + wave * 4096;
        const int gw = blockIdx.x * NWAVES + wave, NGW = gridDim.x * NWAVES;
        constexpr int J0 = 32 * 353, J1 = 16 * 64, J3 = 32 * 64, JE = 32 * 32;
        constexpr int NITEMS = J0 + 2 * J1 + J3 + 3 * 32 * JE;
        for (int it = gw; it < NITEMS; it += NGW) {
            int r = it;
            if (r < J0) { const int kb = r / 353, nb = r % 353; float sc; const int row = win_row(32 * nb, sc);
                tr_item(a.in[I_WIN], IN_DIM, 64 * kb, 32 * nb, (bf16*)(ws + WS_WIN) + (size_t)row * 2048 + 64 * kb, 2048, sc, scr, lane); continue; } r -= J0;
            if (r < J1) { const int kb = r / 64, nb = r % 64; tr_item(a.in[I_WPA], 2048, 64 * kb, 32 * nb, (bf16*)(ws + WS_WPA) + (size_t)(32 * nb) * 1024 + 64 * kb, 1024, 1.f, scr, lane); continue; } r -= J1;
            if (r < J1) { const int kb = r / 64, nb = r % 64; tr_item(a.in[I_WPB], 2048, 64 * kb, 32 * nb, (bf16*)(ws + WS_WPB) + (size_t)(32 * nb) * 1024 + 64 * kb, 1024, 1.f, scr, lane); continue; } r -= J1;
            if (r < J3) { const int kb = r / 64, nb = r % 64; tr_item(a.in[I_WOUT], 2048, 64 * kb, 32 * nb, (bf16*)(ws + WS_WOUT) + (size_t)(32 * nb) * 2048 + 64 * kb, 2048, 1.f, scr, lane); continue; } r -= J3;
            const int e = r / (3 * JE), q = r % (3 * JE), which = q / JE, j = q % JE;
            if (which < 2) {
                const int kb = j / 32, nb = j % 32, n0 = 32 * nb, row = (n0 >> 7) * 256 + which * 128 + (n0 & 127);
                tr_item(a.in[which ? I_W3 : I_W1] + (size_t)e * 2048 * 1024, 1024, 64 * kb, n0, (bf16*)(ws + WS_W13) + ((size_t)e * 2048 + row) * 2048 + 64 * kb, 2048, 1.f, scr, lane);
            } else {
                const int kb = j / 64, nb = j % 64;
                tr_item(a.in[I_W2] + (size_t)e * 1024 * 2048, 2048, 64 * kb, 32 * nb, (bf16*)(ws + WS_W2) + ((size_t)e * 2048 + 32 * nb) * 1024 + 64 * kb, 1024, 1.f, scr, lane);
            }
        }
        { GAS v4u* z = (GAS v4u*)((bf16*)(ws + WS_WIN) + (size_t)(12 * 256 + 32) * 2048); const int nchunks = 224 * 256;
          for (int i = blockIdx.x * NTHR + tid; i < nchunks; i += gridDim.x * NTHR) z[i] = (v4u){0u, 0u, 0u, 0u}; }
    }
}

__device__ __forceinline__ void phase1(const Args& a, int lane, int wave) {
    const int gw = blockIdx.x * NWAVES + wave, NGW = gridDim.x * NWAVES;
    const float* MOD = (const float*)(a.ws + WS_MOD); const float* g = a.in[I_N1G];
    bf16* H = (bf16*)(a.ws + WS_H);
    for (int r = gw; r < NTOK; r += NGW) {
        const float* src = r < NCTX ? a.in[I_CTX] + (size_t)r * D : a.in[I_X] + (size_t)(r - NCTX) * D;
        const int mr = r < NCTX ? 4 : (r - NCTX) / SEQ;
        const f32x4* xr = (const f32x4*)src + lane;
        f32x4 v[8]; float s = 0.f;
#pragma unroll
        for (int j = 0; j < 8; ++j) { v[j] = xr[64 * j]; s += (v[j].x * v[j].x + v[j].y * v[j].y) + (v[j].z * v[j].z + v[j].w * v[j].w); }
        const float rstd = 1.f / sqrtf(wave_sum(s) * (1.f / D) + EPS);
        unsigned long long* o8 = (unsigned long long*)(H + (size_t)r * D) + lane;
#pragma unroll
        for (int j = 0; j < 8; ++j) {
            const int c = 4 * lane + 256 * j;
            const f32x4 gg = *(const f32x4*)(g + c), sh = *(const f32x4*)(MOD + mr * 12288 + c), sc = *(const f32x4*)(MOD + mr * 12288 + 2048 + c);
            const f32x4 y = v[j] * rstd * gg * (sc + 1.f) + sh;
            o8[64 * j] = (unsigned long long)pk2(y.x, y.y) | ((unsigned long long)pk2(y.z, y.w) << 32);
        }
    }
}

struct SchedIn {
    int G, c; const char* A; const char* B;
    __device__ __forceinline__ bool next(int i, pg8::Unit& u) const {
        const int L = i * G + c; if (L >= 1492) return false;
        int pm, pn;
        if (L < 1440) { pg8::tile_order(L, 32, NT_IN, pm, pn); pm += 4; }
        else { const int j = L - 1440; pm = j & 3; pn = j >> 2; }
        u.pm = pm; u.pn = pn; u.aux = 0; u.A = A + (size_t)pm * 256 * D * 2; u.B = B + (size_t)pn * 256 * D * 2; return true;
    }
};
struct EpiIn {
    static constexpr bool PERM = true;
    unsigned char* ws; const float* b_gates;
    template <int ACT> __device__ __forceinline__ void store_tile(const pg8::f32x4 (&acc)[2][2][4][2], bf16* base, int ldc, int wr, int wc, int fr, int fq) const {
#pragma unroll
        for (int ai = 0; ai < 2; ++ai)
#pragma unroll
            for (int m = 0; m < 4; ++m) { bf16* rowp = base + (size_t)(ai * 128 + wr * 64 + m * 16 + fr) * ldc + wc * 32 + 8 * fq;
#pragma unroll
                for (int bj = 0; bj < 2; ++bj) { pg8::f32x4 v0 = acc[ai][bj][m][0], v1 = acc[ai][bj][m][1];
                    if (ACT == 1) {
#pragma unroll
                        for (int j = 0; j < 4; ++j) { v0[j] = sigmoidf_(v0[j]); v1[j] = sigmoidf_(v1[j]); } }
                    if (ACT == 2) {
#pragma unroll
                        for (int j = 0; j < 4; ++j) { v0[j] = gelu_tanh(v0[j]); v1[j] = gelu_tanh(v1[j]); } }
                    pg8::u32x4 w; w.x = pg8::cvt_pk_bf16(v0[0], v0[1]); w.y = pg8::cvt_pk_bf16(v0[2], v0[3]); w.z = pg8::cvt_pk_bf16(v1[0], v1[1]); w.w = pg8::cvt_pk_bf16(v1[2], v1[3]);
                    *(pg8::u32x4*)(rowp + bj * 128) = w; } }
    }
    __device__ __forceinline__ void operator()(const pg8::f32x4 (&acc)[2][2][4][2], const pg8::Unit& u, int wr, int wc, int fr, int fq) const {
        const int pn = u.pn; const size_t row0 = (size_t)u.pm * 256;
        if (pn < 12) {
            const int seg = pn >> 2, ct = pn & 3; bf16* dst = (bf16*)(ws + (seg == 0 ? WS_K : seg == 1 ? WS_V : WS_UX));
            store_tile<0>(acc, dst + row0 * 1024 + ct * 256, 1024, wr, wc, fr, fq);
        } else if (pn == 12) {
            if (wc == 0) {
                float* G = (float*)(ws + WS_GATES);
#pragma unroll
                for (int ai = 0; ai < 2; ++ai)
#pragma unroll
                    for (int m = 0; m < 4; ++m) { float* rowp = G + (row0 + ai * 128 + wr * 64 + m * 16 + fr) * 32 + 8 * fq;
#pragma unroll
                        for (int n = 0; n < 2; ++n) { const pg8::f32x4 bv = *(const pg8::f32x4*)(b_gates + 8 * fq + 4 * n); *(pg8::f32x4*)(rowp + 4 * n) = acc[ai][0][m][n] + bv; } }
            }
        } else if (pn < 29) {
            const int seg = (pn - 13) >> 2, ct = (pn - 13) & 3; const size_t lr = row0 - NCTX;
            bf16* dst = (bf16*)(ws + (seg == 0 ? WS_Q : seg == 1 ? WS_OF : seg == 2 ? WS_OB : WS_UG)) + lr * 1024 + ct * 256;
            if (seg == 0) store_tile<0>(acc, dst, 1024, wr, wc, fr, fq);
            else if (seg == 3) store_tile<2>(acc, dst, 1024, wr, wc, fr, fq);
            else store_tile<1>(acc, dst, 1024, wr, wc, fr, fq);
        } else {
            const int seg = (pn - 29) >> 3, ct = (pn - 29) & 7; const size_t lr = row0 - NCTX;
            store_tile<1>(acc, (bf16*)(ws + (seg ? WS_GB : WS_GA)) + lr * 2048 + ct * 256, 2048, wr, wc, fr, fq);
        }
    }
};

__device__ __forceinline__ int conv_src_row(int r, int d) {
    if (r < NCTX) { const int b = r >> 8, j = (r & 255) + d; return (j < 0 || j >= CTXL) ? -1 : b * CTXL + j; }
    const int q = r - NCTX, b = q >> 11, t = q & 2047, p = (t & 63) * 32 + (t >> 6) + d;
    if (p < 0 || p >= SEQ) return -1;
    return NCTX + b * SEQ + (p & 31) * 64 + (p >> 5);
}
__device__ __forceinline__ void phase3(const Args& a, unsigned char* lds_g, int tid) {
    float* zl = (float*)lds_g;
    const bf16* UX = (const bf16*)(a.ws + WS_UX);
    const float* cw = a.in[I_CONVW]; const float* cb = a.in[I_CONVB];
    float* LA = (float*)(a.ws + WS_LA); float* LB = (float*)(a.ws + WS_LB);
    for (int item = blockIdx.x; item < NTOK / 8; item += gridDim.x) {
        const int r0 = item * 8;
        for (int tk = 0; tk < 8; ++tk) {
            const int r = r0 + tk;
#pragma unroll
            for (int h = 0; h < 2; ++h) { const int ch = tid + 512 * h; float z = cb[ch];
#pragma unroll
                for (int w = 0; w < 4; ++w) { const int sr = conv_src_row(r, w - 2); if (sr >= 0) z += cw[w * 1024 + ch] * bf2f(UX[(size_t)sr * 1024 + ch]); }
                zl[tk * 1024 + ch] = z; }
        }
        __syncthreads();
        float acc[8][2][2][2];
#pragma unroll
        for (int t = 0; t < 8; ++t)
#pragma unroll
            for (int d1 = 0; d1 < 2; ++d1)
#pragma unroll
                for (int d2 = 0; d2 < 2; ++d2) { acc[t][d1][d2][0] = 0.f; acc[t][d1][d2][1] = 0.f; }
        const int blk0 = tid >> 7, dd = tid & 127;
        for (int c = 0; c < 128; ++c) {
            float w[2][2][2];
#pragma unroll
            for (int dir = 0; dir < 2; ++dir)
#pragma unroll
                for (int h = 0; h < 2; ++h) { const size_t wo = ((size_t)(dir * 8 + blk0 + 4 * h) * 128 + c) * 128 + dd; w[dir][0][h] = a.in[I_LWA][wo]; w[dir][1][h] = a.in[I_LWX][wo]; }
#pragma unroll
            for (int t = 0; t < 8; ++t) { const float z0 = zl[t * 1024 + blk0 * 128 + c], z1 = zl[t * 1024 + 512 + blk0 * 128 + c];
#pragma unroll
                for (int dir = 0; dir < 2; ++dir)
#pragma unroll
                    for (int mt = 0; mt < 2; ++mt) { acc[t][dir][mt][0] += z0 * w[dir][mt][0]; acc[t][dir][mt][1] += z1 * w[dir][mt][1]; } }
        }
#pragma unroll
        for (int dir = 0; dir < 2; ++dir)
#pragma unroll
            for (int h = 0; h < 2; ++h) { const int ch = tid + 512 * h;
                const float ba = a.in[I_LBA][dir * 1024 + ch], bx = a.in[I_LBX][dir * 1024 + ch], lam = a.in[I_LAM][dir * 1024 + ch];
                const float sp = (-lam > 20.f) ? -lam : log1pf(__expf(-lam));
#pragma unroll
                for (int t = 0; t < 8; ++t) { const float rr = sigmoidf_(acc[t][dir][0][h] + ba), ii = sigmoidf_(acc[t][dir][1][h] + bx);
                    const float la = -8.f * rr * sp, av = __expf(la), mult = sqrtf(fmaxf(-expm1f(2.f * la), 0.f));
                    const size_t o = ((size_t)dir * NTOK + r0 + t) * 1024 + ch;
                    LA[o] = av; LB[o] = mult * ii * zl[t * 1024 + ch]; } }
        __syncthreads();
    }
}

__device__ __forceinline__ int scan_row(int b, int dir, int s) {
    if (s < CTXL) return b * CTXL + (dir ? (CTXL - 1 - s) : s);
    const int t = s - CTXL; return NCTX + b * SEQ + (dir ? (SEQ - 1 - t) : t);
}
__device__ __forceinline__ void phase4_mlstm(const Args& a, unsigned char* lds_g, int unit, int tid, int lane, int wave) {
    const int b = unit >> 4, h = (unit >> 1) & 7, dir = unit & 1;
    const int v = tid >> 2, kq = tid & 3;
    const bf16* Kb = (const bf16*)(a.ws + WS_K); const bf16* Vb = (const bf16*)(a.ws + WS_V); const bf16* Qb = (const bf16*)(a.ws + WS_Q);
    const bf16* OG = (const bf16*)(a.ws + (dir ? WS_OB : WS_OF));
    const float* GT = (const float*)(a.ws + WS_GATES);
    float* TM = (float*)(a.ws + WS_TM) + (size_t)dir * NLAT * 1024;
    const float hg = a.in[I_HEADG][h * 128 + v];
    float* red = (float*)lds_g;
    float C[32], n[32];
#pragma unroll
    for (int j = 0; j < 32; ++j) { C[j] = 0.f; n[j] = 0.f; }
    for (int s = 0; s < NSTEP; ++s) {
        const int r = scan_row(b, dir, s);
        const float ipre = GT[r * 32 + (dir * 2) * 8 + h], fpre = GT[r * 32 + (dir * 2 + 1) * 8 + h];
        const float f = sigmoidf_(fpre), ig = __expf(ipre);
        const v4u* kp = (const v4u*)(Kb + (size_t)r * 1024 + h * 128 + 32 * kq);
        float kk[32];
#pragma unroll
        for (int q = 0; q < 4; ++q) { const v4u w = kp[q]; kk[8 * q + 0] = bflo(w.x); kk[8 * q + 1] = bfhi(w.x); kk[8 * q + 2] = bflo(w.y); kk[8 * q + 3] = bfhi(w.y); kk[8 * q + 4] = bflo(w.z); kk[8 * q + 5] = bfhi(w.z); kk[8 * q + 6] = bflo(w.w); kk[8 * q + 7] = bfhi(w.w); }
        const float vv = bf2f(Vb[(size_t)r * 1024 + h * 128 + v]) * ig;
#pragma unroll
        for (int j = 0; j < 32; ++j) { C[j] = f * C[j] + vv * kk[j]; n[j] = f * n[j] + ig * kk[j]; }
        if (s >= CTXL) {
            const int lr = r - NCTX;
            const v4u* qp = (const v4u*)(Qb + (size_t)lr * 1024 + h * 128 + 32 * kq);
            float num = 0.f, den = 0.f;
#pragma unroll
            for (int q = 0; q < 4; ++q) { const v4u w = qp[q]; float qq[8] = {bflo(w.x), bfhi(w.x), bflo(w.y), bfhi(w.y), bflo(w.z), bfhi(w.z), bflo(w.w), bfhi(w.w)};
#pragma unroll
                for (int j = 0; j < 8; ++j) { num += C[8 * q + j] * qq[j]; den += n[8 * q + j] * qq[j]; } }
            num += __shfl_xor(num, 1); num += __shfl_xor(num, 2); den += __shfl_xor(den, 1); den += __shfl_xor(den, 2);
            const float hv = num / fmaxf(fabsf(den), 1.f);
            float sq = (kq == 0) ? hv * hv : 0.f; sq = wave_sum(sq);
            float* rd = red + (s & 1) * 8;
            if (lane == 0) rd[wave] = sq;
            __syncthreads();
            float tot = 0.f;
#pragma unroll
            for (int w = 0; w < 8; ++w) tot += rd[w];
            const float hn = hv * (1.f / sqrtf(tot * (1.f / 128.f) + EPS)) * hg;
            if (kq == 0) { const size_t o = (size_t)lr * 1024 + h * 128 + v; TM[o] = hn * bf2f(OG[o]); }
        }
    }
}
__device__ __forceinline__ void phase4_lru(const Args& a, int unit, int tid) {
    const int b = unit >> 2, dir = (unit >> 1) & 1, ch = (unit & 1) * 512 + tid;
    const float* LA = (const float*)(a.ws + WS_LA) + (size_t)dir * NTOK * 1024; const float* LB = (const float*)(a.ws + WS_LB) + (size_t)dir * NTOK * 1024;
    float* HS = (float*)(a.ws + WS_HS) + (size_t)dir * NLAT * 1024;
    float hst = 0.f;
#pragma unroll 8
    for (int s = 0; s < NSTEP; ++s) {
        const int r = scan_row(b, dir, s);
        int rr = r;
        if (s >= CTXL) { const int p = r - NCTX - b * SEQ; rr = NCTX + b * SEQ + (p & 31) * 64 + (p >> 5); }
        hst = LA[(size_t)rr * 1024 + ch] * hst + LB[(size_t)rr * 1024 + ch];
        if (s >= CTXL) HS[(size_t)(rr - NCTX) * 1024 + ch] = hst;
    }
}

__device__ __forceinline__ void phase5(const Args& a, int tid) {
    const float* TM = (const float*)(a.ws + WS_TM); const float* HS = (const float*)(a.ws + WS_HS); const bf16* UG = (const bf16*)(a.ws + WS_UG);
    bf16* YA = (bf16*)(a.ws + WS_YA); bf16* YB = (bf16*)(a.ws + WS_YB);
    const size_t n4 = (size_t)NLAT * 1024 / 4, stride = (size_t)gridDim.x * NTHR;
    for (size_t i = (size_t)blockIdx.x * NTHR + tid; i < n4; i += stride) {
        const f32x4 t0 = ((const f32x4*)TM)[i], t1 = ((const f32x4*)TM)[n4 + i];
        const f32x4 h0 = ((const f32x4*)HS)[i], h1 = ((const f32x4*)HS)[n4 + i];
        const unsigned long long ug = ((const unsigned long long*)UG)[i];
        const unsigned u0 = (unsigned)ug, u1 = (unsigned)(ug >> 32);
        const f32x4 ya = t0 + t1; f32x4 yb = h0 + h1; yb.x *= bflo(u0); yb.y *= bfhi(u0); yb.z *= bflo(u1); yb.w *= bfhi(u1);
        ((unsigned long long*)YA)[i] = (unsigned long long)pk2(ya.x, ya.y) | ((unsigned long long)pk2(ya.z, ya.w) << 32);
        ((unsigned long long*)YB)[i] = (unsigned long long)pk2(yb.x, yb.y) | ((unsigned long long)pk2(yb.z, yb.w) << 32);
    }
}

struct SchedProj {
    int G, c; const char *YA, *YB, *WA, *WB;
    __device__ __forceinline__ bool next(int i, pg8::Unit& u) const {
        const int tile = (i >> 1) * G + c, part = i & 1; if (tile >= 256) return false;
        int pm, pn; pg8::tile_order(tile, 32, 8, pm, pn);
        u.pm = pm; u.pn = pn; u.aux = part; u.A = (part ? YB : YA) + (size_t)pm * 256 * 1024 * 2; u.B = (part ? WB : WA) + (size_t)pn * 256 * 1024 * 2; return true;
    }
};
struct EpiProj {
    static constexpr bool PERM = true;
    const bf16 *GA, *GB; bf16* PRE;
    __device__ __forceinline__ void operator()(const pg8::f32x4 (&acc)[2][2][4][2], const pg8::Unit& u, int wr, int wc, int fr, int fq) const {
        const bf16* gsrc = u.aux ? GB : GA;
#pragma unroll
        for (int ai = 0; ai < 2; ++ai)
#pragma unroll
            for (int m = 0; m < 4; ++m) { const size_t off = (size_t)(u.pm * 256 + ai * 128 + wr * 64 + m * 16 + fr) * 2048 + u.pn * 256 + wc * 32 + 8 * fq;
#pragma unroll
                for (int bj = 0; bj < 2; ++bj) { const pg8::u32x4 gw = *(const pg8::u32x4*)(gsrc + off + bj * 128);
                    pg8::f32x4 v0 = acc[ai][bj][m][0], v1 = acc[ai][bj][m][1];
                    v0[0] *= bflo(gw.x); v0[1] *= bfhi(gw.x); v0[2] *= bflo(gw.y); v0[3] *= bfhi(gw.y); v1[0] *= bflo(gw.z); v1[1] *= bfhi(gw.z); v1[2] *= bflo(gw.w); v1[3] *= bfhi(gw.w);
                    if (u.aux) { const pg8::u32x4 pw = *(const pg8::u32x4*)(PRE + off + bj * 128);
                        v0[0] += bflo(pw.x); v0[1] += bfhi(pw.x); v0[2] += bflo(pw.y); v0[3] += bfhi(pw.y); v1[0] += bflo(pw.z); v1[1] += bfhi(pw.z); v1[2] += bflo(pw.w); v1[3] += bfhi(pw.w); }
                    pg8::u32x4 w; w.x = pg8::cvt_pk_bf16(v0[0], v0[1]); w.y = pg8::cvt_pk_bf16(v0[2], v0[3]); w.z = pg8::cvt_pk_bf16(v1[0], v1[1]); w.w = pg8::cvt_pk_bf16(v1[2], v1[3]);
                    *(pg8::u32x4*)(PRE + off + bj * 128) = w; } }
    }
};

struct SchedOut {
    int G, c; const char *A, *B;
    __device__ __forceinline__ bool next(int i, pg8::Unit& u) const {
        const int L = i * G + c; if (L >= 256) return false;
        int pm, pn; pg8::tile_order(L, 32, 8, pm, pn);
        u.pm = pm; u.pn = pn; u.aux = 0; u.A = A + (size_t)pm * 256 * D * 2; u.B = B + (size_t)pn * 256 * D * 2; return true;
    }
};
struct EpiOut {
    static constexpr bool PERM = false;
    const float* x; const float* MOD; float* X1;
    __device__ __forceinline__ void operator()(const pg8::f32x4 (&acc)[2][2][4][2], const pg8::Unit& u, int wr, int wc, int fr, int fq) const {
        const int b = u.pm >> 3; const int col0 = u.pn * 256 + wc * 32 + 4 * fq;
        pg8::f32x4 g1[2][2];
#pragma unroll
        for (int bj = 0; bj < 2; ++bj)
#pragma unroll
            for (int n = 0; n < 2; ++n) g1[bj][n] = *(const pg8::f32x4*)(MOD + b * 12288 + 2 * 2048 + col0 + bj * 128 + n * 16);
#pragma unroll
        for (int ai = 0; ai < 2; ++ai)
#pragma unroll
            for (int m = 0; m < 4; ++m) { const size_t off = (size_t)(u.pm * 256 + ai * 128 + wr * 64 + m * 16 + fr) * D + col0;
#pragma unroll
                for (int bj = 0; bj < 2; ++bj)
#pragma unroll
                    for (int n = 0; n < 2; ++n) { const pg8::f32x4 xv = *(const pg8::f32x4*)(x + off + bj * 128 + n * 16); *(pg8::f32x4*)(X1 + off + bj * 128 + n * 16) = xv + g1[bj][n] * acc[ai][bj][m][n]; } }
    }
};

__device__ __forceinline__ void phase8(const Args& a, int lane, int wave) {
    const int gw = blockIdx.x * NWAVES + wave, NGW = gridDim.x * NWAVES;
    const float* X1 = (const float*)(a.ws + WS_X1); const float* MOD = (const float*)(a.ws + WS_MOD); const float* g = a.in[I_N2G];
    const float* wrg = a.in[I_WRG]; const float* wre = a.in[I_WRE];
    bf16* H2 = (bf16*)(a.ws + WS_H2); unsigned* cnt = (unsigned*)(a.ws + WS_CTL) + CW_CNT; int4* ASG = (int4*)(a.ws + WS_ASG);
    for (int t = gw; t < NLAT; t += NGW) {
        const int b = t >> 11;
        const f32x4* xr = (const f32x4*)(X1 + (size_t)t * D) + lane;
        f32x4 v[8]; float s = 0.f;
#pragma unroll
        for (int j = 0; j < 8; ++j) { v[j] = xr[64 * j]; s += (v[j].x * v[j].x + v[j].y * v[j].y) + (v[j].z * v[j].z + v[j].w * v[j].w); }
        const float rstd = 1.f / sqrtf(wave_sum(s) * (1.f / D) + EPS);
        unsigned long long* o8 = (unsigned long long*)(H2 + (size_t)t * D) + lane;
        float lg[36];
#pragma unroll
        for (int q = 0; q < 36; ++q) lg[q] = 0.f;
#pragma unroll
        for (int j = 0; j < 8; ++j) {
            const int c = 4 * lane + 256 * j;
            const f32x4 gg = *(const f32x4*)(g + c), sh = *(const f32x4*)(MOD + b * 12288 + 3 * 2048 + c), sc = *(const f32x4*)(MOD + b * 12288 + 4 * 2048 + c);
            const f32x4 y = v[j] * rstd * gg * (sc + 1.f) + sh;
            o8[64 * j] = (unsigned long long)pk2(y.x, y.y) | ((unsigned long long)pk2(y.z, y.w) << 32);
#pragma unroll
            for (int e = 0; e < 4; ++e) { const float yv = y[e]; const int k = c + e;
                const f32x4 wg = *(const f32x4*)(wrg + (size_t)k * 4);
                lg[0] += yv * wg.x; lg[1] += yv * wg.y; lg[2] += yv * wg.z; lg[3] += yv * wg.w;
#pragma unroll
                for (int q = 0; q < 8; ++q) { const f32x4 we = *(const f32x4*)(wre + (size_t)k * 32 + 4 * q); lg[4 + 4 * q] += yv * we.x; lg[5 + 4 * q] += yv * we.y; lg[6 + 4 * q] += yv * we.z; lg[7 + 4 * q] += yv * we.w; } }
        }
#pragma unroll
        for (int q = 0; q < 36; ++q) lg[q] = wave_sum(lg[q]);
        if (lane == 0) {
            int gs = 0; float gm = lg[0];
#pragma unroll
            for (int q = 1; q < 4; ++q) if (lg[q] > gm) { gm = lg[q]; gs = q; }
            float se = 0.f;
#pragma unroll
            for (int q = 0; q < 4; ++q) se += __expf(lg[q] - gm);
            const float pg = 1.f / se;
            float el[8];
#pragma unroll
            for (int q = 0; q < 8; ++q) { el[q] = gs == 0 ? lg[4 + q] : gs == 1 ? lg[12 + q] : gs == 2 ? lg[20 + q] : lg[28 + q]; }
            int i0 = 0; float v0 = el[0];
#pragma unroll
            for (int q = 1; q < 8; ++q) if (el[q] > v0) { v0 = el[q]; i0 = q; }
            int i1 = -1; float v1 = -3.0e38f;
#pragma unroll
            for (int q = 0; q < 8; ++q) if (q != i0 && el[q] > v1) { v1 = el[q]; i1 = q; }
            const float e1 = __expf(v1 - v0), w0 = pg / (1.f + e1), w1 = pg * e1 / (1.f + e1);
            const int ex0 = gs * 8 + i0, ex1 = gs * 8 + i1;
            const unsigned p0 = atomicAdd(cnt + ex0, 1u), p1 = atomicAdd(cnt + ex1, 1u);
            ASG[2 * t] = make_int4(ex0, (int)p0, __float_as_int(w0), 0); ASG[2 * t + 1] = make_int4(ex1, (int)p1, __float_as_int(w1), 0);
        }
    }
}

__device__ __forceinline__ void phase9(const Args& a, unsigned char* lds_g, int tid, int lane, int wave) {
    int* cum = (int*)lds_g;
    unsigned* ctl = (unsigned*)(a.ws + WS_CTL);
    if (tid == 0) { int c = 0; for (int e = 0; e < NEXP; ++e) { cum[e] = c; c += (int)((ctl[CW_CNT + e] + 255u) >> 8); } cum[NEXP] = c;
        if (blockIdx.x == 0) { ctl[CW_NT] = (unsigned)c; for (int e = 0; e < NEXP; ++e) for (int ti = cum[e]; ti < cum[e + 1]; ++ti) ctl[CW_TILE_E + ti] = (unsigned)e; } }
    __syncthreads();
    const int gw = blockIdx.x * NWAVES + wave, NGW = gridDim.x * NWAVES;
    int4* ASG = (int4*)(a.ws + WS_ASG); const bf16* H2 = (const bf16*)(a.ws + WS_H2); bf16* XS = (bf16*)(a.ws + WS_XS);
    for (int as = gw; as < 2 * NLAT; as += NGW) {
        const int4 q = ASG[as]; const int slot = cum[q.x] * 256 + q.y, t = as >> 1;
        if (lane == 0) ASG[as].w = slot;
        const v4u* src = (const v4u*)(H2 + (size_t)t * D) + lane; v4u* dst = (v4u*)(XS + (size_t)slot * D) + lane;
#pragma unroll
        for (int j = 0; j < 4; ++j) dst[64 * j] = src[64 * j];
    }
}

struct SchedMoe {
    int G, c; const char *A, *B; size_t a_tile, b_exp, b_tile; const LAS unsigned* tl;
    __device__ __forceinline__ bool next(int i, pg8::Unit& u) const {
        const int L = i * G + c, ti = L >> 3, nt = L & 7; if (ti >= (int)tl[0]) return false;
        const int e = (int)tl[4 + ti];
        u.pm = ti; u.pn = nt; u.aux = e; u.A = A + (size_t)ti * a_tile; u.B = B + (size_t)e * b_exp + (size_t)nt * b_tile; return true;
    }
};
struct EpiMoe1 {
    static constexpr bool PERM = true;
    bf16* HM;
    __device__ __forceinline__ void operator()(const pg8::f32x4 (&acc)[2][2][4][2], const pg8::Unit& u, int wr, int wc, int fr, int fq) const {
#pragma unroll
        for (int ai = 0; ai < 2; ++ai)
#pragma unroll
            for (int m = 0; m < 4; ++m) { bf16* p = HM + (size_t)(u.pm * 256 + ai * 128 + wr * 64 + m * 16 + fr) * DE + u.pn * 128 + wc * 32 + 8 * fq;
                pg8::f32x4 v0, v1;
#pragma unroll
                for (int j = 0; j < 4; ++j) { const float a0 = acc[ai][0][m][0][j], a1 = acc[ai][0][m][1][j]; v0[j] = a0 * sigmoidf_(a0) * acc[ai][1][m][0][j]; v1[j] = a1 * sigmoidf_(a1) * acc[ai][1][m][1][j]; }
                pg8::u32x4 w; w.x = pg8::cvt_pk_bf16(v0[0], v0[1]); w.y = pg8::cvt_pk_bf16(v0[2], v0[3]); w.z = pg8::cvt_pk_bf16(v1[0], v1[1]); w.w = pg8::cvt_pk_bf16(v1[2], v1[3]);
                *(pg8::u32x4*)p = w; }
    }
};
struct EpiMoe2 {
    static constexpr bool PERM = true;
    bf16* Y2;
    __device__ __forceinline__ void operator()(const pg8::f32x4 (&acc)[2][2][4][2], const pg8::Unit& u, int wr, int wc, int fr, int fq) const {
#pragma unroll
        for (int ai = 0; ai < 2; ++ai)
#pragma unroll
            for (int m = 0; m < 4; ++m) { bf16* rowp = Y2 + (size_t)(u.pm * 256 + ai * 128 + wr * 64 + m * 16 + fr) * D + u.pn * 256 + wc * 32 + 8 * fq;
#pragma unroll
                for (int bj = 0; bj < 2; ++bj) { const pg8::f32x4 v0 = acc[ai][bj][m][0], v1 = acc[ai][bj][m][1];
                    pg8::u32x4 w; w.x = pg8::cvt_pk_bf16(v0[0], v0[1]); w.y = pg8::cvt_pk_bf16(v0[2], v0[3]); w.z = pg8::cvt_pk_bf16(v1[0], v1[1]); w.w = pg8::cvt_pk_bf16(v1[2], v1[3]);
                    *(pg8::u32x4*)(rowp + bj * 128) = w; } }
    }
};
__device__ __forceinline__ void load_tile_table(const Args& a, LAS unsigned* tl, int tid) {
    const unsigned* ctl = (const unsigned*)(a.ws + WS_CTL);
    if (tid == 0) tl[0] = ctl[CW_NT];
    if (tid < MAXTILES) tl[4 + tid] = ctl[CW_TILE_E + tid];
    __syncthreads();
}

__device__ __forceinline__ void phase12(const Args& a, int lane, int wave) {
    const int gw = blockIdx.x * NWAVES + wave, NGW = gridDim.x * NWAVES;
    const float* X1 = (const float*)(a.ws + WS_X1); const float* MOD = (const float*)(a.ws + WS_MOD); const float* fg = a.in[I_FG];
    const int4* ASG = (const int4*)(a.ws + WS_ASG); const bf16* Y2 = (const bf16*)(a.ws + WS_Y2);
    for (int t = gw; t < NLAT; t += NGW) {
        const int b = t >> 11; const int4 q0 = ASG[2 * t], q1 = ASG[2 * t + 1];
        const float w0 = __int_as_float(q0.z), w1 = __int_as_float(q1.z);
        const f32x4* xr = (const f32x4*)(X1 + (size_t)t * D) + lane;
        const unsigned long long* y0 = (const unsigned long long*)(Y2 + (size_t)q0.w * D) + lane; const unsigned long long* y1 = (const unsigned long long*)(Y2 + (size_t)q1.w * D) + lane;
        f32x4 v[8]; float s = 0.f;
#pragma unroll
        for (int j = 0; j < 8; ++j) {
            const int c = 4 * lane + 256 * j;
            const f32x4 g2 = *(const f32x4*)(MOD + b * 12288 + 5 * 2048 + c);
            const unsigned long long a0 = y0[64 * j], a1 = y1[64 * j];
            f32x4 y; y.x = w0 * bflo((unsigned)a0) + w1 * bflo((unsigned)a1); y.y = w0 * bfhi((unsigned)a0) + w1 * bfhi((unsigned)a1);
            y.z = w0 * bflo((unsigned)(a0 >> 32)) + w1 * bflo((unsigned)(a1 >> 32)); y.w = w0 * bfhi((unsigned)(a0 >> 32)) + w1 * bfhi((unsigned)(a1 >> 32));
            v[j] = xr[64 * j] + g2 * y;
            s += (v[j].x * v[j].x + v[j].y * v[j].y) + (v[j].z * v[j].z + v[j].w * v[j].w);
        }
        const float rstd = 1.f / sqrtf(wave_sum(s) * (1.f / D) + EPS);
        f32x4* o = (f32x4*)(a.out + (size_t)t * D) + lane;
#pragma unroll
        for (int j = 0; j < 8; ++j) o[64 * j] = v[j] * rstd * *(const f32x4*)(fg + 4 * lane + 256 * j);
    }
}

__global__ void __launch_bounds__(NTHR, 2) fwd_kernel(Args args) {
    extern __shared__ __attribute__((aligned(16))) unsigned char lds[];
    LAS unsigned char* ldsl = (LAS unsigned char*)lds;
    volatile LAS unsigned* MISC = (volatile LAS unsigned*)(ldsl + MISC_OFF);
    LAS unsigned* TL = (LAS unsigned*)(ldsl + LDSCTL_OFF);
    { const int t0 = fresh_tid(); for (int u = t0; u < (LDS_BYTES - LDSCTL_OFF) / 4; u += NTHR) ((LAS unsigned*)(ldsl + LDSCTL_OFF))[u] = 0u; }
    __syncthreads();
    unsigned char* ws = args.ws;
    unsigned* ctl = (unsigned*)(ws + WS_CTL);
    XcdBarrier bar; bar.bar = ctl + CW_BAR; bar.x = 0; bar.st = nullptr;
    const bool one_launch = (args.ph_hi - args.ph_lo) > 1;
    if (one_launch) bar = xcd_barrier_post(ctl + CW_BAR, MISC + 8);
    const int lo = args.ph_lo, hi = args.ph_hi;
#define IN(k) (lo <= (k) && (k) < hi)
#define SEAM(k) do { if (IN(k) && IN((k) + 1)) xcd_barrier(bar); } while (0)
    const int G = gridDim.x, c = blockIdx.x;

#define FRESH() const int tid = fresh_tid(), lane = tid & 63, wave = __builtin_amdgcn_readfirstlane(tid >> 6); (void)lane; (void)wave
    if (IN(0)) { FRESH(); phase0(args, lds, tid, lane, wave); } SEAM(0);
    if (IN(1)) { FRESH(); phase1(args, lane, wave); } SEAM(1);
    if (IN(2)) {
        SchedIn S{G, c, (const char*)(ws + WS_H), (const char*)(ws + WS_WIN)}; EpiIn E{ws, args.in[I_BGATES]};
        pg8::gemm_phase<EpiIn, SchedIn>(ldsl, D, S, E);
    } SEAM(2);
    if (IN(3)) { FRESH(); phase3(args, lds, tid); } SEAM(3);
    if (IN(4)) { FRESH();
        for (int u = c; u < 80; u += G) { if (u < 64) phase4_mlstm(args, lds, u, tid, lane, wave); else phase4_lru(args, u - 64, tid); __syncthreads(); }
    } SEAM(4);
    if (IN(5)) { FRESH(); phase5(args, tid); } SEAM(5);
    if (IN(6)) {
        SchedProj S{G, c, (const char*)(ws + WS_YA), (const char*)(ws + WS_YB), (const char*)(ws + WS_WPA), (const char*)(ws + WS_WPB)};
        EpiProj E{(const bf16*)(ws + WS_GA), (const bf16*)(ws + WS_GB), (bf16*)(ws + WS_PRE)};
        pg8::gemm_phase<EpiProj, SchedProj>(ldsl, 1024, S, E);
    } SEAM(6);
    if (IN(7)) {
        SchedOut S{G, c, (const char*)(ws + WS_PRE), (const char*)(ws + WS_WOUT)}; EpiOut E{args.in[I_X], (const float*)(ws + WS_MOD), (float*)(ws + WS_X1)};
        pg8::gemm_phase<EpiOut, SchedOut>(ldsl, D, S, E);
    } SEAM(7);
    if (IN(8)) { FRESH(); phase8(args, lane, wave); } SEAM(8);
    if (IN(9)) { FRESH(); phase9(args, lds, tid, lane, wave); } SEAM(9);
    if (IN(10)) {
        { FRESH(); load_tile_table(args, TL, tid); }
        SchedMoe S{G, c, (const char*)(ws + WS_XS), (const char*)(ws + WS_W13), (size_t)256 * D * 2, (size_t)2048 * D * 2, (size_t)256 * D * 2, TL}; EpiMoe1 E{(bf16*)(ws + WS_HM)};
        pg8::gemm_phase<EpiMoe1, SchedMoe>(ldsl, D, S, E);
    } SEAM(10);
    if (IN(11)) {
        { FRESH(); load_tile_table(args, TL, tid); }
        SchedMoe S{G, c, (const char*)(ws + WS_HM), (const char*)(ws + WS_W2), (size_t)256 * DE * 2, (size_t)2048 * DE * 2, (size_t)256 * DE * 2, TL}; EpiMoe2 E{(bf16*)(ws + WS_Y2)};
        pg8::gemm_phase<EpiMoe2, SchedMoe>(ldsl, DE, S, E);
    } SEAM(11);
    if (IN(12)) { FRESH(); phase12(args, lane, wave); }
#undef IN
#undef SEAM
}

extern "C" void kernel_launch(void* const* d_in, const int* in_sizes, int n_in, void* d_out, int out_size, void* d_ws, size_t ws_size, hipStream_t stream) {
    static int grid = 0;
    if (grid == 0) {
        if (n_in != 27 || out_size != NLAT * D || ws_size < WS_END) { fprintf(stderr, "kernel_launch: unexpected shapes (n_in %d, out %d, ws %zu)\n", n_in, out_size, ws_size); grid = -1; return; }
        int dev = 0, cus = 0, per_cu = 0;
        if (hipGetDevice(&dev) != hipSuccess || hipDeviceGetAttribute(&cus, hipDeviceAttributeMultiprocessorCount, dev) != hipSuccess) { grid = -1; return; }
        if (hipFuncSetAttribute((const void*)fwd_kernel, hipFuncAttributeMaxDynamicSharedMemorySize, LDS_BYTES) != hipSuccess) { fprintf(stderr, "kernel_launch: hipFuncSetAttribute failed\n"); grid = -1; return; }
        if (hipOccupancyMaxActiveBlocksPerMultiprocessor(&per_cu, (const void*)fwd_kernel, NTHR, LDS_BYTES) != hipSuccess || per_cu < 1) fprintf(stderr, "kernel_launch: occupancy query says %d\n", per_cu);
        (void)hipGetLastError();
        grid = cus;
    }
    if (grid < 0) return;
    (void)hipMemsetAsync((char*)d_ws + WS_CTL, 0, CTL_ZERO_BYTES, stream);
    Args a{};
    for (int i = 0; i < 27; ++i) a.in[i] = (const float*)d_in[i];
    a.out = (float*)d_out; a.ws = (unsigned char*)d_ws;
#if MK_ONE_LAUNCH
    a.ph_lo = 0; a.ph_hi = NPHASE;
    hipLaunchKernelGGL(fwd_kernel, dim3(grid), dim3(NTHR), LDS_BYTES, stream, a);
#else
    for (int p = 0; p < NPHASE; ++p) { a.ph_lo = p; a.ph_hi = p + 1; hipLaunchKernelGGL(fwd_kernel, dim3(grid), dim3(NTHR), LDS_BYTES, stream, a); }
#endif
}
```

```cpp
#include <hip/hip_runtime.h>
#include <cstdio>
#include <cstdint>

#ifndef MK_ONE_LAUNCH
#define MK_ONE_LAUNCH 1
#endif

namespace pg8 {
#define PG8_LAS __attribute__((address_space(3)))
typedef unsigned short bf16_t;
typedef short bf16x8 __attribute__((ext_vector_type(8)));
typedef float f32x4 __attribute__((ext_vector_type(4)));
typedef float f32x2 __attribute__((ext_vector_type(2)));
typedef unsigned u32x4 __attribute__((ext_vector_type(4)));
typedef unsigned u32x2 __attribute__((ext_vector_type(2)));
constexpr int BM = 256, BK = 64, HALF = 128, HTB = HALF * BK * 2  , STAGE_BYTES = 8 * HTB, NXCD = 8, WGM = 8;

__host__ __device__ __forceinline__ int lds_byte(int r, int c) { const int st = (r >> 4) * 2 + (c >> 5), rr = r & 15, cc = c & 31, ob = rr * 64 + cc * 2; return st * 1024 + (ob ^ (((ob >> 9) & 1) << 5)); }
__host__ __device__ __forceinline__ void stage_rc(int b, int& R, int& C) { const int st = b / 1024, sb = b % 1024, swz = sb ^ (((sb >> 9) & 1) << 5); R = (st >> 1) * 16 + swz / 64; C = (st & 1) * 32 + (swz % 64) / 2; }
__host__ __device__ __forceinline__ int perm32(int rho) { const int n = rho >> 4, i = rho & 15; return 8 * (i >> 2) + 4 * n + (i & 3); }

struct Unit { const char* A; const char* B; int pm, pn, aux; };

__host__ __device__ __forceinline__ void tile_order(int L, int nM, int nN, int& pm, int& pn) {
    const int nwg = nM * nN; int wgid = L;
    { const int q = nwg / NXCD, r = nwg % NXCD, xcd = wgid % NXCD, off = wgid / NXCD; wgid = (xcd < r ? xcd * (q + 1) : r * (q + 1) + (xcd - r) * q) + off; }
    const int nig = WGM * nN, gid = wgid / nig, fm = gid * WGM, gsz = (nM - fm) < WGM ? (nM - fm) : WGM;
    pm = fm + ((wgid % nig) % gsz); pn = (wgid % nig) / gsz;
}

typedef __bf16 bf16n2 __attribute__((ext_vector_type(2)));
__device__ __forceinline__ unsigned cvt_pk_bf16(float lo, float hi) { const f32x2 v = {lo, hi}; return __builtin_bit_cast(unsigned, __builtin_convertvector(v, bf16n2)); }

template <class Epi, class Sched>
__device__ __forceinline__ void gemm_phase(PG8_LAS unsigned char* lds, const int K, const Sched& S, const Epi& E, int tid) {
    const int wid = __builtin_amdgcn_readfirstlane(tid >> 6), lane = tid & 63, wr = wid >> 2, wc = wid & 3, fr = lane & 15, fq = lane >> 4;
    const int nt = K / BK;
    unsigned voffA[2], voffB[2];
#pragma unroll
    for (int i = 0; i < 2; ++i) { int R, C; stage_rc(tid * 16 + i * 8192, R, C); const int Rb = Epi::PERM ? ((R & ~31) + perm32(R & 31)) : R;
        voffA[i] = (unsigned)(R * K + C) * 2u; voffB[i] = (unsigned)(Rb * K + C) * 2u; }
    const size_t kstep = (size_t)(BK * 2);
    const size_t hstep = (size_t)HALF * K * 2;
    const unsigned ldsw = (unsigned)wid * 1024u;
    const int aoff = lds_byte(wr * 64 + fr, fq * 8), boff = lds_byte(wc * 32 + fr, fq * 8);
#define PG8_SA(b, h) (((b) * 2 + (h)) * HTB)
#define PG8_SB(b, h) ((4 + (b) * 2 + (h)) * HTB)
#define PG8_STAGE(bufoff, gbase, voff) do { _Pragma("unroll") for (int _i = 0; _i < 2; ++_i) \
        __builtin_amdgcn_global_load_lds((const unsigned*)((const char*)(gbase) + (voff)[_i]), (PG8_LAS unsigned*)(lds + (bufoff) + ldsw + _i * 8192), 16, 0, 0); } while (0)
#define PG8_LDA(dst, b, h) do { _Pragma("unroll") for (int m = 0; m < 4; ++m) _Pragma("unroll") for (int k = 0; k < 2; ++k) dst[m][k] = *(const PG8_LAS bf16x8*)(lds + PG8_SA(b, h) + aoff + m * 2048 + k * 1024); } while (0)
#define PG8_LDB(dst, b, h) do { _Pragma("unroll") for (int n = 0; n < 2; ++n) _Pragma("unroll") for (int k = 0; k < 2; ++k) dst[n][k] = *(const PG8_LAS bf16x8*)(lds + PG8_SB(b, h) + boff + n * 2048 + k * 1024); } while (0)
#define PG8_MMA(ai, bj, At, Bt) do { __builtin_amdgcn_s_setprio(1); _Pragma("unroll") for (int m = 0; m < 4; ++m) _Pragma("unroll") for (int n = 0; n < 2; ++n) _Pragma("unroll") for (int k = 0; k < 2; ++k) \
        acc[ai][bj][m][n] = __builtin_amdgcn_mfma_f32_16x16x32_bf16(Bt[n][k], At[m][k], acc[ai][bj][m][n], 0, 0, 0); __builtin_amdgcn_s_setprio(0); } while (0)
#define PG8_WAIT_V(n) asm volatile("s_waitcnt vmcnt(" #n ")" ::: "memory")
#define PG8_WAIT_L(n) asm volatile("s_waitcnt lgkmcnt(" #n ")" ::: "memory")
#define PG8_BAR __builtin_amdgcn_s_barrier()
#define PG8_SCHED __builtin_amdgcn_sched_barrier(0)
    Unit cur, nxt; int ui = 0;
    if (!S.next(0, cur)) return;
    f32x4 acc[2][2][4][2];
#pragma unroll
    for (int a = 0; a < 2; ++a)
#pragma unroll
        for (int b = 0; b < 2; ++b)
#pragma unroll
            for (int m = 0; m < 4; ++m)
#pragma unroll
                for (int n = 0; n < 2; ++n) acc[a][b][m][n] = (f32x4){0.f, 0.f, 0.f, 0.f};
    bf16x8 At[4][2], B0[2][2], B1[2][2];
    const char* cA = cur.A; const char* cB = cur.B;
    PG8_STAGE(PG8_SB(0, 0), cB, voffB); PG8_STAGE(PG8_SB(0, 1), cB + hstep, voffB); PG8_STAGE(PG8_SA(0, 0), cA, voffA); PG8_STAGE(PG8_SA(0, 1), cA + hstep, voffA);
    if (wr == 1) PG8_BAR;
    PG8_WAIT_V(2); PG8_BAR;
    PG8_STAGE(PG8_SB(1, 0), cB + kstep, voffB); PG8_STAGE(PG8_SA(1, 0), cA + kstep, voffA); PG8_STAGE(PG8_SB(1, 1), cB + hstep + kstep, voffB);
    PG8_WAIT_V(6); PG8_BAR;
    for (;;) {
        const bool has_next = S.next(ui + 1, nxt);
        const char* nA = has_next ? nxt.A : cA; const char* nB = has_next ? nxt.B : cB;
        for (int t = 0; t < nt; t += 2) {
            const bool last = (t == nt - 2);
            const char* a1 = cA + (size_t)(t + 1) * kstep;
            const char* a2 = last ? nA : cA + (size_t)(t + 2) * kstep; const char* b2 = last ? nB : cB + (size_t)(t + 2) * kstep;
            const char* a3 = a2 + kstep; const char* b3 = b2 + kstep;
            PG8_LDB(B0, 0, 0); PG8_LDB(B1, 0, 1); PG8_SCHED; PG8_LDA(At, 0, 0); PG8_STAGE(PG8_SA(1, 1), a1 + hstep, voffA);
            PG8_WAIT_V(8); PG8_WAIT_L(0); PG8_BAR; PG8_MMA(0, 0, At, B0); PG8_MMA(0, 1, At, B1); PG8_BAR; PG8_SCHED;
            PG8_LDA(At, 0, 1); PG8_STAGE(PG8_SB(0, 0), b2, voffB); PG8_STAGE(PG8_SB(0, 1), b2 + hstep, voffB); PG8_STAGE(PG8_SA(0, 0), a2, voffA);
            PG8_WAIT_V(8); PG8_WAIT_L(0); PG8_BAR; PG8_MMA(1, 0, At, B0); PG8_MMA(1, 1, At, B1); PG8_BAR; PG8_SCHED;
            PG8_LDB(B0, 1, 0); PG8_LDB(B1, 1, 1); PG8_SCHED; PG8_LDA(At, 1, 0); PG8_STAGE(PG8_SA(0, 1), a2 + hstep, voffA);
            PG8_WAIT_V(8); PG8_WAIT_L(0); PG8_BAR; PG8_MMA(0, 0, At, B0); PG8_MMA(0, 1, At, B1); PG8_BAR; PG8_SCHED;
            PG8_LDA(At, 1, 1); PG8_STAGE(PG8_SB(1, 0), b3, voffB); PG8_STAGE(PG8_SB(1, 1), b3 + hstep, voffB); PG8_STAGE(PG8_SA(1, 0), a3, voffA);
            PG8_WAIT_V(8); PG8_WAIT_L(0); PG8_BAR; PG8_MMA(1, 0, At, B0); PG8_MMA(1, 1, At, B1); PG8_BAR; PG8_SCHED;
        }
        if (wr == 0) PG8_BAR;
        { int fr_ = fr, fq_ = fq; asm volatile("" : "+v"(fr_), "+v"(fq_)); E(acc, cur, wr, wc, fr_, fq_); }
        if (!has_next) break;
#pragma unroll
        for (int a = 0; a < 2; ++a)
#pragma unroll
            for (int b = 0; b < 2; ++b)
#pragma unroll
                for (int m = 0; m < 4; ++m)
#pragma unroll
                    for (int n = 0; n < 2; ++n) acc[a][b][m][n] = (f32x4){0.f, 0.f, 0.f, 0.f};
        cur = nxt; cA = nA; cB = nB; ++ui;
        if (wr == 1) PG8_BAR;
    }
    PG8_WAIT_V(0);
    PG8_BAR;
#undef PG8_SA
#undef PG8_SB
#undef PG8_STAGE
#undef PG8_LDA
#undef PG8_LDB
#undef PG8_MMA
#undef PG8_WAIT_V
#undef PG8_WAIT_L
#undef PG8_BAR
#undef PG8_SCHED
}
}

constexpr int NWAVES = 8, NTHR = 512;
constexpr int D = 2048, NB = 4, SEQ = 2048, CTXL = 256, NCTX = NB * CTXL  , NLAT = NB * SEQ  , NTOK = NCTX + NLAT  ;
constexpr int NSTEP = CTXL + SEQ;
constexpr int HEADS = 8, HD = 128, MW = 1024, LW = 1024;
constexpr int NEXP = 32, DE = 1024;
constexpr int IN_DIM = 11296, NT_IN = 45;
constexpr float EPS = 1e-6f;
constexpr int MAXTILES = 96;
constexpr int NPHASE = 9;

constexpr size_t MiB = 1u << 20;
constexpr size_t WS_CTL = 0, CTL_ZERO_BYTES = 1 * MiB;
constexpr size_t WS_MOD = 1 * MiB;
constexpr size_t WS_GATES = 2 * MiB;
constexpr size_t WS_ASG = 4 * MiB + 512 * 1024;
constexpr size_t WS_LIST = 3 * MiB + 512 * 1024;
constexpr size_t WS_WR = 6 * MiB;
constexpr size_t WS_RB = 7 * MiB + 768 * 1024;
constexpr size_t WS_WL = 5 * MiB;
constexpr size_t WS_AGG = 978 * MiB;
constexpr size_t WS_WPA = 8 * MiB, WS_WPB = 12 * MiB, WS_WOUT = 16 * MiB, WS_WIN = 24 * MiB;
constexpr size_t WS_W13 = 72 * MiB, WS_W2 = 328 * MiB;
constexpr size_t WS_PS = 72 * MiB;
constexpr size_t WS_H = 456 * MiB;
constexpr size_t WS_K = 492 * MiB, WS_V = 510 * MiB, WS_UX = 528 * MiB;
constexpr size_t WS_Q = 546 * MiB, WS_OF = 562 * MiB, WS_OB = 578 * MiB, WS_UG = 594 * MiB;
constexpr size_t WS_GA = 610 * MiB, WS_GB = 642 * MiB;
constexpr size_t WS_LA = 674 * MiB, WS_LB = 746 * MiB;
constexpr size_t WS_HS = 818 * MiB, WS_TM = 882 * MiB;
constexpr size_t WS_YA = 946 * MiB, WS_YB = 962 * MiB;
constexpr size_t WS_BT = 982 * MiB;
constexpr size_t WS_SLOC = 984 * MiB;
constexpr size_t WS_END = 1022 * MiB;
constexpr size_t WS_PRE = WS_LA;
constexpr size_t WS_X1 = WS_LB;
constexpr size_t WS_H2 = WS_H;
constexpr size_t WS_XS = WS_K;
constexpr size_t WS_HM = 588 * MiB;
constexpr size_t WS_Y2 = WS_HS;
constexpr int CW_MODC = 32;
constexpr int CW_CNT = 64;
constexpr int CW_NT = 128;
constexpr int CW_TILE_E = 192;
constexpr int CW_BAR = 4096;
constexpr int CW_Q = 8192;
constexpr int CW_TC = 16384;

constexpr int RING_BYTES = 131072;
constexpr int LDSCTL_OFF = 143360;
constexpr int MISC_OFF = LDSCTL_OFF + 384;
constexpr int LDS_BYTES = 147456;

#define GAS __attribute__((address_space(1)))
#define LAS __attribute__((address_space(3)))
typedef unsigned short bf16;
typedef unsigned v4u __attribute__((ext_vector_type(4)));
typedef float f32x4 __attribute__((ext_vector_type(4)));
#define LDS_WAIT() asm volatile("s_waitcnt lgkmcnt(0)" ::: "memory")
#define WG_BAR() do { asm volatile("s_waitcnt lgkmcnt(0)" ::: "memory"); __builtin_amdgcn_s_barrier(); asm volatile("" ::: "memory"); } while (0)

__device__ __forceinline__ unsigned f2bf(float f) { unsigned u = __builtin_bit_cast(unsigned, f); return (u + 0x7fffu + ((u >> 16) & 1u)) >> 16; }
__device__ __forceinline__ unsigned pk2(float lo, float hi) { return pg8::cvt_pk_bf16(lo, hi); }
__device__ __forceinline__ float bf2f(unsigned h) { return __builtin_bit_cast(float, h << 16); }
__device__ __forceinline__ float bflo(unsigned w) { return __builtin_bit_cast(float, w << 16); }
__device__ __forceinline__ float bfhi(unsigned w) { return __builtin_bit_cast(float, w & 0xffff0000u); }
__device__ __forceinline__ float sigmoidf_(float x) { return __builtin_amdgcn_rcpf(1.f + __expf(-x)); }
__device__ __forceinline__ float gelu_tanh(float x) { const float u = 0.7978845608028654f * (x + 0.044715f * x * x * x); return x * __builtin_amdgcn_rcpf(1.f + __expf(-2.f * u)); }
__device__ __forceinline__ float wave_sum(float v) {
#pragma unroll
    for (int o = 1; o < 64; o <<= 1) v += __shfl_xor(v, o);
    return v;
}

#define XB_TMO      128
#define XB_XCNT(j)  (256  + 64 * (j))
#define XB_XSUB(j)  (1280 + 64 * (j))
#define XB_XGEN(j)  (2304 + 64 * (j))
#define XB_TOP      3328
#define XB_TOPGEN   3392
#define XCD_BAR_WORDS 3456
#define XB_SPIN_CAP (1u << 23)
__device__ __forceinline__ unsigned xb_ld(unsigned* p)              { return __hip_atomic_load(p, __ATOMIC_RELAXED, __HIP_MEMORY_SCOPE_AGENT); }
__device__ __forceinline__ unsigned xb_add(unsigned* p, unsigned v) { return __hip_atomic_fetch_add(p, v, __ATOMIC_RELAXED, __HIP_MEMORY_SCOPE_AGENT); }
__device__ __forceinline__ unsigned xb_xcc_id() { return (unsigned)__builtin_amdgcn_s_getreg((3 << 11) | 20) & 0xFu; }
#define XB_SPIN(cond, bar) do { unsigned _sp = 0; while (cond) { __builtin_amdgcn_s_sleep(1); \
    if ((++_sp & 255u) == 0u) { if (xb_ld(&(bar)[XB_TMO])) break; if (_sp > XB_SPIN_CAP) { atomicAdd(&(bar)[XB_TMO], 1u); break; } } } } while (0)
struct XcdBarrier { unsigned* bar; unsigned x; volatile LAS unsigned* st; };
__device__ __forceinline__ XcdBarrier xcd_barrier_post(unsigned* bar, volatile LAS unsigned* st, int tid) {
    XcdBarrier b; b.bar = bar; b.x = xb_xcc_id(); b.st = st;
    if (tid == 0) (void)xb_add(&bar[XB_XCNT(b.x)], 1u);
    return b;
}
__device__ __forceinline__ void xcd_barrier_complete(unsigned* bar, unsigned x, unsigned& nloc, unsigned& nx) {
    const unsigned G = gridDim.x * gridDim.y * gridDim.z;
    unsigned sum, cnt, mine, sp = 0u;
    for (;;) {
        sum = 0u; cnt = 0u; mine = 0u;
#pragma unroll
        for (unsigned j = 0; j < 16; ++j) { const unsigned c = xb_ld(&bar[XB_XCNT(j)]); sum += c; cnt += (c > 0u) ? 1u : 0u; mine = (j == x) ? c : mine; }
        if (sum == G) break;
        __builtin_amdgcn_s_sleep(1);
        if ((++sp & 255u) == 0u) { if (xb_ld(&bar[XB_TMO])) break; if (sp > XB_SPIN_CAP) { atomicAdd(&bar[XB_TMO], 1u); break; } }
    }
    nloc = mine > 0u ? mine : 1u; nx = cnt > 0u ? cnt : 1u;
}
__device__ __forceinline__ void xcd_barrier(const XcdBarrier& b, int tid) {
    asm volatile("s_waitcnt vmcnt(0)" ::: "memory");
    __syncthreads();
    if (tid == 0) {
        unsigned* bar = b.bar;
        __builtin_amdgcn_s_waitcnt(0);
        unsigned nloc = b.st[0], nx = b.st[1];
        if (nloc == 0u) { xcd_barrier_complete(bar, b.x, nloc, nx); b.st[0] = nloc; b.st[1] = nx; }
        const unsigned old = xb_add(&bar[XB_XSUB(b.x)], 1u);
        const unsigned gen = old / nloc;
        if (old + 1u == (gen + 1u) * nloc) {
            __builtin_amdgcn_fence(__ATOMIC_RELEASE, "agent");
            asm volatile("s_waitcnt vmcnt(0)" ::: "memory");
            const unsigned og = xb_add(&bar[XB_TOP], 1u);
            const unsigned tg = og / nx;
            if (og + 1u == (tg + 1u) * nx) xb_add(&bar[XB_TOPGEN], 1u);
            else XB_SPIN(xb_ld(&bar[XB_TOPGEN]) == tg, bar);
            __builtin_amdgcn_fence(__ATOMIC_ACQUIRE, "agent");
            xb_add(&bar[XB_XGEN(b.x)], 1u);
            asm volatile("s_waitcnt vmcnt(0)" ::: "memory");
        } else {
            XB_SPIN(xb_ld(&bar[XB_XGEN(b.x)]) == gen, bar);
            __builtin_amdgcn_fence(__ATOMIC_ACQUIRE, "agent");
            asm volatile("s_waitcnt vmcnt(0)" ::: "memory");
        }
    }
    __syncthreads();
}

__device__ __forceinline__ int make_tid(int wave_s) { int l; asm volatile("v_mbcnt_lo_u32_b32 %0, -1, 0\n\tv_mbcnt_hi_u32_b32 %0, -1, %0" : "=v"(l)); __builtin_assume(l >= 0 && l < 64); __builtin_assume(wave_s >= 0 && wave_s < 8); return wave_s * 64 + l; }
struct Args { const float* in[27]; float* out; unsigned char* ws; int ph_lo, ph_hi; };
enum { I_X = 0, I_C, I_CTX, I_CCTX, I_WMOD, I_BMOD, I_N1G, I_WIN, I_BGATES, I_HEADG, I_CONVW, I_CONVB, I_LWA, I_LBA, I_LWX, I_LBX, I_LAM, I_WPA, I_WPB, I_WOUT, I_N2G, I_WRG, I_WRE, I_W1, I_W3, I_W2, I_FG };

__device__ __forceinline__ void tr_item(const float* __restrict__ W, size_t ldw, int k0, int n0, bf16* dst, size_t ldd, float scale, LAS float* scr, int lane) {
#pragma unroll 16
    for (int i = 0; i < 32; ++i) { const int kk = 2 * i + (lane >> 5); scr[kk * 33 + (lane & 31)] = W[(size_t)(k0 + kk) * ldw + n0 + (lane & 31)]; }
    LDS_WAIT(); asm volatile("" ::: "memory");
    const int c = lane & 7;
#pragma unroll
    for (int j = 0; j < 4; ++j) { const int n = (lane >> 3) + 8 * j; const LAS float* s = scr + (8 * c) * 33 + n;
        v4u o; o.x = pk2(s[0 * 33] * scale, s[1 * 33] * scale); o.y = pk2(s[2 * 33] * scale, s[3 * 33] * scale); o.z = pk2(s[4 * 33] * scale, s[5 * 33] * scale); o.w = pk2(s[6 * 33] * scale, s[7 * 33] * scale);
        *(GAS v4u*)(dst + (size_t)n * ldd + 8 * c) = o; }
    LDS_WAIT(); asm volatile("" ::: "memory");
}
__device__ __forceinline__ int win_row(int n0, float& scale) {
    scale = 1.f;
    if (n0 < 1024) return 13 * 256 + n0;
    if (n0 < 2048) { scale = 0.08838834764831845f; return n0 - 1024; }
    if (n0 < 3072) return 4 * 256 + (n0 - 2048);
    if (n0 < 4096) return 17 * 256 + (n0 - 3072);
    if (n0 < 5120) return 21 * 256 + (n0 - 4096);
    if (n0 < 5152) return 12 * 256 + (n0 - 5120);
    if (n0 < 6176) return 8 * 256 + (n0 - 5152);
    if (n0 < 7200) return 25 * 256 + (n0 - 6176);
    if (n0 < 9248) return 29 * 256 + (n0 - 7200);
    return 37 * 256 + (n0 - 9248);
}

__device__ __forceinline__ void phase0(const Args& a, unsigned char* lds_g, int tid, int lane, int wave) {
    unsigned char* ws = a.ws;
    {
        float* sl = (float*)lds_g;
        float* red = sl + 5 * 2048;
        for (int i = tid; i < 5 * 2048; i += NTHR) { const int r = i >> 11, k = i & 2047; const float v = r < 4 ? a.in[I_C][r * 2048 + k] : a.in[I_CCTX][k]; sl[i] = v / (1.f + __expf(-v)); }
        __syncthreads();
        const float* wm = a.in[I_WMOD]; const float* bm = a.in[I_BMOD]; float* MOD = (float*)(ws + WS_MOD);
        for (int cb = blockIdx.x; cb < 256; cb += gridDim.x) {
            const int n0 = cb * 48;
            if (tid < 504) {
                const int kq = tid / 12, cg = tid % 12;
                f32x4 acc[5];
#pragma unroll
                for (int r = 0; r < 5; ++r) acc[r] = (f32x4){0.f, 0.f, 0.f, 0.f};
#pragma unroll 7
                for (int k = kq; k < 2048; k += 42) {
                    const f32x4 w = *(const f32x4*)(wm + (size_t)k * 12288 + n0 + 4 * cg);
#pragma unroll
                    for (int r = 0; r < 5; ++r) acc[r] += w * sl[r * 2048 + k];
                }
#pragma unroll
                for (int r = 0; r < 5; ++r) *(f32x4*)(red + tid * 20 + r * 4) = acc[r];
            }
            __syncthreads();
            if (tid < 240) {
                const int cg = tid / 20, rj = tid % 20; float s = 0.f;
                for (int kq = 0; kq < 42; ++kq) s += red[(kq * 12 + cg) * 20 + rj];
                const int r = rj >> 2, j = rj & 3, n = n0 + 4 * cg + j;
                __hip_atomic_store(MOD + r * 12288 + n, s + bm[n], __ATOMIC_RELAXED, __HIP_MEMORY_SCOPE_AGENT);
            }
            __syncthreads();
        }
        if (tid == 0) __hip_atomic_fetch_add((unsigned*)(ws + WS_CTL) + CW_MODC, 1u, __ATOMIC_RELAXED, __HIP_MEMORY_SCOPE_AGENT);
    }
    {
        LAS float* scr = (LAS float*)((LAS unsigned char*)lds_g) + wave * 4096;
        const int gw = blockIdx.x * NWAVES + wave, NGW = gridDim.x * NWAVES;
        constexpr int J0 = 32 * 353, J1 = 16 * 64, J3 = 32 * 64;
        constexpr int JL = 256;
        constexpr int NITEMS = J0 + 2 * J1;
        (void)J3; (void)JL;
        for (int it = gw; it < NITEMS; it += NGW) {
            int r = it;
            if (r < J0) { const int kb = r / 353, nb = r % 353; float sc; const int row = win_row(32 * nb, sc);
                tr_item(a.in[I_WIN], IN_DIM, 64 * kb, 32 * nb, (bf16*)(ws + WS_WIN) + (size_t)row * 2048 + 64 * kb, 2048, sc, scr, lane); continue; } r -= J0;
            if (r < J1) { const int kb = r / 64, nb = r % 64; tr_item(a.in[I_WPA], 2048, 64 * kb, 32 * nb, (bf16*)(ws + WS_WPA) + (size_t)(32 * nb) * 1024 + 64 * kb, 1024, 1.f, scr, lane); continue; } r -= J1;
            if (r < J1) { const int kb = r / 64, nb = r % 64; tr_item(a.in[I_WPB], 2048, 64 * kb, 32 * nb, (bf16*)(ws + WS_WPB) + (size_t)(32 * nb) * 1024 + 64 * kb, 1024, 1.f, scr, lane); continue; }
        }
        { GAS v4u* z = (GAS v4u*)((bf16*)(ws + WS_WIN) + (size_t)(12 * 256 + 32) * 2048); const int nchunks = 224 * 256;
          for (int i = blockIdx.x * NTHR + tid; i < nchunks; i += gridDim.x * NTHR) z[i] = (v4u){0u, 0u, 0u, 0u}; }
    }
}

__device__ __forceinline__ void late_prep(const Args& a, unsigned char* lds_g, int gw, int NGW, int lane, int wave) {
    unsigned char* ws = a.ws;
    {
        LAS float* scr = (LAS float*)((LAS unsigned char*)lds_g) + wave * 4096;
        constexpr int J3 = 32 * 64, JL = 256;
        for (int it = gw; it < J3 + JL; it += NGW) {
            int r = it;
            if (r >= J3) { r -= J3; const int mi = r >> 3, kb = (r >> 2) & 1, nb = r & 3, dir = mi >> 4, mat = (mi >> 3) & 1, blk = mi & 7;
                tr_item(a.in[mat ? I_LWX : I_LWA] + (size_t)(dir * 8 + blk) * 128 * 128, 128, 64 * kb, 32 * nb, (bf16*)(ws + WS_WL) + ((size_t)((dir * 2 + mat) * 8 + blk) * 128 + 32 * nb) * 128 + 64 * kb, 128, 1.f, scr, lane); continue; }
            const int kb = r / 64, nb = r % 64; tr_item(a.in[I_WOUT], 2048, 64 * kb, 32 * nb, (bf16*)(ws + WS_WOUT) + (size_t)(32 * nb) * 2048 + 64 * kb, 2048, 1.f, scr, lane);
        }
    }
    {
        const float* MODr = (const float*)(a.ws + WS_MOD); float* WR = (float*)(a.ws + WS_WR); float* RB = (float*)(a.ws + WS_RB);
        for (int idx = gw * 64 + lane; idx < 4 * 48 * 2048; idx += NGW * 64) { const int k = idx & 2047, j = (idx >> 11) % 48, b = idx / (48 * 2048);
            const float gm = a.in[I_N2G][k] * (1.f + MODr[b * 12288 + 4 * 2048 + k]);
            const float wv = j < 32 ? a.in[I_WRE][(size_t)k * 32 + j] : (j < 36 ? a.in[I_WRG][(size_t)k * 4 + (j - 32)] : 0.f);
            WR[idx] = gm * wv; }
        for (int q = gw; q < 4 * 48; q += NGW) { const int b = q / 48, j = q % 48; float sacc = 0.f;
            if (j < 36) { for (int k = lane; k < 2048; k += 64) { const float wv = j < 32 ? a.in[I_WRE][(size_t)k * 32 + j] : a.in[I_WRG][(size_t)k * 4 + (j - 32)]; sacc += MODr[b * 12288 + 3 * 2048 + k] * wv; } }
            sacc = wave_sum(sacc); if (lane == 0) RB[q] = sacc; }
    }
}
__device__ __forceinline__ void mod_wait(const Args& a, int tid) {
    if (tid < 64) { unsigned* mc = (unsigned*)(a.ws + WS_CTL) + CW_MODC; unsigned spins = 0;
        while ((unsigned)__builtin_amdgcn_readfirstlane(__hip_atomic_load(mc, __ATOMIC_RELAXED, __HIP_MEMORY_SCOPE_AGENT)) < gridDim.x) {
            __builtin_amdgcn_s_sleep(2);
            if (++spins > (1u << 22)) { if (tid == 0) __hip_atomic_store((unsigned*)(a.ws + WS_CTL) + 1, 0x800u, __ATOMIC_RELAXED, __HIP_MEMORY_SCOPE_AGENT); break; } }
        __builtin_amdgcn_fence(__ATOMIC_ACQUIRE, "agent");
        asm volatile("s_waitcnt vmcnt(0)" ::: "memory"); }
    __syncthreads();
}
__device__ __forceinline__ void phase1(const Args& a, int lane, int wave) {
    const int gw = blockIdx.x * NWAVES + wave, NGW = gridDim.x * NWAVES;
    const float* MOD = (const float*)(a.ws + WS_MOD); const float* g = a.in[I_N1G];
    bf16* H = (bf16*)(a.ws + WS_H);
    for (int r = gw; r < NTOK; r += NGW) {
        const float* src = r < NCTX ? a.in[I_CTX] + (size_t)r * D : a.in[I_X] + (size_t)(r - NCTX) * D;
        const int mr = r < NCTX ? 4 : (r - NCTX) / SEQ;
        const f32x4* xr = (const f32x4*)src + lane;
        f32x4 v[8]; float s = 0.f;
#pragma unroll
        for (int j = 0; j < 8; ++j) { v[j] = xr[64 * j]; s += (v[j].x * v[j].x + v[j].y * v[j].y) + (v[j].z * v[j].z + v[j].w * v[j].w); }
        const float rstd = 1.f / sqrtf(wave_sum(s) * (1.f / D) + EPS);
        unsigned long long* o8 = (unsigned long long*)(H + (size_t)r * D) + lane;
#pragma unroll
        for (int j = 0; j < 8; ++j) {
            const int c = 4 * lane + 256 * j;
            const f32x4 gg = *(const f32x4*)(g + c), sh = *(const f32x4*)(MOD + mr * 12288 + c), sc = *(const f32x4*)(MOD + mr * 12288 + 2048 + c);
            v[j] = v[j] * rstd * gg * (sc + 1.f) + sh;
        }
#pragma unroll
        for (int j = 0; j < 8; ++j) o8[64 * j] = (unsigned long long)pk2(v[j].x, v[j].y) | ((unsigned long long)pk2(v[j].z, v[j].w) << 32);
    }
}

struct SchedIn {
    int G, c; const char* A; const char* B;
    __device__ __forceinline__ bool next(int i, pg8::Unit& u) const {
        const int L = i * G + c; if (L >= 1492) return false;
        int pm, pn;
        if (L < 1440) { pg8::tile_order(L, 32, NT_IN, pm, pn); pm += 4; }
        else { const int j = L - 1440; pm = j & 3; pn = j >> 2; }
        u.pm = pm; u.pn = pn; u.aux = 0; u.A = A + (size_t)pm * 256 * D * 2; u.B = B + (size_t)pn * 256 * D * 2; return true;
    }
};
struct EpiIn {
    static constexpr bool PERM = true;
    unsigned char* ws; const float* b_gates;
    template <int ACT> __device__ __forceinline__ void store_tile(const pg8::f32x4 (&acc)[2][2][4][2], bf16* base, int ldc, int wr, int wc, int fr, int fq) const {
#pragma unroll
        for (int ai = 0; ai < 2; ++ai)
#pragma unroll
            for (int m = 0; m < 4; ++m) { bf16* rowp = base + (size_t)(ai * 128 + wr * 64 + m * 16 + fr) * ldc + wc * 32 + 8 * fq;
#pragma unroll
                for (int bj = 0; bj < 2; ++bj) { pg8::f32x4 v0 = acc[ai][bj][m][0], v1 = acc[ai][bj][m][1];
                    if (ACT == 1) {
#pragma unroll
                        for (int j = 0; j < 4; ++j) { v0[j] = sigmoidf_(v0[j]); v1[j] = sigmoidf_(v1[j]); } }
                    if (ACT == 2) {
#pragma unroll
                        for (int j = 0; j < 4; ++j) { v0[j] = gelu_tanh(v0[j]); v1[j] = gelu_tanh(v1[j]); } }
                    pg8::u32x4 w; w.x = pg8::cvt_pk_bf16(v0[0], v0[1]); w.y = pg8::cvt_pk_bf16(v0[2], v0[3]); w.z = pg8::cvt_pk_bf16(v1[0], v1[1]); w.w = pg8::cvt_pk_bf16(v1[2], v1[3]);
                    *(pg8::u32x4*)(rowp + bj * 128) = w; } }
    }
    __device__ __forceinline__ void operator()(const pg8::f32x4 (&acc)[2][2][4][2], const pg8::Unit& u, int wr, int wc, int fr, int fq) const {
        const int pn = u.pn; const size_t row0 = (size_t)u.pm * 256;
        if (pn < 12) {
            const int seg = pn >> 2, ct = pn & 3; bf16* dst = (bf16*)(ws + (seg == 0 ? WS_K : seg == 1 ? WS_V : WS_UX));
            store_tile<0>(acc, dst + row0 * 1024 + ct * 256, 1024, wr, wc, fr, fq);
        } else if (pn == 12) {
            if (wc == 0) {
                float* G = (float*)(ws + WS_GATES);
                const pg8::f32x4 bv0 = *(const pg8::f32x4*)(b_gates + 8 * fq), bv1 = *(const pg8::f32x4*)(b_gates + 8 * fq + 4);
#pragma unroll
                for (int ai = 0; ai < 2; ++ai)
#pragma unroll
                    for (int m = 0; m < 4; ++m) { float* rowp = G + (row0 + ai * 128 + wr * 64 + m * 16 + fr) * 32 + 8 * fq;
                        *(pg8::f32x4*)(rowp) = acc[ai][0][m][0] + bv0; *(pg8::f32x4*)(rowp + 4) = acc[ai][0][m][1] + bv1; }
            }
        } else if (pn < 29) {
            const int seg = (pn - 13) >> 2, ct = (pn - 13) & 3; const size_t lr = row0 - NCTX;
            bf16* dst = (bf16*)(ws + (seg == 0 ? WS_Q : seg == 1 ? WS_OF : seg == 2 ? WS_OB : WS_UG)) + lr * 1024 + ct * 256;
            if (seg == 0) store_tile<0>(acc, dst, 1024, wr, wc, fr, fq);
            else if (seg == 3) store_tile<2>(acc, dst, 1024, wr, wc, fr, fq);
            else store_tile<1>(acc, dst, 1024, wr, wc, fr, fq);
        } else {
            const int seg = (pn - 29) >> 3, ct = (pn - 29) & 7; const size_t lr = row0 - NCTX;
            store_tile<1>(acc, (bf16*)(ws + (seg ? WS_GB : WS_GA)) + lr * 2048 + ct * 256, 2048, wr, wc, fr, fq);
        }
    }
};

__device__ __forceinline__ int lru_pos_row(int b, bool isctx, int p) { return isctx ? b * CTXL + p : NCTX + b * SEQ + (p & 31) * 64 + (p >> 5); }
typedef short bf16x8_t __attribute__((ext_vector_type(8)));
template <bool FINAL>
__device__ __forceinline__ void lru_unit(const Args& a, unsigned char* lds_g, int b, int cidx, int blk, int tid) {
    const int lane = tid & 63, w = __builtin_amdgcn_readfirstlane(tid >> 6), fr = lane & 15, fq = lane >> 4;
    float* zf = (float*)lds_g;
    bf16* zb = (bf16*)(lds_g + 64 * 132 * 4);
    const bool isctx = cidx < 4; const int seglen = isctx ? CTXL : SEQ, p0 = (isctx ? cidx : cidx - 4) * 64;
    const bf16* UX = (const bf16*)(a.ws + WS_UX);
    float gba[2], gbx[2], glam[2];
    { const int ch_ = blk * 128 + 16 * w + fr;
#pragma unroll
      for (int d = 0; d < 2; ++d) { gba[d] = a.in[I_LBA][d * 1024 + ch_]; gbx[d] = a.in[I_LBX][d * 1024 + ch_]; glam[d] = a.in[I_LAM][d * 1024 + ch_]; } }
    bf16x8_t wl[2][2][4];
    { const bf16* WL = (const bf16*)(a.ws + WS_WL);
#pragma unroll
      for (int d = 0; d < 2; ++d)
#pragma unroll
        for (int m = 0; m < 2; ++m)
#pragma unroll
            for (int ks = 0; ks < 4; ++ks) wl[d][m][ks] = *(const bf16x8_t*)(WL + ((size_t)((d * 2 + m) * 8 + blk) * 128 + 16 * w + fr) * 128 + 32 * ks + 8 * fq); }
    __builtin_amdgcn_sched_barrier(0);
    {
        const int pos = tid >> 3, cg = tid & 7, ch0 = blk * 128 + cg * 16, p = p0 + pos;
        float z[16];
#pragma unroll
        for (int q = 0; q < 4; ++q) { const f32x4 bv = *(const f32x4*)(a.in[I_CONVB] + ch0 + 4 * q); z[4 * q] = bv.x; z[4 * q + 1] = bv.y; z[4 * q + 2] = bv.z; z[4 * q + 3] = bv.w; }
        v4u ua[4], ub[4]; float msk[4];
#pragma unroll
        for (int w4 = 0; w4 < 4; ++w4) { const int pp = p + w4 - 2; const bool ok = pp >= 0 && pp < seglen; const int ppc = ok ? pp : p;
            const v4u* src = (const v4u*)(UX + (size_t)lru_pos_row(b, isctx, ppc) * 1024 + ch0); ua[w4] = src[0]; ub[w4] = src[1]; msk[w4] = ok ? 1.f : 0.f; }
#pragma unroll
        for (int w4 = 0; w4 < 4; ++w4) { const float* cw = a.in[I_CONVW] + w4 * 1024 + ch0;
            const unsigned uu[8] = {ua[w4].x, ua[w4].y, ua[w4].z, ua[w4].w, ub[w4].x, ub[w4].y, ub[w4].z, ub[w4].w};
#pragma unroll
            for (int q = 0; q < 4; ++q) { const f32x4 cv = *(const f32x4*)(cw + 4 * q) * msk[w4]; z[4 * q] += cv.x * bflo(uu[2 * q]); z[4 * q + 1] += cv.y * bfhi(uu[2 * q]); z[4 * q + 2] += cv.z * bflo(uu[2 * q + 1]); z[4 * q + 3] += cv.w * bfhi(uu[2 * q + 1]); } }
#pragma unroll
        for (int q = 0; q < 4; ++q) *(f32x4*)(zf + pos * 132 + cg * 16 + 4 * q) = (f32x4){z[4 * q], z[4 * q + 1], z[4 * q + 2], z[4 * q + 3]};
        v4u o0, o1; o0.x = pk2(z[0], z[1]); o0.y = pk2(z[2], z[3]); o0.z = pk2(z[4], z[5]); o0.w = pk2(z[6], z[7]); o1.x = pk2(z[8], z[9]); o1.y = pk2(z[10], z[11]); o1.z = pk2(z[12], z[13]); o1.w = pk2(z[14], z[15]);
        *(v4u*)(zb + pos * 136 + cg * 16) = o0; *(v4u*)(zb + pos * 136 + cg * 16 + 8) = o1;
    }
    WG_BAR();
    f32x4 acc[2][2][4];
#pragma unroll
    for (int d = 0; d < 2; ++d)
#pragma unroll
        for (int m = 0; m < 2; ++m)
#pragma unroll
            for (int mt = 0; mt < 4; ++mt) acc[d][m][mt] = (f32x4){0.f, 0.f, 0.f, 0.f};
#pragma unroll
    for (int ks = 0; ks < 4; ++ks) {
        bf16x8_t af[4];
#pragma unroll
        for (int mt = 0; mt < 4; ++mt) af[mt] = *(const bf16x8_t*)(zb + (16 * mt + fr) * 136 + 32 * ks + 8 * fq);
#pragma unroll
        for (int d = 0; d < 2; ++d)
#pragma unroll
            for (int m = 0; m < 2; ++m) {
#pragma unroll
                for (int mt = 0; mt < 4; ++mt) acc[d][m][mt] = __builtin_amdgcn_mfma_f32_16x16x32_bf16(af[mt], wl[d][m][ks], acc[d][m][mt], 0, 0, 0); }
    }
    const int chl = 16 * w + fr, ch = blk * 128 + chl;
    float hsum[4][4];
#pragma unroll
    for (int d = 0; d < 2; ++d) {
        const float ba = gba[d], bx = gbx[d], lam = glam[d];
        const float sp = (-lam > 20.f) ? -lam : log1pf(__expf(-lam));
        float av[4][4], bv[4][4];
#pragma unroll
        for (int mt = 0; mt < 4; ++mt)
#pragma unroll
            for (int r = 0; r < 4; ++r) { const float rr = sigmoidf_(acc[d][0][mt][r] + ba), ii = sigmoidf_(acc[d][1][mt][r] + bx);
                const float aa = __expf(-8.f * rr * sp); av[mt][r] = aa; bv[mt][r] = __builtin_amdgcn_sqrtf(fmaxf(1.f - aa * aa, 0.f)) * ii * zf[(16 * mt + 4 * fq + r) * 132 + chl]; }
        float Pe[4], Se[4], Pt[4], St[4];
#pragma unroll
        for (int mt = 0; mt < 4; ++mt) {
            float P = 1.f, S = 0.f;
#pragma unroll
            for (int rr = 0; rr < 4; ++rr) { const int r = d ? 3 - rr : rr; S = av[mt][r] * S + bv[mt][r]; P = av[mt][r] * P; }
            if (d == 0) {
                float p1 = __shfl_up(P, 16), s1 = __shfl_up(S, 16); if (fq >= 1) { S = P * s1 + S; P = P * p1; }
                p1 = __shfl_up(P, 32); s1 = __shfl_up(S, 32); if (fq >= 2) { S = P * s1 + S; P = P * p1; }
                Pe[mt] = __shfl_up(P, 16); Se[mt] = __shfl_up(S, 16); if (fq == 0) { Pe[mt] = 1.f; Se[mt] = 0.f; }
                Pt[mt] = __shfl(P, fr + 48); St[mt] = __shfl(S, fr + 48);
            } else {
                float p1 = __shfl_down(P, 16), s1 = __shfl_down(S, 16); if (fq <= 2) { S = P * s1 + S; P = P * p1; }
                p1 = __shfl_down(P, 32); s1 = __shfl_down(S, 32); if (fq <= 1) { S = P * s1 + S; P = P * p1; }
                Pe[mt] = __shfl_down(P, 16); Se[mt] = __shfl_down(S, 16); if (fq == 3) { Pe[mt] = 1.f; Se[mt] = 0.f; }
                Pt[mt] = __shfl(P, fr); St[mt] = __shfl(S, fr);
            }
        }
        float2* AGG = (float2*)(a.ws + WS_AGG) + ((size_t)(b * 2 + d) * 36) * 1024 + ch;
        if (!FINAL) {
            if (cidx >= 4) {
                unsigned* PS = (unsigned*)(a.ws + WS_PS) + ((size_t)(b * 2 + d) * NSTEP + 64 * cidx) * 1024 + ch;
#pragma unroll
                for (int mt = 0; mt < 4; ++mt)
#pragma unroll
                    for (int r = 0; r < 4; ++r) PS[(size_t)(16 * mt + 4 * fq + r) * 1024] = pk2(1.f - av[mt][r], bv[mt][r]);
            }
            float Pc = 1.f, Sc = 0.f;
#pragma unroll
            for (int i = 0; i < 4; ++i) { const int mt = d ? 3 - i : i; Sc = Pt[mt] * Sc + St[mt]; Pc = Pt[mt] * Pc; }
            if (fq == 0) AGG[(size_t)cidx * 1024] = make_float2(Pc, Sc);
        } else {
            float h = 0.f;
#pragma unroll
            for (int g3 = 0; g3 < 6; ++g3) {
                float2 qv[6];
#pragma unroll
                for (int i = 0; i < 6; ++i) { const int sidx = 6 * g3 + i; const int c2 = d ? (sidx < 4 ? 3 - sidx : 39 - sidx) : sidx; qv[i] = AGG[(size_t)c2 * 1024]; }
#pragma unroll
                for (int i = 0; i < 6; ++i) { const int sidx = 6 * g3 + i; const int c2 = d ? (sidx < 4 ? 3 - sidx : 39 - sidx) : sidx;
                    const bool use = d ? (sidx < 4 || c2 > cidx) : (c2 < cidx);
                    h = use ? qv[i].x * h + qv[i].y : h; }
            }
#pragma unroll
            for (int i = 0; i < 4; ++i) { const int mt = d ? 3 - i : i;
                float hl = Pe[mt] * h + Se[mt];
#pragma unroll
                for (int rr = 0; rr < 4; ++rr) { const int r = d ? 3 - rr : rr; hl = av[mt][r] * hl + bv[mt][r]; if (d == 0) hsum[mt][r] = hl; else hsum[mt][r] += hl; }
                h = Pt[mt] * h + St[mt]; }
        }
    }
    if (FINAL) {
#pragma unroll
        for (int mt = 0; mt < 4; ++mt)
#pragma unroll
            for (int r = 0; r < 4; ++r) zf[(16 * mt + 4 * fq + r) * 132 + chl] = hsum[mt][r];
        WG_BAR();
        const int pos = tid >> 3, cg = tid & 7, ch0 = blk * 128 + cg * 16;
        const size_t lrow = (size_t)(lru_pos_row(b, false, p0 + pos) - NCTX) * 1024 + ch0;
        const v4u* ug = (const v4u*)((const bf16*)(a.ws + WS_UG) + lrow); const v4u g0 = ug[0], g1 = ug[1];
        const unsigned gg[8] = {g0.x, g0.y, g0.z, g0.w, g1.x, g1.y, g1.z, g1.w}; unsigned o[8];
#pragma unroll
        for (int q = 0; q < 4; ++q) { const f32x4 hv = *(const f32x4*)(zf + pos * 132 + cg * 16 + 4 * q);
            o[2 * q] = pk2(hv.x * bflo(gg[2 * q]), hv.y * bfhi(gg[2 * q])); o[2 * q + 1] = pk2(hv.z * bflo(gg[2 * q + 1]), hv.w * bfhi(gg[2 * q + 1])); }
        v4u* dst = (v4u*)((bf16*)(a.ws + WS_YB) + lrow); dst[0] = (v4u){o[0], o[1], o[2], o[3]}; dst[1] = (v4u){o[4], o[5], o[6], o[7]};
    }
    WG_BAR();
}
constexpr int ML_STRIDE = 136;
constexpr int ML_Q = 0, ML_K = 17408, ML_V = 34816, ML_AUG = 52224  , ML_CB = 54272  ;
constexpr int ML_EB = 93440  , ML_EU = 95488  , ML_EBEND = 97536  , ML_BEND = 97568  , ML_DEN = 97600  , ML_SSQ = 97856  ;
typedef short s4_t __attribute__((ext_vector_type(4)));
__device__ __forceinline__ s4_t ds_tr(const bf16* p) { return __builtin_amdgcn_ds_read_tr16_b64_v4i16((LAS s4_t*)p); }
__device__ __forceinline__ bf16x8_t frag_row(const bf16* img, int row0, int k0, int fr, int fq) { return *(const bf16x8_t*)(img + (row0 + fr) * ML_STRIDE + k0 + 8 * fq); }
__device__ __forceinline__ bf16x8_t frag_tr2(const bf16* img, int stride, int sA, int sB, int col0, int lane) {
    const int fq = lane >> 4, q = (lane & 15) >> 2, p = lane & 3;
    const s4_t lo = ds_tr(img + (sA + 4 * fq + q) * stride + col0 + 4 * p), hi = ds_tr(img + (sB + 4 * fq + q) * stride + col0 + 4 * p);
    return (bf16x8_t){lo.x, lo.y, lo.z, lo.w, hi.x, hi.y, hi.z, hi.w};
}
__device__ __forceinline__ bf16x8_t frag_tr(const bf16* img, int stride, int s0, int col0, int lane) {
    const int fq = lane >> 4, q = (lane & 15) >> 2, p = lane & 3;
    const bf16* b = img + (s0 + 8 * fq + q) * stride + col0 + 4 * p;
    const s4_t lo = ds_tr(b), hi = ds_tr(b + 4 * stride);
    return (bf16x8_t){lo.x, lo.y, lo.z, lo.w, hi.x, hi.y, hi.z, hi.w};
}
__device__ __forceinline__ float logsigmoidf_(float x) { return fminf(x, 0.f) - log1pf(__expf(-fabsf(x))); }

__device__ __forceinline__ void ml_gates(const Args& a, unsigned char* lds_g, int rowbase, int h, int tid) {
    const int lane = tid & 63, w = tid >> 6, dir = w >> 2, c = w & 3;
    const float* GT = (const float*)(a.ws + WS_GATES) + (size_t)(rowbase + 64 * c + lane) * 32;
    const float ipre = GT[(dir * 2) * 8 + h], fpre = GT[(dir * 2 + 1) * 8 + h];
    float bsum = logsigmoidf_(fpre);
    if (dir == 0) {
#pragma unroll
        for (int o = 1; o < 64; o <<= 1) { const float t = __shfl_up(bsum, o); if (lane >= o) bsum += t; }
    } else {
#pragma unroll
        for (int o = 1; o < 64; o <<= 1) { const float t = __shfl_down(bsum, o); if (lane + o < 64) bsum += t; }
    }
    float* eb = (float*)(lds_g + ML_EB); float* eu = (float*)(lds_g + ML_EU);
    eb[dir * 256 + 64 * c + lane] = __expf(bsum); eu[dir * 256 + 64 * c + lane] = __expf(ipre - bsum);
    const float bend = __shfl(bsum, dir ? 0 : 63);
    if (lane == 0) { ((float*)(lds_g + ML_EBEND))[dir * 4 + c] = __expf(bend); ((float*)(lds_g + ML_BEND))[dir * 4 + c] = bend; }
}

template <bool OUT, bool PASS2>
__device__ __forceinline__ void ml_block(const Args& a, unsigned char* lds_g, int rowbase, int h, int dir, f32x4 (&st)[9], int tid) {
    const int lane = tid & 63, w = __builtin_amdgcn_readfirstlane(tid >> 6), fr = lane & 15, fq = lane >> 4;
    bf16* Qi = (bf16*)(lds_g + ML_Q); bf16* Ki = (bf16*)(lds_g + ML_K); bf16* Vi = (bf16*)(lds_g + ML_V); bf16* AUGi = (bf16*)(lds_g + ML_AUG); bf16* CB = (bf16*)(lds_g + ML_CB);
    const float* eb = (const float*)(lds_g + ML_EB) + dir * 256; const float* eu = (const float*)(lds_g + ML_EU) + dir * 256;
    const float* ebend = (const float*)(lds_g + ML_EBEND) + dir * 4;
    float* den = (float*)(lds_g + ML_DEN); float* ssq = (float*)(lds_g + ML_SSQ);
    const bf16* Kb = (const bf16*)(a.ws + WS_K); const bf16* Vb = (const bf16*)(a.ws + WS_V); const bf16* Qb = (const bf16*)(a.ws + WS_Q);
    const int ti = w & 3, vh = w >> 2;
    float hgv[5];
    if (OUT) {
#pragma unroll
        for (int x = 0; x < 5; ++x) { const int vt = vh * 5 + x; hgv[x] = vt < 8 ? a.in[I_HEADG][h * 128 + 16 * vt + fr] : 0.f; } }
    for (int ci = 0; ci < 4; ++ci) {
        const int c = dir ? 3 - ci : ci;
        unsigned short ogv[5][4]; float tmv[5][4];
        if (OUT) {
            const bf16* OGp = (const bf16*)(a.ws + (dir ? WS_OB : WS_OF)); const float* TMp = (const float*)(a.ws + WS_TM);
#pragma unroll
            for (int r = 0; r < 4; ++r) { const size_t ob = (size_t)(rowbase - NCTX + 64 * c + 16 * ti + 4 * fq + r) * 1024 + h * 128;
#pragma unroll
                for (int x = 0; x < 5; ++x) { const int vt = vh * 5 + x; if (vt < 8) { ogv[x][r] = OGp[ob + 16 * vt + fr]; if (PASS2) tmv[x][r] = TMp[ob + 16 * vt + fr]; } } }
            __builtin_amdgcn_sched_barrier(0);
        }
        {
            const int t = tid >> 3, pc = tid & 7; const size_t row = (size_t)(rowbase + 64 * c + t);
            const v4u* ks = (const v4u*)(Kb + row * 1024 + h * 128 + 16 * pc); const v4u k0 = ks[0], k1 = ks[1];
            const v4u* vs = (const v4u*)(Vb + row * 1024 + h * 128 + 16 * pc); const v4u v0 = vs[0], v1 = vs[1];
            v4u q0, q1; if (OUT) { const v4u* qs = (const v4u*)(Qb + (row - NCTX) * 1024 + h * 128 + 16 * pc); q0 = qs[0]; q1 = qs[1]; }
            const float e = eu[64 * c + t];
            *(v4u*)(Ki + t * ML_STRIDE + 16 * pc) = k0; *(v4u*)(Ki + t * ML_STRIDE + 16 * pc + 8) = k1;
            if (OUT) { *(v4u*)(Qi + t * ML_STRIDE + 16 * pc) = q0; *(v4u*)(Qi + t * ML_STRIDE + 16 * pc + 8) = q1; }
            const unsigned vv[8] = {v0.x, v0.y, v0.z, v0.w, v1.x, v1.y, v1.z, v1.w}; unsigned o[8];
#pragma unroll
            for (int i = 0; i < 8; ++i) o[i] = pk2(bflo(vv[i]) * e, bfhi(vv[i]) * e);
            *(v4u*)(Vi + t * ML_STRIDE + 16 * pc) = (v4u){o[0], o[1], o[2], o[3]}; *(v4u*)(Vi + t * ML_STRIDE + 16 * pc + 8) = (v4u){o[4], o[5], o[6], o[7]};
            if (pc == 0) { *(v4u*)(AUGi + t * 16) = (v4u){f2bf(e), 0u, 0u, 0u}; *(v4u*)(AUGi + t * 16 + 8) = (v4u){0u, 0u, 0u, 0u}; }
        }
        WG_BAR();
        f32x4 X[5]; float hval[4][4];
        if (OUT) {
            bf16x8_t qf[4];
#pragma unroll
            for (int ks = 0; ks < 4; ++ks) qf[ks] = frag_row(Qi, 16 * ti, 32 * ks, fr, fq);
            bf16x8_t P[2]; bool pv[2];
#pragma unroll
            for (int pp = 0; pp < 2; ++pp) {
                f32x4 d[2];
#pragma unroll
                for (int hh = 0; hh < 2; ++hh) { const int si = 2 * pp + hh; d[hh] = (f32x4){0.f, 0.f, 0.f, 0.f};
                    const bool valid = dir ? (si >= ti) : (si <= ti);
                    if (valid) {
#pragma unroll
                        for (int ks = 0; ks < 4; ++ks) d[hh] = __builtin_amdgcn_mfma_f32_16x16x32_bf16(frag_row(Ki, 16 * si, 32 * ks, fr, fq), qf[ks], d[hh], 0, 0, 0);
                        if (si == ti) {
#pragma unroll
                            for (int r = 0; r < 4; ++r) { const bool keep = dir ? (4 * fq + r >= fr) : (4 * fq + r <= fr); d[hh][r] = keep ? d[hh][r] : 0.f; } } } }
                pv[pp] = dir ? (2 * pp + 1 >= ti) : (2 * pp <= ti);
                const unsigned p0 = pk2(d[0][0], d[0][1]), p1 = pk2(d[0][2], d[0][3]), p2 = pk2(d[1][0], d[1][1]), p3 = pk2(d[1][2], d[1][3]);
                P[pp] = __builtin_bit_cast(bf16x8_t, (v4u){p0, p1, p2, p3});
            }
#pragma unroll
            for (int x = 0; x < 5; ++x) { X[x] = (f32x4){0.f, 0.f, 0.f, 0.f};
                const int vt = vh * 5 + x;
                if (vt < 9) {
#pragma unroll
                    for (int pp = 0; pp < 2; ++pp) if (pv[pp]) {
                        const bf16x8_t bfv = vt < 8 ? frag_tr2(Vi, ML_STRIDE, 32 * pp, 32 * pp + 16, 16 * vt, lane) : frag_tr2(AUGi, 16, 32 * pp, 32 * pp + 16, 0, lane);
                        X[x] = __builtin_amdgcn_mfma_f32_16x16x32_bf16(P[pp], bfv, X[x], 0, 0, 0); }
#pragma unroll
                    for (int ks = 0; ks < 4; ++ks) X[x] = __builtin_amdgcn_mfma_f32_16x16x32_bf16(qf[ks], frag_row(CB, 16 * vt, 32 * ks, fr, fq), X[x], 0, 0, 0);
                } }
            if (vh == 1 && fr == 0) {
#pragma unroll
                for (int r = 0; r < 4; ++r) den[16 * ti + 4 * fq + r] = X[3][r] * eb[64 * c + 16 * ti + 4 * fq + r]; }
        }
        {
#pragma unroll
            for (int ks = 0; ks < 2; ++ks) { const bf16x8_t kf = frag_tr(Ki, ML_STRIDE, 32 * ks, 16 * w, lane);
#pragma unroll
                for (int vt = 0; vt < 8; ++vt) st[vt] = __builtin_amdgcn_mfma_f32_16x16x32_bf16(kf, frag_tr(Vi, ML_STRIDE, 32 * ks, 16 * vt, lane), st[vt], 0, 0, 0);
                st[8] = __builtin_amdgcn_mfma_f32_16x16x32_bf16(kf, frag_tr(AUGi, 16, 32 * ks, 0, lane), st[8], 0, 0, 0); }
            const float ee = ebend[c];
#pragma unroll
            for (int vt = 0; vt < 9; ++vt) st[vt] = st[vt] * ee;
        }
        WG_BAR();
        if (OUT) {
            float sq[4] = {0.f, 0.f, 0.f, 0.f};
#pragma unroll
            for (int r = 0; r < 4; ++r) { const int t = 16 * ti + 4 * fq + r; const float sc = eb[64 * c + t] * __builtin_amdgcn_rcpf(fmaxf(fabsf(den[t]), 1.f));
#pragma unroll
                for (int x = 0; x < 4; ++x) { const int vt = vh * 5 + x; const float hv = (vt < 8) ? X[x][r] * sc : 0.f; hval[x][r] = hv; sq[r] += hv * hv; }
                if (vh == 0) { const float hv = X[4][r] * sc; X[4][r] = hv; sq[r] += hv * hv; } }
#pragma unroll
            for (int r = 0; r < 4; ++r) { float v = sq[r]; v += __shfl_xor(v, 1); v += __shfl_xor(v, 2); v += __shfl_xor(v, 4); v += __shfl_xor(v, 8); if (fr == 0) ssq[vh * 64 + 16 * ti + 4 * fq + r] = v; }
#pragma unroll
            for (int vt = 0; vt < 9; ++vt) { pg8::u32x2 o; o.x = pk2(st[vt][0], st[vt][1]); o.y = pk2(st[vt][2], st[vt][3]); *(pg8::u32x2*)(CB + (16 * vt + fr) * ML_STRIDE + 16 * w + 4 * fq) = o; }
            WG_BAR();
            float* TM = (float*)(a.ws + WS_TM); bf16* YA = (bf16*)(a.ws + WS_YA);
#pragma unroll
            for (int r = 0; r < 4; ++r) { const int t = 16 * ti + 4 * fq + r; const float rs = __builtin_amdgcn_rsqf((ssq[t] + ssq[64 + t]) * (1.f / 128.f) + EPS);
                const size_t ob = (size_t)(rowbase - NCTX + 64 * c + t) * 1024 + h * 128;
#pragma unroll
                for (int x = 0; x < 5; ++x) { const int vt = vh * 5 + x; if (vt < 8) { const int v = 16 * vt + fr; const float hv = (x < 4) ? hval[x][r] : X[4][r];
                    float y = hv * rs * hgv[x] * bf2f(ogv[x][r]);
                    if (PASS2) { y += tmv[x][r]; YA[ob + v] = (bf16)f2bf(y); } else TM[ob + v] = y; } } }
        }
    }
}

__device__ __forceinline__ void ml_state_quad(const Args& a, unsigned char* lds_g, int qu, int tid) {
    const int seq = qu >> 1, j0 = 4 * (qu & 1), dir = seq & 1, h = (seq >> 1) & 7, b = seq >> 4;
    const int lane = tid & 63, w = __builtin_amdgcn_readfirstlane(tid >> 6);
    f32x4 st[9];
#pragma unroll
    for (int vt = 0; vt < 9; ++vt) st[vt] = (f32x4){0.f, 0.f, 0.f, 0.f};
#pragma unroll 1
    for (int jj = 0; jj < 4; ++jj) {
        const int j = j0 + jj, su = seq * 8 + j;
        const int rowbase = j == 0 ? b * CTXL : NCTX + b * SEQ + 256 * (dir ? 8 - j : j - 1);
        ml_gates(a, lds_g, rowbase, h, tid);
        WG_BAR();
        ml_block<false, false>(a, lds_g, rowbase, h, dir, st, tid);
        f32x4* SL = (f32x4*)(a.ws + WS_SLOC) + ((size_t)(su * 8 + w) * 9) * 64 + lane;
#pragma unroll
        for (int vt = 0; vt < 9; ++vt) SL[vt * 64] = st[vt];
        if (tid == 0) { const float* bd = (const float*)(lds_g + ML_BEND) + dir * 4; ((float*)(a.ws + WS_BT))[su] = (bd[0] + bd[1]) + (bd[2] + bd[3]); }
        WG_BAR();
    }
}
__device__ __forceinline__ void ml_out_unit(const Args& a, unsigned char* lds_g, int u, int tid) {
    const int L = u & 7, h = (u >> 3) & 7, b = u >> 6;
    const int rowbase = NCTX + b * SEQ + 256 * L;
    const int lane = tid & 63, w = __builtin_amdgcn_readfirstlane(tid >> 6), fr = lane & 15, fq = lane >> 4;
    bf16* CB = (bf16*)(lds_g + ML_CB);
    ml_gates(a, lds_g, rowbase, h, tid);
    f32x4 st[9];
#pragma unroll
    for (int dir = 0; dir < 2; ++dir) {
        const int seq = (b * 8 + h) * 2 + dir, jmax = dir ? 7 - L : L;
        const float* BT = (const float*)(a.ws + WS_BT) + seq * 8;
        {
            const f32x4* SLa = (const f32x4*)(a.ws + WS_SLOC) + ((size_t)((seq * 8 + jmax) * 8 + w) * 9) * 64 + lane;
            const f32x4* SLb = (const f32x4*)(a.ws + WS_SLOC) + ((size_t)((seq * 8 + 3) * 8 + w) * 9) * 64 + lane;
            if (jmax >= 4) {
                f32x4 sb[9];
#pragma unroll
                for (int vt = 0; vt < 9; ++vt) { st[vt] = SLa[vt * 64]; sb[vt] = SLb[vt * 64]; }
                float ls = 0.f;
#pragma unroll
                for (int q = 4; q < 8; ++q) ls += (q <= jmax) ? BT[q] : 0.f;
                const float coef = __expf(ls);
#pragma unroll
                for (int vt = 0; vt < 9; ++vt) st[vt] += sb[vt] * coef;
            } else {
#pragma unroll
                for (int vt = 0; vt < 9; ++vt) st[vt] = SLa[vt * 64];
            }
        }
#pragma unroll
        for (int vt = 0; vt < 9; ++vt) { pg8::u32x2 o; o.x = pk2(st[vt][0], st[vt][1]); o.y = pk2(st[vt][2], st[vt][3]); *(pg8::u32x2*)(CB + (16 * vt + fr) * ML_STRIDE + 16 * w + 4 * fq) = o; }
        WG_BAR();
        if (dir == 0) ml_block<true, false>(a, lds_g, rowbase, h, 0, st, tid);
        else ml_block<true, true>(a, lds_g, rowbase, h, 1, st, tid);
        asm volatile("s_waitcnt vmcnt(0)" ::: "memory");
        WG_BAR();
    }
}

__device__ __forceinline__ void lru_out_unit(const Args& a, unsigned char* lds_g, int b, int cidx, int blk, int tid) {
    const int chl = tid & 127, q = tid >> 7, ch = blk * 128 + chl;
    float2* QA = (float2*)lds_g;
    float av[2][16], bv[2][16];
#pragma unroll
    for (int d = 0; d < 2; ++d) { const unsigned* PS = (const unsigned*)(a.ws + WS_PS) + ((size_t)(b * 2 + d) * NSTEP + 64 * cidx + 16 * q) * 1024 + ch;
#pragma unroll
        for (int i = 0; i < 16; ++i) { const unsigned wv = PS[(size_t)i * 1024]; av[d][i] = 1.f - bflo(wv); bv[d][i] = bfhi(wv); } }
    float2* CA = (float2*)(lds_g + 8192);
#pragma unroll
    for (int d = 0; d < 2; ++d) { const float2* AGG = (const float2*)(a.ws + WS_AGG) + ((size_t)(b * 2 + d) * 36) * 1024 + ch; float2 qv[9];
#pragma unroll
        for (int i = 0; i < 9; ++i) { const int sidx = 9 * q + i; const int c2 = d ? (sidx < 4 ? 3 - sidx : 39 - sidx) : sidx; qv[i] = AGG[(size_t)c2 * 1024]; }
        float P = 1.f, S = 0.f;
#pragma unroll
        for (int i = 0; i < 9; ++i) { const int sidx = 9 * q + i; const int c2 = d ? (sidx < 4 ? 3 - sidx : 39 - sidx) : sidx; const bool use = d ? (sidx < 4 || c2 > cidx) : (c2 < cidx);
            S = use ? qv[i].x * S + qv[i].y : S; P = use ? qv[i].x * P : P; }
        CA[(d * 4 + q) * 128 + chl] = make_float2(P, S); }
#pragma unroll
    for (int d = 0; d < 2; ++d) { float P = 1.f, S = 0.f;
#pragma unroll
        for (int ii = 0; ii < 16; ++ii) { const int i = d ? 15 - ii : ii; S = av[d][i] * S + bv[d][i]; P = av[d][i] * P; }
        QA[(d * 4 + q) * 128 + chl] = make_float2(P, S); }
    WG_BAR();
    float hs[16];
#pragma unroll
    for (int d = 0; d < 2; ++d) { float h = 0.f;
#pragma unroll
        for (int k = 0; k < 4; ++k) { const float2 t = CA[(d * 4 + k) * 128 + chl]; h = t.x * h + t.y; }
#pragma unroll
        for (int k = 0; k < 3; ++k) { const int qq = d ? 3 - k : k; const bool use = d ? (qq > q) : (qq < q); const float2 t = QA[(d * 4 + qq) * 128 + chl]; h = use ? t.x * h + t.y : h; }
#pragma unroll
        for (int ii = 0; ii < 16; ++ii) { const int i = d ? 15 - ii : ii; h = av[d][i] * h + bv[d][i]; if (d == 0) hs[i] = h; else hs[i] += h; } }
    const int p0 = (cidx - 4) * 64 + 16 * q;
    unsigned short ugv[16];
#pragma unroll
    for (int i = 0; i < 16; ++i) ugv[i] = ((const bf16*)(a.ws + WS_UG))[(size_t)(lru_pos_row(b, false, p0 + i) - NCTX) * 1024 + ch];
#pragma unroll
    for (int i = 0; i < 16; ++i) { const size_t lrow = (size_t)(lru_pos_row(b, false, p0 + i) - NCTX) * 1024 + ch;
        ((bf16*)(a.ws + WS_YB))[lrow] = (bf16)f2bf(hs[i] * bf2f(ugv[i])); }
    WG_BAR();
}
__device__ __forceinline__ void phase3(const Args& a, unsigned char* lds_g, int tid) {
    {
        int q0 = (int)blockIdx.x, qstep = (int)gridDim.x;
        if (gridDim.x == 256) q0 = blockIdx.x >= 128 ? (int)blockIdx.x - 128 : 128;
        for (int qu = q0; qu < 128; qu += qstep) ml_state_quad(a, lds_g, qu, tid);
    }
    for (int u = blockIdx.x; u < 4 * 36 * 8; u += gridDim.x) { const int blk = u & 7, q = u >> 3; lru_unit<false>(a, lds_g, q / 36, q % 36, blk, tid); }
}

struct SchedProj {
    int G, c; const char *YA, *YB, *WA, *WB;
    __device__ __forceinline__ bool next(int i, pg8::Unit& u) const {
        const int tile = (i >> 1) * G + c, part = i & 1; if (tile >= 256) return false;
        int pm, pn; pg8::tile_order(tile, 32, 8, pm, pn);
        u.pm = pm; u.pn = pn; u.aux = part; u.A = (part ? YB : YA) + (size_t)pm * 256 * 1024 * 2; u.B = (part ? WB : WA) + (size_t)pn * 256 * 1024 * 2; return true;
    }
};
struct EpiProj {
    static constexpr bool PERM = true;
    const bf16 *GA, *GB; bf16* PRE;
    __device__ __forceinline__ void operator()(const pg8::f32x4 (&acc)[2][2][4][2], const pg8::Unit& u, int wr, int wc, int fr, int fq) const {
        const bf16* gsrc = u.aux ? GB : GA;
#pragma unroll
        for (int ai = 0; ai < 2; ++ai) {
            pg8::u32x4 gw[4][2], pw[4][2];
#pragma unroll
            for (int m = 0; m < 4; ++m) { const size_t off = (size_t)(u.pm * 256 + ai * 128 + wr * 64 + m * 16 + fr) * 2048 + u.pn * 256 + wc * 32 + 8 * fq;
#pragma unroll
                for (int bj = 0; bj < 2; ++bj) { gw[m][bj] = *(const pg8::u32x4*)(gsrc + off + bj * 128); if (u.aux) pw[m][bj] = *(const pg8::u32x4*)(PRE + off + bj * 128); } }
#pragma unroll
            for (int m = 0; m < 4; ++m) { const size_t off = (size_t)(u.pm * 256 + ai * 128 + wr * 64 + m * 16 + fr) * 2048 + u.pn * 256 + wc * 32 + 8 * fq;
#pragma unroll
                for (int bj = 0; bj < 2; ++bj) { const pg8::u32x4 g4 = gw[m][bj];
                    pg8::f32x4 v0 = acc[ai][bj][m][0], v1 = acc[ai][bj][m][1];
                    v0[0] *= bflo(g4.x); v0[1] *= bfhi(g4.x); v0[2] *= bflo(g4.y); v0[3] *= bfhi(g4.y); v1[0] *= bflo(g4.z); v1[1] *= bfhi(g4.z); v1[2] *= bflo(g4.w); v1[3] *= bfhi(g4.w);
                    if (u.aux) { const pg8::u32x4 p4 = pw[m][bj];
                        v0[0] += bflo(p4.x); v0[1] += bfhi(p4.x); v0[2] += bflo(p4.y); v0[3] += bfhi(p4.y); v1[0] += bflo(p4.z); v1[1] += bfhi(p4.z); v1[2] += bflo(p4.w); v1[3] += bfhi(p4.w); }
                    pg8::u32x4 w; w.x = pg8::cvt_pk_bf16(v0[0], v0[1]); w.y = pg8::cvt_pk_bf16(v0[2], v0[3]); w.z = pg8::cvt_pk_bf16(v1[0], v1[1]); w.w = pg8::cvt_pk_bf16(v1[2], v1[3]);
                    *(pg8::u32x4*)(PRE + off + bj * 128) = w; } }
        }
    }
};

struct SchedOut {
    int G, c; const char *A, *B;
    __device__ __forceinline__ bool next(int i, pg8::Unit& u) const {
        const int L = i * G + c; if (L >= 256) return false;
        int pm, pn; pg8::tile_order(L, 32, 8, pm, pn);
        u.pm = pm; u.pn = pn; u.aux = 0; u.A = A + (size_t)pm * 256 * D * 2; u.B = B + (size_t)pn * 256 * D * 2; return true;
    }
};
struct EpiOut {
    static constexpr bool PERM = false;
    const float* x; const float* MOD; float* X1;
    __device__ __forceinline__ void operator()(const pg8::f32x4 (&acc)[2][2][4][2], const pg8::Unit& u, int wr, int wc, int fr, int fq) const {
        const int b = u.pm >> 3; const int col0 = u.pn * 256 + wc * 32 + 4 * fq;
        pg8::f32x4 g1[2][2];
#pragma unroll
        for (int bj = 0; bj < 2; ++bj)
#pragma unroll
            for (int n = 0; n < 2; ++n) g1[bj][n] = *(const pg8::f32x4*)(MOD + b * 12288 + 2 * 2048 + col0 + bj * 128 + n * 16);
#pragma unroll
        for (int ai = 0; ai < 2; ++ai) {
            pg8::f32x4 xv[4][2][2];
#pragma unroll
            for (int m = 0; m < 4; ++m) { const size_t off = (size_t)(u.pm * 256 + ai * 128 + wr * 64 + m * 16 + fr) * D + col0;
#pragma unroll
                for (int bj = 0; bj < 2; ++bj)
#pragma unroll
                    for (int n = 0; n < 2; ++n) xv[m][bj][n] = *(const pg8::f32x4*)(x + off + bj * 128 + n * 16); }
#pragma unroll
            for (int m = 0; m < 4; ++m) { const size_t off = (size_t)(u.pm * 256 + ai * 128 + wr * 64 + m * 16 + fr) * D + col0;
#pragma unroll
                for (int bj = 0; bj < 2; ++bj)
#pragma unroll
                    for (int n = 0; n < 2; ++n) *(pg8::f32x4*)(X1 + off + bj * 128 + n * 16) = xv[m][bj][n] + g1[bj][n] * acc[ai][bj][m][n]; }
        }
    }
};

__device__ __forceinline__ void phase_router(const Args& a, unsigned char* lds_g, int tid, int lane, int wave) {
    const float* X1 = (const float*)(a.ws + WS_X1); const float* MOD = (const float*)(a.ws + WS_MOD); const float* g = a.in[I_N2G];
    const float* WR = (const float*)(a.ws + WS_WR); const float* RB = (const float*)(a.ws + WS_RB);
    bf16* H2 = (bf16*)(a.ws + WS_H2); unsigned* cnt = (unsigned*)(a.ws + WS_CTL) + CW_CNT; int4* ASG = (int4*)(a.ws + WS_ASG);
    f32x4* PART = (f32x4*)lds_g;
    float* SSQP = (float*)(lds_g + 24576);
    float* RS = (float*)(lds_g + 24576 + 512);
    float* LG = (float*)(lds_g + 24576 + 1024);
    const int slot = wave >> 2, kq = wave & 3, i = lane & 15, gq = lane >> 4;
    for (int tp = blockIdx.x; tp < NLAT / 32; tp += gridDim.x) {
        const int tok0 = 32 * tp + 16 * slot, b = tok0 >> 11, kbase = kq * 512 + gq * 128;
        const float* xr = X1 + (size_t)(tok0 + i) * D + kbase;
        const float* wr = WR + ((size_t)(b * 48 + i) * 2048 + kbase);
        f32x4 acc0 = (f32x4){0.f, 0.f, 0.f, 0.f}, acc1 = acc0, acc2 = acc0; float sq = 0.f;
#pragma unroll 4
        for (int s4 = 0; s4 < 32; ++s4) {
            const f32x4 xa = *(const f32x4*)(xr + 4 * s4), b0 = *(const f32x4*)(wr + 4 * s4), b1 = *(const f32x4*)(wr + 16 * 2048 + 4 * s4), b2 = *(const f32x4*)(wr + 32 * 2048 + 4 * s4);
#pragma unroll
            for (int e = 0; e < 4; ++e) { acc0 = __builtin_amdgcn_mfma_f32_16x16x4f32(xa[e], b0[e], acc0, 0, 0, 0); acc1 = __builtin_amdgcn_mfma_f32_16x16x4f32(xa[e], b1[e], acc1, 0, 0, 0); acc2 = __builtin_amdgcn_mfma_f32_16x16x4f32(xa[e], b2[e], acc2, 0, 0, 0); }
            sq += (xa.x * xa.x + xa.y * xa.y) + (xa.z * xa.z + xa.w * xa.w);
        }
        sq += __shfl_xor(sq, 16); sq += __shfl_xor(sq, 32);
        PART[((slot * 4 + kq) * 3 + 0) * 64 + lane] = acc0; PART[((slot * 4 + kq) * 3 + 1) * 64 + lane] = acc1; PART[((slot * 4 + kq) * 3 + 2) * 64 + lane] = acc2;
        if (gq == 0) SSQP[(slot * 4 + kq) * 16 + i] = sq;
        __syncthreads();
        if (kq == 0) {
            const float* sp = SSQP + slot * 64; const float rstd = 1.f / sqrtf(((sp[i] + sp[16 + i]) + (sp[32 + i] + sp[48 + i])) * (1.f / D) + EPS);
            if (gq == 0) RS[slot * 16 + i] = rstd;
#pragma unroll
            for (int cb = 0; cb < 3; ++cb) { const f32x4* pp = PART + (slot * 4 * 3 + cb) * 64 + lane; const f32x4 sum = (pp[0] + pp[3 * 64]) + (pp[6 * 64] + pp[9 * 64]);
                const float rb = RB[b * 48 + 16 * cb + i];
#pragma unroll
                for (int r = 0; r < 4; ++r) LG[(slot * 16 + 4 * gq + r) * 48 + 16 * cb + i] = __shfl(rstd, 4 * gq + r) * sum[r] + rb; }
            LDS_WAIT(); asm volatile("" ::: "memory");
            if (lane < 16) {
                const float* lg = LG + (slot * 16 + lane) * 48; const int t = tok0 + lane;
                int gs = 0; float gm = lg[32];
#pragma unroll
                for (int q = 1; q < 4; ++q) { const float v = lg[32 + q]; if (v > gm) { gm = v; gs = q; } }
                float se = 0.f;
#pragma unroll
                for (int q = 0; q < 4; ++q) se += __expf(lg[32 + q] - gm);
                const float pg = 1.f / se;
                int i0 = 0; float v0 = lg[gs * 8];
#pragma unroll
                for (int q = 1; q < 8; ++q) { const float v = lg[gs * 8 + q]; if (v > v0) { v0 = v; i0 = q; } }
                int i1 = -1; float v1 = -3.0e38f;
#pragma unroll
                for (int q = 0; q < 8; ++q) { const float v = lg[gs * 8 + q]; if (q != i0 && v > v1) { v1 = v; i1 = q; } }
                const float e1 = __expf(v1 - v0), w0 = pg / (1.f + e1), w1 = pg * e1 / (1.f + e1);
                const int ex0 = gs * 8 + i0, ex1 = gs * 8 + i1;
                const unsigned p0 = atomicAdd(cnt + ex0, 1u), p1 = atomicAdd(cnt + ex1, 1u);
                ASG[2 * t] = make_int4(ex0, (int)p0, __float_as_int(w0), 0); ASG[2 * t + 1] = make_int4(ex1, (int)p1, __float_as_int(w1), 0);
                int* LIST = (int*)(a.ws + WS_LIST); LIST[ex0 * 8192 + (int)p0] = t; LIST[ex1 * 8192 + (int)p1] = t;
            }
        }
        __syncthreads();
#pragma unroll
        for (int r = 0; r < 4; ++r) { const int tl = 4 * kq + r, t = tok0 + tl; const float rstd = RS[slot * 16 + tl];
            const f32x4* xrow = (const f32x4*)(X1 + (size_t)t * D) + lane; unsigned long long* o8 = (unsigned long long*)(H2 + (size_t)t * D) + lane;
            f32x4 yv[8];
#pragma unroll
            for (int j = 0; j < 8; ++j) { const int c = 4 * lane + 256 * j;
                const f32x4 gg = *(const f32x4*)(g + c), sh = *(const f32x4*)(MOD + b * 12288 + 3 * 2048 + c), sc = *(const f32x4*)(MOD + b * 12288 + 4 * 2048 + c);
                yv[j] = xrow[64 * j] * rstd * gg * (sc + 1.f) + sh; }
#pragma unroll
            for (int j = 0; j < 8; ++j) o8[64 * j] = (unsigned long long)pk2(yv[j].x, yv[j].y) | ((unsigned long long)pk2(yv[j].z, yv[j].w) << 32); }
        __syncthreads();
    }
}

constexpr int MG_A = 0, MG_ABYTES = 32768, MG_B = 65536, MG_BBYTES = 64 * 256  , MG_CUM = 141312  ;
__device__ __forceinline__ int mgb_off(int row, int ch) { return 256 * row + 16 * (ch ^ (((row & 3) << 2) | ((row >> 2) & 3))); }
__device__ __forceinline__ bf16x8_t mgb_frag(const unsigned char* img, int ks, int c, int lane) {
    const int g = lane >> 4, q = (lane & 15) >> 2, p = lane & 3;
    const s4_t lo = ds_tr((const bf16*)(img + mgb_off(32 * ks + 8 * g + q, 2 * c + (p >> 1)) + 8 * (p & 1)));
    const s4_t hi = ds_tr((const bf16*)(img + mgb_off(32 * ks + 8 * g + 4 + q, 2 * c + (p >> 1)) + 8 * (p & 1)));
    return (bf16x8_t){lo.x, lo.y, lo.z, lo.w, hi.x, hi.y, hi.z, hi.w};
}
__device__ __forceinline__ void moe_tables(const Args& a, unsigned char* lds_g, int tid) {
    int* cum = (int*)(lds_g + MG_CUM); const unsigned* ctl = (const unsigned*)(a.ws + WS_CTL);
    if (tid < NEXP) cum[128 + tid] = (int)ctl[CW_CNT + tid];
    if (tid == 0) { int c = 0; for (int e = 0; e < NEXP; ++e) { cum[e] = c; c += (int)((ctl[CW_CNT + e] + 255u) >> 8); } cum[NEXP] = c; }
    __syncthreads();
}
constexpr int MH_A = 0, MH_ABYTES = 32768, MH_B = 65536, MH_BROW = 528, MH_BBYTES = 64 * MH_BROW  ;
__device__ __forceinline__ int mhb_off(int row, int ch) { return MH_BROW * row + 16 * ch; }
__device__ __forceinline__ bf16x8_t mhb_frag(const unsigned char* img, int ks, int c, int lane) {
    const int g = lane >> 4, q = (lane & 15) >> 2, p = lane & 3;
    const s4_t lo = ds_tr((const bf16*)(img + mhb_off(32 * ks + 8 * g + q, 2 * c + (p >> 1)) + 8 * (p & 1)));
    const s4_t hi = ds_tr((const bf16*)(img + mhb_off(32 * ks + 8 * g + 4 + q, 2 * c + (p >> 1)) + 8 * (p & 1)));
    return (bf16x8_t){lo.x, lo.y, lo.z, lo.w, hi.x, hi.y, hi.z, hi.w};
}
__device__ __forceinline__ int moe_pull(const Args& a, unsigned char* lds_g, int tid, int x) {
    int* slot = (int*)(lds_g + MG_CUM + 256);
    __syncthreads();
    if (tid == 0) *slot = (int)__hip_atomic_fetch_add((unsigned*)(a.ws + WS_CTL) + CW_Q + 64 * x, 1u, __ATOMIC_RELAXED, __HIP_MEMORY_SCOPE_AGENT);
    __syncthreads();
    return *slot;
}
template <int MODE>
__device__ __forceinline__ int moe_gemm(const Args& a, unsigned char* lds_g, int tid, int idx0) {
    constexpr int K = MODE == 1 ? D : DE, NT = K / 64;
#define MG_BAR() do { asm volatile("s_waitcnt lgkmcnt(0)" ::: "memory"); __builtin_amdgcn_s_barrier(); asm volatile("" ::: "memory"); } while (0)
    const int lane = tid & 63, w = __builtin_amdgcn_readfirstlane(tid >> 6), fr = lane & 15, fq = lane >> 4;
    const int wm = w >> 1, wn = w & 1, hh = wm >> 1, wr = wm & 1;
    const int* cum = (const int*)(lds_g + MG_CUM); const unsigned* ctl = (const unsigned*)(a.ws + WS_CTL);
    const int T = cum[NEXP], x = blockIdx.x & 7;
    const int aoff = pg8::lds_byte(wr * 64 + fr, fq * 8);
    const int bk = tid >> 6, bp = tid & 63;
    int aR[2], aC[2];
#pragma unroll
    for (int i = 0; i < 2; ++i) pg8::stage_rc(tid * 16 + i * 8192, aR[i], aC[i]);
    for (int idx = idx0;;) {
        if (idx < 0) idx = moe_pull(a, lds_g, tid, x);
        if (idx >= (MODE == 1 ? T : 2 * T)) return idx;
        const int ti = MODE == 1 ? idx : idx - T;
        idx = -1;
        const int nt = x;
        if (MODE == 2) {
            if (tid < 64) { unsigned* tc = (unsigned*)(a.ws + WS_CTL) + CW_TC + 64 * ti; unsigned spins = 0;
                while ((unsigned)__builtin_amdgcn_readfirstlane(__hip_atomic_load(tc, __ATOMIC_RELAXED, __HIP_MEMORY_SCOPE_AGENT)) < 64u) {
                    __builtin_amdgcn_s_sleep(2);
                    if (++spins > (1u << 22)) { if (tid == 0) __hip_atomic_store((unsigned*)(a.ws + WS_CTL) + 1, 0x900u + (unsigned)ti, __ATOMIC_RELAXED, __HIP_MEMORY_SCOPE_AGENT); break; } }
                __builtin_amdgcn_fence(__ATOMIC_ACQUIRE, "agent");
                asm volatile("s_waitcnt vmcnt(0)" ::: "memory"); }
            __syncthreads();
        }
        int e = 0;
#pragma unroll 1
        for (int q = 1; q < NEXP; ++q) e = (cum[q] <= ti) ? q : e;
        const int mt = ti - cum[e];
        const char* abase; unsigned aofs[4]; const char* bbase; unsigned bofs; size_t bld;
        if (MODE == 1) { const int cnt = cum[128 + e];
#pragma unroll
            for (int q = 0; q < 4; ++q) { const int pos = 256 * mt + 128 * (q >> 1) + aR[q & 1]; const int tok = pos < cnt ? ((const int*)(a.ws + WS_LIST))[e * 8192 + pos] : 0;
                aofs[q] = (unsigned)(tok * D + aC[q & 1]) * 2u; }
            abase = (const char*)(a.ws + WS_H2);
            const int seg = bp >> 4, mat = seg & 1, col = 128 * nt + 64 * (seg >> 1) + 4 * (bp & 15);
            bbase = (const char*)(a.in[mat ? I_W3 : I_W1] + (size_t)e * D * DE); bofs = (unsigned)(bk * DE + col) * 4u; bld = DE; }
        else {
#pragma unroll
            for (int q = 0; q < 4; ++q) aofs[q] = (unsigned)((128 * (q >> 1) + aR[q & 1]) * DE + aC[q & 1]) * 2u;
            abase = (const char*)((const bf16*)(a.ws + WS_HM) + (size_t)256 * ti * DE);
            bbase = (const char*)(a.in[I_W2] + (size_t)e * DE * D); bofs = (unsigned)(bk * D + 256 * nt + 4 * bp) * 4u; bld = D; }
        const int bwr0 = mhb_off(bk, bp >> 1) + 8 * (bp & 1);
        f32x4 acc[4][8];
#pragma unroll
        for (int m = 0; m < 4; ++m)
#pragma unroll
            for (int n = 0; n < 8; ++n) acc[m][n] = (f32x4){0.f, 0.f, 0.f, 0.f};
        v4u ra[4]; f32x4 rb[8];
#define MH_LD(t_) do { _Pragma("unroll") for (int j_ = 0; j_ < 4; ++j_) ra[j_] = *(const v4u*)(abase + aofs[j_] + 128 * (t_)); \
        _Pragma("unroll") for (int j_ = 0; j_ < 8; ++j_) rb[j_] = *(const f32x4*)(bbase + bofs + (size_t)(64 * (t_) + 8 * j_) * bld * 4); } while (0)
#define MH_ST(buf_) do { _Pragma("unroll") for (int j_ = 0; j_ < 4; ++j_) *(v4u*)(lds_g + MH_A + (buf_) * MH_ABYTES + (j_ >> 1) * 16384 + (j_ & 1) * 8192 + tid * 16) = ra[j_]; \
        _Pragma("unroll") for (int j_ = 0; j_ < 8; ++j_) { pg8::u32x2 o_; o_.x = pk2(rb[j_].x, rb[j_].y); o_.y = pk2(rb[j_].z, rb[j_].w); *(pg8::u32x2*)(lds_g + MH_B + (buf_) * MH_BBYTES + bwr0 + j_ * 8 * MH_BROW) = o_; } } while (0)
#define MH_MMA(buf_) do { const unsigned char* Bi_ = lds_g + MH_B + (buf_) * MH_BBYTES; \
        _Pragma("unroll") for (int ks_ = 0; ks_ < 2; ++ks_) { bf16x8_t af_[4]; \
            _Pragma("unroll") for (int m_ = 0; m_ < 4; ++m_) af_[m_] = *(const bf16x8_t*)(lds_g + MH_A + (buf_) * MH_ABYTES + hh * 16384 + aoff + m_ * 2048 + ks_ * 1024); \
            _Pragma("unroll") for (int n_ = 0; n_ < 8; n_ += 2) { const bf16x8_t bf0_ = mhb_frag(Bi_, ks_, 8 * wn + n_, lane), bf1_ = mhb_frag(Bi_, ks_, 8 * wn + n_ + 1, lane); \
                _Pragma("unroll") for (int m_ = 0; m_ < 4; ++m_) { acc[m_][n_] = __builtin_amdgcn_mfma_f32_16x16x32_bf16(bf0_, af_[m_], acc[m_][n_], 0, 0, 0); \
                    acc[m_][n_ + 1] = __builtin_amdgcn_mfma_f32_16x16x32_bf16(bf1_, af_[m_], acc[m_][n_ + 1], 0, 0, 0); } \
                __builtin_amdgcn_sched_barrier(0); } } } while (0)
        MH_LD(0);
        MG_BAR();
        MH_ST(0);
        MH_LD(1);
        for (int t = 0; t < NT; t += 2) {
            const int t2 = (t + 2 < NT) ? t + 2 : NT - 1, t3 = (t + 3 < NT) ? t + 3 : NT - 1;
            MG_BAR();
            MH_ST(1);
            MH_LD(t2);
            MH_MMA(0);
            MG_BAR();
            MH_ST(0);
            MH_LD(t3);
            MH_MMA(1);
        }
#undef MH_LD
#undef MH_ST
#undef MH_MMA
        const size_t row0 = (size_t)256 * ti + 128 * hh + 64 * wr + fr;
        if (MODE == 1) { bf16* HM = (bf16*)(a.ws + WS_HM);
#pragma unroll
            for (int m = 0; m < 4; ++m)
#pragma unroll
                for (int n = 0; n < 4; ++n) { float hv[4];
#pragma unroll
                    for (int r = 0; r < 4; ++r) { const float a1 = acc[m][n][r]; hv[r] = a1 * sigmoidf_(a1) * acc[m][n + 4][r]; }
                    const unsigned long long o = (unsigned long long)pk2(hv[0], hv[1]) | ((unsigned long long)pk2(hv[2], hv[3]) << 32);
                    __hip_atomic_store((unsigned long long*)(HM + (row0 + 16 * m) * DE + 128 * nt + 64 * wn + 16 * n + 4 * fq), o, __ATOMIC_RELAXED, __HIP_MEMORY_SCOPE_AGENT); }
            asm volatile("s_waitcnt vmcnt(0)" ::: "memory");
            if (lane == 0) __hip_atomic_fetch_add((unsigned*)(a.ws + WS_CTL) + CW_TC + 64 * ti, 1u, __ATOMIC_RELAXED, __HIP_MEMORY_SCOPE_AGENT); }
        else { bf16* Y2 = (bf16*)(a.ws + WS_Y2);
#pragma unroll
            for (int m = 0; m < 4; ++m)
#pragma unroll
                for (int n = 0; n < 8; ++n) { pg8::u32x2 o; o.x = pk2(acc[m][n][0], acc[m][n][1]); o.y = pk2(acc[m][n][2], acc[m][n][3]);
                    *(pg8::u32x2*)(Y2 + (row0 + 16 * m) * D + 256 * nt + 128 * wn + 16 * n + 4 * fq) = o; } }
    }
#undef MG_BAR
}

__device__ __forceinline__ void phase12(const Args& a, unsigned char* lds_g, int lane, int wave) {
    const int gw = blockIdx.x * NWAVES + wave, NGW = gridDim.x * NWAVES;
    const int* cum = (const int*)(lds_g + MG_CUM);
    const float* X1 = (const float*)(a.ws + WS_X1); const float* MOD = (const float*)(a.ws + WS_MOD); const float* fg = a.in[I_FG];
    const int4* ASG = (const int4*)(a.ws + WS_ASG); const bf16* Y2 = (const bf16*)(a.ws + WS_Y2);
    for (int t = gw; t < NLAT; t += NGW) {
        const int b = t >> 11; const int4 q0 = ASG[2 * t], q1 = ASG[2 * t + 1];
        const float w0 = __int_as_float(q0.z), w1 = __int_as_float(q1.z);
        const f32x4* xr = (const f32x4*)(X1 + (size_t)t * D) + lane;
        const unsigned long long* y0 = (const unsigned long long*)(Y2 + (size_t)(256 * cum[q0.x] + q0.y) * D) + lane; const unsigned long long* y1 = (const unsigned long long*)(Y2 + (size_t)(256 * cum[q1.x] + q1.y) * D) + lane;
        f32x4 v[8]; float s = 0.f;
#pragma unroll
        for (int j = 0; j < 8; ++j) {
            const int c = 4 * lane + 256 * j;
            const f32x4 g2 = *(const f32x4*)(MOD + b * 12288 + 5 * 2048 + c);
            const unsigned long long a0 = y0[64 * j], a1 = y1[64 * j];
            f32x4 y; y.x = w0 * bflo((unsigned)a0) + w1 * bflo((unsigned)a1); y.y = w0 * bfhi((unsigned)a0) + w1 * bfhi((unsigned)a1);
            y.z = w0 * bflo((unsigned)(a0 >> 32)) + w1 * bflo((unsigned)(a1 >> 32)); y.w = w0 * bfhi((unsigned)(a0 >> 32)) + w1 * bfhi((unsigned)(a1 >> 32));
            v[j] = xr[64 * j] + g2 * y;
            s += (v[j].x * v[j].x + v[j].y * v[j].y) + (v[j].z * v[j].z + v[j].w * v[j].w);
        }
        const float rstd = 1.f / sqrtf(wave_sum(s) * (1.f / D) + EPS);
        f32x4* o = (f32x4*)(a.out + (size_t)t * D) + lane; f32x4 fgv[8];
#pragma unroll
        for (int j = 0; j < 8; ++j) fgv[j] = *(const f32x4*)(fg + 4 * lane + 256 * j);
#pragma unroll
        for (int j = 0; j < 8; ++j) o[64 * j] = v[j] * rstd * fgv[j];
    }
}

__global__ void __launch_bounds__(NTHR, 2) fwd_kernel(Args args) {
    extern __shared__ __attribute__((aligned(16))) unsigned char lds[];
    LAS unsigned char* ldsl = (LAS unsigned char*)lds;
    volatile LAS unsigned* MISC = (volatile LAS unsigned*)(ldsl + MISC_OFF);
    LAS unsigned* TL = (LAS unsigned*)(ldsl + LDSCTL_OFF);
    const int wave_s = __builtin_amdgcn_readfirstlane(threadIdx.x >> 6);
#define TID() make_tid(wave_s)
    { const int t0 = TID(); for (int u = t0; u < (LDS_BYTES - LDSCTL_OFF) / 4; u += NTHR) ((LAS unsigned*)(ldsl + LDSCTL_OFF))[u] = 0u; }
    __syncthreads();
    unsigned char* ws = args.ws;
    unsigned* ctl = (unsigned*)(ws + WS_CTL);
    XcdBarrier bar; bar.bar = ctl + CW_BAR; bar.x = 0; bar.st = nullptr;
    const bool one_launch = (args.ph_hi - args.ph_lo) > 1;
    if (one_launch) bar = xcd_barrier_post(ctl + CW_BAR, MISC + 8, TID());
    const int lo = args.ph_lo, hi = args.ph_hi;
#define IN(k) (lo <= (k) && (k) < hi)
#define SEAM(k) do { if (IN(k) && IN((k) + 1)) xcd_barrier(bar, TID()); } while (0)
    const int G = gridDim.x, c = blockIdx.x;

#define FRESH() const int tid = TID(), lane = tid & 63, wave = __builtin_amdgcn_readfirstlane(tid >> 6); (void)lane; (void)wave
#ifndef DUP_PHASE
#define DUP_PHASE (-1)
#endif
#define PH(k, ...) if (IN(k)) { _Pragma("unroll") for (int rep_ = 0; rep_ < ((DUP_PHASE) == (k) ? 2 : 1); ++rep_) { if (rep_) xcd_barrier(bar, TID()); __VA_ARGS__ } } SEAM(k);
    PH(0, { FRESH(); phase0(args, lds, tid, lane, wave); mod_wait(args, tid); phase1(args, lane, wave); })
    PH(1, {
        SchedIn S{G, c, (const char*)(ws + WS_H), (const char*)(ws + WS_WIN)}; EpiIn E{ws, args.in[I_BGATES]};
        pg8::gemm_phase<EpiIn, SchedIn>(ldsl, D, S, E, TID());
        { const int R_ = (1492 + G - 1) / G; int fi_ = 1492 - (R_ - 1) * G; if (fi_ >= G) fi_ = 0;
          if (c >= fi_) { FRESH(); late_prep(args, lds, (c - fi_) * NWAVES + wave, (G - fi_) * NWAVES, lane, wave); } } })
    PH(2, { FRESH(); phase3(args, lds, tid); })
    PH(3, { FRESH();
        for (int u = c; u < 256; u += G) ml_out_unit(args, lds, u, tid);
        for (int u = c; u < 4 * 32 * 8; u += G) { const int blk = u & 7, q = u >> 3; lru_out_unit(args, lds, q >> 5, 4 + (q & 31), blk, tid); } })
    PH(4, {
        SchedProj S{G, c, (const char*)(ws + WS_YA), (const char*)(ws + WS_YB), (const char*)(ws + WS_WPA), (const char*)(ws + WS_WPB)};
        EpiProj E{(const bf16*)(ws + WS_GA), (const bf16*)(ws + WS_GB), (bf16*)(ws + WS_PRE)};
        pg8::gemm_phase<EpiProj, SchedProj>(ldsl, 1024, S, E, TID()); })
    PH(5, {
        SchedOut S{G, c, (const char*)(ws + WS_PRE), (const char*)(ws + WS_WOUT)}; EpiOut E{args.in[I_X], (const float*)(ws + WS_MOD), (float*)(ws + WS_X1)};
        pg8::gemm_phase<EpiOut, SchedOut>(ldsl, D, S, E, TID()); })
    PH(6, { FRESH(); phase_router(args, lds, tid, lane, wave); })
    PH(7, { FRESH(); moe_tables(args, lds, tid); const int nx_ = moe_gemm<1>(args, lds, tid, -1); (void)moe_gemm<2>(args, lds, tid, nx_); })
    PH(8, { FRESH(); moe_tables(args, lds, tid); phase12(args, lds, lane, wave); })
#undef PH
#undef IN
#undef SEAM
}

extern "C" void kernel_launch(void* const* d_in, const int* in_sizes, int n_in, void* d_out, int out_size, void* d_ws, size_t ws_size, hipStream_t stream) {
    static int grid = 0;
    if (grid == 0) {
        if (n_in != 27 || out_size != NLAT * D || ws_size < WS_END) { fprintf(stderr, "kernel_launch: unexpected shapes (n_in %d, out %d, ws %zu)\n", n_in, out_size, ws_size); grid = -1; return; }
        int dev = 0, cus = 0, per_cu = 0;
        if (hipGetDevice(&dev) != hipSuccess || hipDeviceGetAttribute(&cus, hipDeviceAttributeMultiprocessorCount, dev) != hipSuccess) { grid = -1; return; }
        if (hipFuncSetAttribute((const void*)fwd_kernel, hipFuncAttributeMaxDynamicSharedMemorySize, LDS_BYTES) != hipSuccess) { fprintf(stderr, "kernel_launch: hipFuncSetAttribute failed\n"); grid = -1; return; }
        if (hipOccupancyMaxActiveBlocksPerMultiprocessor(&per_cu, (const void*)fwd_kernel, NTHR, LDS_BYTES) != hipSuccess || per_cu < 1) fprintf(stderr, "kernel_launch: occupancy query says %d\n", per_cu);
        (void)hipGetLastError();
        grid = cus;
    }
    if (grid < 0) return;
    (void)hipMemsetAsync((char*)d_ws + WS_CTL, 0, CTL_ZERO_BYTES, stream);
    Args a{};
    for (int i = 0; i < 27; ++i) a.in[i] = (const float*)d_in[i];
    a.out = (float*)d_out; a.ws = (unsigned char*)d_ws;
#if MK_ONE_LAUNCH
    a.ph_lo = 0; a.ph_hi = NPHASE;
    hipLaunchKernelGGL(fwd_kernel, dim3(grid), dim3(NTHR), LDS_BYTES, stream, a);
#else
    for (int p = 0; p < NPHASE; ++p) { a.ph_lo = p; a.ph_hi = p + 1; hipLaunchKernelGGL(fwd_kernel, dim3(grid), dim3(NTHR), LDS_BYTES, stream, a); }
#endif
}
```

```cpp
#include <hip/hip_runtime.h>
#include <cstdio>
#include <cstdint>

#ifndef MK_ONE_LAUNCH
#define MK_ONE_LAUNCH 1
#endif

namespace pg8 {
#define PG8_LAS __attribute__((address_space(3)))
typedef unsigned short bf16_t;
typedef short bf16x8 __attribute__((ext_vector_type(8)));
typedef float f32x4 __attribute__((ext_vector_type(4)));
typedef float f32x2 __attribute__((ext_vector_type(2)));
typedef unsigned u32x4 __attribute__((ext_vector_type(4)));
typedef unsigned u32x2 __attribute__((ext_vector_type(2)));
constexpr int BM = 256, BK = 64, HALF = 128, HTB = HALF * BK * 2  , STAGE_BYTES = 8 * HTB, NXCD = 8, WGM = 8;

__host__ __device__ __forceinline__ int lds_byte(int r, int c) { const int st = (r >> 4) * 2 + (c >> 5), rr = r & 15, cc = c & 31, ob = rr * 64 + cc * 2; return st * 1024 + (ob ^ (((ob >> 9) & 1) << 5)); }
__host__ __device__ __forceinline__ void stage_rc(int b, int& R, int& C) { const int st = b / 1024, sb = b % 1024, swz = sb ^ (((sb >> 9) & 1) << 5); R = (st >> 1) * 16 + swz / 64; C = (st & 1) * 32 + (swz % 64) / 2; }
__host__ __device__ __forceinline__ int perm32(int rho) { const int n = rho >> 4, i = rho & 15; return 8 * (i >> 2) + 4 * n + (i & 3); }

struct Unit { const char* A; const char* B; int pm, pn, aux; };

__host__ __device__ __forceinline__ void tile_order(int L, int nM, int nN, int& pm, int& pn) {
    const int nwg = nM * nN; int wgid = L;
    { const int q = nwg / NXCD, r = nwg % NXCD, xcd = wgid % NXCD, off = wgid / NXCD; wgid = (xcd < r ? xcd * (q + 1) : r * (q + 1) + (xcd - r) * q) + off; }
    const int nig = WGM * nN, gid = wgid / nig, fm = gid * WGM, gsz = (nM - fm) < WGM ? (nM - fm) : WGM;
    pm = fm + ((wgid % nig) % gsz); pn = (wgid % nig) / gsz;
}

typedef __bf16 bf16n2 __attribute__((ext_vector_type(2)));
__device__ __forceinline__ unsigned cvt_pk_bf16(float lo, float hi) { const f32x2 v = {lo, hi}; return __builtin_bit_cast(unsigned, __builtin_convertvector(v, bf16n2)); }

template <class Epi, class Sched>
__device__ __forceinline__ void gemm_phase(PG8_LAS unsigned char* lds, const int K, const Sched& S, const Epi& E, int tid) {
    const int wid = __builtin_amdgcn_readfirstlane(tid >> 6), lane = tid & 63, wr = wid >> 2, wc = wid & 3, fr = lane & 15, fq = lane >> 4;
    const int nt = K / BK;
    unsigned voffA[2], voffB[2];
#pragma unroll
    for (int i = 0; i < 2; ++i) { int R, C; stage_rc(tid * 16 + i * 8192, R, C); const int Rb = Epi::PERM ? ((R & ~31) + perm32(R & 31)) : R;
        voffA[i] = (unsigned)(R * K + C) * 2u; voffB[i] = (unsigned)(Rb * K + C) * 2u; }
    const size_t kstep = (size_t)(BK * 2);
    const size_t hstep = (size_t)HALF * K * 2;
    const unsigned ldsw = (unsigned)wid * 1024u;
    const int aoff = lds_byte(wr * 64 + fr, fq * 8), boff = lds_byte(wc * 32 + fr, fq * 8);
#define PG8_SA(b, h) (((b) * 2 + (h)) * HTB)
#define PG8_SB(b, h) ((4 + (b) * 2 + (h)) * HTB)
#define PG8_STAGE(bufoff, gbase, voff) do { _Pragma("unroll") for (int _i = 0; _i < 2; ++_i) \
        __builtin_amdgcn_global_load_lds((const unsigned*)((const char*)(gbase) + (voff)[_i]), (PG8_LAS unsigned*)(lds + (bufoff) + ldsw + _i * 8192), 16, 0, 0); } while (0)
#define PG8_LDA(dst, b, h) do { _Pragma("unroll") for (int m = 0; m < 4; ++m) _Pragma("unroll") for (int k = 0; k < 2; ++k) dst[m][k] = *(const PG8_LAS bf16x8*)(lds + PG8_SA(b, h) + aoff + m * 2048 + k * 1024); } while (0)
#define PG8_LDB(dst, b, h) do { _Pragma("unroll") for (int n = 0; n < 2; ++n) _Pragma("unroll") for (int k = 0; k < 2; ++k) dst[n][k] = *(const PG8_LAS bf16x8*)(lds + PG8_SB(b, h) + boff + n * 2048 + k * 1024); } while (0)
#define PG8_MMA(ai, bj, At, Bt) do { __builtin_amdgcn_s_setprio(1); _Pragma("unroll") for (int m = 0; m < 4; ++m) _Pragma("unroll") for (int n = 0; n < 2; ++n) _Pragma("unroll") for (int k = 0; k < 2; ++k) \
        acc[ai][bj][m][n] = __builtin_amdgcn_mfma_f32_16x16x32_bf16(Bt[n][k], At[m][k], acc[ai][bj][m][n], 0, 0, 0); __builtin_amdgcn_s_setprio(0); } while (0)
#define PG8_WAIT_V(n) asm volatile("s_waitcnt vmcnt(" #n ")" ::: "memory")
#define PG8_WAIT_L(n) asm volatile("s_waitcnt lgkmcnt(" #n ")" ::: "memory")
#define PG8_BAR __builtin_amdgcn_s_barrier()
#define PG8_SCHED __builtin_amdgcn_sched_barrier(0)
    Unit cur, nxt; int ui = 0;
    if (!S.next(0, cur)) return;
    f32x4 acc[2][2][4][2];
#pragma unroll
    for (int a = 0; a < 2; ++a)
#pragma unroll
        for (int b = 0; b < 2; ++b)
#pragma unroll
            for (int m = 0; m < 4; ++m)
#pragma unroll
                for (int n = 0; n < 2; ++n) acc[a][b][m][n] = (f32x4){0.f, 0.f, 0.f, 0.f};
    bf16x8 At[4][2], B0[2][2], B1[2][2];
    const char* cA = cur.A; const char* cB = cur.B;
    PG8_STAGE(PG8_SB(0, 0), cB, voffB); PG8_STAGE(PG8_SB(0, 1), cB + hstep, voffB); PG8_STAGE(PG8_SA(0, 0), cA, voffA); PG8_STAGE(PG8_SA(0, 1), cA + hstep, voffA);
    if (wr == 1) PG8_BAR;
    PG8_WAIT_V(2); PG8_BAR;
    PG8_STAGE(PG8_SB(1, 0), cB + kstep, voffB); PG8_STAGE(PG8_SA(1, 0), cA + kstep, voffA); PG8_STAGE(PG8_SB(1, 1), cB + hstep + kstep, voffB);
    PG8_WAIT_V(6); PG8_BAR;
    for (;;) {
        const bool has_next = S.next(ui + 1, nxt);
        const char* nA = has_next ? nxt.A : cA; const char* nB = has_next ? nxt.B : cB;
        for (int t = 0; t < nt; t += 2) {
            const bool last = (t == nt - 2);
            const char* a1 = cA + (size_t)(t + 1) * kstep;
            const char* a2 = last ? nA : cA + (size_t)(t + 2) * kstep; const char* b2 = last ? nB : cB + (size_t)(t + 2) * kstep;
            const char* a3 = a2 + kstep; const char* b3 = b2 + kstep;
            PG8_LDB(B0, 0, 0); PG8_LDB(B1, 0, 1); PG8_SCHED; PG8_LDA(At, 0, 0); PG8_STAGE(PG8_SA(1, 1), a1 + hstep, voffA);
            PG8_WAIT_V(8); PG8_WAIT_L(0); PG8_BAR; PG8_MMA(0, 0, At, B0); PG8_MMA(0, 1, At, B1); PG8_BAR; PG8_SCHED;
            PG8_LDA(At, 0, 1); PG8_STAGE(PG8_SB(0, 0), b2, voffB); PG8_STAGE(PG8_SB(0, 1), b2 + hstep, voffB); PG8_STAGE(PG8_SA(0, 0), a2, voffA);
            PG8_WAIT_V(8); PG8_WAIT_L(0); PG8_BAR; PG8_MMA(1, 0, At, B0); PG8_MMA(1, 1, At, B1); PG8_BAR; PG8_SCHED;
            PG8_LDB(B0, 1, 0); PG8_LDB(B1, 1, 1); PG8_SCHED; PG8_LDA(At, 1, 0); PG8_STAGE(PG8_SA(0, 1), a2 + hstep, voffA);
            PG8_WAIT_V(8); PG8_WAIT_L(0); PG8_BAR; PG8_MMA(0, 0, At, B0); PG8_MMA(0, 1, At, B1); PG8_BAR; PG8_SCHED;
            PG8_LDA(At, 1, 1); PG8_STAGE(PG8_SB(1, 0), b3, voffB); PG8_STAGE(PG8_SB(1, 1), b3 + hstep, voffB); PG8_STAGE(PG8_SA(1, 0), a3, voffA);
            PG8_WAIT_V(8); PG8_WAIT_L(0); PG8_BAR; PG8_MMA(1, 0, At, B0); PG8_MMA(1, 1, At, B1); PG8_BAR; PG8_SCHED;
        }
        if (wr == 0) PG8_BAR;
        { int fr_ = fr, fq_ = fq; asm volatile("" : "+v"(fr_), "+v"(fq_)); E(acc, cur, wr, wc, fr_, fq_); }
        if (!has_next) break;
#pragma unroll
        for (int a = 0; a < 2; ++a)
#pragma unroll
            for (int b = 0; b < 2; ++b)
#pragma unroll
                for (int m = 0; m < 4; ++m)
#pragma unroll
                    for (int n = 0; n < 2; ++n) acc[a][b][m][n] = (f32x4){0.f, 0.f, 0.f, 0.f};
        cur = nxt; cA = nA; cB = nB; ++ui;
        if (wr == 1) PG8_BAR;
    }
    PG8_WAIT_V(0);
    PG8_BAR;
#undef PG8_SA
#undef PG8_SB
#undef PG8_STAGE
#undef PG8_LDA
#undef PG8_LDB
#undef PG8_MMA
#undef PG8_WAIT_V
#undef PG8_WAIT_L
#undef PG8_BAR
#undef PG8_SCHED
}
}

constexpr int NWAVES = 8, NTHR = 512;
constexpr int D = 2048, NB = 4, SEQ = 2048, CTXL = 256, NCTX = NB * CTXL  , NLAT = NB * SEQ  , NTOK = NCTX + NLAT  ;
constexpr int NSTEP = CTXL + SEQ;
constexpr int HEADS = 8, HD = 128, MW = 1024, LW = 1024;
constexpr int NEXP = 32, DE = 1024;
constexpr int IN_DIM = 11296, NT_IN = 45;
constexpr float EPS = 1e-6f;
constexpr int MAXTILES = 96;
constexpr int NPHASE = 9;

constexpr size_t MiB = 1u << 20;
constexpr size_t WS_CTL = 0, CTL_ZERO_BYTES = 1 * MiB;
constexpr size_t WS_MOD = 1 * MiB;
constexpr size_t WS_GATES = 2 * MiB;
constexpr size_t WS_ASG = 4 * MiB + 512 * 1024;
constexpr size_t WS_LIST = 3 * MiB + 512 * 1024;
constexpr size_t WS_WR = 6 * MiB;
constexpr size_t WS_RB = 7 * MiB + 768 * 1024;
constexpr size_t WS_WL = 5 * MiB;
constexpr size_t WS_AGG = 978 * MiB;
constexpr size_t WS_WPA = 8 * MiB, WS_WPB = 12 * MiB, WS_WOUT = 16 * MiB, WS_WIN = 24 * MiB;
constexpr size_t WS_W13 = 72 * MiB, WS_W2 = 328 * MiB;
constexpr size_t WS_PS = 72 * MiB;
constexpr size_t WS_H = 456 * MiB;
constexpr size_t WS_K = 492 * MiB, WS_V = 510 * MiB, WS_UX = 528 * MiB;
constexpr size_t WS_Q = 546 * MiB, WS_OF = 562 * MiB, WS_OB = 578 * MiB, WS_UG = 594 * MiB;
constexpr size_t WS_GA = 610 * MiB, WS_GB = 642 * MiB;
constexpr size_t WS_LA = 674 * MiB, WS_LB = 746 * MiB;
constexpr size_t WS_HS = 818 * MiB, WS_TM = 882 * MiB;
constexpr size_t WS_YA = 946 * MiB, WS_YB = 962 * MiB;
constexpr size_t WS_BT = 982 * MiB;
constexpr size_t WS_SLOC = 984 * MiB;
constexpr size_t WS_END = 1022 * MiB;
constexpr size_t WS_PRE = WS_LA;
constexpr size_t WS_X1 = WS_LB;
constexpr size_t WS_H2 = WS_H;
constexpr size_t WS_XS = WS_K;
constexpr size_t WS_HM = 588 * MiB;
constexpr size_t WS_Y2 = WS_HS;
constexpr int CW_MODC = 32;
constexpr int CW_CNT = 64;
constexpr int CW_NT = 128;
constexpr int CW_TILE_E = 192;
constexpr int CW_BAR = 4096;
constexpr int CW_Q = 8192;
constexpr int CW_TC = 16384;

constexpr int RING_BYTES = 131072;
constexpr int LDSCTL_OFF = 143360;
constexpr int MISC_OFF = LDSCTL_OFF + 384;
constexpr int LDS_BYTES = 147456;

#define GAS __attribute__((address_space(1)))
#define LAS __attribute__((address_space(3)))
typedef unsigned short bf16;
typedef unsigned v4u __attribute__((ext_vector_type(4)));
typedef float f32x4 __attribute__((ext_vector_type(4)));
#define LDS_WAIT() asm volatile("s_waitcnt lgkmcnt(0)" ::: "memory")
#define WG_BAR() do { asm volatile("s_waitcnt lgkmcnt(0)" ::: "memory"); __builtin_amdgcn_s_barrier(); asm volatile("" ::: "memory"); } while (0)

__device__ __forceinline__ unsigned f2bf(float f) { unsigned u = __builtin_bit_cast(unsigned, f); return (u + 0x7fffu + ((u >> 16) & 1u)) >> 16; }
__device__ __forceinline__ unsigned pk2(float lo, float hi) { return pg8::cvt_pk_bf16(lo, hi); }
__device__ __forceinline__ float bf2f(unsigned h) { return __builtin_bit_cast(float, h << 16); }
__device__ __forceinline__ float bflo(unsigned w) { return __builtin_bit_cast(float, w << 16); }
__device__ __forceinline__ float bfhi(unsigned w) { return __builtin_bit_cast(float, w & 0xffff0000u); }
__device__ __forceinline__ float sigmoidf_(float x) { return __builtin_amdgcn_rcpf(1.f + __expf(-x)); }
__device__ __forceinline__ float gelu_tanh(float x) { const float u = 0.7978845608028654f * (x + 0.044715f * x * x * x); return x * __builtin_amdgcn_rcpf(1.f + __expf(-2.f * u)); }
__device__ __forceinline__ float wave_sum(float v) {
#pragma unroll
    for (int o = 1; o < 64; o <<= 1) v += __shfl_xor(v, o);
    return v;
}

#define XB_TMO      128
#define XB_XCNT(j)  (256  + 64 * (j))
#define XB_XSUB(j)  (1280 + 64 * (j))
#define XB_XGEN(j)  (2304 + 64 * (j))
#define XB_TOP      3328
#define XB_TOPGEN   3392
#define XCD_BAR_WORDS 3456
#define XB_SPIN_CAP (1u << 23)
__device__ __forceinline__ unsigned xb_ld(unsigned* p)              { return __hip_atomic_load(p, __ATOMIC_RELAXED, __HIP_MEMORY_SCOPE_AGENT); }
__device__ __forceinline__ unsigned xb_add(unsigned* p, unsigned v) { return __hip_atomic_fetch_add(p, v, __ATOMIC_RELAXED, __HIP_MEMORY_SCOPE_AGENT); }
__device__ __forceinline__ unsigned xb_xcc_id() { return (unsigned)__builtin_amdgcn_s_getreg((3 << 11) | 20) & 0xFu; }
#define XB_SPIN(cond, bar) do { unsigned _sp = 0; while (cond) { __builtin_amdgcn_s_sleep(1); \
    if ((++_sp & 255u) == 0u) { if (xb_ld(&(bar)[XB_TMO])) break; if (_sp > XB_SPIN_CAP) { atomicAdd(&(bar)[XB_TMO], 1u); break; } } } } while (0)
struct XcdBarrier { unsigned* bar; unsigned x; volatile LAS unsigned* st; };
__device__ __forceinline__ XcdBarrier xcd_barrier_post(unsigned* bar, volatile LAS unsigned* st, int tid) {
    XcdBarrier b; b.bar = bar; b.x = xb_xcc_id(); b.st = st;
    if (tid == 0) (void)xb_add(&bar[XB_XCNT(b.x)], 1u);
    return b;
}
__device__ __forceinline__ void xcd_barrier_complete(unsigned* bar, unsigned x, unsigned& nloc, unsigned& nx) {
    const unsigned G = gridDim.x * gridDim.y * gridDim.z;
    unsigned sum, cnt, mine, sp = 0u;
    for (;;) {
        sum = 0u; cnt = 0u; mine = 0u;
#pragma unroll
        for (unsigned j = 0; j < 16; ++j) { const unsigned c = xb_ld(&bar[XB_XCNT(j)]); sum += c; cnt += (c > 0u) ? 1u : 0u; mine = (j == x) ? c : mine; }
        if (sum == G) break;
        __builtin_amdgcn_s_sleep(1);
        if ((++sp & 255u) == 0u) { if (xb_ld(&bar[XB_TMO])) break; if (sp > XB_SPIN_CAP) { atomicAdd(&bar[XB_TMO], 1u); break; } }
    }
    nloc = mine > 0u ? mine : 1u; nx = cnt > 0u ? cnt : 1u;
}
__device__ __forceinline__ void xcd_barrier(const XcdBarrier& b, int tid) {
    asm volatile("s_waitcnt vmcnt(0)" ::: "memory");
    __syncthreads();
    if (tid == 0) {
        unsigned* bar = b.bar;
        __builtin_amdgcn_s_waitcnt(0);
        unsigned nloc = b.st[0], nx = b.st[1];
        if (nloc == 0u) { xcd_barrier_complete(bar, b.x, nloc, nx); b.st[0] = nloc; b.st[1] = nx; }
        const unsigned old = xb_add(&bar[XB_XSUB(b.x)], 1u);
        const unsigned gen = old / nloc;
        if (old + 1u == (gen + 1u) * nloc) {
            __builtin_amdgcn_fence(__ATOMIC_RELEASE, "agent");
            asm volatile("s_waitcnt vmcnt(0)" ::: "memory");
            const unsigned og = xb_add(&bar[XB_TOP], 1u);
            const unsigned tg = og / nx;
            if (og + 1u == (tg + 1u) * nx) xb_add(&bar[XB_TOPGEN], 1u);
            else XB_SPIN(xb_ld(&bar[XB_TOPGEN]) == tg, bar);
            __builtin_amdgcn_fence(__ATOMIC_ACQUIRE, "agent");
            xb_add(&bar[XB_XGEN(b.x)], 1u);
            asm volatile("s_waitcnt vmcnt(0)" ::: "memory");
        } else {
            XB_SPIN(xb_ld(&bar[XB_XGEN(b.x)]) == gen, bar);
            __builtin_amdgcn_fence(__ATOMIC_ACQUIRE, "agent");
            asm volatile("s_waitcnt vmcnt(0)" ::: "memory");
        }
    }
    __syncthreads();
}

__device__ __forceinline__ int make_tid(int wave_s) { int l; asm volatile("v_mbcnt_lo_u32_b32 %0, -1, 0\n\tv_mbcnt_hi_u32_b32 %0, -1, %0" : "=v"(l)); __builtin_assume(l >= 0 && l < 64); __builtin_assume(wave_s >= 0 && wave_s < 8); return wave_s * 64 + l; }
struct Args { const float* in[27]; float* out; unsigned char* ws; int ph_lo, ph_hi; };
enum { I_X = 0, I_C, I_CTX, I_CCTX, I_WMOD, I_BMOD, I_N1G, I_WIN, I_BGATES, I_HEADG, I_CONVW, I_CONVB, I_LWA, I_LBA, I_LWX, I_LBX, I_LAM, I_WPA, I_WPB, I_WOUT, I_N2G, I_WRG, I_WRE, I_W1, I_W3, I_W2, I_FG };

__device__ __forceinline__ void tr_item(const float* __restrict__ W, size_t ldw, int k0, int n0, bf16* dst, size_t ldd, float scale, LAS float* scr, int lane) {
#pragma unroll 16
    for (int i = 0; i < 32; ++i) { const int kk = 2 * i + (lane >> 5); scr[kk * 33 + (lane & 31)] = W[(size_t)(k0 + kk) * ldw + n0 + (lane & 31)]; }
    LDS_WAIT(); asm volatile("" ::: "memory");
    const int c = lane & 7;
#pragma unroll
    for (int j = 0; j < 4; ++j) { const int n = (lane >> 3) + 8 * j; const LAS float* s = scr + (8 * c) * 33 + n;
        v4u o; o.x = pk2(s[0 * 33] * scale, s[1 * 33] * scale); o.y = pk2(s[2 * 33] * scale, s[3 * 33] * scale); o.z = pk2(s[4 * 33] * scale, s[5 * 33] * scale); o.w = pk2(s[6 * 33] * scale, s[7 * 33] * scale);
        *(GAS v4u*)(dst + (size_t)n * ldd + 8 * c) = o; }
    LDS_WAIT(); asm volatile("" ::: "memory");
}
__device__ __forceinline__ int win_row(int n0, float& scale) {
    scale = 1.f;
    if (n0 < 1024) return 13 * 256 + n0;
    if (n0 < 2048) { scale = 0.08838834764831845f; return n0 - 1024; }
    if (n0 < 3072) return 4 * 256 + (n0 - 2048);
    if (n0 < 4096) return 17 * 256 + (n0 - 3072);
    if (n0 < 5120) return 21 * 256 + (n0 - 4096);
    if (n0 < 5152) return 12 * 256 + (n0 - 5120);
    if (n0 < 6176) return 8 * 256 + (n0 - 5152);
    if (n0 < 7200) return 25 * 256 + (n0 - 6176);
    if (n0 < 9248) return 29 * 256 + (n0 - 7200);
    return 37 * 256 + (n0 - 9248);
}

__device__ __forceinline__ void phase0(const Args& a, unsigned char* lds_g, int tid, int lane, int wave) {
    unsigned char* ws = a.ws;
    {
        float* sl = (float*)lds_g;
        float* red = sl + 5 * 2048;
        for (int i = tid; i < 5 * 2048; i += NTHR) { const int r = i >> 11, k = i & 2047; const float v = r < 4 ? a.in[I_C][r * 2048 + k] : a.in[I_CCTX][k]; sl[i] = v / (1.f + __expf(-v)); }
        __syncthreads();
        const float* wm = a.in[I_WMOD]; const float* bm = a.in[I_BMOD]; float* MOD = (float*)(ws + WS_MOD);
        for (int cb = blockIdx.x; cb < 256; cb += gridDim.x) {
            const int n0 = cb * 48;
            if (tid < 504) {
                const int kq = tid / 12, cg = tid % 12;
                f32x4 acc[5];
#pragma unroll
                for (int r = 0; r < 5; ++r) acc[r] = (f32x4){0.f, 0.f, 0.f, 0.f};
#pragma unroll 7
                for (int k = kq; k < 2048; k += 42) {
                    const f32x4 w = *(const f32x4*)(wm + (size_t)k * 12288 + n0 + 4 * cg);
#pragma unroll
                    for (int r = 0; r < 5; ++r) acc[r] += w * sl[r * 2048 + k];
                }
#pragma unroll
                for (int r = 0; r < 5; ++r) *(f32x4*)(red + tid * 20 + r * 4) = acc[r];
            }
            __syncthreads();
            if (tid < 240) {
                const int cg = tid / 20, rj = tid % 20; float s = 0.f;
                for (int kq = 0; kq < 42; ++kq) s += red[(kq * 12 + cg) * 20 + rj];
                const int r = rj >> 2, j = rj & 3, n = n0 + 4 * cg + j;
                __hip_atomic_store(MOD + r * 12288 + n, s + bm[n], __ATOMIC_RELAXED, __HIP_MEMORY_SCOPE_AGENT);
            }
            __syncthreads();
        }
        if (tid == 0) __hip_atomic_fetch_add((unsigned*)(ws + WS_CTL) + CW_MODC, 1u, __ATOMIC_RELAXED, __HIP_MEMORY_SCOPE_AGENT);
    }
    {
        LAS float* scr = (LAS float*)((LAS unsigned char*)lds_g) + wave * 4096;
        const int gw = blockIdx.x * NWAVES + wave, NGW = gridDim.x * NWAVES;
        constexpr int J0 = 32 * 353, J1 = 16 * 64, J3 = 32 * 64;
        constexpr int JL = 256;
        constexpr int NITEMS = J0 + 2 * J1;
        (void)J3; (void)JL;
        for (int it = gw; it < NITEMS; it += NGW) {
            int r = it;
            if (r < J0) { const int kb = r / 353, nb = r % 353; float sc; const int row = win_row(32 * nb, sc);
                tr_item(a.in[I_WIN], IN_DIM, 64 * kb, 32 * nb, (bf16*)(ws + WS_WIN) + (size_t)row * 2048 + 64 * kb, 2048, sc, scr, lane); continue; } r -= J0;
            if (r < J1) { const int kb = r / 64, nb = r % 64; tr_item(a.in[I_WPA], 2048, 64 * kb, 32 * nb, (bf16*)(ws + WS_WPA) + (size_t)(32 * nb) * 1024 + 64 * kb, 1024, 1.f, scr, lane); continue; } r -= J1;
            if (r < J1) { const int kb = r / 64, nb = r % 64; tr_item(a.in[I_WPB], 2048, 64 * kb, 32 * nb, (bf16*)(ws + WS_WPB) + (size_t)(32 * nb) * 1024 + 64 * kb, 1024, 1.f, scr, lane); continue; }
        }
        { GAS v4u* z = (GAS v4u*)((bf16*)(ws + WS_WIN) + (size_t)(12 * 256 + 32) * 2048); const int nchunks = 224 * 256;
          for (int i = blockIdx.x * NTHR + tid; i < nchunks; i += gridDim.x * NTHR) z[i] = (v4u){0u, 0u, 0u, 0u}; }
    }
}

__device__ __forceinline__ void late_prep(const Args& a, unsigned char* lds_g, int gw, int NGW, int lane, int wave) {
    unsigned char* ws = a.ws;
    {
        LAS float* scr = (LAS float*)((LAS unsigned char*)lds_g) + wave * 4096;
        constexpr int J3 = 32 * 64, JL = 256;
        for (int it = gw; it < J3 + JL; it += NGW) {
            int r = it;
            if (r >= J3) { r -= J3; const int mi = r >> 3, kb = (r >> 2) & 1, nb = r & 3, dir = mi >> 4, mat = (mi >> 3) & 1, blk = mi & 7;
                tr_item(a.in[mat ? I_LWX : I_LWA] + (size_t)(dir * 8 + blk) * 128 * 128, 128, 64 * kb, 32 * nb, (bf16*)(ws + WS_WL) + ((size_t)((dir * 2 + mat) * 8 + blk) * 128 + 32 * nb) * 128 + 64 * kb, 128, 1.f, scr, lane); continue; }
            const int kb = r / 64, nb = r % 64; tr_item(a.in[I_WOUT], 2048, 64 * kb, 32 * nb, (bf16*)(ws + WS_WOUT) + (size_t)(32 * nb) * 2048 + 64 * kb, 2048, 1.f, scr, lane);
        }
    }
    {
        const float* MODr = (const float*)(a.ws + WS_MOD); float* WR = (float*)(a.ws + WS_WR); float* RB = (float*)(a.ws + WS_RB);
        for (int idx = gw * 64 + lane; idx < 4 * 48 * 2048; idx += NGW * 64) { const int k = idx & 2047, j = (idx >> 11) % 48, b = idx / (48 * 2048);
            const float gm = a.in[I_N2G][k] * (1.f + MODr[b * 12288 + 4 * 2048 + k]);
            const float wv = j < 32 ? a.in[I_WRE][(size_t)k * 32 + j] : (j < 36 ? a.in[I_WRG][(size_t)k * 4 + (j - 32)] : 0.f);
            WR[idx] = gm * wv; }
        for (int q = gw; q < 4 * 48; q += NGW) { const int b = q / 48, j = q % 48; float sacc = 0.f;
            if (j < 36) { for (int k = lane; k < 2048; k += 64) { const float wv = j < 32 ? a.in[I_WRE][(size_t)k * 32 + j] : a.in[I_WRG][(size_t)k * 4 + (j - 32)]; sacc += MODr[b * 12288 + 3 * 2048 + k] * wv; } }
            sacc = wave_sum(sacc); if (lane == 0) RB[q] = sacc; }
    }
}
__device__ __forceinline__ void mod_wait(const Args& a, int tid) {
    if (tid < 64) { unsigned* mc = (unsigned*)(a.ws + WS_CTL) + CW_MODC; unsigned spins = 0;
        while ((unsigned)__builtin_amdgcn_readfirstlane(__hip_atomic_load(mc, __ATOMIC_RELAXED, __HIP_MEMORY_SCOPE_AGENT)) < gridDim.x) {
            __builtin_amdgcn_s_sleep(2);
            if (++spins > (1u << 22)) { if (tid == 0) __hip_atomic_store((unsigned*)(a.ws + WS_CTL) + 1, 0x800u, __ATOMIC_RELAXED, __HIP_MEMORY_SCOPE_AGENT); break; } }
        __builtin_amdgcn_fence(__ATOMIC_ACQUIRE, "agent");
        asm volatile("s_waitcnt vmcnt(0)" ::: "memory"); }
    __syncthreads();
}
__device__ __forceinline__ void phase1(const Args& a, int lane, int wave) {
    const int gw = blockIdx.x * NWAVES + wave, NGW = gridDim.x * NWAVES;
    const float* MOD = (const float*)(a.ws + WS_MOD); const float* g = a.in[I_N1G];
    bf16* H = (bf16*)(a.ws + WS_H);
    for (int r = gw; r < NTOK; r += NGW) {
        const float* src = r < NCTX ? a.in[I_CTX] + (size_t)r * D : a.in[I_X] + (size_t)(r - NCTX) * D;
        const int mr = r < NCTX ? 4 : (r - NCTX) / SEQ;
        const f32x4* xr = (const f32x4*)src + lane;
        f32x4 v[8]; float s = 0.f;
#pragma unroll
        for (int j = 0; j < 8; ++j) { v[j] = xr[64 * j]; s += (v[j].x * v[j].x + v[j].y * v[j].y) + (v[j].z * v[j].z + v[j].w * v[j].w); }
        const float rstd = 1.f / sqrtf(wave_sum(s) * (1.f / D) + EPS);
        unsigned long long* o8 = (unsigned long long*)(H + (size_t)r * D) + lane;
#pragma unroll
        for (int j = 0; j < 8; ++j) {
            const int c = 4 * lane + 256 * j;
            const f32x4 gg = *(const f32x4*)(g + c), sh = *(const f32x4*)(MOD + mr * 12288 + c), sc = *(const f32x4*)(MOD + mr * 12288 + 2048 + c);
            v[j] = v[j] * rstd * gg * (sc + 1.f) + sh;
        }
#pragma unroll
        for (int j = 0; j < 8; ++j) o8[64 * j] = (unsigned long long)pk2(v[j].x, v[j].y) | ((unsigned long long)pk2(v[j].z, v[j].w) << 32);
    }
}

struct SchedIn {
    int G, c; const char* A; const char* B;
    __device__ __forceinline__ bool next(int i, pg8::Unit& u) const {
        const int L = i * G + c; if (L >= 1492) return false;
        int pm, pn;
        if (L < 1440) { pg8::tile_order(L, 32, NT_IN, pm, pn); pm += 4; }
        else { const int j = L - 1440; pm = j & 3; pn = j >> 2; }
        u.pm = pm; u.pn = pn; u.aux = 0; u.A = A + (size_t)pm * 256 * D * 2; u.B = B + (size_t)pn * 256 * D * 2; return true;
    }
};
struct EpiIn {
    static constexpr bool PERM = true;
    unsigned char* ws; const float* b_gates;
    template <int ACT> __device__ __forceinline__ void store_tile(const pg8::f32x4 (&acc)[2][2][4][2], bf16* base, int ldc, int wr, int wc, int fr, int fq) const {
#pragma unroll
        for (int ai = 0; ai < 2; ++ai)
#pragma unroll
            for (int m = 0; m < 4; ++m) { bf16* rowp = base + (size_t)(ai * 128 + wr * 64 + m * 16 + fr) * ldc + wc * 32 + 8 * fq;
#pragma unroll
                for (int bj = 0; bj < 2; ++bj) { pg8::f32x4 v0 = acc[ai][bj][m][0], v1 = acc[ai][bj][m][1];
                    if (ACT == 1) {
#pragma unroll
                        for (int j = 0; j < 4; ++j) { v0[j] = sigmoidf_(v0[j]); v1[j] = sigmoidf_(v1[j]); } }
                    if (ACT == 2) {
#pragma unroll
                        for (int j = 0; j < 4; ++j) { v0[j] = gelu_tanh(v0[j]); v1[j] = gelu_tanh(v1[j]); } }
                    pg8::u32x4 w; w.x = pg8::cvt_pk_bf16(v0[0], v0[1]); w.y = pg8::cvt_pk_bf16(v0[2], v0[3]); w.z = pg8::cvt_pk_bf16(v1[0], v1[1]); w.w = pg8::cvt_pk_bf16(v1[2], v1[3]);
                    *(pg8::u32x4*)(rowp + bj * 128) = w; } }
    }
    __device__ __forceinline__ void operator()(const pg8::f32x4 (&acc)[2][2][4][2], const pg8::Unit& u, int wr, int wc, int fr, int fq) const {
        const int pn = u.pn; const size_t row0 = (size_t)u.pm * 256;
        if (pn < 12) {
            const int seg = pn >> 2, ct = pn & 3; bf16* dst = (bf16*)(ws + (seg == 0 ? WS_K : seg == 1 ? WS_V : WS_UX));
            store_tile<0>(acc, dst + row0 * 1024 + ct * 256, 1024, wr, wc, fr, fq);
        } else if (pn == 12) {
            if (wc == 0) {
                float* G = (float*)(ws + WS_GATES);
                const pg8::f32x4 bv0 = *(const pg8::f32x4*)(b_gates + 8 * fq), bv1 = *(const pg8::f32x4*)(b_gates + 8 * fq + 4);
#pragma unroll
                for (int ai = 0; ai < 2; ++ai)
#pragma unroll
                    for (int m = 0; m < 4; ++m) { float* rowp = G + (row0 + ai * 128 + wr * 64 + m * 16 + fr) * 32 + 8 * fq;
                        *(pg8::f32x4*)(rowp) = acc[ai][0][m][0] + bv0; *(pg8::f32x4*)(rowp + 4) = acc[ai][0][m][1] + bv1; }
            }
        } else if (pn < 29) {
            const int seg = (pn - 13) >> 2, ct = (pn - 13) & 3; const size_t lr = row0 - NCTX;
            bf16* dst = (bf16*)(ws + (seg == 0 ? WS_Q : seg == 1 ? WS_OF : seg == 2 ? WS_OB : WS_UG)) + lr * 1024 + ct * 256;
            if (seg == 0) store_tile<0>(acc, dst, 1024, wr, wc, fr, fq);
            else if (seg == 3) store_tile<2>(acc, dst, 1024, wr, wc, fr, fq);
            else store_tile<1>(acc, dst, 1024, wr, wc, fr, fq);
        } else {
            const int seg = (pn - 29) >> 3, ct = (pn - 29) & 7; const size_t lr = row0 - NCTX;
            store_tile<1>(acc, (bf16*)(ws + (seg ? WS_GB : WS_GA)) + lr * 2048 + ct * 256, 2048, wr, wc, fr, fq);
        }
    }
};

__device__ __forceinline__ int lru_pos_row(int b, bool isctx, int p) { return isctx ? b * CTXL + p : NCTX + b * SEQ + (p & 31) * 64 + (p >> 5); }
typedef short bf16x8_t __attribute__((ext_vector_type(8)));
template <bool FINAL>
__device__ __forceinline__ void lru_unit(const Args& a, unsigned char* lds_g, int b, int cidx, int blk, int tid) {
    const int lane = tid & 63, w = __builtin_amdgcn_readfirstlane(tid >> 6), fr = lane & 15, fq = lane >> 4;
    float* zf = (float*)lds_g;
    bf16* zb = (bf16*)(lds_g + 64 * 132 * 4);
    const bool isctx = cidx < 4; const int seglen = isctx ? CTXL : SEQ, p0 = (isctx ? cidx : cidx - 4) * 64;
    const bf16* UX = (const bf16*)(a.ws + WS_UX);
    float gba[2], gbx[2], glam[2];
    { const int ch_ = blk * 128 + 16 * w + fr;
#pragma unroll
      for (int d = 0; d < 2; ++d) { gba[d] = a.in[I_LBA][d * 1024 + ch_]; gbx[d] = a.in[I_LBX][d * 1024 + ch_]; glam[d] = a.in[I_LAM][d * 1024 + ch_]; } }
    bf16x8_t wl[2][2][4];
    { const bf16* WL = (const bf16*)(a.ws + WS_WL);
#pragma unroll
      for (int d = 0; d < 2; ++d)
#pragma unroll
        for (int m = 0; m < 2; ++m)
#pragma unroll
            for (int ks = 0; ks < 4; ++ks) wl[d][m][ks] = *(const bf16x8_t*)(WL + ((size_t)((d * 2 + m) * 8 + blk) * 128 + 16 * w + fr) * 128 + 32 * ks + 8 * fq); }
    __builtin_amdgcn_sched_barrier(0);
    {
        const int pos = tid >> 3, cg = tid & 7, ch0 = blk * 128 + cg * 16, p = p0 + pos;
        float z[16];
#pragma unroll
        for (int q = 0; q < 4; ++q) { const f32x4 bv = *(const f32x4*)(a.in[I_CONVB] + ch0 + 4 * q); z[4 * q] = bv.x; z[4 * q + 1] = bv.y; z[4 * q + 2] = bv.z; z[4 * q + 3] = bv.w; }
        v4u ua[4], ub[4]; float msk[4];
#pragma unroll
        for (int w4 = 0; w4 < 4; ++w4) { const int pp = p + w4 - 2; const bool ok = pp >= 0 && pp < seglen; const int ppc = ok ? pp : p;
            const v4u* src = (const v4u*)(UX + (size_t)lru_pos_row(b, isctx, ppc) * 1024 + ch0); ua[w4] = src[0]; ub[w4] = src[1]; msk[w4] = ok ? 1.f : 0.f; }
#pragma unroll
        for (int w4 = 0; w4 < 4; ++w4) { const float* cw = a.in[I_CONVW] + w4 * 1024 + ch0;
            const unsigned uu[8] = {ua[w4].x, ua[w4].y, ua[w4].z, ua[w4].w, ub[w4].x, ub[w4].y, ub[w4].z, ub[w4].w};
#pragma unroll
            for (int q = 0; q < 4; ++q) { const f32x4 cv = *(const f32x4*)(cw + 4 * q) * msk[w4]; z[4 * q] += cv.x * bflo(uu[2 * q]); z[4 * q + 1] += cv.y * bfhi(uu[2 * q]); z[4 * q + 2] += cv.z * bflo(uu[2 * q + 1]); z[4 * q + 3] += cv.w * bfhi(uu[2 * q + 1]); } }
#pragma unroll
        for (int q = 0; q < 4; ++q) *(f32x4*)(zf + pos * 132 + cg * 16 + 4 * q) = (f32x4){z[4 * q], z[4 * q + 1], z[4 * q + 2], z[4 * q + 3]};
        v4u o0, o1; o0.x = pk2(z[0], z[1]); o0.y = pk2(z[2], z[3]); o0.z = pk2(z[4], z[5]); o0.w = pk2(z[6], z[7]); o1.x = pk2(z[8], z[9]); o1.y = pk2(z[10], z[11]); o1.z = pk2(z[12], z[13]); o1.w = pk2(z[14], z[15]);
        *(v4u*)(zb + pos * 136 + cg * 16) = o0; *(v4u*)(zb + pos * 136 + cg * 16 + 8) = o1;
    }
    WG_BAR();
    f32x4 acc[2][2][4];
#pragma unroll
    for (int d = 0; d < 2; ++d)
#pragma unroll
        for (int m = 0; m < 2; ++m)
#pragma unroll
            for (int mt = 0; mt < 4; ++mt) acc[d][m][mt] = (f32x4){0.f, 0.f, 0.f, 0.f};
#pragma unroll
    for (int ks = 0; ks < 4; ++ks) {
        bf16x8_t af[4];
#pragma unroll
        for (int mt = 0; mt < 4; ++mt) af[mt] = *(const bf16x8_t*)(zb + (16 * mt + fr) * 136 + 32 * ks + 8 * fq);
#pragma unroll
        for (int d = 0; d < 2; ++d)
#pragma unroll
            for (int m = 0; m < 2; ++m) {
#pragma unroll
                for (int mt = 0; mt < 4; ++mt) acc[d][m][mt] = __builtin_amdgcn_mfma_f32_16x16x32_bf16(af[mt], wl[d][m][ks], acc[d][m][mt], 0, 0, 0); }
    }
    const int chl = 16 * w + fr, ch = blk * 128 + chl;
    float hsum[4][4];
#pragma unroll
    for (int d = 0; d < 2; ++d) {
        const float ba = gba[d], bx = gbx[d], lam = glam[d];
        const float sp = (-lam > 20.f) ? -lam : log1pf(__expf(-lam));
        float av[4][4], bv[4][4];
#pragma unroll
        for (int mt = 0; mt < 4; ++mt)
#pragma unroll
            for (int r = 0; r < 4; ++r) { const float rr = sigmoidf_(acc[d][0][mt][r] + ba), ii = sigmoidf_(acc[d][1][mt][r] + bx);
                const float aa = __expf(-8.f * rr * sp); av[mt][r] = aa; bv[mt][r] = __builtin_amdgcn_sqrtf(fmaxf(1.f - aa * aa, 0.f)) * ii * zf[(16 * mt + 4 * fq + r) * 132 + chl]; }
        float Pe[4], Se[4], Pt[4], St[4];
#pragma unroll
        for (int mt = 0; mt < 4; ++mt) {
            float P = 1.f, S = 0.f;
#pragma unroll
            for (int rr = 0; rr < 4; ++rr) { const int r = d ? 3 - rr : rr; S = av[mt][r] * S + bv[mt][r]; P = av[mt][r] * P; }
            if (d == 0) {
                float p1 = __shfl_up(P, 16), s1 = __shfl_up(S, 16); if (fq >= 1) { S = P * s1 + S; P = P * p1; }
                p1 = __shfl_up(P, 32); s1 = __shfl_up(S, 32); if (fq >= 2) { S = P * s1 + S; P = P * p1; }
                Pe[mt] = __shfl_up(P, 16); Se[mt] = __shfl_up(S, 16); if (fq == 0) { Pe[mt] = 1.f; Se[mt] = 0.f; }
                Pt[mt] = __shfl(P, fr + 48); St[mt] = __shfl(S, fr + 48);
            } else {
                float p1 = __shfl_down(P, 16), s1 = __shfl_down(S, 16); if (fq <= 2) { S = P * s1 + S; P = P * p1; }
                p1 = __shfl_down(P, 32); s1 = __shfl_down(S, 32); if (fq <= 1) { S = P * s1 + S; P = P * p1; }
                Pe[mt] = __shfl_down(P, 16); Se[mt] = __shfl_down(S, 16); if (fq == 3) { Pe[mt] = 1.f; Se[mt] = 0.f; }
                Pt[mt] = __shfl(P, fr); St[mt] = __shfl(S, fr);
            }
        }
        float2* AGG = (float2*)(a.ws + WS_AGG) + ((size_t)(b * 2 + d) * 36) * 1024 + ch;
        if (!FINAL) {
            if (cidx >= 4) {
                unsigned* PS = (unsigned*)(a.ws + WS_PS) + ((size_t)(b * 2 + d) * NSTEP + 64 * cidx) * 1024 + ch;
#pragma unroll
                for (int mt = 0; mt < 4; ++mt)
#pragma unroll
                    for (int r = 0; r < 4; ++r) PS[(size_t)(16 * mt + 4 * fq + r) * 1024] = pk2(1.f - av[mt][r], bv[mt][r]);
            }
            float Pc = 1.f, Sc = 0.f;
#pragma unroll
            for (int i = 0; i < 4; ++i) { const int mt = d ? 3 - i : i; Sc = Pt[mt] * Sc + St[mt]; Pc = Pt[mt] * Pc; }
            if (fq == 0) AGG[(size_t)cidx * 1024] = make_float2(Pc, Sc);
        } else {
            float h = 0.f;
#pragma unroll
            for (int g3 = 0; g3 < 6; ++g3) {
                float2 qv[6];
#pragma unroll
                for (int i = 0; i < 6; ++i) { const int sidx = 6 * g3 + i; const int c2 = d ? (sidx < 4 ? 3 - sidx : 39 - sidx) : sidx; qv[i] = AGG[(size_t)c2 * 1024]; }
#pragma unroll
                for (int i = 0; i < 6; ++i) { const int sidx = 6 * g3 + i; const int c2 = d ? (sidx < 4 ? 3 - sidx : 39 - sidx) : sidx;
                    const bool use = d ? (sidx < 4 || c2 > cidx) : (c2 < cidx);
                    h = use ? qv[i].x * h + qv[i].y : h; }
            }
#pragma unroll
            for (int i = 0; i < 4; ++i) { const int mt = d ? 3 - i : i;
                float hl = Pe[mt] * h + Se[mt];
#pragma unroll
                for (int rr = 0; rr < 4; ++rr) { const int r = d ? 3 - rr : rr; hl = av[mt][r] * hl + bv[mt][r]; if (d == 0) hsum[mt][r] = hl; else hsum[mt][r] += hl; }
                h = Pt[mt] * h + St[mt]; }
        }
    }
    if (FINAL) {
#pragma unroll
        for (int mt = 0; mt < 4; ++mt)
#pragma unroll
            for (int r = 0; r < 4; ++r) zf[(16 * mt + 4 * fq + r) * 132 + chl] = hsum[mt][r];
        WG_BAR();
        const int pos = tid >> 3, cg = tid & 7, ch0 = blk * 128 + cg * 16;
        const size_t lrow = (size_t)(lru_pos_row(b, false, p0 + pos) - NCTX) * 1024 + ch0;
        const v4u* ug = (const v4u*)((const bf16*)(a.ws + WS_UG) + lrow); const v4u g0 = ug[0], g1 = ug[1];
        const unsigned gg[8] = {g0.x, g0.y, g0.z, g0.w, g1.x, g1.y, g1.z, g1.w}; unsigned o[8];
#pragma unroll
        for (int q = 0; q < 4; ++q) { const f32x4 hv = *(const f32x4*)(zf + pos * 132 + cg * 16 + 4 * q);
            o[2 * q] = pk2(hv.x * bflo(gg[2 * q]), hv.y * bfhi(gg[2 * q])); o[2 * q + 1] = pk2(hv.z * bflo(gg[2 * q + 1]), hv.w * bfhi(gg[2 * q + 1])); }
        v4u* dst = (v4u*)((bf16*)(a.ws + WS_YB) + lrow); dst[0] = (v4u){o[0], o[1], o[2], o[3]}; dst[1] = (v4u){o[4], o[5], o[6], o[7]};
    }
    WG_BAR();
}
constexpr int ML_STRIDE = 136;
constexpr int ML_Q = 0, ML_K = 17408, ML_V = 34816, ML_AUG = 52224  , ML_CB = 54272  ;
constexpr int ML_EB = 93440  , ML_EU = 95488  , ML_EBEND = 97536  , ML_BEND = 97568  , ML_DEN = 97600  , ML_SSQ = 97856  ;
typedef short s4_t __attribute__((ext_vector_type(4)));
__device__ __forceinline__ s4_t ds_tr(const bf16* p) { return __builtin_amdgcn_ds_read_tr16_b64_v4i16((LAS s4_t*)p); }
__device__ __forceinline__ bf16x8_t frag_row(const bf16* img, int row0, int k0, int fr, int fq) { return *(const bf16x8_t*)(img + (row0 + fr) * ML_STRIDE + k0 + 8 * fq); }
__device__ __forceinline__ bf16x8_t frag_tr2(const bf16* img, int stride, int sA, int sB, int col0, int lane) {
    const int fq = lane >> 4, q = (lane & 15) >> 2, p = lane & 3;
    const s4_t lo = ds_tr(img + (sA + 4 * fq + q) * stride + col0 + 4 * p), hi = ds_tr(img + (sB + 4 * fq + q) * stride + col0 + 4 * p);
    return (bf16x8_t){lo.x, lo.y, lo.z, lo.w, hi.x, hi.y, hi.z, hi.w};
}
__device__ __forceinline__ bf16x8_t frag_tr(const bf16* img, int stride, int s0, int col0, int lane) {
    const int fq = lane >> 4, q = (lane & 15) >> 2, p = lane & 3;
    const bf16* b = img + (s0 + 8 * fq + q) * stride + col0 + 4 * p;
    const s4_t lo = ds_tr(b), hi = ds_tr(b + 4 * stride);
    return (bf16x8_t){lo.x, lo.y, lo.z, lo.w, hi.x, hi.y, hi.z, hi.w};
}
__device__ __forceinline__ float logsigmoidf_(float x) { return fminf(x, 0.f) - log1pf(__expf(-fabsf(x))); }

__device__ __forceinline__ void ml_gates(const Args& a, unsigned char* lds_g, int rowbase, int h, int tid) {
    const int lane = tid & 63, w = tid >> 6, dir = w >> 2, c = w & 3;
    const float* GT = (const float*)(a.ws + WS_GATES) + (size_t)(rowbase + 64 * c + lane) * 32;
    const float ipre = GT[(dir * 2) * 8 + h], fpre = GT[(dir * 2 + 1) * 8 + h];
    float bsum = logsigmoidf_(fpre);
    if (dir == 0) {
#pragma unroll
        for (int o = 1; o < 64; o <<= 1) { const float t = __shfl_up(bsum, o); if (lane >= o) bsum += t; }
    } else {
#pragma unroll
        for (int o = 1; o < 64; o <<= 1) { const float t = __shfl_down(bsum, o); if (lane + o < 64) bsum += t; }
    }
    float* eb = (float*)(lds_g + ML_EB); float* eu = (float*)(lds_g + ML_EU);
    eb[dir * 256 + 64 * c + lane] = __expf(bsum); eu[dir * 256 + 64 * c + lane] = __expf(ipre - bsum);
    const float bend = __shfl(bsum, dir ? 0 : 63);
    if (lane == 0) { ((float*)(lds_g + ML_EBEND))[dir * 4 + c] = __expf(bend); ((float*)(lds_g + ML_BEND))[dir * 4 + c] = bend; }
}

template <bool OUT, bool PASS2>
__device__ __forceinline__ void ml_block(const Args& a, unsigned char* lds_g, int rowbase, int h, int dir, f32x4 (&st)[9], int tid) {
    const int lane = tid & 63, w = __builtin_amdgcn_readfirstlane(tid >> 6), fr = lane & 15, fq = lane >> 4;
    bf16* Qi = (bf16*)(lds_g + ML_Q); bf16* Ki = (bf16*)(lds_g + ML_K); bf16* Vi = (bf16*)(lds_g + ML_V); bf16* AUGi = (bf16*)(lds_g + ML_AUG); bf16* CB = (bf16*)(lds_g + ML_CB);
    const float* eb = (const float*)(lds_g + ML_EB) + dir * 256; const float* eu = (const float*)(lds_g + ML_EU) + dir * 256;
    const float* ebend = (const float*)(lds_g + ML_EBEND) + dir * 4;
    float* den = (float*)(lds_g + ML_DEN); float* ssq = (float*)(lds_g + ML_SSQ);
    const bf16* Kb = (const bf16*)(a.ws + WS_K); const bf16* Vb = (const bf16*)(a.ws + WS_V); const bf16* Qb = (const bf16*)(a.ws + WS_Q);
    const int ti = w & 3, vh = w >> 2;
    float hgv[5];
    if (OUT) {
#pragma unroll
        for (int x = 0; x < 5; ++x) { const int vt = vh * 5 + x; hgv[x] = vt < 8 ? a.in[I_HEADG][h * 128 + 16 * vt + fr] : 0.f; } }
    for (int ci = 0; ci < 4; ++ci) {
        const int c = dir ? 3 - ci : ci;
        unsigned short ogv[5][4]; float tmv[5][4];
        if (OUT) {
            const bf16* OGp = (const bf16*)(a.ws + (dir ? WS_OB : WS_OF)); const float* TMp = (const float*)(a.ws + WS_TM);
#pragma unroll
            for (int r = 0; r < 4; ++r) { const size_t ob = (size_t)(rowbase - NCTX + 64 * c + 16 * ti + 4 * fq + r) * 1024 + h * 128;
#pragma unroll
                for (int x = 0; x < 5; ++x) { const int vt = vh * 5 + x; if (vt < 8) { ogv[x][r] = OGp[ob + 16 * vt + fr]; if (PASS2) tmv[x][r] = TMp[ob + 16 * vt + fr]; } } }
            __builtin_amdgcn_sched_barrier(0);
        }
        {
            const int t = tid >> 3, pc = tid & 7; const size_t row = (size_t)(rowbase + 64 * c + t);
            const v4u* ks = (const v4u*)(Kb + row * 1024 + h * 128 + 16 * pc); const v4u k0 = ks[0], k1 = ks[1];
            const v4u* vs = (const v4u*)(Vb + row * 1024 + h * 128 + 16 * pc); const v4u v0 = vs[0], v1 = vs[1];
            v4u q0, q1; if (OUT) { const v4u* qs = (const v4u*)(Qb + (row - NCTX) * 1024 + h * 128 + 16 * pc); q0 = qs[0]; q1 = qs[1]; }
            const float e = eu[64 * c + t];
            *(v4u*)(Ki + t * ML_STRIDE + 16 * pc) = k0; *(v4u*)(Ki + t * ML_STRIDE + 16 * pc + 8) = k1;
            if (OUT) { *(v4u*)(Qi + t * ML_STRIDE + 16 * pc) = q0; *(v4u*)(Qi + t * ML_STRIDE + 16 * pc + 8) = q1; }
            const unsigned vv[8] = {v0.x, v0.y, v0.z, v0.w, v1.x, v1.y, v1.z, v1.w}; unsigned o[8];
#pragma unroll
            for (int i = 0; i < 8; ++i) o[i] = pk2(bflo(vv[i]) * e, bfhi(vv[i]) * e);
            *(v4u*)(Vi + t * ML_STRIDE + 16 * pc) = (v4u){o[0], o[1], o[2], o[3]}; *(v4u*)(Vi + t * ML_STRIDE + 16 * pc + 8) = (v4u){o[4], o[5], o[6], o[7]};
            if (pc == 0) { *(v4u*)(AUGi + t * 16) = (v4u){f2bf(e), 0u, 0u, 0u}; *(v4u*)(AUGi + t * 16 + 8) = (v4u){0u, 0u, 0u, 0u}; }
        }
        WG_BAR();
        f32x4 X[5]; float hval[4][4];
        if (OUT) {
            bf16x8_t qf[4];
#pragma unroll
            for (int ks = 0; ks < 4; ++ks) qf[ks] = frag_row(Qi, 16 * ti, 32 * ks, fr, fq);
            bf16x8_t P[2]; bool pv[2];
#pragma unroll
            for (int pp = 0; pp < 2; ++pp) {
                f32x4 d[2];
#pragma unroll
                for (int hh = 0; hh < 2; ++hh) { const int si = 2 * pp + hh; d[hh] = (f32x4){0.f, 0.f, 0.f, 0.f};
                    const bool valid = dir ? (si >= ti) : (si <= ti);
                    if (valid) {
#pragma unroll
                        for (int ks = 0; ks < 4; ++ks) d[hh] = __builtin_amdgcn_mfma_f32_16x16x32_bf16(frag_row(Ki, 16 * si, 32 * ks, fr, fq), qf[ks], d[hh], 0, 0, 0);
                        if (si == ti) {
#pragma unroll
                            for (int r = 0; r < 4; ++r) { const bool keep = dir ? (4 * fq + r >= fr) : (4 * fq + r <= fr); d[hh][r] = keep ? d[hh][r] : 0.f; } } } }
                pv[pp] = dir ? (2 * pp + 1 >= ti) : (2 * pp <= ti);
                const unsigned p0 = pk2(d[0][0], d[0][1]), p1 = pk2(d[0][2], d[0][3]), p2 = pk2(d[1][0], d[1][1]), p3 = pk2(d[1][2], d[1][3]);
                P[pp] = __builtin_bit_cast(bf16x8_t, (v4u){p0, p1, p2, p3});
            }
#pragma unroll
            for (int x = 0; x < 5; ++x) { X[x] = (f32x4){0.f, 0.f, 0.f, 0.f};
                const int vt = vh * 5 + x;
                if (vt < 9) {
#pragma unroll
                    for (int pp = 0; pp < 2; ++pp) if (pv[pp]) {
                        const bf16x8_t bfv = vt < 8 ? frag_tr2(Vi, ML_STRIDE, 32 * pp, 32 * pp + 16, 16 * vt, lane) : frag_tr2(AUGi, 16, 32 * pp, 32 * pp + 16, 0, lane);
                        X[x] = __builtin_amdgcn_mfma_f32_16x16x32_bf16(P[pp], bfv, X[x], 0, 0, 0); }
#pragma unroll
                    for (int ks = 0; ks < 4; ++ks) X[x] = __builtin_amdgcn_mfma_f32_16x16x32_bf16(qf[ks], frag_row(CB, 16 * vt, 32 * ks, fr, fq), X[x], 0, 0, 0);
                } }
            if (vh == 1 && fr == 0) {
#pragma unroll
                for (int r = 0; r < 4; ++r) den[16 * ti + 4 * fq + r] = X[3][r] * eb[64 * c + 16 * ti + 4 * fq + r]; }
        }
        {
#pragma unroll
            for (int ks = 0; ks < 2; ++ks) { const bf16x8_t kf = frag_tr(Ki, ML_STRIDE, 32 * ks, 16 * w, lane);
#pragma unroll
                for (int vt = 0; vt < 8; ++vt) st[vt] = __builtin_amdgcn_mfma_f32_16x16x32_bf16(kf, frag_tr(Vi, ML_STRIDE, 32 * ks, 16 * vt, lane), st[vt], 0, 0, 0);
                st[8] = __builtin_amdgcn_mfma_f32_16x16x32_bf16(kf, frag_tr(AUGi, 16, 32 * ks, 0, lane), st[8], 0, 0, 0); }
            const float ee = ebend[c];
#pragma unroll
            for (int vt = 0; vt < 9; ++vt) st[vt] = st[vt] * ee;
        }
        WG_BAR();
        if (OUT) {
            float sq[4] = {0.f, 0.f, 0.f, 0.f};
#pragma unroll
            for (int r = 0; r < 4; ++r) { const int t = 16 * ti + 4 * fq + r; const float sc = eb[64 * c + t] * __builtin_amdgcn_rcpf(fmaxf(fabsf(den[t]), 1.f));
#pragma unroll
                for (int x = 0; x < 4; ++x) { const int vt = vh * 5 + x; const float hv = (vt < 8) ? X[x][r] * sc : 0.f; hval[x][r] = hv; sq[r] += hv * hv; }
                if (vh == 0) { const float hv = X[4][r] * sc; X[4][r] = hv; sq[r] += hv * hv; } }
#pragma unroll
            for (int r = 0; r < 4; ++r) { float v = sq[r]; v += __shfl_xor(v, 1); v += __shfl_xor(v, 2); v += __shfl_xor(v, 4); v += __shfl_xor(v, 8); if (fr == 0) ssq[vh * 64 + 16 * ti + 4 * fq + r] = v; }
#pragma unroll
            for (int vt = 0; vt < 9; ++vt) { pg8::u32x2 o; o.x = pk2(st[vt][0], st[vt][1]); o.y = pk2(st[vt][2], st[vt][3]); *(pg8::u32x2*)(CB + (16 * vt + fr) * ML_STRIDE + 16 * w + 4 * fq) = o; }
            WG_BAR();
            float* TM = (float*)(a.ws + WS_TM); bf16* YA = (bf16*)(a.ws + WS_YA);
#pragma unroll
            for (int r = 0; r < 4; ++r) { const int t = 16 * ti + 4 * fq + r; const float rs = __builtin_amdgcn_rsqf((ssq[t] + ssq[64 + t]) * (1.f / 128.f) + EPS);
                const size_t ob = (size_t)(rowbase - NCTX + 64 * c + t) * 1024 + h * 128;
#pragma unroll
                for (int x = 0; x < 5; ++x) { const int vt = vh * 5 + x; if (vt < 8) { const int v = 16 * vt + fr; const float hv = (x < 4) ? hval[x][r] : X[4][r];
                    float y = hv * rs * hgv[x] * bf2f(ogv[x][r]);
                    if (PASS2) { y += tmv[x][r]; YA[ob + v] = (bf16)f2bf(y); } else TM[ob + v] = y; } } }
        }
    }
}

__device__ __forceinline__ void ml_state_quad(const Args& a, unsigned char* lds_g, int qu, int tid) {
    const int seq = qu >> 1, j0 = 4 * (qu & 1), dir = seq & 1, h = (seq >> 1) & 7, b = seq >> 4;
    const int lane = tid & 63, w = __builtin_amdgcn_readfirstlane(tid >> 6);
    f32x4 st[9];
#pragma unroll
    for (int vt = 0; vt < 9; ++vt) st[vt] = (f32x4){0.f, 0.f, 0.f, 0.f};
#pragma unroll 1
    for (int jj = 0; jj < 4; ++jj) {
        const int j = j0 + jj, su = seq * 8 + j;
        const int rowbase = j == 0 ? b * CTXL : NCTX + b * SEQ + 256 * (dir ? 8 - j : j - 1);
        ml_gates(a, lds_g, rowbase, h, tid);
        WG_BAR();
        ml_block<false, false>(a, lds_g, rowbase, h, dir, st, tid);
        f32x4* SL = (f32x4*)(a.ws + WS_SLOC) + ((size_t)(su * 8 + w) * 9) * 64 + lane;
#pragma unroll
        for (int vt = 0; vt < 9; ++vt) SL[vt * 64] = st[vt];
        if (tid == 0) { const float* bd = (const float*)(lds_g + ML_BEND) + dir * 4; ((float*)(a.ws + WS_BT))[su] = (bd[0] + bd[1]) + (bd[2] + bd[3]); }
        WG_BAR();
    }
}
__device__ __forceinline__ void ml_out_unit(const Args& a, unsigned char* lds_g, int u, int tid) {
    const int L = u & 7, h = (u >> 3) & 7, b = u >> 6;
    const int rowbase = NCTX + b * SEQ + 256 * L;
    const int lane = tid & 63, w = __builtin_amdgcn_readfirstlane(tid >> 6), fr = lane & 15, fq = lane >> 4;
    bf16* CB = (bf16*)(lds_g + ML_CB);
    ml_gates(a, lds_g, rowbase, h, tid);
    f32x4 st[9];
#pragma unroll
    for (int dir = 0; dir < 2; ++dir) {
        const int seq = (b * 8 + h) * 2 + dir, jmax = dir ? 7 - L : L;
        const float* BT = (const float*)(a.ws + WS_BT) + seq * 8;
        {
            const f32x4* SLa = (const f32x4*)(a.ws + WS_SLOC) + ((size_t)((seq * 8 + jmax) * 8 + w) * 9) * 64 + lane;
            const f32x4* SLb = (const f32x4*)(a.ws + WS_SLOC) + ((size_t)((seq * 8 + 3) * 8 + w) * 9) * 64 + lane;
            if (jmax >= 4) {
                f32x4 sb[9];
#pragma unroll
                for (int vt = 0; vt < 9; ++vt) { st[vt] = SLa[vt * 64]; sb[vt] = SLb[vt * 64]; }
                float ls = 0.f;
#pragma unroll
                for (int q = 4; q < 8; ++q) ls += (q <= jmax) ? BT[q] : 0.f;
                const float coef = __expf(ls);
#pragma unroll
                for (int vt = 0; vt < 9; ++vt) st[vt] += sb[vt] * coef;
            } else {
#pragma unroll
                for (int vt = 0; vt < 9; ++vt) st[vt] = SLa[vt * 64];
            }
        }
#pragma unroll
        for (int vt = 0; vt < 9; ++vt) { pg8::u32x2 o; o.x = pk2(st[vt][0], st[vt][1]); o.y = pk2(st[vt][2], st[vt][3]); *(pg8::u32x2*)(CB + (16 * vt + fr) * ML_STRIDE + 16 * w + 4 * fq) = o; }
        WG_BAR();
        if (dir == 0) ml_block<true, false>(a, lds_g, rowbase, h, 0, st, tid);
        else ml_block<true, true>(a, lds_g, rowbase, h, 1, st, tid);
        asm volatile("s_waitcnt vmcnt(0)" ::: "memory");
        WG_BAR();
    }
}

__device__ __forceinline__ void lru_out_unit(const Args& a, unsigned char* lds_g, int b, int cidx, int blk, int tid) {
    const int chl = tid & 127, q = tid >> 7, ch = blk * 128 + chl;
    float2* QA = (float2*)lds_g;
    float av[2][16], bv[2][16];
#pragma unroll
    for (int d = 0; d < 2; ++d) { const unsigned* PS = (const unsigned*)(a.ws + WS_PS) + ((size_t)(b * 2 + d) * NSTEP + 64 * cidx + 16 * q) * 1024 + ch;
#pragma unroll
        for (int i = 0; i < 16; ++i) { const unsigned wv = PS[(size_t)i * 1024]; av[d][i] = 1.f - bflo(wv); bv[d][i] = bfhi(wv); } }
    float2* CA = (float2*)(lds_g + 8192);
#pragma unroll
    for (int d = 0; d < 2; ++d) { const float2* AGG = (const float2*)(a.ws + WS_AGG) + ((size_t)(b * 2 + d) * 36) * 1024 + ch; float2 qv[9];
#pragma unroll
        for (int i = 0; i < 9; ++i) { const int sidx = 9 * q + i; const int c2 = d ? (sidx < 4 ? 3 - sidx : 39 - sidx) : sidx; qv[i] = AGG[(size_t)c2 * 1024]; }
        float P = 1.f, S = 0.f;
#pragma unroll
        for (int i = 0; i < 9; ++i) { const int sidx = 9 * q + i; const int c2 = d ? (sidx < 4 ? 3 - sidx : 39 - sidx) : sidx; const bool use = d ? (sidx < 4 || c2 > cidx) : (c2 < cidx);
            S = use ? qv[i].x * S + qv[i].y : S; P = use ? qv[i].x * P : P; }
        CA[(d * 4 + q) * 128 + chl] = make_float2(P, S); }
#pragma unroll
    for (int d = 0; d < 2; ++d) { float P = 1.f, S = 0.f;
#pragma unroll
        for (int ii = 0; ii < 16; ++ii) { const int i = d ? 15 - ii : ii; S = av[d][i] * S + bv[d][i]; P = av[d][i] * P; }
        QA[(d * 4 + q) * 128 + chl] = make_float2(P, S); }
    WG_BAR();
    float hs[16];
#pragma unroll
    for (int d = 0; d < 2; ++d) { float h = 0.f;
#pragma unroll
        for (int k = 0; k < 4; ++k) { const float2 t = CA[(d * 4 + k) * 128 + chl]; h = t.x * h + t.y; }
#pragma unroll
        for (int k = 0; k < 3; ++k) { const int qq = d ? 3 - k : k; const bool use = d ? (qq > q) : (qq < q); const float2 t = QA[(d * 4 + qq) * 128 + chl]; h = use ? t.x * h + t.y : h; }
#pragma unroll
        for (int ii = 0; ii < 16; ++ii) { const int i = d ? 15 - ii : ii; h = av[d][i] * h + bv[d][i]; if (d == 0) hs[i] = h; else hs[i] += h; } }
    const int p0 = (cidx - 4) * 64 + 16 * q;
    unsigned short ugv[16];
#pragma unroll
    for (int i = 0; i < 16; ++i) ugv[i] = ((const bf16*)(a.ws + WS_UG))[(size_t)(lru_pos_row(b, false, p0 + i) - NCTX) * 1024 + ch];
#pragma unroll
    for (int i = 0; i < 16; ++i) { const size_t lrow = (size_t)(lru_pos_row(b, false, p0 + i) - NCTX) * 1024 + ch;
        ((bf16*)(a.ws + WS_YB))[lrow] = (bf16)f2bf(hs[i] * bf2f(ugv[i])); }
    WG_BAR();
}
__device__ __forceinline__ void phase3(const Args& a, unsigned char* lds_g, int tid) {
    {
        int q0 = (int)blockIdx.x, qstep = (int)gridDim.x;
        if (gridDim.x == 256) q0 = blockIdx.x >= 128 ? (int)blockIdx.x - 128 : 128;
        for (int qu = q0; qu < 128; qu += qstep) ml_state_quad(a, lds_g, qu, tid);
    }
    for (int u = blockIdx.x; u < 4 * 36 * 8; u += gridDim.x) { const int blk = u & 7, q = u >> 3; lru_unit<false>(a, lds_g, q / 36, q % 36, blk, tid); }
}

struct SchedProj {
    int G, c; const char *YA, *YB, *WA, *WB;
    __device__ __forceinline__ bool next(int i, pg8::Unit& u) const {
        const int tile = (i >> 1) * G + c, part = i & 1; if (tile >= 256) return false;
        int pm, pn; pg8::tile_order(tile, 32, 8, pm, pn);
        u.pm = pm; u.pn = pn; u.aux = part; u.A = (part ? YB : YA) + (size_t)pm * 256 * 1024 * 2; u.B = (part ? WB : WA) + (size_t)pn * 256 * 1024 * 2; return true;
    }
};
struct EpiProj {
    static constexpr bool PERM = true;
    const bf16 *GA, *GB; bf16* PRE;
    __device__ __forceinline__ void operator()(const pg8::f32x4 (&acc)[2][2][4][2], const pg8::Unit& u, int wr, int wc, int fr, int fq) const {
        const bf16* gsrc = u.aux ? GB : GA;
#pragma unroll
        for (int ai = 0; ai < 2; ++ai) {
            pg8::u32x4 gw[4][2], pw[4][2];
#pragma unroll
            for (int m = 0; m < 4; ++m) { const size_t off = (size_t)(u.pm * 256 + ai * 128 + wr * 64 + m * 16 + fr) * 2048 + u.pn * 256 + wc * 32 + 8 * fq;
#pragma unroll
                for (int bj = 0; bj < 2; ++bj) { gw[m][bj] = *(const pg8::u32x4*)(gsrc + off + bj * 128); if (u.aux) pw[m][bj] = *(const pg8::u32x4*)(PRE + off + bj * 128); } }
#pragma unroll
            for (int m = 0; m < 4; ++m) { const size_t off = (size_t)(u.pm * 256 + ai * 128 + wr * 64 + m * 16 + fr) * 2048 + u.pn * 256 + wc * 32 + 8 * fq;
#pragma unroll
                for (int bj = 0; bj < 2; ++bj) { const pg8::u32x4 g4 = gw[m][bj];
                    pg8::f32x4 v0 = acc[ai][bj][m][0], v1 = acc[ai][bj][m][1];
                    v0[0] *= bflo(g4.x); v0[1] *= bfhi(g4.x); v0[2] *= bflo(g4.y); v0[3] *= bfhi(g4.y); v1[0] *= bflo(g4.z); v1[1] *= bfhi(g4.z); v1[2] *= bflo(g4.w); v1[3] *= bfhi(g4.w);
                    if (u.aux) { const pg8::u32x4 p4 = pw[m][bj];
                        v0[0] += bflo(p4.x); v0[1] += bfhi(p4.x); v0[2] += bflo(p4.y); v0[3] += bfhi(p4.y); v1[0] += bflo(p4.z); v1[1] += bfhi(p4.z); v1[2] += bflo(p4.w); v1[3] += bfhi(p4.w); }
                    pg8::u32x4 w; w.x = pg8::cvt_pk_bf16(v0[0], v0[1]); w.y = pg8::cvt_pk_bf16(v0[2], v0[3]); w.z = pg8::cvt_pk_bf16(v1[0], v1[1]); w.w = pg8::cvt_pk_bf16(v1[2], v1[3]);
                    *(pg8::u32x4*)(PRE + off + bj * 128) = w; } }
        }
    }
};

struct SchedOut {
    int G, c; const char *A, *B;
    __device__ __forceinline__ bool next(int i, pg8::Unit& u) const {
        const int L = i * G + c; if (L >= 256) return false;
        int pm, pn; pg8::tile_order(L, 32, 8, pm, pn);
        u.pm = pm; u.pn = pn; u.aux = 0; u.A = A + (size_t)pm * 256 * D * 2; u.B = B + (size_t)pn * 256 * D * 2; return true;
    }
};
struct EpiOut {
    static constexpr bool PERM = false;
    const float* x; const float* MOD; float* X1;
    __device__ __forceinline__ void operator()(const pg8::f32x4 (&acc)[2][2][4][2], const pg8::Unit& u, int wr, int wc, int fr, int fq) const {
        const int b = u.pm >> 3; const int col0 = u.pn * 256 + wc * 32 + 4 * fq;
        pg8::f32x4 g1[2][2];
#pragma unroll
        for (int bj = 0; bj < 2; ++bj)
#pragma unroll
            for (int n = 0; n < 2; ++n) g1[bj][n] = *(const pg8::f32x4*)(MOD + b * 12288 + 2 * 2048 + col0 + bj * 128 + n * 16);
#pragma unroll
        for (int ai = 0; ai < 2; ++ai) {
            pg8::f32x4 xv[4][2][2];
#pragma unroll
            for (int m = 0; m < 4; ++m) { const size_t off = (size_t)(u.pm * 256 + ai * 128 + wr * 64 + m * 16 + fr) * D + col0;
#pragma unroll
                for (int bj = 0; bj < 2; ++bj)
#pragma unroll
                    for (int n = 0; n < 2; ++n) xv[m][bj][n] = *(const pg8::f32x4*)(x + off + bj * 128 + n * 16); }
#pragma unroll
            for (int m = 0; m < 4; ++m) { const size_t off = (size_t)(u.pm * 256 + ai * 128 + wr * 64 + m * 16 + fr) * D + col0;
#pragma unroll
                for (int bj = 0; bj < 2; ++bj)
#pragma unroll
                    for (int n = 0; n < 2; ++n) *(pg8::f32x4*)(X1 + off + bj * 128 + n * 16) = xv[m][bj][n] + g1[bj][n] * acc[ai][bj][m][n]; }
        }
    }
};

__device__ __forceinline__ void phase_router(const Args& a, unsigned char* lds_g, int tid, int lane, int wave) {
    const float* X1 = (const float*)(a.ws + WS_X1); const float* MOD = (const float*)(a.ws + WS_MOD); const float* g = a.in[I_N2G];
    const float* WR = (const float*)(a.ws + WS_WR); const float* RB = (const float*)(a.ws + WS_RB);
    bf16* H2 = (bf16*)(a.ws + WS_H2); unsigned* cnt = (unsigned*)(a.ws + WS_CTL) + CW_CNT; int4* ASG = (int4*)(a.ws + WS_ASG);
    f32x4* PART = (f32x4*)lds_g;
    float* SSQP = (float*)(lds_g + 24576);
    float* RS = (float*)(lds_g + 24576 + 512);
    float* LG = (float*)(lds_g + 24576 + 1024);
    const int slot = wave >> 2, kq = wave & 3, i = lane & 15, gq = lane >> 4;
    for (int tp = blockIdx.x; tp < NLAT / 32; tp += gridDim.x) {
        const int tok0 = 32 * tp + 16 * slot, b = tok0 >> 11, kbase = kq * 512 + 4 * gq;
        const float* xr = X1 + (size_t)(tok0 + i) * D + kbase;
        const float* wr = WR + ((size_t)(b * 48 + i) * 2048 + kbase);
        f32x4 acc0 = (f32x4){0.f, 0.f, 0.f, 0.f}, acc1 = acc0, acc2 = acc0; float sq = 0.f;
#pragma unroll 4
        for (int s4 = 0; s4 < 32; ++s4) {
            const f32x4 xa = *(const f32x4*)(xr + 16 * s4), b0 = *(const f32x4*)(wr + 16 * s4), b1 = *(const f32x4*)(wr + 16 * 2048 + 16 * s4), b2 = *(const f32x4*)(wr + 32 * 2048 + 16 * s4);
#pragma unroll
            for (int e = 0; e < 4; ++e) { acc0 = __builtin_amdgcn_mfma_f32_16x16x4f32(xa[e], b0[e], acc0, 0, 0, 0); acc1 = __builtin_amdgcn_mfma_f32_16x16x4f32(xa[e], b1[e], acc1, 0, 0, 0); acc2 = __builtin_amdgcn_mfma_f32_16x16x4f32(xa[e], b2[e], acc2, 0, 0, 0); }
            sq += (xa.x * xa.x + xa.y * xa.y) + (xa.z * xa.z + xa.w * xa.w);
        }
        sq += __shfl_xor(sq, 16); sq += __shfl_xor(sq, 32);
        PART[((slot * 4 + kq) * 3 + 0) * 64 + lane] = acc0; PART[((slot * 4 + kq) * 3 + 1) * 64 + lane] = acc1; PART[((slot * 4 + kq) * 3 + 2) * 64 + lane] = acc2;
        if (gq == 0) SSQP[(slot * 4 + kq) * 16 + i] = sq;
        __syncthreads();
        if (kq == 0) {
            const float* sp = SSQP + slot * 64; const float rstd = 1.f / sqrtf(((sp[i] + sp[16 + i]) + (sp[32 + i] + sp[48 + i])) * (1.f / D) + EPS);
            if (gq == 0) RS[slot * 16 + i] = rstd;
#pragma unroll
            for (int cb = 0; cb < 3; ++cb) { const f32x4* pp = PART + (slot * 4 * 3 + cb) * 64 + lane; const f32x4 sum = (pp[0] + pp[3 * 64]) + (pp[6 * 64] + pp[9 * 64]);
                const float rb = RB[b * 48 + 16 * cb + i];
#pragma unroll
                for (int r = 0; r < 4; ++r) LG[(slot * 16 + 4 * gq + r) * 48 + 16 * cb + i] = __shfl(rstd, 4 * gq + r) * sum[r] + rb; }
            LDS_WAIT(); asm volatile("" ::: "memory");
            if (lane < 16) {
                const float* lg = LG + (slot * 16 + lane) * 48; const int t = tok0 + lane;
                int gs = 0; float gm = lg[32];
#pragma unroll
                for (int q = 1; q < 4; ++q) { const float v = lg[32 + q]; if (v > gm) { gm = v; gs = q; } }
                float se = 0.f;
#pragma unroll
                for (int q = 0; q < 4; ++q) se += __expf(lg[32 + q] - gm);
                const float pg = 1.f / se;
                int i0 = 0; float v0 = lg[gs * 8];
#pragma unroll
                for (int q = 1; q < 8; ++q) { const float v = lg[gs * 8 + q]; if (v > v0) { v0 = v; i0 = q; } }
                int i1 = -1; float v1 = -3.0e38f;
#pragma unroll
                for (int q = 0; q < 8; ++q) { const float v = lg[gs * 8 + q]; if (q != i0 && v > v1) { v1 = v; i1 = q; } }
                const float e1 = __expf(v1 - v0), w0 = pg / (1.f + e1), w1 = pg * e1 / (1.f + e1);
                const int ex0 = gs * 8 + i0, ex1 = gs * 8 + i1;
                const unsigned p0 = atomicAdd(cnt + ex0, 1u), p1 = atomicAdd(cnt + ex1, 1u);
                ASG[2 * t] = make_int4(ex0, (int)p0, __float_as_int(w0), 0); ASG[2 * t + 1] = make_int4(ex1, (int)p1, __float_as_int(w1), 0);
                int* LIST = (int*)(a.ws + WS_LIST); LIST[ex0 * 8192 + (int)p0] = t; LIST[ex1 * 8192 + (int)p1] = t;
            }
        }
        __syncthreads();
#pragma unroll
        for (int r = 0; r < 4; ++r) { const int tl = 4 * kq + r, t = tok0 + tl; const float rstd = RS[slot * 16 + tl];
            const f32x4* xrow = (const f32x4*)(X1 + (size_t)t * D) + lane; unsigned long long* o8 = (unsigned long long*)(H2 + (size_t)t * D) + lane;
            f32x4 yv[8];
#pragma unroll
            for (int j = 0; j < 8; ++j) { const int c = 4 * lane + 256 * j;
                const f32x4 gg = *(const f32x4*)(g + c), sh = *(const f32x4*)(MOD + b * 12288 + 3 * 2048 + c), sc = *(const f32x4*)(MOD + b * 12288 + 4 * 2048 + c);
                yv[j] = xrow[64 * j] * rstd * gg * (sc + 1.f) + sh; }
#pragma unroll
            for (int j = 0; j < 8; ++j) o8[64 * j] = (unsigned long long)pk2(yv[j].x, yv[j].y) | ((unsigned long long)pk2(yv[j].z, yv[j].w) << 32); }
        __syncthreads();
    }
}

constexpr int MG_A = 0, MG_ABYTES = 32768, MG_B = 65536, MG_BBYTES = 64 * 256  , MG_CUM = 141312  ;
__device__ __forceinline__ int mgb_off(int row, int ch) { return 256 * row + 16 * (ch ^ (((row & 3) << 2) | ((row >> 2) & 3))); }
__device__ __forceinline__ bf16x8_t mgb_frag(const unsigned char* img, int ks, int c, int lane) {
    const int g = lane >> 4, q = (lane & 15) >> 2, p = lane & 3;
    const s4_t lo = ds_tr((const bf16*)(img + mgb_off(32 * ks + 8 * g + q, 2 * c + (p >> 1)) + 8 * (p & 1)));
    const s4_t hi = ds_tr((const bf16*)(img + mgb_off(32 * ks + 8 * g + 4 + q, 2 * c + (p >> 1)) + 8 * (p & 1)));
    return (bf16x8_t){lo.x, lo.y, lo.z, lo.w, hi.x, hi.y, hi.z, hi.w};
}
__device__ __forceinline__ void moe_tables(const Args& a, unsigned char* lds_g, int tid) {
    int* cum = (int*)(lds_g + MG_CUM); const unsigned* ctl = (const unsigned*)(a.ws + WS_CTL);
    if (tid < NEXP) cum[128 + tid] = (int)ctl[CW_CNT + tid];
    if (tid == 0) { int c = 0; for (int e = 0; e < NEXP; ++e) { cum[e] = c; c += (int)((ctl[CW_CNT + e] + 255u) >> 8); } cum[NEXP] = c; }
    __syncthreads();
}
constexpr int MH_A = 0, MH_ABYTES = 32768, MH_B = 65536, MH_BROW = 528, MH_BBYTES = 64 * MH_BROW  ;
__device__ __forceinline__ int mhb_off(int row, int ch) { return MH_BROW * row + 16 * ch; }
__device__ __forceinline__ bf16x8_t mhb_frag(const unsigned char* img, int ks, int c, int lane) {
    const int g = lane >> 4, q = (lane & 15) >> 2, p = lane & 3;
    const s4_t lo = ds_tr((const bf16*)(img + mhb_off(32 * ks + 8 * g + q, 2 * c + (p >> 1)) + 8 * (p & 1)));
    const s4_t hi = ds_tr((const bf16*)(img + mhb_off(32 * ks + 8 * g + 4 + q, 2 * c + (p >> 1)) + 8 * (p & 1)));
    return (bf16x8_t){lo.x, lo.y, lo.z, lo.w, hi.x, hi.y, hi.z, hi.w};
}
__device__ __forceinline__ int moe_pull(const Args& a, unsigned char* lds_g, int tid, int x) {
    int* slot = (int*)(lds_g + MG_CUM + 256);
    __syncthreads();
    if (tid == 0) *slot = (int)__hip_atomic_fetch_add((unsigned*)(a.ws + WS_CTL) + CW_Q + 64 * x, 1u, __ATOMIC_RELAXED, __HIP_MEMORY_SCOPE_AGENT);
    __syncthreads();
    return *slot;
}
template <int MODE>
__device__ __forceinline__ int moe_gemm(const Args& a, unsigned char* lds_g, int tid, int idx0) {
    constexpr int K = MODE == 1 ? D : DE, NT = K / 64;
#define MG_BAR() do { asm volatile("s_waitcnt lgkmcnt(0)" ::: "memory"); __builtin_amdgcn_s_barrier(); asm volatile("" ::: "memory"); } while (0)
    const int lane = tid & 63, w = __builtin_amdgcn_readfirstlane(tid >> 6), fr = lane & 15, fq = lane >> 4;
    const int wm = w >> 1, wn = w & 1, hh = wm >> 1, wr = wm & 1;
    const int* cum = (const int*)(lds_g + MG_CUM); const unsigned* ctl = (const unsigned*)(a.ws + WS_CTL);
    const int T = cum[NEXP], x = blockIdx.x & 7;
    const int aoff = pg8::lds_byte(wr * 64 + fr, fq * 8);
    const int bk = tid >> 6, bp = tid & 63;
    int aR[2], aC[2];
#pragma unroll
    for (int i = 0; i < 2; ++i) pg8::stage_rc(tid * 16 + i * 8192, aR[i], aC[i]);
    for (int idx = idx0;;) {
        if (idx < 0) idx = moe_pull(a, lds_g, tid, x);
        if (idx >= (MODE == 1 ? T : 2 * T)) return idx;
        const int ti = MODE == 1 ? idx : idx - T;
        idx = -1;
        const int nt = x;
        if (MODE == 2) {
            if (tid < 64) { unsigned* tc = (unsigned*)(a.ws + WS_CTL) + CW_TC + 64 * ti; unsigned spins = 0;
                while ((unsigned)__builtin_amdgcn_readfirstlane(__hip_atomic_load(tc, __ATOMIC_RELAXED, __HIP_MEMORY_SCOPE_AGENT)) < 64u) {
                    __builtin_amdgcn_s_sleep(2);
                    if (++spins > (1u << 22)) { if (tid == 0) __hip_atomic_store((unsigned*)(a.ws + WS_CTL) + 1, 0x900u + (unsigned)ti, __ATOMIC_RELAXED, __HIP_MEMORY_SCOPE_AGENT); break; } }
                __builtin_amdgcn_fence(__ATOMIC_ACQUIRE, "agent");
                asm volatile("s_waitcnt vmcnt(0)" ::: "memory"); }
            __syncthreads();
        }
        int e = 0;
#pragma unroll 1
        for (int q = 1; q < NEXP; ++q) e = (cum[q] <= ti) ? q : e;
        const int mt = ti - cum[e];
        const char* abase; unsigned aofs[4]; const char* bbase; unsigned bofs; size_t bld;
        if (MODE == 1) { const int cnt = cum[128 + e];
#pragma unroll
            for (int q = 0; q < 4; ++q) { const int pos = 256 * mt + 128 * (q >> 1) + aR[q & 1]; const int tok = pos < cnt ? ((const int*)(a.ws + WS_LIST))[e * 8192 + pos] : 0;
                aofs[q] = (unsigned)(tok * D + aC[q & 1]) * 2u; }
            abase = (const char*)(a.ws + WS_H2);
            const int seg = bp >> 4, mat = seg & 1, col = 128 * nt + 64 * (seg >> 1) + 4 * (bp & 15);
            bbase = (const char*)(a.in[mat ? I_W3 : I_W1] + (size_t)e * D * DE); bofs = (unsigned)(bk * DE + col) * 4u; bld = DE; }
        else {
#pragma unroll
            for (int q = 0; q < 4; ++q) aofs[q] = (unsigned)((128 * (q >> 1) + aR[q & 1]) * DE + aC[q & 1]) * 2u;
            abase = (const char*)((const bf16*)(a.ws + WS_HM) + (size_t)256 * ti * DE);
            bbase = (const char*)(a.in[I_W2] + (size_t)e * DE * D); bofs = (unsigned)(bk * D + 256 * nt + 4 * bp) * 4u; bld = D; }
        const int bwr0 = mhb_off(bk, bp >> 1) + 8 * (bp & 1);
        f32x4 acc[4][8];
#pragma unroll
        for (int m = 0; m < 4; ++m)
#pragma unroll
            for (int n = 0; n < 8; ++n) acc[m][n] = (f32x4){0.f, 0.f, 0.f, 0.f};
        v4u ra[4]; f32x4 rb[8];
#define MH_LD(t_) do { _Pragma("unroll") for (int j_ = 0; j_ < 4; ++j_) ra[j_] = *(const v4u*)(abase + aofs[j_] + 128 * (t_)); \
        _Pragma("unroll") for (int j_ = 0; j_ < 8; ++j_) rb[j_] = *(const f32x4*)(bbase + bofs + (size_t)(64 * (t_) + 8 * j_) * bld * 4); } while (0)
#define MH_ST(buf_) do { _Pragma("unroll") for (int j_ = 0; j_ < 4; ++j_) *(v4u*)(lds_g + MH_A + (buf_) * MH_ABYTES + (j_ >> 1) * 16384 + (j_ & 1) * 8192 + tid * 16) = ra[j_]; \
        _Pragma("unroll") for (int j_ = 0; j_ < 8; ++j_) { pg8::u32x2 o_; o_.x = pk2(rb[j_].x, rb[j_].y); o_.y = pk2(rb[j_].z, rb[j_].w); *(pg8::u32x2*)(lds_g + MH_B + (buf_) * MH_BBYTES + bwr0 + j_ * 8 * MH_BROW) = o_; } } while (0)
#define MH_MMA(buf_) do { const unsigned char* Bi_ = lds_g + MH_B + (buf_) * MH_BBYTES; \
        _Pragma("unroll") for (int ks_ = 0; ks_ < 2; ++ks_) { bf16x8_t af_[4]; \
            _Pragma("unroll") for (int m_ = 0; m_ < 4; ++m_) af_[m_] = *(const bf16x8_t*)(lds_g + MH_A + (buf_) * MH_ABYTES + hh * 16384 + aoff + m_ * 2048 + ks_ * 1024); \
            _Pragma("unroll") for (int n_ = 0; n_ < 8; n_ += 2) { const bf16x8_t bf0_ = mhb_frag(Bi_, ks_, 8 * wn + n_, lane), bf1_ = mhb_frag(Bi_, ks_, 8 * wn + n_ + 1, lane); \
                _Pragma("unroll") for (int m_ = 0; m_ < 4; ++m_) { acc[m_][n_] = __builtin_amdgcn_mfma_f32_16x16x32_bf16(bf0_, af_[m_], acc[m_][n_], 0, 0, 0); \
                    acc[m_][n_ + 1] = __builtin_amdgcn_mfma_f32_16x16x32_bf16(bf1_, af_[m_], acc[m_][n_ + 1], 0, 0, 0); } \
                __builtin_amdgcn_sched_barrier(0); } } } while (0)
        MH_LD(0);
        MG_BAR();
        MH_ST(0);
        MH_LD(1);
        for (int t = 0; t < NT; t += 2) {
            const int t2 = (t + 2 < NT) ? t + 2 : NT - 1, t3 = (t + 3 < NT) ? t + 3 : NT - 1;
            MG_BAR();
            MH_ST(1);
            MH_LD(t2);
            MH_MMA(0);
            MG_BAR();
            MH_ST(0);
            MH_LD(t3);
            MH_MMA(1);
        }
#undef MH_LD
#undef MH_ST
#undef MH_MMA
        const size_t row0 = (size_t)256 * ti + 128 * hh + 64 * wr + fr;
        if (MODE == 1) { bf16* HM = (bf16*)(a.ws + WS_HM);
#pragma unroll
            for (int m = 0; m < 4; ++m)
#pragma unroll
                for (int n = 0; n < 4; ++n) { float hv[4];
#pragma unroll
                    for (int r = 0; r < 4; ++r) { const float a1 = acc[m][n][r]; hv[r] = a1 * sigmoidf_(a1) * acc[m][n + 4][r]; }
                    const unsigned long long o = (unsigned long long)pk2(hv[0], hv[1]) | ((unsigned long long)pk2(hv[2], hv[3]) << 32);
                    __hip_atomic_store((unsigned long long*)(HM + (row0 + 16 * m) * DE + 128 * nt + 64 * wn + 16 * n + 4 * fq), o, __ATOMIC_RELAXED, __HIP_MEMORY_SCOPE_AGENT); }
            asm volatile("s_waitcnt vmcnt(0)" ::: "memory");
            if (lane == 0) __hip_atomic_fetch_add((unsigned*)(a.ws + WS_CTL) + CW_TC + 64 * ti, 1u, __ATOMIC_RELAXED, __HIP_MEMORY_SCOPE_AGENT); }
        else { bf16* Y2 = (bf16*)(a.ws + WS_Y2);
#pragma unroll
            for (int m = 0; m < 4; ++m)
#pragma unroll
                for (int n = 0; n < 8; ++n) { pg8::u32x2 o; o.x = pk2(acc[m][n][0], acc[m][n][1]); o.y = pk2(acc[m][n][2], acc[m][n][3]);
                    *(pg8::u32x2*)(Y2 + (row0 + 16 * m) * D + 256 * nt + 128 * wn + 16 * n + 4 * fq) = o; } }
    }
#undef MG_BAR
}

__device__ __forceinline__ void phase12(const Args& a, unsigned char* lds_g, int lane, int wave) {
    const int gw = blockIdx.x * NWAVES + wave, NGW = gridDim.x * NWAVES;
    const int* cum = (const int*)(lds_g + MG_CUM);
    const float* X1 = (const float*)(a.ws + WS_X1); const float* MOD = (const float*)(a.ws + WS_MOD); const float* fg = a.in[I_FG];
    const int4* ASG = (const int4*)(a.ws + WS_ASG); const bf16* Y2 = (const bf16*)(a.ws + WS_Y2);
    for (int t = gw; t < NLAT; t += NGW) {
        const int b = t >> 11; const int4 q0 = ASG[2 * t], q1 = ASG[2 * t + 1];
        const float w0 = __int_as_float(q0.z), w1 = __int_as_float(q1.z);
        const f32x4* xr = (const f32x4*)(X1 + (size_t)t * D) + lane;
        const unsigned long long* y0 = (const unsigned long long*)(Y2 + (size_t)(256 * cum[q0.x] + q0.y) * D) + lane; const unsigned long long* y1 = (const unsigned long long*)(Y2 + (size_t)(256 * cum[q1.x] + q1.y) * D) + lane;
        f32x4 v[8]; float s = 0.f;
#pragma unroll
        for (int j = 0; j < 8; ++j) {
            const int c = 4 * lane + 256 * j;
            const f32x4 g2 = *(const f32x4*)(MOD + b * 12288 + 5 * 2048 + c);
            const unsigned long long a0 = y0[64 * j], a1 = y1[64 * j];
            f32x4 y; y.x = w0 * bflo((unsigned)a0) + w1 * bflo((unsigned)a1); y.y = w0 * bfhi((unsigned)a0) + w1 * bfhi((unsigned)a1);
            y.z = w0 * bflo((unsigned)(a0 >> 32)) + w1 * bflo((unsigned)(a1 >> 32)); y.w = w0 * bfhi((unsigned)(a0 >> 32)) + w1 * bfhi((unsigned)(a1 >> 32));
            v[j] = xr[64 * j] + g2 * y;
            s += (v[j].x * v[j].x + v[j].y * v[j].y) + (v[j].z * v[j].z + v[j].w * v[j].w);
        }
        const float rstd = 1.f / sqrtf(wave_sum(s) * (1.f / D) + EPS);
        f32x4* o = (f32x4*)(a.out + (size_t)t * D) + lane; f32x4 fgv[8];
#pragma unroll
        for (int j = 0; j < 8; ++j) fgv[j] = *(const f32x4*)(fg + 4 * lane + 256 * j);
#pragma unroll
        for (int j = 0; j < 8; ++j) o[64 * j] = v[j] * rstd * fgv[j];
    }
}

__global__ void __launch_bounds__(NTHR, 2) fwd_kernel(Args args) {
    extern __shared__ __attribute__((aligned(16))) unsigned char lds[];
    LAS unsigned char* ldsl = (LAS unsigned char*)lds;
    volatile LAS unsigned* MISC = (volatile LAS unsigned*)(ldsl + MISC_OFF);
    LAS unsigned* TL = (LAS unsigned*)(ldsl + LDSCTL_OFF);
    const int wave_s = __builtin_amdgcn_readfirstlane(threadIdx.x >> 6);
#define TID() make_tid(wave_s)
    { const int t0 = TID(); for (int u = t0; u < (LDS_BYTES - LDSCTL_OFF) / 4; u += NTHR) ((LAS unsigned*)(ldsl + LDSCTL_OFF))[u] = 0u; }
    __syncthreads();
    unsigned char* ws = args.ws;
    unsigned* ctl = (unsigned*)(ws + WS_CTL);
    XcdBarrier bar; bar.bar = ctl + CW_BAR; bar.x = 0; bar.st = nullptr;
    const bool one_launch = (args.ph_hi - args.ph_lo) > 1;
    if (one_launch) bar = xcd_barrier_post(ctl + CW_BAR, MISC + 8, TID());
    const int lo = args.ph_lo, hi = args.ph_hi;
#define IN(k) (lo <= (k) && (k) < hi)
#define SEAM(k) do { if (IN(k) && IN((k) + 1)) xcd_barrier(bar, TID()); } while (0)
    const int G = gridDim.x, c = blockIdx.x;

#define FRESH() const int tid = TID(), lane = tid & 63, wave = __builtin_amdgcn_readfirstlane(tid >> 6); (void)lane; (void)wave
#ifndef DUP_PHASE
#define DUP_PHASE (-1)
#endif
#define PH(k, ...) if (IN(k)) { _Pragma("unroll") for (int rep_ = 0; rep_ < ((DUP_PHASE) == (k) ? 2 : 1); ++rep_) { if (rep_) xcd_barrier(bar, TID()); __VA_ARGS__ } } SEAM(k);
    PH(0, { FRESH(); phase0(args, lds, tid, lane, wave); mod_wait(args, tid); phase1(args, lane, wave); })
    PH(1, {
        SchedIn S{G, c, (const char*)(ws + WS_H), (const char*)(ws + WS_WIN)}; EpiIn E{ws, args.in[I_BGATES]};
        pg8::gemm_phase<EpiIn, SchedIn>(ldsl, D, S, E, TID());
        { const int R_ = (1492 + G - 1) / G; int fi_ = 1492 - (R_ - 1) * G; if (fi_ >= G) fi_ = 0;
          if (c >= fi_) { FRESH(); late_prep(args, lds, (c - fi_) * NWAVES + wave, (G - fi_) * NWAVES, lane, wave); } } })
    PH(2, { FRESH(); phase3(args, lds, tid); })
    PH(3, { FRESH();
        for (int u = c; u < 256; u += G) ml_out_unit(args, lds, u, tid);
        for (int u = c; u < 4 * 32 * 8; u += G) { const int blk = u & 7, q = u >> 3; lru_out_unit(args, lds, q >> 5, 4 + (q & 31), blk, tid); } })
    PH(4, {
        SchedProj S{G, c, (const char*)(ws + WS_YA), (const char*)(ws + WS_YB), (const char*)(ws + WS_WPA), (const char*)(ws + WS_WPB)};
        EpiProj E{(const bf16*)(ws + WS_GA), (const bf16*)(ws + WS_GB), (bf16*)(ws + WS_PRE)};
        pg8::gemm_phase<EpiProj, SchedProj>(ldsl, 1024, S, E, TID()); })
    PH(5, {
        SchedOut S{G, c, (const char*)(ws + WS_PRE), (const char*)(ws + WS_WOUT)}; EpiOut E{args.in[I_X], (const float*)(ws + WS_MOD), (float*)(ws + WS_X1)};
        pg8::gemm_phase<EpiOut, SchedOut>(ldsl, D, S, E, TID()); })
    PH(6, { FRESH(); phase_router(args, lds, tid, lane, wave); })
    PH(7, { FRESH(); moe_tables(args, lds, tid); const int nx_ = moe_gemm<1>(args, lds, tid, -1); (void)moe_gemm<2>(args, lds, tid, nx_); })
    PH(8, { FRESH(); moe_tables(args, lds, tid); phase12(args, lds, lane, wave); })
#undef PH
#undef IN
#undef SEAM
}

extern "C" void kernel_launch(void* const* d_in, const int* in_sizes, int n_in, void* d_out, int out_size, void* d_ws, size_t ws_size, hipStream_t stream) {
    static int grid = 0;
    if (grid == 0) {
        if (n_in != 27 || out_size != NLAT * D || ws_size < WS_END) { fprintf(stderr, "kernel_launch: unexpected shapes (n_in %d, out %d, ws %zu)\n", n_in, out_size, ws_size); grid = -1; return; }
        int dev = 0, cus = 0, per_cu = 0;
        if (hipGetDevice(&dev) != hipSuccess || hipDeviceGetAttribute(&cus, hipDeviceAttributeMultiprocessorCount, dev) != hipSuccess) { grid = -1; return; }
        if (hipFuncSetAttribute((const void*)fwd_kernel, hipFuncAttributeMaxDynamicSharedMemorySize, LDS_BYTES) != hipSuccess) { fprintf(stderr, "kernel_launch: hipFuncSetAttribute failed\n"); grid = -1; return; }
        if (hipOccupancyMaxActiveBlocksPerMultiprocessor(&per_cu, (const void*)fwd_kernel, NTHR, LDS_BYTES) != hipSuccess || per_cu < 1) fprintf(stderr, "kernel_launch: occupancy query says %d\n", per_cu);
        (void)hipGetLastError();
        grid = cus;
    }
    if (grid < 0) return;
    (void)hipMemsetAsync((char*)d_ws + WS_CTL, 0, CTL_ZERO_BYTES, stream);
    Args a{};
    for (int i = 0; i < 27; ++i) a.in[i] = (const float*)d_in[i];
    a.out = (float*)d_out; a.ws = (unsigned char*)d_ws;
#if MK_ONE_LAUNCH
    a.ph_lo = 0; a.ph_hi = NPHASE;
    hipLaunchKernelGGL(fwd_kernel, dim3(grid), dim3(NTHR), LDS_BYTES, stream, a);
#else
    for (int p = 0; p < NPHASE; ++p) { a.ph_lo = p; a.ph_hi = p + 1; hipLaunchKernelGGL(fwd_kernel, dim3(grid), dim3(NTHR), LDS_BYTES, stream, a); }
#endif
}
```

```cpp
#include <hip/hip_runtime.h>
#include <cstdio>
#include <cstdint>

#ifndef MK_ONE_LAUNCH
#define MK_ONE_LAUNCH 1
#endif

namespace pg8 {
#define PG8_LAS __attribute__((address_space(3)))
typedef unsigned short bf16_t;
typedef short bf16x8 __attribute__((ext_vector_type(8)));
typedef float f32x4 __attribute__((ext_vector_type(4)));
typedef float f32x2 __attribute__((ext_vector_type(2)));
typedef unsigned u32x4 __attribute__((ext_vector_type(4)));
typedef unsigned u32x2 __attribute__((ext_vector_type(2)));
constexpr int BM = 256, BK = 64, HALF = 128, HTB = HALF * BK * 2  , STAGE_BYTES = 8 * HTB, NXCD = 8, WGM = 8;

__host__ __device__ __forceinline__ int lds_byte(int r, int c) { const int st = (r >> 4) * 2 + (c >> 5), rr = r & 15, cc = c & 31, ob = rr * 64 + cc * 2; return st * 1024 + (ob ^ (((ob >> 9) & 1) << 5)); }
__host__ __device__ __forceinline__ void stage_rc(int b, int& R, int& C) { const int st = b / 1024, sb = b % 1024, swz = sb ^ (((sb >> 9) & 1) << 5); R = (st >> 1) * 16 + swz / 64; C = (st & 1) * 32 + (swz % 64) / 2; }
__host__ __device__ __forceinline__ int perm32(int rho) { const int n = rho >> 4, i = rho & 15; return 8 * (i >> 2) + 4 * n + (i & 3); }

struct Unit { const char* A; const char* B; int pm, pn, aux; };

__host__ __device__ __forceinline__ void tile_order(int L, int nM, int nN, int& pm, int& pn) {
    const int nwg = nM * nN; int wgid = L;
    { const int q = nwg / NXCD, r = nwg % NXCD, xcd = wgid % NXCD, off = wgid / NXCD; wgid = (xcd < r ? xcd * (q + 1) : r * (q + 1) + (xcd - r) * q) + off; }
    const int nig = WGM * nN, gid = wgid / nig, fm = gid * WGM, gsz = (nM - fm) < WGM ? (nM - fm) : WGM;
    pm = fm + ((wgid % nig) % gsz); pn = (wgid % nig) / gsz;
}

typedef __bf16 bf16n2 __attribute__((ext_vector_type(2)));
__device__ __forceinline__ unsigned cvt_pk_bf16(float lo, float hi) { const f32x2 v = {lo, hi}; return __builtin_bit_cast(unsigned, __builtin_convertvector(v, bf16n2)); }

template <class Epi, class Sched>
__device__ __forceinline__ void gemm_phase(PG8_LAS unsigned char* lds, const int K, const Sched& S, const Epi& E, int tid) {
    const int wid = __builtin_amdgcn_readfirstlane(tid >> 6), lane = tid & 63, wr = wid >> 2, wc = wid & 3, fr = lane & 15, fq = lane >> 4;
    const int nt = K / BK;
    unsigned voffA[2], voffB[2];
#pragma unroll
    for (int i = 0; i < 2; ++i) { int R, C; stage_rc(tid * 16 + i * 8192, R, C); const int Rb = Epi::PERM ? ((R & ~31) + perm32(R & 31)) : R;
        voffA[i] = (unsigned)(R * K + C) * 2u; voffB[i] = (unsigned)(Rb * K + C) * 2u; }
    const size_t kstep = (size_t)(BK * 2);
    const size_t hstep = (size_t)HALF * K * 2;
    const unsigned ldsw = (unsigned)wid * 1024u;
    const int aoff = lds_byte(wr * 64 + fr, fq * 8), boff = lds_byte(wc * 32 + fr, fq * 8);
#define PG8_SA(b, h) (((b) * 2 + (h)) * HTB)
#define PG8_SB(b, h) ((4 + (b) * 2 + (h)) * HTB)
#define PG8_STAGE(bufoff, gbase, voff) do { _Pragma("unroll") for (int _i = 0; _i < 2; ++_i) \
        __builtin_amdgcn_global_load_lds((const unsigned*)((const char*)(gbase) + (voff)[_i]), (PG8_LAS unsigned*)(lds + (bufoff) + ldsw + _i * 8192), 16, 0, 0); } while (0)
#define PG8_LDA(dst, b, h) do { _Pragma("unroll") for (int m = 0; m < 4; ++m) _Pragma("unroll") for (int k = 0; k < 2; ++k) dst[m][k] = *(const PG8_LAS bf16x8*)(lds + PG8_SA(b, h) + aoff + m * 2048 + k * 1024); } while (0)
#define PG8_LDB(dst, b, h) do { _Pragma("unroll") for (int n = 0; n < 2; ++n) _Pragma("unroll") for (int k = 0; k < 2; ++k) dst[n][k] = *(const PG8_LAS bf16x8*)(lds + PG8_SB(b, h) + boff + n * 2048 + k * 1024); } while (0)
#define PG8_MMA(ai, bj, At, Bt) do { __builtin_amdgcn_s_setprio(1); _Pragma("unroll") for (int m = 0; m < 4; ++m) _Pragma("unroll") for (int n = 0; n < 2; ++n) _Pragma("unroll") for (int k = 0; k < 2; ++k) \
        acc[ai][bj][m][n] = __builtin_amdgcn_mfma_f32_16x16x32_bf16(Bt[n][k], At[m][k], acc[ai][bj][m][n], 0, 0, 0); __builtin_amdgcn_s_setprio(0); } while (0)
#define PG8_WAIT_V(n) asm volatile("s_waitcnt vmcnt(" #n ")" ::: "memory")
#define PG8_WAIT_L(n) asm volatile("s_waitcnt lgkmcnt(" #n ")" ::: "memory")
#define PG8_BAR __builtin_amdgcn_s_barrier()
#define PG8_SCHED __builtin_amdgcn_sched_barrier(0)
    Unit cur, nxt; int ui = 0;
    if (!S.next(0, cur)) return;
    f32x4 acc[2][2][4][2];
#pragma unroll
    for (int a = 0; a < 2; ++a)
#pragma unroll
        for (int b = 0; b < 2; ++b)
#pragma unroll
            for (int m = 0; m < 4; ++m)
#pragma unroll
                for (int n = 0; n < 2; ++n) acc[a][b][m][n] = (f32x4){0.f, 0.f, 0.f, 0.f};
    bf16x8 At[4][2], B0[2][2], B1[2][2];
    const char* cA = cur.A; const char* cB = cur.B;
    PG8_STAGE(PG8_SB(0, 0), cB, voffB); PG8_STAGE(PG8_SB(0, 1), cB + hstep, voffB); PG8_STAGE(PG8_SA(0, 0), cA, voffA); PG8_STAGE(PG8_SA(0, 1), cA + hstep, voffA);
    if (wr == 1) PG8_BAR;
    PG8_WAIT_V(2); PG8_BAR;
    PG8_STAGE(PG8_SB(1, 0), cB + kstep, voffB); PG8_STAGE(PG8_SA(1, 0), cA + kstep, voffA); PG8_STAGE(PG8_SB(1, 1), cB + hstep + kstep, voffB);
    PG8_WAIT_V(6); PG8_BAR;
    for (;;) {
        const bool has_next = S.next(ui + 1, nxt);
        const char* nA = has_next ? nxt.A : cA; const char* nB = has_next ? nxt.B : cB;
        for (int t = 0; t < nt; t += 2) {
            const bool last = (t == nt - 2);
            const char* a1 = cA + (size_t)(t + 1) * kstep;
            const char* a2 = last ? nA : cA + (size_t)(t + 2) * kstep; const char* b2 = last ? nB : cB + (size_t)(t + 2) * kstep;
            const char* a3 = a2 + kstep; const char* b3 = b2 + kstep;
            PG8_LDB(B0, 0, 0); PG8_LDB(B1, 0, 1); PG8_SCHED; PG8_LDA(At, 0, 0); PG8_STAGE(PG8_SA(1, 1), a1 + hstep, voffA);
            PG8_WAIT_V(8); PG8_WAIT_L(0); PG8_BAR; PG8_MMA(0, 0, At, B0); PG8_MMA(0, 1, At, B1); PG8_BAR; PG8_SCHED;
            PG8_LDA(At, 0, 1); PG8_STAGE(PG8_SB(0, 0), b2, voffB); PG8_STAGE(PG8_SB(0, 1), b2 + hstep, voffB); PG8_STAGE(PG8_SA(0, 0), a2, voffA);
            PG8_WAIT_V(8); PG8_WAIT_L(0); PG8_BAR; PG8_MMA(1, 0, At, B0); PG8_MMA(1, 1, At, B1); PG8_BAR; PG8_SCHED;
            PG8_LDB(B0, 1, 0); PG8_LDB(B1, 1, 1); PG8_SCHED; PG8_LDA(At, 1, 0); PG8_STAGE(PG8_SA(0, 1), a2 + hstep, voffA);
            PG8_WAIT_V(8); PG8_WAIT_L(0); PG8_BAR; PG8_MMA(0, 0, At, B0); PG8_MMA(0, 1, At, B1); PG8_BAR; PG8_SCHED;
            PG8_LDA(At, 1, 1); PG8_STAGE(PG8_SB(1, 0), b3, voffB); PG8_STAGE(PG8_SB(1, 1), b3 + hstep, voffB); PG8_STAGE(PG8_SA(1, 0), a3, voffA);
            PG8_WAIT_V(8); PG8_WAIT_L(0); PG8_BAR; PG8_MMA(1, 0, At, B0); PG8_MMA(1, 1, At, B1); PG8_BAR; PG8_SCHED;
        }
        if (wr == 0) PG8_BAR;
        { int fr_ = fr, fq_ = fq; asm volatile("" : "+v"(fr_), "+v"(fq_)); E(acc, cur, wr, wc, fr_, fq_); }
        if (!has_next) break;
#pragma unroll
        for (int a = 0; a < 2; ++a)
#pragma unroll
            for (int b = 0; b < 2; ++b)
#pragma unroll
                for (int m = 0; m < 4; ++m)
#pragma unroll
                    for (int n = 0; n < 2; ++n) acc[a][b][m][n] = (f32x4){0.f, 0.f, 0.f, 0.f};
        cur = nxt; cA = nA; cB = nB; ++ui;
        if (wr == 1) PG8_BAR;
    }
    PG8_WAIT_V(0);
    PG8_BAR;
#undef PG8_SA
#undef PG8_SB
#undef PG8_STAGE
#undef PG8_LDA
#undef PG8_LDB
#undef PG8_MMA
#undef PG8_WAIT_V
#undef PG8_WAIT_L
#undef PG8_BAR
#undef PG8_SCHED
}
}

constexpr int NWAVES = 8, NTHR = 512;
constexpr int D = 2048, NB = 4, SEQ = 2048, CTXL = 256, NCTX = NB * CTXL  , NLAT = NB * SEQ  , NTOK = NCTX + NLAT  ;
constexpr int NSTEP = CTXL + SEQ;
constexpr int HEADS = 8, HD = 128, MW = 1024, LW = 1024;
constexpr int NEXP = 32, DE = 1024;
constexpr int IN_DIM = 11296, NT_IN = 45;
constexpr float EPS = 1e-6f;
constexpr int MAXTILES = 96;
constexpr int NPHASE = 9;

constexpr size_t MiB = 1u << 20;
constexpr size_t WS_CTL = 0, CTL_ZERO_BYTES = 1 * MiB;
constexpr size_t WS_MOD = 1 * MiB;
constexpr size_t WS_GATES = 2 * MiB;
constexpr size_t WS_ASG = 4 * MiB + 512 * 1024;
constexpr size_t WS_LIST = 3 * MiB + 512 * 1024;
constexpr size_t WS_WR = 6 * MiB;
constexpr size_t WS_RB = 7 * MiB + 768 * 1024;
constexpr size_t WS_WL = 5 * MiB;
constexpr size_t WS_AGG = 978 * MiB;
constexpr size_t WS_WPA = 8 * MiB, WS_WPB = 12 * MiB, WS_WOUT = 16 * MiB, WS_WIN = 24 * MiB;
constexpr size_t WS_W13 = 72 * MiB, WS_W2 = 328 * MiB;
constexpr size_t WS_PS = 72 * MiB;
constexpr size_t WS_H = 456 * MiB;
constexpr size_t WS_K = 492 * MiB, WS_V = 510 * MiB, WS_UX = 528 * MiB;
constexpr size_t WS_Q = 546 * MiB, WS_OF = 562 * MiB, WS_OB = 578 * MiB, WS_UG = 594 * MiB;
constexpr size_t WS_GA = 610 * MiB, WS_GB = 642 * MiB;
constexpr size_t WS_LA = 674 * MiB, WS_LB = 746 * MiB;
constexpr size_t WS_HS = 818 * MiB, WS_TM = 882 * MiB;
constexpr size_t WS_YA = 946 * MiB, WS_YB = 962 * MiB;
constexpr size_t WS_BT = 982 * MiB;
constexpr size_t WS_SLOC = 984 * MiB;
constexpr size_t WS_END = 1022 * MiB;
constexpr size_t WS_PRE = WS_LA;
constexpr size_t WS_X1 = WS_LB;
constexpr size_t WS_H2 = WS_H;
constexpr size_t WS_XS = WS_K;
constexpr size_t WS_HM = 588 * MiB;
constexpr size_t WS_Y2 = WS_HS;
constexpr int CW_MODC = 32;
constexpr int CW_CNT = 64;
constexpr int CW_NT = 128;
constexpr int CW_TILE_E = 192;
constexpr int CW_BAR = 4096;
constexpr int CW_Q = 8192;
constexpr int CW_TC = 16384;

constexpr int RING_BYTES = 131072;
constexpr int LDSCTL_OFF = 143360;
constexpr int MISC_OFF = LDSCTL_OFF + 384;
constexpr int LDS_BYTES = 147456;

#define GAS __attribute__((address_space(1)))
#define LAS __attribute__((address_space(3)))
typedef unsigned short bf16;
typedef unsigned v4u __attribute__((ext_vector_type(4)));
typedef float f32x4 __attribute__((ext_vector_type(4)));
#define LDS_WAIT() asm volatile("s_waitcnt lgkmcnt(0)" ::: "memory")
#define WG_BAR() do { asm volatile("s_waitcnt lgkmcnt(0)" ::: "memory"); __builtin_amdgcn_s_barrier(); asm volatile("" ::: "memory"); } while (0)

__device__ __forceinline__ unsigned f2bf(float f) { unsigned u = __builtin_bit_cast(unsigned, f); return (u + 0x7fffu + ((u >> 16) & 1u)) >> 16; }
__device__ __forceinline__ unsigned pk2(float lo, float hi) { return pg8::cvt_pk_bf16(lo, hi); }
__device__ __forceinline__ float bf2f(unsigned h) { return __builtin_bit_cast(float, h << 16); }
__device__ __forceinline__ float bflo(unsigned w) { return __builtin_bit_cast(float, w << 16); }
__device__ __forceinline__ float bfhi(unsigned w) { return __builtin_bit_cast(float, w & 0xffff0000u); }
__device__ __forceinline__ float sigmoidf_(float x) { return __builtin_amdgcn_rcpf(1.f + __expf(-x)); }
__device__ __forceinline__ float gelu_tanh(float x) { const float u = 0.7978845608028654f * (x + 0.044715f * x * x * x); return x * __builtin_amdgcn_rcpf(1.f + __expf(-2.f * u)); }
__device__ __forceinline__ float wave_sum(float v) {
#pragma unroll
    for (int o = 1; o < 64; o <<= 1) v += __shfl_xor(v, o);
    return v;
}

#define XB_TMO      128
#define XB_XCNT(j)  (256  + 64 * (j))
#define XB_XSUB(j)  (1280 + 64 * (j))
#define XB_XGEN(j)  (2304 + 64 * (j))
#define XB_TOP      3328
#define XB_TOPGEN   3392
#define XCD_BAR_WORDS 3456
#define XB_SPIN_CAP (1u << 23)
__device__ __forceinline__ unsigned xb_ld(unsigned* p)              { return __hip_atomic_load(p, __ATOMIC_RELAXED, __HIP_MEMORY_SCOPE_AGENT); }
__device__ __forceinline__ unsigned xb_add(unsigned* p, unsigned v) { return __hip_atomic_fetch_add(p, v, __ATOMIC_RELAXED, __HIP_MEMORY_SCOPE_AGENT); }
__device__ __forceinline__ unsigned xb_xcc_id() { return (unsigned)__builtin_amdgcn_s_getreg((3 << 11) | 20) & 0xFu; }
#define XB_SPIN(cond, bar) do { unsigned _sp = 0; while (cond) { __builtin_amdgcn_s_sleep(1); \
    if ((++_sp & 255u) == 0u) { if (xb_ld(&(bar)[XB_TMO])) break; if (_sp > XB_SPIN_CAP) { atomicAdd(&(bar)[XB_TMO], 1u); break; } } } } while (0)
struct XcdBarrier { unsigned* bar; unsigned x; volatile LAS unsigned* st; };
__device__ __forceinline__ XcdBarrier xcd_barrier_post(unsigned* bar, volatile LAS unsigned* st, int tid) {
    XcdBarrier b; b.bar = bar; b.x = xb_xcc_id(); b.st = st;
    if (tid == 0) (void)xb_add(&bar[XB_XCNT(b.x)], 1u);
    return b;
}
__device__ __forceinline__ void xcd_barrier_complete(unsigned* bar, unsigned x, unsigned& nloc, unsigned& nx) {
    const unsigned G = gridDim.x * gridDim.y * gridDim.z;
    unsigned sum, cnt, mine, sp = 0u;
    for (;;) {
        sum = 0u; cnt = 0u; mine = 0u;
#pragma unroll
        for (unsigned j = 0; j < 16; ++j) { const unsigned c = xb_ld(&bar[XB_XCNT(j)]); sum += c; cnt += (c > 0u) ? 1u : 0u; mine = (j == x) ? c : mine; }
        if (sum == G) break;
        __builtin_amdgcn_s_sleep(1);
        if ((++sp & 255u) == 0u) { if (xb_ld(&bar[XB_TMO])) break; if (sp > XB_SPIN_CAP) { atomicAdd(&bar[XB_TMO], 1u); break; } }
    }
    nloc = mine > 0u ? mine : 1u; nx = cnt > 0u ? cnt : 1u;
}
__device__ __forceinline__ void xcd_barrier(const XcdBarrier& b, int tid) {
    asm volatile("s_waitcnt vmcnt(0)" ::: "memory");
    __syncthreads();
    if (tid == 0) {
        unsigned* bar = b.bar;
        __builtin_amdgcn_s_waitcnt(0);
        unsigned nloc = b.st[0], nx = b.st[1];
        if (nloc == 0u) { xcd_barrier_complete(bar, b.x, nloc, nx); b.st[0] = nloc; b.st[1] = nx; }
        const unsigned old = xb_add(&bar[XB_XSUB(b.x)], 1u);
        const unsigned gen = old / nloc;
        if (old + 1u == (gen + 1u) * nloc) {
            __builtin_amdgcn_fence(__ATOMIC_RELEASE, "agent");
            asm volatile("s_waitcnt vmcnt(0)" ::: "memory");
            const unsigned og = xb_add(&bar[XB_TOP], 1u);
            const unsigned tg = og / nx;
            if (og + 1u == (tg + 1u) * nx) xb_add(&bar[XB_TOPGEN], 1u);
            else XB_SPIN(xb_ld(&bar[XB_TOPGEN]) == tg, bar);
            __builtin_amdgcn_fence(__ATOMIC_ACQUIRE, "agent");
            xb_add(&bar[XB_XGEN(b.x)], 1u);
            asm volatile("s_waitcnt vmcnt(0)" ::: "memory");
        } else {
            XB_SPIN(xb_ld(&bar[XB_XGEN(b.x)]) == gen, bar);
            __builtin_amdgcn_fence(__ATOMIC_ACQUIRE, "agent");
            asm volatile("s_waitcnt vmcnt(0)" ::: "memory");
        }
    }
    __syncthreads();
}

__device__ __forceinline__ int make_tid(int wave_s) { int l; asm volatile("v_mbcnt_lo_u32_b32 %0, -1, 0\n\tv_mbcnt_hi_u32_b32 %0, -1, %0" : "=v"(l)); __builtin_assume(l >= 0 && l < 64); __builtin_assume(wave_s >= 0 && wave_s < 8); return wave_s * 64 + l; }
struct Args { const float* in[27]; float* out; unsigned char* ws; int ph_lo, ph_hi; };
enum { I_X = 0, I_C, I_CTX, I_CCTX, I_WMOD, I_BMOD, I_N1G, I_WIN, I_BGATES, I_HEADG, I_CONVW, I_CONVB, I_LWA, I_LBA, I_LWX, I_LBX, I_LAM, I_WPA, I_WPB, I_WOUT, I_N2G, I_WRG, I_WRE, I_W1, I_W3, I_W2, I_FG };

__device__ __forceinline__ void tr_item(const float* __restrict__ W, size_t ldw, int k0, int n0, bf16* dst, size_t ldd, float scale, LAS float* scr, int lane) {
#pragma unroll 16
    for (int i = 0; i < 32; ++i) { const int kk = 2 * i + (lane >> 5); scr[kk * 33 + (lane & 31)] = W[(size_t)(k0 + kk) * ldw + n0 + (lane & 31)]; }
    LDS_WAIT(); asm volatile("" ::: "memory");
    const int c = lane & 7;
#pragma unroll
    for (int j = 0; j < 4; ++j) { const int n = (lane >> 3) + 8 * j; const LAS float* s = scr + (8 * c) * 33 + n;
        v4u o; o.x = pk2(s[0 * 33] * scale, s[1 * 33] * scale); o.y = pk2(s[2 * 33] * scale, s[3 * 33] * scale); o.z = pk2(s[4 * 33] * scale, s[5 * 33] * scale); o.w = pk2(s[6 * 33] * scale, s[7 * 33] * scale);
        *(GAS v4u*)(dst + (size_t)n * ldd + 8 * c) = o; }
    LDS_WAIT(); asm volatile("" ::: "memory");
}
__device__ __forceinline__ int win_row(int n0, float& scale) {
    scale = 1.f;
    if (n0 < 1024) return 13 * 256 + n0;
    if (n0 < 2048) { scale = 0.08838834764831845f; return n0 - 1024; }
    if (n0 < 3072) return 4 * 256 + (n0 - 2048);
    if (n0 < 4096) return 17 * 256 + (n0 - 3072);
    if (n0 < 5120) return 21 * 256 + (n0 - 4096);
    if (n0 < 5152) return 12 * 256 + (n0 - 5120);
    if (n0 < 6176) return 8 * 256 + (n0 - 5152);
    if (n0 < 7200) return 25 * 256 + (n0 - 6176);
    if (n0 < 9248) return 29 * 256 + (n0 - 7200);
    return 37 * 256 + (n0 - 9248);
}

__device__ __forceinline__ void phase0(const Args& a, unsigned char* lds_g, int tid, int lane, int wave) {
    unsigned char* ws = a.ws;
    {
        float* sl = (float*)lds_g;
        float* red = sl + 5 * 2048;
        for (int i = tid; i < 5 * 2048; i += NTHR) { const int r = i >> 11, k = i & 2047; const float v = r < 4 ? a.in[I_C][r * 2048 + k] : a.in[I_CCTX][k]; sl[i] = v / (1.f + __expf(-v)); }
        __syncthreads();
        const float* wm = a.in[I_WMOD]; const float* bm = a.in[I_BMOD]; float* MOD = (float*)(ws + WS_MOD);
        for (int cb = blockIdx.x; cb < 256; cb += gridDim.x) {
            const int n0 = cb * 48;
            if (tid < 504) {
                const int kq = tid / 12, cg = tid % 12;
                f32x4 acc[5];
#pragma unroll
                for (int r = 0; r < 5; ++r) acc[r] = (f32x4){0.f, 0.f, 0.f, 0.f};
#pragma unroll 7
                for (int k = kq; k < 2048; k += 42) {
                    const f32x4 w = *(const f32x4*)(wm + (size_t)k * 12288 + n0 + 4 * cg);
#pragma unroll
                    for (int r = 0; r < 5; ++r) acc[r] += w * sl[r * 2048 + k];
                }
#pragma unroll
                for (int r = 0; r < 5; ++r) *(f32x4*)(red + tid * 20 + r * 4) = acc[r];
            }
            __syncthreads();
            if (tid < 240) {
                const int cg = tid / 20, rj = tid % 20; float s = 0.f;
                for (int kq = 0; kq < 42; ++kq) s += red[(kq * 12 + cg) * 20 + rj];
                const int r = rj >> 2, j = rj & 3, n = n0 + 4 * cg + j;
                __hip_atomic_store(MOD + r * 12288 + n, s + bm[n], __ATOMIC_RELAXED, __HIP_MEMORY_SCOPE_AGENT);
            }
            __syncthreads();
        }
        if (tid == 0) __hip_atomic_fetch_add((unsigned*)(ws + WS_CTL) + CW_MODC, 1u, __ATOMIC_RELAXED, __HIP_MEMORY_SCOPE_AGENT);
    }
    {
        LAS float* scr = (LAS float*)((LAS unsigned char*)lds_g) + wave * 4096;
        const int gw = blockIdx.x * NWAVES + wave, NGW = gridDim.x * NWAVES;
        constexpr int J0 = 32 * 353, J1 = 16 * 64, J3 = 32 * 64;
        constexpr int JL = 256;
        constexpr int NITEMS = J0 + 2 * J1;
        (void)J3; (void)JL;
        for (int it = gw; it < NITEMS; it += NGW) {
            int r = it;
            if (r < J0) { const int kb = r / 353, nb = r % 353; float sc; const int row = win_row(32 * nb, sc);
                tr_item(a.in[I_WIN], IN_DIM, 64 * kb, 32 * nb, (bf16*)(ws + WS_WIN) + (size_t)row * 2048 + 64 * kb, 2048, sc, scr, lane); continue; } r -= J0;
            if (r < J1) { const int kb = r / 64, nb = r % 64; tr_item(a.in[I_WPA], 2048, 64 * kb, 32 * nb, (bf16*)(ws + WS_WPA) + (size_t)(32 * nb) * 1024 + 64 * kb, 1024, 1.f, scr, lane); continue; } r -= J1;
            if (r < J1) { const int kb = r / 64, nb = r % 64; tr_item(a.in[I_WPB], 2048, 64 * kb, 32 * nb, (bf16*)(ws + WS_WPB) + (size_t)(32 * nb) * 1024 + 64 * kb, 1024, 1.f, scr, lane); continue; }
        }
        { GAS v4u* z = (GAS v4u*)((bf16*)(ws + WS_WIN) + (size_t)(12 * 256 + 32) * 2048); const int nchunks = 224 * 256;
          for (int i = blockIdx.x * NTHR + tid; i < nchunks; i += gridDim.x * NTHR) z[i] = (v4u){0u, 0u, 0u, 0u}; }
    }
}

__device__ __forceinline__ void late_prep(const Args& a, unsigned char* lds_g, int gw, int NGW, int lane, int wave) {
    unsigned char* ws = a.ws;
    {
        LAS float* scr = (LAS float*)((LAS unsigned char*)lds_g) + wave * 4096;
        constexpr int J3 = 32 * 64, JL = 256;
        for (int it = gw; it < J3 + JL; it += NGW) {
            int r = it;
            if (r >= J3) { r -= J3; const int mi = r >> 3, kb = (r >> 2) & 1, nb = r & 3, dir = mi >> 4, mat = (mi >> 3) & 1, blk = mi & 7;
                tr_item(a.in[mat ? I_LWX : I_LWA] + (size_t)(dir * 8 + blk) * 128 * 128, 128, 64 * kb, 32 * nb, (bf16*)(ws + WS_WL) + ((size_t)((dir * 2 + mat) * 8 + blk) * 128 + 32 * nb) * 128 + 64 * kb, 128, 1.f, scr, lane); continue; }
            const int kb = r / 64, nb = r % 64; tr_item(a.in[I_WOUT], 2048, 64 * kb, 32 * nb, (bf16*)(ws + WS_WOUT) + (size_t)(32 * nb) * 2048 + 64 * kb, 2048, 1.f, scr, lane);
        }
    }
    {
        const float* MODr = (const float*)(a.ws + WS_MOD); float* WR = (float*)(a.ws + WS_WR); float* RB = (float*)(a.ws + WS_RB);
        for (int idx = gw * 64 + lane; idx < 4 * 48 * 2048; idx += NGW * 64) { const int k = idx & 2047, j = (idx >> 11) % 48, b = idx / (48 * 2048);
            const float gm = a.in[I_N2G][k] * (1.f + MODr[b * 12288 + 4 * 2048 + k]);
            const float wv = j < 32 ? a.in[I_WRE][(size_t)k * 32 + j] : (j < 36 ? a.in[I_WRG][(size_t)k * 4 + (j - 32)] : 0.f);
            WR[idx] = gm * wv; }
        for (int q = gw; q < 4 * 48; q += NGW) { const int b = q / 48, j = q % 48; float sacc = 0.f;
            if (j < 36) { for (int k = lane; k < 2048; k += 64) { const float wv = j < 32 ? a.in[I_WRE][(size_t)k * 32 + j] : a.in[I_WRG][(size_t)k * 4 + (j - 32)]; sacc += MODr[b * 12288 + 3 * 2048 + k] * wv; } }
            sacc = wave_sum(sacc); if (lane == 0) RB[q] = sacc; }
    }
}
__device__ __forceinline__ void mod_wait(const Args& a, int tid) {
    if (tid < 64) { unsigned* mc = (unsigned*)(a.ws + WS_CTL) + CW_MODC; unsigned spins = 0;
        while ((unsigned)__builtin_amdgcn_readfirstlane(__hip_atomic_load(mc, __ATOMIC_RELAXED, __HIP_MEMORY_SCOPE_AGENT)) < gridDim.x) {
            __builtin_amdgcn_s_sleep(2);
            if (++spins > (1u << 22)) { if (tid == 0) __hip_atomic_store((unsigned*)(a.ws + WS_CTL) + 1, 0x800u, __ATOMIC_RELAXED, __HIP_MEMORY_SCOPE_AGENT); break; } }
        __builtin_amdgcn_fence(__ATOMIC_ACQUIRE, "agent");
        asm volatile("s_waitcnt vmcnt(0)" ::: "memory"); }
    __syncthreads();
}
__device__ __forceinline__ void phase1(const Args& a, int lane, int wave) {
    const int gw = blockIdx.x * NWAVES + wave, NGW = gridDim.x * NWAVES;
    const float* MOD = (const float*)(a.ws + WS_MOD); const float* g = a.in[I_N1G];
    bf16* H = (bf16*)(a.ws + WS_H);
    for (int r = gw; r < NTOK; r += NGW) {
        const float* src = r < NCTX ? a.in[I_CTX] + (size_t)r * D : a.in[I_X] + (size_t)(r - NCTX) * D;
        const int mr = r < NCTX ? 4 : (r - NCTX) / SEQ;
        const f32x4* xr = (const f32x4*)src + lane;
        f32x4 v[8]; float s = 0.f;
#pragma unroll
        for (int j = 0; j < 8; ++j) { v[j] = xr[64 * j]; s += (v[j].x * v[j].x + v[j].y * v[j].y) + (v[j].z * v[j].z + v[j].w * v[j].w); }
        const float rstd = 1.f / sqrtf(wave_sum(s) * (1.f / D) + EPS);
        unsigned long long* o8 = (unsigned long long*)(H + (size_t)r * D) + lane;
#pragma unroll
        for (int j = 0; j < 8; ++j) {
            const int c = 4 * lane + 256 * j;
            const f32x4 gg = *(const f32x4*)(g + c), sh = *(const f32x4*)(MOD + mr * 12288 + c), sc = *(const f32x4*)(MOD + mr * 12288 + 2048 + c);
            v[j] = v[j] * rstd * gg * (sc + 1.f) + sh;
        }
#pragma unroll
        for (int j = 0; j < 8; ++j) o8[64 * j] = (unsigned long long)pk2(v[j].x, v[j].y) | ((unsigned long long)pk2(v[j].z, v[j].w) << 32);
    }
}

struct SchedIn {
    int G, c; const char* A; const char* B;
    __device__ __forceinline__ bool next(int i, pg8::Unit& u) const {
        const int L = i * G + c; if (L >= 1492) return false;
        int pm, pn;
        if (L < 1440) { pg8::tile_order(L, 32, NT_IN, pm, pn); pm += 4; }
        else { const int j = L - 1440; pm = j & 3; pn = j >> 2; }
        u.pm = pm; u.pn = pn; u.aux = 0; u.A = A + (size_t)pm * 256 * D * 2; u.B = B + (size_t)pn * 256 * D * 2; return true;
    }
};
struct EpiIn {
    static constexpr bool PERM = true;
    unsigned char* ws; const float* b_gates;
    template <int ACT> __device__ __forceinline__ void store_tile(const pg8::f32x4 (&acc)[2][2][4][2], bf16* base, int ldc, int wr, int wc, int fr, int fq) const {
#pragma unroll
        for (int ai = 0; ai < 2; ++ai)
#pragma unroll
            for (int m = 0; m < 4; ++m) { bf16* rowp = base + (size_t)(ai * 128 + wr * 64 + m * 16 + fr) * ldc + wc * 32 + 8 * fq;
#pragma unroll
                for (int bj = 0; bj < 2; ++bj) { pg8::f32x4 v0 = acc[ai][bj][m][0], v1 = acc[ai][bj][m][1];
                    if (ACT == 1) {
#pragma unroll
                        for (int j = 0; j < 4; ++j) { v0[j] = sigmoidf_(v0[j]); v1[j] = sigmoidf_(v1[j]); } }
                    if (ACT == 2) {
#pragma unroll
                        for (int j = 0; j < 4; ++j) { v0[j] = gelu_tanh(v0[j]); v1[j] = gelu_tanh(v1[j]); } }
                    pg8::u32x4 w; w.x = pg8::cvt_pk_bf16(v0[0], v0[1]); w.y = pg8::cvt_pk_bf16(v0[2], v0[3]); w.z = pg8::cvt_pk_bf16(v1[0], v1[1]); w.w = pg8::cvt_pk_bf16(v1[2], v1[3]);
                    *(pg8::u32x4*)(rowp + bj * 128) = w; } }
    }
    __device__ __forceinline__ void operator()(const pg8::f32x4 (&acc)[2][2][4][2], const pg8::Unit& u, int wr, int wc, int fr, int fq) const {
        const int pn = u.pn; const size_t row0 = (size_t)u.pm * 256;
        if (pn < 12) {
            const int seg = pn >> 2, ct = pn & 3; bf16* dst = (bf16*)(ws + (seg == 0 ? WS_K : seg == 1 ? WS_V : WS_UX));
            store_tile<0>(acc, dst + row0 * 1024 + ct * 256, 1024, wr, wc, fr, fq);
        } else if (pn == 12) {
            if (wc == 0) {
                float* G = (float*)(ws + WS_GATES);
                const pg8::f32x4 bv0 = *(const pg8::f32x4*)(b_gates + 8 * fq), bv1 = *(const pg8::f32x4*)(b_gates + 8 * fq + 4);
#pragma unroll
                for (int ai = 0; ai < 2; ++ai)
#pragma unroll
                    for (int m = 0; m < 4; ++m) { float* rowp = G + (row0 + ai * 128 + wr * 64 + m * 16 + fr) * 32 + 8 * fq;
                        *(pg8::f32x4*)(rowp) = acc[ai][0][m][0] + bv0; *(pg8::f32x4*)(rowp + 4) = acc[ai][0][m][1] + bv1; }
            }
        } else if (pn < 29) {
            const int seg = (pn - 13) >> 2, ct = (pn - 13) & 3; const size_t lr = row0 - NCTX;
            bf16* dst = (bf16*)(ws + (seg == 0 ? WS_Q : seg == 1 ? WS_OF : seg == 2 ? WS_OB : WS_UG)) + lr * 1024 + ct * 256;
            if (seg == 0) store_tile<0>(acc, dst, 1024, wr, wc, fr, fq);
            else if (seg == 3) store_tile<2>(acc, dst, 1024, wr, wc, fr, fq);
            else store_tile<1>(acc, dst, 1024, wr, wc, fr, fq);
        } else {
            const int seg = (pn - 29) >> 3, ct = (pn - 29) & 7; const size_t lr = row0 - NCTX;
            store_tile<1>(acc, (bf16*)(ws + (seg ? WS_GB : WS_GA)) + lr * 2048 + ct * 256, 2048, wr, wc, fr, fq);
        }
    }
};

__device__ __forceinline__ int lru_pos_row(int b, bool isctx, int p) { return isctx ? b * CTXL + p : NCTX + b * SEQ + (p & 31) * 64 + (p >> 5); }
typedef short bf16x8_t __attribute__((ext_vector_type(8)));
template <bool FINAL>
__device__ __forceinline__ void lru_unit(const Args& a, unsigned char* lds_g, int b, int cidx, int blk, int tid) {
    const int lane = tid & 63, w = __builtin_amdgcn_readfirstlane(tid >> 6), fr = lane & 15, fq = lane >> 4;
    float* zf = (float*)lds_g;
    bf16* zb = (bf16*)(lds_g + 64 * 132 * 4);
    const bool isctx = cidx < 4; const int seglen = isctx ? CTXL : SEQ, p0 = (isctx ? cidx : cidx - 4) * 64;
    const bf16* UX = (const bf16*)(a.ws + WS_UX);
    float gba[2], gbx[2], glam[2];
    { const int ch_ = blk * 128 + 16 * w + fr;
#pragma unroll
      for (int d = 0; d < 2; ++d) { gba[d] = a.in[I_LBA][d * 1024 + ch_]; gbx[d] = a.in[I_LBX][d * 1024 + ch_]; glam[d] = a.in[I_LAM][d * 1024 + ch_]; } }
    bf16x8_t wl[2][2][4];
    { const bf16* WL = (const bf16*)(a.ws + WS_WL);
#pragma unroll
      for (int d = 0; d < 2; ++d)
#pragma unroll
        for (int m = 0; m < 2; ++m)
#pragma unroll
            for (int ks = 0; ks < 4; ++ks) wl[d][m][ks] = *(const bf16x8_t*)(WL + ((size_t)((d * 2 + m) * 8 + blk) * 128 + 16 * w + fr) * 128 + 32 * ks + 8 * fq); }
    __builtin_amdgcn_sched_barrier(0);
    {
        const int pos = tid >> 3, cg = tid & 7, ch0 = blk * 128 + cg * 16, p = p0 + pos;
        float z[16];
#pragma unroll
        for (int q = 0; q < 4; ++q) { const f32x4 bv = *(const f32x4*)(a.in[I_CONVB] + ch0 + 4 * q); z[4 * q] = bv.x; z[4 * q + 1] = bv.y; z[4 * q + 2] = bv.z; z[4 * q + 3] = bv.w; }
        v4u ua[4], ub[4]; float msk[4];
#pragma unroll
        for (int w4 = 0; w4 < 4; ++w4) { const int pp = p + w4 - 2; const bool ok = pp >= 0 && pp < seglen; const int ppc = ok ? pp : p;
            const v4u* src = (const v4u*)(UX + (size_t)lru_pos_row(b, isctx, ppc) * 1024 + ch0); ua[w4] = src[0]; ub[w4] = src[1]; msk[w4] = ok ? 1.f : 0.f; }
#pragma unroll
        for (int w4 = 0; w4 < 4; ++w4) { const float* cw = a.in[I_CONVW] + w4 * 1024 + ch0;
            const unsigned uu[8] = {ua[w4].x, ua[w4].y, ua[w4].z, ua[w4].w, ub[w4].x, ub[w4].y, ub[w4].z, ub[w4].w};
#pragma unroll
            for (int q = 0; q < 4; ++q) { const f32x4 cv = *(const f32x4*)(cw + 4 * q) * msk[w4]; z[4 * q] += cv.x * bflo(uu[2 * q]); z[4 * q + 1] += cv.y * bfhi(uu[2 * q]); z[4 * q + 2] += cv.z * bflo(uu[2 * q + 1]); z[4 * q + 3] += cv.w * bfhi(uu[2 * q + 1]); } }
#pragma unroll
        for (int q = 0; q < 4; ++q) *(f32x4*)(zf + pos * 132 + cg * 16 + 4 * q) = (f32x4){z[4 * q], z[4 * q + 1], z[4 * q + 2], z[4 * q + 3]};
        v4u o0, o1; o0.x = pk2(z[0], z[1]); o0.y = pk2(z[2], z[3]); o0.z = pk2(z[4], z[5]); o0.w = pk2(z[6], z[7]); o1.x = pk2(z[8], z[9]); o1.y = pk2(z[10], z[11]); o1.z = pk2(z[12], z[13]); o1.w = pk2(z[14], z[15]);
        *(v4u*)(zb + pos * 136 + cg * 16) = o0; *(v4u*)(zb + pos * 136 + cg * 16 + 8) = o1;
    }
    WG_BAR();
    f32x4 acc[2][2][4];
#pragma unroll
    for (int d = 0; d < 2; ++d)
#pragma unroll
        for (int m = 0; m < 2; ++m)
#pragma unroll
            for (int mt = 0; mt < 4; ++mt) acc[d][m][mt] = (f32x4){0.f, 0.f, 0.f, 0.f};
#pragma unroll
    for (int ks = 0; ks < 4; ++ks) {
        bf16x8_t af[4];
#pragma unroll
        for (int mt = 0; mt < 4; ++mt) af[mt] = *(const bf16x8_t*)(zb + (16 * mt + fr) * 136 + 32 * ks + 8 * fq);
#pragma unroll
        for (int d = 0; d < 2; ++d)
#pragma unroll
            for (int m = 0; m < 2; ++m) {
#pragma unroll
                for (int mt = 0; mt < 4; ++mt) acc[d][m][mt] = __builtin_amdgcn_mfma_f32_16x16x32_bf16(af[mt], wl[d][m][ks], acc[d][m][mt], 0, 0, 0); }
    }
    const int chl = 16 * w + fr, ch = blk * 128 + chl;
    float hsum[4][4];
#pragma unroll
    for (int d = 0; d < 2; ++d) {
        const float ba = gba[d], bx = gbx[d], lam = glam[d];
        const float sp = (-lam > 20.f) ? -lam : log1pf(__expf(-lam));
        float av[4][4], bv[4][4];
#pragma unroll
        for (int mt = 0; mt < 4; ++mt)
#pragma unroll
            for (int r = 0; r < 4; ++r) { const float rr = sigmoidf_(acc[d][0][mt][r] + ba), ii = sigmoidf_(acc[d][1][mt][r] + bx);
                const float aa = __expf(-8.f * rr * sp); av[mt][r] = aa; bv[mt][r] = __builtin_amdgcn_sqrtf(fmaxf(1.f - aa * aa, 0.f)) * ii * zf[(16 * mt + 4 * fq + r) * 132 + chl]; }
        float Pe[4], Se[4], Pt[4], St[4];
#pragma unroll
        for (int mt = 0; mt < 4; ++mt) {
            float P = 1.f, S = 0.f;
#pragma unroll
            for (int rr = 0; rr < 4; ++rr) { const int r = d ? 3 - rr : rr; S = av[mt][r] * S + bv[mt][r]; P = av[mt][r] * P; }
            if (d == 0) {
                float p1 = __shfl_up(P, 16), s1 = __shfl_up(S, 16); if (fq >= 1) { S = P * s1 + S; P = P * p1; }
                p1 = __shfl_up(P, 32); s1 = __shfl_up(S, 32); if (fq >= 2) { S = P * s1 + S; P = P * p1; }
                Pe[mt] = __shfl_up(P, 16); Se[mt] = __shfl_up(S, 16); if (fq == 0) { Pe[mt] = 1.f; Se[mt] = 0.f; }
                Pt[mt] = __shfl(P, fr + 48); St[mt] = __shfl(S, fr + 48);
            } else {
                float p1 = __shfl_down(P, 16), s1 = __shfl_down(S, 16); if (fq <= 2) { S = P * s1 + S; P = P * p1; }
                p1 = __shfl_down(P, 32); s1 = __shfl_down(S, 32); if (fq <= 1) { S = P * s1 + S; P = P * p1; }
                Pe[mt] = __shfl_down(P, 16); Se[mt] = __shfl_down(S, 16); if (fq == 3) { Pe[mt] = 1.f; Se[mt] = 0.f; }
                Pt[mt] = __shfl(P, fr); St[mt] = __shfl(S, fr);
            }
        }
        float2* AGG = (float2*)(a.ws + WS_AGG) + ((size_t)(b * 2 + d) * 36) * 1024 + ch;
        if (!FINAL) {
            if (cidx >= 4) {
                unsigned* PS = (unsigned*)(a.ws + WS_PS) + ((size_t)(b * 2 + d) * NSTEP + 64 * cidx) * 1024 + ch;
#pragma unroll
                for (int mt = 0; mt < 4; ++mt)
#pragma unroll
                    for (int r = 0; r < 4; ++r) PS[(size_t)(16 * mt + 4 * fq + r) * 1024] = pk2(1.f - av[mt][r], bv[mt][r]);
            }
            float Pc = 1.f, Sc = 0.f;
#pragma unroll
            for (int i = 0; i < 4; ++i) { const int mt = d ? 3 - i : i; Sc = Pt[mt] * Sc + St[mt]; Pc = Pt[mt] * Pc; }
            if (fq == 0) AGG[(size_t)cidx * 1024] = make_float2(Pc, Sc);
        } else {
            float h = 0.f;
#pragma unroll
            for (int g3 = 0; g3 < 6; ++g3) {
                float2 qv[6];
#pragma unroll
                for (int i = 0; i < 6; ++i) { const int sidx = 6 * g3 + i; const int c2 = d ? (sidx < 4 ? 3 - sidx : 39 - sidx) : sidx; qv[i] = AGG[(size_t)c2 * 1024]; }
#pragma unroll
                for (int i = 0; i < 6; ++i) { const int sidx = 6 * g3 + i; const int c2 = d ? (sidx < 4 ? 3 - sidx : 39 - sidx) : sidx;
                    const bool use = d ? (sidx < 4 || c2 > cidx) : (c2 < cidx);
                    h = use ? qv[i].x * h + qv[i].y : h; }
            }
#pragma unroll
            for (int i = 0; i < 4; ++i) { const int mt = d ? 3 - i : i;
                float hl = Pe[mt] * h + Se[mt];
#pragma unroll
                for (int rr = 0; rr < 4; ++rr) { const int r = d ? 3 - rr : rr; hl = av[mt][r] * hl + bv[mt][r]; if (d == 0) hsum[mt][r] = hl; else hsum[mt][r] += hl; }
                h = Pt[mt] * h + St[mt]; }
        }
    }
    if (FINAL) {
#pragma unroll
        for (int mt = 0; mt < 4; ++mt)
#pragma unroll
            for (int r = 0; r < 4; ++r) zf[(16 * mt + 4 * fq + r) * 132 + chl] = hsum[mt][r];
        WG_BAR();
        const int pos = tid >> 3, cg = tid & 7, ch0 = blk * 128 + cg * 16;
        const size_t lrow = (size_t)(lru_pos_row(b, false, p0 + pos) - NCTX) * 1024 + ch0;
        const v4u* ug = (const v4u*)((const bf16*)(a.ws + WS_UG) + lrow); const v4u g0 = ug[0], g1 = ug[1];
        const unsigned gg[8] = {g0.x, g0.y, g0.z, g0.w, g1.x, g1.y, g1.z, g1.w}; unsigned o[8];
#pragma unroll
        for (int q = 0; q < 4; ++q) { const f32x4 hv = *(const f32x4*)(zf + pos * 132 + cg * 16 + 4 * q);
            o[2 * q] = pk2(hv.x * bflo(gg[2 * q]), hv.y * bfhi(gg[2 * q])); o[2 * q + 1] = pk2(hv.z * bflo(gg[2 * q + 1]), hv.w * bfhi(gg[2 * q + 1])); }
        v4u* dst = (v4u*)((bf16*)(a.ws + WS_YB) + lrow); dst[0] = (v4u){o[0], o[1], o[2], o[3]}; dst[1] = (v4u){o[4], o[5], o[6], o[7]};
    }
    WG_BAR();
}
constexpr int ML_STRIDE = 136;
constexpr int ML_Q = 0, ML_K = 17408, ML_V = 34816, ML_AUG = 52224  , ML_CB = 54272  ;
constexpr int ML_EB = 93440  , ML_EU = 95488  , ML_EBEND = 97536  , ML_BEND = 97568  , ML_DEN = 97600  , ML_SSQ = 97856  ;
typedef short s4_t __attribute__((ext_vector_type(4)));
__device__ __forceinline__ s4_t ds_tr(const bf16* p) { return __builtin_amdgcn_ds_read_tr16_b64_v4i16((LAS s4_t*)p); }
__device__ __forceinline__ bf16x8_t frag_row(const bf16* img, int row0, int k0, int fr, int fq) { return *(const bf16x8_t*)(img + (row0 + fr) * ML_STRIDE + k0 + 8 * fq); }
__device__ __forceinline__ bf16x8_t frag_tr2(const bf16* img, int stride, int sA, int sB, int col0, int lane) {
    const int fq = lane >> 4, q = (lane & 15) >> 2, p = lane & 3;
    const s4_t lo = ds_tr(img + (sA + 4 * fq + q) * stride + col0 + 4 * p), hi = ds_tr(img + (sB + 4 * fq + q) * stride + col0 + 4 * p);
    return (bf16x8_t){lo.x, lo.y, lo.z, lo.w, hi.x, hi.y, hi.z, hi.w};
}
__device__ __forceinline__ bf16x8_t frag_tr(const bf16* img, int stride, int s0, int col0, int lane) {
    const int fq = lane >> 4, q = (lane & 15) >> 2, p = lane & 3;
    const bf16* b = img + (s0 + 8 * fq + q) * stride + col0 + 4 * p;
    const s4_t lo = ds_tr(b), hi = ds_tr(b + 4 * stride);
    return (bf16x8_t){lo.x, lo.y, lo.z, lo.w, hi.x, hi.y, hi.z, hi.w};
}
__device__ __forceinline__ float logsigmoidf_(float x) { return fminf(x, 0.f) - log1pf(__expf(-fabsf(x))); }

__device__ __forceinline__ void ml_gates(const Args& a, unsigned char* lds_g, int rowbase, int h, int tid) {
    const int lane = tid & 63, w = tid >> 6, dir = w >> 2, c = w & 3;
    const float* GT = (const float*)(a.ws + WS_GATES) + (size_t)(rowbase + 64 * c + lane) * 32;
    const float ipre = GT[(dir * 2) * 8 + h], fpre = GT[(dir * 2 + 1) * 8 + h];
    float bsum = logsigmoidf_(fpre);
    if (dir == 0) {
#pragma unroll
        for (int o = 1; o < 64; o <<= 1) { const float t = __shfl_up(bsum, o); if (lane >= o) bsum += t; }
    } else {
#pragma unroll
        for (int o = 1; o < 64; o <<= 1) { const float t = __shfl_down(bsum, o); if (lane + o < 64) bsum += t; }
    }
    float* eb = (float*)(lds_g + ML_EB); float* eu = (float*)(lds_g + ML_EU);
    eb[dir * 256 + 64 * c + lane] = __expf(bsum); eu[dir * 256 + 64 * c + lane] = __expf(ipre - bsum);
    const float bend = __shfl(bsum, dir ? 0 : 63);
    if (lane == 0) { ((float*)(lds_g + ML_EBEND))[dir * 4 + c] = __expf(bend); ((float*)(lds_g + ML_BEND))[dir * 4 + c] = bend; }
}

template <bool OUT, bool PASS2>
__device__ __forceinline__ void ml_block(const Args& a, unsigned char* lds_g, int rowbase, int h, int dir, f32x4 (&st)[9], int tid) {
    const int lane = tid & 63, w = __builtin_amdgcn_readfirstlane(tid >> 6), fr = lane & 15, fq = lane >> 4;
    bf16* Qi = (bf16*)(lds_g + ML_Q); bf16* Ki = (bf16*)(lds_g + ML_K); bf16* Vi = (bf16*)(lds_g + ML_V); bf16* AUGi = (bf16*)(lds_g + ML_AUG); bf16* CB = (bf16*)(lds_g + ML_CB);
    const float* eb = (const float*)(lds_g + ML_EB) + dir * 256; const float* eu = (const float*)(lds_g + ML_EU) + dir * 256;
    const float* ebend = (const float*)(lds_g + ML_EBEND) + dir * 4;
    float* den = (float*)(lds_g + ML_DEN); float* ssq = (float*)(lds_g + ML_SSQ);
    const bf16* Kb = (const bf16*)(a.ws + WS_K); const bf16* Vb = (const bf16*)(a.ws + WS_V); const bf16* Qb = (const bf16*)(a.ws + WS_Q);
    const int ti = w & 3, vh = w >> 2;
    float hgv[5];
    if (OUT) {
#pragma unroll
        for (int x = 0; x < 5; ++x) { const int vt = vh * 5 + x; hgv[x] = vt < 8 ? a.in[I_HEADG][h * 128 + 16 * vt + fr] : 0.f; } }
    for (int ci = 0; ci < 4; ++ci) {
        const int c = dir ? 3 - ci : ci;
        unsigned short ogv[5][4]; float tmv[5][4];
        if (OUT) {
            const bf16* OGp = (const bf16*)(a.ws + (dir ? WS_OB : WS_OF)); const float* TMp = (const float*)(a.ws + WS_TM);
#pragma unroll
            for (int r = 0; r < 4; ++r) { const size_t ob = (size_t)(rowbase - NCTX + 64 * c + 16 * ti + 4 * fq + r) * 1024 + h * 128;
#pragma unroll
                for (int x = 0; x < 5; ++x) { const int vt = vh * 5 + x; if (vt < 8) { ogv[x][r] = OGp[ob + 16 * vt + fr]; if (PASS2) tmv[x][r] = TMp[ob + 16 * vt + fr]; } } }
            __builtin_amdgcn_sched_barrier(0);
        }
        {
            const int t = tid >> 3, pc = tid & 7; const size_t row = (size_t)(rowbase + 64 * c + t);
            const v4u* ks = (const v4u*)(Kb + row * 1024 + h * 128 + 16 * pc); const v4u k0 = ks[0], k1 = ks[1];
            const v4u* vs = (const v4u*)(Vb + row * 1024 + h * 128 + 16 * pc); const v4u v0 = vs[0], v1 = vs[1];
            v4u q0, q1; if (OUT) { const v4u* qs = (const v4u*)(Qb + (row - NCTX) * 1024 + h * 128 + 16 * pc); q0 = qs[0]; q1 = qs[1]; }
            const float e = eu[64 * c + t];
            *(v4u*)(Ki + t * ML_STRIDE + 16 * pc) = k0; *(v4u*)(Ki + t * ML_STRIDE + 16 * pc + 8) = k1;
            if (OUT) { *(v4u*)(Qi + t * ML_STRIDE + 16 * pc) = q0; *(v4u*)(Qi + t * ML_STRIDE + 16 * pc + 8) = q1; }
            const unsigned vv[8] = {v0.x, v0.y, v0.z, v0.w, v1.x, v1.y, v1.z, v1.w}; unsigned o[8];
#pragma unroll
            for (int i = 0; i < 8; ++i) o[i] = pk2(bflo(vv[i]) * e, bfhi(vv[i]) * e);
            *(v4u*)(Vi + t * ML_STRIDE + 16 * pc) = (v4u){o[0], o[1], o[2], o[3]}; *(v4u*)(Vi + t * ML_STRIDE + 16 * pc + 8) = (v4u){o[4], o[5], o[6], o[7]};
            if (pc == 0) { *(v4u*)(AUGi + t * 16) = (v4u){f2bf(e), 0u, 0u, 0u}; *(v4u*)(AUGi + t * 16 + 8) = (v4u){0u, 0u, 0u, 0u}; }
        }
        WG_BAR();
        f32x4 X[5]; float hval[4][4];
        if (OUT) {
            bf16x8_t qf[4];
#pragma unroll
            for (int ks = 0; ks < 4; ++ks) qf[ks] = frag_row(Qi, 16 * ti, 32 * ks, fr, fq);
            bf16x8_t P[2]; bool pv[2];
#pragma unroll
            for (int pp = 0; pp < 2; ++pp) {
                f32x4 d[2];
#pragma unroll
                for (int hh = 0; hh < 2; ++hh) { const int si = 2 * pp + hh; d[hh] = (f32x4){0.f, 0.f, 0.f, 0.f};
                    const bool valid = dir ? (si >= ti) : (si <= ti);
                    if (valid) {
#pragma unroll
                        for (int ks = 0; ks < 4; ++ks) d[hh] = __builtin_amdgcn_mfma_f32_16x16x32_bf16(frag_row(Ki, 16 * si, 32 * ks, fr, fq), qf[ks], d[hh], 0, 0, 0);
                        if (si == ti) {
#pragma unroll
                            for (int r = 0; r < 4; ++r) { const bool keep = dir ? (4 * fq + r >= fr) : (4 * fq + r <= fr); d[hh][r] = keep ? d[hh][r] : 0.f; } } } }
                pv[pp] = dir ? (2 * pp + 1 >= ti) : (2 * pp <= ti);
                const unsigned p0 = pk2(d[0][0], d[0][1]), p1 = pk2(d[0][2], d[0][3]), p2 = pk2(d[1][0], d[1][1]), p3 = pk2(d[1][2], d[1][3]);
                P[pp] = __builtin_bit_cast(bf16x8_t, (v4u){p0, p1, p2, p3});
            }
#pragma unroll
            for (int x = 0; x < 5; ++x) { X[x] = (f32x4){0.f, 0.f, 0.f, 0.f};
                const int vt = vh * 5 + x;
                if (vt < 9) {
#pragma unroll
                    for (int pp = 0; pp < 2; ++pp) if (pv[pp]) {
                        const bf16x8_t bfv = vt < 8 ? frag_tr2(Vi, ML_STRIDE, 32 * pp, 32 * pp + 16, 16 * vt, lane) : frag_tr2(AUGi, 16, 32 * pp, 32 * pp + 16, 0, lane);
                        X[x] = __builtin_amdgcn_mfma_f32_16x16x32_bf16(P[pp], bfv, X[x], 0, 0, 0); }
#pragma unroll
                    for (int ks = 0; ks < 4; ++ks) X[x] = __builtin_amdgcn_mfma_f32_16x16x32_bf16(qf[ks], frag_row(CB, 16 * vt, 32 * ks, fr, fq), X[x], 0, 0, 0);
                } }
            if (vh == 1 && fr == 0) {
#pragma unroll
                for (int r = 0; r < 4; ++r) den[16 * ti + 4 * fq + r] = X[3][r] * eb[64 * c + 16 * ti + 4 * fq + r]; }
        }
        {
#pragma unroll
            for (int ks = 0; ks < 2; ++ks) { const bf16x8_t kf = frag_tr(Ki, ML_STRIDE, 32 * ks, 16 * w, lane);
#pragma unroll
                for (int vt = 0; vt < 8; ++vt) st[vt] = __builtin_amdgcn_mfma_f32_16x16x32_bf16(kf, frag_tr(Vi, ML_STRIDE, 32 * ks, 16 * vt, lane), st[vt], 0, 0, 0);
                st[8] = __builtin_amdgcn_mfma_f32_16x16x32_bf16(kf, frag_tr(AUGi, 16, 32 * ks, 0, lane), st[8], 0, 0, 0); }
            const float ee = ebend[c];
#pragma unroll
            for (int vt = 0; vt < 9; ++vt) st[vt] = st[vt] * ee;
        }
        WG_BAR();
        if (OUT) {
            float sq[4] = {0.f, 0.f, 0.f, 0.f};
#pragma unroll
            for (int r = 0; r < 4; ++r) { const int t = 16 * ti + 4 * fq + r; const float sc = eb[64 * c + t] * __builtin_amdgcn_rcpf(fmaxf(fabsf(den[t]), 1.f));
#pragma unroll
                for (int x = 0; x < 4; ++x) { const int vt = vh * 5 + x; const float hv = (vt < 8) ? X[x][r] * sc : 0.f; hval[x][r] = hv; sq[r] += hv * hv; }
                if (vh == 0) { const float hv = X[4][r] * sc; X[4][r] = hv; sq[r] += hv * hv; } }
#pragma unroll
            for (int r = 0; r < 4; ++r) { float v = sq[r]; v += __shfl_xor(v, 1); v += __shfl_xor(v, 2); v += __shfl_xor(v, 4); v += __shfl_xor(v, 8); if (fr == 0) ssq[vh * 64 + 16 * ti + 4 * fq + r] = v; }
#pragma unroll
            for (int vt = 0; vt < 9; ++vt) { pg8::u32x2 o; o.x = pk2(st[vt][0], st[vt][1]); o.y = pk2(st[vt][2], st[vt][3]); *(pg8::u32x2*)(CB + (16 * vt + fr) * ML_STRIDE + 16 * w + 4 * fq) = o; }
            WG_BAR();
            float* TM = (float*)(a.ws + WS_TM); bf16* YA = (bf16*)(a.ws + WS_YA);
#pragma unroll
            for (int r = 0; r < 4; ++r) { const int t = 16 * ti + 4 * fq + r; const float rs = __builtin_amdgcn_rsqf((ssq[t] + ssq[64 + t]) * (1.f / 128.f) + EPS);
                const size_t ob = (size_t)(rowbase - NCTX + 64 * c + t) * 1024 + h * 128;
#pragma unroll
                for (int x = 0; x < 5; ++x) { const int vt = vh * 5 + x; if (vt < 8) { const int v = 16 * vt + fr; const float hv = (x < 4) ? hval[x][r] : X[4][r];
                    float y = hv * rs * hgv[x] * bf2f(ogv[x][r]);
                    if (PASS2) { y += tmv[x][r]; YA[ob + v] = (bf16)f2bf(y); } else TM[ob + v] = y; } } }
        }
    }
}

__device__ __forceinline__ void ml_state_quad(const Args& a, unsigned char* lds_g, int qu, int tid) {
    const int seq = qu >> 1, j0 = 4 * (qu & 1), dir = seq & 1, h = (seq >> 1) & 7, b = seq >> 4;
    const int lane = tid & 63, w = __builtin_amdgcn_readfirstlane(tid >> 6);
    f32x4 st[9];
#pragma unroll
    for (int vt = 0; vt < 9; ++vt) st[vt] = (f32x4){0.f, 0.f, 0.f, 0.f};
#pragma unroll 1
    for (int jj = 0; jj < 4; ++jj) {
        const int j = j0 + jj, su = seq * 8 + j;
        const int rowbase = j == 0 ? b * CTXL : NCTX + b * SEQ + 256 * (dir ? 8 - j : j - 1);
        ml_gates(a, lds_g, rowbase, h, tid);
        WG_BAR();
        ml_block<false, false>(a, lds_g, rowbase, h, dir, st, tid);
        f32x4* SL = (f32x4*)(a.ws + WS_SLOC) + ((size_t)(su * 8 + w) * 9) * 64 + lane;
#pragma unroll
        for (int vt = 0; vt < 9; ++vt) SL[vt * 64] = st[vt];
        if (tid == 0) { const float* bd = (const float*)(lds_g + ML_BEND) + dir * 4; ((float*)(a.ws + WS_BT))[su] = (bd[0] + bd[1]) + (bd[2] + bd[3]); }
        WG_BAR();
    }
}
__device__ __forceinline__ void ml_out_unit(const Args& a, unsigned char* lds_g, int u, int tid) {
    const int L = u & 7, h = (u >> 3) & 7, b = u >> 6;
    const int rowbase = NCTX + b * SEQ + 256 * L;
    const int lane = tid & 63, w = __builtin_amdgcn_readfirstlane(tid >> 6), fr = lane & 15, fq = lane >> 4;
    bf16* CB = (bf16*)(lds_g + ML_CB);
    ml_gates(a, lds_g, rowbase, h, tid);
    f32x4 st[9];
#pragma unroll
    for (int dir = 0; dir < 2; ++dir) {
        const int seq = (b * 8 + h) * 2 + dir, jmax = dir ? 7 - L : L;
        const float* BT = (const float*)(a.ws + WS_BT) + seq * 8;
        {
            const f32x4* SLa = (const f32x4*)(a.ws + WS_SLOC) + ((size_t)((seq * 8 + jmax) * 8 + w) * 9) * 64 + lane;
            const f32x4* SLb = (const f32x4*)(a.ws + WS_SLOC) + ((size_t)((seq * 8 + 3) * 8 + w) * 9) * 64 + lane;
            if (jmax >= 4) {
                f32x4 sb[9];
#pragma unroll
                for (int vt = 0; vt < 9; ++vt) { st[vt] = SLa[vt * 64]; sb[vt] = SLb[vt * 64]; }
                float ls = 0.f;
#pragma unroll
                for (int q = 4; q < 8; ++q) ls += (q <= jmax) ? BT[q] : 0.f;
                const float coef = __expf(ls);
#pragma unroll
                for (int vt = 0; vt < 9; ++vt) st[vt] += sb[vt] * coef;
            } else {
#pragma unroll
                for (int vt = 0; vt < 9; ++vt) st[vt] = SLa[vt * 64];
            }
        }
#pragma unroll
        for (int vt = 0; vt < 9; ++vt) { pg8::u32x2 o; o.x = pk2(st[vt][0], st[vt][1]); o.y = pk2(st[vt][2], st[vt][3]); *(pg8::u32x2*)(CB + (16 * vt + fr) * ML_STRIDE + 16 * w + 4 * fq) = o; }
        WG_BAR();
        if (dir == 0) ml_block<true, false>(a, lds_g, rowbase, h, 0, st, tid);
        else ml_block<true, true>(a, lds_g, rowbase, h, 1, st, tid);
        asm volatile("s_waitcnt vmcnt(0)" ::: "memory");
        WG_BAR();
    }
}

__device__ __forceinline__ void lru_out_unit(const Args& a, unsigned char* lds_g, int b, int cidx, int blk, int tid) {
    const int chl = tid & 127, q = tid >> 7, ch = blk * 128 + chl;
    float2* QA = (float2*)lds_g;
    float av[2][16], bv[2][16];
#pragma unroll
    for (int d = 0; d < 2; ++d) { const unsigned* PS = (const unsigned*)(a.ws + WS_PS) + ((size_t)(b * 2 + d) * NSTEP + 64 * cidx + 16 * q) * 1024 + ch;
#pragma unroll
        for (int i = 0; i < 16; ++i) { const unsigned wv = PS[(size_t)i * 1024]; av[d][i] = 1.f - bflo(wv); bv[d][i] = bfhi(wv); } }
    float2* CA = (float2*)(lds_g + 8192);
#pragma unroll
    for (int d = 0; d < 2; ++d) { const float2* AGG = (const float2*)(a.ws + WS_AGG) + ((size_t)(b * 2 + d) * 36) * 1024 + ch; float2 qv[9];
#pragma unroll
        for (int i = 0; i < 9; ++i) { const int sidx = 9 * q + i; const int c2 = d ? (sidx < 4 ? 3 - sidx : 39 - sidx) : sidx; qv[i] = AGG[(size_t)c2 * 1024]; }
        float P = 1.f, S = 0.f;
#pragma unroll
        for (int i = 0; i < 9; ++i) { const int sidx = 9 * q + i; const int c2 = d ? (sidx < 4 ? 3 - sidx : 39 - sidx) : sidx; const bool use = d ? (sidx < 4 || c2 > cidx) : (c2 < cidx);
            S = use ? qv[i].x * S + qv[i].y : S; P = use ? qv[i].x * P : P; }
        CA[(d * 4 + q) * 128 + chl] = make_float2(P, S); }
#pragma unroll
    for (int d = 0; d < 2; ++d) { float P = 1.f, S = 0.f;
#pragma unroll
        for (int ii = 0; ii < 16; ++ii) { const int i = d ? 15 - ii : ii; S = av[d][i] * S + bv[d][i]; P = av[d][i] * P; }
        QA[(d * 4 + q) * 128 + chl] = make_float2(P, S); }
    WG_BAR();
    float hs[16];
#pragma unroll
    for (int d = 0; d < 2; ++d) { float h = 0.f;
#pragma unroll
        for (int k = 0; k < 4; ++k) { const float2 t = CA[(d * 4 + k) * 128 + chl]; h = t.x * h + t.y; }
#pragma unroll
        for (int k = 0; k < 3; ++k) { const int qq = d ? 3 - k : k; const bool use = d ? (qq > q) : (qq < q); const float2 t = QA[(d * 4 + qq) * 128 + chl]; h = use ? t.x * h + t.y : h; }
#pragma unroll
        for (int ii = 0; ii < 16; ++ii) { const int i = d ? 15 - ii : ii; h = av[d][i] * h + bv[d][i]; if (d == 0) hs[i] = h; else hs[i] += h; } }
    const int p0 = (cidx - 4) * 64 + 16 * q;
    unsigned short ugv[16];
#pragma unroll
    for (int i = 0; i < 16; ++i) ugv[i] = ((const bf16*)(a.ws + WS_UG))[(size_t)(lru_pos_row(b, false, p0 + i) - NCTX) * 1024 + ch];
#pragma unroll
    for (int i = 0; i < 16; ++i) { const size_t lrow = (size_t)(lru_pos_row(b, false, p0 + i) - NCTX) * 1024 + ch;
        ((bf16*)(a.ws + WS_YB))[lrow] = (bf16)f2bf(hs[i] * bf2f(ugv[i])); }
    WG_BAR();
}
__device__ __forceinline__ void phase3(const Args& a, unsigned char* lds_g, int tid) {
    {
        int q0 = (int)blockIdx.x, qstep = (int)gridDim.x;
        if (gridDim.x == 256) q0 = blockIdx.x >= 128 ? (int)blockIdx.x - 128 : 128;
        for (int qu = q0; qu < 128; qu += qstep) ml_state_quad(a, lds_g, qu, tid);
    }
    for (int u = blockIdx.x; u < 4 * 36 * 8; u += gridDim.x) { const int blk = u & 7, q = u >> 3; lru_unit<false>(a, lds_g, q / 36, q % 36, blk, tid); }
}

struct SchedProj {
    int G, c; const char *YA, *YB, *WA, *WB;
    __device__ __forceinline__ bool next(int i, pg8::Unit& u) const {
        const int tile = (i >> 1) * G + c, part = i & 1; if (tile >= 256) return false;
        int pm, pn; pg8::tile_order(tile, 32, 8, pm, pn);
        u.pm = pm; u.pn = pn; u.aux = part; u.A = (part ? YB : YA) + (size_t)pm * 256 * 1024 * 2; u.B = (part ? WB : WA) + (size_t)pn * 256 * 1024 * 2; return true;
    }
};
struct EpiProj {
    static constexpr bool PERM = true;
    const bf16 *GA, *GB; bf16* PRE;
    __device__ __forceinline__ void operator()(const pg8::f32x4 (&acc)[2][2][4][2], const pg8::Unit& u, int wr, int wc, int fr, int fq) const {
        const bf16* gsrc = u.aux ? GB : GA;
#pragma unroll
        for (int ai = 0; ai < 2; ++ai) {
            pg8::u32x4 gw[4][2], pw[4][2];
#pragma unroll
            for (int m = 0; m < 4; ++m) { const size_t off = (size_t)(u.pm * 256 + ai * 128 + wr * 64 + m * 16 + fr) * 2048 + u.pn * 256 + wc * 32 + 8 * fq;
#pragma unroll
                for (int bj = 0; bj < 2; ++bj) { gw[m][bj] = *(const pg8::u32x4*)(gsrc + off + bj * 128); if (u.aux) pw[m][bj] = *(const pg8::u32x4*)(PRE + off + bj * 128); } }
#pragma unroll
            for (int m = 0; m < 4; ++m) { const size_t off = (size_t)(u.pm * 256 + ai * 128 + wr * 64 + m * 16 + fr) * 2048 + u.pn * 256 + wc * 32 + 8 * fq;
#pragma unroll
                for (int bj = 0; bj < 2; ++bj) { const pg8::u32x4 g4 = gw[m][bj];
                    pg8::f32x4 v0 = acc[ai][bj][m][0], v1 = acc[ai][bj][m][1];
                    v0[0] *= bflo(g4.x); v0[1] *= bfhi(g4.x); v0[2] *= bflo(g4.y); v0[3] *= bfhi(g4.y); v1[0] *= bflo(g4.z); v1[1] *= bfhi(g4.z); v1[2] *= bflo(g4.w); v1[3] *= bfhi(g4.w);
                    if (u.aux) { const pg8::u32x4 p4 = pw[m][bj];
                        v0[0] += bflo(p4.x); v0[1] += bfhi(p4.x); v0[2] += bflo(p4.y); v0[3] += bfhi(p4.y); v1[0] += bflo(p4.z); v1[1] += bfhi(p4.z); v1[2] += bflo(p4.w); v1[3] += bfhi(p4.w); }
                    pg8::u32x4 w; w.x = pg8::cvt_pk_bf16(v0[0], v0[1]); w.y = pg8::cvt_pk_bf16(v0[2], v0[3]); w.z = pg8::cvt_pk_bf16(v1[0], v1[1]); w.w = pg8::cvt_pk_bf16(v1[2], v1[3]);
                    *(pg8::u32x4*)(PRE + off + bj * 128) = w; } }
        }
    }
};

struct SchedOut {
    int G, c; const char *A, *B;
    __device__ __forceinline__ bool next(int i, pg8::Unit& u) const {
        const int L = i * G + c; if (L >= 256) return false;
        int pm, pn; pg8::tile_order(L, 32, 8, pm, pn);
        u.pm = pm; u.pn = pn; u.aux = 0; u.A = A + (size_t)pm * 256 * D * 2; u.B = B + (size_t)pn * 256 * D * 2; return true;
    }
};
struct EpiOut {
    static constexpr bool PERM = true;
    const float* x; const float* MOD; bf16* X1;
    __device__ __forceinline__ void operator()(const pg8::f32x4 (&acc)[2][2][4][2], const pg8::Unit& u, int wr, int wc, int fr, int fq) const {
        const int b = u.pm >> 3; const int col0 = u.pn * 256 + wc * 32 + 8 * fq;
        pg8::f32x4 g1[2][2];
#pragma unroll
        for (int bj = 0; bj < 2; ++bj)
#pragma unroll
            for (int n = 0; n < 2; ++n) g1[bj][n] = *(const pg8::f32x4*)(MOD + b * 12288 + 2 * 2048 + col0 + bj * 128 + n * 4);
#pragma unroll
        for (int ai = 0; ai < 2; ++ai) {
            pg8::f32x4 xv[4][2][2];
#pragma unroll
            for (int m = 0; m < 4; ++m) { const size_t off = (size_t)(u.pm * 256 + ai * 128 + wr * 64 + m * 16 + fr) * D + col0;
#pragma unroll
                for (int bj = 0; bj < 2; ++bj)
#pragma unroll
                    for (int n = 0; n < 2; ++n) xv[m][bj][n] = *(const pg8::f32x4*)(x + off + bj * 128 + n * 4); }
#pragma unroll
            for (int m = 0; m < 4; ++m) { const size_t off = (size_t)(u.pm * 256 + ai * 128 + wr * 64 + m * 16 + fr) * D + col0;
#pragma unroll
                for (int bj = 0; bj < 2; ++bj) { const pg8::f32x4 v0 = xv[m][bj][0] + g1[bj][0] * acc[ai][bj][m][0], v1 = xv[m][bj][1] + g1[bj][1] * acc[ai][bj][m][1];
                    pg8::u32x4 w; w.x = pg8::cvt_pk_bf16(v0[0], v0[1]); w.y = pg8::cvt_pk_bf16(v0[2], v0[3]); w.z = pg8::cvt_pk_bf16(v1[0], v1[1]); w.w = pg8::cvt_pk_bf16(v1[2], v1[3]);
                    *(pg8::u32x4*)(X1 + off + bj * 128) = w; } }
        }
    }
};

__device__ __forceinline__ void phase_router(const Args& a, unsigned char* lds_g, int tid, int lane, int wave) {
    const bf16* X1 = (const bf16*)(a.ws + WS_X1); const float* MOD = (const float*)(a.ws + WS_MOD); const float* g = a.in[I_N2G];
    const float* WR = (const float*)(a.ws + WS_WR); const float* RB = (const float*)(a.ws + WS_RB);
    bf16* H2 = (bf16*)(a.ws + WS_H2); unsigned* cnt = (unsigned*)(a.ws + WS_CTL) + CW_CNT; int4* ASG = (int4*)(a.ws + WS_ASG);
    f32x4* PART = (f32x4*)lds_g;
    float* SSQP = (float*)(lds_g + 24576);
    float* RS = (float*)(lds_g + 24576 + 512);
    float* LG = (float*)(lds_g + 24576 + 1024);
    const int slot = wave >> 2, kq = wave & 3, i = lane & 15, gq = lane >> 4;
    for (int tp = blockIdx.x; tp < NLAT / 32; tp += gridDim.x) {
        const int tok0 = 32 * tp + 16 * slot, b = tok0 >> 11, kbase = kq * 512 + 8 * gq;
        const bf16* xr = X1 + (size_t)(tok0 + i) * D + kbase;
        const float* wr = WR + ((size_t)(b * 48 + i) * 2048 + kbase);
        f32x4 acc0 = (f32x4){0.f, 0.f, 0.f, 0.f}, acc1 = acc0, acc2 = acc0; float sq = 0.f;
#pragma unroll 2
        for (int s8 = 0; s8 < 16; ++s8) {
            const v4u xb = *(const v4u*)(xr + 32 * s8);
            const f32x4 b0a = *(const f32x4*)(wr + 32 * s8), b0b = *(const f32x4*)(wr + 32 * s8 + 4), b1a = *(const f32x4*)(wr + 16 * 2048 + 32 * s8), b1b = *(const f32x4*)(wr + 16 * 2048 + 32 * s8 + 4),
                        b2a = *(const f32x4*)(wr + 32 * 2048 + 32 * s8), b2b = *(const f32x4*)(wr + 32 * 2048 + 32 * s8 + 4);
            const float xe[8] = {bflo(xb.x), bfhi(xb.x), bflo(xb.y), bfhi(xb.y), bflo(xb.z), bfhi(xb.z), bflo(xb.w), bfhi(xb.w)};
#pragma unroll
            for (int e = 0; e < 4; ++e) { acc0 = __builtin_amdgcn_mfma_f32_16x16x4f32(xe[e], b0a[e], acc0, 0, 0, 0); acc1 = __builtin_amdgcn_mfma_f32_16x16x4f32(xe[e], b1a[e], acc1, 0, 0, 0); acc2 = __builtin_amdgcn_mfma_f32_16x16x4f32(xe[e], b2a[e], acc2, 0, 0, 0); }
#pragma unroll
            for (int e = 0; e < 4; ++e) { acc0 = __builtin_amdgcn_mfma_f32_16x16x4f32(xe[4 + e], b0b[e], acc0, 0, 0, 0); acc1 = __builtin_amdgcn_mfma_f32_16x16x4f32(xe[4 + e], b1b[e], acc1, 0, 0, 0); acc2 = __builtin_amdgcn_mfma_f32_16x16x4f32(xe[4 + e], b2b[e], acc2, 0, 0, 0); }
#pragma unroll
            for (int e = 0; e < 8; ++e) sq += xe[e] * xe[e];
        }
        sq += __shfl_xor(sq, 16); sq += __shfl_xor(sq, 32);
        PART[((slot * 4 + kq) * 3 + 0) * 64 + lane] = acc0; PART[((slot * 4 + kq) * 3 + 1) * 64 + lane] = acc1; PART[((slot * 4 + kq) * 3 + 2) * 64 + lane] = acc2;
        if (gq == 0) SSQP[(slot * 4 + kq) * 16 + i] = sq;
        __syncthreads();
        if (kq == 0) {
            const float* sp = SSQP + slot * 64; const float rstd = 1.f / sqrtf(((sp[i] + sp[16 + i]) + (sp[32 + i] + sp[48 + i])) * (1.f / D) + EPS);
            if (gq == 0) RS[slot * 16 + i] = rstd;
#pragma unroll
            for (int cb = 0; cb < 3; ++cb) { const f32x4* pp = PART + (slot * 4 * 3 + cb) * 64 + lane; const f32x4 sum = (pp[0] + pp[3 * 64]) + (pp[6 * 64] + pp[9 * 64]);
                const float rb = RB[b * 48 + 16 * cb + i];
#pragma unroll
                for (int r = 0; r < 4; ++r) LG[(slot * 16 + 4 * gq + r) * 48 + 16 * cb + i] = __shfl(rstd, 4 * gq + r) * sum[r] + rb; }
            LDS_WAIT(); asm volatile("" ::: "memory");
            if (lane < 16) {
                const float* lg = LG + (slot * 16 + lane) * 48; const int t = tok0 + lane;
                int gs = 0; float gm = lg[32];
#pragma unroll
                for (int q = 1; q < 4; ++q) { const float v = lg[32 + q]; if (v > gm) { gm = v; gs = q; } }
                float se = 0.f;
#pragma unroll
                for (int q = 0; q < 4; ++q) se += __expf(lg[32 + q] - gm);
                const float pg = 1.f / se;
                int i0 = 0; float v0 = lg[gs * 8];
#pragma unroll
                for (int q = 1; q < 8; ++q) { const float v = lg[gs * 8 + q]; if (v > v0) { v0 = v; i0 = q; } }
                int i1 = -1; float v1 = -3.0e38f;
#pragma unroll
                for (int q = 0; q < 8; ++q) { const float v = lg[gs * 8 + q]; if (q != i0 && v > v1) { v1 = v; i1 = q; } }
                const float e1 = __expf(v1 - v0), w0 = pg / (1.f + e1), w1 = pg * e1 / (1.f + e1);
                const int ex0 = gs * 8 + i0, ex1 = gs * 8 + i1;
                const unsigned p0 = atomicAdd(cnt + ex0, 1u), p1 = atomicAdd(cnt + ex1, 1u);
                ASG[2 * t] = make_int4(ex0, (int)p0, __float_as_int(w0), 0); ASG[2 * t + 1] = make_int4(ex1, (int)p1, __float_as_int(w1), 0);
                int* LIST = (int*)(a.ws + WS_LIST); LIST[ex0 * 8192 + (int)p0] = t; LIST[ex1 * 8192 + (int)p1] = t;
            }
        }
        __syncthreads();
#pragma unroll
        for (int r = 0; r < 4; ++r) { const int tl = 4 * kq + r, t = tok0 + tl; const float rstd = RS[slot * 16 + tl];
            const unsigned long long* xrow = (const unsigned long long*)(X1 + (size_t)t * D) + lane; unsigned long long* o8 = (unsigned long long*)(H2 + (size_t)t * D) + lane;
            f32x4 yv[8];
#pragma unroll
            for (int j = 0; j < 8; ++j) { const int c = 4 * lane + 256 * j;
                const f32x4 gg = *(const f32x4*)(g + c), sh = *(const f32x4*)(MOD + b * 12288 + 3 * 2048 + c), sc = *(const f32x4*)(MOD + b * 12288 + 4 * 2048 + c);
                const unsigned long long xw = xrow[64 * j]; const f32x4 xv4 = (f32x4){bflo((unsigned)xw), bfhi((unsigned)xw), bflo((unsigned)(xw >> 32)), bfhi((unsigned)(xw >> 32))};
                yv[j] = xv4 * rstd * gg * (sc + 1.f) + sh; }
#pragma unroll
            for (int j = 0; j < 8; ++j) o8[64 * j] = (unsigned long long)pk2(yv[j].x, yv[j].y) | ((unsigned long long)pk2(yv[j].z, yv[j].w) << 32); }
        __syncthreads();
    }
}

constexpr int MG_A = 0, MG_ABYTES = 32768, MG_B = 65536, MG_BBYTES = 64 * 256  , MG_CUM = 141312  ;
__device__ __forceinline__ int mgb_off(int row, int ch) { return 256 * row + 16 * (ch ^ (((row & 3) << 2) | ((row >> 2) & 3))); }
__device__ __forceinline__ bf16x8_t mgb_frag(const unsigned char* img, int ks, int c, int lane) {
    const int g = lane >> 4, q = (lane & 15) >> 2, p = lane & 3;
    const s4_t lo = ds_tr((const bf16*)(img + mgb_off(32 * ks + 8 * g + q, 2 * c + (p >> 1)) + 8 * (p & 1)));
    const s4_t hi = ds_tr((const bf16*)(img + mgb_off(32 * ks + 8 * g + 4 + q, 2 * c + (p >> 1)) + 8 * (p & 1)));
    return (bf16x8_t){lo.x, lo.y, lo.z, lo.w, hi.x, hi.y, hi.z, hi.w};
}
__device__ __forceinline__ void moe_tables(const Args& a, unsigned char* lds_g, int tid) {
    int* cum = (int*)(lds_g + MG_CUM); const unsigned* ctl = (const unsigned*)(a.ws + WS_CTL);
    if (tid < NEXP) cum[128 + tid] = (int)ctl[CW_CNT + tid];
    if (tid == 0) { int c = 0; for (int e = 0; e < NEXP; ++e) { cum[e] = c; c += (int)((ctl[CW_CNT + e] + 255u) >> 8); } cum[NEXP] = c; }
    __syncthreads();
}
constexpr int MH_A = 0, MH_ABYTES = 32768, MH_B = 65536, MH_BROW = 528, MH_BBYTES = 64 * MH_BROW  ;
__device__ __forceinline__ int mhb_off(int row, int ch) { return MH_BROW * row + 16 * ch; }
__device__ __forceinline__ bf16x8_t mhb_frag(const unsigned char* img, int ks, int c, int lane) {
    const int g = lane >> 4, q = (lane & 15) >> 2, p = lane & 3;
    const s4_t lo = ds_tr((const bf16*)(img + mhb_off(32 * ks + 8 * g + q, 2 * c + (p >> 1)) + 8 * (p & 1)));
    const s4_t hi = ds_tr((const bf16*)(img + mhb_off(32 * ks + 8 * g + 4 + q, 2 * c + (p >> 1)) + 8 * (p & 1)));
    return (bf16x8_t){lo.x, lo.y, lo.z, lo.w, hi.x, hi.y, hi.z, hi.w};
}
__device__ __forceinline__ int moe_pull(const Args& a, unsigned char* lds_g, int tid, int x) {
    int* slot = (int*)(lds_g + MG_CUM + 256);
    __syncthreads();
    if (tid == 0) *slot = (int)__hip_atomic_fetch_add((unsigned*)(a.ws + WS_CTL) + CW_Q + 64 * x, 1u, __ATOMIC_RELAXED, __HIP_MEMORY_SCOPE_AGENT);
    __syncthreads();
    return *slot;
}
template <int MODE>
__device__ __forceinline__ int moe_gemm(const Args& a, unsigned char* lds_g, int tid, int idx0) {
    constexpr int K = MODE == 1 ? D : DE, NT = K / 64;
#define MG_BAR() do { asm volatile("s_waitcnt lgkmcnt(0)" ::: "memory"); __builtin_amdgcn_s_barrier(); asm volatile("" ::: "memory"); } while (0)
    const int lane = tid & 63, w = __builtin_amdgcn_readfirstlane(tid >> 6), fr = lane & 15, fq = lane >> 4;
    const int wm = w >> 1, wn = w & 1, hh = wm >> 1, wr = wm & 1;
    const int* cum = (const int*)(lds_g + MG_CUM); const unsigned* ctl = (const unsigned*)(a.ws + WS_CTL);
    const int T = cum[NEXP], x = blockIdx.x & 7;
    const int aoff = pg8::lds_byte(wr * 64 + fr, fq * 8);
    const int bk = tid >> 6, bp = tid & 63;
    int aR[2], aC[2];
#pragma unroll
    for (int i = 0; i < 2; ++i) pg8::stage_rc(tid * 16 + i * 8192, aR[i], aC[i]);
    for (int idx = idx0;;) {
        if (idx < 0) idx = moe_pull(a, lds_g, tid, x);
        if (idx >= (MODE == 1 ? T : 2 * T)) return idx;
        const int ti = MODE == 1 ? idx : idx - T;
        idx = -1;
        const int nt = x;
        if (MODE == 2) {
            if (tid < 64) { unsigned* tc = (unsigned*)(a.ws + WS_CTL) + CW_TC + 64 * ti; unsigned spins = 0;
                while ((unsigned)__builtin_amdgcn_readfirstlane(__hip_atomic_load(tc, __ATOMIC_RELAXED, __HIP_MEMORY_SCOPE_AGENT)) < 64u) {
                    __builtin_amdgcn_s_sleep(2);
                    if (++spins > (1u << 22)) { if (tid == 0) __hip_atomic_store((unsigned*)(a.ws + WS_CTL) + 1, 0x900u + (unsigned)ti, __ATOMIC_RELAXED, __HIP_MEMORY_SCOPE_AGENT); break; } }
                __builtin_amdgcn_fence(__ATOMIC_ACQUIRE, "agent");
                asm volatile("s_waitcnt vmcnt(0)" ::: "memory"); }
            __syncthreads();
        }
        int e = 0;
#pragma unroll 1
        for (int q = 1; q < NEXP; ++q) e = (cum[q] <= ti) ? q : e;
        const int mt = ti - cum[e];
        const char* abase; unsigned aofs[4]; const char* bbase; unsigned bofs; size_t bld;
        if (MODE == 1) { const int cnt = cum[128 + e];
#pragma unroll
            for (int q = 0; q < 4; ++q) { const int pos = 256 * mt + 128 * (q >> 1) + aR[q & 1]; const int tok = pos < cnt ? ((const int*)(a.ws + WS_LIST))[e * 8192 + pos] : 0;
                aofs[q] = (unsigned)(tok * D + aC[q & 1]) * 2u; }
            abase = (const char*)(a.ws + WS_H2);
            const int seg = bp >> 4, mat = seg & 1, col = 128 * nt + 64 * (seg >> 1) + 4 * (bp & 15);
            bbase = (const char*)(a.in[mat ? I_W3 : I_W1] + (size_t)e * D * DE); bofs = (unsigned)(bk * DE + col) * 4u; bld = DE; }
        else {
#pragma unroll
            for (int q = 0; q < 4; ++q) aofs[q] = (unsigned)((128 * (q >> 1) + aR[q & 1]) * DE + aC[q & 1]) * 2u;
            abase = (const char*)((const bf16*)(a.ws + WS_HM) + (size_t)256 * ti * DE);
            bbase = (const char*)(a.in[I_W2] + (size_t)e * DE * D); bofs = (unsigned)(bk * D + 256 * nt + 4 * bp) * 4u; bld = D; }
        const int bwr0 = mhb_off(bk, bp >> 1) + 8 * (bp & 1);
        f32x4 acc[4][8];
#pragma unroll
        for (int m = 0; m < 4; ++m)
#pragma unroll
            for (int n = 0; n < 8; ++n) acc[m][n] = (f32x4){0.f, 0.f, 0.f, 0.f};
        v4u ra[4]; f32x4 rb[8];
#define MH_LD(t_) do { _Pragma("unroll") for (int j_ = 0; j_ < 4; ++j_) ra[j_] = *(const v4u*)(abase + aofs[j_] + 128 * (t_)); \
        _Pragma("unroll") for (int j_ = 0; j_ < 8; ++j_) rb[j_] = *(const f32x4*)(bbase + bofs + (size_t)(64 * (t_) + 8 * j_) * bld * 4); } while (0)
#define MH_ST(buf_) do { _Pragma("unroll") for (int j_ = 0; j_ < 4; ++j_) *(v4u*)(lds_g + MH_A + (buf_) * MH_ABYTES + (j_ >> 1) * 16384 + (j_ & 1) * 8192 + tid * 16) = ra[j_]; \
        _Pragma("unroll") for (int j_ = 0; j_ < 8; ++j_) { pg8::u32x2 o_; o_.x = pk2(rb[j_].x, rb[j_].y); o_.y = pk2(rb[j_].z, rb[j_].w); *(pg8::u32x2*)(lds_g + MH_B + (buf_) * MH_BBYTES + bwr0 + j_ * 8 * MH_BROW) = o_; } } while (0)
#define MH_MMA(buf_) do { const unsigned char* Bi_ = lds_g + MH_B + (buf_) * MH_BBYTES; \
        _Pragma("unroll") for (int ks_ = 0; ks_ < 2; ++ks_) { bf16x8_t af_[4]; \
            _Pragma("unroll") for (int m_ = 0; m_ < 4; ++m_) af_[m_] = *(const bf16x8_t*)(lds_g + MH_A + (buf_) * MH_ABYTES + hh * 16384 + aoff + m_ * 2048 + ks_ * 1024); \
            _Pragma("unroll") for (int n_ = 0; n_ < 8; n_ += 2) { const bf16x8_t bf0_ = mhb_frag(Bi_, ks_, 8 * wn + n_, lane), bf1_ = mhb_frag(Bi_, ks_, 8 * wn + n_ + 1, lane); \
                _Pragma("unroll") for (int m_ = 0; m_ < 4; ++m_) { acc[m_][n_] = __builtin_amdgcn_mfma_f32_16x16x32_bf16(bf0_, af_[m_], acc[m_][n_], 0, 0, 0); \
                    acc[m_][n_ + 1] = __builtin_amdgcn_mfma_f32_16x16x32_bf16(bf1_, af_[m_], acc[m_][n_ + 1], 0, 0, 0); } \
                __builtin_amdgcn_sched_barrier(0); } } } while (0)
        MH_LD(0);
        MG_BAR();
        MH_ST(0);
        MH_LD(1);
        for (int t = 0; t < NT; t += 2) {
            const int t2 = (t + 2 < NT) ? t + 2 : NT - 1, t3 = (t + 3 < NT) ? t + 3 : NT - 1;
            MG_BAR();
            MH_ST(1);
            MH_LD(t2);
            MH_MMA(0);
            MG_BAR();
            MH_ST(0);
            MH_LD(t3);
            MH_MMA(1);
        }
#undef MH_LD
#undef MH_ST
#undef MH_MMA
        const size_t row0 = (size_t)256 * ti + 128 * hh + 64 * wr + fr;
        if (MODE == 1) { bf16* HM = (bf16*)(a.ws + WS_HM);
#pragma unroll
            for (int m = 0; m < 4; ++m)
#pragma unroll
                for (int n = 0; n < 4; ++n) { float hv[4];
#pragma unroll
                    for (int r = 0; r < 4; ++r) { const float a1 = acc[m][n][r]; hv[r] = a1 * sigmoidf_(a1) * acc[m][n + 4][r]; }
                    const unsigned long long o = (unsigned long long)pk2(hv[0], hv[1]) | ((unsigned long long)pk2(hv[2], hv[3]) << 32);
                    __hip_atomic_store((unsigned long long*)(HM + (row0 + 16 * m) * DE + 128 * nt + 64 * wn + 16 * n + 4 * fq), o, __ATOMIC_RELAXED, __HIP_MEMORY_SCOPE_AGENT); }
            asm volatile("s_waitcnt vmcnt(0)" ::: "memory");
            if (lane == 0) __hip_atomic_fetch_add((unsigned*)(a.ws + WS_CTL) + CW_TC + 64 * ti, 1u, __ATOMIC_RELAXED, __HIP_MEMORY_SCOPE_AGENT); }
        else { bf16* Y2 = (bf16*)(a.ws + WS_Y2);
#pragma unroll
            for (int m = 0; m < 4; ++m)
#pragma unroll
                for (int n = 0; n < 8; ++n) { pg8::u32x2 o; o.x = pk2(acc[m][n][0], acc[m][n][1]); o.y = pk2(acc[m][n][2], acc[m][n][3]);
                    *(pg8::u32x2*)(Y2 + (row0 + 16 * m) * D + 256 * nt + 128 * wn + 16 * n + 4 * fq) = o; } }
    }
#undef MG_BAR
}

__device__ __forceinline__ void phase12(const Args& a, unsigned char* lds_g, int lane, int wave) {
    const int gw = blockIdx.x * NWAVES + wave, NGW = gridDim.x * NWAVES;
    const int* cum = (const int*)(lds_g + MG_CUM);
    const bf16* X1 = (const bf16*)(a.ws + WS_X1); const float* MOD = (const float*)(a.ws + WS_MOD); const float* fg = a.in[I_FG];
    const int4* ASG = (const int4*)(a.ws + WS_ASG); const bf16* Y2 = (const bf16*)(a.ws + WS_Y2);
    for (int t = gw; t < NLAT; t += NGW) {
        const int b = t >> 11; const int4 q0 = ASG[2 * t], q1 = ASG[2 * t + 1];
        const float w0 = __int_as_float(q0.z), w1 = __int_as_float(q1.z);
        const unsigned long long* xr = (const unsigned long long*)(X1 + (size_t)t * D) + lane;
        const unsigned long long* y0 = (const unsigned long long*)(Y2 + (size_t)(256 * cum[q0.x] + q0.y) * D) + lane; const unsigned long long* y1 = (const unsigned long long*)(Y2 + (size_t)(256 * cum[q1.x] + q1.y) * D) + lane;
        f32x4 v[8]; float s = 0.f;
#pragma unroll
        for (int j = 0; j < 8; ++j) {
            const int c = 4 * lane + 256 * j;
            const f32x4 g2 = *(const f32x4*)(MOD + b * 12288 + 5 * 2048 + c);
            const unsigned long long a0 = y0[64 * j], a1 = y1[64 * j];
            f32x4 y; y.x = w0 * bflo((unsigned)a0) + w1 * bflo((unsigned)a1); y.y = w0 * bfhi((unsigned)a0) + w1 * bfhi((unsigned)a1);
            y.z = w0 * bflo((unsigned)(a0 >> 32)) + w1 * bflo((unsigned)(a1 >> 32)); y.w = w0 * bfhi((unsigned)(a0 >> 32)) + w1 * bfhi((unsigned)(a1 >> 32));
            const unsigned long long xw = xr[64 * j];
            v[j] = (f32x4){bflo((unsigned)xw), bfhi((unsigned)xw), bflo((unsigned)(xw >> 32)), bfhi((unsigned)(xw >> 32))} + g2 * y;
            s += (v[j].x * v[j].x + v[j].y * v[j].y) + (v[j].z * v[j].z + v[j].w * v[j].w);
        }
        const float rstd = 1.f / sqrtf(wave_sum(s) * (1.f / D) + EPS);
        f32x4* o = (f32x4*)(a.out + (size_t)t * D) + lane; f32x4 fgv[8];
#pragma unroll
        for (int j = 0; j < 8; ++j) fgv[j] = *(const f32x4*)(fg + 4 * lane + 256 * j);
#pragma unroll
        for (int j = 0; j < 8; ++j) o[64 * j] = v[j] * rstd * fgv[j];
    }
}

__global__ void __launch_bounds__(NTHR, 2) fwd_kernel(Args args) {
    extern __shared__ __attribute__((aligned(16))) unsigned char lds[];
    LAS unsigned char* ldsl = (LAS unsigned char*)lds;
    volatile LAS unsigned* MISC = (volatile LAS unsigned*)(ldsl + MISC_OFF);
    LAS unsigned* TL = (LAS unsigned*)(ldsl + LDSCTL_OFF);
    const int wave_s = __builtin_amdgcn_readfirstlane(threadIdx.x >> 6);
#define TID() make_tid(wave_s)
    { const int t0 = TID(); for (int u = t0; u < (LDS_BYTES - LDSCTL_OFF) / 4; u += NTHR) ((LAS unsigned*)(ldsl + LDSCTL_OFF))[u] = 0u; }
    __syncthreads();
    unsigned char* ws = args.ws;
    unsigned* ctl = (unsigned*)(ws + WS_CTL);
    XcdBarrier bar; bar.bar = ctl + CW_BAR; bar.x = 0; bar.st = nullptr;
    const bool one_launch = (args.ph_hi - args.ph_lo) > 1;
    if (one_launch) bar = xcd_barrier_post(ctl + CW_BAR, MISC + 8, TID());
    const int lo = args.ph_lo, hi = args.ph_hi;
#define IN(k) (lo <= (k) && (k) < hi)
#define SEAM(k) do { if (IN(k) && IN((k) + 1)) xcd_barrier(bar, TID()); } while (0)
    const int G = gridDim.x, c = blockIdx.x;

#define FRESH() const int tid = TID(), lane = tid & 63, wave = __builtin_amdgcn_readfirstlane(tid >> 6); (void)lane; (void)wave
#ifndef DUP_PHASE
#define DUP_PHASE (-1)
#endif
#define PH(k, ...) if (IN(k)) { _Pragma("unroll") for (int rep_ = 0; rep_ < ((DUP_PHASE) == (k) ? 2 : 1); ++rep_) { if (rep_) xcd_barrier(bar, TID()); __VA_ARGS__ } } SEAM(k);
    PH(0, { FRESH(); phase0(args, lds, tid, lane, wave); mod_wait(args, tid); phase1(args, lane, wave); })
    PH(1, {
        SchedIn S{G, c, (const char*)(ws + WS_H), (const char*)(ws + WS_WIN)}; EpiIn E{ws, args.in[I_BGATES]};
        pg8::gemm_phase<EpiIn, SchedIn>(ldsl, D, S, E, TID());
        { const int R_ = (1492 + G - 1) / G; int fi_ = 1492 - (R_ - 1) * G; if (fi_ >= G) fi_ = 0;
          if (c >= fi_) { FRESH(); late_prep(args, lds, (c - fi_) * NWAVES + wave, (G - fi_) * NWAVES, lane, wave); } } })
    PH(2, { FRESH(); phase3(args, lds, tid); })
    PH(3, { FRESH();
        for (int u = c; u < 256; u += G) ml_out_unit(args, lds, u, tid);
        for (int u = c; u < 4 * 32 * 8; u += G) { const int blk = u & 7, q = u >> 3; lru_out_unit(args, lds, q >> 5, 4 + (q & 31), blk, tid); } })
    PH(4, {
        SchedProj S{G, c, (const char*)(ws + WS_YA), (const char*)(ws + WS_YB), (const char*)(ws + WS_WPA), (const char*)(ws + WS_WPB)};
        EpiProj E{(const bf16*)(ws + WS_GA), (const bf16*)(ws + WS_GB), (bf16*)(ws + WS_PRE)};
        pg8::gemm_phase<EpiProj, SchedProj>(ldsl, 1024, S, E, TID()); })
    PH(5, {
        SchedOut S{G, c, (const char*)(ws + WS_PRE), (const char*)(ws + WS_WOUT)}; EpiOut E{args.in[I_X], (const float*)(ws + WS_MOD), (bf16*)(ws + WS_X1)};
        pg8::gemm_phase<EpiOut, SchedOut>(ldsl, D, S, E, TID()); })
    PH(6, { FRESH(); phase_router(args, lds, tid, lane, wave); })
    PH(7, { FRESH(); moe_tables(args, lds, tid); const int nx_ = moe_gemm<1>(args, lds, tid, -1); (void)moe_gemm<2>(args, lds, tid, nx_); })
    PH(8, { FRESH(); moe_tables(args, lds, tid); phase12(args, lds, lane, wave); })
#undef PH
#undef IN
#undef SEAM
}

extern "C" void kernel_launch(void* const* d_in, const int* in_sizes, int n_in, void* d_out, int out_size, void* d_ws, size_t ws_size, hipStream_t stream) {
    static int grid = 0;
    if (grid == 0) {
        if (n_in != 27 || out_size != NLAT * D || ws_size < WS_END) { fprintf(stderr, "kernel_launch: unexpected shapes (n_in %d, out %d, ws %zu)\n", n_in, out_size, ws_size); grid = -1; return; }
        int dev = 0, cus = 0, per_cu = 0;
        if (hipGetDevice(&dev) != hipSuccess || hipDeviceGetAttribute(&cus, hipDeviceAttributeMultiprocessorCount, dev) != hipSuccess) { grid = -1; return; }
        if (hipFuncSetAttribute((const void*)fwd_kernel, hipFuncAttributeMaxDynamicSharedMemorySize, LDS_BYTES) != hipSuccess) { fprintf(stderr, "kernel_launch: hipFuncSetAttribute failed\n"); grid = -1; return; }
        if (hipOccupancyMaxActiveBlocksPerMultiprocessor(&per_cu, (const void*)fwd_kernel, NTHR, LDS_BYTES) != hipSuccess || per_cu < 1) fprintf(stderr, "kernel_launch: occupancy query says %d\n", per_cu);
        (void)hipGetLastError();
        grid = cus;
    }
    if (grid < 0) return;
    (void)hipMemsetAsync((char*)d_ws + WS_CTL, 0, CTL_ZERO_BYTES, stream);
    Args a{};
    for (int i = 0; i < 27; ++i) a.in[i] = (const float*)d_in[i];
    a.out = (float*)d_out; a.ws = (unsigned char*)d_ws;
#if MK_ONE_LAUNCH
    a.ph_lo = 0; a.ph_hi = NPHASE;
    hipLaunchKernelGGL(fwd_kernel, dim3(grid), dim3(NTHR), LDS_BYTES, stream, a);
#else
    for (int p = 0; p < NPHASE; ++p) { a.ph_lo = p; a.ph_hi = p + 1; hipLaunchKernelGGL(fwd_kernel, dim3(grid), dim3(NTHR), LDS_BYTES, stream, a); }
#endif
}
```

```cpp
#include <hip/hip_runtime.h>
#include <cstdio>
#include <cstdint>

#ifndef MK_ONE_LAUNCH
#define MK_ONE_LAUNCH 1
#endif

namespace pg8 {
#define PG8_LAS __attribute__((address_space(3)))
typedef unsigned short bf16_t;
typedef short bf16x8 __attribute__((ext_vector_type(8)));
typedef float f32x4 __attribute__((ext_vector_type(4)));
typedef float f32x2 __attribute__((ext_vector_type(2)));
typedef unsigned u32x4 __attribute__((ext_vector_type(4)));
typedef unsigned u32x2 __attribute__((ext_vector_type(2)));
constexpr int BM = 256, BK = 64, HALF = 128, HTB = HALF * BK * 2  , STAGE_BYTES = 8 * HTB, NXCD = 8, WGM = 8;

__host__ __device__ __forceinline__ int lds_byte(int r, int c) { const int st = (r >> 4) * 2 + (c >> 5), rr = r & 15, cc = c & 31, ob = rr * 64 + cc * 2; return st * 1024 + (ob ^ (((ob >> 9) & 1) << 5)); }
__host__ __device__ __forceinline__ void stage_rc(int b, int& R, int& C) { const int st = b / 1024, sb = b % 1024, swz = sb ^ (((sb >> 9) & 1) << 5); R = (st >> 1) * 16 + swz / 64; C = (st & 1) * 32 + (swz % 64) / 2; }
__host__ __device__ __forceinline__ int perm32(int rho) { const int n = rho >> 4, i = rho & 15; return 8 * (i >> 2) + 4 * n + (i & 3); }

struct Unit { const char* A; const char* B; int pm, pn, aux; };

__host__ __device__ __forceinline__ void tile_order(int L, int nM, int nN, int& pm, int& pn) {
    const int nwg = nM * nN; int wgid = L;
    { const int q = nwg / NXCD, r = nwg % NXCD, xcd = wgid % NXCD, off = wgid / NXCD; wgid = (xcd < r ? xcd * (q + 1) : r * (q + 1) + (xcd - r) * q) + off; }
    const int nig = WGM * nN, gid = wgid / nig, fm = gid * WGM, gsz = (nM - fm) < WGM ? (nM - fm) : WGM;
    pm = fm + ((wgid % nig) % gsz); pn = (wgid % nig) / gsz;
}

typedef __bf16 bf16n2 __attribute__((ext_vector_type(2)));
__device__ __forceinline__ unsigned cvt_pk_bf16(float lo, float hi) { const f32x2 v = {lo, hi}; return __builtin_bit_cast(unsigned, __builtin_convertvector(v, bf16n2)); }

template <class Epi, class Sched>
__device__ __forceinline__ void gemm_phase(PG8_LAS unsigned char* lds, const int K, const Sched& S, const Epi& E, int tid) {
    const int wid = __builtin_amdgcn_readfirstlane(tid >> 6), lane = tid & 63, wr = wid >> 2, wc = wid & 3, fr = lane & 15, fq = lane >> 4;
    const int nt = K / BK;
    unsigned voffA[2], voffB[2];
#pragma unroll
    for (int i = 0; i < 2; ++i) { int R, C; stage_rc(tid * 16 + i * 8192, R, C); const int Rb = Epi::PERM ? ((R & ~31) + perm32(R & 31)) : R;
        voffA[i] = (unsigned)(R * K + C) * 2u; voffB[i] = (unsigned)(Rb * K + C) * 2u; }
    const size_t kstep = (size_t)(BK * 2);
    const size_t hstep = (size_t)HALF * K * 2;
    const unsigned ldsw = (unsigned)wid * 1024u;
    const int aoff = lds_byte(wr * 64 + fr, fq * 8), boff = lds_byte(wc * 32 + fr, fq * 8);
#define PG8_SA(b, h) (((b) * 2 + (h)) * HTB)
#define PG8_SB(b, h) ((4 + (b) * 2 + (h)) * HTB)
#define PG8_STAGE(bufoff, gbase, voff) do { _Pragma("unroll") for (int _i = 0; _i < 2; ++_i) \
        __builtin_amdgcn_global_load_lds((const unsigned*)((const char*)(gbase) + (voff)[_i]), (PG8_LAS unsigned*)(lds + (bufoff) + ldsw + _i * 8192), 16, 0, 0); } while (0)
#define PG8_LDA(dst, b, h) do { _Pragma("unroll") for (int m = 0; m < 4; ++m) _Pragma("unroll") for (int k = 0; k < 2; ++k) dst[m][k] = *(const PG8_LAS bf16x8*)(lds + PG8_SA(b, h) + aoff + m * 2048 + k * 1024); } while (0)
#define PG8_LDB(dst, b, h) do { _Pragma("unroll") for (int n = 0; n < 2; ++n) _Pragma("unroll") for (int k = 0; k < 2; ++k) dst[n][k] = *(const PG8_LAS bf16x8*)(lds + PG8_SB(b, h) + boff + n * 2048 + k * 1024); } while (0)
#define PG8_MMA(ai, bj, At, Bt) do { __builtin_amdgcn_s_setprio(1); _Pragma("unroll") for (int m = 0; m < 4; ++m) _Pragma("unroll") for (int n = 0; n < 2; ++n) _Pragma("unroll") for (int k = 0; k < 2; ++k) \
        acc[ai][bj][m][n] = __builtin_amdgcn_mfma_f32_16x16x32_bf16(Bt[n][k], At[m][k], acc[ai][bj][m][n], 0, 0, 0); __builtin_amdgcn_s_setprio(0); } while (0)
#define PG8_WAIT_V(n) asm volatile("s_waitcnt vmcnt(" #n ")" ::: "memory")
#define PG8_WAIT_L(n) asm volatile("s_waitcnt lgkmcnt(" #n ")" ::: "memory")
#define PG8_BAR __builtin_amdgcn_s_barrier()
#define PG8_SCHED __builtin_amdgcn_sched_barrier(0)
    Unit cur, nxt; int ui = 0;
    if (!S.next(0, cur)) return;
    f32x4 acc[2][2][4][2];
#pragma unroll
    for (int a = 0; a < 2; ++a)
#pragma unroll
        for (int b = 0; b < 2; ++b)
#pragma unroll
            for (int m = 0; m < 4; ++m)
#pragma unroll
                for (int n = 0; n < 2; ++n) acc[a][b][m][n] = (f32x4){0.f, 0.f, 0.f, 0.f};
    bf16x8 At[4][2], B0[2][2], B1[2][2];
    const char* cA = cur.A; const char* cB = cur.B;
    PG8_STAGE(PG8_SB(0, 0), cB, voffB); PG8_STAGE(PG8_SB(0, 1), cB + hstep, voffB); PG8_STAGE(PG8_SA(0, 0), cA, voffA); PG8_STAGE(PG8_SA(0, 1), cA + hstep, voffA);
    if (wr == 1) PG8_BAR;
    PG8_WAIT_V(2); PG8_BAR;
    PG8_STAGE(PG8_SB(1, 0), cB + kstep, voffB); PG8_STAGE(PG8_SA(1, 0), cA + kstep, voffA); PG8_STAGE(PG8_SB(1, 1), cB + hstep + kstep, voffB);
    PG8_WAIT_V(6); PG8_BAR;
    for (;;) {
        const bool has_next = S.next(ui + 1, nxt);
        const char* nA = has_next ? nxt.A : cA; const char* nB = has_next ? nxt.B : cB;
        for (int t = 0; t < nt; t += 2) {
            const bool last = (t == nt - 2);
            const char* a1 = cA + (size_t)(t + 1) * kstep;
            const char* a2 = last ? nA : cA + (size_t)(t + 2) * kstep; const char* b2 = last ? nB : cB + (size_t)(t + 2) * kstep;
            const char* a3 = a2 + kstep; const char* b3 = b2 + kstep;
            PG8_LDB(B0, 0, 0); PG8_LDB(B1, 0, 1); PG8_SCHED; PG8_LDA(At, 0, 0); PG8_STAGE(PG8_SA(1, 1), a1 + hstep, voffA);
            PG8_WAIT_V(8); PG8_WAIT_L(0); PG8_BAR; PG8_MMA(0, 0, At, B0); PG8_MMA(0, 1, At, B1); PG8_BAR; PG8_SCHED;
            PG8_LDA(At, 0, 1); PG8_STAGE(PG8_SB(0, 0), b2, voffB); PG8_STAGE(PG8_SB(0, 1), b2 + hstep, voffB); PG8_STAGE(PG8_SA(0, 0), a2, voffA);
            PG8_WAIT_V(8); PG8_WAIT_L(0); PG8_BAR; PG8_MMA(1, 0, At, B0); PG8_MMA(1, 1, At, B1); PG8_BAR; PG8_SCHED;
            PG8_LDB(B0, 1, 0); PG8_LDB(B1, 1, 1); PG8_SCHED; PG8_LDA(At, 1, 0); PG8_STAGE(PG8_SA(0, 1), a2 + hstep, voffA);
            PG8_WAIT_V(8); PG8_WAIT_L(0); PG8_BAR; PG8_MMA(0, 0, At, B0); PG8_MMA(0, 1, At, B1); PG8_BAR; PG8_SCHED;
            PG8_LDA(At, 1, 1); PG8_STAGE(PG8_SB(1, 0), b3, voffB); PG8_STAGE(PG8_SB(1, 1), b3 + hstep, voffB); PG8_STAGE(PG8_SA(1, 0), a3, voffA);
            PG8_WAIT_V(8); PG8_WAIT_L(0); PG8_BAR; PG8_MMA(1, 0, At, B0); PG8_MMA(1, 1, At, B1); PG8_BAR; PG8_SCHED;
        }
        if (wr == 0) PG8_BAR;
        { int fr_ = fr, fq_ = fq; asm volatile("" : "+v"(fr_), "+v"(fq_)); E(acc, cur, wr, wc, fr_, fq_); }
        if (!has_next) break;
#pragma unroll
        for (int a = 0; a < 2; ++a)
#pragma unroll
            for (int b = 0; b < 2; ++b)
#pragma unroll
                for (int m = 0; m < 4; ++m)
#pragma unroll
                    for (int n = 0; n < 2; ++n) acc[a][b][m][n] = (f32x4){0.f, 0.f, 0.f, 0.f};
        cur = nxt; cA = nA; cB = nB; ++ui;
        if (wr == 1) PG8_BAR;
    }
    PG8_WAIT_V(0);
    PG8_BAR;
#undef PG8_SA
#undef PG8_SB
#undef PG8_STAGE
#undef PG8_LDA
#undef PG8_LDB
#undef PG8_MMA
#undef PG8_WAIT_V
#undef PG8_WAIT_L
#undef PG8_BAR
#undef PG8_SCHED
}
}

constexpr int NWAVES = 8, NTHR = 512;
constexpr int D = 2048, NB = 4, SEQ = 2048, CTXL = 256, NCTX = NB * CTXL  , NLAT = NB * SEQ  , NTOK = NCTX + NLAT  ;
constexpr int NSTEP = CTXL + SEQ;
constexpr int HEADS = 8, HD = 128, MW = 1024, LW = 1024;
constexpr int NEXP = 32, DE = 1024;
constexpr int IN_DIM = 11296, NT_IN = 45;
constexpr float EPS = 1e-6f;
constexpr int MAXTILES = 96;
constexpr int NPHASE = 9;

constexpr size_t MiB = 1u << 20;
constexpr size_t WS_CTL = 0, CTL_ZERO_BYTES = 1 * MiB;
constexpr size_t WS_MOD = 1 * MiB;
constexpr size_t WS_GATES = 2 * MiB;
constexpr size_t WS_ASG = 4 * MiB + 512 * 1024;
constexpr size_t WS_LIST = 3 * MiB + 512 * 1024;
constexpr size_t WS_WR = 6 * MiB;
constexpr size_t WS_RB = 7 * MiB + 768 * 1024;
constexpr size_t WS_WL = 5 * MiB;
constexpr size_t WS_AGG = 978 * MiB;
constexpr size_t WS_WPA = 8 * MiB, WS_WPB = 12 * MiB, WS_WOUT = 16 * MiB, WS_WIN = 24 * MiB;
constexpr size_t WS_W13 = 72 * MiB, WS_W2 = 328 * MiB;
constexpr size_t WS_PS = 72 * MiB;
constexpr size_t WS_H = 456 * MiB;
constexpr size_t WS_K = 492 * MiB, WS_V = 510 * MiB, WS_UX = 528 * MiB;
constexpr size_t WS_Q = 546 * MiB, WS_OF = 562 * MiB, WS_OB = 578 * MiB, WS_UG = 594 * MiB;
constexpr size_t WS_GA = 610 * MiB, WS_GB = 642 * MiB;
constexpr size_t WS_LA = 674 * MiB, WS_LB = 746 * MiB;
constexpr size_t WS_HS = 818 * MiB, WS_TM = 882 * MiB;
constexpr size_t WS_YA = 946 * MiB, WS_YB = 962 * MiB;
constexpr size_t WS_BT = 982 * MiB;
constexpr size_t WS_SLOC = 984 * MiB;
constexpr size_t WS_END = 1022 * MiB;
constexpr size_t WS_PRE = WS_LA;
constexpr size_t WS_X1 = WS_LB;
constexpr size_t WS_H2 = WS_H;
constexpr size_t WS_XS = WS_K;
constexpr size_t WS_HM = 588 * MiB;
constexpr size_t WS_Y2 = WS_HS;
constexpr int CW_MODC = 32;
constexpr int CW_CNT = 64;
constexpr int CW_NT = 128;
constexpr int CW_TILE_E = 192;
constexpr int CW_BAR = 4096;
constexpr int CW_Q = 8192;
constexpr int CW_TC = 16384;

constexpr int RING_BYTES = 131072;
constexpr int LDSCTL_OFF = 143360;
constexpr int MISC_OFF = LDSCTL_OFF + 384;
constexpr int LDS_BYTES = 147456;

#define GAS __attribute__((address_space(1)))
#define LAS __attribute__((address_space(3)))
typedef unsigned short bf16;
typedef unsigned v4u __attribute__((ext_vector_type(4)));
typedef float f32x4 __attribute__((ext_vector_type(4)));
#define LDS_WAIT() asm volatile("s_waitcnt lgkmcnt(0)" ::: "memory")
#define WG_BAR() do { asm volatile("s_waitcnt lgkmcnt(0)" ::: "memory"); __builtin_amdgcn_s_barrier(); asm volatile("" ::: "memory"); } while (0)

__device__ __forceinline__ unsigned f2bf(float f) { unsigned u = __builtin_bit_cast(unsigned, f); return (u + 0x7fffu + ((u >> 16) & 1u)) >> 16; }
__device__ __forceinline__ unsigned pk2(float lo, float hi) { return pg8::cvt_pk_bf16(lo, hi); }
__device__ __forceinline__ float bf2f(unsigned h) { return __builtin_bit_cast(float, h << 16); }
__device__ __forceinline__ float bflo(unsigned w) { return __builtin_bit_cast(float, w << 16); }
__device__ __forceinline__ float bfhi(unsigned w) { return __builtin_bit_cast(float, w & 0xffff0000u); }
__device__ __forceinline__ float sigmoidf_(float x) { return __builtin_amdgcn_rcpf(1.f + __expf(-x)); }
__device__ __forceinline__ float gelu_tanh(float x) { const float u = 0.7978845608028654f * (x + 0.044715f * x * x * x); return x * __builtin_amdgcn_rcpf(1.f + __expf(-2.f * u)); }
__device__ __forceinline__ float wave_sum(float v) {
#pragma unroll
    for (int o = 1; o < 64; o <<= 1) v += __shfl_xor(v, o);
    return v;
}

#define XB_TMO      128
#define XB_XCNT(j)  (256  + 64 * (j))
#define XB_XSUB(j)  (1280 + 64 * (j))
#define XB_XGEN(j)  (2304 + 64 * (j))
#define XB_TOP      3328
#define XB_TOPGEN   3392
#define XCD_BAR_WORDS 3456
#define XB_SPIN_CAP (1u << 23)
__device__ __forceinline__ unsigned xb_ld(unsigned* p)              { return __hip_atomic_load(p, __ATOMIC_RELAXED, __HIP_MEMORY_SCOPE_AGENT); }
__device__ __forceinline__ unsigned xb_add(unsigned* p, unsigned v) { return __hip_atomic_fetch_add(p, v, __ATOMIC_RELAXED, __HIP_MEMORY_SCOPE_AGENT); }
__device__ __forceinline__ unsigned xb_xcc_id() { return (unsigned)__builtin_amdgcn_s_getreg((3 << 11) | 20) & 0xFu; }
#define XB_SPIN(cond, bar) do { unsigned _sp = 0; while (cond) { __builtin_amdgcn_s_sleep(1); \
    if ((++_sp & 255u) == 0u) { if (xb_ld(&(bar)[XB_TMO])) break; if (_sp > XB_SPIN_CAP) { atomicAdd(&(bar)[XB_TMO], 1u); break; } } } } while (0)
struct XcdBarrier { unsigned* bar; unsigned x; volatile LAS unsigned* st; };
__device__ __forceinline__ XcdBarrier xcd_barrier_post(unsigned* bar, volatile LAS unsigned* st, int tid) {
    XcdBarrier b; b.bar = bar; b.x = xb_xcc_id(); b.st = st;
    if (tid == 0) (void)xb_add(&bar[XB_XCNT(b.x)], 1u);
    return b;
}
__device__ __forceinline__ void xcd_barrier_complete(unsigned* bar, unsigned x, unsigned& nloc, unsigned& nx) {
    const unsigned G = gridDim.x * gridDim.y * gridDim.z;
    unsigned sum, cnt, mine, sp = 0u;
    for (;;) {
        sum = 0u; cnt = 0u; mine = 0u;
#pragma unroll
        for (unsigned j = 0; j < 16; ++j) { const unsigned c = xb_ld(&bar[XB_XCNT(j)]); sum += c; cnt += (c > 0u) ? 1u : 0u; mine = (j == x) ? c : mine; }
        if (sum == G) break;
        __builtin_amdgcn_s_sleep(1);
        if ((++sp & 255u) == 0u) { if (xb_ld(&bar[XB_TMO])) break; if (sp > XB_SPIN_CAP) { atomicAdd(&bar[XB_TMO], 1u); break; } }
    }
    nloc = mine > 0u ? mine : 1u; nx = cnt > 0u ? cnt : 1u;
}
__device__ __forceinline__ void xcd_barrier(const XcdBarrier& b, int tid) {
    asm volatile("s_waitcnt vmcnt(0)" ::: "memory");
    __syncthreads();
    if (tid == 0) {
        unsigned* bar = b.bar;
        __builtin_amdgcn_s_waitcnt(0);
        unsigned nloc = b.st[0], nx = b.st[1];
        if (nloc == 0u) { xcd_barrier_complete(bar, b.x, nloc, nx); b.st[0] = nloc; b.st[1] = nx; }
        const unsigned old = xb_add(&bar[XB_XSUB(b.x)], 1u);
        const unsigned gen = old / nloc;
        if (old + 1u == (gen + 1u) * nloc) {
            __builtin_amdgcn_fence(__ATOMIC_RELEASE, "agent");
            asm volatile("s_waitcnt vmcnt(0)" ::: "memory");
            const unsigned og = xb_add(&bar[XB_TOP], 1u);
            const unsigned tg = og / nx;
            if (og + 1u == (tg + 1u) * nx) xb_add(&bar[XB_TOPGEN], 1u);
            else XB_SPIN(xb_ld(&bar[XB_TOPGEN]) == tg, bar);
            __builtin_amdgcn_fence(__ATOMIC_ACQUIRE, "agent");
            xb_add(&bar[XB_XGEN(b.x)], 1u);
            asm volatile("s_waitcnt vmcnt(0)" ::: "memory");
        } else {
            XB_SPIN(xb_ld(&bar[XB_XGEN(b.x)]) == gen, bar);
            __builtin_amdgcn_fence(__ATOMIC_ACQUIRE, "agent");
            asm volatile("s_waitcnt vmcnt(0)" ::: "memory");
        }
    }
    __syncthreads();
}

__device__ __forceinline__ int make_tid(int wave_s) { int l; asm volatile("v_mbcnt_lo_u32_b32 %0, -1, 0\n\tv_mbcnt_hi_u32_b32 %0, -1, %0" : "=v"(l)); __builtin_assume(l >= 0 && l < 64); __builtin_assume(wave_s >= 0 && wave_s < 8); return wave_s * 64 + l; }
struct Args { const float* in[27]; float* out; unsigned char* ws; int ph_lo, ph_hi; };
enum { I_X = 0, I_C, I_CTX, I_CCTX, I_WMOD, I_BMOD, I_N1G, I_WIN, I_BGATES, I_HEADG, I_CONVW, I_CONVB, I_LWA, I_LBA, I_LWX, I_LBX, I_LAM, I_WPA, I_WPB, I_WOUT, I_N2G, I_WRG, I_WRE, I_W1, I_W3, I_W2, I_FG };

__device__ __forceinline__ void tr_item(const float* __restrict__ W, size_t ldw, int k0, int n0, bf16* dst, size_t ldd, float scale, LAS float* scr, int lane) {
#pragma unroll 16
    for (int i = 0; i < 32; ++i) { const int kk = 2 * i + (lane >> 5); scr[kk * 33 + (lane & 31)] = W[(size_t)(k0 + kk) * ldw + n0 + (lane & 31)]; }
    LDS_WAIT(); asm volatile("" ::: "memory");
    const int c = lane & 7;
#pragma unroll
    for (int j = 0; j < 4; ++j) { const int n = (lane >> 3) + 8 * j; const LAS float* s = scr + (8 * c) * 33 + n;
        v4u o; o.x = pk2(s[0 * 33] * scale, s[1 * 33] * scale); o.y = pk2(s[2 * 33] * scale, s[3 * 33] * scale); o.z = pk2(s[4 * 33] * scale, s[5 * 33] * scale); o.w = pk2(s[6 * 33] * scale, s[7 * 33] * scale);
        *(GAS v4u*)(dst + (size_t)n * ldd + 8 * c) = o; }
    LDS_WAIT(); asm volatile("" ::: "memory");
}
__device__ __forceinline__ int win_row(int n0, float& scale) {
    scale = 1.f;
    if (n0 < 1024) return 13 * 256 + n0;
    if (n0 < 2048) { scale = 0.08838834764831845f; return n0 - 1024; }
    if (n0 < 3072) return 4 * 256 + (n0 - 2048);
    if (n0 < 4096) return 17 * 256 + (n0 - 3072);
    if (n0 < 5120) return 21 * 256 + (n0 - 4096);
    if (n0 < 5152) return 12 * 256 + (n0 - 5120);
    if (n0 < 6176) return 8 * 256 + (n0 - 5152);
    if (n0 < 7200) return 25 * 256 + (n0 - 6176);
    if (n0 < 9248) return 29 * 256 + (n0 - 7200);
    return 37 * 256 + (n0 - 9248);
}

__device__ __forceinline__ void phase0(const Args& a, unsigned char* lds_g, int tid, int lane, int wave) {
    unsigned char* ws = a.ws;
    {
        float* sl = (float*)lds_g;
        float* red = sl + 5 * 2048;
        for (int i = tid; i < 5 * 2048; i += NTHR) { const int r = i >> 11, k = i & 2047; const float v = r < 4 ? a.in[I_C][r * 2048 + k] : a.in[I_CCTX][k]; sl[i] = v / (1.f + __expf(-v)); }
        __syncthreads();
        const float* wm = a.in[I_WMOD]; const float* bm = a.in[I_BMOD]; float* MOD = (float*)(ws + WS_MOD);
        for (int cb = blockIdx.x; cb < 256; cb += gridDim.x) {
            const int n0 = cb * 48;
            if (tid < 504) {
                const int kq = tid / 12, cg = tid % 12;
                f32x4 acc[5];
#pragma unroll
                for (int r = 0; r < 5; ++r) acc[r] = (f32x4){0.f, 0.f, 0.f, 0.f};
#pragma unroll 7
                for (int k = kq; k < 2048; k += 42) {
                    const f32x4 w = *(const f32x4*)(wm + (size_t)k * 12288 + n0 + 4 * cg);
#pragma unroll
                    for (int r = 0; r < 5; ++r) acc[r] += w * sl[r * 2048 + k];
                }
#pragma unroll
                for (int r = 0; r < 5; ++r) *(f32x4*)(red + tid * 20 + r * 4) = acc[r];
            }
            __syncthreads();
            if (tid < 240) {
                const int cg = tid / 20, rj = tid % 20; float s = 0.f;
                for (int kq = 0; kq < 42; ++kq) s += red[(kq * 12 + cg) * 20 + rj];
                const int r = rj >> 2, j = rj & 3, n = n0 + 4 * cg + j;
                __hip_atomic_store(MOD + r * 12288 + n, s + bm[n], __ATOMIC_RELAXED, __HIP_MEMORY_SCOPE_AGENT);
            }
            __syncthreads();
        }
        if (tid == 0) __hip_atomic_fetch_add((unsigned*)(ws + WS_CTL) + CW_MODC, 1u, __ATOMIC_RELAXED, __HIP_MEMORY_SCOPE_AGENT);
    }
    {
        LAS float* scr = (LAS float*)((LAS unsigned char*)lds_g) + wave * 4096;
        const int gw = blockIdx.x * NWAVES + wave, NGW = gridDim.x * NWAVES;
        constexpr int J0 = 32 * 353, J1 = 16 * 64, J3 = 32 * 64;
        constexpr int JL = 256;
        constexpr int NITEMS = J0 + 2 * J1;
        (void)J3; (void)JL;
        for (int it = gw; it < NITEMS; it += NGW) {
            int r = it;
            if (r < J0) { const int kb = r / 353, nb = r % 353; float sc; const int row = win_row(32 * nb, sc);
                tr_item(a.in[I_WIN], IN_DIM, 64 * kb, 32 * nb, (bf16*)(ws + WS_WIN) + (size_t)row * 2048 + 64 * kb, 2048, sc, scr, lane); continue; } r -= J0;
            if (r < J1) { const int kb = r / 64, nb = r % 64; tr_item(a.in[I_WPA], 2048, 64 * kb, 32 * nb, (bf16*)(ws + WS_WPA) + (size_t)(32 * nb) * 1024 + 64 * kb, 1024, 1.f, scr, lane); continue; } r -= J1;
            if (r < J1) { const int kb = r / 64, nb = r % 64; tr_item(a.in[I_WPB], 2048, 64 * kb, 32 * nb, (bf16*)(ws + WS_WPB) + (size_t)(32 * nb) * 1024 + 64 * kb, 1024, 1.f, scr, lane); continue; }
        }
        { GAS v4u* z = (GAS v4u*)((bf16*)(ws + WS_WIN) + (size_t)(12 * 256 + 32) * 2048); const int nchunks = 224 * 256;
          for (int i = blockIdx.x * NTHR + tid; i < nchunks; i += gridDim.x * NTHR) z[i] = (v4u){0u, 0u, 0u, 0u}; }
    }
}

__device__ __forceinline__ void late_prep(const Args& a, unsigned char* lds_g, int gw, int NGW, int lane, int wave) {
    unsigned char* ws = a.ws;
    {
        LAS float* scr = (LAS float*)((LAS unsigned char*)lds_g) + wave * 4096;
        constexpr int J3 = 32 * 64, JL = 256;
        for (int it = gw; it < J3 + JL; it += NGW) {
            int r = it;
            if (r >= J3) { r -= J3; const int mi = r >> 3, kb = (r >> 2) & 1, nb = r & 3, dir = mi >> 4, mat = (mi >> 3) & 1, blk = mi & 7;
                tr_item(a.in[mat ? I_LWX : I_LWA] + (size_t)(dir * 8 + blk) * 128 * 128, 128, 64 * kb, 32 * nb, (bf16*)(ws + WS_WL) + ((size_t)((dir * 2 + mat) * 8 + blk) * 128 + 32 * nb) * 128 + 64 * kb, 128, 1.f, scr, lane); continue; }
            const int kb = r / 64, nb = r % 64; tr_item(a.in[I_WOUT], 2048, 64 * kb, 32 * nb, (bf16*)(ws + WS_WOUT) + (size_t)(32 * nb) * 2048 + 64 * kb, 2048, 1.f, scr, lane);
        }
    }
    {
        const float* MODr = (const float*)(a.ws + WS_MOD); float* WR = (float*)(a.ws + WS_WR); float* RB = (float*)(a.ws + WS_RB);
        for (int idx = gw * 64 + lane; idx < 4 * 48 * 2048; idx += NGW * 64) { const int k = idx & 2047, j = (idx >> 11) % 48, b = idx / (48 * 2048);
            const float gm = a.in[I_N2G][k] * (1.f + MODr[b * 12288 + 4 * 2048 + k]);
            const float wv = j < 32 ? a.in[I_WRE][(size_t)k * 32 + j] : (j < 36 ? a.in[I_WRG][(size_t)k * 4 + (j - 32)] : 0.f);
            WR[idx] = gm * wv; }
        for (int q = gw; q < 4 * 48; q += NGW) { const int b = q / 48, j = q % 48; float sacc = 0.f;
            if (j < 36) { for (int k = lane; k < 2048; k += 64) { const float wv = j < 32 ? a.in[I_WRE][(size_t)k * 32 + j] : a.in[I_WRG][(size_t)k * 4 + (j - 32)]; sacc += MODr[b * 12288 + 3 * 2048 + k] * wv; } }
            sacc = wave_sum(sacc); if (lane == 0) RB[q] = sacc; }
    }
}
__device__ __forceinline__ void mod_wait(const Args& a, int tid) {
    if (tid < 64) { unsigned* mc = (unsigned*)(a.ws + WS_CTL) + CW_MODC; unsigned spins = 0;
        while ((unsigned)__builtin_amdgcn_readfirstlane(__hip_atomic_load(mc, __ATOMIC_RELAXED, __HIP_MEMORY_SCOPE_AGENT)) < gridDim.x) {
            __builtin_amdgcn_s_sleep(2);
            if (++spins > (1u << 22)) { if (tid == 0) __hip_atomic_store((unsigned*)(a.ws + WS_CTL) + 1, 0x800u, __ATOMIC_RELAXED, __HIP_MEMORY_SCOPE_AGENT); break; } }
        __builtin_amdgcn_fence(__ATOMIC_ACQUIRE, "agent");
        asm volatile("s_waitcnt vmcnt(0)" ::: "memory"); }
    __syncthreads();
}
__device__ __forceinline__ void phase1(const Args& a, int lane, int wave) {
    const int gw = blockIdx.x * NWAVES + wave, NGW = gridDim.x * NWAVES;
    const float* MOD = (const float*)(a.ws + WS_MOD); const float* g = a.in[I_N1G];
    bf16* H = (bf16*)(a.ws + WS_H);
    for (int r = gw; r < NTOK; r += NGW) {
        const float* src = r < NCTX ? a.in[I_CTX] + (size_t)r * D : a.in[I_X] + (size_t)(r - NCTX) * D;
        const int mr = r < NCTX ? 4 : (r - NCTX) / SEQ;
        const f32x4* xr = (const f32x4*)src + lane;
        f32x4 v[8]; float s = 0.f;
#pragma unroll
        for (int j = 0; j < 8; ++j) { v[j] = xr[64 * j]; s += (v[j].x * v[j].x + v[j].y * v[j].y) + (v[j].z * v[j].z + v[j].w * v[j].w); }
        const float rstd = 1.f / sqrtf(wave_sum(s) * (1.f / D) + EPS);
        unsigned long long* o8 = (unsigned long long*)(H + (size_t)r * D) + lane;
#pragma unroll
        for (int j = 0; j < 8; ++j) {
            const int c = 4 * lane + 256 * j;
            const f32x4 gg = *(const f32x4*)(g + c), sh = *(const f32x4*)(MOD + mr * 12288 + c), sc = *(const f32x4*)(MOD + mr * 12288 + 2048 + c);
            v[j] = v[j] * rstd * gg * (sc + 1.f) + sh;
        }
#pragma unroll
        for (int j = 0; j < 8; ++j) o8[64 * j] = (unsigned long long)pk2(v[j].x, v[j].y) | ((unsigned long long)pk2(v[j].z, v[j].w) << 32);
    }
}

struct SchedIn {
    int G, c; const char* A; const char* B;
    __device__ __forceinline__ bool next(int i, pg8::Unit& u) const {
        const int L = i * G + c; if (L >= 1492) return false;
        int pm, pn;
        if (L < 1440) { pg8::tile_order(L, 32, NT_IN, pm, pn); pm += 4; }
        else { const int j = L - 1440; pm = j & 3; pn = j >> 2; }
        u.pm = pm; u.pn = pn; u.aux = 0; u.A = A + (size_t)pm * 256 * D * 2; u.B = B + (size_t)pn * 256 * D * 2; return true;
    }
};
struct EpiIn {
    static constexpr bool PERM = true;
    unsigned char* ws; const float* b_gates;
    template <int ACT> __device__ __forceinline__ void store_tile(const pg8::f32x4 (&acc)[2][2][4][2], bf16* base, int ldc, int wr, int wc, int fr, int fq) const {
#pragma unroll
        for (int ai = 0; ai < 2; ++ai)
#pragma unroll
            for (int m = 0; m < 4; ++m) { bf16* rowp = base + (size_t)(ai * 128 + wr * 64 + m * 16 + fr) * ldc + wc * 32 + 8 * fq;
#pragma unroll
                for (int bj = 0; bj < 2; ++bj) { pg8::f32x4 v0 = acc[ai][bj][m][0], v1 = acc[ai][bj][m][1];
                    if (ACT == 1) {
#pragma unroll
                        for (int j = 0; j < 4; ++j) { v0[j] = sigmoidf_(v0[j]); v1[j] = sigmoidf_(v1[j]); } }
                    if (ACT == 2) {
#pragma unroll
                        for (int j = 0; j < 4; ++j) { v0[j] = gelu_tanh(v0[j]); v1[j] = gelu_tanh(v1[j]); } }
                    pg8::u32x4 w; w.x = pg8::cvt_pk_bf16(v0[0], v0[1]); w.y = pg8::cvt_pk_bf16(v0[2], v0[3]); w.z = pg8::cvt_pk_bf16(v1[0], v1[1]); w.w = pg8::cvt_pk_bf16(v1[2], v1[3]);
                    *(pg8::u32x4*)(rowp + bj * 128) = w; } }
    }
    __device__ __forceinline__ void operator()(const pg8::f32x4 (&acc)[2][2][4][2], const pg8::Unit& u, int wr, int wc, int fr, int fq) const {
        const int pn = u.pn; const size_t row0 = (size_t)u.pm * 256;
        if (pn < 12) {
            const int seg = pn >> 2, ct = pn & 3; bf16* dst = (bf16*)(ws + (seg == 0 ? WS_K : seg == 1 ? WS_V : WS_UX));
            store_tile<0>(acc, dst + row0 * 1024 + ct * 256, 1024, wr, wc, fr, fq);
        } else if (pn == 12) {
            if (wc == 0) {
                float* G = (float*)(ws + WS_GATES);
                const pg8::f32x4 bv0 = *(const pg8::f32x4*)(b_gates + 8 * fq), bv1 = *(const pg8::f32x4*)(b_gates + 8 * fq + 4);
#pragma unroll
                for (int ai = 0; ai < 2; ++ai)
#pragma unroll
                    for (int m = 0; m < 4; ++m) { float* rowp = G + (row0 + ai * 128 + wr * 64 + m * 16 + fr) * 32 + 8 * fq;
                        *(pg8::f32x4*)(rowp) = acc[ai][0][m][0] + bv0; *(pg8::f32x4*)(rowp + 4) = acc[ai][0][m][1] + bv1; }
            }
        } else if (pn < 29) {
            const int seg = (pn - 13) >> 2, ct = (pn - 13) & 3; const size_t lr = row0 - NCTX;
            bf16* dst = (bf16*)(ws + (seg == 0 ? WS_Q : seg == 1 ? WS_OF : seg == 2 ? WS_OB : WS_UG)) + lr * 1024 + ct * 256;
            if (seg == 0) store_tile<0>(acc, dst, 1024, wr, wc, fr, fq);
            else if (seg == 3) store_tile<2>(acc, dst, 1024, wr, wc, fr, fq);
            else store_tile<1>(acc, dst, 1024, wr, wc, fr, fq);
        } else {
            const int seg = (pn - 29) >> 3, ct = (pn - 29) & 7; const size_t lr = row0 - NCTX;
            store_tile<1>(acc, (bf16*)(ws + (seg ? WS_GB : WS_GA)) + lr * 2048 + ct * 256, 2048, wr, wc, fr, fq);
        }
    }
};

__device__ __forceinline__ int lru_pos_row(int b, bool isctx, int p) { return isctx ? b * CTXL + p : NCTX + b * SEQ + (p & 31) * 64 + (p >> 5); }
typedef short bf16x8_t __attribute__((ext_vector_type(8)));
template <bool FINAL>
__device__ __forceinline__ void lru_unit(const Args& a, unsigned char* lds_g, int b, int cidx, int blk, int tid) {
    const int lane = tid & 63, w = __builtin_amdgcn_readfirstlane(tid >> 6), fr = lane & 15, fq = lane >> 4;
    float* zf = (float*)lds_g;
    bf16* zb = (bf16*)(lds_g + 64 * 132 * 4);
    const bool isctx = cidx < 4; const int seglen = isctx ? CTXL : SEQ, p0 = (isctx ? cidx : cidx - 4) * 64;
    const bf16* UX = (const bf16*)(a.ws + WS_UX);
    float gba[2], gbx[2], glam[2];
    { const int ch_ = blk * 128 + 16 * w + fr;
#pragma unroll
      for (int d = 0; d < 2; ++d) { gba[d] = a.in[I_LBA][d * 1024 + ch_]; gbx[d] = a.in[I_LBX][d * 1024 + ch_]; glam[d] = a.in[I_LAM][d * 1024 + ch_]; } }
    bf16x8_t wl[2][2][4];
    { const bf16* WL = (const bf16*)(a.ws + WS_WL);
#pragma unroll
      for (int d = 0; d < 2; ++d)
#pragma unroll
        for (int m = 0; m < 2; ++m)
#pragma unroll
            for (int ks = 0; ks < 4; ++ks) wl[d][m][ks] = *(const bf16x8_t*)(WL + ((size_t)((d * 2 + m) * 8 + blk) * 128 + 16 * w + fr) * 128 + 32 * ks + 8 * fq); }
    __builtin_amdgcn_sched_barrier(0);
    {
        const int pos = tid >> 3, cg = tid & 7, ch0 = blk * 128 + cg * 16, p = p0 + pos;
        float z[16];
#pragma unroll
        for (int q = 0; q < 4; ++q) { const f32x4 bv = *(const f32x4*)(a.in[I_CONVB] + ch0 + 4 * q); z[4 * q] = bv.x; z[4 * q + 1] = bv.y; z[4 * q + 2] = bv.z; z[4 * q + 3] = bv.w; }
        v4u ua[4], ub[4]; float msk[4];
#pragma unroll
        for (int w4 = 0; w4 < 4; ++w4) { const int pp = p + w4 - 2; const bool ok = pp >= 0 && pp < seglen; const int ppc = ok ? pp : p;
            const v4u* src = (const v4u*)(UX + (size_t)lru_pos_row(b, isctx, ppc) * 1024 + ch0); ua[w4] = src[0]; ub[w4] = src[1]; msk[w4] = ok ? 1.f : 0.f; }
#pragma unroll
        for (int w4 = 0; w4 < 4; ++w4) { const float* cw = a.in[I_CONVW] + w4 * 1024 + ch0;
            const unsigned uu[8] = {ua[w4].x, ua[w4].y, ua[w4].z, ua[w4].w, ub[w4].x, ub[w4].y, ub[w4].z, ub[w4].w};
#pragma unroll
            for (int q = 0; q < 4; ++q) { const f32x4 cv = *(const f32x4*)(cw + 4 * q) * msk[w4]; z[4 * q] += cv.x * bflo(uu[2 * q]); z[4 * q + 1] += cv.y * bfhi(uu[2 * q]); z[4 * q + 2] += cv.z * bflo(uu[2 * q + 1]); z[4 * q + 3] += cv.w * bfhi(uu[2 * q + 1]); } }
#pragma unroll
        for (int q = 0; q < 4; ++q) *(f32x4*)(zf + pos * 132 + cg * 16 + 4 * q) = (f32x4){z[4 * q], z[4 * q + 1], z[4 * q + 2], z[4 * q + 3]};
        v4u o0, o1; o0.x = pk2(z[0], z[1]); o0.y = pk2(z[2], z[3]); o0.z = pk2(z[4], z[5]); o0.w = pk2(z[6], z[7]); o1.x = pk2(z[8], z[9]); o1.y = pk2(z[10], z[11]); o1.z = pk2(z[12], z[13]); o1.w = pk2(z[14], z[15]);
        *(v4u*)(zb + pos * 136 + cg * 16) = o0; *(v4u*)(zb + pos * 136 + cg * 16 + 8) = o1;
    }
    WG_BAR();
    f32x4 acc[2][2][4];
#pragma unroll
    for (int d = 0; d < 2; ++d)
#pragma unroll
        for (int m = 0; m < 2; ++m)
#pragma unroll
            for (int mt = 0; mt < 4; ++mt) acc[d][m][mt] = (f32x4){0.f, 0.f, 0.f, 0.f};
#pragma unroll
    for (int ks = 0; ks < 4; ++ks) {
        bf16x8_t af[4];
#pragma unroll
        for (int mt = 0; mt < 4; ++mt) af[mt] = *(const bf16x8_t*)(zb + (16 * mt + fr) * 136 + 32 * ks + 8 * fq);
#pragma unroll
        for (int d = 0; d < 2; ++d)
#pragma unroll
            for (int m = 0; m < 2; ++m) {
#pragma unroll
                for (int mt = 0; mt < 4; ++mt) acc[d][m][mt] = __builtin_amdgcn_mfma_f32_16x16x32_bf16(af[mt], wl[d][m][ks], acc[d][m][mt], 0, 0, 0); }
    }
    const int chl = 16 * w + fr, ch = blk * 128 + chl;
    float hsum[4][4];
#pragma unroll
    for (int d = 0; d < 2; ++d) {
        const float ba = gba[d], bx = gbx[d], lam = glam[d];
        const float sp = (-lam > 20.f) ? -lam : log1pf(__expf(-lam));
        float av[4][4], bv[4][4];
#pragma unroll
        for (int mt = 0; mt < 4; ++mt)
#pragma unroll
            for (int r = 0; r < 4; ++r) { const float rr = sigmoidf_(acc[d][0][mt][r] + ba), ii = sigmoidf_(acc[d][1][mt][r] + bx);
                const float aa = __expf(-8.f * rr * sp); av[mt][r] = aa; bv[mt][r] = __builtin_amdgcn_sqrtf(fmaxf(1.f - aa * aa, 0.f)) * ii * zf[(16 * mt + 4 * fq + r) * 132 + chl]; }
        float Pe[4], Se[4], Pt[4], St[4];
#pragma unroll
        for (int mt = 0; mt < 4; ++mt) {
            float P = 1.f, S = 0.f;
#pragma unroll
            for (int rr = 0; rr < 4; ++rr) { const int r = d ? 3 - rr : rr; S = av[mt][r] * S + bv[mt][r]; P = av[mt][r] * P; }
            if (d == 0) {
                float p1 = __shfl_up(P, 16), s1 = __shfl_up(S, 16); if (fq >= 1) { S = P * s1 + S; P = P * p1; }
                p1 = __shfl_up(P, 32); s1 = __shfl_up(S, 32); if (fq >= 2) { S = P * s1 + S; P = P * p1; }
                Pe[mt] = __shfl_up(P, 16); Se[mt] = __shfl_up(S, 16); if (fq == 0) { Pe[mt] = 1.f; Se[mt] = 0.f; }
                Pt[mt] = __shfl(P, fr + 48); St[mt] = __shfl(S, fr + 48);
            } else {
                float p1 = __shfl_down(P, 16), s1 = __shfl_down(S, 16); if (fq <= 2) { S = P * s1 + S; P = P * p1; }
                p1 = __shfl_down(P, 32); s1 = __shfl_down(S, 32); if (fq <= 1) { S = P * s1 + S; P = P * p1; }
                Pe[mt] = __shfl_down(P, 16); Se[mt] = __shfl_down(S, 16); if (fq == 3) { Pe[mt] = 1.f; Se[mt] = 0.f; }
                Pt[mt] = __shfl(P, fr); St[mt] = __shfl(S, fr);
            }
        }
        float2* AGG = (float2*)(a.ws + WS_AGG) + ((size_t)(b * 2 + d) * 36) * 1024 + ch;
        if (!FINAL) {
            if (cidx >= 4) {
                unsigned* PS = (unsigned*)(a.ws + WS_PS) + ((size_t)(b * 2 + d) * NSTEP + 64 * cidx) * 1024 + ch;
#pragma unroll
                for (int mt = 0; mt < 4; ++mt)
#pragma unroll
                    for (int r = 0; r < 4; ++r) PS[(size_t)(16 * mt + 4 * fq + r) * 1024] = pk2(1.f - av[mt][r], bv[mt][r]);
            }
            float Pc = 1.f, Sc = 0.f;
#pragma unroll
            for (int i = 0; i < 4; ++i) { const int mt = d ? 3 - i : i; Sc = Pt[mt] * Sc + St[mt]; Pc = Pt[mt] * Pc; }
            if (fq == 0) AGG[(size_t)cidx * 1024] = make_float2(Pc, Sc);
        } else {
            float h = 0.f;
#pragma unroll
            for (int g3 = 0; g3 < 6; ++g3) {
                float2 qv[6];
#pragma unroll
                for (int i = 0; i < 6; ++i) { const int sidx = 6 * g3 + i; const int c2 = d ? (sidx < 4 ? 3 - sidx : 39 - sidx) : sidx; qv[i] = AGG[(size_t)c2 * 1024]; }
#pragma unroll
                for (int i = 0; i < 6; ++i) { const int sidx = 6 * g3 + i; const int c2 = d ? (sidx < 4 ? 3 - sidx : 39 - sidx) : sidx;
                    const bool use = d ? (sidx < 4 || c2 > cidx) : (c2 < cidx);
                    h = use ? qv[i].x * h + qv[i].y : h; }
            }
#pragma unroll
            for (int i = 0; i < 4; ++i) { const int mt = d ? 3 - i : i;
                float hl = Pe[mt] * h + Se[mt];
#pragma unroll
                for (int rr = 0; rr < 4; ++rr) { const int r = d ? 3 - rr : rr; hl = av[mt][r] * hl + bv[mt][r]; if (d == 0) hsum[mt][r] = hl; else hsum[mt][r] += hl; }
                h = Pt[mt] * h + St[mt]; }
        }
    }
    if (FINAL) {
#pragma unroll
        for (int mt = 0; mt < 4; ++mt)
#pragma unroll
            for (int r = 0; r < 4; ++r) zf[(16 * mt + 4 * fq + r) * 132 + chl] = hsum[mt][r];
        WG_BAR();
        const int pos = tid >> 3, cg = tid & 7, ch0 = blk * 128 + cg * 16;
        const size_t lrow = (size_t)(lru_pos_row(b, false, p0 + pos) - NCTX) * 1024 + ch0;
        const v4u* ug = (const v4u*)((const bf16*)(a.ws + WS_UG) + lrow); const v4u g0 = ug[0], g1 = ug[1];
        const unsigned gg[8] = {g0.x, g0.y, g0.z, g0.w, g1.x, g1.y, g1.z, g1.w}; unsigned o[8];
#pragma unroll
        for (int q = 0; q < 4; ++q) { const f32x4 hv = *(const f32x4*)(zf + pos * 132 + cg * 16 + 4 * q);
            o[2 * q] = pk2(hv.x * bflo(gg[2 * q]), hv.y * bfhi(gg[2 * q])); o[2 * q + 1] = pk2(hv.z * bflo(gg[2 * q + 1]), hv.w * bfhi(gg[2 * q + 1])); }
        v4u* dst = (v4u*)((bf16*)(a.ws + WS_YB) + lrow); dst[0] = (v4u){o[0], o[1], o[2], o[3]}; dst[1] = (v4u){o[4], o[5], o[6], o[7]};
    }
    WG_BAR();
}
constexpr int ML_STRIDE = 136;
constexpr int ML_Q = 0, ML_K = 17408, ML_V = 34816, ML_AUG = 52224  , ML_CB = 54272  ;
constexpr int ML_EB = 93440  , ML_EU = 95488  , ML_EBEND = 97536  , ML_BEND = 97568  , ML_DEN = 97600  , ML_SSQ = 97856  ;
typedef short s4_t __attribute__((ext_vector_type(4)));
__device__ __forceinline__ s4_t ds_tr(const bf16* p) { return __builtin_amdgcn_ds_read_tr16_b64_v4i16((LAS s4_t*)p); }
__device__ __forceinline__ bf16x8_t frag_row(const bf16* img, int row0, int k0, int fr, int fq) { return *(const bf16x8_t*)(img + (row0 + fr) * ML_STRIDE + k0 + 8 * fq); }
__device__ __forceinline__ bf16x8_t frag_tr2(const bf16* img, int stride, int sA, int sB, int col0, int lane) {
    const int fq = lane >> 4, q = (lane & 15) >> 2, p = lane & 3;
    const s4_t lo = ds_tr(img + (sA + 4 * fq + q) * stride + col0 + 4 * p), hi = ds_tr(img + (sB + 4 * fq + q) * stride + col0 + 4 * p);
    return (bf16x8_t){lo.x, lo.y, lo.z, lo.w, hi.x, hi.y, hi.z, hi.w};
}
__device__ __forceinline__ bf16x8_t frag_tr(const bf16* img, int stride, int s0, int col0, int lane) {
    const int fq = lane >> 4, q = (lane & 15) >> 2, p = lane & 3;
    const bf16* b = img + (s0 + 8 * fq + q) * stride + col0 + 4 * p;
    const s4_t lo = ds_tr(b), hi = ds_tr(b + 4 * stride);
    return (bf16x8_t){lo.x, lo.y, lo.z, lo.w, hi.x, hi.y, hi.z, hi.w};
}
__device__ __forceinline__ float logsigmoidf_(float x) { return fminf(x, 0.f) - log1pf(__expf(-fabsf(x))); }

__device__ __forceinline__ void ml_gates(const Args& a, unsigned char* lds_g, int rowbase, int h, int tid) {
    const int lane = tid & 63, w = tid >> 6, dir = w >> 2, c = w & 3;
    const float* GT = (const float*)(a.ws + WS_GATES) + (size_t)(rowbase + 64 * c + lane) * 32;
    const float ipre = GT[(dir * 2) * 8 + h], fpre = GT[(dir * 2 + 1) * 8 + h];
    float bsum = logsigmoidf_(fpre);
    if (dir == 0) {
#pragma unroll
        for (int o = 1; o < 64; o <<= 1) { const float t = __shfl_up(bsum, o); if (lane >= o) bsum += t; }
    } else {
#pragma unroll
        for (int o = 1; o < 64; o <<= 1) { const float t = __shfl_down(bsum, o); if (lane + o < 64) bsum += t; }
    }
    float* eb = (float*)(lds_g + ML_EB); float* eu = (float*)(lds_g + ML_EU);
    eb[dir * 256 + 64 * c + lane] = __expf(bsum); eu[dir * 256 + 64 * c + lane] = __expf(ipre - bsum);
    const float bend = __shfl(bsum, dir ? 0 : 63);
    if (lane == 0) { ((float*)(lds_g + ML_EBEND))[dir * 4 + c] = __expf(bend); ((float*)(lds_g + ML_BEND))[dir * 4 + c] = bend; }
}

template <bool OUT, bool PASS2>
__device__ __forceinline__ void ml_block(const Args& a, unsigned char* lds_g, int rowbase, int h, int dir, f32x4 (&st)[9], int tid) {
    const int lane = tid & 63, w = __builtin_amdgcn_readfirstlane(tid >> 6), fr = lane & 15, fq = lane >> 4;
    bf16* Qi = (bf16*)(lds_g + ML_Q); bf16* Ki = (bf16*)(lds_g + ML_K); bf16* Vi = (bf16*)(lds_g + ML_V); bf16* AUGi = (bf16*)(lds_g + ML_AUG); bf16* CB = (bf16*)(lds_g + ML_CB);
    const float* eb = (const float*)(lds_g + ML_EB) + dir * 256; const float* eu = (const float*)(lds_g + ML_EU) + dir * 256;
    const float* ebend = (const float*)(lds_g + ML_EBEND) + dir * 4;
    float* den = (float*)(lds_g + ML_DEN); float* ssq = (float*)(lds_g + ML_SSQ);
    const bf16* Kb = (const bf16*)(a.ws + WS_K); const bf16* Vb = (const bf16*)(a.ws + WS_V); const bf16* Qb = (const bf16*)(a.ws + WS_Q);
    const int ti = w & 3, vh = w >> 2;
    float hgv[5];
    if (OUT) {
#pragma unroll
        for (int x = 0; x < 5; ++x) { const int vt = vh * 5 + x; hgv[x] = vt < 8 ? a.in[I_HEADG][h * 128 + 16 * vt + fr] : 0.f; } }
    for (int ci = 0; ci < 4; ++ci) {
        const int c = dir ? 3 - ci : ci;
        unsigned short ogv[5][4]; unsigned short tmv[5][4];
        if (OUT) {
            const bf16* OGp = (const bf16*)(a.ws + (dir ? WS_OB : WS_OF)); const bf16* TMp = (const bf16*)(a.ws + WS_TM);
#pragma unroll
            for (int r = 0; r < 4; ++r) { const size_t ob = (size_t)(rowbase - NCTX + 64 * c + 16 * ti + 4 * fq + r) * 1024 + h * 128;
#pragma unroll
                for (int x = 0; x < 5; ++x) { const int vt = vh * 5 + x; if (vt < 8) { ogv[x][r] = OGp[ob + 16 * vt + fr]; if (PASS2) tmv[x][r] = TMp[ob + 16 * vt + fr]; } } }
            __builtin_amdgcn_sched_barrier(0);
        }
        {
            const int t = tid >> 3, pc = tid & 7; const size_t row = (size_t)(rowbase + 64 * c + t);
            const v4u* ks = (const v4u*)(Kb + row * 1024 + h * 128 + 16 * pc); const v4u k0 = ks[0], k1 = ks[1];
            const v4u* vs = (const v4u*)(Vb + row * 1024 + h * 128 + 16 * pc); const v4u v0 = vs[0], v1 = vs[1];
            v4u q0, q1; if (OUT) { const v4u* qs = (const v4u*)(Qb + (row - NCTX) * 1024 + h * 128 + 16 * pc); q0 = qs[0]; q1 = qs[1]; }
            const float e = eu[64 * c + t];
            *(v4u*)(Ki + t * ML_STRIDE + 16 * pc) = k0; *(v4u*)(Ki + t * ML_STRIDE + 16 * pc + 8) = k1;
            if (OUT) { *(v4u*)(Qi + t * ML_STRIDE + 16 * pc) = q0; *(v4u*)(Qi + t * ML_STRIDE + 16 * pc + 8) = q1; }
            const unsigned vv[8] = {v0.x, v0.y, v0.z, v0.w, v1.x, v1.y, v1.z, v1.w}; unsigned o[8];
#pragma unroll
            for (int i = 0; i < 8; ++i) o[i] = pk2(bflo(vv[i]) * e, bfhi(vv[i]) * e);
            *(v4u*)(Vi + t * ML_STRIDE + 16 * pc) = (v4u){o[0], o[1], o[2], o[3]}; *(v4u*)(Vi + t * ML_STRIDE + 16 * pc + 8) = (v4u){o[4], o[5], o[6], o[7]};
            if (pc == 0) { *(v4u*)(AUGi + t * 16) = (v4u){f2bf(e), 0u, 0u, 0u}; *(v4u*)(AUGi + t * 16 + 8) = (v4u){0u, 0u, 0u, 0u}; }
        }
        WG_BAR();
        f32x4 X[5]; float hval[4][4];
        if (OUT) {
            bf16x8_t qf[4];
#pragma unroll
            for (int ks = 0; ks < 4; ++ks) qf[ks] = frag_row(Qi, 16 * ti, 32 * ks, fr, fq);
            bf16x8_t P[2]; bool pv[2];
#pragma unroll
            for (int pp = 0; pp < 2; ++pp) {
                f32x4 d[2];
#pragma unroll
                for (int hh = 0; hh < 2; ++hh) { const int si = 2 * pp + hh; d[hh] = (f32x4){0.f, 0.f, 0.f, 0.f};
                    const bool valid = dir ? (si >= ti) : (si <= ti);
                    if (valid) {
#pragma unroll
                        for (int ks = 0; ks < 4; ++ks) d[hh] = __builtin_amdgcn_mfma_f32_16x16x32_bf16(frag_row(Ki, 16 * si, 32 * ks, fr, fq), qf[ks], d[hh], 0, 0, 0);
                        if (si == ti) {
#pragma unroll
                            for (int r = 0; r < 4; ++r) { const bool keep = dir ? (4 * fq + r >= fr) : (4 * fq + r <= fr); d[hh][r] = keep ? d[hh][r] : 0.f; } } } }
                pv[pp] = dir ? (2 * pp + 1 >= ti) : (2 * pp <= ti);
                const unsigned p0 = pk2(d[0][0], d[0][1]), p1 = pk2(d[0][2], d[0][3]), p2 = pk2(d[1][0], d[1][1]), p3 = pk2(d[1][2], d[1][3]);
                P[pp] = __builtin_bit_cast(bf16x8_t, (v4u){p0, p1, p2, p3});
            }
#pragma unroll
            for (int x = 0; x < 5; ++x) { X[x] = (f32x4){0.f, 0.f, 0.f, 0.f};
                const int vt = vh * 5 + x;
                if (vt < 9) {
#pragma unroll
                    for (int pp = 0; pp < 2; ++pp) if (pv[pp]) {
                        const bf16x8_t bfv = vt < 8 ? frag_tr2(Vi, ML_STRIDE, 32 * pp, 32 * pp + 16, 16 * vt, lane) : frag_tr2(AUGi, 16, 32 * pp, 32 * pp + 16, 0, lane);
                        X[x] = __builtin_amdgcn_mfma_f32_16x16x32_bf16(P[pp], bfv, X[x], 0, 0, 0); }
#pragma unroll
                    for (int ks = 0; ks < 4; ++ks) X[x] = __builtin_amdgcn_mfma_f32_16x16x32_bf16(qf[ks], frag_row(CB, 16 * vt, 32 * ks, fr, fq), X[x], 0, 0, 0);
                } }
            if (vh == 1 && fr == 0) {
#pragma unroll
                for (int r = 0; r < 4; ++r) den[16 * ti + 4 * fq + r] = X[3][r] * eb[64 * c + 16 * ti + 4 * fq + r]; }
        }
        {
#pragma unroll
            for (int ks = 0; ks < 2; ++ks) { const bf16x8_t kf = frag_tr(Ki, ML_STRIDE, 32 * ks, 16 * w, lane);
#pragma unroll
                for (int vt = 0; vt < 8; ++vt) st[vt] = __builtin_amdgcn_mfma_f32_16x16x32_bf16(kf, frag_tr(Vi, ML_STRIDE, 32 * ks, 16 * vt, lane), st[vt], 0, 0, 0);
                st[8] = __builtin_amdgcn_mfma_f32_16x16x32_bf16(kf, frag_tr(AUGi, 16, 32 * ks, 0, lane), st[8], 0, 0, 0); }
            const float ee = ebend[c];
#pragma unroll
            for (int vt = 0; vt < 9; ++vt) st[vt] = st[vt] * ee;
        }
        WG_BAR();
        if (OUT) {
            float sq[4] = {0.f, 0.f, 0.f, 0.f};
#pragma unroll
            for (int r = 0; r < 4; ++r) { const int t = 16 * ti + 4 * fq + r; const float sc = eb[64 * c + t] * __builtin_amdgcn_rcpf(fmaxf(fabsf(den[t]), 1.f));
#pragma unroll
                for (int x = 0; x < 4; ++x) { const int vt = vh * 5 + x; const float hv = (vt < 8) ? X[x][r] * sc : 0.f; hval[x][r] = hv; sq[r] += hv * hv; }
                if (vh == 0) { const float hv = X[4][r] * sc; X[4][r] = hv; sq[r] += hv * hv; } }
#pragma unroll
            for (int r = 0; r < 4; ++r) { float v = sq[r]; v += __shfl_xor(v, 1); v += __shfl_xor(v, 2); v += __shfl_xor(v, 4); v += __shfl_xor(v, 8); if (fr == 0) ssq[vh * 64 + 16 * ti + 4 * fq + r] = v; }
#pragma unroll
            for (int vt = 0; vt < 9; ++vt) { pg8::u32x2 o; o.x = pk2(st[vt][0], st[vt][1]); o.y = pk2(st[vt][2], st[vt][3]); *(pg8::u32x2*)(CB + (16 * vt + fr) * ML_STRIDE + 16 * w + 4 * fq) = o; }
            WG_BAR();
            bf16* TM = (bf16*)(a.ws + WS_TM); bf16* YA = (bf16*)(a.ws + WS_YA);
#pragma unroll
            for (int r = 0; r < 4; ++r) { const int t = 16 * ti + 4 * fq + r; const float rs = __builtin_amdgcn_rsqf((ssq[t] + ssq[64 + t]) * (1.f / 128.f) + EPS);
                const size_t ob = (size_t)(rowbase - NCTX + 64 * c + t) * 1024 + h * 128;
#pragma unroll
                for (int x = 0; x < 5; ++x) { const int vt = vh * 5 + x; if (vt < 8) { const int v = 16 * vt + fr; const float hv = (x < 4) ? hval[x][r] : X[4][r];
                    float y = hv * rs * hgv[x] * bf2f(ogv[x][r]);
                    if (PASS2) { y += bf2f(tmv[x][r]); YA[ob + v] = (bf16)f2bf(y); } else TM[ob + v] = (bf16)f2bf(y); } } }
        }
    }
}

__device__ __forceinline__ void ml_state_quad(const Args& a, unsigned char* lds_g, int qu, int tid) {
    const int seq = qu >> 1, j0 = 4 * (qu & 1), dir = seq & 1, h = (seq >> 1) & 7, b = seq >> 4;
    const int lane = tid & 63, w = __builtin_amdgcn_readfirstlane(tid >> 6);
    f32x4 st[9];
#pragma unroll
    for (int vt = 0; vt < 9; ++vt) st[vt] = (f32x4){0.f, 0.f, 0.f, 0.f};
#pragma unroll 1
    for (int jj = 0; jj < 4; ++jj) {
        const int j = j0 + jj, su = seq * 8 + j;
        const int rowbase = j == 0 ? b * CTXL : NCTX + b * SEQ + 256 * (dir ? 8 - j : j - 1);
        ml_gates(a, lds_g, rowbase, h, tid);
        WG_BAR();
        ml_block<false, false>(a, lds_g, rowbase, h, dir, st, tid);
        pg8::u32x2* SL = (pg8::u32x2*)(a.ws + WS_SLOC) + ((size_t)(su * 8 + w) * 9) * 64 + lane;
#pragma unroll
        for (int vt = 0; vt < 9; ++vt) { pg8::u32x2 o; o.x = pk2(st[vt][0], st[vt][1]); o.y = pk2(st[vt][2], st[vt][3]); SL[vt * 64] = o; }
        if (tid == 0) { const float* bd = (const float*)(lds_g + ML_BEND) + dir * 4; ((float*)(a.ws + WS_BT))[su] = (bd[0] + bd[1]) + (bd[2] + bd[3]); }
        WG_BAR();
    }
}
__device__ __forceinline__ void ml_out_unit(const Args& a, unsigned char* lds_g, int u, int tid) {
    const int L = u & 7, h = (u >> 3) & 7, b = u >> 6;
    const int rowbase = NCTX + b * SEQ + 256 * L;
    const int lane = tid & 63, w = __builtin_amdgcn_readfirstlane(tid >> 6), fr = lane & 15, fq = lane >> 4;
    bf16* CB = (bf16*)(lds_g + ML_CB);
    ml_gates(a, lds_g, rowbase, h, tid);
    f32x4 st[9];
#pragma unroll
    for (int dir = 0; dir < 2; ++dir) {
        const int seq = (b * 8 + h) * 2 + dir, jmax = dir ? 7 - L : L;
        const float* BT = (const float*)(a.ws + WS_BT) + seq * 8;
        {
            const pg8::u32x2* SLa = (const pg8::u32x2*)(a.ws + WS_SLOC) + ((size_t)((seq * 8 + jmax) * 8 + w) * 9) * 64 + lane;
            const pg8::u32x2* SLb = (const pg8::u32x2*)(a.ws + WS_SLOC) + ((size_t)((seq * 8 + 3) * 8 + w) * 9) * 64 + lane;
            pg8::u32x2 sa[9];
            if (jmax >= 4) {
                pg8::u32x2 sb[9];
#pragma unroll
                for (int vt = 0; vt < 9; ++vt) { sa[vt] = SLa[vt * 64]; sb[vt] = SLb[vt * 64]; }
                float ls = 0.f;
#pragma unroll
                for (int q = 4; q < 8; ++q) ls += (q <= jmax) ? BT[q] : 0.f;
                const float coef = __expf(ls);
#pragma unroll
                for (int vt = 0; vt < 9; ++vt) st[vt] = (f32x4){bflo(sa[vt].x) + bflo(sb[vt].x) * coef, bfhi(sa[vt].x) + bfhi(sb[vt].x) * coef, bflo(sa[vt].y) + bflo(sb[vt].y) * coef, bfhi(sa[vt].y) + bfhi(sb[vt].y) * coef};
            } else {
#pragma unroll
                for (int vt = 0; vt < 9; ++vt) { sa[vt] = SLa[vt * 64]; st[vt] = (f32x4){bflo(sa[vt].x), bfhi(sa[vt].x), bflo(sa[vt].y), bfhi(sa[vt].y)}; }
            }
        }
#pragma unroll
        for (int vt = 0; vt < 9; ++vt) { pg8::u32x2 o; o.x = pk2(st[vt][0], st[vt][1]); o.y = pk2(st[vt][2], st[vt][3]); *(pg8::u32x2*)(CB + (16 * vt + fr) * ML_STRIDE + 16 * w + 4 * fq) = o; }
        WG_BAR();
        if (dir == 0) ml_block<true, false>(a, lds_g, rowbase, h, 0, st, tid);
        else ml_block<true, true>(a, lds_g, rowbase, h, 1, st, tid);
        asm volatile("s_waitcnt vmcnt(0)" ::: "memory");
        WG_BAR();
    }
}

__device__ __forceinline__ void lru_out_unit(const Args& a, unsigned char* lds_g, int b, int cidx, int blk, int tid) {
    const int chl = tid & 127, q = tid >> 7, ch = blk * 128 + chl;
    float2* QA = (float2*)lds_g;
    float av[2][16], bv[2][16];
#pragma unroll
    for (int d = 0; d < 2; ++d) { const unsigned* PS = (const unsigned*)(a.ws + WS_PS) + ((size_t)(b * 2 + d) * NSTEP + 64 * cidx + 16 * q) * 1024 + ch;
#pragma unroll
        for (int i = 0; i < 16; ++i) { const unsigned wv = PS[(size_t)i * 1024]; av[d][i] = 1.f - bflo(wv); bv[d][i] = bfhi(wv); } }
    float2* CA = (float2*)(lds_g + 8192);
#pragma unroll
    for (int d = 0; d < 2; ++d) { const float2* AGG = (const float2*)(a.ws + WS_AGG) + ((size_t)(b * 2 + d) * 36) * 1024 + ch; float2 qv[9];
#pragma unroll
        for (int i = 0; i < 9; ++i) { const int sidx = 9 * q + i; const int c2 = d ? (sidx < 4 ? 3 - sidx : 39 - sidx) : sidx; qv[i] = AGG[(size_t)c2 * 1024]; }
        float P = 1.f, S = 0.f;
#pragma unroll
        for (int i = 0; i < 9; ++i) { const int sidx = 9 * q + i; const int c2 = d ? (sidx < 4 ? 3 - sidx : 39 - sidx) : sidx; const bool use = d ? (sidx < 4 || c2 > cidx) : (c2 < cidx);
            S = use ? qv[i].x * S + qv[i].y : S; P = use ? qv[i].x * P : P; }
        CA[(d * 4 + q) * 128 + chl] = make_float2(P, S); }
#pragma unroll
    for (int d = 0; d < 2; ++d) { float P = 1.f, S = 0.f;
#pragma unroll
        for (int ii = 0; ii < 16; ++ii) { const int i = d ? 15 - ii : ii; S = av[d][i] * S + bv[d][i]; P = av[d][i] * P; }
        QA[(d * 4 + q) * 128 + chl] = make_float2(P, S); }
    WG_BAR();
    float hs[16];
#pragma unroll
    for (int d = 0; d < 2; ++d) { float h = 0.f;
#pragma unroll
        for (int k = 0; k < 4; ++k) { const float2 t = CA[(d * 4 + k) * 128 + chl]; h = t.x * h + t.y; }
#pragma unroll
        for (int k = 0; k < 3; ++k) { const int qq = d ? 3 - k : k; const bool use = d ? (qq > q) : (qq < q); const float2 t = QA[(d * 4 + qq) * 128 + chl]; h = use ? t.x * h + t.y : h; }
#pragma unroll
        for (int ii = 0; ii < 16; ++ii) { const int i = d ? 15 - ii : ii; h = av[d][i] * h + bv[d][i]; if (d == 0) hs[i] = h; else hs[i] += h; } }
    const int p0 = (cidx - 4) * 64 + 16 * q;
    unsigned short ugv[16];
#pragma unroll
    for (int i = 0; i < 16; ++i) ugv[i] = ((const bf16*)(a.ws + WS_UG))[(size_t)(lru_pos_row(b, false, p0 + i) - NCTX) * 1024 + ch];
#pragma unroll
    for (int i = 0; i < 16; ++i) { const size_t lrow = (size_t)(lru_pos_row(b, false, p0 + i) - NCTX) * 1024 + ch;
        ((bf16*)(a.ws + WS_YB))[lrow] = (bf16)f2bf(hs[i] * bf2f(ugv[i])); }
    WG_BAR();
}
__device__ __forceinline__ void phase3(const Args& a, unsigned char* lds_g, int tid) {
    {
        int q0 = (int)blockIdx.x, qstep = (int)gridDim.x;
        if (gridDim.x == 256) q0 = blockIdx.x >= 128 ? (int)blockIdx.x - 128 : 128;
        for (int qu = q0; qu < 128; qu += qstep) ml_state_quad(a, lds_g, qu, tid);
    }
    for (int u = blockIdx.x; u < 4 * 36 * 8; u += gridDim.x) { const int blk = u & 7, q = u >> 3; lru_unit<false>(a, lds_g, q / 36, q % 36, blk, tid); }
}

struct SchedProj {
    int G, c; const char *YA, *YB, *WA, *WB;
    __device__ __forceinline__ bool next(int i, pg8::Unit& u) const {
        const int tile = (i >> 1) * G + c, part = i & 1; if (tile >= 256) return false;
        int pm, pn; pg8::tile_order(tile, 32, 8, pm, pn);
        u.pm = pm; u.pn = pn; u.aux = part; u.A = (part ? YB : YA) + (size_t)pm * 256 * 1024 * 2; u.B = (part ? WB : WA) + (size_t)pn * 256 * 1024 * 2; return true;
    }
};
struct EpiProj {
    static constexpr bool PERM = true;
    const bf16 *GA, *GB; bf16* PRE;
    __device__ __forceinline__ void operator()(const pg8::f32x4 (&acc)[2][2][4][2], const pg8::Unit& u, int wr, int wc, int fr, int fq) const {
        const bf16* gsrc = u.aux ? GB : GA;
#pragma unroll
        for (int ai = 0; ai < 2; ++ai) {
            pg8::u32x4 gw[4][2], pw[4][2];
#pragma unroll
            for (int m = 0; m < 4; ++m) { const size_t off = (size_t)(u.pm * 256 + ai * 128 + wr * 64 + m * 16 + fr) * 2048 + u.pn * 256 + wc * 32 + 8 * fq;
#pragma unroll
                for (int bj = 0; bj < 2; ++bj) { gw[m][bj] = *(const pg8::u32x4*)(gsrc + off + bj * 128); if (u.aux) pw[m][bj] = *(const pg8::u32x4*)(PRE + off + bj * 128); } }
#pragma unroll
            for (int m = 0; m < 4; ++m) { const size_t off = (size_t)(u.pm * 256 + ai * 128 + wr * 64 + m * 16 + fr) * 2048 + u.pn * 256 + wc * 32 + 8 * fq;
#pragma unroll
                for (int bj = 0; bj < 2; ++bj) { const pg8::u32x4 g4 = gw[m][bj];
                    pg8::f32x4 v0 = acc[ai][bj][m][0], v1 = acc[ai][bj][m][1];
                    v0[0] *= bflo(g4.x); v0[1] *= bfhi(g4.x); v0[2] *= bflo(g4.y); v0[3] *= bfhi(g4.y); v1[0] *= bflo(g4.z); v1[1] *= bfhi(g4.z); v1[2] *= bflo(g4.w); v1[3] *= bfhi(g4.w);
                    if (u.aux) { const pg8::u32x4 p4 = pw[m][bj];
                        v0[0] += bflo(p4.x); v0[1] += bfhi(p4.x); v0[2] += bflo(p4.y); v0[3] += bfhi(p4.y); v1[0] += bflo(p4.z); v1[1] += bfhi(p4.z); v1[2] += bflo(p4.w); v1[3] += bfhi(p4.w); }
                    pg8::u32x4 w; w.x = pg8::cvt_pk_bf16(v0[0], v0[1]); w.y = pg8::cvt_pk_bf16(v0[2], v0[3]); w.z = pg8::cvt_pk_bf16(v1[0], v1[1]); w.w = pg8::cvt_pk_bf16(v1[2], v1[3]);
                    *(pg8::u32x4*)(PRE + off + bj * 128) = w; } }
        }
    }
};

struct SchedOut {
    int G, c; const char *A, *B;
    __device__ __forceinline__ bool next(int i, pg8::Unit& u) const {
        const int L = i * G + c; if (L >= 256) return false;
        int pm, pn; pg8::tile_order(L, 32, 8, pm, pn);
        u.pm = pm; u.pn = pn; u.aux = 0; u.A = A + (size_t)pm * 256 * D * 2; u.B = B + (size_t)pn * 256 * D * 2; return true;
    }
};
struct EpiOut {
    static constexpr bool PERM = true;
    const float* x; const float* MOD; bf16* X1;
    __device__ __forceinline__ void operator()(const pg8::f32x4 (&acc)[2][2][4][2], const pg8::Unit& u, int wr, int wc, int fr, int fq) const {
        const int b = u.pm >> 3; const int col0 = u.pn * 256 + wc * 32 + 8 * fq;
        pg8::f32x4 g1[2][2];
#pragma unroll
        for (int bj = 0; bj < 2; ++bj)
#pragma unroll
            for (int n = 0; n < 2; ++n) g1[bj][n] = *(const pg8::f32x4*)(MOD + b * 12288 + 2 * 2048 + col0 + bj * 128 + n * 4);
#pragma unroll
        for (int ai = 0; ai < 2; ++ai) {
            pg8::f32x4 xv[4][2][2];
#pragma unroll
            for (int m = 0; m < 4; ++m) { const size_t off = (size_t)(u.pm * 256 + ai * 128 + wr * 64 + m * 16 + fr) * D + col0;
#pragma unroll
                for (int bj = 0; bj < 2; ++bj)
#pragma unroll
                    for (int n = 0; n < 2; ++n) xv[m][bj][n] = *(const pg8::f32x4*)(x + off + bj * 128 + n * 4); }
#pragma unroll
            for (int m = 0; m < 4; ++m) { const size_t off = (size_t)(u.pm * 256 + ai * 128 + wr * 64 + m * 16 + fr) * D + col0;
#pragma unroll
                for (int bj = 0; bj < 2; ++bj) { const pg8::f32x4 v0 = xv[m][bj][0] + g1[bj][0] * acc[ai][bj][m][0], v1 = xv[m][bj][1] + g1[bj][1] * acc[ai][bj][m][1];
                    pg8::u32x4 w; w.x = pg8::cvt_pk_bf16(v0[0], v0[1]); w.y = pg8::cvt_pk_bf16(v0[2], v0[3]); w.z = pg8::cvt_pk_bf16(v1[0], v1[1]); w.w = pg8::cvt_pk_bf16(v1[2], v1[3]);
                    *(pg8::u32x4*)(X1 + off + bj * 128) = w; } }
        }
    }
};

__device__ __forceinline__ void phase_router(const Args& a, unsigned char* lds_g, int tid, int lane, int wave) {
    const bf16* X1 = (const bf16*)(a.ws + WS_X1); const float* MOD = (const float*)(a.ws + WS_MOD); const float* g = a.in[I_N2G];
    const float* WR = (const float*)(a.ws + WS_WR); const float* RB = (const float*)(a.ws + WS_RB);
    bf16* H2 = (bf16*)(a.ws + WS_H2); unsigned* cnt = (unsigned*)(a.ws + WS_CTL) + CW_CNT; int4* ASG = (int4*)(a.ws + WS_ASG);
    f32x4* PART = (f32x4*)lds_g;
    float* SSQP = (float*)(lds_g + 24576);
    float* RS = (float*)(lds_g + 24576 + 512);
    float* LG = (float*)(lds_g + 24576 + 1024);
    const int slot = wave >> 2, kq = wave & 3, i = lane & 15, gq = lane >> 4;
    for (int tp = blockIdx.x; tp < NLAT / 32; tp += gridDim.x) {
        const int tok0 = 32 * tp + 16 * slot, b = tok0 >> 11, kbase = kq * 512 + 8 * gq;
        const bf16* xr = X1 + (size_t)(tok0 + i) * D + kbase;
        const float* wr = WR + ((size_t)(b * 48 + i) * 2048 + kbase);
        f32x4 acc0 = (f32x4){0.f, 0.f, 0.f, 0.f}, acc1 = acc0, acc2 = acc0; float sq = 0.f;
#pragma unroll 2
        for (int s8 = 0; s8 < 16; ++s8) {
            const v4u xb = *(const v4u*)(xr + 32 * s8);
            const f32x4 b0a = *(const f32x4*)(wr + 32 * s8), b0b = *(const f32x4*)(wr + 32 * s8 + 4), b1a = *(const f32x4*)(wr + 16 * 2048 + 32 * s8), b1b = *(const f32x4*)(wr + 16 * 2048 + 32 * s8 + 4),
                        b2a = *(const f32x4*)(wr + 32 * 2048 + 32 * s8), b2b = *(const f32x4*)(wr + 32 * 2048 + 32 * s8 + 4);
            const float xe[8] = {bflo(xb.x), bfhi(xb.x), bflo(xb.y), bfhi(xb.y), bflo(xb.z), bfhi(xb.z), bflo(xb.w), bfhi(xb.w)};
#pragma unroll
            for (int e = 0; e < 4; ++e) { acc0 = __builtin_amdgcn_mfma_f32_16x16x4f32(xe[e], b0a[e], acc0, 0, 0, 0); acc1 = __builtin_amdgcn_mfma_f32_16x16x4f32(xe[e], b1a[e], acc1, 0, 0, 0); acc2 = __builtin_amdgcn_mfma_f32_16x16x4f32(xe[e], b2a[e], acc2, 0, 0, 0); }
#pragma unroll
            for (int e = 0; e < 4; ++e) { acc0 = __builtin_amdgcn_mfma_f32_16x16x4f32(xe[4 + e], b0b[e], acc0, 0, 0, 0); acc1 = __builtin_amdgcn_mfma_f32_16x16x4f32(xe[4 + e], b1b[e], acc1, 0, 0, 0); acc2 = __builtin_amdgcn_mfma_f32_16x16x4f32(xe[4 + e], b2b[e], acc2, 0, 0, 0); }
#pragma unroll
            for (int e = 0; e < 8; ++e) sq += xe[e] * xe[e];
        }
        sq += __shfl_xor(sq, 16); sq += __shfl_xor(sq, 32);
        PART[((slot * 4 + kq) * 3 + 0) * 64 + lane] = acc0; PART[((slot * 4 + kq) * 3 + 1) * 64 + lane] = acc1; PART[((slot * 4 + kq) * 3 + 2) * 64 + lane] = acc2;
        if (gq == 0) SSQP[(slot * 4 + kq) * 16 + i] = sq;
        __syncthreads();
        if (kq == 0) {
            const float* sp = SSQP + slot * 64; const float rstd = 1.f / sqrtf(((sp[i] + sp[16 + i]) + (sp[32 + i] + sp[48 + i])) * (1.f / D) + EPS);
            if (gq == 0) RS[slot * 16 + i] = rstd;
#pragma unroll
            for (int cb = 0; cb < 3; ++cb) { const f32x4* pp = PART + (slot * 4 * 3 + cb) * 64 + lane; const f32x4 sum = (pp[0] + pp[3 * 64]) + (pp[6 * 64] + pp[9 * 64]);
                const float rb = RB[b * 48 + 16 * cb + i];
#pragma unroll
                for (int r = 0; r < 4; ++r) LG[(slot * 16 + 4 * gq + r) * 48 + 16 * cb + i] = __shfl(rstd, 4 * gq + r) * sum[r] + rb; }
            LDS_WAIT(); asm volatile("" ::: "memory");
            if (lane < 16) {
                const float* lg = LG + (slot * 16 + lane) * 48; const int t = tok0 + lane;
                int gs = 0; float gm = lg[32];
#pragma unroll
                for (int q = 1; q < 4; ++q) { const float v = lg[32 + q]; if (v > gm) { gm = v; gs = q; } }
                float se = 0.f;
#pragma unroll
                for (int q = 0; q < 4; ++q) se += __expf(lg[32 + q] - gm);
                const float pg = 1.f / se;
                int i0 = 0; float v0 = lg[gs * 8];
#pragma unroll
                for (int q = 1; q < 8; ++q) { const float v = lg[gs * 8 + q]; if (v > v0) { v0 = v; i0 = q; } }
                int i1 = -1; float v1 = -3.0e38f;
#pragma unroll
                for (int q = 0; q < 8; ++q) { const float v = lg[gs * 8 + q]; if (q != i0 && v > v1) { v1 = v; i1 = q; } }
                const float e1 = __expf(v1 - v0), w0 = pg / (1.f + e1), w1 = pg * e1 / (1.f + e1);
                const int ex0 = gs * 8 + i0, ex1 = gs * 8 + i1;
                const unsigned p0 = atomicAdd(cnt + ex0, 1u), p1 = atomicAdd(cnt + ex1, 1u);
                ASG[2 * t] = make_int4(ex0, (int)p0, __float_as_int(w0), 0); ASG[2 * t + 1] = make_int4(ex1, (int)p1, __float_as_int(w1), 0);
                int* LIST = (int*)(a.ws + WS_LIST); LIST[ex0 * 8192 + (int)p0] = t; LIST[ex1 * 8192 + (int)p1] = t;
            }
        }
        __syncthreads();
#pragma unroll
        for (int r = 0; r < 4; ++r) { const int tl = 4 * kq + r, t = tok0 + tl; const float rstd = RS[slot * 16 + tl];
            const unsigned long long* xrow = (const unsigned long long*)(X1 + (size_t)t * D) + lane; unsigned long long* o8 = (unsigned long long*)(H2 + (size_t)t * D) + lane;
            f32x4 yv[8];
#pragma unroll
            for (int j = 0; j < 8; ++j) { const int c = 4 * lane + 256 * j;
                const f32x4 gg = *(const f32x4*)(g + c), sh = *(const f32x4*)(MOD + b * 12288 + 3 * 2048 + c), sc = *(const f32x4*)(MOD + b * 12288 + 4 * 2048 + c);
                const unsigned long long xw = xrow[64 * j]; const f32x4 xv4 = (f32x4){bflo((unsigned)xw), bfhi((unsigned)xw), bflo((unsigned)(xw >> 32)), bfhi((unsigned)(xw >> 32))};
                yv[j] = xv4 * rstd * gg * (sc + 1.f) + sh; }
#pragma unroll
            for (int j = 0; j < 8; ++j) o8[64 * j] = (unsigned long long)pk2(yv[j].x, yv[j].y) | ((unsigned long long)pk2(yv[j].z, yv[j].w) << 32); }
        __syncthreads();
    }
}

constexpr int MG_A = 0, MG_ABYTES = 32768, MG_B = 65536, MG_BBYTES = 64 * 256  , MG_CUM = 141312  ;
__device__ __forceinline__ int mgb_off(int row, int ch) { return 256 * row + 16 * (ch ^ (((row & 3) << 2) | ((row >> 2) & 3))); }
__device__ __forceinline__ bf16x8_t mgb_frag(const unsigned char* img, int ks, int c, int lane) {
    const int g = lane >> 4, q = (lane & 15) >> 2, p = lane & 3;
    const s4_t lo = ds_tr((const bf16*)(img + mgb_off(32 * ks + 8 * g + q, 2 * c + (p >> 1)) + 8 * (p & 1)));
    const s4_t hi = ds_tr((const bf16*)(img + mgb_off(32 * ks + 8 * g + 4 + q, 2 * c + (p >> 1)) + 8 * (p & 1)));
    return (bf16x8_t){lo.x, lo.y, lo.z, lo.w, hi.x, hi.y, hi.z, hi.w};
}
__device__ __forceinline__ void moe_tables(const Args& a, unsigned char* lds_g, int tid) {
    int* cum = (int*)(lds_g + MG_CUM); const unsigned* ctl = (const unsigned*)(a.ws + WS_CTL);
    if (tid < NEXP) cum[128 + tid] = (int)ctl[CW_CNT + tid];
    if (tid == 0) { int c = 0; for (int e = 0; e < NEXP; ++e) { cum[e] = c; c += (int)((ctl[CW_CNT + e] + 255u) >> 8); } cum[NEXP] = c; }
    __syncthreads();
}
constexpr int MH_A = 0, MH_ABYTES = 32768, MH_B = 65536, MH_BROW = 528, MH_BBYTES = 64 * MH_BROW  ;
__device__ __forceinline__ int mhb_off(int row, int ch) { return MH_BROW * row + 16 * ch; }
__device__ __forceinline__ bf16x8_t mhb_frag(const unsigned char* img, int ks, int c, int lane) {
    const int g = lane >> 4, q = (lane & 15) >> 2, p = lane & 3;
    const s4_t lo = ds_tr((const bf16*)(img + mhb_off(32 * ks + 8 * g + q, 2 * c + (p >> 1)) + 8 * (p & 1)));
    const s4_t hi = ds_tr((const bf16*)(img + mhb_off(32 * ks + 8 * g + 4 + q, 2 * c + (p >> 1)) + 8 * (p & 1)));
    return (bf16x8_t){lo.x, lo.y, lo.z, lo.w, hi.x, hi.y, hi.z, hi.w};
}
__device__ __forceinline__ int moe_pull(const Args& a, unsigned char* lds_g, int tid, int x) {
    int* slot = (int*)(lds_g + MG_CUM + 256);
    __syncthreads();
    if (tid == 0) *slot = (int)__hip_atomic_fetch_add((unsigned*)(a.ws + WS_CTL) + CW_Q + 64 * x, 1u, __ATOMIC_RELAXED, __HIP_MEMORY_SCOPE_AGENT);
    __syncthreads();
    return *slot;
}
template <int MODE>
__device__ __forceinline__ int moe_gemm(const Args& a, unsigned char* lds_g, int tid, int idx0) {
    constexpr int K = MODE == 1 ? D : DE, NT = K / 64;
#define MG_BAR() do { asm volatile("s_waitcnt lgkmcnt(0)" ::: "memory"); __builtin_amdgcn_s_barrier(); asm volatile("" ::: "memory"); } while (0)
    const int lane = tid & 63, w = __builtin_amdgcn_readfirstlane(tid >> 6), fr = lane & 15, fq = lane >> 4;
    const int wm = w >> 1, wn = w & 1, hh = wm >> 1, wr = wm & 1;
    const int* cum = (const int*)(lds_g + MG_CUM); const unsigned* ctl = (const unsigned*)(a.ws + WS_CTL);
    const int T = cum[NEXP], x = blockIdx.x & 7;
    const int aoff = pg8::lds_byte(wr * 64 + fr, fq * 8);
    const int bk = tid >> 6, bp = tid & 63;
    int aR[2], aC[2];
#pragma unroll
    for (int i = 0; i < 2; ++i) pg8::stage_rc(tid * 16 + i * 8192, aR[i], aC[i]);
    for (int idx = idx0;;) {
        if (idx < 0) idx = moe_pull(a, lds_g, tid, x);
        if (idx >= (MODE == 1 ? T : 2 * T)) return idx;
        const int ti = MODE == 1 ? idx : idx - T;
        idx = -1;
        const int nt = x;
        if (MODE == 2) {
            if (tid < 64) { unsigned* tc = (unsigned*)(a.ws + WS_CTL) + CW_TC + 64 * ti; unsigned spins = 0;
                while ((unsigned)__builtin_amdgcn_readfirstlane(__hip_atomic_load(tc, __ATOMIC_RELAXED, __HIP_MEMORY_SCOPE_AGENT)) < 64u) {
                    __builtin_amdgcn_s_sleep(2);
                    if (++spins > (1u << 22)) { if (tid == 0) __hip_atomic_store((unsigned*)(a.ws + WS_CTL) + 1, 0x900u + (unsigned)ti, __ATOMIC_RELAXED, __HIP_MEMORY_SCOPE_AGENT); break; } }
                __builtin_amdgcn_fence(__ATOMIC_ACQUIRE, "agent");
                asm volatile("s_waitcnt vmcnt(0)" ::: "memory"); }
            __syncthreads();
        }
        int e = 0;
#pragma unroll 1
        for (int q = 1; q < NEXP; ++q) e = (cum[q] <= ti) ? q : e;
        const int mt = ti - cum[e];
        const char* abase; unsigned aofs[4]; const char* bbase; unsigned bofs; size_t bld;
        if (MODE == 1) { const int cnt = cum[128 + e];
#pragma unroll
            for (int q = 0; q < 4; ++q) { const int pos = 256 * mt + 128 * (q >> 1) + aR[q & 1]; const int tok = pos < cnt ? ((const int*)(a.ws + WS_LIST))[e * 8192 + pos] : 0;
                aofs[q] = (unsigned)(tok * D + aC[q & 1]) * 2u; }
            abase = (const char*)(a.ws + WS_H2);
            const int seg = bp >> 4, mat = seg & 1, col = 128 * nt + 64 * (seg >> 1) + 4 * (bp & 15);
            bbase = (const char*)(a.in[mat ? I_W3 : I_W1] + (size_t)e * D * DE); bofs = (unsigned)(bk * DE + col) * 4u; bld = DE; }
        else {
#pragma unroll
            for (int q = 0; q < 4; ++q) aofs[q] = (unsigned)((128 * (q >> 1) + aR[q & 1]) * DE + aC[q & 1]) * 2u;
            abase = (const char*)((const bf16*)(a.ws + WS_HM) + (size_t)256 * ti * DE);
            bbase = (const char*)(a.in[I_W2] + (size_t)e * DE * D); bofs = (unsigned)(bk * D + 256 * nt + 4 * bp) * 4u; bld = D; }
        const int bwr0 = mhb_off(bk, bp >> 1) + 8 * (bp & 1);
        f32x4 acc[4][8];
#pragma unroll
        for (int m = 0; m < 4; ++m)
#pragma unroll
            for (int n = 0; n < 8; ++n) acc[m][n] = (f32x4){0.f, 0.f, 0.f, 0.f};
        v4u ra[4]; f32x4 rb[8];
#define MH_LD(t_) do { _Pragma("unroll") for (int j_ = 0; j_ < 4; ++j_) ra[j_] = *(const v4u*)(abase + aofs[j_] + 128 * (t_)); \
        _Pragma("unroll") for (int j_ = 0; j_ < 8; ++j_) rb[j_] = *(const f32x4*)(bbase + bofs + (size_t)(64 * (t_) + 8 * j_) * bld * 4); } while (0)
#define MH_ST(buf_) do { _Pragma("unroll") for (int j_ = 0; j_ < 4; ++j_) *(v4u*)(lds_g + MH_A + (buf_) * MH_ABYTES + (j_ >> 1) * 16384 + (j_ & 1) * 8192 + tid * 16) = ra[j_]; \
        _Pragma("unroll") for (int j_ = 0; j_ < 8; ++j_) { pg8::u32x2 o_; o_.x = pk2(rb[j_].x, rb[j_].y); o_.y = pk2(rb[j_].z, rb[j_].w); *(pg8::u32x2*)(lds_g + MH_B + (buf_) * MH_BBYTES + bwr0 + j_ * 8 * MH_BROW) = o_; } } while (0)
#define MH_MMA(buf_) do { const unsigned char* Bi_ = lds_g + MH_B + (buf_) * MH_BBYTES; \
        _Pragma("unroll") for (int ks_ = 0; ks_ < 2; ++ks_) { bf16x8_t af_[4]; \
            _Pragma("unroll") for (int m_ = 0; m_ < 4; ++m_) af_[m_] = *(const bf16x8_t*)(lds_g + MH_A + (buf_) * MH_ABYTES + hh * 16384 + aoff + m_ * 2048 + ks_ * 1024); \
            _Pragma("unroll") for (int n_ = 0; n_ < 8; n_ += 2) { const bf16x8_t bf0_ = mhb_frag(Bi_, ks_, 8 * wn + n_, lane), bf1_ = mhb_frag(Bi_, ks_, 8 * wn + n_ + 1, lane); \
                _Pragma("unroll") for (int m_ = 0; m_ < 4; ++m_) { acc[m_][n_] = __builtin_amdgcn_mfma_f32_16x16x32_bf16(bf0_, af_[m_], acc[m_][n_], 0, 0, 0); \
                    acc[m_][n_ + 1] = __builtin_amdgcn_mfma_f32_16x16x32_bf16(bf1_, af_[m_], acc[m_][n_ + 1], 0, 0, 0); } \
                __builtin_amdgcn_sched_barrier(0); } } } while (0)
        MH_LD(0);
        MG_BAR();
        MH_ST(0);
        MH_LD(1);
        for (int t = 0; t < NT; t += 2) {
            const int t2 = (t + 2 < NT) ? t + 2 : NT - 1, t3 = (t + 3 < NT) ? t + 3 : NT - 1;
            MG_BAR();
            MH_ST(1);
            MH_LD(t2);
            MH_MMA(0);
            MG_BAR();
            MH_ST(0);
            MH_LD(t3);
            MH_MMA(1);
        }
#undef MH_LD
#undef MH_ST
#undef MH_MMA
        const size_t row0 = (size_t)256 * ti + 128 * hh + 64 * wr + fr;
        if (MODE == 1) { bf16* HM = (bf16*)(a.ws + WS_HM);
#pragma unroll
            for (int m = 0; m < 4; ++m)
#pragma unroll
                for (int n = 0; n < 4; ++n) { float hv[4];
#pragma unroll
                    for (int r = 0; r < 4; ++r) { const float a1 = acc[m][n][r]; hv[r] = a1 * sigmoidf_(a1) * acc[m][n + 4][r]; }
                    const unsigned long long o = (unsigned long long)pk2(hv[0], hv[1]) | ((unsigned long long)pk2(hv[2], hv[3]) << 32);
                    __hip_atomic_store((unsigned long long*)(HM + (row0 + 16 * m) * DE + 128 * nt + 64 * wn + 16 * n + 4 * fq), o, __ATOMIC_RELAXED, __HIP_MEMORY_SCOPE_AGENT); }
            asm volatile("s_waitcnt vmcnt(0)" ::: "memory");
            if (lane == 0) __hip_atomic_fetch_add((unsigned*)(a.ws + WS_CTL) + CW_TC + 64 * ti, 1u, __ATOMIC_RELAXED, __HIP_MEMORY_SCOPE_AGENT); }
        else { bf16* Y2 = (bf16*)(a.ws + WS_Y2);
#pragma unroll
            for (int m = 0; m < 4; ++m)
#pragma unroll
                for (int n = 0; n < 8; ++n) { pg8::u32x2 o; o.x = pk2(acc[m][n][0], acc[m][n][1]); o.y = pk2(acc[m][n][2], acc[m][n][3]);
                    *(pg8::u32x2*)(Y2 + (row0 + 16 * m) * D + 256 * nt + 128 * wn + 16 * n + 4 * fq) = o; } }
    }
#undef MG_BAR
}

__device__ __forceinline__ void phase12(const Args& a, unsigned char* lds_g, int lane, int wave) {
    const int gw = blockIdx.x * NWAVES + wave, NGW = gridDim.x * NWAVES;
    const int* cum = (const int*)(lds_g + MG_CUM);
    const bf16* X1 = (const bf16*)(a.ws + WS_X1); const float* MOD = (const float*)(a.ws + WS_MOD); const float* fg = a.in[I_FG];
    const int4* ASG = (const int4*)(a.ws + WS_ASG); const bf16* Y2 = (const bf16*)(a.ws + WS_Y2);
    for (int t = gw; t < NLAT; t += NGW) {
        const int b = t >> 11; const int4 q0 = ASG[2 * t], q1 = ASG[2 * t + 1];
        const float w0 = __int_as_float(q0.z), w1 = __int_as_float(q1.z);
        const unsigned long long* xr = (const unsigned long long*)(X1 + (size_t)t * D) + lane;
        const unsigned long long* y0 = (const unsigned long long*)(Y2 + (size_t)(256 * cum[q0.x] + q0.y) * D) + lane; const unsigned long long* y1 = (const unsigned long long*)(Y2 + (size_t)(256 * cum[q1.x] + q1.y) * D) + lane;
        f32x4 v[8]; float s = 0.f;
#pragma unroll
        for (int j = 0; j < 8; ++j) {
            const int c = 4 * lane + 256 * j;
            const f32x4 g2 = *(const f32x4*)(MOD + b * 12288 + 5 * 2048 + c);
            const unsigned long long a0 = y0[64 * j], a1 = y1[64 * j];
            f32x4 y; y.x = w0 * bflo((unsigned)a0) + w1 * bflo((unsigned)a1); y.y = w0 * bfhi((unsigned)a0) + w1 * bfhi((unsigned)a1);
            y.z = w0 * bflo((unsigned)(a0 >> 32)) + w1 * bflo((unsigned)(a1 >> 32)); y.w = w0 * bfhi((unsigned)(a0 >> 32)) + w1 * bfhi((unsigned)(a1 >> 32));
            const unsigned long long xw = xr[64 * j];
            v[j] = (f32x4){bflo((unsigned)xw), bfhi((unsigned)xw), bflo((unsigned)(xw >> 32)), bfhi((unsigned)(xw >> 32))} + g2 * y;
            s += (v[j].x * v[j].x + v[j].y * v[j].y) + (v[j].z * v[j].z + v[j].w * v[j].w);
        }
        const float rstd = 1.f / sqrtf(wave_sum(s) * (1.f / D) + EPS);
        f32x4* o = (f32x4*)(a.out + (size_t)t * D) + lane; f32x4 fgv[8];
#pragma unroll
        for (int j = 0; j < 8; ++j) fgv[j] = *(const f32x4*)(fg + 4 * lane + 256 * j);
#pragma unroll
        for (int j = 0; j < 8; ++j) o[64 * j] = v[j] * rstd * fgv[j];
    }
}

__global__ void __launch_bounds__(NTHR, 2) fwd_kernel(Args args) {
    extern __shared__ __attribute__((aligned(16))) unsigned char lds[];
    LAS unsigned char* ldsl = (LAS unsigned char*)lds;
    volatile LAS unsigned* MISC = (volatile LAS unsigned*)(ldsl + MISC_OFF);
    LAS unsigned* TL = (LAS unsigned*)(ldsl + LDSCTL_OFF);
    const int wave_s = __builtin_amdgcn_readfirstlane(threadIdx.x >> 6);
#define TID() make_tid(wave_s)
    { const int t0 = TID(); for (int u = t0; u < (LDS_BYTES - LDSCTL_OFF) / 4; u += NTHR) ((LAS unsigned*)(ldsl + LDSCTL_OFF))[u] = 0u; }
    __syncthreads();
    unsigned char* ws = args.ws;
    unsigned* ctl = (unsigned*)(ws + WS_CTL);
    XcdBarrier bar; bar.bar = ctl + CW_BAR; bar.x = 0; bar.st = nullptr;
    const bool one_launch = (args.ph_hi - args.ph_lo) > 1;
    if (one_launch) bar = xcd_barrier_post(ctl + CW_BAR, MISC + 8, TID());
    const int lo = args.ph_lo, hi = args.ph_hi;
#define IN(k) (lo <= (k) && (k) < hi)
#define SEAM(k) do { if (IN(k) && IN((k) + 1)) xcd_barrier(bar, TID()); } while (0)
    const int G = gridDim.x, c = blockIdx.x;

#define FRESH() const int tid = TID(), lane = tid & 63, wave = __builtin_amdgcn_readfirstlane(tid >> 6); (void)lane; (void)wave
#ifndef DUP_PHASE
#define DUP_PHASE (-1)
#endif
#define PH(k, ...) if (IN(k)) { _Pragma("unroll") for (int rep_ = 0; rep_ < ((DUP_PHASE) == (k) ? 2 : 1); ++rep_) { if (rep_) xcd_barrier(bar, TID()); __VA_ARGS__ } } SEAM(k);
    PH(0, { FRESH(); phase0(args, lds, tid, lane, wave); mod_wait(args, tid); phase1(args, lane, wave); })
    PH(1, {
        SchedIn S{G, c, (const char*)(ws + WS_H), (const char*)(ws + WS_WIN)}; EpiIn E{ws, args.in[I_BGATES]};
        pg8::gemm_phase<EpiIn, SchedIn>(ldsl, D, S, E, TID());
        { const int R_ = (1492 + G - 1) / G; int fi_ = 1492 - (R_ - 1) * G; if (fi_ >= G) fi_ = 0;
          if (c >= fi_) { FRESH(); late_prep(args, lds, (c - fi_) * NWAVES + wave, (G - fi_) * NWAVES, lane, wave); } } })
    PH(2, { FRESH(); phase3(args, lds, tid); })
    PH(3, { FRESH();
        for (int u = c; u < 256; u += G) ml_out_unit(args, lds, u, tid);
        for (int u = c; u < 4 * 32 * 8; u += G) { const int blk = u & 7, q = u >> 3; lru_out_unit(args, lds, q >> 5, 4 + (q & 31), blk, tid); } })
    PH(4, {
        SchedProj S{G, c, (const char*)(ws + WS_YA), (const char*)(ws + WS_YB), (const char*)(ws + WS_WPA), (const char*)(ws + WS_WPB)};
        EpiProj E{(const bf16*)(ws + WS_GA), (const bf16*)(ws + WS_GB), (bf16*)(ws + WS_PRE)};
        pg8::gemm_phase<EpiProj, SchedProj>(ldsl, 1024, S, E, TID()); })
    PH(5, {
        SchedOut S{G, c, (const char*)(ws + WS_PRE), (const char*)(ws + WS_WOUT)}; EpiOut E{args.in[I_X], (const float*)(ws + WS_MOD), (bf16*)(ws + WS_X1)};
        pg8::gemm_phase<EpiOut, SchedOut>(ldsl, D, S, E, TID()); })
    PH(6, { FRESH(); phase_router(args, lds, tid, lane, wave); })
    PH(7, { FRESH(); moe_tables(args, lds, tid); const int nx_ = moe_gemm<1>(args, lds, tid, -1); (void)moe_gemm<2>(args, lds, tid, nx_); })
    PH(8, { FRESH(); moe_tables(args, lds, tid); phase12(args, lds, lane, wave); })
#undef PH
#undef IN
#undef SEAM
}

extern "C" void kernel_launch(void* const* d_in, const int* in_sizes, int n_in, void* d_out, int out_size, void* d_ws, size_t ws_size, hipStream_t stream) {
    static int grid = 0;
    if (grid == 0) {
        if (n_in != 27 || out_size != NLAT * D || ws_size < WS_END) { fprintf(stderr, "kernel_launch: unexpected shapes (n_in %d, out %d, ws %zu)\n", n_in, out_size, ws_size); grid = -1; return; }
        int dev = 0, cus = 0, per_cu = 0;
        if (hipGetDevice(&dev) != hipSuccess || hipDeviceGetAttribute(&cus, hipDeviceAttributeMultiprocessorCount, dev) != hipSuccess) { grid = -1; return; }
        if (hipFuncSetAttribute((const void*)fwd_kernel, hipFuncAttributeMaxDynamicSharedMemorySize, LDS_BYTES) != hipSuccess) { fprintf(stderr, "kernel_launch: hipFuncSetAttribute failed\n"); grid = -1; return; }
        if (hipOccupancyMaxActiveBlocksPerMultiprocessor(&per_cu, (const void*)fwd_kernel, NTHR, LDS_BYTES) != hipSuccess || per_cu < 1) fprintf(stderr, "kernel_launch: occupancy query says %d\n", per_cu);
        (void)hipGetLastError();
        grid = cus;
    }
    if (grid < 0) return;
    (void)hipMemsetAsync((char*)d_ws + WS_CTL, 0, CTL_ZERO_BYTES, stream);
    Args a{};
    for (int i = 0; i < 27; ++i) a.in[i] = (const float*)d_in[i];
    a.out = (float*)d_out; a.ws = (unsigned char*)d_ws;
#if MK_ONE_LAUNCH
    a.ph_lo = 0; a.ph_hi = NPHASE;
    hipLaunchKernelGGL(fwd_kernel, dim3(grid), dim3(NTHR), LDS_BYTES, stream, a);
#else
    for (int p = 0; p < NPHASE; ++p) { a.ph_lo = p; a.ph_hi = p + 1; hipLaunchKernelGGL(fwd_kernel, dim3(grid), dim3(NTHR), LDS_BYTES, stream, a); }
#endif
}
```

```cpp
#include <hip/hip_runtime.h>
#include <cstdio>
#include <cstdint>

#ifndef MK_ONE_LAUNCH
#define MK_ONE_LAUNCH 1
#endif

namespace pg8 {
#define PG8_LAS __attribute__((address_space(3)))
typedef unsigned short bf16_t;
typedef short bf16x8 __attribute__((ext_vector_type(8)));
typedef float f32x4 __attribute__((ext_vector_type(4)));
typedef float f32x2 __attribute__((ext_vector_type(2)));
typedef unsigned u32x4 __attribute__((ext_vector_type(4)));
typedef unsigned u32x2 __attribute__((ext_vector_type(2)));
constexpr int BM = 256, BK = 64, HALF = 128, HTB = HALF * BK * 2  , STAGE_BYTES = 8 * HTB, NXCD = 8, WGM = 8;

__host__ __device__ __forceinline__ int lds_byte(int r, int c) { const int st = (r >> 4) * 2 + (c >> 5), rr = r & 15, cc = c & 31, ob = rr * 64 + cc * 2; return st * 1024 + (ob ^ (((ob >> 9) & 1) << 5)); }
__host__ __device__ __forceinline__ void stage_rc(int b, int& R, int& C) { const int st = b / 1024, sb = b % 1024, swz = sb ^ (((sb >> 9) & 1) << 5); R = (st >> 1) * 16 + swz / 64; C = (st & 1) * 32 + (swz % 64) / 2; }
__host__ __device__ __forceinline__ int perm32(int rho) { const int n = rho >> 4, i = rho & 15; return 8 * (i >> 2) + 4 * n + (i & 3); }

struct Unit { const char* A; const char* B; int pm, pn, aux; };

__host__ __device__ __forceinline__ void tile_order(int L, int nM, int nN, int& pm, int& pn) {
    const int nwg = nM * nN; int wgid = L;
    { const int q = nwg / NXCD, r = nwg % NXCD, xcd = wgid % NXCD, off = wgid / NXCD; wgid = (xcd < r ? xcd * (q + 1) : r * (q + 1) + (xcd - r) * q) + off; }
    const int nig = WGM * nN, gid = wgid / nig, fm = gid * WGM, gsz = (nM - fm) < WGM ? (nM - fm) : WGM;
    pm = fm + ((wgid % nig) % gsz); pn = (wgid % nig) / gsz;
}

typedef __bf16 bf16n2 __attribute__((ext_vector_type(2)));
__device__ __forceinline__ unsigned cvt_pk_bf16(float lo, float hi) { const f32x2 v = {lo, hi}; return __builtin_bit_cast(unsigned, __builtin_convertvector(v, bf16n2)); }

template <class Epi, class Sched>
__device__ __forceinline__ void gemm_phase(PG8_LAS unsigned char* lds, const int K, const Sched& S, const Epi& E, int tid) {
    const int wid = __builtin_amdgcn_readfirstlane(tid >> 6), lane = tid & 63, wr = wid >> 2, wc = wid & 3, fr = lane & 15, fq = lane >> 4;
    const int nt = K / BK;
    unsigned voffA[2], voffB[2];
#pragma unroll
    for (int i = 0; i < 2; ++i) { int R, C; stage_rc(tid * 16 + i * 8192, R, C); const int Rb = Epi::PERM ? ((R & ~31) + perm32(R & 31)) : R;
        voffA[i] = (unsigned)(R * K + C) * 2u; voffB[i] = (unsigned)(Rb * K + C) * 2u; }
    const size_t kstep = (size_t)(BK * 2);
    const size_t hstep = (size_t)HALF * K * 2;
    const unsigned ldsw = (unsigned)wid * 1024u;
    const int aoff = lds_byte(wr * 64 + fr, fq * 8), boff = lds_byte(wc * 32 + fr, fq * 8);
#define PG8_SA(b, h) (((b) * 2 + (h)) * HTB)
#define PG8_SB(b, h) ((4 + (b) * 2 + (h)) * HTB)
#define PG8_STAGE(bufoff, gbase, voff) do { _Pragma("unroll") for (int _i = 0; _i < 2; ++_i) \
        __builtin_amdgcn_global_load_lds((const unsigned*)((const char*)(gbase) + (voff)[_i]), (PG8_LAS unsigned*)(lds + (bufoff) + ldsw + _i * 8192), 16, 0, 0); } while (0)
#define PG8_LDA(dst, b, h) do { _Pragma("unroll") for (int m = 0; m < 4; ++m) _Pragma("unroll") for (int k = 0; k < 2; ++k) dst[m][k] = *(const PG8_LAS bf16x8*)(lds + PG8_SA(b, h) + aoff + m * 2048 + k * 1024); } while (0)
#define PG8_LDB(dst, b, h) do { _Pragma("unroll") for (int n = 0; n < 2; ++n) _Pragma("unroll") for (int k = 0; k < 2; ++k) dst[n][k] = *(const PG8_LAS bf16x8*)(lds + PG8_SB(b, h) + boff + n * 2048 + k * 1024); } while (0)
#define PG8_MMA(ai, bj, At, Bt) do { __builtin_amdgcn_s_setprio(1); _Pragma("unroll") for (int m = 0; m < 4; ++m) _Pragma("unroll") for (int n = 0; n < 2; ++n) _Pragma("unroll") for (int k = 0; k < 2; ++k) \
        acc[ai][bj][m][n] = __builtin_amdgcn_mfma_f32_16x16x32_bf16(Bt[n][k], At[m][k], acc[ai][bj][m][n], 0, 0, 0); __builtin_amdgcn_s_setprio(0); } while (0)
#define PG8_WAIT_V(n) asm volatile("s_waitcnt vmcnt(" #n ")" ::: "memory")
#define PG8_WAIT_L(n) asm volatile("s_waitcnt lgkmcnt(" #n ")" ::: "memory")
#define PG8_BAR __builtin_amdgcn_s_barrier()
#define PG8_SCHED __builtin_amdgcn_sched_barrier(0)
    Unit cur, nxt; int ui = 0;
    if (!S.next(0, cur)) return;
    f32x4 acc[2][2][4][2];
#pragma unroll
    for (int a = 0; a < 2; ++a)
#pragma unroll
        for (int b = 0; b < 2; ++b)
#pragma unroll
            for (int m = 0; m < 4; ++m)
#pragma unroll
                for (int n = 0; n < 2; ++n) acc[a][b][m][n] = (f32x4){0.f, 0.f, 0.f, 0.f};
    bf16x8 At[4][2], B0[2][2], B1[2][2];
    const char* cA = cur.A; const char* cB = cur.B;
    PG8_STAGE(PG8_SB(0, 0), cB, voffB); PG8_STAGE(PG8_SB(0, 1), cB + hstep, voffB); PG8_STAGE(PG8_SA(0, 0), cA, voffA); PG8_STAGE(PG8_SA(0, 1), cA + hstep, voffA);
    if (wr == 1) PG8_BAR;
    PG8_WAIT_V(2); PG8_BAR;
    PG8_STAGE(PG8_SB(1, 0), cB + kstep, voffB); PG8_STAGE(PG8_SA(1, 0), cA + kstep, voffA); PG8_STAGE(PG8_SB(1, 1), cB + hstep + kstep, voffB);
    PG8_WAIT_V(6); PG8_BAR;
    for (;;) {
        const bool has_next = S.next(ui + 1, nxt);
        const char* nA = has_next ? nxt.A : cA; const char* nB = has_next ? nxt.B : cB;
        for (int t = 0; t < nt; t += 2) {
            const bool last = (t == nt - 2);
            const char* a1 = cA + (size_t)(t + 1) * kstep;
            const char* a2 = last ? nA : cA + (size_t)(t + 2) * kstep; const char* b2 = last ? nB : cB + (size_t)(t + 2) * kstep;
            const char* a3 = a2 + kstep; const char* b3 = b2 + kstep;
            PG8_LDB(B0, 0, 0); PG8_LDB(B1, 0, 1); PG8_SCHED; PG8_LDA(At, 0, 0); PG8_STAGE(PG8_SA(1, 1), a1 + hstep, voffA);
            PG8_WAIT_V(8); PG8_WAIT_L(0); PG8_BAR; PG8_MMA(0, 0, At, B0); PG8_MMA(0, 1, At, B1); PG8_BAR; PG8_SCHED;
            PG8_LDA(At, 0, 1); PG8_STAGE(PG8_SB(0, 0), b2, voffB); PG8_STAGE(PG8_SB(0, 1), b2 + hstep, voffB); PG8_STAGE(PG8_SA(0, 0), a2, voffA);
            PG8_WAIT_V(8); PG8_WAIT_L(0); PG8_BAR; PG8_MMA(1, 0, At, B0); PG8_MMA(1, 1, At, B1); PG8_BAR; PG8_SCHED;
            PG8_LDB(B0, 1, 0); PG8_LDB(B1, 1, 1); PG8_SCHED; PG8_LDA(At, 1, 0); PG8_STAGE(PG8_SA(0, 1), a2 + hstep, voffA);
            PG8_WAIT_V(8); PG8_WAIT_L(0); PG8_BAR; PG8_MMA(0, 0, At, B0); PG8_MMA(0, 1, At, B1); PG8_BAR; PG8_SCHED;
            PG8_LDA(At, 1, 1); PG8_STAGE(PG8_SB(1, 0), b3, voffB); PG8_STAGE(PG8_SB(1, 1), b3 + hstep, voffB); PG8_STAGE(PG8_SA(1, 0), a3, voffA);
            PG8_WAIT_V(8); PG8_WAIT_L(0); PG8_BAR; PG8_MMA(1, 0, At, B0); PG8_MMA(1, 1, At, B1); PG8_BAR; PG8_SCHED;
        }
        if (wr == 0) PG8_BAR;
        { int fr_ = fr, fq_ = fq; asm volatile("" : "+v"(fr_), "+v"(fq_)); E(acc, cur, wr, wc, fr_, fq_); }
        if (!has_next) break;
        if (!(Epi::CARRY && E.keep(cur))) {
#pragma unroll
        for (int a = 0; a < 2; ++a)
#pragma unroll
            for (int b = 0; b < 2; ++b)
#pragma unroll
                for (int m = 0; m < 4; ++m)
#pragma unroll
                    for (int n = 0; n < 2; ++n) acc[a][b][m][n] = (f32x4){0.f, 0.f, 0.f, 0.f};
        }
        cur = nxt; cA = nA; cB = nB; ++ui;
        if (wr == 1) PG8_BAR;
    }
    PG8_WAIT_V(0);
    PG8_BAR;
#undef PG8_SA
#undef PG8_SB
#undef PG8_STAGE
#undef PG8_LDA
#undef PG8_LDB
#undef PG8_MMA
#undef PG8_WAIT_V
#undef PG8_WAIT_L
#undef PG8_BAR
#undef PG8_SCHED
}
}

constexpr int NWAVES = 8, NTHR = 512;
constexpr int D = 2048, NB = 4, SEQ = 2048, CTXL = 256, NCTX = NB * CTXL  , NLAT = NB * SEQ  , NTOK = NCTX + NLAT  ;
constexpr int NSTEP = CTXL + SEQ;
constexpr int HEADS = 8, HD = 128, MW = 1024, LW = 1024;
constexpr int NEXP = 32, DE = 1024;
constexpr int IN_DIM = 11296, NT_IN = 45;
constexpr float EPS = 1e-6f;
constexpr int MAXTILES = 96;
constexpr int NPHASE = 9;

constexpr size_t MiB = 1u << 20;
constexpr size_t WS_CTL = 0, CTL_ZERO_BYTES = 1 * MiB;
constexpr size_t WS_MOD = 1 * MiB;
constexpr size_t WS_GATES = 2 * MiB;
constexpr size_t WS_ASG = 4 * MiB + 512 * 1024;
constexpr size_t WS_LIST = 3 * MiB + 512 * 1024;
constexpr size_t WS_WR = 6 * MiB;
constexpr size_t WS_RB = 7 * MiB + 768 * 1024;
constexpr size_t WS_WL = 5 * MiB;
constexpr size_t WS_AGG = 978 * MiB;
constexpr size_t WS_WPA = 8 * MiB, WS_WPB = 12 * MiB, WS_WOUT = 16 * MiB, WS_WIN = 24 * MiB;
constexpr size_t WS_W13 = 72 * MiB, WS_W2 = 328 * MiB;
constexpr size_t WS_PS = 72 * MiB;
constexpr size_t WS_H = 456 * MiB;
constexpr size_t WS_K = 492 * MiB, WS_V = 510 * MiB, WS_UX = 528 * MiB;
constexpr size_t WS_Q = 546 * MiB, WS_OF = 562 * MiB, WS_OB = 578 * MiB, WS_UG = 594 * MiB;
constexpr size_t WS_GA = 610 * MiB, WS_GB = 642 * MiB;
constexpr size_t WS_LA = 674 * MiB, WS_LB = 746 * MiB;
constexpr size_t WS_HS = 818 * MiB, WS_TM = 882 * MiB;
constexpr size_t WS_YA = 946 * MiB, WS_YB = 962 * MiB;
constexpr size_t WS_BT = 982 * MiB;
constexpr size_t WS_SLOC = 984 * MiB;
constexpr size_t WS_END = 1022 * MiB;
constexpr size_t WS_PRE = WS_LA;
constexpr size_t WS_X1 = WS_LB;
constexpr size_t WS_H2 = WS_H;
constexpr size_t WS_XS = WS_K;
constexpr size_t WS_HM = 588 * MiB;
constexpr size_t WS_Y2 = WS_HS;
constexpr int CW_MODC = 32;
constexpr int CW_CNT = 64;
constexpr int CW_NT = 128;
constexpr int CW_TILE_E = 192;
constexpr int CW_BAR = 4096;
constexpr int CW_Q = 8192;
constexpr int CW_TC = 16384;

constexpr int RING_BYTES = 131072;
constexpr int LDSCTL_OFF = 143360;
constexpr int MISC_OFF = LDSCTL_OFF + 384;
constexpr int LDS_BYTES = 147456;

#define GAS __attribute__((address_space(1)))
#define LAS __attribute__((address_space(3)))
typedef unsigned short bf16;
typedef unsigned v4u __attribute__((ext_vector_type(4)));
typedef float f32x4 __attribute__((ext_vector_type(4)));
#define LDS_WAIT() asm volatile("s_waitcnt lgkmcnt(0)" ::: "memory")
#define WG_BAR() do { asm volatile("s_waitcnt lgkmcnt(0)" ::: "memory"); __builtin_amdgcn_s_barrier(); asm volatile("" ::: "memory"); } while (0)

__device__ __forceinline__ unsigned f2bf(float f) { unsigned u = __builtin_bit_cast(unsigned, f); return (u + 0x7fffu + ((u >> 16) & 1u)) >> 16; }
__device__ __forceinline__ unsigned pk2(float lo, float hi) { return pg8::cvt_pk_bf16(lo, hi); }
__device__ __forceinline__ float bf2f(unsigned h) { return __builtin_bit_cast(float, h << 16); }
__device__ __forceinline__ float bflo(unsigned w) { return __builtin_bit_cast(float, w << 16); }
__device__ __forceinline__ float bfhi(unsigned w) { return __builtin_bit_cast(float, w & 0xffff0000u); }
__device__ __forceinline__ float sigmoidf_(float x) { return __builtin_amdgcn_rcpf(1.f + __expf(-x)); }
__device__ __forceinline__ float gelu_tanh(float x) { const float u = 0.7978845608028654f * (x + 0.044715f * x * x * x); return x * __builtin_amdgcn_rcpf(1.f + __expf(-2.f * u)); }
__device__ __forceinline__ float wave_sum(float v) {
#pragma unroll
    for (int o = 1; o < 64; o <<= 1) v += __shfl_xor(v, o);
    return v;
}

#define XB_TMO      128
#define XB_XCNT(j)  (256  + 64 * (j))
#define XB_XSUB(j)  (1280 + 64 * (j))
#define XB_XGEN(j)  (2304 + 64 * (j))
#define XB_TOP      3328
#define XB_TOPGEN   3392
#define XCD_BAR_WORDS 3456
#define XB_SPIN_CAP (1u << 23)
__device__ __forceinline__ unsigned xb_ld(unsigned* p)              { return __hip_atomic_load(p, __ATOMIC_RELAXED, __HIP_MEMORY_SCOPE_AGENT); }
__device__ __forceinline__ unsigned xb_add(unsigned* p, unsigned v) { return __hip_atomic_fetch_add(p, v, __ATOMIC_RELAXED, __HIP_MEMORY_SCOPE_AGENT); }
__device__ __forceinline__ unsigned xb_xcc_id() { return (unsigned)__builtin_amdgcn_s_getreg((3 << 11) | 20) & 0xFu; }
#define XB_SPIN(cond, bar) do { unsigned _sp = 0; while (cond) { __builtin_amdgcn_s_sleep(1); \
    if ((++_sp & 255u) == 0u) { if (xb_ld(&(bar)[XB_TMO])) break; if (_sp > XB_SPIN_CAP) { atomicAdd(&(bar)[XB_TMO], 1u); break; } } } } while (0)
struct XcdBarrier { unsigned* bar; unsigned x; volatile LAS unsigned* st; };
__device__ __forceinline__ XcdBarrier xcd_barrier_post(unsigned* bar, volatile LAS unsigned* st, int tid) {
    XcdBarrier b; b.bar = bar; b.x = xb_xcc_id(); b.st = st;
    if (tid == 0) (void)xb_add(&bar[XB_XCNT(b.x)], 1u);
    return b;
}
__device__ __forceinline__ void xcd_barrier_complete(unsigned* bar, unsigned x, unsigned& nloc, unsigned& nx) {
    const unsigned G = gridDim.x * gridDim.y * gridDim.z;
    unsigned sum, cnt, mine, sp = 0u;
    for (;;) {
        sum = 0u; cnt = 0u; mine = 0u;
#pragma unroll
        for (unsigned j = 0; j < 16; ++j) { const unsigned c = xb_ld(&bar[XB_XCNT(j)]); sum += c; cnt += (c > 0u) ? 1u : 0u; mine = (j == x) ? c : mine; }
        if (sum == G) break;
        __builtin_amdgcn_s_sleep(1);
        if ((++sp & 255u) == 0u) { if (xb_ld(&bar[XB_TMO])) break; if (sp > XB_SPIN_CAP) { atomicAdd(&bar[XB_TMO], 1u); break; } }
    }
    nloc = mine > 0u ? mine : 1u; nx = cnt > 0u ? cnt : 1u;
}
__device__ __forceinline__ void xcd_barrier(const XcdBarrier& b, int tid) {
    asm volatile("s_waitcnt vmcnt(0)" ::: "memory");
    __syncthreads();
    if (tid == 0) {
        unsigned* bar = b.bar;
        __builtin_amdgcn_s_waitcnt(0);
        unsigned nloc = b.st[0], nx = b.st[1];
        if (nloc == 0u) { xcd_barrier_complete(bar, b.x, nloc, nx); b.st[0] = nloc; b.st[1] = nx; }
        const unsigned old = xb_add(&bar[XB_XSUB(b.x)], 1u);
        const unsigned gen = old / nloc;
        if (old + 1u == (gen + 1u) * nloc) {
            __builtin_amdgcn_fence(__ATOMIC_RELEASE, "agent");
            asm volatile("s_waitcnt vmcnt(0)" ::: "memory");
            const unsigned og = xb_add(&bar[XB_TOP], 1u);
            const unsigned tg = og / nx;
            if (og + 1u == (tg + 1u) * nx) xb_add(&bar[XB_TOPGEN], 1u);
            else XB_SPIN(xb_ld(&bar[XB_TOPGEN]) == tg, bar);
            __builtin_amdgcn_fence(__ATOMIC_ACQUIRE, "agent");
            xb_add(&bar[XB_XGEN(b.x)], 1u);
            asm volatile("s_waitcnt vmcnt(0)" ::: "memory");
        } else {
            XB_SPIN(xb_ld(&bar[XB_XGEN(b.x)]) == gen, bar);
            __builtin_amdgcn_fence(__ATOMIC_ACQUIRE, "agent");
            asm volatile("s_waitcnt vmcnt(0)" ::: "memory");
        }
    }
    __syncthreads();
}

__device__ __forceinline__ int make_tid(int wave_s) { int l; asm volatile("v_mbcnt_lo_u32_b32 %0, -1, 0\n\tv_mbcnt_hi_u32_b32 %0, -1, %0" : "=v"(l)); __builtin_assume(l >= 0 && l < 64); __builtin_assume(wave_s >= 0 && wave_s < 8); return wave_s * 64 + l; }
struct Args { const float* in[27]; float* out; unsigned char* ws; int ph_lo, ph_hi; };
enum { I_X = 0, I_C, I_CTX, I_CCTX, I_WMOD, I_BMOD, I_N1G, I_WIN, I_BGATES, I_HEADG, I_CONVW, I_CONVB, I_LWA, I_LBA, I_LWX, I_LBX, I_LAM, I_WPA, I_WPB, I_WOUT, I_N2G, I_WRG, I_WRE, I_W1, I_W3, I_W2, I_FG };

__device__ __forceinline__ void tr_item(const float* __restrict__ W, size_t ldw, int k0, int n0, bf16* dst, size_t ldd, float scale, LAS float* scr, int lane) {
#pragma unroll 16
    for (int i = 0; i < 32; ++i) { const int kk = 2 * i + (lane >> 5); scr[kk * 33 + (lane & 31)] = W[(size_t)(k0 + kk) * ldw + n0 + (lane & 31)]; }
    LDS_WAIT(); asm volatile("" ::: "memory");
    const int c = lane & 7;
#pragma unroll
    for (int j = 0; j < 4; ++j) { const int n = (lane >> 3) + 8 * j; const LAS float* s = scr + (8 * c) * 33 + n;
        v4u o; o.x = pk2(s[0 * 33] * scale, s[1 * 33] * scale); o.y = pk2(s[2 * 33] * scale, s[3 * 33] * scale); o.z = pk2(s[4 * 33] * scale, s[5 * 33] * scale); o.w = pk2(s[6 * 33] * scale, s[7 * 33] * scale);
        *(GAS v4u*)(dst + (size_t)n * ldd + 8 * c) = o; }
    LDS_WAIT(); asm volatile("" ::: "memory");
}
__device__ __forceinline__ int win_row(int n0, float& scale) {
    scale = 1.f;
    if (n0 < 1024) return 13 * 256 + n0;
    if (n0 < 2048) { scale = 0.08838834764831845f; return n0 - 1024; }
    if (n0 < 3072) return 4 * 256 + (n0 - 2048);
    if (n0 < 4096) return 17 * 256 + (n0 - 3072);
    if (n0 < 5120) return 21 * 256 + (n0 - 4096);
    if (n0 < 5152) return 12 * 256 + (n0 - 5120);
    if (n0 < 6176) return 8 * 256 + (n0 - 5152);
    if (n0 < 7200) return 25 * 256 + (n0 - 6176);
    if (n0 < 9248) return 29 * 256 + (n0 - 7200);
    return 37 * 256 + (n0 - 9248);
}

__device__ __forceinline__ void phase0(const Args& a, unsigned char* lds_g, int tid, int lane, int wave) {
    unsigned char* ws = a.ws;
    {
        float* sl = (float*)lds_g;
        float* red = sl + 5 * 2048;
        for (int i = tid; i < 5 * 2048; i += NTHR) { const int r = i >> 11, k = i & 2047; const float v = r < 4 ? a.in[I_C][r * 2048 + k] : a.in[I_CCTX][k]; sl[i] = v / (1.f + __expf(-v)); }
        __syncthreads();
        const float* wm = a.in[I_WMOD]; const float* bm = a.in[I_BMOD]; float* MOD = (float*)(ws + WS_MOD);
        for (int cb = blockIdx.x; cb < 256; cb += gridDim.x) {
            const int n0 = cb * 48;
            if (tid < 504) {
                const int kq = tid / 12, cg = tid % 12;
                f32x4 acc[5];
#pragma unroll
                for (int r = 0; r < 5; ++r) acc[r] = (f32x4){0.f, 0.f, 0.f, 0.f};
#pragma unroll 7
                for (int k = kq; k < 2048; k += 42) {
                    const f32x4 w = *(const f32x4*)(wm + (size_t)k * 12288 + n0 + 4 * cg);
#pragma unroll
                    for (int r = 0; r < 5; ++r) acc[r] += w * sl[r * 2048 + k];
                }
#pragma unroll
                for (int r = 0; r < 5; ++r) *(f32x4*)(red + tid * 20 + r * 4) = acc[r];
            }
            __syncthreads();
            if (tid < 240) {
                const int cg = tid / 20, rj = tid % 20; float s = 0.f;
                for (int kq = 0; kq < 42; ++kq) s += red[(kq * 12 + cg) * 20 + rj];
                const int r = rj >> 2, j = rj & 3, n = n0 + 4 * cg + j;
                __hip_atomic_store(MOD + r * 12288 + n, s + bm[n], __ATOMIC_RELAXED, __HIP_MEMORY_SCOPE_AGENT);
            }
            __syncthreads();
        }
        if (tid == 0) __hip_atomic_fetch_add((unsigned*)(ws + WS_CTL) + CW_MODC, 1u, __ATOMIC_RELAXED, __HIP_MEMORY_SCOPE_AGENT);
    }
    {
        LAS float* scr = (LAS float*)((LAS unsigned char*)lds_g) + wave * 4096;
        const int gw = blockIdx.x * NWAVES + wave, NGW = gridDim.x * NWAVES;
        constexpr int J0 = 32 * 353, J1 = 16 * 64, J3 = 32 * 64;
        constexpr int JL = 256;
        constexpr int NITEMS = J0 + 2 * J1;
        (void)J3; (void)JL;
        for (int it = gw; it < NITEMS; it += NGW) {
            int r = it;
            if (r < J0) { const int kb = r / 353, nb = r % 353; float sc; const int row = win_row(32 * nb, sc);
                tr_item(a.in[I_WIN], IN_DIM, 64 * kb, 32 * nb, (bf16*)(ws + WS_WIN) + (size_t)row * 2048 + 64 * kb, 2048, sc, scr, lane); continue; } r -= J0;
            if (r < J1) { const int kb = r / 64, nb = r % 64; tr_item(a.in[I_WPA], 2048, 64 * kb, 32 * nb, (bf16*)(ws + WS_WPA) + (size_t)(32 * nb) * 1024 + 64 * kb, 1024, 1.f, scr, lane); continue; } r -= J1;
            if (r < J1) { const int kb = r / 64, nb = r % 64; tr_item(a.in[I_WPB], 2048, 64 * kb, 32 * nb, (bf16*)(ws + WS_WPB) + (size_t)(32 * nb) * 1024 + 64 * kb, 1024, 1.f, scr, lane); continue; }
        }
        { GAS v4u* z = (GAS v4u*)((bf16*)(ws + WS_WIN) + (size_t)(12 * 256 + 32) * 2048); const int nchunks = 224 * 256;
          for (int i = blockIdx.x * NTHR + tid; i < nchunks; i += gridDim.x * NTHR) z[i] = (v4u){0u, 0u, 0u, 0u}; }
    }
}

__device__ __forceinline__ void late_prep(const Args& a, unsigned char* lds_g, int gw, int NGW, int lane, int wave) {
    unsigned char* ws = a.ws;
    {
        LAS float* scr = (LAS float*)((LAS unsigned char*)lds_g) + wave * 4096;
        constexpr int J3 = 32 * 64, JL = 256;
        for (int it = gw; it < J3 + JL; it += NGW) {
            int r = it;
            if (r >= J3) { r -= J3; const int mi = r >> 3, kb = (r >> 2) & 1, nb = r & 3, dir = mi >> 4, mat = (mi >> 3) & 1, blk = mi & 7;
                tr_item(a.in[mat ? I_LWX : I_LWA] + (size_t)(dir * 8 + blk) * 128 * 128, 128, 64 * kb, 32 * nb, (bf16*)(ws + WS_WL) + ((size_t)((dir * 2 + mat) * 8 + blk) * 128 + 32 * nb) * 128 + 64 * kb, 128, 1.f, scr, lane); continue; }
            const int kb = r / 64, nb = r % 64; tr_item(a.in[I_WOUT], 2048, 64 * kb, 32 * nb, (bf16*)(ws + WS_WOUT) + (size_t)(32 * nb) * 2048 + 64 * kb, 2048, 1.f, scr, lane);
        }
    }
    {
        const float* MODr = (const float*)(a.ws + WS_MOD); float* WR = (float*)(a.ws + WS_WR); float* RB = (float*)(a.ws + WS_RB);
        for (int idx = gw * 64 + lane; idx < 4 * 48 * 2048; idx += NGW * 64) { const int k = idx & 2047, j = (idx >> 11) % 48, b = idx / (48 * 2048);
            const float gm = a.in[I_N2G][k] * (1.f + MODr[b * 12288 + 4 * 2048 + k]);
            const float wv = j < 32 ? a.in[I_WRE][(size_t)k * 32 + j] : (j < 36 ? a.in[I_WRG][(size_t)k * 4 + (j - 32)] : 0.f);
            WR[idx] = gm * wv; }
        for (int q = gw; q < 4 * 48; q += NGW) { const int b = q / 48, j = q % 48; float sacc = 0.f;
            if (j < 36) { for (int k = lane; k < 2048; k += 64) { const float wv = j < 32 ? a.in[I_WRE][(size_t)k * 32 + j] : a.in[I_WRG][(size_t)k * 4 + (j - 32)]; sacc += MODr[b * 12288 + 3 * 2048 + k] * wv; } }
            sacc = wave_sum(sacc); if (lane == 0) RB[q] = sacc; }
    }
}
__device__ __forceinline__ void mod_wait(const Args& a, int tid) {
    if (tid < 64) { unsigned* mc = (unsigned*)(a.ws + WS_CTL) + CW_MODC; unsigned spins = 0;
        while ((unsigned)__builtin_amdgcn_readfirstlane(__hip_atomic_load(mc, __ATOMIC_RELAXED, __HIP_MEMORY_SCOPE_AGENT)) < gridDim.x) {
            __builtin_amdgcn_s_sleep(2);
            if (++spins > (1u << 22)) { if (tid == 0) __hip_atomic_store((unsigned*)(a.ws + WS_CTL) + 1, 0x800u, __ATOMIC_RELAXED, __HIP_MEMORY_SCOPE_AGENT); break; } }
        __builtin_amdgcn_fence(__ATOMIC_ACQUIRE, "agent");
        asm volatile("s_waitcnt vmcnt(0)" ::: "memory"); }
    __syncthreads();
}
__device__ __forceinline__ void phase1(const Args& a, int lane, int wave) {
    const int gw = blockIdx.x * NWAVES + wave, NGW = gridDim.x * NWAVES;
    const float* MOD = (const float*)(a.ws + WS_MOD); const float* g = a.in[I_N1G];
    bf16* H = (bf16*)(a.ws + WS_H);
    for (int r = gw; r < NTOK; r += NGW) {
        const float* src = r < NCTX ? a.in[I_CTX] + (size_t)r * D : a.in[I_X] + (size_t)(r - NCTX) * D;
        const int mr = r < NCTX ? 4 : (r - NCTX) / SEQ;
        const f32x4* xr = (const f32x4*)src + lane;
        f32x4 v[8]; float s = 0.f;
#pragma unroll
        for (int j = 0; j < 8; ++j) { v[j] = xr[64 * j]; s += (v[j].x * v[j].x + v[j].y * v[j].y) + (v[j].z * v[j].z + v[j].w * v[j].w); }
        const float rstd = 1.f / sqrtf(wave_sum(s) * (1.f / D) + EPS);
        unsigned long long* o8 = (unsigned long long*)(H + (size_t)r * D) + lane;
#pragma unroll
        for (int j = 0; j < 8; ++j) {
            const int c = 4 * lane + 256 * j;
            const f32x4 gg = *(const f32x4*)(g + c), sh = *(const f32x4*)(MOD + mr * 12288 + c), sc = *(const f32x4*)(MOD + mr * 12288 + 2048 + c);
            v[j] = v[j] * rstd * gg * (sc + 1.f) + sh;
        }
#pragma unroll
        for (int j = 0; j < 8; ++j) o8[64 * j] = (unsigned long long)pk2(v[j].x, v[j].y) | ((unsigned long long)pk2(v[j].z, v[j].w) << 32);
    }
}

struct SchedIn {
    int G, c; const char* A; const char* B;
    __device__ __forceinline__ bool next(int i, pg8::Unit& u) const {
        const int L = i * G + c; if (L >= 1492) return false;
        int pm, pn;
        if (L < 1440) { pg8::tile_order(L, 32, NT_IN, pm, pn); pm += 4; }
        else { const int j = L - 1440; pm = j & 3; pn = j >> 2; }
        u.pm = pm; u.pn = pn; u.aux = 0; u.A = A + (size_t)pm * 256 * D * 2; u.B = B + (size_t)pn * 256 * D * 2; return true;
    }
};
struct EpiIn {
    static constexpr bool PERM = true, CARRY = false;
    __device__ __forceinline__ bool keep(const pg8::Unit&) const { return false; }
    unsigned char* ws; const float* b_gates;
    template <int ACT> __device__ __forceinline__ void store_tile(const pg8::f32x4 (&acc)[2][2][4][2], bf16* base, int ldc, int wr, int wc, int fr, int fq) const {
#pragma unroll
        for (int ai = 0; ai < 2; ++ai)
#pragma unroll
            for (int m = 0; m < 4; ++m) { bf16* rowp = base + (size_t)(ai * 128 + wr * 64 + m * 16 + fr) * ldc + wc * 32 + 8 * fq;
#pragma unroll
                for (int bj = 0; bj < 2; ++bj) { pg8::f32x4 v0 = acc[ai][bj][m][0], v1 = acc[ai][bj][m][1];
                    if (ACT == 1) {
#pragma unroll
                        for (int j = 0; j < 4; ++j) { v0[j] = sigmoidf_(v0[j]); v1[j] = sigmoidf_(v1[j]); } }
                    if (ACT == 2) {
#pragma unroll
                        for (int j = 0; j < 4; ++j) { v0[j] = gelu_tanh(v0[j]); v1[j] = gelu_tanh(v1[j]); } }
                    pg8::u32x4 w; w.x = pg8::cvt_pk_bf16(v0[0], v0[1]); w.y = pg8::cvt_pk_bf16(v0[2], v0[3]); w.z = pg8::cvt_pk_bf16(v1[0], v1[1]); w.w = pg8::cvt_pk_bf16(v1[2], v1[3]);
                    *(pg8::u32x4*)(rowp + bj * 128) = w; } }
    }
    __device__ __forceinline__ void operator()(const pg8::f32x4 (&acc)[2][2][4][2], const pg8::Unit& u, int wr, int wc, int fr, int fq) const {
        const int pn = u.pn; const size_t row0 = (size_t)u.pm * 256;
        if (pn < 12) {
            const int seg = pn >> 2, ct = pn & 3; bf16* dst = (bf16*)(ws + (seg == 0 ? WS_K : seg == 1 ? WS_V : WS_UX));
            store_tile<0>(acc, dst + row0 * 1024 + ct * 256, 1024, wr, wc, fr, fq);
        } else if (pn == 12) {
            if (wc == 0) {
                float* G = (float*)(ws + WS_GATES);
                const pg8::f32x4 bv0 = *(const pg8::f32x4*)(b_gates + 8 * fq), bv1 = *(const pg8::f32x4*)(b_gates + 8 * fq + 4);
#pragma unroll
                for (int ai = 0; ai < 2; ++ai)
#pragma unroll
                    for (int m = 0; m < 4; ++m) { float* rowp = G + (row0 + ai * 128 + wr * 64 + m * 16 + fr) * 32 + 8 * fq;
                        *(pg8::f32x4*)(rowp) = acc[ai][0][m][0] + bv0; *(pg8::f32x4*)(rowp + 4) = acc[ai][0][m][1] + bv1; }
            }
        } else if (pn < 29) {
            const int seg = (pn - 13) >> 2, ct = (pn - 13) & 3; const size_t lr = row0 - NCTX;
            bf16* dst = (bf16*)(ws + (seg == 0 ? WS_Q : seg == 1 ? WS_OF : seg == 2 ? WS_OB : WS_UG)) + lr * 1024 + ct * 256;
            if (seg == 0) store_tile<0>(acc, dst, 1024, wr, wc, fr, fq);
            else if (seg == 3) store_tile<2>(acc, dst, 1024, wr, wc, fr, fq);
            else store_tile<1>(acc, dst, 1024, wr, wc, fr, fq);
        } else {
            const int seg = (pn - 29) >> 3, ct = (pn - 29) & 7; const size_t lr = row0 - NCTX;
            store_tile<1>(acc, (bf16*)(ws + (seg ? WS_GB : WS_GA)) + lr * 2048 + ct * 256, 2048, wr, wc, fr, fq);
        }
    }
};

__device__ __forceinline__ int lru_pos_row(int b, bool isctx, int p) { return isctx ? b * CTXL + p : NCTX + b * SEQ + (p & 31) * 64 + (p >> 5); }
typedef short bf16x8_t __attribute__((ext_vector_type(8)));
template <bool FINAL>
__device__ __forceinline__ void lru_unit(const Args& a, unsigned char* lds_g, int b, int cidx, int blk, int tid) {
    const int lane = tid & 63, w = __builtin_amdgcn_readfirstlane(tid >> 6), fr = lane & 15, fq = lane >> 4;
    float* zf = (float*)lds_g;
    bf16* zb = (bf16*)(lds_g + 64 * 132 * 4);
    const bool isctx = cidx < 4; const int seglen = isctx ? CTXL : SEQ, p0 = (isctx ? cidx : cidx - 4) * 64;
    const bf16* UX = (const bf16*)(a.ws + WS_UX);
    float gba[2], gbx[2], glam[2];
    { const int ch_ = blk * 128 + 16 * w + fr;
#pragma unroll
      for (int d = 0; d < 2; ++d) { gba[d] = a.in[I_LBA][d * 1024 + ch_]; gbx[d] = a.in[I_LBX][d * 1024 + ch_]; glam[d] = a.in[I_LAM][d * 1024 + ch_]; } }
    bf16x8_t wl[2][2][4];
    { const bf16* WL = (const bf16*)(a.ws + WS_WL);
#pragma unroll
      for (int d = 0; d < 2; ++d)
#pragma unroll
        for (int m = 0; m < 2; ++m)
#pragma unroll
            for (int ks = 0; ks < 4; ++ks) wl[d][m][ks] = *(const bf16x8_t*)(WL + ((size_t)((d * 2 + m) * 8 + blk) * 128 + 16 * w + fr) * 128 + 32 * ks + 8 * fq); }
    __builtin_amdgcn_sched_barrier(0);
    {
        const int pos = tid >> 3, cg = tid & 7, ch0 = blk * 128 + cg * 16, p = p0 + pos;
        float z[16];
#pragma unroll
        for (int q = 0; q < 4; ++q) { const f32x4 bv = *(const f32x4*)(a.in[I_CONVB] + ch0 + 4 * q); z[4 * q] = bv.x; z[4 * q + 1] = bv.y; z[4 * q + 2] = bv.z; z[4 * q + 3] = bv.w; }
        v4u ua[4], ub[4]; float msk[4];
#pragma unroll
        for (int w4 = 0; w4 < 4; ++w4) { const int pp = p + w4 - 2; const bool ok = pp >= 0 && pp < seglen; const int ppc = ok ? pp : p;
            const v4u* src = (const v4u*)(UX + (size_t)lru_pos_row(b, isctx, ppc) * 1024 + ch0); ua[w4] = src[0]; ub[w4] = src[1]; msk[w4] = ok ? 1.f : 0.f; }
#pragma unroll
        for (int w4 = 0; w4 < 4; ++w4) { const float* cw = a.in[I_CONVW] + w4 * 1024 + ch0;
            const unsigned uu[8] = {ua[w4].x, ua[w4].y, ua[w4].z, ua[w4].w, ub[w4].x, ub[w4].y, ub[w4].z, ub[w4].w};
#pragma unroll
            for (int q = 0; q < 4; ++q) { const f32x4 cv = *(const f32x4*)(cw + 4 * q) * msk[w4]; z[4 * q] += cv.x * bflo(uu[2 * q]); z[4 * q + 1] += cv.y * bfhi(uu[2 * q]); z[4 * q + 2] += cv.z * bflo(uu[2 * q + 1]); z[4 * q + 3] += cv.w * bfhi(uu[2 * q + 1]); } }
#pragma unroll
        for (int q = 0; q < 4; ++q) *(f32x4*)(zf + pos * 132 + cg * 16 + 4 * q) = (f32x4){z[4 * q], z[4 * q + 1], z[4 * q + 2], z[4 * q + 3]};
        v4u o0, o1; o0.x = pk2(z[0], z[1]); o0.y = pk2(z[2], z[3]); o0.z = pk2(z[4], z[5]); o0.w = pk2(z[6], z[7]); o1.x = pk2(z[8], z[9]); o1.y = pk2(z[10], z[11]); o1.z = pk2(z[12], z[13]); o1.w = pk2(z[14], z[15]);
        *(v4u*)(zb + pos * 136 + cg * 16) = o0; *(v4u*)(zb + pos * 136 + cg * 16 + 8) = o1;
    }
    WG_BAR();
    f32x4 acc[2][2][4];
#pragma unroll
    for (int d = 0; d < 2; ++d)
#pragma unroll
        for (int m = 0; m < 2; ++m)
#pragma unroll
            for (int mt = 0; mt < 4; ++mt) acc[d][m][mt] = (f32x4){0.f, 0.f, 0.f, 0.f};
#pragma unroll
    for (int ks = 0; ks < 4; ++ks) {
        bf16x8_t af[4];
#pragma unroll
        for (int mt = 0; mt < 4; ++mt) af[mt] = *(const bf16x8_t*)(zb + (16 * mt + fr) * 136 + 32 * ks + 8 * fq);
#pragma unroll
        for (int d = 0; d < 2; ++d)
#pragma unroll
            for (int m = 0; m < 2; ++m) {
#pragma unroll
                for (int mt = 0; mt < 4; ++mt) acc[d][m][mt] = __builtin_amdgcn_mfma_f32_16x16x32_bf16(af[mt], wl[d][m][ks], acc[d][m][mt], 0, 0, 0); }
    }
    const int chl = 16 * w + fr, ch = blk * 128 + chl;
    float hsum[4][4];
#pragma unroll
    for (int d = 0; d < 2; ++d) {
        const float ba = gba[d], bx = gbx[d], lam = glam[d];
        const float sp = (-lam > 20.f) ? -lam : log1pf(__expf(-lam));
        float av[4][4], bv[4][4];
#pragma unroll
        for (int mt = 0; mt < 4; ++mt)
#pragma unroll
            for (int r = 0; r < 4; ++r) { const float rr = sigmoidf_(acc[d][0][mt][r] + ba), ii = sigmoidf_(acc[d][1][mt][r] + bx);
                const float aa = __expf(-8.f * rr * sp); av[mt][r] = aa; bv[mt][r] = __builtin_amdgcn_sqrtf(fmaxf(1.f - aa * aa, 0.f)) * ii * zf[(16 * mt + 4 * fq + r) * 132 + chl]; }
        float Pe[4], Se[4], Pt[4], St[4];
#pragma unroll
        for (int mt = 0; mt < 4; ++mt) {
            float P = 1.f, S = 0.f;
#pragma unroll
            for (int rr = 0; rr < 4; ++rr) { const int r = d ? 3 - rr : rr; S = av[mt][r] * S + bv[mt][r]; P = av[mt][r] * P; }
            if (d == 0) {
                float p1 = __shfl_up(P, 16), s1 = __shfl_up(S, 16); if (fq >= 1) { S = P * s1 + S; P = P * p1; }
                p1 = __shfl_up(P, 32); s1 = __shfl_up(S, 32); if (fq >= 2) { S = P * s1 + S; P = P * p1; }
                Pe[mt] = __shfl_up(P, 16); Se[mt] = __shfl_up(S, 16); if (fq == 0) { Pe[mt] = 1.f; Se[mt] = 0.f; }
                Pt[mt] = __shfl(P, fr + 48); St[mt] = __shfl(S, fr + 48);
            } else {
                float p1 = __shfl_down(P, 16), s1 = __shfl_down(S, 16); if (fq <= 2) { S = P * s1 + S; P = P * p1; }
                p1 = __shfl_down(P, 32); s1 = __shfl_down(S, 32); if (fq <= 1) { S = P * s1 + S; P = P * p1; }
                Pe[mt] = __shfl_down(P, 16); Se[mt] = __shfl_down(S, 16); if (fq == 3) { Pe[mt] = 1.f; Se[mt] = 0.f; }
                Pt[mt] = __shfl(P, fr); St[mt] = __shfl(S, fr);
            }
        }
        float2* AGG = (float2*)(a.ws + WS_AGG) + ((size_t)(b * 2 + d) * 36) * 1024 + ch;
        if (!FINAL) {
            if (cidx >= 4) {
                unsigned* PS = (unsigned*)(a.ws + WS_PS) + ((size_t)(b * 2 + d) * NSTEP + 64 * cidx) * 1024 + ch;
#pragma unroll
                for (int mt = 0; mt < 4; ++mt)
#pragma unroll
                    for (int r = 0; r < 4; ++r) PS[(size_t)(16 * mt + 4 * fq + r) * 1024] = pk2(1.f - av[mt][r], bv[mt][r]);
            }
            float Pc = 1.f, Sc = 0.f;
#pragma unroll
            for (int i = 0; i < 4; ++i) { const int mt = d ? 3 - i : i; Sc = Pt[mt] * Sc + St[mt]; Pc = Pt[mt] * Pc; }
            if (fq == 0) AGG[(size_t)cidx * 1024] = make_float2(Pc, Sc);
        } else {
            float h = 0.f;
#pragma unroll
            for (int g3 = 0; g3 < 6; ++g3) {
                float2 qv[6];
#pragma unroll
                for (int i = 0; i < 6; ++i) { const int sidx = 6 * g3 + i; const int c2 = d ? (sidx < 4 ? 3 - sidx : 39 - sidx) : sidx; qv[i] = AGG[(size_t)c2 * 1024]; }
#pragma unroll
                for (int i = 0; i < 6; ++i) { const int sidx = 6 * g3 + i; const int c2 = d ? (sidx < 4 ? 3 - sidx : 39 - sidx) : sidx;
                    const bool use = d ? (sidx < 4 || c2 > cidx) : (c2 < cidx);
                    h = use ? qv[i].x * h + qv[i].y : h; }
            }
#pragma unroll
            for (int i = 0; i < 4; ++i) { const int mt = d ? 3 - i : i;
                float hl = Pe[mt] * h + Se[mt];
#pragma unroll
                for (int rr = 0; rr < 4; ++rr) { const int r = d ? 3 - rr : rr; hl = av[mt][r] * hl + bv[mt][r]; if (d == 0) hsum[mt][r] = hl; else hsum[mt][r] += hl; }
                h = Pt[mt] * h + St[mt]; }
        }
    }
    if (FINAL) {
#pragma unroll
        for (int mt = 0; mt < 4; ++mt)
#pragma unroll
            for (int r = 0; r < 4; ++r) zf[(16 * mt + 4 * fq + r) * 132 + chl] = hsum[mt][r];
        WG_BAR();
        const int pos = tid >> 3, cg = tid & 7, ch0 = blk * 128 + cg * 16;
        const size_t lrow = (size_t)(lru_pos_row(b, false, p0 + pos) - NCTX) * 1024 + ch0;
        const v4u* ug = (const v4u*)((const bf16*)(a.ws + WS_UG) + lrow); const v4u g0 = ug[0], g1 = ug[1];
        const unsigned gg[8] = {g0.x, g0.y, g0.z, g0.w, g1.x, g1.y, g1.z, g1.w}; unsigned o[8];
#pragma unroll
        for (int q = 0; q < 4; ++q) { const f32x4 hv = *(const f32x4*)(zf + pos * 132 + cg * 16 + 4 * q);
            o[2 * q] = pk2(hv.x * bflo(gg[2 * q]), hv.y * bfhi(gg[2 * q])); o[2 * q + 1] = pk2(hv.z * bflo(gg[2 * q + 1]), hv.w * bfhi(gg[2 * q + 1])); }
        v4u* dst = (v4u*)((bf16*)(a.ws + WS_YB) + lrow); dst[0] = (v4u){o[0], o[1], o[2], o[3]}; dst[1] = (v4u){o[4], o[5], o[6], o[7]};
    }
    WG_BAR();
}
constexpr int ML_STRIDE = 136;
constexpr int ML_Q = 0, ML_K = 17408, ML_V = 34816, ML_AUG = 52224  , ML_CB = 54272  ;
constexpr int ML_EB = 93440  , ML_EU = 95488  , ML_EBEND = 97536  , ML_BEND = 97568  , ML_DEN = 97600  , ML_SSQ = 97856  ;
typedef short s4_t __attribute__((ext_vector_type(4)));
__device__ __forceinline__ s4_t ds_tr(const bf16* p) { return __builtin_amdgcn_ds_read_tr16_b64_v4i16((LAS s4_t*)p); }
__device__ __forceinline__ bf16x8_t frag_row(const bf16* img, int row0, int k0, int fr, int fq) { return *(const bf16x8_t*)(img + (row0 + fr) * ML_STRIDE + k0 + 8 * fq); }
__device__ __forceinline__ bf16x8_t frag_tr2(const bf16* img, int stride, int sA, int sB, int col0, int lane) {
    const int fq = lane >> 4, q = (lane & 15) >> 2, p = lane & 3;
    const s4_t lo = ds_tr(img + (sA + 4 * fq + q) * stride + col0 + 4 * p), hi = ds_tr(img + (sB + 4 * fq + q) * stride + col0 + 4 * p);
    return (bf16x8_t){lo.x, lo.y, lo.z, lo.w, hi.x, hi.y, hi.z, hi.w};
}
__device__ __forceinline__ bf16x8_t frag_tr(const bf16* img, int stride, int s0, int col0, int lane) {
    const int fq = lane >> 4, q = (lane & 15) >> 2, p = lane & 3;
    const bf16* b = img + (s0 + 8 * fq + q) * stride + col0 + 4 * p;
    const s4_t lo = ds_tr(b), hi = ds_tr(b + 4 * stride);
    return (bf16x8_t){lo.x, lo.y, lo.z, lo.w, hi.x, hi.y, hi.z, hi.w};
}
__device__ __forceinline__ float logsigmoidf_(float x) { return fminf(x, 0.f) - log1pf(__expf(-fabsf(x))); }

__device__ __forceinline__ void ml_gates(const Args& a, unsigned char* lds_g, int rowbase, int h, int tid) {
    const int lane = tid & 63, w = tid >> 6, dir = w >> 2, c = w & 3;
    const float* GT = (const float*)(a.ws + WS_GATES) + (size_t)(rowbase + 64 * c + lane) * 32;
    const float ipre = GT[(dir * 2) * 8 + h], fpre = GT[(dir * 2 + 1) * 8 + h];
    float bsum = logsigmoidf_(fpre);
    if (dir == 0) {
#pragma unroll
        for (int o = 1; o < 64; o <<= 1) { const float t = __shfl_up(bsum, o); if (lane >= o) bsum += t; }
    } else {
#pragma unroll
        for (int o = 1; o < 64; o <<= 1) { const float t = __shfl_down(bsum, o); if (lane + o < 64) bsum += t; }
    }
    float* eb = (float*)(lds_g + ML_EB); float* eu = (float*)(lds_g + ML_EU);
    eb[dir * 256 + 64 * c + lane] = __expf(bsum); eu[dir * 256 + 64 * c + lane] = __expf(ipre - bsum);
    const float bend = __shfl(bsum, dir ? 0 : 63);
    if (lane == 0) { ((float*)(lds_g + ML_EBEND))[dir * 4 + c] = __expf(bend); ((float*)(lds_g + ML_BEND))[dir * 4 + c] = bend; }
}

template <bool OUT, bool PASS2>
__device__ __forceinline__ void ml_block(const Args& a, unsigned char* lds_g, int rowbase, int h, int dir, f32x4 (&st)[9], int tid) {
    const int lane = tid & 63, w = __builtin_amdgcn_readfirstlane(tid >> 6), fr = lane & 15, fq = lane >> 4;
    bf16* Qi = (bf16*)(lds_g + ML_Q); bf16* Ki = (bf16*)(lds_g + ML_K); bf16* Vi = (bf16*)(lds_g + ML_V); bf16* AUGi = (bf16*)(lds_g + ML_AUG); bf16* CB = (bf16*)(lds_g + ML_CB);
    const float* eb = (const float*)(lds_g + ML_EB) + dir * 256; const float* eu = (const float*)(lds_g + ML_EU) + dir * 256;
    const float* ebend = (const float*)(lds_g + ML_EBEND) + dir * 4;
    float* den = (float*)(lds_g + ML_DEN); float* ssq = (float*)(lds_g + ML_SSQ);
    const bf16* Kb = (const bf16*)(a.ws + WS_K); const bf16* Vb = (const bf16*)(a.ws + WS_V); const bf16* Qb = (const bf16*)(a.ws + WS_Q);
    const int ti = w & 3, vh = w >> 2;
    float hgv[5];
    if (OUT) {
#pragma unroll
        for (int x = 0; x < 5; ++x) { const int vt = vh * 5 + x; hgv[x] = vt < 8 ? a.in[I_HEADG][h * 128 + 16 * vt + fr] : 0.f; } }
    for (int ci = 0; ci < 4; ++ci) {
        const int c = dir ? 3 - ci : ci;
        unsigned short ogv[5][4]; unsigned short tmv[5][4];
        if (OUT) {
            const bf16* OGp = (const bf16*)(a.ws + (dir ? WS_OB : WS_OF)); const bf16* TMp = (const bf16*)(a.ws + WS_TM);
#pragma unroll
            for (int r = 0; r < 4; ++r) { const size_t ob = (size_t)(rowbase - NCTX + 64 * c + 16 * ti + 4 * fq + r) * 1024 + h * 128;
#pragma unroll
                for (int x = 0; x < 5; ++x) { const int vt = vh * 5 + x; if (vt < 8) { ogv[x][r] = OGp[ob + 16 * vt + fr]; if (PASS2) tmv[x][r] = TMp[ob + 16 * vt + fr]; } } }
            __builtin_amdgcn_sched_barrier(0);
        }
        {
            const int t = tid >> 3, pc = tid & 7; const size_t row = (size_t)(rowbase + 64 * c + t);
            const v4u* ks = (const v4u*)(Kb + row * 1024 + h * 128 + 16 * pc); const v4u k0 = ks[0], k1 = ks[1];
            const v4u* vs = (const v4u*)(Vb + row * 1024 + h * 128 + 16 * pc); const v4u v0 = vs[0], v1 = vs[1];
            v4u q0, q1; if (OUT) { const v4u* qs = (const v4u*)(Qb + (row - NCTX) * 1024 + h * 128 + 16 * pc); q0 = qs[0]; q1 = qs[1]; }
            const float e = eu[64 * c + t];
            *(v4u*)(Ki + t * ML_STRIDE + 16 * pc) = k0; *(v4u*)(Ki + t * ML_STRIDE + 16 * pc + 8) = k1;
            if (OUT) { *(v4u*)(Qi + t * ML_STRIDE + 16 * pc) = q0; *(v4u*)(Qi + t * ML_STRIDE + 16 * pc + 8) = q1; }
            const unsigned vv[8] = {v0.x, v0.y, v0.z, v0.w, v1.x, v1.y, v1.z, v1.w}; unsigned o[8];
#pragma unroll
            for (int i = 0; i < 8; ++i) o[i] = pk2(bflo(vv[i]) * e, bfhi(vv[i]) * e);
            *(v4u*)(Vi + t * ML_STRIDE + 16 * pc) = (v4u){o[0], o[1], o[2], o[3]}; *(v4u*)(Vi + t * ML_STRIDE + 16 * pc + 8) = (v4u){o[4], o[5], o[6], o[7]};
            if (pc == 0) { *(v4u*)(AUGi + t * 16) = (v4u){f2bf(e), 0u, 0u, 0u}; *(v4u*)(AUGi + t * 16 + 8) = (v4u){0u, 0u, 0u, 0u}; }
        }
        WG_BAR();
        f32x4 X[5]; float hval[4][4];
        if (OUT) {
            bf16x8_t qf[4];
#pragma unroll
            for (int ks = 0; ks < 4; ++ks) qf[ks] = frag_row(Qi, 16 * ti, 32 * ks, fr, fq);
            bf16x8_t P[2]; bool pv[2];
#pragma unroll
            for (int pp = 0; pp < 2; ++pp) {
                f32x4 d[2];
#pragma unroll
                for (int hh = 0; hh < 2; ++hh) { const int si = 2 * pp + hh; d[hh] = (f32x4){0.f, 0.f, 0.f, 0.f};
                    const bool valid = dir ? (si >= ti) : (si <= ti);
                    if (valid) {
#pragma unroll
                        for (int ks = 0; ks < 4; ++ks) d[hh] = __builtin_amdgcn_mfma_f32_16x16x32_bf16(frag_row(Ki, 16 * si, 32 * ks, fr, fq), qf[ks], d[hh], 0, 0, 0);
                        if (si == ti) {
#pragma unroll
                            for (int r = 0; r < 4; ++r) { const bool keep = dir ? (4 * fq + r >= fr) : (4 * fq + r <= fr); d[hh][r] = keep ? d[hh][r] : 0.f; } } } }
                pv[pp] = dir ? (2 * pp + 1 >= ti) : (2 * pp <= ti);
                const unsigned p0 = pk2(d[0][0], d[0][1]), p1 = pk2(d[0][2], d[0][3]), p2 = pk2(d[1][0], d[1][1]), p3 = pk2(d[1][2], d[1][3]);
                P[pp] = __builtin_bit_cast(bf16x8_t, (v4u){p0, p1, p2, p3});
            }
#pragma unroll
            for (int x = 0; x < 5; ++x) { X[x] = (f32x4){0.f, 0.f, 0.f, 0.f};
                const int vt = vh * 5 + x;
                if (vt < 9) {
#pragma unroll
                    for (int pp = 0; pp < 2; ++pp) if (pv[pp]) {
                        const bf16x8_t bfv = vt < 8 ? frag_tr2(Vi, ML_STRIDE, 32 * pp, 32 * pp + 16, 16 * vt, lane) : frag_tr2(AUGi, 16, 32 * pp, 32 * pp + 16, 0, lane);
                        X[x] = __builtin_amdgcn_mfma_f32_16x16x32_bf16(P[pp], bfv, X[x], 0, 0, 0); }
#pragma unroll
                    for (int ks = 0; ks < 4; ++ks) X[x] = __builtin_amdgcn_mfma_f32_16x16x32_bf16(qf[ks], frag_row(CB, 16 * vt, 32 * ks, fr, fq), X[x], 0, 0, 0);
                } }
            if (vh == 1 && fr == 0) {
#pragma unroll
                for (int r = 0; r < 4; ++r) den[16 * ti + 4 * fq + r] = X[3][r] * eb[64 * c + 16 * ti + 4 * fq + r]; }
        }
        {
#pragma unroll
            for (int ks = 0; ks < 2; ++ks) { const bf16x8_t kf = frag_tr(Ki, ML_STRIDE, 32 * ks, 16 * w, lane);
#pragma unroll
                for (int vt = 0; vt < 8; ++vt) st[vt] = __builtin_amdgcn_mfma_f32_16x16x32_bf16(kf, frag_tr(Vi, ML_STRIDE, 32 * ks, 16 * vt, lane), st[vt], 0, 0, 0);
                st[8] = __builtin_amdgcn_mfma_f32_16x16x32_bf16(kf, frag_tr(AUGi, 16, 32 * ks, 0, lane), st[8], 0, 0, 0); }
            const float ee = ebend[c];
#pragma unroll
            for (int vt = 0; vt < 9; ++vt) st[vt] = st[vt] * ee;
        }
        WG_BAR();
        if (OUT) {
            float sq[4] = {0.f, 0.f, 0.f, 0.f};
#pragma unroll
            for (int r = 0; r < 4; ++r) { const int t = 16 * ti + 4 * fq + r; const float sc = eb[64 * c + t] * __builtin_amdgcn_rcpf(fmaxf(fabsf(den[t]), 1.f));
#pragma unroll
                for (int x = 0; x < 4; ++x) { const int vt = vh * 5 + x; const float hv = (vt < 8) ? X[x][r] * sc : 0.f; hval[x][r] = hv; sq[r] += hv * hv; }
                if (vh == 0) { const float hv = X[4][r] * sc; X[4][r] = hv; sq[r] += hv * hv; } }
#pragma unroll
            for (int r = 0; r < 4; ++r) { float v = sq[r]; v += __shfl_xor(v, 1); v += __shfl_xor(v, 2); v += __shfl_xor(v, 4); v += __shfl_xor(v, 8); if (fr == 0) ssq[vh * 64 + 16 * ti + 4 * fq + r] = v; }
#pragma unroll
            for (int vt = 0; vt < 9; ++vt) { pg8::u32x2 o; o.x = pk2(st[vt][0], st[vt][1]); o.y = pk2(st[vt][2], st[vt][3]); *(pg8::u32x2*)(CB + (16 * vt + fr) * ML_STRIDE + 16 * w + 4 * fq) = o; }
            WG_BAR();
            bf16* TM = (bf16*)(a.ws + WS_TM); bf16* YA = (bf16*)(a.ws + WS_YA);
#pragma unroll
            for (int r = 0; r < 4; ++r) { const int t = 16 * ti + 4 * fq + r; const float rs = __builtin_amdgcn_rsqf((ssq[t] + ssq[64 + t]) * (1.f / 128.f) + EPS);
                const size_t ob = (size_t)(rowbase - NCTX + 64 * c + t) * 1024 + h * 128;
#pragma unroll
                for (int x = 0; x < 5; ++x) { const int vt = vh * 5 + x; if (vt < 8) { const int v = 16 * vt + fr; const float hv = (x < 4) ? hval[x][r] : X[4][r];
                    float y = hv * rs * hgv[x] * bf2f(ogv[x][r]);
                    if (PASS2) { y += bf2f(tmv[x][r]); YA[ob + v] = (bf16)f2bf(y); } else TM[ob + v] = (bf16)f2bf(y); } } }
        }
    }
}

__device__ __forceinline__ void ml_state_quad(const Args& a, unsigned char* lds_g, int qu, int tid) {
    const int seq = qu >> 1, j0 = 4 * (qu & 1), dir = seq & 1, h = (seq >> 1) & 7, b = seq >> 4;
    const int lane = tid & 63, w = __builtin_amdgcn_readfirstlane(tid >> 6);
    f32x4 st[9];
#pragma unroll
    for (int vt = 0; vt < 9; ++vt) st[vt] = (f32x4){0.f, 0.f, 0.f, 0.f};
#pragma unroll 1
    for (int jj = 0; jj < 4; ++jj) {
        const int j = j0 + jj, su = seq * 8 + j;
        const int rowbase = j == 0 ? b * CTXL : NCTX + b * SEQ + 256 * (dir ? 8 - j : j - 1);
        ml_gates(a, lds_g, rowbase, h, tid);
        WG_BAR();
        ml_block<false, false>(a, lds_g, rowbase, h, dir, st, tid);
        pg8::u32x2* SL = (pg8::u32x2*)(a.ws + WS_SLOC) + ((size_t)(su * 8 + w) * 9) * 64 + lane;
#pragma unroll
        for (int vt = 0; vt < 9; ++vt) { pg8::u32x2 o; o.x = pk2(st[vt][0], st[vt][1]); o.y = pk2(st[vt][2], st[vt][3]); SL[vt * 64] = o; }
        if (tid == 0) { const float* bd = (const float*)(lds_g + ML_BEND) + dir * 4; ((float*)(a.ws + WS_BT))[su] = (bd[0] + bd[1]) + (bd[2] + bd[3]); }
        WG_BAR();
    }
}
__device__ __forceinline__ void ml_out_unit(const Args& a, unsigned char* lds_g, int u, int tid) {
    const int L = u & 7, h = (u >> 3) & 7, b = u >> 6;
    const int rowbase = NCTX + b * SEQ + 256 * L;
    const int lane = tid & 63, w = __builtin_amdgcn_readfirstlane(tid >> 6), fr = lane & 15, fq = lane >> 4;
    bf16* CB = (bf16*)(lds_g + ML_CB);
    ml_gates(a, lds_g, rowbase, h, tid);
    f32x4 st[9];
#pragma unroll
    for (int dir = 0; dir < 2; ++dir) {
        const int seq = (b * 8 + h) * 2 + dir, jmax = dir ? 7 - L : L;
        const float* BT = (const float*)(a.ws + WS_BT) + seq * 8;
        {
            const pg8::u32x2* SLa = (const pg8::u32x2*)(a.ws + WS_SLOC) + ((size_t)((seq * 8 + jmax) * 8 + w) * 9) * 64 + lane;
            const pg8::u32x2* SLb = (const pg8::u32x2*)(a.ws + WS_SLOC) + ((size_t)((seq * 8 + 3) * 8 + w) * 9) * 64 + lane;
            pg8::u32x2 sa[9];
            if (jmax >= 4) {
                pg8::u32x2 sb[9];
#pragma unroll
                for (int vt = 0; vt < 9; ++vt) { sa[vt] = SLa[vt * 64]; sb[vt] = SLb[vt * 64]; }
                float ls = 0.f;
#pragma unroll
                for (int q = 4; q < 8; ++q) ls += (q <= jmax) ? BT[q] : 0.f;
                const float coef = __expf(ls);
#pragma unroll
                for (int vt = 0; vt < 9; ++vt) st[vt] = (f32x4){bflo(sa[vt].x) + bflo(sb[vt].x) * coef, bfhi(sa[vt].x) + bfhi(sb[vt].x) * coef, bflo(sa[vt].y) + bflo(sb[vt].y) * coef, bfhi(sa[vt].y) + bfhi(sb[vt].y) * coef};
            } else {
#pragma unroll
                for (int vt = 0; vt < 9; ++vt) { sa[vt] = SLa[vt * 64]; st[vt] = (f32x4){bflo(sa[vt].x), bfhi(sa[vt].x), bflo(sa[vt].y), bfhi(sa[vt].y)}; }
            }
        }
#pragma unroll
        for (int vt = 0; vt < 9; ++vt) { pg8::u32x2 o; o.x = pk2(st[vt][0], st[vt][1]); o.y = pk2(st[vt][2], st[vt][3]); *(pg8::u32x2*)(CB + (16 * vt + fr) * ML_STRIDE + 16 * w + 4 * fq) = o; }
        WG_BAR();
        if (dir == 0) ml_block<true, false>(a, lds_g, rowbase, h, 0, st, tid);
        else ml_block<true, true>(a, lds_g, rowbase, h, 1, st, tid);
        asm volatile("s_waitcnt vmcnt(0)" ::: "memory");
        WG_BAR();
    }
}

__device__ __forceinline__ void lru_out_unit(const Args& a, unsigned char* lds_g, int b, int cidx, int blk, int tid) {
    const int chl = tid & 127, q = tid >> 7, ch = blk * 128 + chl;
    float2* QA = (float2*)lds_g;
    float av[2][16], bv[2][16];
#pragma unroll
    for (int d = 0; d < 2; ++d) { const unsigned* PS = (const unsigned*)(a.ws + WS_PS) + ((size_t)(b * 2 + d) * NSTEP + 64 * cidx + 16 * q) * 1024 + ch;
#pragma unroll
        for (int i = 0; i < 16; ++i) { const unsigned wv = PS[(size_t)i * 1024]; av[d][i] = 1.f - bflo(wv); bv[d][i] = bfhi(wv); } }
    float2* CA = (float2*)(lds_g + 8192);
#pragma unroll
    for (int d = 0; d < 2; ++d) { const float2* AGG = (const float2*)(a.ws + WS_AGG) + ((size_t)(b * 2 + d) * 36) * 1024 + ch; float2 qv[9];
#pragma unroll
        for (int i = 0; i < 9; ++i) { const int sidx = 9 * q + i; const int c2 = d ? (sidx < 4 ? 3 - sidx : 39 - sidx) : sidx; qv[i] = AGG[(size_t)c2 * 1024]; }
        float P = 1.f, S = 0.f;
#pragma unroll
        for (int i = 0; i < 9; ++i) { const int sidx = 9 * q + i; const int c2 = d ? (sidx < 4 ? 3 - sidx : 39 - sidx) : sidx; const bool use = d ? (sidx < 4 || c2 > cidx) : (c2 < cidx);
            S = use ? qv[i].x * S + qv[i].y : S; P = use ? qv[i].x * P : P; }
        CA[(d * 4 + q) * 128 + chl] = make_float2(P, S); }
#pragma unroll
    for (int d = 0; d < 2; ++d) { float P = 1.f, S = 0.f;
#pragma unroll
        for (int ii = 0; ii < 16; ++ii) { const int i = d ? 15 - ii : ii; S = av[d][i] * S + bv[d][i]; P = av[d][i] * P; }
        QA[(d * 4 + q) * 128 + chl] = make_float2(P, S); }
    WG_BAR();
    float hs[16];
#pragma unroll
    for (int d = 0; d < 2; ++d) { float h = 0.f;
#pragma unroll
        for (int k = 0; k < 4; ++k) { const float2 t = CA[(d * 4 + k) * 128 + chl]; h = t.x * h + t.y; }
#pragma unroll
        for (int k = 0; k < 3; ++k) { const int qq = d ? 3 - k : k; const bool use = d ? (qq > q) : (qq < q); const float2 t = QA[(d * 4 + qq) * 128 + chl]; h = use ? t.x * h + t.y : h; }
#pragma unroll
        for (int ii = 0; ii < 16; ++ii) { const int i = d ? 15 - ii : ii; h = av[d][i] * h + bv[d][i]; if (d == 0) hs[i] = h; else hs[i] += h; } }
    const int p0 = (cidx - 4) * 64 + 16 * q;
    unsigned short ugv[16];
#pragma unroll
    for (int i = 0; i < 16; ++i) ugv[i] = ((const bf16*)(a.ws + WS_UG))[(size_t)(lru_pos_row(b, false, p0 + i) - NCTX) * 1024 + ch];
#pragma unroll
    for (int i = 0; i < 16; ++i) { const size_t lrow = (size_t)(lru_pos_row(b, false, p0 + i) - NCTX) * 1024 + ch;
        ((bf16*)(a.ws + WS_YB))[lrow] = (bf16)f2bf(hs[i] * bf2f(ugv[i])); }
    WG_BAR();
}
__device__ __forceinline__ void phase3(const Args& a, unsigned char* lds_g, int tid) {
    {
        int q0 = (int)blockIdx.x, qstep = (int)gridDim.x;
        if (gridDim.x == 256) q0 = blockIdx.x >= 128 ? (int)blockIdx.x - 128 : 128;
        for (int qu = q0; qu < 128; qu += qstep) ml_state_quad(a, lds_g, qu, tid);
    }
    for (int u = blockIdx.x; u < 4 * 36 * 8; u += gridDim.x) { const int blk = u & 7, q = u >> 3; lru_unit<false>(a, lds_g, q / 36, q % 36, blk, tid); }
}

struct SchedProj {
    int G, c; const char *YA, *YB, *WA, *WB;
    __device__ __forceinline__ bool next(int i, pg8::Unit& u) const {
        const int tile = (i >> 1) * G + c, part = i & 1; if (tile >= 256) return false;
        int pm, pn; pg8::tile_order(tile, 32, 8, pm, pn);
        u.pm = pm; u.pn = pn; u.aux = part; u.A = (part ? YB : YA) + (size_t)pm * 256 * 1024 * 2; u.B = (part ? WB : WA) + (size_t)pn * 256 * 1024 * 2; return true;
    }
};
struct EpiProj {
    static constexpr bool PERM = true, CARRY = true;
    const bf16 *GA, *GB; bf16* PRE;
    __device__ __forceinline__ bool keep(const pg8::Unit& u) const { return u.aux == 0; }
    __device__ __forceinline__ void operator()(pg8::f32x4 (&acc)[2][2][4][2], const pg8::Unit& u, int wr, int wc, int fr, int fq) const {
#pragma unroll
        for (int ai = 0; ai < 2; ++ai) {
            pg8::u32x4 gb4[4][2], ga4[4][2];
#pragma unroll
            for (int m = 0; m < 4; ++m) { const size_t off = (size_t)(u.pm * 256 + ai * 128 + wr * 64 + m * 16 + fr) * 2048 + u.pn * 256 + wc * 32 + 8 * fq;
#pragma unroll
                for (int bj = 0; bj < 2; ++bj) { gb4[m][bj] = *(const pg8::u32x4*)(GB + off + bj * 128); if (u.aux == 0) ga4[m][bj] = *(const pg8::u32x4*)(GA + off + bj * 128); } }
#pragma unroll
            for (int m = 0; m < 4; ++m) { const size_t off = (size_t)(u.pm * 256 + ai * 128 + wr * 64 + m * 16 + fr) * 2048 + u.pn * 256 + wc * 32 + 8 * fq;
#pragma unroll
                for (int bj = 0; bj < 2; ++bj) { const pg8::u32x4 g4 = gb4[m][bj];
                    const float gbv[8] = {bflo(g4.x), bfhi(g4.x), bflo(g4.y), bfhi(g4.y), bflo(g4.z), bfhi(g4.z), bflo(g4.w), bfhi(g4.w)};
                    if (u.aux == 0) { const pg8::u32x4 a4 = ga4[m][bj];
                        const float gav[8] = {bflo(a4.x), bfhi(a4.x), bflo(a4.y), bfhi(a4.y), bflo(a4.z), bfhi(a4.z), bflo(a4.w), bfhi(a4.w)};
#pragma unroll
                        for (int e = 0; e < 4; ++e) { acc[ai][bj][m][0][e] *= gav[e] * __builtin_amdgcn_rcpf(fmaxf(gbv[e], 1e-20f)); acc[ai][bj][m][1][e] *= gav[4 + e] * __builtin_amdgcn_rcpf(fmaxf(gbv[4 + e], 1e-20f)); }
                    } else {
                        pg8::f32x4 v0 = acc[ai][bj][m][0], v1 = acc[ai][bj][m][1];
#pragma unroll
                        for (int e = 0; e < 4; ++e) { v0[e] *= gbv[e]; v1[e] *= gbv[4 + e]; }
                        pg8::u32x4 w; w.x = pg8::cvt_pk_bf16(v0[0], v0[1]); w.y = pg8::cvt_pk_bf16(v0[2], v0[3]); w.z = pg8::cvt_pk_bf16(v1[0], v1[1]); w.w = pg8::cvt_pk_bf16(v1[2], v1[3]);
                        *(pg8::u32x4*)(PRE + off + bj * 128) = w; } } }
        }
    }
};

struct SchedOut {
    int G, c; const char *A, *B;
    __device__ __forceinline__ bool next(int i, pg8::Unit& u) const {
        const int L = i * G + c; if (L >= 256) return false;
        int pm, pn; pg8::tile_order(L, 32, 8, pm, pn);
        u.pm = pm; u.pn = pn; u.aux = 0; u.A = A + (size_t)pm * 256 * D * 2; u.B = B + (size_t)pn * 256 * D * 2; return true;
    }
};
struct EpiOut {
    static constexpr bool PERM = true, CARRY = false;
    __device__ __forceinline__ bool keep(const pg8::Unit&) const { return false; }
    const float* x; const float* MOD; bf16* X1;
    __device__ __forceinline__ void operator()(const pg8::f32x4 (&acc)[2][2][4][2], const pg8::Unit& u, int wr, int wc, int fr, int fq) const {
        const int b = u.pm >> 3; const int col0 = u.pn * 256 + wc * 32 + 8 * fq;
        pg8::f32x4 g1[2][2];
#pragma unroll
        for (int bj = 0; bj < 2; ++bj)
#pragma unroll
            for (int n = 0; n < 2; ++n) g1[bj][n] = *(const pg8::f32x4*)(MOD + b * 12288 + 2 * 2048 + col0 + bj * 128 + n * 4);
#pragma unroll
        for (int ai = 0; ai < 2; ++ai) {
            pg8::f32x4 xv[4][2][2];
#pragma unroll
            for (int m = 0; m < 4; ++m) { const size_t off = (size_t)(u.pm * 256 + ai * 128 + wr * 64 + m * 16 + fr) * D + col0;
#pragma unroll
                for (int bj = 0; bj < 2; ++bj)
#pragma unroll
                    for (int n = 0; n < 2; ++n) xv[m][bj][n] = *(const pg8::f32x4*)(x + off + bj * 128 + n * 4); }
#pragma unroll
            for (int m = 0; m < 4; ++m) { const size_t off = (size_t)(u.pm * 256 + ai * 128 + wr * 64 + m * 16 + fr) * D + col0;
#pragma unroll
                for (int bj = 0; bj < 2; ++bj) { const pg8::f32x4 v0 = xv[m][bj][0] + g1[bj][0] * acc[ai][bj][m][0], v1 = xv[m][bj][1] + g1[bj][1] * acc[ai][bj][m][1];
                    pg8::u32x4 w; w.x = pg8::cvt_pk_bf16(v0[0], v0[1]); w.y = pg8::cvt_pk_bf16(v0[2], v0[3]); w.z = pg8::cvt_pk_bf16(v1[0], v1[1]); w.w = pg8::cvt_pk_bf16(v1[2], v1[3]);
                    *(pg8::u32x4*)(X1 + off + bj * 128) = w; } }
        }
    }
};

__device__ __forceinline__ void phase_router(const Args& a, unsigned char* lds_g, int tid, int lane, int wave) {
    const bf16* X1 = (const bf16*)(a.ws + WS_X1); const float* MOD = (const float*)(a.ws + WS_MOD); const float* g = a.in[I_N2G];
    const float* WR = (const float*)(a.ws + WS_WR); const float* RB = (const float*)(a.ws + WS_RB);
    bf16* H2 = (bf16*)(a.ws + WS_H2); unsigned* cnt = (unsigned*)(a.ws + WS_CTL) + CW_CNT; int4* ASG = (int4*)(a.ws + WS_ASG);
    f32x4* PART = (f32x4*)lds_g;
    float* SSQP = (float*)(lds_g + 24576);
    float* RS = (float*)(lds_g + 24576 + 512);
    float* LG = (float*)(lds_g + 24576 + 1024);
    const int slot = wave >> 2, kq = wave & 3, i = lane & 15, gq = lane >> 4;
    for (int tp = blockIdx.x; tp < NLAT / 32; tp += gridDim.x) {
        const int tok0 = 32 * tp + 16 * slot, b = tok0 >> 11, kbase = kq * 512 + 8 * gq;
        const bf16* xr = X1 + (size_t)(tok0 + i) * D + kbase;
        const float* wr = WR + ((size_t)(b * 48 + i) * 2048 + kbase);
        f32x4 acc0 = (f32x4){0.f, 0.f, 0.f, 0.f}, acc1 = acc0, acc2 = acc0; float sq = 0.f;
#pragma unroll 2
        for (int s8 = 0; s8 < 16; ++s8) {
            const v4u xb = *(const v4u*)(xr + 32 * s8);
            const f32x4 b0a = *(const f32x4*)(wr + 32 * s8), b0b = *(const f32x4*)(wr + 32 * s8 + 4), b1a = *(const f32x4*)(wr + 16 * 2048 + 32 * s8), b1b = *(const f32x4*)(wr + 16 * 2048 + 32 * s8 + 4),
                        b2a = *(const f32x4*)(wr + 32 * 2048 + 32 * s8), b2b = *(const f32x4*)(wr + 32 * 2048 + 32 * s8 + 4);
            const float xe[8] = {bflo(xb.x), bfhi(xb.x), bflo(xb.y), bfhi(xb.y), bflo(xb.z), bfhi(xb.z), bflo(xb.w), bfhi(xb.w)};
#pragma unroll
            for (int e = 0; e < 4; ++e) { acc0 = __builtin_amdgcn_mfma_f32_16x16x4f32(xe[e], b0a[e], acc0, 0, 0, 0); acc1 = __builtin_amdgcn_mfma_f32_16x16x4f32(xe[e], b1a[e], acc1, 0, 0, 0); acc2 = __builtin_amdgcn_mfma_f32_16x16x4f32(xe[e], b2a[e], acc2, 0, 0, 0); }
#pragma unroll
            for (int e = 0; e < 4; ++e) { acc0 = __builtin_amdgcn_mfma_f32_16x16x4f32(xe[4 + e], b0b[e], acc0, 0, 0, 0); acc1 = __builtin_amdgcn_mfma_f32_16x16x4f32(xe[4 + e], b1b[e], acc1, 0, 0, 0); acc2 = __builtin_amdgcn_mfma_f32_16x16x4f32(xe[4 + e], b2b[e], acc2, 0, 0, 0); }
#pragma unroll
            for (int e = 0; e < 8; ++e) sq += xe[e] * xe[e];
        }
        sq += __shfl_xor(sq, 16); sq += __shfl_xor(sq, 32);
        PART[((slot * 4 + kq) * 3 + 0) * 64 + lane] = acc0; PART[((slot * 4 + kq) * 3 + 1) * 64 + lane] = acc1; PART[((slot * 4 + kq) * 3 + 2) * 64 + lane] = acc2;
        if (gq == 0) SSQP[(slot * 4 + kq) * 16 + i] = sq;
        __syncthreads();
        if (kq == 0) {
            const float* sp = SSQP + slot * 64; const float rstd = 1.f / sqrtf(((sp[i] + sp[16 + i]) + (sp[32 + i] + sp[48 + i])) * (1.f / D) + EPS);
            if (gq == 0) RS[slot * 16 + i] = rstd;
#pragma unroll
            for (int cb = 0; cb < 3; ++cb) { const f32x4* pp = PART + (slot * 4 * 3 + cb) * 64 + lane; const f32x4 sum = (pp[0] + pp[3 * 64]) + (pp[6 * 64] + pp[9 * 64]);
                const float rb = RB[b * 48 + 16 * cb + i];
#pragma unroll
                for (int r = 0; r < 4; ++r) LG[(slot * 16 + 4 * gq + r) * 48 + 16 * cb + i] = __shfl(rstd, 4 * gq + r) * sum[r] + rb; }
            LDS_WAIT(); asm volatile("" ::: "memory");
            if (lane < 16) {
                const float* lg = LG + (slot * 16 + lane) * 48; const int t = tok0 + lane;
                int gs = 0; float gm = lg[32];
#pragma unroll
                for (int q = 1; q < 4; ++q) { const float v = lg[32 + q]; if (v > gm) { gm = v; gs = q; } }
                float se = 0.f;
#pragma unroll
                for (int q = 0; q < 4; ++q) se += __expf(lg[32 + q] - gm);
                const float pg = 1.f / se;
                int i0 = 0; float v0 = lg[gs * 8];
#pragma unroll
                for (int q = 1; q < 8; ++q) { const float v = lg[gs * 8 + q]; if (v > v0) { v0 = v; i0 = q; } }
                int i1 = -1; float v1 = -3.0e38f;
#pragma unroll
                for (int q = 0; q < 8; ++q) { const float v = lg[gs * 8 + q]; if (q != i0 && v > v1) { v1 = v; i1 = q; } }
                const float e1 = __expf(v1 - v0), w0 = pg / (1.f + e1), w1 = pg * e1 / (1.f + e1);
                const int ex0 = gs * 8 + i0, ex1 = gs * 8 + i1;
                const unsigned p0 = atomicAdd(cnt + ex0, 1u), p1 = atomicAdd(cnt + ex1, 1u);
                ASG[2 * t] = make_int4(ex0, (int)p0, __float_as_int(w0), 0); ASG[2 * t + 1] = make_int4(ex1, (int)p1, __float_as_int(w1), 0);
                int* LIST = (int*)(a.ws + WS_LIST); LIST[ex0 * 8192 + (int)p0] = t; LIST[ex1 * 8192 + (int)p1] = t;
            }
        }
        __syncthreads();
#pragma unroll
        for (int r = 0; r < 4; ++r) { const int tl = 4 * kq + r, t = tok0 + tl; const float rstd = RS[slot * 16 + tl];
            const unsigned long long* xrow = (const unsigned long long*)(X1 + (size_t)t * D) + lane; unsigned long long* o8 = (unsigned long long*)(H2 + (size_t)t * D) + lane;
            f32x4 yv[8];
#pragma unroll
            for (int j = 0; j < 8; ++j) { const int c = 4 * lane + 256 * j;
                const f32x4 gg = *(const f32x4*)(g + c), sh = *(const f32x4*)(MOD + b * 12288 + 3 * 2048 + c), sc = *(const f32x4*)(MOD + b * 12288 + 4 * 2048 + c);
                const unsigned long long xw = xrow[64 * j]; const f32x4 xv4 = (f32x4){bflo((unsigned)xw), bfhi((unsigned)xw), bflo((unsigned)(xw >> 32)), bfhi((unsigned)(xw >> 32))};
                yv[j] = xv4 * rstd * gg * (sc + 1.f) + sh; }
#pragma unroll
            for (int j = 0; j < 8; ++j) o8[64 * j] = (unsigned long long)pk2(yv[j].x, yv[j].y) | ((unsigned long long)pk2(yv[j].z, yv[j].w) << 32); }
        __syncthreads();
    }
}

constexpr int MG_A = 0, MG_ABYTES = 32768, MG_B = 65536, MG_BBYTES = 64 * 256  , MG_CUM = 141312  ;
__device__ __forceinline__ int mgb_off(int row, int ch) { return 256 * row + 16 * (ch ^ (((row & 3) << 2) | ((row >> 2) & 3))); }
__device__ __forceinline__ bf16x8_t mgb_frag(const unsigned char* img, int ks, int c, int lane) {
    const int g = lane >> 4, q = (lane & 15) >> 2, p = lane & 3;
    const s4_t lo = ds_tr((const bf16*)(img + mgb_off(32 * ks + 8 * g + q, 2 * c + (p >> 1)) + 8 * (p & 1)));
    const s4_t hi = ds_tr((const bf16*)(img + mgb_off(32 * ks + 8 * g + 4 + q, 2 * c + (p >> 1)) + 8 * (p & 1)));
    return (bf16x8_t){lo.x, lo.y, lo.z, lo.w, hi.x, hi.y, hi.z, hi.w};
}
__device__ __forceinline__ void moe_tables(const Args& a, unsigned char* lds_g, int tid) {
    int* cum = (int*)(lds_g + MG_CUM); const unsigned* ctl = (const unsigned*)(a.ws + WS_CTL);
    if (tid < NEXP) cum[128 + tid] = (int)ctl[CW_CNT + tid];
    if (tid == 0) { int c = 0; for (int e = 0; e < NEXP; ++e) { cum[e] = c; c += (int)((ctl[CW_CNT + e] + 255u) >> 8); } cum[NEXP] = c; }
    __syncthreads();
}
constexpr int MH_A = 0, MH_ABYTES = 32768, MH_B = 65536, MH_BROW = 528, MH_BBYTES = 64 * MH_BROW  ;
__device__ __forceinline__ int mhb_off(int row, int ch) { return MH_BROW * row + 16 * ch; }
__device__ __forceinline__ bf16x8_t mhb_frag(const unsigned char* img, int ks, int c, int lane) {
    const int g = lane >> 4, q = (lane & 15) >> 2, p = lane & 3;
    const s4_t lo = ds_tr((const bf16*)(img + mhb_off(32 * ks + 8 * g + q, 2 * c + (p >> 1)) + 8 * (p & 1)));
    const s4_t hi = ds_tr((const bf16*)(img + mhb_off(32 * ks + 8 * g + 4 + q, 2 * c + (p >> 1)) + 8 * (p & 1)));
    return (bf16x8_t){lo.x, lo.y, lo.z, lo.w, hi.x, hi.y, hi.z, hi.w};
}
__device__ __forceinline__ int moe_pull(const Args& a, unsigned char* lds_g, int tid, int x) {
    int* slot = (int*)(lds_g + MG_CUM + 256);
    __syncthreads();
    if (tid == 0) *slot = (int)__hip_atomic_fetch_add((unsigned*)(a.ws + WS_CTL) + CW_Q + 64 * x, 1u, __ATOMIC_RELAXED, __HIP_MEMORY_SCOPE_AGENT);
    __syncthreads();
    return *slot;
}
template <int MODE>
__device__ __forceinline__ int moe_gemm(const Args& a, unsigned char* lds_g, int tid, int idx0) {
    constexpr int K = MODE == 1 ? D : DE, NT = K / 64;
#define MG_BAR() do { asm volatile("s_waitcnt lgkmcnt(0)" ::: "memory"); __builtin_amdgcn_s_barrier(); asm volatile("" ::: "memory"); } while (0)
    const int lane = tid & 63, w = __builtin_amdgcn_readfirstlane(tid >> 6), fr = lane & 15, fq = lane >> 4;
    const int wm = w >> 1, wn = w & 1, hh = wm >> 1, wr = wm & 1;
    const int* cum = (const int*)(lds_g + MG_CUM); const unsigned* ctl = (const unsigned*)(a.ws + WS_CTL);
    const int T = cum[NEXP], x = blockIdx.x & 7;
    const int aoff = pg8::lds_byte(wr * 64 + fr, fq * 8);
    const int bk = tid >> 6, bp = tid & 63;
    int aR[2], aC[2];
#pragma unroll
    for (int i = 0; i < 2; ++i) pg8::stage_rc(tid * 16 + i * 8192, aR[i], aC[i]);
    for (int idx = idx0;;) {
        if (idx < 0) idx = moe_pull(a, lds_g, tid, x);
        if (idx >= (MODE == 1 ? T : 2 * T)) return idx;
        const int ti = MODE == 1 ? idx : idx - T;
        idx = -1;
        const int nt = x;
        if (MODE == 2) {
            if (tid < 64) { unsigned* tc = (unsigned*)(a.ws + WS_CTL) + CW_TC + 64 * ti; unsigned spins = 0;
                while ((unsigned)__builtin_amdgcn_readfirstlane(__hip_atomic_load(tc, __ATOMIC_RELAXED, __HIP_MEMORY_SCOPE_AGENT)) < 64u) {
                    __builtin_amdgcn_s_sleep(2);
                    if (++spins > (1u << 22)) { if (tid == 0) __hip_atomic_store((unsigned*)(a.ws + WS_CTL) + 1, 0x900u + (unsigned)ti, __ATOMIC_RELAXED, __HIP_MEMORY_SCOPE_AGENT); break; } }
                __builtin_amdgcn_fence(__ATOMIC_ACQUIRE, "agent");
                asm volatile("s_waitcnt vmcnt(0)" ::: "memory"); }
            __syncthreads();
        }
        int e = 0;
#pragma unroll 1
        for (int q = 1; q < NEXP; ++q) e = (cum[q] <= ti) ? q : e;
        const int mt = ti - cum[e];
        const char* abase; unsigned aofs[4]; const char* bbase; unsigned bofs; size_t bld;
        if (MODE == 1) { const int cnt = cum[128 + e];
#pragma unroll
            for (int q = 0; q < 4; ++q) { const int pos = 256 * mt + 128 * (q >> 1) + aR[q & 1]; const int tok = pos < cnt ? ((const int*)(a.ws + WS_LIST))[e * 8192 + pos] : 0;
                aofs[q] = (unsigned)(tok * D + aC[q & 1]) * 2u; }
            abase = (const char*)(a.ws + WS_H2);
            const int seg = bp >> 4, mat = seg & 1, col = 128 * nt + 64 * (seg >> 1) + 4 * (bp & 15);
            bbase = (const char*)(a.in[mat ? I_W3 : I_W1] + (size_t)e * D * DE); bofs = (unsigned)(bk * DE + col) * 4u; bld = DE; }
        else {
#pragma unroll
            for (int q = 0; q < 4; ++q) aofs[q] = (unsigned)((128 * (q >> 1) + aR[q & 1]) * DE + aC[q & 1]) * 2u;
            abase = (const char*)((const bf16*)(a.ws + WS_HM) + (size_t)256 * ti * DE);
            bbase = (const char*)(a.in[I_W2] + (size_t)e * DE * D); bofs = (unsigned)(bk * D + 256 * nt + 4 * bp) * 4u; bld = D; }
        const int bwr0 = mhb_off(bk, bp >> 1) + 8 * (bp & 1);
        f32x4 acc[4][8];
#pragma unroll
        for (int m = 0; m < 4; ++m)
#pragma unroll
            for (int n = 0; n < 8; ++n) acc[m][n] = (f32x4){0.f, 0.f, 0.f, 0.f};
        v4u ra[4]; f32x4 rb[8];
#define MH_LD(t_) do { _Pragma("unroll") for (int j_ = 0; j_ < 4; ++j_) ra[j_] = *(const v4u*)(abase + aofs[j_] + 128 * (t_)); \
        _Pragma("unroll") for (int j_ = 0; j_ < 8; ++j_) rb[j_] = *(const f32x4*)(bbase + bofs + (size_t)(64 * (t_) + 8 * j_) * bld * 4); } while (0)
#define MH_ST(buf_) do { _Pragma("unroll") for (int j_ = 0; j_ < 4; ++j_) *(v4u*)(lds_g + MH_A + (buf_) * MH_ABYTES + (j_ >> 1) * 16384 + (j_ & 1) * 8192 + tid * 16) = ra[j_]; \
        _Pragma("unroll") for (int j_ = 0; j_ < 8; ++j_) { pg8::u32x2 o_; o_.x = pk2(rb[j_].x, rb[j_].y); o_.y = pk2(rb[j_].z, rb[j_].w); *(pg8::u32x2*)(lds_g + MH_B + (buf_) * MH_BBYTES + bwr0 + j_ * 8 * MH_BROW) = o_; } } while (0)
#define MH_MMA(buf_) do { const unsigned char* Bi_ = lds_g + MH_B + (buf_) * MH_BBYTES; \
        _Pragma("unroll") for (int ks_ = 0; ks_ < 2; ++ks_) { bf16x8_t af_[4]; \
            _Pragma("unroll") for (int m_ = 0; m_ < 4; ++m_) af_[m_] = *(const bf16x8_t*)(lds_g + MH_A + (buf_) * MH_ABYTES + hh * 16384 + aoff + m_ * 2048 + ks_ * 1024); \
            _Pragma("unroll") for (int n_ = 0; n_ < 8; n_ += 2) { const bf16x8_t bf0_ = mhb_frag(Bi_, ks_, 8 * wn + n_, lane), bf1_ = mhb_frag(Bi_, ks_, 8 * wn + n_ + 1, lane); \
                _Pragma("unroll") for (int m_ = 0; m_ < 4; ++m_) { acc[m_][n_] = __builtin_amdgcn_mfma_f32_16x16x32_bf16(bf0_, af_[m_], acc[m_][n_], 0, 0, 0); \
                    acc[m_][n_ + 1] = __builtin_amdgcn_mfma_f32_16x16x32_bf16(bf1_, af_[m_], acc[m_][n_ + 1], 0, 0, 0); } \
                __builtin_amdgcn_sched_barrier(0); } } } while (0)
        MH_LD(0);
        MG_BAR();
        MH_ST(0);
        MH_LD(1);
        for (int t = 0; t < NT; t += 2) {
            const int t2 = (t + 2 < NT) ? t + 2 : NT - 1, t3 = (t + 3 < NT) ? t + 3 : NT - 1;
            MG_BAR();
            MH_ST(1);
            MH_LD(t2);
            MH_MMA(0);
            MG_BAR();
            MH_ST(0);
            MH_LD(t3);
            MH_MMA(1);
        }
#undef MH_LD
#undef MH_ST
#undef MH_MMA
        const size_t row0 = (size_t)256 * ti + 128 * hh + 64 * wr + fr;
        if (MODE == 1) { bf16* HM = (bf16*)(a.ws + WS_HM);
#pragma unroll
            for (int m = 0; m < 4; ++m)
#pragma unroll
                for (int n = 0; n < 4; ++n) { float hv[4];
#pragma unroll
                    for (int r = 0; r < 4; ++r) { const float a1 = acc[m][n][r]; hv[r] = a1 * sigmoidf_(a1) * acc[m][n + 4][r]; }
                    const unsigned long long o = (unsigned long long)pk2(hv[0], hv[1]) | ((unsigned long long)pk2(hv[2], hv[3]) << 32);
                    __hip_atomic_store((unsigned long long*)(HM + (row0 + 16 * m) * DE + 128 * nt + 64 * wn + 16 * n + 4 * fq), o, __ATOMIC_RELAXED, __HIP_MEMORY_SCOPE_AGENT); }
            asm volatile("s_waitcnt vmcnt(0)" ::: "memory");
            if (lane == 0) __hip_atomic_fetch_add((unsigned*)(a.ws + WS_CTL) + CW_TC + 64 * ti, 1u, __ATOMIC_RELAXED, __HIP_MEMORY_SCOPE_AGENT); }
        else { bf16* Y2 = (bf16*)(a.ws + WS_Y2);
#pragma unroll
            for (int m = 0; m < 4; ++m)
#pragma unroll
                for (int n = 0; n < 8; ++n) { pg8::u32x2 o; o.x = pk2(acc[m][n][0], acc[m][n][1]); o.y = pk2(acc[m][n][2], acc[m][n][3]);
                    *(pg8::u32x2*)(Y2 + (row0 + 16 * m) * D + 256 * nt + 128 * wn + 16 * n + 4 * fq) = o; } }
    }
#undef MG_BAR
}

__device__ __forceinline__ void phase12(const Args& a, unsigned char* lds_g, int lane, int wave) {
    const int gw = blockIdx.x * NWAVES + wave, NGW = gridDim.x * NWAVES;
    const int* cum = (const int*)(lds_g + MG_CUM);
    const bf16* X1 = (const bf16*)(a.ws + WS_X1); const float* MOD = (const float*)(a.ws + WS_MOD); const float* fg = a.in[I_FG];
    const int4* ASG = (const int4*)(a.ws + WS_ASG); const bf16* Y2 = (const bf16*)(a.ws + WS_Y2);
    for (int t = gw; t < NLAT; t += NGW) {
        const int b = t >> 11; const int4 q0 = ASG[2 * t], q1 = ASG[2 * t + 1];
        const float w0 = __int_as_float(q0.z), w1 = __int_as_float(q1.z);
        const unsigned long long* xr = (const unsigned long long*)(X1 + (size_t)t * D) + lane;
        const unsigned long long* y0 = (const unsigned long long*)(Y2 + (size_t)(256 * cum[q0.x] + q0.y) * D) + lane; const unsigned long long* y1 = (const unsigned long long*)(Y2 + (size_t)(256 * cum[q1.x] + q1.y) * D) + lane;
        f32x4 v[8]; float s = 0.f;
#pragma unroll
        for (int j = 0; j < 8; ++j) {
            const int c = 4 * lane + 256 * j;
            const f32x4 g2 = *(const f32x4*)(MOD + b * 12288 + 5 * 2048 + c);
            const unsigned long long a0 = y0[64 * j], a1 = y1[64 * j];
            f32x4 y; y.x = w0 * bflo((unsigned)a0) + w1 * bflo((unsigned)a1); y.y = w0 * bfhi((unsigned)a0) + w1 * bfhi((unsigned)a1);
            y.z = w0 * bflo((unsigned)(a0 >> 32)) + w1 * bflo((unsigned)(a1 >> 32)); y.w = w0 * bfhi((unsigned)(a0 >> 32)) + w1 * bfhi((unsigned)(a1 >> 32));
            const unsigned long long xw = xr[64 * j];
            v[j] = (f32x4){bflo((unsigned)xw), bfhi((unsigned)xw), bflo((unsigned)(xw >> 32)), bfhi((unsigned)(xw >> 32))} + g2 * y;
            s += (v[j].x * v[j].x + v[j].y * v[j].y) + (v[j].z * v[j].z + v[j].w * v[j].w);
        }
        const float rstd = 1.f / sqrtf(wave_sum(s) * (1.f / D) + EPS);
        f32x4* o = (f32x4*)(a.out + (size_t)t * D) + lane; f32x4 fgv[8];
#pragma unroll
        for (int j = 0; j < 8; ++j) fgv[j] = *(const f32x4*)(fg + 4 * lane + 256 * j);
#pragma unroll
        for (int j = 0; j < 8; ++j) o[64 * j] = v[j] * rstd * fgv[j];
    }
}

__global__ void __launch_bounds__(NTHR, 2) fwd_kernel(Args args) {
    extern __shared__ __attribute__((aligned(16))) unsigned char lds[];
    LAS unsigned char* ldsl = (LAS unsigned char*)lds;
    volatile LAS unsigned* MISC = (volatile LAS unsigned*)(ldsl + MISC_OFF);
    LAS unsigned* TL = (LAS unsigned*)(ldsl + LDSCTL_OFF);
    const int wave_s = __builtin_amdgcn_readfirstlane(threadIdx.x >> 6);
#define TID() make_tid(wave_s)
    { const int t0 = TID(); for (int u = t0; u < (LDS_BYTES - LDSCTL_OFF) / 4; u += NTHR) ((LAS unsigned*)(ldsl + LDSCTL_OFF))[u] = 0u; }
    __syncthreads();
    unsigned char* ws = args.ws;
    unsigned* ctl = (unsigned*)(ws + WS_CTL);
    XcdBarrier bar; bar.bar = ctl + CW_BAR; bar.x = 0; bar.st = nullptr;
    const bool one_launch = (args.ph_hi - args.ph_lo) > 1;
    if (one_launch) bar = xcd_barrier_post(ctl + CW_BAR, MISC + 8, TID());
    const int lo = args.ph_lo, hi = args.ph_hi;
#define IN(k) (lo <= (k) && (k) < hi)
#define SEAM(k) do { if (IN(k) && IN((k) + 1)) xcd_barrier(bar, TID()); } while (0)
    const int G = gridDim.x, c = blockIdx.x;

#define FRESH() const int tid = TID(), lane = tid & 63, wave = __builtin_amdgcn_readfirstlane(tid >> 6); (void)lane; (void)wave
#ifndef DUP_PHASE
#define DUP_PHASE (-1)
#endif
#define PH(k, ...) if (IN(k)) { _Pragma("unroll") for (int rep_ = 0; rep_ < ((DUP_PHASE) == (k) ? 2 : 1); ++rep_) { if (rep_) xcd_barrier(bar, TID()); __VA_ARGS__ } } SEAM(k);
    PH(0, { FRESH(); phase0(args, lds, tid, lane, wave); mod_wait(args, tid); phase1(args, lane, wave); })
    PH(1, {
        SchedIn S{G, c, (const char*)(ws + WS_H), (const char*)(ws + WS_WIN)}; EpiIn E{ws, args.in[I_BGATES]};
        pg8::gemm_phase<EpiIn, SchedIn>(ldsl, D, S, E, TID());
        { const int R_ = (1492 + G - 1) / G; int fi_ = 1492 - (R_ - 1) * G; if (fi_ >= G) fi_ = 0;
          if (c >= fi_) { FRESH(); late_prep(args, lds, (c - fi_) * NWAVES + wave, (G - fi_) * NWAVES, lane, wave); } } })
    PH(2, { FRESH(); phase3(args, lds, tid); })
    PH(3, { FRESH();
        for (int u = c; u < 256; u += G) ml_out_unit(args, lds, u, tid);
        for (int u = c; u < 4 * 32 * 8; u += G) { const int blk = u & 7, q = u >> 3; lru_out_unit(args, lds, q >> 5, 4 + (q & 31), blk, tid); } })
    PH(4, {
        SchedProj S{G, c, (const char*)(ws + WS_YA), (const char*)(ws + WS_YB), (const char*)(ws + WS_WPA), (const char*)(ws + WS_WPB)};
        EpiProj E{(const bf16*)(ws + WS_GA), (const bf16*)(ws + WS_GB), (bf16*)(ws + WS_PRE)};
        pg8::gemm_phase<EpiProj, SchedProj>(ldsl, 1024, S, E, TID()); })
    PH(5, {
        SchedOut S{G, c, (const char*)(ws + WS_PRE), (const char*)(ws + WS_WOUT)}; EpiOut E{args.in[I_X], (const float*)(ws + WS_MOD), (bf16*)(ws + WS_X1)};
        pg8::gemm_phase<EpiOut, SchedOut>(ldsl, D, S, E, TID()); })
    PH(6, { FRESH(); phase_router(args, lds, tid, lane, wave); })
    PH(7, { FRESH(); moe_tables(args, lds, tid); const int nx_ = moe_gemm<1>(args, lds, tid, -1); (void)moe_gemm<2>(args, lds, tid, nx_); })
    PH(8, { FRESH(); moe_tables(args, lds, tid); phase12(args, lds, lane, wave); })
#undef PH
#undef IN
#undef SEAM
}

extern "C" void kernel_launch(void* const* d_in, const int* in_sizes, int n_in, void* d_out, int out_size, void* d_ws, size_t ws_size, hipStream_t stream) {
    static int grid = 0;
    if (grid == 0) {
        if (n_in != 27 || out_size != NLAT * D || ws_size < WS_END) { fprintf(stderr, "kernel_launch: unexpected shapes (n_in %d, out %d, ws %zu)\n", n_in, out_size, ws_size); grid = -1; return; }
        int dev = 0, cus = 0, per_cu = 0;
        if (hipGetDevice(&dev) != hipSuccess || hipDeviceGetAttribute(&cus, hipDeviceAttributeMultiprocessorCount, dev) != hipSuccess) { grid = -1; return; }
        if (hipFuncSetAttribute((const void*)fwd_kernel, hipFuncAttributeMaxDynamicSharedMemorySize, LDS_BYTES) != hipSuccess) { fprintf(stderr, "kernel_launch: hipFuncSetAttribute failed\n"); grid = -1; return; }
        if (hipOccupancyMaxActiveBlocksPerMultiprocessor(&per_cu, (const void*)fwd_kernel, NTHR, LDS_BYTES) != hipSuccess || per_cu < 1) fprintf(stderr, "kernel_launch: occupancy query says %d\n", per_cu);
        (void)hipGetLastError();
        grid = cus;
    }
    if (grid < 0) return;
    (void)hipMemsetAsync((char*)d_ws + WS_CTL, 0, CTL_ZERO_BYTES, stream);
    Args a{};
    for (int i = 0; i < 27; ++i) a.in[i] = (const float*)d_in[i];
    a.out = (float*)d_out; a.ws = (unsigned char*)d_ws;
#if MK_ONE_LAUNCH
    a.ph_lo = 0; a.ph_hi = NPHASE;
    hipLaunchKernelGGL(fwd_kernel, dim3(grid), dim3(NTHR), LDS_BYTES, stream, a);
#else
    for (int p = 0; p < NPHASE; ++p) { a.ph_lo = p; a.ph_hi = p + 1; hipLaunchKernelGGL(fwd_kernel, dim3(grid), dim3(NTHR), LDS_BYTES, stream, a); }
#endif
}
```

```cpp
#include <hip/hip_runtime.h>
#include <cstdio>
#include <cstdint>

#ifndef MK_ONE_LAUNCH
#define MK_ONE_LAUNCH 1
#endif

namespace pg8 {
#define PG8_LAS __attribute__((address_space(3)))
typedef unsigned short bf16_t;
typedef short bf16x8 __attribute__((ext_vector_type(8)));
typedef float f32x4 __attribute__((ext_vector_type(4)));
typedef float f32x2 __attribute__((ext_vector_type(2)));
typedef unsigned u32x4 __attribute__((ext_vector_type(4)));
typedef unsigned u32x2 __attribute__((ext_vector_type(2)));
constexpr int BM = 256, BK = 64, HALF = 128, HTB = HALF * BK * 2  , STAGE_BYTES = 8 * HTB, NXCD = 8, WGM = 8;

__host__ __device__ __forceinline__ int lds_byte(int r, int c) { const int st = (r >> 4) * 2 + (c >> 5), rr = r & 15, cc = c & 31, ob = rr * 64 + cc * 2; return st * 1024 + (ob ^ (((ob >> 9) & 1) << 5)); }
__host__ __device__ __forceinline__ void stage_rc(int b, int& R, int& C) { const int st = b / 1024, sb = b % 1024, swz = sb ^ (((sb >> 9) & 1) << 5); R = (st >> 1) * 16 + swz / 64; C = (st & 1) * 32 + (swz % 64) / 2; }
__host__ __device__ __forceinline__ int perm32(int rho) { const int n = rho >> 4, i = rho & 15; return 8 * (i >> 2) + 4 * n + (i & 3); }

struct Unit { const char* A; const char* B; int pm, pn, aux; };

__host__ __device__ __forceinline__ void tile_order(int L, int nM, int nN, int& pm, int& pn) {
    const int nwg = nM * nN; int wgid = L;
    { const int q = nwg / NXCD, r = nwg % NXCD, xcd = wgid % NXCD, off = wgid / NXCD; wgid = (xcd < r ? xcd * (q + 1) : r * (q + 1) + (xcd - r) * q) + off; }
    const int nig = WGM * nN, gid = wgid / nig, fm = gid * WGM, gsz = (nM - fm) < WGM ? (nM - fm) : WGM;
    pm = fm + ((wgid % nig) % gsz); pn = (wgid % nig) / gsz;
}

typedef __bf16 bf16n2 __attribute__((ext_vector_type(2)));
__device__ __forceinline__ unsigned cvt_pk_bf16(float lo, float hi) { const f32x2 v = {lo, hi}; return __builtin_bit_cast(unsigned, __builtin_convertvector(v, bf16n2)); }

template <class Epi, class Sched>
__device__ __forceinline__ void gemm_phase(PG8_LAS unsigned char* lds, const int K, const Sched& S, const Epi& E, int tid) {
    const int wid = __builtin_amdgcn_readfirstlane(tid >> 6), lane = tid & 63, wr = wid >> 2, wc = wid & 3, fr = lane & 15, fq = lane >> 4;
    const int nt = K / BK;
    unsigned voffA[2], voffB[2];
#pragma unroll
    for (int i = 0; i < 2; ++i) { int R, C; stage_rc(tid * 16 + i * 8192, R, C); const int Rb = Epi::PERM ? ((R & ~31) + perm32(R & 31)) : R;
        voffA[i] = (unsigned)(R * K + C) * 2u; voffB[i] = (unsigned)(Rb * K + C) * 2u; }
    const size_t kstep = (size_t)(BK * 2);
    const size_t hstep = (size_t)HALF * K * 2;
    const unsigned ldsw = (unsigned)wid * 1024u;
    const int aoff = lds_byte(wr * 64 + fr, fq * 8), boff = lds_byte(wc * 32 + fr, fq * 8);
#define PG8_SA(b, h) (((b) * 2 + (h)) * HTB)
#define PG8_SB(b, h) ((4 + (b) * 2 + (h)) * HTB)
#define PG8_STAGE(bufoff, gbase, voff) do { _Pragma("unroll") for (int _i = 0; _i < 2; ++_i) \
        __builtin_amdgcn_global_load_lds((const unsigned*)((const char*)(gbase) + (voff)[_i]), (PG8_LAS unsigned*)(lds + (bufoff) + ldsw + _i * 8192), 16, 0, 0); } while (0)
#define PG8_LDA(dst, b, h) do { _Pragma("unroll") for (int m = 0; m < 4; ++m) _Pragma("unroll") for (int k = 0; k < 2; ++k) dst[m][k] = *(const PG8_LAS bf16x8*)(lds + PG8_SA(b, h) + aoff + m * 2048 + k * 1024); } while (0)
#define PG8_LDB(dst, b, h) do { _Pragma("unroll") for (int n = 0; n < 2; ++n) _Pragma("unroll") for (int k = 0; k < 2; ++k) dst[n][k] = *(const PG8_LAS bf16x8*)(lds + PG8_SB(b, h) + boff + n * 2048 + k * 1024); } while (0)
#define PG8_MMA(ai, bj, At, Bt) do { __builtin_amdgcn_s_setprio(1); _Pragma("unroll") for (int m = 0; m < 4; ++m) _Pragma("unroll") for (int n = 0; n < 2; ++n) _Pragma("unroll") for (int k = 0; k < 2; ++k) \
        acc[ai][bj][m][n] = __builtin_amdgcn_mfma_f32_16x16x32_bf16(Bt[n][k], At[m][k], acc[ai][bj][m][n], 0, 0, 0); __builtin_amdgcn_s_setprio(0); } while (0)
#define PG8_WAIT_V(n) asm volatile("s_waitcnt vmcnt(" #n ")" ::: "memory")
#define PG8_WAIT_L(n) asm volatile("s_waitcnt lgkmcnt(" #n ")" ::: "memory")
#define PG8_BAR __builtin_amdgcn_s_barrier()
#define PG8_SCHED __builtin_amdgcn_sched_barrier(0)
    Unit cur, nxt; int ui = 0;
    if (!S.next(0, cur)) return;
    f32x4 acc[2][2][4][2];
#pragma unroll
    for (int a = 0; a < 2; ++a)
#pragma unroll
        for (int b = 0; b < 2; ++b)
#pragma unroll
            for (int m = 0; m < 4; ++m)
#pragma unroll
                for (int n = 0; n < 2; ++n) acc[a][b][m][n] = (f32x4){0.f, 0.f, 0.f, 0.f};
    bf16x8 At[4][2], B0[2][2], B1[2][2];
    const char* cA = cur.A; const char* cB = cur.B;
    PG8_STAGE(PG8_SB(0, 0), cB, voffB); PG8_STAGE(PG8_SB(0, 1), cB + hstep, voffB); PG8_STAGE(PG8_SA(0, 0), cA, voffA); PG8_STAGE(PG8_SA(0, 1), cA + hstep, voffA);
    if (wr == 1) PG8_BAR;
    PG8_WAIT_V(2); PG8_BAR;
    PG8_STAGE(PG8_SB(1, 0), cB + kstep, voffB); PG8_STAGE(PG8_SA(1, 0), cA + kstep, voffA); PG8_STAGE(PG8_SB(1, 1), cB + hstep + kstep, voffB);
    PG8_WAIT_V(6); PG8_BAR;
    for (;;) {
        const bool has_next = S.next(ui + 1, nxt);
        const char* nA = has_next ? nxt.A : cA; const char* nB = has_next ? nxt.B : cB;
        for (int t = 0; t < nt; t += 2) {
            const bool last = (t == nt - 2);
            const char* a1 = cA + (size_t)(t + 1) * kstep;
            const char* a2 = last ? nA : cA + (size_t)(t + 2) * kstep; const char* b2 = last ? nB : cB + (size_t)(t + 2) * kstep;
            const char* a3 = a2 + kstep; const char* b3 = b2 + kstep;
            PG8_LDB(B0, 0, 0); PG8_LDB(B1, 0, 1); PG8_SCHED; PG8_LDA(At, 0, 0); PG8_STAGE(PG8_SA(1, 1), a1 + hstep, voffA);
            PG8_WAIT_V(8); PG8_WAIT_L(0); PG8_BAR; PG8_MMA(0, 0, At, B0); PG8_MMA(0, 1, At, B1); PG8_BAR; PG8_SCHED;
            PG8_LDA(At, 0, 1); PG8_STAGE(PG8_SB(0, 0), b2, voffB); PG8_STAGE(PG8_SB(0, 1), b2 + hstep, voffB); PG8_STAGE(PG8_SA(0, 0), a2, voffA);
            PG8_WAIT_V(8); PG8_WAIT_L(0); PG8_BAR; PG8_MMA(1, 0, At, B0); PG8_MMA(1, 1, At, B1); PG8_BAR; PG8_SCHED;
            PG8_LDB(B0, 1, 0); PG8_LDB(B1, 1, 1); PG8_SCHED; PG8_LDA(At, 1, 0); PG8_STAGE(PG8_SA(0, 1), a2 + hstep, voffA);
            PG8_WAIT_V(8); PG8_WAIT_L(0); PG8_BAR; PG8_MMA(0, 0, At, B0); PG8_MMA(0, 1, At, B1); PG8_BAR; PG8_SCHED;
            PG8_LDA(At, 1, 1); PG8_STAGE(PG8_SB(1, 0), b3, voffB); PG8_STAGE(PG8_SB(1, 1), b3 + hstep, voffB); PG8_STAGE(PG8_SA(1, 0), a3, voffA);
            PG8_WAIT_V(8); PG8_WAIT_L(0); PG8_BAR; PG8_MMA(1, 0, At, B0); PG8_MMA(1, 1, At, B1); PG8_BAR; PG8_SCHED;
        }
        if (wr == 0) PG8_BAR;
        { int fr_ = fr, fq_ = fq; asm volatile("" : "+v"(fr_), "+v"(fq_)); E(acc, cur, wr, wc, fr_, fq_); }
        if (!has_next) break;
        if (!(Epi::CARRY && E.keep(cur))) {
#pragma unroll
        for (int a = 0; a < 2; ++a)
#pragma unroll
            for (int b = 0; b < 2; ++b)
#pragma unroll
                for (int m = 0; m < 4; ++m)
#pragma unroll
                    for (int n = 0; n < 2; ++n) acc[a][b][m][n] = (f32x4){0.f, 0.f, 0.f, 0.f};
        }
        cur = nxt; cA = nA; cB = nB; ++ui;
        if (wr == 1) PG8_BAR;
    }
    PG8_WAIT_V(0);
    PG8_BAR;
#undef PG8_SA
#undef PG8_SB
#undef PG8_STAGE
#undef PG8_LDA
#undef PG8_LDB
#undef PG8_MMA
#undef PG8_WAIT_V
#undef PG8_WAIT_L
#undef PG8_BAR
#undef PG8_SCHED
}
}

constexpr int NWAVES = 8, NTHR = 512;
constexpr int D = 2048, NB = 4, SEQ = 2048, CTXL = 256, NCTX = NB * CTXL  , NLAT = NB * SEQ  , NTOK = NCTX + NLAT  ;
constexpr int NSTEP = CTXL + SEQ;
constexpr int HEADS = 8, HD = 128, MW = 1024, LW = 1024;
constexpr int NEXP = 32, DE = 1024;
constexpr int IN_DIM = 11296, NT_IN = 45;
constexpr float EPS = 1e-6f;
constexpr int MAXTILES = 96;
constexpr int NPHASE = 9;

constexpr size_t MiB = 1u << 20;
constexpr size_t WS_CTL = 0, CTL_ZERO_BYTES = 1 * MiB;
constexpr size_t WS_MOD = 1 * MiB;
constexpr size_t WS_GATES = 2 * MiB;
constexpr size_t WS_ASG = 4 * MiB + 512 * 1024;
constexpr size_t WS_LIST = 3 * MiB + 512 * 1024;
constexpr size_t WS_WR = 6 * MiB;
constexpr size_t WS_RB = 7 * MiB + 768 * 1024;
constexpr size_t WS_WL = 5 * MiB;
constexpr size_t WS_AGG = 978 * MiB;
constexpr size_t WS_WPA = 8 * MiB, WS_WPB = 12 * MiB, WS_WOUT = 16 * MiB, WS_WIN = 24 * MiB;
constexpr size_t WS_W13 = 72 * MiB, WS_W2 = 328 * MiB;
constexpr size_t WS_PS = 72 * MiB;
constexpr size_t WS_H = 456 * MiB;
constexpr size_t WS_K = 492 * MiB, WS_V = 510 * MiB, WS_UX = 528 * MiB;
constexpr size_t WS_Q = 546 * MiB, WS_OF = 562 * MiB, WS_OB = 578 * MiB, WS_UG = 594 * MiB;
constexpr size_t WS_GA = 610 * MiB, WS_GB = 642 * MiB;
constexpr size_t WS_LA = 674 * MiB, WS_LB = 746 * MiB;
constexpr size_t WS_HS = 818 * MiB, WS_TM = 882 * MiB;
constexpr size_t WS_YA = 946 * MiB, WS_YB = 962 * MiB;
constexpr size_t WS_BT = 982 * MiB;
constexpr size_t WS_SLOC = 984 * MiB;
constexpr size_t WS_END = 1022 * MiB;
constexpr size_t WS_PRE = WS_LA;
constexpr size_t WS_X1 = WS_LB;
constexpr size_t WS_H2 = WS_H;
constexpr size_t WS_XS = WS_K;
constexpr size_t WS_HM = 588 * MiB;
constexpr size_t WS_Y2 = WS_HS;
constexpr int CW_MODC = 32;
constexpr int CW_CNT = 64;
constexpr int CW_NT = 128;
constexpr int CW_TILE_E = 192;
constexpr int CW_BAR = 4096;
constexpr int CW_Q = 8192;
constexpr int CW_TC = 16384;

constexpr int RING_BYTES = 131072;
constexpr int LDSCTL_OFF = 143360;
constexpr int MISC_OFF = LDSCTL_OFF + 384;
constexpr int LDS_BYTES = 147456;

#define GAS __attribute__((address_space(1)))
#define LAS __attribute__((address_space(3)))
typedef unsigned short bf16;
typedef unsigned v4u __attribute__((ext_vector_type(4)));
typedef float f32x4 __attribute__((ext_vector_type(4)));
#define LDS_WAIT() asm volatile("s_waitcnt lgkmcnt(0)" ::: "memory")
#define WG_BAR() do { asm volatile("s_waitcnt lgkmcnt(0)" ::: "memory"); __builtin_amdgcn_s_barrier(); asm volatile("" ::: "memory"); } while (0)

__device__ __forceinline__ unsigned f2bf(float f) { unsigned u = __builtin_bit_cast(unsigned, f); return (u + 0x7fffu + ((u >> 16) & 1u)) >> 16; }
__device__ __forceinline__ unsigned pk2(float lo, float hi) { return pg8::cvt_pk_bf16(lo, hi); }
__device__ __forceinline__ float bf2f(unsigned h) { return __builtin_bit_cast(float, h << 16); }
__device__ __forceinline__ float bflo(unsigned w) { return __builtin_bit_cast(float, w << 16); }
__device__ __forceinline__ float bfhi(unsigned w) { return __builtin_bit_cast(float, w & 0xffff0000u); }
__device__ __forceinline__ float sigmoidf_(float x) { return __builtin_amdgcn_rcpf(1.f + __expf(-x)); }
__device__ __forceinline__ float gelu_tanh(float x) { const float u = 0.7978845608028654f * (x + 0.044715f * x * x * x); return x * __builtin_amdgcn_rcpf(1.f + __expf(-2.f * u)); }
__device__ __forceinline__ float wave_sum(float v) {
#pragma unroll
    for (int o = 1; o < 64; o <<= 1) v += __shfl_xor(v, o);
    return v;
}

#define XB_TMO      128
#define XB_XCNT(j)  (256  + 64 * (j))
#define XB_XSUB(j)  (1280 + 64 * (j))
#define XB_XGEN(j)  (2304 + 64 * (j))
#define XB_TOP      3328
#define XB_TOPGEN   3392
#define XCD_BAR_WORDS 3456
#define XB_SPIN_CAP (1u << 23)
__device__ __forceinline__ unsigned xb_ld(unsigned* p)              { return __hip_atomic_load(p, __ATOMIC_RELAXED, __HIP_MEMORY_SCOPE_AGENT); }
__device__ __forceinline__ unsigned xb_add(unsigned* p, unsigned v) { return __hip_atomic_fetch_add(p, v, __ATOMIC_RELAXED, __HIP_MEMORY_SCOPE_AGENT); }
__device__ __forceinline__ unsigned xb_xcc_id() { return (unsigned)__builtin_amdgcn_s_getreg((3 << 11) | 20) & 0xFu; }
#define XB_SPIN(cond, bar) do { unsigned _sp = 0; while (cond) { __builtin_amdgcn_s_sleep(1); \
    if ((++_sp & 255u) == 0u) { if (xb_ld(&(bar)[XB_TMO])) break; if (_sp > XB_SPIN_CAP) { atomicAdd(&(bar)[XB_TMO], 1u); break; } } } } while (0)
struct XcdBarrier { unsigned* bar; unsigned x; volatile LAS unsigned* st; };
__device__ __forceinline__ XcdBarrier xcd_barrier_post(unsigned* bar, volatile LAS unsigned* st, int tid) {
    XcdBarrier b; b.bar = bar; b.x = xb_xcc_id(); b.st = st;
    if (tid == 0) (void)xb_add(&bar[XB_XCNT(b.x)], 1u);
    return b;
}
__device__ __forceinline__ void xcd_barrier_complete(unsigned* bar, unsigned x, unsigned& nloc, unsigned& nx) {
    const unsigned G = gridDim.x * gridDim.y * gridDim.z;
    unsigned sum, cnt, mine, sp = 0u;
    for (;;) {
        sum = 0u; cnt = 0u; mine = 0u;
#pragma unroll
        for (unsigned j = 0; j < 16; ++j) { const unsigned c = xb_ld(&bar[XB_XCNT(j)]); sum += c; cnt += (c > 0u) ? 1u : 0u; mine = (j == x) ? c : mine; }
        if (sum == G) break;
        __builtin_amdgcn_s_sleep(1);
        if ((++sp & 255u) == 0u) { if (xb_ld(&bar[XB_TMO])) break; if (sp > XB_SPIN_CAP) { atomicAdd(&bar[XB_TMO], 1u); break; } }
    }
    nloc = mine > 0u ? mine : 1u; nx = cnt > 0u ? cnt : 1u;
}
__device__ __forceinline__ void xcd_barrier(const XcdBarrier& b, int tid) {
    asm volatile("s_waitcnt vmcnt(0)" ::: "memory");
    __syncthreads();
    if (tid == 0) {
        unsigned* bar = b.bar;
        __builtin_amdgcn_s_waitcnt(0);
        unsigned nloc = b.st[0], nx = b.st[1];
        if (nloc == 0u) { xcd_barrier_complete(bar, b.x, nloc, nx); b.st[0] = nloc; b.st[1] = nx; }
        const unsigned old = xb_add(&bar[XB_XSUB(b.x)], 1u);
        const unsigned gen = old / nloc;
        if (old + 1u == (gen + 1u) * nloc) {
            __builtin_amdgcn_fence(__ATOMIC_RELEASE, "agent");
            asm volatile("s_waitcnt vmcnt(0)" ::: "memory");
            const unsigned og = xb_add(&bar[XB_TOP], 1u);
            const unsigned tg = og / nx;
            if (og + 1u == (tg + 1u) * nx) xb_add(&bar[XB_TOPGEN], 1u);
            else XB_SPIN(xb_ld(&bar[XB_TOPGEN]) == tg, bar);
            __builtin_amdgcn_fence(__ATOMIC_ACQUIRE, "agent");
            xb_add(&bar[XB_XGEN(b.x)], 1u);
            asm volatile("s_waitcnt vmcnt(0)" ::: "memory");
        } else {
            XB_SPIN(xb_ld(&bar[XB_XGEN(b.x)]) == gen, bar);
            __builtin_amdgcn_fence(__ATOMIC_ACQUIRE, "agent");
            asm volatile("s_waitcnt vmcnt(0)" ::: "memory");
        }
    }
    __syncthreads();
}

__device__ __forceinline__ int make_tid(int wave_s) { int l; asm volatile("v_mbcnt_lo_u32_b32 %0, -1, 0\n\tv_mbcnt_hi_u32_b32 %0, -1, %0" : "=v"(l)); __builtin_assume(l >= 0 && l < 64); __builtin_assume(wave_s >= 0 && wave_s < 8); return wave_s * 64 + l; }
struct Args { const float* in[27]; float* out; unsigned char* ws; int ph_lo, ph_hi; };
enum { I_X = 0, I_C, I_CTX, I_CCTX, I_WMOD, I_BMOD, I_N1G, I_WIN, I_BGATES, I_HEADG, I_CONVW, I_CONVB, I_LWA, I_LBA, I_LWX, I_LBX, I_LAM, I_WPA, I_WPB, I_WOUT, I_N2G, I_WRG, I_WRE, I_W1, I_W3, I_W2, I_FG };

__device__ __forceinline__ void tr_item(const float* __restrict__ W, size_t ldw, int k0, int n0, bf16* dst, size_t ldd, float scale, LAS float* scr, int lane) {
#pragma unroll 16
    for (int i = 0; i < 32; ++i) { const int kk = 2 * i + (lane >> 5); scr[kk * 33 + (lane & 31)] = W[(size_t)(k0 + kk) * ldw + n0 + (lane & 31)]; }
    LDS_WAIT(); asm volatile("" ::: "memory");
    const int c = lane & 7;
#pragma unroll
    for (int j = 0; j < 4; ++j) { const int n = (lane >> 3) + 8 * j; const LAS float* s = scr + (8 * c) * 33 + n;
        v4u o; o.x = pk2(s[0 * 33] * scale, s[1 * 33] * scale); o.y = pk2(s[2 * 33] * scale, s[3 * 33] * scale); o.z = pk2(s[4 * 33] * scale, s[5 * 33] * scale); o.w = pk2(s[6 * 33] * scale, s[7 * 33] * scale);
        *(GAS v4u*)(dst + (size_t)n * ldd + 8 * c) = o; }
    LDS_WAIT(); asm volatile("" ::: "memory");
}
__device__ __forceinline__ int win_row(int n0, float& scale) {
    scale = 1.f;
    if (n0 < 1024) return 13 * 256 + n0;
    if (n0 < 2048) { scale = 0.08838834764831845f; return n0 - 1024; }
    if (n0 < 3072) return 4 * 256 + (n0 - 2048);
    if (n0 < 4096) return 17 * 256 + (n0 - 3072);
    if (n0 < 5120) return 21 * 256 + (n0 - 4096);
    if (n0 < 5152) return 12 * 256 + (n0 - 5120);
    if (n0 < 6176) return 8 * 256 + (n0 - 5152);
    if (n0 < 7200) return 25 * 256 + (n0 - 6176);
    if (n0 < 9248) return 29 * 256 + (n0 - 7200);
    return 37 * 256 + (n0 - 9248);
}

__device__ __forceinline__ void phase0(const Args& a, unsigned char* lds_g, int tid, int lane, int wave) {
    unsigned char* ws = a.ws;
    {
        float* sl = (float*)lds_g;
        float* red = sl + 5 * 2048;
        for (int i = tid; i < 5 * 2048; i += NTHR) { const int r = i >> 11, k = i & 2047; const float v = r < 4 ? a.in[I_C][r * 2048 + k] : a.in[I_CCTX][k]; sl[i] = v / (1.f + __expf(-v)); }
        __syncthreads();
        const float* wm = a.in[I_WMOD]; const float* bm = a.in[I_BMOD]; float* MOD = (float*)(ws + WS_MOD);
        for (int cb = blockIdx.x; cb < 256; cb += gridDim.x) {
            const int n0 = cb * 48;
            if (tid < 504) {
                const int kq = tid / 12, cg = tid % 12;
                f32x4 acc[5];
#pragma unroll
                for (int r = 0; r < 5; ++r) acc[r] = (f32x4){0.f, 0.f, 0.f, 0.f};
#pragma unroll 7
                for (int k = kq; k < 2048; k += 42) {
                    const f32x4 w = *(const f32x4*)(wm + (size_t)k * 12288 + n0 + 4 * cg);
#pragma unroll
                    for (int r = 0; r < 5; ++r) acc[r] += w * sl[r * 2048 + k];
                }
#pragma unroll
                for (int r = 0; r < 5; ++r) *(f32x4*)(red + tid * 20 + r * 4) = acc[r];
            }
            __syncthreads();
            if (tid < 240) {
                const int cg = tid / 20, rj = tid % 20; float s = 0.f;
                for (int kq = 0; kq < 42; ++kq) s += red[(kq * 12 + cg) * 20 + rj];
                const int r = rj >> 2, j = rj & 3, n = n0 + 4 * cg + j;
                __hip_atomic_store(MOD + r * 12288 + n, s + bm[n], __ATOMIC_RELAXED, __HIP_MEMORY_SCOPE_AGENT);
            }
            __syncthreads();
        }
        if (tid == 0) __hip_atomic_fetch_add((unsigned*)(ws + WS_CTL) + CW_MODC, 1u, __ATOMIC_RELAXED, __HIP_MEMORY_SCOPE_AGENT);
    }
    {
        LAS float* scr = (LAS float*)((LAS unsigned char*)lds_g) + wave * 4096;
        const int gw = blockIdx.x * NWAVES + wave, NGW = gridDim.x * NWAVES;
        constexpr int J0 = 32 * 353, J1 = 16 * 64, J3 = 32 * 64;
        constexpr int JL = 256;
        constexpr int NITEMS = J0 + 2 * J1;
        (void)J3; (void)JL;
        for (int it = gw; it < NITEMS; it += NGW) {
            int r = it;
            if (r < J0) { const int kb = r / 353, nb = r % 353; float sc; const int row = win_row(32 * nb, sc);
                tr_item(a.in[I_WIN], IN_DIM, 64 * kb, 32 * nb, (bf16*)(ws + WS_WIN) + (size_t)row * 2048 + 64 * kb, 2048, sc, scr, lane); continue; } r -= J0;
            if (r < J1) { const int kb = r / 64, nb = r % 64; tr_item(a.in[I_WPA], 2048, 64 * kb, 32 * nb, (bf16*)(ws + WS_WPA) + (size_t)(32 * nb) * 1024 + 64 * kb, 1024, 1.f, scr, lane); continue; } r -= J1;
            if (r < J1) { const int kb = r / 64, nb = r % 64; tr_item(a.in[I_WPB], 2048, 64 * kb, 32 * nb, (bf16*)(ws + WS_WPB) + (size_t)(32 * nb) * 1024 + 64 * kb, 1024, 1.f, scr, lane); continue; }
        }
        { GAS v4u* z = (GAS v4u*)((bf16*)(ws + WS_WIN) + (size_t)(12 * 256 + 32) * 2048); const int nchunks = 224 * 256;
          for (int i = blockIdx.x * NTHR + tid; i < nchunks; i += gridDim.x * NTHR) z[i] = (v4u){0u, 0u, 0u, 0u}; }
    }
}

__device__ __forceinline__ void late_prep(const Args& a, unsigned char* lds_g, int gw, int NGW, int lane, int wave) {
    unsigned char* ws = a.ws;
    {
        LAS float* scr = (LAS float*)((LAS unsigned char*)lds_g) + wave * 4096;
        constexpr int J3 = 32 * 64, JL = 256;
        for (int it = gw; it < J3 + JL; it += NGW) {
            int r = it;
            if (r >= J3) { r -= J3; const int mi = r >> 3, kb = (r >> 2) & 1, nb = r & 3, dir = mi >> 4, mat = (mi >> 3) & 1, blk = mi & 7;
                tr_item(a.in[mat ? I_LWX : I_LWA] + (size_t)(dir * 8 + blk) * 128 * 128, 128, 64 * kb, 32 * nb, (bf16*)(ws + WS_WL) + ((size_t)((dir * 2 + mat) * 8 + blk) * 128 + 32 * nb) * 128 + 64 * kb, 128, 1.f, scr, lane); continue; }
            const int kb = r / 64, nb = r % 64; tr_item(a.in[I_WOUT], 2048, 64 * kb, 32 * nb, (bf16*)(ws + WS_WOUT) + (size_t)(32 * nb) * 2048 + 64 * kb, 2048, 1.f, scr, lane);
        }
    }
    {
        const float* MODr = (const float*)(a.ws + WS_MOD); float* WR = (float*)(a.ws + WS_WR); float* RB = (float*)(a.ws + WS_RB);
        for (int idx = gw * 64 + lane; idx < 4 * 48 * 2048; idx += NGW * 64) { const int k = idx & 2047, j = (idx >> 11) % 48, b = idx / (48 * 2048);
            const float gm = a.in[I_N2G][k] * (1.f + MODr[b * 12288 + 4 * 2048 + k]);
            const float wv = j < 32 ? a.in[I_WRE][(size_t)k * 32 + j] : (j < 36 ? a.in[I_WRG][(size_t)k * 4 + (j - 32)] : 0.f);
            WR[idx] = gm * wv; }
        for (int q = gw; q < 4 * 48; q += NGW) { const int b = q / 48, j = q % 48; float sacc = 0.f;
            if (j < 36) { for (int k = lane; k < 2048; k += 64) { const float wv = j < 32 ? a.in[I_WRE][(size_t)k * 32 + j] : a.in[I_WRG][(size_t)k * 4 + (j - 32)]; sacc += MODr[b * 12288 + 3 * 2048 + k] * wv; } }
            sacc = wave_sum(sacc); if (lane == 0) RB[q] = sacc; }
    }
}
__device__ __forceinline__ void mod_wait(const Args& a, int tid) {
    if (tid < 64) { unsigned* mc = (unsigned*)(a.ws + WS_CTL) + CW_MODC; unsigned spins = 0;
        while ((unsigned)__builtin_amdgcn_readfirstlane(__hip_atomic_load(mc, __ATOMIC_RELAXED, __HIP_MEMORY_SCOPE_AGENT)) < gridDim.x) {
            __builtin_amdgcn_s_sleep(2);
            if (++spins > (1u << 22)) { if (tid == 0) __hip_atomic_store((unsigned*)(a.ws + WS_CTL) + 1, 0x800u, __ATOMIC_RELAXED, __HIP_MEMORY_SCOPE_AGENT); break; } }
        __builtin_amdgcn_fence(__ATOMIC_ACQUIRE, "agent");
        asm volatile("s_waitcnt vmcnt(0)" ::: "memory"); }
    __syncthreads();
}
__device__ __forceinline__ void phase1(const Args& a, int lane, int wave) {
    const int gw = blockIdx.x * NWAVES + wave, NGW = gridDim.x * NWAVES;
    const float* MOD = (const float*)(a.ws + WS_MOD); const float* g = a.in[I_N1G];
    bf16* H = (bf16*)(a.ws + WS_H);
    for (int r = gw; r < NTOK; r += NGW) {
        const float* src = r < NCTX ? a.in[I_CTX] + (size_t)r * D : a.in[I_X] + (size_t)(r - NCTX) * D;
        const int mr = r < NCTX ? 4 : (r - NCTX) / SEQ;
        const f32x4* xr = (const f32x4*)src + lane;
        f32x4 v[8]; float s = 0.f;
#pragma unroll
        for (int j = 0; j < 8; ++j) { v[j] = xr[64 * j]; s += (v[j].x * v[j].x + v[j].y * v[j].y) + (v[j].z * v[j].z + v[j].w * v[j].w); }
        const float rstd = 1.f / sqrtf(wave_sum(s) * (1.f / D) + EPS);
        unsigned long long* o8 = (unsigned long long*)(H + (size_t)r * D) + lane;
#pragma unroll
        for (int j = 0; j < 8; ++j) {
            const int c = 4 * lane + 256 * j;
            const f32x4 gg = *(const f32x4*)(g + c), sh = *(const f32x4*)(MOD + mr * 12288 + c), sc = *(const f32x4*)(MOD + mr * 12288 + 2048 + c);
            v[j] = v[j] * rstd * gg * (sc + 1.f) + sh;
        }
#pragma unroll
        for (int j = 0; j < 8; ++j) o8[64 * j] = (unsigned long long)pk2(v[j].x, v[j].y) | ((unsigned long long)pk2(v[j].z, v[j].w) << 32);
    }
}

struct SchedIn {
    int G, c; const char* A; const char* B;
    __device__ __forceinline__ bool next(int i, pg8::Unit& u) const {
        const int L = i * G + c; if (L >= 1492) return false;
        int pm, pn;
        if (L < 1440) { pg8::tile_order(L, 32, NT_IN, pm, pn); pm += 4; }
        else { const int j = L - 1440; pm = j & 3; pn = j >> 2; }
        u.pm = pm; u.pn = pn; u.aux = 0; u.A = A + (size_t)pm * 256 * D * 2; u.B = B + (size_t)pn * 256 * D * 2; return true;
    }
};
struct EpiIn {
    static constexpr bool PERM = true, CARRY = false;
    __device__ __forceinline__ bool keep(const pg8::Unit&) const { return false; }
    unsigned char* ws; const float* b_gates;
    template <int ACT> __device__ __forceinline__ void store_tile(const pg8::f32x4 (&acc)[2][2][4][2], bf16* base, int ldc, int wr, int wc, int fr, int fq) const {
#pragma unroll
        for (int ai = 0; ai < 2; ++ai)
#pragma unroll
            for (int m = 0; m < 4; ++m) { bf16* rowp = base + (size_t)(ai * 128 + wr * 64 + m * 16 + fr) * ldc + wc * 32 + 8 * fq;
#pragma unroll
                for (int bj = 0; bj < 2; ++bj) { pg8::f32x4 v0 = acc[ai][bj][m][0], v1 = acc[ai][bj][m][1];
                    if (ACT == 1) {
#pragma unroll
                        for (int j = 0; j < 4; ++j) { v0[j] = sigmoidf_(v0[j]); v1[j] = sigmoidf_(v1[j]); } }
                    if (ACT == 2) {
#pragma unroll
                        for (int j = 0; j < 4; ++j) { v0[j] = gelu_tanh(v0[j]); v1[j] = gelu_tanh(v1[j]); } }
                    pg8::u32x4 w; w.x = pg8::cvt_pk_bf16(v0[0], v0[1]); w.y = pg8::cvt_pk_bf16(v0[2], v0[3]); w.z = pg8::cvt_pk_bf16(v1[0], v1[1]); w.w = pg8::cvt_pk_bf16(v1[2], v1[3]);
                    *(pg8::u32x4*)(rowp + bj * 128) = w; } }
    }
    __device__ __forceinline__ void operator()(const pg8::f32x4 (&acc)[2][2][4][2], const pg8::Unit& u, int wr, int wc, int fr, int fq) const {
        const int pn = u.pn; const size_t row0 = (size_t)u.pm * 256;
        if (pn < 12) {
            const int seg = pn >> 2, ct = pn & 3; bf16* dst = (bf16*)(ws + (seg == 0 ? WS_K : seg == 1 ? WS_V : WS_UX));
            store_tile<0>(acc, dst + row0 * 1024 + ct * 256, 1024, wr, wc, fr, fq);
        } else if (pn == 12) {
            if (wc == 0) {
                float* G = (float*)(ws + WS_GATES);
                const pg8::f32x4 bv0 = *(const pg8::f32x4*)(b_gates + 8 * fq), bv1 = *(const pg8::f32x4*)(b_gates + 8 * fq + 4);
#pragma unroll
                for (int ai = 0; ai < 2; ++ai)
#pragma unroll
                    for (int m = 0; m < 4; ++m) { float* rowp = G + (row0 + ai * 128 + wr * 64 + m * 16 + fr) * 32 + 8 * fq;
                        *(pg8::f32x4*)(rowp) = acc[ai][0][m][0] + bv0; *(pg8::f32x4*)(rowp + 4) = acc[ai][0][m][1] + bv1; }
            }
        } else if (pn < 29) {
            const int seg = (pn - 13) >> 2, ct = (pn - 13) & 3; const size_t lr = row0 - NCTX;
            bf16* dst = (bf16*)(ws + (seg == 0 ? WS_Q : seg == 1 ? WS_OF : seg == 2 ? WS_OB : WS_UG)) + lr * 1024 + ct * 256;
            if (seg == 0) store_tile<0>(acc, dst, 1024, wr, wc, fr, fq);
            else if (seg == 3) store_tile<2>(acc, dst, 1024, wr, wc, fr, fq);
            else store_tile<1>(acc, dst, 1024, wr, wc, fr, fq);
        } else {
            const int seg = (pn - 29) >> 3, ct = (pn - 29) & 7; const size_t lr = row0 - NCTX;
            store_tile<1>(acc, (bf16*)(ws + (seg ? WS_GB : WS_GA)) + lr * 2048 + ct * 256, 2048, wr, wc, fr, fq);
        }
    }
};

__device__ __forceinline__ int lru_pos_row(int b, bool isctx, int p) { return isctx ? b * CTXL + p : NCTX + b * SEQ + (p & 31) * 64 + (p >> 5); }
typedef short bf16x8_t __attribute__((ext_vector_type(8)));
template <bool FINAL>
__device__ __forceinline__ void lru_unit(const Args& a, unsigned char* lds_g, int b, int cidx, int blk, int tid) {
    const int lane = tid & 63, w = __builtin_amdgcn_readfirstlane(tid >> 6), fr = lane & 15, fq = lane >> 4;
    float* zf = (float*)lds_g;
    bf16* zb = (bf16*)(lds_g + 64 * 132 * 4);
    const bool isctx = cidx < 4; const int seglen = isctx ? CTXL : SEQ, p0 = (isctx ? cidx : cidx - 4) * 64;
    const bf16* UX = (const bf16*)(a.ws + WS_UX);
    float gba[2], gbx[2], glam[2];
    { const int ch_ = blk * 128 + 16 * w + fr;
#pragma unroll
      for (int d = 0; d < 2; ++d) { gba[d] = a.in[I_LBA][d * 1024 + ch_]; gbx[d] = a.in[I_LBX][d * 1024 + ch_]; glam[d] = a.in[I_LAM][d * 1024 + ch_]; } }
    bf16x8_t wl[2][2][4];
    { const bf16* WL = (const bf16*)(a.ws + WS_WL);
#pragma unroll
      for (int d = 0; d < 2; ++d)
#pragma unroll
        for (int m = 0; m < 2; ++m)
#pragma unroll
            for (int ks = 0; ks < 4; ++ks) wl[d][m][ks] = *(const bf16x8_t*)(WL + ((size_t)((d * 2 + m) * 8 + blk) * 128 + 16 * w + fr) * 128 + 32 * ks + 8 * fq); }
    __builtin_amdgcn_sched_barrier(0);
    {
        const int pos = tid >> 3, cg = tid & 7, ch0 = blk * 128 + cg * 16, p = p0 + pos;
        float z[16];
#pragma unroll
        for (int q = 0; q < 4; ++q) { const f32x4 bv = *(const f32x4*)(a.in[I_CONVB] + ch0 + 4 * q); z[4 * q] = bv.x; z[4 * q + 1] = bv.y; z[4 * q + 2] = bv.z; z[4 * q + 3] = bv.w; }
        v4u ua[4], ub[4]; float msk[4];
#pragma unroll
        for (int w4 = 0; w4 < 4; ++w4) { const int pp = p + w4 - 2; const bool ok = pp >= 0 && pp < seglen; const int ppc = ok ? pp : p;
            const v4u* src = (const v4u*)(UX + (size_t)lru_pos_row(b, isctx, ppc) * 1024 + ch0); ua[w4] = src[0]; ub[w4] = src[1]; msk[w4] = ok ? 1.f : 0.f; }
#pragma unroll
        for (int w4 = 0; w4 < 4; ++w4) { const float* cw = a.in[I_CONVW] + w4 * 1024 + ch0;
            const unsigned uu[8] = {ua[w4].x, ua[w4].y, ua[w4].z, ua[w4].w, ub[w4].x, ub[w4].y, ub[w4].z, ub[w4].w};
#pragma unroll
            for (int q = 0; q < 4; ++q) { const f32x4 cv = *(const f32x4*)(cw + 4 * q) * msk[w4]; z[4 * q] += cv.x * bflo(uu[2 * q]); z[4 * q + 1] += cv.y * bfhi(uu[2 * q]); z[4 * q + 2] += cv.z * bflo(uu[2 * q + 1]); z[4 * q + 3] += cv.w * bfhi(uu[2 * q + 1]); } }
#pragma unroll
        for (int q = 0; q < 4; ++q) *(f32x4*)(zf + pos * 132 + cg * 16 + 4 * q) = (f32x4){z[4 * q], z[4 * q + 1], z[4 * q + 2], z[4 * q + 3]};
        v4u o0, o1; o0.x = pk2(z[0], z[1]); o0.y = pk2(z[2], z[3]); o0.z = pk2(z[4], z[5]); o0.w = pk2(z[6], z[7]); o1.x = pk2(z[8], z[9]); o1.y = pk2(z[10], z[11]); o1.z = pk2(z[12], z[13]); o1.w = pk2(z[14], z[15]);
        *(v4u*)(zb + pos * 136 + cg * 16) = o0; *(v4u*)(zb + pos * 136 + cg * 16 + 8) = o1;
    }
    WG_BAR();
    f32x4 acc[2][2][4];
#pragma unroll
    for (int d = 0; d < 2; ++d)
#pragma unroll
        for (int m = 0; m < 2; ++m)
#pragma unroll
            for (int mt = 0; mt < 4; ++mt) acc[d][m][mt] = (f32x4){0.f, 0.f, 0.f, 0.f};
#pragma unroll
    for (int ks = 0; ks < 4; ++ks) {
        bf16x8_t af[4];
#pragma unroll
        for (int mt = 0; mt < 4; ++mt) af[mt] = *(const bf16x8_t*)(zb + (16 * mt + fr) * 136 + 32 * ks + 8 * fq);
#pragma unroll
        for (int d = 0; d < 2; ++d)
#pragma unroll
            for (int m = 0; m < 2; ++m) {
#pragma unroll
                for (int mt = 0; mt < 4; ++mt) acc[d][m][mt] = __builtin_amdgcn_mfma_f32_16x16x32_bf16(af[mt], wl[d][m][ks], acc[d][m][mt], 0, 0, 0); }
    }
    const int chl = 16 * w + fr, ch = blk * 128 + chl;
    float hsum[4][4];
#pragma unroll
    for (int d = 0; d < 2; ++d) {
        const float ba = gba[d], bx = gbx[d], lam = glam[d];
        const float sp = (-lam > 20.f) ? -lam : log1pf(__expf(-lam));
        float av[4][4], bv[4][4];
#pragma unroll
        for (int mt = 0; mt < 4; ++mt)
#pragma unroll
            for (int r = 0; r < 4; ++r) { const float rr = sigmoidf_(acc[d][0][mt][r] + ba), ii = sigmoidf_(acc[d][1][mt][r] + bx);
                const float aa = __expf(-8.f * rr * sp); av[mt][r] = aa; bv[mt][r] = __builtin_amdgcn_sqrtf(fmaxf(1.f - aa * aa, 0.f)) * ii * zf[(16 * mt + 4 * fq + r) * 132 + chl]; }
        float Pe[4], Se[4], Pt[4], St[4];
#pragma unroll
        for (int mt = 0; mt < 4; ++mt) {
            float P = 1.f, S = 0.f;
#pragma unroll
            for (int rr = 0; rr < 4; ++rr) { const int r = d ? 3 - rr : rr; S = av[mt][r] * S + bv[mt][r]; P = av[mt][r] * P; }
            if (d == 0) {
                float p1 = __shfl_up(P, 16), s1 = __shfl_up(S, 16); if (fq >= 1) { S = P * s1 + S; P = P * p1; }
                p1 = __shfl_up(P, 32); s1 = __shfl_up(S, 32); if (fq >= 2) { S = P * s1 + S; P = P * p1; }
                Pe[mt] = __shfl_up(P, 16); Se[mt] = __shfl_up(S, 16); if (fq == 0) { Pe[mt] = 1.f; Se[mt] = 0.f; }
                Pt[mt] = __shfl(P, fr + 48); St[mt] = __shfl(S, fr + 48);
            } else {
                float p1 = __shfl_down(P, 16), s1 = __shfl_down(S, 16); if (fq <= 2) { S = P * s1 + S; P = P * p1; }
                p1 = __shfl_down(P, 32); s1 = __shfl_down(S, 32); if (fq <= 1) { S = P * s1 + S; P = P * p1; }
                Pe[mt] = __shfl_down(P, 16); Se[mt] = __shfl_down(S, 16); if (fq == 3) { Pe[mt] = 1.f; Se[mt] = 0.f; }
                Pt[mt] = __shfl(P, fr); St[mt] = __shfl(S, fr);
            }
        }
        float2* AGG = (float2*)(a.ws + WS_AGG) + ((size_t)(b * 2 + d) * 36) * 1024 + ch;
        if (!FINAL) {
            if (cidx >= 4) {
                unsigned* PS = (unsigned*)(a.ws + WS_PS) + ((size_t)(b * 2 + d) * NSTEP + 64 * cidx) * 1024 + ch;
#pragma unroll
                for (int mt = 0; mt < 4; ++mt)
#pragma unroll
                    for (int r = 0; r < 4; ++r) PS[(size_t)(16 * mt + 4 * fq + r) * 1024] = pk2(1.f - av[mt][r], bv[mt][r]);
            }
            float Pc = 1.f, Sc = 0.f;
#pragma unroll
            for (int i = 0; i < 4; ++i) { const int mt = d ? 3 - i : i; Sc = Pt[mt] * Sc + St[mt]; Pc = Pt[mt] * Pc; }
            if (fq == 0) AGG[(size_t)cidx * 1024] = make_float2(Pc, Sc);
        } else {
            float h = 0.f;
#pragma unroll
            for (int g3 = 0; g3 < 6; ++g3) {
                float2 qv[6];
#pragma unroll
                for (int i = 0; i < 6; ++i) { const int sidx = 6 * g3 + i; const int c2 = d ? (sidx < 4 ? 3 - sidx : 39 - sidx) : sidx; qv[i] = AGG[(size_t)c2 * 1024]; }
#pragma unroll
                for (int i = 0; i < 6; ++i) { const int sidx = 6 * g3 + i; const int c2 = d ? (sidx < 4 ? 3 - sidx : 39 - sidx) : sidx;
                    const bool use = d ? (sidx < 4 || c2 > cidx) : (c2 < cidx);
                    h = use ? qv[i].x * h + qv[i].y : h; }
            }
#pragma unroll
            for (int i = 0; i < 4; ++i) { const int mt = d ? 3 - i : i;
                float hl = Pe[mt] * h + Se[mt];
#pragma unroll
                for (int rr = 0; rr < 4; ++rr) { const int r = d ? 3 - rr : rr; hl = av[mt][r] * hl + bv[mt][r]; if (d == 0) hsum[mt][r] = hl; else hsum[mt][r] += hl; }
                h = Pt[mt] * h + St[mt]; }
        }
    }
    if (FINAL) {
#pragma unroll
        for (int mt = 0; mt < 4; ++mt)
#pragma unroll
            for (int r = 0; r < 4; ++r) zf[(16 * mt + 4 * fq + r) * 132 + chl] = hsum[mt][r];
        WG_BAR();
        const int pos = tid >> 3, cg = tid & 7, ch0 = blk * 128 + cg * 16;
        const size_t lrow = (size_t)(lru_pos_row(b, false, p0 + pos) - NCTX) * 1024 + ch0;
        const v4u* ug = (const v4u*)((const bf16*)(a.ws + WS_UG) + lrow); const v4u g0 = ug[0], g1 = ug[1];
        const unsigned gg[8] = {g0.x, g0.y, g0.z, g0.w, g1.x, g1.y, g1.z, g1.w}; unsigned o[8];
#pragma unroll
        for (int q = 0; q < 4; ++q) { const f32x4 hv = *(const f32x4*)(zf + pos * 132 + cg * 16 + 4 * q);
            o[2 * q] = pk2(hv.x * bflo(gg[2 * q]), hv.y * bfhi(gg[2 * q])); o[2 * q + 1] = pk2(hv.z * bflo(gg[2 * q + 1]), hv.w * bfhi(gg[2 * q + 1])); }
        v4u* dst = (v4u*)((bf16*)(a.ws + WS_YB) + lrow); dst[0] = (v4u){o[0], o[1], o[2], o[3]}; dst[1] = (v4u){o[4], o[5], o[6], o[7]};
    }
    WG_BAR();
}
constexpr int ML_STRIDE = 136;
constexpr int ML_Q = 0, ML_K = 17408, ML_V = 34816, ML_AUG = 52224  , ML_CB = 54272  ;
constexpr int ML_EB = 93440  , ML_EU = 95488  , ML_EBEND = 97536  , ML_BEND = 97568  , ML_DEN = 97600  , ML_SSQ = 97856  ;
typedef short s4_t __attribute__((ext_vector_type(4)));
__device__ __forceinline__ s4_t ds_tr(const bf16* p) { return __builtin_amdgcn_ds_read_tr16_b64_v4i16((LAS s4_t*)p); }
__device__ __forceinline__ bf16x8_t frag_row(const bf16* img, int row0, int k0, int fr, int fq) { return *(const bf16x8_t*)(img + (row0 + fr) * ML_STRIDE + k0 + 8 * fq); }
__device__ __forceinline__ bf16x8_t frag_tr2(const bf16* img, int stride, int sA, int sB, int col0, int lane) {
    const int fq = lane >> 4, q = (lane & 15) >> 2, p = lane & 3;
    const s4_t lo = ds_tr(img + (sA + 4 * fq + q) * stride + col0 + 4 * p), hi = ds_tr(img + (sB + 4 * fq + q) * stride + col0 + 4 * p);
    return (bf16x8_t){lo.x, lo.y, lo.z, lo.w, hi.x, hi.y, hi.z, hi.w};
}
__device__ __forceinline__ bf16x8_t frag_tr(const bf16* img, int stride, int s0, int col0, int lane) {
    const int fq = lane >> 4, q = (lane & 15) >> 2, p = lane & 3;
    const bf16* b = img + (s0 + 8 * fq + q) * stride + col0 + 4 * p;
    const s4_t lo = ds_tr(b), hi = ds_tr(b + 4 * stride);
    return (bf16x8_t){lo.x, lo.y, lo.z, lo.w, hi.x, hi.y, hi.z, hi.w};
}
__device__ __forceinline__ float logsigmoidf_(float x) { return fminf(x, 0.f) - log1pf(__expf(-fabsf(x))); }

__device__ __forceinline__ void ml_gates(const Args& a, unsigned char* lds_g, int rowbase, int h, int tid) {
    const int lane = tid & 63, w = tid >> 6, dir = w >> 2, c = w & 3;
    const float* GT = (const float*)(a.ws + WS_GATES) + (size_t)(rowbase + 64 * c + lane) * 32;
    const float ipre = GT[(dir * 2) * 8 + h], fpre = GT[(dir * 2 + 1) * 8 + h];
    float bsum = logsigmoidf_(fpre);
    if (dir == 0) {
#pragma unroll
        for (int o = 1; o < 64; o <<= 1) { const float t = __shfl_up(bsum, o); if (lane >= o) bsum += t; }
    } else {
#pragma unroll
        for (int o = 1; o < 64; o <<= 1) { const float t = __shfl_down(bsum, o); if (lane + o < 64) bsum += t; }
    }
    float* eb = (float*)(lds_g + ML_EB); float* eu = (float*)(lds_g + ML_EU);
    eb[dir * 256 + 64 * c + lane] = __expf(bsum); eu[dir * 256 + 64 * c + lane] = __expf(ipre - bsum);
    const float bend = __shfl(bsum, dir ? 0 : 63);
    if (lane == 0) { ((float*)(lds_g + ML_EBEND))[dir * 4 + c] = __expf(bend); ((float*)(lds_g + ML_BEND))[dir * 4 + c] = bend; }
}

template <bool OUT, bool PASS2>
__device__ __forceinline__ void ml_block(const Args& a, unsigned char* lds_g, int rowbase, int h, int dir, f32x4 (&st)[9], int tid) {
    const int lane = tid & 63, w = __builtin_amdgcn_readfirstlane(tid >> 6), fr = lane & 15, fq = lane >> 4;
    bf16* Qi = (bf16*)(lds_g + ML_Q); bf16* Ki = (bf16*)(lds_g + ML_K); bf16* Vi = (bf16*)(lds_g + ML_V); bf16* AUGi = (bf16*)(lds_g + ML_AUG); bf16* CB = (bf16*)(lds_g + ML_CB);
    const float* eb = (const float*)(lds_g + ML_EB) + dir * 256; const float* eu = (const float*)(lds_g + ML_EU) + dir * 256;
    const float* ebend = (const float*)(lds_g + ML_EBEND) + dir * 4;
    float* den = (float*)(lds_g + ML_DEN); float* ssq = (float*)(lds_g + ML_SSQ);
    const bf16* Kb = (const bf16*)(a.ws + WS_K); const bf16* Vb = (const bf16*)(a.ws + WS_V); const bf16* Qb = (const bf16*)(a.ws + WS_Q);
    const int ti = w & 3, vh = w >> 2;
    float hgv[5];
    if (OUT) {
#pragma unroll
        for (int x = 0; x < 5; ++x) { const int vt = vh * 5 + x; hgv[x] = vt < 8 ? a.in[I_HEADG][h * 128 + 16 * vt + fr] : 0.f; } }
    for (int ci = 0; ci < 4; ++ci) {
        const int c = dir ? 3 - ci : ci;
        unsigned short ogv[5][4]; unsigned short tmv[5][4];
        if (OUT) {
            const bf16* OGp = (const bf16*)(a.ws + (dir ? WS_OB : WS_OF)); const bf16* TMp = (const bf16*)(a.ws + WS_TM);
#pragma unroll
            for (int r = 0; r < 4; ++r) { const size_t ob = (size_t)(rowbase - NCTX + 64 * c + 16 * ti + 4 * fq + r) * 1024 + h * 128;
#pragma unroll
                for (int x = 0; x < 5; ++x) { const int vt = vh * 5 + x; if (vt < 8) { ogv[x][r] = OGp[ob + 16 * vt + fr]; if (PASS2) tmv[x][r] = TMp[ob + 16 * vt + fr]; } } }
            __builtin_amdgcn_sched_barrier(0);
        }
        {
            const int t = tid >> 3, pc = tid & 7; const size_t row = (size_t)(rowbase + 64 * c + t);
            const v4u* ks = (const v4u*)(Kb + row * 1024 + h * 128 + 16 * pc); const v4u k0 = ks[0], k1 = ks[1];
            const v4u* vs = (const v4u*)(Vb + row * 1024 + h * 128 + 16 * pc); const v4u v0 = vs[0], v1 = vs[1];
            v4u q0, q1; if (OUT) { const v4u* qs = (const v4u*)(Qb + (row - NCTX) * 1024 + h * 128 + 16 * pc); q0 = qs[0]; q1 = qs[1]; }
            const float e = eu[64 * c + t];
            *(v4u*)(Ki + t * ML_STRIDE + 16 * pc) = k0; *(v4u*)(Ki + t * ML_STRIDE + 16 * pc + 8) = k1;
            if (OUT) { *(v4u*)(Qi + t * ML_STRIDE + 16 * pc) = q0; *(v4u*)(Qi + t * ML_STRIDE + 16 * pc + 8) = q1; }
            const unsigned vv[8] = {v0.x, v0.y, v0.z, v0.w, v1.x, v1.y, v1.z, v1.w}; unsigned o[8];
#pragma unroll
            for (int i = 0; i < 8; ++i) o[i] = pk2(bflo(vv[i]) * e, bfhi(vv[i]) * e);
            *(v4u*)(Vi + t * ML_STRIDE + 16 * pc) = (v4u){o[0], o[1], o[2], o[3]}; *(v4u*)(Vi + t * ML_STRIDE + 16 * pc + 8) = (v4u){o[4], o[5], o[6], o[7]};
            if (pc == 0) { *(v4u*)(AUGi + t * 16) = (v4u){f2bf(e), 0u, 0u, 0u}; *(v4u*)(AUGi + t * 16 + 8) = (v4u){0u, 0u, 0u, 0u}; }
        }
        WG_BAR();
        f32x4 X[5]; float hval[4][4];
        if (OUT) {
            bf16x8_t qf[4];
#pragma unroll
            for (int ks = 0; ks < 4; ++ks) qf[ks] = frag_row(Qi, 16 * ti, 32 * ks, fr, fq);
            bf16x8_t P[2]; bool pv[2];
#pragma unroll
            for (int pp = 0; pp < 2; ++pp) {
                f32x4 d[2];
#pragma unroll
                for (int hh = 0; hh < 2; ++hh) { const int si = 2 * pp + hh; d[hh] = (f32x4){0.f, 0.f, 0.f, 0.f};
                    const bool valid = dir ? (si >= ti) : (si <= ti);
                    if (valid) {
#pragma unroll
                        for (int ks = 0; ks < 4; ++ks) d[hh] = __builtin_amdgcn_mfma_f32_16x16x32_bf16(frag_row(Ki, 16 * si, 32 * ks, fr, fq), qf[ks], d[hh], 0, 0, 0);
                        if (si == ti) {
#pragma unroll
                            for (int r = 0; r < 4; ++r) { const bool keep = dir ? (4 * fq + r >= fr) : (4 * fq + r <= fr); d[hh][r] = keep ? d[hh][r] : 0.f; } } } }
                pv[pp] = dir ? (2 * pp + 1 >= ti) : (2 * pp <= ti);
                const unsigned p0 = pk2(d[0][0], d[0][1]), p1 = pk2(d[0][2], d[0][3]), p2 = pk2(d[1][0], d[1][1]), p3 = pk2(d[1][2], d[1][3]);
                P[pp] = __builtin_bit_cast(bf16x8_t, (v4u){p0, p1, p2, p3});
            }
#pragma unroll
            for (int x = 0; x < 5; ++x) { X[x] = (f32x4){0.f, 0.f, 0.f, 0.f};
                const int vt = vh * 5 + x;
                if (vt < 9) {
#pragma unroll
                    for (int pp = 0; pp < 2; ++pp) if (pv[pp]) {
                        const bf16x8_t bfv = vt < 8 ? frag_tr2(Vi, ML_STRIDE, 32 * pp, 32 * pp + 16, 16 * vt, lane) : frag_tr2(AUGi, 16, 32 * pp, 32 * pp + 16, 0, lane);
                        X[x] = __builtin_amdgcn_mfma_f32_16x16x32_bf16(P[pp], bfv, X[x], 0, 0, 0); }
#pragma unroll
                    for (int ks = 0; ks < 4; ++ks) X[x] = __builtin_amdgcn_mfma_f32_16x16x32_bf16(qf[ks], frag_row(CB, 16 * vt, 32 * ks, fr, fq), X[x], 0, 0, 0);
                } }
            if (vh == 1 && fr == 0) {
#pragma unroll
                for (int r = 0; r < 4; ++r) den[16 * ti + 4 * fq + r] = X[3][r] * eb[64 * c + 16 * ti + 4 * fq + r]; }
        }
        {
#pragma unroll
            for (int ks = 0; ks < 2; ++ks) { const bf16x8_t kf = frag_tr(Ki, ML_STRIDE, 32 * ks, 16 * w, lane);
#pragma unroll
                for (int vt = 0; vt < 8; ++vt) st[vt] = __builtin_amdgcn_mfma_f32_16x16x32_bf16(kf, frag_tr(Vi, ML_STRIDE, 32 * ks, 16 * vt, lane), st[vt], 0, 0, 0);
                st[8] = __builtin_amdgcn_mfma_f32_16x16x32_bf16(kf, frag_tr(AUGi, 16, 32 * ks, 0, lane), st[8], 0, 0, 0); }
            const float ee = ebend[c];
#pragma unroll
            for (int vt = 0; vt < 9; ++vt) st[vt] = st[vt] * ee;
        }
        WG_BAR();
        if (OUT) {
            float sq[4] = {0.f, 0.f, 0.f, 0.f};
#pragma unroll
            for (int r = 0; r < 4; ++r) { const int t = 16 * ti + 4 * fq + r; const float sc = eb[64 * c + t] * __builtin_amdgcn_rcpf(fmaxf(fabsf(den[t]), 1.f));
#pragma unroll
                for (int x = 0; x < 4; ++x) { const int vt = vh * 5 + x; const float hv = (vt < 8) ? X[x][r] * sc : 0.f; hval[x][r] = hv; sq[r] += hv * hv; }
                if (vh == 0) { const float hv = X[4][r] * sc; X[4][r] = hv; sq[r] += hv * hv; } }
#pragma unroll
            for (int r = 0; r < 4; ++r) { float v = sq[r]; v += __shfl_xor(v, 1); v += __shfl_xor(v, 2); v += __shfl_xor(v, 4); v += __shfl_xor(v, 8); if (fr == 0) ssq[vh * 64 + 16 * ti + 4 * fq + r] = v; }
#pragma unroll
            for (int vt = 0; vt < 9; ++vt) { pg8::u32x2 o; o.x = pk2(st[vt][0], st[vt][1]); o.y = pk2(st[vt][2], st[vt][3]); *(pg8::u32x2*)(CB + (16 * vt + fr) * ML_STRIDE + 16 * w + 4 * fq) = o; }
            WG_BAR();
            bf16* TM = (bf16*)(a.ws + WS_TM); bf16* YA = (bf16*)(a.ws + WS_YA);
#pragma unroll
            for (int r = 0; r < 4; ++r) { const int t = 16 * ti + 4 * fq + r; const float rs = __builtin_amdgcn_rsqf((ssq[t] + ssq[64 + t]) * (1.f / 128.f) + EPS);
                const size_t ob = (size_t)(rowbase - NCTX + 64 * c + t) * 1024 + h * 128;
#pragma unroll
                for (int x = 0; x < 5; ++x) { const int vt = vh * 5 + x; if (vt < 8) { const int v = 16 * vt + fr; const float hv = (x < 4) ? hval[x][r] : X[4][r];
                    float y = hv * rs * hgv[x] * bf2f(ogv[x][r]);
                    if (PASS2) { y += bf2f(tmv[x][r]); YA[ob + v] = (bf16)f2bf(y); } else TM[ob + v] = (bf16)f2bf(y); } } }
        }
    }
}

__device__ __forceinline__ void ml_state_quad(const Args& a, unsigned char* lds_g, int qu, int tid) {
    const int seq = qu >> 1, j0 = 4 * (qu & 1), dir = seq & 1, h = (seq >> 1) & 7, b = seq >> 4;
    const int lane = tid & 63, w = __builtin_amdgcn_readfirstlane(tid >> 6);
    f32x4 st[9];
#pragma unroll
    for (int vt = 0; vt < 9; ++vt) st[vt] = (f32x4){0.f, 0.f, 0.f, 0.f};
#pragma unroll 1
    for (int jj = 0; jj < 4; ++jj) {
        const int j = j0 + jj, su = seq * 8 + j;
        const int rowbase = j == 0 ? b * CTXL : NCTX + b * SEQ + 256 * (dir ? 8 - j : j - 1);
        ml_gates(a, lds_g, rowbase, h, tid);
        WG_BAR();
        ml_block<false, false>(a, lds_g, rowbase, h, dir, st, tid);
        pg8::u32x2* SL = (pg8::u32x2*)(a.ws + WS_SLOC) + ((size_t)(su * 8 + w) * 9) * 64 + lane;
#pragma unroll
        for (int vt = 0; vt < 9; ++vt) { pg8::u32x2 o; o.x = pk2(st[vt][0], st[vt][1]); o.y = pk2(st[vt][2], st[vt][3]); SL[vt * 64] = o; }
        if (tid == 0) { const float* bd = (const float*)(lds_g + ML_BEND) + dir * 4; ((float*)(a.ws + WS_BT))[su] = (bd[0] + bd[1]) + (bd[2] + bd[3]); }
        WG_BAR();
    }
}
__device__ __forceinline__ void ml_out_unit(const Args& a, unsigned char* lds_g, int u, int tid) {
    const int L = u & 7, h = (u >> 3) & 7, b = u >> 6;
    const int rowbase = NCTX + b * SEQ + 256 * L;
    const int lane = tid & 63, w = __builtin_amdgcn_readfirstlane(tid >> 6), fr = lane & 15, fq = lane >> 4;
    bf16* CB = (bf16*)(lds_g + ML_CB);
    ml_gates(a, lds_g, rowbase, h, tid);
    f32x4 st[9];
#pragma unroll
    for (int dir = 0; dir < 2; ++dir) {
        const int seq = (b * 8 + h) * 2 + dir, jmax = dir ? 7 - L : L;
        const float* BT = (const float*)(a.ws + WS_BT) + seq * 8;
        {
            const pg8::u32x2* SLa = (const pg8::u32x2*)(a.ws + WS_SLOC) + ((size_t)((seq * 8 + jmax) * 8 + w) * 9) * 64 + lane;
            const pg8::u32x2* SLb = (const pg8::u32x2*)(a.ws + WS_SLOC) + ((size_t)((seq * 8 + 3) * 8 + w) * 9) * 64 + lane;
            pg8::u32x2 sa[9];
            if (jmax >= 4) {
                pg8::u32x2 sb[9];
#pragma unroll
                for (int vt = 0; vt < 9; ++vt) { sa[vt] = SLa[vt * 64]; sb[vt] = SLb[vt * 64]; }
                float ls = 0.f;
#pragma unroll
                for (int q = 4; q < 8; ++q) ls += (q <= jmax) ? BT[q] : 0.f;
                const float coef = __expf(ls);
#pragma unroll
                for (int vt = 0; vt < 9; ++vt) st[vt] = (f32x4){bflo(sa[vt].x) + bflo(sb[vt].x) * coef, bfhi(sa[vt].x) + bfhi(sb[vt].x) * coef, bflo(sa[vt].y) + bflo(sb[vt].y) * coef, bfhi(sa[vt].y) + bfhi(sb[vt].y) * coef};
            } else {
#pragma unroll
                for (int vt = 0; vt < 9; ++vt) { sa[vt] = SLa[vt * 64]; st[vt] = (f32x4){bflo(sa[vt].x), bfhi(sa[vt].x), bflo(sa[vt].y), bfhi(sa[vt].y)}; }
            }
        }
#pragma unroll
        for (int vt = 0; vt < 9; ++vt) { pg8::u32x2 o; o.x = pk2(st[vt][0], st[vt][1]); o.y = pk2(st[vt][2], st[vt][3]); *(pg8::u32x2*)(CB + (16 * vt + fr) * ML_STRIDE + 16 * w + 4 * fq) = o; }
        WG_BAR();
        if (dir == 0) ml_block<true, false>(a, lds_g, rowbase, h, 0, st, tid);
        else ml_block<true, true>(a, lds_g, rowbase, h, 1, st, tid);
        asm volatile("s_waitcnt vmcnt(0)" ::: "memory");
        WG_BAR();
    }
}

__device__ __forceinline__ void lru_out_unit(const Args& a, unsigned char* lds_g, int b, int cidx, int blk, int tid) {
    const int chl = tid & 127, q = tid >> 7, ch = blk * 128 + chl;
    float2* QA = (float2*)lds_g;
    float av[2][16], bv[2][16];
#pragma unroll
    for (int d = 0; d < 2; ++d) { const unsigned* PS = (const unsigned*)(a.ws + WS_PS) + ((size_t)(b * 2 + d) * NSTEP + 64 * cidx + 16 * q) * 1024 + ch;
#pragma unroll
        for (int i = 0; i < 16; ++i) { const unsigned wv = PS[(size_t)i * 1024]; av[d][i] = 1.f - bflo(wv); bv[d][i] = bfhi(wv); } }
    float2* CA = (float2*)(lds_g + 8192);
#pragma unroll
    for (int d = 0; d < 2; ++d) { const float2* AGG = (const float2*)(a.ws + WS_AGG) + ((size_t)(b * 2 + d) * 36) * 1024 + ch; float2 qv[9];
#pragma unroll
        for (int i = 0; i < 9; ++i) { const int sidx = 9 * q + i; const int c2 = d ? (sidx < 4 ? 3 - sidx : 39 - sidx) : sidx; qv[i] = AGG[(size_t)c2 * 1024]; }
        float P = 1.f, S = 0.f;
#pragma unroll
        for (int i = 0; i < 9; ++i) { const int sidx = 9 * q + i; const int c2 = d ? (sidx < 4 ? 3 - sidx : 39 - sidx) : sidx; const bool use = d ? (sidx < 4 || c2 > cidx) : (c2 < cidx);
            S = use ? qv[i].x * S + qv[i].y : S; P = use ? qv[i].x * P : P; }
        CA[(d * 4 + q) * 128 + chl] = make_float2(P, S); }
#pragma unroll
    for (int d = 0; d < 2; ++d) { float P = 1.f, S = 0.f;
#pragma unroll
        for (int ii = 0; ii < 16; ++ii) { const int i = d ? 15 - ii : ii; S = av[d][i] * S + bv[d][i]; P = av[d][i] * P; }
        QA[(d * 4 + q) * 128 + chl] = make_float2(P, S); }
    WG_BAR();
    float hs[16];
#pragma unroll
    for (int d = 0; d < 2; ++d) { float h = 0.f;
#pragma unroll
        for (int k = 0; k < 4; ++k) { const float2 t = CA[(d * 4 + k) * 128 + chl]; h = t.x * h + t.y; }
#pragma unroll
        for (int k = 0; k < 3; ++k) { const int qq = d ? 3 - k : k; const bool use = d ? (qq > q) : (qq < q); const float2 t = QA[(d * 4 + qq) * 128 + chl]; h = use ? t.x * h + t.y : h; }
#pragma unroll
        for (int ii = 0; ii < 16; ++ii) { const int i = d ? 15 - ii : ii; h = av[d][i] * h + bv[d][i]; if (d == 0) hs[i] = h; else hs[i] += h; } }
    const int p0 = (cidx - 4) * 64 + 16 * q;
    unsigned short ugv[16];
#pragma unroll
    for (int i = 0; i < 16; ++i) ugv[i] = ((const bf16*)(a.ws + WS_UG))[(size_t)(lru_pos_row(b, false, p0 + i) - NCTX) * 1024 + ch];
#pragma unroll
    for (int i = 0; i < 16; ++i) { const size_t lrow = (size_t)(lru_pos_row(b, false, p0 + i) - NCTX) * 1024 + ch;
        ((bf16*)(a.ws + WS_YB))[lrow] = (bf16)f2bf(hs[i] * bf2f(ugv[i])); }
    WG_BAR();
}
__device__ __forceinline__ void phase3(const Args& a, unsigned char* lds_g, int tid) {
    {
        int q0 = (int)blockIdx.x, qstep = (int)gridDim.x;
        if (gridDim.x == 256) q0 = blockIdx.x >= 128 ? (int)blockIdx.x - 128 : 128;
        for (int qu = q0; qu < 128; qu += qstep) ml_state_quad(a, lds_g, qu, tid);
    }
    for (int u = blockIdx.x; u < 4 * 36 * 8; u += gridDim.x) { const int blk = u & 7, q = u >> 3; lru_unit<false>(a, lds_g, q / 36, q % 36, blk, tid); }
}

struct SchedProj {
    int G, c; const char *YA, *YB, *WA, *WB;
    __device__ __forceinline__ bool next(int i, pg8::Unit& u) const {
        const int tile = (i >> 1) * G + c, part = i & 1; if (tile >= 256) return false;
        int pm, pn; pg8::tile_order(tile, 32, 8, pm, pn);
        u.pm = pm; u.pn = pn; u.aux = part; u.A = (part ? YB : YA) + (size_t)pm * 256 * 1024 * 2; u.B = (part ? WB : WA) + (size_t)pn * 256 * 1024 * 2; return true;
    }
};
struct EpiProj {
    static constexpr bool PERM = true, CARRY = true;
    const bf16 *GA, *GB; bf16* PRE;
    __device__ __forceinline__ bool keep(const pg8::Unit& u) const { return u.aux == 0; }
    __device__ __forceinline__ void operator()(pg8::f32x4 (&acc)[2][2][4][2], const pg8::Unit& u, int wr, int wc, int fr, int fq) const {
#pragma unroll
        for (int ai = 0; ai < 2; ++ai) {
            pg8::u32x4 gb4[4][2], ga4[4][2];
#pragma unroll
            for (int m = 0; m < 4; ++m) { const size_t off = (size_t)(u.pm * 256 + ai * 128 + wr * 64 + m * 16 + fr) * 2048 + u.pn * 256 + wc * 32 + 8 * fq;
#pragma unroll
                for (int bj = 0; bj < 2; ++bj) { gb4[m][bj] = *(const pg8::u32x4*)(GB + off + bj * 128); if (u.aux == 0) ga4[m][bj] = *(const pg8::u32x4*)(GA + off + bj * 128); } }
#pragma unroll
            for (int m = 0; m < 4; ++m) { const size_t off = (size_t)(u.pm * 256 + ai * 128 + wr * 64 + m * 16 + fr) * 2048 + u.pn * 256 + wc * 32 + 8 * fq;
#pragma unroll
                for (int bj = 0; bj < 2; ++bj) { const pg8::u32x4 g4 = gb4[m][bj];
                    const float gbv[8] = {bflo(g4.x), bfhi(g4.x), bflo(g4.y), bfhi(g4.y), bflo(g4.z), bfhi(g4.z), bflo(g4.w), bfhi(g4.w)};
                    if (u.aux == 0) { const pg8::u32x4 a4 = ga4[m][bj];
                        const float gav[8] = {bflo(a4.x), bfhi(a4.x), bflo(a4.y), bfhi(a4.y), bflo(a4.z), bfhi(a4.z), bflo(a4.w), bfhi(a4.w)};
#pragma unroll
                        for (int e = 0; e < 4; ++e) { acc[ai][bj][m][0][e] *= gav[e] * __builtin_amdgcn_rcpf(fmaxf(gbv[e], 1e-20f)); acc[ai][bj][m][1][e] *= gav[4 + e] * __builtin_amdgcn_rcpf(fmaxf(gbv[4 + e], 1e-20f)); }
                    } else {
                        pg8::f32x4 v0 = acc[ai][bj][m][0], v1 = acc[ai][bj][m][1];
#pragma unroll
                        for (int e = 0; e < 4; ++e) { v0[e] *= gbv[e]; v1[e] *= gbv[4 + e]; }
                        pg8::u32x4 w; w.x = pg8::cvt_pk_bf16(v0[0], v0[1]); w.y = pg8::cvt_pk_bf16(v0[2], v0[3]); w.z = pg8::cvt_pk_bf16(v1[0], v1[1]); w.w = pg8::cvt_pk_bf16(v1[2], v1[3]);
                        *(pg8::u32x4*)(PRE + off + bj * 128) = w; } } }
        }
    }
};

struct SchedOut {
    int G, c; const char *A, *B;
    __device__ __forceinline__ bool next(int i, pg8::Unit& u) const {
        const int L = i * G + c; if (L >= 256) return false;
        int pm, pn; pg8::tile_order(L, 32, 8, pm, pn);
        u.pm = pm; u.pn = pn; u.aux = 0; u.A = A + (size_t)pm * 256 * D * 2; u.B = B + (size_t)pn * 256 * D * 2; return true;
    }
};
struct EpiOut {
    static constexpr bool PERM = true, CARRY = false;
    __device__ __forceinline__ bool keep(const pg8::Unit&) const { return false; }
    const float* x; const float* MOD; bf16* X1;
    __device__ __forceinline__ void operator()(const pg8::f32x4 (&acc)[2][2][4][2], const pg8::Unit& u, int wr, int wc, int fr, int fq) const {
        const int b = u.pm >> 3; const int col0 = u.pn * 256 + wc * 32 + 8 * fq;
        pg8::f32x4 g1[2][2];
#pragma unroll
        for (int bj = 0; bj < 2; ++bj)
#pragma unroll
            for (int n = 0; n < 2; ++n) g1[bj][n] = *(const pg8::f32x4*)(MOD + b * 12288 + 2 * 2048 + col0 + bj * 128 + n * 4);
#pragma unroll
        for (int ai = 0; ai < 2; ++ai) {
            pg8::f32x4 xv[4][2][2];
#pragma unroll
            for (int m = 0; m < 4; ++m) { const size_t off = (size_t)(u.pm * 256 + ai * 128 + wr * 64 + m * 16 + fr) * D + col0;
#pragma unroll
                for (int bj = 0; bj < 2; ++bj)
#pragma unroll
                    for (int n = 0; n < 2; ++n) xv[m][bj][n] = *(const pg8::f32x4*)(x + off + bj * 128 + n * 4); }
#pragma unroll
            for (int m = 0; m < 4; ++m) { const size_t off = (size_t)(u.pm * 256 + ai * 128 + wr * 64 + m * 16 + fr) * D + col0;
#pragma unroll
                for (int bj = 0; bj < 2; ++bj) { const pg8::f32x4 v0 = xv[m][bj][0] + g1[bj][0] * acc[ai][bj][m][0], v1 = xv[m][bj][1] + g1[bj][1] * acc[ai][bj][m][1];
                    pg8::u32x4 w; w.x = pg8::cvt_pk_bf16(v0[0], v0[1]); w.y = pg8::cvt_pk_bf16(v0[2], v0[3]); w.z = pg8::cvt_pk_bf16(v1[0], v1[1]); w.w = pg8::cvt_pk_bf16(v1[2], v1[3]);
                    *(pg8::u32x4*)(X1 + off + bj * 128) = w; } }
        }
    }
};

__device__ __forceinline__ void phase_router(const Args& a, unsigned char* lds_g, int tid, int lane, int wave) {
    const bf16* X1 = (const bf16*)(a.ws + WS_X1); const float* MOD = (const float*)(a.ws + WS_MOD); const float* g = a.in[I_N2G];
    const float* WR = (const float*)(a.ws + WS_WR); const float* RB = (const float*)(a.ws + WS_RB);
    bf16* H2 = (bf16*)(a.ws + WS_H2); unsigned* cnt = (unsigned*)(a.ws + WS_CTL) + CW_CNT; int4* ASG = (int4*)(a.ws + WS_ASG);
    f32x4* PART = (f32x4*)lds_g;
    float* SSQP = (float*)(lds_g + 24576);
    float* RS = (float*)(lds_g + 24576 + 512);
    float* LG = (float*)(lds_g + 24576 + 1024);
    const int slot = wave >> 2, kq = wave & 3, i = lane & 15, gq = lane >> 4;
    for (int tp = blockIdx.x; tp < NLAT / 32; tp += gridDim.x) {
        const int tok0 = 32 * tp + 16 * slot, b = tok0 >> 11, kbase = kq * 512 + 8 * gq;
        const bf16* xr = X1 + (size_t)(tok0 + i) * D + kbase;
        const float* wr = WR + ((size_t)(b * 48 + i) * 2048 + kbase);
        f32x4 acc0 = (f32x4){0.f, 0.f, 0.f, 0.f}, acc1 = acc0, acc2 = acc0; float sq = 0.f;
#pragma unroll 2
        for (int s8 = 0; s8 < 16; ++s8) {
            const v4u xb = *(const v4u*)(xr + 32 * s8);
            const f32x4 b0a = *(const f32x4*)(wr + 32 * s8), b0b = *(const f32x4*)(wr + 32 * s8 + 4), b1a = *(const f32x4*)(wr + 16 * 2048 + 32 * s8), b1b = *(const f32x4*)(wr + 16 * 2048 + 32 * s8 + 4),
                        b2a = *(const f32x4*)(wr + 32 * 2048 + 32 * s8), b2b = *(const f32x4*)(wr + 32 * 2048 + 32 * s8 + 4);
            const float xe[8] = {bflo(xb.x), bfhi(xb.x), bflo(xb.y), bfhi(xb.y), bflo(xb.z), bfhi(xb.z), bflo(xb.w), bfhi(xb.w)};
#pragma unroll
            for (int e = 0; e < 4; ++e) { acc0 = __builtin_amdgcn_mfma_f32_16x16x4f32(xe[e], b0a[e], acc0, 0, 0, 0); acc1 = __builtin_amdgcn_mfma_f32_16x16x4f32(xe[e], b1a[e], acc1, 0, 0, 0); acc2 = __builtin_amdgcn_mfma_f32_16x16x4f32(xe[e], b2a[e], acc2, 0, 0, 0); }
#pragma unroll
            for (int e = 0; e < 4; ++e) { acc0 = __builtin_amdgcn_mfma_f32_16x16x4f32(xe[4 + e], b0b[e], acc0, 0, 0, 0); acc1 = __builtin_amdgcn_mfma_f32_16x16x4f32(xe[4 + e], b1b[e], acc1, 0, 0, 0); acc2 = __builtin_amdgcn_mfma_f32_16x16x4f32(xe[4 + e], b2b[e], acc2, 0, 0, 0); }
#pragma unroll
            for (int e = 0; e < 8; ++e) sq += xe[e] * xe[e];
        }
        sq += __shfl_xor(sq, 16); sq += __shfl_xor(sq, 32);
        PART[((slot * 4 + kq) * 3 + 0) * 64 + lane] = acc0; PART[((slot * 4 + kq) * 3 + 1) * 64 + lane] = acc1; PART[((slot * 4 + kq) * 3 + 2) * 64 + lane] = acc2;
        if (gq == 0) SSQP[(slot * 4 + kq) * 16 + i] = sq;
        __syncthreads();
        if (kq == 0) {
            const float* sp = SSQP + slot * 64; const float rstd = 1.f / sqrtf(((sp[i] + sp[16 + i]) + (sp[32 + i] + sp[48 + i])) * (1.f / D) + EPS);
            if (gq == 0) RS[slot * 16 + i] = rstd;
#pragma unroll
            for (int cb = 0; cb < 3; ++cb) { const f32x4* pp = PART + (slot * 4 * 3 + cb) * 64 + lane; const f32x4 sum = (pp[0] + pp[3 * 64]) + (pp[6 * 64] + pp[9 * 64]);
                const float rb = RB[b * 48 + 16 * cb + i];
#pragma unroll
                for (int r = 0; r < 4; ++r) LG[(slot * 16 + 4 * gq + r) * 48 + 16 * cb + i] = __shfl(rstd, 4 * gq + r) * sum[r] + rb; }
            LDS_WAIT(); asm volatile("" ::: "memory");
            if (lane < 16) {
                const float* lg = LG + (slot * 16 + lane) * 48; const int t = tok0 + lane;
                int gs = 0; float gm = lg[32];
#pragma unroll
                for (int q = 1; q < 4; ++q) { const float v = lg[32 + q]; if (v > gm) { gm = v; gs = q; } }
                float se = 0.f;
#pragma unroll
                for (int q = 0; q < 4; ++q) se += __expf(lg[32 + q] - gm);
                const float pg = 1.f / se;
                int i0 = 0; float v0 = lg[gs * 8];
#pragma unroll
                for (int q = 1; q < 8; ++q) { const float v = lg[gs * 8 + q]; if (v > v0) { v0 = v; i0 = q; } }
                int i1 = -1; float v1 = -3.0e38f;
#pragma unroll
                for (int q = 0; q < 8; ++q) { const float v = lg[gs * 8 + q]; if (q != i0 && v > v1) { v1 = v; i1 = q; } }
                const float e1 = __expf(v1 - v0), w0 = pg / (1.f + e1), w1 = pg * e1 / (1.f + e1);
                const int ex0 = gs * 8 + i0, ex1 = gs * 8 + i1;
                const unsigned p0 = atomicAdd(cnt + ex0, 1u), p1 = atomicAdd(cnt + ex1, 1u);
                ASG[2 * t] = make_int4(ex0, (int)p0, __float_as_int(w0), 0); ASG[2 * t + 1] = make_int4(ex1, (int)p1, __float_as_int(w1), 0);
                int* LIST = (int*)(a.ws + WS_LIST); LIST[ex0 * 8192 + (int)p0] = t; LIST[ex1 * 8192 + (int)p1] = t;
            }
        }
        __syncthreads();
#pragma unroll
        for (int r = 0; r < 4; ++r) { const int tl = 4 * kq + r, t = tok0 + tl; const float rstd = RS[slot * 16 + tl];
            const unsigned long long* xrow = (const unsigned long long*)(X1 + (size_t)t * D) + lane; unsigned* o4 = (unsigned*)((unsigned char*)H2 + (size_t)t * D) + lane;
            f32x4 yv[8];
#pragma unroll
            for (int j = 0; j < 8; ++j) { const int c = 4 * lane + 256 * j;
                const f32x4 gg = *(const f32x4*)(g + c), sh = *(const f32x4*)(MOD + b * 12288 + 3 * 2048 + c), sc = *(const f32x4*)(MOD + b * 12288 + 4 * 2048 + c);
                const unsigned long long xw = xrow[64 * j]; const f32x4 xv4 = (f32x4){bflo((unsigned)xw), bfhi((unsigned)xw), bflo((unsigned)(xw >> 32)), bfhi((unsigned)(xw >> 32))};
                yv[j] = xv4 * rstd * gg * (sc + 1.f) + sh; }
#pragma unroll
            for (int j = 0; j < 8; ++j) { int w8 = __builtin_amdgcn_cvt_pk_fp8_f32(yv[j].x, yv[j].y, 0, false); w8 = __builtin_amdgcn_cvt_pk_fp8_f32(yv[j].z, yv[j].w, w8, true); o4[64 * j] = (unsigned)w8; } }
        __syncthreads();
    }
}

constexpr int MG_A = 0, MG_ABYTES = 32768, MG_B = 65536, MG_BBYTES = 64 * 256  , MG_CUM = 141312  ;
__device__ __forceinline__ int mgb_off(int row, int ch) { return 256 * row + 16 * (ch ^ (((row & 3) << 2) | ((row >> 2) & 3))); }
__device__ __forceinline__ bf16x8_t mgb_frag(const unsigned char* img, int ks, int c, int lane) {
    const int g = lane >> 4, q = (lane & 15) >> 2, p = lane & 3;
    const s4_t lo = ds_tr((const bf16*)(img + mgb_off(32 * ks + 8 * g + q, 2 * c + (p >> 1)) + 8 * (p & 1)));
    const s4_t hi = ds_tr((const bf16*)(img + mgb_off(32 * ks + 8 * g + 4 + q, 2 * c + (p >> 1)) + 8 * (p & 1)));
    return (bf16x8_t){lo.x, lo.y, lo.z, lo.w, hi.x, hi.y, hi.z, hi.w};
}
__device__ __forceinline__ void moe_tables(const Args& a, unsigned char* lds_g, int tid) {
    int* cum = (int*)(lds_g + MG_CUM); const unsigned* ctl = (const unsigned*)(a.ws + WS_CTL);
    if (tid < NEXP) cum[128 + tid] = (int)ctl[CW_CNT + tid];
    if (tid == 0) { int c = 0; for (int e = 0; e < NEXP; ++e) { cum[e] = c; c += (int)((ctl[CW_CNT + e] + 255u) >> 8); } cum[NEXP] = c; }
    __syncthreads();
}
constexpr int MH_A = 0, MH_ABYTES = 32768, MH_B = 65536, MH_BROW = 528, MH_BBYTES = 64 * MH_BROW  ;
__device__ __forceinline__ int mhb_off(int row, int ch) { return MH_BROW * row + 16 * ch; }
__device__ __forceinline__ bf16x8_t mhb_frag(const LAS unsigned char* lbase, int cofs) {
    const s4_t lo = __builtin_amdgcn_ds_read_tr16_b64_v4i16((LAS s4_t*)(lbase + cofs));
    const s4_t hi = __builtin_amdgcn_ds_read_tr16_b64_v4i16((LAS s4_t*)(lbase + cofs + 4 * MH_BROW));
    return (bf16x8_t){lo.x, lo.y, lo.z, lo.w, hi.x, hi.y, hi.z, hi.w};
}
__device__ __forceinline__ int fresh_lane() { int l; asm volatile("v_mbcnt_lo_u32_b32 %0, -1, 0\n\tv_mbcnt_hi_u32_b32 %0, -1, %0" : "=v"(l)); __builtin_assume(l >= 0 && l < 64); return l; }
__device__ __forceinline__ int moe_pull(const Args& a, unsigned char* lds_g, int w, int x) {
    int* slot = (int*)(lds_g + MG_CUM + 256);
    __syncthreads();
    if (w == 0 && fresh_lane() == 0) *slot = (int)__hip_atomic_fetch_add((unsigned*)(a.ws + WS_CTL) + CW_Q + 64 * x, 1u, __ATOMIC_RELAXED, __HIP_MEMORY_SCOPE_AGENT);
    __syncthreads();
    return __builtin_amdgcn_readfirstlane(*slot);
}
__device__ __forceinline__ unsigned f8pair_lo(unsigned w) { const auto v = __builtin_amdgcn_cvt_pk_f32_fp8((int)w, false); return pk2(v[0], v[1]); }
__device__ __forceinline__ unsigned f8pair_hi(unsigned w) { const auto v = __builtin_amdgcn_cvt_pk_f32_fp8((int)w, true); return pk2(v[0], v[1]); }
template <int MODE>
__device__ __forceinline__ int moe_gemm(const Args& a, unsigned char* lds_g, int tid, int idx0) {
    constexpr int K = MODE == 1 ? D : DE, NT = K / 64;
#define MG_BAR() do { asm volatile("s_waitcnt lgkmcnt(0)" ::: "memory"); __builtin_amdgcn_s_barrier(); asm volatile("" ::: "memory"); } while (0)
    const int w = __builtin_amdgcn_readfirstlane(tid >> 6);
    const int wm = w >> 1, wn = w & 1, hh = wm >> 1, wr = wm & 1;
    const int* cum = (const int*)(lds_g + MG_CUM); const unsigned* ctl = (const unsigned*)(a.ws + WS_CTL);
    const int T = cum[NEXP], x = blockIdx.x & 7;
    for (int idx = idx0;;) {
        if (idx < 0) idx = moe_pull(a, lds_g, w, x);
        if (idx >= (MODE == 1 ? T : 2 * T)) return idx;
        const int ti = MODE == 1 ? idx : idx - T;
        idx = -1;
        const int nt = x;
        if (MODE == 2) {
            if (w == 0) { unsigned* tc = (unsigned*)(a.ws + WS_CTL) + CW_TC + 64 * ti; unsigned spins = 0;
                while ((unsigned)__builtin_amdgcn_readfirstlane(__hip_atomic_load(tc, __ATOMIC_RELAXED, __HIP_MEMORY_SCOPE_AGENT)) < 64u) {
                    __builtin_amdgcn_s_sleep(2);
                    if (++spins > (1u << 22)) { if (fresh_lane() == 0) __hip_atomic_store((unsigned*)(a.ws + WS_CTL) + 1, 0x900u + (unsigned)ti, __ATOMIC_RELAXED, __HIP_MEMORY_SCOPE_AGENT); break; } }
                __builtin_amdgcn_fence(__ATOMIC_ACQUIRE, "agent");
                asm volatile("s_waitcnt vmcnt(0)" ::: "memory"); }
            __syncthreads();
        }
        const int lane = fresh_lane(), tidu = w * 64 + lane, fr = lane & 15, fq = lane >> 4;
        const int aoff = pg8::lds_byte(wr * 64 + fr, fq * 8);
        const int bk = w, bp = lane;
        int aR[2], aC[2];
#pragma unroll
        for (int i = 0; i < 2; ++i) pg8::stage_rc(tidu * 16 + i * 8192, aR[i], aC[i]);
        int e = 0;
#pragma unroll 1
        for (int q = 1; q < NEXP; ++q) e = (cum[q] <= ti) ? q : e;
        e = __builtin_amdgcn_readfirstlane(e);
        const int mt = __builtin_amdgcn_readfirstlane(ti - cum[e]);
        unsigned aofs[4]; unsigned bofs; int bwr0;
        __amdgpu_buffer_rsrc_t rsA, rsB, rsB3;
        if (MODE == 1) { const int cnt = cum[128 + e];
#pragma unroll
            for (int q = 0; q < 2; ++q) { const int pos = 256 * mt + 128 * q + (tidu >> 2); const int tok = pos < cnt ? ((const int*)(a.ws + WS_LIST))[e * 8192 + pos] : 0;
                aofs[q] = (unsigned)(tok * D + 16 * (tidu & 3)); }
            aofs[2] = aofs[3] = 0u;
            rsA = __builtin_amdgcn_make_buffer_rsrc((void*)(a.ws + WS_H2), 0, 0x7fffffff, 0x00020000);
            rsB = __builtin_amdgcn_make_buffer_rsrc((void*)(a.in[I_W1] + (size_t)e * D * DE), 0, 0x7fffffff, 0x00020000); rsB3 = __builtin_amdgcn_make_buffer_rsrc((void*)(a.in[I_W3] + (size_t)e * D * DE), 0, 0x7fffffff, 0x00020000);
            bofs = (unsigned)((bk + 8 * (bp >> 5)) * DE + 128 * nt + 4 * (bp & 31)) * 4u;
            bwr0 = MH_BROW * (bk + 8 * (bp >> 5)) + 2 * (128 * ((bp & 31) >> 4) + 4 * (bp & 15)); }
        else {
#pragma unroll
            for (int q = 0; q < 4; ++q) aofs[q] = (unsigned)((128 * (q >> 1) + aR[q & 1]) * DE + aC[q & 1]) * 2u;
            rsA = __builtin_amdgcn_make_buffer_rsrc((void*)((const bf16*)(a.ws + WS_HM) + (size_t)256 * ti * DE), 0, 0x7fffffff, 0x00020000);
            rsB = __builtin_amdgcn_make_buffer_rsrc((void*)(a.in[I_W2] + (size_t)e * DE * D), 0, 0x7fffffff, 0x00020000); rsB3 = rsB;
            bofs = (unsigned)(bk * D + 256 * nt + 4 * bp) * 4u; bwr0 = mhb_off(bk, bp >> 1) + 8 * (bp & 1); }
        const LAS unsigned char* blane = (const LAS unsigned char*)lds_g + MH_B + mhb_off(8 * (lane >> 4) + ((lane & 15) >> 2), 16 * wn + ((lane & 3) >> 1)) + 8 * (lane & 1);
        f32x4 acc[4][8];
#pragma unroll
        for (int m = 0; m < 4; ++m)
#pragma unroll
            for (int n = 0; n < 8; ++n) acc[m][n] = (f32x4){0.f, 0.f, 0.f, 0.f};
        v4u ra[4]; f32x4 rb[8];
#define MH_LD(t_) do { _Pragma("unroll") for (int j_ = 0; j_ < 4; ++j_) ra[j_] = __builtin_amdgcn_raw_buffer_load_b128(rsA, aofs[j_], 128 * (t_), 0); \
        _Pragma("unroll") for (int j_ = 0; j_ < 8; ++j_) rb[j_] = __builtin_bit_cast(f32x4, __builtin_amdgcn_raw_buffer_load_b128(rsB, bofs, (64 * (t_) + 8 * j_) * D * 4, 0)); } while (0)
#define MH_ST(buf_) do { _Pragma("unroll") for (int j_ = 0; j_ < 4; ++j_) *(v4u*)(lds_g + MH_A + (buf_) * MH_ABYTES + (j_ >> 1) * 16384 + (j_ & 1) * 8192 + tidu * 16) = ra[j_]; \
        _Pragma("unroll") for (int j_ = 0; j_ < 8; ++j_) { pg8::u32x2 o_; o_.x = pk2(rb[j_].x, rb[j_].y); o_.y = pk2(rb[j_].z, rb[j_].w); *(pg8::u32x2*)(lds_g + MH_B + (buf_) * MH_BBYTES + bwr0 + j_ * 8 * MH_BROW) = o_; } } while (0)
#define MH_MMA(buf_) do { const LAS unsigned char* Bi_ = blane + (buf_) * MH_BBYTES; \
        _Pragma("unroll") for (int ks_ = 0; ks_ < 2; ++ks_) { bf16x8_t af_[4]; \
            _Pragma("unroll") for (int m_ = 0; m_ < 4; ++m_) af_[m_] = *(const bf16x8_t*)(lds_g + MH_A + (buf_) * MH_ABYTES + hh * 16384 + aoff + m_ * 2048 + ks_ * 1024); \
            _Pragma("unroll") for (int n_ = 0; n_ < 8; n_ += 2) { const bf16x8_t bf0_ = mhb_frag(Bi_, 32 * ks_ * MH_BROW + 32 * n_), bf1_ = mhb_frag(Bi_, 32 * ks_ * MH_BROW + 32 * (n_ + 1)); \
                _Pragma("unroll") for (int m_ = 0; m_ < 4; ++m_) { acc[m_][n_] = __builtin_amdgcn_mfma_f32_16x16x32_bf16(bf0_, af_[m_], acc[m_][n_], 0, 0, 0); \
                    acc[m_][n_ + 1] = __builtin_amdgcn_mfma_f32_16x16x32_bf16(bf1_, af_[m_], acc[m_][n_ + 1], 0, 0, 0); } \
                __builtin_amdgcn_sched_barrier(0); } } } while (0)
        if (MODE == 1) {
            const int awr = pg8::lds_byte(tidu >> 2, 16 * (tidu & 3));
#define MH_LDB(t_) do { _Pragma("unroll") for (int j_ = 0; j_ < 8; ++j_) rb[j_] = __builtin_bit_cast(f32x4, __builtin_amdgcn_raw_buffer_load_b128((j_ & 1) ? rsB3 : rsB, bofs, (64 * (t_) + 16 * (j_ >> 1)) * DE * 4, 0)); } while (0)
#define MH_LDA(te_, to_) do { ra[0] = __builtin_amdgcn_raw_buffer_load_b128(rsA, aofs[0], 64 * (te_), 0); ra[1] = __builtin_amdgcn_raw_buffer_load_b128(rsA, aofs[1], 64 * (te_), 0); \
            ra[2] = __builtin_amdgcn_raw_buffer_load_b128(rsA, aofs[0], 64 * (to_), 0); ra[3] = __builtin_amdgcn_raw_buffer_load_b128(rsA, aofs[1], 64 * (to_), 0); } while (0)
#define MH_F8(w_) f8pair_lo(w_), f8pair_hi(w_)
#define MH_STA(buf_, x_) do { _Pragma("unroll") for (int h_ = 0; h_ < 2; ++h_) { const v4u p_ = ra[(x_) + h_]; \
            *(v4u*)(lds_g + MH_A + (buf_) * MH_ABYTES + h_ * 16384 + awr) = (v4u){MH_F8(p_.x), MH_F8(p_.y)}; __builtin_amdgcn_sched_barrier(0); \
            *(v4u*)(lds_g + MH_A + (buf_) * MH_ABYTES + h_ * 16384 + awr + 16) = (v4u){MH_F8(p_.z), MH_F8(p_.w)}; __builtin_amdgcn_sched_barrier(0); } } while (0)
#define MH_STB(buf_) do { _Pragma("unroll") for (int j_ = 0; j_ < 8; ++j_) { pg8::u32x2 o_; o_.x = pk2(rb[j_].x, rb[j_].y); o_.y = pk2(rb[j_].z, rb[j_].w); *(pg8::u32x2*)(lds_g + MH_B + (buf_) * MH_BBYTES + bwr0 + (j_ >> 1) * 16 * MH_BROW + (j_ & 1) * 128) = o_; } } while (0)
            MH_LDA(0, 1); MH_LDB(0);
            MG_BAR();
            MH_STA(0, 0); MH_STB(0);
            MH_LDB(1);
            for (int t = 0; t < NT; t += 2) {
                const int t2 = (t + 2 < NT) ? t + 2 : NT - 1, t3 = (t + 3 < NT) ? t + 3 : NT - 1;
                MG_BAR();
                MH_STA(1, 2); MH_STB(1);
                MH_LDA(t2, t3); MH_LDB(t2);
                MH_MMA(0);
                MG_BAR();
                MH_STA(0, 0); MH_STB(0);
                MH_LDB(t3);
                MH_MMA(1);
            }
#undef MH_LDB
#undef MH_LDA
#undef MH_F8
#undef MH_STA
#undef MH_STB
        } else {
        MH_LD(0);
            MG_BAR();
            MH_ST(0);
            MH_LD(1);
            for (int t = 0; t < NT; t += 2) {
                const int t2 = (t + 2 < NT) ? t + 2 : NT - 1, t3 = (t + 3 < NT) ? t + 3 : NT - 1;
                MG_BAR();
                MH_ST(1);
                MH_LD(t2);
                MH_MMA(0);
                MG_BAR();
                MH_ST(0);
                MH_LD(t3);
                MH_MMA(1);
            }
        }
#undef MH_LD
#undef MH_ST
#undef MH_MMA
        const int ln_ = fresh_lane();
        const int efr = ln_ & 15, efq = ln_ >> 4;
        if (MODE == 1) { bf16* HM = (bf16*)(a.ws + WS_HM) + (size_t)256 * ti * DE + 128 * nt + 64 * wn; const unsigned lo_ = (unsigned)((128 * hh + 64 * wr + efr) * DE + 4 * efq);
#pragma unroll
            for (int m = 0; m < 4; ++m)
#pragma unroll
                for (int n = 0; n < 4; ++n) { float hv[4];
#pragma unroll
                    for (int r = 0; r < 4; ++r) { const float a1 = acc[m][n][r]; hv[r] = a1 * sigmoidf_(a1) * acc[m][n + 4][r]; }
                    const unsigned long long o = (unsigned long long)pk2(hv[0], hv[1]) | ((unsigned long long)pk2(hv[2], hv[3]) << 32);
                    __hip_atomic_store((unsigned long long*)(HM + lo_ + 16 * m * DE + 16 * n), o, __ATOMIC_RELAXED, __HIP_MEMORY_SCOPE_AGENT); }
            asm volatile("s_waitcnt vmcnt(0)" ::: "memory");
            if (ln_ == 0) __hip_atomic_fetch_add((unsigned*)(a.ws + WS_CTL) + CW_TC + 64 * ti, 1u, __ATOMIC_RELAXED, __HIP_MEMORY_SCOPE_AGENT); }
        else { bf16* Y2 = (bf16*)(a.ws + WS_Y2) + (size_t)256 * ti * D + 256 * nt + 128 * wn; const unsigned lo_ = (unsigned)((128 * hh + 64 * wr + efr) * D + 4 * efq);
#pragma unroll
            for (int m = 0; m < 4; ++m)
#pragma unroll
                for (int n = 0; n < 8; ++n) { pg8::u32x2 o; o.x = pk2(acc[m][n][0], acc[m][n][1]); o.y = pk2(acc[m][n][2], acc[m][n][3]);
                    *(pg8::u32x2*)(Y2 + lo_ + 16 * m * D + 16 * n) = o; } }
    }
#undef MG_BAR
}

__device__ __forceinline__ void phase12(const Args& a, unsigned char* lds_g, int lane, int wave) {
    const int gw = blockIdx.x * NWAVES + wave, NGW = gridDim.x * NWAVES;
    const int* cum = (const int*)(lds_g + MG_CUM);
    const bf16* X1 = (const bf16*)(a.ws + WS_X1); const float* MOD = (const float*)(a.ws + WS_MOD); const float* fg = a.in[I_FG];
    const int4* ASG = (const int4*)(a.ws + WS_ASG); const bf16* Y2 = (const bf16*)(a.ws + WS_Y2);
    for (int t = gw; t < NLAT; t += NGW) {
        const int b = t >> 11; const int4 q0 = ASG[2 * t], q1 = ASG[2 * t + 1];
        const float w0 = __int_as_float(q0.z), w1 = __int_as_float(q1.z);
        const unsigned long long* xr = (const unsigned long long*)(X1 + (size_t)t * D) + lane;
        const unsigned long long* y0 = (const unsigned long long*)(Y2 + (size_t)(256 * cum[q0.x] + q0.y) * D) + lane; const unsigned long long* y1 = (const unsigned long long*)(Y2 + (size_t)(256 * cum[q1.x] + q1.y) * D) + lane;
        f32x4 v[8]; float s = 0.f;
#pragma unroll
        for (int j = 0; j < 8; ++j) {
            const int c = 4 * lane + 256 * j;
            const f32x4 g2 = *(const f32x4*)(MOD + b * 12288 + 5 * 2048 + c);
            const unsigned long long a0 = y0[64 * j], a1 = y1[64 * j];
            f32x4 y; y.x = w0 * bflo((unsigned)a0) + w1 * bflo((unsigned)a1); y.y = w0 * bfhi((unsigned)a0) + w1 * bfhi((unsigned)a1);
            y.z = w0 * bflo((unsigned)(a0 >> 32)) + w1 * bflo((unsigned)(a1 >> 32)); y.w = w0 * bfhi((unsigned)(a0 >> 32)) + w1 * bfhi((unsigned)(a1 >> 32));
            const unsigned long long xw = xr[64 * j];
            v[j] = (f32x4){bflo((unsigned)xw), bfhi((unsigned)xw), bflo((unsigned)(xw >> 32)), bfhi((unsigned)(xw >> 32))} + g2 * y;
            s += (v[j].x * v[j].x + v[j].y * v[j].y) + (v[j].z * v[j].z + v[j].w * v[j].w);
        }
        const float rstd = 1.f / sqrtf(wave_sum(s) * (1.f / D) + EPS);
        f32x4* o = (f32x4*)(a.out + (size_t)t * D) + lane; f32x4 fgv[8];
#pragma unroll
        for (int j = 0; j < 8; ++j) fgv[j] = *(const f32x4*)(fg + 4 * lane + 256 * j);
#pragma unroll
        for (int j = 0; j < 8; ++j) o[64 * j] = v[j] * rstd * fgv[j];
    }
}

__global__ void __launch_bounds__(NTHR, 2) fwd_kernel(Args args) {
    extern __shared__ __attribute__((aligned(16))) unsigned char lds[];
    LAS unsigned char* ldsl = (LAS unsigned char*)lds;
    volatile LAS unsigned* MISC = (volatile LAS unsigned*)(ldsl + MISC_OFF);
    LAS unsigned* TL = (LAS unsigned*)(ldsl + LDSCTL_OFF);
    const int wave_s = __builtin_amdgcn_readfirstlane(threadIdx.x >> 6);
#define TID() make_tid(wave_s)
    { const int t0 = TID(); for (int u = t0; u < (LDS_BYTES - LDSCTL_OFF) / 4; u += NTHR) ((LAS unsigned*)(ldsl + LDSCTL_OFF))[u] = 0u; }
    __syncthreads();
    unsigned char* ws = args.ws;
    unsigned* ctl = (unsigned*)(ws + WS_CTL);
    XcdBarrier bar; bar.bar = ctl + CW_BAR; bar.x = 0; bar.st = nullptr;
    const bool one_launch = (args.ph_hi - args.ph_lo) > 1;
    if (one_launch) bar = xcd_barrier_post(ctl + CW_BAR, MISC + 8, TID());
    const int lo = args.ph_lo, hi = args.ph_hi;
#define IN(k) (lo <= (k) && (k) < hi)
#define SEAM(k) do { if (IN(k) && IN((k) + 1)) xcd_barrier(bar, TID()); } while (0)
    const int G = gridDim.x, c = blockIdx.x;

#define FRESH() const int tid = TID(), lane = tid & 63, wave = __builtin_amdgcn_readfirstlane(tid >> 6); (void)lane; (void)wave
#ifndef DUP_PHASE
#define DUP_PHASE (-1)
#endif
#define PH(k, ...) if (IN(k)) { _Pragma("unroll") for (int rep_ = 0; rep_ < ((DUP_PHASE) == (k) ? 2 : 1); ++rep_) { if (rep_) xcd_barrier(bar, TID()); __VA_ARGS__ } } SEAM(k);
    PH(0, { FRESH(); phase0(args, lds, tid, lane, wave); mod_wait(args, tid); phase1(args, lane, wave); })
    PH(1, {
        SchedIn S{G, c, (const char*)(ws + WS_H), (const char*)(ws + WS_WIN)}; EpiIn E{ws, args.in[I_BGATES]};
        pg8::gemm_phase<EpiIn, SchedIn>(ldsl, D, S, E, TID());
        { const int R_ = (1492 + G - 1) / G; int fi_ = 1492 - (R_ - 1) * G; if (fi_ >= G) fi_ = 0;
          if (c >= fi_) { FRESH(); late_prep(args, lds, (c - fi_) * NWAVES + wave, (G - fi_) * NWAVES, lane, wave); } } })
    PH(2, { FRESH(); phase3(args, lds, tid); })
    PH(3, { FRESH();
        for (int u = c; u < 256; u += G) ml_out_unit(args, lds, u, tid);
        for (int u = c; u < 4 * 32 * 8; u += G) { const int blk = u & 7, q = u >> 3; lru_out_unit(args, lds, q >> 5, 4 + (q & 31), blk, tid); } })
    PH(4, {
        SchedProj S{G, c, (const char*)(ws + WS_YA), (const char*)(ws + WS_YB), (const char*)(ws + WS_WPA), (const char*)(ws + WS_WPB)};
        EpiProj E{(const bf16*)(ws + WS_GA), (const bf16*)(ws + WS_GB), (bf16*)(ws + WS_PRE)};
        pg8::gemm_phase<EpiProj, SchedProj>(ldsl, 1024, S, E, TID()); })
    PH(5, {
        SchedOut S{G, c, (const char*)(ws + WS_PRE), (const char*)(ws + WS_WOUT)}; EpiOut E{args.in[I_X], (const float*)(ws + WS_MOD), (bf16*)(ws + WS_X1)};
        pg8::gemm_phase<EpiOut, SchedOut>(ldsl, D, S, E, TID()); })
    PH(6, { FRESH(); phase_router(args, lds, tid, lane, wave); })
    PH(7, { FRESH(); moe_tables(args, lds, tid); const int nx_ = moe_gemm<1>(args, lds, tid, -1); { const int tid2_ = TID(); (void)moe_gemm<2>(args, lds, tid2_, nx_); } })
    PH(8, { FRESH(); moe_tables(args, lds, tid); phase12(args, lds, lane, wave); })
#undef PH
#undef IN
#undef SEAM
}

extern "C" void kernel_launch(void* const* d_in, const int* in_sizes, int n_in, void* d_out, int out_size, void* d_ws, size_t ws_size, hipStream_t stream) {
    static int grid = 0;
    if (grid == 0) {
        if (n_in != 27 || out_size != NLAT * D || ws_size < WS_END) { fprintf(stderr, "kernel_launch: unexpected shapes (n_in %d, out %d, ws %zu)\n", n_in, out_size, ws_size); grid = -1; return; }
        int dev = 0, cus = 0, per_cu = 0;
        if (hipGetDevice(&dev) != hipSuccess || hipDeviceGetAttribute(&cus, hipDeviceAttributeMultiprocessorCount, dev) != hipSuccess) { grid = -1; return; }
        if (hipFuncSetAttribute((const void*)fwd_kernel, hipFuncAttributeMaxDynamicSharedMemorySize, LDS_BYTES) != hipSuccess) { fprintf(stderr, "kernel_launch: hipFuncSetAttribute failed\n"); grid = -1; return; }
        if (hipOccupancyMaxActiveBlocksPerMultiprocessor(&per_cu, (const void*)fwd_kernel, NTHR, LDS_BYTES) != hipSuccess || per_cu < 1) fprintf(stderr, "kernel_launch: occupancy query says %d\n", per_cu);
        (void)hipGetLastError();
        grid = cus;
    }
    if (grid < 0) return;
    (void)hipMemsetAsync((char*)d_ws + WS_CTL, 0, CTL_ZERO_BYTES, stream);
    Args a{};
    for (int i = 0; i < 27; ++i) a.in[i] = (const float*)d_in[i];
    a.out = (float*)d_out; a.ws = (unsigned char*)d_ws;
#if MK_ONE_LAUNCH
    a.ph_lo = 0; a.ph_hi = NPHASE;
    hipLaunchKernelGGL(fwd_kernel, dim3(grid), dim3(NTHR), LDS_BYTES, stream, a);
#else
    for (int p = 0; p < NPHASE; ++p) { a.ph_lo = p; a.ph_hi = p + 1; hipLaunchKernelGGL(fwd_kernel, dim3(grid), dim3(NTHR), LDS_BYTES, stream, a); }
#endif
}
```

```cpp
#include <hip/hip_runtime.h>
#include <cstdio>
#include <cstdint>

#ifndef MK_ONE_LAUNCH
#define MK_ONE_LAUNCH 1
#endif

namespace pg8 {
#define PG8_LAS __attribute__((address_space(3)))
typedef unsigned short bf16_t;
typedef short bf16x8 __attribute__((ext_vector_type(8)));
typedef float f32x4 __attribute__((ext_vector_type(4)));
typedef float f32x2 __attribute__((ext_vector_type(2)));
typedef unsigned u32x4 __attribute__((ext_vector_type(4)));
typedef unsigned u32x2 __attribute__((ext_vector_type(2)));
constexpr int BM = 256, BK = 64, HALF = 128, HTB = HALF * BK * 2  , STAGE_BYTES = 8 * HTB, NXCD = 8, WGM = 8;

__host__ __device__ __forceinline__ int lds_byte(int r, int c) { const int st = (r >> 4) * 2 + (c >> 5), rr = r & 15, cc = c & 31, ob = rr * 64 + cc * 2; return st * 1024 + (ob ^ (((ob >> 9) & 1) << 5)); }
__host__ __device__ __forceinline__ void stage_rc(int b, int& R, int& C) { const int st = b / 1024, sb = b % 1024, swz = sb ^ (((sb >> 9) & 1) << 5); R = (st >> 1) * 16 + swz / 64; C = (st & 1) * 32 + (swz % 64) / 2; }
__host__ __device__ __forceinline__ int perm32(int rho) { const int n = rho >> 4, i = rho & 15; return 8 * (i >> 2) + 4 * n + (i & 3); }

struct Unit { const char* A; const char* B; int pm, pn, aux; };

__host__ __device__ __forceinline__ void tile_order(int L, int nM, int nN, int& pm, int& pn) {
    const int nwg = nM * nN; int wgid = L;
    { const int q = nwg / NXCD, r = nwg % NXCD, xcd = wgid % NXCD, off = wgid / NXCD; wgid = (xcd < r ? xcd * (q + 1) : r * (q + 1) + (xcd - r) * q) + off; }
    const int nig = WGM * nN, gid = wgid / nig, fm = gid * WGM, gsz = (nM - fm) < WGM ? (nM - fm) : WGM;
    pm = fm + ((wgid % nig) % gsz); pn = (wgid % nig) / gsz;
}

typedef __bf16 bf16n2 __attribute__((ext_vector_type(2)));
__device__ __forceinline__ unsigned cvt_pk_bf16(float lo, float hi) { const f32x2 v = {lo, hi}; return __builtin_bit_cast(unsigned, __builtin_convertvector(v, bf16n2)); }

template <class Epi, class Sched>
__device__ __forceinline__ void gemm_phase(PG8_LAS unsigned char* lds, const int K, const Sched& S, const Epi& E, int tid) {
    const int wid = __builtin_amdgcn_readfirstlane(tid >> 6), lane = tid & 63, wr = wid >> 2, wc = wid & 3, fr = lane & 15, fq = lane >> 4;
    const int nt = K / BK;
    unsigned voffA[2], voffB[2];
#pragma unroll
    for (int i = 0; i < 2; ++i) { int R, C; stage_rc(tid * 16 + i * 8192, R, C); const int Rb = Epi::PERM ? ((R & ~31) + perm32(R & 31)) : R;
        voffA[i] = (unsigned)(R * K + C) * 2u; voffB[i] = (unsigned)(Rb * K + C) * 2u; }
    const size_t kstep = (size_t)(BK * 2);
    const size_t hstep = (size_t)HALF * K * 2;
    const unsigned ldsw = (unsigned)wid * 1024u;
    const int aoff = lds_byte(wr * 64 + fr, fq * 8), boff = lds_byte(wc * 32 + fr, fq * 8);
#define PG8_SA(b, h) (((b) * 2 + (h)) * HTB)
#define PG8_SB(b, h) ((4 + (b) * 2 + (h)) * HTB)
#define PG8_STAGE(bufoff, gbase, voff) do { _Pragma("unroll") for (int _i = 0; _i < 2; ++_i) \
        __builtin_amdgcn_global_load_lds((const unsigned*)((const char*)(gbase) + (voff)[_i]), (PG8_LAS unsigned*)(lds + (bufoff) + ldsw + _i * 8192), 16, 0, 0); } while (0)
#define PG8_LDA(dst, b, h) do { _Pragma("unroll") for (int m = 0; m < 4; ++m) _Pragma("unroll") for (int k = 0; k < 2; ++k) dst[m][k] = *(const PG8_LAS bf16x8*)(lds + PG8_SA(b, h) + aoff + m * 2048 + k * 1024); } while (0)
#define PG8_LDB(dst, b, h) do { _Pragma("unroll") for (int n = 0; n < 2; ++n) _Pragma("unroll") for (int k = 0; k < 2; ++k) dst[n][k] = *(const PG8_LAS bf16x8*)(lds + PG8_SB(b, h) + boff + n * 2048 + k * 1024); } while (0)
#define PG8_MMA(ai, bj, At, Bt) do { __builtin_amdgcn_s_setprio(1); _Pragma("unroll") for (int m = 0; m < 4; ++m) _Pragma("unroll") for (int n = 0; n < 2; ++n) _Pragma("unroll") for (int k = 0; k < 2; ++k) \
        acc[ai][bj][m][n] = __builtin_amdgcn_mfma_f32_16x16x32_bf16(Bt[n][k], At[m][k], acc[ai][bj][m][n], 0, 0, 0); __builtin_amdgcn_s_setprio(0); } while (0)
#define PG8_WAIT_V(n) asm volatile("s_waitcnt vmcnt(" #n ")" ::: "memory")
#define PG8_WAIT_L(n) asm volatile("s_waitcnt lgkmcnt(" #n ")" ::: "memory")
#define PG8_BAR __builtin_amdgcn_s_barrier()
#define PG8_SCHED __builtin_amdgcn_sched_barrier(0)
    Unit cur, nxt; int ui = 0;
    if (!S.next(0, cur)) return;
    f32x4 acc[2][2][4][2];
#pragma unroll
    for (int a = 0; a < 2; ++a)
#pragma unroll
        for (int b = 0; b < 2; ++b)
#pragma unroll
            for (int m = 0; m < 4; ++m)
#pragma unroll
                for (int n = 0; n < 2; ++n) acc[a][b][m][n] = (f32x4){0.f, 0.f, 0.f, 0.f};
    bf16x8 At[4][2], B0[2][2], B1[2][2];
    const char* cA = cur.A; const char* cB = cur.B;
    PG8_STAGE(PG8_SB(0, 0), cB, voffB); PG8_STAGE(PG8_SB(0, 1), cB + hstep, voffB); PG8_STAGE(PG8_SA(0, 0), cA, voffA); PG8_STAGE(PG8_SA(0, 1), cA + hstep, voffA);
    if (wr == 1) PG8_BAR;
    PG8_WAIT_V(2); PG8_BAR;
    PG8_STAGE(PG8_SB(1, 0), cB + kstep, voffB); PG8_STAGE(PG8_SA(1, 0), cA + kstep, voffA); PG8_STAGE(PG8_SB(1, 1), cB + hstep + kstep, voffB);
    PG8_WAIT_V(6); PG8_BAR;
    for (;;) {
        const bool has_next = S.next(ui + 1, nxt);
        const char* nA = has_next ? nxt.A : cA; const char* nB = has_next ? nxt.B : cB;
        for (int t = 0; t < nt; t += 2) {
            const bool last = (t == nt - 2);
            const char* a1 = cA + (size_t)(t + 1) * kstep;
            const char* a2 = last ? nA : cA + (size_t)(t + 2) * kstep; const char* b2 = last ? nB : cB + (size_t)(t + 2) * kstep;
            const char* a3 = a2 + kstep; const char* b3 = b2 + kstep;
            PG8_LDB(B0, 0, 0); PG8_LDB(B1, 0, 1); PG8_SCHED; PG8_LDA(At, 0, 0); PG8_STAGE(PG8_SA(1, 1), a1 + hstep, voffA);
            PG8_WAIT_V(8); PG8_WAIT_L(0); PG8_BAR; PG8_MMA(0, 0, At, B0); PG8_MMA(0, 1, At, B1); PG8_BAR; PG8_SCHED;
            PG8_LDA(At, 0, 1); PG8_STAGE(PG8_SB(0, 0), b2, voffB); PG8_STAGE(PG8_SB(0, 1), b2 + hstep, voffB); PG8_STAGE(PG8_SA(0, 0), a2, voffA);
            PG8_WAIT_V(8); PG8_WAIT_L(0); PG8_BAR; PG8_MMA(1, 0, At, B0); PG8_MMA(1, 1, At, B1); PG8_BAR; PG8_SCHED;
            PG8_LDB(B0, 1, 0); PG8_LDB(B1, 1, 1); PG8_SCHED; PG8_LDA(At, 1, 0); PG8_STAGE(PG8_SA(0, 1), a2 + hstep, voffA);
            PG8_WAIT_V(8); PG8_WAIT_L(0); PG8_BAR; PG8_MMA(0, 0, At, B0); PG8_MMA(0, 1, At, B1); PG8_BAR; PG8_SCHED;
            PG8_LDA(At, 1, 1); PG8_STAGE(PG8_SB(1, 0), b3, voffB); PG8_STAGE(PG8_SB(1, 1), b3 + hstep, voffB); PG8_STAGE(PG8_SA(1, 0), a3, voffA);
            PG8_WAIT_V(8); PG8_WAIT_L(0); PG8_BAR; PG8_MMA(1, 0, At, B0); PG8_MMA(1, 1, At, B1); PG8_BAR; PG8_SCHED;
        }
        if (wr == 0) PG8_BAR;
        { int fr_ = fr, fq_ = fq; asm volatile("" : "+v"(fr_), "+v"(fq_)); E(acc, cur, wr, wc, fr_, fq_); }
        if (!has_next) break;
        if (!(Epi::CARRY && E.keep(cur))) {
#pragma unroll
        for (int a = 0; a < 2; ++a)
#pragma unroll
            for (int b = 0; b < 2; ++b)
#pragma unroll
                for (int m = 0; m < 4; ++m)
#pragma unroll
                    for (int n = 0; n < 2; ++n) acc[a][b][m][n] = (f32x4){0.f, 0.f, 0.f, 0.f};
        }
        cur = nxt; cA = nA; cB = nB; ++ui;
        if (wr == 1) PG8_BAR;
    }
    PG8_WAIT_V(0);
    PG8_BAR;
#undef PG8_SA
#undef PG8_SB
#undef PG8_STAGE
#undef PG8_LDA
#undef PG8_LDB
#undef PG8_MMA
#undef PG8_WAIT_V
#undef PG8_WAIT_L
#undef PG8_BAR
#undef PG8_SCHED
}
}

constexpr int NWAVES = 8, NTHR = 512;
constexpr int D = 2048, NB = 4, SEQ = 2048, CTXL = 256, NCTX = NB * CTXL  , NLAT = NB * SEQ  , NTOK = NCTX + NLAT  ;
constexpr int NSTEP = CTXL + SEQ;
constexpr int HEADS = 8, HD = 128, MW = 1024, LW = 1024;
constexpr int NEXP = 32, DE = 1024;
constexpr int IN_DIM = 11296, NT_IN = 45;
constexpr float EPS = 1e-6f;
constexpr int MAXTILES = 96;
constexpr int NPHASE = 9;

constexpr size_t MiB = 1u << 20;
constexpr size_t WS_CTL = 0, CTL_ZERO_BYTES = 1 * MiB;
constexpr size_t WS_MOD = 1 * MiB;
constexpr size_t WS_GATES = 2 * MiB;
constexpr size_t WS_ASG = 4 * MiB + 512 * 1024;
constexpr size_t WS_LIST = 3 * MiB + 512 * 1024;
constexpr size_t WS_WR = 6 * MiB;
constexpr size_t WS_RB = 7 * MiB + 768 * 1024;
constexpr size_t WS_WL = 5 * MiB;
constexpr size_t WS_AGG = 978 * MiB;
constexpr size_t WS_WPA = 8 * MiB, WS_WPB = 12 * MiB, WS_WOUT = 16 * MiB, WS_WIN = 24 * MiB;
constexpr size_t WS_W13 = 72 * MiB, WS_W2 = 328 * MiB;
constexpr size_t WS_PS = 72 * MiB;
constexpr size_t WS_H = 456 * MiB;
constexpr size_t WS_K = 492 * MiB, WS_V = 510 * MiB, WS_UX = 528 * MiB;
constexpr size_t WS_Q = 546 * MiB, WS_OF = 562 * MiB, WS_OB = 578 * MiB, WS_UG = 594 * MiB;
constexpr size_t WS_GA = 610 * MiB, WS_GB = 642 * MiB;
constexpr size_t WS_LA = 674 * MiB, WS_LB = 746 * MiB;
constexpr size_t WS_HS = 818 * MiB, WS_TM = 882 * MiB;
constexpr size_t WS_YA = 946 * MiB, WS_YB = 962 * MiB;
constexpr size_t WS_BT = 982 * MiB;
constexpr size_t WS_SLOC = 984 * MiB;
constexpr size_t WS_END = 1022 * MiB;
constexpr size_t WS_PRE = WS_LA;
constexpr size_t WS_X1 = WS_LB;
constexpr size_t WS_H2 = WS_H;
constexpr size_t WS_XS = WS_K;
constexpr size_t WS_HM = 588 * MiB;
constexpr size_t WS_Y2 = WS_HS;
constexpr int CW_MODC = 32;
constexpr int CW_CNT = 64;
constexpr int CW_NT = 128;
constexpr int CW_TILE_E = 192;
constexpr int CW_BAR = 4096;
constexpr int CW_Q = 8192;
constexpr int CW_TC = 16384;

constexpr int RING_BYTES = 131072;
constexpr int LDSCTL_OFF = 143360;
constexpr int MISC_OFF = LDSCTL_OFF + 384;
constexpr int LDS_BYTES = 147456;

#define GAS __attribute__((address_space(1)))
#define LAS __attribute__((address_space(3)))
typedef unsigned short bf16;
typedef unsigned v4u __attribute__((ext_vector_type(4)));
typedef float f32x4 __attribute__((ext_vector_type(4)));
#define LDS_WAIT() asm volatile("s_waitcnt lgkmcnt(0)" ::: "memory")
#define WG_BAR() do { asm volatile("s_waitcnt lgkmcnt(0)" ::: "memory"); __builtin_amdgcn_s_barrier(); asm volatile("" ::: "memory"); } while (0)

__device__ __forceinline__ unsigned f2bf(float f) { unsigned u = __builtin_bit_cast(unsigned, f); return (u + 0x7fffu + ((u >> 16) & 1u)) >> 16; }
__device__ __forceinline__ unsigned pk2(float lo, float hi) { return pg8::cvt_pk_bf16(lo, hi); }
__device__ __forceinline__ float bf2f(unsigned h) { return __builtin_bit_cast(float, h << 16); }
__device__ __forceinline__ float bflo(unsigned w) { return __builtin_bit_cast(float, w << 16); }
__device__ __forceinline__ float bfhi(unsigned w) { return __builtin_bit_cast(float, w & 0xffff0000u); }
__device__ __forceinline__ float sigmoidf_(float x) { return __builtin_amdgcn_rcpf(1.f + __expf(-x)); }
__device__ __forceinline__ float gelu_tanh(float x) { const float u = 0.7978845608028654f * (x + 0.044715f * x * x * x); return x * __builtin_amdgcn_rcpf(1.f + __expf(-2.f * u)); }
__device__ __forceinline__ float wave_sum(float v) {
#pragma unroll
    for (int o = 1; o < 64; o <<= 1) v += __shfl_xor(v, o);
    return v;
}

#define XB_TMO      128
#define XB_XCNT(j)  (256  + 64 * (j))
#define XB_XSUB(j)  (1280 + 64 * (j))
#define XB_XGEN(j)  (2304 + 64 * (j))
#define XB_TOP      3328
#define XB_TOPGEN   3392
#define XCD_BAR_WORDS 3456
#define XB_SPIN_CAP (1u << 23)
__device__ __forceinline__ unsigned xb_ld(unsigned* p)              { return __hip_atomic_load(p, __ATOMIC_RELAXED, __HIP_MEMORY_SCOPE_AGENT); }
__device__ __forceinline__ unsigned xb_add(unsigned* p, unsigned v) { return __hip_atomic_fetch_add(p, v, __ATOMIC_RELAXED, __HIP_MEMORY_SCOPE_AGENT); }
__device__ __forceinline__ unsigned xb_xcc_id() { return (unsigned)__builtin_amdgcn_s_getreg((3 << 11) | 20) & 0xFu; }
#define XB_SPIN(cond, bar) do { unsigned _sp = 0; while (cond) { __builtin_amdgcn_s_sleep(1); \
    if ((++_sp & 255u) == 0u) { if (xb_ld(&(bar)[XB_TMO])) break; if (_sp > XB_SPIN_CAP) { atomicAdd(&(bar)[XB_TMO], 1u); break; } } } } while (0)
struct XcdBarrier { unsigned* bar; unsigned x; volatile LAS unsigned* st; };
__device__ __forceinline__ XcdBarrier xcd_barrier_post(unsigned* bar, volatile LAS unsigned* st, int tid) {
    XcdBarrier b; b.bar = bar; b.x = xb_xcc_id(); b.st = st;
    if (tid == 0) (void)xb_add(&bar[XB_XCNT(b.x)], 1u);
    return b;
}
__device__ __forceinline__ void xcd_barrier_complete(unsigned* bar, unsigned x, unsigned& nloc, unsigned& nx) {
    const unsigned G = gridDim.x * gridDim.y * gridDim.z;
    unsigned sum, cnt, mine, sp = 0u;
    for (;;) {
        sum = 0u; cnt = 0u; mine = 0u;
#pragma unroll
        for (unsigned j = 0; j < 16; ++j) { const unsigned c = xb_ld(&bar[XB_XCNT(j)]); sum += c; cnt += (c > 0u) ? 1u : 0u; mine = (j == x) ? c : mine; }
        if (sum == G) break;
        __builtin_amdgcn_s_sleep(1);
        if ((++sp & 255u) == 0u) { if (xb_ld(&bar[XB_TMO])) break; if (sp > XB_SPIN_CAP) { atomicAdd(&bar[XB_TMO], 1u); break; } }
    }
    nloc = mine > 0u ? mine : 1u; nx = cnt > 0u ? cnt : 1u;
}
__device__ __forceinline__ void xcd_barrier(const XcdBarrier& b, int tid) {
    asm volatile("s_waitcnt vmcnt(0)" ::: "memory");
    __syncthreads();
    if (tid == 0) {
        unsigned* bar = b.bar;
        __builtin_amdgcn_s_waitcnt(0);
        unsigned nloc = b.st[0], nx = b.st[1];
        if (nloc == 0u) { xcd_barrier_complete(bar, b.x, nloc, nx); b.st[0] = nloc; b.st[1] = nx; }
        const unsigned old = xb_add(&bar[XB_XSUB(b.x)], 1u);
        const unsigned gen = old / nloc;
        if (old + 1u == (gen + 1u) * nloc) {
            __builtin_amdgcn_fence(__ATOMIC_RELEASE, "agent");
            asm volatile("s_waitcnt vmcnt(0)" ::: "memory");
            const unsigned og = xb_add(&bar[XB_TOP], 1u);
            const unsigned tg = og / nx;
            if (og + 1u == (tg + 1u) * nx) xb_add(&bar[XB_TOPGEN], 1u);
            else XB_SPIN(xb_ld(&bar[XB_TOPGEN]) == tg, bar);
            __builtin_amdgcn_fence(__ATOMIC_ACQUIRE, "agent");
            xb_add(&bar[XB_XGEN(b.x)], 1u);
            asm volatile("s_waitcnt vmcnt(0)" ::: "memory");
        } else {
            XB_SPIN(xb_ld(&bar[XB_XGEN(b.x)]) == gen, bar);
            __builtin_amdgcn_fence(__ATOMIC_ACQUIRE, "agent");
            asm volatile("s_waitcnt vmcnt(0)" ::: "memory");
        }
    }
    __syncthreads();
}

__device__ __forceinline__ int make_tid(int wave_s) { int l; asm volatile("v_mbcnt_lo_u32_b32 %0, -1, 0\n\tv_mbcnt_hi_u32_b32 %0, -1, %0" : "=v"(l)); __builtin_assume(l >= 0 && l < 64); __builtin_assume(wave_s >= 0 && wave_s < 8); return wave_s * 64 + l; }
struct Args { const float* in[27]; float* out; unsigned char* ws; int ph_lo, ph_hi; };
enum { I_X = 0, I_C, I_CTX, I_CCTX, I_WMOD, I_BMOD, I_N1G, I_WIN, I_BGATES, I_HEADG, I_CONVW, I_CONVB, I_LWA, I_LBA, I_LWX, I_LBX, I_LAM, I_WPA, I_WPB, I_WOUT, I_N2G, I_WRG, I_WRE, I_W1, I_W3, I_W2, I_FG };

__device__ __forceinline__ void tr_item(const float* __restrict__ W, size_t ldw, int k0, int n0, bf16* dst, size_t ldd, float scale, LAS float* scr, int lane) {
#pragma unroll 16
    for (int i = 0; i < 32; ++i) { const int kk = 2 * i + (lane >> 5); scr[kk * 33 + (lane & 31)] = W[(size_t)(k0 + kk) * ldw + n0 + (lane & 31)]; }
    LDS_WAIT(); asm volatile("" ::: "memory");
    const int c = lane & 7;
#pragma unroll
    for (int j = 0; j < 4; ++j) { const int n = (lane >> 3) + 8 * j; const LAS float* s = scr + (8 * c) * 33 + n;
        v4u o; o.x = pk2(s[0 * 33] * scale, s[1 * 33] * scale); o.y = pk2(s[2 * 33] * scale, s[3 * 33] * scale); o.z = pk2(s[4 * 33] * scale, s[5 * 33] * scale); o.w = pk2(s[6 * 33] * scale, s[7 * 33] * scale);
        *(GAS v4u*)(dst + (size_t)n * ldd + 8 * c) = o; }
    LDS_WAIT(); asm volatile("" ::: "memory");
}
__device__ __forceinline__ int win_row(int n0, float& scale) {
    scale = 1.f;
    if (n0 < 1024) return 13 * 256 + n0;
    if (n0 < 2048) { scale = 0.08838834764831845f; return n0 - 1024; }
    if (n0 < 3072) return 4 * 256 + (n0 - 2048);
    if (n0 < 4096) return 17 * 256 + (n0 - 3072);
    if (n0 < 5120) return 21 * 256 + (n0 - 4096);
    if (n0 < 5152) return 12 * 256 + (n0 - 5120);
    if (n0 < 6176) return 8 * 256 + (n0 - 5152);
    if (n0 < 7200) return 25 * 256 + (n0 - 6176);
    if (n0 < 9248) return 29 * 256 + (n0 - 7200);
    return 37 * 256 + (n0 - 9248);
}

__device__ __forceinline__ void phase0(const Args& a, unsigned char* lds_g, int tid, int lane, int wave) {
    unsigned char* ws = a.ws;
    {
        float* sl = (float*)lds_g;
        float* red = sl + 5 * 2048;
        for (int i = tid; i < 5 * 2048; i += NTHR) { const int r = i >> 11, k = i & 2047; const float v = r < 4 ? a.in[I_C][r * 2048 + k] : a.in[I_CCTX][k]; sl[i] = v / (1.f + __expf(-v)); }
        __syncthreads();
        const float* wm = a.in[I_WMOD]; const float* bm = a.in[I_BMOD]; float* MOD = (float*)(ws + WS_MOD);
        for (int cb = blockIdx.x; cb < 256; cb += gridDim.x) {
            const int n0 = cb * 48;
            if (tid < 504) {
                const int kq = tid / 12, cg = tid % 12;
                f32x4 acc[5];
#pragma unroll
                for (int r = 0; r < 5; ++r) acc[r] = (f32x4){0.f, 0.f, 0.f, 0.f};
#pragma unroll 7
                for (int k = kq; k < 2048; k += 42) {
                    const f32x4 w = *(const f32x4*)(wm + (size_t)k * 12288 + n0 + 4 * cg);
#pragma unroll
                    for (int r = 0; r < 5; ++r) acc[r] += w * sl[r * 2048 + k];
                }
#pragma unroll
                for (int r = 0; r < 5; ++r) *(f32x4*)(red + tid * 20 + r * 4) = acc[r];
            }
            __syncthreads();
            if (tid < 240) {
                const int cg = tid / 20, rj = tid % 20; float s = 0.f;
                for (int kq = 0; kq < 42; ++kq) s += red[(kq * 12 + cg) * 20 + rj];
                const int r = rj >> 2, j = rj & 3, n = n0 + 4 * cg + j;
                __hip_atomic_store(MOD + r * 12288 + n, s + bm[n], __ATOMIC_RELAXED, __HIP_MEMORY_SCOPE_AGENT);
            }
            __syncthreads();
        }
        if (tid == 0) __hip_atomic_fetch_add((unsigned*)(ws + WS_CTL) + CW_MODC, 1u, __ATOMIC_RELAXED, __HIP_MEMORY_SCOPE_AGENT);
    }
    {
        LAS float* scr = (LAS float*)((LAS unsigned char*)lds_g) + wave * 4096;
        const int gw = blockIdx.x * NWAVES + wave, NGW = gridDim.x * NWAVES;
        constexpr int J0 = 32 * 353, J1 = 16 * 64, J3 = 32 * 64;
        constexpr int JL = 256;
        constexpr int NITEMS = J0 + 2 * J1;
        (void)J3; (void)JL;
        for (int it = gw; it < NITEMS; it += NGW) {
            int r = it;
            if (r < J0) { const int kb = r / 353, nb = r % 353; float sc; const int row = win_row(32 * nb, sc);
                tr_item(a.in[I_WIN], IN_DIM, 64 * kb, 32 * nb, (bf16*)(ws + WS_WIN) + (size_t)row * 2048 + 64 * kb, 2048, sc, scr, lane); continue; } r -= J0;
            if (r < J1) { const int kb = r / 64, nb = r % 64; tr_item(a.in[I_WPA], 2048, 64 * kb, 32 * nb, (bf16*)(ws + WS_WPA) + (size_t)(32 * nb) * 1024 + 64 * kb, 1024, 1.f, scr, lane); continue; } r -= J1;
            if (r < J1) { const int kb = r / 64, nb = r % 64; tr_item(a.in[I_WPB], 2048, 64 * kb, 32 * nb, (bf16*)(ws + WS_WPB) + (size_t)(32 * nb) * 1024 + 64 * kb, 1024, 1.f, scr, lane); continue; }
        }
        { GAS v4u* z = (GAS v4u*)((bf16*)(ws + WS_WIN) + (size_t)(12 * 256 + 32) * 2048); const int nchunks = 224 * 256;
          for (int i = blockIdx.x * NTHR + tid; i < nchunks; i += gridDim.x * NTHR) z[i] = (v4u){0u, 0u, 0u, 0u}; }
    }
}

__device__ __forceinline__ void late_prep(const Args& a, unsigned char* lds_g, int gw, int NGW, int lane, int wave) {
    unsigned char* ws = a.ws;
    {
        LAS float* scr = (LAS float*)((LAS unsigned char*)lds_g) + wave * 4096;
        constexpr int J3 = 32 * 64, JL = 256;
        for (int it = gw; it < J3 + JL; it += NGW) {
            int r = it;
            if (r >= J3) { r -= J3; const int mi = r >> 3, kb = (r >> 2) & 1, nb = r & 3, dir = mi >> 4, mat = (mi >> 3) & 1, blk = mi & 7;
                tr_item(a.in[mat ? I_LWX : I_LWA] + (size_t)(dir * 8 + blk) * 128 * 128, 128, 64 * kb, 32 * nb, (bf16*)(ws + WS_WL) + ((size_t)((dir * 2 + mat) * 8 + blk) * 128 + 32 * nb) * 128 + 64 * kb, 128, 1.f, scr, lane); continue; }
            const int kb = r / 64, nb = r % 64; tr_item(a.in[I_WOUT], 2048, 64 * kb, 32 * nb, (bf16*)(ws + WS_WOUT) + (size_t)(32 * nb) * 2048 + 64 * kb, 2048, 1.f, scr, lane);
        }
    }
    {
        const float* MODr = (const float*)(a.ws + WS_MOD); float* WR = (float*)(a.ws + WS_WR); float* RB = (float*)(a.ws + WS_RB);
        for (int idx = gw * 64 + lane; idx < 4 * 48 * 2048; idx += NGW * 64) { const int k = idx & 2047, j = (idx >> 11) % 48, b = idx / (48 * 2048);
            const float gm = a.in[I_N2G][k] * (1.f + MODr[b * 12288 + 4 * 2048 + k]);
            const float wv = j < 32 ? a.in[I_WRE][(size_t)k * 32 + j] : (j < 36 ? a.in[I_WRG][(size_t)k * 4 + (j - 32)] : 0.f);
            WR[idx] = gm * wv; }
        for (int q = gw; q < 4 * 48; q += NGW) { const int b = q / 48, j = q % 48; float sacc = 0.f;
            if (j < 36) { for (int k = lane; k < 2048; k += 64) { const float wv = j < 32 ? a.in[I_WRE][(size_t)k * 32 + j] : a.in[I_WRG][(size_t)k * 4 + (j - 32)]; sacc += MODr[b * 12288 + 3 * 2048 + k] * wv; } }
            sacc = wave_sum(sacc); if (lane == 0) RB[q] = sacc; }
    }
}
__device__ __forceinline__ void mod_wait(const Args& a, int tid) {
    if (tid < 64) { unsigned* mc = (unsigned*)(a.ws + WS_CTL) + CW_MODC; unsigned spins = 0;
        while ((unsigned)__builtin_amdgcn_readfirstlane(__hip_atomic_load(mc, __ATOMIC_RELAXED, __HIP_MEMORY_SCOPE_AGENT)) < gridDim.x) {
            __builtin_amdgcn_s_sleep(2);
            if (++spins > (1u << 22)) { if (tid == 0) __hip_atomic_store((unsigned*)(a.ws + WS_CTL) + 1, 0x800u, __ATOMIC_RELAXED, __HIP_MEMORY_SCOPE_AGENT); break; } }
        __builtin_amdgcn_fence(__ATOMIC_ACQUIRE, "agent");
        asm volatile("s_waitcnt vmcnt(0)" ::: "memory"); }
    __syncthreads();
}
__device__ __forceinline__ void phase1(const Args& a, int lane, int wave) {
    const int gw = blockIdx.x * NWAVES + wave, NGW = gridDim.x * NWAVES;
    const float* MOD = (const float*)(a.ws + WS_MOD); const float* g = a.in[I_N1G];
    bf16* H = (bf16*)(a.ws + WS_H);
    for (int r = gw; r < NTOK; r += NGW) {
        const float* src = r < NCTX ? a.in[I_CTX] + (size_t)r * D : a.in[I_X] + (size_t)(r - NCTX) * D;
        const int mr = r < NCTX ? 4 : (r - NCTX) / SEQ;
        const f32x4* xr = (const f32x4*)src + lane;
        f32x4 v[8]; float s = 0.f;
#pragma unroll
        for (int j = 0; j < 8; ++j) { v[j] = xr[64 * j]; s += (v[j].x * v[j].x + v[j].y * v[j].y) + (v[j].z * v[j].z + v[j].w * v[j].w); }
        const float rstd = 1.f / sqrtf(wave_sum(s) * (1.f / D) + EPS);
        unsigned long long* o8 = (unsigned long long*)(H + (size_t)r * D) + lane;
#pragma unroll
        for (int j = 0; j < 8; ++j) {
            const int c = 4 * lane + 256 * j;
            const f32x4 gg = *(const f32x4*)(g + c), sh = *(const f32x4*)(MOD + mr * 12288 + c), sc = *(const f32x4*)(MOD + mr * 12288 + 2048 + c);
            v[j] = v[j] * rstd * gg * (sc + 1.f) + sh;
        }
#pragma unroll
        for (int j = 0; j < 8; ++j) o8[64 * j] = (unsigned long long)pk2(v[j].x, v[j].y) | ((unsigned long long)pk2(v[j].z, v[j].w) << 32);
    }
}

struct SchedIn {
    int G, c; const char* A; const char* B;
    __device__ __forceinline__ bool next(int i, pg8::Unit& u) const {
        const int L = i * G + c; if (L >= 1492) return false;
        int pm, pn;
        if (L < 1440) { pg8::tile_order(L, 32, NT_IN, pm, pn); pm += 4; }
        else { const int j = L - 1440; pm = j & 3; pn = j >> 2; }
        u.pm = pm; u.pn = pn; u.aux = 0; u.A = A + (size_t)pm * 256 * D * 2; u.B = B + (size_t)pn * 256 * D * 2; return true;
    }
};
struct EpiIn {
    static constexpr bool PERM = true, CARRY = false;
    __device__ __forceinline__ bool keep(const pg8::Unit&) const { return false; }
    unsigned char* ws; const float* b_gates;
    template <int ACT> __device__ __forceinline__ void store_tile(const pg8::f32x4 (&acc)[2][2][4][2], bf16* base, int ldc, int wr, int wc, int fr, int fq) const {
#pragma unroll
        for (int ai = 0; ai < 2; ++ai)
#pragma unroll
            for (int m = 0; m < 4; ++m) { bf16* rowp = base + (size_t)(ai * 128 + wr * 64 + m * 16 + fr) * ldc + wc * 32 + 8 * fq;
#pragma unroll
                for (int bj = 0; bj < 2; ++bj) { pg8::f32x4 v0 = acc[ai][bj][m][0], v1 = acc[ai][bj][m][1];
                    if (ACT == 1) {
#pragma unroll
                        for (int j = 0; j < 4; ++j) { v0[j] = sigmoidf_(v0[j]); v1[j] = sigmoidf_(v1[j]); } }
                    if (ACT == 2) {
#pragma unroll
                        for (int j = 0; j < 4; ++j) { v0[j] = gelu_tanh(v0[j]); v1[j] = gelu_tanh(v1[j]); } }
                    pg8::u32x4 w; w.x = pg8::cvt_pk_bf16(v0[0], v0[1]); w.y = pg8::cvt_pk_bf16(v0[2], v0[3]); w.z = pg8::cvt_pk_bf16(v1[0], v1[1]); w.w = pg8::cvt_pk_bf16(v1[2], v1[3]);
                    *(pg8::u32x4*)(rowp + bj * 128) = w; } }
    }
    __device__ __forceinline__ void operator()(const pg8::f32x4 (&acc)[2][2][4][2], const pg8::Unit& u, int wr, int wc, int fr, int fq) const {
        const int pn = u.pn; const size_t row0 = (size_t)u.pm * 256;
        if (pn < 12) {
            const int seg = pn >> 2, ct = pn & 3; bf16* dst = (bf16*)(ws + (seg == 0 ? WS_K : seg == 1 ? WS_V : WS_UX));
            store_tile<0>(acc, dst + row0 * 1024 + ct * 256, 1024, wr, wc, fr, fq);
        } else if (pn == 12) {
            if (wc == 0) {
                float* G = (float*)(ws + WS_GATES);
                const pg8::f32x4 bv0 = *(const pg8::f32x4*)(b_gates + 8 * fq), bv1 = *(const pg8::f32x4*)(b_gates + 8 * fq + 4);
#pragma unroll
                for (int ai = 0; ai < 2; ++ai)
#pragma unroll
                    for (int m = 0; m < 4; ++m) { float* rowp = G + (row0 + ai * 128 + wr * 64 + m * 16 + fr) * 32 + 8 * fq;
                        *(pg8::f32x4*)(rowp) = acc[ai][0][m][0] + bv0; *(pg8::f32x4*)(rowp + 4) = acc[ai][0][m][1] + bv1; }
            }
        } else if (pn < 29) {
            const int seg = (pn - 13) >> 2, ct = (pn - 13) & 3; const size_t lr = row0 - NCTX;
            bf16* dst = (bf16*)(ws + (seg == 0 ? WS_Q : seg == 1 ? WS_OF : seg == 2 ? WS_OB : WS_UG)) + lr * 1024 + ct * 256;
            if (seg == 0) store_tile<0>(acc, dst, 1024, wr, wc, fr, fq);
            else if (seg == 3) store_tile<2>(acc, dst, 1024, wr, wc, fr, fq);
            else store_tile<1>(acc, dst, 1024, wr, wc, fr, fq);
        } else {
            const int seg = (pn - 29) >> 3, ct = (pn - 29) & 7; const size_t lr = row0 - NCTX;
            store_tile<1>(acc, (bf16*)(ws + (seg ? WS_GB : WS_GA)) + lr * 2048 + ct * 256, 2048, wr, wc, fr, fq);
        }
    }
};

__device__ __forceinline__ int lru_pos_row(int b, bool isctx, int p) { return isctx ? b * CTXL + p : NCTX + b * SEQ + (p & 31) * 64 + (p >> 5); }
typedef short bf16x8_t __attribute__((ext_vector_type(8)));
template <bool FINAL>
__device__ __forceinline__ void lru_unit(const Args& a, unsigned char* lds_g, int b, int cidx, int blk, int tid) {
    const int lane = tid & 63, w = __builtin_amdgcn_readfirstlane(tid >> 6), fr = lane & 15, fq = lane >> 4;
    float* zf = (float*)lds_g;
    bf16* zb = (bf16*)(lds_g + 64 * 132 * 4);
    const bool isctx = cidx < 4; const int seglen = isctx ? CTXL : SEQ, p0 = (isctx ? cidx : cidx - 4) * 64;
    const bf16* UX = (const bf16*)(a.ws + WS_UX);
    float gba[2], gbx[2], glam[2];
    { const int ch_ = blk * 128 + 16 * w + fr;
#pragma unroll
      for (int d = 0; d < 2; ++d) { gba[d] = a.in[I_LBA][d * 1024 + ch_]; gbx[d] = a.in[I_LBX][d * 1024 + ch_]; glam[d] = a.in[I_LAM][d * 1024 + ch_]; } }
    bf16x8_t wl[2][2][4];
    { const bf16* WL = (const bf16*)(a.ws + WS_WL);
#pragma unroll
      for (int d = 0; d < 2; ++d)
#pragma unroll
        for (int m = 0; m < 2; ++m)
#pragma unroll
            for (int ks = 0; ks < 4; ++ks) wl[d][m][ks] = *(const bf16x8_t*)(WL + ((size_t)((d * 2 + m) * 8 + blk) * 128 + 16 * w + fr) * 128 + 32 * ks + 8 * fq); }
    __builtin_amdgcn_sched_barrier(0);
    {
        const int pos = tid >> 3, cg = tid & 7, ch0 = blk * 128 + cg * 16, p = p0 + pos;
        float z[16];
#pragma unroll
        for (int q = 0; q < 4; ++q) { const f32x4 bv = *(const f32x4*)(a.in[I_CONVB] + ch0 + 4 * q); z[4 * q] = bv.x; z[4 * q + 1] = bv.y; z[4 * q + 2] = bv.z; z[4 * q + 3] = bv.w; }
        v4u ua[4], ub[4]; float msk[4];
#pragma unroll
        for (int w4 = 0; w4 < 4; ++w4) { const int pp = p + w4 - 2; const bool ok = pp >= 0 && pp < seglen; const int ppc = ok ? pp : p;
            const v4u* src = (const v4u*)(UX + (size_t)lru_pos_row(b, isctx, ppc) * 1024 + ch0); ua[w4] = src[0]; ub[w4] = src[1]; msk[w4] = ok ? 1.f : 0.f; }
#pragma unroll
        for (int w4 = 0; w4 < 4; ++w4) { const float* cw = a.in[I_CONVW] + w4 * 1024 + ch0;
            const unsigned uu[8] = {ua[w4].x, ua[w4].y, ua[w4].z, ua[w4].w, ub[w4].x, ub[w4].y, ub[w4].z, ub[w4].w};
#pragma unroll
            for (int q = 0; q < 4; ++q) { const f32x4 cv = *(const f32x4*)(cw + 4 * q) * msk[w4]; z[4 * q] += cv.x * bflo(uu[2 * q]); z[4 * q + 1] += cv.y * bfhi(uu[2 * q]); z[4 * q + 2] += cv.z * bflo(uu[2 * q + 1]); z[4 * q + 3] += cv.w * bfhi(uu[2 * q + 1]); } }
#pragma unroll
        for (int q = 0; q < 4; ++q) *(f32x4*)(zf + pos * 132 + cg * 16 + 4 * q) = (f32x4){z[4 * q], z[4 * q + 1], z[4 * q + 2], z[4 * q + 3]};
        v4u o0, o1; o0.x = pk2(z[0], z[1]); o0.y = pk2(z[2], z[3]); o0.z = pk2(z[4], z[5]); o0.w = pk2(z[6], z[7]); o1.x = pk2(z[8], z[9]); o1.y = pk2(z[10], z[11]); o1.z = pk2(z[12], z[13]); o1.w = pk2(z[14], z[15]);
        *(v4u*)(zb + pos * 136 + cg * 16) = o0; *(v4u*)(zb + pos * 136 + cg * 16 + 8) = o1;
    }
    WG_BAR();
    f32x4 acc[2][2][4];
#pragma unroll
    for (int d = 0; d < 2; ++d)
#pragma unroll
        for (int m = 0; m < 2; ++m)
#pragma unroll
            for (int mt = 0; mt < 4; ++mt) acc[d][m][mt] = (f32x4){0.f, 0.f, 0.f, 0.f};
#pragma unroll
    for (int ks = 0; ks < 4; ++ks) {
        bf16x8_t af[4];
#pragma unroll
        for (int mt = 0; mt < 4; ++mt) af[mt] = *(const bf16x8_t*)(zb + (16 * mt + fr) * 136 + 32 * ks + 8 * fq);
#pragma unroll
        for (int d = 0; d < 2; ++d)
#pragma unroll
            for (int m = 0; m < 2; ++m) {
#pragma unroll
                for (int mt = 0; mt < 4; ++mt) acc[d][m][mt] = __builtin_amdgcn_mfma_f32_16x16x32_bf16(af[mt], wl[d][m][ks], acc[d][m][mt], 0, 0, 0); }
    }
    const int chl = 16 * w + fr, ch = blk * 128 + chl;
    float hsum[4][4];
#pragma unroll
    for (int d = 0; d < 2; ++d) {
        const float ba = gba[d], bx = gbx[d], lam = glam[d];
        const float sp = (-lam > 20.f) ? -lam : log1pf(__expf(-lam));
        float av[4][4], bv[4][4];
#pragma unroll
        for (int mt = 0; mt < 4; ++mt)
#pragma unroll
            for (int r = 0; r < 4; ++r) { const float rr = sigmoidf_(acc[d][0][mt][r] + ba), ii = sigmoidf_(acc[d][1][mt][r] + bx);
                const float aa = __expf(-8.f * rr * sp); av[mt][r] = aa; bv[mt][r] = __builtin_amdgcn_sqrtf(fmaxf(1.f - aa * aa, 0.f)) * ii * zf[(16 * mt + 4 * fq + r) * 132 + chl]; }
        float Pe[4], Se[4], Pt[4], St[4];
#pragma unroll
        for (int mt = 0; mt < 4; ++mt) {
            float P = 1.f, S = 0.f;
#pragma unroll
            for (int rr = 0; rr < 4; ++rr) { const int r = d ? 3 - rr : rr; S = av[mt][r] * S + bv[mt][r]; P = av[mt][r] * P; }
            if (d == 0) {
                float p1 = __shfl_up(P, 16), s1 = __shfl_up(S, 16); if (fq >= 1) { S = P * s1 + S; P = P * p1; }
                p1 = __shfl_up(P, 32); s1 = __shfl_up(S, 32); if (fq >= 2) { S = P * s1 + S; P = P * p1; }
                Pe[mt] = __shfl_up(P, 16); Se[mt] = __shfl_up(S, 16); if (fq == 0) { Pe[mt] = 1.f; Se[mt] = 0.f; }
                Pt[mt] = __shfl(P, fr + 48); St[mt] = __shfl(S, fr + 48);
            } else {
                float p1 = __shfl_down(P, 16), s1 = __shfl_down(S, 16); if (fq <= 2) { S = P * s1 + S; P = P * p1; }
                p1 = __shfl_down(P, 32); s1 = __shfl_down(S, 32); if (fq <= 1) { S = P * s1 + S; P = P * p1; }
                Pe[mt] = __shfl_down(P, 16); Se[mt] = __shfl_down(S, 16); if (fq == 3) { Pe[mt] = 1.f; Se[mt] = 0.f; }
                Pt[mt] = __shfl(P, fr); St[mt] = __shfl(S, fr);
            }
        }
        float2* AGG = (float2*)(a.ws + WS_AGG) + ((size_t)(b * 2 + d) * 36) * 1024 + ch;
        if (!FINAL) {
            if (cidx >= 4) {
                unsigned* PS = (unsigned*)(a.ws + WS_PS) + ((size_t)(b * 2 + d) * NSTEP + 64 * cidx) * 1024 + ch;
#pragma unroll
                for (int mt = 0; mt < 4; ++mt)
#pragma unroll
                    for (int r = 0; r < 4; ++r) PS[(size_t)(16 * mt + 4 * fq + r) * 1024] = pk2(1.f - av[mt][r], bv[mt][r]);
            }
            float Pc = 1.f, Sc = 0.f;
#pragma unroll
            for (int i = 0; i < 4; ++i) { const int mt = d ? 3 - i : i; Sc = Pt[mt] * Sc + St[mt]; Pc = Pt[mt] * Pc; }
            if (fq == 0) AGG[(size_t)cidx * 1024] = make_float2(Pc, Sc);
        } else {
            float h = 0.f;
#pragma unroll
            for (int g3 = 0; g3 < 6; ++g3) {
                float2 qv[6];
#pragma unroll
                for (int i = 0; i < 6; ++i) { const int sidx = 6 * g3 + i; const int c2 = d ? (sidx < 4 ? 3 - sidx : 39 - sidx) : sidx; qv[i] = AGG[(size_t)c2 * 1024]; }
#pragma unroll
                for (int i = 0; i < 6; ++i) { const int sidx = 6 * g3 + i; const int c2 = d ? (sidx < 4 ? 3 - sidx : 39 - sidx) : sidx;
                    const bool use = d ? (sidx < 4 || c2 > cidx) : (c2 < cidx);
                    h = use ? qv[i].x * h + qv[i].y : h; }
            }
#pragma unroll
            for (int i = 0; i < 4; ++i) { const int mt = d ? 3 - i : i;
                float hl = Pe[mt] * h + Se[mt];
#pragma unroll
                for (int rr = 0; rr < 4; ++rr) { const int r = d ? 3 - rr : rr; hl = av[mt][r] * hl + bv[mt][r]; if (d == 0) hsum[mt][r] = hl; else hsum[mt][r] += hl; }
                h = Pt[mt] * h + St[mt]; }
        }
    }
    if (FINAL) {
#pragma unroll
        for (int mt = 0; mt < 4; ++mt)
#pragma unroll
            for (int r = 0; r < 4; ++r) zf[(16 * mt + 4 * fq + r) * 132 + chl] = hsum[mt][r];
        WG_BAR();
        const int pos = tid >> 3, cg = tid & 7, ch0 = blk * 128 + cg * 16;
        const size_t lrow = (size_t)(lru_pos_row(b, false, p0 + pos) - NCTX) * 1024 + ch0;
        const v4u* ug = (const v4u*)((const bf16*)(a.ws + WS_UG) + lrow); const v4u g0 = ug[0], g1 = ug[1];
        const unsigned gg[8] = {g0.x, g0.y, g0.z, g0.w, g1.x, g1.y, g1.z, g1.w}; unsigned o[8];
#pragma unroll
        for (int q = 0; q < 4; ++q) { const f32x4 hv = *(const f32x4*)(zf + pos * 132 + cg * 16 + 4 * q);
            o[2 * q] = pk2(hv.x * bflo(gg[2 * q]), hv.y * bfhi(gg[2 * q])); o[2 * q + 1] = pk2(hv.z * bflo(gg[2 * q + 1]), hv.w * bfhi(gg[2 * q + 1])); }
        v4u* dst = (v4u*)((bf16*)(a.ws + WS_YB) + lrow); dst[0] = (v4u){o[0], o[1], o[2], o[3]}; dst[1] = (v4u){o[4], o[5], o[6], o[7]};
    }
    WG_BAR();
}
constexpr int ML_STRIDE = 136;
constexpr int ML_Q = 0, ML_K = 17408, ML_V = 34816, ML_AUG = 52224  , ML_CB = 54272  ;
constexpr int ML_EB = 93440  , ML_EU = 95488  , ML_EBEND = 97536  , ML_BEND = 97568  , ML_DEN = 97600  , ML_SSQ = 97856  ;
typedef short s4_t __attribute__((ext_vector_type(4)));
__device__ __forceinline__ s4_t ds_tr(const bf16* p) { return __builtin_amdgcn_ds_read_tr16_b64_v4i16((LAS s4_t*)p); }
__device__ __forceinline__ bf16x8_t frag_row(const bf16* img, int row0, int k0, int fr, int fq) { return *(const bf16x8_t*)(img + (row0 + fr) * ML_STRIDE + k0 + 8 * fq); }
__device__ __forceinline__ bf16x8_t frag_tr2(const bf16* img, int stride, int sA, int sB, int col0, int lane) {
    const int fq = lane >> 4, q = (lane & 15) >> 2, p = lane & 3;
    const s4_t lo = ds_tr(img + (sA + 4 * fq + q) * stride + col0 + 4 * p), hi = ds_tr(img + (sB + 4 * fq + q) * stride + col0 + 4 * p);
    return (bf16x8_t){lo.x, lo.y, lo.z, lo.w, hi.x, hi.y, hi.z, hi.w};
}
__device__ __forceinline__ bf16x8_t frag_tr(const bf16* img, int stride, int s0, int col0, int lane) {
    const int fq = lane >> 4, q = (lane & 15) >> 2, p = lane & 3;
    const bf16* b = img + (s0 + 8 * fq + q) * stride + col0 + 4 * p;
    const s4_t lo = ds_tr(b), hi = ds_tr(b + 4 * stride);
    return (bf16x8_t){lo.x, lo.y, lo.z, lo.w, hi.x, hi.y, hi.z, hi.w};
}
__device__ __forceinline__ float logsigmoidf_(float x) { return fminf(x, 0.f) - log1pf(__expf(-fabsf(x))); }

__device__ __forceinline__ void ml_gates(const Args& a, unsigned char* lds_g, int rowbase, int h, int tid) {
    const int lane = tid & 63, w = tid >> 6, dir = w >> 2, c = w & 3;
    const float* GT = (const float*)(a.ws + WS_GATES) + (size_t)(rowbase + 64 * c + lane) * 32;
    const float ipre = GT[(dir * 2) * 8 + h], fpre = GT[(dir * 2 + 1) * 8 + h];
    float bsum = logsigmoidf_(fpre);
    if (dir == 0) {
#pragma unroll
        for (int o = 1; o < 64; o <<= 1) { const float t = __shfl_up(bsum, o); if (lane >= o) bsum += t; }
    } else {
#pragma unroll
        for (int o = 1; o < 64; o <<= 1) { const float t = __shfl_down(bsum, o); if (lane + o < 64) bsum += t; }
    }
    float* eb = (float*)(lds_g + ML_EB); float* eu = (float*)(lds_g + ML_EU);
    eb[dir * 256 + 64 * c + lane] = __expf(bsum); eu[dir * 256 + 64 * c + lane] = __expf(ipre - bsum);
    const float bend = __shfl(bsum, dir ? 0 : 63);
    if (lane == 0) { ((float*)(lds_g + ML_EBEND))[dir * 4 + c] = __expf(bend); ((float*)(lds_g + ML_BEND))[dir * 4 + c] = bend; }
}

template <bool OUT, bool PASS2>
__device__ __forceinline__ void ml_block(const Args& a, unsigned char* lds_g, int rowbase, int h, int dir, f32x4 (&st)[9], int tid) {
    const int lane = tid & 63, w = __builtin_amdgcn_readfirstlane(tid >> 6), fr = lane & 15, fq = lane >> 4;
    bf16* Qi = (bf16*)(lds_g + ML_Q); bf16* Ki = (bf16*)(lds_g + ML_K); bf16* Vi = (bf16*)(lds_g + ML_V); bf16* AUGi = (bf16*)(lds_g + ML_AUG); bf16* CB = (bf16*)(lds_g + ML_CB);
    const float* eb = (const float*)(lds_g + ML_EB) + dir * 256; const float* eu = (const float*)(lds_g + ML_EU) + dir * 256;
    const float* ebend = (const float*)(lds_g + ML_EBEND) + dir * 4;
    float* den = (float*)(lds_g + ML_DEN); float* ssq = (float*)(lds_g + ML_SSQ);
    const bf16* Kb = (const bf16*)(a.ws + WS_K); const bf16* Vb = (const bf16*)(a.ws + WS_V); const bf16* Qb = (const bf16*)(a.ws + WS_Q);
    const int ti = w & 3, vh = w >> 2;
    float hgv[5];
    if (OUT) {
#pragma unroll
        for (int x = 0; x < 5; ++x) { const int vt = vh * 5 + x; hgv[x] = vt < 8 ? a.in[I_HEADG][h * 128 + 16 * vt + fr] : 0.f; } }
    for (int ci = 0; ci < 4; ++ci) {
        const int c = dir ? 3 - ci : ci;
        unsigned short ogv[5][4]; unsigned short tmv[5][4];
        if (OUT) {
            const bf16* OGp = (const bf16*)(a.ws + (dir ? WS_OB : WS_OF)); const bf16* TMp = (const bf16*)(a.ws + WS_TM);
#pragma unroll
            for (int r = 0; r < 4; ++r) { const size_t ob = (size_t)(rowbase - NCTX + 64 * c + 16 * ti + 4 * fq + r) * 1024 + h * 128;
#pragma unroll
                for (int x = 0; x < 5; ++x) { const int vt = vh * 5 + x; if (vt < 8) { ogv[x][r] = OGp[ob + 16 * vt + fr]; if (PASS2) tmv[x][r] = TMp[ob + 16 * vt + fr]; } } }
            __builtin_amdgcn_sched_barrier(0);
        }
        {
            const int t = tid >> 3, pc = tid & 7; const size_t row = (size_t)(rowbase + 64 * c + t);
            const v4u* ks = (const v4u*)(Kb + row * 1024 + h * 128 + 16 * pc); const v4u k0 = ks[0], k1 = ks[1];
            const v4u* vs = (const v4u*)(Vb + row * 1024 + h * 128 + 16 * pc); const v4u v0 = vs[0], v1 = vs[1];
            v4u q0, q1; if (OUT) { const v4u* qs = (const v4u*)(Qb + (row - NCTX) * 1024 + h * 128 + 16 * pc); q0 = qs[0]; q1 = qs[1]; }
            const float e = eu[64 * c + t];
            *(v4u*)(Ki + t * ML_STRIDE + 16 * pc) = k0; *(v4u*)(Ki + t * ML_STRIDE + 16 * pc + 8) = k1;
            if (OUT) { *(v4u*)(Qi + t * ML_STRIDE + 16 * pc) = q0; *(v4u*)(Qi + t * ML_STRIDE + 16 * pc + 8) = q1; }
            const unsigned vv[8] = {v0.x, v0.y, v0.z, v0.w, v1.x, v1.y, v1.z, v1.w}; unsigned o[8];
#pragma unroll
            for (int i = 0; i < 8; ++i) o[i] = pk2(bflo(vv[i]) * e, bfhi(vv[i]) * e);
            *(v4u*)(Vi + t * ML_STRIDE + 16 * pc) = (v4u){o[0], o[1], o[2], o[3]}; *(v4u*)(Vi + t * ML_STRIDE + 16 * pc + 8) = (v4u){o[4], o[5], o[6], o[7]};
            if (pc == 0) { *(v4u*)(AUGi + t * 16) = (v4u){f2bf(e), 0u, 0u, 0u}; *(v4u*)(AUGi + t * 16 + 8) = (v4u){0u, 0u, 0u, 0u}; }
        }
        WG_BAR();
        f32x4 X[5]; float hval[4][4];
        if (OUT) {
            bf16x8_t qf[4];
#pragma unroll
            for (int ks = 0; ks < 4; ++ks) qf[ks] = frag_row(Qi, 16 * ti, 32 * ks, fr, fq);
            bf16x8_t P[2]; bool pv[2];
#pragma unroll
            for (int pp = 0; pp < 2; ++pp) {
                f32x4 d[2];
#pragma unroll
                for (int hh = 0; hh < 2; ++hh) { const int si = 2 * pp + hh; d[hh] = (f32x4){0.f, 0.f, 0.f, 0.f};
                    const bool valid = dir ? (si >= ti) : (si <= ti);
                    if (valid) {
#pragma unroll
                        for (int ks = 0; ks < 4; ++ks) d[hh] = __builtin_amdgcn_mfma_f32_16x16x32_bf16(frag_row(Ki, 16 * si, 32 * ks, fr, fq), qf[ks], d[hh], 0, 0, 0);
                        if (si == ti) {
#pragma unroll
                            for (int r = 0; r < 4; ++r) { const bool keep = dir ? (4 * fq + r >= fr) : (4 * fq + r <= fr); d[hh][r] = keep ? d[hh][r] : 0.f; } } } }
                pv[pp] = dir ? (2 * pp + 1 >= ti) : (2 * pp <= ti);
                const unsigned p0 = pk2(d[0][0], d[0][1]), p1 = pk2(d[0][2], d[0][3]), p2 = pk2(d[1][0], d[1][1]), p3 = pk2(d[1][2], d[1][3]);
                P[pp] = __builtin_bit_cast(bf16x8_t, (v4u){p0, p1, p2, p3});
            }
#pragma unroll
            for (int x = 0; x < 5; ++x) { X[x] = (f32x4){0.f, 0.f, 0.f, 0.f};
                const int vt = vh * 5 + x;
                if (vt < 9) {
#pragma unroll
                    for (int pp = 0; pp < 2; ++pp) if (pv[pp]) {
                        const bf16x8_t bfv = vt < 8 ? frag_tr2(Vi, ML_STRIDE, 32 * pp, 32 * pp + 16, 16 * vt, lane) : frag_tr2(AUGi, 16, 32 * pp, 32 * pp + 16, 0, lane);
                        X[x] = __builtin_amdgcn_mfma_f32_16x16x32_bf16(P[pp], bfv, X[x], 0, 0, 0); }
#pragma unroll
                    for (int ks = 0; ks < 4; ++ks) X[x] = __builtin_amdgcn_mfma_f32_16x16x32_bf16(qf[ks], frag_row(CB, 16 * vt, 32 * ks, fr, fq), X[x], 0, 0, 0);
                } }
            if (vh == 1 && fr == 0) {
#pragma unroll
                for (int r = 0; r < 4; ++r) den[16 * ti + 4 * fq + r] = X[3][r] * eb[64 * c + 16 * ti + 4 * fq + r]; }
        }
        {
#pragma unroll
            for (int ks = 0; ks < 2; ++ks) { const bf16x8_t kf = frag_tr(Ki, ML_STRIDE, 32 * ks, 16 * w, lane);
#pragma unroll
                for (int vt = 0; vt < 8; ++vt) st[vt] = __builtin_amdgcn_mfma_f32_16x16x32_bf16(kf, frag_tr(Vi, ML_STRIDE, 32 * ks, 16 * vt, lane), st[vt], 0, 0, 0);
                st[8] = __builtin_amdgcn_mfma_f32_16x16x32_bf16(kf, frag_tr(AUGi, 16, 32 * ks, 0, lane), st[8], 0, 0, 0); }
            const float ee = ebend[c];
#pragma unroll
            for (int vt = 0; vt < 9; ++vt) st[vt] = st[vt] * ee;
        }
        WG_BAR();
        if (OUT) {
            float sq[4] = {0.f, 0.f, 0.f, 0.f};
#pragma unroll
            for (int r = 0; r < 4; ++r) { const int t = 16 * ti + 4 * fq + r; const float sc = eb[64 * c + t] * __builtin_amdgcn_rcpf(fmaxf(fabsf(den[t]), 1.f));
#pragma unroll
                for (int x = 0; x < 4; ++x) { const int vt = vh * 5 + x; const float hv = (vt < 8) ? X[x][r] * sc : 0.f; hval[x][r] = hv; sq[r] += hv * hv; }
                if (vh == 0) { const float hv = X[4][r] * sc; X[4][r] = hv; sq[r] += hv * hv; } }
#pragma unroll
            for (int r = 0; r < 4; ++r) { float v = sq[r]; v += __shfl_xor(v, 1); v += __shfl_xor(v, 2); v += __shfl_xor(v, 4); v += __shfl_xor(v, 8); if (fr == 0) ssq[vh * 64 + 16 * ti + 4 * fq + r] = v; }
#pragma unroll
            for (int vt = 0; vt < 9; ++vt) { pg8::u32x2 o; o.x = pk2(st[vt][0], st[vt][1]); o.y = pk2(st[vt][2], st[vt][3]); *(pg8::u32x2*)(CB + (16 * vt + fr) * ML_STRIDE + 16 * w + 4 * fq) = o; }
            WG_BAR();
            bf16* TM = (bf16*)(a.ws + WS_TM); bf16* YA = (bf16*)(a.ws + WS_YA);
#pragma unroll
            for (int r = 0; r < 4; ++r) { const int t = 16 * ti + 4 * fq + r; const float rs = __builtin_amdgcn_rsqf((ssq[t] + ssq[64 + t]) * (1.f / 128.f) + EPS);
                const size_t ob = (size_t)(rowbase - NCTX + 64 * c + t) * 1024 + h * 128;
#pragma unroll
                for (int x = 0; x < 5; ++x) { const int vt = vh * 5 + x; if (vt < 8) { const int v = 16 * vt + fr; const float hv = (x < 4) ? hval[x][r] : X[4][r];
                    float y = hv * rs * hgv[x] * bf2f(ogv[x][r]);
                    if (PASS2) { y += bf2f(tmv[x][r]); YA[ob + v] = (bf16)f2bf(y); } else TM[ob + v] = (bf16)f2bf(y); } } }
        }
    }
}

__device__ __forceinline__ void ml_state_quad(const Args& a, unsigned char* lds_g, int qu, int tid) {
    const int seq = qu >> 1, j0 = 4 * (qu & 1), dir = seq & 1, h = (seq >> 1) & 7, b = seq >> 4;
    const int lane = tid & 63, w = __builtin_amdgcn_readfirstlane(tid >> 6);
    f32x4 st[9];
#pragma unroll
    for (int vt = 0; vt < 9; ++vt) st[vt] = (f32x4){0.f, 0.f, 0.f, 0.f};
#pragma unroll 1
    for (int jj = 0; jj < 4; ++jj) {
        const int j = j0 + jj, su = seq * 8 + j;
        const int rowbase = j == 0 ? b * CTXL : NCTX + b * SEQ + 256 * (dir ? 8 - j : j - 1);
        ml_gates(a, lds_g, rowbase, h, tid);
        WG_BAR();
        ml_block<false, false>(a, lds_g, rowbase, h, dir, st, tid);
        pg8::u32x2* SL = (pg8::u32x2*)(a.ws + WS_SLOC) + ((size_t)(su * 8 + w) * 9) * 64 + lane;
#pragma unroll
        for (int vt = 0; vt < 9; ++vt) { pg8::u32x2 o; o.x = pk2(st[vt][0], st[vt][1]); o.y = pk2(st[vt][2], st[vt][3]); SL[vt * 64] = o; }
        if (tid == 0) { const float* bd = (const float*)(lds_g + ML_BEND) + dir * 4; ((float*)(a.ws + WS_BT))[su] = (bd[0] + bd[1]) + (bd[2] + bd[3]); }
        WG_BAR();
    }
}
__device__ __forceinline__ void ml_out_unit(const Args& a, unsigned char* lds_g, int u, int tid) {
    const int L = u & 7, h = (u >> 3) & 7, b = u >> 6;
    const int rowbase = NCTX + b * SEQ + 256 * L;
    const int lane = tid & 63, w = __builtin_amdgcn_readfirstlane(tid >> 6), fr = lane & 15, fq = lane >> 4;
    bf16* CB = (bf16*)(lds_g + ML_CB);
    ml_gates(a, lds_g, rowbase, h, tid);
    f32x4 st[9];
#pragma unroll
    for (int dir = 0; dir < 2; ++dir) {
        const int seq = (b * 8 + h) * 2 + dir, jmax = dir ? 7 - L : L;
        const float* BT = (const float*)(a.ws + WS_BT) + seq * 8;
        {
            const pg8::u32x2* SLa = (const pg8::u32x2*)(a.ws + WS_SLOC) + ((size_t)((seq * 8 + jmax) * 8 + w) * 9) * 64 + lane;
            const pg8::u32x2* SLb = (const pg8::u32x2*)(a.ws + WS_SLOC) + ((size_t)((seq * 8 + 3) * 8 + w) * 9) * 64 + lane;
            pg8::u32x2 sa[9];
            if (jmax >= 4) {
                pg8::u32x2 sb[9];
#pragma unroll
                for (int vt = 0; vt < 9; ++vt) { sa[vt] = SLa[vt * 64]; sb[vt] = SLb[vt * 64]; }
                float ls = 0.f;
#pragma unroll
                for (int q = 4; q < 8; ++q) ls += (q <= jmax) ? BT[q] : 0.f;
                const float coef = __expf(ls);
#pragma unroll
                for (int vt = 0; vt < 9; ++vt) st[vt] = (f32x4){bflo(sa[vt].x) + bflo(sb[vt].x) * coef, bfhi(sa[vt].x) + bfhi(sb[vt].x) * coef, bflo(sa[vt].y) + bflo(sb[vt].y) * coef, bfhi(sa[vt].y) + bfhi(sb[vt].y) * coef};
            } else {
#pragma unroll
                for (int vt = 0; vt < 9; ++vt) { sa[vt] = SLa[vt * 64]; st[vt] = (f32x4){bflo(sa[vt].x), bfhi(sa[vt].x), bflo(sa[vt].y), bfhi(sa[vt].y)}; }
            }
        }
#pragma unroll
        for (int vt = 0; vt < 9; ++vt) { pg8::u32x2 o; o.x = pk2(st[vt][0], st[vt][1]); o.y = pk2(st[vt][2], st[vt][3]); *(pg8::u32x2*)(CB + (16 * vt + fr) * ML_STRIDE + 16 * w + 4 * fq) = o; }
        WG_BAR();
        if (dir == 0) ml_block<true, false>(a, lds_g, rowbase, h, 0, st, tid);
        else ml_block<true, true>(a, lds_g, rowbase, h, 1, st, tid);
        asm volatile("s_waitcnt vmcnt(0)" ::: "memory");
        WG_BAR();
    }
}

__device__ __forceinline__ void lru_out_unit(const Args& a, unsigned char* lds_g, int b, int cidx, int blk, int tid) {
    const int chl = tid & 127, q = tid >> 7, ch = blk * 128 + chl;
    float2* QA = (float2*)lds_g;
    float av[2][16], bv[2][16];
#pragma unroll
    for (int d = 0; d < 2; ++d) { const unsigned* PS = (const unsigned*)(a.ws + WS_PS) + ((size_t)(b * 2 + d) * NSTEP + 64 * cidx + 16 * q) * 1024 + ch;
#pragma unroll
        for (int i = 0; i < 16; ++i) { const unsigned wv = PS[(size_t)i * 1024]; av[d][i] = 1.f - bflo(wv); bv[d][i] = bfhi(wv); } }
    float2* CA = (float2*)(lds_g + 8192);
#pragma unroll
    for (int d = 0; d < 2; ++d) { const float2* AGG = (const float2*)(a.ws + WS_AGG) + ((size_t)(b * 2 + d) * 36) * 1024 + ch; float2 qv[9];
#pragma unroll
        for (int i = 0; i < 9; ++i) { const int sidx = 9 * q + i; const int c2 = d ? (sidx < 4 ? 3 - sidx : 39 - sidx) : sidx; qv[i] = AGG[(size_t)c2 * 1024]; }
        float P = 1.f, S = 0.f;
#pragma unroll
        for (int i = 0; i < 9; ++i) { const int sidx = 9 * q + i; const int c2 = d ? (sidx < 4 ? 3 - sidx : 39 - sidx) : sidx; const bool use = d ? (sidx < 4 || c2 > cidx) : (c2 < cidx);
            S = use ? qv[i].x * S + qv[i].y : S; P = use ? qv[i].x * P : P; }
        CA[(d * 4 + q) * 128 + chl] = make_float2(P, S); }
#pragma unroll
    for (int d = 0; d < 2; ++d) { float P = 1.f, S = 0.f;
#pragma unroll
        for (int ii = 0; ii < 16; ++ii) { const int i = d ? 15 - ii : ii; S = av[d][i] * S + bv[d][i]; P = av[d][i] * P; }
        QA[(d * 4 + q) * 128 + chl] = make_float2(P, S); }
    WG_BAR();
    float hs[16];
#pragma unroll
    for (int d = 0; d < 2; ++d) { float h = 0.f;
#pragma unroll
        for (int k = 0; k < 4; ++k) { const float2 t = CA[(d * 4 + k) * 128 + chl]; h = t.x * h + t.y; }
#pragma unroll
        for (int k = 0; k < 3; ++k) { const int qq = d ? 3 - k : k; const bool use = d ? (qq > q) : (qq < q); const float2 t = QA[(d * 4 + qq) * 128 + chl]; h = use ? t.x * h + t.y : h; }
#pragma unroll
        for (int ii = 0; ii < 16; ++ii) { const int i = d ? 15 - ii : ii; h = av[d][i] * h + bv[d][i]; if (d == 0) hs[i] = h; else hs[i] += h; } }
    const int p0 = (cidx - 4) * 64 + 16 * q;
    unsigned short ugv[16];
#pragma unroll
    for (int i = 0; i < 16; ++i) ugv[i] = ((const bf16*)(a.ws + WS_UG))[(size_t)(lru_pos_row(b, false, p0 + i) - NCTX) * 1024 + ch];
#pragma unroll
    for (int i = 0; i < 16; ++i) { const size_t lrow = (size_t)(lru_pos_row(b, false, p0 + i) - NCTX) * 1024 + ch;
        ((bf16*)(a.ws + WS_YB))[lrow] = (bf16)f2bf(hs[i] * bf2f(ugv[i])); }
    WG_BAR();
}
__device__ __forceinline__ void phase3(const Args& a, unsigned char* lds_g, int tid) {
    {
        int q0 = (int)blockIdx.x, qstep = (int)gridDim.x;
        if (gridDim.x == 256) q0 = blockIdx.x >= 128 ? (int)blockIdx.x - 128 : 128;
        for (int qu = q0; qu < 128; qu += qstep) ml_state_quad(a, lds_g, qu, tid);
    }
    for (int u = blockIdx.x; u < 4 * 36 * 8; u += gridDim.x) { const int blk = u & 7, q = u >> 3; lru_unit<false>(a, lds_g, q / 36, q % 36, blk, tid); }
}

struct SchedProj {
    int G, c; const char *YA, *YB, *WA, *WB;
    __device__ __forceinline__ bool next(int i, pg8::Unit& u) const {
        const int tile = (i >> 1) * G + c, part = i & 1; if (tile >= 256) return false;
        int pm, pn; pg8::tile_order(tile, 32, 8, pm, pn);
        u.pm = pm; u.pn = pn; u.aux = part; u.A = (part ? YB : YA) + (size_t)pm * 256 * 1024 * 2; u.B = (part ? WB : WA) + (size_t)pn * 256 * 1024 * 2; return true;
    }
};
struct EpiProj {
    static constexpr bool PERM = true, CARRY = true;
    const bf16 *GA, *GB; bf16* PRE;
    __device__ __forceinline__ bool keep(const pg8::Unit& u) const { return u.aux == 0; }
    __device__ __forceinline__ void operator()(pg8::f32x4 (&acc)[2][2][4][2], const pg8::Unit& u, int wr, int wc, int fr, int fq) const {
#pragma unroll
        for (int ai = 0; ai < 2; ++ai) {
            pg8::u32x4 gb4[4][2], ga4[4][2];
#pragma unroll
            for (int m = 0; m < 4; ++m) { const size_t off = (size_t)(u.pm * 256 + ai * 128 + wr * 64 + m * 16 + fr) * 2048 + u.pn * 256 + wc * 32 + 8 * fq;
#pragma unroll
                for (int bj = 0; bj < 2; ++bj) { gb4[m][bj] = *(const pg8::u32x4*)(GB + off + bj * 128); if (u.aux == 0) ga4[m][bj] = *(const pg8::u32x4*)(GA + off + bj * 128); } }
#pragma unroll
            for (int m = 0; m < 4; ++m) { const size_t off = (size_t)(u.pm * 256 + ai * 128 + wr * 64 + m * 16 + fr) * 2048 + u.pn * 256 + wc * 32 + 8 * fq;
#pragma unroll
                for (int bj = 0; bj < 2; ++bj) { const pg8::u32x4 g4 = gb4[m][bj];
                    const float gbv[8] = {bflo(g4.x), bfhi(g4.x), bflo(g4.y), bfhi(g4.y), bflo(g4.z), bfhi(g4.z), bflo(g4.w), bfhi(g4.w)};
                    if (u.aux == 0) { const pg8::u32x4 a4 = ga4[m][bj];
                        const float gav[8] = {bflo(a4.x), bfhi(a4.x), bflo(a4.y), bfhi(a4.y), bflo(a4.z), bfhi(a4.z), bflo(a4.w), bfhi(a4.w)};
#pragma unroll
                        for (int e = 0; e < 4; ++e) { acc[ai][bj][m][0][e] *= gav[e] * __builtin_amdgcn_rcpf(fmaxf(gbv[e], 1e-20f)); acc[ai][bj][m][1][e] *= gav[4 + e] * __builtin_amdgcn_rcpf(fmaxf(gbv[4 + e], 1e-20f)); }
                    } else {
                        pg8::f32x4 v0 = acc[ai][bj][m][0], v1 = acc[ai][bj][m][1];
#pragma unroll
                        for (int e = 0; e < 4; ++e) { v0[e] *= gbv[e]; v1[e] *= gbv[4 + e]; }
                        pg8::u32x4 w; w.x = pg8::cvt_pk_bf16(v0[0], v0[1]); w.y = pg8::cvt_pk_bf16(v0[2], v0[3]); w.z = pg8::cvt_pk_bf16(v1[0], v1[1]); w.w = pg8::cvt_pk_bf16(v1[2], v1[3]);
                        *(pg8::u32x4*)(PRE + off + bj * 128) = w; } } }
        }
    }
};

struct SchedOut {
    int G, c; const char *A, *B;
    __device__ __forceinline__ bool next(int i, pg8::Unit& u) const {
        const int L = i * G + c; if (L >= 256) return false;
        int pm, pn; pg8::tile_order(L, 32, 8, pm, pn);
        u.pm = pm; u.pn = pn; u.aux = 0; u.A = A + (size_t)pm * 256 * D * 2; u.B = B + (size_t)pn * 256 * D * 2; return true;
    }
};
struct EpiOut {
    static constexpr bool PERM = true, CARRY = false;
    __device__ __forceinline__ bool keep(const pg8::Unit&) const { return false; }
    const float* x; const float* MOD; bf16* X1;
    __device__ __forceinline__ void operator()(const pg8::f32x4 (&acc)[2][2][4][2], const pg8::Unit& u, int wr, int wc, int fr, int fq) const {
        const int b = u.pm >> 3; const int col0 = u.pn * 256 + wc * 32 + 8 * fq;
        pg8::f32x4 g1[2][2];
#pragma unroll
        for (int bj = 0; bj < 2; ++bj)
#pragma unroll
            for (int n = 0; n < 2; ++n) g1[bj][n] = *(const pg8::f32x4*)(MOD + b * 12288 + 2 * 2048 + col0 + bj * 128 + n * 4);
#pragma unroll
        for (int ai = 0; ai < 2; ++ai) {
            pg8::f32x4 xv[4][2][2];
#pragma unroll
            for (int m = 0; m < 4; ++m) { const size_t off = (size_t)(u.pm * 256 + ai * 128 + wr * 64 + m * 16 + fr) * D + col0;
#pragma unroll
                for (int bj = 0; bj < 2; ++bj)
#pragma unroll
                    for (int n = 0; n < 2; ++n) xv[m][bj][n] = *(const pg8::f32x4*)(x + off + bj * 128 + n * 4); }
#pragma unroll
            for (int m = 0; m < 4; ++m) { const size_t off = (size_t)(u.pm * 256 + ai * 128 + wr * 64 + m * 16 + fr) * D + col0;
#pragma unroll
                for (int bj = 0; bj < 2; ++bj) { const pg8::f32x4 v0 = xv[m][bj][0] + g1[bj][0] * acc[ai][bj][m][0], v1 = xv[m][bj][1] + g1[bj][1] * acc[ai][bj][m][1];
                    pg8::u32x4 w; w.x = pg8::cvt_pk_bf16(v0[0], v0[1]); w.y = pg8::cvt_pk_bf16(v0[2], v0[3]); w.z = pg8::cvt_pk_bf16(v1[0], v1[1]); w.w = pg8::cvt_pk_bf16(v1[2], v1[3]);
                    *(pg8::u32x4*)(X1 + off + bj * 128) = w; } }
        }
    }
};

__device__ __forceinline__ void phase_router(const Args& a, unsigned char* lds_g, int tid, int lane, int wave) {
    const bf16* X1 = (const bf16*)(a.ws + WS_X1); const float* MOD = (const float*)(a.ws + WS_MOD); const float* g = a.in[I_N2G];
    const float* WR = (const float*)(a.ws + WS_WR); const float* RB = (const float*)(a.ws + WS_RB);
    bf16* H2 = (bf16*)(a.ws + WS_H2); unsigned* cnt = (unsigned*)(a.ws + WS_CTL) + CW_CNT; int4* ASG = (int4*)(a.ws + WS_ASG);
    f32x4* PART = (f32x4*)lds_g;
    float* SSQP = (float*)(lds_g + 24576);
    float* RS = (float*)(lds_g + 24576 + 512);
    float* LG = (float*)(lds_g + 24576 + 1024);
    const int slot = wave >> 2, kq = wave & 3, i = lane & 15, gq = lane >> 4;
    for (int tp = blockIdx.x; tp < NLAT / 32; tp += gridDim.x) {
        const int tok0 = 32 * tp + 16 * slot, b = tok0 >> 11, kbase = kq * 512 + 8 * gq;
        const bf16* xr = X1 + (size_t)(tok0 + i) * D + kbase;
        const float* wr = WR + ((size_t)(b * 48 + i) * 2048 + kbase);
        f32x4 acc0 = (f32x4){0.f, 0.f, 0.f, 0.f}, acc1 = acc0, acc2 = acc0; float sq = 0.f;
#pragma unroll 2
        for (int s8 = 0; s8 < 16; ++s8) {
            const v4u xb = *(const v4u*)(xr + 32 * s8);
            const f32x4 b0a = *(const f32x4*)(wr + 32 * s8), b0b = *(const f32x4*)(wr + 32 * s8 + 4), b1a = *(const f32x4*)(wr + 16 * 2048 + 32 * s8), b1b = *(const f32x4*)(wr + 16 * 2048 + 32 * s8 + 4),
                        b2a = *(const f32x4*)(wr + 32 * 2048 + 32 * s8), b2b = *(const f32x4*)(wr + 32 * 2048 + 32 * s8 + 4);
            const float xe[8] = {bflo(xb.x), bfhi(xb.x), bflo(xb.y), bfhi(xb.y), bflo(xb.z), bfhi(xb.z), bflo(xb.w), bfhi(xb.w)};
#pragma unroll
            for (int e = 0; e < 4; ++e) { acc0 = __builtin_amdgcn_mfma_f32_16x16x4f32(xe[e], b0a[e], acc0, 0, 0, 0); acc1 = __builtin_amdgcn_mfma_f32_16x16x4f32(xe[e], b1a[e], acc1, 0, 0, 0); acc2 = __builtin_amdgcn_mfma_f32_16x16x4f32(xe[e], b2a[e], acc2, 0, 0, 0); }
#pragma unroll
            for (int e = 0; e < 4; ++e) { acc0 = __builtin_amdgcn_mfma_f32_16x16x4f32(xe[4 + e], b0b[e], acc0, 0, 0, 0); acc1 = __builtin_amdgcn_mfma_f32_16x16x4f32(xe[4 + e], b1b[e], acc1, 0, 0, 0); acc2 = __builtin_amdgcn_mfma_f32_16x16x4f32(xe[4 + e], b2b[e], acc2, 0, 0, 0); }
#pragma unroll
            for (int e = 0; e < 8; ++e) sq += xe[e] * xe[e];
        }
        sq += __shfl_xor(sq, 16); sq += __shfl_xor(sq, 32);
        PART[((slot * 4 + kq) * 3 + 0) * 64 + lane] = acc0; PART[((slot * 4 + kq) * 3 + 1) * 64 + lane] = acc1; PART[((slot * 4 + kq) * 3 + 2) * 64 + lane] = acc2;
        if (gq == 0) SSQP[(slot * 4 + kq) * 16 + i] = sq;
        __syncthreads();
        if (kq == 0) {
            const float* sp = SSQP + slot * 64; const float rstd = 1.f / sqrtf(((sp[i] + sp[16 + i]) + (sp[32 + i] + sp[48 + i])) * (1.f / D) + EPS);
            if (gq == 0) RS[slot * 16 + i] = rstd;
#pragma unroll
            for (int cb = 0; cb < 3; ++cb) { const f32x4* pp = PART + (slot * 4 * 3 + cb) * 64 + lane; const f32x4 sum = (pp[0] + pp[3 * 64]) + (pp[6 * 64] + pp[9 * 64]);
                const float rb = RB[b * 48 + 16 * cb + i];
#pragma unroll
                for (int r = 0; r < 4; ++r) LG[(slot * 16 + 4 * gq + r) * 48 + 16 * cb + i] = __shfl(rstd, 4 * gq + r) * sum[r] + rb; }
            LDS_WAIT(); asm volatile("" ::: "memory");
            if (lane < 16) {
                const float* lg = LG + (slot * 16 + lane) * 48; const int t = tok0 + lane;
                int gs = 0; float gm = lg[32];
#pragma unroll
                for (int q = 1; q < 4; ++q) { const float v = lg[32 + q]; if (v > gm) { gm = v; gs = q; } }
                float se = 0.f;
#pragma unroll
                for (int q = 0; q < 4; ++q) se += __expf(lg[32 + q] - gm);
                const float pg = 1.f / se;
                int i0 = 0; float v0 = lg[gs * 8];
#pragma unroll
                for (int q = 1; q < 8; ++q) { const float v = lg[gs * 8 + q]; if (v > v0) { v0 = v; i0 = q; } }
                int i1 = -1; float v1 = -3.0e38f;
#pragma unroll
                for (int q = 0; q < 8; ++q) { const float v = lg[gs * 8 + q]; if (q != i0 && v > v1) { v1 = v; i1 = q; } }
                const float e1 = __expf(v1 - v0), w0 = pg / (1.f + e1), w1 = pg * e1 / (1.f + e1);
                const int ex0 = gs * 8 + i0, ex1 = gs * 8 + i1;
                const unsigned p0 = atomicAdd(cnt + ex0, 1u), p1 = atomicAdd(cnt + ex1, 1u);
                ASG[2 * t] = make_int4(ex0, (int)p0, __float_as_int(w0), 0); ASG[2 * t + 1] = make_int4(ex1, (int)p1, __float_as_int(w1), 0);
                int* LIST = (int*)(a.ws + WS_LIST); LIST[ex0 * 8192 + (int)p0] = t; LIST[ex1 * 8192 + (int)p1] = t;
            }
        }
        __syncthreads();
#pragma unroll
        for (int r = 0; r < 4; ++r) { const int tl = 4 * kq + r, t = tok0 + tl; const float rstd = RS[slot * 16 + tl];
            const unsigned long long* xrow = (const unsigned long long*)(X1 + (size_t)t * D) + lane; unsigned* o4 = (unsigned*)((unsigned char*)H2 + (size_t)t * D) + lane;
            f32x4 yv[8];
#pragma unroll
            for (int j = 0; j < 8; ++j) { const int c = 4 * lane + 256 * j;
                const f32x4 gg = *(const f32x4*)(g + c), sh = *(const f32x4*)(MOD + b * 12288 + 3 * 2048 + c), sc = *(const f32x4*)(MOD + b * 12288 + 4 * 2048 + c);
                const unsigned long long xw = xrow[64 * j]; const f32x4 xv4 = (f32x4){bflo((unsigned)xw), bfhi((unsigned)xw), bflo((unsigned)(xw >> 32)), bfhi((unsigned)(xw >> 32))};
                yv[j] = xv4 * rstd * gg * (sc + 1.f) + sh; }
#pragma unroll
            for (int j = 0; j < 8; ++j) { int w8 = __builtin_amdgcn_cvt_pk_fp8_f32(yv[j].x, yv[j].y, 0, false); w8 = __builtin_amdgcn_cvt_pk_fp8_f32(yv[j].z, yv[j].w, w8, true); o4[64 * j] = (unsigned)w8; } }
        __syncthreads();
    }
}

constexpr int MG_A = 0, MG_ABYTES = 32768, MG_B = 65536, MG_BBYTES = 64 * 256  , MG_CUM = 141312  ;
__device__ __forceinline__ int mgb_off(int row, int ch) { return 256 * row + 16 * (ch ^ (((row & 3) << 2) | ((row >> 2) & 3))); }
__device__ __forceinline__ bf16x8_t mgb_frag(const unsigned char* img, int ks, int c, int lane) {
    const int g = lane >> 4, q = (lane & 15) >> 2, p = lane & 3;
    const s4_t lo = ds_tr((const bf16*)(img + mgb_off(32 * ks + 8 * g + q, 2 * c + (p >> 1)) + 8 * (p & 1)));
    const s4_t hi = ds_tr((const bf16*)(img + mgb_off(32 * ks + 8 * g + 4 + q, 2 * c + (p >> 1)) + 8 * (p & 1)));
    return (bf16x8_t){lo.x, lo.y, lo.z, lo.w, hi.x, hi.y, hi.z, hi.w};
}
__device__ __forceinline__ void moe_tables(const Args& a, unsigned char* lds_g, int tid) {
    int* cum = (int*)(lds_g + MG_CUM); const unsigned* ctl = (const unsigned*)(a.ws + WS_CTL);
    if (tid < NEXP) cum[128 + tid] = (int)ctl[CW_CNT + tid];
    if (tid == 0) { int c = 0; for (int e = 0; e < NEXP; ++e) { cum[e] = c; c += (int)((ctl[CW_CNT + e] + 255u) >> 8); } cum[NEXP] = c; }
    __syncthreads();
}
constexpr int MH_A = 0, MH_ABYTES = 32768, MH_B = 65536, MH_BROW = 528, MH_BBYTES = 64 * MH_BROW  ;
__device__ __forceinline__ int mhb_off(int row, int ch) { return MH_BROW * row + 16 * ch; }
__device__ __forceinline__ bf16x8_t mhb_frag(const LAS unsigned char* lbase, int cofs) {
    const s4_t lo = __builtin_amdgcn_ds_read_tr16_b64_v4i16((LAS s4_t*)(lbase + cofs));
    const s4_t hi = __builtin_amdgcn_ds_read_tr16_b64_v4i16((LAS s4_t*)(lbase + cofs + 4 * MH_BROW));
    return (bf16x8_t){lo.x, lo.y, lo.z, lo.w, hi.x, hi.y, hi.z, hi.w};
}
__device__ __forceinline__ int fresh_lane() { int l; asm volatile("v_mbcnt_lo_u32_b32 %0, -1, 0\n\tv_mbcnt_hi_u32_b32 %0, -1, %0" : "=v"(l)); __builtin_assume(l >= 0 && l < 64); return l; }
__device__ __forceinline__ int moe_pull(const Args& a, unsigned char* lds_g, int w, int x) {
    int* slot = (int*)(lds_g + MG_CUM + 256);
    __syncthreads();
    if (w == 0 && fresh_lane() == 0) *slot = (int)__hip_atomic_fetch_add((unsigned*)(a.ws + WS_CTL) + CW_Q + 64 * x, 1u, __ATOMIC_RELAXED, __HIP_MEMORY_SCOPE_AGENT);
    __syncthreads();
    return __builtin_amdgcn_readfirstlane(*slot);
}
__device__ __forceinline__ unsigned f8pair_lo(unsigned w) { const auto v = __builtin_amdgcn_cvt_pk_f32_fp8((int)w, false); return pk2(v[0], v[1]); }
__device__ __forceinline__ unsigned f8pair_hi(unsigned w) { const auto v = __builtin_amdgcn_cvt_pk_f32_fp8((int)w, true); return pk2(v[0], v[1]); }
template <int MODE>
__device__ __forceinline__ int moe_gemm(const Args& a, unsigned char* lds_g, int tid, int idx0) {
    constexpr int K = MODE == 1 ? D : DE, NT = K / 64;
#define MG_BAR() do { asm volatile("s_waitcnt lgkmcnt(0)" ::: "memory"); __builtin_amdgcn_s_barrier(); asm volatile("" ::: "memory"); } while (0)
    const int w = __builtin_amdgcn_readfirstlane(tid >> 6);
    const int wm = w >> 1, wn = w & 1, hh = wm >> 1, wr = wm & 1;
    const int* cum = (const int*)(lds_g + MG_CUM); const unsigned* ctl = (const unsigned*)(a.ws + WS_CTL);
    const int T = cum[NEXP], x = blockIdx.x & 7;
    for (int idx = idx0;;) {
        if (idx < 0) idx = moe_pull(a, lds_g, w, x);
        if (idx >= (MODE == 1 ? T : 2 * T)) return idx;
        const int ti = MODE == 1 ? idx : idx - T;
        idx = -1;
        const int nt = x;
        if (MODE == 2) {
            if (w == 0) { unsigned* tc = (unsigned*)(a.ws + WS_CTL) + CW_TC + 64 * ti; unsigned spins = 0;
                while ((unsigned)__builtin_amdgcn_readfirstlane(__hip_atomic_load(tc, __ATOMIC_RELAXED, __HIP_MEMORY_SCOPE_AGENT)) < 64u) {
                    __builtin_amdgcn_s_sleep(2);
                    if (++spins > (1u << 22)) { if (fresh_lane() == 0) __hip_atomic_store((unsigned*)(a.ws + WS_CTL) + 1, 0x900u + (unsigned)ti, __ATOMIC_RELAXED, __HIP_MEMORY_SCOPE_AGENT); break; } }
                __builtin_amdgcn_fence(__ATOMIC_ACQUIRE, "agent");
                asm volatile("s_waitcnt vmcnt(0)" ::: "memory"); }
            __syncthreads();
        }
        const int lane = fresh_lane(), tidu = w * 64 + lane, fr = lane & 15, fq = lane >> 4;
        const int aoff = pg8::lds_byte(wr * 64 + fr, fq * 8);
        const int bk = w, bp = lane;
        int aR[2], aC[2];
#pragma unroll
        for (int i = 0; i < 2; ++i) pg8::stage_rc(tidu * 16 + i * 8192, aR[i], aC[i]);
        int e = 0;
#pragma unroll 1
        for (int q = 1; q < NEXP; ++q) e = (cum[q] <= ti) ? q : e;
        e = __builtin_amdgcn_readfirstlane(e);
        const int mt = __builtin_amdgcn_readfirstlane(ti - cum[e]);
        unsigned aofs[4]; unsigned bofs; int bwr0;
        __amdgpu_buffer_rsrc_t rsA, rsB, rsB3;
        if (MODE == 1) { const int cnt = cum[128 + e];
#pragma unroll
            for (int q = 0; q < 2; ++q) { const int pos = 256 * mt + 128 * q + (tidu >> 2); const int tok = pos < cnt ? ((const int*)(a.ws + WS_LIST))[e * 8192 + pos] : 0;
                aofs[q] = (unsigned)(tok * D + 16 * (tidu & 3)); }
            aofs[2] = aofs[3] = 0u;
            rsA = __builtin_amdgcn_make_buffer_rsrc((void*)(a.ws + WS_H2), 0, 0x7fffffff, 0x00020000);
            rsB = __builtin_amdgcn_make_buffer_rsrc((void*)(a.in[I_W1] + (size_t)e * D * DE), 0, 0x7fffffff, 0x00020000); rsB3 = __builtin_amdgcn_make_buffer_rsrc((void*)(a.in[I_W3] + (size_t)e * D * DE), 0, 0x7fffffff, 0x00020000);
            bofs = (unsigned)((bk + 8 * (bp >> 5)) * DE + 128 * nt + 4 * (bp & 31)) * 4u;
            bwr0 = MH_BROW * (bk + 8 * (bp >> 5)) + 2 * (128 * ((bp & 31) >> 4) + 4 * (bp & 15)); }
        else {
#pragma unroll
            for (int q = 0; q < 4; ++q) aofs[q] = (unsigned)((128 * (q >> 1) + aR[q & 1]) * DE + aC[q & 1]) * 2u;
            rsA = __builtin_amdgcn_make_buffer_rsrc((void*)((const bf16*)(a.ws + WS_HM) + (size_t)256 * ti * DE), 0, 0x7fffffff, 0x00020000);
            rsB = __builtin_amdgcn_make_buffer_rsrc((void*)(a.in[I_W2] + (size_t)e * DE * D), 0, 0x7fffffff, 0x00020000); rsB3 = rsB;
            bofs = (unsigned)(bk * D + 256 * nt + 4 * bp) * 4u; bwr0 = mhb_off(bk, bp >> 1) + 8 * (bp & 1); }
        const LAS unsigned char* blane = (const LAS unsigned char*)lds_g + MH_B + mhb_off(8 * (lane >> 4) + ((lane & 15) >> 2), 16 * wn + ((lane & 3) >> 1)) + 8 * (lane & 1);
        f32x4 acc[4][8];
#pragma unroll
        for (int m = 0; m < 4; ++m)
#pragma unroll
            for (int n = 0; n < 8; ++n) acc[m][n] = (f32x4){0.f, 0.f, 0.f, 0.f};
        v4u ra[4]; f32x4 rb[8];
#define MH_LD(t_) do { _Pragma("unroll") for (int j_ = 0; j_ < 4; ++j_) ra[j_] = __builtin_amdgcn_raw_buffer_load_b128(rsA, aofs[j_], 128 * (t_), 0); \
        _Pragma("unroll") for (int j_ = 0; j_ < 8; ++j_) rb[j_] = __builtin_bit_cast(f32x4, __builtin_amdgcn_raw_buffer_load_b128(rsB, bofs, (64 * (t_) + 8 * j_) * D * 4, 0)); } while (0)
#define MH_ST(buf_) do { _Pragma("unroll") for (int j_ = 0; j_ < 4; ++j_) *(v4u*)(lds_g + MH_A + (buf_) * MH_ABYTES + (j_ >> 1) * 16384 + (j_ & 1) * 8192 + tidu * 16) = ra[j_]; \
        _Pragma("unroll") for (int j_ = 0; j_ < 8; ++j_) { pg8::u32x2 o_; o_.x = pk2(rb[j_].x, rb[j_].y); o_.y = pk2(rb[j_].z, rb[j_].w); *(pg8::u32x2*)(lds_g + MH_B + (buf_) * MH_BBYTES + bwr0 + j_ * 8 * MH_BROW) = o_; } } while (0)
#define MH_MMA(buf_) do { const LAS unsigned char* Bi_ = blane + (buf_) * MH_BBYTES; \
        bf16x8_t bc0_ = mhb_frag(Bi_, 0), bc1_ = mhb_frag(Bi_, 32); \
        _Pragma("unroll") for (int ks_ = 0; ks_ < 2; ++ks_) { bf16x8_t af_[4]; \
            _Pragma("unroll") for (int m_ = 0; m_ < 4; ++m_) af_[m_] = *(const bf16x8_t*)(lds_g + MH_A + (buf_) * MH_ABYTES + hh * 16384 + aoff + m_ * 2048 + ks_ * 1024); \
            _Pragma("unroll") for (int n_ = 0; n_ < 8; n_ += 2) { bf16x8_t bn0_ = bc0_, bn1_ = bc1_; \
                if (n_ + 2 < 8) { bn0_ = mhb_frag(Bi_, 32 * ks_ * MH_BROW + 32 * (n_ + 2)); bn1_ = mhb_frag(Bi_, 32 * ks_ * MH_BROW + 32 * (n_ + 3)); } \
                else if (ks_ == 0) { bn0_ = mhb_frag(Bi_, 32 * MH_BROW); bn1_ = mhb_frag(Bi_, 32 * MH_BROW + 32); } \
                __builtin_amdgcn_sched_barrier(0); \
                _Pragma("unroll") for (int m_ = 0; m_ < 4; ++m_) { acc[m_][n_] = __builtin_amdgcn_mfma_f32_16x16x32_bf16(bc0_, af_[m_], acc[m_][n_], 0, 0, 0); \
                    acc[m_][n_ + 1] = __builtin_amdgcn_mfma_f32_16x16x32_bf16(bc1_, af_[m_], acc[m_][n_ + 1], 0, 0, 0); } \
                __builtin_amdgcn_sched_barrier(0); bc0_ = bn0_; bc1_ = bn1_; } } } while (0)
        if (MODE == 1) {
            const int awr = pg8::lds_byte(tidu >> 2, 16 * (tidu & 3));
#define MH_LDB(t_) do { _Pragma("unroll") for (int j_ = 0; j_ < 8; ++j_) rb[j_] = __builtin_bit_cast(f32x4, __builtin_amdgcn_raw_buffer_load_b128((j_ & 1) ? rsB3 : rsB, bofs, (64 * (t_) + 16 * (j_ >> 1)) * DE * 4, 0)); } while (0)
#define MH_LDA(te_, to_) do { ra[0] = __builtin_amdgcn_raw_buffer_load_b128(rsA, aofs[0], 64 * (te_), 0); ra[1] = __builtin_amdgcn_raw_buffer_load_b128(rsA, aofs[1], 64 * (te_), 0); \
            ra[2] = __builtin_amdgcn_raw_buffer_load_b128(rsA, aofs[0], 64 * (to_), 0); ra[3] = __builtin_amdgcn_raw_buffer_load_b128(rsA, aofs[1], 64 * (to_), 0); } while (0)
#define MH_F8(w_) f8pair_lo(w_), f8pair_hi(w_)
#define MH_STA(buf_, x_) do { _Pragma("unroll") for (int h_ = 0; h_ < 2; ++h_) { const v4u p_ = ra[(x_) + h_]; \
            *(v4u*)(lds_g + MH_A + (buf_) * MH_ABYTES + h_ * 16384 + awr) = (v4u){MH_F8(p_.x), MH_F8(p_.y)}; __builtin_amdgcn_sched_barrier(0); \
            *(v4u*)(lds_g + MH_A + (buf_) * MH_ABYTES + h_ * 16384 + awr + 16) = (v4u){MH_F8(p_.z), MH_F8(p_.w)}; __builtin_amdgcn_sched_barrier(0); } } while (0)
#define MH_STB(buf_) do { _Pragma("unroll") for (int j_ = 0; j_ < 8; ++j_) { pg8::u32x2 o_; o_.x = pk2(rb[j_].x, rb[j_].y); o_.y = pk2(rb[j_].z, rb[j_].w); *(pg8::u32x2*)(lds_g + MH_B + (buf_) * MH_BBYTES + bwr0 + (j_ >> 1) * 16 * MH_BROW + (j_ & 1) * 128) = o_; } } while (0)
            MH_LDA(0, 1); MH_LDB(0);
            MG_BAR();
            MH_STA(0, 0); MH_STB(0);
            MH_LDB(1);
            for (int t = 0; t < NT; t += 2) {
                const int t2 = (t + 2 < NT) ? t + 2 : NT - 1, t3 = (t + 3 < NT) ? t + 3 : NT - 1;
                MG_BAR();
                MH_STA(1, 2); MH_STB(1);
                MH_LDA(t2, t3); MH_LDB(t2);
                MH_MMA(0);
                MG_BAR();
                MH_STA(0, 0); MH_STB(0);
                MH_LDB(t3);
                MH_MMA(1);
            }
#undef MH_LDB
#undef MH_LDA
#undef MH_F8
#undef MH_STA
#undef MH_STB
        } else {
        MH_LD(0);
            MG_BAR();
            MH_ST(0);
            MH_LD(1);
            for (int t = 0; t < NT; t += 2) {
                const int t2 = (t + 2 < NT) ? t + 2 : NT - 1, t3 = (t + 3 < NT) ? t + 3 : NT - 1;
                MG_BAR();
                MH_ST(1);
                MH_LD(t2);
                MH_MMA(0);
                MG_BAR();
                MH_ST(0);
                MH_LD(t3);
                MH_MMA(1);
            }
        }
#undef MH_LD
#undef MH_ST
#undef MH_MMA
        const int ln_ = fresh_lane();
        const int efr = ln_ & 15, efq = ln_ >> 4;
        if (MODE == 1) { bf16* HM = (bf16*)(a.ws + WS_HM) + (size_t)256 * ti * DE + 128 * nt + 64 * wn; const unsigned lo_ = (unsigned)((128 * hh + 64 * wr + efr) * DE + 4 * efq);
#pragma unroll
            for (int m = 0; m < 4; ++m)
#pragma unroll
                for (int n = 0; n < 4; ++n) { float hv[4];
#pragma unroll
                    for (int r = 0; r < 4; ++r) { const float a1 = acc[m][n][r]; hv[r] = a1 * sigmoidf_(a1) * acc[m][n + 4][r]; }
                    const unsigned long long o = (unsigned long long)pk2(hv[0], hv[1]) | ((unsigned long long)pk2(hv[2], hv[3]) << 32);
                    __hip_atomic_store((unsigned long long*)(HM + lo_ + 16 * m * DE + 16 * n), o, __ATOMIC_RELAXED, __HIP_MEMORY_SCOPE_AGENT); }
            asm volatile("s_waitcnt vmcnt(0)" ::: "memory");
            if (ln_ == 0) __hip_atomic_fetch_add((unsigned*)(a.ws + WS_CTL) + CW_TC + 64 * ti, 1u, __ATOMIC_RELAXED, __HIP_MEMORY_SCOPE_AGENT); }
        else { bf16* Y2 = (bf16*)(a.ws + WS_Y2) + (size_t)256 * ti * D + 256 * nt + 128 * wn; const unsigned lo_ = (unsigned)((128 * hh + 64 * wr + efr) * D + 4 * efq);
#pragma unroll
            for (int m = 0; m < 4; ++m)
#pragma unroll
                for (int n = 0; n < 8; ++n) { pg8::u32x2 o; o.x = pk2(acc[m][n][0], acc[m][n][1]); o.y = pk2(acc[m][n][2], acc[m][n][3]);
                    *(pg8::u32x2*)(Y2 + lo_ + 16 * m * D + 16 * n) = o; } }
    }
#undef MG_BAR
}

__device__ __forceinline__ void phase12(const Args& a, unsigned char* lds_g, int lane, int wave) {
    const int gw = blockIdx.x * NWAVES + wave, NGW = gridDim.x * NWAVES;
    const int* cum = (const int*)(lds_g + MG_CUM);
    const bf16* X1 = (const bf16*)(a.ws + WS_X1); const float* MOD = (const float*)(a.ws + WS_MOD); const float* fg = a.in[I_FG];
    const int4* ASG = (const int4*)(a.ws + WS_ASG); const bf16* Y2 = (const bf16*)(a.ws + WS_Y2);
    for (int t = gw; t < NLAT; t += NGW) {
        const int b = t >> 11; const int4 q0 = ASG[2 * t], q1 = ASG[2 * t + 1];
        const float w0 = __int_as_float(q0.z), w1 = __int_as_float(q1.z);
        const unsigned long long* xr = (const unsigned long long*)(X1 + (size_t)t * D) + lane;
        const unsigned long long* y0 = (const unsigned long long*)(Y2 + (size_t)(256 * cum[q0.x] + q0.y) * D) + lane; const unsigned long long* y1 = (const unsigned long long*)(Y2 + (size_t)(256 * cum[q1.x] + q1.y) * D) + lane;
        f32x4 v[8]; float s = 0.f;
#pragma unroll
        for (int j = 0; j < 8; ++j) {
            const int c = 4 * lane + 256 * j;
            const f32x4 g2 = *(const f32x4*)(MOD + b * 12288 + 5 * 2048 + c);
            const unsigned long long a0 = y0[64 * j], a1 = y1[64 * j];
            f32x4 y; y.x = w0 * bflo((unsigned)a0) + w1 * bflo((unsigned)a1); y.y = w0 * bfhi((unsigned)a0) + w1 * bfhi((unsigned)a1);
            y.z = w0 * bflo((unsigned)(a0 >> 32)) + w1 * bflo((unsigned)(a1 >> 32)); y.w = w0 * bfhi((unsigned)(a0 >> 32)) + w1 * bfhi((unsigned)(a1 >> 32));
            const unsigned long long xw = xr[64 * j];
            v[j] = (f32x4){bflo((unsigned)xw), bfhi((unsigned)xw), bflo((unsigned)(xw >> 32)), bfhi((unsigned)(xw >> 32))} + g2 * y;
            s += (v[j].x * v[j].x + v[j].y * v[j].y) + (v[j].z * v[j].z + v[j].w * v[j].w);
        }
        const float rstd = 1.f / sqrtf(wave_sum(s) * (1.f / D) + EPS);
        f32x4* o = (f32x4*)(a.out + (size_t)t * D) + lane; f32x4 fgv[8];
#pragma unroll
        for (int j = 0; j < 8; ++j) fgv[j] = *(const f32x4*)(fg + 4 * lane + 256 * j);
#pragma unroll
        for (int j = 0; j < 8; ++j) o[64 * j] = v[j] * rstd * fgv[j];
    }
}

__global__ void __launch_bounds__(NTHR, 2) fwd_kernel(Args args) {
    extern __shared__ __attribute__((aligned(16))) unsigned char lds[];
    LAS unsigned char* ldsl = (LAS unsigned char*)lds;
    volatile LAS unsigned* MISC = (volatile LAS unsigned*)(ldsl + MISC_OFF);
    LAS unsigned* TL = (LAS unsigned*)(ldsl + LDSCTL_OFF);
    const int wave_s = __builtin_amdgcn_readfirstlane(threadIdx.x >> 6);
#define TID() make_tid(wave_s)
    { const int t0 = TID(); for (int u = t0; u < (LDS_BYTES - LDSCTL_OFF) / 4; u += NTHR) ((LAS unsigned*)(ldsl + LDSCTL_OFF))[u] = 0u; }
    __syncthreads();
    unsigned char* ws = args.ws;
    unsigned* ctl = (unsigned*)(ws + WS_CTL);
    XcdBarrier bar; bar.bar = ctl + CW_BAR; bar.x = 0; bar.st = nullptr;
    const bool one_launch = (args.ph_hi - args.ph_lo) > 1;
    if (one_launch) bar = xcd_barrier_post(ctl + CW_BAR, MISC + 8, TID());
    const int lo = args.ph_lo, hi = args.ph_hi;
#define IN(k) (lo <= (k) && (k) < hi)
#define SEAM(k) do { if (IN(k) && IN((k) + 1)) xcd_barrier(bar, TID()); } while (0)
    const int G = gridDim.x, c = blockIdx.x;

#define FRESH() const int tid = TID(), lane = tid & 63, wave = __builtin_amdgcn_readfirstlane(tid >> 6); (void)lane; (void)wave
#ifndef DUP_PHASE
#define DUP_PHASE (-1)
#endif
#define PH(k, ...) if (IN(k)) { _Pragma("unroll") for (int rep_ = 0; rep_ < ((DUP_PHASE) == (k) ? 2 : 1); ++rep_) { if (rep_) xcd_barrier(bar, TID()); __VA_ARGS__ } } SEAM(k);
    PH(0, { FRESH(); phase0(args, lds, tid, lane, wave); mod_wait(args, tid); phase1(args, lane, wave); })
    PH(1, {
        SchedIn S{G, c, (const char*)(ws + WS_H), (const char*)(ws + WS_WIN)}; EpiIn E{ws, args.in[I_BGATES]};
        pg8::gemm_phase<EpiIn, SchedIn>(ldsl, D, S, E, TID());
        { const int R_ = (1492 + G - 1) / G; int fi_ = 1492 - (R_ - 1) * G; if (fi_ >= G) fi_ = 0;
          if (c >= fi_) { FRESH(); late_prep(args, lds, (c - fi_) * NWAVES + wave, (G - fi_) * NWAVES, lane, wave); } } })
    PH(2, { FRESH(); phase3(args, lds, tid); })
    PH(3, { FRESH();
        for (int u = c; u < 256; u += G) ml_out_unit(args, lds, u, tid);
        for (int u = c; u < 4 * 32 * 8; u += G) { const int blk = u & 7, q = u >> 3; lru_out_unit(args, lds, q >> 5, 4 + (q & 31), blk, tid); } })
    PH(4, {
        SchedProj S{G, c, (const char*)(ws + WS_YA), (const char*)(ws + WS_YB), (const char*)(ws + WS_WPA), (const char*)(ws + WS_WPB)};
        EpiProj E{(const bf16*)(ws + WS_GA), (const bf16*)(ws + WS_GB), (bf16*)(ws + WS_PRE)};
        pg8::gemm_phase<EpiProj, SchedProj>(ldsl, 1024, S, E, TID()); })
    PH(5, {
        SchedOut S{G, c, (const char*)(ws + WS_PRE), (const char*)(ws + WS_WOUT)}; EpiOut E{args.in[I_X], (const float*)(ws + WS_MOD), (bf16*)(ws + WS_X1)};
        pg8::gemm_phase<EpiOut, SchedOut>(ldsl, D, S, E, TID()); })
    PH(6, { FRESH(); phase_router(args, lds, tid, lane, wave); })
    PH(7, { FRESH(); moe_tables(args, lds, tid); const int nx_ = moe_gemm<1>(args, lds, tid, -1); { const int tid2_ = TID(); (void)moe_gemm<2>(args, lds, tid2_, nx_); } })
    PH(8, { FRESH(); moe_tables(args, lds, tid); phase12(args, lds, lane, wave); })
#undef PH
#undef IN
#undef SEAM
}

extern "C" void kernel_launch(void* const* d_in, const int* in_sizes, int n_in, void* d_out, int out_size, void* d_ws, size_t ws_size, hipStream_t stream) {
    static int grid = 0;
    if (grid == 0) {
        if (n_in != 27 || out_size != NLAT * D || ws_size < WS_END) { fprintf(stderr, "kernel_launch: unexpected shapes (n_in %d, out %d, ws %zu)\n", n_in, out_size, ws_size); grid = -1; return; }
        int dev = 0, cus = 0, per_cu = 0;
        if (hipGetDevice(&dev) != hipSuccess || hipDeviceGetAttribute(&cus, hipDeviceAttributeMultiprocessorCount, dev) != hipSuccess) { grid = -1; return; }
        if (hipFuncSetAttribute((const void*)fwd_kernel, hipFuncAttributeMaxDynamicSharedMemorySize, LDS_BYTES) != hipSuccess) { fprintf(stderr, "kernel_launch: hipFuncSetAttribute failed\n"); grid = -1; return; }
        if (hipOccupancyMaxActiveBlocksPerMultiprocessor(&per_cu, (const void*)fwd_kernel, NTHR, LDS_BYTES) != hipSuccess || per_cu < 1) fprintf(stderr, "kernel_launch: occupancy query says %d\n", per_cu);
        (void)hipGetLastError();
        grid = cus;
    }
    if (grid < 0) return;
    (void)hipMemsetAsync((char*)d_ws + WS_CTL, 0, CTL_ZERO_BYTES, stream);
    Args a{};
    for (int i = 0; i < 27; ++i) a.in[i] = (const float*)d_in[i];
    a.out = (float*)d_out; a.ws = (unsigned char*)d_ws;
#if MK_ONE_LAUNCH
    a.ph_lo = 0; a.ph_hi = NPHASE;
    hipLaunchKernelGGL(fwd_kernel, dim3(grid), dim3(NTHR), LDS_BYTES, stream, a);
#else
    for (int p = 0; p < NPHASE; ++p) { a.ph_lo = p; a.ph_hi = p + 1; hipLaunchKernelGGL(fwd_kernel, dim3(grid), dim3(NTHR), LDS_BYTES, stream, a); }
#endif
}
```

```cpp
#include <hip/hip_runtime.h>
#include <cstdio>
#include <cstdint>

#ifndef MK_ONE_LAUNCH
#define MK_ONE_LAUNCH 1
#endif

namespace pg8 {
#define PG8_LAS __attribute__((address_space(3)))
typedef unsigned short bf16_t;
typedef short bf16x8 __attribute__((ext_vector_type(8)));
typedef float f32x4 __attribute__((ext_vector_type(4)));
typedef float f32x2 __attribute__((ext_vector_type(2)));
typedef unsigned u32x4 __attribute__((ext_vector_type(4)));
typedef unsigned u32x2 __attribute__((ext_vector_type(2)));
constexpr int BM = 256, BK = 64, HALF = 128, HTB = HALF * BK * 2  , STAGE_BYTES = 8 * HTB, NXCD = 8, WGM = 8;

__host__ __device__ __forceinline__ int lds_byte(int r, int c) { const int st = (r >> 4) * 2 + (c >> 5), rr = r & 15, cc = c & 31, ob = rr * 64 + cc * 2; return st * 1024 + (ob ^ (((ob >> 9) & 1) << 5)); }
__host__ __device__ __forceinline__ void stage_rc(int b, int& R, int& C) { const int st = b / 1024, sb = b % 1024, swz = sb ^ (((sb >> 9) & 1) << 5); R = (st >> 1) * 16 + swz / 64; C = (st & 1) * 32 + (swz % 64) / 2; }
__host__ __device__ __forceinline__ int perm32(int rho) { const int n = rho >> 4, i = rho & 15; return 8 * (i >> 2) + 4 * n + (i & 3); }

struct Unit { const char* A; const char* B; int pm, pn, aux; };

__host__ __device__ __forceinline__ void tile_order(int L, int nM, int nN, int& pm, int& pn) {
    const int nwg = nM * nN; int wgid = L;
    { const int q = nwg / NXCD, r = nwg % NXCD, xcd = wgid % NXCD, off = wgid / NXCD; wgid = (xcd < r ? xcd * (q + 1) : r * (q + 1) + (xcd - r) * q) + off; }
    const int nig = WGM * nN, gid = wgid / nig, fm = gid * WGM, gsz = (nM - fm) < WGM ? (nM - fm) : WGM;
    pm = fm + ((wgid % nig) % gsz); pn = (wgid % nig) / gsz;
}

typedef __bf16 bf16n2 __attribute__((ext_vector_type(2)));
__device__ __forceinline__ unsigned cvt_pk_bf16(float lo, float hi) { const f32x2 v = {lo, hi}; return __builtin_bit_cast(unsigned, __builtin_convertvector(v, bf16n2)); }

template <class Epi, class Sched>
__device__ __forceinline__ void gemm_phase(PG8_LAS unsigned char* lds, const int K, const Sched& S, const Epi& E, int tid) {
    const int wid = __builtin_amdgcn_readfirstlane(tid >> 6), lane = tid & 63, wr = wid >> 2, wc = wid & 3, fr = lane & 15, fq = lane >> 4;
    const int nt = K / BK;
    unsigned voffA[2], voffB[2];
#pragma unroll
    for (int i = 0; i < 2; ++i) { int R, C; stage_rc(tid * 16 + i * 8192, R, C); const int Rb = Epi::PERM ? ((R & ~31) + perm32(R & 31)) : R;
        voffA[i] = (unsigned)(R * K + C) * 2u; voffB[i] = (unsigned)(Rb * K + C) * 2u; }
    const size_t kstep = (size_t)(BK * 2);
    const size_t hstep = (size_t)HALF * K * 2;
    const unsigned ldsw = (unsigned)wid * 1024u;
    const int aoff = lds_byte(wr * 64 + fr, fq * 8), boff = lds_byte(wc * 32 + fr, fq * 8);
#define PG8_SA(b, h) (((b) * 2 + (h)) * HTB)
#define PG8_SB(b, h) ((4 + (b) * 2 + (h)) * HTB)
#define PG8_STAGE(bufoff, gbase, voff) do { _Pragma("unroll") for (int _i = 0; _i < 2; ++_i) \
        __builtin_amdgcn_global_load_lds((const unsigned*)((const char*)(gbase) + (voff)[_i]), (PG8_LAS unsigned*)(lds + (bufoff) + ldsw + _i * 8192), 16, 0, 0); } while (0)
#define PG8_LDA(dst, b, h) do { _Pragma("unroll") for (int m = 0; m < 4; ++m) _Pragma("unroll") for (int k = 0; k < 2; ++k) dst[m][k] = *(const PG8_LAS bf16x8*)(lds + PG8_SA(b, h) + aoff + m * 2048 + k * 1024); } while (0)
#define PG8_LDB(dst, b, h) do { _Pragma("unroll") for (int n = 0; n < 2; ++n) _Pragma("unroll") for (int k = 0; k < 2; ++k) dst[n][k] = *(const PG8_LAS bf16x8*)(lds + PG8_SB(b, h) + boff + n * 2048 + k * 1024); } while (0)
#define PG8_MMA(ai, bj, At, Bt) do { __builtin_amdgcn_s_setprio(1); _Pragma("unroll") for (int m = 0; m < 4; ++m) _Pragma("unroll") for (int n = 0; n < 2; ++n) _Pragma("unroll") for (int k = 0; k < 2; ++k) \
        acc[ai][bj][m][n] = __builtin_amdgcn_mfma_f32_16x16x32_bf16(Bt[n][k], At[m][k], acc[ai][bj][m][n], 0, 0, 0); __builtin_amdgcn_s_setprio(0); } while (0)
#define PG8_WAIT_V(n) asm volatile("s_waitcnt vmcnt(" #n ")" ::: "memory")
#define PG8_WAIT_L(n) asm volatile("s_waitcnt lgkmcnt(" #n ")" ::: "memory")
#define PG8_BAR __builtin_amdgcn_s_barrier()
#define PG8_SCHED __builtin_amdgcn_sched_barrier(0)
    Unit cur, nxt; int ui = 0;
    if (!S.next(0, cur)) return;
    f32x4 acc[2][2][4][2];
#pragma unroll
    for (int a = 0; a < 2; ++a)
#pragma unroll
        for (int b = 0; b < 2; ++b)
#pragma unroll
            for (int m = 0; m < 4; ++m)
#pragma unroll
                for (int n = 0; n < 2; ++n) acc[a][b][m][n] = (f32x4){0.f, 0.f, 0.f, 0.f};
    bf16x8 At[4][2], B0[2][2], B1[2][2];
    const char* cA = cur.A; const char* cB = cur.B;
    PG8_STAGE(PG8_SB(0, 0), cB, voffB); PG8_STAGE(PG8_SB(0, 1), cB + hstep, voffB); PG8_STAGE(PG8_SA(0, 0), cA, voffA); PG8_STAGE(PG8_SA(0, 1), cA + hstep, voffA);
    if (wr == 1) PG8_BAR;
    PG8_WAIT_V(2); PG8_BAR;
    PG8_STAGE(PG8_SB(1, 0), cB + kstep, voffB); PG8_STAGE(PG8_SA(1, 0), cA + kstep, voffA); PG8_STAGE(PG8_SB(1, 1), cB + hstep + kstep, voffB);
    PG8_WAIT_V(6); PG8_BAR;
    for (;;) {
        const bool has_next = S.next(ui + 1, nxt);
        const char* nA = has_next ? nxt.A : cA; const char* nB = has_next ? nxt.B : cB;
        for (int t = 0; t < nt; t += 2) {
            const bool last = (t == nt - 2);
            const char* a1 = cA + (size_t)(t + 1) * kstep;
            const char* a2 = last ? nA : cA + (size_t)(t + 2) * kstep; const char* b2 = last ? nB : cB + (size_t)(t + 2) * kstep;
            const char* a3 = a2 + kstep; const char* b3 = b2 + kstep;
            PG8_LDB(B0, 0, 0); PG8_LDB(B1, 0, 1); PG8_SCHED; PG8_LDA(At, 0, 0); PG8_STAGE(PG8_SA(1, 1), a1 + hstep, voffA);
            PG8_WAIT_V(8); PG8_WAIT_L(0); PG8_BAR; PG8_MMA(0, 0, At, B0); PG8_MMA(0, 1, At, B1); PG8_BAR; PG8_SCHED;
            PG8_LDA(At, 0, 1); PG8_STAGE(PG8_SB(0, 0), b2, voffB); PG8_STAGE(PG8_SB(0, 1), b2 + hstep, voffB); PG8_STAGE(PG8_SA(0, 0), a2, voffA);
            PG8_WAIT_V(8); PG8_WAIT_L(0); PG8_BAR; PG8_MMA(1, 0, At, B0); PG8_MMA(1, 1, At, B1); PG8_BAR; PG8_SCHED;
            PG8_LDB(B0, 1, 0); PG8_LDB(B1, 1, 1); PG8_SCHED; PG8_LDA(At, 1, 0); PG8_STAGE(PG8_SA(0, 1), a2 + hstep, voffA);
            PG8_WAIT_V(8); PG8_WAIT_L(0); PG8_BAR; PG8_MMA(0, 0, At, B0); PG8_MMA(0, 1, At, B1); PG8_BAR; PG8_SCHED;
            PG8_LDA(At, 1, 1); PG8_STAGE(PG8_SB(1, 0), b3, voffB); PG8_STAGE(PG8_SB(1, 1), b3 + hstep, voffB); PG8_STAGE(PG8_SA(1, 0), a3, voffA);
            PG8_WAIT_V(8); PG8_WAIT_L(0); PG8_BAR; PG8_MMA(1, 0, At, B0); PG8_MMA(1, 1, At, B1); PG8_BAR; PG8_SCHED;
        }
        if (wr == 0) PG8_BAR;
        { int fr_ = fr, fq_ = fq; asm volatile("" : "+v"(fr_), "+v"(fq_)); E(acc, cur, wr, wc, fr_, fq_); }
        if (!has_next) break;
        if (!(Epi::CARRY && E.keep(cur))) {
#pragma unroll
        for (int a = 0; a < 2; ++a)
#pragma unroll
            for (int b = 0; b < 2; ++b)
#pragma unroll
                for (int m = 0; m < 4; ++m)
#pragma unroll
                    for (int n = 0; n < 2; ++n) acc[a][b][m][n] = (f32x4){0.f, 0.f, 0.f, 0.f};
        }
        cur = nxt; cA = nA; cB = nB; ++ui;
        if (wr == 1) PG8_BAR;
    }
    PG8_WAIT_V(0);
    PG8_BAR;
#undef PG8_SA
#undef PG8_SB
#undef PG8_STAGE
#undef PG8_LDA
#undef PG8_LDB
#undef PG8_MMA
#undef PG8_WAIT_V
#undef PG8_WAIT_L
#undef PG8_BAR
#undef PG8_SCHED
}
}

constexpr int NWAVES = 8, NTHR = 512;
constexpr int D = 2048, NB = 4, SEQ = 2048, CTXL = 256, NCTX = NB * CTXL  , NLAT = NB * SEQ  , NTOK = NCTX + NLAT  ;
constexpr int NSTEP = CTXL + SEQ;
constexpr int HEADS = 8, HD = 128, MW = 1024, LW = 1024;
constexpr int NEXP = 32, DE = 1024;
constexpr int IN_DIM = 11296, NT_IN = 45;
constexpr float EPS = 1e-6f;
constexpr int MAXTILES = 96;
constexpr int NPHASE = 9;

constexpr size_t MiB = 1u << 20;
constexpr size_t WS_CTL = 0, CTL_ZERO_BYTES = 1 * MiB;
constexpr size_t WS_MOD = 1 * MiB;
constexpr size_t WS_GATES = 2 * MiB;
constexpr size_t WS_ASG = 4 * MiB + 512 * 1024;
constexpr size_t WS_LIST = 3 * MiB + 512 * 1024;
constexpr size_t WS_WR = 6 * MiB;
constexpr size_t WS_RB = 7 * MiB + 768 * 1024;
constexpr size_t WS_WL = 5 * MiB;
constexpr size_t WS_AGG = 978 * MiB;
constexpr size_t WS_WPA = 8 * MiB, WS_WPB = 12 * MiB, WS_WOUT = 16 * MiB, WS_WIN = 24 * MiB;
constexpr size_t WS_W13 = 72 * MiB, WS_W2 = 328 * MiB;
constexpr size_t WS_PS = 72 * MiB;
constexpr size_t WS_H = 456 * MiB;
constexpr size_t WS_K = 492 * MiB, WS_V = 510 * MiB, WS_UX = 528 * MiB;
constexpr size_t WS_Q = 546 * MiB, WS_OF = 562 * MiB, WS_OB = 578 * MiB, WS_UG = 594 * MiB;
constexpr size_t WS_GA = 610 * MiB, WS_GB = 642 * MiB;
constexpr size_t WS_LA = 674 * MiB, WS_LB = 746 * MiB;
constexpr size_t WS_HS = 818 * MiB, WS_TM = 882 * MiB;
constexpr size_t WS_YA = 946 * MiB, WS_YB = 962 * MiB;
constexpr size_t WS_BT = 982 * MiB;
constexpr size_t WS_SLOC = 984 * MiB;
constexpr size_t WS_END = 1022 * MiB;
constexpr size_t WS_PRE = WS_LA;
constexpr size_t WS_X1 = WS_LB;
constexpr size_t WS_H2 = WS_H;
constexpr size_t WS_XS = WS_K;
constexpr size_t WS_HM = 588 * MiB;
constexpr size_t WS_Y2 = WS_HS;
constexpr int CW_MODC = 32;
constexpr int CW_CNT = 64;
constexpr int CW_NT = 128;
constexpr int CW_TILE_E = 192;
constexpr int CW_BAR = 4096;
constexpr int CW_Q = 8192;
constexpr int CW_TC = 16384;

constexpr int RING_BYTES = 131072;
constexpr int LDSCTL_OFF = 143360;
constexpr int MISC_OFF = LDSCTL_OFF + 384;
constexpr int LDS_BYTES = 147456;

#define GAS __attribute__((address_space(1)))
#define LAS __attribute__((address_space(3)))
typedef unsigned short bf16;
typedef unsigned v4u __attribute__((ext_vector_type(4)));
typedef float f32x4 __attribute__((ext_vector_type(4)));
#define LDS_WAIT() asm volatile("s_waitcnt lgkmcnt(0)" ::: "memory")
#define WG_BAR() do { asm volatile("s_waitcnt lgkmcnt(0)" ::: "memory"); __builtin_amdgcn_s_barrier(); asm volatile("" ::: "memory"); } while (0)

__device__ __forceinline__ unsigned f2bf(float f) { unsigned u = __builtin_bit_cast(unsigned, f); return (u + 0x7fffu + ((u >> 16) & 1u)) >> 16; }
__device__ __forceinline__ unsigned pk2(float lo, float hi) { return pg8::cvt_pk_bf16(lo, hi); }
__device__ __forceinline__ float bf2f(unsigned h) { return __builtin_bit_cast(float, h << 16); }
__device__ __forceinline__ float bflo(unsigned w) { return __builtin_bit_cast(float, w << 16); }
__device__ __forceinline__ float bfhi(unsigned w) { return __builtin_bit_cast(float, w & 0xffff0000u); }
__device__ __forceinline__ float sigmoidf_(float x) { return __builtin_amdgcn_rcpf(1.f + __expf(-x)); }
__device__ __forceinline__ float gelu_tanh(float x) { const float u = 0.7978845608028654f * (x + 0.044715f * x * x * x); return x * __builtin_amdgcn_rcpf(1.f + __expf(-2.f * u)); }
__device__ __forceinline__ float wave_sum(float v) {
#pragma unroll
    for (int o = 1; o < 64; o <<= 1) v += __shfl_xor(v, o);
    return v;
}

#define XB_TMO      128
#define XB_XCNT(j)  (256  + 64 * (j))
#define XB_XSUB(j)  (1280 + 64 * (j))
#define XB_XGEN(j)  (2304 + 64 * (j))
#define XB_TOP      3328
#define XB_TOPGEN   3392
#define XCD_BAR_WORDS 3456
#define XB_SPIN_CAP (1u << 23)
__device__ __forceinline__ unsigned xb_ld(unsigned* p)              { return __hip_atomic_load(p, __ATOMIC_RELAXED, __HIP_MEMORY_SCOPE_AGENT); }
__device__ __forceinline__ unsigned xb_add(unsigned* p, unsigned v) { return __hip_atomic_fetch_add(p, v, __ATOMIC_RELAXED, __HIP_MEMORY_SCOPE_AGENT); }
__device__ __forceinline__ unsigned xb_xcc_id() { return (unsigned)__builtin_amdgcn_s_getreg((3 << 11) | 20) & 0xFu; }
#define XB_SPIN(cond, bar) do { unsigned _sp = 0; while (cond) { __builtin_amdgcn_s_sleep(1); \
    if ((++_sp & 255u) == 0u) { if (xb_ld(&(bar)[XB_TMO])) break; if (_sp > XB_SPIN_CAP) { atomicAdd(&(bar)[XB_TMO], 1u); break; } } } } while (0)
struct XcdBarrier { unsigned* bar; unsigned x; volatile LAS unsigned* st; };
__device__ __forceinline__ XcdBarrier xcd_barrier_post(unsigned* bar, volatile LAS unsigned* st, int tid) {
    XcdBarrier b; b.bar = bar; b.x = xb_xcc_id(); b.st = st;
    if (tid == 0) (void)xb_add(&bar[XB_XCNT(b.x)], 1u);
    return b;
}
__device__ __forceinline__ void xcd_barrier_complete(unsigned* bar, unsigned x, unsigned& nloc, unsigned& nx) {
    const unsigned G = gridDim.x * gridDim.y * gridDim.z;
    unsigned sum, cnt, mine, sp = 0u;
    for (;;) {
        sum = 0u; cnt = 0u; mine = 0u;
#pragma unroll
        for (unsigned j = 0; j < 16; ++j) { const unsigned c = xb_ld(&bar[XB_XCNT(j)]); sum += c; cnt += (c > 0u) ? 1u : 0u; mine = (j == x) ? c : mine; }
        if (sum == G) break;
        __builtin_amdgcn_s_sleep(1);
        if ((++sp & 255u) == 0u) { if (xb_ld(&bar[XB_TMO])) break; if (sp > XB_SPIN_CAP) { atomicAdd(&bar[XB_TMO], 1u); break; } }
    }
    nloc = mine > 0u ? mine : 1u; nx = cnt > 0u ? cnt : 1u;
}
__device__ __forceinline__ void xcd_barrier(const XcdBarrier& b, int tid) {
    asm volatile("s_waitcnt vmcnt(0)" ::: "memory");
    __syncthreads();
    if (tid == 0) {
        unsigned* bar = b.bar;
        __builtin_amdgcn_s_waitcnt(0);
        unsigned nloc = b.st[0], nx = b.st[1];
        if (nloc == 0u) { xcd_barrier_complete(bar, b.x, nloc, nx); b.st[0] = nloc; b.st[1] = nx; }
        const unsigned old = xb_add(&bar[XB_XSUB(b.x)], 1u);
        const unsigned gen = old / nloc;
        if (old + 1u == (gen + 1u) * nloc) {
            __builtin_amdgcn_fence(__ATOMIC_RELEASE, "agent");
            asm volatile("s_waitcnt vmcnt(0)" ::: "memory");
            const unsigned og = xb_add(&bar[XB_TOP], 1u);
            const unsigned tg = og / nx;
            if (og + 1u == (tg + 1u) * nx) xb_add(&bar[XB_TOPGEN], 1u);
            else XB_SPIN(xb_ld(&bar[XB_TOPGEN]) == tg, bar);
            __builtin_amdgcn_fence(__ATOMIC_ACQUIRE, "agent");
            xb_add(&bar[XB_XGEN(b.x)], 1u);
            asm volatile("s_waitcnt vmcnt(0)" ::: "memory");
        } else {
            XB_SPIN(xb_ld(&bar[XB_XGEN(b.x)]) == gen, bar);
            __builtin_amdgcn_fence(__ATOMIC_ACQUIRE, "agent");
            asm volatile("s_waitcnt vmcnt(0)" ::: "memory");
        }
    }
    __syncthreads();
}

__device__ __forceinline__ int make_tid(int wave_s) { int l; asm volatile("v_mbcnt_lo_u32_b32 %0, -1, 0\n\tv_mbcnt_hi_u32_b32 %0, -1, %0" : "=v"(l)); __builtin_assume(l >= 0 && l < 64); __builtin_assume(wave_s >= 0 && wave_s < 8); return wave_s * 64 + l; }
struct Args { const float* in[27]; float* out; unsigned char* ws; int ph_lo, ph_hi; };
enum { I_X = 0, I_C, I_CTX, I_CCTX, I_WMOD, I_BMOD, I_N1G, I_WIN, I_BGATES, I_HEADG, I_CONVW, I_CONVB, I_LWA, I_LBA, I_LWX, I_LBX, I_LAM, I_WPA, I_WPB, I_WOUT, I_N2G, I_WRG, I_WRE, I_W1, I_W3, I_W2, I_FG };

__device__ __forceinline__ void tr_item(const float* __restrict__ W, size_t ldw, int k0, int n0, bf16* dst, size_t ldd, float scale, LAS float* scr, int lane) {
#pragma unroll 16
    for (int i = 0; i < 32; ++i) { const int kk = 2 * i + (lane >> 5); scr[kk * 33 + (lane & 31)] = W[(size_t)(k0 + kk) * ldw + n0 + (lane & 31)]; }
    LDS_WAIT(); asm volatile("" ::: "memory");
    const int c = lane & 7;
#pragma unroll
    for (int j = 0; j < 4; ++j) { const int n = (lane >> 3) + 8 * j; const LAS float* s = scr + (8 * c) * 33 + n;
        v4u o; o.x = pk2(s[0 * 33] * scale, s[1 * 33] * scale); o.y = pk2(s[2 * 33] * scale, s[3 * 33] * scale); o.z = pk2(s[4 * 33] * scale, s[5 * 33] * scale); o.w = pk2(s[6 * 33] * scale, s[7 * 33] * scale);
        *(GAS v4u*)(dst + (size_t)n * ldd + 8 * c) = o; }
    LDS_WAIT(); asm volatile("" ::: "memory");
}
__device__ __forceinline__ int win_row(int n0, float& scale) {
    scale = 1.f;
    if (n0 < 1024) return 13 * 256 + n0;
    if (n0 < 2048) { scale = 0.08838834764831845f; return n0 - 1024; }
    if (n0 < 3072) return 4 * 256 + (n0 - 2048);
    if (n0 < 4096) return 17 * 256 + (n0 - 3072);
    if (n0 < 5120) return 21 * 256 + (n0 - 4096);
    if (n0 < 5152) return 12 * 256 + (n0 - 5120);
    if (n0 < 6176) return 8 * 256 + (n0 - 5152);
    if (n0 < 7200) return 25 * 256 + (n0 - 6176);
    if (n0 < 9248) return 29 * 256 + (n0 - 7200);
    return 37 * 256 + (n0 - 9248);
}

__device__ __forceinline__ void phase0(const Args& a, unsigned char* lds_g, int tid, int lane, int wave) {
    unsigned char* ws = a.ws;
    {
        float* sl = (float*)lds_g;
        float* red = sl + 5 * 2048;
        for (int i = tid; i < 5 * 2048; i += NTHR) { const int r = i >> 11, k = i & 2047; const float v = r < 4 ? a.in[I_C][r * 2048 + k] : a.in[I_CCTX][k]; sl[i] = v / (1.f + __expf(-v)); }
        __syncthreads();
        const float* wm = a.in[I_WMOD]; const float* bm = a.in[I_BMOD]; float* MOD = (float*)(ws + WS_MOD);
        for (int cb = blockIdx.x; cb < 256; cb += gridDim.x) {
            const int n0 = cb * 48;
            if (tid < 504) {
                const int kq = tid / 12, cg = tid % 12;
                f32x4 acc[5];
#pragma unroll
                for (int r = 0; r < 5; ++r) acc[r] = (f32x4){0.f, 0.f, 0.f, 0.f};
#pragma unroll 7
                for (int k = kq; k < 2048; k += 42) {
                    const f32x4 w = *(const f32x4*)(wm + (size_t)k * 12288 + n0 + 4 * cg);
#pragma unroll
                    for (int r = 0; r < 5; ++r) acc[r] += w * sl[r * 2048 + k];
                }
#pragma unroll
                for (int r = 0; r < 5; ++r) *(f32x4*)(red + tid * 20 + r * 4) = acc[r];
            }
            __syncthreads();
            if (tid < 240) {
                const int cg = tid / 20, rj = tid % 20; float s = 0.f;
                for (int kq = 0; kq < 42; ++kq) s += red[(kq * 12 + cg) * 20 + rj];
                const int r = rj >> 2, j = rj & 3, n = n0 + 4 * cg + j;
                __hip_atomic_store(MOD + r * 12288 + n, s + bm[n], __ATOMIC_RELAXED, __HIP_MEMORY_SCOPE_AGENT);
            }
            __syncthreads();
        }
        if (tid == 0) __hip_atomic_fetch_add((unsigned*)(ws + WS_CTL) + CW_MODC, 1u, __ATOMIC_RELAXED, __HIP_MEMORY_SCOPE_AGENT);
    }
    {
        LAS float* scr = (LAS float*)((LAS unsigned char*)lds_g) + wave * 4096;
        const int gw = blockIdx.x * NWAVES + wave, NGW = gridDim.x * NWAVES;
        constexpr int J0 = 32 * 353, J1 = 16 * 64, J3 = 32 * 64;
        constexpr int JL = 256;
        constexpr int NITEMS = J0 + 2 * J1;
        (void)J3; (void)JL;
        for (int it = gw; it < NITEMS; it += NGW) {
            int r = it;
            if (r < J0) { const int kb = r / 353, nb = r % 353; float sc; const int row = win_row(32 * nb, sc);
                tr_item(a.in[I_WIN], IN_DIM, 64 * kb, 32 * nb, (bf16*)(ws + WS_WIN) + (size_t)row * 2048 + 64 * kb, 2048, sc, scr, lane); continue; } r -= J0;
            if (r < J1) { const int kb = r / 64, nb = r % 64; tr_item(a.in[I_WPA], 2048, 64 * kb, 32 * nb, (bf16*)(ws + WS_WPA) + (size_t)(32 * nb) * 1024 + 64 * kb, 1024, 1.f, scr, lane); continue; } r -= J1;
            if (r < J1) { const int kb = r / 64, nb = r % 64; tr_item(a.in[I_WPB], 2048, 64 * kb, 32 * nb, (bf16*)(ws + WS_WPB) + (size_t)(32 * nb) * 1024 + 64 * kb, 1024, 1.f, scr, lane); continue; }
        }
        { GAS v4u* z = (GAS v4u*)((bf16*)(ws + WS_WIN) + (size_t)(12 * 256 + 32) * 2048); const int nchunks = 224 * 256;
          for (int i = blockIdx.x * NTHR + tid; i < nchunks; i += gridDim.x * NTHR) z[i] = (v4u){0u, 0u, 0u, 0u}; }
    }
}

__device__ __forceinline__ void late_prep(const Args& a, unsigned char* lds_g, int gw, int NGW, int lane, int wave) {
    unsigned char* ws = a.ws;
    {
        LAS float* scr = (LAS float*)((LAS unsigned char*)lds_g) + wave * 4096;
        constexpr int J3 = 32 * 64, JL = 256;
        for (int it = gw; it < J3 + JL; it += NGW) {
            int r = it;
            if (r >= J3) { r -= J3; const int mi = r >> 3, kb = (r >> 2) & 1, nb = r & 3, dir = mi >> 4, mat = (mi >> 3) & 1, blk = mi & 7;
                tr_item(a.in[mat ? I_LWX : I_LWA] + (size_t)(dir * 8 + blk) * 128 * 128, 128, 64 * kb, 32 * nb, (bf16*)(ws + WS_WL) + ((size_t)((dir * 2 + mat) * 8 + blk) * 128 + 32 * nb) * 128 + 64 * kb, 128, 1.f, scr, lane); continue; }
            const int kb = r / 64, nb = r % 64; tr_item(a.in[I_WOUT], 2048, 64 * kb, 32 * nb, (bf16*)(ws + WS_WOUT) + (size_t)(32 * nb) * 2048 + 64 * kb, 2048, 1.f, scr, lane);
        }
    }
    {
        const float* MODr = (const float*)(a.ws + WS_MOD); float* WR = (float*)(a.ws + WS_WR); float* RB = (float*)(a.ws + WS_RB);
        for (int idx = gw * 64 + lane; idx < 4 * 48 * 2048; idx += NGW * 64) { const int k = idx & 2047, j = (idx >> 11) % 48, b = idx / (48 * 2048);
            const float gm = a.in[I_N2G][k] * (1.f + MODr[b * 12288 + 4 * 2048 + k]);
            const float wv = j < 32 ? a.in[I_WRE][(size_t)k * 32 + j] : (j < 36 ? a.in[I_WRG][(size_t)k * 4 + (j - 32)] : 0.f);
            WR[idx] = gm * wv; }
        for (int q = gw; q < 4 * 48; q += NGW) { const int b = q / 48, j = q % 48; float sacc = 0.f;
            if (j < 36) { for (int k = lane; k < 2048; k += 64) { const float wv = j < 32 ? a.in[I_WRE][(size_t)k * 32 + j] : a.in[I_WRG][(size_t)k * 4 + (j - 32)]; sacc += MODr[b * 12288 + 3 * 2048 + k] * wv; } }
            sacc = wave_sum(sacc); if (lane == 0) RB[q] = sacc; }
    }
}
__device__ __forceinline__ void mod_wait(const Args& a, int tid) {
    if (tid < 64) { unsigned* mc = (unsigned*)(a.ws + WS_CTL) + CW_MODC; unsigned spins = 0;
        while ((unsigned)__builtin_amdgcn_readfirstlane(__hip_atomic_load(mc, __ATOMIC_RELAXED, __HIP_MEMORY_SCOPE_AGENT)) < gridDim.x) {
            __builtin_amdgcn_s_sleep(2);
            if (++spins > (1u << 22)) { if (tid == 0) __hip_atomic_store((unsigned*)(a.ws + WS_CTL) + 1, 0x800u, __ATOMIC_RELAXED, __HIP_MEMORY_SCOPE_AGENT); break; } }
        __builtin_amdgcn_fence(__ATOMIC_ACQUIRE, "agent");
        asm volatile("s_waitcnt vmcnt(0)" ::: "memory"); }
    __syncthreads();
}
__device__ __forceinline__ void phase1(const Args& a, int lane, int wave) {
    const int gw = blockIdx.x * NWAVES + wave, NGW = gridDim.x * NWAVES;
    const float* MOD = (const float*)(a.ws + WS_MOD); const float* g = a.in[I_N1G];
    bf16* H = (bf16*)(a.ws + WS_H);
    for (int r = gw; r < NTOK; r += NGW) {
        const float* src = r < NCTX ? a.in[I_CTX] + (size_t)r * D : a.in[I_X] + (size_t)(r - NCTX) * D;
        const int mr = r < NCTX ? 4 : (r - NCTX) / SEQ;
        const f32x4* xr = (const f32x4*)src + lane;
        f32x4 v[8]; float s = 0.f;
#pragma unroll
        for (int j = 0; j < 8; ++j) { v[j] = xr[64 * j]; s += (v[j].x * v[j].x + v[j].y * v[j].y) + (v[j].z * v[j].z + v[j].w * v[j].w); }
        const float rstd = 1.f / sqrtf(wave_sum(s) * (1.f / D) + EPS);
        unsigned long long* o8 = (unsigned long long*)(H + (size_t)r * D) + lane;
#pragma unroll
        for (int j = 0; j < 8; ++j) {
            const int c = 4 * lane + 256 * j;
            const f32x4 gg = *(const f32x4*)(g + c), sh = *(const f32x4*)(MOD + mr * 12288 + c), sc = *(const f32x4*)(MOD + mr * 12288 + 2048 + c);
            v[j] = v[j] * rstd * gg * (sc + 1.f) + sh;
        }
#pragma unroll
        for (int j = 0; j < 8; ++j) o8[64 * j] = (unsigned long long)pk2(v[j].x, v[j].y) | ((unsigned long long)pk2(v[j].z, v[j].w) << 32);
    }
}

struct SchedIn {
    int G, c; const char* A; const char* B;
    __device__ __forceinline__ bool next(int i, pg8::Unit& u) const {
        const int L = i * G + c; if (L >= 1492) return false;
        int pm, pn;
        if (L < 1440) { pg8::tile_order(L, 32, NT_IN, pm, pn); pm += 4; }
        else { const int j = L - 1440; pm = j & 3; pn = j >> 2; }
        u.pm = pm; u.pn = pn; u.aux = 0; u.A = A + (size_t)pm * 256 * D * 2; u.B = B + (size_t)pn * 256 * D * 2; return true;
    }
};
struct EpiIn {
    static constexpr bool PERM = true, CARRY = false;
    __device__ __forceinline__ bool keep(const pg8::Unit&) const { return false; }
    unsigned char* ws; const float* b_gates;
    template <int ACT> __device__ __forceinline__ void store_tile(const pg8::f32x4 (&acc)[2][2][4][2], bf16* base, int ldc, int wr, int wc, int fr, int fq) const {
#pragma unroll
        for (int ai = 0; ai < 2; ++ai)
#pragma unroll
            for (int m = 0; m < 4; ++m) { bf16* rowp = base + (size_t)(ai * 128 + wr * 64 + m * 16 + fr) * ldc + wc * 32 + 8 * fq;
#pragma unroll
                for (int bj = 0; bj < 2; ++bj) { pg8::f32x4 v0 = acc[ai][bj][m][0], v1 = acc[ai][bj][m][1];
                    if (ACT == 1) {
#pragma unroll
                        for (int j = 0; j < 4; ++j) { v0[j] = sigmoidf_(v0[j]); v1[j] = sigmoidf_(v1[j]); } }
                    if (ACT == 2) {
#pragma unroll
                        for (int j = 0; j < 4; ++j) { v0[j] = gelu_tanh(v0[j]); v1[j] = gelu_tanh(v1[j]); } }
                    pg8::u32x4 w; w.x = pg8::cvt_pk_bf16(v0[0], v0[1]); w.y = pg8::cvt_pk_bf16(v0[2], v0[3]); w.z = pg8::cvt_pk_bf16(v1[0], v1[1]); w.w = pg8::cvt_pk_bf16(v1[2], v1[3]);
                    *(pg8::u32x4*)(rowp + bj * 128) = w; } }
    }
    __device__ __forceinline__ void operator()(const pg8::f32x4 (&acc)[2][2][4][2], const pg8::Unit& u, int wr, int wc, int fr, int fq) const {
        const int pn = u.pn; const size_t row0 = (size_t)u.pm * 256;
        if (pn < 12) {
            const int seg = pn >> 2, ct = pn & 3; bf16* dst = (bf16*)(ws + (seg == 0 ? WS_K : seg == 1 ? WS_V : WS_UX));
            store_tile<0>(acc, dst + row0 * 1024 + ct * 256, 1024, wr, wc, fr, fq);
        } else if (pn == 12) {
            if (wc == 0) {
                float* G = (float*)(ws + WS_GATES);
                const pg8::f32x4 bv0 = *(const pg8::f32x4*)(b_gates + 8 * fq), bv1 = *(const pg8::f32x4*)(b_gates + 8 * fq + 4);
#pragma unroll
                for (int ai = 0; ai < 2; ++ai)
#pragma unroll
                    for (int m = 0; m < 4; ++m) { float* rowp = G + (row0 + ai * 128 + wr * 64 + m * 16 + fr) * 32 + 8 * fq;
                        *(pg8::f32x4*)(rowp) = acc[ai][0][m][0] + bv0; *(pg8::f32x4*)(rowp + 4) = acc[ai][0][m][1] + bv1; }
            }
        } else if (pn < 29) {
            const int seg = (pn - 13) >> 2, ct = (pn - 13) & 3; const size_t lr = row0 - NCTX;
            bf16* dst = (bf16*)(ws + (seg == 0 ? WS_Q : seg == 1 ? WS_OF : seg == 2 ? WS_OB : WS_UG)) + lr * 1024 + ct * 256;
            if (seg == 0) store_tile<0>(acc, dst, 1024, wr, wc, fr, fq);
            else if (seg == 3) store_tile<2>(acc, dst, 1024, wr, wc, fr, fq);
            else store_tile<1>(acc, dst, 1024, wr, wc, fr, fq);
        } else {
            const int seg = (pn - 29) >> 3, ct = (pn - 29) & 7; const size_t lr = row0 - NCTX;
            store_tile<1>(acc, (bf16*)(ws + (seg ? WS_GB : WS_GA)) + lr * 2048 + ct * 256, 2048, wr, wc, fr, fq);
        }
    }
};

__device__ __forceinline__ int lru_pos_row(int b, bool isctx, int p) { return isctx ? b * CTXL + p : NCTX + b * SEQ + (p & 31) * 64 + (p >> 5); }
typedef short bf16x8_t __attribute__((ext_vector_type(8)));
template <bool FINAL>
__device__ __forceinline__ void lru_unit(const Args& a, unsigned char* lds_g, int b, int cidx, int blk, int tid) {
    const int lane = tid & 63, w = __builtin_amdgcn_readfirstlane(tid >> 6), fr = lane & 15, fq = lane >> 4;
    float* zf = (float*)lds_g;
    bf16* zb = (bf16*)(lds_g + 64 * 132 * 4);
    const bool isctx = cidx < 4; const int seglen = isctx ? CTXL : SEQ, p0 = (isctx ? cidx : cidx - 4) * 64;
    const bf16* UX = (const bf16*)(a.ws + WS_UX);
    float gba[2], gbx[2], glam[2];
    { const int ch_ = blk * 128 + 16 * w + fr;
#pragma unroll
      for (int d = 0; d < 2; ++d) { gba[d] = a.in[I_LBA][d * 1024 + ch_]; gbx[d] = a.in[I_LBX][d * 1024 + ch_]; glam[d] = a.in[I_LAM][d * 1024 + ch_]; } }
    bf16x8_t wl[2][2][4];
    { const bf16* WL = (const bf16*)(a.ws + WS_WL);
#pragma unroll
      for (int d = 0; d < 2; ++d)
#pragma unroll
        for (int m = 0; m < 2; ++m)
#pragma unroll
            for (int ks = 0; ks < 4; ++ks) wl[d][m][ks] = *(const bf16x8_t*)(WL + ((size_t)((d * 2 + m) * 8 + blk) * 128 + 16 * w + fr) * 128 + 32 * ks + 8 * fq); }
    __builtin_amdgcn_sched_barrier(0);
    {
        const int pos = tid >> 3, cg = tid & 7, ch0 = blk * 128 + cg * 16, p = p0 + pos;
        float z[16];
#pragma unroll
        for (int q = 0; q < 4; ++q) { const f32x4 bv = *(const f32x4*)(a.in[I_CONVB] + ch0 + 4 * q); z[4 * q] = bv.x; z[4 * q + 1] = bv.y; z[4 * q + 2] = bv.z; z[4 * q + 3] = bv.w; }
        v4u ua[4], ub[4]; float msk[4];
#pragma unroll
        for (int w4 = 0; w4 < 4; ++w4) { const int pp = p + w4 - 2; const bool ok = pp >= 0 && pp < seglen; const int ppc = ok ? pp : p;
            const v4u* src = (const v4u*)(UX + (size_t)lru_pos_row(b, isctx, ppc) * 1024 + ch0); ua[w4] = src[0]; ub[w4] = src[1]; msk[w4] = ok ? 1.f : 0.f; }
#pragma unroll
        for (int w4 = 0; w4 < 4; ++w4) { const float* cw = a.in[I_CONVW] + w4 * 1024 + ch0;
            const unsigned uu[8] = {ua[w4].x, ua[w4].y, ua[w4].z, ua[w4].w, ub[w4].x, ub[w4].y, ub[w4].z, ub[w4].w};
#pragma unroll
            for (int q = 0; q < 4; ++q) { const f32x4 cv = *(const f32x4*)(cw + 4 * q) * msk[w4]; z[4 * q] += cv.x * bflo(uu[2 * q]); z[4 * q + 1] += cv.y * bfhi(uu[2 * q]); z[4 * q + 2] += cv.z * bflo(uu[2 * q + 1]); z[4 * q + 3] += cv.w * bfhi(uu[2 * q + 1]); } }
#pragma unroll
        for (int q = 0; q < 4; ++q) *(f32x4*)(zf + pos * 132 + cg * 16 + 4 * q) = (f32x4){z[4 * q], z[4 * q + 1], z[4 * q + 2], z[4 * q + 3]};
        v4u o0, o1; o0.x = pk2(z[0], z[1]); o0.y = pk2(z[2], z[3]); o0.z = pk2(z[4], z[5]); o0.w = pk2(z[6], z[7]); o1.x = pk2(z[8], z[9]); o1.y = pk2(z[10], z[11]); o1.z = pk2(z[12], z[13]); o1.w = pk2(z[14], z[15]);
        *(v4u*)(zb + pos * 136 + cg * 16) = o0; *(v4u*)(zb + pos * 136 + cg * 16 + 8) = o1;
    }
    WG_BAR();
    f32x4 acc[2][2][4];
#pragma unroll
    for (int d = 0; d < 2; ++d)
#pragma unroll
        for (int m = 0; m < 2; ++m)
#pragma unroll
            for (int mt = 0; mt < 4; ++mt) acc[d][m][mt] = (f32x4){0.f, 0.f, 0.f, 0.f};
#pragma unroll
    for (int ks = 0; ks < 4; ++ks) {
        bf16x8_t af[4];
#pragma unroll
        for (int mt = 0; mt < 4; ++mt) af[mt] = *(const bf16x8_t*)(zb + (16 * mt + fr) * 136 + 32 * ks + 8 * fq);
#pragma unroll
        for (int d = 0; d < 2; ++d)
#pragma unroll
            for (int m = 0; m < 2; ++m) {
#pragma unroll
                for (int mt = 0; mt < 4; ++mt) acc[d][m][mt] = __builtin_amdgcn_mfma_f32_16x16x32_bf16(af[mt], wl[d][m][ks], acc[d][m][mt], 0, 0, 0); }
    }
    const int chl = 16 * w + fr, ch = blk * 128 + chl;
    float hsum[4][4];
#pragma unroll
    for (int d = 0; d < 2; ++d) {
        const float ba = gba[d], bx = gbx[d], lam = glam[d];
        const float sp = (-lam > 20.f) ? -lam : log1pf(__expf(-lam));
        float av[4][4], bv[4][4];
#pragma unroll
        for (int mt = 0; mt < 4; ++mt)
#pragma unroll
            for (int r = 0; r < 4; ++r) { const float rr = sigmoidf_(acc[d][0][mt][r] + ba), ii = sigmoidf_(acc[d][1][mt][r] + bx);
                const float aa = __expf(-8.f * rr * sp); av[mt][r] = aa; bv[mt][r] = __builtin_amdgcn_sqrtf(fmaxf(1.f - aa * aa, 0.f)) * ii * zf[(16 * mt + 4 * fq + r) * 132 + chl]; }
        float Pe[4], Se[4], Pt[4], St[4];
#pragma unroll
        for (int mt = 0; mt < 4; ++mt) {
            float P = 1.f, S = 0.f;
#pragma unroll
            for (int rr = 0; rr < 4; ++rr) { const int r = d ? 3 - rr : rr; S = av[mt][r] * S + bv[mt][r]; P = av[mt][r] * P; }
            if (d == 0) {
                float p1 = __shfl_up(P, 16), s1 = __shfl_up(S, 16); if (fq >= 1) { S = P * s1 + S; P = P * p1; }
                p1 = __shfl_up(P, 32); s1 = __shfl_up(S, 32); if (fq >= 2) { S = P * s1 + S; P = P * p1; }
                Pe[mt] = __shfl_up(P, 16); Se[mt] = __shfl_up(S, 16); if (fq == 0) { Pe[mt] = 1.f; Se[mt] = 0.f; }
                Pt[mt] = __shfl(P, fr + 48); St[mt] = __shfl(S, fr + 48);
            } else {
                float p1 = __shfl_down(P, 16), s1 = __shfl_down(S, 16); if (fq <= 2) { S = P * s1 + S; P = P * p1; }
                p1 = __shfl_down(P, 32); s1 = __shfl_down(S, 32); if (fq <= 1) { S = P * s1 + S; P = P * p1; }
                Pe[mt] = __shfl_down(P, 16); Se[mt] = __shfl_down(S, 16); if (fq == 3) { Pe[mt] = 1.f; Se[mt] = 0.f; }
                Pt[mt] = __shfl(P, fr); St[mt] = __shfl(S, fr);
            }
        }
        float2* AGG = (float2*)(a.ws + WS_AGG) + ((size_t)(b * 2 + d) * 36) * 1024 + ch;
        if (!FINAL) {
            if (cidx >= 4) {
                unsigned* PS = (unsigned*)(a.ws + WS_PS) + ((size_t)(b * 2 + d) * NSTEP + 64 * cidx) * 1024 + ch;
#pragma unroll
                for (int mt = 0; mt < 4; ++mt)
#pragma unroll
                    for (int r = 0; r < 4; ++r) PS[(size_t)(16 * mt + 4 * fq + r) * 1024] = pk2(1.f - av[mt][r], bv[mt][r]);
            }
            float Pc = 1.f, Sc = 0.f;
#pragma unroll
            for (int i = 0; i < 4; ++i) { const int mt = d ? 3 - i : i; Sc = Pt[mt] * Sc + St[mt]; Pc = Pt[mt] * Pc; }
            if (fq == 0) AGG[(size_t)cidx * 1024] = make_float2(Pc, Sc);
        } else {
            float h = 0.f;
#pragma unroll
            for (int g3 = 0; g3 < 6; ++g3) {
                float2 qv[6];
#pragma unroll
                for (int i = 0; i < 6; ++i) { const int sidx = 6 * g3 + i; const int c2 = d ? (sidx < 4 ? 3 - sidx : 39 - sidx) : sidx; qv[i] = AGG[(size_t)c2 * 1024]; }
#pragma unroll
                for (int i = 0; i < 6; ++i) { const int sidx = 6 * g3 + i; const int c2 = d ? (sidx < 4 ? 3 - sidx : 39 - sidx) : sidx;
                    const bool use = d ? (sidx < 4 || c2 > cidx) : (c2 < cidx);
                    h = use ? qv[i].x * h + qv[i].y : h; }
            }
#pragma unroll
            for (int i = 0; i < 4; ++i) { const int mt = d ? 3 - i : i;
                float hl = Pe[mt] * h + Se[mt];
#pragma unroll
                for (int rr = 0; rr < 4; ++rr) { const int r = d ? 3 - rr : rr; hl = av[mt][r] * hl + bv[mt][r]; if (d == 0) hsum[mt][r] = hl; else hsum[mt][r] += hl; }
                h = Pt[mt] * h + St[mt]; }
        }
    }
    if (FINAL) {
#pragma unroll
        for (int mt = 0; mt < 4; ++mt)
#pragma unroll
            for (int r = 0; r < 4; ++r) zf[(16 * mt + 4 * fq + r) * 132 + chl] = hsum[mt][r];
        WG_BAR();
        const int pos = tid >> 3, cg = tid & 7, ch0 = blk * 128 + cg * 16;
        const size_t lrow = (size_t)(lru_pos_row(b, false, p0 + pos) - NCTX) * 1024 + ch0;
        const v4u* ug = (const v4u*)((const bf16*)(a.ws + WS_UG) + lrow); const v4u g0 = ug[0], g1 = ug[1];
        const unsigned gg[8] = {g0.x, g0.y, g0.z, g0.w, g1.x, g1.y, g1.z, g1.w}; unsigned o[8];
#pragma unroll
        for (int q = 0; q < 4; ++q) { const f32x4 hv = *(const f32x4*)(zf + pos * 132 + cg * 16 + 4 * q);
            o[2 * q] = pk2(hv.x * bflo(gg[2 * q]), hv.y * bfhi(gg[2 * q])); o[2 * q + 1] = pk2(hv.z * bflo(gg[2 * q + 1]), hv.w * bfhi(gg[2 * q + 1])); }
        v4u* dst = (v4u*)((bf16*)(a.ws + WS_YB) + lrow); dst[0] = (v4u){o[0], o[1], o[2], o[3]}; dst[1] = (v4u){o[4], o[5], o[6], o[7]};
    }
    WG_BAR();
}
constexpr int ML_STRIDE = 136;
constexpr int ML_Q = 0, ML_K = 17408, ML_V = 34816, ML_AUG = 52224  , ML_CB = 54272  ;
constexpr int ML_EB = 93440  , ML_EU = 95488  , ML_EBEND = 97536  , ML_BEND = 97568  , ML_DEN = 97600  , ML_SSQ = 97856  ;
typedef short s4_t __attribute__((ext_vector_type(4)));
__device__ __forceinline__ s4_t ds_tr(const bf16* p) { return __builtin_amdgcn_ds_read_tr16_b64_v4i16((LAS s4_t*)p); }
__device__ __forceinline__ bf16x8_t frag_row(const bf16* img, int row0, int k0, int fr, int fq) { return *(const bf16x8_t*)(img + (row0 + fr) * ML_STRIDE + k0 + 8 * fq); }
__device__ __forceinline__ bf16x8_t frag_tr2(const bf16* img, int stride, int sA, int sB, int col0, int lane) {
    const int fq = lane >> 4, q = (lane & 15) >> 2, p = lane & 3;
    const s4_t lo = ds_tr(img + (sA + 4 * fq + q) * stride + col0 + 4 * p), hi = ds_tr(img + (sB + 4 * fq + q) * stride + col0 + 4 * p);
    return (bf16x8_t){lo.x, lo.y, lo.z, lo.w, hi.x, hi.y, hi.z, hi.w};
}
__device__ __forceinline__ bf16x8_t frag_tr(const bf16* img, int stride, int s0, int col0, int lane) {
    const int fq = lane >> 4, q = (lane & 15) >> 2, p = lane & 3;
    const bf16* b = img + (s0 + 8 * fq + q) * stride + col0 + 4 * p;
    const s4_t lo = ds_tr(b), hi = ds_tr(b + 4 * stride);
    return (bf16x8_t){lo.x, lo.y, lo.z, lo.w, hi.x, hi.y, hi.z, hi.w};
}
__device__ __forceinline__ float logsigmoidf_(float x) { return fminf(x, 0.f) - log1pf(__expf(-fabsf(x))); }

__device__ __forceinline__ void ml_gates(const Args& a, unsigned char* lds_g, int rowbase, int h, int tid) {
    const int lane = tid & 63, w = tid >> 6, dir = w >> 2, c = w & 3;
    const float* GT = (const float*)(a.ws + WS_GATES) + (size_t)(rowbase + 64 * c + lane) * 32;
    const float ipre = GT[(dir * 2) * 8 + h], fpre = GT[(dir * 2 + 1) * 8 + h];
    float bsum = logsigmoidf_(fpre);
    if (dir == 0) {
#pragma unroll
        for (int o = 1; o < 64; o <<= 1) { const float t = __shfl_up(bsum, o); if (lane >= o) bsum += t; }
    } else {
#pragma unroll
        for (int o = 1; o < 64; o <<= 1) { const float t = __shfl_down(bsum, o); if (lane + o < 64) bsum += t; }
    }
    float* eb = (float*)(lds_g + ML_EB); float* eu = (float*)(lds_g + ML_EU);
    eb[dir * 256 + 64 * c + lane] = __expf(bsum); eu[dir * 256 + 64 * c + lane] = __expf(ipre - bsum);
    const float bend = __shfl(bsum, dir ? 0 : 63);
    if (lane == 0) { ((float*)(lds_g + ML_EBEND))[dir * 4 + c] = __expf(bend); ((float*)(lds_g + ML_BEND))[dir * 4 + c] = bend; }
}

template <bool OUT, bool PASS2>
__device__ __forceinline__ void ml_block(const Args& a, unsigned char* lds_g, int rowbase, int h, int dir, f32x4 (&st)[9], int tid) {
    const int lane = tid & 63, w = __builtin_amdgcn_readfirstlane(tid >> 6), fr = lane & 15, fq = lane >> 4;
    bf16* Qi = (bf16*)(lds_g + ML_Q); bf16* Ki = (bf16*)(lds_g + ML_K); bf16* Vi = (bf16*)(lds_g + ML_V); bf16* AUGi = (bf16*)(lds_g + ML_AUG); bf16* CB = (bf16*)(lds_g + ML_CB);
    const float* eb = (const float*)(lds_g + ML_EB) + dir * 256; const float* eu = (const float*)(lds_g + ML_EU) + dir * 256;
    const float* ebend = (const float*)(lds_g + ML_EBEND) + dir * 4;
    float* den = (float*)(lds_g + ML_DEN); float* ssq = (float*)(lds_g + ML_SSQ);
    const bf16* Kb = (const bf16*)(a.ws + WS_K); const bf16* Vb = (const bf16*)(a.ws + WS_V); const bf16* Qb = (const bf16*)(a.ws + WS_Q);
    const int ti = w & 3, vh = w >> 2;
    float hgv[5];
    if (OUT) {
#pragma unroll
        for (int x = 0; x < 5; ++x) { const int vt = vh * 5 + x; hgv[x] = vt < 8 ? a.in[I_HEADG][h * 128 + 16 * vt + fr] : 0.f; } }
    for (int ci = 0; ci < 4; ++ci) {
        const int c = dir ? 3 - ci : ci;
        unsigned short ogv[5][4]; unsigned short tmv[5][4];
        if (OUT) {
            const bf16* OGp = (const bf16*)(a.ws + (dir ? WS_OB : WS_OF)); const bf16* TMp = (const bf16*)(a.ws + WS_TM);
#pragma unroll
            for (int r = 0; r < 4; ++r) { const size_t ob = (size_t)(rowbase - NCTX + 64 * c + 16 * ti + 4 * fq + r) * 1024 + h * 128;
#pragma unroll
                for (int x = 0; x < 5; ++x) { const int vt = vh * 5 + x; if (vt < 8) { ogv[x][r] = OGp[ob + 16 * vt + fr]; if (PASS2) tmv[x][r] = TMp[ob + 16 * vt + fr]; } } }
            __builtin_amdgcn_sched_barrier(0);
        }
        {
            const int t = tid >> 3, pc = tid & 7; const size_t row = (size_t)(rowbase + 64 * c + t);
            const v4u* ks = (const v4u*)(Kb + row * 1024 + h * 128 + 16 * pc); const v4u k0 = ks[0], k1 = ks[1];
            const v4u* vs = (const v4u*)(Vb + row * 1024 + h * 128 + 16 * pc); const v4u v0 = vs[0], v1 = vs[1];
            v4u q0, q1; if (OUT) { const v4u* qs = (const v4u*)(Qb + (row - NCTX) * 1024 + h * 128 + 16 * pc); q0 = qs[0]; q1 = qs[1]; }
            const float e = eu[64 * c + t];
            *(v4u*)(Ki + t * ML_STRIDE + 16 * pc) = k0; *(v4u*)(Ki + t * ML_STRIDE + 16 * pc + 8) = k1;
            if (OUT) { *(v4u*)(Qi + t * ML_STRIDE + 16 * pc) = q0; *(v4u*)(Qi + t * ML_STRIDE + 16 * pc + 8) = q1; }
            const unsigned vv[8] = {v0.x, v0.y, v0.z, v0.w, v1.x, v1.y, v1.z, v1.w}; unsigned o[8];
#pragma unroll
            for (int i = 0; i < 8; ++i) o[i] = pk2(bflo(vv[i]) * e, bfhi(vv[i]) * e);
            *(v4u*)(Vi + t * ML_STRIDE + 16 * pc) = (v4u){o[0], o[1], o[2], o[3]}; *(v4u*)(Vi + t * ML_STRIDE + 16 * pc + 8) = (v4u){o[4], o[5], o[6], o[7]};
            if (pc == 0) { *(v4u*)(AUGi + t * 16) = (v4u){f2bf(e), 0u, 0u, 0u}; *(v4u*)(AUGi + t * 16 + 8) = (v4u){0u, 0u, 0u, 0u}; }
        }
        WG_BAR();
        f32x4 X[5]; float hval[4][4];
        if (OUT) {
            bf16x8_t qf[4];
#pragma unroll
            for (int ks = 0; ks < 4; ++ks) qf[ks] = frag_row(Qi, 16 * ti, 32 * ks, fr, fq);
            bf16x8_t P[2]; bool pv[2];
#pragma unroll
            for (int pp = 0; pp < 2; ++pp) {
                f32x4 d[2];
#pragma unroll
                for (int hh = 0; hh < 2; ++hh) { const int si = 2 * pp + hh; d[hh] = (f32x4){0.f, 0.f, 0.f, 0.f};
                    const bool valid = dir ? (si >= ti) : (si <= ti);
                    if (valid) {
#pragma unroll
                        for (int ks = 0; ks < 4; ++ks) d[hh] = __builtin_amdgcn_mfma_f32_16x16x32_bf16(frag_row(Ki, 16 * si, 32 * ks, fr, fq), qf[ks], d[hh], 0, 0, 0);
                        if (si == ti) {
#pragma unroll
                            for (int r = 0; r < 4; ++r) { const bool keep = dir ? (4 * fq + r >= fr) : (4 * fq + r <= fr); d[hh][r] = keep ? d[hh][r] : 0.f; } } } }
                pv[pp] = dir ? (2 * pp + 1 >= ti) : (2 * pp <= ti);
                const unsigned p0 = pk2(d[0][0], d[0][1]), p1 = pk2(d[0][2], d[0][3]), p2 = pk2(d[1][0], d[1][1]), p3 = pk2(d[1][2], d[1][3]);
                P[pp] = __builtin_bit_cast(bf16x8_t, (v4u){p0, p1, p2, p3});
            }
#pragma unroll
            for (int x = 0; x < 5; ++x) { X[x] = (f32x4){0.f, 0.f, 0.f, 0.f};
                const int vt = vh * 5 + x;
                if (vt < 9) {
#pragma unroll
                    for (int pp = 0; pp < 2; ++pp) if (pv[pp]) {
                        const bf16x8_t bfv = vt < 8 ? frag_tr2(Vi, ML_STRIDE, 32 * pp, 32 * pp + 16, 16 * vt, lane) : frag_tr2(AUGi, 16, 32 * pp, 32 * pp + 16, 0, lane);
                        X[x] = __builtin_amdgcn_mfma_f32_16x16x32_bf16(P[pp], bfv, X[x], 0, 0, 0); }
#pragma unroll
                    for (int ks = 0; ks < 4; ++ks) X[x] = __builtin_amdgcn_mfma_f32_16x16x32_bf16(qf[ks], frag_row(CB, 16 * vt, 32 * ks, fr, fq), X[x], 0, 0, 0);
                } }
            if (vh == 1 && fr == 0) {
#pragma unroll
                for (int r = 0; r < 4; ++r) den[16 * ti + 4 * fq + r] = X[3][r] * eb[64 * c + 16 * ti + 4 * fq + r]; }
        }
        {
#pragma unroll
            for (int ks = 0; ks < 2; ++ks) { const bf16x8_t kf = frag_tr(Ki, ML_STRIDE, 32 * ks, 16 * w, lane);
#pragma unroll
                for (int vt = 0; vt < 8; ++vt) st[vt] = __builtin_amdgcn_mfma_f32_16x16x32_bf16(kf, frag_tr(Vi, ML_STRIDE, 32 * ks, 16 * vt, lane), st[vt], 0, 0, 0);
                st[8] = __builtin_amdgcn_mfma_f32_16x16x32_bf16(kf, frag_tr(AUGi, 16, 32 * ks, 0, lane), st[8], 0, 0, 0); }
            const float ee = ebend[c];
#pragma unroll
            for (int vt = 0; vt < 9; ++vt) st[vt] = st[vt] * ee;
        }
        WG_BAR();
        if (OUT) {
            float sq[4] = {0.f, 0.f, 0.f, 0.f};
#pragma unroll
            for (int r = 0; r < 4; ++r) { const int t = 16 * ti + 4 * fq + r; const float sc = eb[64 * c + t] * __builtin_amdgcn_rcpf(fmaxf(fabsf(den[t]), 1.f));
#pragma unroll
                for (int x = 0; x < 4; ++x) { const int vt = vh * 5 + x; const float hv = (vt < 8) ? X[x][r] * sc : 0.f; hval[x][r] = hv; sq[r] += hv * hv; }
                if (vh == 0) { const float hv = X[4][r] * sc; X[4][r] = hv; sq[r] += hv * hv; } }
#pragma unroll
            for (int r = 0; r < 4; ++r) { float v = sq[r]; v += __shfl_xor(v, 1); v += __shfl_xor(v, 2); v += __shfl_xor(v, 4); v += __shfl_xor(v, 8); if (fr == 0) ssq[vh * 64 + 16 * ti + 4 * fq + r] = v; }
#pragma unroll
            for (int vt = 0; vt < 9; ++vt) { pg8::u32x2 o; o.x = pk2(st[vt][0], st[vt][1]); o.y = pk2(st[vt][2], st[vt][3]); *(pg8::u32x2*)(CB + (16 * vt + fr) * ML_STRIDE + 16 * w + 4 * fq) = o; }
            WG_BAR();
            bf16* TM = (bf16*)(a.ws + WS_TM); bf16* YA = (bf16*)(a.ws + WS_YA);
#pragma unroll
            for (int r = 0; r < 4; ++r) { const int t = 16 * ti + 4 * fq + r; const float rs = __builtin_amdgcn_rsqf((ssq[t] + ssq[64 + t]) * (1.f / 128.f) + EPS);
                const size_t ob = (size_t)(rowbase - NCTX + 64 * c + t) * 1024 + h * 128;
#pragma unroll
                for (int x = 0; x < 5; ++x) { const int vt = vh * 5 + x; if (vt < 8) { const int v = 16 * vt + fr; const float hv = (x < 4) ? hval[x][r] : X[4][r];
                    float y = hv * rs * hgv[x] * bf2f(ogv[x][r]);
                    if (PASS2) { y += bf2f(tmv[x][r]); YA[ob + v] = (bf16)f2bf(y); } else TM[ob + v] = (bf16)f2bf(y); } } }
        }
    }
}

__device__ __forceinline__ void ml_state_quad(const Args& a, unsigned char* lds_g, int qu, int tid) {
    const int seq = qu >> 1, j0 = 4 * (qu & 1), dir = seq & 1, h = (seq >> 1) & 7, b = seq >> 4;
    const int lane = tid & 63, w = __builtin_amdgcn_readfirstlane(tid >> 6);
    f32x4 st[9];
#pragma unroll
    for (int vt = 0; vt < 9; ++vt) st[vt] = (f32x4){0.f, 0.f, 0.f, 0.f};
#pragma unroll 1
    for (int jj = 0; jj < 4; ++jj) {
        const int j = j0 + jj, su = seq * 8 + j;
        const int rowbase = j == 0 ? b * CTXL : NCTX + b * SEQ + 256 * (dir ? 8 - j : j - 1);
        ml_gates(a, lds_g, rowbase, h, tid);
        WG_BAR();
        ml_block<false, false>(a, lds_g, rowbase, h, dir, st, tid);
        pg8::u32x2* SL = (pg8::u32x2*)(a.ws + WS_SLOC) + ((size_t)(su * 8 + w) * 9) * 64 + lane;
#pragma unroll
        for (int vt = 0; vt < 9; ++vt) { pg8::u32x2 o; o.x = pk2(st[vt][0], st[vt][1]); o.y = pk2(st[vt][2], st[vt][3]); SL[vt * 64] = o; }
        if (tid == 0) { const float* bd = (const float*)(lds_g + ML_BEND) + dir * 4; ((float*)(a.ws + WS_BT))[su] = (bd[0] + bd[1]) + (bd[2] + bd[3]); }
        WG_BAR();
    }
}
__device__ __forceinline__ void ml_out_unit(const Args& a, unsigned char* lds_g, int u, int tid) {
    const int L = u & 7, h = (u >> 3) & 7, b = u >> 6;
    const int rowbase = NCTX + b * SEQ + 256 * L;
    const int lane = tid & 63, w = __builtin_amdgcn_readfirstlane(tid >> 6), fr = lane & 15, fq = lane >> 4;
    bf16* CB = (bf16*)(lds_g + ML_CB);
    ml_gates(a, lds_g, rowbase, h, tid);
    f32x4 st[9];
#pragma unroll
    for (int dir = 0; dir < 2; ++dir) {
        const int seq = (b * 8 + h) * 2 + dir, jmax = dir ? 7 - L : L;
        const float* BT = (const float*)(a.ws + WS_BT) + seq * 8;
        {
            const pg8::u32x2* SLa = (const pg8::u32x2*)(a.ws + WS_SLOC) + ((size_t)((seq * 8 + jmax) * 8 + w) * 9) * 64 + lane;
            const pg8::u32x2* SLb = (const pg8::u32x2*)(a.ws + WS_SLOC) + ((size_t)((seq * 8 + 3) * 8 + w) * 9) * 64 + lane;
            pg8::u32x2 sa[9];
            if (jmax >= 4) {
                pg8::u32x2 sb[9];
#pragma unroll
                for (int vt = 0; vt < 9; ++vt) { sa[vt] = SLa[vt * 64]; sb[vt] = SLb[vt * 64]; }
                float ls = 0.f;
#pragma unroll
                for (int q = 4; q < 8; ++q) ls += (q <= jmax) ? BT[q] : 0.f;
                const float coef = __expf(ls);
#pragma unroll
                for (int vt = 0; vt < 9; ++vt) st[vt] = (f32x4){bflo(sa[vt].x) + bflo(sb[vt].x) * coef, bfhi(sa[vt].x) + bfhi(sb[vt].x) * coef, bflo(sa[vt].y) + bflo(sb[vt].y) * coef, bfhi(sa[vt].y) + bfhi(sb[vt].y) * coef};
            } else {
#pragma unroll
                for (int vt = 0; vt < 9; ++vt) { sa[vt] = SLa[vt * 64]; st[vt] = (f32x4){bflo(sa[vt].x), bfhi(sa[vt].x), bflo(sa[vt].y), bfhi(sa[vt].y)}; }
            }
        }
#pragma unroll
        for (int vt = 0; vt < 9; ++vt) { pg8::u32x2 o; o.x = pk2(st[vt][0], st[vt][1]); o.y = pk2(st[vt][2], st[vt][3]); *(pg8::u32x2*)(CB + (16 * vt + fr) * ML_STRIDE + 16 * w + 4 * fq) = o; }
        WG_BAR();
        if (dir == 0) ml_block<true, false>(a, lds_g, rowbase, h, 0, st, tid);
        else ml_block<true, true>(a, lds_g, rowbase, h, 1, st, tid);
        asm volatile("s_waitcnt vmcnt(0)" ::: "memory");
        WG_BAR();
    }
}

__device__ __forceinline__ void lru_out_unit(const Args& a, unsigned char* lds_g, int b, int cidx, int blk, int tid) {
    const int chl = tid & 127, q = tid >> 7, ch = blk * 128 + chl;
    float2* QA = (float2*)lds_g;
    float av[2][16], bv[2][16];
#pragma unroll
    for (int d = 0; d < 2; ++d) { const unsigned* PS = (const unsigned*)(a.ws + WS_PS) + ((size_t)(b * 2 + d) * NSTEP + 64 * cidx + 16 * q) * 1024 + ch;
#pragma unroll
        for (int i = 0; i < 16; ++i) { const unsigned wv = PS[(size_t)i * 1024]; av[d][i] = 1.f - bflo(wv); bv[d][i] = bfhi(wv); } }
    float2* CA = (float2*)(lds_g + 8192);
#pragma unroll
    for (int d = 0; d < 2; ++d) { const float2* AGG = (const float2*)(a.ws + WS_AGG) + ((size_t)(b * 2 + d) * 36) * 1024 + ch; float2 qv[9];
#pragma unroll
        for (int i = 0; i < 9; ++i) { const int sidx = 9 * q + i; const int c2 = d ? (sidx < 4 ? 3 - sidx : 39 - sidx) : sidx; qv[i] = AGG[(size_t)c2 * 1024]; }
        float P = 1.f, S = 0.f;
#pragma unroll
        for (int i = 0; i < 9; ++i) { const int sidx = 9 * q + i; const int c2 = d ? (sidx < 4 ? 3 - sidx : 39 - sidx) : sidx; const bool use = d ? (sidx < 4 || c2 > cidx) : (c2 < cidx);
            S = use ? qv[i].x * S + qv[i].y : S; P = use ? qv[i].x * P : P; }
        CA[(d * 4 + q) * 128 + chl] = make_float2(P, S); }
#pragma unroll
    for (int d = 0; d < 2; ++d) { float P = 1.f, S = 0.f;
#pragma unroll
        for (int ii = 0; ii < 16; ++ii) { const int i = d ? 15 - ii : ii; S = av[d][i] * S + bv[d][i]; P = av[d][i] * P; }
        QA[(d * 4 + q) * 128 + chl] = make_float2(P, S); }
    WG_BAR();
    float hs[16];
#pragma unroll
    for (int d = 0; d < 2; ++d) { float h = 0.f;
#pragma unroll
        for (int k = 0; k < 4; ++k) { const float2 t = CA[(d * 4 + k) * 128 + chl]; h = t.x * h + t.y; }
#pragma unroll
        for (int k = 0; k < 3; ++k) { const int qq = d ? 3 - k : k; const bool use = d ? (qq > q) : (qq < q); const float2 t = QA[(d * 4 + qq) * 128 + chl]; h = use ? t.x * h + t.y : h; }
#pragma unroll
        for (int ii = 0; ii < 16; ++ii) { const int i = d ? 15 - ii : ii; h = av[d][i] * h + bv[d][i]; if (d == 0) hs[i] = h; else hs[i] += h; } }
    const int p0 = (cidx - 4) * 64 + 16 * q;
    unsigned short ugv[16];
#pragma unroll
    for (int i = 0; i < 16; ++i) ugv[i] = ((const bf16*)(a.ws + WS_UG))[(size_t)(lru_pos_row(b, false, p0 + i) - NCTX) * 1024 + ch];
#pragma unroll
    for (int i = 0; i < 16; ++i) { const size_t lrow = (size_t)(lru_pos_row(b, false, p0 + i) - NCTX) * 1024 + ch;
        ((bf16*)(a.ws + WS_YB))[lrow] = (bf16)f2bf(hs[i] * bf2f(ugv[i])); }
    WG_BAR();
}
__device__ __forceinline__ void phase3(const Args& a, unsigned char* lds_g, int tid) {
    {
        int q0 = (int)blockIdx.x, qstep = (int)gridDim.x;
        if (gridDim.x == 256) q0 = blockIdx.x >= 128 ? (int)blockIdx.x - 128 : 128;
        for (int qu = q0; qu < 128; qu += qstep) ml_state_quad(a, lds_g, qu, tid);
    }
    for (int u = blockIdx.x; u < 4 * 36 * 8; u += gridDim.x) { const int blk = u & 7, q = u >> 3; lru_unit<false>(a, lds_g, q / 36, q % 36, blk, tid); }
}

struct SchedProj {
    int G, c; const char *YA, *YB, *WA, *WB;
    __device__ __forceinline__ bool next(int i, pg8::Unit& u) const {
        const int tile = (i >> 1) * G + c, part = i & 1; if (tile >= 256) return false;
        int pm, pn; pg8::tile_order(tile, 32, 8, pm, pn);
        u.pm = pm; u.pn = pn; u.aux = part; u.A = (part ? YB : YA) + (size_t)pm * 256 * 1024 * 2; u.B = (part ? WB : WA) + (size_t)pn * 256 * 1024 * 2; return true;
    }
};
struct EpiProj {
    static constexpr bool PERM = true, CARRY = true;
    const bf16 *GA, *GB; bf16* PRE;
    __device__ __forceinline__ bool keep(const pg8::Unit& u) const { return u.aux == 0; }
    __device__ __forceinline__ void operator()(pg8::f32x4 (&acc)[2][2][4][2], const pg8::Unit& u, int wr, int wc, int fr, int fq) const {
#pragma unroll
        for (int ai = 0; ai < 2; ++ai) {
            pg8::u32x4 gb4[4][2], ga4[4][2];
#pragma unroll
            for (int m = 0; m < 4; ++m) { const size_t off = (size_t)(u.pm * 256 + ai * 128 + wr * 64 + m * 16 + fr) * 2048 + u.pn * 256 + wc * 32 + 8 * fq;
#pragma unroll
                for (int bj = 0; bj < 2; ++bj) { gb4[m][bj] = *(const pg8::u32x4*)(GB + off + bj * 128); if (u.aux == 0) ga4[m][bj] = *(const pg8::u32x4*)(GA + off + bj * 128); } }
#pragma unroll
            for (int m = 0; m < 4; ++m) { const size_t off = (size_t)(u.pm * 256 + ai * 128 + wr * 64 + m * 16 + fr) * 2048 + u.pn * 256 + wc * 32 + 8 * fq;
#pragma unroll
                for (int bj = 0; bj < 2; ++bj) { const pg8::u32x4 g4 = gb4[m][bj];
                    const float gbv[8] = {bflo(g4.x), bfhi(g4.x), bflo(g4.y), bfhi(g4.y), bflo(g4.z), bfhi(g4.z), bflo(g4.w), bfhi(g4.w)};
                    if (u.aux == 0) { const pg8::u32x4 a4 = ga4[m][bj];
                        const float gav[8] = {bflo(a4.x), bfhi(a4.x), bflo(a4.y), bfhi(a4.y), bflo(a4.z), bfhi(a4.z), bflo(a4.w), bfhi(a4.w)};
#pragma unroll
                        for (int e = 0; e < 4; ++e) { acc[ai][bj][m][0][e] *= gav[e] * __builtin_amdgcn_rcpf(fmaxf(gbv[e], 1e-20f)); acc[ai][bj][m][1][e] *= gav[4 + e] * __builtin_amdgcn_rcpf(fmaxf(gbv[4 + e], 1e-20f)); }
                    } else {
                        pg8::f32x4 v0 = acc[ai][bj][m][0], v1 = acc[ai][bj][m][1];
#pragma unroll
                        for (int e = 0; e < 4; ++e) { v0[e] *= gbv[e]; v1[e] *= gbv[4 + e]; }
                        pg8::u32x4 w; w.x = pg8::cvt_pk_bf16(v0[0], v0[1]); w.y = pg8::cvt_pk_bf16(v0[2], v0[3]); w.z = pg8::cvt_pk_bf16(v1[0], v1[1]); w.w = pg8::cvt_pk_bf16(v1[2], v1[3]);
                        *(pg8::u32x4*)(PRE + off + bj * 128) = w; } } }
        }
    }
};

struct SchedOut {
    int G, c; const char *A, *B;
    __device__ __forceinline__ bool next(int i, pg8::Unit& u) const {
        const int L = i * G + c; if (L >= 256) return false;
        int pm, pn; pg8::tile_order(L, 32, 8, pm, pn);
        u.pm = pm; u.pn = pn; u.aux = 0; u.A = A + (size_t)pm * 256 * D * 2; u.B = B + (size_t)pn * 256 * D * 2; return true;
    }
};
struct EpiOut {
    static constexpr bool PERM = true, CARRY = false;
    __device__ __forceinline__ bool keep(const pg8::Unit&) const { return false; }
    const float* x; const float* MOD; bf16* X1;
    __device__ __forceinline__ void operator()(const pg8::f32x4 (&acc)[2][2][4][2], const pg8::Unit& u, int wr, int wc, int fr, int fq) const {
        const int b = u.pm >> 3; const int col0 = u.pn * 256 + wc * 32 + 8 * fq;
        pg8::f32x4 g1[2][2];
#pragma unroll
        for (int bj = 0; bj < 2; ++bj)
#pragma unroll
            for (int n = 0; n < 2; ++n) g1[bj][n] = *(const pg8::f32x4*)(MOD + b * 12288 + 2 * 2048 + col0 + bj * 128 + n * 4);
#pragma unroll
        for (int ai = 0; ai < 2; ++ai) {
            pg8::f32x4 xv[4][2][2];
#pragma unroll
            for (int m = 0; m < 4; ++m) { const size_t off = (size_t)(u.pm * 256 + ai * 128 + wr * 64 + m * 16 + fr) * D + col0;
#pragma unroll
                for (int bj = 0; bj < 2; ++bj)
#pragma unroll
                    for (int n = 0; n < 2; ++n) xv[m][bj][n] = *(const pg8::f32x4*)(x + off + bj * 128 + n * 4); }
#pragma unroll
            for (int m = 0; m < 4; ++m) { const size_t off = (size_t)(u.pm * 256 + ai * 128 + wr * 64 + m * 16 + fr) * D + col0;
#pragma unroll
                for (int bj = 0; bj < 2; ++bj) { const pg8::f32x4 v0 = xv[m][bj][0] + g1[bj][0] * acc[ai][bj][m][0], v1 = xv[m][bj][1] + g1[bj][1] * acc[ai][bj][m][1];
                    pg8::u32x4 w; w.x = pg8::cvt_pk_bf16(v0[0], v0[1]); w.y = pg8::cvt_pk_bf16(v0[2], v0[3]); w.z = pg8::cvt_pk_bf16(v1[0], v1[1]); w.w = pg8::cvt_pk_bf16(v1[2], v1[3]);
                    *(pg8::u32x4*)(X1 + off + bj * 128) = w; } }
        }
    }
};

__device__ __forceinline__ void phase_router(const Args& a, unsigned char* lds_g, int tid, int lane, int wave) {
    const bf16* X1 = (const bf16*)(a.ws + WS_X1); const float* MOD = (const float*)(a.ws + WS_MOD); const float* g = a.in[I_N2G];
    const float* WR = (const float*)(a.ws + WS_WR); const float* RB = (const float*)(a.ws + WS_RB);
    bf16* H2 = (bf16*)(a.ws + WS_H2); unsigned* cnt = (unsigned*)(a.ws + WS_CTL) + CW_CNT; int4* ASG = (int4*)(a.ws + WS_ASG);
    f32x4* PART = (f32x4*)lds_g;
    float* SSQP = (float*)(lds_g + 24576);
    float* RS = (float*)(lds_g + 24576 + 512);
    float* LG = (float*)(lds_g + 24576 + 1024);
    const int slot = wave >> 2, kq = wave & 3, i = lane & 15, gq = lane >> 4;
    for (int tp = blockIdx.x; tp < NLAT / 32; tp += gridDim.x) {
        const int tok0 = 32 * tp + 16 * slot, b = tok0 >> 11, kbase = kq * 512 + 8 * gq;
        const bf16* xr = X1 + (size_t)(tok0 + i) * D + kbase;
        const float* wr = WR + ((size_t)(b * 48 + i) * 2048 + kbase);
        f32x4 acc0 = (f32x4){0.f, 0.f, 0.f, 0.f}, acc1 = acc0, acc2 = acc0; float sq = 0.f;
#pragma unroll 2
        for (int s8 = 0; s8 < 16; ++s8) {
            const v4u xb = *(const v4u*)(xr + 32 * s8);
            const f32x4 b0a = *(const f32x4*)(wr + 32 * s8), b0b = *(const f32x4*)(wr + 32 * s8 + 4), b1a = *(const f32x4*)(wr + 16 * 2048 + 32 * s8), b1b = *(const f32x4*)(wr + 16 * 2048 + 32 * s8 + 4),
                        b2a = *(const f32x4*)(wr + 32 * 2048 + 32 * s8), b2b = *(const f32x4*)(wr + 32 * 2048 + 32 * s8 + 4);
            const float xe[8] = {bflo(xb.x), bfhi(xb.x), bflo(xb.y), bfhi(xb.y), bflo(xb.z), bfhi(xb.z), bflo(xb.w), bfhi(xb.w)};
#pragma unroll
            for (int e = 0; e < 4; ++e) { acc0 = __builtin_amdgcn_mfma_f32_16x16x4f32(xe[e], b0a[e], acc0, 0, 0, 0); acc1 = __builtin_amdgcn_mfma_f32_16x16x4f32(xe[e], b1a[e], acc1, 0, 0, 0); acc2 = __builtin_amdgcn_mfma_f32_16x16x4f32(xe[e], b2a[e], acc2, 0, 0, 0); }
#pragma unroll
            for (int e = 0; e < 4; ++e) { acc0 = __builtin_amdgcn_mfma_f32_16x16x4f32(xe[4 + e], b0b[e], acc0, 0, 0, 0); acc1 = __builtin_amdgcn_mfma_f32_16x16x4f32(xe[4 + e], b1b[e], acc1, 0, 0, 0); acc2 = __builtin_amdgcn_mfma_f32_16x16x4f32(xe[4 + e], b2b[e], acc2, 0, 0, 0); }
#pragma unroll
            for (int e = 0; e < 8; ++e) sq += xe[e] * xe[e];
        }
        sq += __shfl_xor(sq, 16); sq += __shfl_xor(sq, 32);
        PART[((slot * 4 + kq) * 3 + 0) * 64 + lane] = acc0; PART[((slot * 4 + kq) * 3 + 1) * 64 + lane] = acc1; PART[((slot * 4 + kq) * 3 + 2) * 64 + lane] = acc2;
        if (gq == 0) SSQP[(slot * 4 + kq) * 16 + i] = sq;
        __syncthreads();
        if (kq == 0) {
            const float* sp = SSQP + slot * 64; const float rstd = 1.f / sqrtf(((sp[i] + sp[16 + i]) + (sp[32 + i] + sp[48 + i])) * (1.f / D) + EPS);
            if (gq == 0) RS[slot * 16 + i] = rstd;
#pragma unroll
            for (int cb = 0; cb < 3; ++cb) { const f32x4* pp = PART + (slot * 4 * 3 + cb) * 64 + lane; const f32x4 sum = (pp[0] + pp[3 * 64]) + (pp[6 * 64] + pp[9 * 64]);
                const float rb = RB[b * 48 + 16 * cb + i];
#pragma unroll
                for (int r = 0; r < 4; ++r) LG[(slot * 16 + 4 * gq + r) * 48 + 16 * cb + i] = __shfl(rstd, 4 * gq + r) * sum[r] + rb; }
            LDS_WAIT(); asm volatile("" ::: "memory");
            if (lane < 16) {
                const float* lg = LG + (slot * 16 + lane) * 48; const int t = tok0 + lane;
                int gs = 0; float gm = lg[32];
#pragma unroll
                for (int q = 1; q < 4; ++q) { const float v = lg[32 + q]; if (v > gm) { gm = v; gs = q; } }
                float se = 0.f;
#pragma unroll
                for (int q = 0; q < 4; ++q) se += __expf(lg[32 + q] - gm);
                const float pg = 1.f / se;
                int i0 = 0; float v0 = lg[gs * 8];
#pragma unroll
                for (int q = 1; q < 8; ++q) { const float v = lg[gs * 8 + q]; if (v > v0) { v0 = v; i0 = q; } }
                int i1 = -1; float v1 = -3.0e38f;
#pragma unroll
                for (int q = 0; q < 8; ++q) { const float v = lg[gs * 8 + q]; if (q != i0 && v > v1) { v1 = v; i1 = q; } }
                const float e1 = __expf(v1 - v0), w0 = pg / (1.f + e1), w1 = pg * e1 / (1.f + e1);
                const int ex0 = gs * 8 + i0, ex1 = gs * 8 + i1;
                const unsigned p0 = atomicAdd(cnt + ex0, 1u), p1 = atomicAdd(cnt + ex1, 1u);
                ASG[2 * t] = make_int4(ex0, (int)p0, __float_as_int(w0), 0); ASG[2 * t + 1] = make_int4(ex1, (int)p1, __float_as_int(w1), 0);
                int* LIST = (int*)(a.ws + WS_LIST); LIST[ex0 * 8192 + (int)p0] = t; LIST[ex1 * 8192 + (int)p1] = t;
            }
        }
        __syncthreads();
#pragma unroll
        for (int r = 0; r < 4; ++r) { const int tl = 4 * kq + r, t = tok0 + tl; const float rstd = RS[slot * 16 + tl];
            const unsigned long long* xrow = (const unsigned long long*)(X1 + (size_t)t * D) + lane; unsigned* o4 = (unsigned*)((unsigned char*)H2 + (size_t)t * D) + lane;
            f32x4 yv[8];
#pragma unroll
            for (int j = 0; j < 8; ++j) { const int c = 4 * lane + 256 * j;
                const f32x4 gg = *(const f32x4*)(g + c), sh = *(const f32x4*)(MOD + b * 12288 + 3 * 2048 + c), sc = *(const f32x4*)(MOD + b * 12288 + 4 * 2048 + c);
                const unsigned long long xw = xrow[64 * j]; const f32x4 xv4 = (f32x4){bflo((unsigned)xw), bfhi((unsigned)xw), bflo((unsigned)(xw >> 32)), bfhi((unsigned)(xw >> 32))};
                yv[j] = xv4 * rstd * gg * (sc + 1.f) + sh; }
#pragma unroll
            for (int j = 0; j < 8; ++j) { int w8 = __builtin_amdgcn_cvt_pk_fp8_f32(yv[j].x, yv[j].y, 0, false); w8 = __builtin_amdgcn_cvt_pk_fp8_f32(yv[j].z, yv[j].w, w8, true); o4[64 * j] = (unsigned)w8; } }
        __syncthreads();
    }
}

constexpr int MG_A = 0, MG_ABYTES = 32768, MG_B = 65536, MG_BBYTES = 64 * 256  , MG_CUM = 141312  ;
__device__ __forceinline__ int mgb_off(int row, int ch) { return 256 * row + 16 * (ch ^ (((row & 3) << 2) | ((row >> 2) & 3))); }
__device__ __forceinline__ bf16x8_t mgb_frag(const unsigned char* img, int ks, int c, int lane) {
    const int g = lane >> 4, q = (lane & 15) >> 2, p = lane & 3;
    const s4_t lo = ds_tr((const bf16*)(img + mgb_off(32 * ks + 8 * g + q, 2 * c + (p >> 1)) + 8 * (p & 1)));
    const s4_t hi = ds_tr((const bf16*)(img + mgb_off(32 * ks + 8 * g + 4 + q, 2 * c + (p >> 1)) + 8 * (p & 1)));
    return (bf16x8_t){lo.x, lo.y, lo.z, lo.w, hi.x, hi.y, hi.z, hi.w};
}
__device__ __forceinline__ void moe_tables(const Args& a, unsigned char* lds_g, int tid) {
    int* cum = (int*)(lds_g + MG_CUM); const unsigned* ctl = (const unsigned*)(a.ws + WS_CTL);
    if (tid < NEXP) cum[128 + tid] = (int)ctl[CW_CNT + tid];
    if (tid == 0) { int c = 0; for (int e = 0; e < NEXP; ++e) { cum[e] = c; c += (int)((ctl[CW_CNT + e] + 255u) >> 8); } cum[NEXP] = c; }
    __syncthreads();
}
constexpr int MH_A = 0, MH_ABYTES = 32768, MH_B = 65536, MH_BROW = 528, MH_BBYTES = 64 * MH_BROW  ;
__device__ __forceinline__ int mhb_off(int row, int ch) { return MH_BROW * row + 16 * ch; }
__device__ __forceinline__ bf16x8_t mhb_frag(const LAS unsigned char* lbase, int cofs) {
    const s4_t lo = __builtin_amdgcn_ds_read_tr16_b64_v4i16((LAS s4_t*)(lbase + cofs));
    const s4_t hi = __builtin_amdgcn_ds_read_tr16_b64_v4i16((LAS s4_t*)(lbase + cofs + 4 * MH_BROW));
    return (bf16x8_t){lo.x, lo.y, lo.z, lo.w, hi.x, hi.y, hi.z, hi.w};
}
__device__ __forceinline__ int fresh_lane() { int l; asm volatile("v_mbcnt_lo_u32_b32 %0, -1, 0\n\tv_mbcnt_hi_u32_b32 %0, -1, %0" : "=v"(l)); __builtin_assume(l >= 0 && l < 64); return l; }
__device__ __forceinline__ int moe_pull(const Args& a, unsigned char* lds_g, int w, int x) {
    int* slot = (int*)(lds_g + MG_CUM + 256);
    __syncthreads();
    if (w == 0 && fresh_lane() == 0) *slot = (int)__hip_atomic_fetch_add((unsigned*)(a.ws + WS_CTL) + CW_Q + 64 * x, 1u, __ATOMIC_RELAXED, __HIP_MEMORY_SCOPE_AGENT);
    __syncthreads();
    return __builtin_amdgcn_readfirstlane(*slot);
}
__device__ __forceinline__ unsigned f8pair_lo(unsigned w) { const auto v = __builtin_amdgcn_cvt_pk_f32_fp8((int)w, false); return pk2(v[0], v[1]); }
__device__ __forceinline__ unsigned f8pair_hi(unsigned w) { const auto v = __builtin_amdgcn_cvt_pk_f32_fp8((int)w, true); return pk2(v[0], v[1]); }
template <int MODE>
__device__ __forceinline__ int moe_gemm(const Args& a, unsigned char* lds_g, int tid, int idx0) {
    constexpr int K = MODE == 1 ? D : DE, NT = K / 64;
#define MG_BAR() do { asm volatile("s_waitcnt lgkmcnt(0)" ::: "memory"); __builtin_amdgcn_s_barrier(); asm volatile("" ::: "memory"); } while (0)
    const int w = __builtin_amdgcn_readfirstlane(tid >> 6);
    const int wm = w >> 1, wn = w & 1, hh = wm >> 1, wr = wm & 1;
    const int* cum = (const int*)(lds_g + MG_CUM); const unsigned* ctl = (const unsigned*)(a.ws + WS_CTL);
    const int T = cum[NEXP], x = blockIdx.x & 7;
    for (int idx = idx0;;) {
        if (idx < 0) idx = moe_pull(a, lds_g, w, x);
        if (idx >= (MODE == 1 ? T : 2 * T)) return idx;
        const int ti = MODE == 1 ? idx : idx - T;
        idx = -1;
        const int nt = x;
        if (MODE == 2) {
            if (w == 0) { unsigned* tc = (unsigned*)(a.ws + WS_CTL) + CW_TC + 64 * ti; unsigned spins = 0;
                while ((unsigned)__builtin_amdgcn_readfirstlane(__hip_atomic_load(tc, __ATOMIC_RELAXED, __HIP_MEMORY_SCOPE_AGENT)) < 64u) {
                    __builtin_amdgcn_s_sleep(2);
                    if (++spins > (1u << 22)) { if (fresh_lane() == 0) __hip_atomic_store((unsigned*)(a.ws + WS_CTL) + 1, 0x900u + (unsigned)ti, __ATOMIC_RELAXED, __HIP_MEMORY_SCOPE_AGENT); break; } }
                __builtin_amdgcn_fence(__ATOMIC_ACQUIRE, "agent");
                asm volatile("s_waitcnt vmcnt(0)" ::: "memory"); }
            __syncthreads();
        }
        const int lane = fresh_lane(), tidu = w * 64 + lane, fr = lane & 15, fq = lane >> 4;
        const int aoff = pg8::lds_byte(wr * 64 + fr, fq * 8);
        const int bk = w, bp = lane;
        int e = 0;
#pragma unroll 1
        for (int q = 1; q < NEXP; ++q) e = (cum[q] <= ti) ? q : e;
        e = __builtin_amdgcn_readfirstlane(e);
        const int mt = __builtin_amdgcn_readfirstlane(ti - cum[e]);
        unsigned aofs[4]; unsigned bofs; int bwr0;
        __amdgpu_buffer_rsrc_t rsA, rsB, rsB3;
        if (MODE == 1) { const int cnt = cum[128 + e];
#pragma unroll
            for (int q = 0; q < 2; ++q) { const int pos = 256 * mt + 128 * q + (tidu >> 2); const int tok = pos < cnt ? ((const int*)(a.ws + WS_LIST))[e * 8192 + pos] : 0;
                aofs[q] = (unsigned)(tok * D + 16 * (tidu & 3)); }
            aofs[2] = aofs[3] = 0u;
            rsA = __builtin_amdgcn_make_buffer_rsrc((void*)(a.ws + WS_H2), 0, 0x7fffffff, 0x00020000);
            rsB = __builtin_amdgcn_make_buffer_rsrc((void*)(a.in[I_W1] + (size_t)e * D * DE), 0, 0x7fffffff, 0x00020000); rsB3 = __builtin_amdgcn_make_buffer_rsrc((void*)(a.in[I_W3] + (size_t)e * D * DE), 0, 0x7fffffff, 0x00020000);
            bofs = (unsigned)((bk + 8 * (bp >> 5)) * DE + 128 * nt + 4 * (bp & 31)) * 4u;
            bwr0 = MH_BROW * (bk + 8 * (bp >> 5)) + 2 * (128 * ((bp & 31) >> 4) + 4 * (bp & 15)); }
        else {
#pragma unroll
            for (int q = 0; q < 2; ++q) aofs[q] = (unsigned)((128 * q + (tidu >> 2)) * DE + 16 * (tidu & 3));
            aofs[2] = aofs[3] = 0u;
            rsA = __builtin_amdgcn_make_buffer_rsrc((void*)((const unsigned char*)(a.ws + WS_HM) + (size_t)256 * ti * DE), 0, 0x7fffffff, 0x00020000);
            rsB = __builtin_amdgcn_make_buffer_rsrc((void*)(a.in[I_W2] + (size_t)e * DE * D), 0, 0x7fffffff, 0x00020000); rsB3 = rsB;
            bofs = (unsigned)(bk * D + 256 * nt + 4 * bp) * 4u; bwr0 = mhb_off(bk, bp >> 1) + 8 * (bp & 1); }
        const LAS unsigned char* blane = (const LAS unsigned char*)lds_g + MH_B + mhb_off(8 * (lane >> 4) + ((lane & 15) >> 2), 16 * wn + ((lane & 3) >> 1)) + 8 * (lane & 1);
        f32x4 acc[4][8];
#pragma unroll
        for (int m = 0; m < 4; ++m)
#pragma unroll
            for (int n = 0; n < 8; ++n) acc[m][n] = (f32x4){0.f, 0.f, 0.f, 0.f};
        v4u ra[4]; f32x4 rb[8];
#define MH_MMA(buf_) do { const LAS unsigned char* Bi_ = blane + (buf_) * MH_BBYTES; \
        bf16x8_t bc0_ = mhb_frag(Bi_, 0), bc1_ = mhb_frag(Bi_, 32); \
        _Pragma("unroll") for (int ks_ = 0; ks_ < 2; ++ks_) { bf16x8_t af_[4]; \
            _Pragma("unroll") for (int m_ = 0; m_ < 4; ++m_) af_[m_] = *(const bf16x8_t*)(lds_g + MH_A + (buf_) * MH_ABYTES + hh * 16384 + aoff + m_ * 2048 + ks_ * 1024); \
            _Pragma("unroll") for (int n_ = 0; n_ < 8; n_ += 2) { bf16x8_t bn0_ = bc0_, bn1_ = bc1_; \
                if (n_ + 2 < 8) { bn0_ = mhb_frag(Bi_, 32 * ks_ * MH_BROW + 32 * (n_ + 2)); bn1_ = mhb_frag(Bi_, 32 * ks_ * MH_BROW + 32 * (n_ + 3)); } \
                else if (ks_ == 0) { bn0_ = mhb_frag(Bi_, 32 * MH_BROW); bn1_ = mhb_frag(Bi_, 32 * MH_BROW + 32); } \
                __builtin_amdgcn_sched_barrier(0); \
                _Pragma("unroll") for (int m_ = 0; m_ < 4; ++m_) { acc[m_][n_] = __builtin_amdgcn_mfma_f32_16x16x32_bf16(bc0_, af_[m_], acc[m_][n_], 0, 0, 0); \
                    acc[m_][n_ + 1] = __builtin_amdgcn_mfma_f32_16x16x32_bf16(bc1_, af_[m_], acc[m_][n_ + 1], 0, 0, 0); } \
                __builtin_amdgcn_sched_barrier(0); bc0_ = bn0_; bc1_ = bn1_; } } } while (0)
        {
            const int awr = pg8::lds_byte(tidu >> 2, 16 * (tidu & 3));
#define MH_LDB(t_) do { _Pragma("unroll") for (int j_ = 0; j_ < 8; ++j_) rb[j_] = __builtin_bit_cast(f32x4, MODE == 1 ? __builtin_amdgcn_raw_buffer_load_b128((j_ & 1) ? rsB3 : rsB, bofs, (64 * (t_) + 16 * (j_ >> 1)) * DE * 4, 0) \
                                                                                                   : __builtin_amdgcn_raw_buffer_load_b128(rsB, bofs, (64 * (t_) + 8 * j_) * D * 4, 0)); } while (0)
#define MH_LDA(te_, to_) do { ra[0] = __builtin_amdgcn_raw_buffer_load_b128(rsA, aofs[0], 64 * (te_), 0); ra[1] = __builtin_amdgcn_raw_buffer_load_b128(rsA, aofs[1], 64 * (te_), 0); \
            ra[2] = __builtin_amdgcn_raw_buffer_load_b128(rsA, aofs[0], 64 * (to_), 0); ra[3] = __builtin_amdgcn_raw_buffer_load_b128(rsA, aofs[1], 64 * (to_), 0); } while (0)
#define MH_F8(w_) f8pair_lo(w_), f8pair_hi(w_)
#define MH_STA(buf_, x_) do { _Pragma("unroll") for (int h_ = 0; h_ < 2; ++h_) { const v4u p_ = ra[(x_) + h_]; \
            *(v4u*)(lds_g + MH_A + (buf_) * MH_ABYTES + h_ * 16384 + awr) = (v4u){MH_F8(p_.x), MH_F8(p_.y)}; __builtin_amdgcn_sched_barrier(0); \
            *(v4u*)(lds_g + MH_A + (buf_) * MH_ABYTES + h_ * 16384 + awr + 16) = (v4u){MH_F8(p_.z), MH_F8(p_.w)}; __builtin_amdgcn_sched_barrier(0); } } while (0)
#define MH_STB(buf_) do { _Pragma("unroll") for (int j_ = 0; j_ < 8; ++j_) { pg8::u32x2 o_; o_.x = pk2(rb[j_].x, rb[j_].y); o_.y = pk2(rb[j_].z, rb[j_].w); \
            *(pg8::u32x2*)(lds_g + MH_B + (buf_) * MH_BBYTES + bwr0 + (MODE == 1 ? (j_ >> 1) * 16 * MH_BROW + (j_ & 1) * 128 : j_ * 8 * MH_BROW)) = o_; } } while (0)
            MH_LDA(0, 1); MH_LDB(0);
            MG_BAR();
            MH_STA(0, 0); MH_STB(0);
            MH_LDB(1);
            for (int t = 0; t < NT; t += 2) {
                const int t2 = (t + 2 < NT) ? t + 2 : NT - 1, t3 = (t + 3 < NT) ? t + 3 : NT - 1;
                MG_BAR();
                MH_STA(1, 2); MH_STB(1);
                MH_LDA(t2, t3); MH_LDB(t2);
                MH_MMA(0);
                MG_BAR();
                MH_STA(0, 0); MH_STB(0);
                MH_LDB(t3);
                MH_MMA(1);
            }
#undef MH_LDB
#undef MH_LDA
#undef MH_F8
#undef MH_STA
#undef MH_STB
        }
#undef MH_MMA
        const int ln_ = fresh_lane();
        const int efr = ln_ & 15, efq = ln_ >> 4;
        if (MODE == 1) { unsigned char* HM = (unsigned char*)(a.ws + WS_HM) + (size_t)256 * ti * DE + 128 * nt + 64 * wn; const unsigned lo_ = (unsigned)((128 * hh + 64 * wr + efr) * DE + 4 * efq);
#pragma unroll
            for (int m = 0; m < 4; ++m)
#pragma unroll
                for (int n = 0; n < 4; ++n) { float hv[4];
#pragma unroll
                    for (int r = 0; r < 4; ++r) { const float a1 = acc[m][n][r]; hv[r] = a1 * sigmoidf_(a1) * acc[m][n + 4][r]; }
                    int w8 = __builtin_amdgcn_cvt_pk_fp8_f32(hv[0], hv[1], 0, false); w8 = __builtin_amdgcn_cvt_pk_fp8_f32(hv[2], hv[3], w8, true);
                    __hip_atomic_store((unsigned*)(HM + lo_ + 16 * m * DE + 16 * n), (unsigned)w8, __ATOMIC_RELAXED, __HIP_MEMORY_SCOPE_AGENT); }
            asm volatile("s_waitcnt vmcnt(0)" ::: "memory");
            if (ln_ == 0) __hip_atomic_fetch_add((unsigned*)(a.ws + WS_CTL) + CW_TC + 64 * ti, 1u, __ATOMIC_RELAXED, __HIP_MEMORY_SCOPE_AGENT); }
        else { bf16* Y2 = (bf16*)(a.ws + WS_Y2) + (size_t)256 * ti * D + 256 * nt + 128 * wn; const unsigned lo_ = (unsigned)((128 * hh + 64 * wr + efr) * D + 4 * efq);
#pragma unroll
            for (int m = 0; m < 4; ++m)
#pragma unroll
                for (int n = 0; n < 8; ++n) { pg8::u32x2 o; o.x = pk2(acc[m][n][0], acc[m][n][1]); o.y = pk2(acc[m][n][2], acc[m][n][3]);
                    *(pg8::u32x2*)(Y2 + lo_ + 16 * m * D + 16 * n) = o; } }
    }
#undef MG_BAR
}

__device__ __forceinline__ void phase12(const Args& a, unsigned char* lds_g, int lane, int wave) {
    const int gw = blockIdx.x * NWAVES + wave, NGW = gridDim.x * NWAVES;
    const int* cum = (const int*)(lds_g + MG_CUM);
    const bf16* X1 = (const bf16*)(a.ws + WS_X1); const float* MOD = (const float*)(a.ws + WS_MOD); const float* fg = a.in[I_FG];
    const int4* ASG = (const int4*)(a.ws + WS_ASG); const bf16* Y2 = (const bf16*)(a.ws + WS_Y2);
    for (int t = gw; t < NLAT; t += NGW) {
        const int b = t >> 11; const int4 q0 = ASG[2 * t], q1 = ASG[2 * t + 1];
        const float w0 = __int_as_float(q0.z), w1 = __int_as_float(q1.z);
        const unsigned long long* xr = (const unsigned long long*)(X1 + (size_t)t * D) + lane;
        const unsigned long long* y0 = (const unsigned long long*)(Y2 + (size_t)(256 * cum[q0.x] + q0.y) * D) + lane; const unsigned long long* y1 = (const unsigned long long*)(Y2 + (size_t)(256 * cum[q1.x] + q1.y) * D) + lane;
        f32x4 v[8]; float s = 0.f;
#pragma unroll
        for (int j = 0; j < 8; ++j) {
            const int c = 4 * lane + 256 * j;
            const f32x4 g2 = *(const f32x4*)(MOD + b * 12288 + 5 * 2048 + c);
            const unsigned long long a0 = y0[64 * j], a1 = y1[64 * j];
            f32x4 y; y.x = w0 * bflo((unsigned)a0) + w1 * bflo((unsigned)a1); y.y = w0 * bfhi((unsigned)a0) + w1 * bfhi((unsigned)a1);
            y.z = w0 * bflo((unsigned)(a0 >> 32)) + w1 * bflo((unsigned)(a1 >> 32)); y.w = w0 * bfhi((unsigned)(a0 >> 32)) + w1 * bfhi((unsigned)(a1 >> 32));
            const unsigned long long xw = xr[64 * j];
            v[j] = (f32x4){bflo((unsigned)xw), bfhi((unsigned)xw), bflo((unsigned)(xw >> 32)), bfhi((unsigned)(xw >> 32))} + g2 * y;
            s += (v[j].x * v[j].x + v[j].y * v[j].y) + (v[j].z * v[j].z + v[j].w * v[j].w);
        }
        const float rstd = 1.f / sqrtf(wave_sum(s) * (1.f / D) + EPS);
        f32x4* o = (f32x4*)(a.out + (size_t)t * D) + lane; f32x4 fgv[8];
#pragma unroll
        for (int j = 0; j < 8; ++j) fgv[j] = *(const f32x4*)(fg + 4 * lane + 256 * j);
#pragma unroll
        for (int j = 0; j < 8; ++j) o[64 * j] = v[j] * rstd * fgv[j];
    }
}

__global__ void __launch_bounds__(NTHR, 2) fwd_kernel(Args args) {
    extern __shared__ __attribute__((aligned(16))) unsigned char lds[];
    LAS unsigned char* ldsl = (LAS unsigned char*)lds;
    volatile LAS unsigned* MISC = (volatile LAS unsigned*)(ldsl + MISC_OFF);
    LAS unsigned* TL = (LAS unsigned*)(ldsl + LDSCTL_OFF);
    const int wave_s = __builtin_amdgcn_readfirstlane(threadIdx.x >> 6);
#define TID() make_tid(wave_s)
    { const int t0 = TID(); for (int u = t0; u < (LDS_BYTES - LDSCTL_OFF) / 4; u += NTHR) ((LAS unsigned*)(ldsl + LDSCTL_OFF))[u] = 0u; }
    __syncthreads();
    unsigned char* ws = args.ws;
    unsigned* ctl = (unsigned*)(ws + WS_CTL);
    XcdBarrier bar; bar.bar = ctl + CW_BAR; bar.x = 0; bar.st = nullptr;
    const bool one_launch = (args.ph_hi - args.ph_lo) > 1;
    if (one_launch) bar = xcd_barrier_post(ctl + CW_BAR, MISC + 8, TID());
    const int lo = args.ph_lo, hi = args.ph_hi;
#define IN(k) (lo <= (k) && (k) < hi)
#define SEAM(k) do { if (IN(k) && IN((k) + 1)) xcd_barrier(bar, TID()); } while (0)
    const int G = gridDim.x, c = blockIdx.x;

#define FRESH() const int tid = TID(), lane = tid & 63, wave = __builtin_amdgcn_readfirstlane(tid >> 6); (void)lane; (void)wave
#ifndef DUP_PHASE
#define DUP_PHASE (-1)
#endif
#define PH(k, ...) if (IN(k)) { _Pragma("unroll") for (int rep_ = 0; rep_ < ((DUP_PHASE) == (k) ? 2 : 1); ++rep_) { if (rep_) xcd_barrier(bar, TID()); __VA_ARGS__ } } SEAM(k);
    PH(0, { FRESH(); phase0(args, lds, tid, lane, wave); mod_wait(args, tid); phase1(args, lane, wave); })
    PH(1, {
        SchedIn S{G, c, (const char*)(ws + WS_H), (const char*)(ws + WS_WIN)}; EpiIn E{ws, args.in[I_BGATES]};
        pg8::gemm_phase<EpiIn, SchedIn>(ldsl, D, S, E, TID());
        { const int R_ = (1492 + G - 1) / G; int fi_ = 1492 - (R_ - 1) * G; if (fi_ >= G) fi_ = 0;
          if (c >= fi_) { FRESH(); late_prep(args, lds, (c - fi_) * NWAVES + wave, (G - fi_) * NWAVES, lane, wave); } } })
    PH(2, { FRESH(); phase3(args, lds, tid); })
    PH(3, { FRESH();
        for (int u = c; u < 256; u += G) ml_out_unit(args, lds, u, tid);
        for (int u = c; u < 4 * 32 * 8; u += G) { const int blk = u & 7, q = u >> 3; lru_out_unit(args, lds, q >> 5, 4 + (q & 31), blk, tid); } })
    PH(4, {
        SchedProj S{G, c, (const char*)(ws + WS_YA), (const char*)(ws + WS_YB), (const char*)(ws + WS_WPA), (const char*)(ws + WS_WPB)};
        EpiProj E{(const bf16*)(ws + WS_GA), (const bf16*)(ws + WS_GB), (bf16*)(ws + WS_PRE)};
        pg8::gemm_phase<EpiProj, SchedProj>(ldsl, 1024, S, E, TID()); })
    PH(5, {
        SchedOut S{G, c, (const char*)(ws + WS_PRE), (const char*)(ws + WS_WOUT)}; EpiOut E{args.in[I_X], (const float*)(ws + WS_MOD), (bf16*)(ws + WS_X1)};
        pg8::gemm_phase<EpiOut, SchedOut>(ldsl, D, S, E, TID()); })
    PH(6, { FRESH(); phase_router(args, lds, tid, lane, wave); })
    PH(7, { FRESH(); moe_tables(args, lds, tid); const int nx_ = moe_gemm<1>(args, lds, tid, -1); { const int tid2_ = TID(); (void)moe_gemm<2>(args, lds, tid2_, nx_); } })
    PH(8, { FRESH(); moe_tables(args, lds, tid); phase12(args, lds, lane, wave); })
#undef PH
#undef IN
#undef SEAM
}

extern "C" void kernel_launch(void* const* d_in, const int* in_sizes, int n_in, void* d_out, int out_size, void* d_ws, size_t ws_size, hipStream_t stream) {
    static int grid = 0;
    if (grid == 0) {
        if (n_in != 27 || out_size != NLAT * D || ws_size < WS_END) { fprintf(stderr, "kernel_launch: unexpected shapes (n_in %d, out %d, ws %zu)\n", n_in, out_size, ws_size); grid = -1; return; }
        int dev = 0, cus = 0, per_cu = 0;
        if (hipGetDevice(&dev) != hipSuccess || hipDeviceGetAttribute(&cus, hipDeviceAttributeMultiprocessorCount, dev) != hipSuccess) { grid = -1; return; }
        if (hipFuncSetAttribute((const void*)fwd_kernel, hipFuncAttributeMaxDynamicSharedMemorySize, LDS_BYTES) != hipSuccess) { fprintf(stderr, "kernel_launch: hipFuncSetAttribute failed\n"); grid = -1; return; }
        if (hipOccupancyMaxActiveBlocksPerMultiprocessor(&per_cu, (const void*)fwd_kernel, NTHR, LDS_BYTES) != hipSuccess || per_cu < 1) fprintf(stderr, "kernel_launch: occupancy query says %d\n", per_cu);
        (void)hipGetLastError();
        grid = cus;
    }
    if (grid < 0) return;
    (void)hipMemsetAsync((char*)d_ws + WS_CTL, 0, CTL_ZERO_BYTES, stream);
    Args a{};
    for (int i = 0; i < 27; ++i) a.in[i] = (const float*)d_in[i];
    a.out = (float*)d_out; a.ws = (unsigned char*)d_ws;
#if MK_ONE_LAUNCH
    a.ph_lo = 0; a.ph_hi = NPHASE;
    hipLaunchKernelGGL(fwd_kernel, dim3(grid), dim3(NTHR), LDS_BYTES, stream, a);
#else
    for (int p = 0; p < NPHASE; ++p) { a.ph_lo = p; a.ph_hi = p + 1; hipLaunchKernelGGL(fwd_kernel, dim3(grid), dim3(NTHR), LDS_BYTES, stream, a); }
#endif
}
```

```cpp
#include <hip/hip_runtime.h>
#include <cstdio>
#include <cstdint>

#ifndef MK_ONE_LAUNCH
#define MK_ONE_LAUNCH 1
#endif

namespace pg8 {
#define PG8_LAS __attribute__((address_space(3)))
typedef unsigned short bf16_t;
typedef short bf16x8 __attribute__((ext_vector_type(8)));
typedef float f32x4 __attribute__((ext_vector_type(4)));
typedef float f32x2 __attribute__((ext_vector_type(2)));
typedef unsigned u32x4 __attribute__((ext_vector_type(4)));
typedef unsigned u32x2 __attribute__((ext_vector_type(2)));
constexpr int BM = 256, BK = 64, HALF = 128, HTB = HALF * BK * 2  , STAGE_BYTES = 8 * HTB, NXCD = 8, WGM = 8;

__host__ __device__ __forceinline__ int lds_byte(int r, int c) { const int st = (r >> 4) * 2 + (c >> 5), rr = r & 15, cc = c & 31, ob = rr * 64 + cc * 2; return st * 1024 + (ob ^ (((ob >> 9) & 1) << 5)); }
__host__ __device__ __forceinline__ void stage_rc(int b, int& R, int& C) { const int st = b / 1024, sb = b % 1024, swz = sb ^ (((sb >> 9) & 1) << 5); R = (st >> 1) * 16 + swz / 64; C = (st & 1) * 32 + (swz % 64) / 2; }
__host__ __device__ __forceinline__ int perm32(int rho) { const int n = rho >> 4, i = rho & 15; return 8 * (i >> 2) + 4 * n + (i & 3); }

struct Unit { const char* A; const char* B; int pm, pn, aux; };

__host__ __device__ __forceinline__ void tile_order(int L, int nM, int nN, int& pm, int& pn) {
    const int nwg = nM * nN; int wgid = L;
    { const int q = nwg / NXCD, r = nwg % NXCD, xcd = wgid % NXCD, off = wgid / NXCD; wgid = (xcd < r ? xcd * (q + 1) : r * (q + 1) + (xcd - r) * q) + off; }
    const int nig = WGM * nN, gid = wgid / nig, fm = gid * WGM, gsz = (nM - fm) < WGM ? (nM - fm) : WGM;
    pm = fm + ((wgid % nig) % gsz); pn = (wgid % nig) / gsz;
}

typedef __bf16 bf16n2 __attribute__((ext_vector_type(2)));
__device__ __forceinline__ unsigned cvt_pk_bf16(float lo, float hi) { const f32x2 v = {lo, hi}; return __builtin_bit_cast(unsigned, __builtin_convertvector(v, bf16n2)); }

template <class Epi, class Sched>
__device__ __forceinline__ void gemm_phase(PG8_LAS unsigned char* lds, const int K, const Sched& S, const Epi& E, int tid) {
    const int wid = __builtin_amdgcn_readfirstlane(tid >> 6), lane = tid & 63, wr = wid >> 2, wc = wid & 3, fr = lane & 15, fq = lane >> 4;
    const int nt = K / BK;
    unsigned voffA[2], voffB[2];
#pragma unroll
    for (int i = 0; i < 2; ++i) { int R, C; stage_rc(tid * 16 + i * 8192, R, C); const int Rb = Epi::PERM ? ((R & ~31) + perm32(R & 31)) : R;
        voffA[i] = (unsigned)(R * K + C) * 2u; voffB[i] = (unsigned)(Rb * K + C) * 2u; }
    const size_t kstep = (size_t)(BK * 2);
    const size_t hstep = (size_t)HALF * K * 2;
    const unsigned ldsw = (unsigned)wid * 1024u;
    const int aoff = lds_byte(wr * 64 + fr, fq * 8), boff = lds_byte(wc * 32 + fr, fq * 8);
#define PG8_SA(b, h) (((b) * 2 + (h)) * HTB)
#define PG8_SB(b, h) ((4 + (b) * 2 + (h)) * HTB)
#define PG8_STAGE(bufoff, gbase, voff) do { _Pragma("unroll") for (int _i = 0; _i < 2; ++_i) \
        __builtin_amdgcn_global_load_lds((const unsigned*)((const char*)(gbase) + (voff)[_i]), (PG8_LAS unsigned*)(lds + (bufoff) + ldsw + _i * 8192), 16, 0, 0); } while (0)
#define PG8_LDA(dst, b, h) do { _Pragma("unroll") for (int m = 0; m < 4; ++m) _Pragma("unroll") for (int k = 0; k < 2; ++k) dst[m][k] = *(const PG8_LAS bf16x8*)(lds + PG8_SA(b, h) + aoff + m * 2048 + k * 1024); } while (0)
#define PG8_LDB(dst, b, h) do { _Pragma("unroll") for (int n = 0; n < 2; ++n) _Pragma("unroll") for (int k = 0; k < 2; ++k) dst[n][k] = *(const PG8_LAS bf16x8*)(lds + PG8_SB(b, h) + boff + n * 2048 + k * 1024); } while (0)
#define PG8_MMA(ai, bj, At, Bt) do { __builtin_amdgcn_s_setprio(1); _Pragma("unroll") for (int m = 0; m < 4; ++m) _Pragma("unroll") for (int n = 0; n < 2; ++n) _Pragma("unroll") for (int k = 0; k < 2; ++k) \
        acc[ai][bj][m][n] = __builtin_amdgcn_mfma_f32_16x16x32_bf16(Bt[n][k], At[m][k], acc[ai][bj][m][n], 0, 0, 0); __builtin_amdgcn_s_setprio(0); } while (0)
#define PG8_WAIT_V(n) asm volatile("s_waitcnt vmcnt(" #n ")" ::: "memory")
#define PG8_WAIT_L(n) asm volatile("s_waitcnt lgkmcnt(" #n ")" ::: "memory")
#define PG8_BAR __builtin_amdgcn_s_barrier()
#define PG8_SCHED __builtin_amdgcn_sched_barrier(0)
    Unit cur, nxt; int ui = 0;
    if (!S.next(0, cur)) return;
    f32x4 acc[2][2][4][2];
#pragma unroll
    for (int a = 0; a < 2; ++a)
#pragma unroll
        for (int b = 0; b < 2; ++b)
#pragma unroll
            for (int m = 0; m < 4; ++m)
#pragma unroll
                for (int n = 0; n < 2; ++n) acc[a][b][m][n] = (f32x4){0.f, 0.f, 0.f, 0.f};
    bf16x8 At[4][2], B0[2][2], B1[2][2];
    const char* cA = cur.A; const char* cB = cur.B;
    PG8_STAGE(PG8_SB(0, 0), cB, voffB); PG8_STAGE(PG8_SB(0, 1), cB + hstep, voffB); PG8_STAGE(PG8_SA(0, 0), cA, voffA); PG8_STAGE(PG8_SA(0, 1), cA + hstep, voffA);
    if (wr == 1) PG8_BAR;
    PG8_WAIT_V(2); PG8_BAR;
    PG8_STAGE(PG8_SB(1, 0), cB + kstep, voffB); PG8_STAGE(PG8_SA(1, 0), cA + kstep, voffA); PG8_STAGE(PG8_SB(1, 1), cB + hstep + kstep, voffB);
    PG8_WAIT_V(6); PG8_BAR;
    for (;;) {
        const bool has_next = S.next(ui + 1, nxt);
        const char* nA = has_next ? nxt.A : cA; const char* nB = has_next ? nxt.B : cB;
        for (int t = 0; t < nt; t += 2) {
            const bool last = (t == nt - 2);
            const char* a1 = cA + (size_t)(t + 1) * kstep;
            const char* a2 = last ? nA : cA + (size_t)(t + 2) * kstep; const char* b2 = last ? nB : cB + (size_t)(t + 2) * kstep;
            const char* a3 = a2 + kstep; const char* b3 = b2 + kstep;
            PG8_LDB(B0, 0, 0); PG8_LDB(B1, 0, 1); PG8_SCHED; PG8_LDA(At, 0, 0); PG8_STAGE(PG8_SA(1, 1), a1 + hstep, voffA);
            PG8_WAIT_V(8); PG8_WAIT_L(0); PG8_BAR; PG8_MMA(0, 0, At, B0); PG8_MMA(0, 1, At, B1); PG8_BAR; PG8_SCHED;
            PG8_LDA(At, 0, 1); PG8_STAGE(PG8_SB(0, 0), b2, voffB); PG8_STAGE(PG8_SB(0, 1), b2 + hstep, voffB); PG8_STAGE(PG8_SA(0, 0), a2, voffA);
            PG8_WAIT_V(8); PG8_WAIT_L(0); PG8_BAR; PG8_MMA(1, 0, At, B0); PG8_MMA(1, 1, At, B1); PG8_BAR; PG8_SCHED;
            PG8_LDB(B0, 1, 0); PG8_LDB(B1, 1, 1); PG8_SCHED; PG8_LDA(At, 1, 0); PG8_STAGE(PG8_SA(0, 1), a2 + hstep, voffA);
            PG8_WAIT_V(8); PG8_WAIT_L(0); PG8_BAR; PG8_MMA(0, 0, At, B0); PG8_MMA(0, 1, At, B1); PG8_BAR; PG8_SCHED;
            PG8_LDA(At, 1, 1); PG8_STAGE(PG8_SB(1, 0), b3, voffB); PG8_STAGE(PG8_SB(1, 1), b3 + hstep, voffB); PG8_STAGE(PG8_SA(1, 0), a3, voffA);
            PG8_WAIT_V(8); PG8_WAIT_L(0); PG8_BAR; PG8_MMA(1, 0, At, B0); PG8_MMA(1, 1, At, B1); PG8_BAR; PG8_SCHED;
        }
        if (wr == 0) PG8_BAR;
        { int fr_ = fr, fq_ = fq; asm volatile("" : "+v"(fr_), "+v"(fq_)); E(acc, cur, wr, wc, fr_, fq_); }
        if (!has_next) break;
        if (!(Epi::CARRY && E.keep(cur))) {
#pragma unroll
        for (int a = 0; a < 2; ++a)
#pragma unroll
            for (int b = 0; b < 2; ++b)
#pragma unroll
                for (int m = 0; m < 4; ++m)
#pragma unroll
                    for (int n = 0; n < 2; ++n) acc[a][b][m][n] = (f32x4){0.f, 0.f, 0.f, 0.f};
        }
        cur = nxt; cA = nA; cB = nB; ++ui;
        if (wr == 1) PG8_BAR;
    }
    PG8_WAIT_V(0);
    PG8_BAR;
#undef PG8_SA
#undef PG8_SB
#undef PG8_STAGE
#undef PG8_LDA
#undef PG8_LDB
#undef PG8_MMA
#undef PG8_WAIT_V
#undef PG8_WAIT_L
#undef PG8_BAR
#undef PG8_SCHED
}
}

constexpr int NWAVES = 8, NTHR = 512;
constexpr int D = 2048, NB = 4, SEQ = 2048, CTXL = 256, NCTX = NB * CTXL  , NLAT = NB * SEQ  , NTOK = NCTX + NLAT  ;
constexpr int NSTEP = CTXL + SEQ;
constexpr int HEADS = 8, HD = 128, MW = 1024, LW = 1024;
constexpr int NEXP = 32, DE = 1024;
constexpr int IN_DIM = 11296, NT_IN = 45;
constexpr float EPS = 1e-6f;
constexpr int MAXTILES = 96;
constexpr int NPHASE = 9;

constexpr size_t MiB = 1u << 20;
constexpr size_t WS_CTL = 0, CTL_ZERO_BYTES = 1 * MiB;
constexpr size_t WS_MOD = 1 * MiB;
constexpr size_t WS_GATES = 2 * MiB;
constexpr size_t WS_ASG = 4 * MiB + 512 * 1024;
constexpr size_t WS_LIST = 3 * MiB + 512 * 1024;
constexpr size_t WS_WR = 6 * MiB;
constexpr size_t WS_RB = 7 * MiB + 768 * 1024;
constexpr size_t WS_WL = 5 * MiB;
constexpr size_t WS_AGG = 978 * MiB;
constexpr size_t WS_WPA = 8 * MiB, WS_WPB = 12 * MiB, WS_WOUT = 16 * MiB, WS_WIN = 24 * MiB;
constexpr size_t WS_W13 = 72 * MiB, WS_W2 = 328 * MiB;
constexpr size_t WS_PS = 72 * MiB;
constexpr size_t WS_H = 456 * MiB;
constexpr size_t WS_K = 492 * MiB, WS_V = 510 * MiB, WS_UX = 528 * MiB;
constexpr size_t WS_Q = 546 * MiB, WS_OF = 562 * MiB, WS_OB = 578 * MiB, WS_UG = 594 * MiB;
constexpr size_t WS_GA = 610 * MiB, WS_GB = 642 * MiB;
constexpr size_t WS_LA = 674 * MiB, WS_LB = 746 * MiB;
constexpr size_t WS_HS = 818 * MiB, WS_TM = 882 * MiB;
constexpr size_t WS_YA = 946 * MiB, WS_YB = 962 * MiB;
constexpr size_t WS_BT = 982 * MiB;
constexpr size_t WS_SLOC = 984 * MiB;
constexpr size_t WS_END = 1022 * MiB;
constexpr size_t WS_PRE = WS_LA;
constexpr size_t WS_X1 = WS_LB;
constexpr size_t WS_H2 = WS_H;
constexpr size_t WS_XS = WS_K;
constexpr size_t WS_HM = 588 * MiB;
constexpr size_t WS_Y2 = WS_HS;
constexpr int CW_MODC = 32;
constexpr int CW_CNT = 64;
constexpr int CW_NT = 128;
constexpr int CW_TILE_E = 192;
constexpr int CW_BAR = 4096;
constexpr int CW_Q = 8192;
constexpr int CW_TC = 16384;

constexpr int RING_BYTES = 131072;
constexpr int LDSCTL_OFF = 143360;
constexpr int MISC_OFF = LDSCTL_OFF + 384;
constexpr int LDS_BYTES = 147456;

#define GAS __attribute__((address_space(1)))
#define LAS __attribute__((address_space(3)))
typedef unsigned short bf16;
typedef unsigned v4u __attribute__((ext_vector_type(4)));
typedef float f32x4 __attribute__((ext_vector_type(4)));
#define LDS_WAIT() asm volatile("s_waitcnt lgkmcnt(0)" ::: "memory")
#define WG_BAR() do { asm volatile("s_waitcnt lgkmcnt(0)" ::: "memory"); __builtin_amdgcn_s_barrier(); asm volatile("" ::: "memory"); } while (0)

__device__ __forceinline__ unsigned f2bf(float f) { unsigned u = __builtin_bit_cast(unsigned, f); return (u + 0x7fffu + ((u >> 16) & 1u)) >> 16; }
__device__ __forceinline__ unsigned pk2(float lo, float hi) { return pg8::cvt_pk_bf16(lo, hi); }
__device__ __forceinline__ float bf2f(unsigned h) { return __builtin_bit_cast(float, h << 16); }
__device__ __forceinline__ float bflo(unsigned w) { return __builtin_bit_cast(float, w << 16); }
__device__ __forceinline__ float bfhi(unsigned w) { return __builtin_bit_cast(float, w & 0xffff0000u); }
__device__ __forceinline__ float sigmoidf_(float x) { return __builtin_amdgcn_rcpf(1.f + __expf(-x)); }
__device__ __forceinline__ float gelu_tanh(float x) { const float u = 0.7978845608028654f * (x + 0.044715f * x * x * x); return x * __builtin_amdgcn_rcpf(1.f + __expf(-2.f * u)); }
__device__ __forceinline__ float wave_sum(float v) {
#pragma unroll
    for (int o = 1; o < 64; o <<= 1) v += __shfl_xor(v, o);
    return v;
}

#define XB_TMO      128
#define XB_XCNT(j)  (256  + 64 * (j))
#define XB_XSUB(j)  (1280 + 64 * (j))
#define XB_XGEN(j)  (2304 + 64 * (j))
#define XB_TOP      3328
#define XB_TOPGEN   3392
#define XCD_BAR_WORDS 3456
#define XB_SPIN_CAP (1u << 23)
__device__ __forceinline__ unsigned xb_ld(unsigned* p)              { return __hip_atomic_load(p, __ATOMIC_RELAXED, __HIP_MEMORY_SCOPE_AGENT); }
__device__ __forceinline__ unsigned xb_add(unsigned* p, unsigned v) { return __hip_atomic_fetch_add(p, v, __ATOMIC_RELAXED, __HIP_MEMORY_SCOPE_AGENT); }
__device__ __forceinline__ unsigned xb_xcc_id() { return (unsigned)__builtin_amdgcn_s_getreg((3 << 11) | 20) & 0xFu; }
#define XB_SPIN(cond, bar) do { unsigned _sp = 0; while (cond) { __builtin_amdgcn_s_sleep(1); \
    if ((++_sp & 255u) == 0u) { if (xb_ld(&(bar)[XB_TMO])) break; if (_sp > XB_SPIN_CAP) { atomicAdd(&(bar)[XB_TMO], 1u); break; } } } } while (0)
struct XcdBarrier { unsigned* bar; unsigned x; volatile LAS unsigned* st; };
__device__ __forceinline__ XcdBarrier xcd_barrier_post(unsigned* bar, volatile LAS unsigned* st, int tid) {
    XcdBarrier b; b.bar = bar; b.x = xb_xcc_id(); b.st = st;
    if (tid == 0) (void)xb_add(&bar[XB_XCNT(b.x)], 1u);
    return b;
}
__device__ __forceinline__ void xcd_barrier_complete(unsigned* bar, unsigned x, unsigned& nloc, unsigned& nx) {
    const unsigned G = gridDim.x * gridDim.y * gridDim.z;
    unsigned sum, cnt, mine, sp = 0u;
    for (;;) {
        sum = 0u; cnt = 0u; mine = 0u;
#pragma unroll
        for (unsigned j = 0; j < 16; ++j) { const unsigned c = xb_ld(&bar[XB_XCNT(j)]); sum += c; cnt += (c > 0u) ? 1u : 0u; mine = (j == x) ? c : mine; }
        if (sum == G) break;
        __builtin_amdgcn_s_sleep(1);
        if ((++sp & 255u) == 0u) { if (xb_ld(&bar[XB_TMO])) break; if (sp > XB_SPIN_CAP) { atomicAdd(&bar[XB_TMO], 1u); break; } }
    }
    nloc = mine > 0u ? mine : 1u; nx = cnt > 0u ? cnt : 1u;
}
__device__ __forceinline__ void xcd_barrier(const XcdBarrier& b, int tid) {
    asm volatile("s_waitcnt vmcnt(0)" ::: "memory");
    __syncthreads();
    if (tid == 0) {
        unsigned* bar = b.bar;
        __builtin_amdgcn_s_waitcnt(0);
        unsigned nloc = b.st[0], nx = b.st[1];
        if (nloc == 0u) { xcd_barrier_complete(bar, b.x, nloc, nx); b.st[0] = nloc; b.st[1] = nx; }
        const unsigned old = xb_add(&bar[XB_XSUB(b.x)], 1u);
        const unsigned gen = old / nloc;
        if (old + 1u == (gen + 1u) * nloc) {
            __builtin_amdgcn_fence(__ATOMIC_RELEASE, "agent");
            asm volatile("s_waitcnt vmcnt(0)" ::: "memory");
            const unsigned og = xb_add(&bar[XB_TOP], 1u);
            const unsigned tg = og / nx;
            if (og + 1u == (tg + 1u) * nx) xb_add(&bar[XB_TOPGEN], 1u);
            else XB_SPIN(xb_ld(&bar[XB_TOPGEN]) == tg, bar);
            __builtin_amdgcn_fence(__ATOMIC_ACQUIRE, "agent");
            xb_add(&bar[XB_XGEN(b.x)], 1u);
            asm volatile("s_waitcnt vmcnt(0)" ::: "memory");
        } else {
            XB_SPIN(xb_ld(&bar[XB_XGEN(b.x)]) == gen, bar);
            __builtin_amdgcn_fence(__ATOMIC_ACQUIRE, "agent");
            asm volatile("s_waitcnt vmcnt(0)" ::: "memory");
        }
    }
    __syncthreads();
}

__device__ __forceinline__ int make_tid(int wave_s) { int l; asm volatile("v_mbcnt_lo_u32_b32 %0, -1, 0\n\tv_mbcnt_hi_u32_b32 %0, -1, %0" : "=v"(l)); __builtin_assume(l >= 0 && l < 64); __builtin_assume(wave_s >= 0 && wave_s < 8); return wave_s * 64 + l; }
struct Args { const float* in[27]; float* out; unsigned char* ws; int ph_lo, ph_hi; };
enum { I_X = 0, I_C, I_CTX, I_CCTX, I_WMOD, I_BMOD, I_N1G, I_WIN, I_BGATES, I_HEADG, I_CONVW, I_CONVB, I_LWA, I_LBA, I_LWX, I_LBX, I_LAM, I_WPA, I_WPB, I_WOUT, I_N2G, I_WRG, I_WRE, I_W1, I_W3, I_W2, I_FG };

__device__ __forceinline__ void tr_item(const float* __restrict__ W, size_t ldw, int k0, int n0, bf16* dst, size_t ldd, float scale, LAS float* scr, int lane) {
#pragma unroll 16
    for (int i = 0; i < 32; ++i) { const int kk = 2 * i + (lane >> 5); scr[kk * 33 + (lane & 31)] = W[(size_t)(k0 + kk) * ldw + n0 + (lane & 31)]; }
    LDS_WAIT(); asm volatile("" ::: "memory");
    const int c = lane & 7;
#pragma unroll
    for (int j = 0; j < 4; ++j) { const int n = (lane >> 3) + 8 * j; const LAS float* s = scr + (8 * c) * 33 + n;
        v4u o; o.x = pk2(s[0 * 33] * scale, s[1 * 33] * scale); o.y = pk2(s[2 * 33] * scale, s[3 * 33] * scale); o.z = pk2(s[4 * 33] * scale, s[5 * 33] * scale); o.w = pk2(s[6 * 33] * scale, s[7 * 33] * scale);
        *(GAS v4u*)(dst + (size_t)n * ldd + 8 * c) = o; }
    LDS_WAIT(); asm volatile("" ::: "memory");
}
__device__ __forceinline__ int win_row(int n0, float& scale) {
    scale = 1.f;
    if (n0 < 1024) return 13 * 256 + n0;
    if (n0 < 2048) { scale = 0.08838834764831845f; return n0 - 1024; }
    if (n0 < 3072) return 4 * 256 + (n0 - 2048);
    if (n0 < 4096) return 17 * 256 + (n0 - 3072);
    if (n0 < 5120) return 21 * 256 + (n0 - 4096);
    if (n0 < 5152) return 12 * 256 + (n0 - 5120);
    if (n0 < 6176) return 8 * 256 + (n0 - 5152);
    if (n0 < 7200) return 25 * 256 + (n0 - 6176);
    if (n0 < 9248) return 29 * 256 + (n0 - 7200);
    return 37 * 256 + (n0 - 9248);
}

__device__ __forceinline__ void phase0(const Args& a, unsigned char* lds_g, int tid, int lane, int wave) {
    unsigned char* ws = a.ws;
    {
        float* sl = (float*)lds_g;
        float* red = sl + 5 * 2048;
        for (int i = tid; i < 5 * 2048; i += NTHR) { const int r = i >> 11, k = i & 2047; const float v = r < 4 ? a.in[I_C][r * 2048 + k] : a.in[I_CCTX][k]; sl[i] = v / (1.f + __expf(-v)); }
        __syncthreads();
        const float* wm = a.in[I_WMOD]; const float* bm = a.in[I_BMOD]; float* MOD = (float*)(ws + WS_MOD);
        for (int cb = blockIdx.x; cb < 256; cb += gridDim.x) {
            const int n0 = cb * 48;
            if (tid < 504) {
                const int kq = tid / 12, cg = tid % 12;
                f32x4 acc[5];
#pragma unroll
                for (int r = 0; r < 5; ++r) acc[r] = (f32x4){0.f, 0.f, 0.f, 0.f};
#pragma unroll 7
                for (int k = kq; k < 2048; k += 42) {
                    const f32x4 w = *(const f32x4*)(wm + (size_t)k * 12288 + n0 + 4 * cg);
#pragma unroll
                    for (int r = 0; r < 5; ++r) acc[r] += w * sl[r * 2048 + k];
                }
#pragma unroll
                for (int r = 0; r < 5; ++r) *(f32x4*)(red + tid * 20 + r * 4) = acc[r];
            }
            __syncthreads();
            if (tid < 240) {
                const int cg = tid / 20, rj = tid % 20; float s = 0.f;
                for (int kq = 0; kq < 42; ++kq) s += red[(kq * 12 + cg) * 20 + rj];
                const int r = rj >> 2, j = rj & 3, n = n0 + 4 * cg + j;
                __hip_atomic_store(MOD + r * 12288 + n, s + bm[n], __ATOMIC_RELAXED, __HIP_MEMORY_SCOPE_AGENT);
            }
            __syncthreads();
        }
        if (tid == 0) __hip_atomic_fetch_add((unsigned*)(ws + WS_CTL) + CW_MODC, 1u, __ATOMIC_RELAXED, __HIP_MEMORY_SCOPE_AGENT);
    }
    {
        LAS float* scr = (LAS float*)((LAS unsigned char*)lds_g) + wave * 4096;
        const int gw = blockIdx.x * NWAVES + wave, NGW = gridDim.x * NWAVES;
        constexpr int J0 = 32 * 353, J1 = 16 * 64, J3 = 32 * 64;
        constexpr int JL = 256;
        constexpr int NITEMS = J0 + 2 * J1;
        (void)J3; (void)JL;
        for (int it = gw; it < NITEMS; it += NGW) {
            int r = it;
            if (r < J0) { const int kb = r / 353, nb = r % 353; float sc; const int row = win_row(32 * nb, sc);
                tr_item(a.in[I_WIN], IN_DIM, 64 * kb, 32 * nb, (bf16*)(ws + WS_WIN) + (size_t)row * 2048 + 64 * kb, 2048, sc, scr, lane); continue; } r -= J0;
            if (r < J1) { const int kb = r / 64, nb = r % 64; tr_item(a.in[I_WPA], 2048, 64 * kb, 32 * nb, (bf16*)(ws + WS_WPA) + (size_t)(32 * nb) * 1024 + 64 * kb, 1024, 1.f, scr, lane); continue; } r -= J1;
            if (r < J1) { const int kb = r / 64, nb = r % 64; tr_item(a.in[I_WPB], 2048, 64 * kb, 32 * nb, (bf16*)(ws + WS_WPB) + (size_t)(32 * nb) * 1024 + 64 * kb, 1024, 1.f, scr, lane); continue; }
        }
        { GAS v4u* z = (GAS v4u*)((bf16*)(ws + WS_WIN) + (size_t)(12 * 256 + 32) * 2048); const int nchunks = 224 * 256;
          for (int i = blockIdx.x * NTHR + tid; i < nchunks; i += gridDim.x * NTHR) z[i] = (v4u){0u, 0u, 0u, 0u}; }
    }
}

__device__ __forceinline__ void late_prep(const Args& a, unsigned char* lds_g, int gw, int NGW, int lane, int wave) {
    unsigned char* ws = a.ws;
    {
        LAS float* scr = (LAS float*)((LAS unsigned char*)lds_g) + wave * 4096;
        constexpr int J3 = 32 * 64, JL = 256;
        for (int it = gw; it < J3 + JL; it += NGW) {
            int r = it;
            if (r >= J3) { r -= J3; const int mi = r >> 3, kb = (r >> 2) & 1, nb = r & 3, dir = mi >> 4, mat = (mi >> 3) & 1, blk = mi & 7;
                tr_item(a.in[mat ? I_LWX : I_LWA] + (size_t)(dir * 8 + blk) * 128 * 128, 128, 64 * kb, 32 * nb, (bf16*)(ws + WS_WL) + ((size_t)((dir * 2 + mat) * 8 + blk) * 128 + 32 * nb) * 128 + 64 * kb, 128, 1.f, scr, lane); continue; }
            const int kb = r / 64, nb = r % 64; tr_item(a.in[I_WOUT], 2048, 64 * kb, 32 * nb, (bf16*)(ws + WS_WOUT) + (size_t)(32 * nb) * 2048 + 64 * kb, 2048, 1.f, scr, lane);
        }
    }
    {
        const float* MODr = (const float*)(a.ws + WS_MOD); float* WR = (float*)(a.ws + WS_WR); float* RB = (float*)(a.ws + WS_RB);
        for (int idx = gw * 64 + lane; idx < 4 * 48 * 2048; idx += NGW * 64) { const int k = idx & 2047, j = (idx >> 11) % 48, b = idx / (48 * 2048);
            const float gm = a.in[I_N2G][k] * (1.f + MODr[b * 12288 + 4 * 2048 + k]);
            const float wv = j < 32 ? a.in[I_WRE][(size_t)k * 32 + j] : (j < 36 ? a.in[I_WRG][(size_t)k * 4 + (j - 32)] : 0.f);
            WR[idx] = gm * wv; }
        for (int q = gw; q < 4 * 48; q += NGW) { const int b = q / 48, j = q % 48; float sacc = 0.f;
            if (j < 36) { for (int k = lane; k < 2048; k += 64) { const float wv = j < 32 ? a.in[I_WRE][(size_t)k * 32 + j] : a.in[I_WRG][(size_t)k * 4 + (j - 32)]; sacc += MODr[b * 12288 + 3 * 2048 + k] * wv; } }
            sacc = wave_sum(sacc); if (lane == 0) RB[q] = sacc; }
    }
}
__device__ __forceinline__ void mod_wait(const Args& a, int tid) {
    if (tid < 64) { unsigned* mc = (unsigned*)(a.ws + WS_CTL) + CW_MODC; unsigned spins = 0;
        while ((unsigned)__builtin_amdgcn_readfirstlane(__hip_atomic_load(mc, __ATOMIC_RELAXED, __HIP_MEMORY_SCOPE_AGENT)) < gridDim.x) {
            __builtin_amdgcn_s_sleep(2);
            if (++spins > (1u << 22)) { if (tid == 0) __hip_atomic_store((unsigned*)(a.ws + WS_CTL) + 1, 0x800u, __ATOMIC_RELAXED, __HIP_MEMORY_SCOPE_AGENT); break; } }
        __builtin_amdgcn_fence(__ATOMIC_ACQUIRE, "agent");
        asm volatile("s_waitcnt vmcnt(0)" ::: "memory"); }
    __syncthreads();
}
__device__ __forceinline__ void phase1(const Args& a, int lane, int wave) {
    const int gw = blockIdx.x * NWAVES + wave, NGW = gridDim.x * NWAVES;
    const float* MOD = (const float*)(a.ws + WS_MOD); const float* g = a.in[I_N1G];
    bf16* H = (bf16*)(a.ws + WS_H);
    for (int r = gw; r < NTOK; r += NGW) {
        const float* src = r < NCTX ? a.in[I_CTX] + (size_t)r * D : a.in[I_X] + (size_t)(r - NCTX) * D;
        const int mr = r < NCTX ? 4 : (r - NCTX) / SEQ;
        const f32x4* xr = (const f32x4*)src + lane;
        f32x4 v[8]; float s = 0.f;
#pragma unroll
        for (int j = 0; j < 8; ++j) { v[j] = xr[64 * j]; s += (v[j].x * v[j].x + v[j].y * v[j].y) + (v[j].z * v[j].z + v[j].w * v[j].w); }
        const float rstd = 1.f / sqrtf(wave_sum(s) * (1.f / D) + EPS);
        unsigned long long* o8 = (unsigned long long*)(H + (size_t)r * D) + lane;
#pragma unroll
        for (int j = 0; j < 8; ++j) {
            const int c = 4 * lane + 256 * j;
            const f32x4 gg = *(const f32x4*)(g + c), sh = *(const f32x4*)(MOD + mr * 12288 + c), sc = *(const f32x4*)(MOD + mr * 12288 + 2048 + c);
            v[j] = v[j] * rstd * gg * (sc + 1.f) + sh;
        }
#pragma unroll
        for (int j = 0; j < 8; ++j) o8[64 * j] = (unsigned long long)pk2(v[j].x, v[j].y) | ((unsigned long long)pk2(v[j].z, v[j].w) << 32);
    }
}

struct SchedIn {
    int G, c; const char* A; const char* B;
    __device__ __forceinline__ bool next(int i, pg8::Unit& u) const {
        const int L = i * G + c; if (L >= 1492) return false;
        int pm, pn;
        if (L < 1440) { pg8::tile_order(L, 32, NT_IN, pm, pn); pm += 4; }
        else { const int j = L - 1440; pm = j & 3; pn = j >> 2; }
        u.pm = pm; u.pn = pn; u.aux = 0; u.A = A + (size_t)pm * 256 * D * 2; u.B = B + (size_t)pn * 256 * D * 2; return true;
    }
};
struct EpiIn {
    static constexpr bool PERM = true, CARRY = false;
    __device__ __forceinline__ bool keep(const pg8::Unit&) const { return false; }
    unsigned char* ws; const float* b_gates;
    template <int ACT> __device__ __forceinline__ void store_tile(const pg8::f32x4 (&acc)[2][2][4][2], bf16* base, int ldc, int wr, int wc, int fr, int fq) const {
#pragma unroll
        for (int ai = 0; ai < 2; ++ai)
#pragma unroll
            for (int m = 0; m < 4; ++m) { bf16* rowp = base + (size_t)(ai * 128 + wr * 64 + m * 16 + fr) * ldc + wc * 32 + 8 * fq;
#pragma unroll
                for (int bj = 0; bj < 2; ++bj) { pg8::f32x4 v0 = acc[ai][bj][m][0], v1 = acc[ai][bj][m][1];
                    if (ACT == 1) {
#pragma unroll
                        for (int j = 0; j < 4; ++j) { v0[j] = sigmoidf_(v0[j]); v1[j] = sigmoidf_(v1[j]); } }
                    if (ACT == 2) {
#pragma unroll
                        for (int j = 0; j < 4; ++j) { v0[j] = gelu_tanh(v0[j]); v1[j] = gelu_tanh(v1[j]); } }
                    pg8::u32x4 w; w.x = pg8::cvt_pk_bf16(v0[0], v0[1]); w.y = pg8::cvt_pk_bf16(v0[2], v0[3]); w.z = pg8::cvt_pk_bf16(v1[0], v1[1]); w.w = pg8::cvt_pk_bf16(v1[2], v1[3]);
                    *(pg8::u32x4*)(rowp + bj * 128) = w; } }
    }
    __device__ __forceinline__ void operator()(const pg8::f32x4 (&acc)[2][2][4][2], const pg8::Unit& u, int wr, int wc, int fr, int fq) const {
        const int pn = u.pn; const size_t row0 = (size_t)u.pm * 256;
        if (pn < 12) {
            const int seg = pn >> 2, ct = pn & 3; bf16* dst = (bf16*)(ws + (seg == 0 ? WS_K : seg == 1 ? WS_V : WS_UX));
            store_tile<0>(acc, dst + row0 * 1024 + ct * 256, 1024, wr, wc, fr, fq);
        } else if (pn == 12) {
            if (wc == 0) {
                float* G = (float*)(ws + WS_GATES);
                const pg8::f32x4 bv0 = *(const pg8::f32x4*)(b_gates + 8 * fq), bv1 = *(const pg8::f32x4*)(b_gates + 8 * fq + 4);
#pragma unroll
                for (int ai = 0; ai < 2; ++ai)
#pragma unroll
                    for (int m = 0; m < 4; ++m) { float* rowp = G + (row0 + ai * 128 + wr * 64 + m * 16 + fr) * 32 + 8 * fq;
                        *(pg8::f32x4*)(rowp) = acc[ai][0][m][0] + bv0; *(pg8::f32x4*)(rowp + 4) = acc[ai][0][m][1] + bv1; }
            }
        } else if (pn < 29) {
            const int seg = (pn - 13) >> 2, ct = (pn - 13) & 3; const size_t lr = row0 - NCTX;
            bf16* dst = (bf16*)(ws + (seg == 0 ? WS_Q : seg == 1 ? WS_OF : seg == 2 ? WS_OB : WS_UG)) + lr * 1024 + ct * 256;
            if (seg == 0) store_tile<0>(acc, dst, 1024, wr, wc, fr, fq);
            else if (seg == 3) store_tile<2>(acc, dst, 1024, wr, wc, fr, fq);
            else store_tile<1>(acc, dst, 1024, wr, wc, fr, fq);
        } else {
            const int seg = (pn - 29) >> 3, ct = (pn - 29) & 7; const size_t lr = row0 - NCTX;
            store_tile<1>(acc, (bf16*)(ws + (seg ? WS_GB : WS_GA)) + lr * 2048 + ct * 256, 2048, wr, wc, fr, fq);
        }
    }
};

__device__ __forceinline__ int lru_pos_row(int b, bool isctx, int p) { return isctx ? b * CTXL + p : NCTX + b * SEQ + (p & 31) * 64 + (p >> 5); }
typedef short bf16x8_t __attribute__((ext_vector_type(8)));
template <bool FINAL>
__device__ __forceinline__ void lru_unit(const Args& a, unsigned char* lds_g, int b, int cidx, int blk, int tid) {
    const int lane = tid & 63, w = __builtin_amdgcn_readfirstlane(tid >> 6), fr = lane & 15, fq = lane >> 4;
    float* zf = (float*)lds_g;
    bf16* zb = (bf16*)(lds_g + 64 * 132 * 4);
    const bool isctx = cidx < 4; const int seglen = isctx ? CTXL : SEQ, p0 = (isctx ? cidx : cidx - 4) * 64;
    const bf16* UX = (const bf16*)(a.ws + WS_UX);
    float gba[2], gbx[2], glam[2];
    { const int ch_ = blk * 128 + 16 * w + fr;
#pragma unroll
      for (int d = 0; d < 2; ++d) { gba[d] = a.in[I_LBA][d * 1024 + ch_]; gbx[d] = a.in[I_LBX][d * 1024 + ch_]; glam[d] = a.in[I_LAM][d * 1024 + ch_]; } }
    bf16x8_t wl[2][2][4];
    { const bf16* WL = (const bf16*)(a.ws + WS_WL);
#pragma unroll
      for (int d = 0; d < 2; ++d)
#pragma unroll
        for (int m = 0; m < 2; ++m)
#pragma unroll
            for (int ks = 0; ks < 4; ++ks) wl[d][m][ks] = *(const bf16x8_t*)(WL + ((size_t)((d * 2 + m) * 8 + blk) * 128 + 16 * w + fr) * 128 + 32 * ks + 8 * fq); }
    __builtin_amdgcn_sched_barrier(0);
    {
        const int pos = tid >> 3, cg = tid & 7, ch0 = blk * 128 + cg * 16, p = p0 + pos;
        float z[16];
#pragma unroll
        for (int q = 0; q < 4; ++q) { const f32x4 bv = *(const f32x4*)(a.in[I_CONVB] + ch0 + 4 * q); z[4 * q] = bv.x; z[4 * q + 1] = bv.y; z[4 * q + 2] = bv.z; z[4 * q + 3] = bv.w; }
        v4u ua[4], ub[4]; float msk[4];
#pragma unroll
        for (int w4 = 0; w4 < 4; ++w4) { const int pp = p + w4 - 2; const bool ok = pp >= 0 && pp < seglen; const int ppc = ok ? pp : p;
            const v4u* src = (const v4u*)(UX + (size_t)lru_pos_row(b, isctx, ppc) * 1024 + ch0); ua[w4] = src[0]; ub[w4] = src[1]; msk[w4] = ok ? 1.f : 0.f; }
#pragma unroll
        for (int w4 = 0; w4 < 4; ++w4) { const float* cw = a.in[I_CONVW] + w4 * 1024 + ch0;
            const unsigned uu[8] = {ua[w4].x, ua[w4].y, ua[w4].z, ua[w4].w, ub[w4].x, ub[w4].y, ub[w4].z, ub[w4].w};
#pragma unroll
            for (int q = 0; q < 4; ++q) { const f32x4 cv = *(const f32x4*)(cw + 4 * q) * msk[w4]; z[4 * q] += cv.x * bflo(uu[2 * q]); z[4 * q + 1] += cv.y * bfhi(uu[2 * q]); z[4 * q + 2] += cv.z * bflo(uu[2 * q + 1]); z[4 * q + 3] += cv.w * bfhi(uu[2 * q + 1]); } }
#pragma unroll
        for (int q = 0; q < 4; ++q) *(f32x4*)(zf + pos * 132 + cg * 16 + 4 * q) = (f32x4){z[4 * q], z[4 * q + 1], z[4 * q + 2], z[4 * q + 3]};
        v4u o0, o1; o0.x = pk2(z[0], z[1]); o0.y = pk2(z[2], z[3]); o0.z = pk2(z[4], z[5]); o0.w = pk2(z[6], z[7]); o1.x = pk2(z[8], z[9]); o1.y = pk2(z[10], z[11]); o1.z = pk2(z[12], z[13]); o1.w = pk2(z[14], z[15]);
        *(v4u*)(zb + pos * 136 + cg * 16) = o0; *(v4u*)(zb + pos * 136 + cg * 16 + 8) = o1;
    }
    WG_BAR();
    f32x4 acc[2][2][4];
#pragma unroll
    for (int d = 0; d < 2; ++d)
#pragma unroll
        for (int m = 0; m < 2; ++m)
#pragma unroll
            for (int mt = 0; mt < 4; ++mt) acc[d][m][mt] = (f32x4){0.f, 0.f, 0.f, 0.f};
#pragma unroll
    for (int ks = 0; ks < 4; ++ks) {
        bf16x8_t af[4];
#pragma unroll
        for (int mt = 0; mt < 4; ++mt) af[mt] = *(const bf16x8_t*)(zb + (16 * mt + fr) * 136 + 32 * ks + 8 * fq);
#pragma unroll
        for (int d = 0; d < 2; ++d)
#pragma unroll
            for (int m = 0; m < 2; ++m) {
#pragma unroll
                for (int mt = 0; mt < 4; ++mt) acc[d][m][mt] = __builtin_amdgcn_mfma_f32_16x16x32_bf16(af[mt], wl[d][m][ks], acc[d][m][mt], 0, 0, 0); }
    }
    const int chl = 16 * w + fr, ch = blk * 128 + chl;
    float hsum[4][4];
#pragma unroll
    for (int d = 0; d < 2; ++d) {
        const float ba = gba[d], bx = gbx[d], lam = glam[d];
        const float sp = (-lam > 20.f) ? -lam : log1pf(__expf(-lam));
        float av[4][4], bv[4][4];
#pragma unroll
        for (int mt = 0; mt < 4; ++mt)
#pragma unroll
            for (int r = 0; r < 4; ++r) { const float rr = sigmoidf_(acc[d][0][mt][r] + ba), ii = sigmoidf_(acc[d][1][mt][r] + bx);
                const float aa = __expf(-8.f * rr * sp); av[mt][r] = aa; bv[mt][r] = __builtin_amdgcn_sqrtf(fmaxf(1.f - aa * aa, 0.f)) * ii * zf[(16 * mt + 4 * fq + r) * 132 + chl]; }
        float Pe[4], Se[4], Pt[4], St[4];
#pragma unroll
        for (int mt = 0; mt < 4; ++mt) {
            float P = 1.f, S = 0.f;
#pragma unroll
            for (int rr = 0; rr < 4; ++rr) { const int r = d ? 3 - rr : rr; S = av[mt][r] * S + bv[mt][r]; P = av[mt][r] * P; }
            if (d == 0) {
                float p1 = __shfl_up(P, 16), s1 = __shfl_up(S, 16); if (fq >= 1) { S = P * s1 + S; P = P * p1; }
                p1 = __shfl_up(P, 32); s1 = __shfl_up(S, 32); if (fq >= 2) { S = P * s1 + S; P = P * p1; }
                Pe[mt] = __shfl_up(P, 16); Se[mt] = __shfl_up(S, 16); if (fq == 0) { Pe[mt] = 1.f; Se[mt] = 0.f; }
                Pt[mt] = __shfl(P, fr + 48); St[mt] = __shfl(S, fr + 48);
            } else {
                float p1 = __shfl_down(P, 16), s1 = __shfl_down(S, 16); if (fq <= 2) { S = P * s1 + S; P = P * p1; }
                p1 = __shfl_down(P, 32); s1 = __shfl_down(S, 32); if (fq <= 1) { S = P * s1 + S; P = P * p1; }
                Pe[mt] = __shfl_down(P, 16); Se[mt] = __shfl_down(S, 16); if (fq == 3) { Pe[mt] = 1.f; Se[mt] = 0.f; }
                Pt[mt] = __shfl(P, fr); St[mt] = __shfl(S, fr);
            }
        }
        float2* AGG = (float2*)(a.ws + WS_AGG) + ((size_t)(b * 2 + d) * 36) * 1024 + ch;
        if (!FINAL) {
            if (cidx >= 4) {
                unsigned* PS = (unsigned*)(a.ws + WS_PS) + ((size_t)(b * 2 + d) * NSTEP + 64 * cidx) * 1024 + ch;
#pragma unroll
                for (int mt = 0; mt < 4; ++mt)
#pragma unroll
                    for (int r = 0; r < 4; ++r) PS[(size_t)(16 * mt + 4 * fq + r) * 1024] = pk2(1.f - av[mt][r], bv[mt][r]);
            }
            float Pc = 1.f, Sc = 0.f;
#pragma unroll
            for (int i = 0; i < 4; ++i) { const int mt = d ? 3 - i : i; Sc = Pt[mt] * Sc + St[mt]; Pc = Pt[mt] * Pc; }
            if (fq == 0) AGG[(size_t)cidx * 1024] = make_float2(Pc, Sc);
        } else {
            float h = 0.f;
#pragma unroll
            for (int g3 = 0; g3 < 6; ++g3) {
                float2 qv[6];
#pragma unroll
                for (int i = 0; i < 6; ++i) { const int sidx = 6 * g3 + i; const int c2 = d ? (sidx < 4 ? 3 - sidx : 39 - sidx) : sidx; qv[i] = AGG[(size_t)c2 * 1024]; }
#pragma unroll
                for (int i = 0; i < 6; ++i) { const int sidx = 6 * g3 + i; const int c2 = d ? (sidx < 4 ? 3 - sidx : 39 - sidx) : sidx;
                    const bool use = d ? (sidx < 4 || c2 > cidx) : (c2 < cidx);
                    h = use ? qv[i].x * h + qv[i].y : h; }
            }
#pragma unroll
            for (int i = 0; i < 4; ++i) { const int mt = d ? 3 - i : i;
                float hl = Pe[mt] * h + Se[mt];
#pragma unroll
                for (int rr = 0; rr < 4; ++rr) { const int r = d ? 3 - rr : rr; hl = av[mt][r] * hl + bv[mt][r]; if (d == 0) hsum[mt][r] = hl; else hsum[mt][r] += hl; }
                h = Pt[mt] * h + St[mt]; }
        }
    }
    if (FINAL) {
#pragma unroll
        for (int mt = 0; mt < 4; ++mt)
#pragma unroll
            for (int r = 0; r < 4; ++r) zf[(16 * mt + 4 * fq + r) * 132 + chl] = hsum[mt][r];
        WG_BAR();
        const int pos = tid >> 3, cg = tid & 7, ch0 = blk * 128 + cg * 16;
        const size_t lrow = (size_t)(lru_pos_row(b, false, p0 + pos) - NCTX) * 1024 + ch0;
        const v4u* ug = (const v4u*)((const bf16*)(a.ws + WS_UG) + lrow); const v4u g0 = ug[0], g1 = ug[1];
        const unsigned gg[8] = {g0.x, g0.y, g0.z, g0.w, g1.x, g1.y, g1.z, g1.w}; unsigned o[8];
#pragma unroll
        for (int q = 0; q < 4; ++q) { const f32x4 hv = *(const f32x4*)(zf + pos * 132 + cg * 16 + 4 * q);
            o[2 * q] = pk2(hv.x * bflo(gg[2 * q]), hv.y * bfhi(gg[2 * q])); o[2 * q + 1] = pk2(hv.z * bflo(gg[2 * q + 1]), hv.w * bfhi(gg[2 * q + 1])); }
        v4u* dst = (v4u*)((bf16*)(a.ws + WS_YB) + lrow); dst[0] = (v4u){o[0], o[1], o[2], o[3]}; dst[1] = (v4u){o[4], o[5], o[6], o[7]};
    }
    WG_BAR();
}
constexpr int ML_STRIDE = 136;
constexpr int ML_Q = 0, ML_K = 17408, ML_V = 34816, ML_AUG = 52224  , ML_CB = 54272  ;
constexpr int ML_EB = 93440  , ML_EU = 95488  , ML_EBEND = 97536  , ML_BEND = 97568  , ML_DEN = 97600  , ML_SSQ = 97856  ;
typedef short s4_t __attribute__((ext_vector_type(4)));
__device__ __forceinline__ s4_t ds_tr(const bf16* p) { return __builtin_amdgcn_ds_read_tr16_b64_v4i16((LAS s4_t*)p); }
__device__ __forceinline__ bf16x8_t frag_row(const bf16* img, int row0, int k0, int fr, int fq) { return *(const bf16x8_t*)(img + (row0 + fr) * ML_STRIDE + k0 + 8 * fq); }
__device__ __forceinline__ bf16x8_t frag_tr2(const bf16* img, int stride, int sA, int sB, int col0, int lane) {
    const int fq = lane >> 4, q = (lane & 15) >> 2, p = lane & 3;
    const s4_t lo = ds_tr(img + (sA + 4 * fq + q) * stride + col0 + 4 * p), hi = ds_tr(img + (sB + 4 * fq + q) * stride + col0 + 4 * p);
    return (bf16x8_t){lo.x, lo.y, lo.z, lo.w, hi.x, hi.y, hi.z, hi.w};
}
__device__ __forceinline__ bf16x8_t frag_tr(const bf16* img, int stride, int s0, int col0, int lane) {
    const int fq = lane >> 4, q = (lane & 15) >> 2, p = lane & 3;
    const bf16* b = img + (s0 + 8 * fq + q) * stride + col0 + 4 * p;
    const s4_t lo = ds_tr(b), hi = ds_tr(b + 4 * stride);
    return (bf16x8_t){lo.x, lo.y, lo.z, lo.w, hi.x, hi.y, hi.z, hi.w};
}
__device__ __forceinline__ float logsigmoidf_(float x) { return fminf(x, 0.f) - log1pf(__expf(-fabsf(x))); }

__device__ __forceinline__ void ml_gates(const Args& a, unsigned char* lds_g, int rowbase, int h, int tid) {
    const int lane = tid & 63, w = tid >> 6, dir = w >> 2, c = w & 3;
    const float* GT = (const float*)(a.ws + WS_GATES) + (size_t)(rowbase + 64 * c + lane) * 32;
    const float ipre = GT[(dir * 2) * 8 + h], fpre = GT[(dir * 2 + 1) * 8 + h];
    float bsum = logsigmoidf_(fpre);
    if (dir == 0) {
#pragma unroll
        for (int o = 1; o < 64; o <<= 1) { const float t = __shfl_up(bsum, o); if (lane >= o) bsum += t; }
    } else {
#pragma unroll
        for (int o = 1; o < 64; o <<= 1) { const float t = __shfl_down(bsum, o); if (lane + o < 64) bsum += t; }
    }
    float* eb = (float*)(lds_g + ML_EB); float* eu = (float*)(lds_g + ML_EU);
    eb[dir * 256 + 64 * c + lane] = __expf(bsum); eu[dir * 256 + 64 * c + lane] = __expf(ipre - bsum);
    const float bend = __shfl(bsum, dir ? 0 : 63);
    if (lane == 0) { ((float*)(lds_g + ML_EBEND))[dir * 4 + c] = __expf(bend); ((float*)(lds_g + ML_BEND))[dir * 4 + c] = bend; }
}

template <bool OUT, bool PASS2>
__device__ __forceinline__ void ml_block(const Args& a, unsigned char* lds_g, int rowbase, int h, int dir, f32x4 (&st)[9], int tid) {
    const int lane = tid & 63, w = __builtin_amdgcn_readfirstlane(tid >> 6), fr = lane & 15, fq = lane >> 4;
    bf16* Qi = (bf16*)(lds_g + ML_Q); bf16* Ki = (bf16*)(lds_g + ML_K); bf16* Vi = (bf16*)(lds_g + ML_V); bf16* AUGi = (bf16*)(lds_g + ML_AUG); bf16* CB = (bf16*)(lds_g + ML_CB);
    const float* eb = (const float*)(lds_g + ML_EB) + dir * 256; const float* eu = (const float*)(lds_g + ML_EU) + dir * 256;
    const float* ebend = (const float*)(lds_g + ML_EBEND) + dir * 4;
    float* den = (float*)(lds_g + ML_DEN); float* ssq = (float*)(lds_g + ML_SSQ);
    const bf16* Kb = (const bf16*)(a.ws + WS_K); const bf16* Vb = (const bf16*)(a.ws + WS_V); const bf16* Qb = (const bf16*)(a.ws + WS_Q);
    const int ti = w & 3, vh = w >> 2;
    float hgv[5];
    if (OUT) {
#pragma unroll
        for (int x = 0; x < 5; ++x) { const int vt = vh * 5 + x; hgv[x] = vt < 8 ? a.in[I_HEADG][h * 128 + 16 * vt + fr] : 0.f; } }
    for (int ci = 0; ci < 4; ++ci) {
        const int c = dir ? 3 - ci : ci;
        unsigned short ogv[5][4]; unsigned short tmv[5][4];
        if (OUT) {
            const bf16* OGp = (const bf16*)(a.ws + (dir ? WS_OB : WS_OF)); const bf16* TMp = (const bf16*)(a.ws + WS_TM);
#pragma unroll
            for (int r = 0; r < 4; ++r) { const size_t ob = (size_t)(rowbase - NCTX + 64 * c + 16 * ti + 4 * fq + r) * 1024 + h * 128;
#pragma unroll
                for (int x = 0; x < 5; ++x) { const int vt = vh * 5 + x; if (vt < 8) { ogv[x][r] = OGp[ob + 16 * vt + fr]; if (PASS2) tmv[x][r] = TMp[ob + 16 * vt + fr]; } } }
            __builtin_amdgcn_sched_barrier(0);
        }
        {
            const int t = tid >> 3, pc = tid & 7; const size_t row = (size_t)(rowbase + 64 * c + t);
            const v4u* ks = (const v4u*)(Kb + row * 1024 + h * 128 + 16 * pc); const v4u k0 = ks[0], k1 = ks[1];
            const v4u* vs = (const v4u*)(Vb + row * 1024 + h * 128 + 16 * pc); const v4u v0 = vs[0], v1 = vs[1];
            v4u q0, q1; if (OUT) { const v4u* qs = (const v4u*)(Qb + (row - NCTX) * 1024 + h * 128 + 16 * pc); q0 = qs[0]; q1 = qs[1]; }
            const float e = eu[64 * c + t];
            *(v4u*)(Ki + t * ML_STRIDE + 16 * pc) = k0; *(v4u*)(Ki + t * ML_STRIDE + 16 * pc + 8) = k1;
            if (OUT) { *(v4u*)(Qi + t * ML_STRIDE + 16 * pc) = q0; *(v4u*)(Qi + t * ML_STRIDE + 16 * pc + 8) = q1; }
            const unsigned vv[8] = {v0.x, v0.y, v0.z, v0.w, v1.x, v1.y, v1.z, v1.w}; unsigned o[8];
#pragma unroll
            for (int i = 0; i < 8; ++i) o[i] = pk2(bflo(vv[i]) * e, bfhi(vv[i]) * e);
            *(v4u*)(Vi + t * ML_STRIDE + 16 * pc) = (v4u){o[0], o[1], o[2], o[3]}; *(v4u*)(Vi + t * ML_STRIDE + 16 * pc + 8) = (v4u){o[4], o[5], o[6], o[7]};
            if (pc == 0) { *(v4u*)(AUGi + t * 16) = (v4u){f2bf(e), 0u, 0u, 0u}; *(v4u*)(AUGi + t * 16 + 8) = (v4u){0u, 0u, 0u, 0u}; }
        }
        WG_BAR();
        f32x4 X[5]; float hval[4][4];
        if (OUT) {
            bf16x8_t qf[4];
#pragma unroll
            for (int ks = 0; ks < 4; ++ks) qf[ks] = frag_row(Qi, 16 * ti, 32 * ks, fr, fq);
            bf16x8_t P[2]; bool pv[2];
#pragma unroll
            for (int pp = 0; pp < 2; ++pp) {
                f32x4 d[2];
#pragma unroll
                for (int hh = 0; hh < 2; ++hh) { const int si = 2 * pp + hh; d[hh] = (f32x4){0.f, 0.f, 0.f, 0.f};
                    const bool valid = dir ? (si >= ti) : (si <= ti);
                    if (valid) {
#pragma unroll
                        for (int ks = 0; ks < 4; ++ks) d[hh] = __builtin_amdgcn_mfma_f32_16x16x32_bf16(frag_row(Ki, 16 * si, 32 * ks, fr, fq), qf[ks], d[hh], 0, 0, 0);
                        if (si == ti) {
#pragma unroll
                            for (int r = 0; r < 4; ++r) { const bool keep = dir ? (4 * fq + r >= fr) : (4 * fq + r <= fr); d[hh][r] = keep ? d[hh][r] : 0.f; } } } }
                pv[pp] = dir ? (2 * pp + 1 >= ti) : (2 * pp <= ti);
                const unsigned p0 = pk2(d[0][0], d[0][1]), p1 = pk2(d[0][2], d[0][3]), p2 = pk2(d[1][0], d[1][1]), p3 = pk2(d[1][2], d[1][3]);
                P[pp] = __builtin_bit_cast(bf16x8_t, (v4u){p0, p1, p2, p3});
            }
#pragma unroll
            for (int x = 0; x < 5; ++x) { X[x] = (f32x4){0.f, 0.f, 0.f, 0.f};
                const int vt = vh * 5 + x;
                if (vt < 9) {
#pragma unroll
                    for (int pp = 0; pp < 2; ++pp) if (pv[pp]) {
                        const bf16x8_t bfv = vt < 8 ? frag_tr2(Vi, ML_STRIDE, 32 * pp, 32 * pp + 16, 16 * vt, lane) : frag_tr2(AUGi, 16, 32 * pp, 32 * pp + 16, 0, lane);
                        X[x] = __builtin_amdgcn_mfma_f32_16x16x32_bf16(P[pp], bfv, X[x], 0, 0, 0); }
#pragma unroll
                    for (int ks = 0; ks < 4; ++ks) X[x] = __builtin_amdgcn_mfma_f32_16x16x32_bf16(qf[ks], frag_row(CB, 16 * vt, 32 * ks, fr, fq), X[x], 0, 0, 0);
                } }
            if (vh == 1 && fr == 0) {
#pragma unroll
                for (int r = 0; r < 4; ++r) den[16 * ti + 4 * fq + r] = X[3][r] * eb[64 * c + 16 * ti + 4 * fq + r]; }
        }
        {
#pragma unroll
            for (int ks = 0; ks < 2; ++ks) { const bf16x8_t kf = frag_tr(Ki, ML_STRIDE, 32 * ks, 16 * w, lane);
#pragma unroll
                for (int vt = 0; vt < 8; ++vt) st[vt] = __builtin_amdgcn_mfma_f32_16x16x32_bf16(kf, frag_tr(Vi, ML_STRIDE, 32 * ks, 16 * vt, lane), st[vt], 0, 0, 0);
                st[8] = __builtin_amdgcn_mfma_f32_16x16x32_bf16(kf, frag_tr(AUGi, 16, 32 * ks, 0, lane), st[8], 0, 0, 0); }
            const float ee = ebend[c];
#pragma unroll
            for (int vt = 0; vt < 9; ++vt) st[vt] = st[vt] * ee;
        }
        WG_BAR();
        if (OUT) {
            float sq[4] = {0.f, 0.f, 0.f, 0.f};
#pragma unroll
            for (int r = 0; r < 4; ++r) { const int t = 16 * ti + 4 * fq + r; const float sc = eb[64 * c + t] * __builtin_amdgcn_rcpf(fmaxf(fabsf(den[t]), 1.f));
#pragma unroll
                for (int x = 0; x < 4; ++x) { const int vt = vh * 5 + x; const float hv = (vt < 8) ? X[x][r] * sc : 0.f; hval[x][r] = hv; sq[r] += hv * hv; }
                if (vh == 0) { const float hv = X[4][r] * sc; X[4][r] = hv; sq[r] += hv * hv; } }
#pragma unroll
            for (int r = 0; r < 4; ++r) { float v = sq[r]; v += __shfl_xor(v, 1); v += __shfl_xor(v, 2); v += __shfl_xor(v, 4); v += __shfl_xor(v, 8); if (fr == 0) ssq[vh * 64 + 16 * ti + 4 * fq + r] = v; }
#pragma unroll
            for (int vt = 0; vt < 9; ++vt) { pg8::u32x2 o; o.x = pk2(st[vt][0], st[vt][1]); o.y = pk2(st[vt][2], st[vt][3]); *(pg8::u32x2*)(CB + (16 * vt + fr) * ML_STRIDE + 16 * w + 4 * fq) = o; }
            WG_BAR();
            bf16* TM = (bf16*)(a.ws + WS_TM); bf16* YA = (bf16*)(a.ws + WS_YA);
#pragma unroll
            for (int r = 0; r < 4; ++r) { const int t = 16 * ti + 4 * fq + r; const float rs = __builtin_amdgcn_rsqf((ssq[t] + ssq[64 + t]) * (1.f / 128.f) + EPS);
                const size_t ob = (size_t)(rowbase - NCTX + 64 * c + t) * 1024 + h * 128;
#pragma unroll
                for (int x = 0; x < 5; ++x) { const int vt = vh * 5 + x; if (vt < 8) { const int v = 16 * vt + fr; const float hv = (x < 4) ? hval[x][r] : X[4][r];
                    float y = hv * rs * hgv[x] * bf2f(ogv[x][r]);
                    if (PASS2) { y += bf2f(tmv[x][r]); YA[ob + v] = (bf16)f2bf(y); } else TM[ob + v] = (bf16)f2bf(y); } } }
        }
    }
}

__device__ __forceinline__ void ml_state_quad(const Args& a, unsigned char* lds_g, int qu, int tid) {
    const int seq = qu >> 1, j0 = 4 * (qu & 1), dir = seq & 1, h = (seq >> 1) & 7, b = seq >> 4;
    const int lane = tid & 63, w = __builtin_amdgcn_readfirstlane(tid >> 6);
    f32x4 st[9];
#pragma unroll
    for (int vt = 0; vt < 9; ++vt) st[vt] = (f32x4){0.f, 0.f, 0.f, 0.f};
#pragma unroll 1
    for (int jj = 0; jj < 4; ++jj) {
        const int j = j0 + jj, su = seq * 8 + j;
        const int rowbase = j == 0 ? b * CTXL : NCTX + b * SEQ + 256 * (dir ? 8 - j : j - 1);
        ml_gates(a, lds_g, rowbase, h, tid);
        WG_BAR();
        ml_block<false, false>(a, lds_g, rowbase, h, dir, st, tid);
        pg8::u32x2* SL = (pg8::u32x2*)(a.ws + WS_SLOC) + ((size_t)(su * 8 + w) * 9) * 64 + lane;
#pragma unroll
        for (int vt = 0; vt < 9; ++vt) { pg8::u32x2 o; o.x = pk2(st[vt][0], st[vt][1]); o.y = pk2(st[vt][2], st[vt][3]); SL[vt * 64] = o; }
        if (tid == 0) { const float* bd = (const float*)(lds_g + ML_BEND) + dir * 4; ((float*)(a.ws + WS_BT))[su] = (bd[0] + bd[1]) + (bd[2] + bd[3]); }
        WG_BAR();
    }
}
__device__ __forceinline__ void ml_out_unit(const Args& a, unsigned char* lds_g, int u, int tid) {
    const int L = u & 7, h = (u >> 3) & 7, b = u >> 6;
    const int rowbase = NCTX + b * SEQ + 256 * L;
    const int lane = tid & 63, w = __builtin_amdgcn_readfirstlane(tid >> 6), fr = lane & 15, fq = lane >> 4;
    bf16* CB = (bf16*)(lds_g + ML_CB);
    ml_gates(a, lds_g, rowbase, h, tid);
    f32x4 st[9];
#pragma unroll
    for (int dir = 0; dir < 2; ++dir) {
        const int seq = (b * 8 + h) * 2 + dir, jmax = dir ? 7 - L : L;
        const float* BT = (const float*)(a.ws + WS_BT) + seq * 8;
        {
            const pg8::u32x2* SLa = (const pg8::u32x2*)(a.ws + WS_SLOC) + ((size_t)((seq * 8 + jmax) * 8 + w) * 9) * 64 + lane;
            const pg8::u32x2* SLb = (const pg8::u32x2*)(a.ws + WS_SLOC) + ((size_t)((seq * 8 + 3) * 8 + w) * 9) * 64 + lane;
            pg8::u32x2 sa[9];
            if (jmax >= 4) {
                pg8::u32x2 sb[9];
#pragma unroll
                for (int vt = 0; vt < 9; ++vt) { sa[vt] = SLa[vt * 64]; sb[vt] = SLb[vt * 64]; }
                float ls = 0.f;
#pragma unroll
                for (int q = 4; q < 8; ++q) ls += (q <= jmax) ? BT[q] : 0.f;
                const float coef = __expf(ls);
#pragma unroll
                for (int vt = 0; vt < 9; ++vt) st[vt] = (f32x4){bflo(sa[vt].x) + bflo(sb[vt].x) * coef, bfhi(sa[vt].x) + bfhi(sb[vt].x) * coef, bflo(sa[vt].y) + bflo(sb[vt].y) * coef, bfhi(sa[vt].y) + bfhi(sb[vt].y) * coef};
            } else {
#pragma unroll
                for (int vt = 0; vt < 9; ++vt) { sa[vt] = SLa[vt * 64]; st[vt] = (f32x4){bflo(sa[vt].x), bfhi(sa[vt].x), bflo(sa[vt].y), bfhi(sa[vt].y)}; }
            }
        }
#pragma unroll
        for (int vt = 0; vt < 9; ++vt) { pg8::u32x2 o; o.x = pk2(st[vt][0], st[vt][1]); o.y = pk2(st[vt][2], st[vt][3]); *(pg8::u32x2*)(CB + (16 * vt + fr) * ML_STRIDE + 16 * w + 4 * fq) = o; }
        WG_BAR();
        if (dir == 0) ml_block<true, false>(a, lds_g, rowbase, h, 0, st, tid);
        else ml_block<true, true>(a, lds_g, rowbase, h, 1, st, tid);
        asm volatile("s_waitcnt vmcnt(0)" ::: "memory");
        WG_BAR();
    }
}

__device__ __forceinline__ void lru_out_unit(const Args& a, unsigned char* lds_g, int b, int cidx, int blk, int tid) {
    const int chl = tid & 127, q = tid >> 7, ch = blk * 128 + chl;
    float2* QA = (float2*)lds_g;
    float av[2][16], bv[2][16];
#pragma unroll
    for (int d = 0; d < 2; ++d) { const unsigned* PS = (const unsigned*)(a.ws + WS_PS) + ((size_t)(b * 2 + d) * NSTEP + 64 * cidx + 16 * q) * 1024 + ch;
#pragma unroll
        for (int i = 0; i < 16; ++i) { const unsigned wv = PS[(size_t)i * 1024]; av[d][i] = 1.f - bflo(wv); bv[d][i] = bfhi(wv); } }
    float2* CA = (float2*)(lds_g + 8192);
#pragma unroll
    for (int d = 0; d < 2; ++d) { const float2* AGG = (const float2*)(a.ws + WS_AGG) + ((size_t)(b * 2 + d) * 36) * 1024 + ch; float2 qv[9];
#pragma unroll
        for (int i = 0; i < 9; ++i) { const int sidx = 9 * q + i; const int c2 = d ? (sidx < 4 ? 3 - sidx : 39 - sidx) : sidx; qv[i] = AGG[(size_t)c2 * 1024]; }
        float P = 1.f, S = 0.f;
#pragma unroll
        for (int i = 0; i < 9; ++i) { const int sidx = 9 * q + i; const int c2 = d ? (sidx < 4 ? 3 - sidx : 39 - sidx) : sidx; const bool use = d ? (sidx < 4 || c2 > cidx) : (c2 < cidx);
            S = use ? qv[i].x * S + qv[i].y : S; P = use ? qv[i].x * P : P; }
        CA[(d * 4 + q) * 128 + chl] = make_float2(P, S); }
#pragma unroll
    for (int d = 0; d < 2; ++d) { float P = 1.f, S = 0.f;
#pragma unroll
        for (int ii = 0; ii < 16; ++ii) { const int i = d ? 15 - ii : ii; S = av[d][i] * S + bv[d][i]; P = av[d][i] * P; }
        QA[(d * 4 + q) * 128 + chl] = make_float2(P, S); }
    WG_BAR();
    float hs[16];
#pragma unroll
    for (int d = 0; d < 2; ++d) { float h = 0.f;
#pragma unroll
        for (int k = 0; k < 4; ++k) { const float2 t = CA[(d * 4 + k) * 128 + chl]; h = t.x * h + t.y; }
#pragma unroll
        for (int k = 0; k < 3; ++k) { const int qq = d ? 3 - k : k; const bool use = d ? (qq > q) : (qq < q); const float2 t = QA[(d * 4 + qq) * 128 + chl]; h = use ? t.x * h + t.y : h; }
#pragma unroll
        for (int ii = 0; ii < 16; ++ii) { const int i = d ? 15 - ii : ii; h = av[d][i] * h + bv[d][i]; if (d == 0) hs[i] = h; else hs[i] += h; } }
    const int p0 = (cidx - 4) * 64 + 16 * q;
    unsigned short ugv[16];
#pragma unroll
    for (int i = 0; i < 16; ++i) ugv[i] = ((const bf16*)(a.ws + WS_UG))[(size_t)(lru_pos_row(b, false, p0 + i) - NCTX) * 1024 + ch];
#pragma unroll
    for (int i = 0; i < 16; ++i) { const size_t lrow = (size_t)(lru_pos_row(b, false, p0 + i) - NCTX) * 1024 + ch;
        ((bf16*)(a.ws + WS_YB))[lrow] = (bf16)f2bf(hs[i] * bf2f(ugv[i])); }
    WG_BAR();
}
__device__ __forceinline__ void phase3(const Args& a, unsigned char* lds_g, int tid) {
    {
        int q0 = (int)blockIdx.x, qstep = (int)gridDim.x;
        if (gridDim.x == 256) q0 = blockIdx.x >= 128 ? (int)blockIdx.x - 128 : 128;
        for (int qu = q0; qu < 128; qu += qstep) ml_state_quad(a, lds_g, qu, tid);
    }
    for (int u = blockIdx.x; u < 4 * 36 * 8; u += gridDim.x) { const int blk = u & 7, q = u >> 3; lru_unit<false>(a, lds_g, q / 36, q % 36, blk, tid); }
}

struct SchedProj {
    int G, c; const char *YA, *YB, *WA, *WB;
    __device__ __forceinline__ bool next(int i, pg8::Unit& u) const {
        const int tile = (i >> 1) * G + c, part = i & 1; if (tile >= 256) return false;
        int pm, pn; pg8::tile_order(tile, 32, 8, pm, pn);
        u.pm = pm; u.pn = pn; u.aux = part; u.A = (part ? YB : YA) + (size_t)pm * 256 * 1024 * 2; u.B = (part ? WB : WA) + (size_t)pn * 256 * 1024 * 2; return true;
    }
};
struct EpiProj {
    static constexpr bool PERM = true, CARRY = true;
    const bf16 *GA, *GB; bf16* PRE;
    __device__ __forceinline__ bool keep(const pg8::Unit& u) const { return u.aux == 0; }
    __device__ __forceinline__ void operator()(pg8::f32x4 (&acc)[2][2][4][2], const pg8::Unit& u, int wr, int wc, int fr, int fq) const {
#pragma unroll
        for (int ai = 0; ai < 2; ++ai) {
            pg8::u32x4 gb4[4][2], ga4[4][2];
#pragma unroll
            for (int m = 0; m < 4; ++m) { const size_t off = (size_t)(u.pm * 256 + ai * 128 + wr * 64 + m * 16 + fr) * 2048 + u.pn * 256 + wc * 32 + 8 * fq;
#pragma unroll
                for (int bj = 0; bj < 2; ++bj) { gb4[m][bj] = *(const pg8::u32x4*)(GB + off + bj * 128); if (u.aux == 0) ga4[m][bj] = *(const pg8::u32x4*)(GA + off + bj * 128); } }
#pragma unroll
            for (int m = 0; m < 4; ++m) { const size_t off = (size_t)(u.pm * 256 + ai * 128 + wr * 64 + m * 16 + fr) * 2048 + u.pn * 256 + wc * 32 + 8 * fq;
#pragma unroll
                for (int bj = 0; bj < 2; ++bj) { const pg8::u32x4 g4 = gb4[m][bj];
                    const float gbv[8] = {bflo(g4.x), bfhi(g4.x), bflo(g4.y), bfhi(g4.y), bflo(g4.z), bfhi(g4.z), bflo(g4.w), bfhi(g4.w)};
                    if (u.aux == 0) { const pg8::u32x4 a4 = ga4[m][bj];
                        const float gav[8] = {bflo(a4.x), bfhi(a4.x), bflo(a4.y), bfhi(a4.y), bflo(a4.z), bfhi(a4.z), bflo(a4.w), bfhi(a4.w)};
#pragma unroll
                        for (int e = 0; e < 4; ++e) { acc[ai][bj][m][0][e] *= gav[e] * __builtin_amdgcn_rcpf(fmaxf(gbv[e], 1e-20f)); acc[ai][bj][m][1][e] *= gav[4 + e] * __builtin_amdgcn_rcpf(fmaxf(gbv[4 + e], 1e-20f)); }
                    } else {
                        pg8::f32x4 v0 = acc[ai][bj][m][0], v1 = acc[ai][bj][m][1];
#pragma unroll
                        for (int e = 0; e < 4; ++e) { v0[e] *= gbv[e]; v1[e] *= gbv[4 + e]; }
                        pg8::u32x4 w; w.x = pg8::cvt_pk_bf16(v0[0], v0[1]); w.y = pg8::cvt_pk_bf16(v0[2], v0[3]); w.z = pg8::cvt_pk_bf16(v1[0], v1[1]); w.w = pg8::cvt_pk_bf16(v1[2], v1[3]);
                        *(pg8::u32x4*)(PRE + off + bj * 128) = w; } } }
        }
    }
};

struct SchedOut {
    int G, c; const char *A, *B;
    __device__ __forceinline__ bool next(int i, pg8::Unit& u) const {
        const int L = i * G + c; if (L >= 256) return false;
        int pm, pn; pg8::tile_order(L, 32, 8, pm, pn);
        u.pm = pm; u.pn = pn; u.aux = 0; u.A = A + (size_t)pm * 256 * D * 2; u.B = B + (size_t)pn * 256 * D * 2; return true;
    }
};
struct EpiOut {
    static constexpr bool PERM = true, CARRY = false;
    __device__ __forceinline__ bool keep(const pg8::Unit&) const { return false; }
    const float* x; const float* MOD; bf16* X1;
    __device__ __forceinline__ void operator()(const pg8::f32x4 (&acc)[2][2][4][2], const pg8::Unit& u, int wr, int wc, int fr, int fq) const {
        const int b = u.pm >> 3; const int col0 = u.pn * 256 + wc * 32 + 8 * fq;
        pg8::f32x4 g1[2][2];
#pragma unroll
        for (int bj = 0; bj < 2; ++bj)
#pragma unroll
            for (int n = 0; n < 2; ++n) g1[bj][n] = *(const pg8::f32x4*)(MOD + b * 12288 + 2 * 2048 + col0 + bj * 128 + n * 4);
#pragma unroll
        for (int ai = 0; ai < 2; ++ai) {
            pg8::f32x4 xv[4][2][2];
#pragma unroll
            for (int m = 0; m < 4; ++m) { const size_t off = (size_t)(u.pm * 256 + ai * 128 + wr * 64 + m * 16 + fr) * D + col0;
#pragma unroll
                for (int bj = 0; bj < 2; ++bj)
#pragma unroll
                    for (int n = 0; n < 2; ++n) xv[m][bj][n] = *(const pg8::f32x4*)(x + off + bj * 128 + n * 4); }
#pragma unroll
            for (int m = 0; m < 4; ++m) { const size_t off = (size_t)(u.pm * 256 + ai * 128 + wr * 64 + m * 16 + fr) * D + col0;
#pragma unroll
                for (int bj = 0; bj < 2; ++bj) { const pg8::f32x4 v0 = xv[m][bj][0] + g1[bj][0] * acc[ai][bj][m][0], v1 = xv[m][bj][1] + g1[bj][1] * acc[ai][bj][m][1];
                    pg8::u32x4 w; w.x = pg8::cvt_pk_bf16(v0[0], v0[1]); w.y = pg8::cvt_pk_bf16(v0[2], v0[3]); w.z = pg8::cvt_pk_bf16(v1[0], v1[1]); w.w = pg8::cvt_pk_bf16(v1[2], v1[3]);
                    *(pg8::u32x4*)(X1 + off + bj * 128) = w; } }
        }
    }
};

__device__ __forceinline__ void phase_router(const Args& a, unsigned char* lds_g, int tid, int lane, int wave) {
    const bf16* X1 = (const bf16*)(a.ws + WS_X1); const float* MOD = (const float*)(a.ws + WS_MOD); const float* g = a.in[I_N2G];
    const float* WR = (const float*)(a.ws + WS_WR); const float* RB = (const float*)(a.ws + WS_RB);
    bf16* H2 = (bf16*)(a.ws + WS_H2); unsigned* cnt = (unsigned*)(a.ws + WS_CTL) + CW_CNT; int4* ASG = (int4*)(a.ws + WS_ASG);
    f32x4* PART = (f32x4*)lds_g;
    float* SSQP = (float*)(lds_g + 24576);
    float* RS = (float*)(lds_g + 24576 + 512);
    float* LG = (float*)(lds_g + 24576 + 1024);
    const int slot = wave >> 2, kq = wave & 3, i = lane & 15, gq = lane >> 4;
    for (int tp = blockIdx.x; tp < NLAT / 32; tp += gridDim.x) {
        const int tok0 = 32 * tp + 16 * slot, b = tok0 >> 11, kbase = kq * 512 + 8 * gq;
        const bf16* xr = X1 + (size_t)(tok0 + i) * D + kbase;
        const float* wr = WR + ((size_t)(b * 48 + i) * 2048 + kbase);
        f32x4 acc0 = (f32x4){0.f, 0.f, 0.f, 0.f}, acc1 = acc0, acc2 = acc0; float sq = 0.f;
#pragma unroll 2
        for (int s8 = 0; s8 < 16; ++s8) {
            const v4u xb = *(const v4u*)(xr + 32 * s8);
            const f32x4 b0a = *(const f32x4*)(wr + 32 * s8), b0b = *(const f32x4*)(wr + 32 * s8 + 4), b1a = *(const f32x4*)(wr + 16 * 2048 + 32 * s8), b1b = *(const f32x4*)(wr + 16 * 2048 + 32 * s8 + 4),
                        b2a = *(const f32x4*)(wr + 32 * 2048 + 32 * s8), b2b = *(const f32x4*)(wr + 32 * 2048 + 32 * s8 + 4);
            const float xe[8] = {bflo(xb.x), bfhi(xb.x), bflo(xb.y), bfhi(xb.y), bflo(xb.z), bfhi(xb.z), bflo(xb.w), bfhi(xb.w)};
#pragma unroll
            for (int e = 0; e < 4; ++e) { acc0 = __builtin_amdgcn_mfma_f32_16x16x4f32(xe[e], b0a[e], acc0, 0, 0, 0); acc1 = __builtin_amdgcn_mfma_f32_16x16x4f32(xe[e], b1a[e], acc1, 0, 0, 0); acc2 = __builtin_amdgcn_mfma_f32_16x16x4f32(xe[e], b2a[e], acc2, 0, 0, 0); }
#pragma unroll
            for (int e = 0; e < 4; ++e) { acc0 = __builtin_amdgcn_mfma_f32_16x16x4f32(xe[4 + e], b0b[e], acc0, 0, 0, 0); acc1 = __builtin_amdgcn_mfma_f32_16x16x4f32(xe[4 + e], b1b[e], acc1, 0, 0, 0); acc2 = __builtin_amdgcn_mfma_f32_16x16x4f32(xe[4 + e], b2b[e], acc2, 0, 0, 0); }
#pragma unroll
            for (int e = 0; e < 8; ++e) sq += xe[e] * xe[e];
        }
        sq += __shfl_xor(sq, 16); sq += __shfl_xor(sq, 32);
        PART[((slot * 4 + kq) * 3 + 0) * 64 + lane] = acc0; PART[((slot * 4 + kq) * 3 + 1) * 64 + lane] = acc1; PART[((slot * 4 + kq) * 3 + 2) * 64 + lane] = acc2;
        if (gq == 0) SSQP[(slot * 4 + kq) * 16 + i] = sq;
        __syncthreads();
        if (kq == 0) {
            const float* sp = SSQP + slot * 64; const float rstd = 1.f / sqrtf(((sp[i] + sp[16 + i]) + (sp[32 + i] + sp[48 + i])) * (1.f / D) + EPS);
            if (gq == 0) RS[slot * 16 + i] = rstd;
#pragma unroll
            for (int cb = 0; cb < 3; ++cb) { const f32x4* pp = PART + (slot * 4 * 3 + cb) * 64 + lane; const f32x4 sum = (pp[0] + pp[3 * 64]) + (pp[6 * 64] + pp[9 * 64]);
                const float rb = RB[b * 48 + 16 * cb + i];
#pragma unroll
                for (int r = 0; r < 4; ++r) LG[(slot * 16 + 4 * gq + r) * 48 + 16 * cb + i] = __shfl(rstd, 4 * gq + r) * sum[r] + rb; }
            LDS_WAIT(); asm volatile("" ::: "memory");
            if (lane < 16) {
                const float* lg = LG + (slot * 16 + lane) * 48; const int t = tok0 + lane;
                int gs = 0; float gm = lg[32];
#pragma unroll
                for (int q = 1; q < 4; ++q) { const float v = lg[32 + q]; if (v > gm) { gm = v; gs = q; } }
                float se = 0.f;
#pragma unroll
                for (int q = 0; q < 4; ++q) se += __expf(lg[32 + q] - gm);
                const float pg = 1.f / se;
                int i0 = 0; float v0 = lg[gs * 8];
#pragma unroll
                for (int q = 1; q < 8; ++q) { const float v = lg[gs * 8 + q]; if (v > v0) { v0 = v; i0 = q; } }
                int i1 = -1; float v1 = -3.0e38f;
#pragma unroll
                for (int q = 0; q < 8; ++q) { const float v = lg[gs * 8 + q]; if (q != i0 && v > v1) { v1 = v; i1 = q; } }
                const float e1 = __expf(v1 - v0), w0 = pg / (1.f + e1), w1 = pg * e1 / (1.f + e1);
                const int ex0 = gs * 8 + i0, ex1 = gs * 8 + i1;
                const unsigned p0 = atomicAdd(cnt + ex0, 1u), p1 = atomicAdd(cnt + ex1, 1u);
                ASG[2 * t] = make_int4(ex0, (int)p0, __float_as_int(w0), 0); ASG[2 * t + 1] = make_int4(ex1, (int)p1, __float_as_int(w1), 0);
                int* LIST = (int*)(a.ws + WS_LIST); LIST[ex0 * 8192 + (int)p0] = t; LIST[ex1 * 8192 + (int)p1] = t;
            }
        }
        __syncthreads();
#pragma unroll
        for (int r = 0; r < 4; ++r) { const int tl = 4 * kq + r, t = tok0 + tl; const float rstd = RS[slot * 16 + tl];
            const unsigned long long* xrow = (const unsigned long long*)(X1 + (size_t)t * D) + lane; unsigned* o4 = (unsigned*)((unsigned char*)H2 + (size_t)t * D) + lane;
            f32x4 yv[8];
#pragma unroll
            for (int j = 0; j < 8; ++j) { const int c = 4 * lane + 256 * j;
                const f32x4 gg = *(const f32x4*)(g + c), sh = *(const f32x4*)(MOD + b * 12288 + 3 * 2048 + c), sc = *(const f32x4*)(MOD + b * 12288 + 4 * 2048 + c);
                const unsigned long long xw = xrow[64 * j]; const f32x4 xv4 = (f32x4){bflo((unsigned)xw), bfhi((unsigned)xw), bflo((unsigned)(xw >> 32)), bfhi((unsigned)(xw >> 32))};
                yv[j] = xv4 * rstd * gg * (sc + 1.f) + sh; }
#pragma unroll
            for (int j = 0; j < 8; ++j) { int w8 = __builtin_amdgcn_cvt_pk_fp8_f32(yv[j].x, yv[j].y, 0, false); w8 = __builtin_amdgcn_cvt_pk_fp8_f32(yv[j].z, yv[j].w, w8, true); o4[64 * j] = (unsigned)w8; } }
        __syncthreads();
    }
}

constexpr int MG_A = 0, MG_ABYTES = 32768, MG_B = 65536, MG_BBYTES = 64 * 256  , MG_CUM = 141312  ;
__device__ __forceinline__ int mgb_off(int row, int ch) { return 256 * row + 16 * (ch ^ (((row & 3) << 2) | ((row >> 2) & 3))); }
__device__ __forceinline__ bf16x8_t mgb_frag(const unsigned char* img, int ks, int c, int lane) {
    const int g = lane >> 4, q = (lane & 15) >> 2, p = lane & 3;
    const s4_t lo = ds_tr((const bf16*)(img + mgb_off(32 * ks + 8 * g + q, 2 * c + (p >> 1)) + 8 * (p & 1)));
    const s4_t hi = ds_tr((const bf16*)(img + mgb_off(32 * ks + 8 * g + 4 + q, 2 * c + (p >> 1)) + 8 * (p & 1)));
    return (bf16x8_t){lo.x, lo.y, lo.z, lo.w, hi.x, hi.y, hi.z, hi.w};
}
__device__ __forceinline__ void moe_tables(const Args& a, unsigned char* lds_g, int tid) {
    int* cum = (int*)(lds_g + MG_CUM); const unsigned* ctl = (const unsigned*)(a.ws + WS_CTL);
    if (tid < NEXP) cum[128 + tid] = (int)ctl[CW_CNT + tid];
    if (tid == 0) { int c = 0; for (int e = 0; e < NEXP; ++e) { cum[e] = c; c += (int)((ctl[CW_CNT + e] + 255u) >> 8); } cum[NEXP] = c; }
    __syncthreads();
}
constexpr int MH_A = 0, MH_ABYTES = 32768, MH_B = 65536, MH_BROW = 528, MH_BBYTES = 64 * MH_BROW  ;
__device__ __forceinline__ int mhb_off(int row, int ch) { return MH_BROW * row + 16 * ch; }
__device__ __forceinline__ bf16x8_t mhb_frag(const LAS unsigned char* lbase, int cofs) {
    const s4_t lo = __builtin_amdgcn_ds_read_tr16_b64_v4i16((LAS s4_t*)(lbase + cofs));
    const s4_t hi = __builtin_amdgcn_ds_read_tr16_b64_v4i16((LAS s4_t*)(lbase + cofs + MH_BROW));
    return (bf16x8_t){lo.x, lo.y, lo.z, lo.w, hi.x, hi.y, hi.z, hi.w};
}
__device__ __forceinline__ int fresh_lane() { int l; asm volatile("v_mbcnt_lo_u32_b32 %0, -1, 0\n\tv_mbcnt_hi_u32_b32 %0, -1, %0" : "=v"(l)); __builtin_assume(l >= 0 && l < 64); return l; }
__device__ __forceinline__ int moe_pull(const Args& a, unsigned char* lds_g, int w, int x) {
    int* slot = (int*)(lds_g + MG_CUM + 256);
    __syncthreads();
    if (w == 0 && fresh_lane() == 0) *slot = (int)__hip_atomic_fetch_add((unsigned*)(a.ws + WS_CTL) + CW_Q + 64 * x, 1u, __ATOMIC_RELAXED, __HIP_MEMORY_SCOPE_AGENT);
    __syncthreads();
    return __builtin_amdgcn_readfirstlane(*slot);
}
__device__ __forceinline__ unsigned f8pair_lo(unsigned w) { const auto v = __builtin_amdgcn_cvt_pk_f32_fp8((int)w, false); return pk2(v[0], v[1]); }
__device__ __forceinline__ unsigned f8pair_hi(unsigned w) { const auto v = __builtin_amdgcn_cvt_pk_f32_fp8((int)w, true); return pk2(v[0], v[1]); }
template <int MODE>
__device__ __forceinline__ int moe_gemm(const Args& a, unsigned char* lds_g, int tid, int idx0) {
    constexpr int K = MODE == 1 ? D : DE, NT = K / 64;
#define MG_BAR() do { asm volatile("s_waitcnt lgkmcnt(0)" ::: "memory"); __builtin_amdgcn_s_barrier(); asm volatile("" ::: "memory"); } while (0)
    const int w = __builtin_amdgcn_readfirstlane(tid >> 6);
    const int wm = w >> 1, wn = w & 1, hh = wm >> 1, wr = wm & 1;
    const int* cum = (const int*)(lds_g + MG_CUM); const unsigned* ctl = (const unsigned*)(a.ws + WS_CTL);
    const int T = cum[NEXP], x = blockIdx.x & 7;
    for (int idx = idx0;;) {
        if (idx < 0) idx = moe_pull(a, lds_g, w, x);
        if (idx >= (MODE == 1 ? T : 2 * T)) return idx;
        const int ti = MODE == 1 ? idx : idx - T;
        idx = -1;
        const int nt = x;
        if (MODE == 2) {
            if (w == 0) { unsigned* tc = (unsigned*)(a.ws + WS_CTL) + CW_TC + 64 * ti; unsigned spins = 0;
                while ((unsigned)__builtin_amdgcn_readfirstlane(__hip_atomic_load(tc, __ATOMIC_RELAXED, __HIP_MEMORY_SCOPE_AGENT)) < 64u) {
                    __builtin_amdgcn_s_sleep(2);
                    if (++spins > (1u << 22)) { if (fresh_lane() == 0) __hip_atomic_store((unsigned*)(a.ws + WS_CTL) + 1, 0x900u + (unsigned)ti, __ATOMIC_RELAXED, __HIP_MEMORY_SCOPE_AGENT); break; } }
                __builtin_amdgcn_fence(__ATOMIC_ACQUIRE, "agent");
                asm volatile("s_waitcnt vmcnt(0)" ::: "memory"); }
            __syncthreads();
        }
        const int lane = fresh_lane(), tidu = w * 64 + lane, fr = lane & 15, fq = lane >> 4;
        const int aoff = pg8::lds_byte(wr * 64 + fr, fq * 8);
        const int bk = w, bp = lane;
        int e = 0;
#pragma unroll 1
        for (int q = 1; q < NEXP; ++q) e = (cum[q] <= ti) ? q : e;
        e = __builtin_amdgcn_readfirstlane(e);
        const int mt = __builtin_amdgcn_readfirstlane(ti - cum[e]);
        unsigned aofs[4]; unsigned bofs; int bwr0;
        __amdgpu_buffer_rsrc_t rsA, rsB, rsB3;
        if (MODE == 1) { const int cnt = cum[128 + e];
#pragma unroll
            for (int q = 0; q < 2; ++q) { const int pos = 256 * mt + 128 * q + (tidu >> 2); const int tok = pos < cnt ? ((const int*)(a.ws + WS_LIST))[e * 8192 + pos] : 0;
                aofs[q] = (unsigned)(tok * D + 16 * (tidu & 3)); }
            aofs[2] = aofs[3] = 0u;
            rsA = __builtin_amdgcn_make_buffer_rsrc((void*)(a.ws + WS_H2), 0, 0x7fffffff, 0x00020000);
            rsB = __builtin_amdgcn_make_buffer_rsrc((void*)(a.in[I_W1] + (size_t)e * D * DE), 0, 0x7fffffff, 0x00020000); rsB3 = __builtin_amdgcn_make_buffer_rsrc((void*)(a.in[I_W3] + (size_t)e * D * DE), 0, 0x7fffffff, 0x00020000);
            bofs = (unsigned)((bk + 8 * (bp >> 5)) * DE + 128 * nt + 4 * (bp & 31)) * 4u;
            bwr0 = MH_BROW * (2 * (bk & 3) + (bk >> 2) + 8 * (bp >> 5)) + 2 * (128 * ((bp & 31) >> 4) + 4 * (bp & 15)); }
        else {
#pragma unroll
            for (int q = 0; q < 2; ++q) aofs[q] = (unsigned)((128 * q + (tidu >> 2)) * DE + 16 * (tidu & 3));
            aofs[2] = aofs[3] = 0u;
            rsA = __builtin_amdgcn_make_buffer_rsrc((void*)((const unsigned char*)(a.ws + WS_HM) + (size_t)256 * ti * DE), 0, 0x7fffffff, 0x00020000);
            rsB = __builtin_amdgcn_make_buffer_rsrc((void*)(a.in[I_W2] + (size_t)e * DE * D), 0, 0x7fffffff, 0x00020000); rsB3 = rsB;
            bofs = (unsigned)(bk * D + 256 * nt + 4 * bp) * 4u; bwr0 = mhb_off(2 * (bk & 3) + (bk >> 2), bp >> 1) + 8 * (bp & 1); }
        const LAS unsigned char* blane = (const LAS unsigned char*)lds_g + MH_B + mhb_off(16 * (lane >> 5) + 8 * ((lane >> 4) & 1) + 2 * ((lane & 15) >> 2), 16 * wn + ((lane & 3) >> 1)) + 8 * (lane & 1);
        f32x4 acc[4][8];
#pragma unroll
        for (int m = 0; m < 4; ++m)
#pragma unroll
            for (int n = 0; n < 8; ++n) acc[m][n] = (f32x4){0.f, 0.f, 0.f, 0.f};
        v4u ra[4]; f32x4 rb[8];
#define MH_MMA(buf_) do { const LAS unsigned char* Bi_ = blane + (buf_) * MH_BBYTES; \
        bf16x8_t bc0_ = mhb_frag(Bi_, 0), bc1_ = mhb_frag(Bi_, 32); \
        _Pragma("unroll") for (int ks_ = 0; ks_ < 2; ++ks_) { bf16x8_t af_[4]; \
            _Pragma("unroll") for (int m_ = 0; m_ < 4; ++m_) af_[m_] = *(const bf16x8_t*)(lds_g + MH_A + (buf_) * MH_ABYTES + hh * 16384 + aoff + m_ * 2048 + ks_ * 1024); \
            _Pragma("unroll") for (int n_ = 0; n_ < 8; n_ += 2) { bf16x8_t bn0_ = bc0_, bn1_ = bc1_; \
                if (n_ + 2 < 8) { bn0_ = mhb_frag(Bi_, 32 * ks_ * MH_BROW + 32 * (n_ + 2)); bn1_ = mhb_frag(Bi_, 32 * ks_ * MH_BROW + 32 * (n_ + 3)); } \
                else if (ks_ == 0) { bn0_ = mhb_frag(Bi_, 32 * MH_BROW); bn1_ = mhb_frag(Bi_, 32 * MH_BROW + 32); } \
                __builtin_amdgcn_sched_barrier(0); \
                _Pragma("unroll") for (int m_ = 0; m_ < 4; ++m_) { acc[m_][n_] = __builtin_amdgcn_mfma_f32_16x16x32_bf16(bc0_, af_[m_], acc[m_][n_], 0, 0, 0); \
                    acc[m_][n_ + 1] = __builtin_amdgcn_mfma_f32_16x16x32_bf16(bc1_, af_[m_], acc[m_][n_ + 1], 0, 0, 0); } \
                __builtin_amdgcn_sched_barrier(0); bc0_ = bn0_; bc1_ = bn1_; } } } while (0)
        {
            const int awr = pg8::lds_byte(tidu >> 2, 16 * (tidu & 3));
#define MH_LDB(t_) do { _Pragma("unroll") for (int j_ = 0; j_ < 8; ++j_) rb[j_] = __builtin_bit_cast(f32x4, MODE == 1 ? __builtin_amdgcn_raw_buffer_load_b128((j_ & 1) ? rsB3 : rsB, bofs, (64 * (t_) + 16 * (j_ >> 1)) * DE * 4, 0) \
                                                                                                   : __builtin_amdgcn_raw_buffer_load_b128(rsB, bofs, (64 * (t_) + 8 * j_) * D * 4, 0)); } while (0)
#define MH_LDA(te_, to_) do { ra[0] = __builtin_amdgcn_raw_buffer_load_b128(rsA, aofs[0], 64 * (te_), 0); ra[1] = __builtin_amdgcn_raw_buffer_load_b128(rsA, aofs[1], 64 * (te_), 0); \
            ra[2] = __builtin_amdgcn_raw_buffer_load_b128(rsA, aofs[0], 64 * (to_), 0); ra[3] = __builtin_amdgcn_raw_buffer_load_b128(rsA, aofs[1], 64 * (to_), 0); } while (0)
#define MH_F8(w_) f8pair_lo(w_), f8pair_hi(w_)
#define MH_STA(buf_, x_) do { _Pragma("unroll") for (int h_ = 0; h_ < 2; ++h_) { const v4u p_ = ra[(x_) + h_]; \
            *(v4u*)(lds_g + MH_A + (buf_) * MH_ABYTES + h_ * 16384 + awr) = (v4u){MH_F8(p_.x), MH_F8(p_.y)}; __builtin_amdgcn_sched_barrier(0); \
            *(v4u*)(lds_g + MH_A + (buf_) * MH_ABYTES + h_ * 16384 + awr + 16) = (v4u){MH_F8(p_.z), MH_F8(p_.w)}; __builtin_amdgcn_sched_barrier(0); } } while (0)
#define MH_STB(buf_) do { _Pragma("unroll") for (int j_ = 0; j_ < 8; ++j_) { pg8::u32x2 o_; o_.x = pk2(rb[j_].x, rb[j_].y); o_.y = pk2(rb[j_].z, rb[j_].w); \
            *(pg8::u32x2*)(lds_g + MH_B + (buf_) * MH_BBYTES + bwr0 + (MODE == 1 ? (j_ >> 1) * 16 * MH_BROW + (j_ & 1) * 128 : j_ * 8 * MH_BROW)) = o_; } } while (0)
            MH_LDA(0, 1); MH_LDB(0);
            MG_BAR();
            MH_STA(0, 0); MH_STB(0);
            MH_LDB(1);
            for (int t = 0; t < NT; t += 2) {
                const int t2 = (t + 2 < NT) ? t + 2 : NT - 1, t3 = (t + 3 < NT) ? t + 3 : NT - 1;
                MG_BAR();
                MH_STA(1, 2); MH_STB(1);
                MH_LDA(t2, t3); MH_LDB(t2);
                MH_MMA(0);
                MG_BAR();
                MH_STA(0, 0); MH_STB(0);
                MH_LDB(t3);
                MH_MMA(1);
            }
#undef MH_LDB
#undef MH_LDA
#undef MH_F8
#undef MH_STA
#undef MH_STB
        }
#undef MH_MMA
        const int ln_ = fresh_lane();
        const int efr = ln_ & 15, efq = ln_ >> 4;
        if (MODE == 1) { unsigned char* HM = (unsigned char*)(a.ws + WS_HM) + (size_t)256 * ti * DE + 128 * nt + 64 * wn; const unsigned lo_ = (unsigned)((128 * hh + 64 * wr + efr) * DE + 4 * efq);
#pragma unroll
            for (int m = 0; m < 4; ++m)
#pragma unroll
                for (int n = 0; n < 4; ++n) { float hv[4];
#pragma unroll
                    for (int r = 0; r < 4; ++r) { const float a1 = acc[m][n][r]; hv[r] = a1 * sigmoidf_(a1) * acc[m][n + 4][r]; }
                    int w8 = __builtin_amdgcn_cvt_pk_fp8_f32(hv[0], hv[1], 0, false); w8 = __builtin_amdgcn_cvt_pk_fp8_f32(hv[2], hv[3], w8, true);
                    __hip_atomic_store((unsigned*)(HM + lo_ + 16 * m * DE + 16 * n), (unsigned)w8, __ATOMIC_RELAXED, __HIP_MEMORY_SCOPE_AGENT); }
            asm volatile("s_waitcnt vmcnt(0)" ::: "memory");
            if (ln_ == 0) __hip_atomic_fetch_add((unsigned*)(a.ws + WS_CTL) + CW_TC + 64 * ti, 1u, __ATOMIC_RELAXED, __HIP_MEMORY_SCOPE_AGENT); }
        else { bf16* Y2 = (bf16*)(a.ws + WS_Y2) + (size_t)256 * ti * D + 256 * nt + 128 * wn; const unsigned lo_ = (unsigned)((128 * hh + 64 * wr + efr) * D + 4 * efq);
#pragma unroll
            for (int m = 0; m < 4; ++m)
#pragma unroll
                for (int n = 0; n < 8; ++n) { pg8::u32x2 o; o.x = pk2(acc[m][n][0], acc[m][n][1]); o.y = pk2(acc[m][n][2], acc[m][n][3]);
                    *(pg8::u32x2*)(Y2 + lo_ + 16 * m * D + 16 * n) = o; } }
    }
#undef MG_BAR
}

__device__ __forceinline__ void phase12(const Args& a, unsigned char* lds_g, int lane, int wave) {
    const int gw = blockIdx.x * NWAVES + wave, NGW = gridDim.x * NWAVES;
    const int* cum = (const int*)(lds_g + MG_CUM);
    const bf16* X1 = (const bf16*)(a.ws + WS_X1); const float* MOD = (const float*)(a.ws + WS_MOD); const float* fg = a.in[I_FG];
    const int4* ASG = (const int4*)(a.ws + WS_ASG); const bf16* Y2 = (const bf16*)(a.ws + WS_Y2);
    for (int t = gw; t < NLAT; t += NGW) {
        const int b = t >> 11; const int4 q0 = ASG[2 * t], q1 = ASG[2 * t + 1];
        const float w0 = __int_as_float(q0.z), w1 = __int_as_float(q1.z);
        const unsigned long long* xr = (const unsigned long long*)(X1 + (size_t)t * D) + lane;
        const unsigned long long* y0 = (const unsigned long long*)(Y2 + (size_t)(256 * cum[q0.x] + q0.y) * D) + lane; const unsigned long long* y1 = (const unsigned long long*)(Y2 + (size_t)(256 * cum[q1.x] + q1.y) * D) + lane;
        f32x4 v[8]; float s = 0.f;
#pragma unroll
        for (int j = 0; j < 8; ++j) {
            const int c = 4 * lane + 256 * j;
            const f32x4 g2 = *(const f32x4*)(MOD + b * 12288 + 5 * 2048 + c);
            const unsigned long long a0 = y0[64 * j], a1 = y1[64 * j];
            f32x4 y; y.x = w0 * bflo((unsigned)a0) + w1 * bflo((unsigned)a1); y.y = w0 * bfhi((unsigned)a0) + w1 * bfhi((unsigned)a1);
            y.z = w0 * bflo((unsigned)(a0 >> 32)) + w1 * bflo((unsigned)(a1 >> 32)); y.w = w0 * bfhi((unsigned)(a0 >> 32)) + w1 * bfhi((unsigned)(a1 >> 32));
            const unsigned long long xw = xr[64 * j];
            v[j] = (f32x4){bflo((unsigned)xw), bfhi((unsigned)xw), bflo((unsigned)(xw >> 32)), bfhi((unsigned)(xw >> 32))} + g2 * y;
            s += (v[j].x * v[j].x + v[j].y * v[j].y) + (v[j].z * v[j].z + v[j].w * v[j].w);
        }
        const float rstd = 1.f / sqrtf(wave_sum(s) * (1.f / D) + EPS);
        f32x4* o = (f32x4*)(a.out + (size_t)t * D) + lane; f32x4 fgv[8];
#pragma unroll
        for (int j = 0; j < 8; ++j) fgv[j] = *(const f32x4*)(fg + 4 * lane + 256 * j);
#pragma unroll
        for (int j = 0; j < 8; ++j) o[64 * j] = v[j] * rstd * fgv[j];
    }
}

__global__ void __launch_bounds__(NTHR, 2) fwd_kernel(Args args) {
    extern __shared__ __attribute__((aligned(16))) unsigned char lds[];
    LAS unsigned char* ldsl = (LAS unsigned char*)lds;
    volatile LAS unsigned* MISC = (volatile LAS unsigned*)(ldsl + MISC_OFF);
    LAS unsigned* TL = (LAS unsigned*)(ldsl + LDSCTL_OFF);
    const int wave_s = __builtin_amdgcn_readfirstlane(threadIdx.x >> 6);
#define TID() make_tid(wave_s)
    { const int t0 = TID(); for (int u = t0; u < (LDS_BYTES - LDSCTL_OFF) / 4; u += NTHR) ((LAS unsigned*)(ldsl + LDSCTL_OFF))[u] = 0u; }
    __syncthreads();
    unsigned char* ws = args.ws;
    unsigned* ctl = (unsigned*)(ws + WS_CTL);
    XcdBarrier bar; bar.bar = ctl + CW_BAR; bar.x = 0; bar.st = nullptr;
    const bool one_launch = (args.ph_hi - args.ph_lo) > 1;
    if (one_launch) bar = xcd_barrier_post(ctl + CW_BAR, MISC + 8, TID());
    const int lo = args.ph_lo, hi = args.ph_hi;
#define IN(k) (lo <= (k) && (k) < hi)
#define SEAM(k) do { if (IN(k) && IN((k) + 1)) xcd_barrier(bar, TID()); } while (0)
    const int G = gridDim.x, c = blockIdx.x;

#define FRESH() const int tid = TID(), lane = tid & 63, wave = __builtin_amdgcn_readfirstlane(tid >> 6); (void)lane; (void)wave
#ifndef DUP_PHASE
#define DUP_PHASE (-1)
#endif
#define PH(k, ...) if (IN(k)) { _Pragma("unroll") for (int rep_ = 0; rep_ < ((DUP_PHASE) == (k) ? 2 : 1); ++rep_) { if (rep_) xcd_barrier(bar, TID()); __VA_ARGS__ } } SEAM(k);
    PH(0, { FRESH(); phase0(args, lds, tid, lane, wave); mod_wait(args, tid); phase1(args, lane, wave); })
    PH(1, {
        SchedIn S{G, c, (const char*)(ws + WS_H), (const char*)(ws + WS_WIN)}; EpiIn E{ws, args.in[I_BGATES]};
        pg8::gemm_phase<EpiIn, SchedIn>(ldsl, D, S, E, TID());
        { const int R_ = (1492 + G - 1) / G; int fi_ = 1492 - (R_ - 1) * G; if (fi_ >= G) fi_ = 0;
          if (c >= fi_) { FRESH(); late_prep(args, lds, (c - fi_) * NWAVES + wave, (G - fi_) * NWAVES, lane, wave); } } })
    PH(2, { FRESH(); phase3(args, lds, tid); })
    PH(3, { FRESH();
        for (int u = c; u < 256; u += G) ml_out_unit(args, lds, u, tid);
        for (int u = c; u < 4 * 32 * 8; u += G) { const int blk = u & 7, q = u >> 3; lru_out_unit(args, lds, q >> 5, 4 + (q & 31), blk, tid); } })
    PH(4, {
        SchedProj S{G, c, (const char*)(ws + WS_YA), (const char*)(ws + WS_YB), (const char*)(ws + WS_WPA), (const char*)(ws + WS_WPB)};
        EpiProj E{(const bf16*)(ws + WS_GA), (const bf16*)(ws + WS_GB), (bf16*)(ws + WS_PRE)};
        pg8::gemm_phase<EpiProj, SchedProj>(ldsl, 1024, S, E, TID()); })
    PH(5, {
        SchedOut S{G, c, (const char*)(ws + WS_PRE), (const char*)(ws + WS_WOUT)}; EpiOut E{args.in[I_X], (const float*)(ws + WS_MOD), (bf16*)(ws + WS_X1)};
        pg8::gemm_phase<EpiOut, SchedOut>(ldsl, D, S, E, TID()); })
    PH(6, { FRESH(); phase_router(args, lds, tid, lane, wave); })
    PH(7, { FRESH(); moe_tables(args, lds, tid); const int nx_ = moe_gemm<1>(args, lds, tid, -1); { const int tid2_ = TID(); (void)moe_gemm<2>(args, lds, tid2_, nx_); } })
    PH(8, { FRESH(); moe_tables(args, lds, tid); phase12(args, lds, lane, wave); })
#undef PH
#undef IN
#undef SEAM
}

extern "C" void kernel_launch(void* const* d_in, const int* in_sizes, int n_in, void* d_out, int out_size, void* d_ws, size_t ws_size, hipStream_t stream) {
    static int grid = 0;
    if (grid == 0) {
        if (n_in != 27 || out_size != NLAT * D || ws_size < WS_END) { fprintf(stderr, "kernel_launch: unexpected shapes (n_in %d, out %d, ws %zu)\n", n_in, out_size, ws_size); grid = -1; return; }
        int dev = 0, cus = 0, per_cu = 0;
        if (hipGetDevice(&dev) != hipSuccess || hipDeviceGetAttribute(&cus, hipDeviceAttributeMultiprocessorCount, dev) != hipSuccess) { grid = -1; return; }
        if (hipFuncSetAttribute((const void*)fwd_kernel, hipFuncAttributeMaxDynamicSharedMemorySize, LDS_BYTES) != hipSuccess) { fprintf(stderr, "kernel_launch: hipFuncSetAttribute failed\n"); grid = -1; return; }
        if (hipOccupancyMaxActiveBlocksPerMultiprocessor(&per_cu, (const void*)fwd_kernel, NTHR, LDS_BYTES) != hipSuccess || per_cu < 1) fprintf(stderr, "kernel_launch: occupancy query says %d\n", per_cu);
        (void)hipGetLastError();
        grid = cus;
    }
    if (grid < 0) return;
    (void)hipMemsetAsync((char*)d_ws + WS_CTL, 0, CTL_ZERO_BYTES, stream);
    Args a{};
    for (int i = 0; i < 27; ++i) a.in[i] = (const float*)d_in[i];
    a.out = (float*)d_out; a.ws = (unsigned char*)d_ws;
#if MK_ONE_LAUNCH
    a.ph_lo = 0; a.ph_hi = NPHASE;
    hipLaunchKernelGGL(fwd_kernel, dim3(grid), dim3(NTHR), LDS_BYTES, stream, a);
#else
    for (int p = 0; p < NPHASE; ++p) { a.ph_lo = p; a.ph_hi = p + 1; hipLaunchKernelGGL(fwd_kernel, dim3(grid), dim3(NTHR), LDS_BYTES, stream, a); }
#endif
}
```

```cpp
#include <hip/hip_runtime.h>
#include <cstdio>
#include <cstdint>

#ifndef MK_ONE_LAUNCH
#define MK_ONE_LAUNCH 1
#endif

namespace pg8 {
#define PG8_LAS __attribute__((address_space(3)))
typedef unsigned short bf16_t;
typedef short bf16x8 __attribute__((ext_vector_type(8)));
typedef float f32x4 __attribute__((ext_vector_type(4)));
typedef float f32x2 __attribute__((ext_vector_type(2)));
typedef unsigned u32x4 __attribute__((ext_vector_type(4)));
typedef unsigned u32x2 __attribute__((ext_vector_type(2)));
constexpr int BM = 256, BK = 64, HALF = 128, HTB = HALF * BK * 2  , STAGE_BYTES = 8 * HTB, NXCD = 8, WGM = 8;

__host__ __device__ __forceinline__ int lds_byte(int r, int c) { const int st = (r >> 4) * 2 + (c >> 5), rr = r & 15, cc = c & 31, ob = rr * 64 + cc * 2; return st * 1024 + (ob ^ (((ob >> 9) & 1) << 5)); }
__host__ __device__ __forceinline__ void stage_rc(int b, int& R, int& C) { const int st = b / 1024, sb = b % 1024, swz = sb ^ (((sb >> 9) & 1) << 5); R = (st >> 1) * 16 + swz / 64; C = (st & 1) * 32 + (swz % 64) / 2; }
__host__ __device__ __forceinline__ int perm32(int rho) { const int n = rho >> 4, i = rho & 15; return 8 * (i >> 2) + 4 * n + (i & 3); }

struct Unit { const char* A; const char* B; int pm, pn, aux; };

__host__ __device__ __forceinline__ void tile_order(int L, int nM, int nN, int& pm, int& pn) {
    const int nwg = nM * nN; int wgid = L;
    { const int q = nwg / NXCD, r = nwg % NXCD, xcd = wgid % NXCD, off = wgid / NXCD; wgid = (xcd < r ? xcd * (q + 1) : r * (q + 1) + (xcd - r) * q) + off; }
    const int nig = WGM * nN, gid = wgid / nig, fm = gid * WGM, gsz = (nM - fm) < WGM ? (nM - fm) : WGM;
    pm = fm + ((wgid % nig) % gsz); pn = (wgid % nig) / gsz;
}

typedef __bf16 bf16n2 __attribute__((ext_vector_type(2)));
__device__ __forceinline__ unsigned cvt_pk_bf16(float lo, float hi) { const f32x2 v = {lo, hi}; return __builtin_bit_cast(unsigned, __builtin_convertvector(v, bf16n2)); }

template <class Epi, class Sched>
__device__ __forceinline__ void gemm_phase(PG8_LAS unsigned char* lds, const int K, const Sched& S, const Epi& E, int tid) {
    const int wid = __builtin_amdgcn_readfirstlane(tid >> 6), lane = tid & 63, wr = wid >> 2, wc = wid & 3, fr = lane & 15, fq = lane >> 4;
    const int nt = K / BK;
    unsigned voffA[2], voffB[2];
#pragma unroll
    for (int i = 0; i < 2; ++i) { int R, C; stage_rc(tid * 16 + i * 8192, R, C); const int Rb = Epi::PERM ? ((R & ~31) + perm32(R & 31)) : R;
        voffA[i] = (unsigned)(R * K + C) * 2u; voffB[i] = (unsigned)(Rb * K + C) * 2u; }
    const size_t kstep = (size_t)(BK * 2);
    const size_t hstep = (size_t)HALF * K * 2;
    const unsigned ldsw = (unsigned)wid * 1024u;
    const int aoff = lds_byte(wr * 64 + fr, fq * 8), boff = lds_byte(wc * 32 + fr, fq * 8);
#define PG8_SA(b, h) (((b) * 2 + (h)) * HTB)
#define PG8_SB(b, h) ((4 + (b) * 2 + (h)) * HTB)
#define PG8_STAGE(bufoff, gbase, voff) do { _Pragma("unroll") for (int _i = 0; _i < 2; ++_i) \
        __builtin_amdgcn_global_load_lds((const unsigned*)((const char*)(gbase) + (voff)[_i]), (PG8_LAS unsigned*)(lds + (bufoff) + ldsw + _i * 8192), 16, 0, 0); } while (0)
#define PG8_LDA(dst, b, h) do { _Pragma("unroll") for (int m = 0; m < 4; ++m) _Pragma("unroll") for (int k = 0; k < 2; ++k) dst[m][k] = *(const PG8_LAS bf16x8*)(lds + PG8_SA(b, h) + aoff + m * 2048 + k * 1024); } while (0)
#define PG8_LDB(dst, b, h) do { _Pragma("unroll") for (int n = 0; n < 2; ++n) _Pragma("unroll") for (int k = 0; k < 2; ++k) dst[n][k] = *(const PG8_LAS bf16x8*)(lds + PG8_SB(b, h) + boff + n * 2048 + k * 1024); } while (0)
#define PG8_MMA(ai, bj, At, Bt) do { __builtin_amdgcn_s_setprio(1); _Pragma("unroll") for (int m = 0; m < 4; ++m) _Pragma("unroll") for (int n = 0; n < 2; ++n) _Pragma("unroll") for (int k = 0; k < 2; ++k) \
        acc[ai][bj][m][n] = __builtin_amdgcn_mfma_f32_16x16x32_bf16(Bt[n][k], At[m][k], acc[ai][bj][m][n], 0, 0, 0); __builtin_amdgcn_s_setprio(0); } while (0)
#define PG8_WAIT_V(n) asm volatile("s_waitcnt vmcnt(" #n ")" ::: "memory")
#define PG8_WAIT_L(n) asm volatile("s_waitcnt lgkmcnt(" #n ")" ::: "memory")
#define PG8_BAR __builtin_amdgcn_s_barrier()
#define PG8_SCHED __builtin_amdgcn_sched_barrier(0)
    Unit cur, nxt; int ui = 0;
    if (!S.next(0, cur)) return;
    f32x4 acc[2][2][4][2];
#pragma unroll
    for (int a = 0; a < 2; ++a)
#pragma unroll
        for (int b = 0; b < 2; ++b)
#pragma unroll
            for (int m = 0; m < 4; ++m)
#pragma unroll
                for (int n = 0; n < 2; ++n) acc[a][b][m][n] = (f32x4){0.f, 0.f, 0.f, 0.f};
    bf16x8 At[4][2], B0[2][2], B1[2][2];
    const char* cA = cur.A; const char* cB = cur.B;
    PG8_STAGE(PG8_SB(0, 0), cB, voffB); PG8_STAGE(PG8_SB(0, 1), cB + hstep, voffB); PG8_STAGE(PG8_SA(0, 0), cA, voffA); PG8_STAGE(PG8_SA(0, 1), cA + hstep, voffA);
    if (wr == 1) PG8_BAR;
    PG8_WAIT_V(2); PG8_BAR;
    PG8_STAGE(PG8_SB(1, 0), cB + kstep, voffB); PG8_STAGE(PG8_SA(1, 0), cA + kstep, voffA); PG8_STAGE(PG8_SB(1, 1), cB + hstep + kstep, voffB);
    PG8_WAIT_V(6); PG8_BAR;
    for (;;) {
        const bool has_next = S.next(ui + 1, nxt);
        const char* nA = has_next ? nxt.A : cA; const char* nB = has_next ? nxt.B : cB;
        for (int t = 0; t < nt; t += 2) {
            const bool last = (t == nt - 2);
            const char* a1 = cA + (size_t)(t + 1) * kstep;
            const char* a2 = last ? nA : cA + (size_t)(t + 2) * kstep; const char* b2 = last ? nB : cB + (size_t)(t + 2) * kstep;
            const char* a3 = a2 + kstep; const char* b3 = b2 + kstep;
            PG8_LDB(B0, 0, 0); PG8_LDB(B1, 0, 1); PG8_SCHED; PG8_LDA(At, 0, 0); PG8_STAGE(PG8_SA(1, 1), a1 + hstep, voffA);
            PG8_WAIT_V(8); PG8_WAIT_L(0); PG8_BAR; PG8_MMA(0, 0, At, B0); PG8_MMA(0, 1, At, B1); PG8_BAR; PG8_SCHED;
            PG8_LDA(At, 0, 1); PG8_STAGE(PG8_SB(0, 0), b2, voffB); PG8_STAGE(PG8_SB(0, 1), b2 + hstep, voffB); PG8_STAGE(PG8_SA(0, 0), a2, voffA);
            PG8_WAIT_V(8); PG8_WAIT_L(0); PG8_BAR; PG8_MMA(1, 0, At, B0); PG8_MMA(1, 1, At, B1); PG8_BAR; PG8_SCHED;
            PG8_LDB(B0, 1, 0); PG8_LDB(B1, 1, 1); PG8_SCHED; PG8_LDA(At, 1, 0); PG8_STAGE(PG8_SA(0, 1), a2 + hstep, voffA);
            PG8_WAIT_V(8); PG8_WAIT_L(0); PG8_BAR; PG8_MMA(0, 0, At, B0); PG8_MMA(0, 1, At, B1); PG8_BAR; PG8_SCHED;
            PG8_LDA(At, 1, 1); PG8_STAGE(PG8_SB(1, 0), b3, voffB); PG8_STAGE(PG8_SB(1, 1), b3 + hstep, voffB); PG8_STAGE(PG8_SA(1, 0), a3, voffA);
            PG8_WAIT_V(8); PG8_WAIT_L(0); PG8_BAR; PG8_MMA(1, 0, At, B0); PG8_MMA(1, 1, At, B1); PG8_BAR; PG8_SCHED;
        }
        if (wr == 0) PG8_BAR;
        { int fr_ = fr, fq_ = fq; asm volatile("" : "+v"(fr_), "+v"(fq_)); E(acc, cur, wr, wc, fr_, fq_); }
        if (!has_next) break;
        if (!(Epi::CARRY && E.keep(cur))) {
#pragma unroll
        for (int a = 0; a < 2; ++a)
#pragma unroll
            for (int b = 0; b < 2; ++b)
#pragma unroll
                for (int m = 0; m < 4; ++m)
#pragma unroll
                    for (int n = 0; n < 2; ++n) acc[a][b][m][n] = (f32x4){0.f, 0.f, 0.f, 0.f};
        }
        cur = nxt; cA = nA; cB = nB; ++ui;
        if (wr == 1) PG8_BAR;
    }
    PG8_WAIT_V(0);
    PG8_BAR;
#undef PG8_SA
#undef PG8_SB
#undef PG8_STAGE
#undef PG8_LDA
#undef PG8_LDB
#undef PG8_MMA
#undef PG8_WAIT_V
#undef PG8_WAIT_L
#undef PG8_BAR
#undef PG8_SCHED
}
}

constexpr int NWAVES = 8, NTHR = 512;
constexpr int D = 2048, NB = 4, SEQ = 2048, CTXL = 256, NCTX = NB * CTXL  , NLAT = NB * SEQ  , NTOK = NCTX + NLAT  ;
constexpr int NSTEP = CTXL + SEQ;
constexpr int HEADS = 8, HD = 128, MW = 1024, LW = 1024;
constexpr int NEXP = 32, DE = 1024;
constexpr int IN_DIM = 11296, NT_IN = 45;
constexpr float EPS = 1e-6f;
constexpr int MAXTILES = 96;
constexpr int NPHASE = 9;

constexpr size_t MiB = 1u << 20;
constexpr size_t WS_CTL = 0, CTL_ZERO_BYTES = 1 * MiB;
constexpr size_t WS_MOD = 1 * MiB;
constexpr size_t WS_GATES = 2 * MiB;
constexpr size_t WS_ASG = 4 * MiB + 512 * 1024;
constexpr size_t WS_LIST = 3 * MiB + 512 * 1024;
constexpr size_t WS_WR = 6 * MiB;
constexpr size_t WS_RB = 7 * MiB + 768 * 1024;
constexpr size_t WS_WL = 5 * MiB;
constexpr size_t WS_AGG = 978 * MiB;
constexpr size_t WS_WPA = 8 * MiB, WS_WPB = 12 * MiB, WS_WOUT = 16 * MiB, WS_WIN = 24 * MiB;
constexpr size_t WS_W13 = 72 * MiB, WS_W2 = 328 * MiB;
constexpr size_t WS_PS = 72 * MiB;
constexpr size_t WS_H = 456 * MiB;
constexpr size_t WS_K = 492 * MiB, WS_V = 510 * MiB, WS_UX = 528 * MiB;
constexpr size_t WS_Q = 546 * MiB, WS_OF = 562 * MiB, WS_OB = 578 * MiB, WS_UG = 594 * MiB;
constexpr size_t WS_GA = 610 * MiB, WS_GB = 642 * MiB;
constexpr size_t WS_LA = 674 * MiB, WS_LB = 746 * MiB;
constexpr size_t WS_HS = 818 * MiB, WS_TM = 882 * MiB;
constexpr size_t WS_YA = 946 * MiB, WS_YB = 962 * MiB;
constexpr size_t WS_BT = 982 * MiB;
constexpr size_t WS_SLOC = 984 * MiB;
constexpr size_t WS_END = 1022 * MiB;
constexpr size_t WS_PRE = WS_LA;
constexpr size_t WS_X1 = WS_LB;
constexpr size_t WS_H2 = WS_H;
constexpr size_t WS_XS = WS_K;
constexpr size_t WS_HM = 588 * MiB;
constexpr size_t WS_Y2 = WS_HS;
constexpr int CW_MODC = 32;
constexpr int CW_CNT = 64;
constexpr int CW_NT = 128;
constexpr int CW_TILE_E = 192;
constexpr int CW_BAR = 4096;
constexpr int CW_Q = 8192;
constexpr int CW_TC = 16384;

constexpr int RING_BYTES = 131072;
constexpr int LDSCTL_OFF = 143360;
constexpr int MISC_OFF = LDSCTL_OFF + 384;
constexpr int LDS_BYTES = 147456;

#define GAS __attribute__((address_space(1)))
#define LAS __attribute__((address_space(3)))
typedef unsigned short bf16;
typedef unsigned v4u __attribute__((ext_vector_type(4)));
typedef float f32x4 __attribute__((ext_vector_type(4)));
#define LDS_WAIT() asm volatile("s_waitcnt lgkmcnt(0)" ::: "memory")
#define WG_BAR() do { asm volatile("s_waitcnt lgkmcnt(0)" ::: "memory"); __builtin_amdgcn_s_barrier(); asm volatile("" ::: "memory"); } while (0)

__device__ __forceinline__ unsigned f2bf(float f) { unsigned u = __builtin_bit_cast(unsigned, f); return (u + 0x7fffu + ((u >> 16) & 1u)) >> 16; }
__device__ __forceinline__ unsigned pk2(float lo, float hi) { return pg8::cvt_pk_bf16(lo, hi); }
__device__ __forceinline__ float bf2f(unsigned h) { return __builtin_bit_cast(float, h << 16); }
__device__ __forceinline__ float bflo(unsigned w) { return __builtin_bit_cast(float, w << 16); }
__device__ __forceinline__ float bfhi(unsigned w) { return __builtin_bit_cast(float, w & 0xffff0000u); }
__device__ __forceinline__ float sigmoidf_(float x) { return __builtin_amdgcn_rcpf(1.f + __expf(-x)); }
__device__ __forceinline__ float gelu_tanh(float x) { const float u = 0.7978845608028654f * (x + 0.044715f * x * x * x); return x * __builtin_amdgcn_rcpf(1.f + __expf(-2.f * u)); }
__device__ __forceinline__ float wave_sum(float v) {
#pragma unroll
    for (int o = 1; o < 64; o <<= 1) v += __shfl_xor(v, o);
    return v;
}

#define XB_TMO      128
#define XB_XCNT(j)  (256  + 64 * (j))
#define XB_XSUB(j)  (1280 + 64 * (j))
#define XB_XGEN(j)  (2304 + 64 * (j))
#define XB_TOP      3328
#define XB_TOPGEN   3392
#define XCD_BAR_WORDS 3456
#define XB_SPIN_CAP (1u << 23)
__device__ __forceinline__ unsigned xb_ld(unsigned* p)              { return __hip_atomic_load(p, __ATOMIC_RELAXED, __HIP_MEMORY_SCOPE_AGENT); }
__device__ __forceinline__ unsigned xb_add(unsigned* p, unsigned v) { return __hip_atomic_fetch_add(p, v, __ATOMIC_RELAXED, __HIP_MEMORY_SCOPE_AGENT); }
__device__ __forceinline__ unsigned xb_xcc_id() { return (unsigned)__builtin_amdgcn_s_getreg((3 << 11) | 20) & 0xFu; }
#define XB_SPIN(cond, bar) do { unsigned _sp = 0; while (cond) { __builtin_amdgcn_s_sleep(1); \
    if ((++_sp & 255u) == 0u) { if (xb_ld(&(bar)[XB_TMO])) break; if (_sp > XB_SPIN_CAP) { atomicAdd(&(bar)[XB_TMO], 1u); break; } } } } while (0)
struct XcdBarrier { unsigned* bar; unsigned x; volatile LAS unsigned* st; };
__device__ __forceinline__ XcdBarrier xcd_barrier_post(unsigned* bar, volatile LAS unsigned* st, int tid) {
    XcdBarrier b; b.bar = bar; b.x = xb_xcc_id(); b.st = st;
    if (tid == 0) (void)xb_add(&bar[XB_XCNT(b.x)], 1u);
    return b;
}
__device__ __forceinline__ void xcd_barrier_complete(unsigned* bar, unsigned x, unsigned& nloc, unsigned& nx) {
    const unsigned G = gridDim.x * gridDim.y * gridDim.z;
    unsigned sum, cnt, mine, sp = 0u;
    for (;;) {
        sum = 0u; cnt = 0u; mine = 0u;
#pragma unroll
        for (unsigned j = 0; j < 16; ++j) { const unsigned c = xb_ld(&bar[XB_XCNT(j)]); sum += c; cnt += (c > 0u) ? 1u : 0u; mine = (j == x) ? c : mine; }
        if (sum == G) break;
        __builtin_amdgcn_s_sleep(1);
        if ((++sp & 255u) == 0u) { if (xb_ld(&bar[XB_TMO])) break; if (sp > XB_SPIN_CAP) { atomicAdd(&bar[XB_TMO], 1u); break; } }
    }
    nloc = mine > 0u ? mine : 1u; nx = cnt > 0u ? cnt : 1u;
}
__device__ __forceinline__ void xcd_barrier(const XcdBarrier& b, int tid) {
    asm volatile("s_waitcnt vmcnt(0)" ::: "memory");
    __syncthreads();
    if (tid == 0) {
        unsigned* bar = b.bar;
        __builtin_amdgcn_s_waitcnt(0);
        unsigned nloc = b.st[0], nx = b.st[1];
        if (nloc == 0u) { xcd_barrier_complete(bar, b.x, nloc, nx); b.st[0] = nloc; b.st[1] = nx; }
        const unsigned old = xb_add(&bar[XB_XSUB(b.x)], 1u);
        const unsigned gen = old / nloc;
        if (old + 1u == (gen + 1u) * nloc) {
            __builtin_amdgcn_fence(__ATOMIC_RELEASE, "agent");
            asm volatile("s_waitcnt vmcnt(0)" ::: "memory");
            const unsigned og = xb_add(&bar[XB_TOP], 1u);
            const unsigned tg = og / nx;
            if (og + 1u == (tg + 1u) * nx) xb_add(&bar[XB_TOPGEN], 1u);
            else XB_SPIN(xb_ld(&bar[XB_TOPGEN]) == tg, bar);
            __builtin_amdgcn_fence(__ATOMIC_ACQUIRE, "agent");
            xb_add(&bar[XB_XGEN(b.x)], 1u);
            asm volatile("s_waitcnt vmcnt(0)" ::: "memory");
        } else {
            XB_SPIN(xb_ld(&bar[XB_XGEN(b.x)]) == gen, bar);
            __builtin_amdgcn_fence(__ATOMIC_ACQUIRE, "agent");
            asm volatile("s_waitcnt vmcnt(0)" ::: "memory");
        }
    }
    __syncthreads();
}

__device__ __forceinline__ int make_tid(int wave_s) { int l; asm volatile("v_mbcnt_lo_u32_b32 %0, -1, 0\n\tv_mbcnt_hi_u32_b32 %0, -1, %0" : "=v"(l)); __builtin_assume(l >= 0 && l < 64); __builtin_assume(wave_s >= 0 && wave_s < 8); return wave_s * 64 + l; }
struct Args { const float* in[27]; float* out; unsigned char* ws; int ph_lo, ph_hi; };
enum { I_X = 0, I_C, I_CTX, I_CCTX, I_WMOD, I_BMOD, I_N1G, I_WIN, I_BGATES, I_HEADG, I_CONVW, I_CONVB, I_LWA, I_LBA, I_LWX, I_LBX, I_LAM, I_WPA, I_WPB, I_WOUT, I_N2G, I_WRG, I_WRE, I_W1, I_W3, I_W2, I_FG };

__device__ __forceinline__ void tr_item(const float* __restrict__ W, size_t ldw, int k0, int n0, bf16* dst, size_t ldd, float scale, LAS float* scr, int lane) {
#pragma unroll 16
    for (int i = 0; i < 32; ++i) { const int kk = 2 * i + (lane >> 5); scr[kk * 33 + (lane & 31)] = W[(size_t)(k0 + kk) * ldw + n0 + (lane & 31)]; }
    LDS_WAIT(); asm volatile("" ::: "memory");
    const int c = lane & 7;
#pragma unroll
    for (int j = 0; j < 4; ++j) { const int n = (lane >> 3) + 8 * j; const LAS float* s = scr + (8 * c) * 33 + n;
        v4u o; o.x = pk2(s[0 * 33] * scale, s[1 * 33] * scale); o.y = pk2(s[2 * 33] * scale, s[3 * 33] * scale); o.z = pk2(s[4 * 33] * scale, s[5 * 33] * scale); o.w = pk2(s[6 * 33] * scale, s[7 * 33] * scale);
        *(GAS v4u*)(dst + (size_t)n * ldd + 8 * c) = o; }
    LDS_WAIT(); asm volatile("" ::: "memory");
}
__device__ __forceinline__ int win_row(int n0, float& scale) {
    scale = 1.f;
    if (n0 < 1024) return 13 * 256 + n0;
    if (n0 < 2048) { scale = 0.08838834764831845f; return n0 - 1024; }
    if (n0 < 3072) return 4 * 256 + (n0 - 2048);
    if (n0 < 4096) return 17 * 256 + (n0 - 3072);
    if (n0 < 5120) return 21 * 256 + (n0 - 4096);
    if (n0 < 5152) return 12 * 256 + (n0 - 5120);
    if (n0 < 6176) return 8 * 256 + (n0 - 5152);
    if (n0 < 7200) return 25 * 256 + (n0 - 6176);
    if (n0 < 9248) return 29 * 256 + (n0 - 7200);
    return 37 * 256 + (n0 - 9248);
}

__device__ __forceinline__ void phase0(const Args& a, unsigned char* lds_g, int tid, int lane, int wave) {
    unsigned char* ws = a.ws;
    {
        float* sl = (float*)lds_g;
        float* red = sl + 5 * 2048;
        for (int i = tid; i < 5 * 2048; i += NTHR) { const int r = i >> 11, k = i & 2047; const float v = r < 4 ? a.in[I_C][r * 2048 + k] : a.in[I_CCTX][k]; sl[i] = v / (1.f + __expf(-v)); }
        __syncthreads();
        const float* wm = a.in[I_WMOD]; const float* bm = a.in[I_BMOD]; float* MOD = (float*)(ws + WS_MOD);
        for (int cb = blockIdx.x; cb < 256; cb += gridDim.x) {
            const int n0 = cb * 48;
            if (tid < 504) {
                const int kq = tid / 12, cg = tid % 12;
                f32x4 acc[5];
#pragma unroll
                for (int r = 0; r < 5; ++r) acc[r] = (f32x4){0.f, 0.f, 0.f, 0.f};
#pragma unroll 7
                for (int k = kq; k < 2048; k += 42) {
                    const f32x4 w = *(const f32x4*)(wm + (size_t)k * 12288 + n0 + 4 * cg);
#pragma unroll
                    for (int r = 0; r < 5; ++r) acc[r] += w * sl[r * 2048 + k];
                }
#pragma unroll
                for (int r = 0; r < 5; ++r) *(f32x4*)(red + tid * 20 + r * 4) = acc[r];
            }
            __syncthreads();
            if (tid < 240) {
                const int cg = tid / 20, rj = tid % 20; float s = 0.f;
                for (int kq = 0; kq < 42; ++kq) s += red[(kq * 12 + cg) * 20 + rj];
                const int r = rj >> 2, j = rj & 3, n = n0 + 4 * cg + j;
                __hip_atomic_store(MOD + r * 12288 + n, s + bm[n], __ATOMIC_RELAXED, __HIP_MEMORY_SCOPE_AGENT);
            }
            __syncthreads();
        }
        if (tid == 0) __hip_atomic_fetch_add((unsigned*)(ws + WS_CTL) + CW_MODC, 1u, __ATOMIC_RELAXED, __HIP_MEMORY_SCOPE_AGENT);
    }
    {
        LAS float* scr = (LAS float*)((LAS unsigned char*)lds_g) + wave * 4096;
        const int gw = blockIdx.x * NWAVES + wave, NGW = gridDim.x * NWAVES;
        constexpr int J0 = 32 * 353, J1 = 16 * 64, J3 = 32 * 64;
        constexpr int JL = 256;
        constexpr int NITEMS = J0 + 2 * J1;
        (void)J3; (void)JL;
        for (int it = gw; it < NITEMS; it += NGW) {
            int r = it;
            if (r < J0) { const int kb = r / 353, nb = r % 353; float sc; const int row = win_row(32 * nb, sc);
                tr_item(a.in[I_WIN], IN_DIM, 64 * kb, 32 * nb, (bf16*)(ws + WS_WIN) + (size_t)row * 2048 + 64 * kb, 2048, sc, scr, lane); continue; } r -= J0;
            if (r < J1) { const int kb = r / 64, nb = r % 64; tr_item(a.in[I_WPA], 2048, 64 * kb, 32 * nb, (bf16*)(ws + WS_WPA) + (size_t)(32 * nb) * 1024 + 64 * kb, 1024, 1.f, scr, lane); continue; } r -= J1;
            if (r < J1) { const int kb = r / 64, nb = r % 64; tr_item(a.in[I_WPB], 2048, 64 * kb, 32 * nb, (bf16*)(ws + WS_WPB) + (size_t)(32 * nb) * 1024 + 64 * kb, 1024, 1.f, scr, lane); continue; }
        }
        { GAS v4u* z = (GAS v4u*)((bf16*)(ws + WS_WIN) + (size_t)(12 * 256 + 32) * 2048); const int nchunks = 224 * 256;
          for (int i = blockIdx.x * NTHR + tid; i < nchunks; i += gridDim.x * NTHR) z[i] = (v4u){0u, 0u, 0u, 0u}; }
    }
}

__device__ __forceinline__ void late_prep(const Args& a, unsigned char* lds_g, int gw, int NGW, int lane, int wave) {
    unsigned char* ws = a.ws;
    {
        LAS float* scr = (LAS float*)((LAS unsigned char*)lds_g) + wave * 4096;
        constexpr int J3 = 32 * 64, JL = 256;
        for (int it = gw; it < J3 + JL; it += NGW) {
            int r = it;
            if (r >= J3) { r -= J3; const int mi = r >> 3, kb = (r >> 2) & 1, nb = r & 3, dir = mi >> 4, mat = (mi >> 3) & 1, blk = mi & 7;
                tr_item(a.in[mat ? I_LWX : I_LWA] + (size_t)(dir * 8 + blk) * 128 * 128, 128, 64 * kb, 32 * nb, (bf16*)(ws + WS_WL) + ((size_t)((dir * 2 + mat) * 8 + blk) * 128 + 32 * nb) * 128 + 64 * kb, 128, 1.f, scr, lane); continue; }
            const int kb = r / 64, nb = r % 64; tr_item(a.in[I_WOUT], 2048, 64 * kb, 32 * nb, (bf16*)(ws + WS_WOUT) + (size_t)(32 * nb) * 2048 + 64 * kb, 2048, 1.f, scr, lane);
        }
    }
    {
        const float* MODr = (const float*)(a.ws + WS_MOD); float* WR = (float*)(a.ws + WS_WR); float* RB = (float*)(a.ws + WS_RB);
        for (int idx = gw * 64 + lane; idx < 4 * 48 * 2048; idx += NGW * 64) { const int k = idx & 2047, j = (idx >> 11) % 48, b = idx / (48 * 2048);
            const float gm = a.in[I_N2G][k] * (1.f + MODr[b * 12288 + 4 * 2048 + k]);
            const float wv = j < 32 ? a.in[I_WRE][(size_t)k * 32 + j] : (j < 36 ? a.in[I_WRG][(size_t)k * 4 + (j - 32)] : 0.f);
            WR[idx] = gm * wv; }
        for (int q = gw; q < 4 * 48; q += NGW) { const int b = q / 48, j = q % 48; float sacc = 0.f;
            if (j < 36) { for (int k = lane; k < 2048; k += 64) { const float wv = j < 32 ? a.in[I_WRE][(size_t)k * 32 + j] : a.in[I_WRG][(size_t)k * 4 + (j - 32)]; sacc += MODr[b * 12288 + 3 * 2048 + k] * wv; } }
            sacc = wave_sum(sacc); if (lane == 0) RB[q] = sacc; }
    }
}
__device__ __forceinline__ void mod_wait(const Args& a, int tid) {
    if (tid < 64) { unsigned* mc = (unsigned*)(a.ws + WS_CTL) + CW_MODC; unsigned spins = 0;
        while ((unsigned)__builtin_amdgcn_readfirstlane(__hip_atomic_load(mc, __ATOMIC_RELAXED, __HIP_MEMORY_SCOPE_AGENT)) < gridDim.x) {
            __builtin_amdgcn_s_sleep(2);
            if (++spins > (1u << 22)) { if (tid == 0) __hip_atomic_store((unsigned*)(a.ws + WS_CTL) + 1, 0x800u, __ATOMIC_RELAXED, __HIP_MEMORY_SCOPE_AGENT); break; } }
        __builtin_amdgcn_fence(__ATOMIC_ACQUIRE, "agent");
        asm volatile("s_waitcnt vmcnt(0)" ::: "memory"); }
    __syncthreads();
}
__device__ __forceinline__ void phase1(const Args& a, int lane, int wave) {
    const int gw = blockIdx.x * NWAVES + wave, NGW = gridDim.x * NWAVES;
    const float* MOD = (const float*)(a.ws + WS_MOD); const float* g = a.in[I_N1G];
    bf16* H = (bf16*)(a.ws + WS_H);
    for (int r = gw; r < NTOK; r += NGW) {
        const float* src = r < NCTX ? a.in[I_CTX] + (size_t)r * D : a.in[I_X] + (size_t)(r - NCTX) * D;
        const int mr = r < NCTX ? 4 : (r - NCTX) / SEQ;
        const f32x4* xr = (const f32x4*)src + lane;
        f32x4 v[8]; float s = 0.f;
#pragma unroll
        for (int j = 0; j < 8; ++j) { v[j] = xr[64 * j]; s += (v[j].x * v[j].x + v[j].y * v[j].y) + (v[j].z * v[j].z + v[j].w * v[j].w); }
        const float rstd = 1.f / sqrtf(wave_sum(s) * (1.f / D) + EPS);
        unsigned long long* o8 = (unsigned long long*)(H + (size_t)r * D) + lane;
#pragma unroll
        for (int j = 0; j < 8; ++j) {
            const int c = 4 * lane + 256 * j;
            const f32x4 gg = *(const f32x4*)(g + c), sh = *(const f32x4*)(MOD + mr * 12288 + c), sc = *(const f32x4*)(MOD + mr * 12288 + 2048 + c);
            v[j] = v[j] * rstd * gg * (sc + 1.f) + sh;
        }
#pragma unroll
        for (int j = 0; j < 8; ++j) o8[64 * j] = (unsigned long long)pk2(v[j].x, v[j].y) | ((unsigned long long)pk2(v[j].z, v[j].w) << 32);
    }
}

struct SchedIn {
    int G, c; const char* A; const char* B;
    __device__ __forceinline__ bool next(int i, pg8::Unit& u) const {
        const int L = i * G + c; if (L >= 1492) return false;
        int pm, pn;
        if (L < 1440) { pg8::tile_order(L, 32, NT_IN, pm, pn); pm += 4; }
        else { const int j = L - 1440; pm = j & 3; pn = j >> 2; }
        u.pm = pm; u.pn = pn; u.aux = 0; u.A = A + (size_t)pm * 256 * D * 2; u.B = B + (size_t)pn * 256 * D * 2; return true;
    }
};
struct EpiIn {
    static constexpr bool PERM = true, CARRY = false;
    __device__ __forceinline__ bool keep(const pg8::Unit&) const { return false; }
    unsigned char* ws; const float* b_gates;
    template <int ACT> __device__ __forceinline__ void store_tile(const pg8::f32x4 (&acc)[2][2][4][2], bf16* base, int ldc, int wr, int wc, int fr, int fq) const {
#pragma unroll
        for (int ai = 0; ai < 2; ++ai)
#pragma unroll
            for (int m = 0; m < 4; ++m) { bf16* rowp = base + (size_t)(ai * 128 + wr * 64 + m * 16 + fr) * ldc + wc * 32 + 8 * fq;
#pragma unroll
                for (int bj = 0; bj < 2; ++bj) { pg8::f32x4 v0 = acc[ai][bj][m][0], v1 = acc[ai][bj][m][1];
                    if (ACT == 1) {
#pragma unroll
                        for (int j = 0; j < 4; ++j) { v0[j] = sigmoidf_(v0[j]); v1[j] = sigmoidf_(v1[j]); } }
                    if (ACT == 2) {
#pragma unroll
                        for (int j = 0; j < 4; ++j) { v0[j] = gelu_tanh(v0[j]); v1[j] = gelu_tanh(v1[j]); } }
                    pg8::u32x4 w; w.x = pg8::cvt_pk_bf16(v0[0], v0[1]); w.y = pg8::cvt_pk_bf16(v0[2], v0[3]); w.z = pg8::cvt_pk_bf16(v1[0], v1[1]); w.w = pg8::cvt_pk_bf16(v1[2], v1[3]);
                    *(pg8::u32x4*)(rowp + bj * 128) = w; } }
    }
    __device__ __forceinline__ void operator()(const pg8::f32x4 (&acc)[2][2][4][2], const pg8::Unit& u, int wr, int wc, int fr, int fq) const {
        const int pn = u.pn; const size_t row0 = (size_t)u.pm * 256;
        if (pn < 12) {
            const int seg = pn >> 2, ct = pn & 3; bf16* dst = (bf16*)(ws + (seg == 0 ? WS_K : seg == 1 ? WS_V : WS_UX));
            store_tile<0>(acc, dst + row0 * 1024 + ct * 256, 1024, wr, wc, fr, fq);
        } else if (pn == 12) {
            if (wc == 0) {
                float* G = (float*)(ws + WS_GATES);
                const pg8::f32x4 bv0 = *(const pg8::f32x4*)(b_gates + 8 * fq), bv1 = *(const pg8::f32x4*)(b_gates + 8 * fq + 4);
#pragma unroll
                for (int ai = 0; ai < 2; ++ai)
#pragma unroll
                    for (int m = 0; m < 4; ++m) { float* rowp = G + (row0 + ai * 128 + wr * 64 + m * 16 + fr) * 32 + 8 * fq;
                        *(pg8::f32x4*)(rowp) = acc[ai][0][m][0] + bv0; *(pg8::f32x4*)(rowp + 4) = acc[ai][0][m][1] + bv1; }
            }
        } else if (pn < 29) {
            const int seg = (pn - 13) >> 2, ct = (pn - 13) & 3; const size_t lr = row0 - NCTX;
            bf16* dst = (bf16*)(ws + (seg == 0 ? WS_Q : seg == 1 ? WS_OF : seg == 2 ? WS_OB : WS_UG)) + lr * 1024 + ct * 256;
            if (seg == 0) store_tile<0>(acc, dst, 1024, wr, wc, fr, fq);
            else if (seg == 3) store_tile<2>(acc, dst, 1024, wr, wc, fr, fq);
            else store_tile<1>(acc, dst, 1024, wr, wc, fr, fq);
        } else {
            const int seg = (pn - 29) >> 3, ct = (pn - 29) & 7; const size_t lr = row0 - NCTX;
            store_tile<1>(acc, (bf16*)(ws + (seg ? WS_GB : WS_GA)) + lr * 2048 + ct * 256, 2048, wr, wc, fr, fq);
        }
    }
};

__device__ __forceinline__ int lru_pos_row(int b, bool isctx, int p) { return isctx ? b * CTXL + p : NCTX + b * SEQ + (p & 31) * 64 + (p >> 5); }
typedef short bf16x8_t __attribute__((ext_vector_type(8)));
template <bool FINAL>
__device__ __forceinline__ void lru_unit(const Args& a, unsigned char* lds_g, int b, int cidx, int blk, int tid) {
    const int lane = tid & 63, w = __builtin_amdgcn_readfirstlane(tid >> 6), fr = lane & 15, fq = lane >> 4;
    float* zf = (float*)lds_g;
    bf16* zb = (bf16*)(lds_g + 64 * 132 * 4);
    const bool isctx = cidx < 4; const int seglen = isctx ? CTXL : SEQ, p0 = (isctx ? cidx : cidx - 4) * 64;
    const bf16* UX = (const bf16*)(a.ws + WS_UX);
    float gba[2], gbx[2], glam[2];
    { const int ch_ = blk * 128 + 16 * w + fr;
#pragma unroll
      for (int d = 0; d < 2; ++d) { gba[d] = a.in[I_LBA][d * 1024 + ch_]; gbx[d] = a.in[I_LBX][d * 1024 + ch_]; glam[d] = a.in[I_LAM][d * 1024 + ch_]; } }
    bf16x8_t wl[2][2][4];
    { const bf16* WL = (const bf16*)(a.ws + WS_WL);
#pragma unroll
      for (int d = 0; d < 2; ++d)
#pragma unroll
        for (int m = 0; m < 2; ++m)
#pragma unroll
            for (int ks = 0; ks < 4; ++ks) wl[d][m][ks] = *(const bf16x8_t*)(WL + ((size_t)((d * 2 + m) * 8 + blk) * 128 + 16 * w + fr) * 128 + 32 * ks + 8 * fq); }
    __builtin_amdgcn_sched_barrier(0);
    {
        const int pos = tid >> 3, cg = tid & 7, ch0 = blk * 128 + cg * 16, p = p0 + pos;
        float z[16];
#pragma unroll
        for (int q = 0; q < 4; ++q) { const f32x4 bv = *(const f32x4*)(a.in[I_CONVB] + ch0 + 4 * q); z[4 * q] = bv.x; z[4 * q + 1] = bv.y; z[4 * q + 2] = bv.z; z[4 * q + 3] = bv.w; }
        v4u ua[4], ub[4]; float msk[4];
#pragma unroll
        for (int w4 = 0; w4 < 4; ++w4) { const int pp = p + w4 - 2; const bool ok = pp >= 0 && pp < seglen; const int ppc = ok ? pp : p;
            const v4u* src = (const v4u*)(UX + (size_t)lru_pos_row(b, isctx, ppc) * 1024 + ch0); ua[w4] = src[0]; ub[w4] = src[1]; msk[w4] = ok ? 1.f : 0.f; }
#pragma unroll
        for (int w4 = 0; w4 < 4; ++w4) { const float* cw = a.in[I_CONVW] + w4 * 1024 + ch0;
            const unsigned uu[8] = {ua[w4].x, ua[w4].y, ua[w4].z, ua[w4].w, ub[w4].x, ub[w4].y, ub[w4].z, ub[w4].w};
#pragma unroll
            for (int q = 0; q < 4; ++q) { const f32x4 cv = *(const f32x4*)(cw + 4 * q) * msk[w4]; z[4 * q] += cv.x * bflo(uu[2 * q]); z[4 * q + 1] += cv.y * bfhi(uu[2 * q]); z[4 * q + 2] += cv.z * bflo(uu[2 * q + 1]); z[4 * q + 3] += cv.w * bfhi(uu[2 * q + 1]); } }
#pragma unroll
        for (int q = 0; q < 4; ++q) *(f32x4*)(zf + pos * 132 + cg * 16 + 4 * q) = (f32x4){z[4 * q], z[4 * q + 1], z[4 * q + 2], z[4 * q + 3]};
        v4u o0, o1; o0.x = pk2(z[0], z[1]); o0.y = pk2(z[2], z[3]); o0.z = pk2(z[4], z[5]); o0.w = pk2(z[6], z[7]); o1.x = pk2(z[8], z[9]); o1.y = pk2(z[10], z[11]); o1.z = pk2(z[12], z[13]); o1.w = pk2(z[14], z[15]);
        *(v4u*)(zb + pos * 136 + cg * 16) = o0; *(v4u*)(zb + pos * 136 + cg * 16 + 8) = o1;
    }
    WG_BAR();
    f32x4 acc[2][2][4];
#pragma unroll
    for (int d = 0; d < 2; ++d)
#pragma unroll
        for (int m = 0; m < 2; ++m)
#pragma unroll
            for (int mt = 0; mt < 4; ++mt) acc[d][m][mt] = (f32x4){0.f, 0.f, 0.f, 0.f};
#pragma unroll
    for (int ks = 0; ks < 4; ++ks) {
        bf16x8_t af[4];
#pragma unroll
        for (int mt = 0; mt < 4; ++mt) af[mt] = *(const bf16x8_t*)(zb + (16 * mt + fr) * 136 + 32 * ks + 8 * fq);
#pragma unroll
        for (int d = 0; d < 2; ++d)
#pragma unroll
            for (int m = 0; m < 2; ++m) {
#pragma unroll
                for (int mt = 0; mt < 4; ++mt) acc[d][m][mt] = __builtin_amdgcn_mfma_f32_16x16x32_bf16(af[mt], wl[d][m][ks], acc[d][m][mt], 0, 0, 0); }
    }
    const int chl = 16 * w + fr, ch = blk * 128 + chl;
    float hsum[4][4];
#pragma unroll
    for (int d = 0; d < 2; ++d) {
        const float ba = gba[d], bx = gbx[d], lam = glam[d];
        const float sp = (-lam > 20.f) ? -lam : log1pf(__expf(-lam));
        float av[4][4], bv[4][4];
#pragma unroll
        for (int mt = 0; mt < 4; ++mt)
#pragma unroll
            for (int r = 0; r < 4; ++r) { const float rr = sigmoidf_(acc[d][0][mt][r] + ba), ii = sigmoidf_(acc[d][1][mt][r] + bx);
                const float aa = __expf(-8.f * rr * sp); av[mt][r] = aa; bv[mt][r] = __builtin_amdgcn_sqrtf(fmaxf(1.f - aa * aa, 0.f)) * ii * zf[(16 * mt + 4 * fq + r) * 132 + chl]; }
        float Pe[4], Se[4], Pt[4], St[4];
#pragma unroll
        for (int mt = 0; mt < 4; ++mt) {
            float P = 1.f, S = 0.f;
#pragma unroll
            for (int rr = 0; rr < 4; ++rr) { const int r = d ? 3 - rr : rr; S = av[mt][r] * S + bv[mt][r]; P = av[mt][r] * P; }
            if (d == 0) {
                float p1 = __shfl_up(P, 16), s1 = __shfl_up(S, 16); if (fq >= 1) { S = P * s1 + S; P = P * p1; }
                p1 = __shfl_up(P, 32); s1 = __shfl_up(S, 32); if (fq >= 2) { S = P * s1 + S; P = P * p1; }
                Pe[mt] = __shfl_up(P, 16); Se[mt] = __shfl_up(S, 16); if (fq == 0) { Pe[mt] = 1.f; Se[mt] = 0.f; }
                Pt[mt] = __shfl(P, fr + 48); St[mt] = __shfl(S, fr + 48);
            } else {
                float p1 = __shfl_down(P, 16), s1 = __shfl_down(S, 16); if (fq <= 2) { S = P * s1 + S; P = P * p1; }
                p1 = __shfl_down(P, 32); s1 = __shfl_down(S, 32); if (fq <= 1) { S = P * s1 + S; P = P * p1; }
                Pe[mt] = __shfl_down(P, 16); Se[mt] = __shfl_down(S, 16); if (fq == 3) { Pe[mt] = 1.f; Se[mt] = 0.f; }
                Pt[mt] = __shfl(P, fr); St[mt] = __shfl(S, fr);
            }
        }
        float2* AGG = (float2*)(a.ws + WS_AGG) + ((size_t)(b * 2 + d) * 36) * 1024 + ch;
        if (!FINAL) {
            if (cidx >= 4) {
                unsigned* PS = (unsigned*)(a.ws + WS_PS) + ((size_t)(b * 2 + d) * NSTEP + 64 * cidx) * 1024 + ch;
#pragma unroll
                for (int mt = 0; mt < 4; ++mt)
#pragma unroll
                    for (int r = 0; r < 4; ++r) PS[(size_t)(16 * mt + 4 * fq + r) * 1024] = pk2(1.f - av[mt][r], bv[mt][r]);
            }
            float Pc = 1.f, Sc = 0.f;
#pragma unroll
            for (int i = 0; i < 4; ++i) { const int mt = d ? 3 - i : i; Sc = Pt[mt] * Sc + St[mt]; Pc = Pt[mt] * Pc; }
            if (fq == 0) AGG[(size_t)cidx * 1024] = make_float2(Pc, Sc);
        } else {
            float h = 0.f;
#pragma unroll
            for (int g3 = 0; g3 < 6; ++g3) {
                float2 qv[6];
#pragma unroll
                for (int i = 0; i < 6; ++i) { const int sidx = 6 * g3 + i; const int c2 = d ? (sidx < 4 ? 3 - sidx : 39 - sidx) : sidx; qv[i] = AGG[(size_t)c2 * 1024]; }
#pragma unroll
                for (int i = 0; i < 6; ++i) { const int sidx = 6 * g3 + i; const int c2 = d ? (sidx < 4 ? 3 - sidx : 39 - sidx) : sidx;
                    const bool use = d ? (sidx < 4 || c2 > cidx) : (c2 < cidx);
                    h = use ? qv[i].x * h + qv[i].y : h; }
            }
#pragma unroll
            for (int i = 0; i < 4; ++i) { const int mt = d ? 3 - i : i;
                float hl = Pe[mt] * h + Se[mt];
#pragma unroll
                for (int rr = 0; rr < 4; ++rr) { const int r = d ? 3 - rr : rr; hl = av[mt][r] * hl + bv[mt][r]; if (d == 0) hsum[mt][r] = hl; else hsum[mt][r] += hl; }
                h = Pt[mt] * h + St[mt]; }
        }
    }
    if (FINAL) {
#pragma unroll
        for (int mt = 0; mt < 4; ++mt)
#pragma unroll
            for (int r = 0; r < 4; ++r) zf[(16 * mt + 4 * fq + r) * 132 + chl] = hsum[mt][r];
        WG_BAR();
        const int pos = tid >> 3, cg = tid & 7, ch0 = blk * 128 + cg * 16;
        const size_t lrow = (size_t)(lru_pos_row(b, false, p0 + pos) - NCTX) * 1024 + ch0;
        const v4u* ug = (const v4u*)((const bf16*)(a.ws + WS_UG) + lrow); const v4u g0 = ug[0], g1 = ug[1];
        const unsigned gg[8] = {g0.x, g0.y, g0.z, g0.w, g1.x, g1.y, g1.z, g1.w}; unsigned o[8];
#pragma unroll
        for (int q = 0; q < 4; ++q) { const f32x4 hv = *(const f32x4*)(zf + pos * 132 + cg * 16 + 4 * q);
            o[2 * q] = pk2(hv.x * bflo(gg[2 * q]), hv.y * bfhi(gg[2 * q])); o[2 * q + 1] = pk2(hv.z * bflo(gg[2 * q + 1]), hv.w * bfhi(gg[2 * q + 1])); }
        v4u* dst = (v4u*)((bf16*)(a.ws + WS_YB) + lrow); dst[0] = (v4u){o[0], o[1], o[2], o[3]}; dst[1] = (v4u){o[4], o[5], o[6], o[7]};
    }
    WG_BAR();
}
constexpr int ML_STRIDE = 136;
constexpr int ML_Q = 0, ML_K = 17408, ML_V = 34816, ML_AUG = 52224  , ML_CB = 54272  ;
constexpr int ML_EB = 93440  , ML_EU = 95488  , ML_EBEND = 97536  , ML_BEND = 97568  , ML_DEN = 97600  , ML_SSQ = 97856  ;
typedef short s4_t __attribute__((ext_vector_type(4)));
__device__ __forceinline__ s4_t ds_tr(const bf16* p) { return __builtin_amdgcn_ds_read_tr16_b64_v4i16((LAS s4_t*)p); }
__device__ __forceinline__ bf16x8_t frag_row(const bf16* img, int row0, int k0, int fr, int fq) { return *(const bf16x8_t*)(img + (row0 + fr) * ML_STRIDE + k0 + 8 * fq); }
__device__ __forceinline__ bf16x8_t frag_tr2(const bf16* img, int stride, int sA, int sB, int col0, int lane) {
    const int fq = lane >> 4, q = (lane & 15) >> 2, p = lane & 3;
    const s4_t lo = ds_tr(img + (sA + 4 * fq + q) * stride + col0 + 4 * p), hi = ds_tr(img + (sB + 4 * fq + q) * stride + col0 + 4 * p);
    return (bf16x8_t){lo.x, lo.y, lo.z, lo.w, hi.x, hi.y, hi.z, hi.w};
}
__device__ __forceinline__ bf16x8_t frag_tr(const bf16* img, int stride, int s0, int col0, int lane) {
    const int fq = lane >> 4, q = (lane & 15) >> 2, p = lane & 3;
    const bf16* b = img + (s0 + 8 * fq + q) * stride + col0 + 4 * p;
    const s4_t lo = ds_tr(b), hi = ds_tr(b + 4 * stride);
    return (bf16x8_t){lo.x, lo.y, lo.z, lo.w, hi.x, hi.y, hi.z, hi.w};
}
__device__ __forceinline__ float logsigmoidf_(float x) { return fminf(x, 0.f) - log1pf(__expf(-fabsf(x))); }

__device__ __forceinline__ void ml_gates(const Args& a, unsigned char* lds_g, int rowbase, int h, int tid) {
    const int lane = tid & 63, w = tid >> 6, dir = w >> 2, c = w & 3;
    const float* GT = (const float*)(a.ws + WS_GATES) + (size_t)(rowbase + 64 * c + lane) * 32;
    const float ipre = GT[(dir * 2) * 8 + h], fpre = GT[(dir * 2 + 1) * 8 + h];
    float bsum = logsigmoidf_(fpre);
    if (dir == 0) {
#pragma unroll
        for (int o = 1; o < 64; o <<= 1) { const float t = __shfl_up(bsum, o); if (lane >= o) bsum += t; }
    } else {
#pragma unroll
        for (int o = 1; o < 64; o <<= 1) { const float t = __shfl_down(bsum, o); if (lane + o < 64) bsum += t; }
    }
    float* eb = (float*)(lds_g + ML_EB); float* eu = (float*)(lds_g + ML_EU);
    eb[dir * 256 + 64 * c + lane] = __expf(bsum); eu[dir * 256 + 64 * c + lane] = __expf(ipre - bsum);
    const float bend = __shfl(bsum, dir ? 0 : 63);
    if (lane == 0) { ((float*)(lds_g + ML_EBEND))[dir * 4 + c] = __expf(bend); ((float*)(lds_g + ML_BEND))[dir * 4 + c] = bend; }
}

template <bool OUT, bool PASS2>
__device__ __forceinline__ void ml_block(const Args& a, unsigned char* lds_g, int rowbase, int h, int dir, f32x4 (&st)[9], int tid) {
    const int lane = tid & 63, w = __builtin_amdgcn_readfirstlane(tid >> 6), fr = lane & 15, fq = lane >> 4;
    bf16* Qi = (bf16*)(lds_g + ML_Q); bf16* Ki = (bf16*)(lds_g + ML_K); bf16* Vi = (bf16*)(lds_g + ML_V); bf16* AUGi = (bf16*)(lds_g + ML_AUG); bf16* CB = (bf16*)(lds_g + ML_CB);
    const float* eb = (const float*)(lds_g + ML_EB) + dir * 256; const float* eu = (const float*)(lds_g + ML_EU) + dir * 256;
    const float* ebend = (const float*)(lds_g + ML_EBEND) + dir * 4;
    float* den = (float*)(lds_g + ML_DEN); float* ssq = (float*)(lds_g + ML_SSQ);
    const bf16* Kb = (const bf16*)(a.ws + WS_K); const bf16* Vb = (const bf16*)(a.ws + WS_V); const bf16* Qb = (const bf16*)(a.ws + WS_Q);
    const int ti = w & 3, vh = w >> 2;
    float hgv[5];
    if (OUT) {
#pragma unroll
        for (int x = 0; x < 5; ++x) { const int vt = vh * 5 + x; hgv[x] = vt < 8 ? a.in[I_HEADG][h * 128 + 16 * vt + fr] : 0.f; } }
    for (int ci = 0; ci < 4; ++ci) {
        const int c = dir ? 3 - ci : ci;
        unsigned short ogv[5][4]; unsigned short tmv[5][4];
        if (OUT) {
            const bf16* OGp = (const bf16*)(a.ws + (dir ? WS_OB : WS_OF)); const bf16* TMp = (const bf16*)(a.ws + WS_TM);
#pragma unroll
            for (int r = 0; r < 4; ++r) { const size_t ob = (size_t)(rowbase - NCTX + 64 * c + 16 * ti + 4 * fq + r) * 1024 + h * 128;
#pragma unroll
                for (int x = 0; x < 5; ++x) { const int vt = vh * 5 + x; if (vt < 8) { ogv[x][r] = OGp[ob + 16 * vt + fr]; if (PASS2) tmv[x][r] = TMp[ob + 16 * vt + fr]; } } }
            __builtin_amdgcn_sched_barrier(0);
        }
        {
            const int t = tid >> 3, pc = tid & 7; const size_t row = (size_t)(rowbase + 64 * c + t);
            const v4u* ks = (const v4u*)(Kb + row * 1024 + h * 128 + 16 * pc); const v4u k0 = ks[0], k1 = ks[1];
            const v4u* vs = (const v4u*)(Vb + row * 1024 + h * 128 + 16 * pc); const v4u v0 = vs[0], v1 = vs[1];
            v4u q0, q1; if (OUT) { const v4u* qs = (const v4u*)(Qb + (row - NCTX) * 1024 + h * 128 + 16 * pc); q0 = qs[0]; q1 = qs[1]; }
            const float e = eu[64 * c + t];
            *(v4u*)(Ki + t * ML_STRIDE + 16 * pc) = k0; *(v4u*)(Ki + t * ML_STRIDE + 16 * pc + 8) = k1;
            if (OUT) { *(v4u*)(Qi + t * ML_STRIDE + 16 * pc) = q0; *(v4u*)(Qi + t * ML_STRIDE + 16 * pc + 8) = q1; }
            const unsigned vv[8] = {v0.x, v0.y, v0.z, v0.w, v1.x, v1.y, v1.z, v1.w}; unsigned o[8];
#pragma unroll
            for (int i = 0; i < 8; ++i) o[i] = pk2(bflo(vv[i]) * e, bfhi(vv[i]) * e);
            *(v4u*)(Vi + t * ML_STRIDE + 16 * pc) = (v4u){o[0], o[1], o[2], o[3]}; *(v4u*)(Vi + t * ML_STRIDE + 16 * pc + 8) = (v4u){o[4], o[5], o[6], o[7]};
            if (pc == 0) { *(v4u*)(AUGi + t * 16) = (v4u){f2bf(e), 0u, 0u, 0u}; *(v4u*)(AUGi + t * 16 + 8) = (v4u){0u, 0u, 0u, 0u}; }
        }
        WG_BAR();
        f32x4 X[5]; float hval[4][4];
        if (OUT) {
            bf16x8_t qf[4];
#pragma unroll
            for (int ks = 0; ks < 4; ++ks) qf[ks] = frag_row(Qi, 16 * ti, 32 * ks, fr, fq);
            bf16x8_t P[2]; bool pv[2];
#pragma unroll
            for (int pp = 0; pp < 2; ++pp) {
                f32x4 d[2];
#pragma unroll
                for (int hh = 0; hh < 2; ++hh) { const int si = 2 * pp + hh; d[hh] = (f32x4){0.f, 0.f, 0.f, 0.f};
                    const bool valid = dir ? (si >= ti) : (si <= ti);
                    if (valid) {
#pragma unroll
                        for (int ks = 0; ks < 4; ++ks) d[hh] = __builtin_amdgcn_mfma_f32_16x16x32_bf16(frag_row(Ki, 16 * si, 32 * ks, fr, fq), qf[ks], d[hh], 0, 0, 0);
                        if (si == ti) {
#pragma unroll
                            for (int r = 0; r < 4; ++r) { const bool keep = dir ? (4 * fq + r >= fr) : (4 * fq + r <= fr); d[hh][r] = keep ? d[hh][r] : 0.f; } } } }
                pv[pp] = dir ? (2 * pp + 1 >= ti) : (2 * pp <= ti);
                const unsigned p0 = pk2(d[0][0], d[0][1]), p1 = pk2(d[0][2], d[0][3]), p2 = pk2(d[1][0], d[1][1]), p3 = pk2(d[1][2], d[1][3]);
                P[pp] = __builtin_bit_cast(bf16x8_t, (v4u){p0, p1, p2, p3});
            }
#pragma unroll
            for (int x = 0; x < 5; ++x) { X[x] = (f32x4){0.f, 0.f, 0.f, 0.f};
                const int vt = vh * 5 + x;
                if (vt < 9) {
#pragma unroll
                    for (int pp = 0; pp < 2; ++pp) if (pv[pp]) {
                        const bf16x8_t bfv = vt < 8 ? frag_tr2(Vi, ML_STRIDE, 32 * pp, 32 * pp + 16, 16 * vt, lane) : frag_tr2(AUGi, 16, 32 * pp, 32 * pp + 16, 0, lane);
                        X[x] = __builtin_amdgcn_mfma_f32_16x16x32_bf16(P[pp], bfv, X[x], 0, 0, 0); }
#pragma unroll
                    for (int ks = 0; ks < 4; ++ks) X[x] = __builtin_amdgcn_mfma_f32_16x16x32_bf16(qf[ks], frag_row(CB, 16 * vt, 32 * ks, fr, fq), X[x], 0, 0, 0);
                } }
            if (vh == 1 && fr == 0) {
#pragma unroll
                for (int r = 0; r < 4; ++r) den[16 * ti + 4 * fq + r] = X[3][r] * eb[64 * c + 16 * ti + 4 * fq + r]; }
        }
        {
#pragma unroll
            for (int ks = 0; ks < 2; ++ks) { const bf16x8_t kf = frag_tr(Ki, ML_STRIDE, 32 * ks, 16 * w, lane);
#pragma unroll
                for (int vt = 0; vt < 8; ++vt) st[vt] = __builtin_amdgcn_mfma_f32_16x16x32_bf16(kf, frag_tr(Vi, ML_STRIDE, 32 * ks, 16 * vt, lane), st[vt], 0, 0, 0);
                st[8] = __builtin_amdgcn_mfma_f32_16x16x32_bf16(kf, frag_tr(AUGi, 16, 32 * ks, 0, lane), st[8], 0, 0, 0); }
            const float ee = ebend[c];
#pragma unroll
            for (int vt = 0; vt < 9; ++vt) st[vt] = st[vt] * ee;
        }
        WG_BAR();
        if (OUT) {
            float sq[4] = {0.f, 0.f, 0.f, 0.f};
#pragma unroll
            for (int r = 0; r < 4; ++r) { const int t = 16 * ti + 4 * fq + r; const float sc = eb[64 * c + t] * __builtin_amdgcn_rcpf(fmaxf(fabsf(den[t]), 1.f));
#pragma unroll
                for (int x = 0; x < 4; ++x) { const int vt = vh * 5 + x; const float hv = (vt < 8) ? X[x][r] * sc : 0.f; hval[x][r] = hv; sq[r] += hv * hv; }
                if (vh == 0) { const float hv = X[4][r] * sc; X[4][r] = hv; sq[r] += hv * hv; } }
#pragma unroll
            for (int r = 0; r < 4; ++r) { float v = sq[r]; v += __shfl_xor(v, 1); v += __shfl_xor(v, 2); v += __shfl_xor(v, 4); v += __shfl_xor(v, 8); if (fr == 0) ssq[vh * 64 + 16 * ti + 4 * fq + r] = v; }
#pragma unroll
            for (int vt = 0; vt < 9; ++vt) { pg8::u32x2 o; o.x = pk2(st[vt][0], st[vt][1]); o.y = pk2(st[vt][2], st[vt][3]); *(pg8::u32x2*)(CB + (16 * vt + fr) * ML_STRIDE + 16 * w + 4 * fq) = o; }
            WG_BAR();
            bf16* TM = (bf16*)(a.ws + WS_TM); bf16* YA = (bf16*)(a.ws + WS_YA);
#pragma unroll
            for (int r = 0; r < 4; ++r) { const int t = 16 * ti + 4 * fq + r; const float rs = __builtin_amdgcn_rsqf((ssq[t] + ssq[64 + t]) * (1.f / 128.f) + EPS);
                const size_t ob = (size_t)(rowbase - NCTX + 64 * c + t) * 1024 + h * 128;
#pragma unroll
                for (int x = 0; x < 5; ++x) { const int vt = vh * 5 + x; if (vt < 8) { const int v = 16 * vt + fr; const float hv = (x < 4) ? hval[x][r] : X[4][r];
                    float y = hv * rs * hgv[x] * bf2f(ogv[x][r]);
                    if (PASS2) { y += bf2f(tmv[x][r]); YA[ob + v] = (bf16)f2bf(y); } else TM[ob + v] = (bf16)f2bf(y); } } }
        }
    }
}

__device__ __forceinline__ void ml_state_quad(const Args& a, unsigned char* lds_g, int qu, int tid) {
    const int seq = qu >> 1, j0 = 4 * (qu & 1), dir = seq & 1, h = (seq >> 1) & 7, b = seq >> 4;
    const int lane = tid & 63, w = __builtin_amdgcn_readfirstlane(tid >> 6);
    f32x4 st[9];
#pragma unroll
    for (int vt = 0; vt < 9; ++vt) st[vt] = (f32x4){0.f, 0.f, 0.f, 0.f};
#pragma unroll 1
    for (int jj = 0; jj < 4; ++jj) {
        const int j = j0 + jj, su = seq * 8 + j;
        const int rowbase = j == 0 ? b * CTXL : NCTX + b * SEQ + 256 * (dir ? 8 - j : j - 1);
        ml_gates(a, lds_g, rowbase, h, tid);
        WG_BAR();
        ml_block<false, false>(a, lds_g, rowbase, h, dir, st, tid);
        pg8::u32x2* SL = (pg8::u32x2*)(a.ws + WS_SLOC) + ((size_t)(su * 8 + w) * 9) * 64 + lane;
#pragma unroll
        for (int vt = 0; vt < 9; ++vt) { pg8::u32x2 o; o.x = pk2(st[vt][0], st[vt][1]); o.y = pk2(st[vt][2], st[vt][3]); SL[vt * 64] = o; }
        if (tid == 0) { const float* bd = (const float*)(lds_g + ML_BEND) + dir * 4; ((float*)(a.ws + WS_BT))[su] = (bd[0] + bd[1]) + (bd[2] + bd[3]); }
        WG_BAR();
    }
}
__device__ __forceinline__ void ml_out_unit(const Args& a, unsigned char* lds_g, int u, int tid) {
    const int L = u & 7, h = (u >> 3) & 7, b = u >> 6;
    const int rowbase = NCTX + b * SEQ + 256 * L;
    const int lane = tid & 63, w = __builtin_amdgcn_readfirstlane(tid >> 6), fr = lane & 15, fq = lane >> 4;
    bf16* CB = (bf16*)(lds_g + ML_CB);
    ml_gates(a, lds_g, rowbase, h, tid);
    f32x4 st[9];
#pragma unroll
    for (int dir = 0; dir < 2; ++dir) {
        const int seq = (b * 8 + h) * 2 + dir, jmax = dir ? 7 - L : L;
        const float* BT = (const float*)(a.ws + WS_BT) + seq * 8;
        {
            const pg8::u32x2* SLa = (const pg8::u32x2*)(a.ws + WS_SLOC) + ((size_t)((seq * 8 + jmax) * 8 + w) * 9) * 64 + lane;
            const pg8::u32x2* SLb = (const pg8::u32x2*)(a.ws + WS_SLOC) + ((size_t)((seq * 8 + 3) * 8 + w) * 9) * 64 + lane;
            pg8::u32x2 sa[9];
            if (jmax >= 4) {
                pg8::u32x2 sb[9];
#pragma unroll
                for (int vt = 0; vt < 9; ++vt) { sa[vt] = SLa[vt * 64]; sb[vt] = SLb[vt * 64]; }
                float ls = 0.f;
#pragma unroll
                for (int q = 4; q < 8; ++q) ls += (q <= jmax) ? BT[q] : 0.f;
                const float coef = __expf(ls);
#pragma unroll
                for (int vt = 0; vt < 9; ++vt) st[vt] = (f32x4){bflo(sa[vt].x) + bflo(sb[vt].x) * coef, bfhi(sa[vt].x) + bfhi(sb[vt].x) * coef, bflo(sa[vt].y) + bflo(sb[vt].y) * coef, bfhi(sa[vt].y) + bfhi(sb[vt].y) * coef};
            } else {
#pragma unroll
                for (int vt = 0; vt < 9; ++vt) { sa[vt] = SLa[vt * 64]; st[vt] = (f32x4){bflo(sa[vt].x), bfhi(sa[vt].x), bflo(sa[vt].y), bfhi(sa[vt].y)}; }
            }
        }
#pragma unroll
        for (int vt = 0; vt < 9; ++vt) { pg8::u32x2 o; o.x = pk2(st[vt][0], st[vt][1]); o.y = pk2(st[vt][2], st[vt][3]); *(pg8::u32x2*)(CB + (16 * vt + fr) * ML_STRIDE + 16 * w + 4 * fq) = o; }
        WG_BAR();
        if (dir == 0) ml_block<true, false>(a, lds_g, rowbase, h, 0, st, tid);
        else ml_block<true, true>(a, lds_g, rowbase, h, 1, st, tid);
        asm volatile("s_waitcnt vmcnt(0)" ::: "memory");
        WG_BAR();
    }
}

__device__ __forceinline__ void lru_out_unit(const Args& a, unsigned char* lds_g, int b, int cidx, int blk, int tid) {
    const int chl = tid & 127, q = tid >> 7, ch = blk * 128 + chl;
    float2* QA = (float2*)lds_g;
    float av[2][16], bv[2][16];
#pragma unroll
    for (int d = 0; d < 2; ++d) { const unsigned* PS = (const unsigned*)(a.ws + WS_PS) + ((size_t)(b * 2 + d) * NSTEP + 64 * cidx + 16 * q) * 1024 + ch;
#pragma unroll
        for (int i = 0; i < 16; ++i) { const unsigned wv = PS[(size_t)i * 1024]; av[d][i] = 1.f - bflo(wv); bv[d][i] = bfhi(wv); } }
    float2* CA = (float2*)(lds_g + 8192);
#pragma unroll
    for (int d = 0; d < 2; ++d) { const float2* AGG = (const float2*)(a.ws + WS_AGG) + ((size_t)(b * 2 + d) * 36) * 1024 + ch; float2 qv[9];
#pragma unroll
        for (int i = 0; i < 9; ++i) { const int sidx = 9 * q + i; const int c2 = d ? (sidx < 4 ? 3 - sidx : 39 - sidx) : sidx; qv[i] = AGG[(size_t)c2 * 1024]; }
        float P = 1.f, S = 0.f;
#pragma unroll
        for (int i = 0; i < 9; ++i) { const int sidx = 9 * q + i; const int c2 = d ? (sidx < 4 ? 3 - sidx : 39 - sidx) : sidx; const bool use = d ? (sidx < 4 || c2 > cidx) : (c2 < cidx);
            S = use ? qv[i].x * S + qv[i].y : S; P = use ? qv[i].x * P : P; }
        CA[(d * 4 + q) * 128 + chl] = make_float2(P, S); }
#pragma unroll
    for (int d = 0; d < 2; ++d) { float P = 1.f, S = 0.f;
#pragma unroll
        for (int ii = 0; ii < 16; ++ii) { const int i = d ? 15 - ii : ii; S = av[d][i] * S + bv[d][i]; P = av[d][i] * P; }
        QA[(d * 4 + q) * 128 + chl] = make_float2(P, S); }
    WG_BAR();
    float hs[16];
#pragma unroll
    for (int d = 0; d < 2; ++d) { float h = 0.f;
#pragma unroll
        for (int k = 0; k < 4; ++k) { const float2 t = CA[(d * 4 + k) * 128 + chl]; h = t.x * h + t.y; }
#pragma unroll
        for (int k = 0; k < 3; ++k) { const int qq = d ? 3 - k : k; const bool use = d ? (qq > q) : (qq < q); const float2 t = QA[(d * 4 + qq) * 128 + chl]; h = use ? t.x * h + t.y : h; }
#pragma unroll
        for (int ii = 0; ii < 16; ++ii) { const int i = d ? 15 - ii : ii; h = av[d][i] * h + bv[d][i]; if (d == 0) hs[i] = h; else hs[i] += h; } }
    const int p0 = (cidx - 4) * 64 + 16 * q;
    unsigned short ugv[16];
#pragma unroll
    for (int i = 0; i < 16; ++i) ugv[i] = ((const bf16*)(a.ws + WS_UG))[(size_t)(lru_pos_row(b, false, p0 + i) - NCTX) * 1024 + ch];
#pragma unroll
    for (int i = 0; i < 16; ++i) { const size_t lrow = (size_t)(lru_pos_row(b, false, p0 + i) - NCTX) * 1024 + ch;
        ((bf16*)(a.ws + WS_YB))[lrow] = (bf16)f2bf(hs[i] * bf2f(ugv[i])); }
    WG_BAR();
}
__device__ __forceinline__ void phase3(const Args& a, unsigned char* lds_g, int tid) {
    {
        int q0 = (int)blockIdx.x, qstep = (int)gridDim.x;
        if (gridDim.x == 256) q0 = blockIdx.x >= 128 ? (int)blockIdx.x - 128 : 128;
        for (int qu = q0; qu < 128; qu += qstep) ml_state_quad(a, lds_g, qu, tid);
    }
    for (int u = blockIdx.x; u < 4 * 36 * 8; u += gridDim.x) { const int blk = u & 7, q = u >> 3; lru_unit<false>(a, lds_g, q / 36, q % 36, blk, tid); }
}

struct SchedProj {
    int G, c; const char *YA, *YB, *WA, *WB;
    __device__ __forceinline__ bool next(int i, pg8::Unit& u) const {
        const int tile = (i >> 1) * G + c, part = i & 1; if (tile >= 256) return false;
        int pm, pn; pg8::tile_order(tile, 32, 8, pm, pn);
        u.pm = pm; u.pn = pn; u.aux = part; u.A = (part ? YB : YA) + (size_t)pm * 256 * 1024 * 2; u.B = (part ? WB : WA) + (size_t)pn * 256 * 1024 * 2; return true;
    }
};
struct EpiProj {
    static constexpr bool PERM = true, CARRY = true;
    const bf16 *GA, *GB; bf16* PRE;
    __device__ __forceinline__ bool keep(const pg8::Unit& u) const { return u.aux == 0; }
    __device__ __forceinline__ void operator()(pg8::f32x4 (&acc)[2][2][4][2], const pg8::Unit& u, int wr, int wc, int fr, int fq) const {
#pragma unroll
        for (int ai = 0; ai < 2; ++ai) {
            pg8::u32x4 gb4[4][2], ga4[4][2];
#pragma unroll
            for (int m = 0; m < 4; ++m) { const size_t off = (size_t)(u.pm * 256 + ai * 128 + wr * 64 + m * 16 + fr) * 2048 + u.pn * 256 + wc * 32 + 8 * fq;
#pragma unroll
                for (int bj = 0; bj < 2; ++bj) { gb4[m][bj] = *(const pg8::u32x4*)(GB + off + bj * 128); if (u.aux == 0) ga4[m][bj] = *(const pg8::u32x4*)(GA + off + bj * 128); } }
#pragma unroll
            for (int m = 0; m < 4; ++m) { const size_t off = (size_t)(u.pm * 256 + ai * 128 + wr * 64 + m * 16 + fr) * 2048 + u.pn * 256 + wc * 32 + 8 * fq;
#pragma unroll
                for (int bj = 0; bj < 2; ++bj) { const pg8::u32x4 g4 = gb4[m][bj];
                    const float gbv[8] = {bflo(g4.x), bfhi(g4.x), bflo(g4.y), bfhi(g4.y), bflo(g4.z), bfhi(g4.z), bflo(g4.w), bfhi(g4.w)};
                    if (u.aux == 0) { const pg8::u32x4 a4 = ga4[m][bj];
                        const float gav[8] = {bflo(a4.x), bfhi(a4.x), bflo(a4.y), bfhi(a4.y), bflo(a4.z), bfhi(a4.z), bflo(a4.w), bfhi(a4.w)};
#pragma unroll
                        for (int e = 0; e < 4; ++e) { acc[ai][bj][m][0][e] *= gav[e] * __builtin_amdgcn_rcpf(fmaxf(gbv[e], 1e-20f)); acc[ai][bj][m][1][e] *= gav[4 + e] * __builtin_amdgcn_rcpf(fmaxf(gbv[4 + e], 1e-20f)); }
                    } else {
                        pg8::f32x4 v0 = acc[ai][bj][m][0], v1 = acc[ai][bj][m][1];
#pragma unroll
                        for (int e = 0; e < 4; ++e) { v0[e] *= gbv[e]; v1[e] *= gbv[4 + e]; }
                        pg8::u32x4 w; w.x = pg8::cvt_pk_bf16(v0[0], v0[1]); w.y = pg8::cvt_pk_bf16(v0[2], v0[3]); w.z = pg8::cvt_pk_bf16(v1[0], v1[1]); w.w = pg8::cvt_pk_bf16(v1[2], v1[3]);
                        *(pg8::u32x4*)(PRE + off + bj * 128) = w; } } }
        }
    }
};

struct SchedOut {
    int G, c; const char *A, *B;
    __device__ __forceinline__ bool next(int i, pg8::Unit& u) const {
        const int L = i * G + c; if (L >= 256) return false;
        int pm, pn; pg8::tile_order(L, 32, 8, pm, pn);
        u.pm = pm; u.pn = pn; u.aux = 0; u.A = A + (size_t)pm * 256 * D * 2; u.B = B + (size_t)pn * 256 * D * 2; return true;
    }
};
struct EpiOut {
    static constexpr bool PERM = true, CARRY = false;
    __device__ __forceinline__ bool keep(const pg8::Unit&) const { return false; }
    const float* x; const float* MOD; bf16* X1;
    __device__ __forceinline__ void operator()(const pg8::f32x4 (&acc)[2][2][4][2], const pg8::Unit& u, int wr, int wc, int fr, int fq) const {
        const int b = u.pm >> 3; const int col0 = u.pn * 256 + wc * 32 + 8 * fq;
        pg8::f32x4 g1[2][2];
#pragma unroll
        for (int bj = 0; bj < 2; ++bj)
#pragma unroll
            for (int n = 0; n < 2; ++n) g1[bj][n] = *(const pg8::f32x4*)(MOD + b * 12288 + 2 * 2048 + col0 + bj * 128 + n * 4);
#pragma unroll
        for (int ai = 0; ai < 2; ++ai) {
            pg8::f32x4 xv[4][2][2];
#pragma unroll
            for (int m = 0; m < 4; ++m) { const size_t off = (size_t)(u.pm * 256 + ai * 128 + wr * 64 + m * 16 + fr) * D + col0;
#pragma unroll
                for (int bj = 0; bj < 2; ++bj)
#pragma unroll
                    for (int n = 0; n < 2; ++n) xv[m][bj][n] = *(const pg8::f32x4*)(x + off + bj * 128 + n * 4); }
#pragma unroll
            for (int m = 0; m < 4; ++m) { const size_t off = (size_t)(u.pm * 256 + ai * 128 + wr * 64 + m * 16 + fr) * D + col0;
#pragma unroll
                for (int bj = 0; bj < 2; ++bj) { const pg8::f32x4 v0 = xv[m][bj][0] + g1[bj][0] * acc[ai][bj][m][0], v1 = xv[m][bj][1] + g1[bj][1] * acc[ai][bj][m][1];
                    pg8::u32x4 w; w.x = pg8::cvt_pk_bf16(v0[0], v0[1]); w.y = pg8::cvt_pk_bf16(v0[2], v0[3]); w.z = pg8::cvt_pk_bf16(v1[0], v1[1]); w.w = pg8::cvt_pk_bf16(v1[2], v1[3]);
                    *(pg8::u32x4*)(X1 + off + bj * 128) = w; } }
        }
    }
};

__device__ __forceinline__ void phase_router(const Args& a, unsigned char* lds_g, int tid, int lane, int wave) {
    const bf16* X1 = (const bf16*)(a.ws + WS_X1); const float* MOD = (const float*)(a.ws + WS_MOD); const float* g = a.in[I_N2G];
    const float* WR = (const float*)(a.ws + WS_WR); const float* RB = (const float*)(a.ws + WS_RB);
    bf16* H2 = (bf16*)(a.ws + WS_H2); unsigned* cnt = (unsigned*)(a.ws + WS_CTL) + CW_CNT; int4* ASG = (int4*)(a.ws + WS_ASG);
    f32x4* PART = (f32x4*)lds_g;
    float* SSQP = (float*)(lds_g + 24576);
    float* RS = (float*)(lds_g + 24576 + 512);
    float* LG = (float*)(lds_g + 24576 + 1024);
    const int slot = wave >> 2, kq = wave & 3, i = lane & 15, gq = lane >> 4;
    for (int tp = blockIdx.x; tp < NLAT / 32; tp += gridDim.x) {
        const int tok0 = 32 * tp + 16 * slot, b = tok0 >> 11, kbase = kq * 512 + 8 * gq;
        const bf16* xr = X1 + (size_t)(tok0 + i) * D + kbase;
        const float* wr = WR + ((size_t)(b * 48 + i) * 2048 + kbase);
        f32x4 acc0 = (f32x4){0.f, 0.f, 0.f, 0.f}, acc1 = acc0, acc2 = acc0; float sq = 0.f;
#pragma unroll 2
        for (int s8 = 0; s8 < 16; ++s8) {
            const v4u xb = *(const v4u*)(xr + 32 * s8);
            const f32x4 b0a = *(const f32x4*)(wr + 32 * s8), b0b = *(const f32x4*)(wr + 32 * s8 + 4), b1a = *(const f32x4*)(wr + 16 * 2048 + 32 * s8), b1b = *(const f32x4*)(wr + 16 * 2048 + 32 * s8 + 4),
                        b2a = *(const f32x4*)(wr + 32 * 2048 + 32 * s8), b2b = *(const f32x4*)(wr + 32 * 2048 + 32 * s8 + 4);
            const float xe[8] = {bflo(xb.x), bfhi(xb.x), bflo(xb.y), bfhi(xb.y), bflo(xb.z), bfhi(xb.z), bflo(xb.w), bfhi(xb.w)};
#pragma unroll
            for (int e = 0; e < 4; ++e) { acc0 = __builtin_amdgcn_mfma_f32_16x16x4f32(xe[e], b0a[e], acc0, 0, 0, 0); acc1 = __builtin_amdgcn_mfma_f32_16x16x4f32(xe[e], b1a[e], acc1, 0, 0, 0); acc2 = __builtin_amdgcn_mfma_f32_16x16x4f32(xe[e], b2a[e], acc2, 0, 0, 0); }
#pragma unroll
            for (int e = 0; e < 4; ++e) { acc0 = __builtin_amdgcn_mfma_f32_16x16x4f32(xe[4 + e], b0b[e], acc0, 0, 0, 0); acc1 = __builtin_amdgcn_mfma_f32_16x16x4f32(xe[4 + e], b1b[e], acc1, 0, 0, 0); acc2 = __builtin_amdgcn_mfma_f32_16x16x4f32(xe[4 + e], b2b[e], acc2, 0, 0, 0); }
#pragma unroll
            for (int e = 0; e < 8; ++e) sq += xe[e] * xe[e];
        }
        sq += __shfl_xor(sq, 16); sq += __shfl_xor(sq, 32);
        PART[((slot * 4 + kq) * 3 + 0) * 64 + lane] = acc0; PART[((slot * 4 + kq) * 3 + 1) * 64 + lane] = acc1; PART[((slot * 4 + kq) * 3 + 2) * 64 + lane] = acc2;
        if (gq == 0) SSQP[(slot * 4 + kq) * 16 + i] = sq;
        __syncthreads();
        if (kq == 0) {
            const float* sp = SSQP + slot * 64; const float rstd = 1.f / sqrtf(((sp[i] + sp[16 + i]) + (sp[32 + i] + sp[48 + i])) * (1.f / D) + EPS);
            if (gq == 0) RS[slot * 16 + i] = rstd;
#pragma unroll
            for (int cb = 0; cb < 3; ++cb) { const f32x4* pp = PART + (slot * 4 * 3 + cb) * 64 + lane; const f32x4 sum = (pp[0] + pp[3 * 64]) + (pp[6 * 64] + pp[9 * 64]);
                const float rb = RB[b * 48 + 16 * cb + i];
#pragma unroll
                for (int r = 0; r < 4; ++r) LG[(slot * 16 + 4 * gq + r) * 48 + 16 * cb + i] = __shfl(rstd, 4 * gq + r) * sum[r] + rb; }
            LDS_WAIT(); asm volatile("" ::: "memory");
            if (lane < 16) {
                const float* lg = LG + (slot * 16 + lane) * 48; const int t = tok0 + lane;
                int gs = 0; float gm = lg[32];
#pragma unroll
                for (int q = 1; q < 4; ++q) { const float v = lg[32 + q]; if (v > gm) { gm = v; gs = q; } }
                float se = 0.f;
#pragma unroll
                for (int q = 0; q < 4; ++q) se += __expf(lg[32 + q] - gm);
                const float pg = 1.f / se;
                int i0 = 0; float v0 = lg[gs * 8];
#pragma unroll
                for (int q = 1; q < 8; ++q) { const float v = lg[gs * 8 + q]; if (v > v0) { v0 = v; i0 = q; } }
                int i1 = -1; float v1 = -3.0e38f;
#pragma unroll
                for (int q = 0; q < 8; ++q) { const float v = lg[gs * 8 + q]; if (q != i0 && v > v1) { v1 = v; i1 = q; } }
                const float e1 = __expf(v1 - v0), w0 = pg / (1.f + e1), w1 = pg * e1 / (1.f + e1);
                const int ex0 = gs * 8 + i0, ex1 = gs * 8 + i1;
                const unsigned p0 = atomicAdd(cnt + ex0, 1u), p1 = atomicAdd(cnt + ex1, 1u);
                ASG[2 * t] = make_int4(ex0, (int)p0, __float_as_int(w0), 0); ASG[2 * t + 1] = make_int4(ex1, (int)p1, __float_as_int(w1), 0);
                int* LIST = (int*)(a.ws + WS_LIST); LIST[ex0 * 8192 + (int)p0] = t; LIST[ex1 * 8192 + (int)p1] = t;
            }
        }
        __syncthreads();
#pragma unroll
        for (int r = 0; r < 4; ++r) { const int tl = 4 * kq + r, t = tok0 + tl; const float rstd = RS[slot * 16 + tl];
            const unsigned long long* xrow = (const unsigned long long*)(X1 + (size_t)t * D) + lane; unsigned* o4 = (unsigned*)((unsigned char*)H2 + (size_t)t * D) + lane;
            f32x4 yv[8];
#pragma unroll
            for (int j = 0; j < 8; ++j) { const int c = 4 * lane + 256 * j;
                const f32x4 gg = *(const f32x4*)(g + c), sh = *(const f32x4*)(MOD + b * 12288 + 3 * 2048 + c), sc = *(const f32x4*)(MOD + b * 12288 + 4 * 2048 + c);
                const unsigned long long xw = xrow[64 * j]; const f32x4 xv4 = (f32x4){bflo((unsigned)xw), bfhi((unsigned)xw), bflo((unsigned)(xw >> 32)), bfhi((unsigned)(xw >> 32))};
                yv[j] = xv4 * rstd * gg * (sc + 1.f) + sh; }
#pragma unroll
            for (int j = 0; j < 8; ++j) { int w8 = __builtin_amdgcn_cvt_pk_fp8_f32(yv[j].x, yv[j].y, 0, false); w8 = __builtin_amdgcn_cvt_pk_fp8_f32(yv[j].z, yv[j].w, w8, true); o4[64 * j] = (unsigned)w8; } }
        __syncthreads();
    }
}

constexpr int MG_A = 0, MG_ABYTES = 32768, MG_B = 65536, MG_BBYTES = 64 * 256  , MG_CUM = 141312  ;
__device__ __forceinline__ int mgb_off(int row, int ch) { return 256 * row + 16 * (ch ^ (((row & 3) << 2) | ((row >> 2) & 3))); }
__device__ __forceinline__ bf16x8_t mgb_frag(const unsigned char* img, int ks, int c, int lane) {
    const int g = lane >> 4, q = (lane & 15) >> 2, p = lane & 3;
    const s4_t lo = ds_tr((const bf16*)(img + mgb_off(32 * ks + 8 * g + q, 2 * c + (p >> 1)) + 8 * (p & 1)));
    const s4_t hi = ds_tr((const bf16*)(img + mgb_off(32 * ks + 8 * g + 4 + q, 2 * c + (p >> 1)) + 8 * (p & 1)));
    return (bf16x8_t){lo.x, lo.y, lo.z, lo.w, hi.x, hi.y, hi.z, hi.w};
}
__device__ __forceinline__ void moe_tables(const Args& a, unsigned char* lds_g, int tid) {
    int* cum = (int*)(lds_g + MG_CUM); const unsigned* ctl = (const unsigned*)(a.ws + WS_CTL);
    if (tid < NEXP) cum[128 + tid] = (int)ctl[CW_CNT + tid];
    if (tid == 0) { int c = 0; for (int e = 0; e < NEXP; ++e) { cum[e] = c; c += (int)((ctl[CW_CNT + e] + 255u) >> 8); } cum[NEXP] = c; }
    __syncthreads();
}
constexpr int MH_A = 0, MH_ABYTES = 32768, MH_B = 65536, MH_BROW = 528, MH_BBYTES = 64 * MH_BROW  ;
__device__ __forceinline__ int mhb_off(int row, int ch) { return MH_BROW * row + 16 * ch; }
__device__ __forceinline__ bf16x8_t mhb_frag(const LAS unsigned char* lbase, int cofs) {
    const s4_t lo = __builtin_amdgcn_ds_read_tr16_b64_v4i16((LAS s4_t*)(lbase + cofs));
    const s4_t hi = __builtin_amdgcn_ds_read_tr16_b64_v4i16((LAS s4_t*)(lbase + cofs + MH_BROW));
    return (bf16x8_t){lo.x, lo.y, lo.z, lo.w, hi.x, hi.y, hi.z, hi.w};
}
__device__ __forceinline__ int fresh_lane() { int l; asm volatile("v_mbcnt_lo_u32_b32 %0, -1, 0\n\tv_mbcnt_hi_u32_b32 %0, -1, %0" : "=v"(l)); __builtin_assume(l >= 0 && l < 64); return l; }
__device__ __forceinline__ int moe_pull(const Args& a, unsigned char* lds_g, int w, int x) {
    int* slot = (int*)(lds_g + MG_CUM + 256);
    __syncthreads();
    if (w == 0 && fresh_lane() == 0) *slot = (int)__hip_atomic_fetch_add((unsigned*)(a.ws + WS_CTL) + CW_Q + 64 * x, 1u, __ATOMIC_RELAXED, __HIP_MEMORY_SCOPE_AGENT);
    __syncthreads();
    return __builtin_amdgcn_readfirstlane(*slot);
}
__device__ __forceinline__ unsigned f8pair_lo(unsigned w) { const auto v = __builtin_amdgcn_cvt_pk_f32_fp8((int)w, false); return pk2(v[0], v[1]); }
__device__ __forceinline__ unsigned f8pair_hi(unsigned w) { const auto v = __builtin_amdgcn_cvt_pk_f32_fp8((int)w, true); return pk2(v[0], v[1]); }
template <int MODE>
__device__ __forceinline__ int moe_gemm(const Args& a, unsigned char* lds_g, int tid, int idx0) {
    constexpr int K = MODE == 1 ? D : DE, NT = K / 64;
#define MG_BAR() do { asm volatile("s_waitcnt lgkmcnt(0)" ::: "memory"); __builtin_amdgcn_s_barrier(); asm volatile("" ::: "memory"); } while (0)
    const int w = __builtin_amdgcn_readfirstlane(tid >> 6);
    const int wm = w >> 1, wn = w & 1, hh = wm >> 1, wr = wm & 1;
    const int* cum = (const int*)(lds_g + MG_CUM); const unsigned* ctl = (const unsigned*)(a.ws + WS_CTL);
    const int T = cum[NEXP], x = blockIdx.x & 7;
    for (int idx = idx0;;) {
        if (idx < 0) idx = moe_pull(a, lds_g, w, x);
        if (idx >= (MODE == 1 ? T : 2 * T)) return idx;
        const int ti = MODE == 1 ? idx : idx - T;
        idx = -1;
        const int nt = x;
        if (MODE == 2) {
            if (w == 0) { unsigned* tc = (unsigned*)(a.ws + WS_CTL) + CW_TC + 64 * ti; unsigned spins = 0;
                while ((unsigned)__builtin_amdgcn_readfirstlane(__hip_atomic_load(tc, __ATOMIC_RELAXED, __HIP_MEMORY_SCOPE_AGENT)) < 64u) {
                    __builtin_amdgcn_s_sleep(2);
                    if (++spins > (1u << 22)) { if (fresh_lane() == 0) __hip_atomic_store((unsigned*)(a.ws + WS_CTL) + 1, 0x900u + (unsigned)ti, __ATOMIC_RELAXED, __HIP_MEMORY_SCOPE_AGENT); break; } }
                __builtin_amdgcn_fence(__ATOMIC_ACQUIRE, "agent");
                asm volatile("s_waitcnt vmcnt(0)" ::: "memory"); }
            __syncthreads();
        }
        const int lane = fresh_lane(), tidu = w * 64 + lane, fr = lane & 15, fq = lane >> 4;
        const int aoff = pg8::lds_byte(wr * 64 + fr, fq * 8);
        const int bk = w, bp = lane;
        int e = 0;
#pragma unroll 1
        for (int q = 1; q < NEXP; ++q) e = (cum[q] <= ti) ? q : e;
        e = __builtin_amdgcn_readfirstlane(e);
        const int mt = __builtin_amdgcn_readfirstlane(ti - cum[e]);
        unsigned aofs[4]; unsigned bofs; int bwr0;
        __amdgpu_buffer_rsrc_t rsA, rsB, rsB3;
        if (MODE == 1) { const int cnt = cum[128 + e];
#pragma unroll
            for (int q = 0; q < 2; ++q) { const int pos = 256 * mt + 128 * q + (tidu >> 2); const int tok = pos < cnt ? ((const int*)(a.ws + WS_LIST))[e * 8192 + pos] : 0;
                aofs[q] = (unsigned)(tok * D + 16 * (tidu & 3)); }
            aofs[2] = aofs[3] = 0u;
            rsA = __builtin_amdgcn_make_buffer_rsrc((void*)(a.ws + WS_H2), 0, 0x7fffffff, 0x00020000);
            rsB = __builtin_amdgcn_make_buffer_rsrc((void*)(a.in[I_W1] + (size_t)e * D * DE), 0, 0x7fffffff, 0x00020000); rsB3 = __builtin_amdgcn_make_buffer_rsrc((void*)(a.in[I_W3] + (size_t)e * D * DE), 0, 0x7fffffff, 0x00020000);
            bofs = (unsigned)((bk + 8 * (bp >> 5)) * DE + 128 * nt + 4 * (bp & 31)) * 4u;
            bwr0 = MH_BROW * (2 * (bk & 3) + (bk >> 2) + 8 * (bp >> 5)) + 2 * (128 * ((bp & 31) >> 4) + 4 * (bp & 15)); }
        else {
#pragma unroll
            for (int q = 0; q < 2; ++q) aofs[q] = (unsigned)((128 * q + (tidu >> 2)) * DE + 16 * (tidu & 3));
            aofs[2] = aofs[3] = 0u;
            rsA = __builtin_amdgcn_make_buffer_rsrc((void*)((const unsigned char*)(a.ws + WS_HM) + (size_t)256 * ti * DE), 0, 0x7fffffff, 0x00020000);
            rsB = __builtin_amdgcn_make_buffer_rsrc((void*)(a.in[I_W2] + (size_t)e * DE * D), 0, 0x7fffffff, 0x00020000); rsB3 = rsB;
            bofs = (unsigned)(bk * D + 256 * nt + 4 * bp) * 4u; bwr0 = MH_BROW * (2 * (bk & 3) + (bk >> 2)) + 2 * (128 * (bp >> 5) + 32 * ((bp & 31) >> 3) + 16 * (bp & 1) + 4 * ((bp >> 1) & 3)); }
        const LAS unsigned char* blane = (const LAS unsigned char*)lds_g + MH_B + mhb_off(16 * (lane >> 5) + 8 * ((lane >> 4) & 1) + 2 * ((lane & 15) >> 2), 16 * wn + ((lane & 3) >> 1)) + 8 * (lane & 1);
        f32x4 acc[4][8];
#pragma unroll
        for (int m = 0; m < 4; ++m)
#pragma unroll
            for (int n = 0; n < 8; ++n) acc[m][n] = (f32x4){0.f, 0.f, 0.f, 0.f};
        v4u ra[4]; f32x4 rb[8];
#define MH_MMA(buf_) do { const LAS unsigned char* Bi_ = blane + (buf_) * MH_BBYTES; \
        bf16x8_t bc0_ = mhb_frag(Bi_, 0), bc1_ = mhb_frag(Bi_, 32); \
        _Pragma("unroll") for (int ks_ = 0; ks_ < 2; ++ks_) { bf16x8_t af_[4]; \
            _Pragma("unroll") for (int m_ = 0; m_ < 4; ++m_) af_[m_] = *(const bf16x8_t*)(lds_g + MH_A + (buf_) * MH_ABYTES + hh * 16384 + aoff + m_ * 2048 + ks_ * 1024); \
            _Pragma("unroll") for (int n_ = 0; n_ < 8; n_ += 2) { bf16x8_t bn0_ = bc0_, bn1_ = bc1_; \
                if (n_ + 2 < 8) { bn0_ = mhb_frag(Bi_, 32 * ks_ * MH_BROW + 32 * (n_ + 2)); bn1_ = mhb_frag(Bi_, 32 * ks_ * MH_BROW + 32 * (n_ + 3)); } \
                else if (ks_ == 0) { bn0_ = mhb_frag(Bi_, 32 * MH_BROW); bn1_ = mhb_frag(Bi_, 32 * MH_BROW + 32); } \
                __builtin_amdgcn_sched_barrier(0); \
                _Pragma("unroll") for (int m_ = 0; m_ < 4; ++m_) { acc[m_][n_] = __builtin_amdgcn_mfma_f32_16x16x32_bf16(bc0_, af_[m_], acc[m_][n_], 0, 0, 0); \
                    acc[m_][n_ + 1] = __builtin_amdgcn_mfma_f32_16x16x32_bf16(bc1_, af_[m_], acc[m_][n_ + 1], 0, 0, 0); } \
                __builtin_amdgcn_sched_barrier(0); bc0_ = bn0_; bc1_ = bn1_; } } } while (0)
        {
            const int awr = pg8::lds_byte(tidu >> 2, 16 * (tidu & 3));
#define MH_LDB(t_) do { _Pragma("unroll") for (int j_ = 0; j_ < 8; ++j_) rb[j_] = __builtin_bit_cast(f32x4, MODE == 1 ? __builtin_amdgcn_raw_buffer_load_b128((j_ & 1) ? rsB3 : rsB, bofs, (64 * (t_) + 16 * (j_ >> 1)) * DE * 4, 0) \
                                                                                                   : __builtin_amdgcn_raw_buffer_load_b128(rsB, bofs, (64 * (t_) + 8 * j_) * D * 4, 0)); } while (0)
#define MH_LDA(te_, to_) do { ra[0] = __builtin_amdgcn_raw_buffer_load_b128(rsA, aofs[0], 64 * (te_), 0); ra[1] = __builtin_amdgcn_raw_buffer_load_b128(rsA, aofs[1], 64 * (te_), 0); \
            ra[2] = __builtin_amdgcn_raw_buffer_load_b128(rsA, aofs[0], 64 * (to_), 0); ra[3] = __builtin_amdgcn_raw_buffer_load_b128(rsA, aofs[1], 64 * (to_), 0); } while (0)
#define MH_F8(w_) f8pair_lo(w_), f8pair_hi(w_)
#define MH_STA(buf_, x_) do { _Pragma("unroll") for (int h_ = 0; h_ < 2; ++h_) { const v4u p_ = ra[(x_) + h_]; \
            *(v4u*)(lds_g + MH_A + (buf_) * MH_ABYTES + h_ * 16384 + awr) = (v4u){MH_F8(p_.x), MH_F8(p_.y)}; __builtin_amdgcn_sched_barrier(0); \
            *(v4u*)(lds_g + MH_A + (buf_) * MH_ABYTES + h_ * 16384 + awr + 16) = (v4u){MH_F8(p_.z), MH_F8(p_.w)}; __builtin_amdgcn_sched_barrier(0); } } while (0)
#define MH_STB(buf_) do { _Pragma("unroll") for (int j_ = 0; j_ < 8; ++j_) { pg8::u32x2 o_; o_.x = pk2(rb[j_].x, rb[j_].y); o_.y = pk2(rb[j_].z, rb[j_].w); \
            *(pg8::u32x2*)(lds_g + MH_B + (buf_) * MH_BBYTES + bwr0 + (MODE == 1 ? (j_ >> 1) * 16 * MH_BROW + (j_ & 1) * 128 : j_ * 8 * MH_BROW)) = o_; } } while (0)
            MH_LDA(0, 1); MH_LDB(0);
            MG_BAR();
            MH_STA(0, 0); MH_STB(0);
            MH_LDB(1);
            for (int t = 0; t < NT; t += 2) {
                const int t2 = (t + 2 < NT) ? t + 2 : NT - 1, t3 = (t + 3 < NT) ? t + 3 : NT - 1;
                MG_BAR();
                MH_STA(1, 2); MH_STB(1);
                MH_LDA(t2, t3); MH_LDB(t2);
                MH_MMA(0);
                MG_BAR();
                MH_STA(0, 0); MH_STB(0);
                MH_LDB(t3);
                MH_MMA(1);
            }
#undef MH_LDB
#undef MH_LDA
#undef MH_F8
#undef MH_STA
#undef MH_STB
        }
#undef MH_MMA
        const int ln_ = fresh_lane();
        const int efr = ln_ & 15, efq = ln_ >> 4;
        if (MODE == 1) { unsigned char* HM = (unsigned char*)(a.ws + WS_HM) + (size_t)256 * ti * DE + 128 * nt + 64 * wn; const unsigned lo_ = (unsigned)((128 * hh + 64 * wr + efr) * DE + 4 * efq);
#pragma unroll
            for (int m = 0; m < 4; ++m)
#pragma unroll
                for (int n = 0; n < 4; ++n) { float hv[4];
#pragma unroll
                    for (int r = 0; r < 4; ++r) { const float a1 = acc[m][n][r]; hv[r] = a1 * sigmoidf_(a1) * acc[m][n + 4][r]; }
                    int w8 = __builtin_amdgcn_cvt_pk_fp8_f32(hv[0], hv[1], 0, false); w8 = __builtin_amdgcn_cvt_pk_fp8_f32(hv[2], hv[3], w8, true);
                    __hip_atomic_store((unsigned*)(HM + lo_ + 16 * m * DE + 16 * n), (unsigned)w8, __ATOMIC_RELAXED, __HIP_MEMORY_SCOPE_AGENT); }
            asm volatile("s_waitcnt vmcnt(0)" ::: "memory");
            if (ln_ == 0) __hip_atomic_fetch_add((unsigned*)(a.ws + WS_CTL) + CW_TC + 64 * ti, 1u, __ATOMIC_RELAXED, __HIP_MEMORY_SCOPE_AGENT); }
        else { bf16* Y2 = (bf16*)(a.ws + WS_Y2) + (size_t)256 * ti * D + 256 * nt + 128 * wn; const unsigned lo_ = (unsigned)((128 * hh + 64 * wr + efr) * D + 8 * efq);
#pragma unroll
            for (int m = 0; m < 4; ++m)
#pragma unroll
                for (int n = 0; n < 8; n += 2) { v4u o; o.x = pk2(acc[m][n][0], acc[m][n][1]); o.y = pk2(acc[m][n][2], acc[m][n][3]); o.z = pk2(acc[m][n + 1][0], acc[m][n + 1][1]); o.w = pk2(acc[m][n + 1][2], acc[m][n + 1][3]);
                    *(v4u*)(Y2 + lo_ + 16 * m * D + 16 * n) = o; } }
    }
#undef MG_BAR
}

__device__ __forceinline__ void phase12(const Args& a, unsigned char* lds_g, int lane, int wave) {
    const int gw = blockIdx.x * NWAVES + wave, NGW = gridDim.x * NWAVES;
    const int* cum = (const int*)(lds_g + MG_CUM);
    const bf16* X1 = (const bf16*)(a.ws + WS_X1); const float* MOD = (const float*)(a.ws + WS_MOD); const float* fg = a.in[I_FG];
    const int4* ASG = (const int4*)(a.ws + WS_ASG); const bf16* Y2 = (const bf16*)(a.ws + WS_Y2);
    for (int t = gw; t < NLAT; t += NGW) {
        const int b = t >> 11; const int4 q0 = ASG[2 * t], q1 = ASG[2 * t + 1];
        const float w0 = __int_as_float(q0.z), w1 = __int_as_float(q1.z);
        const unsigned long long* xr = (const unsigned long long*)(X1 + (size_t)t * D) + lane;
        const unsigned long long* y0 = (const unsigned long long*)(Y2 + (size_t)(256 * cum[q0.x] + q0.y) * D) + lane; const unsigned long long* y1 = (const unsigned long long*)(Y2 + (size_t)(256 * cum[q1.x] + q1.y) * D) + lane;
        f32x4 v[8]; float s = 0.f;
#pragma unroll
        for (int j = 0; j < 8; ++j) {
            const int c = 4 * lane + 256 * j;
            const f32x4 g2 = *(const f32x4*)(MOD + b * 12288 + 5 * 2048 + c);
            const unsigned long long a0 = y0[64 * j], a1 = y1[64 * j];
            f32x4 y; y.x = w0 * bflo((unsigned)a0) + w1 * bflo((unsigned)a1); y.y = w0 * bfhi((unsigned)a0) + w1 * bfhi((unsigned)a1);
            y.z = w0 * bflo((unsigned)(a0 >> 32)) + w1 * bflo((unsigned)(a1 >> 32)); y.w = w0 * bfhi((unsigned)(a0 >> 32)) + w1 * bfhi((unsigned)(a1 >> 32));
            const unsigned long long xw = xr[64 * j];
            v[j] = (f32x4){bflo((unsigned)xw), bfhi((unsigned)xw), bflo((unsigned)(xw >> 32)), bfhi((unsigned)(xw >> 32))} + g2 * y;
            s += (v[j].x * v[j].x + v[j].y * v[j].y) + (v[j].z * v[j].z + v[j].w * v[j].w);
        }
        const float rstd = 1.f / sqrtf(wave_sum(s) * (1.f / D) + EPS);
        f32x4* o = (f32x4*)(a.out + (size_t)t * D) + lane; f32x4 fgv[8];
#pragma unroll
        for (int j = 0; j < 8; ++j) fgv[j] = *(const f32x4*)(fg + 4 * lane + 256 * j);
#pragma unroll
        for (int j = 0; j < 8; ++j) o[64 * j] = v[j] * rstd * fgv[j];
    }
}

__global__ void __launch_bounds__(NTHR, 2) fwd_kernel(Args args) {
    extern __shared__ __attribute__((aligned(16))) unsigned char lds[];
    LAS unsigned char* ldsl = (LAS unsigned char*)lds;
    volatile LAS unsigned* MISC = (volatile LAS unsigned*)(ldsl + MISC_OFF);
    LAS unsigned* TL = (LAS unsigned*)(ldsl + LDSCTL_OFF);
    const int wave_s = __builtin_amdgcn_readfirstlane(threadIdx.x >> 6);
#define TID() make_tid(wave_s)
    { const int t0 = TID(); for (int u = t0; u < (LDS_BYTES - LDSCTL_OFF) / 4; u += NTHR) ((LAS unsigned*)(ldsl + LDSCTL_OFF))[u] = 0u; }
    __syncthreads();
    unsigned char* ws = args.ws;
    unsigned* ctl = (unsigned*)(ws + WS_CTL);
    XcdBarrier bar; bar.bar = ctl + CW_BAR; bar.x = 0; bar.st = nullptr;
    const bool one_launch = (args.ph_hi - args.ph_lo) > 1;
    if (one_launch) bar = xcd_barrier_post(ctl + CW_BAR, MISC + 8, TID());
    const int lo = args.ph_lo, hi = args.ph_hi;
#define IN(k) (lo <= (k) && (k) < hi)
#define SEAM(k) do { if (IN(k) && IN((k) + 1)) xcd_barrier(bar, TID()); } while (0)
    const int G = gridDim.x, c = blockIdx.x;

#define FRESH() const int tid = TID(), lane = tid & 63, wave = __builtin_amdgcn_readfirstlane(tid >> 6); (void)lane; (void)wave
#ifndef DUP_PHASE
#define DUP_PHASE (-1)
#endif
#define PH(k, ...) if (IN(k)) { _Pragma("unroll") for (int rep_ = 0; rep_ < ((DUP_PHASE) == (k) ? 2 : 1); ++rep_) { if (rep_) xcd_barrier(bar, TID()); __VA_ARGS__ } } SEAM(k);
    PH(0, { FRESH(); phase0(args, lds, tid, lane, wave); mod_wait(args, tid); phase1(args, lane, wave); })
    PH(1, {
        SchedIn S{G, c, (const char*)(ws + WS_H), (const char*)(ws + WS_WIN)}; EpiIn E{ws, args.in[I_BGATES]};
        pg8::gemm_phase<EpiIn, SchedIn>(ldsl, D, S, E, TID());
        { const int R_ = (1492 + G - 1) / G; int fi_ = 1492 - (R_ - 1) * G; if (fi_ >= G) fi_ = 0;
          if (c >= fi_) { FRESH(); late_prep(args, lds, (c - fi_) * NWAVES + wave, (G - fi_) * NWAVES, lane, wave); } } })
    PH(2, { FRESH(); phase3(args, lds, tid); })
    PH(3, { FRESH();
        for (int u = c; u < 256; u += G) ml_out_unit(args, lds, u, tid);
        for (int u = c; u < 4 * 32 * 8; u += G) { const int blk = u & 7, q = u >> 3; lru_out_unit(args, lds, q >> 5, 4 + (q & 31), blk, tid); } })
    PH(4, {
        SchedProj S{G, c, (const char*)(ws + WS_YA), (const char*)(ws + WS_YB), (const char*)(ws + WS_WPA), (const char*)(ws + WS_WPB)};
        EpiProj E{(const bf16*)(ws + WS_GA), (const bf16*)(ws + WS_GB), (bf16*)(ws + WS_PRE)};
        pg8::gemm_phase<EpiProj, SchedProj>(ldsl, 1024, S, E, TID()); })
    PH(5, {
        SchedOut S{G, c, (const char*)(ws + WS_PRE), (const char*)(ws + WS_WOUT)}; EpiOut E{args.in[I_X], (const float*)(ws + WS_MOD), (bf16*)(ws + WS_X1)};
        pg8::gemm_phase<EpiOut, SchedOut>(ldsl, D, S, E, TID()); })
    PH(6, { FRESH(); phase_router(args, lds, tid, lane, wave); })
    PH(7, { FRESH(); moe_tables(args, lds, tid); const int nx_ = moe_gemm<1>(args, lds, tid, -1); { const int tid2_ = TID(); (void)moe_gemm<2>(args, lds, tid2_, nx_); } })
    PH(8, { FRESH(); moe_tables(args, lds, tid); phase12(args, lds, lane, wave); })
#undef PH
#undef IN
#undef SEAM
}

extern "C" void kernel_launch(void* const* d_in, const int* in_sizes, int n_in, void* d_out, int out_size, void* d_ws, size_t ws_size, hipStream_t stream) {
    static int grid = 0;
    if (grid == 0) {
        if (n_in != 27 || out_size != NLAT * D || ws_size < WS_END) { fprintf(stderr, "kernel_launch: unexpected shapes (n_in %d, out %d, ws %zu)\n", n_in, out_size, ws_size); grid = -1; return; }
        int dev = 0, cus = 0, per_cu = 0;
        if (hipGetDevice(&dev) != hipSuccess || hipDeviceGetAttribute(&cus, hipDeviceAttributeMultiprocessorCount, dev) != hipSuccess) { grid = -1; return; }
        if (hipFuncSetAttribute((const void*)fwd_kernel, hipFuncAttributeMaxDynamicSharedMemorySize, LDS_BYTES) != hipSuccess) { fprintf(stderr, "kernel_launch: hipFuncSetAttribute failed\n"); grid = -1; return; }
        if (hipOccupancyMaxActiveBlocksPerMultiprocessor(&per_cu, (const void*)fwd_kernel, NTHR, LDS_BYTES) != hipSuccess || per_cu < 1) fprintf(stderr, "kernel_launch: occupancy query says %d\n", per_cu);
        (void)hipGetLastError();
        grid = cus;
    }
    if (grid < 0) return;
    (void)hipMemsetAsync((char*)d_ws + WS_CTL, 0, CTL_ZERO_BYTES, stream);
    Args a{};
    for (int i = 0; i < 27; ++i) a.in[i] = (const float*)d_in[i];
    a.out = (float*)d_out; a.ws = (unsigned char*)d_ws;
#if MK_ONE_LAUNCH
    a.ph_lo = 0; a.ph_hi = NPHASE;
    hipLaunchKernelGGL(fwd_kernel, dim3(grid), dim3(NTHR), LDS_BYTES, stream, a);
#else
    for (int p = 0; p < NPHASE; ++p) { a.ph_lo = p; a.ph_hi = p + 1; hipLaunchKernelGGL(fwd_kernel, dim3(grid), dim3(NTHR), LDS_BYTES, stream, a); }
#endif
}
```

```cpp
#include <hip/hip_runtime.h>
#include <cstdio>
#include <cstdint>

#ifndef MK_ONE_LAUNCH
#define MK_ONE_LAUNCH 1
#endif

namespace pg8 {
#define PG8_LAS __attribute__((address_space(3)))
typedef unsigned short bf16_t;
typedef short bf16x8 __attribute__((ext_vector_type(8)));
typedef float f32x4 __attribute__((ext_vector_type(4)));
typedef float f32x2 __attribute__((ext_vector_type(2)));
typedef unsigned u32x4 __attribute__((ext_vector_type(4)));
typedef unsigned u32x2 __attribute__((ext_vector_type(2)));
constexpr int BM = 256, BK = 64, HALF = 128, HTB = HALF * BK * 2  , STAGE_BYTES = 8 * HTB, NXCD = 8, WGM = 8;

__host__ __device__ __forceinline__ int lds_byte(int r, int c) { const int st = (r >> 4) * 2 + (c >> 5), rr = r & 15, cc = c & 31, ob = rr * 64 + cc * 2; return st * 1024 + (ob ^ (((ob >> 9) & 1) << 5)); }
__host__ __device__ __forceinline__ void stage_rc(int b, int& R, int& C) { const int st = b / 1024, sb = b % 1024, swz = sb ^ (((sb >> 9) & 1) << 5); R = (st >> 1) * 16 + swz / 64; C = (st & 1) * 32 + (swz % 64) / 2; }
__host__ __device__ __forceinline__ int perm32(int rho) { const int n = rho >> 4, i = rho & 15; return 8 * (i >> 2) + 4 * n + (i & 3); }

struct Unit { const char* A; const char* B; int pm, pn, aux; };

__host__ __device__ __forceinline__ void tile_order(int L, int nM, int nN, int& pm, int& pn) {
    const int nwg = nM * nN; int wgid = L;
    { const int q = nwg / NXCD, r = nwg % NXCD, xcd = wgid % NXCD, off = wgid / NXCD; wgid = (xcd < r ? xcd * (q + 1) : r * (q + 1) + (xcd - r) * q) + off; }
    const int nig = WGM * nN, gid = wgid / nig, fm = gid * WGM, gsz = (nM - fm) < WGM ? (nM - fm) : WGM;
    pm = fm + ((wgid % nig) % gsz); pn = (wgid % nig) / gsz;
}

typedef __bf16 bf16n2 __attribute__((ext_vector_type(2)));
__device__ __forceinline__ unsigned cvt_pk_bf16(float lo, float hi) { const f32x2 v = {lo, hi}; return __builtin_bit_cast(unsigned, __builtin_convertvector(v, bf16n2)); }

template <class Epi, class Sched>
__device__ __forceinline__ void gemm_phase(PG8_LAS unsigned char* lds, const int K, const Sched& S, const Epi& E, int tid) {
    const int wid = __builtin_amdgcn_readfirstlane(tid >> 6), lane = tid & 63, wr = wid >> 2, wc = wid & 3, fr = lane & 15, fq = lane >> 4;
    const int nt = K / BK;
    unsigned voffA[2], voffB[2];
#pragma unroll
    for (int i = 0; i < 2; ++i) { int R, C; stage_rc(tid * 16 + i * 8192, R, C); const int Rb = Epi::PERM ? ((R & ~31) + perm32(R & 31)) : R;
        voffA[i] = (unsigned)(R * K + C) * 2u; voffB[i] = (unsigned)(Rb * K + C) * 2u; }
    const size_t kstep = (size_t)(BK * 2);
    const size_t hstep = (size_t)HALF * K * 2;
    const unsigned ldsw = (unsigned)wid * 1024u;
    const int aoff = lds_byte(wr * 64 + fr, fq * 8), boff = lds_byte(wc * 32 + fr, fq * 8);
#define PG8_SA(b, h) (((b) * 2 + (h)) * HTB)
#define PG8_SB(b, h) ((4 + (b) * 2 + (h)) * HTB)
#define PG8_STAGE(bufoff, gbase, voff) do { _Pragma("unroll") for (int _i = 0; _i < 2; ++_i) \
        __builtin_amdgcn_global_load_lds((const unsigned*)((const char*)(gbase) + (voff)[_i]), (PG8_LAS unsigned*)(lds + (bufoff) + ldsw + _i * 8192), 16, 0, 0); } while (0)
#define PG8_LDA(dst, b, h) do { _Pragma("unroll") for (int m = 0; m < 4; ++m) _Pragma("unroll") for (int k = 0; k < 2; ++k) dst[m][k] = *(const PG8_LAS bf16x8*)(lds + PG8_SA(b, h) + aoff + m * 2048 + k * 1024); } while (0)
#define PG8_LDB(dst, b, h) do { _Pragma("unroll") for (int n = 0; n < 2; ++n) _Pragma("unroll") for (int k = 0; k < 2; ++k) dst[n][k] = *(const PG8_LAS bf16x8*)(lds + PG8_SB(b, h) + boff + n * 2048 + k * 1024); } while (0)
#define PG8_MMA(ai, bj, At, Bt) do { __builtin_amdgcn_s_setprio(1); _Pragma("unroll") for (int m = 0; m < 4; ++m) _Pragma("unroll") for (int n = 0; n < 2; ++n) _Pragma("unroll") for (int k = 0; k < 2; ++k) \
        acc[ai][bj][m][n] = __builtin_amdgcn_mfma_f32_16x16x32_bf16(Bt[n][k], At[m][k], acc[ai][bj][m][n], 0, 0, 0); __builtin_amdgcn_s_setprio(0); } while (0)
#define PG8_WAIT_V(n) asm volatile("s_waitcnt vmcnt(" #n ")" ::: "memory")
#define PG8_WAIT_L(n) asm volatile("s_waitcnt lgkmcnt(" #n ")" ::: "memory")
#define PG8_BAR __builtin_amdgcn_s_barrier()
#define PG8_SCHED __builtin_amdgcn_sched_barrier(0)
    Unit cur, nxt; int ui = 0;
    if (!S.next(0, cur)) return;
    f32x4 acc[2][2][4][2];
#pragma unroll
    for (int a = 0; a < 2; ++a)
#pragma unroll
        for (int b = 0; b < 2; ++b)
#pragma unroll
            for (int m = 0; m < 4; ++m)
#pragma unroll
                for (int n = 0; n < 2; ++n) acc[a][b][m][n] = (f32x4){0.f, 0.f, 0.f, 0.f};
    bf16x8 At[4][2], B0[2][2], B1[2][2];
    const char* cA = cur.A; const char* cB = cur.B;
    PG8_STAGE(PG8_SB(0, 0), cB, voffB); PG8_STAGE(PG8_SB(0, 1), cB + hstep, voffB); PG8_STAGE(PG8_SA(0, 0), cA, voffA); PG8_STAGE(PG8_SA(0, 1), cA + hstep, voffA);
    if (wr == 1) PG8_BAR;
    PG8_WAIT_V(2); PG8_BAR;
    PG8_STAGE(PG8_SB(1, 0), cB + kstep, voffB); PG8_STAGE(PG8_SA(1, 0), cA + kstep, voffA); PG8_STAGE(PG8_SB(1, 1), cB + hstep + kstep, voffB);
    PG8_WAIT_V(6); PG8_BAR;
    for (;;) {
        const bool has_next = S.next(ui + 1, nxt);
        const char* nA = has_next ? nxt.A : cA; const char* nB = has_next ? nxt.B : cB;
        for (int t = 0; t < nt; t += 2) {
            const bool last = (t == nt - 2);
            const char* a1 = cA + (size_t)(t + 1) * kstep;
            const char* a2 = last ? nA : cA + (size_t)(t + 2) * kstep; const char* b2 = last ? nB : cB + (size_t)(t + 2) * kstep;
            const char* a3 = a2 + kstep; const char* b3 = b2 + kstep;
            PG8_LDB(B0, 0, 0); PG8_LDB(B1, 0, 1); PG8_SCHED; PG8_LDA(At, 0, 0); PG8_STAGE(PG8_SA(1, 1), a1 + hstep, voffA);
            PG8_WAIT_V(8); PG8_WAIT_L(0); PG8_BAR; PG8_MMA(0, 0, At, B0); PG8_MMA(0, 1, At, B1); PG8_BAR; PG8_SCHED;
            PG8_LDA(At, 0, 1); PG8_STAGE(PG8_SB(0, 0), b2, voffB); PG8_STAGE(PG8_SB(0, 1), b2 + hstep, voffB); PG8_STAGE(PG8_SA(0, 0), a2, voffA);
            PG8_WAIT_V(8); PG8_WAIT_L(0); PG8_BAR; PG8_MMA(1, 0, At, B0); PG8_MMA(1, 1, At, B1); PG8_BAR; PG8_SCHED;
            PG8_LDB(B0, 1, 0); PG8_LDB(B1, 1, 1); PG8_SCHED; PG8_LDA(At, 1, 0); PG8_STAGE(PG8_SA(0, 1), a2 + hstep, voffA);
            PG8_WAIT_V(8); PG8_WAIT_L(0); PG8_BAR; PG8_MMA(0, 0, At, B0); PG8_MMA(0, 1, At, B1); PG8_BAR; PG8_SCHED;
            PG8_LDA(At, 1, 1); PG8_STAGE(PG8_SB(1, 0), b3, voffB); PG8_STAGE(PG8_SB(1, 1), b3 + hstep, voffB); PG8_STAGE(PG8_SA(1, 0), a3, voffA);
            PG8_WAIT_V(8); PG8_WAIT_L(0); PG8_BAR; PG8_MMA(1, 0, At, B0); PG8_MMA(1, 1, At, B1); PG8_BAR; PG8_SCHED;
        }
        if (wr == 0) PG8_BAR;
        { int fr_ = fr, fq_ = fq; asm volatile("" : "+v"(fr_), "+v"(fq_)); E(acc, cur, wr, wc, fr_, fq_); }
        if (!has_next) break;
        if (!(Epi::CARRY && E.keep(cur))) {
#pragma unroll
        for (int a = 0; a < 2; ++a)
#pragma unroll
            for (int b = 0; b < 2; ++b)
#pragma unroll
                for (int m = 0; m < 4; ++m)
#pragma unroll
                    for (int n = 0; n < 2; ++n) acc[a][b][m][n] = (f32x4){0.f, 0.f, 0.f, 0.f};
        }
        cur = nxt; cA = nA; cB = nB; ++ui;
        if (wr == 1) PG8_BAR;
    }
    PG8_WAIT_V(0);
    PG8_BAR;
#undef PG8_SA
#undef PG8_SB
#undef PG8_STAGE
#undef PG8_LDA
#undef PG8_LDB
#undef PG8_MMA
#undef PG8_WAIT_V
#undef PG8_WAIT_L
#undef PG8_BAR
#undef PG8_SCHED
}
}

constexpr int NWAVES = 8, NTHR = 512;
constexpr int D = 2048, NB = 4, SEQ = 2048, CTXL = 256, NCTX = NB * CTXL  , NLAT = NB * SEQ  , NTOK = NCTX + NLAT  ;
constexpr int NSTEP = CTXL + SEQ;
constexpr int HEADS = 8, HD = 128, MW = 1024, LW = 1024;
constexpr int NEXP = 32, DE = 1024;
constexpr int IN_DIM = 11296, NT_IN = 45;
constexpr float EPS = 1e-6f;
constexpr int MAXTILES = 96;
constexpr int NPHASE = 9;

constexpr size_t MiB = 1u << 20;
constexpr size_t WS_CTL = 0, CTL_ZERO_BYTES = 1 * MiB;
constexpr size_t WS_MOD = 1 * MiB;
constexpr size_t WS_GATES = 2 * MiB;
constexpr size_t WS_ASG = 4 * MiB + 512 * 1024;
constexpr size_t WS_LIST = 3 * MiB + 512 * 1024;
constexpr size_t WS_WR = 6 * MiB;
constexpr size_t WS_RB = 7 * MiB + 768 * 1024;
constexpr size_t WS_WL = 5 * MiB;
constexpr size_t WS_AGG = 978 * MiB;
constexpr size_t WS_WPA = 8 * MiB, WS_WPB = 12 * MiB, WS_WOUT = 16 * MiB, WS_WIN = 24 * MiB;
constexpr size_t WS_W13 = 72 * MiB, WS_W2 = 328 * MiB;
constexpr size_t WS_PS = 72 * MiB;
constexpr size_t WS_H = 456 * MiB;
constexpr size_t WS_K = 492 * MiB, WS_V = 510 * MiB, WS_UX = 528 * MiB;
constexpr size_t WS_Q = 546 * MiB, WS_OF = 562 * MiB, WS_OB = 578 * MiB, WS_UG = 594 * MiB;
constexpr size_t WS_GA = 610 * MiB, WS_GB = 642 * MiB;
constexpr size_t WS_LA = 674 * MiB, WS_LB = 746 * MiB;
constexpr size_t WS_HS = 818 * MiB, WS_TM = 882 * MiB;
constexpr size_t WS_YA = 946 * MiB, WS_YB = 962 * MiB;
constexpr size_t WS_BT = 982 * MiB;
constexpr size_t WS_SLOC = 984 * MiB;
constexpr size_t WS_END = 1022 * MiB;
constexpr size_t WS_PRE = WS_LA;
constexpr size_t WS_X1 = WS_LB;
constexpr size_t WS_H2 = WS_H;
constexpr size_t WS_XS = WS_K;
constexpr size_t WS_HM = 588 * MiB;
constexpr size_t WS_Y2 = WS_HS;
constexpr int CW_MODC = 32;
constexpr int CW_CNT = 64;
constexpr int CW_NT = 128;
constexpr int CW_TILE_E = 192;
constexpr int CW_BAR = 4096;
constexpr int CW_Q = 8192;
constexpr int CW_TC = 16384;

constexpr int RING_BYTES = 131072;
constexpr int LDSCTL_OFF = 143360;
constexpr int MISC_OFF = LDSCTL_OFF + 384;
constexpr int LDS_BYTES = 147456;

#define GAS __attribute__((address_space(1)))
#define LAS __attribute__((address_space(3)))
typedef unsigned short bf16;
typedef unsigned v4u __attribute__((ext_vector_type(4)));
typedef float f32x4 __attribute__((ext_vector_type(4)));
#define LDS_WAIT() asm volatile("s_waitcnt lgkmcnt(0)" ::: "memory")
#define WG_BAR() do { asm volatile("s_waitcnt lgkmcnt(0)" ::: "memory"); __builtin_amdgcn_s_barrier(); asm volatile("" ::: "memory"); } while (0)

__device__ __forceinline__ unsigned f2bf(float f) { unsigned u = __builtin_bit_cast(unsigned, f); return (u + 0x7fffu + ((u >> 16) & 1u)) >> 16; }
__device__ __forceinline__ unsigned pk2(float lo, float hi) { return pg8::cvt_pk_bf16(lo, hi); }
__device__ __forceinline__ float bf2f(unsigned h) { return __builtin_bit_cast(float, h << 16); }
__device__ __forceinline__ float bflo(unsigned w) { return __builtin_bit_cast(float, w << 16); }
__device__ __forceinline__ float bfhi(unsigned w) { return __builtin_bit_cast(float, w & 0xffff0000u); }
__device__ __forceinline__ float sigmoidf_(float x) { return __builtin_amdgcn_rcpf(1.f + __expf(-x)); }
__device__ __forceinline__ float gelu_tanh(float x) { const float u = 0.7978845608028654f * (x + 0.044715f * x * x * x); return x * __builtin_amdgcn_rcpf(1.f + __expf(-2.f * u)); }
__device__ __forceinline__ float wave_sum(float v) {
#pragma unroll
    for (int o = 1; o < 64; o <<= 1) v += __shfl_xor(v, o);
    return v;
}

#define XB_TMO      128
#define XB_XCNT(j)  (256  + 64 * (j))
#define XB_XSUB(j)  (1280 + 64 * (j))
#define XB_XGEN(j)  (2304 + 64 * (j))
#define XB_TOP      3328
#define XB_TOPGEN   3392
#define XCD_BAR_WORDS 3456
#define XB_SPIN_CAP (1u << 23)
__device__ __forceinline__ unsigned xb_ld(unsigned* p)              { return __hip_atomic_load(p, __ATOMIC_RELAXED, __HIP_MEMORY_SCOPE_AGENT); }
__device__ __forceinline__ unsigned xb_add(unsigned* p, unsigned v) { return __hip_atomic_fetch_add(p, v, __ATOMIC_RELAXED, __HIP_MEMORY_SCOPE_AGENT); }
__device__ __forceinline__ unsigned xb_xcc_id() { return (unsigned)__builtin_amdgcn_s_getreg((3 << 11) | 20) & 0xFu; }
#define XB_SPIN(cond, bar) do { unsigned _sp = 0; while (cond) { __builtin_amdgcn_s_sleep(1); \
    if ((++_sp & 255u) == 0u) { if (xb_ld(&(bar)[XB_TMO])) break; if (_sp > XB_SPIN_CAP) { atomicAdd(&(bar)[XB_TMO], 1u); break; } } } } while (0)
struct XcdBarrier { unsigned* bar; unsigned x; volatile LAS unsigned* st; };
__device__ __forceinline__ XcdBarrier xcd_barrier_post(unsigned* bar, volatile LAS unsigned* st, int tid) {
    XcdBarrier b; b.bar = bar; b.x = xb_xcc_id(); b.st = st;
    if (tid == 0) (void)xb_add(&bar[XB_XCNT(b.x)], 1u);
    return b;
}
__device__ __forceinline__ void xcd_barrier_complete(unsigned* bar, unsigned x, unsigned& nloc, unsigned& nx) {
    const unsigned G = gridDim.x * gridDim.y * gridDim.z;
    unsigned sum, cnt, mine, sp = 0u;
    for (;;) {
        sum = 0u; cnt = 0u; mine = 0u;
#pragma unroll
        for (unsigned j = 0; j < 16; ++j) { const unsigned c = xb_ld(&bar[XB_XCNT(j)]); sum += c; cnt += (c > 0u) ? 1u : 0u; mine = (j == x) ? c : mine; }
        if (sum == G) break;
        __builtin_amdgcn_s_sleep(1);
        if ((++sp & 255u) == 0u) { if (xb_ld(&bar[XB_TMO])) break; if (sp > XB_SPIN_CAP) { atomicAdd(&bar[XB_TMO], 1u); break; } }
    }
    nloc = mine > 0u ? mine : 1u; nx = cnt > 0u ? cnt : 1u;
}
__device__ __forceinline__ void xcd_barrier(const XcdBarrier& b, int tid) {
    asm volatile("s_waitcnt vmcnt(0)" ::: "memory");
    __syncthreads();
    if (tid == 0) {
        unsigned* bar = b.bar;
        __builtin_amdgcn_s_waitcnt(0);
        unsigned nloc = b.st[0], nx = b.st[1];
        if (nloc == 0u) { xcd_barrier_complete(bar, b.x, nloc, nx); b.st[0] = nloc; b.st[1] = nx; }
        const unsigned old = xb_add(&bar[XB_XSUB(b.x)], 1u);
        const unsigned gen = old / nloc;
        if (old + 1u == (gen + 1u) * nloc) {
            __builtin_amdgcn_fence(__ATOMIC_RELEASE, "agent");
            asm volatile("s_waitcnt vmcnt(0)" ::: "memory");
            const unsigned og = xb_add(&bar[XB_TOP], 1u);
            const unsigned tg = og / nx;
            if (og + 1u == (tg + 1u) * nx) xb_add(&bar[XB_TOPGEN], 1u);
            else XB_SPIN(xb_ld(&bar[XB_TOPGEN]) == tg, bar);
            __builtin_amdgcn_fence(__ATOMIC_ACQUIRE, "agent");
            xb_add(&bar[XB_XGEN(b.x)], 1u);
            asm volatile("s_waitcnt vmcnt(0)" ::: "memory");
        } else {
            XB_SPIN(xb_ld(&bar[XB_XGEN(b.x)]) == gen, bar);
            __builtin_amdgcn_fence(__ATOMIC_ACQUIRE, "agent");
            asm volatile("s_waitcnt vmcnt(0)" ::: "memory");
        }
    }
    __syncthreads();
}

__device__ __forceinline__ int make_tid(int wave_s) { int l; asm volatile("v_mbcnt_lo_u32_b32 %0, -1, 0\n\tv_mbcnt_hi_u32_b32 %0, -1, %0" : "=v"(l)); __builtin_assume(l >= 0 && l < 64); __builtin_assume(wave_s >= 0 && wave_s < 8); return wave_s * 64 + l; }
__device__ __forceinline__ int fresh_lane() { int l; asm volatile("v_mbcnt_lo_u32_b32 %0, -1, 0\n\tv_mbcnt_hi_u32_b32 %0, -1, %0" : "=v"(l)); __builtin_assume(l >= 0 && l < 64); return l; }
struct Args { const float* in[27]; float* out; unsigned char* ws; int ph_lo, ph_hi; };
enum { I_X = 0, I_C, I_CTX, I_CCTX, I_WMOD, I_BMOD, I_N1G, I_WIN, I_BGATES, I_HEADG, I_CONVW, I_CONVB, I_LWA, I_LBA, I_LWX, I_LBX, I_LAM, I_WPA, I_WPB, I_WOUT, I_N2G, I_WRG, I_WRE, I_W1, I_W3, I_W2, I_FG };

__device__ __forceinline__ void tr_item(const float* __restrict__ W, size_t ldw, int k0, int n0, bf16* dst, size_t ldd, float scale, LAS float* scr, int lane) {
#pragma unroll 16
    for (int i = 0; i < 32; ++i) { const int kk = 2 * i + (lane >> 5); scr[kk * 33 + (lane & 31)] = W[(size_t)(k0 + kk) * ldw + n0 + (lane & 31)]; }
    LDS_WAIT(); asm volatile("" ::: "memory");
    const int c = lane & 7;
#pragma unroll
    for (int j = 0; j < 4; ++j) { const int n = (lane >> 3) + 8 * j; const LAS float* s = scr + (8 * c) * 33 + n;
        v4u o; o.x = pk2(s[0 * 33] * scale, s[1 * 33] * scale); o.y = pk2(s[2 * 33] * scale, s[3 * 33] * scale); o.z = pk2(s[4 * 33] * scale, s[5 * 33] * scale); o.w = pk2(s[6 * 33] * scale, s[7 * 33] * scale);
        *(GAS v4u*)(dst + (size_t)n * ldd + 8 * c) = o; }
    LDS_WAIT(); asm volatile("" ::: "memory");
}
__device__ __forceinline__ int win_row(int n0, float& scale) {
    scale = 1.f;
    if (n0 < 1024) return 13 * 256 + n0;
    if (n0 < 2048) { scale = 0.08838834764831845f; return n0 - 1024; }
    if (n0 < 3072) return 4 * 256 + (n0 - 2048);
    if (n0 < 4096) return 17 * 256 + (n0 - 3072);
    if (n0 < 5120) return 21 * 256 + (n0 - 4096);
    if (n0 < 5152) return 12 * 256 + (n0 - 5120);
    if (n0 < 6176) return 8 * 256 + (n0 - 5152);
    if (n0 < 7200) return 25 * 256 + (n0 - 6176);
    if (n0 < 9248) return 29 * 256 + (n0 - 7200);
    return 37 * 256 + (n0 - 9248);
}

__device__ __forceinline__ void phase0(const Args& a, unsigned char* lds_g, int tid, int lane, int wave) {
    unsigned char* ws = a.ws;
    {
        float* sl = (float*)lds_g;
        float* red = sl + 5 * 2048;
        for (int i = tid; i < 5 * 2048; i += NTHR) { const int r = i >> 11, k = i & 2047; const float v = r < 4 ? a.in[I_C][r * 2048 + k] : a.in[I_CCTX][k]; sl[i] = v / (1.f + __expf(-v)); }
        __syncthreads();
        const float* wm = a.in[I_WMOD]; const float* bm = a.in[I_BMOD]; float* MOD = (float*)(ws + WS_MOD);
        for (int cb = blockIdx.x; cb < 256; cb += gridDim.x) {
            const int n0 = cb * 48;
            if (tid < 504) {
                const int kq = tid / 12, cg = tid % 12;
                f32x4 acc[5];
#pragma unroll
                for (int r = 0; r < 5; ++r) acc[r] = (f32x4){0.f, 0.f, 0.f, 0.f};
#pragma unroll 7
                for (int k = kq; k < 2048; k += 42) {
                    const f32x4 w = *(const f32x4*)(wm + (size_t)k * 12288 + n0 + 4 * cg);
#pragma unroll
                    for (int r = 0; r < 5; ++r) acc[r] += w * sl[r * 2048 + k];
                }
#pragma unroll
                for (int r = 0; r < 5; ++r) *(f32x4*)(red + tid * 20 + r * 4) = acc[r];
            }
            __syncthreads();
            if (tid < 240) {
                const int cg = tid / 20, rj = tid % 20; float s = 0.f;
                for (int kq = 0; kq < 42; ++kq) s += red[(kq * 12 + cg) * 20 + rj];
                const int r = rj >> 2, j = rj & 3, n = n0 + 4 * cg + j;
                __hip_atomic_store(MOD + r * 12288 + n, s + bm[n], __ATOMIC_RELAXED, __HIP_MEMORY_SCOPE_AGENT);
            }
            __syncthreads();
        }
        if (tid == 0) __hip_atomic_fetch_add((unsigned*)(ws + WS_CTL) + CW_MODC, 1u, __ATOMIC_RELAXED, __HIP_MEMORY_SCOPE_AGENT);
    }
    {
        LAS float* scr = (LAS float*)((LAS unsigned char*)lds_g) + wave * 4096;
        const int gw = blockIdx.x * NWAVES + wave, NGW = gridDim.x * NWAVES;
        constexpr int J0 = 32 * 353, J1 = 16 * 64, J3 = 32 * 64;
        constexpr int JL = 256;
        constexpr int NITEMS = J0 + 2 * J1;
        (void)J3; (void)JL;
        for (int it = gw; it < NITEMS; it += NGW) {
            int r = it;
            if (r < J0) { const int kb = r / 353, nb = r % 353; float sc; const int row = win_row(32 * nb, sc);
                tr_item(a.in[I_WIN], IN_DIM, 64 * kb, 32 * nb, (bf16*)(ws + WS_WIN) + (size_t)row * 2048 + 64 * kb, 2048, sc, scr, lane); continue; } r -= J0;
            if (r < J1) { const int kb = r / 64, nb = r % 64; tr_item(a.in[I_WPA], 2048, 64 * kb, 32 * nb, (bf16*)(ws + WS_WPA) + (size_t)(32 * nb) * 1024 + 64 * kb, 1024, 1.f, scr, lane); continue; } r -= J1;
            if (r < J1) { const int kb = r / 64, nb = r % 64; tr_item(a.in[I_WPB], 2048, 64 * kb, 32 * nb, (bf16*)(ws + WS_WPB) + (size_t)(32 * nb) * 1024 + 64 * kb, 1024, 1.f, scr, lane); continue; }
        }
        { GAS v4u* z = (GAS v4u*)((bf16*)(ws + WS_WIN) + (size_t)(12 * 256 + 32) * 2048); const int nchunks = 224 * 256;
          for (int i = blockIdx.x * NTHR + tid; i < nchunks; i += gridDim.x * NTHR) z[i] = (v4u){0u, 0u, 0u, 0u}; }
    }
}

__device__ __forceinline__ void late_prep(const Args& a, unsigned char* lds_g, int gw, int NGW, int lane, int wave) {
    unsigned char* ws = a.ws;
    {
        LAS float* scr = (LAS float*)((LAS unsigned char*)lds_g) + wave * 4096;
        constexpr int J3 = 32 * 64, JL = 256;
        for (int it = gw; it < J3 + JL; it += NGW) {
            int r = it;
            if (r >= J3) { r -= J3; const int mi = r >> 3, kb = (r >> 2) & 1, nb = r & 3, dir = mi >> 4, mat = (mi >> 3) & 1, blk = mi & 7;
                tr_item(a.in[mat ? I_LWX : I_LWA] + (size_t)(dir * 8 + blk) * 128 * 128, 128, 64 * kb, 32 * nb, (bf16*)(ws + WS_WL) + ((size_t)((dir * 2 + mat) * 8 + blk) * 128 + 32 * nb) * 128 + 64 * kb, 128, 1.f, scr, lane); continue; }
            const int kb = r / 64, nb = r % 64; tr_item(a.in[I_WOUT], 2048, 64 * kb, 32 * nb, (bf16*)(ws + WS_WOUT) + (size_t)(32 * nb) * 2048 + 64 * kb, 2048, 1.f, scr, lane);
        }
    }
    {
        const float* MODr = (const float*)(a.ws + WS_MOD); float* WR = (float*)(a.ws + WS_WR); float* RB = (float*)(a.ws + WS_RB);
        for (int idx = gw * 64 + lane; idx < 4 * 48 * 2048; idx += NGW * 64) { const int k = idx & 2047, j = (idx >> 11) % 48, b = idx / (48 * 2048);
            const float gm = a.in[I_N2G][k] * (1.f + MODr[b * 12288 + 4 * 2048 + k]);
            const float wv = j < 32 ? a.in[I_WRE][(size_t)k * 32 + j] : (j < 36 ? a.in[I_WRG][(size_t)k * 4 + (j - 32)] : 0.f);
            WR[idx] = gm * wv; }
        for (int q = gw; q < 4 * 48; q += NGW) { const int b = q / 48, j = q % 48; float sacc = 0.f;
            if (j < 36) { for (int k = lane; k < 2048; k += 64) { const float wv = j < 32 ? a.in[I_WRE][(size_t)k * 32 + j] : a.in[I_WRG][(size_t)k * 4 + (j - 32)]; sacc += MODr[b * 12288 + 3 * 2048 + k] * wv; } }
            sacc = wave_sum(sacc); if (lane == 0) RB[q] = sacc; }
    }
}
__device__ __forceinline__ void mod_wait(const Args& a, int tid) {
    if (tid < 64) { unsigned* mc = (unsigned*)(a.ws + WS_CTL) + CW_MODC; unsigned spins = 0;
        while ((unsigned)__builtin_amdgcn_readfirstlane(__hip_atomic_load(mc, __ATOMIC_RELAXED, __HIP_MEMORY_SCOPE_AGENT)) < gridDim.x) {
            __builtin_amdgcn_s_sleep(2);
            if (++spins > (1u << 22)) { if (tid == 0) __hip_atomic_store((unsigned*)(a.ws + WS_CTL) + 1, 0x800u, __ATOMIC_RELAXED, __HIP_MEMORY_SCOPE_AGENT); break; } }
        __builtin_amdgcn_fence(__ATOMIC_ACQUIRE, "agent");
        asm volatile("s_waitcnt vmcnt(0)" ::: "memory"); }
    __syncthreads();
}
__device__ __forceinline__ void phase1(const Args& a, int lane, int wave) {
    const int gw = blockIdx.x * NWAVES + wave, NGW = gridDim.x * NWAVES;
    const float* MOD = (const float*)(a.ws + WS_MOD); const float* g = a.in[I_N1G];
    bf16* H = (bf16*)(a.ws + WS_H);
    for (int r = gw; r < NTOK; r += NGW) {
        const float* src = r < NCTX ? a.in[I_CTX] + (size_t)r * D : a.in[I_X] + (size_t)(r - NCTX) * D;
        const int mr = r < NCTX ? 4 : (r - NCTX) / SEQ;
        const f32x4* xr = (const f32x4*)src + lane;
        f32x4 v[8]; float s = 0.f;
#pragma unroll
        for (int j = 0; j < 8; ++j) { v[j] = xr[64 * j]; s += (v[j].x * v[j].x + v[j].y * v[j].y) + (v[j].z * v[j].z + v[j].w * v[j].w); }
        const float rstd = 1.f / sqrtf(wave_sum(s) * (1.f / D) + EPS);
        unsigned long long* o8 = (unsigned long long*)(H + (size_t)r * D) + lane;
#pragma unroll
        for (int j = 0; j < 8; ++j) {
            const int c = 4 * lane + 256 * j;
            const f32x4 gg = *(const f32x4*)(g + c), sh = *(const f32x4*)(MOD + mr * 12288 + c), sc = *(const f32x4*)(MOD + mr * 12288 + 2048 + c);
            v[j] = v[j] * rstd * gg * (sc + 1.f) + sh;
        }
#pragma unroll
        for (int j = 0; j < 8; ++j) o8[64 * j] = (unsigned long long)pk2(v[j].x, v[j].y) | ((unsigned long long)pk2(v[j].z, v[j].w) << 32);
    }
}

struct SchedIn {
    int G, c; const char* A; const char* B;
    __device__ __forceinline__ bool next(int i, pg8::Unit& u) const {
        const int L = i * G + c; if (L >= 1492) return false;
        int pm, pn;
        if (L < 1440) { pg8::tile_order(L, 32, NT_IN, pm, pn); pm += 4; }
        else { const int j = L - 1440; pm = j & 3; pn = j >> 2; }
        u.pm = pm; u.pn = pn; u.aux = 0; u.A = A + (size_t)pm * 256 * D * 2; u.B = B + (size_t)pn * 256 * D * 2; return true;
    }
};
struct EpiIn {
    static constexpr bool PERM = true, CARRY = false;
    __device__ __forceinline__ bool keep(const pg8::Unit&) const { return false; }
    unsigned char* ws; const float* b_gates;
    template <int ACT> __device__ __forceinline__ void store_tile(const pg8::f32x4 (&acc)[2][2][4][2], bf16* base, int ldc, int wr, int wc, int fr, int fq) const {
#pragma unroll
        for (int ai = 0; ai < 2; ++ai)
#pragma unroll
            for (int m = 0; m < 4; ++m) { bf16* rowp = base + (size_t)(ai * 128 + wr * 64 + m * 16 + fr) * ldc + wc * 32 + 8 * fq;
#pragma unroll
                for (int bj = 0; bj < 2; ++bj) { pg8::f32x4 v0 = acc[ai][bj][m][0], v1 = acc[ai][bj][m][1];
                    if (ACT == 1) {
#pragma unroll
                        for (int j = 0; j < 4; ++j) { v0[j] = sigmoidf_(v0[j]); v1[j] = sigmoidf_(v1[j]); } }
                    if (ACT == 2) {
#pragma unroll
                        for (int j = 0; j < 4; ++j) { v0[j] = gelu_tanh(v0[j]); v1[j] = gelu_tanh(v1[j]); } }
                    pg8::u32x4 w; w.x = pg8::cvt_pk_bf16(v0[0], v0[1]); w.y = pg8::cvt_pk_bf16(v0[2], v0[3]); w.z = pg8::cvt_pk_bf16(v1[0], v1[1]); w.w = pg8::cvt_pk_bf16(v1[2], v1[3]);
                    *(pg8::u32x4*)(rowp + bj * 128) = w; } }
    }
    __device__ __forceinline__ void operator()(const pg8::f32x4 (&acc)[2][2][4][2], const pg8::Unit& u, int wr, int wc, int fr, int fq) const {
        const int pn = u.pn; const size_t row0 = (size_t)u.pm * 256;
        if (pn < 12) {
            const int seg = pn >> 2, ct = pn & 3; bf16* dst = (bf16*)(ws + (seg == 0 ? WS_K : seg == 1 ? WS_V : WS_UX));
            store_tile<0>(acc, dst + row0 * 1024 + ct * 256, 1024, wr, wc, fr, fq);
        } else if (pn == 12) {
            if (wc == 0) {
                float* G = (float*)(ws + WS_GATES);
                const pg8::f32x4 bv0 = *(const pg8::f32x4*)(b_gates + 8 * fq), bv1 = *(const pg8::f32x4*)(b_gates + 8 * fq + 4);
#pragma unroll
                for (int ai = 0; ai < 2; ++ai)
#pragma unroll
                    for (int m = 0; m < 4; ++m) { float* rowp = G + (row0 + ai * 128 + wr * 64 + m * 16 + fr) * 32 + 8 * fq;
                        *(pg8::f32x4*)(rowp) = acc[ai][0][m][0] + bv0; *(pg8::f32x4*)(rowp + 4) = acc[ai][0][m][1] + bv1; }
            }
        } else if (pn < 29) {
            const int seg = (pn - 13) >> 2, ct = (pn - 13) & 3; const size_t lr = row0 - NCTX;
            bf16* dst = (bf16*)(ws + (seg == 0 ? WS_Q : seg == 1 ? WS_OF : seg == 2 ? WS_OB : WS_UG)) + lr * 1024 + ct * 256;
            if (seg == 0) store_tile<0>(acc, dst, 1024, wr, wc, fr, fq);
            else if (seg == 3) store_tile<2>(acc, dst, 1024, wr, wc, fr, fq);
            else store_tile<1>(acc, dst, 1024, wr, wc, fr, fq);
        } else {
            const int seg = (pn - 29) >> 3, ct = (pn - 29) & 7; const size_t lr = row0 - NCTX;
            store_tile<1>(acc, (bf16*)(ws + (seg ? WS_GB : WS_GA)) + lr * 2048 + ct * 256, 2048, wr, wc, fr, fq);
        }
    }
};

__device__ __forceinline__ int lru_pos_row(int b, bool isctx, int p) { return isctx ? b * CTXL + p : NCTX + b * SEQ + (p & 31) * 64 + (p >> 5); }
typedef short bf16x8_t __attribute__((ext_vector_type(8)));
template <bool FINAL>
__device__ __forceinline__ void lru_unit(const Args& a, unsigned char* lds_g, int b, int cidx, int blk, int tid) {
    const int lane = tid & 63, w = __builtin_amdgcn_readfirstlane(tid >> 6), fr = lane & 15, fq = lane >> 4;
    float* zf = (float*)lds_g;
    bf16* zb = (bf16*)(lds_g + 64 * 132 * 4);
    const bool isctx = cidx < 4; const int seglen = isctx ? CTXL : SEQ, p0 = (isctx ? cidx : cidx - 4) * 64;
    const bf16* UX = (const bf16*)(a.ws + WS_UX);
    float gba[2], gbx[2], glam[2];
    { const int ch_ = blk * 128 + 16 * w + fr;
#pragma unroll
      for (int d = 0; d < 2; ++d) { gba[d] = a.in[I_LBA][d * 1024 + ch_]; gbx[d] = a.in[I_LBX][d * 1024 + ch_]; glam[d] = a.in[I_LAM][d * 1024 + ch_]; } }
    bf16x8_t wl[2][2][4];
    { const bf16* WL = (const bf16*)(a.ws + WS_WL);
#pragma unroll
      for (int d = 0; d < 2; ++d)
#pragma unroll
        for (int m = 0; m < 2; ++m)
#pragma unroll
            for (int ks = 0; ks < 4; ++ks) wl[d][m][ks] = *(const bf16x8_t*)(WL + ((size_t)((d * 2 + m) * 8 + blk) * 128 + 16 * w + fr) * 128 + 32 * ks + 8 * fq); }
    __builtin_amdgcn_sched_barrier(0);
    {
        const int pos = tid >> 3, cg = tid & 7, ch0 = blk * 128 + cg * 16, p = p0 + pos;
        float z[16];
#pragma unroll
        for (int q = 0; q < 4; ++q) { const f32x4 bv = *(const f32x4*)(a.in[I_CONVB] + ch0 + 4 * q); z[4 * q] = bv.x; z[4 * q + 1] = bv.y; z[4 * q + 2] = bv.z; z[4 * q + 3] = bv.w; }
        v4u ua[4], ub[4]; float msk[4];
#pragma unroll
        for (int w4 = 0; w4 < 4; ++w4) { const int pp = p + w4 - 2; const bool ok = pp >= 0 && pp < seglen; const int ppc = ok ? pp : p;
            const v4u* src = (const v4u*)(UX + (size_t)lru_pos_row(b, isctx, ppc) * 1024 + ch0); ua[w4] = src[0]; ub[w4] = src[1]; msk[w4] = ok ? 1.f : 0.f; }
#pragma unroll
        for (int w4 = 0; w4 < 4; ++w4) { const float* cw = a.in[I_CONVW] + w4 * 1024 + ch0;
            const unsigned uu[8] = {ua[w4].x, ua[w4].y, ua[w4].z, ua[w4].w, ub[w4].x, ub[w4].y, ub[w4].z, ub[w4].w};
#pragma unroll
            for (int q = 0; q < 4; ++q) { const f32x4 cv = *(const f32x4*)(cw + 4 * q) * msk[w4]; z[4 * q] += cv.x * bflo(uu[2 * q]); z[4 * q + 1] += cv.y * bfhi(uu[2 * q]); z[4 * q + 2] += cv.z * bflo(uu[2 * q + 1]); z[4 * q + 3] += cv.w * bfhi(uu[2 * q + 1]); } }
#pragma unroll
        for (int q = 0; q < 4; ++q) *(f32x4*)(zf + pos * 132 + cg * 16 + 4 * q) = (f32x4){z[4 * q], z[4 * q + 1], z[4 * q + 2], z[4 * q + 3]};
        v4u o0, o1; o0.x = pk2(z[0], z[1]); o0.y = pk2(z[2], z[3]); o0.z = pk2(z[4], z[5]); o0.w = pk2(z[6], z[7]); o1.x = pk2(z[8], z[9]); o1.y = pk2(z[10], z[11]); o1.z = pk2(z[12], z[13]); o1.w = pk2(z[14], z[15]);
        *(v4u*)(zb + pos * 136 + cg * 16) = o0; *(v4u*)(zb + pos * 136 + cg * 16 + 8) = o1;
    }
    WG_BAR();
    f32x4 acc[2][2][4];
#pragma unroll
    for (int d = 0; d < 2; ++d)
#pragma unroll
        for (int m = 0; m < 2; ++m)
#pragma unroll
            for (int mt = 0; mt < 4; ++mt) acc[d][m][mt] = (f32x4){0.f, 0.f, 0.f, 0.f};
#pragma unroll
    for (int ks = 0; ks < 4; ++ks) {
        bf16x8_t af[4];
#pragma unroll
        for (int mt = 0; mt < 4; ++mt) af[mt] = *(const bf16x8_t*)(zb + (16 * mt + fr) * 136 + 32 * ks + 8 * fq);
#pragma unroll
        for (int d = 0; d < 2; ++d)
#pragma unroll
            for (int m = 0; m < 2; ++m) {
#pragma unroll
                for (int mt = 0; mt < 4; ++mt) acc[d][m][mt] = __builtin_amdgcn_mfma_f32_16x16x32_bf16(af[mt], wl[d][m][ks], acc[d][m][mt], 0, 0, 0); }
    }
    const int chl = 16 * w + fr, ch = blk * 128 + chl;
    float hsum[4][4];
#pragma unroll
    for (int d = 0; d < 2; ++d) {
        const float ba = gba[d], bx = gbx[d], lam = glam[d];
        const float sp = (-lam > 20.f) ? -lam : log1pf(__expf(-lam));
        float av[4][4], bv[4][4];
#pragma unroll
        for (int mt = 0; mt < 4; ++mt)
#pragma unroll
            for (int r = 0; r < 4; ++r) { const float rr = sigmoidf_(acc[d][0][mt][r] + ba), ii = sigmoidf_(acc[d][1][mt][r] + bx);
                const float aa = __expf(-8.f * rr * sp); av[mt][r] = aa; bv[mt][r] = __builtin_amdgcn_sqrtf(fmaxf(1.f - aa * aa, 0.f)) * ii * zf[(16 * mt + 4 * fq + r) * 132 + chl]; }
        float Pe[4], Se[4], Pt[4], St[4];
#pragma unroll
        for (int mt = 0; mt < 4; ++mt) {
            float P = 1.f, S = 0.f;
#pragma unroll
            for (int rr = 0; rr < 4; ++rr) { const int r = d ? 3 - rr : rr; S = av[mt][r] * S + bv[mt][r]; P = av[mt][r] * P; }
            if (d == 0) {
                float p1 = __shfl_up(P, 16), s1 = __shfl_up(S, 16); if (fq >= 1) { S = P * s1 + S; P = P * p1; }
                p1 = __shfl_up(P, 32); s1 = __shfl_up(S, 32); if (fq >= 2) { S = P * s1 + S; P = P * p1; }
                Pe[mt] = __shfl_up(P, 16); Se[mt] = __shfl_up(S, 16); if (fq == 0) { Pe[mt] = 1.f; Se[mt] = 0.f; }
                Pt[mt] = __shfl(P, fr + 48); St[mt] = __shfl(S, fr + 48);
            } else {
                float p1 = __shfl_down(P, 16), s1 = __shfl_down(S, 16); if (fq <= 2) { S = P * s1 + S; P = P * p1; }
                p1 = __shfl_down(P, 32); s1 = __shfl_down(S, 32); if (fq <= 1) { S = P * s1 + S; P = P * p1; }
                Pe[mt] = __shfl_down(P, 16); Se[mt] = __shfl_down(S, 16); if (fq == 3) { Pe[mt] = 1.f; Se[mt] = 0.f; }
                Pt[mt] = __shfl(P, fr); St[mt] = __shfl(S, fr);
            }
        }
        float2* AGG = (float2*)(a.ws + WS_AGG) + ((size_t)(b * 2 + d) * 36) * 1024 + ch;
        if (!FINAL) {
            if (cidx >= 4) {
                unsigned* PS = (unsigned*)(a.ws + WS_PS) + ((size_t)(b * 2 + d) * NSTEP + 64 * cidx) * 1024 + ch;
#pragma unroll
                for (int mt = 0; mt < 4; ++mt)
#pragma unroll
                    for (int r = 0; r < 4; ++r) PS[(size_t)(16 * mt + 4 * fq + r) * 1024] = pk2(1.f - av[mt][r], bv[mt][r]);
            }
            float Pc = 1.f, Sc = 0.f;
#pragma unroll
            for (int i = 0; i < 4; ++i) { const int mt = d ? 3 - i : i; Sc = Pt[mt] * Sc + St[mt]; Pc = Pt[mt] * Pc; }
            if (fq == 0) AGG[(size_t)cidx * 1024] = make_float2(Pc, Sc);
        } else {
            float h = 0.f;
#pragma unroll
            for (int g3 = 0; g3 < 6; ++g3) {
                float2 qv[6];
#pragma unroll
                for (int i = 0; i < 6; ++i) { const int sidx = 6 * g3 + i; const int c2 = d ? (sidx < 4 ? 3 - sidx : 39 - sidx) : sidx; qv[i] = AGG[(size_t)c2 * 1024]; }
#pragma unroll
                for (int i = 0; i < 6; ++i) { const int sidx = 6 * g3 + i; const int c2 = d ? (sidx < 4 ? 3 - sidx : 39 - sidx) : sidx;
                    const bool use = d ? (sidx < 4 || c2 > cidx) : (c2 < cidx);
                    h = use ? qv[i].x * h + qv[i].y : h; }
            }
#pragma unroll
            for (int i = 0; i < 4; ++i) { const int mt = d ? 3 - i : i;
                float hl = Pe[mt] * h + Se[mt];
#pragma unroll
                for (int rr = 0; rr < 4; ++rr) { const int r = d ? 3 - rr : rr; hl = av[mt][r] * hl + bv[mt][r]; if (d == 0) hsum[mt][r] = hl; else hsum[mt][r] += hl; }
                h = Pt[mt] * h + St[mt]; }
        }
    }
    if (FINAL) {
#pragma unroll
        for (int mt = 0; mt < 4; ++mt)
#pragma unroll
            for (int r = 0; r < 4; ++r) zf[(16 * mt + 4 * fq + r) * 132 + chl] = hsum[mt][r];
        WG_BAR();
        const int pos = tid >> 3, cg = tid & 7, ch0 = blk * 128 + cg * 16;
        const size_t lrow = (size_t)(lru_pos_row(b, false, p0 + pos) - NCTX) * 1024 + ch0;
        const v4u* ug = (const v4u*)((const bf16*)(a.ws + WS_UG) + lrow); const v4u g0 = ug[0], g1 = ug[1];
        const unsigned gg[8] = {g0.x, g0.y, g0.z, g0.w, g1.x, g1.y, g1.z, g1.w}; unsigned o[8];
#pragma unroll
        for (int q = 0; q < 4; ++q) { const f32x4 hv = *(const f32x4*)(zf + pos * 132 + cg * 16 + 4 * q);
            o[2 * q] = pk2(hv.x * bflo(gg[2 * q]), hv.y * bfhi(gg[2 * q])); o[2 * q + 1] = pk2(hv.z * bflo(gg[2 * q + 1]), hv.w * bfhi(gg[2 * q + 1])); }
        v4u* dst = (v4u*)((bf16*)(a.ws + WS_YB) + lrow); dst[0] = (v4u){o[0], o[1], o[2], o[3]}; dst[1] = (v4u){o[4], o[5], o[6], o[7]};
    }
    WG_BAR();
}
constexpr int ML_STRIDE = 136;
constexpr int ML_Q = 0, ML_K = 17408, ML_V = 34816, ML_AUG = 52224  , ML_CB = 54272  ;
constexpr int ML_EB = 93440  , ML_EU = 95488  , ML_EBEND = 97536  , ML_BEND = 97568  , ML_DEN = 97600  , ML_SSQ = 97856  ;
typedef short s4_t __attribute__((ext_vector_type(4)));
__device__ __forceinline__ s4_t ds_tr(const bf16* p) { return __builtin_amdgcn_ds_read_tr16_b64_v4i16((LAS s4_t*)p); }
__device__ __forceinline__ bf16x8_t frag_row(const bf16* img, int row0, int k0, int fr, int fq) { return *(const bf16x8_t*)(img + (row0 + fr) * ML_STRIDE + k0 + 8 * fq); }
__device__ __forceinline__ bf16x8_t frag_tr2(const bf16* img, int stride, int sA, int sB, int col0, int lane) {
    const int fq = lane >> 4, q = (lane & 15) >> 2, p = lane & 3;
    const s4_t lo = ds_tr(img + (sA + 4 * fq + q) * stride + col0 + 4 * p), hi = ds_tr(img + (sB + 4 * fq + q) * stride + col0 + 4 * p);
    return (bf16x8_t){lo.x, lo.y, lo.z, lo.w, hi.x, hi.y, hi.z, hi.w};
}
__device__ __forceinline__ bf16x8_t frag_tr(const bf16* img, int stride, int s0, int col0, int lane) {
    const int fq = lane >> 4, q = (lane & 15) >> 2, p = lane & 3;
    const bf16* b = img + (s0 + 8 * fq + q) * stride + col0 + 4 * p;
    const s4_t lo = ds_tr(b), hi = ds_tr(b + 4 * stride);
    return (bf16x8_t){lo.x, lo.y, lo.z, lo.w, hi.x, hi.y, hi.z, hi.w};
}
__device__ __forceinline__ float logsigmoidf_(float x) { return fminf(x, 0.f) - log1pf(__expf(-fabsf(x))); }

__device__ __forceinline__ void ml_gates(const Args& a, unsigned char* lds_g, int rowbase, int h, int tid) {
    const int lane = fresh_lane(), w = __builtin_amdgcn_readfirstlane(tid >> 6), dir = w >> 2, c = w & 3;
    const float* GT = (const float*)(a.ws + WS_GATES) + (size_t)(rowbase + 64 * c + lane) * 32;
    const float ipre = GT[(dir * 2) * 8 + h], fpre = GT[(dir * 2 + 1) * 8 + h];
    float bsum = logsigmoidf_(fpre);
    if (dir == 0) {
#pragma unroll
        for (int o = 1; o < 64; o <<= 1) { const float t = __shfl_up(bsum, o); if (lane >= o) bsum += t; }
    } else {
#pragma unroll
        for (int o = 1; o < 64; o <<= 1) { const float t = __shfl_down(bsum, o); if (lane + o < 64) bsum += t; }
    }
    float* eb = (float*)(lds_g + ML_EB); float* eu = (float*)(lds_g + ML_EU);
    eb[dir * 256 + 64 * c + lane] = __expf(bsum); eu[dir * 256 + 64 * c + lane] = __expf(ipre - bsum);
    const float bend = __shfl(bsum, dir ? 0 : 63);
    if (lane == 0) { ((float*)(lds_g + ML_EBEND))[dir * 4 + c] = __expf(bend); ((float*)(lds_g + ML_BEND))[dir * 4 + c] = bend; }
}

template <bool OUT, bool PASS2>
__device__ __forceinline__ void ml_block(const Args& a, unsigned char* lds_g, int rowbase, int h, int dir, f32x4 (&st)[9], int tid) {
    const int lane = tid & 63, w = __builtin_amdgcn_readfirstlane(tid >> 6), fr = lane & 15, fq = lane >> 4;
    bf16* Qi = (bf16*)(lds_g + ML_Q); bf16* Ki = (bf16*)(lds_g + ML_K); bf16* Vi = (bf16*)(lds_g + ML_V); bf16* AUGi = (bf16*)(lds_g + ML_AUG); bf16* CB = (bf16*)(lds_g + ML_CB);
    const float* eb = (const float*)(lds_g + ML_EB) + dir * 256; const float* eu = (const float*)(lds_g + ML_EU) + dir * 256;
    const float* ebend = (const float*)(lds_g + ML_EBEND) + dir * 4;
    float* den = (float*)(lds_g + ML_DEN); float* ssq = (float*)(lds_g + ML_SSQ);
    const bf16* Kb = (const bf16*)(a.ws + WS_K); const bf16* Vb = (const bf16*)(a.ws + WS_V); const bf16* Qb = (const bf16*)(a.ws + WS_Q);
    const int ti = w & 3, vh = w >> 2;
    float hgv[5];
    if (OUT) {
#pragma unroll
        for (int x = 0; x < 5; ++x) { const int vt = vh * 5 + x; hgv[x] = vt < 8 ? a.in[I_HEADG][h * 128 + 16 * vt + fr] : 0.f; } }
    const int st_t = tid >> 3, st_pc = tid & 7;
    v4u k0, k1, v0, v1, q0, q1;
#define ML_LOADC(c_) do { const size_t row_ = (size_t)(rowbase + 64 * (c_) + st_t); \
        const v4u* ks_ = (const v4u*)(Kb + row_ * 1024 + h * 128 + 16 * st_pc); k0 = ks_[0]; k1 = ks_[1]; \
        const v4u* vs_ = (const v4u*)(Vb + row_ * 1024 + h * 128 + 16 * st_pc); v0 = vs_[0]; v1 = vs_[1]; \
        if (OUT) { const v4u* qs_ = (const v4u*)(Qb + (row_ - NCTX) * 1024 + h * 128 + 16 * st_pc); q0 = qs_[0]; q1 = qs_[1]; } } while (0)
    ML_LOADC(dir ? 3 : 0);
    for (int ci = 0; ci < 4; ++ci) {
        const int c = dir ? 3 - ci : ci;
        unsigned short ogv[5][4]; unsigned short tmv[5][4];
        if (OUT) {
            const bf16* OGp = (const bf16*)(a.ws + (dir ? WS_OB : WS_OF)); const bf16* TMp = (const bf16*)(a.ws + WS_TM);
#pragma unroll
            for (int r = 0; r < 4; ++r) { const size_t ob = (size_t)(rowbase - NCTX + 64 * c + 16 * ti + 4 * fq + r) * 1024 + h * 128;
#pragma unroll
                for (int x = 0; x < 5; ++x) { const int vt = vh * 5 + x; if (vt < 8) { ogv[x][r] = OGp[ob + 16 * vt + fr]; if (PASS2) tmv[x][r] = TMp[ob + 16 * vt + fr]; } } }
            __builtin_amdgcn_sched_barrier(0);
        }
        {
            const int t = st_t, pc = st_pc;
            const float e = eu[64 * c + t];
            *(v4u*)(Ki + t * ML_STRIDE + 16 * pc) = k0; *(v4u*)(Ki + t * ML_STRIDE + 16 * pc + 8) = k1;
            if (OUT) { *(v4u*)(Qi + t * ML_STRIDE + 16 * pc) = q0; *(v4u*)(Qi + t * ML_STRIDE + 16 * pc + 8) = q1; }
            const unsigned vv[8] = {v0.x, v0.y, v0.z, v0.w, v1.x, v1.y, v1.z, v1.w}; unsigned o[8];
#pragma unroll
            for (int i = 0; i < 8; ++i) o[i] = pk2(bflo(vv[i]) * e, bfhi(vv[i]) * e);
            *(v4u*)(Vi + t * ML_STRIDE + 16 * pc) = (v4u){o[0], o[1], o[2], o[3]}; *(v4u*)(Vi + t * ML_STRIDE + 16 * pc + 8) = (v4u){o[4], o[5], o[6], o[7]};
            if (pc == 0) { *(v4u*)(AUGi + t * 16) = (v4u){f2bf(e), 0u, 0u, 0u}; *(v4u*)(AUGi + t * 16 + 8) = (v4u){0u, 0u, 0u, 0u}; }
        }
        WG_BAR();
        if (ci < 3) ML_LOADC(dir ? 2 - ci : ci + 1);
        f32x4 X[5]; float hval[4][4];
        if (OUT) {
            bf16x8_t qf[4];
#pragma unroll
            for (int ks = 0; ks < 4; ++ks) qf[ks] = frag_row(Qi, 16 * ti, 32 * ks, fr, fq);
            bf16x8_t P[2]; bool pv[2];
#pragma unroll
            for (int pp = 0; pp < 2; ++pp) {
                f32x4 d[2];
#pragma unroll
                for (int hh = 0; hh < 2; ++hh) { const int si = 2 * pp + hh; d[hh] = (f32x4){0.f, 0.f, 0.f, 0.f};
                    const bool valid = dir ? (si >= ti) : (si <= ti);
                    if (valid) {
#pragma unroll
                        for (int ks = 0; ks < 4; ++ks) d[hh] = __builtin_amdgcn_mfma_f32_16x16x32_bf16(frag_row(Ki, 16 * si, 32 * ks, fr, fq), qf[ks], d[hh], 0, 0, 0);
                        if (si == ti) {
#pragma unroll
                            for (int r = 0; r < 4; ++r) { const bool keep = dir ? (4 * fq + r >= fr) : (4 * fq + r <= fr); d[hh][r] = keep ? d[hh][r] : 0.f; } } } }
                pv[pp] = dir ? (2 * pp + 1 >= ti) : (2 * pp <= ti);
                const unsigned p0 = pk2(d[0][0], d[0][1]), p1 = pk2(d[0][2], d[0][3]), p2 = pk2(d[1][0], d[1][1]), p3 = pk2(d[1][2], d[1][3]);
                P[pp] = __builtin_bit_cast(bf16x8_t, (v4u){p0, p1, p2, p3});
            }
#pragma unroll
            for (int x = 0; x < 5; ++x) { X[x] = (f32x4){0.f, 0.f, 0.f, 0.f};
                const int vt = vh * 5 + x;
                if (vt < 9) {
#pragma unroll
                    for (int pp = 0; pp < 2; ++pp) if (pv[pp]) {
                        const bf16x8_t bfv = vt < 8 ? frag_tr2(Vi, ML_STRIDE, 32 * pp, 32 * pp + 16, 16 * vt, lane) : frag_tr2(AUGi, 16, 32 * pp, 32 * pp + 16, 0, lane);
                        X[x] = __builtin_amdgcn_mfma_f32_16x16x32_bf16(P[pp], bfv, X[x], 0, 0, 0); }
#pragma unroll
                    for (int ks = 0; ks < 4; ++ks) X[x] = __builtin_amdgcn_mfma_f32_16x16x32_bf16(qf[ks], frag_row(CB, 16 * vt, 32 * ks, fr, fq), X[x], 0, 0, 0);
                } }
            if (vh == 1 && fr == 0) {
#pragma unroll
                for (int r = 0; r < 4; ++r) den[16 * ti + 4 * fq + r] = X[3][r] * eb[64 * c + 16 * ti + 4 * fq + r]; }
        }
        {
#pragma unroll
            for (int ks = 0; ks < 2; ++ks) { const bf16x8_t kf = frag_tr(Ki, ML_STRIDE, 32 * ks, 16 * w, lane);
#pragma unroll
                for (int vt = 0; vt < 8; ++vt) st[vt] = __builtin_amdgcn_mfma_f32_16x16x32_bf16(kf, frag_tr(Vi, ML_STRIDE, 32 * ks, 16 * vt, lane), st[vt], 0, 0, 0);
                st[8] = __builtin_amdgcn_mfma_f32_16x16x32_bf16(kf, frag_tr(AUGi, 16, 32 * ks, 0, lane), st[8], 0, 0, 0); }
            const float ee = ebend[c];
#pragma unroll
            for (int vt = 0; vt < 9; ++vt) st[vt] = st[vt] * ee;
        }
        WG_BAR();
        if (OUT) {
            float sq[4] = {0.f, 0.f, 0.f, 0.f};
#pragma unroll
            for (int r = 0; r < 4; ++r) { const int t = 16 * ti + 4 * fq + r; const float sc = eb[64 * c + t] * __builtin_amdgcn_rcpf(fmaxf(fabsf(den[t]), 1.f));
#pragma unroll
                for (int x = 0; x < 4; ++x) { const int vt = vh * 5 + x; const float hv = (vt < 8) ? X[x][r] * sc : 0.f; hval[x][r] = hv; sq[r] += hv * hv; }
                if (vh == 0) { const float hv = X[4][r] * sc; X[4][r] = hv; sq[r] += hv * hv; } }
#pragma unroll
            for (int r = 0; r < 4; ++r) { float v = sq[r]; v += __shfl_xor(v, 1); v += __shfl_xor(v, 2); v += __shfl_xor(v, 4); v += __shfl_xor(v, 8); if (fr == 0) ssq[vh * 64 + 16 * ti + 4 * fq + r] = v; }
#pragma unroll
            for (int vt = 0; vt < 9; ++vt) { pg8::u32x2 o; o.x = pk2(st[vt][0], st[vt][1]); o.y = pk2(st[vt][2], st[vt][3]); *(pg8::u32x2*)(CB + (16 * vt + fr) * ML_STRIDE + 16 * w + 4 * fq) = o; }
            WG_BAR();
            bf16* TM = (bf16*)(a.ws + WS_TM); bf16* YA = (bf16*)(a.ws + WS_YA);
#pragma unroll
            for (int r = 0; r < 4; ++r) { const int t = 16 * ti + 4 * fq + r; const float rs = __builtin_amdgcn_rsqf((ssq[t] + ssq[64 + t]) * (1.f / 128.f) + EPS);
                const size_t ob = (size_t)(rowbase - NCTX + 64 * c + t) * 1024 + h * 128;
#pragma unroll
                for (int x = 0; x < 5; ++x) { const int vt = vh * 5 + x; if (vt < 8) { const int v = 16 * vt + fr; const float hv = (x < 4) ? hval[x][r] : X[4][r];
                    float y = hv * rs * hgv[x] * bf2f(ogv[x][r]);
                    if (PASS2) { y += bf2f(tmv[x][r]); YA[ob + v] = (bf16)f2bf(y); } else TM[ob + v] = (bf16)f2bf(y); } } }
        }
    }
}

#undef ML_LOADC
__device__ __forceinline__ void ml_state_quad(const Args& a, unsigned char* lds_g, int qu, int tid) {
    const int seq = qu >> 1, j0 = 4 * (qu & 1), dir = seq & 1, h = (seq >> 1) & 7, b = seq >> 4;
    const int lane = tid & 63, w = __builtin_amdgcn_readfirstlane(tid >> 6);
    f32x4 st[9];
#pragma unroll
    for (int vt = 0; vt < 9; ++vt) st[vt] = (f32x4){0.f, 0.f, 0.f, 0.f};
#pragma unroll 1
    for (int jj = 0; jj < 4; ++jj) {
        const int j = j0 + jj, su = seq * 8 + j;
        const int rowbase = j == 0 ? b * CTXL : NCTX + b * SEQ + 256 * (dir ? 8 - j : j - 1);
        ml_gates(a, lds_g, rowbase, h, tid);
        WG_BAR();
        ml_block<false, false>(a, lds_g, rowbase, h, dir, st, tid);
        pg8::u32x2* SL = (pg8::u32x2*)(a.ws + WS_SLOC) + ((size_t)(su * 8 + w) * 9) * 64 + lane;
#pragma unroll
        for (int vt = 0; vt < 9; ++vt) { pg8::u32x2 o; o.x = pk2(st[vt][0], st[vt][1]); o.y = pk2(st[vt][2], st[vt][3]); SL[vt * 64] = o; }
        if (tid == 0) { const float* bd = (const float*)(lds_g + ML_BEND) + dir * 4; ((float*)(a.ws + WS_BT))[su] = (bd[0] + bd[1]) + (bd[2] + bd[3]); }
        WG_BAR();
    }
}
__device__ __forceinline__ void ml_out_unit(const Args& a, unsigned char* lds_g, int u, int tid) {
    const int L = u & 7, h = (u >> 3) & 7, b = u >> 6;
    const int rowbase = NCTX + b * SEQ + 256 * L;
    const int lane = tid & 63, w = __builtin_amdgcn_readfirstlane(tid >> 6), fr = lane & 15, fq = lane >> 4;
    bf16* CB = (bf16*)(lds_g + ML_CB);
    ml_gates(a, lds_g, rowbase, h, tid);
    f32x4 st[9];
#pragma unroll
    for (int dir = 0; dir < 2; ++dir) {
        const int seq = (b * 8 + h) * 2 + dir, jmax = dir ? 7 - L : L;
        const float* BT = (const float*)(a.ws + WS_BT) + seq * 8;
        {
            const pg8::u32x2* SLa = (const pg8::u32x2*)(a.ws + WS_SLOC) + ((size_t)((seq * 8 + jmax) * 8 + w) * 9) * 64 + lane;
            const pg8::u32x2* SLb = (const pg8::u32x2*)(a.ws + WS_SLOC) + ((size_t)((seq * 8 + 3) * 8 + w) * 9) * 64 + lane;
            pg8::u32x2 sa[9];
            if (jmax >= 4) {
                pg8::u32x2 sb[9];
#pragma unroll
                for (int vt = 0; vt < 9; ++vt) { sa[vt] = SLa[vt * 64]; sb[vt] = SLb[vt * 64]; }
                float ls = 0.f;
#pragma unroll
                for (int q = 4; q < 8; ++q) ls += (q <= jmax) ? BT[q] : 0.f;
                const float coef = __expf(ls);
#pragma unroll
                for (int vt = 0; vt < 9; ++vt) st[vt] = (f32x4){bflo(sa[vt].x) + bflo(sb[vt].x) * coef, bfhi(sa[vt].x) + bfhi(sb[vt].x) * coef, bflo(sa[vt].y) + bflo(sb[vt].y) * coef, bfhi(sa[vt].y) + bfhi(sb[vt].y) * coef};
            } else {
#pragma unroll
                for (int vt = 0; vt < 9; ++vt) { sa[vt] = SLa[vt * 64]; st[vt] = (f32x4){bflo(sa[vt].x), bfhi(sa[vt].x), bflo(sa[vt].y), bfhi(sa[vt].y)}; }
            }
        }
#pragma unroll
        for (int vt = 0; vt < 9; ++vt) { pg8::u32x2 o; o.x = pk2(st[vt][0], st[vt][1]); o.y = pk2(st[vt][2], st[vt][3]); *(pg8::u32x2*)(CB + (16 * vt + fr) * ML_STRIDE + 16 * w + 4 * fq) = o; }
        WG_BAR();
        if (dir == 0) ml_block<true, false>(a, lds_g, rowbase, h, 0, st, tid);
        else ml_block<true, true>(a, lds_g, rowbase, h, 1, st, tid);
        asm volatile("s_waitcnt vmcnt(0)" ::: "memory");
        WG_BAR();
    }
}

__device__ __forceinline__ void lru_out_unit(const Args& a, unsigned char* lds_g, int b, int cidx, int blk, int tid) {
    const int chl = tid & 127, q = tid >> 7, ch = blk * 128 + chl;
    float2* QA = (float2*)lds_g;
    float av[2][16], bv[2][16];
#pragma unroll
    for (int d = 0; d < 2; ++d) { const unsigned* PS = (const unsigned*)(a.ws + WS_PS) + ((size_t)(b * 2 + d) * NSTEP + 64 * cidx + 16 * q) * 1024 + ch;
#pragma unroll
        for (int i = 0; i < 16; ++i) { const unsigned wv = PS[(size_t)i * 1024]; av[d][i] = 1.f - bflo(wv); bv[d][i] = bfhi(wv); } }
    float2* CA = (float2*)(lds_g + 8192);
#pragma unroll
    for (int d = 0; d < 2; ++d) { const float2* AGG = (const float2*)(a.ws + WS_AGG) + ((size_t)(b * 2 + d) * 36) * 1024 + ch; float2 qv[9];
#pragma unroll
        for (int i = 0; i < 9; ++i) { const int sidx = 9 * q + i; const int c2 = d ? (sidx < 4 ? 3 - sidx : 39 - sidx) : sidx; qv[i] = AGG[(size_t)c2 * 1024]; }
        float P = 1.f, S = 0.f;
#pragma unroll
        for (int i = 0; i < 9; ++i) { const int sidx = 9 * q + i; const int c2 = d ? (sidx < 4 ? 3 - sidx : 39 - sidx) : sidx; const bool use = d ? (sidx < 4 || c2 > cidx) : (c2 < cidx);
            S = use ? qv[i].x * S + qv[i].y : S; P = use ? qv[i].x * P : P; }
        CA[(d * 4 + q) * 128 + chl] = make_float2(P, S); }
#pragma unroll
    for (int d = 0; d < 2; ++d) { float P = 1.f, S = 0.f;
#pragma unroll
        for (int ii = 0; ii < 16; ++ii) { const int i = d ? 15 - ii : ii; S = av[d][i] * S + bv[d][i]; P = av[d][i] * P; }
        QA[(d * 4 + q) * 128 + chl] = make_float2(P, S); }
    WG_BAR();
    float hs[16];
#pragma unroll
    for (int d = 0; d < 2; ++d) { float h = 0.f;
#pragma unroll
        for (int k = 0; k < 4; ++k) { const float2 t = CA[(d * 4 + k) * 128 + chl]; h = t.x * h + t.y; }
#pragma unroll
        for (int k = 0; k < 3; ++k) { const int qq = d ? 3 - k : k; const bool use = d ? (qq > q) : (qq < q); const float2 t = QA[(d * 4 + qq) * 128 + chl]; h = use ? t.x * h + t.y : h; }
#pragma unroll
        for (int ii = 0; ii < 16; ++ii) { const int i = d ? 15 - ii : ii; h = av[d][i] * h + bv[d][i]; if (d == 0) hs[i] = h; else hs[i] += h; } }
    const int p0 = (cidx - 4) * 64 + 16 * q;
    unsigned short ugv[16];
#pragma unroll
    for (int i = 0; i < 16; ++i) ugv[i] = ((const bf16*)(a.ws + WS_UG))[(size_t)(lru_pos_row(b, false, p0 + i) - NCTX) * 1024 + ch];
#pragma unroll
    for (int i = 0; i < 16; ++i) { const size_t lrow = (size_t)(lru_pos_row(b, false, p0 + i) - NCTX) * 1024 + ch;
        ((bf16*)(a.ws + WS_YB))[lrow] = (bf16)f2bf(hs[i] * bf2f(ugv[i])); }
    WG_BAR();
}
__device__ __forceinline__ void phase3(const Args& a, unsigned char* lds_g, int tid) {
    {
        int q0 = (int)blockIdx.x, qstep = (int)gridDim.x;
        if (gridDim.x == 256) q0 = blockIdx.x >= 128 ? (int)blockIdx.x - 128 : 128;
        for (int qu = q0; qu < 128; qu += qstep) ml_state_quad(a, lds_g, qu, tid);
    }
    for (int u = blockIdx.x; u < 4 * 36 * 8; u += gridDim.x) { const int blk = u & 7, q = u >> 3; lru_unit<false>(a, lds_g, q / 36, q % 36, blk, tid); }
}

struct SchedProj {
    int G, c; const char *YA, *YB, *WA, *WB;
    __device__ __forceinline__ bool next(int i, pg8::Unit& u) const {
        const int tile = (i >> 1) * G + c, part = i & 1; if (tile >= 256) return false;
        int pm, pn; pg8::tile_order(tile, 32, 8, pm, pn);
        u.pm = pm; u.pn = pn; u.aux = part; u.A = (part ? YB : YA) + (size_t)pm * 256 * 1024 * 2; u.B = (part ? WB : WA) + (size_t)pn * 256 * 1024 * 2; return true;
    }
};
struct EpiProj {
    static constexpr bool PERM = true, CARRY = true;
    const bf16 *GA, *GB; bf16* PRE;
    __device__ __forceinline__ bool keep(const pg8::Unit& u) const { return u.aux == 0; }
    __device__ __forceinline__ void operator()(pg8::f32x4 (&acc)[2][2][4][2], const pg8::Unit& u, int wr, int wc, int fr, int fq) const {
#pragma unroll
        for (int ai = 0; ai < 2; ++ai) {
            pg8::u32x4 gb4[4][2], ga4[4][2];
#pragma unroll
            for (int m = 0; m < 4; ++m) { const size_t off = (size_t)(u.pm * 256 + ai * 128 + wr * 64 + m * 16 + fr) * 2048 + u.pn * 256 + wc * 32 + 8 * fq;
#pragma unroll
                for (int bj = 0; bj < 2; ++bj) { gb4[m][bj] = *(const pg8::u32x4*)(GB + off + bj * 128); if (u.aux == 0) ga4[m][bj] = *(const pg8::u32x4*)(GA + off + bj * 128); } }
#pragma unroll
            for (int m = 0; m < 4; ++m) { const size_t off = (size_t)(u.pm * 256 + ai * 128 + wr * 64 + m * 16 + fr) * 2048 + u.pn * 256 + wc * 32 + 8 * fq;
#pragma unroll
                for (int bj = 0; bj < 2; ++bj) { const pg8::u32x4 g4 = gb4[m][bj];
                    const float gbv[8] = {bflo(g4.x), bfhi(g4.x), bflo(g4.y), bfhi(g4.y), bflo(g4.z), bfhi(g4.z), bflo(g4.w), bfhi(g4.w)};
                    if (u.aux == 0) { const pg8::u32x4 a4 = ga4[m][bj];
                        const float gav[8] = {bflo(a4.x), bfhi(a4.x), bflo(a4.y), bfhi(a4.y), bflo(a4.z), bfhi(a4.z), bflo(a4.w), bfhi(a4.w)};
#pragma unroll
                        for (int e = 0; e < 4; ++e) { acc[ai][bj][m][0][e] *= gav[e] * __builtin_amdgcn_rcpf(fmaxf(gbv[e], 1e-20f)); acc[ai][bj][m][1][e] *= gav[4 + e] * __builtin_amdgcn_rcpf(fmaxf(gbv[4 + e], 1e-20f)); }
                    } else {
                        pg8::f32x4 v0 = acc[ai][bj][m][0], v1 = acc[ai][bj][m][1];
#pragma unroll
                        for (int e = 0; e < 4; ++e) { v0[e] *= gbv[e]; v1[e] *= gbv[4 + e]; }
                        pg8::u32x4 w; w.x = pg8::cvt_pk_bf16(v0[0], v0[1]); w.y = pg8::cvt_pk_bf16(v0[2], v0[3]); w.z = pg8::cvt_pk_bf16(v1[0], v1[1]); w.w = pg8::cvt_pk_bf16(v1[2], v1[3]);
                        *(pg8::u32x4*)(PRE + off + bj * 128) = w; } } }
        }
    }
};

struct SchedOut {
    int G, c; const char *A, *B;
    __device__ __forceinline__ bool next(int i, pg8::Unit& u) const {
        const int L = i * G + c; if (L >= 256) return false;
        int pm, pn; pg8::tile_order(L, 32, 8, pm, pn);
        u.pm = pm; u.pn = pn; u.aux = 0; u.A = A + (size_t)pm * 256 * D * 2; u.B = B + (size_t)pn * 256 * D * 2; return true;
    }
};
struct EpiOut {
    static constexpr bool PERM = true, CARRY = false;
    __device__ __forceinline__ bool keep(const pg8::Unit&) const { return false; }
    const float* x; const float* MOD; bf16* X1;
    __device__ __forceinline__ void operator()(const pg8::f32x4 (&acc)[2][2][4][2], const pg8::Unit& u, int wr, int wc, int fr, int fq) const {
        const int b = u.pm >> 3; const int col0 = u.pn * 256 + wc * 32 + 8 * fq;
        pg8::f32x4 g1[2][2];
#pragma unroll
        for (int bj = 0; bj < 2; ++bj)
#pragma unroll
            for (int n = 0; n < 2; ++n) g1[bj][n] = *(const pg8::f32x4*)(MOD + b * 12288 + 2 * 2048 + col0 + bj * 128 + n * 4);
#pragma unroll
        for (int ai = 0; ai < 2; ++ai) {
            pg8::f32x4 xv[4][2][2];
#pragma unroll
            for (int m = 0; m < 4; ++m) { const size_t off = (size_t)(u.pm * 256 + ai * 128 + wr * 64 + m * 16 + fr) * D + col0;
#pragma unroll
                for (int bj = 0; bj < 2; ++bj)
#pragma unroll
                    for (int n = 0; n < 2; ++n) xv[m][bj][n] = *(const pg8::f32x4*)(x + off + bj * 128 + n * 4); }
#pragma unroll
            for (int m = 0; m < 4; ++m) { const size_t off = (size_t)(u.pm * 256 + ai * 128 + wr * 64 + m * 16 + fr) * D + col0;
#pragma unroll
                for (int bj = 0; bj < 2; ++bj) { const pg8::f32x4 v0 = xv[m][bj][0] + g1[bj][0] * acc[ai][bj][m][0], v1 = xv[m][bj][1] + g1[bj][1] * acc[ai][bj][m][1];
                    pg8::u32x4 w; w.x = pg8::cvt_pk_bf16(v0[0], v0[1]); w.y = pg8::cvt_pk_bf16(v0[2], v0[3]); w.z = pg8::cvt_pk_bf16(v1[0], v1[1]); w.w = pg8::cvt_pk_bf16(v1[2], v1[3]);
                    *(pg8::u32x4*)(X1 + off + bj * 128) = w; } }
        }
    }
};

__device__ __forceinline__ void phase_router(const Args& a, unsigned char* lds_g, int tid, int lane, int wave) {
    const bf16* X1 = (const bf16*)(a.ws + WS_X1); const float* MOD = (const float*)(a.ws + WS_MOD); const float* g = a.in[I_N2G];
    const float* WR = (const float*)(a.ws + WS_WR); const float* RB = (const float*)(a.ws + WS_RB);
    bf16* H2 = (bf16*)(a.ws + WS_H2); unsigned* cnt = (unsigned*)(a.ws + WS_CTL) + CW_CNT; int4* ASG = (int4*)(a.ws + WS_ASG);
    f32x4* PART = (f32x4*)lds_g;
    float* SSQP = (float*)(lds_g + 24576);
    float* RS = (float*)(lds_g + 24576 + 512);
    float* LG = (float*)(lds_g + 24576 + 1024);
    const int slot = wave >> 2, kq = wave & 3, i = lane & 15, gq = lane >> 4;
    for (int tp = blockIdx.x; tp < NLAT / 32; tp += gridDim.x) {
        const int tok0 = 32 * tp + 16 * slot, b = tok0 >> 11, kbase = kq * 512 + 8 * gq;
        const bf16* xr = X1 + (size_t)(tok0 + i) * D + kbase;
        const float* wr = WR + ((size_t)(b * 48 + i) * 2048 + kbase);
        f32x4 acc0 = (f32x4){0.f, 0.f, 0.f, 0.f}, acc1 = acc0, acc2 = acc0; float sq = 0.f;
#pragma unroll 2
        for (int s8 = 0; s8 < 16; ++s8) {
            const v4u xb = *(const v4u*)(xr + 32 * s8);
            const f32x4 b0a = *(const f32x4*)(wr + 32 * s8), b0b = *(const f32x4*)(wr + 32 * s8 + 4), b1a = *(const f32x4*)(wr + 16 * 2048 + 32 * s8), b1b = *(const f32x4*)(wr + 16 * 2048 + 32 * s8 + 4),
                        b2a = *(const f32x4*)(wr + 32 * 2048 + 32 * s8), b2b = *(const f32x4*)(wr + 32 * 2048 + 32 * s8 + 4);
            const float xe[8] = {bflo(xb.x), bfhi(xb.x), bflo(xb.y), bfhi(xb.y), bflo(xb.z), bfhi(xb.z), bflo(xb.w), bfhi(xb.w)};
#pragma unroll
            for (int e = 0; e < 4; ++e) { acc0 = __builtin_amdgcn_mfma_f32_16x16x4f32(xe[e], b0a[e], acc0, 0, 0, 0); acc1 = __builtin_amdgcn_mfma_f32_16x16x4f32(xe[e], b1a[e], acc1, 0, 0, 0); acc2 = __builtin_amdgcn_mfma_f32_16x16x4f32(xe[e], b2a[e], acc2, 0, 0, 0); }
#pragma unroll
            for (int e = 0; e < 4; ++e) { acc0 = __builtin_amdgcn_mfma_f32_16x16x4f32(xe[4 + e], b0b[e], acc0, 0, 0, 0); acc1 = __builtin_amdgcn_mfma_f32_16x16x4f32(xe[4 + e], b1b[e], acc1, 0, 0, 0); acc2 = __builtin_amdgcn_mfma_f32_16x16x4f32(xe[4 + e], b2b[e], acc2, 0, 0, 0); }
#pragma unroll
            for (int e = 0; e < 8; ++e) sq += xe[e] * xe[e];
        }
        sq += __shfl_xor(sq, 16); sq += __shfl_xor(sq, 32);
        PART[((slot * 4 + kq) * 3 + 0) * 64 + lane] = acc0; PART[((slot * 4 + kq) * 3 + 1) * 64 + lane] = acc1; PART[((slot * 4 + kq) * 3 + 2) * 64 + lane] = acc2;
        if (gq == 0) SSQP[(slot * 4 + kq) * 16 + i] = sq;
        __syncthreads();
        if (kq == 0) {
            const float* sp = SSQP + slot * 64; const float rstd = 1.f / sqrtf(((sp[i] + sp[16 + i]) + (sp[32 + i] + sp[48 + i])) * (1.f / D) + EPS);
            if (gq == 0) RS[slot * 16 + i] = rstd;
#pragma unroll
            for (int cb = 0; cb < 3; ++cb) { const f32x4* pp = PART + (slot * 4 * 3 + cb) * 64 + lane; const f32x4 sum = (pp[0] + pp[3 * 64]) + (pp[6 * 64] + pp[9 * 64]);
                const float rb = RB[b * 48 + 16 * cb + i];
#pragma unroll
                for (int r = 0; r < 4; ++r) LG[(slot * 16 + 4 * gq + r) * 48 + 16 * cb + i] = __shfl(rstd, 4 * gq + r) * sum[r] + rb; }
            LDS_WAIT(); asm volatile("" ::: "memory");
            if (lane < 16) {
                const float* lg = LG + (slot * 16 + lane) * 48; const int t = tok0 + lane;
                int gs = 0; float gm = lg[32];
#pragma unroll
                for (int q = 1; q < 4; ++q) { const float v = lg[32 + q]; if (v > gm) { gm = v; gs = q; } }
                float se = 0.f;
#pragma unroll
                for (int q = 0; q < 4; ++q) se += __expf(lg[32 + q] - gm);
                const float pg = 1.f / se;
                int i0 = 0; float v0 = lg[gs * 8];
#pragma unroll
                for (int q = 1; q < 8; ++q) { const float v = lg[gs * 8 + q]; if (v > v0) { v0 = v; i0 = q; } }
                int i1 = -1; float v1 = -3.0e38f;
#pragma unroll
                for (int q = 0; q < 8; ++q) { const float v = lg[gs * 8 + q]; if (q != i0 && v > v1) { v1 = v; i1 = q; } }
                const float e1 = __expf(v1 - v0), w0 = pg / (1.f + e1), w1 = pg * e1 / (1.f + e1);
                const int ex0 = gs * 8 + i0, ex1 = gs * 8 + i1;
                const unsigned p0 = atomicAdd(cnt + ex0, 1u), p1 = atomicAdd(cnt + ex1, 1u);
                ASG[2 * t] = make_int4(ex0, (int)p0, __float_as_int(w0), 0); ASG[2 * t + 1] = make_int4(ex1, (int)p1, __float_as_int(w1), 0);
                int* LIST = (int*)(a.ws + WS_LIST); LIST[ex0 * 8192 + (int)p0] = t; LIST[ex1 * 8192 + (int)p1] = t;
            }
        }
        __syncthreads();
#pragma unroll
        for (int r = 0; r < 4; ++r) { const int tl = 4 * kq + r, t = tok0 + tl; const float rstd = RS[slot * 16 + tl];
            const unsigned long long* xrow = (const unsigned long long*)(X1 + (size_t)t * D) + lane; unsigned* o4 = (unsigned*)((unsigned char*)H2 + (size_t)t * D) + lane;
            f32x4 yv[8];
#pragma unroll
            for (int j = 0; j < 8; ++j) { const int c = 4 * lane + 256 * j;
                const f32x4 gg = *(const f32x4*)(g + c), sh = *(const f32x4*)(MOD + b * 12288 + 3 * 2048 + c), sc = *(const f32x4*)(MOD + b * 12288 + 4 * 2048 + c);
                const unsigned long long xw = xrow[64 * j]; const f32x4 xv4 = (f32x4){bflo((unsigned)xw), bfhi((unsigned)xw), bflo((unsigned)(xw >> 32)), bfhi((unsigned)(xw >> 32))};
                yv[j] = xv4 * rstd * gg * (sc + 1.f) + sh; }
#pragma unroll
            for (int j = 0; j < 8; ++j) { int w8 = __builtin_amdgcn_cvt_pk_fp8_f32(yv[j].x, yv[j].y, 0, false); w8 = __builtin_amdgcn_cvt_pk_fp8_f32(yv[j].z, yv[j].w, w8, true); o4[64 * j] = (unsigned)w8; } }
        __syncthreads();
    }
}

constexpr int MG_A = 0, MG_ABYTES = 32768, MG_B = 65536, MG_BBYTES = 64 * 256  , MG_CUM = 141312  ;
__device__ __forceinline__ int mgb_off(int row, int ch) { return 256 * row + 16 * (ch ^ (((row & 3) << 2) | ((row >> 2) & 3))); }
__device__ __forceinline__ bf16x8_t mgb_frag(const unsigned char* img, int ks, int c, int lane) {
    const int g = lane >> 4, q = (lane & 15) >> 2, p = lane & 3;
    const s4_t lo = ds_tr((const bf16*)(img + mgb_off(32 * ks + 8 * g + q, 2 * c + (p >> 1)) + 8 * (p & 1)));
    const s4_t hi = ds_tr((const bf16*)(img + mgb_off(32 * ks + 8 * g + 4 + q, 2 * c + (p >> 1)) + 8 * (p & 1)));
    return (bf16x8_t){lo.x, lo.y, lo.z, lo.w, hi.x, hi.y, hi.z, hi.w};
}
__device__ __forceinline__ void moe_tables(const Args& a, unsigned char* lds_g, int tid) {
    int* cum = (int*)(lds_g + MG_CUM); const unsigned* ctl = (const unsigned*)(a.ws + WS_CTL);
    if (tid < NEXP) cum[128 + tid] = (int)ctl[CW_CNT + tid];
    if (tid == 0) { int c = 0; for (int e = 0; e < NEXP; ++e) { cum[e] = c; c += (int)((ctl[CW_CNT + e] + 255u) >> 8); } cum[NEXP] = c; }
    __syncthreads();
}
constexpr int MH_A = 0, MH_ABYTES = 32768, MH_B = 65536, MH_BROW = 528, MH_BBYTES = 64 * MH_BROW  ;
__device__ __forceinline__ int mhb_off(int row, int ch) { return MH_BROW * row + 16 * ch; }
__device__ __forceinline__ bf16x8_t mhb_frag(const LAS unsigned char* lbase, int cofs) {
    const s4_t lo = __builtin_amdgcn_ds_read_tr16_b64_v4i16((LAS s4_t*)(lbase + cofs));
    const s4_t hi = __builtin_amdgcn_ds_read_tr16_b64_v4i16((LAS s4_t*)(lbase + cofs + MH_BROW));
    return (bf16x8_t){lo.x, lo.y, lo.z, lo.w, hi.x, hi.y, hi.z, hi.w};
}
__device__ __forceinline__ int moe_pull(const Args& a, unsigned char* lds_g, int w, int x) {
    int* slot = (int*)(lds_g + MG_CUM + 256);
    __syncthreads();
    if (w == 0 && fresh_lane() == 0) *slot = (int)__hip_atomic_fetch_add((unsigned*)(a.ws + WS_CTL) + CW_Q + 64 * x, 1u, __ATOMIC_RELAXED, __HIP_MEMORY_SCOPE_AGENT);
    __syncthreads();
    return __builtin_amdgcn_readfirstlane(*slot);
}
__device__ __forceinline__ unsigned f8pair_lo(unsigned w) { const auto v = __builtin_amdgcn_cvt_pk_f32_fp8((int)w, false); return pk2(v[0], v[1]); }
__device__ __forceinline__ unsigned f8pair_hi(unsigned w) { const auto v = __builtin_amdgcn_cvt_pk_f32_fp8((int)w, true); return pk2(v[0], v[1]); }
template <int MODE>
__device__ __forceinline__ int moe_gemm(const Args& a, unsigned char* lds_g, int tid, int idx0) {
    constexpr int K = MODE == 1 ? D : DE, NT = K / 64;
#define MG_BAR() do { asm volatile("s_waitcnt lgkmcnt(0)" ::: "memory"); __builtin_amdgcn_s_barrier(); asm volatile("" ::: "memory"); } while (0)
    const int w = __builtin_amdgcn_readfirstlane(tid >> 6);
    const int wm = w >> 1, wn = w & 1, hh = wm >> 1, wr = wm & 1;
    const int* cum = (const int*)(lds_g + MG_CUM); const unsigned* ctl = (const unsigned*)(a.ws + WS_CTL);
    const int T = cum[NEXP], x = blockIdx.x & 7;
    for (int idx = idx0;;) {
        if (idx < 0) idx = moe_pull(a, lds_g, w, x);
        if (idx >= (MODE == 1 ? T : 2 * T)) return idx;
        const int ti = MODE == 1 ? idx : idx - T;
        idx = -1;
        const int nt = x;
        if (MODE == 2) {
            if (w == 0) { unsigned* tc = (unsigned*)(a.ws + WS_CTL) + CW_TC + 64 * ti; unsigned spins = 0;
                while ((unsigned)__builtin_amdgcn_readfirstlane(__hip_atomic_load(tc, __ATOMIC_RELAXED, __HIP_MEMORY_SCOPE_AGENT)) < 64u) {
                    __builtin_amdgcn_s_sleep(2);
                    if (++spins > (1u << 22)) { if (fresh_lane() == 0) __hip_atomic_store((unsigned*)(a.ws + WS_CTL) + 1, 0x900u + (unsigned)ti, __ATOMIC_RELAXED, __HIP_MEMORY_SCOPE_AGENT); break; } }
                __builtin_amdgcn_fence(__ATOMIC_ACQUIRE, "agent");
                asm volatile("s_waitcnt vmcnt(0)" ::: "memory"); }
            __syncthreads();
        }
        const int lane = fresh_lane(), tidu = w * 64 + lane, fr = lane & 15, fq = lane >> 4;
        const int aoff = pg8::lds_byte(wr * 64 + fr, fq * 8);
        const int bk = w, bp = lane;
        int e = 0;
#pragma unroll 1
        for (int q = 1; q < NEXP; ++q) e = (cum[q] <= ti) ? q : e;
        e = __builtin_amdgcn_readfirstlane(e);
        const int mt = __builtin_amdgcn_readfirstlane(ti - cum[e]);
        unsigned aofs[4]; unsigned bofs; int bwr0;
        __amdgpu_buffer_rsrc_t rsA, rsB, rsB3;
        if (MODE == 1) { const int cnt = cum[128 + e];
#pragma unroll
            for (int q = 0; q < 2; ++q) { const int pos = 256 * mt + 128 * q + (tidu >> 2); const int tok = pos < cnt ? ((const int*)(a.ws + WS_LIST))[e * 8192 + pos] : 0;
                aofs[q] = (unsigned)(tok * D + 16 * (tidu & 3)); }
            aofs[2] = aofs[3] = 0u;
            rsA = __builtin_amdgcn_make_buffer_rsrc((void*)(a.ws + WS_H2), 0, 0x7fffffff, 0x00020000);
            rsB = __builtin_amdgcn_make_buffer_rsrc((void*)(a.in[I_W1] + (size_t)e * D * DE), 0, 0x7fffffff, 0x00020000); rsB3 = __builtin_amdgcn_make_buffer_rsrc((void*)(a.in[I_W3] + (size_t)e * D * DE), 0, 0x7fffffff, 0x00020000);
            bofs = (unsigned)((bk + 8 * (bp >> 5)) * DE + 128 * nt + 4 * (bp & 31)) * 4u;
            bwr0 = MH_BROW * (2 * (bk & 3) + (bk >> 2) + 8 * (bp >> 5)) + 2 * (128 * ((bp & 31) >> 4) + 4 * (bp & 15)); }
        else {
#pragma unroll
            for (int q = 0; q < 2; ++q) aofs[q] = (unsigned)((128 * q + (tidu >> 2)) * DE + 16 * (tidu & 3));
            aofs[2] = aofs[3] = 0u;
            rsA = __builtin_amdgcn_make_buffer_rsrc((void*)((const unsigned char*)(a.ws + WS_HM) + (size_t)256 * ti * DE), 0, 0x7fffffff, 0x00020000);
            rsB = __builtin_amdgcn_make_buffer_rsrc((void*)(a.in[I_W2] + (size_t)e * DE * D), 0, 0x7fffffff, 0x00020000); rsB3 = rsB;
            bofs = (unsigned)(bk * D + 256 * nt + 4 * bp) * 4u; bwr0 = MH_BROW * (2 * (bk & 3) + (bk >> 2)) + 2 * (128 * (bp >> 5) + 32 * ((bp & 31) >> 3) + 16 * (bp & 1) + 4 * ((bp >> 1) & 3)); }
        const LAS unsigned char* blane = (const LAS unsigned char*)lds_g + MH_B + mhb_off(16 * (lane >> 5) + 8 * ((lane >> 4) & 1) + 2 * ((lane & 15) >> 2), 16 * wn + ((lane & 3) >> 1)) + 8 * (lane & 1);
        f32x4 acc[4][8];
#pragma unroll
        for (int m = 0; m < 4; ++m)
#pragma unroll
            for (int n = 0; n < 8; ++n) acc[m][n] = (f32x4){0.f, 0.f, 0.f, 0.f};
        v4u ra[4]; f32x4 rb[8];
#define MH_MMA(buf_) do { const LAS unsigned char* Bi_ = blane + (buf_) * MH_BBYTES; \
        bf16x8_t bc0_ = mhb_frag(Bi_, 0), bc1_ = mhb_frag(Bi_, 32); \
        _Pragma("unroll") for (int ks_ = 0; ks_ < 2; ++ks_) { bf16x8_t af_[4]; \
            _Pragma("unroll") for (int m_ = 0; m_ < 4; ++m_) af_[m_] = *(const bf16x8_t*)(lds_g + MH_A + (buf_) * MH_ABYTES + hh * 16384 + aoff + m_ * 2048 + ks_ * 1024); \
            _Pragma("unroll") for (int n_ = 0; n_ < 8; n_ += 2) { bf16x8_t bn0_ = bc0_, bn1_ = bc1_; \
                if (n_ + 2 < 8) { bn0_ = mhb_frag(Bi_, 32 * ks_ * MH_BROW + 32 * (n_ + 2)); bn1_ = mhb_frag(Bi_, 32 * ks_ * MH_BROW + 32 * (n_ + 3)); } \
                else if (ks_ == 0) { bn0_ = mhb_frag(Bi_, 32 * MH_BROW); bn1_ = mhb_frag(Bi_, 32 * MH_BROW + 32); } \
                __builtin_amdgcn_sched_barrier(0); \
                _Pragma("unroll") for (int m_ = 0; m_ < 4; ++m_) { acc[m_][n_] = __builtin_amdgcn_mfma_f32_16x16x32_bf16(bc0_, af_[m_], acc[m_][n_], 0, 0, 0); \
                    acc[m_][n_ + 1] = __builtin_amdgcn_mfma_f32_16x16x32_bf16(bc1_, af_[m_], acc[m_][n_ + 1], 0, 0, 0); } \
                __builtin_amdgcn_sched_barrier(0); bc0_ = bn0_; bc1_ = bn1_; } } } while (0)
        {
            const int awr = pg8::lds_byte(tidu >> 2, 16 * (tidu & 3));
#define MH_LDB(t_) do { _Pragma("unroll") for (int j_ = 0; j_ < 8; ++j_) rb[j_] = __builtin_bit_cast(f32x4, MODE == 1 ? __builtin_amdgcn_raw_buffer_load_b128((j_ & 1) ? rsB3 : rsB, bofs, (64 * (t_) + 16 * (j_ >> 1)) * DE * 4, 0) \
                                                                                                   : __builtin_amdgcn_raw_buffer_load_b128(rsB, bofs, (64 * (t_) + 8 * j_) * D * 4, 0)); } while (0)
#define MH_LDA(te_, to_) do { ra[0] = __builtin_amdgcn_raw_buffer_load_b128(rsA, aofs[0], 64 * (te_), 0); ra[1] = __builtin_amdgcn_raw_buffer_load_b128(rsA, aofs[1], 64 * (te_), 0); \
            ra[2] = __builtin_amdgcn_raw_buffer_load_b128(rsA, aofs[0], 64 * (to_), 0); ra[3] = __builtin_amdgcn_raw_buffer_load_b128(rsA, aofs[1], 64 * (to_), 0); } while (0)
#define MH_F8(w_) f8pair_lo(w_), f8pair_hi(w_)
#define MH_STA(buf_, x_) do { _Pragma("unroll") for (int h_ = 0; h_ < 2; ++h_) { const v4u p_ = ra[(x_) + h_]; \
            *(v4u*)(lds_g + MH_A + (buf_) * MH_ABYTES + h_ * 16384 + awr) = (v4u){MH_F8(p_.x), MH_F8(p_.y)}; __builtin_amdgcn_sched_barrier(0); \
            *(v4u*)(lds_g + MH_A + (buf_) * MH_ABYTES + h_ * 16384 + awr + 16) = (v4u){MH_F8(p_.z), MH_F8(p_.w)}; __builtin_amdgcn_sched_barrier(0); } } while (0)
#define MH_STB(buf_) do { _Pragma("unroll") for (int j_ = 0; j_ < 8; ++j_) { pg8::u32x2 o_; o_.x = pk2(rb[j_].x, rb[j_].y); o_.y = pk2(rb[j_].z, rb[j_].w); \
            *(pg8::u32x2*)(lds_g + MH_B + (buf_) * MH_BBYTES + bwr0 + (MODE == 1 ? (j_ >> 1) * 16 * MH_BROW + (j_ & 1) * 128 : j_ * 8 * MH_BROW)) = o_; } } while (0)
            MH_LDA(0, 1); MH_LDB(0);
            MG_BAR();
            MH_STA(0, 0); MH_STB(0);
            MH_LDB(1);
            for (int t = 0; t < NT; t += 2) {
                const int t2 = (t + 2 < NT) ? t + 2 : NT - 1, t3 = (t + 3 < NT) ? t + 3 : NT - 1;
                MG_BAR();
                MH_STA(1, 2); MH_STB(1);
                MH_LDA(t2, t3); MH_LDB(t2);
                MH_MMA(0);
                MG_BAR();
                MH_STA(0, 0); MH_STB(0);
                MH_LDB(t3);
                MH_MMA(1);
            }
#undef MH_LDB
#undef MH_LDA
#undef MH_F8
#undef MH_STA
#undef MH_STB
        }
#undef MH_MMA
        const int ln_ = fresh_lane();
        const int efr = ln_ & 15, efq = ln_ >> 4;
        if (MODE == 1) { unsigned char* HM = (unsigned char*)(a.ws + WS_HM) + (size_t)256 * ti * DE + 128 * nt + 64 * wn; const unsigned lo_ = (unsigned)((128 * hh + 64 * wr + efr) * DE + 4 * efq);
#pragma unroll
            for (int m = 0; m < 4; ++m)
#pragma unroll
                for (int n = 0; n < 4; ++n) { float hv[4];
#pragma unroll
                    for (int r = 0; r < 4; ++r) { const float a1 = acc[m][n][r]; hv[r] = a1 * sigmoidf_(a1) * acc[m][n + 4][r]; }
                    int w8 = __builtin_amdgcn_cvt_pk_fp8_f32(hv[0], hv[1], 0, false); w8 = __builtin_amdgcn_cvt_pk_fp8_f32(hv[2], hv[3], w8, true);
                    __hip_atomic_store((unsigned*)(HM + lo_ + 16 * m * DE + 16 * n), (unsigned)w8, __ATOMIC_RELAXED, __HIP_MEMORY_SCOPE_AGENT); }
            asm volatile("s_waitcnt vmcnt(0)" ::: "memory");
            if (ln_ == 0) __hip_atomic_fetch_add((unsigned*)(a.ws + WS_CTL) + CW_TC + 64 * ti, 1u, __ATOMIC_RELAXED, __HIP_MEMORY_SCOPE_AGENT); }
        else { bf16* Y2 = (bf16*)(a.ws + WS_Y2) + (size_t)256 * ti * D + 256 * nt + 128 * wn; const unsigned lo_ = (unsigned)((128 * hh + 64 * wr + efr) * D + 8 * efq);
#pragma unroll
            for (int m = 0; m < 4; ++m)
#pragma unroll
                for (int n = 0; n < 8; n += 2) { v4u o; o.x = pk2(acc[m][n][0], acc[m][n][1]); o.y = pk2(acc[m][n][2], acc[m][n][3]); o.z = pk2(acc[m][n + 1][0], acc[m][n + 1][1]); o.w = pk2(acc[m][n + 1][2], acc[m][n + 1][3]);
                    *(v4u*)(Y2 + lo_ + 16 * m * D + 16 * n) = o; } }
    }
#undef MG_BAR
}

__device__ __forceinline__ void phase12(const Args& a, unsigned char* lds_g, int lane, int wave) {
    const int gw = blockIdx.x * NWAVES + wave, NGW = gridDim.x * NWAVES;
    const int* cum = (const int*)(lds_g + MG_CUM);
    const bf16* X1 = (const bf16*)(a.ws + WS_X1); const float* MOD = (const float*)(a.ws + WS_MOD); const float* fg = a.in[I_FG];
    const int4* ASG = (const int4*)(a.ws + WS_ASG); const bf16* Y2 = (const bf16*)(a.ws + WS_Y2);
    for (int t = gw; t < NLAT; t += NGW) {
        const int b = t >> 11; const int4 q0 = ASG[2 * t], q1 = ASG[2 * t + 1];
        const float w0 = __int_as_float(q0.z), w1 = __int_as_float(q1.z);
        const unsigned long long* xr = (const unsigned long long*)(X1 + (size_t)t * D) + lane;
        const unsigned long long* y0 = (const unsigned long long*)(Y2 + (size_t)(256 * cum[q0.x] + q0.y) * D) + lane; const unsigned long long* y1 = (const unsigned long long*)(Y2 + (size_t)(256 * cum[q1.x] + q1.y) * D) + lane;
        f32x4 v[8]; float s = 0.f;
#pragma unroll
        for (int j = 0; j < 8; ++j) {
            const int c = 4 * lane + 256 * j;
            const f32x4 g2 = *(const f32x4*)(MOD + b * 12288 + 5 * 2048 + c);
            const unsigned long long a0 = y0[64 * j], a1 = y1[64 * j];
            f32x4 y; y.x = w0 * bflo((unsigned)a0) + w1 * bflo((unsigned)a1); y.y = w0 * bfhi((unsigned)a0) + w1 * bfhi((unsigned)a1);
            y.z = w0 * bflo((unsigned)(a0 >> 32)) + w1 * bflo((unsigned)(a1 >> 32)); y.w = w0 * bfhi((unsigned)(a0 >> 32)) + w1 * bfhi((unsigned)(a1 >> 32));
            const unsigned long long xw = xr[64 * j];
            v[j] = (f32x4){bflo((unsigned)xw), bfhi((unsigned)xw), bflo((unsigned)(xw >> 32)), bfhi((unsigned)(xw >> 32))} + g2 * y;
            s += (v[j].x * v[j].x + v[j].y * v[j].y) + (v[j].z * v[j].z + v[j].w * v[j].w);
        }
        const float rstd = 1.f / sqrtf(wave_sum(s) * (1.f / D) + EPS);
        f32x4* o = (f32x4*)(a.out + (size_t)t * D) + lane; f32x4 fgv[8];
#pragma unroll
        for (int j = 0; j < 8; ++j) fgv[j] = *(const f32x4*)(fg + 4 * lane + 256 * j);
#pragma unroll
        for (int j = 0; j < 8; ++j) o[64 * j] = v[j] * rstd * fgv[j];
    }
}

__global__ void __launch_bounds__(NTHR, 2) fwd_kernel(Args args) {
    extern __shared__ __attribute__((aligned(16))) unsigned char lds[];
    LAS unsigned char* ldsl = (LAS unsigned char*)lds;
    volatile LAS unsigned* MISC = (volatile LAS unsigned*)(ldsl + MISC_OFF);
    LAS unsigned* TL = (LAS unsigned*)(ldsl + LDSCTL_OFF);
    const int wave_s = __builtin_amdgcn_readfirstlane(threadIdx.x >> 6);
#define TID() make_tid(wave_s)
    { const int t0 = TID(); for (int u = t0; u < (LDS_BYTES - LDSCTL_OFF) / 4; u += NTHR) ((LAS unsigned*)(ldsl + LDSCTL_OFF))[u] = 0u; }
    __syncthreads();
    unsigned char* ws = args.ws;
    unsigned* ctl = (unsigned*)(ws + WS_CTL);
    XcdBarrier bar; bar.bar = ctl + CW_BAR; bar.x = 0; bar.st = nullptr;
    const bool one_launch = (args.ph_hi - args.ph_lo) > 1;
    if (one_launch) bar = xcd_barrier_post(ctl + CW_BAR, MISC + 8, TID());
    const int lo = args.ph_lo, hi = args.ph_hi;
#define IN(k) (lo <= (k) && (k) < hi)
#define SEAM(k) do { if (IN(k) && IN((k) + 1)) xcd_barrier(bar, TID()); } while (0)
    const int G = gridDim.x, c = blockIdx.x;

#define FRESH() const int tid = TID(), lane = tid & 63, wave = __builtin_amdgcn_readfirstlane(tid >> 6); (void)lane; (void)wave
#ifndef DUP_PHASE
#define DUP_PHASE (-1)
#endif
#define PH(k, ...) if (IN(k)) { _Pragma("unroll") for (int rep_ = 0; rep_ < ((DUP_PHASE) == (k) ? 2 : 1); ++rep_) { if (rep_) xcd_barrier(bar, TID()); __VA_ARGS__ } } SEAM(k);
    PH(0, { FRESH(); phase0(args, lds, tid, lane, wave); mod_wait(args, tid); phase1(args, lane, wave); })
    PH(1, {
        SchedIn S{G, c, (const char*)(ws + WS_H), (const char*)(ws + WS_WIN)}; EpiIn E{ws, args.in[I_BGATES]};
        pg8::gemm_phase<EpiIn, SchedIn>(ldsl, D, S, E, TID());
        { const int R_ = (1492 + G - 1) / G; int fi_ = 1492 - (R_ - 1) * G; if (fi_ >= G) fi_ = 0;
          if (c >= fi_) { FRESH(); late_prep(args, lds, (c - fi_) * NWAVES + wave, (G - fi_) * NWAVES, lane, wave); } } })
    PH(2, { FRESH(); phase3(args, lds, tid); })
    PH(3, { FRESH();
        for (int u = c; u < 256; u += G) ml_out_unit(args, lds, u, tid);
        for (int u = c; u < 4 * 32 * 8; u += G) { const int blk = u & 7, q = u >> 3; lru_out_unit(args, lds, q >> 5, 4 + (q & 31), blk, tid); } })
    PH(4, {
        SchedProj S{G, c, (const char*)(ws + WS_YA), (const char*)(ws + WS_YB), (const char*)(ws + WS_WPA), (const char*)(ws + WS_WPB)};
        EpiProj E{(const bf16*)(ws + WS_GA), (const bf16*)(ws + WS_GB), (bf16*)(ws + WS_PRE)};
        pg8::gemm_phase<EpiProj, SchedProj>(ldsl, 1024, S, E, TID()); })
    PH(5, {
        SchedOut S{G, c, (const char*)(ws + WS_PRE), (const char*)(ws + WS_WOUT)}; EpiOut E{args.in[I_X], (const float*)(ws + WS_MOD), (bf16*)(ws + WS_X1)};
        pg8::gemm_phase<EpiOut, SchedOut>(ldsl, D, S, E, TID()); })
    PH(6, { FRESH(); phase_router(args, lds, tid, lane, wave); })
    PH(7, { FRESH(); moe_tables(args, lds, tid); const int nx_ = moe_gemm<1>(args, lds, tid, -1); { const int tid2_ = TID(); (void)moe_gemm<2>(args, lds, tid2_, nx_); } })
    PH(8, { FRESH(); moe_tables(args, lds, tid); phase12(args, lds, lane, wave); })
#undef PH
#undef IN
#undef SEAM
}

extern "C" void kernel_launch(void* const* d_in, const int* in_sizes, int n_in, void* d_out, int out_size, void* d_ws, size_t ws_size, hipStream_t stream) {
    static int grid = 0;
    if (grid == 0) {
        if (n_in != 27 || out_size != NLAT * D || ws_size < WS_END) { fprintf(stderr, "kernel_launch: unexpected shapes (n_in %d, out %d, ws %zu)\n", n_in, out_size, ws_size); grid = -1; return; }
        int dev = 0, cus = 0, per_cu = 0;
        if (hipGetDevice(&dev) != hipSuccess || hipDeviceGetAttribute(&cus, hipDeviceAttributeMultiprocessorCount, dev) != hipSuccess) { grid = -1; return; }
        if (hipFuncSetAttribute((const void*)fwd_kernel, hipFuncAttributeMaxDynamicSharedMemorySize, LDS_BYTES) != hipSuccess) { fprintf(stderr, "kernel_launch: hipFuncSetAttribute failed\n"); grid = -1; return; }
        if (hipOccupancyMaxActiveBlocksPerMultiprocessor(&per_cu, (const void*)fwd_kernel, NTHR, LDS_BYTES) != hipSuccess || per_cu < 1) fprintf(stderr, "kernel_launch: occupancy query says %d\n", per_cu);
        (void)hipGetLastError();
        grid = cus;
    }
    if (grid < 0) return;
    (void)hipMemsetAsync((char*)d_ws + WS_CTL, 0, CTL_ZERO_BYTES, stream);
    Args a{};
    for (int i = 0; i < 27; ++i) a.in[i] = (const float*)d_in[i];
    a.out = (float*)d_out; a.ws = (unsigned char*)d_ws;
#if MK_ONE_LAUNCH
    a.ph_lo = 0; a.ph_hi = NPHASE;
    hipLaunchKernelGGL(fwd_kernel, dim3(grid), dim3(NTHR), LDS_BYTES, stream, a);
#else
    for (int p = 0; p < NPHASE; ++p) { a.ph_lo = p; a.ph_hi = p + 1; hipLaunchKernelGGL(fwd_kernel, dim3(grid), dim3(NTHR), LDS_BYTES, stream, a); }
#endif
}
```

```cpp
#include <hip/hip_runtime.h>
#include <cstdio>
#include <cstdint>

#ifndef MK_ONE_LAUNCH
#define MK_ONE_LAUNCH 1
#endif

namespace pg8 {
#define PG8_LAS __attribute__((address_space(3)))
typedef unsigned short bf16_t;
typedef short bf16x8 __attribute__((ext_vector_type(8)));
typedef float f32x4 __attribute__((ext_vector_type(4)));
typedef float f32x2 __attribute__((ext_vector_type(2)));
typedef unsigned u32x4 __attribute__((ext_vector_type(4)));
typedef unsigned u32x2 __attribute__((ext_vector_type(2)));
constexpr int BM = 256, BK = 64, HALF = 128, HTB = HALF * BK * 2  , STAGE_BYTES = 8 * HTB, NXCD = 8, WGM = 8;

__host__ __device__ __forceinline__ int lds_byte(int r, int c) { const int st = (r >> 4) * 2 + (c >> 5), rr = r & 15, cc = c & 31, ob = rr * 64 + cc * 2; return st * 1024 + (ob ^ (((ob >> 9) & 1) << 5)); }
__host__ __device__ __forceinline__ void stage_rc(int b, int& R, int& C) { const int st = b / 1024, sb = b % 1024, swz = sb ^ (((sb >> 9) & 1) << 5); R = (st >> 1) * 16 + swz / 64; C = (st & 1) * 32 + (swz % 64) / 2; }
__host__ __device__ __forceinline__ int perm32(int rho) { const int n = rho >> 4, i = rho & 15; return 8 * (i >> 2) + 4 * n + (i & 3); }

struct Unit { const char* A; const char* B; int pm, pn, aux; };

__host__ __device__ __forceinline__ void tile_order(int L, int nM, int nN, int& pm, int& pn) {
    const int nwg = nM * nN; int wgid = L;
    { const int q = nwg / NXCD, r = nwg % NXCD, xcd = wgid % NXCD, off = wgid / NXCD; wgid = (xcd < r ? xcd * (q + 1) : r * (q + 1) + (xcd - r) * q) + off; }
    const int nig = WGM * nN, gid = wgid / nig, fm = gid * WGM, gsz = (nM - fm) < WGM ? (nM - fm) : WGM;
    pm = fm + ((wgid % nig) % gsz); pn = (wgid % nig) / gsz;
}

typedef __bf16 bf16n2 __attribute__((ext_vector_type(2)));
__device__ __forceinline__ unsigned cvt_pk_bf16(float lo, float hi) { const f32x2 v = {lo, hi}; return __builtin_bit_cast(unsigned, __builtin_convertvector(v, bf16n2)); }

template <class Epi, class Sched>
__device__ __forceinline__ void gemm_phase(PG8_LAS unsigned char* lds, const int K, const Sched& S, const Epi& E, int tid) {
    const int wid = __builtin_amdgcn_readfirstlane(tid >> 6), lane = tid & 63, wr = wid >> 2, wc = wid & 3, fr = lane & 15, fq = lane >> 4;
    const int nt = K / BK;
    unsigned voffA[2], voffB[2];
#pragma unroll
    for (int i = 0; i < 2; ++i) { int R, C; stage_rc(tid * 16 + i * 8192, R, C); const int Rb = Epi::PERM ? ((R & ~31) + perm32(R & 31)) : R;
        voffA[i] = (unsigned)(R * K + C) * 2u; voffB[i] = (unsigned)(Rb * K + C) * 2u; }
    const size_t kstep = (size_t)(BK * 2);
    const size_t hstep = (size_t)HALF * K * 2;
    const unsigned ldsw = (unsigned)wid * 1024u;
    const int aoff = lds_byte(wr * 64 + fr, fq * 8), boff = lds_byte(wc * 32 + fr, fq * 8);
#define PG8_SA(b, h) (((b) * 2 + (h)) * HTB)
#define PG8_SB(b, h) ((4 + (b) * 2 + (h)) * HTB)
#define PG8_STAGE(bufoff, gbase, voff) do { _Pragma("unroll") for (int _i = 0; _i < 2; ++_i) \
        __builtin_amdgcn_global_load_lds((const unsigned*)((const char*)(gbase) + (voff)[_i]), (PG8_LAS unsigned*)(lds + (bufoff) + ldsw + _i * 8192), 16, 0, 0); } while (0)
#define PG8_LDA(dst, b, h) do { _Pragma("unroll") for (int m = 0; m < 4; ++m) _Pragma("unroll") for (int k = 0; k < 2; ++k) dst[m][k] = *(const PG8_LAS bf16x8*)(lds + PG8_SA(b, h) + aoff + m * 2048 + k * 1024); } while (0)
#define PG8_LDB(dst, b, h) do { _Pragma("unroll") for (int n = 0; n < 2; ++n) _Pragma("unroll") for (int k = 0; k < 2; ++k) dst[n][k] = *(const PG8_LAS bf16x8*)(lds + PG8_SB(b, h) + boff + n * 2048 + k * 1024); } while (0)
#define PG8_MMA(ai, bj, At, Bt) do { __builtin_amdgcn_s_setprio(1); _Pragma("unroll") for (int m = 0; m < 4; ++m) _Pragma("unroll") for (int n = 0; n < 2; ++n) _Pragma("unroll") for (int k = 0; k < 2; ++k) \
        acc[ai][bj][m][n] = __builtin_amdgcn_mfma_f32_16x16x32_bf16(Bt[n][k], At[m][k], acc[ai][bj][m][n], 0, 0, 0); __builtin_amdgcn_s_setprio(0); } while (0)
#define PG8_WAIT_V(n) asm volatile("s_waitcnt vmcnt(" #n ")" ::: "memory")
#define PG8_WAIT_L(n) asm volatile("s_waitcnt lgkmcnt(" #n ")" ::: "memory")
#define PG8_BAR __builtin_amdgcn_s_barrier()
#define PG8_SCHED __builtin_amdgcn_sched_barrier(0)
    Unit cur, nxt; int ui = 0;
    if (!S.next(0, cur)) return;
    f32x4 acc[2][2][4][2];
#pragma unroll
    for (int a = 0; a < 2; ++a)
#pragma unroll
        for (int b = 0; b < 2; ++b)
#pragma unroll
            for (int m = 0; m < 4; ++m)
#pragma unroll
                for (int n = 0; n < 2; ++n) acc[a][b][m][n] = (f32x4){0.f, 0.f, 0.f, 0.f};
    bf16x8 At[4][2], B0[2][2], B1[2][2];
    const char* cA = cur.A; const char* cB = cur.B;
    PG8_STAGE(PG8_SB(0, 0), cB, voffB); PG8_STAGE(PG8_SB(0, 1), cB + hstep, voffB); PG8_STAGE(PG8_SA(0, 0), cA, voffA); PG8_STAGE(PG8_SA(0, 1), cA + hstep, voffA);
    if (wr == 1) PG8_BAR;
    PG8_WAIT_V(2); PG8_BAR;
    PG8_STAGE(PG8_SB(1, 0), cB + kstep, voffB); PG8_STAGE(PG8_SA(1, 0), cA + kstep, voffA); PG8_STAGE(PG8_SB(1, 1), cB + hstep + kstep, voffB);
    PG8_WAIT_V(6); PG8_BAR;
    for (;;) {
        const bool has_next = S.next(ui + 1, nxt);
        const char* nA = has_next ? nxt.A : cA; const char* nB = has_next ? nxt.B : cB;
        for (int t = 0; t < nt; t += 2) {
            const bool last = (t == nt - 2);
            const char* a1 = cA + (size_t)(t + 1) * kstep;
            const char* a2 = last ? nA : cA + (size_t)(t + 2) * kstep; const char* b2 = last ? nB : cB + (size_t)(t + 2) * kstep;
            const char* a3 = a2 + kstep; const char* b3 = b2 + kstep;
            PG8_LDB(B0, 0, 0); PG8_LDB(B1, 0, 1); PG8_SCHED; PG8_LDA(At, 0, 0); PG8_STAGE(PG8_SA(1, 1), a1 + hstep, voffA);
            PG8_WAIT_V(8); PG8_WAIT_L(0); PG8_BAR; PG8_MMA(0, 0, At, B0); PG8_MMA(0, 1, At, B1); PG8_BAR; PG8_SCHED;
            PG8_LDA(At, 0, 1); PG8_STAGE(PG8_SB(0, 0), b2, voffB); PG8_STAGE(PG8_SB(0, 1), b2 + hstep, voffB); PG8_STAGE(PG8_SA(0, 0), a2, voffA);
            PG8_WAIT_V(8); PG8_WAIT_L(0); PG8_BAR; PG8_MMA(1, 0, At, B0); PG8_MMA(1, 1, At, B1); PG8_BAR; PG8_SCHED;
            PG8_LDB(B0, 1, 0); PG8_LDB(B1, 1, 1); PG8_SCHED; PG8_LDA(At, 1, 0); PG8_STAGE(PG8_SA(0, 1), a2 + hstep, voffA);
            PG8_WAIT_V(8); PG8_WAIT_L(0); PG8_BAR; PG8_MMA(0, 0, At, B0); PG8_MMA(0, 1, At, B1); PG8_BAR; PG8_SCHED;
            PG8_LDA(At, 1, 1); PG8_STAGE(PG8_SB(1, 0), b3, voffB); PG8_STAGE(PG8_SB(1, 1), b3 + hstep, voffB); PG8_STAGE(PG8_SA(1, 0), a3, voffA);
            PG8_WAIT_V(8); PG8_WAIT_L(0); PG8_BAR; PG8_MMA(1, 0, At, B0); PG8_MMA(1, 1, At, B1); PG8_BAR; PG8_SCHED;
        }
        if (wr == 0) PG8_BAR;
        { int fr_ = fr, fq_ = fq; asm volatile("" : "+v"(fr_), "+v"(fq_)); E(acc, cur, wr, wc, fr_, fq_); }
        if (!has_next) break;
        if (!(Epi::CARRY && E.keep(cur))) {
#pragma unroll
        for (int a = 0; a < 2; ++a)
#pragma unroll
            for (int b = 0; b < 2; ++b)
#pragma unroll
                for (int m = 0; m < 4; ++m)
#pragma unroll
                    for (int n = 0; n < 2; ++n) acc[a][b][m][n] = (f32x4){0.f, 0.f, 0.f, 0.f};
        }
        cur = nxt; cA = nA; cB = nB; ++ui;
        if (wr == 1) PG8_BAR;
    }
    PG8_WAIT_V(0);
    PG8_BAR;
#undef PG8_SA
#undef PG8_SB
#undef PG8_STAGE
#undef PG8_LDA
#undef PG8_LDB
#undef PG8_MMA
#undef PG8_WAIT_V
#undef PG8_WAIT_L
#undef PG8_BAR
#undef PG8_SCHED
}
}

constexpr int NWAVES = 8, NTHR = 512;
constexpr int D = 2048, NB = 4, SEQ = 2048, CTXL = 256, NCTX = NB * CTXL  , NLAT = NB * SEQ  , NTOK = NCTX + NLAT  ;
constexpr int NSTEP = CTXL + SEQ;
constexpr int HEADS = 8, HD = 128, MW = 1024, LW = 1024;
constexpr int NEXP = 32, DE = 1024;
constexpr int IN_DIM = 11296, NT_IN = 45;
constexpr float EPS = 1e-6f;
constexpr int MAXTILES = 96;
constexpr int NPHASE = 9;

constexpr size_t MiB = 1u << 20;
constexpr size_t WS_CTL = 0, CTL_ZERO_BYTES = 1 * MiB;
constexpr size_t WS_MOD = 1 * MiB;
constexpr size_t WS_GATES = 2 * MiB;
constexpr size_t WS_ASG = 4 * MiB + 512 * 1024;
constexpr size_t WS_LIST = 3 * MiB + 512 * 1024;
constexpr size_t WS_WR = 6 * MiB;
constexpr size_t WS_RB = 7 * MiB + 768 * 1024;
constexpr size_t WS_WL = 5 * MiB;
constexpr size_t WS_AGG = 978 * MiB;
constexpr size_t WS_WPA = 8 * MiB, WS_WPB = 12 * MiB, WS_WOUT = 16 * MiB, WS_WIN = 24 * MiB;
constexpr size_t WS_W13 = 72 * MiB, WS_W2 = 328 * MiB;
constexpr size_t WS_PS = 72 * MiB;
constexpr size_t WS_H = 456 * MiB;
constexpr size_t WS_K = 492 * MiB, WS_V = 510 * MiB, WS_UX = 528 * MiB;
constexpr size_t WS_Q = 546 * MiB, WS_OF = 562 * MiB, WS_OB = 578 * MiB, WS_UG = 594 * MiB;
constexpr size_t WS_GA = 610 * MiB, WS_GB = 642 * MiB;
constexpr size_t WS_LA = 674 * MiB, WS_LB = 746 * MiB;
constexpr size_t WS_HS = 818 * MiB, WS_TM = 882 * MiB;
constexpr size_t WS_YA = 946 * MiB, WS_YB = 962 * MiB;
constexpr size_t WS_BT = 982 * MiB;
constexpr size_t WS_SLOC = 984 * MiB;
constexpr size_t WS_END = 1022 * MiB;
constexpr size_t WS_PRE = WS_LA;
constexpr size_t WS_X1 = WS_LB;
constexpr size_t WS_H2 = WS_H;
constexpr size_t WS_XS = WS_K;
constexpr size_t WS_HM = 588 * MiB;
constexpr size_t WS_Y2 = WS_HS;
constexpr int CW_MODC = 32;
constexpr int CW_CNT = 64;
constexpr int CW_NT = 128;
constexpr int CW_TILE_E = 192;
constexpr int CW_BAR = 4096;
constexpr int CW_Q = 8192;
constexpr int CW_TC = 16384;

constexpr int RING_BYTES = 131072;
constexpr int LDSCTL_OFF = 143360;
constexpr int MISC_OFF = LDSCTL_OFF + 384;
constexpr int LDS_BYTES = 147456;

#define GAS __attribute__((address_space(1)))
#define LAS __attribute__((address_space(3)))
typedef unsigned short bf16;
typedef unsigned v4u __attribute__((ext_vector_type(4)));
typedef float f32x4 __attribute__((ext_vector_type(4)));
#define LDS_WAIT() asm volatile("s_waitcnt lgkmcnt(0)" ::: "memory")
#define WG_BAR() do { asm volatile("s_waitcnt lgkmcnt(0)" ::: "memory"); __builtin_amdgcn_s_barrier(); asm volatile("" ::: "memory"); } while (0)

__device__ __forceinline__ unsigned f2bf(float f) { unsigned u = __builtin_bit_cast(unsigned, f); return (u + 0x7fffu + ((u >> 16) & 1u)) >> 16; }
__device__ __forceinline__ unsigned pk2(float lo, float hi) { return pg8::cvt_pk_bf16(lo, hi); }
__device__ __forceinline__ float bf2f(unsigned h) { return __builtin_bit_cast(float, h << 16); }
__device__ __forceinline__ float bflo(unsigned w) { return __builtin_bit_cast(float, w << 16); }
__device__ __forceinline__ float bfhi(unsigned w) { return __builtin_bit_cast(float, w & 0xffff0000u); }
__device__ __forceinline__ float sigmoidf_(float x) { return __builtin_amdgcn_rcpf(1.f + __expf(-x)); }
__device__ __forceinline__ float gelu_tanh(float x) { const float u = 0.7978845608028654f * (x + 0.044715f * x * x * x); return x * __builtin_amdgcn_rcpf(1.f + __expf(-2.f * u)); }
__device__ __forceinline__ float wave_sum(float v) {
#pragma unroll
    for (int o = 1; o < 64; o <<= 1) v += __shfl_xor(v, o);
    return v;
}

#define XB_TMO      128
#define XB_XCNT(j)  (256  + 64 * (j))
#define XB_XSUB(j)  (1280 + 64 * (j))
#define XB_XGEN(j)  (2304 + 64 * (j))
#define XB_TOP      3328
#define XB_TOPGEN   3392
#define XCD_BAR_WORDS 3456
#define XB_SPIN_CAP (1u << 23)
__device__ __forceinline__ unsigned xb_ld(unsigned* p)              { return __hip_atomic_load(p, __ATOMIC_RELAXED, __HIP_MEMORY_SCOPE_AGENT); }
__device__ __forceinline__ unsigned xb_add(unsigned* p, unsigned v) { return __hip_atomic_fetch_add(p, v, __ATOMIC_RELAXED, __HIP_MEMORY_SCOPE_AGENT); }
__device__ __forceinline__ unsigned xb_xcc_id() { return (unsigned)__builtin_amdgcn_s_getreg((3 << 11) | 20) & 0xFu; }
#define XB_SPIN(cond, bar) do { unsigned _sp = 0; while (cond) { __builtin_amdgcn_s_sleep(1); \
    if ((++_sp & 255u) == 0u) { if (xb_ld(&(bar)[XB_TMO])) break; if (_sp > XB_SPIN_CAP) { atomicAdd(&(bar)[XB_TMO], 1u); break; } } } } while (0)
struct XcdBarrier { unsigned* bar; unsigned x; volatile LAS unsigned* st; };
__device__ __forceinline__ XcdBarrier xcd_barrier_post(unsigned* bar, volatile LAS unsigned* st, int tid) {
    XcdBarrier b; b.bar = bar; b.x = xb_xcc_id(); b.st = st;
    if (tid == 0) (void)xb_add(&bar[XB_XCNT(b.x)], 1u);
    return b;
}
__device__ __forceinline__ void xcd_barrier_complete(unsigned* bar, unsigned x, unsigned& nloc, unsigned& nx) {
    const unsigned G = gridDim.x * gridDim.y * gridDim.z;
    unsigned sum, cnt, mine, sp = 0u;
    for (;;) {
        sum = 0u; cnt = 0u; mine = 0u;
#pragma unroll
        for (unsigned j = 0; j < 16; ++j) { const unsigned c = xb_ld(&bar[XB_XCNT(j)]); sum += c; cnt += (c > 0u) ? 1u : 0u; mine = (j == x) ? c : mine; }
        if (sum == G) break;
        __builtin_amdgcn_s_sleep(1);
        if ((++sp & 255u) == 0u) { if (xb_ld(&bar[XB_TMO])) break; if (sp > XB_SPIN_CAP) { atomicAdd(&bar[XB_TMO], 1u); break; } }
    }
    nloc = mine > 0u ? mine : 1u; nx = cnt > 0u ? cnt : 1u;
}
__device__ __forceinline__ void xcd_barrier(const XcdBarrier& b, int tid) {
    asm volatile("s_waitcnt vmcnt(0)" ::: "memory");
    __syncthreads();
    if (tid == 0) {
        unsigned* bar = b.bar;
        __builtin_amdgcn_s_waitcnt(0);
        unsigned nloc = b.st[0], nx = b.st[1];
        if (nloc == 0u) { xcd_barrier_complete(bar, b.x, nloc, nx); b.st[0] = nloc; b.st[1] = nx; }
        const unsigned old = xb_add(&bar[XB_XSUB(b.x)], 1u);
        const unsigned gen = old / nloc;
        if (old + 1u == (gen + 1u) * nloc) {
            __builtin_amdgcn_fence(__ATOMIC_RELEASE, "agent");
            asm volatile("s_waitcnt vmcnt(0)" ::: "memory");
            const unsigned og = xb_add(&bar[XB_TOP], 1u);
            const unsigned tg = og / nx;
            if (og + 1u == (tg + 1u) * nx) xb_add(&bar[XB_TOPGEN], 1u);
            else XB_SPIN(xb_ld(&bar[XB_TOPGEN]) == tg, bar);
            __builtin_amdgcn_fence(__ATOMIC_ACQUIRE, "agent");
            xb_add(&bar[XB_XGEN(b.x)], 1u);
            asm volatile("s_waitcnt vmcnt(0)" ::: "memory");
        } else {
            XB_SPIN(xb_ld(&bar[XB_XGEN(b.x)]) == gen, bar);
            __builtin_amdgcn_fence(__ATOMIC_ACQUIRE, "agent");
            asm volatile("s_waitcnt vmcnt(0)" ::: "memory");
        }
    }
    __syncthreads();
}

__device__ __forceinline__ int make_tid(int wave_s) { int l; asm volatile("v_mbcnt_lo_u32_b32 %0, -1, 0\n\tv_mbcnt_hi_u32_b32 %0, -1, %0" : "=v"(l)); __builtin_assume(l >= 0 && l < 64); __builtin_assume(wave_s >= 0 && wave_s < 8); return wave_s * 64 + l; }
__device__ __forceinline__ int fresh_lane() { int l; asm volatile("v_mbcnt_lo_u32_b32 %0, -1, 0\n\tv_mbcnt_hi_u32_b32 %0, -1, %0" : "=v"(l)); __builtin_assume(l >= 0 && l < 64); return l; }
struct Args { const float* in[27]; float* out; unsigned char* ws; int ph_lo, ph_hi; };
enum { I_X = 0, I_C, I_CTX, I_CCTX, I_WMOD, I_BMOD, I_N1G, I_WIN, I_BGATES, I_HEADG, I_CONVW, I_CONVB, I_LWA, I_LBA, I_LWX, I_LBX, I_LAM, I_WPA, I_WPB, I_WOUT, I_N2G, I_WRG, I_WRE, I_W1, I_W3, I_W2, I_FG };

__device__ __forceinline__ void tr_item(const float* __restrict__ W, size_t ldw, int k0, int n0, bf16* dst, size_t ldd, float scale, LAS float* scr, int lane) {
#pragma unroll 16
    for (int i = 0; i < 32; ++i) { const int kk = 2 * i + (lane >> 5); scr[kk * 33 + (lane & 31)] = W[(size_t)(k0 + kk) * ldw + n0 + (lane & 31)]; }
    LDS_WAIT(); asm volatile("" ::: "memory");
    const int c = lane & 7;
#pragma unroll
    for (int j = 0; j < 4; ++j) { const int n = (lane >> 3) + 8 * j; const LAS float* s = scr + (8 * c) * 33 + n;
        v4u o; o.x = pk2(s[0 * 33] * scale, s[1 * 33] * scale); o.y = pk2(s[2 * 33] * scale, s[3 * 33] * scale); o.z = pk2(s[4 * 33] * scale, s[5 * 33] * scale); o.w = pk2(s[6 * 33] * scale, s[7 * 33] * scale);
        *(GAS v4u*)(dst + (size_t)n * ldd + 8 * c) = o; }
    LDS_WAIT(); asm volatile("" ::: "memory");
}
__device__ __forceinline__ int win_row(int n0, float& scale) {
    scale = 1.f;
    if (n0 < 1024) return 13 * 256 + n0;
    if (n0 < 2048) { scale = 0.08838834764831845f; return n0 - 1024; }
    if (n0 < 3072) return 4 * 256 + (n0 - 2048);
    if (n0 < 4096) return 17 * 256 + (n0 - 3072);
    if (n0 < 5120) return 21 * 256 + (n0 - 4096);
    if (n0 < 5152) return 12 * 256 + (n0 - 5120);
    if (n0 < 6176) return 8 * 256 + (n0 - 5152);
    if (n0 < 7200) return 25 * 256 + (n0 - 6176);
    if (n0 < 9248) return 29 * 256 + (n0 - 7200);
    return 37 * 256 + (n0 - 9248);
}

__device__ __forceinline__ void phase0(const Args& a, unsigned char* lds_g, int tid, int lane, int wave) {
    unsigned char* ws = a.ws;
    {
        float* sl = (float*)lds_g;
        float* red = sl + 5 * 2048;
        for (int i = tid; i < 5 * 2048; i += NTHR) { const int r = i >> 11, k = i & 2047; const float v = r < 4 ? a.in[I_C][r * 2048 + k] : a.in[I_CCTX][k]; sl[i] = v / (1.f + __expf(-v)); }
        __syncthreads();
        const float* wm = a.in[I_WMOD]; const float* bm = a.in[I_BMOD]; float* MOD = (float*)(ws + WS_MOD);
        for (int cb = blockIdx.x; cb < 256; cb += gridDim.x) {
            const int n0 = cb * 48;
            if (tid < 504) {
                const int kq = tid / 12, cg = tid % 12;
                f32x4 acc[5];
#pragma unroll
                for (int r = 0; r < 5; ++r) acc[r] = (f32x4){0.f, 0.f, 0.f, 0.f};
#pragma unroll 7
                for (int k = kq; k < 2048; k += 42) {
                    const f32x4 w = *(const f32x4*)(wm + (size_t)k * 12288 + n0 + 4 * cg);
#pragma unroll
                    for (int r = 0; r < 5; ++r) acc[r] += w * sl[r * 2048 + k];
                }
#pragma unroll
                for (int r = 0; r < 5; ++r) *(f32x4*)(red + tid * 20 + r * 4) = acc[r];
            }
            __syncthreads();
            if (tid < 240) {
                const int cg = tid / 20, rj = tid % 20; float s = 0.f;
                for (int kq = 0; kq < 42; ++kq) s += red[(kq * 12 + cg) * 20 + rj];
                const int r = rj >> 2, j = rj & 3, n = n0 + 4 * cg + j;
                __hip_atomic_store(MOD + r * 12288 + n, s + bm[n], __ATOMIC_RELAXED, __HIP_MEMORY_SCOPE_AGENT);
            }
            __syncthreads();
        }
        if (tid == 0) __hip_atomic_fetch_add((unsigned*)(ws + WS_CTL) + CW_MODC, 1u, __ATOMIC_RELAXED, __HIP_MEMORY_SCOPE_AGENT);
    }
    {
        LAS float* scr = (LAS float*)((LAS unsigned char*)lds_g) + wave * 4096;
        const int gw = blockIdx.x * NWAVES + wave, NGW = gridDim.x * NWAVES;
        constexpr int J0 = 32 * 353, J1 = 16 * 64, J3 = 32 * 64;
        constexpr int JL = 256;
        constexpr int NITEMS = J0 + 2 * J1;
        (void)J3; (void)JL;
        for (int it = gw; it < NITEMS; it += NGW) {
            int r = it;
            if (r < J0) { const int kb = r / 353, nb = r % 353; float sc; const int row = win_row(32 * nb, sc);
                tr_item(a.in[I_WIN], IN_DIM, 64 * kb, 32 * nb, (bf16*)(ws + WS_WIN) + (size_t)row * 2048 + 64 * kb, 2048, sc, scr, lane); continue; } r -= J0;
            if (r < J1) { const int kb = r / 64, nb = r % 64; tr_item(a.in[I_WPA], 2048, 64 * kb, 32 * nb, (bf16*)(ws + WS_WPA) + (size_t)(32 * nb) * 1024 + 64 * kb, 1024, 1.f, scr, lane); continue; } r -= J1;
            if (r < J1) { const int kb = r / 64, nb = r % 64; tr_item(a.in[I_WPB], 2048, 64 * kb, 32 * nb, (bf16*)(ws + WS_WPB) + (size_t)(32 * nb) * 1024 + 64 * kb, 1024, 1.f, scr, lane); continue; }
        }
        { GAS v4u* z = (GAS v4u*)((bf16*)(ws + WS_WIN) + (size_t)(12 * 256 + 32) * 2048); const int nchunks = 224 * 256;
          for (int i = blockIdx.x * NTHR + tid; i < nchunks; i += gridDim.x * NTHR) z[i] = (v4u){0u, 0u, 0u, 0u}; }
    }
}

__device__ __forceinline__ void late_prep(const Args& a, unsigned char* lds_g, int gw, int NGW, int lane, int wave) {
    unsigned char* ws = a.ws;
    {
        LAS float* scr = (LAS float*)((LAS unsigned char*)lds_g) + wave * 4096;
        constexpr int J3 = 32 * 64, JL = 256;
        for (int it = gw; it < J3 + JL; it += NGW) {
            int r = it;
            if (r >= J3) { r -= J3; const int mi = r >> 3, kb = (r >> 2) & 1, nb = r & 3, dir = mi >> 4, mat = (mi >> 3) & 1, blk = mi & 7;
                tr_item(a.in[mat ? I_LWX : I_LWA] + (size_t)(dir * 8 + blk) * 128 * 128, 128, 64 * kb, 32 * nb, (bf16*)(ws + WS_WL) + ((size_t)((dir * 2 + mat) * 8 + blk) * 128 + 32 * nb) * 128 + 64 * kb, 128, 1.f, scr, lane); continue; }
            const int kb = r / 64, nb = r % 64; tr_item(a.in[I_WOUT], 2048, 64 * kb, 32 * nb, (bf16*)(ws + WS_WOUT) + (size_t)(32 * nb) * 2048 + 64 * kb, 2048, 1.f, scr, lane);
        }
    }
    {
        const float* MODr = (const float*)(a.ws + WS_MOD); float* WR = (float*)(a.ws + WS_WR); float* RB = (float*)(a.ws + WS_RB);
        for (int idx = gw * 64 + lane; idx < 4 * 48 * 2048; idx += NGW * 64) { const int k = idx & 2047, j = (idx >> 11) % 48, b = idx / (48 * 2048);
            const float gm = a.in[I_N2G][k] * (1.f + MODr[b * 12288 + 4 * 2048 + k]);
            const float wv = j < 32 ? a.in[I_WRE][(size_t)k * 32 + j] : (j < 36 ? a.in[I_WRG][(size_t)k * 4 + (j - 32)] : 0.f);
            WR[idx] = gm * wv; }
        for (int q = gw; q < 4 * 48; q += NGW) { const int b = q / 48, j = q % 48; float sacc = 0.f;
            if (j < 36) { for (int k = lane; k < 2048; k += 64) { const float wv = j < 32 ? a.in[I_WRE][(size_t)k * 32 + j] : a.in[I_WRG][(size_t)k * 4 + (j - 32)]; sacc += MODr[b * 12288 + 3 * 2048 + k] * wv; } }
            sacc = wave_sum(sacc); if (lane == 0) RB[q] = sacc; }
    }
}
__device__ __forceinline__ void mod_wait(const Args& a, int tid) {
    if (tid < 64) { unsigned* mc = (unsigned*)(a.ws + WS_CTL) + CW_MODC; unsigned spins = 0;
        while ((unsigned)__builtin_amdgcn_readfirstlane(__hip_atomic_load(mc, __ATOMIC_RELAXED, __HIP_MEMORY_SCOPE_AGENT)) < gridDim.x) {
            __builtin_amdgcn_s_sleep(2);
            if (++spins > (1u << 22)) { if (tid == 0) __hip_atomic_store((unsigned*)(a.ws + WS_CTL) + 1, 0x800u, __ATOMIC_RELAXED, __HIP_MEMORY_SCOPE_AGENT); break; } }
        __builtin_amdgcn_fence(__ATOMIC_ACQUIRE, "agent");
        asm volatile("s_waitcnt vmcnt(0)" ::: "memory"); }
    __syncthreads();
}
__device__ __forceinline__ void phase1(const Args& a, int lane, int wave) {
    const int gw = blockIdx.x * NWAVES + wave, NGW = gridDim.x * NWAVES;
    const float* MOD = (const float*)(a.ws + WS_MOD); const float* g = a.in[I_N1G];
    bf16* H = (bf16*)(a.ws + WS_H);
    for (int r = gw; r < NTOK; r += NGW) {
        const float* src = r < NCTX ? a.in[I_CTX] + (size_t)r * D : a.in[I_X] + (size_t)(r - NCTX) * D;
        const int mr = r < NCTX ? 4 : (r - NCTX) / SEQ;
        const f32x4* xr = (const f32x4*)src + lane;
        f32x4 v[8]; float s = 0.f;
#pragma unroll
        for (int j = 0; j < 8; ++j) { v[j] = xr[64 * j]; s += (v[j].x * v[j].x + v[j].y * v[j].y) + (v[j].z * v[j].z + v[j].w * v[j].w); }
        const float rstd = 1.f / sqrtf(wave_sum(s) * (1.f / D) + EPS);
        unsigned long long* o8 = (unsigned long long*)(H + (size_t)r * D) + lane;
#pragma unroll
        for (int j = 0; j < 8; ++j) {
            const int c = 4 * lane + 256 * j;
            const f32x4 gg = *(const f32x4*)(g + c), sh = *(const f32x4*)(MOD + mr * 12288 + c), sc = *(const f32x4*)(MOD + mr * 12288 + 2048 + c);
            v[j] = v[j] * rstd * gg * (sc + 1.f) + sh;
        }
#pragma unroll
        for (int j = 0; j < 8; ++j) o8[64 * j] = (unsigned long long)pk2(v[j].x, v[j].y) | ((unsigned long long)pk2(v[j].z, v[j].w) << 32);
    }
}

struct SchedIn {
    int G, c; const char* A; const char* B;
    __device__ __forceinline__ bool next(int i, pg8::Unit& u) const {
        const int L = i * G + c; if (L >= 1492) return false;
        int pm, pn;
        if (L < 1440) { pg8::tile_order(L, 32, NT_IN, pm, pn); pm += 4; }
        else { const int j = L - 1440; pm = j & 3; pn = j >> 2; }
        u.pm = pm; u.pn = pn; u.aux = 0; u.A = A + (size_t)pm * 256 * D * 2; u.B = B + (size_t)pn * 256 * D * 2; return true;
    }
};
struct EpiIn {
    static constexpr bool PERM = true, CARRY = false;
    __device__ __forceinline__ bool keep(const pg8::Unit&) const { return false; }
    unsigned char* ws; const float* b_gates;
    template <int ACT> __device__ __forceinline__ void store_tile(const pg8::f32x4 (&acc)[2][2][4][2], bf16* base, int ldc, int wr, int wc, int fr, int fq) const {
#pragma unroll
        for (int ai = 0; ai < 2; ++ai)
#pragma unroll
            for (int m = 0; m < 4; ++m) { bf16* rowp = base + (size_t)(ai * 128 + wr * 64 + m * 16 + fr) * ldc + wc * 32 + 8 * fq;
#pragma unroll
                for (int bj = 0; bj < 2; ++bj) { pg8::f32x4 v0 = acc[ai][bj][m][0], v1 = acc[ai][bj][m][1];
                    if (ACT == 1) {
#pragma unroll
                        for (int j = 0; j < 4; ++j) { v0[j] = sigmoidf_(v0[j]); v1[j] = sigmoidf_(v1[j]); } }
                    if (ACT == 2) {
#pragma unroll
                        for (int j = 0; j < 4; ++j) { v0[j] = gelu_tanh(v0[j]); v1[j] = gelu_tanh(v1[j]); } }
                    pg8::u32x4 w; w.x = pg8::cvt_pk_bf16(v0[0], v0[1]); w.y = pg8::cvt_pk_bf16(v0[2], v0[3]); w.z = pg8::cvt_pk_bf16(v1[0], v1[1]); w.w = pg8::cvt_pk_bf16(v1[2], v1[3]);
                    *(pg8::u32x4*)(rowp + bj * 128) = w; } }
    }
    __device__ __forceinline__ void operator()(const pg8::f32x4 (&acc)[2][2][4][2], const pg8::Unit& u, int wr, int wc, int fr, int fq) const {
        const int pn = u.pn; const size_t row0 = (size_t)u.pm * 256;
        if (pn < 12) {
            const int seg = pn >> 2, ct = pn & 3; bf16* dst = (bf16*)(ws + (seg == 0 ? WS_K : seg == 1 ? WS_V : WS_UX));
            store_tile<0>(acc, dst + row0 * 1024 + ct * 256, 1024, wr, wc, fr, fq);
        } else if (pn == 12) {
            if (wc == 0) {
                float* G = (float*)(ws + WS_GATES);
                const pg8::f32x4 bv0 = *(const pg8::f32x4*)(b_gates + 8 * fq), bv1 = *(const pg8::f32x4*)(b_gates + 8 * fq + 4);
#pragma unroll
                for (int ai = 0; ai < 2; ++ai)
#pragma unroll
                    for (int m = 0; m < 4; ++m) { float* rowp = G + (row0 + ai * 128 + wr * 64 + m * 16 + fr) * 32 + 8 * fq;
                        *(pg8::f32x4*)(rowp) = acc[ai][0][m][0] + bv0; *(pg8::f32x4*)(rowp + 4) = acc[ai][0][m][1] + bv1; }
            }
        } else if (pn < 29) {
            const int seg = (pn - 13) >> 2, ct = (pn - 13) & 3; const size_t lr = row0 - NCTX;
            bf16* dst = (bf16*)(ws + (seg == 0 ? WS_Q : seg == 1 ? WS_OF : seg == 2 ? WS_OB : WS_UG)) + lr * 1024 + ct * 256;
            if (seg == 0) store_tile<0>(acc, dst, 1024, wr, wc, fr, fq);
            else if (seg == 3) store_tile<2>(acc, dst, 1024, wr, wc, fr, fq);
            else store_tile<1>(acc, dst, 1024, wr, wc, fr, fq);
        } else {
            const int seg = (pn - 29) >> 3, ct = (pn - 29) & 7; const size_t lr = row0 - NCTX;
            store_tile<1>(acc, (bf16*)(ws + (seg ? WS_GB : WS_GA)) + lr * 2048 + ct * 256, 2048, wr, wc, fr, fq);
        }
    }
};

__device__ __forceinline__ int lru_pos_row(int b, bool isctx, int p) { return isctx ? b * CTXL + p : NCTX + b * SEQ + (p & 31) * 64 + (p >> 5); }
typedef short bf16x8_t __attribute__((ext_vector_type(8)));
template <bool FINAL>
__device__ __forceinline__ void lru_unit(const Args& a, unsigned char* lds_g, int b, int cidx, int blk, int tid, bf16x8_t (&wl)[2][2][4], int& wl_blk) {
    const int lane = fresh_lane(), w = __builtin_amdgcn_readfirstlane(tid >> 6), fr = lane & 15, fq = lane >> 4; tid = w * 64 + lane;
    float* zf = (float*)lds_g;
    bf16* zb = (bf16*)(lds_g + 64 * 132 * 4);
    const bool isctx = cidx < 4; const int seglen = isctx ? CTXL : SEQ, p0 = (isctx ? cidx : cidx - 4) * 64;
    const bf16* UX = (const bf16*)(a.ws + WS_UX);
    float gba[2], gbx[2], glam[2];
    { const int ch_ = blk * 128 + 16 * w + fr;
#pragma unroll
      for (int d = 0; d < 2; ++d) { gba[d] = a.in[I_LBA][d * 1024 + ch_]; gbx[d] = a.in[I_LBX][d * 1024 + ch_]; glam[d] = a.in[I_LAM][d * 1024 + ch_]; } }
    if (wl_blk != blk) { const bf16* WL = (const bf16*)(a.ws + WS_WL); wl_blk = blk;
#pragma unroll
      for (int d = 0; d < 2; ++d)
#pragma unroll
        for (int m = 0; m < 2; ++m)
#pragma unroll
            for (int ks = 0; ks < 4; ++ks) wl[d][m][ks] = *(const bf16x8_t*)(WL + ((size_t)((d * 2 + m) * 8 + blk) * 128 + 16 * w + fr) * 128 + 32 * ks + 8 * fq); }
    __builtin_amdgcn_sched_barrier(0);
    {
        const int pos = tid >> 3, cg = tid & 7, ch0 = blk * 128 + cg * 16, p = p0 + pos;
        float z[16];
#pragma unroll
        for (int q = 0; q < 4; ++q) { const f32x4 bv = *(const f32x4*)(a.in[I_CONVB] + ch0 + 4 * q); z[4 * q] = bv.x; z[4 * q + 1] = bv.y; z[4 * q + 2] = bv.z; z[4 * q + 3] = bv.w; }
        v4u ua[4], ub[4]; float msk[4];
#pragma unroll
        for (int w4 = 0; w4 < 4; ++w4) { const int pp = p + w4 - 2; const bool ok = pp >= 0 && pp < seglen; const int ppc = ok ? pp : p;
            const v4u* src = (const v4u*)(UX + (size_t)lru_pos_row(b, isctx, ppc) * 1024 + ch0); ua[w4] = src[0]; ub[w4] = src[1]; msk[w4] = ok ? 1.f : 0.f; }
#pragma unroll
        for (int w4 = 0; w4 < 4; ++w4) { const float* cw = a.in[I_CONVW] + w4 * 1024 + ch0;
            const unsigned uu[8] = {ua[w4].x, ua[w4].y, ua[w4].z, ua[w4].w, ub[w4].x, ub[w4].y, ub[w4].z, ub[w4].w};
#pragma unroll
            for (int q = 0; q < 4; ++q) { const f32x4 cv = *(const f32x4*)(cw + 4 * q) * msk[w4]; z[4 * q] += cv.x * bflo(uu[2 * q]); z[4 * q + 1] += cv.y * bfhi(uu[2 * q]); z[4 * q + 2] += cv.z * bflo(uu[2 * q + 1]); z[4 * q + 3] += cv.w * bfhi(uu[2 * q + 1]); } }
#pragma unroll
        for (int q = 0; q < 4; ++q) *(f32x4*)(zf + pos * 132 + cg * 16 + 4 * q) = (f32x4){z[4 * q], z[4 * q + 1], z[4 * q + 2], z[4 * q + 3]};
        v4u o0, o1; o0.x = pk2(z[0], z[1]); o0.y = pk2(z[2], z[3]); o0.z = pk2(z[4], z[5]); o0.w = pk2(z[6], z[7]); o1.x = pk2(z[8], z[9]); o1.y = pk2(z[10], z[11]); o1.z = pk2(z[12], z[13]); o1.w = pk2(z[14], z[15]);
        *(v4u*)(zb + pos * 136 + cg * 16) = o0; *(v4u*)(zb + pos * 136 + cg * 16 + 8) = o1;
    }
    WG_BAR();
    f32x4 acc[2][2][4];
#pragma unroll
    for (int d = 0; d < 2; ++d)
#pragma unroll
        for (int m = 0; m < 2; ++m)
#pragma unroll
            for (int mt = 0; mt < 4; ++mt) acc[d][m][mt] = (f32x4){0.f, 0.f, 0.f, 0.f};
#pragma unroll
    for (int ks = 0; ks < 4; ++ks) {
        bf16x8_t af[4];
#pragma unroll
        for (int mt = 0; mt < 4; ++mt) af[mt] = *(const bf16x8_t*)(zb + (16 * mt + fr) * 136 + 32 * ks + 8 * fq);
#pragma unroll
        for (int d = 0; d < 2; ++d)
#pragma unroll
            for (int m = 0; m < 2; ++m) {
#pragma unroll
                for (int mt = 0; mt < 4; ++mt) acc[d][m][mt] = __builtin_amdgcn_mfma_f32_16x16x32_bf16(af[mt], wl[d][m][ks], acc[d][m][mt], 0, 0, 0); }
    }
    const int chl = 16 * w + fr, ch = blk * 128 + chl;
    float hsum[4][4];
#pragma unroll
    for (int d = 0; d < 2; ++d) {
        const float ba = gba[d], bx = gbx[d], lam = glam[d];
        const float sp = (-lam > 20.f) ? -lam : log1pf(__expf(-lam));
        float av[4][4], bv[4][4];
#pragma unroll
        for (int mt = 0; mt < 4; ++mt)
#pragma unroll
            for (int r = 0; r < 4; ++r) { const float rr = sigmoidf_(acc[d][0][mt][r] + ba), ii = sigmoidf_(acc[d][1][mt][r] + bx);
                const float aa = __expf(-8.f * rr * sp); av[mt][r] = aa; bv[mt][r] = __builtin_amdgcn_sqrtf(fmaxf(1.f - aa * aa, 0.f)) * ii * zf[(16 * mt + 4 * fq + r) * 132 + chl]; }
        float Pe[4], Se[4], Pt[4], St[4];
#pragma unroll
        for (int mt = 0; mt < 4; ++mt) {
            float P = 1.f, S = 0.f;
#pragma unroll
            for (int rr = 0; rr < 4; ++rr) { const int r = d ? 3 - rr : rr; S = av[mt][r] * S + bv[mt][r]; P = av[mt][r] * P; }
            if (d == 0) {
                float p1 = __shfl_up(P, 16), s1 = __shfl_up(S, 16); if (fq >= 1) { S = P * s1 + S; P = P * p1; }
                p1 = __shfl_up(P, 32); s1 = __shfl_up(S, 32); if (fq >= 2) { S = P * s1 + S; P = P * p1; }
                Pe[mt] = __shfl_up(P, 16); Se[mt] = __shfl_up(S, 16); if (fq == 0) { Pe[mt] = 1.f; Se[mt] = 0.f; }
                Pt[mt] = __shfl(P, fr + 48); St[mt] = __shfl(S, fr + 48);
            } else {
                float p1 = __shfl_down(P, 16), s1 = __shfl_down(S, 16); if (fq <= 2) { S = P * s1 + S; P = P * p1; }
                p1 = __shfl_down(P, 32); s1 = __shfl_down(S, 32); if (fq <= 1) { S = P * s1 + S; P = P * p1; }
                Pe[mt] = __shfl_down(P, 16); Se[mt] = __shfl_down(S, 16); if (fq == 3) { Pe[mt] = 1.f; Se[mt] = 0.f; }
                Pt[mt] = __shfl(P, fr); St[mt] = __shfl(S, fr);
            }
        }
        float2* AGG = (float2*)(a.ws + WS_AGG) + ((size_t)(b * 2 + d) * 36) * 1024 + ch;
        if (!FINAL) {
            if (cidx >= 4) {
                unsigned* PS = (unsigned*)(a.ws + WS_PS) + ((size_t)(b * 2 + d) * NSTEP + 64 * cidx) * 1024 + ch;
#pragma unroll
                for (int mt = 0; mt < 4; ++mt)
#pragma unroll
                    for (int r = 0; r < 4; ++r) PS[(size_t)(16 * mt + 4 * fq + r) * 1024] = pk2(1.f - av[mt][r], bv[mt][r]);
            }
            float Pc = 1.f, Sc = 0.f;
#pragma unroll
            for (int i = 0; i < 4; ++i) { const int mt = d ? 3 - i : i; Sc = Pt[mt] * Sc + St[mt]; Pc = Pt[mt] * Pc; }
            if (fq == 0) AGG[(size_t)cidx * 1024] = make_float2(Pc, Sc);
        } else {
            float h = 0.f;
#pragma unroll
            for (int g3 = 0; g3 < 6; ++g3) {
                float2 qv[6];
#pragma unroll
                for (int i = 0; i < 6; ++i) { const int sidx = 6 * g3 + i; const int c2 = d ? (sidx < 4 ? 3 - sidx : 39 - sidx) : sidx; qv[i] = AGG[(size_t)c2 * 1024]; }
#pragma unroll
                for (int i = 0; i < 6; ++i) { const int sidx = 6 * g3 + i; const int c2 = d ? (sidx < 4 ? 3 - sidx : 39 - sidx) : sidx;
                    const bool use = d ? (sidx < 4 || c2 > cidx) : (c2 < cidx);
                    h = use ? qv[i].x * h + qv[i].y : h; }
            }
#pragma unroll
            for (int i = 0; i < 4; ++i) { const int mt = d ? 3 - i : i;
                float hl = Pe[mt] * h + Se[mt];
#pragma unroll
                for (int rr = 0; rr < 4; ++rr) { const int r = d ? 3 - rr : rr; hl = av[mt][r] * hl + bv[mt][r]; if (d == 0) hsum[mt][r] = hl; else hsum[mt][r] += hl; }
                h = Pt[mt] * h + St[mt]; }
        }
    }
    if (FINAL) {
#pragma unroll
        for (int mt = 0; mt < 4; ++mt)
#pragma unroll
            for (int r = 0; r < 4; ++r) zf[(16 * mt + 4 * fq + r) * 132 + chl] = hsum[mt][r];
        WG_BAR();
        const int pos = tid >> 3, cg = tid & 7, ch0 = blk * 128 + cg * 16;
        const size_t lrow = (size_t)(lru_pos_row(b, false, p0 + pos) - NCTX) * 1024 + ch0;
        const v4u* ug = (const v4u*)((const bf16*)(a.ws + WS_UG) + lrow); const v4u g0 = ug[0], g1 = ug[1];
        const unsigned gg[8] = {g0.x, g0.y, g0.z, g0.w, g1.x, g1.y, g1.z, g1.w}; unsigned o[8];
#pragma unroll
        for (int q = 0; q < 4; ++q) { const f32x4 hv = *(const f32x4*)(zf + pos * 132 + cg * 16 + 4 * q);
            o[2 * q] = pk2(hv.x * bflo(gg[2 * q]), hv.y * bfhi(gg[2 * q])); o[2 * q + 1] = pk2(hv.z * bflo(gg[2 * q + 1]), hv.w * bfhi(gg[2 * q + 1])); }
        v4u* dst = (v4u*)((bf16*)(a.ws + WS_YB) + lrow); dst[0] = (v4u){o[0], o[1], o[2], o[3]}; dst[1] = (v4u){o[4], o[5], o[6], o[7]};
    }
    WG_BAR();
}
constexpr int ML_STRIDE = 136;
constexpr int ML_Q = 0, ML_K = 17408, ML_V = 34816, ML_AUG = 52224  , ML_CB = 54272  ;
constexpr int ML_EB = 93440  , ML_EU = 95488  , ML_EBEND = 97536  , ML_BEND = 97568  , ML_DEN = 97600  , ML_SSQ = 97856  ;
typedef short s4_t __attribute__((ext_vector_type(4)));
__device__ __forceinline__ s4_t ds_tr(const bf16* p) { return __builtin_amdgcn_ds_read_tr16_b64_v4i16((LAS s4_t*)p); }
__device__ __forceinline__ bf16x8_t frag_row(const bf16* img, int row0, int k0, int fr, int fq) { return *(const bf16x8_t*)(img + (row0 + fr) * ML_STRIDE + k0 + 8 * fq); }
__device__ __forceinline__ bf16x8_t frag_tr2(const bf16* img, int stride, int sA, int sB, int col0, int lane) {
    const int fq = lane >> 4, q = (lane & 15) >> 2, p = lane & 3;
    const s4_t lo = ds_tr(img + (sA + 4 * fq + q) * stride + col0 + 4 * p), hi = ds_tr(img + (sB + 4 * fq + q) * stride + col0 + 4 * p);
    return (bf16x8_t){lo.x, lo.y, lo.z, lo.w, hi.x, hi.y, hi.z, hi.w};
}
__device__ __forceinline__ bf16x8_t frag_tr(const bf16* img, int stride, int s0, int col0, int lane) {
    const int fq = lane >> 4, q = (lane & 15) >> 2, p = lane & 3;
    const bf16* b = img + (s0 + 8 * fq + q) * stride + col0 + 4 * p;
    const s4_t lo = ds_tr(b), hi = ds_tr(b + 4 * stride);
    return (bf16x8_t){lo.x, lo.y, lo.z, lo.w, hi.x, hi.y, hi.z, hi.w};
}
__device__ __forceinline__ float logsigmoidf_(float x) { return fminf(x, 0.f) - log1pf(__expf(-fabsf(x))); }

__device__ __forceinline__ void ml_gates(const Args& a, unsigned char* lds_g, int rowbase, int h, int tid) {
    const int lane = fresh_lane(), w = __builtin_amdgcn_readfirstlane(tid >> 6), dir = w >> 2, c = w & 3;
    const float* GT = (const float*)(a.ws + WS_GATES) + (size_t)(rowbase + 64 * c + lane) * 32;
    const float ipre = GT[(dir * 2) * 8 + h], fpre = GT[(dir * 2 + 1) * 8 + h];
    float bsum = logsigmoidf_(fpre);
    if (dir == 0) {
#pragma unroll
        for (int o = 1; o < 64; o <<= 1) { const float t = __shfl_up(bsum, o); if (lane >= o) bsum += t; }
    } else {
#pragma unroll
        for (int o = 1; o < 64; o <<= 1) { const float t = __shfl_down(bsum, o); if (lane + o < 64) bsum += t; }
    }
    float* eb = (float*)(lds_g + ML_EB); float* eu = (float*)(lds_g + ML_EU);
    eb[dir * 256 + 64 * c + lane] = __expf(bsum); eu[dir * 256 + 64 * c + lane] = __expf(ipre - bsum);
    const float bend = __shfl(bsum, dir ? 0 : 63);
    if (lane == 0) { ((float*)(lds_g + ML_EBEND))[dir * 4 + c] = __expf(bend); ((float*)(lds_g + ML_BEND))[dir * 4 + c] = bend; }
}

template <bool OUT, bool PASS2>
__device__ __forceinline__ void ml_block(const Args& a, unsigned char* lds_g, int rowbase, int h, int dir, f32x4 (&st)[9], int tid) {
    const int lane = tid & 63, w = __builtin_amdgcn_readfirstlane(tid >> 6), fr = lane & 15, fq = lane >> 4;
    bf16* Qi = (bf16*)(lds_g + ML_Q); bf16* Ki = (bf16*)(lds_g + ML_K); bf16* Vi = (bf16*)(lds_g + ML_V); bf16* AUGi = (bf16*)(lds_g + ML_AUG); bf16* CB = (bf16*)(lds_g + ML_CB);
    const float* eb = (const float*)(lds_g + ML_EB) + dir * 256; const float* eu = (const float*)(lds_g + ML_EU) + dir * 256;
    const float* ebend = (const float*)(lds_g + ML_EBEND) + dir * 4;
    float* den = (float*)(lds_g + ML_DEN); float* ssq = (float*)(lds_g + ML_SSQ);
    const bf16* Kb = (const bf16*)(a.ws + WS_K); const bf16* Vb = (const bf16*)(a.ws + WS_V); const bf16* Qb = (const bf16*)(a.ws + WS_Q);
    const int ti = w & 3, vh = w >> 2;
    float hgv[5];
    if (OUT) {
#pragma unroll
        for (int x = 0; x < 5; ++x) { const int vt = vh * 5 + x; hgv[x] = vt < 8 ? a.in[I_HEADG][h * 128 + 16 * vt + fr] : 0.f; } }
    const int st_t = tid >> 3, st_pc = tid & 7;
    v4u k0, k1, v0, v1, q0, q1;
#define ML_LOADC(c_) do { const size_t row_ = (size_t)(rowbase + 64 * (c_) + st_t); \
        const v4u* ks_ = (const v4u*)(Kb + row_ * 1024 + h * 128 + 16 * st_pc); k0 = ks_[0]; k1 = ks_[1]; \
        const v4u* vs_ = (const v4u*)(Vb + row_ * 1024 + h * 128 + 16 * st_pc); v0 = vs_[0]; v1 = vs_[1]; \
        if (OUT) { const v4u* qs_ = (const v4u*)(Qb + (row_ - NCTX) * 1024 + h * 128 + 16 * st_pc); q0 = qs_[0]; q1 = qs_[1]; } } while (0)
    ML_LOADC(dir ? 3 : 0);
    for (int ci = 0; ci < 4; ++ci) {
        const int c = dir ? 3 - ci : ci;
        unsigned short ogv[5][4]; unsigned short tmv[5][4];
        if (OUT) {
            const bf16* OGp = (const bf16*)(a.ws + (dir ? WS_OB : WS_OF)); const bf16* TMp = (const bf16*)(a.ws + WS_TM);
#pragma unroll
            for (int r = 0; r < 4; ++r) { const size_t ob = (size_t)(rowbase - NCTX + 64 * c + 16 * ti + 4 * fq + r) * 1024 + h * 128;
#pragma unroll
                for (int x = 0; x < 5; ++x) { const int vt = vh * 5 + x; if (vt < 8) { ogv[x][r] = OGp[ob + 16 * vt + fr]; if (PASS2) tmv[x][r] = TMp[ob + 16 * vt + fr]; } } }
            __builtin_amdgcn_sched_barrier(0);
        }
        {
            const int t = st_t, pc = st_pc;
            const float e = eu[64 * c + t];
            *(v4u*)(Ki + t * ML_STRIDE + 16 * pc) = k0; *(v4u*)(Ki + t * ML_STRIDE + 16 * pc + 8) = k1;
            if (OUT) { *(v4u*)(Qi + t * ML_STRIDE + 16 * pc) = q0; *(v4u*)(Qi + t * ML_STRIDE + 16 * pc + 8) = q1; }
            const unsigned vv[8] = {v0.x, v0.y, v0.z, v0.w, v1.x, v1.y, v1.z, v1.w}; unsigned o[8];
#pragma unroll
            for (int i = 0; i < 8; ++i) o[i] = pk2(bflo(vv[i]) * e, bfhi(vv[i]) * e);
            *(v4u*)(Vi + t * ML_STRIDE + 16 * pc) = (v4u){o[0], o[1], o[2], o[3]}; *(v4u*)(Vi + t * ML_STRIDE + 16 * pc + 8) = (v4u){o[4], o[5], o[6], o[7]};
            if (pc == 0) { *(v4u*)(AUGi + t * 16) = (v4u){f2bf(e), 0u, 0u, 0u}; *(v4u*)(AUGi + t * 16 + 8) = (v4u){0u, 0u, 0u, 0u}; }
        }
        WG_BAR();
        if (ci < 3) ML_LOADC(dir ? 2 - ci : ci + 1);
        f32x4 X[5]; float hval[4][4];
        if (OUT) {
            bf16x8_t qf[4];
#pragma unroll
            for (int ks = 0; ks < 4; ++ks) qf[ks] = frag_row(Qi, 16 * ti, 32 * ks, fr, fq);
            bf16x8_t P[2]; bool pv[2];
#pragma unroll
            for (int pp = 0; pp < 2; ++pp) {
                f32x4 d[2];
#pragma unroll
                for (int hh = 0; hh < 2; ++hh) { const int si = 2 * pp + hh; d[hh] = (f32x4){0.f, 0.f, 0.f, 0.f};
                    const bool valid = dir ? (si >= ti) : (si <= ti);
                    if (valid) {
#pragma unroll
                        for (int ks = 0; ks < 4; ++ks) d[hh] = __builtin_amdgcn_mfma_f32_16x16x32_bf16(frag_row(Ki, 16 * si, 32 * ks, fr, fq), qf[ks], d[hh], 0, 0, 0);
                        if (si == ti) {
#pragma unroll
                            for (int r = 0; r < 4; ++r) { const bool keep = dir ? (4 * fq + r >= fr) : (4 * fq + r <= fr); d[hh][r] = keep ? d[hh][r] : 0.f; } } } }
                pv[pp] = dir ? (2 * pp + 1 >= ti) : (2 * pp <= ti);
                const unsigned p0 = pk2(d[0][0], d[0][1]), p1 = pk2(d[0][2], d[0][3]), p2 = pk2(d[1][0], d[1][1]), p3 = pk2(d[1][2], d[1][3]);
                P[pp] = __builtin_bit_cast(bf16x8_t, (v4u){p0, p1, p2, p3});
            }
#pragma unroll
            for (int x = 0; x < 5; ++x) { X[x] = (f32x4){0.f, 0.f, 0.f, 0.f};
                const int vt = vh * 5 + x;
                if (vt < 9) {
#pragma unroll
                    for (int pp = 0; pp < 2; ++pp) if (pv[pp]) {
                        const bf16x8_t bfv = vt < 8 ? frag_tr2(Vi, ML_STRIDE, 32 * pp, 32 * pp + 16, 16 * vt, lane) : frag_tr2(AUGi, 16, 32 * pp, 32 * pp + 16, 0, lane);
                        X[x] = __builtin_amdgcn_mfma_f32_16x16x32_bf16(P[pp], bfv, X[x], 0, 0, 0); }
#pragma unroll
                    for (int ks = 0; ks < 4; ++ks) X[x] = __builtin_amdgcn_mfma_f32_16x16x32_bf16(qf[ks], frag_row(CB, 16 * vt, 32 * ks, fr, fq), X[x], 0, 0, 0);
                } }
            if (vh == 1 && fr == 0) {
#pragma unroll
                for (int r = 0; r < 4; ++r) den[16 * ti + 4 * fq + r] = X[3][r] * eb[64 * c + 16 * ti + 4 * fq + r]; }
        }
        {
#pragma unroll
            for (int ks = 0; ks < 2; ++ks) { const bf16x8_t kf = frag_tr(Ki, ML_STRIDE, 32 * ks, 16 * w, lane);
#pragma unroll
                for (int vt = 0; vt < 8; ++vt) st[vt] = __builtin_amdgcn_mfma_f32_16x16x32_bf16(kf, frag_tr(Vi, ML_STRIDE, 32 * ks, 16 * vt, lane), st[vt], 0, 0, 0);
                st[8] = __builtin_amdgcn_mfma_f32_16x16x32_bf16(kf, frag_tr(AUGi, 16, 32 * ks, 0, lane), st[8], 0, 0, 0); }
            const float ee = ebend[c];
#pragma unroll
            for (int vt = 0; vt < 9; ++vt) st[vt] = st[vt] * ee;
        }
        WG_BAR();
        if (OUT) {
            float sq[4] = {0.f, 0.f, 0.f, 0.f};
#pragma unroll
            for (int r = 0; r < 4; ++r) { const int t = 16 * ti + 4 * fq + r; const float sc = eb[64 * c + t] * __builtin_amdgcn_rcpf(fmaxf(fabsf(den[t]), 1.f));
#pragma unroll
                for (int x = 0; x < 4; ++x) { const int vt = vh * 5 + x; const float hv = (vt < 8) ? X[x][r] * sc : 0.f; hval[x][r] = hv; sq[r] += hv * hv; }
                if (vh == 0) { const float hv = X[4][r] * sc; X[4][r] = hv; sq[r] += hv * hv; } }
#pragma unroll
            for (int r = 0; r < 4; ++r) { float v = sq[r]; v += __shfl_xor(v, 1); v += __shfl_xor(v, 2); v += __shfl_xor(v, 4); v += __shfl_xor(v, 8); if (fr == 0) ssq[vh * 64 + 16 * ti + 4 * fq + r] = v; }
#pragma unroll
            for (int vt = 0; vt < 9; ++vt) { pg8::u32x2 o; o.x = pk2(st[vt][0], st[vt][1]); o.y = pk2(st[vt][2], st[vt][3]); *(pg8::u32x2*)(CB + (16 * vt + fr) * ML_STRIDE + 16 * w + 4 * fq) = o; }
            WG_BAR();
            bf16* TM = (bf16*)(a.ws + WS_TM); bf16* YA = (bf16*)(a.ws + WS_YA);
#pragma unroll
            for (int r = 0; r < 4; ++r) { const int t = 16 * ti + 4 * fq + r; const float rs = __builtin_amdgcn_rsqf((ssq[t] + ssq[64 + t]) * (1.f / 128.f) + EPS);
                const size_t ob = (size_t)(rowbase - NCTX + 64 * c + t) * 1024 + h * 128;
#pragma unroll
                for (int x = 0; x < 5; ++x) { const int vt = vh * 5 + x; if (vt < 8) { const int v = 16 * vt + fr; const float hv = (x < 4) ? hval[x][r] : X[4][r];
                    float y = hv * rs * hgv[x] * bf2f(ogv[x][r]);
                    if (PASS2) { y += bf2f(tmv[x][r]); YA[ob + v] = (bf16)f2bf(y); } else TM[ob + v] = (bf16)f2bf(y); } } }
        }
    }
}

#undef ML_LOADC
__device__ __forceinline__ void ml_state_quad(const Args& a, unsigned char* lds_g, int qu, int tid) {
    const int seq = qu >> 1, j0 = 4 * (qu & 1), dir = seq & 1, h = (seq >> 1) & 7, b = seq >> 4;
    const int lane = tid & 63, w = __builtin_amdgcn_readfirstlane(tid >> 6);
    f32x4 st[9];
#pragma unroll
    for (int vt = 0; vt < 9; ++vt) st[vt] = (f32x4){0.f, 0.f, 0.f, 0.f};
#pragma unroll 1
    for (int jj = 0; jj < 4; ++jj) {
        const int j = j0 + jj, su = seq * 8 + j;
        const int rowbase = j == 0 ? b * CTXL : NCTX + b * SEQ + 256 * (dir ? 8 - j : j - 1);
        ml_gates(a, lds_g, rowbase, h, tid);
        WG_BAR();
        ml_block<false, false>(a, lds_g, rowbase, h, dir, st, tid);
        pg8::u32x2* SL = (pg8::u32x2*)(a.ws + WS_SLOC) + ((size_t)(su * 8 + w) * 9) * 64 + lane;
#pragma unroll
        for (int vt = 0; vt < 9; ++vt) { pg8::u32x2 o; o.x = pk2(st[vt][0], st[vt][1]); o.y = pk2(st[vt][2], st[vt][3]); SL[vt * 64] = o; }
        if (tid == 0) { const float* bd = (const float*)(lds_g + ML_BEND) + dir * 4; ((float*)(a.ws + WS_BT))[su] = (bd[0] + bd[1]) + (bd[2] + bd[3]); }
        WG_BAR();
    }
}
__device__ __forceinline__ void ml_out_unit(const Args& a, unsigned char* lds_g, int u, int tid) {
    const int L = u & 7, h = (u >> 3) & 7, b = u >> 6;
    const int rowbase = NCTX + b * SEQ + 256 * L;
    const int lane = tid & 63, w = __builtin_amdgcn_readfirstlane(tid >> 6), fr = lane & 15, fq = lane >> 4;
    bf16* CB = (bf16*)(lds_g + ML_CB);
    ml_gates(a, lds_g, rowbase, h, tid);
    f32x4 st[9];
#pragma unroll
    for (int dir = 0; dir < 2; ++dir) {
        const int seq = (b * 8 + h) * 2 + dir, jmax = dir ? 7 - L : L;
        const float* BT = (const float*)(a.ws + WS_BT) + seq * 8;
        {
            const pg8::u32x2* SLa = (const pg8::u32x2*)(a.ws + WS_SLOC) + ((size_t)((seq * 8 + jmax) * 8 + w) * 9) * 64 + lane;
            const pg8::u32x2* SLb = (const pg8::u32x2*)(a.ws + WS_SLOC) + ((size_t)((seq * 8 + 3) * 8 + w) * 9) * 64 + lane;
            pg8::u32x2 sa[9];
            if (jmax >= 4) {
                pg8::u32x2 sb[9];
#pragma unroll
                for (int vt = 0; vt < 9; ++vt) { sa[vt] = SLa[vt * 64]; sb[vt] = SLb[vt * 64]; }
                float ls = 0.f;
#pragma unroll
                for (int q = 4; q < 8; ++q) ls += (q <= jmax) ? BT[q] : 0.f;
                const float coef = __expf(ls);
#pragma unroll
                for (int vt = 0; vt < 9; ++vt) st[vt] = (f32x4){bflo(sa[vt].x) + bflo(sb[vt].x) * coef, bfhi(sa[vt].x) + bfhi(sb[vt].x) * coef, bflo(sa[vt].y) + bflo(sb[vt].y) * coef, bfhi(sa[vt].y) + bfhi(sb[vt].y) * coef};
            } else {
#pragma unroll
                for (int vt = 0; vt < 9; ++vt) { sa[vt] = SLa[vt * 64]; st[vt] = (f32x4){bflo(sa[vt].x), bfhi(sa[vt].x), bflo(sa[vt].y), bfhi(sa[vt].y)}; }
            }
        }
#pragma unroll
        for (int vt = 0; vt < 9; ++vt) { pg8::u32x2 o; o.x = pk2(st[vt][0], st[vt][1]); o.y = pk2(st[vt][2], st[vt][3]); *(pg8::u32x2*)(CB + (16 * vt + fr) * ML_STRIDE + 16 * w + 4 * fq) = o; }
        WG_BAR();
        if (dir == 0) ml_block<true, false>(a, lds_g, rowbase, h, 0, st, tid);
        else ml_block<true, true>(a, lds_g, rowbase, h, 1, st, tid);
        asm volatile("s_waitcnt vmcnt(0)" ::: "memory");
        WG_BAR();
    }
}

__device__ __forceinline__ void lru_out_unit(const Args& a, unsigned char* lds_g, int b, int cidx, int blk, int tid) {
    const int chl = tid & 127, q = tid >> 7, ch = blk * 128 + chl;
    float2* QA = (float2*)lds_g;
    float av[2][16], bv[2][16];
#pragma unroll
    for (int d = 0; d < 2; ++d) { const unsigned* PS = (const unsigned*)(a.ws + WS_PS) + ((size_t)(b * 2 + d) * NSTEP + 64 * cidx + 16 * q) * 1024 + ch;
#pragma unroll
        for (int i = 0; i < 16; ++i) { const unsigned wv = PS[(size_t)i * 1024]; av[d][i] = 1.f - bflo(wv); bv[d][i] = bfhi(wv); } }
    float2* CA = (float2*)(lds_g + 8192);
#pragma unroll
    for (int d = 0; d < 2; ++d) { const float2* AGG = (const float2*)(a.ws + WS_AGG) + ((size_t)(b * 2 + d) * 36) * 1024 + ch; float2 qv[9];
#pragma unroll
        for (int i = 0; i < 9; ++i) { const int sidx = 9 * q + i; const int c2 = d ? (sidx < 4 ? 3 - sidx : 39 - sidx) : sidx; qv[i] = AGG[(size_t)c2 * 1024]; }
        float P = 1.f, S = 0.f;
#pragma unroll
        for (int i = 0; i < 9; ++i) { const int sidx = 9 * q + i; const int c2 = d ? (sidx < 4 ? 3 - sidx : 39 - sidx) : sidx; const bool use = d ? (sidx < 4 || c2 > cidx) : (c2 < cidx);
            S = use ? qv[i].x * S + qv[i].y : S; P = use ? qv[i].x * P : P; }
        CA[(d * 4 + q) * 128 + chl] = make_float2(P, S); }
#pragma unroll
    for (int d = 0; d < 2; ++d) { float P = 1.f, S = 0.f;
#pragma unroll
        for (int ii = 0; ii < 16; ++ii) { const int i = d ? 15 - ii : ii; S = av[d][i] * S + bv[d][i]; P = av[d][i] * P; }
        QA[(d * 4 + q) * 128 + chl] = make_float2(P, S); }
    WG_BAR();
    float hs[16];
#pragma unroll
    for (int d = 0; d < 2; ++d) { float h = 0.f;
#pragma unroll
        for (int k = 0; k < 4; ++k) { const float2 t = CA[(d * 4 + k) * 128 + chl]; h = t.x * h + t.y; }
#pragma unroll
        for (int k = 0; k < 3; ++k) { const int qq = d ? 3 - k : k; const bool use = d ? (qq > q) : (qq < q); const float2 t = QA[(d * 4 + qq) * 128 + chl]; h = use ? t.x * h + t.y : h; }
#pragma unroll
        for (int ii = 0; ii < 16; ++ii) { const int i = d ? 15 - ii : ii; h = av[d][i] * h + bv[d][i]; if (d == 0) hs[i] = h; else hs[i] += h; } }
    const int p0 = (cidx - 4) * 64 + 16 * q;
    unsigned short ugv[16];
#pragma unroll
    for (int i = 0; i < 16; ++i) ugv[i] = ((const bf16*)(a.ws + WS_UG))[(size_t)(lru_pos_row(b, false, p0 + i) - NCTX) * 1024 + ch];
#pragma unroll
    for (int i = 0; i < 16; ++i) { const size_t lrow = (size_t)(lru_pos_row(b, false, p0 + i) - NCTX) * 1024 + ch;
        ((bf16*)(a.ws + WS_YB))[lrow] = (bf16)f2bf(hs[i] * bf2f(ugv[i])); }
    WG_BAR();
}
__device__ __forceinline__ void phase3(const Args& a, unsigned char* lds_g, int tid) {
    {
        int q0 = (int)blockIdx.x, qstep = (int)gridDim.x;
        if (gridDim.x == 256) q0 = blockIdx.x >= 128 ? (int)blockIdx.x - 128 : 128;
        for (int qu = q0; qu < 128; qu += qstep) ml_state_quad(a, lds_g, qu, tid);
    }
    bf16x8_t wl[2][2][4]; int wl_blk = -1;
    for (int u = blockIdx.x; u < 4 * 36 * 8; u += gridDim.x) { const int blk = u & 7, q = u >> 3; lru_unit<false>(a, lds_g, q / 36, q % 36, blk, tid, wl, wl_blk); }
}

struct SchedProj {
    int G, c; const char *YA, *YB, *WA, *WB;
    __device__ __forceinline__ bool next(int i, pg8::Unit& u) const {
        const int tile = (i >> 1) * G + c, part = i & 1; if (tile >= 256) return false;
        int pm, pn; pg8::tile_order(tile, 32, 8, pm, pn);
        u.pm = pm; u.pn = pn; u.aux = part; u.A = (part ? YB : YA) + (size_t)pm * 256 * 1024 * 2; u.B = (part ? WB : WA) + (size_t)pn * 256 * 1024 * 2; return true;
    }
};
struct EpiProj {
    static constexpr bool PERM = true, CARRY = true;
    const bf16 *GA, *GB; bf16* PRE;
    __device__ __forceinline__ bool keep(const pg8::Unit& u) const { return u.aux == 0; }
    __device__ __forceinline__ void operator()(pg8::f32x4 (&acc)[2][2][4][2], const pg8::Unit& u, int wr, int wc, int fr, int fq) const {
#pragma unroll
        for (int ai = 0; ai < 2; ++ai) {
            pg8::u32x4 gb4[4][2], ga4[4][2];
#pragma unroll
            for (int m = 0; m < 4; ++m) { const size_t off = (size_t)(u.pm * 256 + ai * 128 + wr * 64 + m * 16 + fr) * 2048 + u.pn * 256 + wc * 32 + 8 * fq;
#pragma unroll
                for (int bj = 0; bj < 2; ++bj) { gb4[m][bj] = *(const pg8::u32x4*)(GB + off + bj * 128); if (u.aux == 0) ga4[m][bj] = *(const pg8::u32x4*)(GA + off + bj * 128); } }
#pragma unroll
            for (int m = 0; m < 4; ++m) { const size_t off = (size_t)(u.pm * 256 + ai * 128 + wr * 64 + m * 16 + fr) * 2048 + u.pn * 256 + wc * 32 + 8 * fq;
#pragma unroll
                for (int bj = 0; bj < 2; ++bj) { const pg8::u32x4 g4 = gb4[m][bj];
                    const float gbv[8] = {bflo(g4.x), bfhi(g4.x), bflo(g4.y), bfhi(g4.y), bflo(g4.z), bfhi(g4.z), bflo(g4.w), bfhi(g4.w)};
                    if (u.aux == 0) { const pg8::u32x4 a4 = ga4[m][bj];
                        const float gav[8] = {bflo(a4.x), bfhi(a4.x), bflo(a4.y), bfhi(a4.y), bflo(a4.z), bfhi(a4.z), bflo(a4.w), bfhi(a4.w)};
#pragma unroll
                        for (int e = 0; e < 4; ++e) { acc[ai][bj][m][0][e] *= gav[e] * __builtin_amdgcn_rcpf(fmaxf(gbv[e], 1e-20f)); acc[ai][bj][m][1][e] *= gav[4 + e] * __builtin_amdgcn_rcpf(fmaxf(gbv[4 + e], 1e-20f)); }
                    } else {
                        pg8::f32x4 v0 = acc[ai][bj][m][0], v1 = acc[ai][bj][m][1];
#pragma unroll
                        for (int e = 0; e < 4; ++e) { v0[e] *= gbv[e]; v1[e] *= gbv[4 + e]; }
                        pg8::u32x4 w; w.x = pg8::cvt_pk_bf16(v0[0], v0[1]); w.y = pg8::cvt_pk_bf16(v0[2], v0[3]); w.z = pg8::cvt_pk_bf16(v1[0], v1[1]); w.w = pg8::cvt_pk_bf16(v1[2], v1[3]);
                        *(pg8::u32x4*)(PRE + off + bj * 128) = w; } } }
        }
    }
};

struct SchedOut {
    int G, c; const char *A, *B;
    __device__ __forceinline__ bool next(int i, pg8::Unit& u) const {
        const int L = i * G + c; if (L >= 256) return false;
        int pm, pn; pg8::tile_order(L, 32, 8, pm, pn);
        u.pm = pm; u.pn = pn; u.aux = 0; u.A = A + (size_t)pm * 256 * D * 2; u.B = B + (size_t)pn * 256 * D * 2; return true;
    }
};
struct EpiOut {
    static constexpr bool PERM = true, CARRY = false;
    __device__ __forceinline__ bool keep(const pg8::Unit&) const { return false; }
    const float* x; const float* MOD; bf16* X1;
    __device__ __forceinline__ void operator()(const pg8::f32x4 (&acc)[2][2][4][2], const pg8::Unit& u, int wr, int wc, int fr, int fq) const {
        const int b = u.pm >> 3; const int col0 = u.pn * 256 + wc * 32 + 8 * fq;
        pg8::f32x4 g1[2][2];
#pragma unroll
        for (int bj = 0; bj < 2; ++bj)
#pragma unroll
            for (int n = 0; n < 2; ++n) g1[bj][n] = *(const pg8::f32x4*)(MOD + b * 12288 + 2 * 2048 + col0 + bj * 128 + n * 4);
#pragma unroll
        for (int ai = 0; ai < 2; ++ai) {
            pg8::f32x4 xv[4][2][2];
#pragma unroll
            for (int m = 0; m < 4; ++m) { const size_t off = (size_t)(u.pm * 256 + ai * 128 + wr * 64 + m * 16 + fr) * D + col0;
#pragma unroll
                for (int bj = 0; bj < 2; ++bj)
#pragma unroll
                    for (int n = 0; n < 2; ++n) xv[m][bj][n] = *(const pg8::f32x4*)(x + off + bj * 128 + n * 4); }
#pragma unroll
            for (int m = 0; m < 4; ++m) { const size_t off = (size_t)(u.pm * 256 + ai * 128 + wr * 64 + m * 16 + fr) * D + col0;
#pragma unroll
                for (int bj = 0; bj < 2; ++bj) { const pg8::f32x4 v0 = xv[m][bj][0] + g1[bj][0] * acc[ai][bj][m][0], v1 = xv[m][bj][1] + g1[bj][1] * acc[ai][bj][m][1];
                    pg8::u32x4 w; w.x = pg8::cvt_pk_bf16(v0[0], v0[1]); w.y = pg8::cvt_pk_bf16(v0[2], v0[3]); w.z = pg8::cvt_pk_bf16(v1[0], v1[1]); w.w = pg8::cvt_pk_bf16(v1[2], v1[3]);
                    *(pg8::u32x4*)(X1 + off + bj * 128) = w; } }
        }
    }
};

__device__ __forceinline__ void phase_router(const Args& a, unsigned char* lds_g, int tid, int lane, int wave) {
    const bf16* X1 = (const bf16*)(a.ws + WS_X1); const float* MOD = (const float*)(a.ws + WS_MOD); const float* g = a.in[I_N2G];
    const float* WR = (const float*)(a.ws + WS_WR); const float* RB = (const float*)(a.ws + WS_RB);
    bf16* H2 = (bf16*)(a.ws + WS_H2); unsigned* cnt = (unsigned*)(a.ws + WS_CTL) + CW_CNT; int4* ASG = (int4*)(a.ws + WS_ASG);
    f32x4* PART = (f32x4*)lds_g;
    float* SSQP = (float*)(lds_g + 24576);
    float* RS = (float*)(lds_g + 24576 + 512);
    float* LG = (float*)(lds_g + 24576 + 1024);
    const int slot = wave >> 2, kq = wave & 3, i = lane & 15, gq = lane >> 4;
    for (int tp = blockIdx.x; tp < NLAT / 32; tp += gridDim.x) {
        const int tok0 = 32 * tp + 16 * slot, b = tok0 >> 11, kbase = kq * 512 + 8 * gq;
        const bf16* xr = X1 + (size_t)(tok0 + i) * D + kbase;
        const float* wr = WR + ((size_t)(b * 48 + i) * 2048 + kbase);
        f32x4 acc0 = (f32x4){0.f, 0.f, 0.f, 0.f}, acc1 = acc0, acc2 = acc0; float sq = 0.f;
#pragma unroll 2
        for (int s8 = 0; s8 < 16; ++s8) {
            const v4u xb = *(const v4u*)(xr + 32 * s8);
            const f32x4 b0a = *(const f32x4*)(wr + 32 * s8), b0b = *(const f32x4*)(wr + 32 * s8 + 4), b1a = *(const f32x4*)(wr + 16 * 2048 + 32 * s8), b1b = *(const f32x4*)(wr + 16 * 2048 + 32 * s8 + 4),
                        b2a = *(const f32x4*)(wr + 32 * 2048 + 32 * s8), b2b = *(const f32x4*)(wr + 32 * 2048 + 32 * s8 + 4);
            const float xe[8] = {bflo(xb.x), bfhi(xb.x), bflo(xb.y), bfhi(xb.y), bflo(xb.z), bfhi(xb.z), bflo(xb.w), bfhi(xb.w)};
#pragma unroll
            for (int e = 0; e < 4; ++e) { acc0 = __builtin_amdgcn_mfma_f32_16x16x4f32(xe[e], b0a[e], acc0, 0, 0, 0); acc1 = __builtin_amdgcn_mfma_f32_16x16x4f32(xe[e], b1a[e], acc1, 0, 0, 0); acc2 = __builtin_amdgcn_mfma_f32_16x16x4f32(xe[e], b2a[e], acc2, 0, 0, 0); }
#pragma unroll
            for (int e = 0; e < 4; ++e) { acc0 = __builtin_amdgcn_mfma_f32_16x16x4f32(xe[4 + e], b0b[e], acc0, 0, 0, 0); acc1 = __builtin_amdgcn_mfma_f32_16x16x4f32(xe[4 + e], b1b[e], acc1, 0, 0, 0); acc2 = __builtin_amdgcn_mfma_f32_16x16x4f32(xe[4 + e], b2b[e], acc2, 0, 0, 0); }
#pragma unroll
            for (int e = 0; e < 8; ++e) sq += xe[e] * xe[e];
        }
        sq += __shfl_xor(sq, 16); sq += __shfl_xor(sq, 32);
        PART[((slot * 4 + kq) * 3 + 0) * 64 + lane] = acc0; PART[((slot * 4 + kq) * 3 + 1) * 64 + lane] = acc1; PART[((slot * 4 + kq) * 3 + 2) * 64 + lane] = acc2;
        if (gq == 0) SSQP[(slot * 4 + kq) * 16 + i] = sq;
        __syncthreads();
        if (kq == 0) {
            const float* sp = SSQP + slot * 64; const float rstd = 1.f / sqrtf(((sp[i] + sp[16 + i]) + (sp[32 + i] + sp[48 + i])) * (1.f / D) + EPS);
            if (gq == 0) RS[slot * 16 + i] = rstd;
#pragma unroll
            for (int cb = 0; cb < 3; ++cb) { const f32x4* pp = PART + (slot * 4 * 3 + cb) * 64 + lane; const f32x4 sum = (pp[0] + pp[3 * 64]) + (pp[6 * 64] + pp[9 * 64]);
                const float rb = RB[b * 48 + 16 * cb + i];
#pragma unroll
                for (int r = 0; r < 4; ++r) LG[(slot * 16 + 4 * gq + r) * 48 + 16 * cb + i] = __shfl(rstd, 4 * gq + r) * sum[r] + rb; }
            LDS_WAIT(); asm volatile("" ::: "memory");
            if (lane < 16) {
                const float* lg = LG + (slot * 16 + lane) * 48; const int t = tok0 + lane;
                int gs = 0; float gm = lg[32];
#pragma unroll
                for (int q = 1; q < 4; ++q) { const float v = lg[32 + q]; if (v > gm) { gm = v; gs = q; } }
                float se = 0.f;
#pragma unroll
                for (int q = 0; q < 4; ++q) se += __expf(lg[32 + q] - gm);
                const float pg = 1.f / se;
                int i0 = 0; float v0 = lg[gs * 8];
#pragma unroll
                for (int q = 1; q < 8; ++q) { const float v = lg[gs * 8 + q]; if (v > v0) { v0 = v; i0 = q; } }
                int i1 = -1; float v1 = -3.0e38f;
#pragma unroll
                for (int q = 0; q < 8; ++q) { const float v = lg[gs * 8 + q]; if (q != i0 && v > v1) { v1 = v; i1 = q; } }
                const float e1 = __expf(v1 - v0), w0 = pg / (1.f + e1), w1 = pg * e1 / (1.f + e1);
                const int ex0 = gs * 8 + i0, ex1 = gs * 8 + i1;
                const unsigned p0 = atomicAdd(cnt + ex0, 1u), p1 = atomicAdd(cnt + ex1, 1u);
                ASG[2 * t] = make_int4(ex0, (int)p0, __float_as_int(w0), 0); ASG[2 * t + 1] = make_int4(ex1, (int)p1, __float_as_int(w1), 0);
                int* LIST = (int*)(a.ws + WS_LIST); LIST[ex0 * 8192 + (int)p0] = t; LIST[ex1 * 8192 + (int)p1] = t;
            }
        }
        __syncthreads();
#pragma unroll
        for (int r = 0; r < 4; ++r) { const int tl = 4 * kq + r, t = tok0 + tl; const float rstd = RS[slot * 16 + tl];
            const unsigned long long* xrow = (const unsigned long long*)(X1 + (size_t)t * D) + lane; unsigned* o4 = (unsigned*)((unsigned char*)H2 + (size_t)t * D) + lane;
            f32x4 yv[8];
#pragma unroll
            for (int j = 0; j < 8; ++j) { const int c = 4 * lane + 256 * j;
                const f32x4 gg = *(const f32x4*)(g + c), sh = *(const f32x4*)(MOD + b * 12288 + 3 * 2048 + c), sc = *(const f32x4*)(MOD + b * 12288 + 4 * 2048 + c);
                const unsigned long long xw = xrow[64 * j]; const f32x4 xv4 = (f32x4){bflo((unsigned)xw), bfhi((unsigned)xw), bflo((unsigned)(xw >> 32)), bfhi((unsigned)(xw >> 32))};
                yv[j] = xv4 * rstd * gg * (sc + 1.f) + sh; }
#pragma unroll
            for (int j = 0; j < 8; ++j) { int w8 = __builtin_amdgcn_cvt_pk_fp8_f32(yv[j].x, yv[j].y, 0, false); w8 = __builtin_amdgcn_cvt_pk_fp8_f32(yv[j].z, yv[j].w, w8, true); o4[64 * j] = (unsigned)w8; } }
        __syncthreads();
    }
}

constexpr int MG_A = 0, MG_ABYTES = 32768, MG_B = 65536, MG_BBYTES = 64 * 256  , MG_CUM = 141312  ;
__device__ __forceinline__ int mgb_off(int row, int ch) { return 256 * row + 16 * (ch ^ (((row & 3) << 2) | ((row >> 2) & 3))); }
__device__ __forceinline__ bf16x8_t mgb_frag(const unsigned char* img, int ks, int c, int lane) {
    const int g = lane >> 4, q = (lane & 15) >> 2, p = lane & 3;
    const s4_t lo = ds_tr((const bf16*)(img + mgb_off(32 * ks + 8 * g + q, 2 * c + (p >> 1)) + 8 * (p & 1)));
    const s4_t hi = ds_tr((const bf16*)(img + mgb_off(32 * ks + 8 * g + 4 + q, 2 * c + (p >> 1)) + 8 * (p & 1)));
    return (bf16x8_t){lo.x, lo.y, lo.z, lo.w, hi.x, hi.y, hi.z, hi.w};
}
__device__ __forceinline__ void moe_tables(const Args& a, unsigned char* lds_g, int tid) {
    int* cum = (int*)(lds_g + MG_CUM); const unsigned* ctl = (const unsigned*)(a.ws + WS_CTL);
    if (tid < NEXP) cum[128 + tid] = (int)ctl[CW_CNT + tid];
    if (tid == 0) { int c = 0; for (int e = 0; e < NEXP; ++e) { cum[e] = c; c += (int)((ctl[CW_CNT + e] + 255u) >> 8); } cum[NEXP] = c; }
    __syncthreads();
}
constexpr int MH_A = 0, MH_ABYTES = 32768, MH_B = 65536, MH_BROW = 528, MH_BBYTES = 64 * MH_BROW  ;
__device__ __forceinline__ int mhb_off(int row, int ch) { return MH_BROW * row + 16 * ch; }
__device__ __forceinline__ bf16x8_t mhb_frag(const LAS unsigned char* lbase, int cofs) {
    const s4_t lo = __builtin_amdgcn_ds_read_tr16_b64_v4i16((LAS s4_t*)(lbase + cofs));
    const s4_t hi = __builtin_amdgcn_ds_read_tr16_b64_v4i16((LAS s4_t*)(lbase + cofs + MH_BROW));
    return (bf16x8_t){lo.x, lo.y, lo.z, lo.w, hi.x, hi.y, hi.z, hi.w};
}
__device__ __forceinline__ int moe_pull(const Args& a, unsigned char* lds_g, int w, int x) {
    int* slot = (int*)(lds_g + MG_CUM + 256);
    __syncthreads();
    if (w == 0 && fresh_lane() == 0) *slot = (int)__hip_atomic_fetch_add((unsigned*)(a.ws + WS_CTL) + CW_Q + 64 * x, 1u, __ATOMIC_RELAXED, __HIP_MEMORY_SCOPE_AGENT);
    __syncthreads();
    return __builtin_amdgcn_readfirstlane(*slot);
}
__device__ __forceinline__ unsigned f8pair_lo(unsigned w) { const auto v = __builtin_amdgcn_cvt_pk_f32_fp8((int)w, false); return pk2(v[0], v[1]); }
__device__ __forceinline__ unsigned f8pair_hi(unsigned w) { const auto v = __builtin_amdgcn_cvt_pk_f32_fp8((int)w, true); return pk2(v[0], v[1]); }
template <int MODE>
__device__ __forceinline__ int moe_gemm(const Args& a, unsigned char* lds_g, int tid, int idx0) {
    constexpr int K = MODE == 1 ? D : DE, NT = K / 64;
#define MG_BAR() do { asm volatile("s_waitcnt lgkmcnt(0)" ::: "memory"); __builtin_amdgcn_s_barrier(); asm volatile("" ::: "memory"); } while (0)
    const int w = __builtin_amdgcn_readfirstlane(tid >> 6);
    const int wm = w >> 1, wn = w & 1, hh = wm >> 1, wr = wm & 1;
    const int* cum = (const int*)(lds_g + MG_CUM); const unsigned* ctl = (const unsigned*)(a.ws + WS_CTL);
    const int T = cum[NEXP], x = blockIdx.x & 7;
    for (int idx = idx0;;) {
        if (idx < 0) idx = moe_pull(a, lds_g, w, x);
        if (idx >= (MODE == 1 ? T : 2 * T)) return idx;
        const int ti = MODE == 1 ? idx : idx - T;
        idx = -1;
        const int nt = x;
        if (MODE == 2) {
            if (w == 0) { unsigned* tc = (unsigned*)(a.ws + WS_CTL) + CW_TC + 64 * ti; unsigned spins = 0;
                while ((unsigned)__builtin_amdgcn_readfirstlane(__hip_atomic_load(tc, __ATOMIC_RELAXED, __HIP_MEMORY_SCOPE_AGENT)) < 64u) {
                    __builtin_amdgcn_s_sleep(2);
                    if (++spins > (1u << 22)) { if (fresh_lane() == 0) __hip_atomic_store((unsigned*)(a.ws + WS_CTL) + 1, 0x900u + (unsigned)ti, __ATOMIC_RELAXED, __HIP_MEMORY_SCOPE_AGENT); break; } }
                __builtin_amdgcn_fence(__ATOMIC_ACQUIRE, "agent");
                asm volatile("s_waitcnt vmcnt(0)" ::: "memory"); }
            __syncthreads();
        }
        const int lane = fresh_lane(), tidu = w * 64 + lane, fr = lane & 15, fq = lane >> 4;
        const int aoff = pg8::lds_byte(wr * 64 + fr, fq * 8);
        const int bk = w, bp = lane;
        int e = 0;
#pragma unroll 1
        for (int q = 1; q < NEXP; ++q) e = (cum[q] <= ti) ? q : e;
        e = __builtin_amdgcn_readfirstlane(e);
        const int mt = __builtin_amdgcn_readfirstlane(ti - cum[e]);
        unsigned aofs[4]; unsigned bofs; int bwr0;
        __amdgpu_buffer_rsrc_t rsA, rsB, rsB3;
        if (MODE == 1) { const int cnt = cum[128 + e];
#pragma unroll
            for (int q = 0; q < 2; ++q) { const int pos = 256 * mt + 128 * q + (tidu >> 2); const int tok = pos < cnt ? ((const int*)(a.ws + WS_LIST))[e * 8192 + pos] : 0;
                aofs[q] = (unsigned)(tok * D + 16 * (tidu & 3)); }
            aofs[2] = aofs[3] = 0u;
            rsA = __builtin_amdgcn_make_buffer_rsrc((void*)(a.ws + WS_H2), 0, 0x7fffffff, 0x00020000);
            rsB = __builtin_amdgcn_make_buffer_rsrc((void*)(a.in[I_W1] + (size_t)e * D * DE), 0, 0x7fffffff, 0x00020000); rsB3 = __builtin_amdgcn_make_buffer_rsrc((void*)(a.in[I_W3] + (size_t)e * D * DE), 0, 0x7fffffff, 0x00020000);
            bofs = (unsigned)((bk + 8 * (bp >> 5)) * DE + 128 * nt + 4 * (bp & 31)) * 4u;
            bwr0 = MH_BROW * (2 * (bk & 3) + (bk >> 2) + 8 * (bp >> 5)) + 2 * (128 * ((bp & 31) >> 4) + 4 * (bp & 15)); }
        else {
#pragma unroll
            for (int q = 0; q < 2; ++q) aofs[q] = (unsigned)((128 * q + (tidu >> 2)) * DE + 16 * (tidu & 3));
            aofs[2] = aofs[3] = 0u;
            rsA = __builtin_amdgcn_make_buffer_rsrc((void*)((const unsigned char*)(a.ws + WS_HM) + (size_t)256 * ti * DE), 0, 0x7fffffff, 0x00020000);
            rsB = __builtin_amdgcn_make_buffer_rsrc((void*)(a.in[I_W2] + (size_t)e * DE * D), 0, 0x7fffffff, 0x00020000); rsB3 = rsB;
            bofs = (unsigned)(bk * D + 256 * nt + 4 * bp) * 4u; bwr0 = MH_BROW * (2 * (bk & 3) + (bk >> 2)) + 2 * (128 * (bp >> 5) + 32 * ((bp & 31) >> 3) + 16 * (bp & 1) + 4 * ((bp >> 1) & 3)); }
        const LAS unsigned char* blane = (const LAS unsigned char*)lds_g + MH_B + mhb_off(16 * (lane >> 5) + 8 * ((lane >> 4) & 1) + 2 * ((lane & 15) >> 2), 16 * wn + ((lane & 3) >> 1)) + 8 * (lane & 1);
        f32x4 acc[4][8];
#pragma unroll
        for (int m = 0; m < 4; ++m)
#pragma unroll
            for (int n = 0; n < 8; ++n) acc[m][n] = (f32x4){0.f, 0.f, 0.f, 0.f};
        v4u ra[4]; f32x4 rb[8];
#define MH_MMA(buf_) do { const LAS unsigned char* Bi_ = blane + (buf_) * MH_BBYTES; \
        bf16x8_t bc0_ = mhb_frag(Bi_, 0), bc1_ = mhb_frag(Bi_, 32); \
        _Pragma("unroll") for (int ks_ = 0; ks_ < 2; ++ks_) { bf16x8_t af_[4]; \
            _Pragma("unroll") for (int m_ = 0; m_ < 4; ++m_) af_[m_] = *(const bf16x8_t*)(lds_g + MH_A + (buf_) * MH_ABYTES + hh * 16384 + aoff + m_ * 2048 + ks_ * 1024); \
            _Pragma("unroll") for (int n_ = 0; n_ < 8; n_ += 2) { bf16x8_t bn0_ = bc0_, bn1_ = bc1_; \
                if (n_ + 2 < 8) { bn0_ = mhb_frag(Bi_, 32 * ks_ * MH_BROW + 32 * (n_ + 2)); bn1_ = mhb_frag(Bi_, 32 * ks_ * MH_BROW + 32 * (n_ + 3)); } \
                else if (ks_ == 0) { bn0_ = mhb_frag(Bi_, 32 * MH_BROW); bn1_ = mhb_frag(Bi_, 32 * MH_BROW + 32); } \
                __builtin_amdgcn_sched_barrier(0); \
                _Pragma("unroll") for (int m_ = 0; m_ < 4; ++m_) { acc[m_][n_] = __builtin_amdgcn_mfma_f32_16x16x32_bf16(bc0_, af_[m_], acc[m_][n_], 0, 0, 0); \
                    acc[m_][n_ + 1] = __builtin_amdgcn_mfma_f32_16x16x32_bf16(bc1_, af_[m_], acc[m_][n_ + 1], 0, 0, 0); } \
                __builtin_amdgcn_sched_barrier(0); bc0_ = bn0_; bc1_ = bn1_; } } } while (0)
        {
            const int awr = pg8::lds_byte(tidu >> 2, 16 * (tidu & 3));
#define MH_LDB(t_) do { _Pragma("unroll") for (int j_ = 0; j_ < 8; ++j_) rb[j_] = __builtin_bit_cast(f32x4, MODE == 1 ? __builtin_amdgcn_raw_buffer_load_b128((j_ & 1) ? rsB3 : rsB, bofs, (64 * (t_) + 16 * (j_ >> 1)) * DE * 4, 0) \
                                                                                                   : __builtin_amdgcn_raw_buffer_load_b128(rsB, bofs, (64 * (t_) + 8 * j_) * D * 4, 0)); } while (0)
#define MH_LDA(te_, to_) do { ra[0] = __builtin_amdgcn_raw_buffer_load_b128(rsA, aofs[0], 64 * (te_), 0); ra[1] = __builtin_amdgcn_raw_buffer_load_b128(rsA, aofs[1], 64 * (te_), 0); \
            ra[2] = __builtin_amdgcn_raw_buffer_load_b128(rsA, aofs[0], 64 * (to_), 0); ra[3] = __builtin_amdgcn_raw_buffer_load_b128(rsA, aofs[1], 64 * (to_), 0); } while (0)
#define MH_F8(w_) f8pair_lo(w_), f8pair_hi(w_)
#define MH_STA(buf_, x_) do { _Pragma("unroll") for (int h_ = 0; h_ < 2; ++h_) { const v4u p_ = ra[(x_) + h_]; \
            *(v4u*)(lds_g + MH_A + (buf_) * MH_ABYTES + h_ * 16384 + awr) = (v4u){MH_F8(p_.x), MH_F8(p_.y)}; __builtin_amdgcn_sched_barrier(0); \
            *(v4u*)(lds_g + MH_A + (buf_) * MH_ABYTES + h_ * 16384 + awr + 16) = (v4u){MH_F8(p_.z), MH_F8(p_.w)}; __builtin_amdgcn_sched_barrier(0); } } while (0)
#define MH_STB(buf_) do { _Pragma("unroll") for (int j_ = 0; j_ < 8; ++j_) { pg8::u32x2 o_; o_.x = pk2(rb[j_].x, rb[j_].y); o_.y = pk2(rb[j_].z, rb[j_].w); \
            *(pg8::u32x2*)(lds_g + MH_B + (buf_) * MH_BBYTES + bwr0 + (MODE == 1 ? (j_ >> 1) * 16 * MH_BROW + (j_ & 1) * 128 : j_ * 8 * MH_BROW)) = o_; } } while (0)
            MH_LDA(0, 1); MH_LDB(0);
            MG_BAR();
            MH_STA(0, 0); MH_STB(0);
            MH_LDB(1);
            for (int t = 0; t < NT; t += 2) {
                const int t2 = (t + 2 < NT) ? t + 2 : NT - 1, t3 = (t + 3 < NT) ? t + 3 : NT - 1;
                MG_BAR();
                MH_STA(1, 2); MH_STB(1);
                MH_LDA(t2, t3); MH_LDB(t2);
                MH_MMA(0);
                MG_BAR();
                MH_STA(0, 0); MH_STB(0);
                MH_LDB(t3);
                MH_MMA(1);
            }
#undef MH_LDB
#undef MH_LDA
#undef MH_F8
#undef MH_STA
#undef MH_STB
        }
#undef MH_MMA
        const int ln_ = fresh_lane();
        const int efr = ln_ & 15, efq = ln_ >> 4;
        if (MODE == 1) { unsigned char* HM = (unsigned char*)(a.ws + WS_HM) + (size_t)256 * ti * DE + 128 * nt + 64 * wn; const unsigned lo_ = (unsigned)((128 * hh + 64 * wr + efr) * DE + 4 * efq);
#pragma unroll
            for (int m = 0; m < 4; ++m)
#pragma unroll
                for (int n = 0; n < 4; ++n) { float hv[4];
#pragma unroll
                    for (int r = 0; r < 4; ++r) { const float a1 = acc[m][n][r]; hv[r] = a1 * sigmoidf_(a1) * acc[m][n + 4][r]; }
                    int w8 = __builtin_amdgcn_cvt_pk_fp8_f32(hv[0], hv[1], 0, false); w8 = __builtin_amdgcn_cvt_pk_fp8_f32(hv[2], hv[3], w8, true);
                    __hip_atomic_store((unsigned*)(HM + lo_ + 16 * m * DE + 16 * n), (unsigned)w8, __ATOMIC_RELAXED, __HIP_MEMORY_SCOPE_AGENT); }
            asm volatile("s_waitcnt vmcnt(0)" ::: "memory");
            if (ln_ == 0) __hip_atomic_fetch_add((unsigned*)(a.ws + WS_CTL) + CW_TC + 64 * ti, 1u, __ATOMIC_RELAXED, __HIP_MEMORY_SCOPE_AGENT); }
        else { bf16* Y2 = (bf16*)(a.ws + WS_Y2) + (size_t)256 * ti * D + 256 * nt + 128 * wn; const unsigned lo_ = (unsigned)((128 * hh + 64 * wr + efr) * D + 8 * efq);
#pragma unroll
            for (int m = 0; m < 4; ++m)
#pragma unroll
                for (int n = 0; n < 8; n += 2) { v4u o; o.x = pk2(acc[m][n][0], acc[m][n][1]); o.y = pk2(acc[m][n][2], acc[m][n][3]); o.z = pk2(acc[m][n + 1][0], acc[m][n + 1][1]); o.w = pk2(acc[m][n + 1][2], acc[m][n + 1][3]);
                    *(v4u*)(Y2 + lo_ + 16 * m * D + 16 * n) = o; } }
    }
#undef MG_BAR
}

__device__ __forceinline__ void phase12(const Args& a, unsigned char* lds_g, int lane, int wave) {
    const int gw = blockIdx.x * NWAVES + wave, NGW = gridDim.x * NWAVES;
    const int* cum = (const int*)(lds_g + MG_CUM);
    const bf16* X1 = (const bf16*)(a.ws + WS_X1); const float* MOD = (const float*)(a.ws + WS_MOD); const float* fg = a.in[I_FG];
    const int4* ASG = (const int4*)(a.ws + WS_ASG); const bf16* Y2 = (const bf16*)(a.ws + WS_Y2);
    for (int t = gw; t < NLAT; t += NGW) {
        const int b = t >> 11; const int4 q0 = ASG[2 * t], q1 = ASG[2 * t + 1];
        const float w0 = __int_as_float(q0.z), w1 = __int_as_float(q1.z);
        const unsigned long long* xr = (const unsigned long long*)(X1 + (size_t)t * D) + lane;
        const unsigned long long* y0 = (const unsigned long long*)(Y2 + (size_t)(256 * cum[q0.x] + q0.y) * D) + lane; const unsigned long long* y1 = (const unsigned long long*)(Y2 + (size_t)(256 * cum[q1.x] + q1.y) * D) + lane;
        f32x4 v[8]; float s = 0.f;
#pragma unroll
        for (int j = 0; j < 8; ++j) {
            const int c = 4 * lane + 256 * j;
            const f32x4 g2 = *(const f32x4*)(MOD + b * 12288 + 5 * 2048 + c);
            const unsigned long long a0 = y0[64 * j], a1 = y1[64 * j];
            f32x4 y; y.x = w0 * bflo((unsigned)a0) + w1 * bflo((unsigned)a1); y.y = w0 * bfhi((unsigned)a0) + w1 * bfhi((unsigned)a1);
            y.z = w0 * bflo((unsigned)(a0 >> 32)) + w1 * bflo((unsigned)(a1 >> 32)); y.w = w0 * bfhi((unsigned)(a0 >> 32)) + w1 * bfhi((unsigned)(a1 >> 32));
            const unsigned long long xw = xr[64 * j];
            v[j] = (f32x4){bflo((unsigned)xw), bfhi((unsigned)xw), bflo((unsigned)(xw >> 32)), bfhi((unsigned)(xw >> 32))} + g2 * y;
            s += (v[j].x * v[j].x + v[j].y * v[j].y) + (v[j].z * v[j].z + v[j].w * v[j].w);
        }
        const float rstd = 1.f / sqrtf(wave_sum(s) * (1.f / D) + EPS);
        f32x4* o = (f32x4*)(a.out + (size_t)t * D) + lane; f32x4 fgv[8];
#pragma unroll
        for (int j = 0; j < 8; ++j) fgv[j] = *(const f32x4*)(fg + 4 * lane + 256 * j);
#pragma unroll
        for (int j = 0; j < 8; ++j) o[64 * j] = v[j] * rstd * fgv[j];
    }
}

__global__ void __launch_bounds__(NTHR, 2) fwd_kernel(Args args) {
    extern __shared__ __attribute__((aligned(16))) unsigned char lds[];
    LAS unsigned char* ldsl = (LAS unsigned char*)lds;
    volatile LAS unsigned* MISC = (volatile LAS unsigned*)(ldsl + MISC_OFF);
    LAS unsigned* TL = (LAS unsigned*)(ldsl + LDSCTL_OFF);
    const int wave_s = __builtin_amdgcn_readfirstlane(threadIdx.x >> 6);
#define TID() make_tid(wave_s)
    { const int t0 = TID(); for (int u = t0; u < (LDS_BYTES - LDSCTL_OFF) / 4; u += NTHR) ((LAS unsigned*)(ldsl + LDSCTL_OFF))[u] = 0u; }
    __syncthreads();
    unsigned char* ws = args.ws;
    unsigned* ctl = (unsigned*)(ws + WS_CTL);
    XcdBarrier bar; bar.bar = ctl + CW_BAR; bar.x = 0; bar.st = nullptr;
    const bool one_launch = (args.ph_hi - args.ph_lo) > 1;
    if (one_launch) bar = xcd_barrier_post(ctl + CW_BAR, MISC + 8, TID());
    const int lo = args.ph_lo, hi = args.ph_hi;
#define IN(k) (lo <= (k) && (k) < hi)
#define SEAM(k) do { if (IN(k) && IN((k) + 1)) xcd_barrier(bar, TID()); } while (0)
    const int G = gridDim.x, c = blockIdx.x;

#define FRESH() const int tid = TID(), lane = tid & 63, wave = __builtin_amdgcn_readfirstlane(tid >> 6); (void)lane; (void)wave
#ifndef DUP_PHASE
#define DUP_PHASE (-1)
#endif
#define PH(k, ...) if (IN(k)) { _Pragma("unroll") for (int rep_ = 0; rep_ < ((DUP_PHASE) == (k) ? 2 : 1); ++rep_) { if (rep_) xcd_barrier(bar, TID()); __VA_ARGS__ } } SEAM(k);
    PH(0, { FRESH(); phase0(args, lds, tid, lane, wave); mod_wait(args, tid); phase1(args, lane, wave); })
    PH(1, {
        SchedIn S{G, c, (const char*)(ws + WS_H), (const char*)(ws + WS_WIN)}; EpiIn E{ws, args.in[I_BGATES]};
        pg8::gemm_phase<EpiIn, SchedIn>(ldsl, D, S, E, TID());
        { const int R_ = (1492 + G - 1) / G; int fi_ = 1492 - (R_ - 1) * G; if (fi_ >= G) fi_ = 0;
          if (c >= fi_) { FRESH(); late_prep(args, lds, (c - fi_) * NWAVES + wave, (G - fi_) * NWAVES, lane, wave); } } })
    PH(2, { FRESH(); phase3(args, lds, tid); })
    PH(3, { FRESH();
        for (int u = c; u < 256; u += G) ml_out_unit(args, lds, u, tid);
        for (int u = c; u < 4 * 32 * 8; u += G) { const int blk = u & 7, q = u >> 3; lru_out_unit(args, lds, q >> 5, 4 + (q & 31), blk, tid); } })
    PH(4, {
        SchedProj S{G, c, (const char*)(ws + WS_YA), (const char*)(ws + WS_YB), (const char*)(ws + WS_WPA), (const char*)(ws + WS_WPB)};
        EpiProj E{(const bf16*)(ws + WS_GA), (const bf16*)(ws + WS_GB), (bf16*)(ws + WS_PRE)};
        pg8::gemm_phase<EpiProj, SchedProj>(ldsl, 1024, S, E, TID()); })
    PH(5, {
        SchedOut S{G, c, (const char*)(ws + WS_PRE), (const char*)(ws + WS_WOUT)}; EpiOut E{args.in[I_X], (const float*)(ws + WS_MOD), (bf16*)(ws + WS_X1)};
        pg8::gemm_phase<EpiOut, SchedOut>(ldsl, D, S, E, TID()); })
    PH(6, { FRESH(); phase_router(args, lds, tid, lane, wave); })
    PH(7, { FRESH(); moe_tables(args, lds, tid); const int nx_ = moe_gemm<1>(args, lds, tid, -1); { const int tid2_ = TID(); (void)moe_gemm<2>(args, lds, tid2_, nx_); } })
    PH(8, { FRESH(); moe_tables(args, lds, tid); phase12(args, lds, lane, wave); })
#undef PH
#undef IN
#undef SEAM
}

extern "C" void kernel_launch(void* const* d_in, const int* in_sizes, int n_in, void* d_out, int out_size, void* d_ws, size_t ws_size, hipStream_t stream) {
    static int grid = 0;
    if (grid == 0) {
        if (n_in != 27 || out_size != NLAT * D || ws_size < WS_END) { fprintf(stderr, "kernel_launch: unexpected shapes (n_in %d, out %d, ws %zu)\n", n_in, out_size, ws_size); grid = -1; return; }
        int dev = 0, cus = 0, per_cu = 0;
        if (hipGetDevice(&dev) != hipSuccess || hipDeviceGetAttribute(&cus, hipDeviceAttributeMultiprocessorCount, dev) != hipSuccess) { grid = -1; return; }
        if (hipFuncSetAttribute((const void*)fwd_kernel, hipFuncAttributeMaxDynamicSharedMemorySize, LDS_BYTES) != hipSuccess) { fprintf(stderr, "kernel_launch: hipFuncSetAttribute failed\n"); grid = -1; return; }
        if (hipOccupancyMaxActiveBlocksPerMultiprocessor(&per_cu, (const void*)fwd_kernel, NTHR, LDS_BYTES) != hipSuccess || per_cu < 1) fprintf(stderr, "kernel_launch: occupancy query says %d\n", per_cu);
        (void)hipGetLastError();
        grid = cus;
    }
    if (grid < 0) return;
    (void)hipMemsetAsync((char*)d_ws + WS_CTL, 0, CTL_ZERO_BYTES, stream);
    Args a{};
    for (int i = 0; i < 27; ++i) a.in[i] = (const float*)d_in[i];
    a.out = (float*)d_out; a.ws = (unsigned char*)d_ws;
#if MK_ONE_LAUNCH
    a.ph_lo = 0; a.ph_hi = NPHASE;
    hipLaunchKernelGGL(fwd_kernel, dim3(grid), dim3(NTHR), LDS_BYTES, stream, a);
#else
    for (int p = 0; p < NPHASE; ++p) { a.ph_lo = p; a.ph_hi = p + 1; hipLaunchKernelGGL(fwd_kernel, dim3(grid), dim3(NTHR), LDS_BYTES, stream, a); }
#endif
}
```

```cpp
#include <hip/hip_runtime.h>
#include <cstdio>
#include <cstdint>

#ifndef MK_ONE_LAUNCH
#define MK_ONE_LAUNCH 1
#endif

namespace pg8 {
#define PG8_LAS __attribute__((address_space(3)))
typedef unsigned short bf16_t;
typedef short bf16x8 __attribute__((ext_vector_type(8)));
typedef float f32x4 __attribute__((ext_vector_type(4)));
typedef float f32x2 __attribute__((ext_vector_type(2)));
typedef unsigned u32x4 __attribute__((ext_vector_type(4)));
typedef unsigned u32x2 __attribute__((ext_vector_type(2)));
constexpr int BM = 256, BK = 64, HALF = 128, HTB = HALF * BK * 2  , STAGE_BYTES = 8 * HTB, NXCD = 8, WGM = 8;

__host__ __device__ __forceinline__ int lds_byte(int r, int c) { const int st = (r >> 4) * 2 + (c >> 5), rr = r & 15, cc = c & 31, ob = rr * 64 + cc * 2; return st * 1024 + (ob ^ (((ob >> 9) & 1) << 5)); }
__host__ __device__ __forceinline__ void stage_rc(int b, int& R, int& C) { const int st = b / 1024, sb = b % 1024, swz = sb ^ (((sb >> 9) & 1) << 5); R = (st >> 1) * 16 + swz / 64; C = (st & 1) * 32 + (swz % 64) / 2; }
__host__ __device__ __forceinline__ int perm32(int rho) { const int n = rho >> 4, i = rho & 15; return 8 * (i >> 2) + 4 * n + (i & 3); }

struct Unit { const char* A; const char* B; int pm, pn, aux; };

__host__ __device__ __forceinline__ void tile_order(int L, int nM, int nN, int& pm, int& pn) {
    const int nwg = nM * nN; int wgid = L;
    { const int q = nwg / NXCD, r = nwg % NXCD, xcd = wgid % NXCD, off = wgid / NXCD; wgid = (xcd < r ? xcd * (q + 1) : r * (q + 1) + (xcd - r) * q) + off; }
    const int nig = WGM * nN, gid = wgid / nig, fm = gid * WGM, gsz = (nM - fm) < WGM ? (nM - fm) : WGM;
    pm = fm + ((wgid % nig) % gsz); pn = (wgid % nig) / gsz;
}

typedef __bf16 bf16n2 __attribute__((ext_vector_type(2)));
__device__ __forceinline__ unsigned cvt_pk_bf16(float lo, float hi) { const f32x2 v = {lo, hi}; return __builtin_bit_cast(unsigned, __builtin_convertvector(v, bf16n2)); }

template <class Epi, class Sched>
__device__ __forceinline__ void gemm_phase(PG8_LAS unsigned char* lds, const int K, const Sched& S, const Epi& E, int tid) {
    const int wid = __builtin_amdgcn_readfirstlane(tid >> 6), lane = tid & 63, wr = wid >> 2, wc = wid & 3, fr = lane & 15, fq = lane >> 4;
    const int nt = K / BK;
    unsigned voffA[2], voffB[2];
#pragma unroll
    for (int i = 0; i < 2; ++i) { int R, C; stage_rc(tid * 16 + i * 8192, R, C); const int Rb = Epi::PERM ? ((R & ~31) + perm32(R & 31)) : R;
        voffA[i] = (unsigned)(R * K + C) * 2u; voffB[i] = (unsigned)(Rb * K + C) * 2u; }
    const size_t kstep = (size_t)(BK * 2);
    const size_t hstep = (size_t)HALF * K * 2;
    const unsigned ldsw = (unsigned)wid * 1024u;
    const int aoff = lds_byte(wr * 64 + fr, fq * 8), boff = lds_byte(wc * 32 + fr, fq * 8);
#define PG8_SA(b, h) (((b) * 2 + (h)) * HTB)
#define PG8_SB(b, h) ((4 + (b) * 2 + (h)) * HTB)
#define PG8_STAGE(bufoff, gbase, voff) do { _Pragma("unroll") for (int _i = 0; _i < 2; ++_i) \
        __builtin_amdgcn_global_load_lds((const unsigned*)((const char*)(gbase) + (voff)[_i]), (PG8_LAS unsigned*)(lds + (bufoff) + ldsw + _i * 8192), 16, 0, 0); } while (0)
#define PG8_LDA(dst, b, h) do { _Pragma("unroll") for (int m = 0; m < 4; ++m) _Pragma("unroll") for (int k = 0; k < 2; ++k) dst[m][k] = *(const PG8_LAS bf16x8*)(lds + PG8_SA(b, h) + aoff + m * 2048 + k * 1024); } while (0)
#define PG8_LDB(dst, b, h) do { _Pragma("unroll") for (int n = 0; n < 2; ++n) _Pragma("unroll") for (int k = 0; k < 2; ++k) dst[n][k] = *(const PG8_LAS bf16x8*)(lds + PG8_SB(b, h) + boff + n * 2048 + k * 1024); } while (0)
#define PG8_MMA(ai, bj, At, Bt) do { __builtin_amdgcn_s_setprio(1); _Pragma("unroll") for (int m = 0; m < 4; ++m) _Pragma("unroll") for (int n = 0; n < 2; ++n) _Pragma("unroll") for (int k = 0; k < 2; ++k) \
        acc[ai][bj][m][n] = __builtin_amdgcn_mfma_f32_16x16x32_bf16(Bt[n][k], At[m][k], acc[ai][bj][m][n], 0, 0, 0); __builtin_amdgcn_s_setprio(0); } while (0)
#define PG8_WAIT_V(n) asm volatile("s_waitcnt vmcnt(" #n ")" ::: "memory")
#define PG8_WAIT_L(n) asm volatile("s_waitcnt lgkmcnt(" #n ")" ::: "memory")
#define PG8_BAR __builtin_amdgcn_s_barrier()
#define PG8_SCHED __builtin_amdgcn_sched_barrier(0)
    Unit cur, nxt; int ui = 0;
    if (!S.next(0, cur)) return;
    f32x4 acc[2][2][4][2];
#pragma unroll
    for (int a = 0; a < 2; ++a)
#pragma unroll
        for (int b = 0; b < 2; ++b)
#pragma unroll
            for (int m = 0; m < 4; ++m)
#pragma unroll
                for (int n = 0; n < 2; ++n) acc[a][b][m][n] = (f32x4){0.f, 0.f, 0.f, 0.f};
    bf16x8 At[4][2], B0[2][2], B1[2][2];
    const char* cA = cur.A; const char* cB = cur.B;
    PG8_STAGE(PG8_SB(0, 0), cB, voffB); PG8_STAGE(PG8_SB(0, 1), cB + hstep, voffB); PG8_STAGE(PG8_SA(0, 0), cA, voffA); PG8_STAGE(PG8_SA(0, 1), cA + hstep, voffA);
    if (wr == 1) PG8_BAR;
    PG8_WAIT_V(2); PG8_BAR;
    PG8_STAGE(PG8_SB(1, 0), cB + kstep, voffB); PG8_STAGE(PG8_SA(1, 0), cA + kstep, voffA); PG8_STAGE(PG8_SB(1, 1), cB + hstep + kstep, voffB);
    PG8_WAIT_V(6); PG8_BAR;
    for (;;) {
        const bool has_next = S.next(ui + 1, nxt);
        const char* nA = has_next ? nxt.A : cA; const char* nB = has_next ? nxt.B : cB;
        for (int t = 0; t < nt; t += 2) {
            const bool last = (t == nt - 2);
            const char* a1 = cA + (size_t)(t + 1) * kstep;
            const char* a2 = last ? nA : cA + (size_t)(t + 2) * kstep; const char* b2 = last ? nB : cB + (size_t)(t + 2) * kstep;
            const char* a3 = a2 + kstep; const char* b3 = b2 + kstep;
            PG8_LDB(B0, 0, 0); PG8_LDB(B1, 0, 1); PG8_SCHED; PG8_LDA(At, 0, 0); PG8_STAGE(PG8_SA(1, 1), a1 + hstep, voffA);
            PG8_WAIT_V(8); PG8_WAIT_L(0); PG8_BAR; PG8_MMA(0, 0, At, B0); PG8_MMA(0, 1, At, B1); PG8_BAR; PG8_SCHED;
            PG8_LDA(At, 0, 1); PG8_STAGE(PG8_SB(0, 0), b2, voffB); PG8_STAGE(PG8_SB(0, 1), b2 + hstep, voffB); PG8_STAGE(PG8_SA(0, 0), a2, voffA);
            PG8_WAIT_V(8); PG8_WAIT_L(0); PG8_BAR; PG8_MMA(1, 0, At, B0); PG8_MMA(1, 1, At, B1); PG8_BAR; PG8_SCHED;
            PG8_LDB(B0, 1, 0); PG8_LDB(B1, 1, 1); PG8_SCHED; PG8_LDA(At, 1, 0); PG8_STAGE(PG8_SA(0, 1), a2 + hstep, voffA);
            PG8_WAIT_V(8); PG8_WAIT_L(0); PG8_BAR; PG8_MMA(0, 0, At, B0); PG8_MMA(0, 1, At, B1); PG8_BAR; PG8_SCHED;
            PG8_LDA(At, 1, 1); PG8_STAGE(PG8_SB(1, 0), b3, voffB); PG8_STAGE(PG8_SB(1, 1), b3 + hstep, voffB); PG8_STAGE(PG8_SA(1, 0), a3, voffA);
            PG8_WAIT_V(8); PG8_WAIT_L(0); PG8_BAR; PG8_MMA(1, 0, At, B0); PG8_MMA(1, 1, At, B1); PG8_BAR; PG8_SCHED;
        }
        if (wr == 0) PG8_BAR;
        { int fr_ = fr, fq_ = fq; asm volatile("" : "+v"(fr_), "+v"(fq_)); E(acc, cur, wr, wc, fr_, fq_); }
        if (!has_next) break;
        if (!(Epi::CARRY && E.keep(cur))) {
#pragma unroll
        for (int a = 0; a < 2; ++a)
#pragma unroll
            for (int b = 0; b < 2; ++b)
#pragma unroll
                for (int m = 0; m < 4; ++m)
#pragma unroll
                    for (int n = 0; n < 2; ++n) acc[a][b][m][n] = (f32x4){0.f, 0.f, 0.f, 0.f};
        }
        cur = nxt; cA = nA; cB = nB; ++ui;
        if (wr == 1) PG8_BAR;
    }
    PG8_WAIT_V(0);
    PG8_BAR;
#undef PG8_SA
#undef PG8_SB
#undef PG8_STAGE
#undef PG8_LDA
#undef PG8_LDB
#undef PG8_MMA
#undef PG8_WAIT_V
#undef PG8_WAIT_L
#undef PG8_BAR
#undef PG8_SCHED
}
}

constexpr int NWAVES = 8, NTHR = 512;
constexpr int D = 2048, NB = 4, SEQ = 2048, CTXL = 256, NCTX = NB * CTXL  , NLAT = NB * SEQ  , NTOK = NCTX + NLAT  ;
constexpr int NSTEP = CTXL + SEQ;
constexpr int HEADS = 8, HD = 128, MW = 1024, LW = 1024;
constexpr int NEXP = 32, DE = 1024;
constexpr int IN_DIM = 11296, NT_IN = 45;
constexpr float EPS = 1e-6f;
constexpr int MAXTILES = 96;
constexpr int NPHASE = 9;

constexpr size_t MiB = 1u << 20;
constexpr size_t WS_CTL = 0, CTL_ZERO_BYTES = 1 * MiB;
constexpr size_t WS_MOD = 1 * MiB;
constexpr size_t WS_GATES = 2 * MiB;
constexpr size_t WS_ASG = 4 * MiB + 512 * 1024;
constexpr size_t WS_LIST = 3 * MiB + 512 * 1024;
constexpr size_t WS_WR = 6 * MiB;
constexpr size_t WS_RB = 7 * MiB + 768 * 1024;
constexpr size_t WS_WL = 5 * MiB;
constexpr size_t WS_AGG = 978 * MiB;
constexpr size_t WS_WPA = 8 * MiB, WS_WPB = 12 * MiB, WS_WOUT = 16 * MiB, WS_WIN = 24 * MiB;
constexpr size_t WS_W13 = 72 * MiB, WS_W2 = 328 * MiB;
constexpr size_t WS_PS = 72 * MiB;
constexpr size_t WS_H = 456 * MiB;
constexpr size_t WS_K = 492 * MiB, WS_V = 510 * MiB, WS_UX = 528 * MiB;
constexpr size_t WS_Q = 546 * MiB, WS_OF = 562 * MiB, WS_OB = 578 * MiB, WS_UG = 594 * MiB;
constexpr size_t WS_GA = 610 * MiB, WS_GB = 642 * MiB;
constexpr size_t WS_LA = 674 * MiB, WS_LB = 746 * MiB;
constexpr size_t WS_HS = 818 * MiB, WS_TM = 882 * MiB;
constexpr size_t WS_YA = 946 * MiB, WS_YB = 962 * MiB;
constexpr size_t WS_BT = 982 * MiB;
constexpr size_t WS_SLOC = 984 * MiB;
constexpr size_t WS_END = 1022 * MiB;
constexpr size_t WS_PRE = WS_LA;
constexpr size_t WS_X1 = WS_LB;
constexpr size_t WS_H2 = WS_H;
constexpr size_t WS_XS = WS_K;
constexpr size_t WS_HM = 588 * MiB;
constexpr size_t WS_Y2 = WS_HS;
constexpr int CW_MODC = 32;
constexpr int CW_CNT = 64;
constexpr int CW_NT = 128;
constexpr int CW_TILE_E = 192;
constexpr int CW_BAR = 4096;
constexpr int CW_Q = 8192;
constexpr int CW_TC = 16384;

constexpr int RING_BYTES = 131072;
constexpr int LDSCTL_OFF = 143360;
constexpr int MISC_OFF = LDSCTL_OFF + 384;
constexpr int LDS_BYTES = 147456;

#define GAS __attribute__((address_space(1)))
#define LAS __attribute__((address_space(3)))
typedef unsigned short bf16;
typedef unsigned v4u __attribute__((ext_vector_type(4)));
typedef float f32x4 __attribute__((ext_vector_type(4)));
#define LDS_WAIT() asm volatile("s_waitcnt lgkmcnt(0)" ::: "memory")
#define WG_BAR() do { asm volatile("s_waitcnt lgkmcnt(0)" ::: "memory"); __builtin_amdgcn_s_barrier(); asm volatile("" ::: "memory"); } while (0)

__device__ __forceinline__ unsigned f2bf(float f) { unsigned u = __builtin_bit_cast(unsigned, f); return (u + 0x7fffu + ((u >> 16) & 1u)) >> 16; }
__device__ __forceinline__ unsigned pk2(float lo, float hi) { return pg8::cvt_pk_bf16(lo, hi); }
__device__ __forceinline__ float bf2f(unsigned h) { return __builtin_bit_cast(float, h << 16); }
__device__ __forceinline__ float bflo(unsigned w) { return __builtin_bit_cast(float, w << 16); }
__device__ __forceinline__ float bfhi(unsigned w) { return __builtin_bit_cast(float, w & 0xffff0000u); }
__device__ __forceinline__ float sigmoidf_(float x) { return __builtin_amdgcn_rcpf(1.f + __expf(-x)); }
__device__ __forceinline__ float gelu_tanh(float x) { const float u = 0.7978845608028654f * (x + 0.044715f * x * x * x); return x * __builtin_amdgcn_rcpf(1.f + __expf(-2.f * u)); }
__device__ __forceinline__ float wave_sum(float v) {
#pragma unroll
    for (int o = 1; o < 64; o <<= 1) v += __shfl_xor(v, o);
    return v;
}

#define XB_TMO      128
#define XB_XCNT(j)  (256  + 64 * (j))
#define XB_XSUB(j)  (1280 + 64 * (j))
#define XB_XGEN(j)  (2304 + 64 * (j))
#define XB_TOP      3328
#define XB_TOPGEN   3392
#define XCD_BAR_WORDS 3456
#define XB_SPIN_CAP (1u << 23)
__device__ __forceinline__ unsigned xb_ld(unsigned* p)              { return __hip_atomic_load(p, __ATOMIC_RELAXED, __HIP_MEMORY_SCOPE_AGENT); }
__device__ __forceinline__ unsigned xb_add(unsigned* p, unsigned v) { return __hip_atomic_fetch_add(p, v, __ATOMIC_RELAXED, __HIP_MEMORY_SCOPE_AGENT); }
__device__ __forceinline__ unsigned xb_xcc_id() { return (unsigned)__builtin_amdgcn_s_getreg((3 << 11) | 20) & 0xFu; }
#define XB_SPIN(cond, bar) do { unsigned _sp = 0; while (cond) { __builtin_amdgcn_s_sleep(1); \
    if ((++_sp & 255u) == 0u) { if (xb_ld(&(bar)[XB_TMO])) break; if (_sp > XB_SPIN_CAP) { atomicAdd(&(bar)[XB_TMO], 1u); break; } } } } while (0)
struct XcdBarrier { unsigned* bar; unsigned x; volatile LAS unsigned* st; };
__device__ __forceinline__ XcdBarrier xcd_barrier_post(unsigned* bar, volatile LAS unsigned* st, int tid) {
    XcdBarrier b; b.bar = bar; b.x = xb_xcc_id(); b.st = st;
    if (tid == 0) (void)xb_add(&bar[XB_XCNT(b.x)], 1u);
    return b;
}
__device__ __forceinline__ void xcd_barrier_complete(unsigned* bar, unsigned x, unsigned& nloc, unsigned& nx) {
    const unsigned G = gridDim.x * gridDim.y * gridDim.z;
    unsigned sum, cnt, mine, sp = 0u;
    for (;;) {
        sum = 0u; cnt = 0u; mine = 0u;
#pragma unroll
        for (unsigned j = 0; j < 16; ++j) { const unsigned c = xb_ld(&bar[XB_XCNT(j)]); sum += c; cnt += (c > 0u) ? 1u : 0u; mine = (j == x) ? c : mine; }
        if (sum == G) break;
        __builtin_amdgcn_s_sleep(1);
        if ((++sp & 255u) == 0u) { if (xb_ld(&bar[XB_TMO])) break; if (sp > XB_SPIN_CAP) { atomicAdd(&bar[XB_TMO], 1u); break; } }
    }
    nloc = mine > 0u ? mine : 1u; nx = cnt > 0u ? cnt : 1u;
}
__device__ __forceinline__ void xcd_barrier(const XcdBarrier& b, int tid) {
    asm volatile("s_waitcnt vmcnt(0)" ::: "memory");
    __syncthreads();
    if (tid == 0) {
        unsigned* bar = b.bar;
        __builtin_amdgcn_s_waitcnt(0);
        unsigned nloc = b.st[0], nx = b.st[1];
        if (nloc == 0u) { xcd_barrier_complete(bar, b.x, nloc, nx); b.st[0] = nloc; b.st[1] = nx; }
        const unsigned old = xb_add(&bar[XB_XSUB(b.x)], 1u);
        const unsigned gen = old / nloc;
        if (old + 1u == (gen + 1u) * nloc) {
            __builtin_amdgcn_fence(__ATOMIC_RELEASE, "agent");
            asm volatile("s_waitcnt vmcnt(0)" ::: "memory");
            const unsigned og = xb_add(&bar[XB_TOP], 1u);
            const unsigned tg = og / nx;
            if (og + 1u == (tg + 1u) * nx) xb_add(&bar[XB_TOPGEN], 1u);
            else XB_SPIN(xb_ld(&bar[XB_TOPGEN]) == tg, bar);
            __builtin_amdgcn_fence(__ATOMIC_ACQUIRE, "agent");
            xb_add(&bar[XB_XGEN(b.x)], 1u);
            asm volatile("s_waitcnt vmcnt(0)" ::: "memory");
        } else {
            XB_SPIN(xb_ld(&bar[XB_XGEN(b.x)]) == gen, bar);
            __builtin_amdgcn_fence(__ATOMIC_ACQUIRE, "agent");
            asm volatile("s_waitcnt vmcnt(0)" ::: "memory");
        }
    }
    __syncthreads();
}

__device__ __forceinline__ int make_tid(int wave_s) { int l; asm volatile("v_mbcnt_lo_u32_b32 %0, -1, 0\n\tv_mbcnt_hi_u32_b32 %0, -1, %0" : "=v"(l)); __builtin_assume(l >= 0 && l < 64); __builtin_assume(wave_s >= 0 && wave_s < 8); return wave_s * 64 + l; }
__device__ __forceinline__ int fresh_lane() { int l; asm volatile("v_mbcnt_lo_u32_b32 %0, -1, 0\n\tv_mbcnt_hi_u32_b32 %0, -1, %0" : "=v"(l)); __builtin_assume(l >= 0 && l < 64); return l; }
struct Args { const float* in[27]; float* out; unsigned char* ws; int ph_lo, ph_hi; };
enum { I_X = 0, I_C, I_CTX, I_CCTX, I_WMOD, I_BMOD, I_N1G, I_WIN, I_BGATES, I_HEADG, I_CONVW, I_CONVB, I_LWA, I_LBA, I_LWX, I_LBX, I_LAM, I_WPA, I_WPB, I_WOUT, I_N2G, I_WRG, I_WRE, I_W1, I_W3, I_W2, I_FG };

__device__ __forceinline__ void tr_item(const float* __restrict__ W, size_t ldw, int k0, int n0, bf16* dst, size_t ldd, float scale, LAS float* scr, int lane) {
#pragma unroll 16
    for (int i = 0; i < 32; ++i) { const int kk = 2 * i + (lane >> 5); scr[kk * 33 + (lane & 31)] = W[(size_t)(k0 + kk) * ldw + n0 + (lane & 31)]; }
    LDS_WAIT(); asm volatile("" ::: "memory");
    const int c = lane & 7;
#pragma unroll
    for (int j = 0; j < 4; ++j) { const int n = (lane >> 3) + 8 * j; const LAS float* s = scr + (8 * c) * 33 + n;
        v4u o; o.x = pk2(s[0 * 33] * scale, s[1 * 33] * scale); o.y = pk2(s[2 * 33] * scale, s[3 * 33] * scale); o.z = pk2(s[4 * 33] * scale, s[5 * 33] * scale); o.w = pk2(s[6 * 33] * scale, s[7 * 33] * scale);
        *(GAS v4u*)(dst + (size_t)n * ldd + 8 * c) = o; }
    LDS_WAIT(); asm volatile("" ::: "memory");
}
__device__ __forceinline__ int win_row(int n0, float& scale) {
    scale = 1.f;
    if (n0 < 1024) return 13 * 256 + n0;
    if (n0 < 2048) { scale = 0.08838834764831845f; return n0 - 1024; }
    if (n0 < 3072) return 4 * 256 + (n0 - 2048);
    if (n0 < 4096) return 17 * 256 + (n0 - 3072);
    if (n0 < 5120) return 21 * 256 + (n0 - 4096);
    if (n0 < 5152) return 12 * 256 + (n0 - 5120);
    if (n0 < 6176) return 8 * 256 + (n0 - 5152);
    if (n0 < 7200) return 25 * 256 + (n0 - 6176);
    if (n0 < 9248) return 29 * 256 + (n0 - 7200);
    return 37 * 256 + (n0 - 9248);
}

__device__ __forceinline__ void phase0(const Args& a, unsigned char* lds_g, int tid, int lane, int wave) {
    unsigned char* ws = a.ws;
    {
        float* sl = (float*)lds_g;
        float* red = sl + 5 * 2048;
        for (int i = tid; i < 5 * 2048; i += NTHR) { const int r = i >> 11, k = i & 2047; const float v = r < 4 ? a.in[I_C][r * 2048 + k] : a.in[I_CCTX][k]; sl[i] = v / (1.f + __expf(-v)); }
        __syncthreads();
        const float* wm = a.in[I_WMOD]; const float* bm = a.in[I_BMOD]; float* MOD = (float*)(ws + WS_MOD);
        for (int cb = blockIdx.x; cb < 256; cb += gridDim.x) {
            const int n0 = cb * 48;
            if (tid < 504) {
                const int kq = tid / 12, cg = tid % 12;
                f32x4 acc[5];
#pragma unroll
                for (int r = 0; r < 5; ++r) acc[r] = (f32x4){0.f, 0.f, 0.f, 0.f};
#pragma unroll 7
                for (int k = kq; k < 2048; k += 42) {
                    const f32x4 w = *(const f32x4*)(wm + (size_t)k * 12288 + n0 + 4 * cg);
#pragma unroll
                    for (int r = 0; r < 5; ++r) acc[r] += w * sl[r * 2048 + k];
                }
#pragma unroll
                for (int r = 0; r < 5; ++r) *(f32x4*)(red + tid * 20 + r * 4) = acc[r];
            }
            __syncthreads();
            if (tid < 240) {
                const int cg = tid / 20, rj = tid % 20; float s = 0.f;
                for (int kq = 0; kq < 42; ++kq) s += red[(kq * 12 + cg) * 20 + rj];
                const int r = rj >> 2, j = rj & 3, n = n0 + 4 * cg + j;
                __hip_atomic_store(MOD + r * 12288 + n, s + bm[n], __ATOMIC_RELAXED, __HIP_MEMORY_SCOPE_AGENT);
            }
            __syncthreads();
        }
        if (tid == 0) __hip_atomic_fetch_add((unsigned*)(ws + WS_CTL) + CW_MODC, 1u, __ATOMIC_RELAXED, __HIP_MEMORY_SCOPE_AGENT);
    }
    {
        LAS float* scr = (LAS float*)((LAS unsigned char*)lds_g) + wave * 4096;
        const int gw = blockIdx.x * NWAVES + wave, NGW = gridDim.x * NWAVES;
        constexpr int J0 = 32 * 353, J1 = 16 * 64, J3 = 32 * 64;
        constexpr int JL = 256;
        constexpr int NITEMS = J0 + 2 * J1;
        (void)J3; (void)JL;
        for (int it = gw; it < NITEMS; it += NGW) {
            int r = it;
            if (r < J0) { const int kb = r / 353, nb = r % 353; float sc; const int row = win_row(32 * nb, sc);
                tr_item(a.in[I_WIN], IN_DIM, 64 * kb, 32 * nb, (bf16*)(ws + WS_WIN) + (size_t)row * 2048 + 64 * kb, 2048, sc, scr, lane); continue; } r -= J0;
            if (r < J1) { const int kb = r / 64, nb = r % 64; tr_item(a.in[I_WPA], 2048, 64 * kb, 32 * nb, (bf16*)(ws + WS_WPA) + (size_t)(32 * nb) * 1024 + 64 * kb, 1024, 1.f, scr, lane); continue; } r -= J1;
            if (r < J1) { const int kb = r / 64, nb = r % 64; tr_item(a.in[I_WPB], 2048, 64 * kb, 32 * nb, (bf16*)(ws + WS_WPB) + (size_t)(32 * nb) * 1024 + 64 * kb, 1024, 1.f, scr, lane); continue; }
        }
        { GAS v4u* z = (GAS v4u*)((bf16*)(ws + WS_WIN) + (size_t)(12 * 256 + 32) * 2048); const int nchunks = 224 * 256;
          for (int i = blockIdx.x * NTHR + tid; i < nchunks; i += gridDim.x * NTHR) z[i] = (v4u){0u, 0u, 0u, 0u}; }
    }
}

__device__ __forceinline__ void late_prep(const Args& a, unsigned char* lds_g, int gw, int NGW, int lane, int wave) {
    unsigned char* ws = a.ws;
    {
        LAS float* scr = (LAS float*)((LAS unsigned char*)lds_g) + wave * 4096;
        constexpr int J3 = 32 * 64, JL = 256;
        for (int it = gw; it < J3 + JL; it += NGW) {
            int r = it;
            if (r >= J3) { r -= J3; const int mi = r >> 3, kb = (r >> 2) & 1, nb = r & 3, dir = mi >> 4, mat = (mi >> 3) & 1, blk = mi & 7;
                tr_item(a.in[mat ? I_LWX : I_LWA] + (size_t)(dir * 8 + blk) * 128 * 128, 128, 64 * kb, 32 * nb, (bf16*)(ws + WS_WL) + ((size_t)((dir * 2 + mat) * 8 + blk) * 128 + 32 * nb) * 128 + 64 * kb, 128, 1.f, scr, lane); continue; }
            const int kb = r / 64, nb = r % 64; tr_item(a.in[I_WOUT], 2048, 64 * kb, 32 * nb, (bf16*)(ws + WS_WOUT) + (size_t)(32 * nb) * 2048 + 64 * kb, 2048, 1.f, scr, lane);
        }
    }
    {
        const float* MODr = (const float*)(a.ws + WS_MOD); float* WR = (float*)(a.ws + WS_WR); float* RB = (float*)(a.ws + WS_RB);
        for (int idx = gw * 64 + lane; idx < 4 * 48 * 2048; idx += NGW * 64) { const int k = idx & 2047, j = (idx >> 11) % 48, b = idx / (48 * 2048);
            const float gm = a.in[I_N2G][k] * (1.f + MODr[b * 12288 + 4 * 2048 + k]);
            const float wv = j < 32 ? a.in[I_WRE][(size_t)k * 32 + j] : (j < 36 ? a.in[I_WRG][(size_t)k * 4 + (j - 32)] : 0.f);
            WR[idx] = gm * wv; }
        for (int q = gw; q < 4 * 48; q += NGW) { const int b = q / 48, j = q % 48; float sacc = 0.f;
            if (j < 36) { for (int k = lane; k < 2048; k += 64) { const float wv = j < 32 ? a.in[I_WRE][(size_t)k * 32 + j] : a.in[I_WRG][(size_t)k * 4 + (j - 32)]; sacc += MODr[b * 12288 + 3 * 2048 + k] * wv; } }
            sacc = wave_sum(sacc); if (lane == 0) RB[q] = sacc; }
    }
}
__device__ __forceinline__ void mod_wait(const Args& a, int tid) {
    if (tid < 64) { unsigned* mc = (unsigned*)(a.ws + WS_CTL) + CW_MODC; unsigned spins = 0;
        while ((unsigned)__builtin_amdgcn_readfirstlane(__hip_atomic_load(mc, __ATOMIC_RELAXED, __HIP_MEMORY_SCOPE_AGENT)) < gridDim.x) {
            __builtin_amdgcn_s_sleep(2);
            if (++spins > (1u << 22)) { if (tid == 0) __hip_atomic_store((unsigned*)(a.ws + WS_CTL) + 1, 0x800u, __ATOMIC_RELAXED, __HIP_MEMORY_SCOPE_AGENT); break; } }
        __builtin_amdgcn_fence(__ATOMIC_ACQUIRE, "agent");
        asm volatile("s_waitcnt vmcnt(0)" ::: "memory"); }
    __syncthreads();
}
__device__ __forceinline__ void phase1(const Args& a, int lane, int wave) {
    const int gw = blockIdx.x * NWAVES + wave, NGW = gridDim.x * NWAVES;
    const float* MOD = (const float*)(a.ws + WS_MOD); const float* g = a.in[I_N1G];
    bf16* H = (bf16*)(a.ws + WS_H);
    for (int r = gw; r < NTOK; r += NGW) {
        const float* src = r < NCTX ? a.in[I_CTX] + (size_t)r * D : a.in[I_X] + (size_t)(r - NCTX) * D;
        const int mr = r < NCTX ? 4 : (r - NCTX) / SEQ;
        const f32x4* xr = (const f32x4*)src + lane;
        f32x4 v[8]; float s = 0.f;
#pragma unroll
        for (int j = 0; j < 8; ++j) { v[j] = xr[64 * j]; s += (v[j].x * v[j].x + v[j].y * v[j].y) + (v[j].z * v[j].z + v[j].w * v[j].w); }
        const float rstd = 1.f / sqrtf(wave_sum(s) * (1.f / D) + EPS);
        unsigned long long* o8 = (unsigned long long*)(H + (size_t)r * D) + lane;
#pragma unroll
        for (int j = 0; j < 8; ++j) {
            const int c = 4 * lane + 256 * j;
            const f32x4 gg = *(const f32x4*)(g + c), sh = *(const f32x4*)(MOD + mr * 12288 + c), sc = *(const f32x4*)(MOD + mr * 12288 + 2048 + c);
            v[j] = v[j] * rstd * gg * (sc + 1.f) + sh;
        }
#pragma unroll
        for (int j = 0; j < 8; ++j) o8[64 * j] = (unsigned long long)pk2(v[j].x, v[j].y) | ((unsigned long long)pk2(v[j].z, v[j].w) << 32);
    }
}

struct SchedIn {
    int G, c; const char* A; const char* B;
    __device__ __forceinline__ bool next(int i, pg8::Unit& u) const {
        const int L = i * G + c; if (L >= 1492) return false;
        int pm, pn;
        if (L < 1440) { pg8::tile_order(L, 32, NT_IN, pm, pn); pm += 4; }
        else { const int j = L - 1440; pm = j & 3; pn = j >> 2; }
        u.pm = pm; u.pn = pn; u.aux = 0; u.A = A + (size_t)pm * 256 * D * 2; u.B = B + (size_t)pn * 256 * D * 2; return true;
    }
};
struct EpiIn {
    static constexpr bool PERM = true, CARRY = false;
    __device__ __forceinline__ bool keep(const pg8::Unit&) const { return false; }
    unsigned char* ws; const float* b_gates;
    template <int ACT> __device__ __forceinline__ void store_tile(const pg8::f32x4 (&acc)[2][2][4][2], bf16* base, int ldc, int wr, int wc, int fr, int fq) const {
#pragma unroll
        for (int ai = 0; ai < 2; ++ai)
#pragma unroll
            for (int m = 0; m < 4; ++m) { bf16* rowp = base + (size_t)(ai * 128 + wr * 64 + m * 16 + fr) * ldc + wc * 32 + 8 * fq;
#pragma unroll
                for (int bj = 0; bj < 2; ++bj) { pg8::f32x4 v0 = acc[ai][bj][m][0], v1 = acc[ai][bj][m][1];
                    if (ACT == 1) {
#pragma unroll
                        for (int j = 0; j < 4; ++j) { v0[j] = sigmoidf_(v0[j]); v1[j] = sigmoidf_(v1[j]); } }
                    if (ACT == 2) {
#pragma unroll
                        for (int j = 0; j < 4; ++j) { v0[j] = gelu_tanh(v0[j]); v1[j] = gelu_tanh(v1[j]); } }
                    pg8::u32x4 w; w.x = pg8::cvt_pk_bf16(v0[0], v0[1]); w.y = pg8::cvt_pk_bf16(v0[2], v0[3]); w.z = pg8::cvt_pk_bf16(v1[0], v1[1]); w.w = pg8::cvt_pk_bf16(v1[2], v1[3]);
                    *(pg8::u32x4*)(rowp + bj * 128) = w; } }
    }
    __device__ __forceinline__ void operator()(const pg8::f32x4 (&acc)[2][2][4][2], const pg8::Unit& u, int wr, int wc, int fr, int fq) const {
        const int pn = u.pn; const size_t row0 = (size_t)u.pm * 256;
        if (pn < 12) {
            const int seg = pn >> 2, ct = pn & 3; bf16* dst = (bf16*)(ws + (seg == 0 ? WS_K : seg == 1 ? WS_V : WS_UX));
            store_tile<0>(acc, dst + row0 * 1024 + ct * 256, 1024, wr, wc, fr, fq);
        } else if (pn == 12) {
            if (wc == 0) {
                float* G = (float*)(ws + WS_GATES);
                const pg8::f32x4 bv0 = *(const pg8::f32x4*)(b_gates + 8 * fq), bv1 = *(const pg8::f32x4*)(b_gates + 8 * fq + 4);
#pragma unroll
                for (int ai = 0; ai < 2; ++ai)
#pragma unroll
                    for (int m = 0; m < 4; ++m) { float* rowp = G + (row0 + ai * 128 + wr * 64 + m * 16 + fr) * 32 + 8 * fq;
                        *(pg8::f32x4*)(rowp) = acc[ai][0][m][0] + bv0; *(pg8::f32x4*)(rowp + 4) = acc[ai][0][m][1] + bv1; }
            }
        } else if (pn < 29) {
            const int seg = (pn - 13) >> 2, ct = (pn - 13) & 3; const size_t lr = row0 - NCTX;
            bf16* dst = (bf16*)(ws + (seg == 0 ? WS_Q : seg == 1 ? WS_OF : seg == 2 ? WS_OB : WS_UG)) + lr * 1024 + ct * 256;
            if (seg == 0) store_tile<0>(acc, dst, 1024, wr, wc, fr, fq);
            else if (seg == 3) store_tile<2>(acc, dst, 1024, wr, wc, fr, fq);
            else store_tile<1>(acc, dst, 1024, wr, wc, fr, fq);
        } else {
            const int seg = (pn - 29) >> 3, ct = (pn - 29) & 7; const size_t lr = row0 - NCTX;
            store_tile<1>(acc, (bf16*)(ws + (seg ? WS_GB : WS_GA)) + lr * 2048 + ct * 256, 2048, wr, wc, fr, fq);
        }
    }
};

__device__ __forceinline__ int lru_pos_row(int b, bool isctx, int p) { return isctx ? b * CTXL + p : NCTX + b * SEQ + (p & 31) * 64 + (p >> 5); }
typedef short bf16x8_t __attribute__((ext_vector_type(8)));
template <bool FINAL>
__device__ __forceinline__ void lru_unit(const Args& a, unsigned char* lds_g, int b, int cidx, int blk, int tid, bf16x8_t (&wl)[2][2][4], int& wl_blk) {
    const int lane = fresh_lane(), w = __builtin_amdgcn_readfirstlane(tid >> 6), fr = lane & 15, fq = lane >> 4; tid = w * 64 + lane;
    float* zf = (float*)lds_g;
    bf16* zb = (bf16*)(lds_g + 64 * 132 * 4);
    const bool isctx = cidx < 4; const int seglen = isctx ? CTXL : SEQ, p0 = (isctx ? cidx : cidx - 4) * 64;
    const bf16* UX = (const bf16*)(a.ws + WS_UX);
    float gba[2], gbx[2], glam[2];
    { const int ch_ = blk * 128 + 16 * w + fr;
#pragma unroll
      for (int d = 0; d < 2; ++d) { gba[d] = a.in[I_LBA][d * 1024 + ch_]; gbx[d] = a.in[I_LBX][d * 1024 + ch_]; glam[d] = a.in[I_LAM][d * 1024 + ch_]; } }
    if (wl_blk != blk) { const bf16* WL = (const bf16*)(a.ws + WS_WL); wl_blk = blk;
#pragma unroll
      for (int d = 0; d < 2; ++d)
#pragma unroll
        for (int m = 0; m < 2; ++m)
#pragma unroll
            for (int ks = 0; ks < 4; ++ks) wl[d][m][ks] = *(const bf16x8_t*)(WL + ((size_t)((d * 2 + m) * 8 + blk) * 128 + 16 * w + fr) * 128 + 32 * ks + 8 * fq); }
    __builtin_amdgcn_sched_barrier(0);
    {
        const int pos = tid >> 3, cg = tid & 7, ch0 = blk * 128 + cg * 16, p = p0 + pos;
        float z[16];
#pragma unroll
        for (int q = 0; q < 4; ++q) { const f32x4 bv = *(const f32x4*)(a.in[I_CONVB] + ch0 + 4 * q); z[4 * q] = bv.x; z[4 * q + 1] = bv.y; z[4 * q + 2] = bv.z; z[4 * q + 3] = bv.w; }
        v4u ua[4], ub[4]; float msk[4];
#pragma unroll
        for (int w4 = 0; w4 < 4; ++w4) { const int pp = p + w4 - 2; const bool ok = pp >= 0 && pp < seglen; const int ppc = ok ? pp : p;
            const v4u* src = (const v4u*)(UX + (size_t)lru_pos_row(b, isctx, ppc) * 1024 + ch0); ua[w4] = src[0]; ub[w4] = src[1]; msk[w4] = ok ? 1.f : 0.f; }
#pragma unroll
        for (int w4 = 0; w4 < 4; ++w4) { const float* cw = a.in[I_CONVW] + w4 * 1024 + ch0;
            const unsigned uu[8] = {ua[w4].x, ua[w4].y, ua[w4].z, ua[w4].w, ub[w4].x, ub[w4].y, ub[w4].z, ub[w4].w};
#pragma unroll
            for (int q = 0; q < 4; ++q) { const f32x4 cv = *(const f32x4*)(cw + 4 * q) * msk[w4]; z[4 * q] += cv.x * bflo(uu[2 * q]); z[4 * q + 1] += cv.y * bfhi(uu[2 * q]); z[4 * q + 2] += cv.z * bflo(uu[2 * q + 1]); z[4 * q + 3] += cv.w * bfhi(uu[2 * q + 1]); } }
#pragma unroll
        for (int q = 0; q < 4; ++q) *(f32x4*)(zf + pos * 132 + cg * 16 + 4 * q) = (f32x4){z[4 * q], z[4 * q + 1], z[4 * q + 2], z[4 * q + 3]};
        v4u o0, o1; o0.x = pk2(z[0], z[1]); o0.y = pk2(z[2], z[3]); o0.z = pk2(z[4], z[5]); o0.w = pk2(z[6], z[7]); o1.x = pk2(z[8], z[9]); o1.y = pk2(z[10], z[11]); o1.z = pk2(z[12], z[13]); o1.w = pk2(z[14], z[15]);
        *(v4u*)(zb + pos * 136 + cg * 16) = o0; *(v4u*)(zb + pos * 136 + cg * 16 + 8) = o1;
    }
    WG_BAR();
    f32x4 acc[2][2][4];
#pragma unroll
    for (int d = 0; d < 2; ++d)
#pragma unroll
        for (int m = 0; m < 2; ++m)
#pragma unroll
            for (int mt = 0; mt < 4; ++mt) acc[d][m][mt] = (f32x4){0.f, 0.f, 0.f, 0.f};
#pragma unroll
    for (int ks = 0; ks < 4; ++ks) {
        bf16x8_t af[4];
#pragma unroll
        for (int mt = 0; mt < 4; ++mt) af[mt] = *(const bf16x8_t*)(zb + (16 * mt + fr) * 136 + 32 * ks + 8 * fq);
#pragma unroll
        for (int d = 0; d < 2; ++d)
#pragma unroll
            for (int m = 0; m < 2; ++m) {
#pragma unroll
                for (int mt = 0; mt < 4; ++mt) acc[d][m][mt] = __builtin_amdgcn_mfma_f32_16x16x32_bf16(af[mt], wl[d][m][ks], acc[d][m][mt], 0, 0, 0); }
    }
    const int chl = 16 * w + fr, ch = blk * 128 + chl;
    float hsum[4][4];
#pragma unroll
    for (int d = 0; d < 2; ++d) {
        const float ba = gba[d], bx = gbx[d], lam = glam[d];
        const float sp = (-lam > 20.f) ? -lam : log1pf(__expf(-lam));
        float av[4][4], bv[4][4];
#pragma unroll
        for (int mt = 0; mt < 4; ++mt)
#pragma unroll
            for (int r = 0; r < 4; ++r) { const float rr = sigmoidf_(acc[d][0][mt][r] + ba), ii = sigmoidf_(acc[d][1][mt][r] + bx);
                const float aa = __expf(-8.f * rr * sp); av[mt][r] = aa; bv[mt][r] = __builtin_amdgcn_sqrtf(fmaxf(1.f - aa * aa, 0.f)) * ii * zf[(16 * mt + 4 * fq + r) * 132 + chl]; }
        float Pe[4], Se[4], Pt[4], St[4];
#pragma unroll
        for (int mt = 0; mt < 4; ++mt) {
            float P = 1.f, S = 0.f;
#pragma unroll
            for (int rr = 0; rr < 4; ++rr) { const int r = d ? 3 - rr : rr; S = av[mt][r] * S + bv[mt][r]; P = av[mt][r] * P; }
            if (d == 0) {
                float p1 = __shfl_up(P, 16), s1 = __shfl_up(S, 16); if (fq >= 1) { S = P * s1 + S; P = P * p1; }
                p1 = __shfl_up(P, 32); s1 = __shfl_up(S, 32); if (fq >= 2) { S = P * s1 + S; P = P * p1; }
                Pe[mt] = __shfl_up(P, 16); Se[mt] = __shfl_up(S, 16); if (fq == 0) { Pe[mt] = 1.f; Se[mt] = 0.f; }
                Pt[mt] = __shfl(P, fr + 48); St[mt] = __shfl(S, fr + 48);
            } else {
                float p1 = __shfl_down(P, 16), s1 = __shfl_down(S, 16); if (fq <= 2) { S = P * s1 + S; P = P * p1; }
                p1 = __shfl_down(P, 32); s1 = __shfl_down(S, 32); if (fq <= 1) { S = P * s1 + S; P = P * p1; }
                Pe[mt] = __shfl_down(P, 16); Se[mt] = __shfl_down(S, 16); if (fq == 3) { Pe[mt] = 1.f; Se[mt] = 0.f; }
                Pt[mt] = __shfl(P, fr); St[mt] = __shfl(S, fr);
            }
        }
        float2* AGG = (float2*)(a.ws + WS_AGG) + ((size_t)(b * 2 + d) * 36) * 1024 + ch;
        if (!FINAL) {
            if (cidx >= 4) {
                unsigned* PS = (unsigned*)(a.ws + WS_PS) + ((size_t)(b * 2 + d) * NSTEP + 64 * cidx) * 1024 + ch;
#pragma unroll
                for (int mt = 0; mt < 4; ++mt)
#pragma unroll
                    for (int r = 0; r < 4; ++r) PS[(size_t)(16 * mt + 4 * fq + r) * 1024] = pk2(1.f - av[mt][r], bv[mt][r]);
            }
            float Pc = 1.f, Sc = 0.f;
#pragma unroll
            for (int i = 0; i < 4; ++i) { const int mt = d ? 3 - i : i; Sc = Pt[mt] * Sc + St[mt]; Pc = Pt[mt] * Pc; }
            if (fq == 0) AGG[(size_t)cidx * 1024] = make_float2(Pc, Sc);
        } else {
            float h = 0.f;
#pragma unroll
            for (int g3 = 0; g3 < 6; ++g3) {
                float2 qv[6];
#pragma unroll
                for (int i = 0; i < 6; ++i) { const int sidx = 6 * g3 + i; const int c2 = d ? (sidx < 4 ? 3 - sidx : 39 - sidx) : sidx; qv[i] = AGG[(size_t)c2 * 1024]; }
#pragma unroll
                for (int i = 0; i < 6; ++i) { const int sidx = 6 * g3 + i; const int c2 = d ? (sidx < 4 ? 3 - sidx : 39 - sidx) : sidx;
                    const bool use = d ? (sidx < 4 || c2 > cidx) : (c2 < cidx);
                    h = use ? qv[i].x * h + qv[i].y : h; }
            }
#pragma unroll
            for (int i = 0; i < 4; ++i) { const int mt = d ? 3 - i : i;
                float hl = Pe[mt] * h + Se[mt];
#pragma unroll
                for (int rr = 0; rr < 4; ++rr) { const int r = d ? 3 - rr : rr; hl = av[mt][r] * hl + bv[mt][r]; if (d == 0) hsum[mt][r] = hl; else hsum[mt][r] += hl; }
                h = Pt[mt] * h + St[mt]; }
        }
    }
    if (FINAL) {
#pragma unroll
        for (int mt = 0; mt < 4; ++mt)
#pragma unroll
            for (int r = 0; r < 4; ++r) zf[(16 * mt + 4 * fq + r) * 132 + chl] = hsum[mt][r];
        WG_BAR();
        const int pos = tid >> 3, cg = tid & 7, ch0 = blk * 128 + cg * 16;
        const size_t lrow = (size_t)(lru_pos_row(b, false, p0 + pos) - NCTX) * 1024 + ch0;
        const v4u* ug = (const v4u*)((const bf16*)(a.ws + WS_UG) + lrow); const v4u g0 = ug[0], g1 = ug[1];
        const unsigned gg[8] = {g0.x, g0.y, g0.z, g0.w, g1.x, g1.y, g1.z, g1.w}; unsigned o[8];
#pragma unroll
        for (int q = 0; q < 4; ++q) { const f32x4 hv = *(const f32x4*)(zf + pos * 132 + cg * 16 + 4 * q);
            o[2 * q] = pk2(hv.x * bflo(gg[2 * q]), hv.y * bfhi(gg[2 * q])); o[2 * q + 1] = pk2(hv.z * bflo(gg[2 * q + 1]), hv.w * bfhi(gg[2 * q + 1])); }
        v4u* dst = (v4u*)((bf16*)(a.ws + WS_YB) + lrow); dst[0] = (v4u){o[0], o[1], o[2], o[3]}; dst[1] = (v4u){o[4], o[5], o[6], o[7]};
    }
    WG_BAR();
}
constexpr int ML_STRIDE = 136;
constexpr int ML_Q = 0, ML_K = 17408, ML_V = 34816, ML_AUG = 52224  , ML_CB = 54272  ;
constexpr int ML_EB = 93440  , ML_EU = 95488  , ML_EBEND = 97536  , ML_BEND = 97568  , ML_DEN = 97600  , ML_SSQ = 97856  ;
typedef short s4_t __attribute__((ext_vector_type(4)));
__device__ __forceinline__ s4_t ds_tr(const bf16* p) { return __builtin_amdgcn_ds_read_tr16_b64_v4i16((LAS s4_t*)p); }
__device__ __forceinline__ bf16x8_t frag_row(const bf16* img, int row0, int k0, int fr, int fq) { return *(const bf16x8_t*)(img + (row0 + fr) * ML_STRIDE + k0 + 8 * fq); }
__device__ __forceinline__ bf16x8_t frag_tr2(const bf16* img, int stride, int sA, int sB, int col0, int lane) {
    const int fq = lane >> 4, q = (lane & 15) >> 2, p = lane & 3;
    const s4_t lo = ds_tr(img + (sA + 4 * fq + q) * stride + col0 + 4 * p), hi = ds_tr(img + (sB + 4 * fq + q) * stride + col0 + 4 * p);
    return (bf16x8_t){lo.x, lo.y, lo.z, lo.w, hi.x, hi.y, hi.z, hi.w};
}
__device__ __forceinline__ bf16x8_t frag_tr(const bf16* img, int stride, int s0, int col0, int lane) {
    const int fq = lane >> 4, q = (lane & 15) >> 2, p = lane & 3;
    const bf16* b = img + (s0 + 8 * fq + q) * stride + col0 + 4 * p;
    const s4_t lo = ds_tr(b), hi = ds_tr(b + 4 * stride);
    return (bf16x8_t){lo.x, lo.y, lo.z, lo.w, hi.x, hi.y, hi.z, hi.w};
}
__device__ __forceinline__ float logsigmoidf_(float x) { return fminf(x, 0.f) - log1pf(__expf(-fabsf(x))); }

__device__ __forceinline__ void ml_gates(const Args& a, unsigned char* lds_g, int rowbase, int h, int tid) {
    const int lane = fresh_lane(), w = __builtin_amdgcn_readfirstlane(tid >> 6), dir = w >> 2, c = w & 3;
    const float* GT = (const float*)(a.ws + WS_GATES) + (size_t)(rowbase + 64 * c + lane) * 32;
    const float ipre = GT[(dir * 2) * 8 + h], fpre = GT[(dir * 2 + 1) * 8 + h];
    float bsum = logsigmoidf_(fpre);
    if (dir == 0) {
#pragma unroll
        for (int o = 1; o < 64; o <<= 1) { const float t = __shfl_up(bsum, o); if (lane >= o) bsum += t; }
    } else {
#pragma unroll
        for (int o = 1; o < 64; o <<= 1) { const float t = __shfl_down(bsum, o); if (lane + o < 64) bsum += t; }
    }
    float* eb = (float*)(lds_g + ML_EB); float* eu = (float*)(lds_g + ML_EU);
    eb[dir * 256 + 64 * c + lane] = __expf(bsum); eu[dir * 256 + 64 * c + lane] = __expf(ipre - bsum);
    const float bend = __shfl(bsum, dir ? 0 : 63);
    if (lane == 0) { ((float*)(lds_g + ML_EBEND))[dir * 4 + c] = __expf(bend); ((float*)(lds_g + ML_BEND))[dir * 4 + c] = bend; }
}

template <bool OUT, bool PASS2>
__device__ __forceinline__ void ml_block(const Args& a, unsigned char* lds_g, int rowbase, int h, int dir, f32x4 (&st)[9], int tid) {
    const int lane = tid & 63, w = __builtin_amdgcn_readfirstlane(tid >> 6), fr = lane & 15, fq = lane >> 4;
    bf16* Qi = (bf16*)(lds_g + ML_Q); bf16* Ki = (bf16*)(lds_g + ML_K); bf16* Vi = (bf16*)(lds_g + ML_V); bf16* AUGi = (bf16*)(lds_g + ML_AUG); bf16* CB = (bf16*)(lds_g + ML_CB);
    const float* eb = (const float*)(lds_g + ML_EB) + dir * 256; const float* eu = (const float*)(lds_g + ML_EU) + dir * 256;
    const float* ebend = (const float*)(lds_g + ML_EBEND) + dir * 4;
    float* den = (float*)(lds_g + ML_DEN); float* ssq = (float*)(lds_g + ML_SSQ);
    const bf16* Kb = (const bf16*)(a.ws + WS_K); const bf16* Vb = (const bf16*)(a.ws + WS_V); const bf16* Qb = (const bf16*)(a.ws + WS_Q);
    const int ti = w & 3, vh = w >> 2;
    float hgv[5];
    if (OUT) {
#pragma unroll
        for (int x = 0; x < 5; ++x) { const int vt = vh * 5 + x; hgv[x] = vt < 8 ? a.in[I_HEADG][h * 128 + 16 * vt + fr] : 0.f; } }
    const int st_t = tid >> 3, st_pc = tid & 7;
    v4u k0, k1, v0, v1, q0, q1;
#define ML_LOADC(c_) do { const size_t row_ = (size_t)(rowbase + 64 * (c_) + st_t); \
        const v4u* ks_ = (const v4u*)(Kb + row_ * 1024 + h * 128 + 16 * st_pc); k0 = ks_[0]; k1 = ks_[1]; \
        const v4u* vs_ = (const v4u*)(Vb + row_ * 1024 + h * 128 + 16 * st_pc); v0 = vs_[0]; v1 = vs_[1]; \
        if (OUT) { const v4u* qs_ = (const v4u*)(Qb + (row_ - NCTX) * 1024 + h * 128 + 16 * st_pc); q0 = qs_[0]; q1 = qs_[1]; } } while (0)
    ML_LOADC(dir ? 3 : 0);
    for (int ci = 0; ci < 4; ++ci) {
        const int c = dir ? 3 - ci : ci;
        unsigned short ogv[5][4]; unsigned short tmv[5][4];
        if (OUT) {
            const bf16* OGp = (const bf16*)(a.ws + (dir ? WS_OB : WS_OF)); const bf16* TMp = (const bf16*)(a.ws + WS_TM);
#pragma unroll
            for (int r = 0; r < 4; ++r) { const size_t ob = (size_t)(rowbase - NCTX + 64 * c + 16 * ti + 4 * fq + r) * 1024 + h * 128;
#pragma unroll
                for (int x = 0; x < 5; ++x) { const int vt = vh * 5 + x; if (vt < 8) { ogv[x][r] = OGp[ob + 16 * vt + fr]; if (PASS2) tmv[x][r] = TMp[ob + 16 * vt + fr]; } } }
            __builtin_amdgcn_sched_barrier(0);
        }
        {
            const int t = st_t, pc = st_pc;
            const float e = eu[64 * c + t];
            *(v4u*)(Ki + t * ML_STRIDE + 16 * pc) = k0; *(v4u*)(Ki + t * ML_STRIDE + 16 * pc + 8) = k1;
            if (OUT) { *(v4u*)(Qi + t * ML_STRIDE + 16 * pc) = q0; *(v4u*)(Qi + t * ML_STRIDE + 16 * pc + 8) = q1; }
            const unsigned vv[8] = {v0.x, v0.y, v0.z, v0.w, v1.x, v1.y, v1.z, v1.w}; unsigned o[8];
#pragma unroll
            for (int i = 0; i < 8; ++i) o[i] = pk2(bflo(vv[i]) * e, bfhi(vv[i]) * e);
            *(v4u*)(Vi + t * ML_STRIDE + 16 * pc) = (v4u){o[0], o[1], o[2], o[3]}; *(v4u*)(Vi + t * ML_STRIDE + 16 * pc + 8) = (v4u){o[4], o[5], o[6], o[7]};
            if (pc == 0) { *(v4u*)(AUGi + t * 16) = (v4u){f2bf(e), 0u, 0u, 0u}; *(v4u*)(AUGi + t * 16 + 8) = (v4u){0u, 0u, 0u, 0u}; }
        }
        WG_BAR();
        if (ci < 3) ML_LOADC(dir ? 2 - ci : ci + 1);
        f32x4 X[5]; float hval[4][4];
        if (OUT) {
            bf16x8_t qf[4];
#pragma unroll
            for (int ks = 0; ks < 4; ++ks) qf[ks] = frag_row(Qi, 16 * ti, 32 * ks, fr, fq);
            bf16x8_t P[2]; bool pv[2];
#pragma unroll
            for (int pp = 0; pp < 2; ++pp) {
                f32x4 d[2];
#pragma unroll
                for (int hh = 0; hh < 2; ++hh) { const int si = 2 * pp + hh; d[hh] = (f32x4){0.f, 0.f, 0.f, 0.f};
                    const bool valid = dir ? (si >= ti) : (si <= ti);
                    if (valid) {
#pragma unroll
                        for (int ks = 0; ks < 4; ++ks) d[hh] = __builtin_amdgcn_mfma_f32_16x16x32_bf16(frag_row(Ki, 16 * si, 32 * ks, fr, fq), qf[ks], d[hh], 0, 0, 0);
                        if (si == ti) {
#pragma unroll
                            for (int r = 0; r < 4; ++r) { const bool keep = dir ? (4 * fq + r >= fr) : (4 * fq + r <= fr); d[hh][r] = keep ? d[hh][r] : 0.f; } } } }
                pv[pp] = dir ? (2 * pp + 1 >= ti) : (2 * pp <= ti);
                const unsigned p0 = pk2(d[0][0], d[0][1]), p1 = pk2(d[0][2], d[0][3]), p2 = pk2(d[1][0], d[1][1]), p3 = pk2(d[1][2], d[1][3]);
                P[pp] = __builtin_bit_cast(bf16x8_t, (v4u){p0, p1, p2, p3});
            }
#pragma unroll
            for (int x = 0; x < 5; ++x) { X[x] = (f32x4){0.f, 0.f, 0.f, 0.f};
                const int vt = vh * 5 + x;
                if (vt < 9) {
#pragma unroll
                    for (int pp = 0; pp < 2; ++pp) if (pv[pp]) {
                        const bf16x8_t bfv = vt < 8 ? frag_tr2(Vi, ML_STRIDE, 32 * pp, 32 * pp + 16, 16 * vt, lane) : frag_tr2(AUGi, 16, 32 * pp, 32 * pp + 16, 0, lane);
                        X[x] = __builtin_amdgcn_mfma_f32_16x16x32_bf16(P[pp], bfv, X[x], 0, 0, 0); }
#pragma unroll
                    for (int ks = 0; ks < 4; ++ks) X[x] = __builtin_amdgcn_mfma_f32_16x16x32_bf16(qf[ks], frag_row(CB, 16 * vt, 32 * ks, fr, fq), X[x], 0, 0, 0);
                } }
            if (vh == 1 && fr == 0) {
#pragma unroll
                for (int r = 0; r < 4; ++r) den[16 * ti + 4 * fq + r] = X[3][r] * eb[64 * c + 16 * ti + 4 * fq + r]; }
        }
        {
#pragma unroll
            for (int ks = 0; ks < 2; ++ks) { const bf16x8_t kf = frag_tr(Ki, ML_STRIDE, 32 * ks, 16 * w, lane);
#pragma unroll
                for (int vt = 0; vt < 8; ++vt) st[vt] = __builtin_amdgcn_mfma_f32_16x16x32_bf16(kf, frag_tr(Vi, ML_STRIDE, 32 * ks, 16 * vt, lane), st[vt], 0, 0, 0);
                st[8] = __builtin_amdgcn_mfma_f32_16x16x32_bf16(kf, frag_tr(AUGi, 16, 32 * ks, 0, lane), st[8], 0, 0, 0); }
            const float ee = ebend[c];
#pragma unroll
            for (int vt = 0; vt < 9; ++vt) st[vt] = st[vt] * ee;
        }
        WG_BAR();
        if (OUT) {
            float sq[4] = {0.f, 0.f, 0.f, 0.f};
#pragma unroll
            for (int r = 0; r < 4; ++r) { const int t = 16 * ti + 4 * fq + r; const float sc = eb[64 * c + t] * __builtin_amdgcn_rcpf(fmaxf(fabsf(den[t]), 1.f));
#pragma unroll
                for (int x = 0; x < 4; ++x) { const int vt = vh * 5 + x; const float hv = (vt < 8) ? X[x][r] * sc : 0.f; hval[x][r] = hv; sq[r] += hv * hv; }
                if (vh == 0) { const float hv = X[4][r] * sc; X[4][r] = hv; sq[r] += hv * hv; } }
#pragma unroll
            for (int r = 0; r < 4; ++r) { float v = sq[r]; v += __shfl_xor(v, 1); v += __shfl_xor(v, 2); v += __shfl_xor(v, 4); v += __shfl_xor(v, 8); if (fr == 0) ssq[vh * 64 + 16 * ti + 4 * fq + r] = v; }
#pragma unroll
            for (int vt = 0; vt < 9; ++vt) { pg8::u32x2 o; o.x = pk2(st[vt][0], st[vt][1]); o.y = pk2(st[vt][2], st[vt][3]); *(pg8::u32x2*)(CB + (16 * vt + fr) * ML_STRIDE + 16 * w + 4 * fq) = o; }
            WG_BAR();
            bf16* TM = (bf16*)(a.ws + WS_TM); bf16* YA = (bf16*)(a.ws + WS_YA);
#pragma unroll
            for (int r = 0; r < 4; ++r) { const int t = 16 * ti + 4 * fq + r; const float rs = __builtin_amdgcn_rsqf((ssq[t] + ssq[64 + t]) * (1.f / 128.f) + EPS);
                const size_t ob = (size_t)(rowbase - NCTX + 64 * c + t) * 1024 + h * 128;
#pragma unroll
                for (int x = 0; x < 5; ++x) { const int vt = vh * 5 + x; if (vt < 8) { const int v = 16 * vt + fr; const float hv = (x < 4) ? hval[x][r] : X[4][r];
                    float y = hv * rs * hgv[x] * bf2f(ogv[x][r]);
                    if (PASS2) { y += bf2f(tmv[x][r]); YA[ob + v] = (bf16)f2bf(y); } else TM[ob + v] = (bf16)f2bf(y); } } }
        }
    }
}

#undef ML_LOADC
__device__ __forceinline__ void ml_state_quad(const Args& a, unsigned char* lds_g, int qu, int tid) {
    const int seq = qu >> 1, j0 = 4 * (qu & 1), dir = seq & 1, h = (seq >> 1) & 7, b = seq >> 4;
    const int lane = tid & 63, w = __builtin_amdgcn_readfirstlane(tid >> 6);
    f32x4 st[9];
#pragma unroll
    for (int vt = 0; vt < 9; ++vt) st[vt] = (f32x4){0.f, 0.f, 0.f, 0.f};
#pragma unroll 1
    for (int jj = 0; jj < 4; ++jj) {
        const int j = j0 + jj, su = seq * 8 + j;
        const int rowbase = j == 0 ? b * CTXL : NCTX + b * SEQ + 256 * (dir ? 8 - j : j - 1);
        ml_gates(a, lds_g, rowbase, h, tid);
        WG_BAR();
        ml_block<false, false>(a, lds_g, rowbase, h, dir, st, tid);
        pg8::u32x2* SL = (pg8::u32x2*)(a.ws + WS_SLOC) + ((size_t)(su * 8 + w) * 9) * 64 + lane;
#pragma unroll
        for (int vt = 0; vt < 9; ++vt) { pg8::u32x2 o; o.x = pk2(st[vt][0], st[vt][1]); o.y = pk2(st[vt][2], st[vt][3]); SL[vt * 64] = o; }
        if (tid == 0) { const float* bd = (const float*)(lds_g + ML_BEND) + dir * 4; ((float*)(a.ws + WS_BT))[su] = (bd[0] + bd[1]) + (bd[2] + bd[3]); }
        WG_BAR();
    }
}
__device__ __forceinline__ void ml_out_unit(const Args& a, unsigned char* lds_g, int u, int tid) {
    const int L = u & 7, h = (u >> 3) & 7, b = u >> 6;
    const int rowbase = NCTX + b * SEQ + 256 * L;
    const int lane = tid & 63, w = __builtin_amdgcn_readfirstlane(tid >> 6), fr = lane & 15, fq = lane >> 4;
    bf16* CB = (bf16*)(lds_g + ML_CB);
    ml_gates(a, lds_g, rowbase, h, tid);
    f32x4 st[9];
#pragma unroll
    for (int dir = 0; dir < 2; ++dir) {
        const int seq = (b * 8 + h) * 2 + dir, jmax = dir ? 7 - L : L;
        const float* BT = (const float*)(a.ws + WS_BT) + seq * 8;
        {
            const pg8::u32x2* SLa = (const pg8::u32x2*)(a.ws + WS_SLOC) + ((size_t)((seq * 8 + jmax) * 8 + w) * 9) * 64 + lane;
            const pg8::u32x2* SLb = (const pg8::u32x2*)(a.ws + WS_SLOC) + ((size_t)((seq * 8 + 3) * 8 + w) * 9) * 64 + lane;
            pg8::u32x2 sa[9];
            if (jmax >= 4) {
                pg8::u32x2 sb[9];
#pragma unroll
                for (int vt = 0; vt < 9; ++vt) { sa[vt] = SLa[vt * 64]; sb[vt] = SLb[vt * 64]; }
                float ls = 0.f;
#pragma unroll
                for (int q = 4; q < 8; ++q) ls += (q <= jmax) ? BT[q] : 0.f;
                const float coef = __expf(ls);
#pragma unroll
                for (int vt = 0; vt < 9; ++vt) st[vt] = (f32x4){bflo(sa[vt].x) + bflo(sb[vt].x) * coef, bfhi(sa[vt].x) + bfhi(sb[vt].x) * coef, bflo(sa[vt].y) + bflo(sb[vt].y) * coef, bfhi(sa[vt].y) + bfhi(sb[vt].y) * coef};
            } else {
#pragma unroll
                for (int vt = 0; vt < 9; ++vt) { sa[vt] = SLa[vt * 64]; st[vt] = (f32x4){bflo(sa[vt].x), bfhi(sa[vt].x), bflo(sa[vt].y), bfhi(sa[vt].y)}; }
            }
        }
#pragma unroll
        for (int vt = 0; vt < 9; ++vt) { pg8::u32x2 o; o.x = pk2(st[vt][0], st[vt][1]); o.y = pk2(st[vt][2], st[vt][3]); *(pg8::u32x2*)(CB + (16 * vt + fr) * ML_STRIDE + 16 * w + 4 * fq) = o; }
        WG_BAR();
        if (dir == 0) ml_block<true, false>(a, lds_g, rowbase, h, 0, st, tid);
        else ml_block<true, true>(a, lds_g, rowbase, h, 1, st, tid);
        asm volatile("s_waitcnt vmcnt(0)" ::: "memory");
        WG_BAR();
    }
}

__device__ __forceinline__ void lru_out_loadps(const Args& a, int b, int cidx, int blk, int tid, unsigned (&psw)[2][16]) {
    const int chl = tid & 127, q = tid >> 7, ch = blk * 128 + chl;
#pragma unroll
    for (int d = 0; d < 2; ++d) { const unsigned* PS = (const unsigned*)(a.ws + WS_PS) + ((size_t)(b * 2 + d) * NSTEP + 64 * cidx + 16 * q) * 1024 + ch;
#pragma unroll
        for (int i = 0; i < 16; ++i) psw[d][i] = PS[(size_t)i * 1024]; }
}
__device__ __forceinline__ void lru_out_unit(const Args& a, unsigned char* lds_g, int b, int cidx, int blk, int tid, unsigned (&psw)[2][16], int nb, int ncidx, int nblk) {
    tid = __builtin_amdgcn_readfirstlane(tid >> 6) * 64 + fresh_lane();
    const int chl = tid & 127, q = tid >> 7, ch = blk * 128 + chl;
    float2* QA = (float2*)lds_g;
    float av[2][16], bv[2][16];
#pragma unroll
    for (int d = 0; d < 2; ++d)
#pragma unroll
        for (int i = 0; i < 16; ++i) { const unsigned wv = psw[d][i]; av[d][i] = 1.f - bflo(wv); bv[d][i] = bfhi(wv); }
    const int p0 = (cidx - 4) * 64 + 16 * q;
    unsigned short ugv[16];
#pragma unroll
    for (int i = 0; i < 16; ++i) ugv[i] = ((const bf16*)(a.ws + WS_UG))[(size_t)(lru_pos_row(b, false, p0 + i) - NCTX) * 1024 + ch];
    if (ncidx >= 0) lru_out_loadps(a, nb, ncidx, nblk, tid, psw);
    float2* CA = (float2*)(lds_g + 8192);
#pragma unroll
    for (int d = 0; d < 2; ++d) { const float2* AGG = (const float2*)(a.ws + WS_AGG) + ((size_t)(b * 2 + d) * 36) * 1024 + ch; float2 qv[9];
#pragma unroll
        for (int i = 0; i < 9; ++i) { const int sidx = 9 * q + i; const int c2 = d ? (sidx < 4 ? 3 - sidx : 39 - sidx) : sidx; qv[i] = AGG[(size_t)c2 * 1024]; }
        float P = 1.f, S = 0.f;
#pragma unroll
        for (int i = 0; i < 9; ++i) { const int sidx = 9 * q + i; const int c2 = d ? (sidx < 4 ? 3 - sidx : 39 - sidx) : sidx; const bool use = d ? (sidx < 4 || c2 > cidx) : (c2 < cidx);
            S = use ? qv[i].x * S + qv[i].y : S; P = use ? qv[i].x * P : P; }
        CA[(d * 4 + q) * 128 + chl] = make_float2(P, S); }
#pragma unroll
    for (int d = 0; d < 2; ++d) { float P = 1.f, S = 0.f;
#pragma unroll
        for (int ii = 0; ii < 16; ++ii) { const int i = d ? 15 - ii : ii; S = av[d][i] * S + bv[d][i]; P = av[d][i] * P; }
        QA[(d * 4 + q) * 128 + chl] = make_float2(P, S); }
    WG_BAR();
    float hs[16];
#pragma unroll
    for (int d = 0; d < 2; ++d) { float h = 0.f;
#pragma unroll
        for (int k = 0; k < 4; ++k) { const float2 t = CA[(d * 4 + k) * 128 + chl]; h = t.x * h + t.y; }
#pragma unroll
        for (int k = 0; k < 3; ++k) { const int qq = d ? 3 - k : k; const bool use = d ? (qq > q) : (qq < q); const float2 t = QA[(d * 4 + qq) * 128 + chl]; h = use ? t.x * h + t.y : h; }
#pragma unroll
        for (int ii = 0; ii < 16; ++ii) { const int i = d ? 15 - ii : ii; h = av[d][i] * h + bv[d][i]; if (d == 0) hs[i] = h; else hs[i] += h; } }
#pragma unroll
    for (int i = 0; i < 16; ++i) { const size_t lrow = (size_t)(lru_pos_row(b, false, p0 + i) - NCTX) * 1024 + ch;
        ((bf16*)(a.ws + WS_YB))[lrow] = (bf16)f2bf(hs[i] * bf2f(ugv[i])); }
    WG_BAR();
}
__device__ __forceinline__ void phase3(const Args& a, unsigned char* lds_g, int tid) {
    {
        int q0 = (int)blockIdx.x, qstep = (int)gridDim.x;
        if (gridDim.x == 256) q0 = blockIdx.x >= 128 ? (int)blockIdx.x - 128 : 128;
        for (int qu = q0; qu < 128; qu += qstep) ml_state_quad(a, lds_g, qu, tid);
    }
    bf16x8_t wl[2][2][4]; int wl_blk = -1;
    for (int u = blockIdx.x; u < 4 * 36 * 8; u += gridDim.x) { const int blk = u & 7, q = u >> 3; lru_unit<false>(a, lds_g, q / 36, q % 36, blk, tid, wl, wl_blk); }
}

struct SchedProj {
    int G, c; const char *YA, *YB, *WA, *WB;
    __device__ __forceinline__ bool next(int i, pg8::Unit& u) const {
        const int tile = (i >> 1) * G + c, part = i & 1; if (tile >= 256) return false;
        int pm, pn; pg8::tile_order(tile, 32, 8, pm, pn);
        u.pm = pm; u.pn = pn; u.aux = part; u.A = (part ? YB : YA) + (size_t)pm * 256 * 1024 * 2; u.B = (part ? WB : WA) + (size_t)pn * 256 * 1024 * 2; return true;
    }
};
struct EpiProj {
    static constexpr bool PERM = true, CARRY = true;
    const bf16 *GA, *GB; bf16* PRE;
    __device__ __forceinline__ bool keep(const pg8::Unit& u) const { return u.aux == 0; }
    __device__ __forceinline__ void operator()(pg8::f32x4 (&acc)[2][2][4][2], const pg8::Unit& u, int wr, int wc, int fr, int fq) const {
#pragma unroll
        for (int ai = 0; ai < 2; ++ai) {
            pg8::u32x4 gb4[4][2], ga4[4][2];
#pragma unroll
            for (int m = 0; m < 4; ++m) { const size_t off = (size_t)(u.pm * 256 + ai * 128 + wr * 64 + m * 16 + fr) * 2048 + u.pn * 256 + wc * 32 + 8 * fq;
#pragma unroll
                for (int bj = 0; bj < 2; ++bj) { gb4[m][bj] = *(const pg8::u32x4*)(GB + off + bj * 128); if (u.aux == 0) ga4[m][bj] = *(const pg8::u32x4*)(GA + off + bj * 128); } }
#pragma unroll
            for (int m = 0; m < 4; ++m) { const size_t off = (size_t)(u.pm * 256 + ai * 128 + wr * 64 + m * 16 + fr) * 2048 + u.pn * 256 + wc * 32 + 8 * fq;
#pragma unroll
                for (int bj = 0; bj < 2; ++bj) { const pg8::u32x4 g4 = gb4[m][bj];
                    const float gbv[8] = {bflo(g4.x), bfhi(g4.x), bflo(g4.y), bfhi(g4.y), bflo(g4.z), bfhi(g4.z), bflo(g4.w), bfhi(g4.w)};
                    if (u.aux == 0) { const pg8::u32x4 a4 = ga4[m][bj];
                        const float gav[8] = {bflo(a4.x), bfhi(a4.x), bflo(a4.y), bfhi(a4.y), bflo(a4.z), bfhi(a4.z), bflo(a4.w), bfhi(a4.w)};
#pragma unroll
                        for (int e = 0; e < 4; ++e) { acc[ai][bj][m][0][e] *= gav[e] * __builtin_amdgcn_rcpf(fmaxf(gbv[e], 1e-20f)); acc[ai][bj][m][1][e] *= gav[4 + e] * __builtin_amdgcn_rcpf(fmaxf(gbv[4 + e], 1e-20f)); }
                    } else {
                        pg8::f32x4 v0 = acc[ai][bj][m][0], v1 = acc[ai][bj][m][1];
#pragma unroll
                        for (int e = 0; e < 4; ++e) { v0[e] *= gbv[e]; v1[e] *= gbv[4 + e]; }
                        pg8::u32x4 w; w.x = pg8::cvt_pk_bf16(v0[0], v0[1]); w.y = pg8::cvt_pk_bf16(v0[2], v0[3]); w.z = pg8::cvt_pk_bf16(v1[0], v1[1]); w.w = pg8::cvt_pk_bf16(v1[2], v1[3]);
                        *(pg8::u32x4*)(PRE + off + bj * 128) = w; } } }
        }
    }
};

struct SchedOut {
    int G, c; const char *A, *B;
    __device__ __forceinline__ bool next(int i, pg8::Unit& u) const {
        const int L = i * G + c; if (L >= 256) return false;
        int pm, pn; pg8::tile_order(L, 32, 8, pm, pn);
        u.pm = pm; u.pn = pn; u.aux = 0; u.A = A + (size_t)pm * 256 * D * 2; u.B = B + (size_t)pn * 256 * D * 2; return true;
    }
};
struct EpiOut {
    static constexpr bool PERM = true, CARRY = false;
    __device__ __forceinline__ bool keep(const pg8::Unit&) const { return false; }
    const float* x; const float* MOD; bf16* X1;
    __device__ __forceinline__ void operator()(const pg8::f32x4 (&acc)[2][2][4][2], const pg8::Unit& u, int wr, int wc, int fr, int fq) const {
        const int b = u.pm >> 3; const int col0 = u.pn * 256 + wc * 32 + 8 * fq;
        pg8::f32x4 g1[2][2];
#pragma unroll
        for (int bj = 0; bj < 2; ++bj)
#pragma unroll
            for (int n = 0; n < 2; ++n) g1[bj][n] = *(const pg8::f32x4*)(MOD + b * 12288 + 2 * 2048 + col0 + bj * 128 + n * 4);
#pragma unroll
        for (int ai = 0; ai < 2; ++ai) {
            pg8::f32x4 xv[4][2][2];
#pragma unroll
            for (int m = 0; m < 4; ++m) { const size_t off = (size_t)(u.pm * 256 + ai * 128 + wr * 64 + m * 16 + fr) * D + col0;
#pragma unroll
                for (int bj = 0; bj < 2; ++bj)
#pragma unroll
                    for (int n = 0; n < 2; ++n) xv[m][bj][n] = *(const pg8::f32x4*)(x + off + bj * 128 + n * 4); }
#pragma unroll
            for (int m = 0; m < 4; ++m) { const size_t off = (size_t)(u.pm * 256 + ai * 128 + wr * 64 + m * 16 + fr) * D + col0;
#pragma unroll
                for (int bj = 0; bj < 2; ++bj) { const pg8::f32x4 v0 = xv[m][bj][0] + g1[bj][0] * acc[ai][bj][m][0], v1 = xv[m][bj][1] + g1[bj][1] * acc[ai][bj][m][1];
                    pg8::u32x4 w; w.x = pg8::cvt_pk_bf16(v0[0], v0[1]); w.y = pg8::cvt_pk_bf16(v0[2], v0[3]); w.z = pg8::cvt_pk_bf16(v1[0], v1[1]); w.w = pg8::cvt_pk_bf16(v1[2], v1[3]);
                    *(pg8::u32x4*)(X1 + off + bj * 128) = w; } }
        }
    }
};

__device__ __forceinline__ void phase_router(const Args& a, unsigned char* lds_g, int tid, int lane, int wave) {
    const bf16* X1 = (const bf16*)(a.ws + WS_X1); const float* MOD = (const float*)(a.ws + WS_MOD); const float* g = a.in[I_N2G];
    const float* WR = (const float*)(a.ws + WS_WR); const float* RB = (const float*)(a.ws + WS_RB);
    bf16* H2 = (bf16*)(a.ws + WS_H2); unsigned* cnt = (unsigned*)(a.ws + WS_CTL) + CW_CNT; int4* ASG = (int4*)(a.ws + WS_ASG);
    f32x4* PART = (f32x4*)lds_g;
    float* SSQP = (float*)(lds_g + 24576);
    float* RS = (float*)(lds_g + 24576 + 512);
    float* LG = (float*)(lds_g + 24576 + 1024);
    const int slot = wave >> 2, kq = wave & 3, i = lane & 15, gq = lane >> 4;
    for (int tp = blockIdx.x; tp < NLAT / 32; tp += gridDim.x) {
        const int tok0 = 32 * tp + 16 * slot, b = tok0 >> 11, kbase = kq * 512 + 8 * gq;
        const bf16* xr = X1 + (size_t)(tok0 + i) * D + kbase;
        const float* wr = WR + ((size_t)(b * 48 + i) * 2048 + kbase);
        f32x4 acc0 = (f32x4){0.f, 0.f, 0.f, 0.f}, acc1 = acc0, acc2 = acc0; float sq = 0.f;
#pragma unroll 2
        for (int s8 = 0; s8 < 16; ++s8) {
            const v4u xb = *(const v4u*)(xr + 32 * s8);
            const f32x4 b0a = *(const f32x4*)(wr + 32 * s8), b0b = *(const f32x4*)(wr + 32 * s8 + 4), b1a = *(const f32x4*)(wr + 16 * 2048 + 32 * s8), b1b = *(const f32x4*)(wr + 16 * 2048 + 32 * s8 + 4),
                        b2a = *(const f32x4*)(wr + 32 * 2048 + 32 * s8), b2b = *(const f32x4*)(wr + 32 * 2048 + 32 * s8 + 4);
            const float xe[8] = {bflo(xb.x), bfhi(xb.x), bflo(xb.y), bfhi(xb.y), bflo(xb.z), bfhi(xb.z), bflo(xb.w), bfhi(xb.w)};
#pragma unroll
            for (int e = 0; e < 4; ++e) { acc0 = __builtin_amdgcn_mfma_f32_16x16x4f32(xe[e], b0a[e], acc0, 0, 0, 0); acc1 = __builtin_amdgcn_mfma_f32_16x16x4f32(xe[e], b1a[e], acc1, 0, 0, 0); acc2 = __builtin_amdgcn_mfma_f32_16x16x4f32(xe[e], b2a[e], acc2, 0, 0, 0); }
#pragma unroll
            for (int e = 0; e < 4; ++e) { acc0 = __builtin_amdgcn_mfma_f32_16x16x4f32(xe[4 + e], b0b[e], acc0, 0, 0, 0); acc1 = __builtin_amdgcn_mfma_f32_16x16x4f32(xe[4 + e], b1b[e], acc1, 0, 0, 0); acc2 = __builtin_amdgcn_mfma_f32_16x16x4f32(xe[4 + e], b2b[e], acc2, 0, 0, 0); }
#pragma unroll
            for (int e = 0; e < 8; ++e) sq += xe[e] * xe[e];
        }
        sq += __shfl_xor(sq, 16); sq += __shfl_xor(sq, 32);
        PART[((slot * 4 + kq) * 3 + 0) * 64 + lane] = acc0; PART[((slot * 4 + kq) * 3 + 1) * 64 + lane] = acc1; PART[((slot * 4 + kq) * 3 + 2) * 64 + lane] = acc2;
        if (gq == 0) SSQP[(slot * 4 + kq) * 16 + i] = sq;
        __syncthreads();
        if (kq == 0) {
            const float* sp = SSQP + slot * 64; const float rstd = 1.f / sqrtf(((sp[i] + sp[16 + i]) + (sp[32 + i] + sp[48 + i])) * (1.f / D) + EPS);
            if (gq == 0) RS[slot * 16 + i] = rstd;
#pragma unroll
            for (int cb = 0; cb < 3; ++cb) { const f32x4* pp = PART + (slot * 4 * 3 + cb) * 64 + lane; const f32x4 sum = (pp[0] + pp[3 * 64]) + (pp[6 * 64] + pp[9 * 64]);
                const float rb = RB[b * 48 + 16 * cb + i];
#pragma unroll
                for (int r = 0; r < 4; ++r) LG[(slot * 16 + 4 * gq + r) * 48 + 16 * cb + i] = __shfl(rstd, 4 * gq + r) * sum[r] + rb; }
            LDS_WAIT(); asm volatile("" ::: "memory");
            if (lane < 16) {
                const float* lg = LG + (slot * 16 + lane) * 48; const int t = tok0 + lane;
                int gs = 0; float gm = lg[32];
#pragma unroll
                for (int q = 1; q < 4; ++q) { const float v = lg[32 + q]; if (v > gm) { gm = v; gs = q; } }
                float se = 0.f;
#pragma unroll
                for (int q = 0; q < 4; ++q) se += __expf(lg[32 + q] - gm);
                const float pg = 1.f / se;
                int i0 = 0; float v0 = lg[gs * 8];
#pragma unroll
                for (int q = 1; q < 8; ++q) { const float v = lg[gs * 8 + q]; if (v > v0) { v0 = v; i0 = q; } }
                int i1 = -1; float v1 = -3.0e38f;
#pragma unroll
                for (int q = 0; q < 8; ++q) { const float v = lg[gs * 8 + q]; if (q != i0 && v > v1) { v1 = v; i1 = q; } }
                const float e1 = __expf(v1 - v0), w0 = pg / (1.f + e1), w1 = pg * e1 / (1.f + e1);
                const int ex0 = gs * 8 + i0, ex1 = gs * 8 + i1;
                const unsigned p0 = atomicAdd(cnt + ex0, 1u), p1 = atomicAdd(cnt + ex1, 1u);
                ASG[2 * t] = make_int4(ex0, (int)p0, __float_as_int(w0), 0); ASG[2 * t + 1] = make_int4(ex1, (int)p1, __float_as_int(w1), 0);
                int* LIST = (int*)(a.ws + WS_LIST); LIST[ex0 * 8192 + (int)p0] = t; LIST[ex1 * 8192 + (int)p1] = t;
            }
        }
        __syncthreads();
#pragma unroll
        for (int r = 0; r < 4; ++r) { const int tl = 4 * kq + r, t = tok0 + tl; const float rstd = RS[slot * 16 + tl];
            const unsigned long long* xrow = (const unsigned long long*)(X1 + (size_t)t * D) + lane; unsigned* o4 = (unsigned*)((unsigned char*)H2 + (size_t)t * D) + lane;
            f32x4 yv[8];
#pragma unroll
            for (int j = 0; j < 8; ++j) { const int c = 4 * lane + 256 * j;
                const f32x4 gg = *(const f32x4*)(g + c), sh = *(const f32x4*)(MOD + b * 12288 + 3 * 2048 + c), sc = *(const f32x4*)(MOD + b * 12288 + 4 * 2048 + c);
                const unsigned long long xw = xrow[64 * j]; const f32x4 xv4 = (f32x4){bflo((unsigned)xw), bfhi((unsigned)xw), bflo((unsigned)(xw >> 32)), bfhi((unsigned)(xw >> 32))};
                yv[j] = xv4 * rstd * gg * (sc + 1.f) + sh; }
#pragma unroll
            for (int j = 0; j < 8; ++j) { int w8 = __builtin_amdgcn_cvt_pk_fp8_f32(yv[j].x, yv[j].y, 0, false); w8 = __builtin_amdgcn_cvt_pk_fp8_f32(yv[j].z, yv[j].w, w8, true); o4[64 * j] = (unsigned)w8; } }
        __syncthreads();
    }
}

constexpr int MG_A = 0, MG_ABYTES = 32768, MG_B = 65536, MG_BBYTES = 64 * 256  , MG_CUM = 141312  ;
__device__ __forceinline__ int mgb_off(int row, int ch) { return 256 * row + 16 * (ch ^ (((row & 3) << 2) | ((row >> 2) & 3))); }
__device__ __forceinline__ bf16x8_t mgb_frag(const unsigned char* img, int ks, int c, int lane) {
    const int g = lane >> 4, q = (lane & 15) >> 2, p = lane & 3;
    const s4_t lo = ds_tr((const bf16*)(img + mgb_off(32 * ks + 8 * g + q, 2 * c + (p >> 1)) + 8 * (p & 1)));
    const s4_t hi = ds_tr((const bf16*)(img + mgb_off(32 * ks + 8 * g + 4 + q, 2 * c + (p >> 1)) + 8 * (p & 1)));
    return (bf16x8_t){lo.x, lo.y, lo.z, lo.w, hi.x, hi.y, hi.z, hi.w};
}
__device__ __forceinline__ void moe_tables(const Args& a, unsigned char* lds_g, int tid) {
    int* cum = (int*)(lds_g + MG_CUM); const unsigned* ctl = (const unsigned*)(a.ws + WS_CTL);
    if (tid < NEXP) cum[128 + tid] = (int)ctl[CW_CNT + tid];
    if (tid == 0) { int c = 0; for (int e = 0; e < NEXP; ++e) { cum[e] = c; c += (int)((ctl[CW_CNT + e] + 255u) >> 8); } cum[NEXP] = c; }
    __syncthreads();
}
constexpr int MH_A = 0, MH_ABYTES = 32768, MH_B = 65536, MH_BROW = 528, MH_BBYTES = 64 * MH_BROW  ;
__device__ __forceinline__ int mhb_off(int row, int ch) { return MH_BROW * row + 16 * ch; }
__device__ __forceinline__ bf16x8_t mhb_frag(const LAS unsigned char* lbase, int cofs) {
    const s4_t lo = __builtin_amdgcn_ds_read_tr16_b64_v4i16((LAS s4_t*)(lbase + cofs));
    const s4_t hi = __builtin_amdgcn_ds_read_tr16_b64_v4i16((LAS s4_t*)(lbase + cofs + MH_BROW));
    return (bf16x8_t){lo.x, lo.y, lo.z, lo.w, hi.x, hi.y, hi.z, hi.w};
}
__device__ __forceinline__ int moe_pull(const Args& a, unsigned char* lds_g, int w, int x) {
    int* slot = (int*)(lds_g + MG_CUM + 256);
    __syncthreads();
    if (w == 0 && fresh_lane() == 0) *slot = (int)__hip_atomic_fetch_add((unsigned*)(a.ws + WS_CTL) + CW_Q + 64 * x, 1u, __ATOMIC_RELAXED, __HIP_MEMORY_SCOPE_AGENT);
    __syncthreads();
    return __builtin_amdgcn_readfirstlane(*slot);
}
__device__ __forceinline__ unsigned f8pair_lo(unsigned w) { const auto v = __builtin_amdgcn_cvt_pk_f32_fp8((int)w, false); return pk2(v[0], v[1]); }
__device__ __forceinline__ unsigned f8pair_hi(unsigned w) { const auto v = __builtin_amdgcn_cvt_pk_f32_fp8((int)w, true); return pk2(v[0], v[1]); }
template <int MODE>
__device__ __forceinline__ int moe_gemm(const Args& a, unsigned char* lds_g, int tid, int idx0) {
    constexpr int K = MODE == 1 ? D : DE, NT = K / 64;
#define MG_BAR() do { asm volatile("s_waitcnt lgkmcnt(0)" ::: "memory"); __builtin_amdgcn_s_barrier(); asm volatile("" ::: "memory"); } while (0)
    const int w = __builtin_amdgcn_readfirstlane(tid >> 6);
    const int wm = w >> 1, wn = w & 1, hh = wm >> 1, wr = wm & 1;
    const int* cum = (const int*)(lds_g + MG_CUM); const unsigned* ctl = (const unsigned*)(a.ws + WS_CTL);
    const int T = cum[NEXP], x = blockIdx.x & 7;
    for (int idx = idx0;;) {
        if (idx < 0) idx = moe_pull(a, lds_g, w, x);
        if (idx >= (MODE == 1 ? T : 2 * T)) return idx;
        const int ti = MODE == 1 ? idx : idx - T;
        idx = -1;
        const int nt = x;
        if (MODE == 2) {
            if (w == 0) { unsigned* tc = (unsigned*)(a.ws + WS_CTL) + CW_TC + 64 * ti; unsigned spins = 0;
                while ((unsigned)__builtin_amdgcn_readfirstlane(__hip_atomic_load(tc, __ATOMIC_RELAXED, __HIP_MEMORY_SCOPE_AGENT)) < 64u) {
                    __builtin_amdgcn_s_sleep(2);
                    if (++spins > (1u << 22)) { if (fresh_lane() == 0) __hip_atomic_store((unsigned*)(a.ws + WS_CTL) + 1, 0x900u + (unsigned)ti, __ATOMIC_RELAXED, __HIP_MEMORY_SCOPE_AGENT); break; } }
                __builtin_amdgcn_fence(__ATOMIC_ACQUIRE, "agent");
                asm volatile("s_waitcnt vmcnt(0)" ::: "memory"); }
            __syncthreads();
        }
        const int lane = fresh_lane(), tidu = w * 64 + lane, fr = lane & 15, fq = lane >> 4;
        const int aoff = pg8::lds_byte(wr * 64 + fr, fq * 8);
        const int bk = w, bp = lane;
        int e = 0;
#pragma unroll 1
        for (int q = 1; q < NEXP; ++q) e = (cum[q] <= ti) ? q : e;
        e = __builtin_amdgcn_readfirstlane(e);
        const int mt = __builtin_amdgcn_readfirstlane(ti - cum[e]);
        unsigned aofs[4]; unsigned bofs; int bwr0;
        __amdgpu_buffer_rsrc_t rsA, rsB, rsB3;
        if (MODE == 1) { const int cnt = cum[128 + e];
#pragma unroll
            for (int q = 0; q < 2; ++q) { const int pos = 256 * mt + 128 * q + (tidu >> 2); const int tok = pos < cnt ? ((const int*)(a.ws + WS_LIST))[e * 8192 + pos] : 0;
                aofs[q] = (unsigned)(tok * D + 16 * (tidu & 3)); }
            aofs[2] = aofs[3] = 0u;
            rsA = __builtin_amdgcn_make_buffer_rsrc((void*)(a.ws + WS_H2), 0, 0x7fffffff, 0x00020000);
            rsB = __builtin_amdgcn_make_buffer_rsrc((void*)(a.in[I_W1] + (size_t)e * D * DE), 0, 0x7fffffff, 0x00020000); rsB3 = __builtin_amdgcn_make_buffer_rsrc((void*)(a.in[I_W3] + (size_t)e * D * DE), 0, 0x7fffffff, 0x00020000);
            bofs = (unsigned)((bk + 8 * (bp >> 5)) * DE + 128 * nt + 4 * (bp & 31)) * 4u;
            bwr0 = MH_BROW * (2 * (bk & 3) + (bk >> 2) + 8 * (bp >> 5)) + 2 * (128 * ((bp & 31) >> 4) + 4 * (bp & 15)); }
        else {
#pragma unroll
            for (int q = 0; q < 2; ++q) aofs[q] = (unsigned)((128 * q + (tidu >> 2)) * DE + 16 * (tidu & 3));
            aofs[2] = aofs[3] = 0u;
            rsA = __builtin_amdgcn_make_buffer_rsrc((void*)((const unsigned char*)(a.ws + WS_HM) + (size_t)256 * ti * DE), 0, 0x7fffffff, 0x00020000);
            rsB = __builtin_amdgcn_make_buffer_rsrc((void*)(a.in[I_W2] + (size_t)e * DE * D), 0, 0x7fffffff, 0x00020000); rsB3 = rsB;
            bofs = (unsigned)(bk * D + 256 * nt + 4 * bp) * 4u; bwr0 = MH_BROW * (2 * (bk & 3) + (bk >> 2)) + 2 * (128 * (bp >> 5) + 32 * ((bp & 31) >> 3) + 16 * (bp & 1) + 4 * ((bp >> 1) & 3)); }
        const LAS unsigned char* blane = (const LAS unsigned char*)lds_g + MH_B + mhb_off(16 * (lane >> 5) + 8 * ((lane >> 4) & 1) + 2 * ((lane & 15) >> 2), 16 * wn + ((lane & 3) >> 1)) + 8 * (lane & 1);
        f32x4 acc[4][8];
#pragma unroll
        for (int m = 0; m < 4; ++m)
#pragma unroll
            for (int n = 0; n < 8; ++n) acc[m][n] = (f32x4){0.f, 0.f, 0.f, 0.f};
        v4u ra[4]; f32x4 rb[8];
#define MH_MMA(buf_) do { const LAS unsigned char* Bi_ = blane + (buf_) * MH_BBYTES; \
        bf16x8_t bc0_ = mhb_frag(Bi_, 0), bc1_ = mhb_frag(Bi_, 32); \
        _Pragma("unroll") for (int ks_ = 0; ks_ < 2; ++ks_) { bf16x8_t af_[4]; \
            _Pragma("unroll") for (int m_ = 0; m_ < 4; ++m_) af_[m_] = *(const bf16x8_t*)(lds_g + MH_A + (buf_) * MH_ABYTES + hh * 16384 + aoff + m_ * 2048 + ks_ * 1024); \
            _Pragma("unroll") for (int n_ = 0; n_ < 8; n_ += 2) { bf16x8_t bn0_ = bc0_, bn1_ = bc1_; \
                if (n_ + 2 < 8) { bn0_ = mhb_frag(Bi_, 32 * ks_ * MH_BROW + 32 * (n_ + 2)); bn1_ = mhb_frag(Bi_, 32 * ks_ * MH_BROW + 32 * (n_ + 3)); } \
                else if (ks_ == 0) { bn0_ = mhb_frag(Bi_, 32 * MH_BROW); bn1_ = mhb_frag(Bi_, 32 * MH_BROW + 32); } \
                __builtin_amdgcn_sched_barrier(0); \
                _Pragma("unroll") for (int m_ = 0; m_ < 4; ++m_) { acc[m_][n_] = __builtin_amdgcn_mfma_f32_16x16x32_bf16(bc0_, af_[m_], acc[m_][n_], 0, 0, 0); \
                    acc[m_][n_ + 1] = __builtin_amdgcn_mfma_f32_16x16x32_bf16(bc1_, af_[m_], acc[m_][n_ + 1], 0, 0, 0); } \
                __builtin_amdgcn_sched_barrier(0); bc0_ = bn0_; bc1_ = bn1_; } } } while (0)
        {
            const int awr = pg8::lds_byte(tidu >> 2, 16 * (tidu & 3));
#define MH_LDB(t_) do { _Pragma("unroll") for (int j_ = 0; j_ < 8; ++j_) rb[j_] = __builtin_bit_cast(f32x4, MODE == 1 ? __builtin_amdgcn_raw_buffer_load_b128((j_ & 1) ? rsB3 : rsB, bofs, (64 * (t_) + 16 * (j_ >> 1)) * DE * 4, 0) \
                                                                                                   : __builtin_amdgcn_raw_buffer_load_b128(rsB, bofs, (64 * (t_) + 8 * j_) * D * 4, 0)); } while (0)
#define MH_LDA(te_, to_) do { ra[0] = __builtin_amdgcn_raw_buffer_load_b128(rsA, aofs[0], 64 * (te_), 0); ra[1] = __builtin_amdgcn_raw_buffer_load_b128(rsA, aofs[1], 64 * (te_), 0); \
            ra[2] = __builtin_amdgcn_raw_buffer_load_b128(rsA, aofs[0], 64 * (to_), 0); ra[3] = __builtin_amdgcn_raw_buffer_load_b128(rsA, aofs[1], 64 * (to_), 0); } while (0)
#define MH_F8(w_) f8pair_lo(w_), f8pair_hi(w_)
#define MH_STA(buf_, x_) do { _Pragma("unroll") for (int h_ = 0; h_ < 2; ++h_) { const v4u p_ = ra[(x_) + h_]; \
            *(v4u*)(lds_g + MH_A + (buf_) * MH_ABYTES + h_ * 16384 + awr) = (v4u){MH_F8(p_.x), MH_F8(p_.y)}; __builtin_amdgcn_sched_barrier(0); \
            *(v4u*)(lds_g + MH_A + (buf_) * MH_ABYTES + h_ * 16384 + awr + 16) = (v4u){MH_F8(p_.z), MH_F8(p_.w)}; __builtin_amdgcn_sched_barrier(0); } } while (0)
#define MH_STB(buf_) do { _Pragma("unroll") for (int j_ = 0; j_ < 8; ++j_) { pg8::u32x2 o_; o_.x = pk2(rb[j_].x, rb[j_].y); o_.y = pk2(rb[j_].z, rb[j_].w); \
            *(pg8::u32x2*)(lds_g + MH_B + (buf_) * MH_BBYTES + bwr0 + (MODE == 1 ? (j_ >> 1) * 16 * MH_BROW + (j_ & 1) * 128 : j_ * 8 * MH_BROW)) = o_; } } while (0)
            MH_LDA(0, 1); MH_LDB(0);
            MG_BAR();
            MH_STA(0, 0); MH_STB(0);
            MH_LDB(1);
            for (int t = 0; t < NT; t += 2) {
                const int t2 = (t + 2 < NT) ? t + 2 : NT - 1, t3 = (t + 3 < NT) ? t + 3 : NT - 1;
                MG_BAR();
                MH_STA(1, 2); MH_STB(1);
                MH_LDA(t2, t3); MH_LDB(t2);
                MH_MMA(0);
                MG_BAR();
                MH_STA(0, 0); MH_STB(0);
                MH_LDB(t3);
                MH_MMA(1);
            }
#undef MH_LDB
#undef MH_LDA
#undef MH_F8
#undef MH_STA
#undef MH_STB
        }
#undef MH_MMA
        const int ln_ = fresh_lane();
        const int efr = ln_ & 15, efq = ln_ >> 4;
        if (MODE == 1) { unsigned char* HM = (unsigned char*)(a.ws + WS_HM) + (size_t)256 * ti * DE + 128 * nt + 64 * wn; const unsigned lo_ = (unsigned)((128 * hh + 64 * wr + efr) * DE + 4 * efq);
#pragma unroll
            for (int m = 0; m < 4; ++m)
#pragma unroll
                for (int n = 0; n < 4; ++n) { float hv[4];
#pragma unroll
                    for (int r = 0; r < 4; ++r) { const float a1 = acc[m][n][r]; hv[r] = a1 * sigmoidf_(a1) * acc[m][n + 4][r]; }
                    int w8 = __builtin_amdgcn_cvt_pk_fp8_f32(hv[0], hv[1], 0, false); w8 = __builtin_amdgcn_cvt_pk_fp8_f32(hv[2], hv[3], w8, true);
                    __hip_atomic_store((unsigned*)(HM + lo_ + 16 * m * DE + 16 * n), (unsigned)w8, __ATOMIC_RELAXED, __HIP_MEMORY_SCOPE_AGENT); }
            asm volatile("s_waitcnt vmcnt(0)" ::: "memory");
            if (ln_ == 0) __hip_atomic_fetch_add((unsigned*)(a.ws + WS_CTL) + CW_TC + 64 * ti, 1u, __ATOMIC_RELAXED, __HIP_MEMORY_SCOPE_AGENT); }
        else { bf16* Y2 = (bf16*)(a.ws + WS_Y2) + (size_t)256 * ti * D + 256 * nt + 128 * wn; const unsigned lo_ = (unsigned)((128 * hh + 64 * wr + efr) * D + 8 * efq);
#pragma unroll
            for (int m = 0; m < 4; ++m)
#pragma unroll
                for (int n = 0; n < 8; n += 2) { v4u o; o.x = pk2(acc[m][n][0], acc[m][n][1]); o.y = pk2(acc[m][n][2], acc[m][n][3]); o.z = pk2(acc[m][n + 1][0], acc[m][n + 1][1]); o.w = pk2(acc[m][n + 1][2], acc[m][n + 1][3]);
                    *(v4u*)(Y2 + lo_ + 16 * m * D + 16 * n) = o; } }
    }
#undef MG_BAR
}

__device__ __forceinline__ void phase12(const Args& a, unsigned char* lds_g, int lane, int wave) {
    const int gw = blockIdx.x * NWAVES + wave, NGW = gridDim.x * NWAVES;
    const int* cum = (const int*)(lds_g + MG_CUM);
    const bf16* X1 = (const bf16*)(a.ws + WS_X1); const float* MOD = (const float*)(a.ws + WS_MOD); const float* fg = a.in[I_FG];
    const int4* ASG = (const int4*)(a.ws + WS_ASG); const bf16* Y2 = (const bf16*)(a.ws + WS_Y2);
    for (int t = gw; t < NLAT; t += NGW) {
        const int b = t >> 11; const int4 q0 = ASG[2 * t], q1 = ASG[2 * t + 1];
        const float w0 = __int_as_float(q0.z), w1 = __int_as_float(q1.z);
        const unsigned long long* xr = (const unsigned long long*)(X1 + (size_t)t * D) + lane;
        const unsigned long long* y0 = (const unsigned long long*)(Y2 + (size_t)(256 * cum[q0.x] + q0.y) * D) + lane; const unsigned long long* y1 = (const unsigned long long*)(Y2 + (size_t)(256 * cum[q1.x] + q1.y) * D) + lane;
        f32x4 v[8]; float s = 0.f;
#pragma unroll
        for (int j = 0; j < 8; ++j) {
            const int c = 4 * lane + 256 * j;
            const f32x4 g2 = *(const f32x4*)(MOD + b * 12288 + 5 * 2048 + c);
            const unsigned long long a0 = y0[64 * j], a1 = y1[64 * j];
            f32x4 y; y.x = w0 * bflo((unsigned)a0) + w1 * bflo((unsigned)a1); y.y = w0 * bfhi((unsigned)a0) + w1 * bfhi((unsigned)a1);
            y.z = w0 * bflo((unsigned)(a0 >> 32)) + w1 * bflo((unsigned)(a1 >> 32)); y.w = w0 * bfhi((unsigned)(a0 >> 32)) + w1 * bfhi((unsigned)(a1 >> 32));
            const unsigned long long xw = xr[64 * j];
            v[j] = (f32x4){bflo((unsigned)xw), bfhi((unsigned)xw), bflo((unsigned)(xw >> 32)), bfhi((unsigned)(xw >> 32))} + g2 * y;
            s += (v[j].x * v[j].x + v[j].y * v[j].y) + (v[j].z * v[j].z + v[j].w * v[j].w);
        }
        const float rstd = 1.f / sqrtf(wave_sum(s) * (1.f / D) + EPS);
        f32x4* o = (f32x4*)(a.out + (size_t)t * D) + lane; f32x4 fgv[8];
#pragma unroll
        for (int j = 0; j < 8; ++j) fgv[j] = *(const f32x4*)(fg + 4 * lane + 256 * j);
#pragma unroll
        for (int j = 0; j < 8; ++j) o[64 * j] = v[j] * rstd * fgv[j];
    }
}

__global__ void __launch_bounds__(NTHR, 2) fwd_kernel(Args args) {
    extern __shared__ __attribute__((aligned(16))) unsigned char lds[];
    LAS unsigned char* ldsl = (LAS unsigned char*)lds;
    volatile LAS unsigned* MISC = (volatile LAS unsigned*)(ldsl + MISC_OFF);
    LAS unsigned* TL = (LAS unsigned*)(ldsl + LDSCTL_OFF);
    const int wave_s = __builtin_amdgcn_readfirstlane(threadIdx.x >> 6);
#define TID() make_tid(wave_s)
    { const int t0 = TID(); for (int u = t0; u < (LDS_BYTES - LDSCTL_OFF) / 4; u += NTHR) ((LAS unsigned*)(ldsl + LDSCTL_OFF))[u] = 0u; }
    __syncthreads();
    unsigned char* ws = args.ws;
    unsigned* ctl = (unsigned*)(ws + WS_CTL);
    XcdBarrier bar; bar.bar = ctl + CW_BAR; bar.x = 0; bar.st = nullptr;
    const bool one_launch = (args.ph_hi - args.ph_lo) > 1;
    if (one_launch) bar = xcd_barrier_post(ctl + CW_BAR, MISC + 8, TID());
    const int lo = args.ph_lo, hi = args.ph_hi;
#define IN(k) (lo <= (k) && (k) < hi)
#define SEAM(k) do { if (IN(k) && IN((k) + 1)) xcd_barrier(bar, TID()); } while (0)
    const int G = gridDim.x, c = blockIdx.x;

#define FRESH() const int tid = TID(), lane = tid & 63, wave = __builtin_amdgcn_readfirstlane(tid >> 6); (void)lane; (void)wave
#ifndef DUP_PHASE
#define DUP_PHASE (-1)
#endif
#define PH(k, ...) if (IN(k)) { _Pragma("unroll") for (int rep_ = 0; rep_ < ((DUP_PHASE) == (k) ? 2 : 1); ++rep_) { if (rep_) xcd_barrier(bar, TID()); __VA_ARGS__ } } SEAM(k);
    PH(0, { FRESH(); phase0(args, lds, tid, lane, wave); mod_wait(args, tid); phase1(args, lane, wave); })
    PH(1, {
        SchedIn S{G, c, (const char*)(ws + WS_H), (const char*)(ws + WS_WIN)}; EpiIn E{ws, args.in[I_BGATES]};
        pg8::gemm_phase<EpiIn, SchedIn>(ldsl, D, S, E, TID());
        { const int R_ = (1492 + G - 1) / G; int fi_ = 1492 - (R_ - 1) * G; if (fi_ >= G) fi_ = 0;
          if (c >= fi_) { FRESH(); late_prep(args, lds, (c - fi_) * NWAVES + wave, (G - fi_) * NWAVES, lane, wave); } } })
    PH(2, { FRESH(); phase3(args, lds, tid); })
    PH(3, { FRESH();
        for (int u = c; u < 256; u += G) ml_out_unit(args, lds, u, tid);
        unsigned psw[2][16];
        if (c < 4 * 32 * 8) { const int q = c >> 3; lru_out_loadps(args, q >> 5, 4 + (q & 31), c & 7, __builtin_amdgcn_readfirstlane(tid >> 6) * 64 + fresh_lane(), psw); }
        for (int u = c; u < 4 * 32 * 8; u += G) { const int blk = u & 7, q = u >> 3; const int un = u + G, qn = un >> 3; const bool hn = un < 4 * 32 * 8;
            lru_out_unit(args, lds, q >> 5, 4 + (q & 31), blk, tid, psw, hn ? qn >> 5 : 0, hn ? 4 + (qn & 31) : -1, un & 7); } })
    PH(4, {
        SchedProj S{G, c, (const char*)(ws + WS_YA), (const char*)(ws + WS_YB), (const char*)(ws + WS_WPA), (const char*)(ws + WS_WPB)};
        EpiProj E{(const bf16*)(ws + WS_GA), (const bf16*)(ws + WS_GB), (bf16*)(ws + WS_PRE)};
        pg8::gemm_phase<EpiProj, SchedProj>(ldsl, 1024, S, E, TID()); })
    PH(5, {
        SchedOut S{G, c, (const char*)(ws + WS_PRE), (const char*)(ws + WS_WOUT)}; EpiOut E{args.in[I_X], (const float*)(ws + WS_MOD), (bf16*)(ws + WS_X1)};
        pg8::gemm_phase<EpiOut, SchedOut>(ldsl, D, S, E, TID()); })
    PH(6, { FRESH(); phase_router(args, lds, tid, lane, wave); })
    PH(7, { FRESH(); moe_tables(args, lds, tid); const int nx_ = moe_gemm<1>(args, lds, tid, -1); { const int tid2_ = TID(); (void)moe_gemm<2>(args, lds, tid2_, nx_); } })
    PH(8, { FRESH(); moe_tables(args, lds, tid); phase12(args, lds, lane, wave); })
#undef PH
#undef IN
#undef SEAM
}

extern "C" void kernel_launch(void* const* d_in, const int* in_sizes, int n_in, void* d_out, int out_size, void* d_ws, size_t ws_size, hipStream_t stream) {
    static int grid = 0;
    if (grid == 0) {
        if (n_in != 27 || out_size != NLAT * D || ws_size < WS_END) { fprintf(stderr, "kernel_launch: unexpected shapes (n_in %d, out %d, ws %zu)\n", n_in, out_size, ws_size); grid = -1; return; }
        int dev = 0, cus = 0, per_cu = 0;
        if (hipGetDevice(&dev) != hipSuccess || hipDeviceGetAttribute(&cus, hipDeviceAttributeMultiprocessorCount, dev) != hipSuccess) { grid = -1; return; }
        if (hipFuncSetAttribute((const void*)fwd_kernel, hipFuncAttributeMaxDynamicSharedMemorySize, LDS_BYTES) != hipSuccess) { fprintf(stderr, "kernel_launch: hipFuncSetAttribute failed\n"); grid = -1; return; }
        if (hipOccupancyMaxActiveBlocksPerMultiprocessor(&per_cu, (const void*)fwd_kernel, NTHR, LDS_BYTES) != hipSuccess || per_cu < 1) fprintf(stderr, "kernel_launch: occupancy query says %d\n", per_cu);
        (void)hipGetLastError();
        grid = cus;
    }
    if (grid < 0) return;
    (void)hipMemsetAsync((char*)d_ws + WS_CTL, 0, CTL_ZERO_BYTES, stream);
    Args a{};
    for (int i = 0; i < 27; ++i) a.in[i] = (const float*)d_in[i];
    a.out = (float*)d_out; a.ws = (unsigned char*)d_ws;
#if MK_ONE_LAUNCH
    a.ph_lo = 0; a.ph_hi = NPHASE;
    hipLaunchKernelGGL(fwd_kernel, dim3(grid), dim3(NTHR), LDS_BYTES, stream, a);
#else
    for (int p = 0; p < NPHASE; ++p) { a.ph_lo = p; a.ph_hi = p + 1; hipLaunchKernelGGL(fwd_kernel, dim3(grid), dim3(NTHR), LDS_BYTES, stream, a); }
#endif
}
```

```cpp
#include <hip/hip_runtime.h>
#include <cstdio>
#include <cstdint>

#ifndef MK_ONE_LAUNCH
#define MK_ONE_LAUNCH 1
#endif

namespace pg8 {
#define PG8_LAS __attribute__((address_space(3)))
typedef unsigned short bf16_t;
typedef short bf16x8 __attribute__((ext_vector_type(8)));
typedef float f32x4 __attribute__((ext_vector_type(4)));
typedef float f32x2 __attribute__((ext_vector_type(2)));
typedef unsigned u32x4 __attribute__((ext_vector_type(4)));
typedef unsigned u32x2 __attribute__((ext_vector_type(2)));
constexpr int BM = 256, BK = 64, HALF = 128, HTB = HALF * BK * 2  , STAGE_BYTES = 8 * HTB, NXCD = 8, WGM = 8;

__host__ __device__ __forceinline__ int lds_byte(int r, int c) { const int st = (r >> 4) * 2 + (c >> 5), rr = r & 15, cc = c & 31, ob = rr * 64 + cc * 2; return st * 1024 + (ob ^ (((ob >> 9) & 1) << 5)); }
__host__ __device__ __forceinline__ void stage_rc(int b, int& R, int& C) { const int st = b / 1024, sb = b % 1024, swz = sb ^ (((sb >> 9) & 1) << 5); R = (st >> 1) * 16 + swz / 64; C = (st & 1) * 32 + (swz % 64) / 2; }
__host__ __device__ __forceinline__ int perm32(int rho) { const int n = rho >> 4, i = rho & 15; return 8 * (i >> 2) + 4 * n + (i & 3); }

struct Unit { const char* A; const char* B; int pm, pn, aux; };

__host__ __device__ __forceinline__ void tile_order(int L, int nM, int nN, int& pm, int& pn) {
    const int nwg = nM * nN; int wgid = L;
    { const int q = nwg / NXCD, r = nwg % NXCD, xcd = wgid % NXCD, off = wgid / NXCD; wgid = (xcd < r ? xcd * (q + 1) : r * (q + 1) + (xcd - r) * q) + off; }
    const int nig = WGM * nN, gid = wgid / nig, fm = gid * WGM, gsz = (nM - fm) < WGM ? (nM - fm) : WGM;
    pm = fm + ((wgid % nig) % gsz); pn = (wgid % nig) / gsz;
}

typedef __bf16 bf16n2 __attribute__((ext_vector_type(2)));
__device__ __forceinline__ unsigned cvt_pk_bf16(float lo, float hi) { const f32x2 v = {lo, hi}; return __builtin_bit_cast(unsigned, __builtin_convertvector(v, bf16n2)); }

template <class Epi, class Sched>
__device__ __forceinline__ void gemm_phase(PG8_LAS unsigned char* lds, const int K, const Sched& S, const Epi& E, int tid) {
    const int wid = __builtin_amdgcn_readfirstlane(tid >> 6), lane = tid & 63, wr = wid >> 2, wc = wid & 3, fr = lane & 15, fq = lane >> 4;
    const int nt = K / BK;
    unsigned voffA[2], voffB[2];
#pragma unroll
    for (int i = 0; i < 2; ++i) { int R, C; stage_rc(tid * 16 + i * 8192, R, C); const int Rb = Epi::PERM ? ((R & ~31) + perm32(R & 31)) : R;
        voffA[i] = (unsigned)(R * K + C) * 2u; voffB[i] = (unsigned)(Rb * K + C) * 2u; }
    const size_t kstep = (size_t)(BK * 2);
    const size_t hstep = (size_t)HALF * K * 2;
    const unsigned ldsw = (unsigned)wid * 1024u;
    const int aoff = lds_byte(wr * 64 + fr, fq * 8), boff = lds_byte(wc * 32 + fr, fq * 8);
#define PG8_SA(b, h) (((b) * 2 + (h)) * HTB)
#define PG8_SB(b, h) ((4 + (b) * 2 + (h)) * HTB)
#define PG8_STAGE(bufoff, gbase, voff) do { _Pragma("unroll") for (int _i = 0; _i < 2; ++_i) \
        __builtin_amdgcn_global_load_lds((const unsigned*)((const char*)(gbase) + (voff)[_i]), (PG8_LAS unsigned*)(lds + (bufoff) + ldsw + _i * 8192), 16, 0, 0); } while (0)
#define PG8_LDA(dst, b, h) do { _Pragma("unroll") for (int m = 0; m < 4; ++m) _Pragma("unroll") for (int k = 0; k < 2; ++k) dst[m][k] = *(const PG8_LAS bf16x8*)(lds + PG8_SA(b, h) + aoff + m * 2048 + k * 1024); } while (0)
#define PG8_LDB(dst, b, h) do { _Pragma("unroll") for (int n = 0; n < 2; ++n) _Pragma("unroll") for (int k = 0; k < 2; ++k) dst[n][k] = *(const PG8_LAS bf16x8*)(lds + PG8_SB(b, h) + boff + n * 2048 + k * 1024); } while (0)
#define PG8_MMA(ai, bj, At, Bt) do { __builtin_amdgcn_s_setprio(1); _Pragma("unroll") for (int m = 0; m < 4; ++m) _Pragma("unroll") for (int n = 0; n < 2; ++n) _Pragma("unroll") for (int k = 0; k < 2; ++k) \
        acc[ai][bj][m][n] = __builtin_amdgcn_mfma_f32_16x16x32_bf16(Bt[n][k], At[m][k], acc[ai][bj][m][n], 0, 0, 0); __builtin_amdgcn_s_setprio(0); } while (0)
#define PG8_WAIT_V(n) asm volatile("s_waitcnt vmcnt(" #n ")" ::: "memory")
#define PG8_WAIT_L(n) asm volatile("s_waitcnt lgkmcnt(" #n ")" ::: "memory")
#define PG8_BAR __builtin_amdgcn_s_barrier()
#define PG8_SCHED __builtin_amdgcn_sched_barrier(0)
    Unit cur, nxt; int ui = 0;
    if (!S.next(0, cur)) return;
    f32x4 acc[2][2][4][2];
#pragma unroll
    for (int a = 0; a < 2; ++a)
#pragma unroll
        for (int b = 0; b < 2; ++b)
#pragma unroll
            for (int m = 0; m < 4; ++m)
#pragma unroll
                for (int n = 0; n < 2; ++n) acc[a][b][m][n] = (f32x4){0.f, 0.f, 0.f, 0.f};
    bf16x8 At[4][2], B0[2][2], B1[2][2];
    const char* cA = cur.A; const char* cB = cur.B;
    PG8_STAGE(PG8_SB(0, 0), cB, voffB); PG8_STAGE(PG8_SB(0, 1), cB + hstep, voffB); PG8_STAGE(PG8_SA(0, 0), cA, voffA); PG8_STAGE(PG8_SA(0, 1), cA + hstep, voffA);
    if (wr == 1) PG8_BAR;
    PG8_WAIT_V(2); PG8_BAR;
    PG8_STAGE(PG8_SB(1, 0), cB + kstep, voffB); PG8_STAGE(PG8_SA(1, 0), cA + kstep, voffA); PG8_STAGE(PG8_SB(1, 1), cB + hstep + kstep, voffB);
    PG8_WAIT_V(6); PG8_BAR;
    for (;;) {
        const bool has_next = S.next(ui + 1, nxt);
        const char* nA = has_next ? nxt.A : cA; const char* nB = has_next ? nxt.B : cB;
        for (int t = 0; t < nt; t += 2) {
            const bool last = (t == nt - 2);
            const char* a1 = cA + (size_t)(t + 1) * kstep;
            const char* a2 = last ? nA : cA + (size_t)(t + 2) * kstep; const char* b2 = last ? nB : cB + (size_t)(t + 2) * kstep;
            const char* a3 = a2 + kstep; const char* b3 = b2 + kstep;
            PG8_LDB(B0, 0, 0); PG8_LDB(B1, 0, 1); PG8_SCHED; PG8_LDA(At, 0, 0); PG8_STAGE(PG8_SA(1, 1), a1 + hstep, voffA);
            PG8_WAIT_V(8); PG8_WAIT_L(0); PG8_BAR; PG8_MMA(0, 0, At, B0); PG8_MMA(0, 1, At, B1); PG8_BAR; PG8_SCHED;
            PG8_LDA(At, 0, 1); PG8_STAGE(PG8_SB(0, 0), b2, voffB); PG8_STAGE(PG8_SB(0, 1), b2 + hstep, voffB); PG8_STAGE(PG8_SA(0, 0), a2, voffA);
            PG8_WAIT_V(8); PG8_WAIT_L(0); PG8_BAR; PG8_MMA(1, 0, At, B0); PG8_MMA(1, 1, At, B1); PG8_BAR; PG8_SCHED;
            PG8_LDB(B0, 1, 0); PG8_LDB(B1, 1, 1); PG8_SCHED; PG8_LDA(At, 1, 0); PG8_STAGE(PG8_SA(0, 1), a2 + hstep, voffA);
            PG8_WAIT_V(8); PG8_WAIT_L(0); PG8_BAR; PG8_MMA(0, 0, At, B0); PG8_MMA(0, 1, At, B1); PG8_BAR; PG8_SCHED;
            PG8_LDA(At, 1, 1); PG8_STAGE(PG8_SB(1, 0), b3, voffB); PG8_STAGE(PG8_SB(1, 1), b3 + hstep, voffB); PG8_STAGE(PG8_SA(1, 0), a3, voffA);
            PG8_WAIT_V(8); PG8_WAIT_L(0); PG8_BAR; PG8_MMA(1, 0, At, B0); PG8_MMA(1, 1, At, B1); PG8_BAR; PG8_SCHED;
        }
        if (wr == 0) PG8_BAR;
        { int fr_ = fr, fq_ = fq; asm volatile("" : "+v"(fr_), "+v"(fq_)); E(acc, cur, wr, wc, fr_, fq_); }
        if (!has_next) break;
        if (!(Epi::CARRY && E.keep(cur))) {
#pragma unroll
        for (int a = 0; a < 2; ++a)
#pragma unroll
            for (int b = 0; b < 2; ++b)
#pragma unroll
                for (int m = 0; m < 4; ++m)
#pragma unroll
                    for (int n = 0; n < 2; ++n) acc[a][b][m][n] = (f32x4){0.f, 0.f, 0.f, 0.f};
        }
        cur = nxt; cA = nA; cB = nB; ++ui;
        if (wr == 1) PG8_BAR;
    }
    PG8_WAIT_V(0);
    PG8_BAR;
#undef PG8_SA
#undef PG8_SB
#undef PG8_STAGE
#undef PG8_LDA
#undef PG8_LDB
#undef PG8_MMA
#undef PG8_WAIT_V
#undef PG8_WAIT_L
#undef PG8_BAR
#undef PG8_SCHED
}
}

constexpr int NWAVES = 8, NTHR = 512;
constexpr int D = 2048, NB = 4, SEQ = 2048, CTXL = 256, NCTX = NB * CTXL  , NLAT = NB * SEQ  , NTOK = NCTX + NLAT  ;
constexpr int NSTEP = CTXL + SEQ;
constexpr int HEADS = 8, HD = 128, MW = 1024, LW = 1024;
constexpr int NEXP = 32, DE = 1024;
constexpr int IN_DIM = 11296, NT_IN = 45;
constexpr float EPS = 1e-6f;
constexpr int MAXTILES = 96;
constexpr int NPHASE = 9;

constexpr size_t MiB = 1u << 20;
constexpr size_t WS_CTL = 0, CTL_ZERO_BYTES = 1 * MiB;
constexpr size_t WS_MOD = 1 * MiB;
constexpr size_t WS_GATES = 2 * MiB;
constexpr size_t WS_ASG = 4 * MiB + 512 * 1024;
constexpr size_t WS_LIST = 3 * MiB + 512 * 1024;
constexpr size_t WS_WR = 6 * MiB;
constexpr size_t WS_RB = 7 * MiB + 768 * 1024;
constexpr size_t WS_WL = 5 * MiB;
constexpr size_t WS_AGG = 978 * MiB;
constexpr size_t WS_WPA = 8 * MiB, WS_WPB = 12 * MiB, WS_WOUT = 16 * MiB, WS_WIN = 24 * MiB;
constexpr size_t WS_W13 = 72 * MiB, WS_W2 = 328 * MiB;
constexpr size_t WS_PS = 72 * MiB;
constexpr size_t WS_H = 456 * MiB;
constexpr size_t WS_K = 492 * MiB, WS_V = 510 * MiB, WS_UX = 528 * MiB;
constexpr size_t WS_Q = 546 * MiB, WS_OF = 562 * MiB, WS_OB = 578 * MiB, WS_UG = 594 * MiB;
constexpr size_t WS_GA = 610 * MiB, WS_GB = 642 * MiB;
constexpr size_t WS_LA = 674 * MiB, WS_LB = 746 * MiB;
constexpr size_t WS_HS = 818 * MiB, WS_TM = 882 * MiB;
constexpr size_t WS_YA = 946 * MiB, WS_YB = 962 * MiB;
constexpr size_t WS_BT = 982 * MiB;
constexpr size_t WS_SLOC = 984 * MiB;
constexpr size_t WS_END = 1022 * MiB;
constexpr size_t WS_PRE = WS_LA;
constexpr size_t WS_X1 = WS_LB;
constexpr size_t WS_H2 = WS_H;
constexpr size_t WS_XS = WS_K;
constexpr size_t WS_HM = 588 * MiB;
constexpr size_t WS_Y2 = WS_HS;
constexpr int CW_MODC = 32;
constexpr int CW_CNT = 64;
constexpr int CW_NT = 128;
constexpr int CW_TILE_E = 192;
constexpr int CW_BAR = 4096;
constexpr int CW_Q = 8192;
constexpr int CW_TC = 16384;

constexpr int RING_BYTES = 131072;
constexpr int LDSCTL_OFF = 143360;
constexpr int MISC_OFF = LDSCTL_OFF + 384;
constexpr int LDS_BYTES = 147456;

#define GAS __attribute__((address_space(1)))
#define LAS __attribute__((address_space(3)))
typedef unsigned short bf16;
typedef unsigned v4u __attribute__((ext_vector_type(4)));
typedef float f32x4 __attribute__((ext_vector_type(4)));
#define LDS_WAIT() asm volatile("s_waitcnt lgkmcnt(0)" ::: "memory")
#define WG_BAR() do { asm volatile("s_waitcnt lgkmcnt(0)" ::: "memory"); __builtin_amdgcn_s_barrier(); asm volatile("" ::: "memory"); } while (0)

__device__ __forceinline__ unsigned f2bf(float f) { unsigned u = __builtin_bit_cast(unsigned, f); return (u + 0x7fffu + ((u >> 16) & 1u)) >> 16; }
__device__ __forceinline__ unsigned pk2(float lo, float hi) { return pg8::cvt_pk_bf16(lo, hi); }
__device__ __forceinline__ float bf2f(unsigned h) { return __builtin_bit_cast(float, h << 16); }
__device__ __forceinline__ float bflo(unsigned w) { return __builtin_bit_cast(float, w << 16); }
__device__ __forceinline__ float bfhi(unsigned w) { return __builtin_bit_cast(float, w & 0xffff0000u); }
__device__ __forceinline__ float sigmoidf_(float x) { return __builtin_amdgcn_rcpf(1.f + __expf(-x)); }
__device__ __forceinline__ float gelu_tanh(float x) { const float u = 0.7978845608028654f * (x + 0.044715f * x * x * x); return x * __builtin_amdgcn_rcpf(1.f + __expf(-2.f * u)); }
__device__ __forceinline__ float wave_sum(float v) {
#pragma unroll
    for (int o = 1; o < 64; o <<= 1) v += __shfl_xor(v, o);
    return v;
}

#define XB_TMO      128
#define XB_XCNT(j)  (256  + 64 * (j))
#define XB_XSUB(j)  (1280 + 64 * (j))
#define XB_XGEN(j)  (2304 + 64 * (j))
#define XB_TOP      3328
#define XB_TOPGEN   3392
#define XCD_BAR_WORDS 3456
#define XB_SPIN_CAP (1u << 23)
__device__ __forceinline__ unsigned xb_ld(unsigned* p)              { return __hip_atomic_load(p, __ATOMIC_RELAXED, __HIP_MEMORY_SCOPE_AGENT); }
__device__ __forceinline__ unsigned xb_add(unsigned* p, unsigned v) { return __hip_atomic_fetch_add(p, v, __ATOMIC_RELAXED, __HIP_MEMORY_SCOPE_AGENT); }
__device__ __forceinline__ unsigned xb_xcc_id() { return (unsigned)__builtin_amdgcn_s_getreg((3 << 11) | 20) & 0xFu; }
#define XB_SPIN(cond, bar) do { unsigned _sp = 0; while (cond) { __builtin_amdgcn_s_sleep(1); \
    if ((++_sp & 255u) == 0u) { if (xb_ld(&(bar)[XB_TMO])) break; if (_sp > XB_SPIN_CAP) { atomicAdd(&(bar)[XB_TMO], 1u); break; } } } } while (0)
struct XcdBarrier { unsigned* bar; unsigned x; volatile LAS unsigned* st; };
__device__ __forceinline__ XcdBarrier xcd_barrier_post(unsigned* bar, volatile LAS unsigned* st, int tid) {
    XcdBarrier b; b.bar = bar; b.x = xb_xcc_id(); b.st = st;
    if (tid == 0) (void)xb_add(&bar[XB_XCNT(b.x)], 1u);
    return b;
}
__device__ __forceinline__ void xcd_barrier_complete(unsigned* bar, unsigned x, unsigned& nloc, unsigned& nx) {
    const unsigned G = gridDim.x * gridDim.y * gridDim.z;
    unsigned sum, cnt, mine, sp = 0u;
    for (;;) {
        sum = 0u; cnt = 0u; mine = 0u;
#pragma unroll
        for (unsigned j = 0; j < 16; ++j) { const unsigned c = xb_ld(&bar[XB_XCNT(j)]); sum += c; cnt += (c > 0u) ? 1u : 0u; mine = (j == x) ? c : mine; }
        if (sum == G) break;
        __builtin_amdgcn_s_sleep(1);
        if ((++sp & 255u) == 0u) { if (xb_ld(&bar[XB_TMO])) break; if (sp > XB_SPIN_CAP) { atomicAdd(&bar[XB_TMO], 1u); break; } }
    }
    nloc = mine > 0u ? mine : 1u; nx = cnt > 0u ? cnt : 1u;
}
__device__ __forceinline__ void xcd_barrier(const XcdBarrier& b, int tid) {
    asm volatile("s_waitcnt vmcnt(0)" ::: "memory");
    __syncthreads();
    if (tid == 0) {
        unsigned* bar = b.bar;
        __builtin_amdgcn_s_waitcnt(0);
        unsigned nloc = b.st[0], nx = b.st[1];
        if (nloc == 0u) { xcd_barrier_complete(bar, b.x, nloc, nx); b.st[0] = nloc; b.st[1] = nx; }
        const unsigned old = xb_add(&bar[XB_XSUB(b.x)], 1u);
        const unsigned gen = old / nloc;
        if (old + 1u == (gen + 1u) * nloc) {
            __builtin_amdgcn_fence(__ATOMIC_RELEASE, "agent");
            asm volatile("s_waitcnt vmcnt(0)" ::: "memory");
            const unsigned og = xb_add(&bar[XB_TOP], 1u);
            const unsigned tg = og / nx;
            if (og + 1u == (tg + 1u) * nx) xb_add(&bar[XB_TOPGEN], 1u);
            else XB_SPIN(xb_ld(&bar[XB_TOPGEN]) == tg, bar);
            __builtin_amdgcn_fence(__ATOMIC_ACQUIRE, "agent");
            xb_add(&bar[XB_XGEN(b.x)], 1u);
            asm volatile("s_waitcnt vmcnt(0)" ::: "memory");
        } else {
            XB_SPIN(xb_ld(&bar[XB_XGEN(b.x)]) == gen, bar);
            __builtin_amdgcn_fence(__ATOMIC_ACQUIRE, "agent");
            asm volatile("s_waitcnt vmcnt(0)" ::: "memory");
        }
    }
    __syncthreads();
}

__device__ __forceinline__ int make_tid(int wave_s) { int l; asm volatile("v_mbcnt_lo_u32_b32 %0, -1, 0\n\tv_mbcnt_hi_u32_b32 %0, -1, %0" : "=v"(l)); __builtin_assume(l >= 0 && l < 64); __builtin_assume(wave_s >= 0 && wave_s < 8); return wave_s * 64 + l; }
__device__ __forceinline__ int fresh_lane() { int l; asm volatile("v_mbcnt_lo_u32_b32 %0, -1, 0\n\tv_mbcnt_hi_u32_b32 %0, -1, %0" : "=v"(l)); __builtin_assume(l >= 0 && l < 64); return l; }
struct Args { const float* in[27]; float* out; unsigned char* ws; int ph_lo, ph_hi; };
enum { I_X = 0, I_C, I_CTX, I_CCTX, I_WMOD, I_BMOD, I_N1G, I_WIN, I_BGATES, I_HEADG, I_CONVW, I_CONVB, I_LWA, I_LBA, I_LWX, I_LBX, I_LAM, I_WPA, I_WPB, I_WOUT, I_N2G, I_WRG, I_WRE, I_W1, I_W3, I_W2, I_FG };

__device__ __forceinline__ void tr_item(const float* __restrict__ W, size_t ldw, int k0, int n0, bf16* dst, size_t ldd, float scale, LAS float* scr, int lane) {
#pragma unroll 16
    for (int i = 0; i < 32; ++i) { const int kk = 2 * i + (lane >> 5); scr[kk * 33 + (lane & 31)] = W[(size_t)(k0 + kk) * ldw + n0 + (lane & 31)]; }
    LDS_WAIT(); asm volatile("" ::: "memory");
    const int c = lane & 7;
#pragma unroll
    for (int j = 0; j < 4; ++j) { const int n = (lane >> 3) + 8 * j; const LAS float* s = scr + (8 * c) * 33 + n;
        v4u o; o.x = pk2(s[0 * 33] * scale, s[1 * 33] * scale); o.y = pk2(s[2 * 33] * scale, s[3 * 33] * scale); o.z = pk2(s[4 * 33] * scale, s[5 * 33] * scale); o.w = pk2(s[6 * 33] * scale, s[7 * 33] * scale);
        *(GAS v4u*)(dst + (size_t)n * ldd + 8 * c) = o; }
    LDS_WAIT(); asm volatile("" ::: "memory");
}
__device__ __forceinline__ int win_row(int n0, float& scale) {
    scale = 1.f;
    if (n0 < 1024) return 13 * 256 + n0;
    if (n0 < 2048) { scale = 0.08838834764831845f; return n0 - 1024; }
    if (n0 < 3072) return 4 * 256 + (n0 - 2048);
    if (n0 < 4096) return 17 * 256 + (n0 - 3072);
    if (n0 < 5120) return 21 * 256 + (n0 - 4096);
    if (n0 < 5152) return 12 * 256 + (n0 - 5120);
    if (n0 < 6176) return 8 * 256 + (n0 - 5152);
    if (n0 < 7200) return 25 * 256 + (n0 - 6176);
    if (n0 < 9248) return 29 * 256 + (n0 - 7200);
    return 37 * 256 + (n0 - 9248);
}

__device__ __forceinline__ void phase0(const Args& a, unsigned char* lds_g, int tid, int lane, int wave) {
    unsigned char* ws = a.ws;
    {
        float* sl = (float*)lds_g;
        float* red = sl + 5 * 2048;
        for (int i = tid; i < 5 * 2048; i += NTHR) { const int r = i >> 11, k = i & 2047; const float v = r < 4 ? a.in[I_C][r * 2048 + k] : a.in[I_CCTX][k]; sl[i] = v / (1.f + __expf(-v)); }
        __syncthreads();
        const float* wm = a.in[I_WMOD]; const float* bm = a.in[I_BMOD]; float* MOD = (float*)(ws + WS_MOD);
        for (int cb = blockIdx.x; cb < 256; cb += gridDim.x) {
            const int n0 = cb * 48;
            if (tid < 504) {
                const int kq = tid / 12, cg = tid % 12;
                f32x4 acc[5];
#pragma unroll
                for (int r = 0; r < 5; ++r) acc[r] = (f32x4){0.f, 0.f, 0.f, 0.f};
#pragma unroll 7
                for (int k = kq; k < 2048; k += 42) {
                    const f32x4 w = *(const f32x4*)(wm + (size_t)k * 12288 + n0 + 4 * cg);
#pragma unroll
                    for (int r = 0; r < 5; ++r) acc[r] += w * sl[r * 2048 + k];
                }
#pragma unroll
                for (int r = 0; r < 5; ++r) *(f32x4*)(red + tid * 20 + r * 4) = acc[r];
            }
            __syncthreads();
            if (tid < 240) {
                const int cg = tid / 20, rj = tid % 20; float s = 0.f;
                for (int kq = 0; kq < 42; ++kq) s += red[(kq * 12 + cg) * 20 + rj];
                const int r = rj >> 2, j = rj & 3, n = n0 + 4 * cg + j;
                __hip_atomic_store(MOD + r * 12288 + n, s + bm[n], __ATOMIC_RELAXED, __HIP_MEMORY_SCOPE_AGENT);
            }
            __syncthreads();
        }
        if (tid == 0) __hip_atomic_fetch_add((unsigned*)(ws + WS_CTL) + CW_MODC, 1u, __ATOMIC_RELAXED, __HIP_MEMORY_SCOPE_AGENT);
    }
    {
        LAS float* scr = (LAS float*)((LAS unsigned char*)lds_g) + wave * 4096;
        const int gw = blockIdx.x * NWAVES + wave, NGW = gridDim.x * NWAVES;
        constexpr int J0 = 32 * 353, J1 = 16 * 64, J3 = 32 * 64;
        constexpr int JL = 256;
        constexpr int NITEMS = J0 + 2 * J1;
        (void)J3; (void)JL;
        for (int it = gw; it < NITEMS; it += NGW) {
            int r = it;
            if (r < J0) { const int kb = r / 353, nb = r % 353; float sc; const int row = win_row(32 * nb, sc);
                tr_item(a.in[I_WIN], IN_DIM, 64 * kb, 32 * nb, (bf16*)(ws + WS_WIN) + (size_t)row * 2048 + 64 * kb, 2048, sc, scr, lane); continue; } r -= J0;
            if (r < J1) { const int kb = r / 64, nb = r % 64; tr_item(a.in[I_WPA], 2048, 64 * kb, 32 * nb, (bf16*)(ws + WS_WPA) + (size_t)(32 * nb) * 1024 + 64 * kb, 1024, 1.f, scr, lane); continue; } r -= J1;
            if (r < J1) { const int kb = r / 64, nb = r % 64; tr_item(a.in[I_WPB], 2048, 64 * kb, 32 * nb, (bf16*)(ws + WS_WPB) + (size_t)(32 * nb) * 1024 + 64 * kb, 1024, 1.f, scr, lane); continue; }
        }
        { GAS v4u* z = (GAS v4u*)((bf16*)(ws + WS_WIN) + (size_t)(12 * 256 + 32) * 2048); const int nchunks = 224 * 256;
          for (int i = blockIdx.x * NTHR + tid; i < nchunks; i += gridDim.x * NTHR) z[i] = (v4u){0u, 0u, 0u, 0u}; }
    }
}

__device__ __forceinline__ void late_prep(const Args& a, unsigned char* lds_g, int gw, int NGW, int lane, int wave) {
    unsigned char* ws = a.ws;
    {
        LAS float* scr = (LAS float*)((LAS unsigned char*)lds_g) + wave * 4096;
        constexpr int J3 = 32 * 64, JL = 256;
        for (int it = gw; it < J3 + JL; it += NGW) {
            int r = it;
            if (r >= J3) { r -= J3; const int mi = r >> 3, kb = (r >> 2) & 1, nb = r & 3, dir = mi >> 4, mat = (mi >> 3) & 1, blk = mi & 7;
                tr_item(a.in[mat ? I_LWX : I_LWA] + (size_t)(dir * 8 + blk) * 128 * 128, 128, 64 * kb, 32 * nb, (bf16*)(ws + WS_WL) + ((size_t)((dir * 2 + mat) * 8 + blk) * 128 + 32 * nb) * 128 + 64 * kb, 128, 1.f, scr, lane); continue; }
            const int kb = r / 64, nb = r % 64; tr_item(a.in[I_WOUT], 2048, 64 * kb, 32 * nb, (bf16*)(ws + WS_WOUT) + (size_t)(32 * nb) * 2048 + 64 * kb, 2048, 1.f, scr, lane);
        }
    }
    {
        const float* MODr = (const float*)(a.ws + WS_MOD); float* WR = (float*)(a.ws + WS_WR); float* RB = (float*)(a.ws + WS_RB);
        for (int idx = gw * 64 + lane; idx < 4 * 48 * 2048; idx += NGW * 64) { const int k = idx & 2047, j = (idx >> 11) % 48, b = idx / (48 * 2048);
            const float gm = a.in[I_N2G][k] * (1.f + MODr[b * 12288 + 4 * 2048 + k]);
            const float wv = j < 32 ? a.in[I_WRE][(size_t)k * 32 + j] : (j < 36 ? a.in[I_WRG][(size_t)k * 4 + (j - 32)] : 0.f);
            WR[idx] = gm * wv; }
        for (int q = gw; q < 4 * 48; q += NGW) { const int b = q / 48, j = q % 48; float sacc = 0.f;
            if (j < 36) { for (int k = lane; k < 2048; k += 64) { const float wv = j < 32 ? a.in[I_WRE][(size_t)k * 32 + j] : a.in[I_WRG][(size_t)k * 4 + (j - 32)]; sacc += MODr[b * 12288 + 3 * 2048 + k] * wv; } }
            sacc = wave_sum(sacc); if (lane == 0) RB[q] = sacc; }
    }
}
__device__ __forceinline__ void mod_wait(const Args& a, int tid) {
    if (tid < 64) { unsigned* mc = (unsigned*)(a.ws + WS_CTL) + CW_MODC; unsigned spins = 0;
        while ((unsigned)__builtin_amdgcn_readfirstlane(__hip_atomic_load(mc, __ATOMIC_RELAXED, __HIP_MEMORY_SCOPE_AGENT)) < gridDim.x) {
            __builtin_amdgcn_s_sleep(2);
            if (++spins > (1u << 22)) { if (tid == 0) __hip_atomic_store((unsigned*)(a.ws + WS_CTL) + 1, 0x800u, __ATOMIC_RELAXED, __HIP_MEMORY_SCOPE_AGENT); break; } }
        __builtin_amdgcn_fence(__ATOMIC_ACQUIRE, "agent");
        asm volatile("s_waitcnt vmcnt(0)" ::: "memory"); }
    __syncthreads();
}
__device__ __forceinline__ void phase1(const Args& a, int lane, int wave) {
    const int gw = blockIdx.x * NWAVES + wave, NGW = gridDim.x * NWAVES;
    const float* MOD = (const float*)(a.ws + WS_MOD); const float* g = a.in[I_N1G];
    bf16* H = (bf16*)(a.ws + WS_H);
    for (int r = gw; r < NTOK; r += NGW) {
        const float* src = r < NCTX ? a.in[I_CTX] + (size_t)r * D : a.in[I_X] + (size_t)(r - NCTX) * D;
        const int mr = r < NCTX ? 4 : (r - NCTX) / SEQ;
        const f32x4* xr = (const f32x4*)src + lane;
        f32x4 v[8]; float s = 0.f;
#pragma unroll
        for (int j = 0; j < 8; ++j) { v[j] = xr[64 * j]; s += (v[j].x * v[j].x + v[j].y * v[j].y) + (v[j].z * v[j].z + v[j].w * v[j].w); }
        const float rstd = 1.f / sqrtf(wave_sum(s) * (1.f / D) + EPS);
        unsigned long long* o8 = (unsigned long long*)(H + (size_t)r * D) + lane;
#pragma unroll
        for (int j = 0; j < 8; ++j) {
            const int c = 4 * lane + 256 * j;
            const f32x4 gg = *(const f32x4*)(g + c), sh = *(const f32x4*)(MOD + mr * 12288 + c), sc = *(const f32x4*)(MOD + mr * 12288 + 2048 + c);
            v[j] = v[j] * rstd * gg * (sc + 1.f) + sh;
        }
#pragma unroll
        for (int j = 0; j < 8; ++j) o8[64 * j] = (unsigned long long)pk2(v[j].x, v[j].y) | ((unsigned long long)pk2(v[j].z, v[j].w) << 32);
    }
}

struct SchedIn {
    int G, c; const char* A; const char* B;
    __device__ __forceinline__ bool next(int i, pg8::Unit& u) const {
        const int L = i * G + c; if (L >= 1492) return false;
        int pm, pn;
        if (L < 1440) { pg8::tile_order(L, 32, NT_IN, pm, pn); pm += 4; }
        else { const int j = L - 1440; pm = j & 3; pn = j >> 2; }
        u.pm = pm; u.pn = pn; u.aux = 0; u.A = A + (size_t)pm * 256 * D * 2; u.B = B + (size_t)pn * 256 * D * 2; return true;
    }
};
struct EpiIn {
    static constexpr bool PERM = true, CARRY = false;
    __device__ __forceinline__ bool keep(const pg8::Unit&) const { return false; }
    unsigned char* ws; const float* b_gates;
    template <int ACT> __device__ __forceinline__ void store_tile(const pg8::f32x4 (&acc)[2][2][4][2], bf16* base, int ldc, int wr, int wc, int fr, int fq) const {
#pragma unroll
        for (int ai = 0; ai < 2; ++ai)
#pragma unroll
            for (int m = 0; m < 4; ++m) { bf16* rowp = base + (size_t)(ai * 128 + wr * 64 + m * 16 + fr) * ldc + wc * 32 + 8 * fq;
#pragma unroll
                for (int bj = 0; bj < 2; ++bj) { pg8::f32x4 v0 = acc[ai][bj][m][0], v1 = acc[ai][bj][m][1];
                    if (ACT == 1) {
#pragma unroll
                        for (int j = 0; j < 4; ++j) { v0[j] = sigmoidf_(v0[j]); v1[j] = sigmoidf_(v1[j]); } }
                    if (ACT == 2) {
#pragma unroll
                        for (int j = 0; j < 4; ++j) { v0[j] = gelu_tanh(v0[j]); v1[j] = gelu_tanh(v1[j]); } }
                    pg8::u32x4 w; w.x = pg8::cvt_pk_bf16(v0[0], v0[1]); w.y = pg8::cvt_pk_bf16(v0[2], v0[3]); w.z = pg8::cvt_pk_bf16(v1[0], v1[1]); w.w = pg8::cvt_pk_bf16(v1[2], v1[3]);
                    *(pg8::u32x4*)(rowp + bj * 128) = w; } }
    }
    __device__ __forceinline__ void operator()(const pg8::f32x4 (&acc)[2][2][4][2], const pg8::Unit& u, int wr, int wc, int fr, int fq) const {
        const int pn = u.pn; const size_t row0 = (size_t)u.pm * 256;
        if (pn < 12) {
            const int seg = pn >> 2, ct = pn & 3; bf16* dst = (bf16*)(ws + (seg == 0 ? WS_K : seg == 1 ? WS_V : WS_UX));
            store_tile<0>(acc, dst + row0 * 1024 + ct * 256, 1024, wr, wc, fr, fq);
        } else if (pn == 12) {
            if (wc == 0) {
                float* G = (float*)(ws + WS_GATES);
                const pg8::f32x4 bv0 = *(const pg8::f32x4*)(b_gates + 8 * fq), bv1 = *(const pg8::f32x4*)(b_gates + 8 * fq + 4);
#pragma unroll
                for (int ai = 0; ai < 2; ++ai)
#pragma unroll
                    for (int m = 0; m < 4; ++m) { float* rowp = G + (row0 + ai * 128 + wr * 64 + m * 16 + fr) * 32 + 8 * fq;
                        *(pg8::f32x4*)(rowp) = acc[ai][0][m][0] + bv0; *(pg8::f32x4*)(rowp + 4) = acc[ai][0][m][1] + bv1; }
            }
        } else if (pn < 29) {
            const int seg = (pn - 13) >> 2, ct = (pn - 13) & 3; const size_t lr = row0 - NCTX;
            bf16* dst = (bf16*)(ws + (seg == 0 ? WS_Q : seg == 1 ? WS_OF : seg == 2 ? WS_OB : WS_UG)) + lr * 1024 + ct * 256;
            if (seg == 0) store_tile<0>(acc, dst, 1024, wr, wc, fr, fq);
            else if (seg == 3) store_tile<2>(acc, dst, 1024, wr, wc, fr, fq);
            else store_tile<1>(acc, dst, 1024, wr, wc, fr, fq);
        } else {
            const int seg = (pn - 29) >> 3, ct = (pn - 29) & 7; const size_t lr = row0 - NCTX;
            store_tile<1>(acc, (bf16*)(ws + (seg ? WS_GB : WS_GA)) + lr * 2048 + ct * 256, 2048, wr, wc, fr, fq);
        }
    }
};

__device__ __forceinline__ int lru_pos_row(int b, bool isctx, int p) { return isctx ? b * CTXL + p : NCTX + b * SEQ + (p & 31) * 64 + (p >> 5); }
typedef short bf16x8_t __attribute__((ext_vector_type(8)));
template <bool FINAL>
__device__ __forceinline__ void lru_unit(const Args& a, unsigned char* lds_g, int b, int cidx, int blk, int tid, bf16x8_t (&wl)[2][2][4], int& wl_blk) {
    const int lane = fresh_lane(), w = __builtin_amdgcn_readfirstlane(tid >> 6), fr = lane & 15, fq = lane >> 4; tid = w * 64 + lane;
    float* zf = (float*)lds_g;
    bf16* zb = (bf16*)(lds_g + 64 * 132 * 4);
    const bool isctx = cidx < 4; const int seglen = isctx ? CTXL : SEQ, p0 = (isctx ? cidx : cidx - 4) * 64;
    const bf16* UX = (const bf16*)(a.ws + WS_UX);
    float gba[2], gbx[2], glam[2];
    { const int ch_ = blk * 128 + 16 * w + fr;
#pragma unroll
      for (int d = 0; d < 2; ++d) { gba[d] = a.in[I_LBA][d * 1024 + ch_]; gbx[d] = a.in[I_LBX][d * 1024 + ch_]; glam[d] = a.in[I_LAM][d * 1024 + ch_]; } }
    if (wl_blk != blk) { const bf16* WL = (const bf16*)(a.ws + WS_WL); wl_blk = blk;
#pragma unroll
      for (int d = 0; d < 2; ++d)
#pragma unroll
        for (int m = 0; m < 2; ++m)
#pragma unroll
            for (int ks = 0; ks < 4; ++ks) wl[d][m][ks] = *(const bf16x8_t*)(WL + ((size_t)((d * 2 + m) * 8 + blk) * 128 + 16 * w + fr) * 128 + 32 * ks + 8 * fq); }
    __builtin_amdgcn_sched_barrier(0);
    {
        const int pos = tid >> 3, cg = tid & 7, ch0 = blk * 128 + cg * 16, p = p0 + pos;
        float z[16];
#pragma unroll
        for (int q = 0; q < 4; ++q) { const f32x4 bv = *(const f32x4*)(a.in[I_CONVB] + ch0 + 4 * q); z[4 * q] = bv.x; z[4 * q + 1] = bv.y; z[4 * q + 2] = bv.z; z[4 * q + 3] = bv.w; }
        v4u ua[4], ub[4]; float msk[4];
#pragma unroll
        for (int w4 = 0; w4 < 4; ++w4) { const int pp = p + w4 - 2; const bool ok = pp >= 0 && pp < seglen; const int ppc = ok ? pp : p;
            const v4u* src = (const v4u*)(UX + (size_t)lru_pos_row(b, isctx, ppc) * 1024 + ch0); ua[w4] = src[0]; ub[w4] = src[1]; msk[w4] = ok ? 1.f : 0.f; }
#pragma unroll
        for (int w4 = 0; w4 < 4; ++w4) { const float* cw = a.in[I_CONVW] + w4 * 1024 + ch0;
            const unsigned uu[8] = {ua[w4].x, ua[w4].y, ua[w4].z, ua[w4].w, ub[w4].x, ub[w4].y, ub[w4].z, ub[w4].w};
#pragma unroll
            for (int q = 0; q < 4; ++q) { const f32x4 cv = *(const f32x4*)(cw + 4 * q) * msk[w4]; z[4 * q] += cv.x * bflo(uu[2 * q]); z[4 * q + 1] += cv.y * bfhi(uu[2 * q]); z[4 * q + 2] += cv.z * bflo(uu[2 * q + 1]); z[4 * q + 3] += cv.w * bfhi(uu[2 * q + 1]); } }
#pragma unroll
        for (int q = 0; q < 4; ++q) *(f32x4*)(zf + pos * 132 + cg * 16 + 4 * q) = (f32x4){z[4 * q], z[4 * q + 1], z[4 * q + 2], z[4 * q + 3]};
        v4u o0, o1; o0.x = pk2(z[0], z[1]); o0.y = pk2(z[2], z[3]); o0.z = pk2(z[4], z[5]); o0.w = pk2(z[6], z[7]); o1.x = pk2(z[8], z[9]); o1.y = pk2(z[10], z[11]); o1.z = pk2(z[12], z[13]); o1.w = pk2(z[14], z[15]);
        *(v4u*)(zb + pos * 136 + cg * 16) = o0; *(v4u*)(zb + pos * 136 + cg * 16 + 8) = o1;
    }
    WG_BAR();
    f32x4 acc[2][2][4];
#pragma unroll
    for (int d = 0; d < 2; ++d)
#pragma unroll
        for (int m = 0; m < 2; ++m)
#pragma unroll
            for (int mt = 0; mt < 4; ++mt) acc[d][m][mt] = (f32x4){0.f, 0.f, 0.f, 0.f};
#pragma unroll
    for (int ks = 0; ks < 4; ++ks) {
        bf16x8_t af[4];
#pragma unroll
        for (int mt = 0; mt < 4; ++mt) af[mt] = *(const bf16x8_t*)(zb + (16 * mt + fr) * 136 + 32 * ks + 8 * fq);
#pragma unroll
        for (int d = 0; d < 2; ++d)
#pragma unroll
            for (int m = 0; m < 2; ++m) {
#pragma unroll
                for (int mt = 0; mt < 4; ++mt) acc[d][m][mt] = __builtin_amdgcn_mfma_f32_16x16x32_bf16(af[mt], wl[d][m][ks], acc[d][m][mt], 0, 0, 0); }
    }
    const int chl = 16 * w + fr, ch = blk * 128 + chl;
    float hsum[4][4];
#pragma unroll
    for (int d = 0; d < 2; ++d) {
        const float ba = gba[d], bx = gbx[d], lam = glam[d];
        const float sp = (-lam > 20.f) ? -lam : log1pf(__expf(-lam));
        float av[4][4], bv[4][4];
#pragma unroll
        for (int mt = 0; mt < 4; ++mt)
#pragma unroll
            for (int r = 0; r < 4; ++r) { const float rr = sigmoidf_(acc[d][0][mt][r] + ba), ii = sigmoidf_(acc[d][1][mt][r] + bx);
                const float aa = __expf(-8.f * rr * sp); av[mt][r] = aa; bv[mt][r] = __builtin_amdgcn_sqrtf(fmaxf(1.f - aa * aa, 0.f)) * ii * zf[(16 * mt + 4 * fq + r) * 132 + chl]; }
        float Pe[4], Se[4], Pt[4], St[4];
#pragma unroll
        for (int mt = 0; mt < 4; ++mt) {
            float P = 1.f, S = 0.f;
#pragma unroll
            for (int rr = 0; rr < 4; ++rr) { const int r = d ? 3 - rr : rr; S = av[mt][r] * S + bv[mt][r]; P = av[mt][r] * P; }
            if (d == 0) {
                float p1 = __shfl_up(P, 16), s1 = __shfl_up(S, 16); if (fq >= 1) { S = P * s1 + S; P = P * p1; }
                p1 = __shfl_up(P, 32); s1 = __shfl_up(S, 32); if (fq >= 2) { S = P * s1 + S; P = P * p1; }
                Pe[mt] = __shfl_up(P, 16); Se[mt] = __shfl_up(S, 16); if (fq == 0) { Pe[mt] = 1.f; Se[mt] = 0.f; }
                Pt[mt] = __shfl(P, fr + 48); St[mt] = __shfl(S, fr + 48);
            } else {
                float p1 = __shfl_down(P, 16), s1 = __shfl_down(S, 16); if (fq <= 2) { S = P * s1 + S; P = P * p1; }
                p1 = __shfl_down(P, 32); s1 = __shfl_down(S, 32); if (fq <= 1) { S = P * s1 + S; P = P * p1; }
                Pe[mt] = __shfl_down(P, 16); Se[mt] = __shfl_down(S, 16); if (fq == 3) { Pe[mt] = 1.f; Se[mt] = 0.f; }
                Pt[mt] = __shfl(P, fr); St[mt] = __shfl(S, fr);
            }
        }
        float2* AGG = (float2*)(a.ws + WS_AGG) + ((size_t)(b * 2 + d) * 36) * 1024 + ch;
        if (!FINAL) {
            if (cidx >= 4) {
                unsigned* PS = (unsigned*)(a.ws + WS_PS) + ((size_t)(b * 2 + d) * NSTEP + 64 * cidx) * 1024 + ch;
#pragma unroll
                for (int mt = 0; mt < 4; ++mt)
#pragma unroll
                    for (int r = 0; r < 4; ++r) PS[(size_t)(16 * mt + 4 * fq + r) * 1024] = pk2(1.f - av[mt][r], bv[mt][r]);
            }
            float Pc = 1.f, Sc = 0.f;
#pragma unroll
            for (int i = 0; i < 4; ++i) { const int mt = d ? 3 - i : i; Sc = Pt[mt] * Sc + St[mt]; Pc = Pt[mt] * Pc; }
            if (fq == 0) AGG[(size_t)cidx * 1024] = make_float2(Pc, Sc);
        } else {
            float h = 0.f;
#pragma unroll
            for (int g3 = 0; g3 < 6; ++g3) {
                float2 qv[6];
#pragma unroll
                for (int i = 0; i < 6; ++i) { const int sidx = 6 * g3 + i; const int c2 = d ? (sidx < 4 ? 3 - sidx : 39 - sidx) : sidx; qv[i] = AGG[(size_t)c2 * 1024]; }
#pragma unroll
                for (int i = 0; i < 6; ++i) { const int sidx = 6 * g3 + i; const int c2 = d ? (sidx < 4 ? 3 - sidx : 39 - sidx) : sidx;
                    const bool use = d ? (sidx < 4 || c2 > cidx) : (c2 < cidx);
                    h = use ? qv[i].x * h + qv[i].y : h; }
            }
#pragma unroll
            for (int i = 0; i < 4; ++i) { const int mt = d ? 3 - i : i;
                float hl = Pe[mt] * h + Se[mt];
#pragma unroll
                for (int rr = 0; rr < 4; ++rr) { const int r = d ? 3 - rr : rr; hl = av[mt][r] * hl + bv[mt][r]; if (d == 0) hsum[mt][r] = hl; else hsum[mt][r] += hl; }
                h = Pt[mt] * h + St[mt]; }
        }
    }
    if (FINAL) {
#pragma unroll
        for (int mt = 0; mt < 4; ++mt)
#pragma unroll
            for (int r = 0; r < 4; ++r) zf[(16 * mt + 4 * fq + r) * 132 + chl] = hsum[mt][r];
        WG_BAR();
        const int pos = tid >> 3, cg = tid & 7, ch0 = blk * 128 + cg * 16;
        const size_t lrow = (size_t)(lru_pos_row(b, false, p0 + pos) - NCTX) * 1024 + ch0;
        const v4u* ug = (const v4u*)((const bf16*)(a.ws + WS_UG) + lrow); const v4u g0 = ug[0], g1 = ug[1];
        const unsigned gg[8] = {g0.x, g0.y, g0.z, g0.w, g1.x, g1.y, g1.z, g1.w}; unsigned o[8];
#pragma unroll
        for (int q = 0; q < 4; ++q) { const f32x4 hv = *(const f32x4*)(zf + pos * 132 + cg * 16 + 4 * q);
            o[2 * q] = pk2(hv.x * bflo(gg[2 * q]), hv.y * bfhi(gg[2 * q])); o[2 * q + 1] = pk2(hv.z * bflo(gg[2 * q + 1]), hv.w * bfhi(gg[2 * q + 1])); }
        v4u* dst = (v4u*)((bf16*)(a.ws + WS_YB) + lrow); dst[0] = (v4u){o[0], o[1], o[2], o[3]}; dst[1] = (v4u){o[4], o[5], o[6], o[7]};
    }
    WG_BAR();
}
constexpr int ML_STRIDE = 136;
constexpr int ML_Q = 0, ML_K = 17408, ML_V = 34816, ML_AUG = 52224  , ML_CB = 54272  ;
constexpr int ML_EB = 93440  , ML_EU = 95488  , ML_EBEND = 97536  , ML_BEND = 97568  , ML_DEN = 97600  , ML_SSQ = 97856  ;
typedef short s4_t __attribute__((ext_vector_type(4)));
__device__ __forceinline__ s4_t ds_tr(const bf16* p) { return __builtin_amdgcn_ds_read_tr16_b64_v4i16((LAS s4_t*)p); }
__device__ __forceinline__ bf16x8_t frag_row(const bf16* img, int row0, int k0, int fr, int fq) { return *(const bf16x8_t*)(img + (row0 + fr) * ML_STRIDE + k0 + 8 * fq); }
__device__ __forceinline__ bf16x8_t frag_tr2(const bf16* img, int stride, int sA, int sB, int col0, int lane) {
    const int fq = lane >> 4, q = (lane & 15) >> 2, p = lane & 3;
    const s4_t lo = ds_tr(img + (sA + 4 * fq + q) * stride + col0 + 4 * p), hi = ds_tr(img + (sB + 4 * fq + q) * stride + col0 + 4 * p);
    return (bf16x8_t){lo.x, lo.y, lo.z, lo.w, hi.x, hi.y, hi.z, hi.w};
}
__device__ __forceinline__ bf16x8_t frag_tr(const bf16* img, int stride, int s0, int col0, int lane) {
    const int fq = lane >> 4, q = (lane & 15) >> 2, p = lane & 3;
    const bf16* b = img + (s0 + 8 * fq + q) * stride + col0 + 4 * p;
    const s4_t lo = ds_tr(b), hi = ds_tr(b + 4 * stride);
    return (bf16x8_t){lo.x, lo.y, lo.z, lo.w, hi.x, hi.y, hi.z, hi.w};
}
__device__ __forceinline__ float logsigmoidf_(float x) { return fminf(x, 0.f) - log1pf(__expf(-fabsf(x))); }

__device__ __forceinline__ void ml_gates(const Args& a, unsigned char* lds_g, int rowbase, int h, int tid) {
    const int lane = fresh_lane(), w = __builtin_amdgcn_readfirstlane(tid >> 6), dir = w >> 2, c = w & 3;
    const float* GT = (const float*)(a.ws + WS_GATES) + (size_t)(rowbase + 64 * c + lane) * 32;
    const float ipre = GT[(dir * 2) * 8 + h], fpre = GT[(dir * 2 + 1) * 8 + h];
    float bsum = logsigmoidf_(fpre);
    if (dir == 0) {
#pragma unroll
        for (int o = 1; o < 64; o <<= 1) { const float t = __shfl_up(bsum, o); if (lane >= o) bsum += t; }
    } else {
#pragma unroll
        for (int o = 1; o < 64; o <<= 1) { const float t = __shfl_down(bsum, o); if (lane + o < 64) bsum += t; }
    }
    float* eb = (float*)(lds_g + ML_EB); float* eu = (float*)(lds_g + ML_EU);
    eb[dir * 256 + 64 * c + lane] = __expf(bsum); eu[dir * 256 + 64 * c + lane] = __expf(ipre - bsum);
    const float bend = __shfl(bsum, dir ? 0 : 63);
    if (lane == 0) { ((float*)(lds_g + ML_EBEND))[dir * 4 + c] = __expf(bend); ((float*)(lds_g + ML_BEND))[dir * 4 + c] = bend; }
}

template <bool OUT, bool PASS2>
__device__ __forceinline__ void ml_block(const Args& a, unsigned char* lds_g, int rowbase, int h, int dir, f32x4 (&st)[9], int tid) {
    const int lane = tid & 63, w = __builtin_amdgcn_readfirstlane(tid >> 6), fr = lane & 15, fq = lane >> 4;
    bf16* Qi = (bf16*)(lds_g + ML_Q); bf16* Ki = (bf16*)(lds_g + ML_K); bf16* Vi = (bf16*)(lds_g + ML_V); bf16* AUGi = (bf16*)(lds_g + ML_AUG); bf16* CB = (bf16*)(lds_g + ML_CB);
    const float* eb = (const float*)(lds_g + ML_EB) + dir * 256; const float* eu = (const float*)(lds_g + ML_EU) + dir * 256;
    const float* ebend = (const float*)(lds_g + ML_EBEND) + dir * 4;
    float* den = (float*)(lds_g + ML_DEN); float* ssq = (float*)(lds_g + ML_SSQ);
    const bf16* Kb = (const bf16*)(a.ws + WS_K); const bf16* Vb = (const bf16*)(a.ws + WS_V); const bf16* Qb = (const bf16*)(a.ws + WS_Q);
    const int ti = w & 3, vh = w >> 2;
    float hgv[5];
    if (OUT) {
#pragma unroll
        for (int x = 0; x < 5; ++x) { const int vt = vh * 5 + x; hgv[x] = vt < 8 ? a.in[I_HEADG][h * 128 + 16 * vt + fr] : 0.f; } }
    const int st_t = tid >> 3, st_pc = tid & 7;
    v4u k0, k1, v0, v1, q0, q1;
#define ML_LOADC(c_) do { const size_t row_ = (size_t)(rowbase + 64 * (c_) + st_t); \
        const v4u* ks_ = (const v4u*)(Kb + row_ * 1024 + h * 128 + 16 * st_pc); k0 = ks_[0]; k1 = ks_[1]; \
        const v4u* vs_ = (const v4u*)(Vb + row_ * 1024 + h * 128 + 16 * st_pc); v0 = vs_[0]; v1 = vs_[1]; \
        if (OUT) { const v4u* qs_ = (const v4u*)(Qb + (row_ - NCTX) * 1024 + h * 128 + 16 * st_pc); q0 = qs_[0]; q1 = qs_[1]; } } while (0)
    ML_LOADC(dir ? 3 : 0);
    for (int ci = 0; ci < 4; ++ci) {
        const int c = dir ? 3 - ci : ci;
        unsigned short ogv[5][4]; unsigned short tmv[5][4];
        if (OUT) {
            const bf16* OGp = (const bf16*)(a.ws + (dir ? WS_OB : WS_OF)); const bf16* TMp = (const bf16*)(a.ws + WS_TM);
#pragma unroll
            for (int r = 0; r < 4; ++r) { const size_t ob = (size_t)(rowbase - NCTX + 64 * c + 16 * ti + 4 * fq + r) * 1024 + h * 128;
#pragma unroll
                for (int x = 0; x < 5; ++x) { const int vt = vh * 5 + x; if (vt < 8) { ogv[x][r] = OGp[ob + 16 * vt + fr]; if (PASS2) tmv[x][r] = TMp[ob + 16 * vt + fr]; } } }
            __builtin_amdgcn_sched_barrier(0);
        }
        {
            const int t = st_t, pc = st_pc;
            const float e = eu[64 * c + t];
            *(v4u*)(Ki + t * ML_STRIDE + 16 * pc) = k0; *(v4u*)(Ki + t * ML_STRIDE + 16 * pc + 8) = k1;
            if (OUT) { *(v4u*)(Qi + t * ML_STRIDE + 16 * pc) = q0; *(v4u*)(Qi + t * ML_STRIDE + 16 * pc + 8) = q1; }
            const unsigned vv[8] = {v0.x, v0.y, v0.z, v0.w, v1.x, v1.y, v1.z, v1.w}; unsigned o[8];
#pragma unroll
            for (int i = 0; i < 8; ++i) o[i] = pk2(bflo(vv[i]) * e, bfhi(vv[i]) * e);
            *(v4u*)(Vi + t * ML_STRIDE + 16 * pc) = (v4u){o[0], o[1], o[2], o[3]}; *(v4u*)(Vi + t * ML_STRIDE + 16 * pc + 8) = (v4u){o[4], o[5], o[6], o[7]};
            if (pc == 0) { *(v4u*)(AUGi + t * 16) = (v4u){f2bf(e), 0u, 0u, 0u}; *(v4u*)(AUGi + t * 16 + 8) = (v4u){0u, 0u, 0u, 0u}; }
        }
        WG_BAR();
        if (ci < 3) ML_LOADC(dir ? 2 - ci : ci + 1);
        f32x4 X[5]; float hval[4][4];
        if (OUT) {
            bf16x8_t qf[4];
#pragma unroll
            for (int ks = 0; ks < 4; ++ks) qf[ks] = frag_row(Qi, 16 * ti, 32 * ks, fr, fq);
            bf16x8_t P[2]; bool pv[2];
#pragma unroll
            for (int pp = 0; pp < 2; ++pp) {
                f32x4 d[2];
#pragma unroll
                for (int hh = 0; hh < 2; ++hh) { const int si = 2 * pp + hh; d[hh] = (f32x4){0.f, 0.f, 0.f, 0.f};
                    const bool valid = dir ? (si >= ti) : (si <= ti);
                    if (valid) {
#pragma unroll
                        for (int ks = 0; ks < 4; ++ks) d[hh] = __builtin_amdgcn_mfma_f32_16x16x32_bf16(frag_row(Ki, 16 * si, 32 * ks, fr, fq), qf[ks], d[hh], 0, 0, 0);
                        if (si == ti) {
#pragma unroll
                            for (int r = 0; r < 4; ++r) { const bool keep = dir ? (4 * fq + r >= fr) : (4 * fq + r <= fr); d[hh][r] = keep ? d[hh][r] : 0.f; } } } }
                pv[pp] = dir ? (2 * pp + 1 >= ti) : (2 * pp <= ti);
                const unsigned p0 = pk2(d[0][0], d[0][1]), p1 = pk2(d[0][2], d[0][3]), p2 = pk2(d[1][0], d[1][1]), p3 = pk2(d[1][2], d[1][3]);
                P[pp] = __builtin_bit_cast(bf16x8_t, (v4u){p0, p1, p2, p3});
            }
#pragma unroll
            for (int x = 0; x < 5; ++x) { X[x] = (f32x4){0.f, 0.f, 0.f, 0.f};
                const int vt = vh * 5 + x;
                if (vt < 9) {
#pragma unroll
                    for (int pp = 0; pp < 2; ++pp) if (pv[pp]) {
                        const bf16x8_t bfv = vt < 8 ? frag_tr2(Vi, ML_STRIDE, 32 * pp, 32 * pp + 16, 16 * vt, lane) : frag_tr2(AUGi, 16, 32 * pp, 32 * pp + 16, 0, lane);
                        X[x] = __builtin_amdgcn_mfma_f32_16x16x32_bf16(P[pp], bfv, X[x], 0, 0, 0); }
#pragma unroll
                    for (int ks = 0; ks < 4; ++ks) X[x] = __builtin_amdgcn_mfma_f32_16x16x32_bf16(qf[ks], frag_row(CB, 16 * vt, 32 * ks, fr, fq), X[x], 0, 0, 0);
                } }
            if (vh == 1 && fr == 0) {
#pragma unroll
                for (int r = 0; r < 4; ++r) den[16 * ti + 4 * fq + r] = X[3][r] * eb[64 * c + 16 * ti + 4 * fq + r]; }
        }
        {
#pragma unroll
            for (int ks = 0; ks < 2; ++ks) { const bf16x8_t kf = frag_tr(Ki, ML_STRIDE, 32 * ks, 16 * w, lane);
#pragma unroll
                for (int vt = 0; vt < 8; ++vt) st[vt] = __builtin_amdgcn_mfma_f32_16x16x32_bf16(kf, frag_tr(Vi, ML_STRIDE, 32 * ks, 16 * vt, lane), st[vt], 0, 0, 0);
                st[8] = __builtin_amdgcn_mfma_f32_16x16x32_bf16(kf, frag_tr(AUGi, 16, 32 * ks, 0, lane), st[8], 0, 0, 0); }
            const float ee = ebend[c];
#pragma unroll
            for (int vt = 0; vt < 9; ++vt) st[vt] = st[vt] * ee;
        }
        WG_BAR();
        if (OUT) {
            float sq[4] = {0.f, 0.f, 0.f, 0.f};
#pragma unroll
            for (int r = 0; r < 4; ++r) { const int t = 16 * ti + 4 * fq + r; const float sc = eb[64 * c + t] * __builtin_amdgcn_rcpf(fmaxf(fabsf(den[t]), 1.f));
#pragma unroll
                for (int x = 0; x < 4; ++x) { const int vt = vh * 5 + x; const float hv = (vt < 8) ? X[x][r] * sc : 0.f; hval[x][r] = hv; sq[r] += hv * hv; }
                if (vh == 0) { const float hv = X[4][r] * sc; X[4][r] = hv; sq[r] += hv * hv; } }
#pragma unroll
            for (int r = 0; r < 4; ++r) { float v = sq[r]; v += __shfl_xor(v, 1); v += __shfl_xor(v, 2); v += __shfl_xor(v, 4); v += __shfl_xor(v, 8); if (fr == 0) ssq[vh * 64 + 16 * ti + 4 * fq + r] = v; }
#pragma unroll
            for (int vt = 0; vt < 9; ++vt) { pg8::u32x2 o; o.x = pk2(st[vt][0], st[vt][1]); o.y = pk2(st[vt][2], st[vt][3]); *(pg8::u32x2*)(CB + (16 * vt + fr) * ML_STRIDE + 16 * w + 4 * fq) = o; }
            WG_BAR();
            bf16* TM = (bf16*)(a.ws + WS_TM); bf16* YA = (bf16*)(a.ws + WS_YA);
#pragma unroll
            for (int r = 0; r < 4; ++r) { const int t = 16 * ti + 4 * fq + r; const float rs = __builtin_amdgcn_rsqf((ssq[t] + ssq[64 + t]) * (1.f / 128.f) + EPS);
                const size_t ob = (size_t)(rowbase - NCTX + 64 * c + t) * 1024 + h * 128;
#pragma unroll
                for (int x = 0; x < 5; ++x) { const int vt = vh * 5 + x; if (vt < 8) { const int v = 16 * vt + fr; const float hv = (x < 4) ? hval[x][r] : X[4][r];
                    float y = hv * rs * hgv[x] * bf2f(ogv[x][r]);
                    if (PASS2) { y += bf2f(tmv[x][r]); YA[ob + v] = (bf16)f2bf(y); } else TM[ob + v] = (bf16)f2bf(y); } } }
        }
    }
}

#undef ML_LOADC
__device__ __forceinline__ void ml_state_quad(const Args& a, unsigned char* lds_g, int qu, int tid) {
    const int seq = qu >> 1, j0 = 4 * (qu & 1), dir = seq & 1, h = (seq >> 1) & 7, b = seq >> 4;
    const int lane = tid & 63, w = __builtin_amdgcn_readfirstlane(tid >> 6);
    f32x4 st[9];
#pragma unroll
    for (int vt = 0; vt < 9; ++vt) st[vt] = (f32x4){0.f, 0.f, 0.f, 0.f};
#pragma unroll 1
    for (int jj = 0; jj < 4; ++jj) {
        const int j = j0 + jj, su = seq * 8 + j;
        const int rowbase = j == 0 ? b * CTXL : NCTX + b * SEQ + 256 * (dir ? 8 - j : j - 1);
        ml_gates(a, lds_g, rowbase, h, tid);
        WG_BAR();
        ml_block<false, false>(a, lds_g, rowbase, h, dir, st, tid);
        pg8::u32x2* SL = (pg8::u32x2*)(a.ws + WS_SLOC) + ((size_t)(su * 8 + w) * 9) * 64 + lane;
#pragma unroll
        for (int vt = 0; vt < 9; ++vt) { pg8::u32x2 o; o.x = pk2(st[vt][0], st[vt][1]); o.y = pk2(st[vt][2], st[vt][3]); SL[vt * 64] = o; }
        if (tid == 0) { const float* bd = (const float*)(lds_g + ML_BEND) + dir * 4; ((float*)(a.ws + WS_BT))[su] = (bd[0] + bd[1]) + (bd[2] + bd[3]); }
        WG_BAR();
    }
}
__device__ __forceinline__ void ml_out_unit(const Args& a, unsigned char* lds_g, int u, int tid) {
    const int L = u & 7, h = (u >> 3) & 7, b = u >> 6;
    const int rowbase = NCTX + b * SEQ + 256 * L;
    const int lane = tid & 63, w = __builtin_amdgcn_readfirstlane(tid >> 6), fr = lane & 15, fq = lane >> 4;
    bf16* CB = (bf16*)(lds_g + ML_CB);
    ml_gates(a, lds_g, rowbase, h, tid);
    f32x4 st[9];
#pragma unroll
    for (int dir = 0; dir < 2; ++dir) {
        const int seq = (b * 8 + h) * 2 + dir, jmax = dir ? 7 - L : L;
        const float* BT = (const float*)(a.ws + WS_BT) + seq * 8;
        {
            const pg8::u32x2* SLa = (const pg8::u32x2*)(a.ws + WS_SLOC) + ((size_t)((seq * 8 + jmax) * 8 + w) * 9) * 64 + lane;
            const pg8::u32x2* SLb = (const pg8::u32x2*)(a.ws + WS_SLOC) + ((size_t)((seq * 8 + 3) * 8 + w) * 9) * 64 + lane;
            pg8::u32x2 sa[9];
            if (jmax >= 4) {
                pg8::u32x2 sb[9];
#pragma unroll
                for (int vt = 0; vt < 9; ++vt) { sa[vt] = SLa[vt * 64]; sb[vt] = SLb[vt * 64]; }
                float ls = 0.f;
#pragma unroll
                for (int q = 4; q < 8; ++q) ls += (q <= jmax) ? BT[q] : 0.f;
                const float coef = __expf(ls);
#pragma unroll
                for (int vt = 0; vt < 9; ++vt) st[vt] = (f32x4){bflo(sa[vt].x) + bflo(sb[vt].x) * coef, bfhi(sa[vt].x) + bfhi(sb[vt].x) * coef, bflo(sa[vt].y) + bflo(sb[vt].y) * coef, bfhi(sa[vt].y) + bfhi(sb[vt].y) * coef};
            } else {
#pragma unroll
                for (int vt = 0; vt < 9; ++vt) { sa[vt] = SLa[vt * 64]; st[vt] = (f32x4){bflo(sa[vt].x), bfhi(sa[vt].x), bflo(sa[vt].y), bfhi(sa[vt].y)}; }
            }
        }
#pragma unroll
        for (int vt = 0; vt < 9; ++vt) { pg8::u32x2 o; o.x = pk2(st[vt][0], st[vt][1]); o.y = pk2(st[vt][2], st[vt][3]); *(pg8::u32x2*)(CB + (16 * vt + fr) * ML_STRIDE + 16 * w + 4 * fq) = o; }
        WG_BAR();
        if (dir == 0) ml_block<true, false>(a, lds_g, rowbase, h, 0, st, tid);
        else ml_block<true, true>(a, lds_g, rowbase, h, 1, st, tid);
        asm volatile("s_waitcnt vmcnt(0)" ::: "memory");
        WG_BAR();
    }
}

__device__ __forceinline__ void lru_out_loadps(const Args& a, int b, int cidx, int blk, int tid, unsigned (&psw)[2][16]) {
    const int chl = tid & 127, q = tid >> 7, ch = blk * 128 + chl;
#pragma unroll
    for (int d = 0; d < 2; ++d) { const unsigned* PS = (const unsigned*)(a.ws + WS_PS) + ((size_t)(b * 2 + d) * NSTEP + 64 * cidx + 16 * q) * 1024 + ch;
#pragma unroll
        for (int i = 0; i < 16; ++i) psw[d][i] = PS[(size_t)i * 1024]; }
}
__device__ __forceinline__ void lru_out_unit(const Args& a, unsigned char* lds_g, int b, int cidx, int blk, int tid, unsigned (&psw)[2][16], int nb, int ncidx, int nblk) {
    tid = __builtin_amdgcn_readfirstlane(tid >> 6) * 64 + fresh_lane();
    const int chl = tid & 127, q = tid >> 7, ch = blk * 128 + chl;
    float2* QA = (float2*)lds_g;
    float av[2][16], bv[2][16];
#pragma unroll
    for (int d = 0; d < 2; ++d)
#pragma unroll
        for (int i = 0; i < 16; ++i) { const unsigned wv = psw[d][i]; av[d][i] = 1.f - bflo(wv); bv[d][i] = bfhi(wv); }
    const int p0 = (cidx - 4) * 64 + 16 * q;
    unsigned short ugv[16];
#pragma unroll
    for (int i = 0; i < 16; ++i) ugv[i] = ((const bf16*)(a.ws + WS_UG))[(size_t)(lru_pos_row(b, false, p0 + i) - NCTX) * 1024 + ch];
    if (ncidx >= 0) lru_out_loadps(a, nb, ncidx, nblk, tid, psw);
    float2* CA = (float2*)(lds_g + 8192);
#pragma unroll
    for (int d = 0; d < 2; ++d) { const float2* AGG = (const float2*)(a.ws + WS_AGG) + ((size_t)(b * 2 + d) * 36) * 1024 + ch; float2 qv[9];
#pragma unroll
        for (int i = 0; i < 9; ++i) { const int sidx = 9 * q + i; const int c2 = d ? (sidx < 4 ? 3 - sidx : 39 - sidx) : sidx; qv[i] = AGG[(size_t)c2 * 1024]; }
        float P = 1.f, S = 0.f;
#pragma unroll
        for (int i = 0; i < 9; ++i) { const int sidx = 9 * q + i; const int c2 = d ? (sidx < 4 ? 3 - sidx : 39 - sidx) : sidx; const bool use = d ? (sidx < 4 || c2 > cidx) : (c2 < cidx);
            S = use ? qv[i].x * S + qv[i].y : S; P = use ? qv[i].x * P : P; }
        CA[(d * 4 + q) * 128 + chl] = make_float2(P, S); }
#pragma unroll
    for (int d = 0; d < 2; ++d) { float P = 1.f, S = 0.f;
#pragma unroll
        for (int ii = 0; ii < 16; ++ii) { const int i = d ? 15 - ii : ii; S = av[d][i] * S + bv[d][i]; P = av[d][i] * P; }
        QA[(d * 4 + q) * 128 + chl] = make_float2(P, S); }
    WG_BAR();
    float hs[16];
#pragma unroll
    for (int d = 0; d < 2; ++d) { float h = 0.f;
#pragma unroll
        for (int k = 0; k < 4; ++k) { const float2 t = CA[(d * 4 + k) * 128 + chl]; h = t.x * h + t.y; }
#pragma unroll
        for (int k = 0; k < 3; ++k) { const int qq = d ? 3 - k : k; const bool use = d ? (qq > q) : (qq < q); const float2 t = QA[(d * 4 + qq) * 128 + chl]; h = use ? t.x * h + t.y : h; }
#pragma unroll
        for (int ii = 0; ii < 16; ++ii) { const int i = d ? 15 - ii : ii; h = av[d][i] * h + bv[d][i]; if (d == 0) hs[i] = h; else hs[i] += h; } }
#pragma unroll
    for (int i = 0; i < 16; ++i) { const size_t lrow = (size_t)(lru_pos_row(b, false, p0 + i) - NCTX) * 1024 + ch;
        ((bf16*)(a.ws + WS_YB))[lrow] = (bf16)f2bf(hs[i] * bf2f(ugv[i])); }
    WG_BAR();
}
__device__ __forceinline__ void phase3(const Args& a, unsigned char* lds_g, int tid) {
    {
        int q0 = (int)blockIdx.x, qstep = (int)gridDim.x;
        if (gridDim.x == 256) q0 = blockIdx.x >= 128 ? (int)blockIdx.x - 128 : 128;
        for (int qu = q0; qu < 128; qu += qstep) ml_state_quad(a, lds_g, qu, tid);
    }
    bf16x8_t wl[2][2][4]; int wl_blk = -1;
    for (int u = blockIdx.x; u < 4 * 36 * 8; u += gridDim.x) { const int blk = u & 7, q = u >> 3; lru_unit<false>(a, lds_g, q / 36, q % 36, blk, tid, wl, wl_blk); }
}

struct SchedProj {
    int G, c; const char *YA, *YB, *WA, *WB;
    __device__ __forceinline__ bool next(int i, pg8::Unit& u) const {
        const int tile = (i >> 1) * G + c, part = i & 1; if (tile >= 256) return false;
        int pm, pn; pg8::tile_order(tile, 32, 8, pm, pn);
        u.pm = pm; u.pn = pn; u.aux = part; u.A = (part ? YB : YA) + (size_t)pm * 256 * 1024 * 2; u.B = (part ? WB : WA) + (size_t)pn * 256 * 1024 * 2; return true;
    }
};
struct EpiProj {
    static constexpr bool PERM = true, CARRY = true;
    const bf16 *GA, *GB; bf16* PRE;
    __device__ __forceinline__ bool keep(const pg8::Unit& u) const { return u.aux == 0; }
    __device__ __forceinline__ void operator()(pg8::f32x4 (&acc)[2][2][4][2], const pg8::Unit& u, int wr, int wc, int fr, int fq) const {
#pragma unroll
        for (int ai = 0; ai < 2; ++ai) {
            pg8::u32x4 gb4[4][2], ga4[4][2];
#pragma unroll
            for (int m = 0; m < 4; ++m) { const size_t off = (size_t)(u.pm * 256 + ai * 128 + wr * 64 + m * 16 + fr) * 2048 + u.pn * 256 + wc * 32 + 8 * fq;
#pragma unroll
                for (int bj = 0; bj < 2; ++bj) { gb4[m][bj] = *(const pg8::u32x4*)(GB + off + bj * 128); if (u.aux == 0) ga4[m][bj] = *(const pg8::u32x4*)(GA + off + bj * 128); } }
#pragma unroll
            for (int m = 0; m < 4; ++m) { const size_t off = (size_t)(u.pm * 256 + ai * 128 + wr * 64 + m * 16 + fr) * 2048 + u.pn * 256 + wc * 32 + 8 * fq;
#pragma unroll
                for (int bj = 0; bj < 2; ++bj) { const pg8::u32x4 g4 = gb4[m][bj];
                    const float gbv[8] = {bflo(g4.x), bfhi(g4.x), bflo(g4.y), bfhi(g4.y), bflo(g4.z), bfhi(g4.z), bflo(g4.w), bfhi(g4.w)};
                    if (u.aux == 0) { const pg8::u32x4 a4 = ga4[m][bj];
                        const float gav[8] = {bflo(a4.x), bfhi(a4.x), bflo(a4.y), bfhi(a4.y), bflo(a4.z), bfhi(a4.z), bflo(a4.w), bfhi(a4.w)};
#pragma unroll
                        for (int e = 0; e < 4; ++e) { acc[ai][bj][m][0][e] *= gav[e] * __builtin_amdgcn_rcpf(fmaxf(gbv[e], 1e-20f)); acc[ai][bj][m][1][e] *= gav[4 + e] * __builtin_amdgcn_rcpf(fmaxf(gbv[4 + e], 1e-20f)); }
                    } else {
                        pg8::f32x4 v0 = acc[ai][bj][m][0], v1 = acc[ai][bj][m][1];
#pragma unroll
                        for (int e = 0; e < 4; ++e) { v0[e] *= gbv[e]; v1[e] *= gbv[4 + e]; }
                        pg8::u32x4 w; w.x = pg8::cvt_pk_bf16(v0[0], v0[1]); w.y = pg8::cvt_pk_bf16(v0[2], v0[3]); w.z = pg8::cvt_pk_bf16(v1[0], v1[1]); w.w = pg8::cvt_pk_bf16(v1[2], v1[3]);
                        *(pg8::u32x4*)(PRE + off + bj * 128) = w; } } }
        }
    }
};

struct SchedOut {
    int G, c; const char *A, *B;
    __device__ __forceinline__ bool next(int i, pg8::Unit& u) const {
        const int L = i * G + c; if (L >= 256) return false;
        int pm, pn; pg8::tile_order(L, 32, 8, pm, pn);
        u.pm = pm; u.pn = pn; u.aux = 0; u.A = A + (size_t)pm * 256 * D * 2; u.B = B + (size_t)pn * 256 * D * 2; return true;
    }
};
struct EpiOut {
    static constexpr bool PERM = true, CARRY = false;
    __device__ __forceinline__ bool keep(const pg8::Unit&) const { return false; }
    const float* x; const float* MOD; bf16* X1;
    __device__ __forceinline__ void operator()(const pg8::f32x4 (&acc)[2][2][4][2], const pg8::Unit& u, int wr, int wc, int fr, int fq) const {
        const int b = u.pm >> 3; const int col0 = u.pn * 256 + wc * 32 + 8 * fq;
        pg8::f32x4 g1[2][2];
#pragma unroll
        for (int bj = 0; bj < 2; ++bj)
#pragma unroll
            for (int n = 0; n < 2; ++n) g1[bj][n] = *(const pg8::f32x4*)(MOD + b * 12288 + 2 * 2048 + col0 + bj * 128 + n * 4);
#pragma unroll
        for (int ai = 0; ai < 2; ++ai) {
            pg8::f32x4 xv[4][2][2];
#pragma unroll
            for (int m = 0; m < 4; ++m) { const size_t off = (size_t)(u.pm * 256 + ai * 128 + wr * 64 + m * 16 + fr) * D + col0;
#pragma unroll
                for (int bj = 0; bj < 2; ++bj)
#pragma unroll
                    for (int n = 0; n < 2; ++n) xv[m][bj][n] = *(const pg8::f32x4*)(x + off + bj * 128 + n * 4); }
#pragma unroll
            for (int m = 0; m < 4; ++m) { const size_t off = (size_t)(u.pm * 256 + ai * 128 + wr * 64 + m * 16 + fr) * D + col0;
#pragma unroll
                for (int bj = 0; bj < 2; ++bj) { const pg8::f32x4 v0 = xv[m][bj][0] + g1[bj][0] * acc[ai][bj][m][0], v1 = xv[m][bj][1] + g1[bj][1] * acc[ai][bj][m][1];
                    pg8::u32x4 w; w.x = pg8::cvt_pk_bf16(v0[0], v0[1]); w.y = pg8::cvt_pk_bf16(v0[2], v0[3]); w.z = pg8::cvt_pk_bf16(v1[0], v1[1]); w.w = pg8::cvt_pk_bf16(v1[2], v1[3]);
                    *(pg8::u32x4*)(X1 + off + bj * 128) = w; } }
        }
    }
};

__device__ __forceinline__ void phase_router(const Args& a, unsigned char* lds_g, int tid, int lane, int wave) {
    const bf16* X1 = (const bf16*)(a.ws + WS_X1); const float* MOD = (const float*)(a.ws + WS_MOD); const float* g = a.in[I_N2G];
    const float* WR = (const float*)(a.ws + WS_WR); const float* RB = (const float*)(a.ws + WS_RB);
    bf16* H2 = (bf16*)(a.ws + WS_H2); unsigned* cnt = (unsigned*)(a.ws + WS_CTL) + CW_CNT; int4* ASG = (int4*)(a.ws + WS_ASG);
    f32x4* PART = (f32x4*)lds_g;
    float* SSQP = (float*)(lds_g + 24576);
    float* RS = (float*)(lds_g + 24576 + 512);
    float* LG = (float*)(lds_g + 24576 + 1024);
    const int slot = wave >> 2, kq = wave & 3, i = lane & 15, gq = lane >> 4;
    for (int tp = blockIdx.x; tp < NLAT / 32; tp += gridDim.x) {
        const int tok0 = 32 * tp + 16 * slot, b = tok0 >> 11, kbase = kq * 512 + 8 * gq;
        const bf16* xr = X1 + (size_t)(tok0 + i) * D + kbase;
        const float* wr = WR + ((size_t)(b * 48 + i) * 2048 + kbase);
        f32x4 acc0 = (f32x4){0.f, 0.f, 0.f, 0.f}, acc1 = acc0, acc2 = acc0; float sq = 0.f;
#pragma unroll 2
        for (int s8 = 0; s8 < 16; ++s8) {
            const v4u xb = *(const v4u*)(xr + 32 * s8);
            const f32x4 b0a = *(const f32x4*)(wr + 32 * s8), b0b = *(const f32x4*)(wr + 32 * s8 + 4), b1a = *(const f32x4*)(wr + 16 * 2048 + 32 * s8), b1b = *(const f32x4*)(wr + 16 * 2048 + 32 * s8 + 4),
                        b2a = *(const f32x4*)(wr + 32 * 2048 + 32 * s8), b2b = *(const f32x4*)(wr + 32 * 2048 + 32 * s8 + 4);
            const float xe[8] = {bflo(xb.x), bfhi(xb.x), bflo(xb.y), bfhi(xb.y), bflo(xb.z), bfhi(xb.z), bflo(xb.w), bfhi(xb.w)};
#pragma unroll
            for (int e = 0; e < 4; ++e) { acc0 = __builtin_amdgcn_mfma_f32_16x16x4f32(xe[e], b0a[e], acc0, 0, 0, 0); acc1 = __builtin_amdgcn_mfma_f32_16x16x4f32(xe[e], b1a[e], acc1, 0, 0, 0); acc2 = __builtin_amdgcn_mfma_f32_16x16x4f32(xe[e], b2a[e], acc2, 0, 0, 0); }
#pragma unroll
            for (int e = 0; e < 4; ++e) { acc0 = __builtin_amdgcn_mfma_f32_16x16x4f32(xe[4 + e], b0b[e], acc0, 0, 0, 0); acc1 = __builtin_amdgcn_mfma_f32_16x16x4f32(xe[4 + e], b1b[e], acc1, 0, 0, 0); acc2 = __builtin_amdgcn_mfma_f32_16x16x4f32(xe[4 + e], b2b[e], acc2, 0, 0, 0); }
#pragma unroll
            for (int e = 0; e < 8; ++e) sq += xe[e] * xe[e];
        }
        sq += __shfl_xor(sq, 16); sq += __shfl_xor(sq, 32);
        PART[((slot * 4 + kq) * 3 + 0) * 64 + lane] = acc0; PART[((slot * 4 + kq) * 3 + 1) * 64 + lane] = acc1; PART[((slot * 4 + kq) * 3 + 2) * 64 + lane] = acc2;
        if (gq == 0) SSQP[(slot * 4 + kq) * 16 + i] = sq;
        __syncthreads();
        if (kq == 0) {
            const float* sp = SSQP + slot * 64; const float rstd = 1.f / sqrtf(((sp[i] + sp[16 + i]) + (sp[32 + i] + sp[48 + i])) * (1.f / D) + EPS);
            if (gq == 0) RS[slot * 16 + i] = rstd;
#pragma unroll
            for (int cb = 0; cb < 3; ++cb) { const f32x4* pp = PART + (slot * 4 * 3 + cb) * 64 + lane; const f32x4 sum = (pp[0] + pp[3 * 64]) + (pp[6 * 64] + pp[9 * 64]);
                const float rb = RB[b * 48 + 16 * cb + i];
#pragma unroll
                for (int r = 0; r < 4; ++r) LG[(slot * 16 + 4 * gq + r) * 48 + 16 * cb + i] = __shfl(rstd, 4 * gq + r) * sum[r] + rb; }
            LDS_WAIT(); asm volatile("" ::: "memory");
            if (lane < 16) {
                const float* lg = LG + (slot * 16 + lane) * 48; const int t = tok0 + lane;
                int gs = 0; float gm = lg[32];
#pragma unroll
                for (int q = 1; q < 4; ++q) { const float v = lg[32 + q]; if (v > gm) { gm = v; gs = q; } }
                float se = 0.f;
#pragma unroll
                for (int q = 0; q < 4; ++q) se += __expf(lg[32 + q] - gm);
                const float pg = 1.f / se;
                int i0 = 0; float v0 = lg[gs * 8];
#pragma unroll
                for (int q = 1; q < 8; ++q) { const float v = lg[gs * 8 + q]; if (v > v0) { v0 = v; i0 = q; } }
                int i1 = -1; float v1 = -3.0e38f;
#pragma unroll
                for (int q = 0; q < 8; ++q) { const float v = lg[gs * 8 + q]; if (q != i0 && v > v1) { v1 = v; i1 = q; } }
                const float e1 = __expf(v1 - v0), w0 = pg / (1.f + e1), w1 = pg * e1 / (1.f + e1);
                const int ex0 = gs * 8 + i0, ex1 = gs * 8 + i1;
                const unsigned p0 = atomicAdd(cnt + ex0, 1u), p1 = atomicAdd(cnt + ex1, 1u);
                ASG[2 * t] = make_int4(ex0, (int)p0, __float_as_int(w0), 0); ASG[2 * t + 1] = make_int4(ex1, (int)p1, __float_as_int(w1), 0);
                int* LIST = (int*)(a.ws + WS_LIST); LIST[ex0 * 8192 + (int)p0] = t; LIST[ex1 * 8192 + (int)p1] = t;
            }
        }
        __syncthreads();
#pragma unroll
        for (int r = 0; r < 4; ++r) { const int tl = 4 * kq + r, t = tok0 + tl; const float rstd = RS[slot * 16 + tl];
            const unsigned long long* xrow = (const unsigned long long*)(X1 + (size_t)t * D) + lane; unsigned* o4 = (unsigned*)((unsigned char*)H2 + (size_t)t * D) + lane;
            f32x4 yv[8];
#pragma unroll
            for (int j = 0; j < 8; ++j) { const int c = 4 * lane + 256 * j;
                const f32x4 gg = *(const f32x4*)(g + c), sh = *(const f32x4*)(MOD + b * 12288 + 3 * 2048 + c), sc = *(const f32x4*)(MOD + b * 12288 + 4 * 2048 + c);
                const unsigned long long xw = xrow[64 * j]; const f32x4 xv4 = (f32x4){bflo((unsigned)xw), bfhi((unsigned)xw), bflo((unsigned)(xw >> 32)), bfhi((unsigned)(xw >> 32))};
                yv[j] = xv4 * rstd * gg * (sc + 1.f) + sh; }
#pragma unroll
            for (int j = 0; j < 8; ++j) { int w8 = __builtin_amdgcn_cvt_pk_fp8_f32(yv[j].x, yv[j].y, 0, false); w8 = __builtin_amdgcn_cvt_pk_fp8_f32(yv[j].z, yv[j].w, w8, true); o4[64 * j] = (unsigned)w8; } }
        __syncthreads();
    }
}

constexpr int MG_A = 0, MG_ABYTES = 32768, MG_B = 65536, MG_BBYTES = 64 * 256  , MG_CUM = 141312  ;
__device__ __forceinline__ int mgb_off(int row, int ch) { return 256 * row + 16 * (ch ^ (((row & 3) << 2) | ((row >> 2) & 3))); }
__device__ __forceinline__ bf16x8_t mgb_frag(const unsigned char* img, int ks, int c, int lane) {
    const int g = lane >> 4, q = (lane & 15) >> 2, p = lane & 3;
    const s4_t lo = ds_tr((const bf16*)(img + mgb_off(32 * ks + 8 * g + q, 2 * c + (p >> 1)) + 8 * (p & 1)));
    const s4_t hi = ds_tr((const bf16*)(img + mgb_off(32 * ks + 8 * g + 4 + q, 2 * c + (p >> 1)) + 8 * (p & 1)));
    return (bf16x8_t){lo.x, lo.y, lo.z, lo.w, hi.x, hi.y, hi.z, hi.w};
}
__device__ __forceinline__ void moe_tables(const Args& a, unsigned char* lds_g, int tid) {
    int* cum = (int*)(lds_g + MG_CUM); const unsigned* ctl = (const unsigned*)(a.ws + WS_CTL);
    if (tid < NEXP) cum[128 + tid] = (int)ctl[CW_CNT + tid];
    if (tid == 0) { int c = 0; for (int e = 0; e < NEXP; ++e) { cum[e] = c; c += (int)((ctl[CW_CNT + e] + 255u) >> 8); } cum[NEXP] = c; }
    __syncthreads();
}
constexpr int MH_A = 0, MH_ABYTES = 32768, MH_B = 65536, MH_BROW = 528, MH_BBYTES = 64 * MH_BROW  ;
__device__ __forceinline__ int mhb_off(int row, int ch) { return MH_BROW * row + 16 * ch; }
__device__ __forceinline__ bf16x8_t mhb_frag(const LAS unsigned char* lbase, int cofs) {
    const s4_t lo = __builtin_amdgcn_ds_read_tr16_b64_v4i16((LAS s4_t*)(lbase + cofs));
    const s4_t hi = __builtin_amdgcn_ds_read_tr16_b64_v4i16((LAS s4_t*)(lbase + cofs + MH_BROW));
    return (bf16x8_t){lo.x, lo.y, lo.z, lo.w, hi.x, hi.y, hi.z, hi.w};
}
__device__ __forceinline__ int moe_pull(const Args& a, unsigned char* lds_g, int w, int x) {
    int* slot = (int*)(lds_g + MG_CUM + 256);
    __syncthreads();
    if (w == 0 && fresh_lane() == 0) *slot = (int)__hip_atomic_fetch_add((unsigned*)(a.ws + WS_CTL) + CW_Q + 64 * x, 1u, __ATOMIC_RELAXED, __HIP_MEMORY_SCOPE_AGENT);
    __syncthreads();
    return __builtin_amdgcn_readfirstlane(*slot);
}
__device__ __forceinline__ unsigned f8pair_lo(unsigned w) { const auto v = __builtin_amdgcn_cvt_pk_f32_fp8((int)w, false); return pk2(v[0], v[1]); }
__device__ __forceinline__ unsigned f8pair_hi(unsigned w) { const auto v = __builtin_amdgcn_cvt_pk_f32_fp8((int)w, true); return pk2(v[0], v[1]); }
template <int MODE>
__device__ __forceinline__ int moe_gemm(const Args& a, unsigned char* lds_g, int tid, int idx0) {
    constexpr int K = MODE == 1 ? D : DE, NT = K / 64;
#define MG_BAR() do { asm volatile("s_waitcnt lgkmcnt(0)" ::: "memory"); __builtin_amdgcn_s_barrier(); asm volatile("" ::: "memory"); } while (0)
    const int w = __builtin_amdgcn_readfirstlane(tid >> 6);
    const int wm = w >> 1, wn = w & 1, hh = wm >> 1, wr = wm & 1;
    const int* cum = (const int*)(lds_g + MG_CUM); const unsigned* ctl = (const unsigned*)(a.ws + WS_CTL);
    const int T = cum[NEXP], x = blockIdx.x & 7;
    for (int idx = idx0;;) {
        if (idx < 0) idx = moe_pull(a, lds_g, w, x);
        if (idx >= (MODE == 1 ? T : 2 * T)) return idx;
        const int ti = MODE == 1 ? idx : idx - T;
        idx = -1;
        const int nt = x;
        if (MODE == 2) {
            if (w == 0) { unsigned* tc = (unsigned*)(a.ws + WS_CTL) + CW_TC + 64 * ti; unsigned spins = 0;
                while ((unsigned)__builtin_amdgcn_readfirstlane(__hip_atomic_load(tc, __ATOMIC_RELAXED, __HIP_MEMORY_SCOPE_AGENT)) < 64u) {
                    __builtin_amdgcn_s_sleep(2);
                    if (++spins > (1u << 22)) { if (fresh_lane() == 0) __hip_atomic_store((unsigned*)(a.ws + WS_CTL) + 1, 0x900u + (unsigned)ti, __ATOMIC_RELAXED, __HIP_MEMORY_SCOPE_AGENT); break; } }
                __builtin_amdgcn_fence(__ATOMIC_ACQUIRE, "agent");
                asm volatile("s_waitcnt vmcnt(0)" ::: "memory"); }
            __syncthreads();
        }
        const int lane = fresh_lane(), tidu = w * 64 + lane, fr = lane & 15, fq = lane >> 4;
        const int aoff = pg8::lds_byte(wr * 64 + fr, fq * 8);
        const int bk = w, bp = lane;
        int e = 0;
#pragma unroll 1
        for (int q = 1; q < NEXP; ++q) e = (cum[q] <= ti) ? q : e;
        e = __builtin_amdgcn_readfirstlane(e);
        const int mt = __builtin_amdgcn_readfirstlane(ti - cum[e]);
        unsigned aofs[4]; unsigned bofs; int bwr0;
        __amdgpu_buffer_rsrc_t rsA, rsB, rsB3;
        if (MODE == 1) { const int cnt = cum[128 + e];
#pragma unroll
            for (int q = 0; q < 2; ++q) { const int pos = 256 * mt + 128 * q + (tidu >> 2); const int tok = pos < cnt ? ((const int*)(a.ws + WS_LIST))[e * 8192 + pos] : 0;
                aofs[q] = (unsigned)(tok * D + 16 * (tidu & 3)); }
            aofs[2] = aofs[3] = 0u;
            rsA = __builtin_amdgcn_make_buffer_rsrc((void*)(a.ws + WS_H2), 0, 0x7fffffff, 0x00020000);
            rsB = __builtin_amdgcn_make_buffer_rsrc((void*)(a.in[I_W1] + (size_t)e * D * DE), 0, 0x7fffffff, 0x00020000); rsB3 = __builtin_amdgcn_make_buffer_rsrc((void*)(a.in[I_W3] + (size_t)e * D * DE), 0, 0x7fffffff, 0x00020000);
            bofs = (unsigned)((bk + 8 * (bp >> 5)) * DE + 128 * nt + 4 * (bp & 31)) * 4u;
            bwr0 = MH_BROW * (2 * (bk & 3) + (bk >> 2) + 8 * (bp >> 5)) + 2 * (128 * ((bp & 31) >> 4) + 4 * (bp & 15)); }
        else {
#pragma unroll
            for (int q = 0; q < 2; ++q) aofs[q] = (unsigned)((128 * q + (tidu >> 2)) * DE + 16 * (tidu & 3));
            aofs[2] = aofs[3] = 0u;
            rsA = __builtin_amdgcn_make_buffer_rsrc((void*)((const unsigned char*)(a.ws + WS_HM) + (size_t)256 * ti * DE), 0, 0x7fffffff, 0x00020000);
            rsB = __builtin_amdgcn_make_buffer_rsrc((void*)(a.in[I_W2] + (size_t)e * DE * D), 0, 0x7fffffff, 0x00020000); rsB3 = rsB;
            bofs = (unsigned)(bk * D + 256 * nt + 4 * bp) * 4u; bwr0 = MH_BROW * (2 * (bk & 3) + (bk >> 2)) + 2 * (128 * (bp >> 5) + 32 * ((bp & 31) >> 3) + 16 * (bp & 1) + 4 * ((bp >> 1) & 3)); }
        const LAS unsigned char* blane = (const LAS unsigned char*)lds_g + MH_B + mhb_off(16 * (lane >> 5) + 8 * ((lane >> 4) & 1) + 2 * ((lane & 15) >> 2), 16 * wn + ((lane & 3) >> 1)) + 8 * (lane & 1);
        f32x4 acc[4][8];
#pragma unroll
        for (int m = 0; m < 4; ++m)
#pragma unroll
            for (int n = 0; n < 8; ++n) acc[m][n] = (f32x4){0.f, 0.f, 0.f, 0.f};
        v4u ra[4]; f32x4 rb[8];
#define MH_MMA(buf_) do { const LAS unsigned char* Bi_ = blane + (buf_) * MH_BBYTES; \
        bf16x8_t bc0_ = mhb_frag(Bi_, 0), bc1_ = mhb_frag(Bi_, 32); \
        _Pragma("unroll") for (int ks_ = 0; ks_ < 2; ++ks_) { bf16x8_t af_[4]; \
            _Pragma("unroll") for (int m_ = 0; m_ < 4; ++m_) af_[m_] = *(const bf16x8_t*)(lds_g + MH_A + (buf_) * MH_ABYTES + hh * 16384 + aoff + m_ * 2048 + ks_ * 1024); \
            _Pragma("unroll") for (int n_ = 0; n_ < 8; n_ += 2) { bf16x8_t bn0_ = bc0_, bn1_ = bc1_; \
                if (n_ + 2 < 8) { bn0_ = mhb_frag(Bi_, 32 * ks_ * MH_BROW + 32 * (n_ + 2)); bn1_ = mhb_frag(Bi_, 32 * ks_ * MH_BROW + 32 * (n_ + 3)); } \
                else if (ks_ == 0) { bn0_ = mhb_frag(Bi_, 32 * MH_BROW); bn1_ = mhb_frag(Bi_, 32 * MH_BROW + 32); } \
                __builtin_amdgcn_sched_barrier(0); \
                _Pragma("unroll") for (int m_ = 0; m_ < 4; ++m_) { acc[m_][n_] = __builtin_amdgcn_mfma_f32_16x16x32_bf16(bc0_, af_[m_], acc[m_][n_], 0, 0, 0); \
                    acc[m_][n_ + 1] = __builtin_amdgcn_mfma_f32_16x16x32_bf16(bc1_, af_[m_], acc[m_][n_ + 1], 0, 0, 0); } \
                __builtin_amdgcn_sched_barrier(0); bc0_ = bn0_; bc1_ = bn1_; } } } while (0)
        {
            const int awr = pg8::lds_byte(tidu >> 2, 16 * (tidu & 3));
#define MH_LDB(t_) do { _Pragma("unroll") for (int j_ = 0; j_ < 8; ++j_) rb[j_] = __builtin_bit_cast(f32x4, MODE == 1 ? __builtin_amdgcn_raw_buffer_load_b128((j_ & 1) ? rsB3 : rsB, bofs, (64 * (t_) + 16 * (j_ >> 1)) * DE * 4, 0) \
                                                                                                   : __builtin_amdgcn_raw_buffer_load_b128(rsB, bofs, (64 * (t_) + 8 * j_) * D * 4, 0)); } while (0)
#define MH_LDA(te_, to_) do { ra[0] = __builtin_amdgcn_raw_buffer_load_b128(rsA, aofs[0], 64 * (te_), 0); ra[1] = __builtin_amdgcn_raw_buffer_load_b128(rsA, aofs[1], 64 * (te_), 0); \
            ra[2] = __builtin_amdgcn_raw_buffer_load_b128(rsA, aofs[0], 64 * (to_), 0); ra[3] = __builtin_amdgcn_raw_buffer_load_b128(rsA, aofs[1], 64 * (to_), 0); } while (0)
#define MH_F8(w_) f8pair_lo(w_), f8pair_hi(w_)
#define MH_STA(buf_, x_) do { _Pragma("unroll") for (int h_ = 0; h_ < 2; ++h_) { const v4u p_ = ra[(x_) + h_]; \
            *(v4u*)(lds_g + MH_A + (buf_) * MH_ABYTES + h_ * 16384 + awr) = (v4u){MH_F8(p_.x), MH_F8(p_.y)}; __builtin_amdgcn_sched_barrier(0); \
            *(v4u*)(lds_g + MH_A + (buf_) * MH_ABYTES + h_ * 16384 + awr + 16) = (v4u){MH_F8(p_.z), MH_F8(p_.w)}; __builtin_amdgcn_sched_barrier(0); } } while (0)
#define MH_STB(buf_) do { _Pragma("unroll") for (int j_ = 0; j_ < 8; ++j_) { pg8::u32x2 o_; o_.x = pk2(rb[j_].x, rb[j_].y); o_.y = pk2(rb[j_].z, rb[j_].w); \
            *(pg8::u32x2*)(lds_g + MH_B + (buf_) * MH_BBYTES + bwr0 + (MODE == 1 ? (j_ >> 1) * 16 * MH_BROW + (j_ & 1) * 128 : j_ * 8 * MH_BROW)) = o_; } } while (0)
            MH_LDA(0, 1); MH_LDB(0);
            MG_BAR();
            MH_STA(0, 0); MH_STB(0);
            MH_LDB(1);
            for (int t = 0; t < NT; t += 2) {
                const int t2 = (t + 2 < NT) ? t + 2 : NT - 1, t3 = (t + 3 < NT) ? t + 3 : NT - 1;
                MG_BAR();
                MH_STA(1, 2); MH_STB(1);
                MH_LDA(t2, t3); MH_LDB(t2);
                MH_MMA(0);
                MG_BAR();
                MH_STA(0, 0); MH_STB(0);
                MH_LDB(t3);
                MH_MMA(1);
            }
#undef MH_LDB
#undef MH_LDA
#undef MH_F8
#undef MH_STA
#undef MH_STB
        }
#undef MH_MMA
        const int ln_ = fresh_lane();
        const int efr = ln_ & 15, efq = ln_ >> 4;
        if (MODE == 1) { unsigned char* HM = (unsigned char*)(a.ws + WS_HM) + (size_t)256 * ti * DE + 128 * nt + 64 * wn; const unsigned lo_ = (unsigned)((128 * hh + 64 * wr + efr) * DE + 4 * efq);
#pragma unroll
            for (int m = 0; m < 4; ++m)
#pragma unroll
                for (int n = 0; n < 4; ++n) { float hv[4];
#pragma unroll
                    for (int r = 0; r < 4; ++r) { const float a1 = acc[m][n][r]; hv[r] = a1 * sigmoidf_(a1) * acc[m][n + 4][r]; }
                    int w8 = __builtin_amdgcn_cvt_pk_fp8_f32(hv[0], hv[1], 0, false); w8 = __builtin_amdgcn_cvt_pk_fp8_f32(hv[2], hv[3], w8, true);
                    __hip_atomic_store((unsigned*)(HM + lo_ + 16 * m * DE + 16 * n), (unsigned)w8, __ATOMIC_RELAXED, __HIP_MEMORY_SCOPE_AGENT); }
            asm volatile("s_waitcnt vmcnt(0)" ::: "memory");
            if (ln_ == 0) __hip_atomic_fetch_add((unsigned*)(a.ws + WS_CTL) + CW_TC + 64 * ti, 1u, __ATOMIC_RELAXED, __HIP_MEMORY_SCOPE_AGENT); }
        else { unsigned char* Y2 = (unsigned char*)(a.ws + WS_Y2) + (size_t)256 * ti * D + 256 * nt + 128 * wn; const unsigned lo_ = (unsigned)((128 * hh + 64 * wr + efr) * D + 8 * efq);
#pragma unroll
            for (int m = 0; m < 4; ++m)
#pragma unroll
                for (int n = 0; n < 8; n += 2) { int w0_ = __builtin_amdgcn_cvt_pk_fp8_f32(acc[m][n][0], acc[m][n][1], 0, false); w0_ = __builtin_amdgcn_cvt_pk_fp8_f32(acc[m][n][2], acc[m][n][3], w0_, true);
                    int w1_ = __builtin_amdgcn_cvt_pk_fp8_f32(acc[m][n + 1][0], acc[m][n + 1][1], 0, false); w1_ = __builtin_amdgcn_cvt_pk_fp8_f32(acc[m][n + 1][2], acc[m][n + 1][3], w1_, true);
                    pg8::u32x2 o; o.x = (unsigned)w0_; o.y = (unsigned)w1_; *(pg8::u32x2*)(Y2 + lo_ + 16 * m * D + 16 * n) = o; } }
    }
#undef MG_BAR
}

__device__ __forceinline__ void phase12(const Args& a, unsigned char* lds_g, int lane, int wave) {
    const int gw = blockIdx.x * NWAVES + wave, NGW = gridDim.x * NWAVES;
    const int* cum = (const int*)(lds_g + MG_CUM);
    const bf16* X1 = (const bf16*)(a.ws + WS_X1); const float* MOD = (const float*)(a.ws + WS_MOD); const float* fg = a.in[I_FG];
    const int4* ASG = (const int4*)(a.ws + WS_ASG); const unsigned char* Y2 = (const unsigned char*)(a.ws + WS_Y2);
    for (int t = gw; t < NLAT; t += NGW) {
        const int b = t >> 11; const int4 q0 = ASG[2 * t], q1 = ASG[2 * t + 1];
        const float w0 = __int_as_float(q0.z), w1 = __int_as_float(q1.z);
        const unsigned long long* xr = (const unsigned long long*)(X1 + (size_t)t * D) + lane;
        const unsigned* y0 = (const unsigned*)(Y2 + (size_t)(256 * cum[q0.x] + q0.y) * D) + lane; const unsigned* y1 = (const unsigned*)(Y2 + (size_t)(256 * cum[q1.x] + q1.y) * D) + lane;
        f32x4 v[8]; float s = 0.f;
#pragma unroll
        for (int j = 0; j < 8; ++j) {
            const int c = 4 * lane + 256 * j;
            const f32x4 g2 = *(const f32x4*)(MOD + b * 12288 + 5 * 2048 + c);
            const unsigned a0 = y0[64 * j], a1 = y1[64 * j];
            const auto l0 = __builtin_amdgcn_cvt_pk_f32_fp8((int)a0, false), h0 = __builtin_amdgcn_cvt_pk_f32_fp8((int)a0, true), l1 = __builtin_amdgcn_cvt_pk_f32_fp8((int)a1, false), h1 = __builtin_amdgcn_cvt_pk_f32_fp8((int)a1, true);
            f32x4 y; y.x = w0 * l0[0] + w1 * l1[0]; y.y = w0 * l0[1] + w1 * l1[1]; y.z = w0 * h0[0] + w1 * h1[0]; y.w = w0 * h0[1] + w1 * h1[1];
            const unsigned long long xw = xr[64 * j];
            v[j] = (f32x4){bflo((unsigned)xw), bfhi((unsigned)xw), bflo((unsigned)(xw >> 32)), bfhi((unsigned)(xw >> 32))} + g2 * y;
            s += (v[j].x * v[j].x + v[j].y * v[j].y) + (v[j].z * v[j].z + v[j].w * v[j].w);
        }
        const float rstd = 1.f / sqrtf(wave_sum(s) * (1.f / D) + EPS);
        f32x4* o = (f32x4*)(a.out + (size_t)t * D) + lane; f32x4 fgv[8];
#pragma unroll
        for (int j = 0; j < 8; ++j) fgv[j] = *(const f32x4*)(fg + 4 * lane + 256 * j);
#pragma unroll
        for (int j = 0; j < 8; ++j) o[64 * j] = v[j] * rstd * fgv[j];
    }
}

__global__ void __launch_bounds__(NTHR, 2) fwd_kernel(Args args) {
    extern __shared__ __attribute__((aligned(16))) unsigned char lds[];
    LAS unsigned char* ldsl = (LAS unsigned char*)lds;
    volatile LAS unsigned* MISC = (volatile LAS unsigned*)(ldsl + MISC_OFF);
    LAS unsigned* TL = (LAS unsigned*)(ldsl + LDSCTL_OFF);
    const int wave_s = __builtin_amdgcn_readfirstlane(threadIdx.x >> 6);
#define TID() make_tid(wave_s)
    { const int t0 = TID(); for (int u = t0; u < (LDS_BYTES - LDSCTL_OFF) / 4; u += NTHR) ((LAS unsigned*)(ldsl + LDSCTL_OFF))[u] = 0u; }
    __syncthreads();
    unsigned char* ws = args.ws;
    unsigned* ctl = (unsigned*)(ws + WS_CTL);
    XcdBarrier bar; bar.bar = ctl + CW_BAR; bar.x = 0; bar.st = nullptr;
    const bool one_launch = (args.ph_hi - args.ph_lo) > 1;
    if (one_launch) bar = xcd_barrier_post(ctl + CW_BAR, MISC + 8, TID());
    const int lo = args.ph_lo, hi = args.ph_hi;
#define IN(k) (lo <= (k) && (k) < hi)
#define SEAM(k) do { if (IN(k) && IN((k) + 1)) xcd_barrier(bar, TID()); } while (0)
    const int G = gridDim.x, c = blockIdx.x;

#define FRESH() const int tid = TID(), lane = tid & 63, wave = __builtin_amdgcn_readfirstlane(tid >> 6); (void)lane; (void)wave
#ifndef DUP_PHASE
#define DUP_PHASE (-1)
#endif
#define PH(k, ...) if (IN(k)) { _Pragma("unroll") for (int rep_ = 0; rep_ < ((DUP_PHASE) == (k) ? 2 : 1); ++rep_) { if (rep_) xcd_barrier(bar, TID()); __VA_ARGS__ } } SEAM(k);
    PH(0, { FRESH(); phase0(args, lds, tid, lane, wave); mod_wait(args, tid); phase1(args, lane, wave); })
    PH(1, {
        SchedIn S{G, c, (const char*)(ws + WS_H), (const char*)(ws + WS_WIN)}; EpiIn E{ws, args.in[I_BGATES]};
        pg8::gemm_phase<EpiIn, SchedIn>(ldsl, D, S, E, TID());
        { const int R_ = (1492 + G - 1) / G; int fi_ = 1492 - (R_ - 1) * G; if (fi_ >= G) fi_ = 0;
          if (c >= fi_) { FRESH(); late_prep(args, lds, (c - fi_) * NWAVES + wave, (G - fi_) * NWAVES, lane, wave); } } })
    PH(2, { FRESH(); phase3(args, lds, tid); })
    PH(3, { FRESH();
        for (int u = c; u < 256; u += G) ml_out_unit(args, lds, u, tid);
        unsigned psw[2][16];
        if (c < 4 * 32 * 8) { const int q = c >> 3; lru_out_loadps(args, q >> 5, 4 + (q & 31), c & 7, __builtin_amdgcn_readfirstlane(tid >> 6) * 64 + fresh_lane(), psw); }
        for (int u = c; u < 4 * 32 * 8; u += G) { const int blk = u & 7, q = u >> 3; const int un = u + G, qn = un >> 3; const bool hn = un < 4 * 32 * 8;
            lru_out_unit(args, lds, q >> 5, 4 + (q & 31), blk, tid, psw, hn ? qn >> 5 : 0, hn ? 4 + (qn & 31) : -1, un & 7); } })
    PH(4, {
        SchedProj S{G, c, (const char*)(ws + WS_YA), (const char*)(ws + WS_YB), (const char*)(ws + WS_WPA), (const char*)(ws + WS_WPB)};
        EpiProj E{(const bf16*)(ws + WS_GA), (const bf16*)(ws + WS_GB), (bf16*)(ws + WS_PRE)};
        pg8::gemm_phase<EpiProj, SchedProj>(ldsl, 1024, S, E, TID()); })
    PH(5, {
        SchedOut S{G, c, (const char*)(ws + WS_PRE), (const char*)(ws + WS_WOUT)}; EpiOut E{args.in[I_X], (const float*)(ws + WS_MOD), (bf16*)(ws + WS_X1)};
        pg8::gemm_phase<EpiOut, SchedOut>(ldsl, D, S, E, TID()); })
    PH(6, { FRESH(); phase_router(args, lds, tid, lane, wave); })
    PH(7, { FRESH(); moe_tables(args, lds, tid); const int nx_ = moe_gemm<1>(args, lds, tid, -1); { const int tid2_ = TID(); (void)moe_gemm<2>(args, lds, tid2_, nx_); } })
    PH(8, { FRESH(); moe_tables(args, lds, tid); phase12(args, lds, lane, wave); })
#undef PH
#undef IN
#undef SEAM
}

extern "C" void kernel_launch(void* const* d_in, const int* in_sizes, int n_in, void* d_out, int out_size, void* d_ws, size_t ws_size, hipStream_t stream) {
    static int grid = 0;
    if (grid == 0) {
        if (n_in != 27 || out_size != NLAT * D || ws_size < WS_END) { fprintf(stderr, "kernel_launch: unexpected shapes (n_in %d, out %d, ws %zu)\n", n_in, out_size, ws_size); grid = -1; return; }
        int dev = 0, cus = 0, per_cu = 0;
        if (hipGetDevice(&dev) != hipSuccess || hipDeviceGetAttribute(&cus, hipDeviceAttributeMultiprocessorCount, dev) != hipSuccess) { grid = -1; return; }
        if (hipFuncSetAttribute((const void*)fwd_kernel, hipFuncAttributeMaxDynamicSharedMemorySize, LDS_BYTES) != hipSuccess) { fprintf(stderr, "kernel_launch: hipFuncSetAttribute failed\n"); grid = -1; return; }
        if (hipOccupancyMaxActiveBlocksPerMultiprocessor(&per_cu, (const void*)fwd_kernel, NTHR, LDS_BYTES) != hipSuccess || per_cu < 1) fprintf(stderr, "kernel_launch: occupancy query says %d\n", per_cu);
        (void)hipGetLastError();
        grid = cus;
    }
    if (grid < 0) return;
    (void)hipMemsetAsync((char*)d_ws + WS_CTL, 0, CTL_ZERO_BYTES, stream);
    Args a{};
    for (int i = 0; i < 27; ++i) a.in[i] = (const float*)d_in[i];
    a.out = (float*)d_out; a.ws = (unsigned char*)d_ws;
#if MK_ONE_LAUNCH
    a.ph_lo = 0; a.ph_hi = NPHASE;
    hipLaunchKernelGGL(fwd_kernel, dim3(grid), dim3(NTHR), LDS_BYTES, stream, a);
#else
    for (int p = 0; p < NPHASE; ++p) { a.ph_lo = p; a.ph_hi = p + 1; hipLaunchKernelGGL(fwd_kernel, dim3(grid), dim3(NTHR), LDS_BYTES, stream, a); }
#endif
}
```

```cpp
#include <hip/hip_runtime.h>
#include <cstdio>
#include <cstdint>

#ifndef MK_ONE_LAUNCH
#define MK_ONE_LAUNCH 1
#endif

namespace pg8 {
#define PG8_LAS __attribute__((address_space(3)))
typedef unsigned short bf16_t;
typedef short bf16x8 __attribute__((ext_vector_type(8)));
typedef float f32x4 __attribute__((ext_vector_type(4)));
typedef float f32x2 __attribute__((ext_vector_type(2)));
typedef unsigned u32x4 __attribute__((ext_vector_type(4)));
typedef unsigned u32x2 __attribute__((ext_vector_type(2)));
constexpr int BM = 256, BK = 64, HALF = 128, HTB = HALF * BK * 2  , STAGE_BYTES = 8 * HTB, NXCD = 8, WGM = 8;

__host__ __device__ __forceinline__ int lds_byte(int r, int c) { const int st = (r >> 4) * 2 + (c >> 5), rr = r & 15, cc = c & 31, ob = rr * 64 + cc * 2; return st * 1024 + (ob ^ (((ob >> 9) & 1) << 5)); }
__host__ __device__ __forceinline__ void stage_rc(int b, int& R, int& C) { const int st = b / 1024, sb = b % 1024, swz = sb ^ (((sb >> 9) & 1) << 5); R = (st >> 1) * 16 + swz / 64; C = (st & 1) * 32 + (swz % 64) / 2; }
__host__ __device__ __forceinline__ int perm32(int rho) { const int n = rho >> 4, i = rho & 15; return 8 * (i >> 2) + 4 * n + (i & 3); }

struct Unit { const char* A; const char* B; int pm, pn, aux; };

__host__ __device__ __forceinline__ void tile_order(int L, int nM, int nN, int& pm, int& pn) {
    const int nwg = nM * nN; int wgid = L;
    { const int q = nwg / NXCD, r = nwg % NXCD, xcd = wgid % NXCD, off = wgid / NXCD; wgid = (xcd < r ? xcd * (q + 1) : r * (q + 1) + (xcd - r) * q) + off; }
    const int nig = WGM * nN, gid = wgid / nig, fm = gid * WGM, gsz = (nM - fm) < WGM ? (nM - fm) : WGM;
    pm = fm + ((wgid % nig) % gsz); pn = (wgid % nig) / gsz;
}

typedef __bf16 bf16n2 __attribute__((ext_vector_type(2)));
__device__ __forceinline__ unsigned cvt_pk_bf16(float lo, float hi) { const f32x2 v = {lo, hi}; return __builtin_bit_cast(unsigned, __builtin_convertvector(v, bf16n2)); }

template <class Epi, class Sched>
__device__ __forceinline__ void gemm_phase(PG8_LAS unsigned char* lds, const int K, const Sched& S, const Epi& E, int tid) {
    const int wid = __builtin_amdgcn_readfirstlane(tid >> 6), lane = tid & 63, wr = wid >> 2, wc = wid & 3, fr = lane & 15, fq = lane >> 4;
    const int nt = K / BK;
    unsigned voffA[2], voffB[2];
#pragma unroll
    for (int i = 0; i < 2; ++i) { int R, C; stage_rc(tid * 16 + i * 8192, R, C); const int Rb = Epi::PERM ? ((R & ~31) + perm32(R & 31)) : R;
        voffA[i] = (unsigned)(R * K + C) * 2u; voffB[i] = (unsigned)(Rb * K + C) * 2u; }
    const size_t kstep = (size_t)(BK * 2);
    const size_t hstep = (size_t)HALF * K * 2;
    const unsigned ldsw = (unsigned)wid * 1024u;
    const int aoff = lds_byte(wr * 64 + fr, fq * 8), boff = lds_byte(wc * 32 + fr, fq * 8);
#define PG8_SA(b, h) (((b) * 2 + (h)) * HTB)
#define PG8_SB(b, h) ((4 + (b) * 2 + (h)) * HTB)
#define PG8_STAGE(bufoff, gbase, voff) do { _Pragma("unroll") for (int _i = 0; _i < 2; ++_i) \
        __builtin_amdgcn_global_load_lds((const unsigned*)((const char*)(gbase) + (voff)[_i]), (PG8_LAS unsigned*)(lds + (bufoff) + ldsw + _i * 8192), 16, 0, 0); } while (0)
#define PG8_LDA(dst, b, h) do { _Pragma("unroll") for (int m = 0; m < 4; ++m) _Pragma("unroll") for (int k = 0; k < 2; ++k) dst[m][k] = *(const PG8_LAS bf16x8*)(lds + PG8_SA(b, h) + aoff + m * 2048 + k * 1024); } while (0)
#define PG8_LDB(dst, b, h) do { _Pragma("unroll") for (int n = 0; n < 2; ++n) _Pragma("unroll") for (int k = 0; k < 2; ++k) dst[n][k] = *(const PG8_LAS bf16x8*)(lds + PG8_SB(b, h) + boff + n * 2048 + k * 1024); } while (0)
#define PG8_MMA(ai, bj, At, Bt) do { __builtin_amdgcn_s_setprio(1); _Pragma("unroll") for (int m = 0; m < 4; ++m) _Pragma("unroll") for (int n = 0; n < 2; ++n) _Pragma("unroll") for (int k = 0; k < 2; ++k) \
        acc[ai][bj][m][n] = __builtin_amdgcn_mfma_f32_16x16x32_bf16(Bt[n][k], At[m][k], acc[ai][bj][m][n], 0, 0, 0); __builtin_amdgcn_s_setprio(0); } while (0)
#define PG8_WAIT_V(n) asm volatile("s_waitcnt vmcnt(" #n ")" ::: "memory")
#define PG8_WAIT_L(n) asm volatile("s_waitcnt lgkmcnt(" #n ")" ::: "memory")
#define PG8_BAR __builtin_amdgcn_s_barrier()
#define PG8_SCHED __builtin_amdgcn_sched_barrier(0)
    Unit cur, nxt; int ui = 0;
    if (!S.next(0, cur)) return;
    f32x4 acc[2][2][4][2];
#pragma unroll
    for (int a = 0; a < 2; ++a)
#pragma unroll
        for (int b = 0; b < 2; ++b)
#pragma unroll
            for (int m = 0; m < 4; ++m)
#pragma unroll
                for (int n = 0; n < 2; ++n) acc[a][b][m][n] = (f32x4){0.f, 0.f, 0.f, 0.f};
    bf16x8 At[4][2], B0[2][2], B1[2][2];
    const char* cA = cur.A; const char* cB = cur.B;
    PG8_STAGE(PG8_SB(0, 0), cB, voffB); PG8_STAGE(PG8_SB(0, 1), cB + hstep, voffB); PG8_STAGE(PG8_SA(0, 0), cA, voffA); PG8_STAGE(PG8_SA(0, 1), cA + hstep, voffA);
    if (wr == 1) PG8_BAR;
    PG8_WAIT_V(2); PG8_BAR;
    PG8_STAGE(PG8_SB(1, 0), cB + kstep, voffB); PG8_STAGE(PG8_SA(1, 0), cA + kstep, voffA); PG8_STAGE(PG8_SB(1, 1), cB + hstep + kstep, voffB);
    PG8_WAIT_V(6); PG8_BAR;
    for (;;) {
        const bool has_next = S.next(ui + 1, nxt);
        const char* nA = has_next ? nxt.A : cA; const char* nB = has_next ? nxt.B : cB;
        for (int t = 0; t < nt; t += 2) {
            const bool last = (t == nt - 2);
            const char* a1 = cA + (size_t)(t + 1) * kstep;
            const char* a2 = last ? nA : cA + (size_t)(t + 2) * kstep; const char* b2 = last ? nB : cB + (size_t)(t + 2) * kstep;
            const char* a3 = a2 + kstep; const char* b3 = b2 + kstep;
            PG8_LDB(B0, 0, 0); PG8_LDB(B1, 0, 1); PG8_SCHED; PG8_LDA(At, 0, 0); PG8_STAGE(PG8_SA(1, 1), a1 + hstep, voffA);
            PG8_WAIT_V(8); PG8_WAIT_L(0); PG8_BAR; PG8_MMA(0, 0, At, B0); PG8_MMA(0, 1, At, B1); PG8_BAR; PG8_SCHED;
            PG8_LDA(At, 0, 1); PG8_STAGE(PG8_SB(0, 0), b2, voffB); PG8_STAGE(PG8_SB(0, 1), b2 + hstep, voffB); PG8_STAGE(PG8_SA(0, 0), a2, voffA);
            PG8_WAIT_V(8); PG8_WAIT_L(0); PG8_BAR; PG8_MMA(1, 0, At, B0); PG8_MMA(1, 1, At, B1); PG8_BAR; PG8_SCHED;
            PG8_LDB(B0, 1, 0); PG8_LDB(B1, 1, 1); PG8_SCHED; PG8_LDA(At, 1, 0); PG8_STAGE(PG8_SA(0, 1), a2 + hstep, voffA);
            PG8_WAIT_V(8); PG8_WAIT_L(0); PG8_BAR; PG8_MMA(0, 0, At, B0); PG8_MMA(0, 1, At, B1); PG8_BAR; PG8_SCHED;
            PG8_LDA(At, 1, 1); PG8_STAGE(PG8_SB(1, 0), b3, voffB); PG8_STAGE(PG8_SB(1, 1), b3 + hstep, voffB); PG8_STAGE(PG8_SA(1, 0), a3, voffA);
            PG8_WAIT_V(8); PG8_WAIT_L(0); PG8_BAR; PG8_MMA(1, 0, At, B0); PG8_MMA(1, 1, At, B1); PG8_BAR; PG8_SCHED;
        }
        if (wr == 0) PG8_BAR;
        { int fr_ = fr, fq_ = fq; asm volatile("" : "+v"(fr_), "+v"(fq_)); E(acc, cur, wr, wc, fr_, fq_); }
        if (!has_next) break;
        if (!(Epi::CARRY && E.keep(cur))) {
#pragma unroll
        for (int a = 0; a < 2; ++a)
#pragma unroll
            for (int b = 0; b < 2; ++b)
#pragma unroll
                for (int m = 0; m < 4; ++m)
#pragma unroll
                    for (int n = 0; n < 2; ++n) acc[a][b][m][n] = (f32x4){0.f, 0.f, 0.f, 0.f};
        }
        cur = nxt; cA = nA; cB = nB; ++ui;
        if (wr == 1) PG8_BAR;
    }
    PG8_WAIT_V(0);
    PG8_BAR;
#undef PG8_SA
#undef PG8_SB
#undef PG8_STAGE
#undef PG8_LDA
#undef PG8_LDB
#undef PG8_MMA
#undef PG8_WAIT_V
#undef PG8_WAIT_L
#undef PG8_BAR
#undef PG8_SCHED
}
}

constexpr int NWAVES = 8, NTHR = 512;
constexpr int D = 2048, NB = 4, SEQ = 2048, CTXL = 256, NCTX = NB * CTXL  , NLAT = NB * SEQ  , NTOK = NCTX + NLAT  ;
constexpr int NSTEP = CTXL + SEQ;
constexpr int HEADS = 8, HD = 128, MW = 1024, LW = 1024;
constexpr int NEXP = 32, DE = 1024;
constexpr int IN_DIM = 11296, NT_IN = 45;
constexpr float EPS = 1e-6f;
constexpr int MAXTILES = 96;
constexpr int NPHASE = 9;

constexpr size_t MiB = 1u << 20;
constexpr size_t WS_CTL = 0, CTL_ZERO_BYTES = 1 * MiB;
constexpr size_t WS_MOD = 1 * MiB;
constexpr size_t WS_GATES = 2 * MiB;
constexpr size_t WS_ASG = 4 * MiB + 512 * 1024;
constexpr size_t WS_LIST = 3 * MiB + 512 * 1024;
constexpr size_t WS_WR = 6 * MiB;
constexpr size_t WS_RB = 7 * MiB + 768 * 1024;
constexpr size_t WS_WL = 5 * MiB;
constexpr size_t WS_AGG = 978 * MiB;
constexpr size_t WS_WPA = 8 * MiB, WS_WPB = 12 * MiB, WS_WOUT = 16 * MiB, WS_WIN = 24 * MiB;
constexpr size_t WS_W13 = 72 * MiB, WS_W2 = 328 * MiB;
constexpr size_t WS_PS = 72 * MiB;
constexpr size_t WS_H = 456 * MiB;
constexpr size_t WS_K = 492 * MiB, WS_V = 510 * MiB, WS_UX = 528 * MiB;
constexpr size_t WS_Q = 546 * MiB, WS_OF = 562 * MiB, WS_OB = 578 * MiB, WS_UG = 594 * MiB;
constexpr size_t WS_GA = 610 * MiB, WS_GB = 642 * MiB;
constexpr size_t WS_LA = 674 * MiB, WS_LB = 746 * MiB;
constexpr size_t WS_HS = 818 * MiB, WS_TM = 882 * MiB;
constexpr size_t WS_YA = 946 * MiB, WS_YB = 962 * MiB;
constexpr size_t WS_BT = 982 * MiB;
constexpr size_t WS_SLOC = 984 * MiB;
constexpr size_t WS_END = 1022 * MiB;
constexpr size_t WS_PRE = WS_LA;
constexpr size_t WS_X1 = WS_LB;
constexpr size_t WS_H2 = WS_H;
constexpr size_t WS_XS = WS_K;
constexpr size_t WS_HM = 588 * MiB;
constexpr size_t WS_Y2 = WS_HS;
constexpr int CW_MODC = 32;
constexpr int CW_CNT = 64;
constexpr int CW_NT = 128;
constexpr int CW_TILE_E = 192;
constexpr int CW_BAR = 4096;
constexpr int CW_Q = 8192;
constexpr int CW_TC = 16384;

constexpr int RING_BYTES = 131072;
constexpr int LDSCTL_OFF = 143360;
constexpr int MISC_OFF = LDSCTL_OFF + 384;
constexpr int LDS_BYTES = 147456;

#define GAS __attribute__((address_space(1)))
#define LAS __attribute__((address_space(3)))
typedef unsigned short bf16;
typedef unsigned v4u __attribute__((ext_vector_type(4)));
typedef float f32x4 __attribute__((ext_vector_type(4)));
#define LDS_WAIT() asm volatile("s_waitcnt lgkmcnt(0)" ::: "memory")
#define WG_BAR() do { asm volatile("s_waitcnt lgkmcnt(0)" ::: "memory"); __builtin_amdgcn_s_barrier(); asm volatile("" ::: "memory"); } while (0)

__device__ __forceinline__ unsigned f2bf(float f) { unsigned u = __builtin_bit_cast(unsigned, f); return (u + 0x7fffu + ((u >> 16) & 1u)) >> 16; }
__device__ __forceinline__ unsigned pk2(float lo, float hi) { return pg8::cvt_pk_bf16(lo, hi); }
__device__ __forceinline__ float bf2f(unsigned h) { return __builtin_bit_cast(float, h << 16); }
__device__ __forceinline__ float bflo(unsigned w) { return __builtin_bit_cast(float, w << 16); }
__device__ __forceinline__ float bfhi(unsigned w) { return __builtin_bit_cast(float, w & 0xffff0000u); }
__device__ __forceinline__ float sigmoidf_(float x) { return __builtin_amdgcn_rcpf(1.f + __expf(-x)); }
__device__ __forceinline__ float gelu_tanh(float x) { const float u = 0.7978845608028654f * (x + 0.044715f * x * x * x); return x * __builtin_amdgcn_rcpf(1.f + __expf(-2.f * u)); }
__device__ __forceinline__ float wave_sum(float v) {
#pragma unroll
    for (int o = 1; o < 64; o <<= 1) v += __shfl_xor(v, o);
    return v;
}

#define XB_TMO      128
#define XB_XCNT(j)  (256  + 64 * (j))
#define XB_XSUB(j)  (1280 + 64 * (j))
#define XB_XGEN(j)  (2304 + 64 * (j))
#define XB_TOP      3328
#define XB_TOPGEN   3392
#define XCD_BAR_WORDS 3456
#define XB_SPIN_CAP (1u << 23)
__device__ __forceinline__ unsigned xb_ld(unsigned* p)              { return __hip_atomic_load(p, __ATOMIC_RELAXED, __HIP_MEMORY_SCOPE_AGENT); }
__device__ __forceinline__ unsigned xb_add(unsigned* p, unsigned v) { return __hip_atomic_fetch_add(p, v, __ATOMIC_RELAXED, __HIP_MEMORY_SCOPE_AGENT); }
__device__ __forceinline__ unsigned xb_xcc_id() { return (unsigned)__builtin_amdgcn_s_getreg((3 << 11) | 20) & 0xFu; }
#define XB_SPIN(cond, bar) do { unsigned _sp = 0; while (cond) { __builtin_amdgcn_s_sleep(1); \
    if ((++_sp & 255u) == 0u) { if (xb_ld(&(bar)[XB_TMO])) break; if (_sp > XB_SPIN_CAP) { atomicAdd(&(bar)[XB_TMO], 1u); break; } } } } while (0)
struct XcdBarrier { unsigned* bar; unsigned x; volatile LAS unsigned* st; };
__device__ __forceinline__ XcdBarrier xcd_barrier_post(unsigned* bar, volatile LAS unsigned* st, int tid) {
    XcdBarrier b; b.bar = bar; b.x = xb_xcc_id(); b.st = st;
    if (tid == 0) (void)xb_add(&bar[XB_XCNT(b.x)], 1u);
    return b;
}
__device__ __forceinline__ void xcd_barrier_complete(unsigned* bar, unsigned x, unsigned& nloc, unsigned& nx) {
    const unsigned G = gridDim.x * gridDim.y * gridDim.z;
    unsigned sum, cnt, mine, sp = 0u;
    for (;;) {
        sum = 0u; cnt = 0u; mine = 0u;
#pragma unroll
        for (unsigned j = 0; j < 16; ++j) { const unsigned c = xb_ld(&bar[XB_XCNT(j)]); sum += c; cnt += (c > 0u) ? 1u : 0u; mine = (j == x) ? c : mine; }
        if (sum == G) break;
        __builtin_amdgcn_s_sleep(1);
        if ((++sp & 255u) == 0u) { if (xb_ld(&bar[XB_TMO])) break; if (sp > XB_SPIN_CAP) { atomicAdd(&bar[XB_TMO], 1u); break; } }
    }
    nloc = mine > 0u ? mine : 1u; nx = cnt > 0u ? cnt : 1u;
}
__device__ __forceinline__ void xcd_barrier(const XcdBarrier& b, int tid) {
    asm volatile("s_waitcnt vmcnt(0)" ::: "memory");
    __syncthreads();
    if (tid == 0) {
        unsigned* bar = b.bar;
        __builtin_amdgcn_s_waitcnt(0);
        unsigned nloc = b.st[0], nx = b.st[1];
        if (nloc == 0u) { xcd_barrier_complete(bar, b.x, nloc, nx); b.st[0] = nloc; b.st[1] = nx; }
        const unsigned old = xb_add(&bar[XB_XSUB(b.x)], 1u);
        const unsigned gen = old / nloc;
        if (old + 1u == (gen + 1u) * nloc) {
            __builtin_amdgcn_fence(__ATOMIC_RELEASE, "agent");
            asm volatile("s_waitcnt vmcnt(0)" ::: "memory");
            const unsigned og = xb_add(&bar[XB_TOP], 1u);
            const unsigned tg = og / nx;
            if (og + 1u == (tg + 1u) * nx) xb_add(&bar[XB_TOPGEN], 1u);
            else XB_SPIN(xb_ld(&bar[XB_TOPGEN]) == tg, bar);
            __builtin_amdgcn_fence(__ATOMIC_ACQUIRE, "agent");
            xb_add(&bar[XB_XGEN(b.x)], 1u);
            asm volatile("s_waitcnt vmcnt(0)" ::: "memory");
        } else {
            XB_SPIN(xb_ld(&bar[XB_XGEN(b.x)]) == gen, bar);
            __builtin_amdgcn_fence(__ATOMIC_ACQUIRE, "agent");
            asm volatile("s_waitcnt vmcnt(0)" ::: "memory");
        }
    }
    __syncthreads();
}

__device__ __forceinline__ int make_tid(int wave_s) { int l; asm volatile("v_mbcnt_lo_u32_b32 %0, -1, 0\n\tv_mbcnt_hi_u32_b32 %0, -1, %0" : "=v"(l)); __builtin_assume(l >= 0 && l < 64); __builtin_assume(wave_s >= 0 && wave_s < 8); return wave_s * 64 + l; }
__device__ __forceinline__ int fresh_lane() { int l; asm volatile("v_mbcnt_lo_u32_b32 %0, -1, 0\n\tv_mbcnt_hi_u32_b32 %0, -1, %0" : "=v"(l)); __builtin_assume(l >= 0 && l < 64); return l; }
struct Args { const float* in[27]; float* out; unsigned char* ws; int ph_lo, ph_hi; };
enum { I_X = 0, I_C, I_CTX, I_CCTX, I_WMOD, I_BMOD, I_N1G, I_WIN, I_BGATES, I_HEADG, I_CONVW, I_CONVB, I_LWA, I_LBA, I_LWX, I_LBX, I_LAM, I_WPA, I_WPB, I_WOUT, I_N2G, I_WRG, I_WRE, I_W1, I_W3, I_W2, I_FG };

__device__ __forceinline__ void tr_item(const float* __restrict__ W, size_t ldw, int k0, int n0, bf16* dst, size_t ldd, float scale, LAS float* scr, int lane) {
#pragma unroll 16
    for (int i = 0; i < 32; ++i) { const int kk = 2 * i + (lane >> 5); scr[kk * 33 + (lane & 31)] = W[(size_t)(k0 + kk) * ldw + n0 + (lane & 31)]; }
    LDS_WAIT(); asm volatile("" ::: "memory");
    const int c = lane & 7;
#pragma unroll
    for (int j = 0; j < 4; ++j) { const int n = (lane >> 3) + 8 * j; const LAS float* s = scr + (8 * c) * 33 + n;
        v4u o; o.x = pk2(s[0 * 33] * scale, s[1 * 33] * scale); o.y = pk2(s[2 * 33] * scale, s[3 * 33] * scale); o.z = pk2(s[4 * 33] * scale, s[5 * 33] * scale); o.w = pk2(s[6 * 33] * scale, s[7 * 33] * scale);
        *(GAS v4u*)(dst + (size_t)n * ldd + 8 * c) = o; }
    LDS_WAIT(); asm volatile("" ::: "memory");
}
__device__ __forceinline__ int win_row(int n0, float& scale) {
    scale = 1.f;
    if (n0 < 1024) return 13 * 256 + n0;
    if (n0 < 2048) { scale = 0.08838834764831845f; return n0 - 1024; }
    if (n0 < 3072) return 4 * 256 + (n0 - 2048);
    if (n0 < 4096) return 17 * 256 + (n0 - 3072);
    if (n0 < 5120) return 21 * 256 + (n0 - 4096);
    if (n0 < 5152) return 12 * 256 + (n0 - 5120);
    if (n0 < 6176) return 8 * 256 + (n0 - 5152);
    if (n0 < 7200) return 25 * 256 + (n0 - 6176);
    if (n0 < 9248) return 29 * 256 + (n0 - 7200);
    return 37 * 256 + (n0 - 9248);
}

__device__ __forceinline__ void phase0(const Args& a, unsigned char* lds_g, int tid, int lane, int wave) {
    unsigned char* ws = a.ws;
    {
        float* sl = (float*)lds_g;
        float* red = sl + 5 * 2048;
        for (int i = tid; i < 5 * 2048; i += NTHR) { const int r = i >> 11, k = i & 2047; const float v = r < 4 ? a.in[I_C][r * 2048 + k] : a.in[I_CCTX][k]; sl[i] = v / (1.f + __expf(-v)); }
        __syncthreads();
        const float* wm = a.in[I_WMOD]; const float* bm = a.in[I_BMOD]; float* MOD = (float*)(ws + WS_MOD);
        for (int cb = blockIdx.x; cb < 256; cb += gridDim.x) {
            const int n0 = cb * 48;
            if (tid < 504) {
                const int kq = tid / 12, cg = tid % 12;
                f32x4 acc[5];
#pragma unroll
                for (int r = 0; r < 5; ++r) acc[r] = (f32x4){0.f, 0.f, 0.f, 0.f};
#pragma unroll 7
                for (int k = kq; k < 2048; k += 42) {
                    const f32x4 w = *(const f32x4*)(wm + (size_t)k * 12288 + n0 + 4 * cg);
#pragma unroll
                    for (int r = 0; r < 5; ++r) acc[r] += w * sl[r * 2048 + k];
                }
#pragma unroll
                for (int r = 0; r < 5; ++r) *(f32x4*)(red + tid * 20 + r * 4) = acc[r];
            }
            __syncthreads();
            if (tid < 240) {
                const int cg = tid / 20, rj = tid % 20; float s = 0.f;
                for (int kq = 0; kq < 42; ++kq) s += red[(kq * 12 + cg) * 20 + rj];
                const int r = rj >> 2, j = rj & 3, n = n0 + 4 * cg + j;
                __hip_atomic_store(MOD + r * 12288 + n, s + bm[n], __ATOMIC_RELAXED, __HIP_MEMORY_SCOPE_AGENT);
            }
            __syncthreads();
        }
        if (tid == 0) __hip_atomic_fetch_add((unsigned*)(ws + WS_CTL) + CW_MODC, 1u, __ATOMIC_RELAXED, __HIP_MEMORY_SCOPE_AGENT);
    }
    {
        LAS float* scr = (LAS float*)((LAS unsigned char*)lds_g) + wave * 4096;
        const int gw = blockIdx.x * NWAVES + wave, NGW = gridDim.x * NWAVES;
        constexpr int J0 = 32 * 353, J1 = 16 * 64, J3 = 32 * 64;
        constexpr int JL = 256;
        constexpr int NITEMS = J0 + 2 * J1;
        (void)J3; (void)JL;
        for (int it = gw; it < NITEMS; it += NGW) {
            int r = it;
            if (r < J0) { const int kb = r / 353, nb = r % 353; float sc; const int row = win_row(32 * nb, sc);
                tr_item(a.in[I_WIN], IN_DIM, 64 * kb, 32 * nb, (bf16*)(ws + WS_WIN) + (size_t)row * 2048 + 64 * kb, 2048, sc, scr, lane); continue; } r -= J0;
            if (r < J1) { const int kb = r / 64, nb = r % 64; tr_item(a.in[I_WPA], 2048, 64 * kb, 32 * nb, (bf16*)(ws + WS_WPA) + (size_t)(32 * nb) * 1024 + 64 * kb, 1024, 1.f, scr, lane); continue; } r -= J1;
            if (r < J1) { const int kb = r / 64, nb = r % 64; tr_item(a.in[I_WPB], 2048, 64 * kb, 32 * nb, (bf16*)(ws + WS_WPB) + (size_t)(32 * nb) * 1024 + 64 * kb, 1024, 1.f, scr, lane); continue; }
        }
        { GAS v4u* z = (GAS v4u*)((bf16*)(ws + WS_WIN) + (size_t)(12 * 256 + 32) * 2048); const int nchunks = 224 * 256;
          for (int i = blockIdx.x * NTHR + tid; i < nchunks; i += gridDim.x * NTHR) z[i] = (v4u){0u, 0u, 0u, 0u}; }
    }
}

__device__ __forceinline__ void late_prep(const Args& a, unsigned char* lds_g, int gw, int NGW, int lane, int wave) {
    unsigned char* ws = a.ws;
    {
        LAS float* scr = (LAS float*)((LAS unsigned char*)lds_g) + wave * 4096;
        constexpr int J3 = 32 * 64, JL = 256;
        for (int it = gw; it < J3 + JL; it += NGW) {
            int r = it;
            if (r >= J3) { r -= J3; const int mi = r >> 3, kb = (r >> 2) & 1, nb = r & 3, dir = mi >> 4, mat = (mi >> 3) & 1, blk = mi & 7;
                tr_item(a.in[mat ? I_LWX : I_LWA] + (size_t)(dir * 8 + blk) * 128 * 128, 128, 64 * kb, 32 * nb, (bf16*)(ws + WS_WL) + ((size_t)((dir * 2 + mat) * 8 + blk) * 128 + 32 * nb) * 128 + 64 * kb, 128, 1.f, scr, lane); continue; }
            const int kb = r / 64, nb = r % 64; tr_item(a.in[I_WOUT], 2048, 64 * kb, 32 * nb, (bf16*)(ws + WS_WOUT) + (size_t)(32 * nb) * 2048 + 64 * kb, 2048, 1.f, scr, lane);
        }
    }
    {
        const float* MODr = (const float*)(a.ws + WS_MOD); bf16* WRh = (bf16*)(a.ws + WS_WR); bf16* WRl = WRh + 4 * 48 * 2048; float* RB = (float*)(a.ws + WS_RB);
        for (int idx = gw * 64 + lane; idx < 4 * 48 * 2048; idx += NGW * 64) { const int k = idx & 2047, j = (idx >> 11) % 48, b = idx / (48 * 2048);
            const float gm = a.in[I_N2G][k] * (1.f + MODr[b * 12288 + 4 * 2048 + k]);
            const float wv = j < 32 ? a.in[I_WRE][(size_t)k * 32 + j] : (j < 36 ? a.in[I_WRG][(size_t)k * 4 + (j - 32)] : 0.f);
            const float v_ = gm * wv; const unsigned hi_ = f2bf(v_); WRh[idx] = (bf16)hi_; WRl[idx] = (bf16)f2bf(v_ - bf2f(hi_)); }
        for (int q = gw; q < 4 * 48; q += NGW) { const int b = q / 48, j = q % 48; float sacc = 0.f;
            if (j < 36) { for (int k = lane; k < 2048; k += 64) { const float wv = j < 32 ? a.in[I_WRE][(size_t)k * 32 + j] : a.in[I_WRG][(size_t)k * 4 + (j - 32)]; sacc += MODr[b * 12288 + 3 * 2048 + k] * wv; } }
            sacc = wave_sum(sacc); if (lane == 0) RB[q] = sacc; }
    }
}
__device__ __forceinline__ void mod_wait(const Args& a, int tid) {
    if (tid < 64) { unsigned* mc = (unsigned*)(a.ws + WS_CTL) + CW_MODC; unsigned spins = 0;
        while ((unsigned)__builtin_amdgcn_readfirstlane(__hip_atomic_load(mc, __ATOMIC_RELAXED, __HIP_MEMORY_SCOPE_AGENT)) < gridDim.x) {
            __builtin_amdgcn_s_sleep(2);
            if (++spins > (1u << 22)) { if (tid == 0) __hip_atomic_store((unsigned*)(a.ws + WS_CTL) + 1, 0x800u, __ATOMIC_RELAXED, __HIP_MEMORY_SCOPE_AGENT); break; } }
        __builtin_amdgcn_fence(__ATOMIC_ACQUIRE, "agent");
        asm volatile("s_waitcnt vmcnt(0)" ::: "memory"); }
    __syncthreads();
}
__device__ __forceinline__ void phase1(const Args& a, unsigned char* lds_g, int lane, int wave) {
    const int gw = blockIdx.x * NWAVES + wave, NGW = gridDim.x * NWAVES;
    const float* MOD = (const float*)(a.ws + WS_MOD); const float* g = a.in[I_N1G];
    bf16* H = (bf16*)(a.ws + WS_H);
#define P1_PARAMS(mr_) do { _Pragma("unroll") for (int j = 0; j < 8; ++j) { const int c = 4 * lane + 256 * j; \
        const f32x4 gg = *(const f32x4*)(g + c), sc = *(const f32x4*)(MOD + (mr_) * 12288 + 2048 + c); pscale[j] = gg * (sc + 1.f); pshift[j] = *(const f32x4*)(MOD + (mr_) * 12288 + c); } } while (0)
#define P1_ROW(r_) do { const int rr_ = (r_); const float* src = rr_ < NCTX ? a.in[I_CTX] + (size_t)rr_ * D : a.in[I_X] + (size_t)(rr_ - NCTX) * D; \
        const f32x4* xr = (const f32x4*)src + lane; f32x4 v[8]; float s = 0.f; \
        _Pragma("unroll") for (int j = 0; j < 8; ++j) { v[j] = xr[64 * j]; s += (v[j].x * v[j].x + v[j].y * v[j].y) + (v[j].z * v[j].z + v[j].w * v[j].w); } \
        const float rstd = 1.f / sqrtf(wave_sum(s) * (1.f / D) + EPS); \
        unsigned long long* o8 = (unsigned long long*)(H + (size_t)rr_ * D) + lane; \
        _Pragma("unroll") for (int j = 0; j < 8; ++j) { v[j] = v[j] * rstd * pscale[j] + pshift[j]; o8[64 * j] = (unsigned long long)pk2(v[j].x, v[j].y) | ((unsigned long long)pk2(v[j].z, v[j].w) << 32); } } while (0)
    f32x4 pscale[8], pshift[8];
    const bool shp = gridDim.x == 256; f32x4* PSH = (f32x4*)lds_g;
    if (shp) { const int t_ = wave * 64 + lane, c_ = 4 * t_;
#pragma unroll
        for (int s_ = 0; s_ < 2; ++s_) { const int r_ = s_ ? NTOK - 1 : 32 * (int)blockIdx.x, m_ = r_ < NCTX ? 4 : (r_ - NCTX) / SEQ;
            const f32x4 gg = *(const f32x4*)(g + c_), sc = *(const f32x4*)(MOD + m_ * 12288 + 2048 + c_); PSH[s_ * 1024 + t_] = gg * (sc + 1.f); PSH[s_ * 1024 + 512 + t_] = *(const f32x4*)(MOD + m_ * 12288 + c_); }
        __syncthreads(); }
#define P1_PARAMS_L(s_) do { _Pragma("unroll") for (int j = 0; j < 8; ++j) { pscale[j] = PSH[(s_) * 1024 + lane + 64 * j]; pshift[j] = PSH[(s_) * 1024 + 512 + lane + 64 * j]; } } while (0)
    for (int ch = gw; ch < NTOK / 4; ch += NGW) {
        if (NGW * 4 < NTOK && ch >= NGW) break;
        const int r0 = 4 * ch, mr = r0 < NCTX ? 4 : (r0 - NCTX) / SEQ;
        if (shp) P1_PARAMS_L(0); else P1_PARAMS(mr);
#pragma unroll 1
        for (int k = 0; k < 4; ++k) P1_ROW(r0 + k);
    }
    if (NGW * 4 < NTOK) for (int r = 4 * NGW + gw; r < NTOK; r += NGW) { const int mr = r < NCTX ? 4 : (r - NCTX) / SEQ; if (shp) P1_PARAMS_L(1); else P1_PARAMS(mr); P1_ROW(r); }
#undef P1_PARAMS
#undef P1_PARAMS_L
#undef P1_ROW
}

struct SchedIn {
    int G, c; const char* A; const char* B;
    __device__ __forceinline__ bool next(int i, pg8::Unit& u) const {
        const int L = i * G + c; if (L >= 1492) return false;
        int pm, pn;
        if (L < 1440) { pg8::tile_order(L, 32, NT_IN, pm, pn); pm += 4; }
        else { const int j = L - 1440; pm = j & 3; pn = j >> 2; }
        u.pm = pm; u.pn = pn; u.aux = 0; u.A = A + (size_t)pm * 256 * D * 2; u.B = B + (size_t)pn * 256 * D * 2; return true;
    }
};
struct EpiIn {
    static constexpr bool PERM = true, CARRY = false;
    __device__ __forceinline__ bool keep(const pg8::Unit&) const { return false; }
    unsigned char* ws; const float* b_gates;
    template <int ACT> __device__ __forceinline__ void store_tile(const pg8::f32x4 (&acc)[2][2][4][2], bf16* base, int ldc, int wr, int wc, int fr, int fq) const {
#pragma unroll
        for (int ai = 0; ai < 2; ++ai)
#pragma unroll
            for (int m = 0; m < 4; ++m) { bf16* rowp = base + (size_t)(ai * 128 + wr * 64 + m * 16 + fr) * ldc + wc * 32 + 8 * fq;
#pragma unroll
                for (int bj = 0; bj < 2; ++bj) { pg8::f32x4 v0 = acc[ai][bj][m][0], v1 = acc[ai][bj][m][1];
                    if (ACT == 1) {
#pragma unroll
                        for (int j = 0; j < 4; ++j) { v0[j] = sigmoidf_(v0[j]); v1[j] = sigmoidf_(v1[j]); } }
                    if (ACT == 2) {
#pragma unroll
                        for (int j = 0; j < 4; ++j) { v0[j] = gelu_tanh(v0[j]); v1[j] = gelu_tanh(v1[j]); } }
                    pg8::u32x4 w; w.x = pg8::cvt_pk_bf16(v0[0], v0[1]); w.y = pg8::cvt_pk_bf16(v0[2], v0[3]); w.z = pg8::cvt_pk_bf16(v1[0], v1[1]); w.w = pg8::cvt_pk_bf16(v1[2], v1[3]);
                    *(pg8::u32x4*)(rowp + bj * 128) = w; } }
    }
    __device__ __forceinline__ void operator()(const pg8::f32x4 (&acc)[2][2][4][2], const pg8::Unit& u, int wr, int wc, int fr, int fq) const {
        const int pn = u.pn; const size_t row0 = (size_t)u.pm * 256;
        if (pn < 12) {
            const int seg = pn >> 2, ct = pn & 3; bf16* dst = (bf16*)(ws + (seg == 0 ? WS_K : seg == 1 ? WS_V : WS_UX));
            store_tile<0>(acc, dst + row0 * 1024 + ct * 256, 1024, wr, wc, fr, fq);
        } else if (pn == 12) {
            if (wc == 0) {
                float* G = (float*)(ws + WS_GATES);
                const pg8::f32x4 bv0 = *(const pg8::f32x4*)(b_gates + 8 * fq), bv1 = *(const pg8::f32x4*)(b_gates + 8 * fq + 4);
#pragma unroll
                for (int ai = 0; ai < 2; ++ai)
#pragma unroll
                    for (int m = 0; m < 4; ++m) { float* rowp = G + (row0 + ai * 128 + wr * 64 + m * 16 + fr) * 32 + 8 * fq;
                        *(pg8::f32x4*)(rowp) = acc[ai][0][m][0] + bv0; *(pg8::f32x4*)(rowp + 4) = acc[ai][0][m][1] + bv1; }
            }
        } else if (pn < 29) {
            const int seg = (pn - 13) >> 2, ct = (pn - 13) & 3; const size_t lr = row0 - NCTX;
            bf16* dst = (bf16*)(ws + (seg == 0 ? WS_Q : seg == 1 ? WS_OF : seg == 2 ? WS_OB : WS_UG)) + lr * 1024 + ct * 256;
            if (seg == 0) store_tile<0>(acc, dst, 1024, wr, wc, fr, fq);
            else if (seg == 3) store_tile<2>(acc, dst, 1024, wr, wc, fr, fq);
            else store_tile<1>(acc, dst, 1024, wr, wc, fr, fq);
        } else {
            const int seg = (pn - 29) >> 3, ct = (pn - 29) & 7; const size_t lr = row0 - NCTX;
            store_tile<1>(acc, (bf16*)(ws + (seg ? WS_GB : WS_GA)) + lr * 2048 + ct * 256, 2048, wr, wc, fr, fq);
        }
    }
};

__device__ __forceinline__ int lru_pos_row(int b, bool isctx, int p) { return isctx ? b * CTXL + p : NCTX + b * SEQ + (p & 31) * 64 + (p >> 5); }
typedef short bf16x8_t __attribute__((ext_vector_type(8)));
template <bool FINAL>
__device__ __forceinline__ void lru_unit(const Args& a, unsigned char* lds_g, int b, int cidx, int blk, int tid, bf16x8_t (&wl)[2][2][4], int& wl_blk) {
    const int lane = fresh_lane(), w = __builtin_amdgcn_readfirstlane(tid >> 6), fr = lane & 15, fq = lane >> 4; tid = w * 64 + lane;
    float* zf = (float*)lds_g;
    bf16* zb = (bf16*)(lds_g + 64 * 132 * 4);
    const bool isctx = cidx < 4; const int seglen = isctx ? CTXL : SEQ, p0 = (isctx ? cidx : cidx - 4) * 64;
    const bf16* UX = (const bf16*)(a.ws + WS_UX);
    float gba[2], gbx[2], glam[2];
    { const int ch_ = blk * 128 + 16 * w + fr;
#pragma unroll
      for (int d = 0; d < 2; ++d) { gba[d] = a.in[I_LBA][d * 1024 + ch_]; gbx[d] = a.in[I_LBX][d * 1024 + ch_]; glam[d] = a.in[I_LAM][d * 1024 + ch_]; } }
    if (wl_blk != blk) { const bf16* WL = (const bf16*)(a.ws + WS_WL); wl_blk = blk;
#pragma unroll
      for (int d = 0; d < 2; ++d)
#pragma unroll
        for (int m = 0; m < 2; ++m)
#pragma unroll
            for (int ks = 0; ks < 4; ++ks) wl[d][m][ks] = *(const bf16x8_t*)(WL + ((size_t)((d * 2 + m) * 8 + blk) * 128 + 16 * w + fr) * 128 + 32 * ks + 8 * fq); }
    __builtin_amdgcn_sched_barrier(0);
    {
        const int pos = tid >> 3, cg = tid & 7, ch0 = blk * 128 + cg * 16, p = p0 + pos;
        float z[16];
#pragma unroll
        for (int q = 0; q < 4; ++q) { const f32x4 bv = *(const f32x4*)(a.in[I_CONVB] + ch0 + 4 * q); z[4 * q] = bv.x; z[4 * q + 1] = bv.y; z[4 * q + 2] = bv.z; z[4 * q + 3] = bv.w; }
        v4u ua[4], ub[4]; float msk[4];
#pragma unroll
        for (int w4 = 0; w4 < 4; ++w4) { const int pp = p + w4 - 2; const bool ok = pp >= 0 && pp < seglen; const int ppc = ok ? pp : p;
            const v4u* src = (const v4u*)(UX + (size_t)lru_pos_row(b, isctx, ppc) * 1024 + ch0); ua[w4] = src[0]; ub[w4] = src[1]; msk[w4] = ok ? 1.f : 0.f; }
#pragma unroll
        for (int w4 = 0; w4 < 4; ++w4) { const float* cw = a.in[I_CONVW] + w4 * 1024 + ch0;
            const unsigned uu[8] = {ua[w4].x, ua[w4].y, ua[w4].z, ua[w4].w, ub[w4].x, ub[w4].y, ub[w4].z, ub[w4].w};
#pragma unroll
            for (int q = 0; q < 4; ++q) { const f32x4 cv = *(const f32x4*)(cw + 4 * q) * msk[w4]; z[4 * q] += cv.x * bflo(uu[2 * q]); z[4 * q + 1] += cv.y * bfhi(uu[2 * q]); z[4 * q + 2] += cv.z * bflo(uu[2 * q + 1]); z[4 * q + 3] += cv.w * bfhi(uu[2 * q + 1]); } }
#pragma unroll
        for (int q = 0; q < 4; ++q) *(f32x4*)(zf + pos * 132 + cg * 16 + 4 * q) = (f32x4){z[4 * q], z[4 * q + 1], z[4 * q + 2], z[4 * q + 3]};
        v4u o0, o1; o0.x = pk2(z[0], z[1]); o0.y = pk2(z[2], z[3]); o0.z = pk2(z[4], z[5]); o0.w = pk2(z[6], z[7]); o1.x = pk2(z[8], z[9]); o1.y = pk2(z[10], z[11]); o1.z = pk2(z[12], z[13]); o1.w = pk2(z[14], z[15]);
        *(v4u*)(zb + pos * 136 + cg * 16) = o0; *(v4u*)(zb + pos * 136 + cg * 16 + 8) = o1;
    }
    WG_BAR();
    f32x4 acc[2][2][4];
#pragma unroll
    for (int d = 0; d < 2; ++d)
#pragma unroll
        for (int m = 0; m < 2; ++m)
#pragma unroll
            for (int mt = 0; mt < 4; ++mt) acc[d][m][mt] = (f32x4){0.f, 0.f, 0.f, 0.f};
#pragma unroll
    for (int ks = 0; ks < 4; ++ks) {
        bf16x8_t af[4];
#pragma unroll
        for (int mt = 0; mt < 4; ++mt) af[mt] = *(const bf16x8_t*)(zb + (16 * mt + fr) * 136 + 32 * ks + 8 * fq);
#pragma unroll
        for (int d = 0; d < 2; ++d)
#pragma unroll
            for (int m = 0; m < 2; ++m) {
#pragma unroll
                for (int mt = 0; mt < 4; ++mt) acc[d][m][mt] = __builtin_amdgcn_mfma_f32_16x16x32_bf16(af[mt], wl[d][m][ks], acc[d][m][mt], 0, 0, 0); }
    }
    const int chl = 16 * w + fr, ch = blk * 128 + chl;
    float hsum[4][4];
#pragma unroll
    for (int d = 0; d < 2; ++d) {
        const float ba = gba[d], bx = gbx[d], lam = glam[d];
        const float sp = (-lam > 20.f) ? -lam : log1pf(__expf(-lam));
        float av[4][4], bv[4][4];
#pragma unroll
        for (int mt = 0; mt < 4; ++mt)
#pragma unroll
            for (int r = 0; r < 4; ++r) { const float rr = sigmoidf_(acc[d][0][mt][r] + ba), ii = sigmoidf_(acc[d][1][mt][r] + bx);
                const float aa = __expf(-8.f * rr * sp); av[mt][r] = aa; bv[mt][r] = __builtin_amdgcn_sqrtf(fmaxf(1.f - aa * aa, 0.f)) * ii * zf[(16 * mt + 4 * fq + r) * 132 + chl]; }
        float Pe[4], Se[4], Pt[4], St[4];
#pragma unroll
        for (int mt = 0; mt < 4; ++mt) {
            float P = 1.f, S = 0.f;
#pragma unroll
            for (int rr = 0; rr < 4; ++rr) { const int r = d ? 3 - rr : rr; S = av[mt][r] * S + bv[mt][r]; P = av[mt][r] * P; }
            if (d == 0) {
                float p1 = __shfl_up(P, 16), s1 = __shfl_up(S, 16); if (fq >= 1) { S = P * s1 + S; P = P * p1; }
                p1 = __shfl_up(P, 32); s1 = __shfl_up(S, 32); if (fq >= 2) { S = P * s1 + S; P = P * p1; }
                Pe[mt] = __shfl_up(P, 16); Se[mt] = __shfl_up(S, 16); if (fq == 0) { Pe[mt] = 1.f; Se[mt] = 0.f; }
                Pt[mt] = __shfl(P, fr + 48); St[mt] = __shfl(S, fr + 48);
            } else {
                float p1 = __shfl_down(P, 16), s1 = __shfl_down(S, 16); if (fq <= 2) { S = P * s1 + S; P = P * p1; }
                p1 = __shfl_down(P, 32); s1 = __shfl_down(S, 32); if (fq <= 1) { S = P * s1 + S; P = P * p1; }
                Pe[mt] = __shfl_down(P, 16); Se[mt] = __shfl_down(S, 16); if (fq == 3) { Pe[mt] = 1.f; Se[mt] = 0.f; }
                Pt[mt] = __shfl(P, fr); St[mt] = __shfl(S, fr);
            }
        }
        float2* AGG = (float2*)(a.ws + WS_AGG) + ((size_t)(b * 2 + d) * 36) * 1024 + ch;
        if (!FINAL) {
            if (cidx >= 4) {
                unsigned* PS = (unsigned*)(a.ws + WS_PS) + ((size_t)(b * 2 + d) * NSTEP + 64 * cidx) * 1024 + ch;
#pragma unroll
                for (int mt = 0; mt < 4; ++mt)
#pragma unroll
                    for (int r = 0; r < 4; ++r) PS[(size_t)(16 * mt + 4 * fq + r) * 1024] = pk2(1.f - av[mt][r], bv[mt][r]);
            }
            float Pc = 1.f, Sc = 0.f;
#pragma unroll
            for (int i = 0; i < 4; ++i) { const int mt = d ? 3 - i : i; Sc = Pt[mt] * Sc + St[mt]; Pc = Pt[mt] * Pc; }
            if (fq == 0) AGG[(size_t)cidx * 1024] = make_float2(Pc, Sc);
        } else {
            float h = 0.f;
#pragma unroll
            for (int g3 = 0; g3 < 6; ++g3) {
                float2 qv[6];
#pragma unroll
                for (int i = 0; i < 6; ++i) { const int sidx = 6 * g3 + i; const int c2 = d ? (sidx < 4 ? 3 - sidx : 39 - sidx) : sidx; qv[i] = AGG[(size_t)c2 * 1024]; }
#pragma unroll
                for (int i = 0; i < 6; ++i) { const int sidx = 6 * g3 + i; const int c2 = d ? (sidx < 4 ? 3 - sidx : 39 - sidx) : sidx;
                    const bool use = d ? (sidx < 4 || c2 > cidx) : (c2 < cidx);
                    h = use ? qv[i].x * h + qv[i].y : h; }
            }
#pragma unroll
            for (int i = 0; i < 4; ++i) { const int mt = d ? 3 - i : i;
                float hl = Pe[mt] * h + Se[mt];
#pragma unroll
                for (int rr = 0; rr < 4; ++rr) { const int r = d ? 3 - rr : rr; hl = av[mt][r] * hl + bv[mt][r]; if (d == 0) hsum[mt][r] = hl; else hsum[mt][r] += hl; }
                h = Pt[mt] * h + St[mt]; }
        }
    }
    if (FINAL) {
#pragma unroll
        for (int mt = 0; mt < 4; ++mt)
#pragma unroll
            for (int r = 0; r < 4; ++r) zf[(16 * mt + 4 * fq + r) * 132 + chl] = hsum[mt][r];
        WG_BAR();
        const int pos = tid >> 3, cg = tid & 7, ch0 = blk * 128 + cg * 16;
        const size_t lrow = (size_t)(lru_pos_row(b, false, p0 + pos) - NCTX) * 1024 + ch0;
        const v4u* ug = (const v4u*)((const bf16*)(a.ws + WS_UG) + lrow); const v4u g0 = ug[0], g1 = ug[1];
        const unsigned gg[8] = {g0.x, g0.y, g0.z, g0.w, g1.x, g1.y, g1.z, g1.w}; unsigned o[8];
#pragma unroll
        for (int q = 0; q < 4; ++q) { const f32x4 hv = *(const f32x4*)(zf + pos * 132 + cg * 16 + 4 * q);
            o[2 * q] = pk2(hv.x * bflo(gg[2 * q]), hv.y * bfhi(gg[2 * q])); o[2 * q + 1] = pk2(hv.z * bflo(gg[2 * q + 1]), hv.w * bfhi(gg[2 * q + 1])); }
        v4u* dst = (v4u*)((bf16*)(a.ws + WS_YB) + lrow); dst[0] = (v4u){o[0], o[1], o[2], o[3]}; dst[1] = (v4u){o[4], o[5], o[6], o[7]};
    }
    WG_BAR();
}
constexpr int ML_STRIDE = 136;
constexpr int ML_Q = 0, ML_K = 17408, ML_V = 34816, ML_AUG = 52224  , ML_CB = 54272  ;
constexpr int ML_EB = 93440  , ML_EU = 95488  , ML_EBEND = 97536  , ML_BEND = 97568  , ML_DEN = 97600  , ML_SSQ = 97856  ;
typedef short s4_t __attribute__((ext_vector_type(4)));
__device__ __forceinline__ s4_t ds_tr(const bf16* p) { return __builtin_amdgcn_ds_read_tr16_b64_v4i16((LAS s4_t*)p); }
__device__ __forceinline__ bf16x8_t frag_row(const bf16* img, int row0, int k0, int fr, int fq) { return *(const bf16x8_t*)(img + (row0 + fr) * ML_STRIDE + k0 + 8 * fq); }
__device__ __forceinline__ bf16x8_t frag_tr2(const bf16* img, int stride, int sA, int sB, int col0, int lane) {
    const int fq = lane >> 4, q = (lane & 15) >> 2, p = lane & 3;
    const s4_t lo = ds_tr(img + (sA + 4 * fq + q) * stride + col0 + 4 * p), hi = ds_tr(img + (sB + 4 * fq + q) * stride + col0 + 4 * p);
    return (bf16x8_t){lo.x, lo.y, lo.z, lo.w, hi.x, hi.y, hi.z, hi.w};
}
__device__ __forceinline__ bf16x8_t frag_tr(const bf16* img, int stride, int s0, int col0, int lane) {
    const int fq = lane >> 4, q = (lane & 15) >> 2, p = lane & 3;
    const bf16* b = img + (s0 + 8 * fq + q) * stride + col0 + 4 * p;
    const s4_t lo = ds_tr(b), hi = ds_tr(b + 4 * stride);
    return (bf16x8_t){lo.x, lo.y, lo.z, lo.w, hi.x, hi.y, hi.z, hi.w};
}
__device__ __forceinline__ float logsigmoidf_(float x) { return fminf(x, 0.f) - log1pf(__expf(-fabsf(x))); }

__device__ __forceinline__ void ml_gates(const Args& a, unsigned char* lds_g, int rowbase, int h, int tid) {
    const int lane = fresh_lane(), w = __builtin_amdgcn_readfirstlane(tid >> 6), dir = w >> 2, c = w & 3;
    const float* GT = (const float*)(a.ws + WS_GATES) + (size_t)(rowbase + 64 * c + lane) * 32;
    const float ipre = GT[(dir * 2) * 8 + h], fpre = GT[(dir * 2 + 1) * 8 + h];
    float bsum = logsigmoidf_(fpre);
    if (dir == 0) {
#pragma unroll
        for (int o = 1; o < 64; o <<= 1) { const float t = __shfl_up(bsum, o); if (lane >= o) bsum += t; }
    } else {
#pragma unroll
        for (int o = 1; o < 64; o <<= 1) { const float t = __shfl_down(bsum, o); if (lane + o < 64) bsum += t; }
    }
    float* eb = (float*)(lds_g + ML_EB); float* eu = (float*)(lds_g + ML_EU);
    eb[dir * 256 + 64 * c + lane] = __expf(bsum); eu[dir * 256 + 64 * c + lane] = __expf(ipre - bsum);
    const float bend = __shfl(bsum, dir ? 0 : 63);
    if (lane == 0) { ((float*)(lds_g + ML_EBEND))[dir * 4 + c] = __expf(bend); ((float*)(lds_g + ML_BEND))[dir * 4 + c] = bend; }
}

template <bool OUT, bool PASS2>
__device__ __forceinline__ void ml_block(const Args& a, unsigned char* lds_g, int rowbase, int h, int dir, f32x4 (&st)[9], int tid) {
    const int lane = tid & 63, w = __builtin_amdgcn_readfirstlane(tid >> 6), fr = lane & 15, fq = lane >> 4;
    bf16* Qi = (bf16*)(lds_g + ML_Q); bf16* Ki = (bf16*)(lds_g + ML_K); bf16* Vi = (bf16*)(lds_g + ML_V); bf16* AUGi = (bf16*)(lds_g + ML_AUG); bf16* CB = (bf16*)(lds_g + ML_CB);
    const float* eb = (const float*)(lds_g + ML_EB) + dir * 256; const float* eu = (const float*)(lds_g + ML_EU) + dir * 256;
    const float* ebend = (const float*)(lds_g + ML_EBEND) + dir * 4;
    float* den = (float*)(lds_g + ML_DEN); float* ssq = (float*)(lds_g + ML_SSQ);
    const bf16* Kb = (const bf16*)(a.ws + WS_K); const bf16* Vb = (const bf16*)(a.ws + WS_V); const bf16* Qb = (const bf16*)(a.ws + WS_Q);
    const int ti = w & 3, vh = w >> 2;
    float hgv[5];
    if (OUT) {
#pragma unroll
        for (int x = 0; x < 5; ++x) { const int vt = vh * 5 + x; hgv[x] = vt < 8 ? a.in[I_HEADG][h * 128 + 16 * vt + fr] : 0.f; } }
    const int st_t = tid >> 3, st_pc = tid & 7;
    v4u k0, k1, v0, v1, q0, q1;
#define ML_LOADC(c_) do { const size_t row_ = (size_t)(rowbase + 64 * (c_) + st_t); \
        const v4u* ks_ = (const v4u*)(Kb + row_ * 1024 + h * 128 + 16 * st_pc); k0 = ks_[0]; k1 = ks_[1]; \
        const v4u* vs_ = (const v4u*)(Vb + row_ * 1024 + h * 128 + 16 * st_pc); v0 = vs_[0]; v1 = vs_[1]; \
        if (OUT) { const v4u* qs_ = (const v4u*)(Qb + (row_ - NCTX) * 1024 + h * 128 + 16 * st_pc); q0 = qs_[0]; q1 = qs_[1]; } } while (0)
    ML_LOADC(dir ? 3 : 0);
    for (int ci = 0; ci < 4; ++ci) {
        const int c = dir ? 3 - ci : ci;
        unsigned short ogv[5][4]; unsigned short tmv[5][4];
        if (OUT) {
            const bf16* OGp = (const bf16*)(a.ws + (dir ? WS_OB : WS_OF)); const bf16* TMp = (const bf16*)(a.ws + WS_TM);
#pragma unroll
            for (int r = 0; r < 4; ++r) { const size_t ob = (size_t)(rowbase - NCTX + 64 * c + 16 * ti + 4 * fq + r) * 1024 + h * 128;
#pragma unroll
                for (int x = 0; x < 5; ++x) { const int vt = vh * 5 + x; if (vt < 8) { ogv[x][r] = OGp[ob + 16 * vt + fr]; if (PASS2) tmv[x][r] = TMp[ob + 16 * vt + fr]; } } }
            __builtin_amdgcn_sched_barrier(0);
        }
        {
            const int t = st_t, pc = st_pc;
            const float e = eu[64 * c + t];
            *(v4u*)(Ki + t * ML_STRIDE + 16 * pc) = k0; *(v4u*)(Ki + t * ML_STRIDE + 16 * pc + 8) = k1;
            if (OUT) { *(v4u*)(Qi + t * ML_STRIDE + 16 * pc) = q0; *(v4u*)(Qi + t * ML_STRIDE + 16 * pc + 8) = q1; }
            const unsigned vv[8] = {v0.x, v0.y, v0.z, v0.w, v1.x, v1.y, v1.z, v1.w}; unsigned o[8];
#pragma unroll
            for (int i = 0; i < 8; ++i) o[i] = pk2(bflo(vv[i]) * e, bfhi(vv[i]) * e);
            *(v4u*)(Vi + t * ML_STRIDE + 16 * pc) = (v4u){o[0], o[1], o[2], o[3]}; *(v4u*)(Vi + t * ML_STRIDE + 16 * pc + 8) = (v4u){o[4], o[5], o[6], o[7]};
            if (pc == 0) { *(v4u*)(AUGi + t * 16) = (v4u){f2bf(e), 0u, 0u, 0u}; *(v4u*)(AUGi + t * 16 + 8) = (v4u){0u, 0u, 0u, 0u}; }
        }
        WG_BAR();
        if (ci < 3) ML_LOADC(dir ? 2 - ci : ci + 1);
        f32x4 X[5]; float hval[4][4];
        if (OUT) {
            bf16x8_t qf[4];
#pragma unroll
            for (int ks = 0; ks < 4; ++ks) qf[ks] = frag_row(Qi, 16 * ti, 32 * ks, fr, fq);
            bf16x8_t P[2]; bool pv[2];
#pragma unroll
            for (int pp = 0; pp < 2; ++pp) {
                f32x4 d[2];
#pragma unroll
                for (int hh = 0; hh < 2; ++hh) { const int si = 2 * pp + hh; d[hh] = (f32x4){0.f, 0.f, 0.f, 0.f};
                    const bool valid = dir ? (si >= ti) : (si <= ti);
                    if (valid) {
#pragma unroll
                        for (int ks = 0; ks < 4; ++ks) d[hh] = __builtin_amdgcn_mfma_f32_16x16x32_bf16(frag_row(Ki, 16 * si, 32 * ks, fr, fq), qf[ks], d[hh], 0, 0, 0);
                        if (si == ti) {
#pragma unroll
                            for (int r = 0; r < 4; ++r) { const bool keep = dir ? (4 * fq + r >= fr) : (4 * fq + r <= fr); d[hh][r] = keep ? d[hh][r] : 0.f; } } } }
                pv[pp] = dir ? (2 * pp + 1 >= ti) : (2 * pp <= ti);
                const unsigned p0 = pk2(d[0][0], d[0][1]), p1 = pk2(d[0][2], d[0][3]), p2 = pk2(d[1][0], d[1][1]), p3 = pk2(d[1][2], d[1][3]);
                P[pp] = __builtin_bit_cast(bf16x8_t, (v4u){p0, p1, p2, p3});
            }
#pragma unroll
            for (int x = 0; x < 5; ++x) { X[x] = (f32x4){0.f, 0.f, 0.f, 0.f};
                const int vt = vh * 5 + x;
                if (vt < 9) {
#pragma unroll
                    for (int pp = 0; pp < 2; ++pp) if (pv[pp]) {
                        const bf16x8_t bfv = vt < 8 ? frag_tr2(Vi, ML_STRIDE, 32 * pp, 32 * pp + 16, 16 * vt, lane) : frag_tr2(AUGi, 16, 32 * pp, 32 * pp + 16, 0, lane);
                        X[x] = __builtin_amdgcn_mfma_f32_16x16x32_bf16(P[pp], bfv, X[x], 0, 0, 0); }
#pragma unroll
                    for (int ks = 0; ks < 4; ++ks) X[x] = __builtin_amdgcn_mfma_f32_16x16x32_bf16(qf[ks], frag_row(CB, 16 * vt, 32 * ks, fr, fq), X[x], 0, 0, 0);
                } }
            if (vh == 1 && fr == 0) {
#pragma unroll
                for (int r = 0; r < 4; ++r) den[16 * ti + 4 * fq + r] = X[3][r] * eb[64 * c + 16 * ti + 4 * fq + r]; }
        }
        {
#pragma unroll
            for (int ks = 0; ks < 2; ++ks) { const bf16x8_t kf = frag_tr(Ki, ML_STRIDE, 32 * ks, 16 * w, lane);
#pragma unroll
                for (int vt = 0; vt < 8; ++vt) st[vt] = __builtin_amdgcn_mfma_f32_16x16x32_bf16(kf, frag_tr(Vi, ML_STRIDE, 32 * ks, 16 * vt, lane), st[vt], 0, 0, 0);
                st[8] = __builtin_amdgcn_mfma_f32_16x16x32_bf16(kf, frag_tr(AUGi, 16, 32 * ks, 0, lane), st[8], 0, 0, 0); }
            const float ee = ebend[c];
#pragma unroll
            for (int vt = 0; vt < 9; ++vt) st[vt] = st[vt] * ee;
        }
        WG_BAR();
        if (OUT) {
            float sq[4] = {0.f, 0.f, 0.f, 0.f};
#pragma unroll
            for (int r = 0; r < 4; ++r) { const int t = 16 * ti + 4 * fq + r; const float sc = eb[64 * c + t] * __builtin_amdgcn_rcpf(fmaxf(fabsf(den[t]), 1.f));
#pragma unroll
                for (int x = 0; x < 4; ++x) { const int vt = vh * 5 + x; const float hv = (vt < 8) ? X[x][r] * sc : 0.f; hval[x][r] = hv; sq[r] += hv * hv; }
                if (vh == 0) { const float hv = X[4][r] * sc; X[4][r] = hv; sq[r] += hv * hv; } }
#pragma unroll
            for (int r = 0; r < 4; ++r) { float v = sq[r]; v += __shfl_xor(v, 1); v += __shfl_xor(v, 2); v += __shfl_xor(v, 4); v += __shfl_xor(v, 8); if (fr == 0) ssq[vh * 64 + 16 * ti + 4 * fq + r] = v; }
#pragma unroll
            for (int vt = 0; vt < 9; ++vt) { pg8::u32x2 o; o.x = pk2(st[vt][0], st[vt][1]); o.y = pk2(st[vt][2], st[vt][3]); *(pg8::u32x2*)(CB + (16 * vt + fr) * ML_STRIDE + 16 * w + 4 * fq) = o; }
            WG_BAR();
            bf16* TM = (bf16*)(a.ws + WS_TM); bf16* YA = (bf16*)(a.ws + WS_YA);
#pragma unroll
            for (int r = 0; r < 4; ++r) { const int t = 16 * ti + 4 * fq + r; const float rs = __builtin_amdgcn_rsqf((ssq[t] + ssq[64 + t]) * (1.f / 128.f) + EPS);
                const size_t ob = (size_t)(rowbase - NCTX + 64 * c + t) * 1024 + h * 128;
#pragma unroll
                for (int x = 0; x < 5; ++x) { const int vt = vh * 5 + x; if (vt < 8) { const int v = 16 * vt + fr; const float hv = (x < 4) ? hval[x][r] : X[4][r];
                    float y = hv * rs * hgv[x] * bf2f(ogv[x][r]);
                    if (PASS2) { y += bf2f(tmv[x][r]); YA[ob + v] = (bf16)f2bf(y); } else TM[ob + v] = (bf16)f2bf(y); } } }
        }
    }
}

#undef ML_LOADC
__device__ __forceinline__ void ml_state_quad(const Args& a, unsigned char* lds_g, int qu, int tid) {
    const int seq = qu >> 1, j0 = 4 * (qu & 1), dir = seq & 1, h = (seq >> 1) & 7, b = seq >> 4;
    const int lane = tid & 63, w = __builtin_amdgcn_readfirstlane(tid >> 6);
    f32x4 st[9];
#pragma unroll
    for (int vt = 0; vt < 9; ++vt) st[vt] = (f32x4){0.f, 0.f, 0.f, 0.f};
#pragma unroll 1
    for (int jj = 0; jj < 4; ++jj) {
        const int j = j0 + jj, su = seq * 8 + j;
        const int rowbase = j == 0 ? b * CTXL : NCTX + b * SEQ + 256 * (dir ? 8 - j : j - 1);
        ml_gates(a, lds_g, rowbase, h, tid);
        WG_BAR();
        ml_block<false, false>(a, lds_g, rowbase, h, dir, st, tid);
        pg8::u32x2* SL = (pg8::u32x2*)(a.ws + WS_SLOC) + ((size_t)(su * 8 + w) * 9) * 64 + lane;
#pragma unroll
        for (int vt = 0; vt < 9; ++vt) { pg8::u32x2 o; o.x = pk2(st[vt][0], st[vt][1]); o.y = pk2(st[vt][2], st[vt][3]); SL[vt * 64] = o; }
        if (tid == 0) { const float* bd = (const float*)(lds_g + ML_BEND) + dir * 4; ((float*)(a.ws + WS_BT))[su] = (bd[0] + bd[1]) + (bd[2] + bd[3]); }
        WG_BAR();
    }
}
__device__ __forceinline__ void ml_out_unit(const Args& a, unsigned char* lds_g, int u, int tid) {
    const int L = u & 7, h = (u >> 3) & 7, b = u >> 6;
    const int rowbase = NCTX + b * SEQ + 256 * L;
    const int lane = tid & 63, w = __builtin_amdgcn_readfirstlane(tid >> 6), fr = lane & 15, fq = lane >> 4;
    bf16* CB = (bf16*)(lds_g + ML_CB);
    ml_gates(a, lds_g, rowbase, h, tid);
    f32x4 st[9];
#pragma unroll
    for (int dir = 0; dir < 2; ++dir) {
        const int seq = (b * 8 + h) * 2 + dir, jmax = dir ? 7 - L : L;
        const float* BT = (const float*)(a.ws + WS_BT) + seq * 8;
        {
            const pg8::u32x2* SLa = (const pg8::u32x2*)(a.ws + WS_SLOC) + ((size_t)((seq * 8 + jmax) * 8 + w) * 9) * 64 + lane;
            const pg8::u32x2* SLb = (const pg8::u32x2*)(a.ws + WS_SLOC) + ((size_t)((seq * 8 + 3) * 8 + w) * 9) * 64 + lane;
            pg8::u32x2 sa[9];
            if (jmax >= 4) {
                pg8::u32x2 sb[9];
#pragma unroll
                for (int vt = 0; vt < 9; ++vt) { sa[vt] = SLa[vt * 64]; sb[vt] = SLb[vt * 64]; }
                float ls = 0.f;
#pragma unroll
                for (int q = 4; q < 8; ++q) ls += (q <= jmax) ? BT[q] : 0.f;
                const float coef = __expf(ls);
#pragma unroll
                for (int vt = 0; vt < 9; ++vt) st[vt] = (f32x4){bflo(sa[vt].x) + bflo(sb[vt].x) * coef, bfhi(sa[vt].x) + bfhi(sb[vt].x) * coef, bflo(sa[vt].y) + bflo(sb[vt].y) * coef, bfhi(sa[vt].y) + bfhi(sb[vt].y) * coef};
            } else {
#pragma unroll
                for (int vt = 0; vt < 9; ++vt) { sa[vt] = SLa[vt * 64]; st[vt] = (f32x4){bflo(sa[vt].x), bfhi(sa[vt].x), bflo(sa[vt].y), bfhi(sa[vt].y)}; }
            }
        }
#pragma unroll
        for (int vt = 0; vt < 9; ++vt) { pg8::u32x2 o; o.x = pk2(st[vt][0], st[vt][1]); o.y = pk2(st[vt][2], st[vt][3]); *(pg8::u32x2*)(CB + (16 * vt + fr) * ML_STRIDE + 16 * w + 4 * fq) = o; }
        WG_BAR();
        if (dir == 0) ml_block<true, false>(a, lds_g, rowbase, h, 0, st, tid);
        else ml_block<true, true>(a, lds_g, rowbase, h, 1, st, tid);
        asm volatile("s_waitcnt vmcnt(0)" ::: "memory");
        WG_BAR();
    }
}

__device__ __forceinline__ void lru_out_loadps(const Args& a, int b, int cidx, int blk, int tid, unsigned (&psw)[2][16]) {
    const int chl = tid & 127, q = tid >> 7, ch = blk * 128 + chl;
#pragma unroll
    for (int d = 0; d < 2; ++d) { const unsigned* PS = (const unsigned*)(a.ws + WS_PS) + ((size_t)(b * 2 + d) * NSTEP + 64 * cidx + 16 * q) * 1024 + ch;
#pragma unroll
        for (int i = 0; i < 16; ++i) psw[d][i] = PS[(size_t)i * 1024]; }
}
__device__ __forceinline__ void lru_out_unit(const Args& a, unsigned char* lds_g, int b, int cidx, int blk, int tid, unsigned (&psw)[2][16], int nb, int ncidx, int nblk) {
    tid = __builtin_amdgcn_readfirstlane(tid >> 6) * 64 + fresh_lane();
    const int chl = tid & 127, q = tid >> 7, ch = blk * 128 + chl;
    float2* QA = (float2*)lds_g;
    float av[2][16], bv[2][16];
#pragma unroll
    for (int d = 0; d < 2; ++d)
#pragma unroll
        for (int i = 0; i < 16; ++i) { const unsigned wv = psw[d][i]; av[d][i] = 1.f - bflo(wv); bv[d][i] = bfhi(wv); }
    const int p0 = (cidx - 4) * 64 + 16 * q;
    unsigned short ugv[16];
#pragma unroll
    for (int i = 0; i < 16; ++i) ugv[i] = ((const bf16*)(a.ws + WS_UG))[(size_t)(lru_pos_row(b, false, p0 + i) - NCTX) * 1024 + ch];
    if (ncidx >= 0) lru_out_loadps(a, nb, ncidx, nblk, tid, psw);
    float2* CA = (float2*)(lds_g + 8192);
#pragma unroll
    for (int d = 0; d < 2; ++d) { const float2* AGG = (const float2*)(a.ws + WS_AGG) + ((size_t)(b * 2 + d) * 36) * 1024 + ch; float2 qv[9];
#pragma unroll
        for (int i = 0; i < 9; ++i) { const int sidx = 9 * q + i; const int c2 = d ? (sidx < 4 ? 3 - sidx : 39 - sidx) : sidx; qv[i] = AGG[(size_t)c2 * 1024]; }
        float P = 1.f, S = 0.f;
#pragma unroll
        for (int i = 0; i < 9; ++i) { const int sidx = 9 * q + i; const int c2 = d ? (sidx < 4 ? 3 - sidx : 39 - sidx) : sidx; const bool use = d ? (sidx < 4 || c2 > cidx) : (c2 < cidx);
            S = use ? qv[i].x * S + qv[i].y : S; P = use ? qv[i].x * P : P; }
        CA[(d * 4 + q) * 128 + chl] = make_float2(P, S); }
#pragma unroll
    for (int d = 0; d < 2; ++d) { float P = 1.f, S = 0.f;
#pragma unroll
        for (int ii = 0; ii < 16; ++ii) { const int i = d ? 15 - ii : ii; S = av[d][i] * S + bv[d][i]; P = av[d][i] * P; }
        QA[(d * 4 + q) * 128 + chl] = make_float2(P, S); }
    WG_BAR();
    float hs[16];
#pragma unroll
    for (int d = 0; d < 2; ++d) { float h = 0.f;
#pragma unroll
        for (int k = 0; k < 4; ++k) { const float2 t = CA[(d * 4 + k) * 128 + chl]; h = t.x * h + t.y; }
#pragma unroll
        for (int k = 0; k < 3; ++k) { const int qq = d ? 3 - k : k; const bool use = d ? (qq > q) : (qq < q); const float2 t = QA[(d * 4 + qq) * 128 + chl]; h = use ? t.x * h + t.y : h; }
#pragma unroll
        for (int ii = 0; ii < 16; ++ii) { const int i = d ? 15 - ii : ii; h = av[d][i] * h + bv[d][i]; if (d == 0) hs[i] = h; else hs[i] += h; } }
#pragma unroll
    for (int i = 0; i < 16; ++i) { const size_t lrow = (size_t)(lru_pos_row(b, false, p0 + i) - NCTX) * 1024 + ch;
        ((bf16*)(a.ws + WS_YB))[lrow] = (bf16)f2bf(hs[i] * bf2f(ugv[i])); }
    WG_BAR();
}
__device__ __forceinline__ void phase3(const Args& a, unsigned char* lds_g, int tid) {
    {
        int q0 = (int)blockIdx.x, qstep = (int)gridDim.x;
        if (gridDim.x == 256) q0 = blockIdx.x >= 128 ? (int)blockIdx.x - 128 : 128;
        for (int qu = q0; qu < 128; qu += qstep) ml_state_quad(a, lds_g, qu, tid);
    }
    bf16x8_t wl[2][2][4]; int wl_blk = -1;
    for (int u = blockIdx.x; u < 4 * 36 * 8; u += gridDim.x) { const int blk = u & 7, q = u >> 3; lru_unit<false>(a, lds_g, q / 36, q % 36, blk, tid, wl, wl_blk); }
}

struct SchedProj {
    int G, c; const char *YA, *YB, *WA, *WB;
    __device__ __forceinline__ bool next(int i, pg8::Unit& u) const {
        const int tile = (i >> 1) * G + c, part = i & 1; if (tile >= 256) return false;
        int pm, pn; pg8::tile_order(tile, 32, 8, pm, pn);
        u.pm = pm; u.pn = pn; u.aux = part; u.A = (part ? YB : YA) + (size_t)pm * 256 * 1024 * 2; u.B = (part ? WB : WA) + (size_t)pn * 256 * 1024 * 2; return true;
    }
};
struct EpiProj {
    static constexpr bool PERM = true, CARRY = true;
    const bf16 *GA, *GB; bf16* PRE;
    __device__ __forceinline__ bool keep(const pg8::Unit& u) const { return u.aux == 0; }
    __device__ __forceinline__ void operator()(pg8::f32x4 (&acc)[2][2][4][2], const pg8::Unit& u, int wr, int wc, int fr, int fq) const {
#pragma unroll
        for (int ai = 0; ai < 2; ++ai) {
            pg8::u32x4 gb4[4][2], ga4[4][2];
#pragma unroll
            for (int m = 0; m < 4; ++m) { const size_t off = (size_t)(u.pm * 256 + ai * 128 + wr * 64 + m * 16 + fr) * 2048 + u.pn * 256 + wc * 32 + 8 * fq;
#pragma unroll
                for (int bj = 0; bj < 2; ++bj) { gb4[m][bj] = *(const pg8::u32x4*)(GB + off + bj * 128); if (u.aux == 0) ga4[m][bj] = *(const pg8::u32x4*)(GA + off + bj * 128); } }
#pragma unroll
            for (int m = 0; m < 4; ++m) { const size_t off = (size_t)(u.pm * 256 + ai * 128 + wr * 64 + m * 16 + fr) * 2048 + u.pn * 256 + wc * 32 + 8 * fq;
#pragma unroll
                for (int bj = 0; bj < 2; ++bj) { const pg8::u32x4 g4 = gb4[m][bj];
                    const float gbv[8] = {bflo(g4.x), bfhi(g4.x), bflo(g4.y), bfhi(g4.y), bflo(g4.z), bfhi(g4.z), bflo(g4.w), bfhi(g4.w)};
                    if (u.aux == 0) { const pg8::u32x4 a4 = ga4[m][bj];
                        const float gav[8] = {bflo(a4.x), bfhi(a4.x), bflo(a4.y), bfhi(a4.y), bflo(a4.z), bfhi(a4.z), bflo(a4.w), bfhi(a4.w)};
#pragma unroll
                        for (int e = 0; e < 4; ++e) { acc[ai][bj][m][0][e] *= gav[e] * __builtin_amdgcn_rcpf(fmaxf(gbv[e], 1e-20f)); acc[ai][bj][m][1][e] *= gav[4 + e] * __builtin_amdgcn_rcpf(fmaxf(gbv[4 + e], 1e-20f)); }
                    } else {
                        pg8::f32x4 v0 = acc[ai][bj][m][0], v1 = acc[ai][bj][m][1];
#pragma unroll
                        for (int e = 0; e < 4; ++e) { v0[e] *= gbv[e]; v1[e] *= gbv[4 + e]; }
                        pg8::u32x4 w; w.x = pg8::cvt_pk_bf16(v0[0], v0[1]); w.y = pg8::cvt_pk_bf16(v0[2], v0[3]); w.z = pg8::cvt_pk_bf16(v1[0], v1[1]); w.w = pg8::cvt_pk_bf16(v1[2], v1[3]);
                        *(pg8::u32x4*)(PRE + off + bj * 128) = w; } } }
        }
    }
};

struct SchedOut {
    int G, c; const char *A, *B;
    __device__ __forceinline__ bool next(int i, pg8::Unit& u) const {
        const int L = i * G + c; if (L >= 256) return false;
        int pm, pn; pg8::tile_order(L, 32, 8, pm, pn);
        u.pm = pm; u.pn = pn; u.aux = 0; u.A = A + (size_t)pm * 256 * D * 2; u.B = B + (size_t)pn * 256 * D * 2; return true;
    }
};
struct EpiOut {
    static constexpr bool PERM = true, CARRY = false;
    __device__ __forceinline__ bool keep(const pg8::Unit&) const { return false; }
    const float* x; const float* MOD; bf16* X1;
    __device__ __forceinline__ void operator()(const pg8::f32x4 (&acc)[2][2][4][2], const pg8::Unit& u, int wr, int wc, int fr, int fq) const {
        const int b = u.pm >> 3; const int col0 = u.pn * 256 + wc * 32 + 8 * fq;
        pg8::f32x4 g1[2][2];
#pragma unroll
        for (int bj = 0; bj < 2; ++bj)
#pragma unroll
            for (int n = 0; n < 2; ++n) g1[bj][n] = *(const pg8::f32x4*)(MOD + b * 12288 + 2 * 2048 + col0 + bj * 128 + n * 4);
#pragma unroll
        for (int ai = 0; ai < 2; ++ai) {
            pg8::f32x4 xv[4][2][2];
#pragma unroll
            for (int m = 0; m < 4; ++m) { const size_t off = (size_t)(u.pm * 256 + ai * 128 + wr * 64 + m * 16 + fr) * D + col0;
#pragma unroll
                for (int bj = 0; bj < 2; ++bj)
#pragma unroll
                    for (int n = 0; n < 2; ++n) xv[m][bj][n] = *(const pg8::f32x4*)(x + off + bj * 128 + n * 4); }
#pragma unroll
            for (int m = 0; m < 4; ++m) { const size_t off = (size_t)(u.pm * 256 + ai * 128 + wr * 64 + m * 16 + fr) * D + col0;
#pragma unroll
                for (int bj = 0; bj < 2; ++bj) { const pg8::f32x4 v0 = xv[m][bj][0] + g1[bj][0] * acc[ai][bj][m][0], v1 = xv[m][bj][1] + g1[bj][1] * acc[ai][bj][m][1];
                    pg8::u32x4 w; w.x = pg8::cvt_pk_bf16(v0[0], v0[1]); w.y = pg8::cvt_pk_bf16(v0[2], v0[3]); w.z = pg8::cvt_pk_bf16(v1[0], v1[1]); w.w = pg8::cvt_pk_bf16(v1[2], v1[3]);
                    *(pg8::u32x4*)(X1 + off + bj * 128) = w; } }
        }
    }
};

__device__ __forceinline__ void phase_router(const Args& a, unsigned char* lds_g, int tid, int lane, int wave) {
    const bf16* X1 = (const bf16*)(a.ws + WS_X1); const float* MOD = (const float*)(a.ws + WS_MOD); const float* g = a.in[I_N2G];
    const bf16* WRh = (const bf16*)(a.ws + WS_WR); const bf16* WRl = WRh + 4 * 48 * 2048; const float* RB = (const float*)(a.ws + WS_RB);
    bf16* H2 = (bf16*)(a.ws + WS_H2); unsigned* cnt = (unsigned*)(a.ws + WS_CTL) + CW_CNT; int4* ASG = (int4*)(a.ws + WS_ASG);
    f32x4* PART = (f32x4*)lds_g;
    float* SSQP = (float*)(lds_g + 49152);
    float* RS = (float*)(lds_g + 49152 + 1024);
    float* LG = (float*)(lds_g + 49152 + 2048);
    const int slot = wave >> 2, kq = wave & 3, i = lane & 15, gq = lane >> 4;
    const bool shp = gridDim.x == 256; f32x4* PSH = (f32x4*)(lds_g + 65536);
    if (shp) { const int t_ = wave * 64 + lane, c_ = 4 * t_, b_ = (32 * (int)blockIdx.x) >> 11;
        const f32x4 gg = *(const f32x4*)(g + c_), sc = *(const f32x4*)(MOD + b_ * 12288 + 4 * 2048 + c_); PSH[t_] = gg * (sc + 1.f); PSH[512 + t_] = *(const f32x4*)(MOD + b_ * 12288 + 3 * 2048 + c_); }
    for (int tp = blockIdx.x; tp < NLAT / 32; tp += gridDim.x) {
        const int tok0 = 32 * tp + 16 * slot, b = tok0 >> 11, kbase = wave * 256 + 8 * gq;
        const bf16* xr0 = X1 + (size_t)(32 * tp + i) * D + kbase; const bf16* xr1 = xr0 + (size_t)16 * D;
        const bf16* wh = WRh + ((size_t)(b * 48 + i) * 2048 + kbase); const bf16* wl = WRl + ((size_t)(b * 48 + i) * 2048 + kbase);
        f32x4 ac[2][3]; float sq0 = 0.f, sq1 = 0.f;
#pragma unroll
        for (int s = 0; s < 2; ++s)
#pragma unroll
            for (int cb = 0; cb < 3; ++cb) ac[s][cb] = (f32x4){0.f, 0.f, 0.f, 0.f};
#pragma unroll 4
        for (int s8 = 0; s8 < 8; ++s8) {
            const v4u xb0 = *(const v4u*)(xr0 + 32 * s8), xb1 = *(const v4u*)(xr1 + 32 * s8);
            const bf16x8_t h0 = *(const bf16x8_t*)(wh + 32 * s8), h1 = *(const bf16x8_t*)(wh + 16 * 2048 + 32 * s8), h2 = *(const bf16x8_t*)(wh + 32 * 2048 + 32 * s8);
            const bf16x8_t l0 = *(const bf16x8_t*)(wl + 32 * s8), l1 = *(const bf16x8_t*)(wl + 16 * 2048 + 32 * s8), l2 = *(const bf16x8_t*)(wl + 32 * 2048 + 32 * s8);
            const bf16x8_t xf0 = __builtin_bit_cast(bf16x8_t, xb0), xf1 = __builtin_bit_cast(bf16x8_t, xb1);
            ac[0][0] = __builtin_amdgcn_mfma_f32_16x16x32_bf16(xf0, h0, ac[0][0], 0, 0, 0); ac[0][1] = __builtin_amdgcn_mfma_f32_16x16x32_bf16(xf0, h1, ac[0][1], 0, 0, 0); ac[0][2] = __builtin_amdgcn_mfma_f32_16x16x32_bf16(xf0, h2, ac[0][2], 0, 0, 0);
            ac[1][0] = __builtin_amdgcn_mfma_f32_16x16x32_bf16(xf1, h0, ac[1][0], 0, 0, 0); ac[1][1] = __builtin_amdgcn_mfma_f32_16x16x32_bf16(xf1, h1, ac[1][1], 0, 0, 0); ac[1][2] = __builtin_amdgcn_mfma_f32_16x16x32_bf16(xf1, h2, ac[1][2], 0, 0, 0);
            ac[0][0] = __builtin_amdgcn_mfma_f32_16x16x32_bf16(xf0, l0, ac[0][0], 0, 0, 0); ac[0][1] = __builtin_amdgcn_mfma_f32_16x16x32_bf16(xf0, l1, ac[0][1], 0, 0, 0); ac[0][2] = __builtin_amdgcn_mfma_f32_16x16x32_bf16(xf0, l2, ac[0][2], 0, 0, 0);
            ac[1][0] = __builtin_amdgcn_mfma_f32_16x16x32_bf16(xf1, l0, ac[1][0], 0, 0, 0); ac[1][1] = __builtin_amdgcn_mfma_f32_16x16x32_bf16(xf1, l1, ac[1][1], 0, 0, 0); ac[1][2] = __builtin_amdgcn_mfma_f32_16x16x32_bf16(xf1, l2, ac[1][2], 0, 0, 0);
            const unsigned xw0[4] = {xb0.x, xb0.y, xb0.z, xb0.w}, xw1[4] = {xb1.x, xb1.y, xb1.z, xb1.w};
#pragma unroll
            for (int e = 0; e < 4; ++e) { sq0 += bflo(xw0[e]) * bflo(xw0[e]) + bfhi(xw0[e]) * bfhi(xw0[e]); sq1 += bflo(xw1[e]) * bflo(xw1[e]) + bfhi(xw1[e]) * bfhi(xw1[e]); }
        }
        sq0 += __shfl_xor(sq0, 16); sq0 += __shfl_xor(sq0, 32); sq1 += __shfl_xor(sq1, 16); sq1 += __shfl_xor(sq1, 32);
#pragma unroll
        for (int s = 0; s < 2; ++s)
#pragma unroll
            for (int cb = 0; cb < 3; ++cb) PART[((s * 8 + wave) * 3 + cb) * 64 + lane] = ac[s][cb];
        if (gq == 0) { SSQP[(0 * 8 + wave) * 16 + i] = sq0; SSQP[(1 * 8 + wave) * 16 + i] = sq1; }
        __syncthreads();
        if (wave < 2) { const int slot = wave; const int tok0 = 32 * tp + 16 * slot;
            const float* sp = SSQP + slot * 128; const float rstd = 1.f / sqrtf((((sp[i] + sp[16 + i]) + (sp[32 + i] + sp[48 + i])) + ((sp[64 + i] + sp[80 + i]) + (sp[96 + i] + sp[112 + i]))) * (1.f / D) + EPS);
            if (gq == 0) RS[slot * 16 + i] = rstd;
#pragma unroll
            for (int cb = 0; cb < 3; ++cb) { const f32x4* pp = PART + (slot * 8 * 3 + cb) * 64 + lane; const f32x4 sum = ((pp[0] + pp[3 * 64]) + (pp[6 * 64] + pp[9 * 64])) + ((pp[12 * 64] + pp[15 * 64]) + (pp[18 * 64] + pp[21 * 64]));
                const float rb = RB[b * 48 + 16 * cb + i];
#pragma unroll
                for (int r = 0; r < 4; ++r) LG[(slot * 16 + 4 * gq + r) * 48 + 16 * cb + i] = __shfl(rstd, 4 * gq + r) * sum[r] + rb; }
            LDS_WAIT(); asm volatile("" ::: "memory");
            if (lane < 16) {
                const float* lg = LG + (slot * 16 + lane) * 48; const int t = tok0 + lane;
                int gs = 0; float gm = lg[32];
#pragma unroll
                for (int q = 1; q < 4; ++q) { const float v = lg[32 + q]; if (v > gm) { gm = v; gs = q; } }
                float se = 0.f;
#pragma unroll
                for (int q = 0; q < 4; ++q) se += __expf(lg[32 + q] - gm);
                const float pg = 1.f / se;
                int i0 = 0; float v0 = lg[gs * 8];
#pragma unroll
                for (int q = 1; q < 8; ++q) { const float v = lg[gs * 8 + q]; if (v > v0) { v0 = v; i0 = q; } }
                int i1 = -1; float v1 = -3.0e38f;
#pragma unroll
                for (int q = 0; q < 8; ++q) { const float v = lg[gs * 8 + q]; if (q != i0 && v > v1) { v1 = v; i1 = q; } }
                const float e1 = __expf(v1 - v0), w0 = pg / (1.f + e1), w1 = pg * e1 / (1.f + e1);
                const int ex0 = gs * 8 + i0, ex1 = gs * 8 + i1;
                const unsigned p0 = atomicAdd(cnt + ex0, 1u), p1 = atomicAdd(cnt + ex1, 1u);
                ASG[2 * t] = make_int4(ex0, (int)p0, __float_as_int(w0), 0); ASG[2 * t + 1] = make_int4(ex1, (int)p1, __float_as_int(w1), 0);
                int* LIST = (int*)(a.ws + WS_LIST); LIST[ex0 * 8192 + (int)p0] = t; LIST[ex1 * 8192 + (int)p1] = t;
            }
        }
        __syncthreads();
#pragma unroll
        for (int r = 0; r < 4; ++r) { const int tl = 4 * kq + r, t = tok0 + tl; const float rstd = RS[slot * 16 + tl];
            const unsigned long long* xrow = (const unsigned long long*)(X1 + (size_t)t * D) + lane; unsigned* o4 = (unsigned*)((unsigned char*)H2 + (size_t)t * D) + lane;
            f32x4 yv[8];
#pragma unroll
            for (int j = 0; j < 8; ++j) { const int c = 4 * lane + 256 * j;
                f32x4 gs, sh; if (shp) { gs = PSH[lane + 64 * j]; sh = PSH[512 + lane + 64 * j]; } else { const f32x4 gg = *(const f32x4*)(g + c), sc = *(const f32x4*)(MOD + b * 12288 + 4 * 2048 + c); gs = gg * (sc + 1.f); sh = *(const f32x4*)(MOD + b * 12288 + 3 * 2048 + c); }
                const unsigned long long xw = xrow[64 * j]; const f32x4 xv4 = (f32x4){bflo((unsigned)xw), bfhi((unsigned)xw), bflo((unsigned)(xw >> 32)), bfhi((unsigned)(xw >> 32))};
                yv[j] = xv4 * rstd * gs + sh; }
#pragma unroll
            for (int j = 0; j < 8; ++j) { int w8 = __builtin_amdgcn_cvt_pk_fp8_f32(yv[j].x, yv[j].y, 0, false); w8 = __builtin_amdgcn_cvt_pk_fp8_f32(yv[j].z, yv[j].w, w8, true); o4[64 * j] = (unsigned)w8; } }
        __syncthreads();
    }
}

constexpr int MG_A = 0, MG_ABYTES = 32768, MG_B = 65536, MG_BBYTES = 64 * 256  , MG_CUM = 141312  ;
__device__ __forceinline__ int mgb_off(int row, int ch) { return 256 * row + 16 * (ch ^ (((row & 3) << 2) | ((row >> 2) & 3))); }
__device__ __forceinline__ bf16x8_t mgb_frag(const unsigned char* img, int ks, int c, int lane) {
    const int g = lane >> 4, q = (lane & 15) >> 2, p = lane & 3;
    const s4_t lo = ds_tr((const bf16*)(img + mgb_off(32 * ks + 8 * g + q, 2 * c + (p >> 1)) + 8 * (p & 1)));
    const s4_t hi = ds_tr((const bf16*)(img + mgb_off(32 * ks + 8 * g + 4 + q, 2 * c + (p >> 1)) + 8 * (p & 1)));
    return (bf16x8_t){lo.x, lo.y, lo.z, lo.w, hi.x, hi.y, hi.z, hi.w};
}
__device__ __forceinline__ void moe_tables(const Args& a, unsigned char* lds_g, int tid) {
    int* cum = (int*)(lds_g + MG_CUM); const unsigned* ctl = (const unsigned*)(a.ws + WS_CTL);
    if (tid < NEXP) cum[128 + tid] = (int)ctl[CW_CNT + tid];
    if (tid == 0) { int c = 0; for (int e = 0; e < NEXP; ++e) { cum[e] = c; c += (int)((ctl[CW_CNT + e] + 255u) >> 8); } cum[NEXP] = c; }
    __syncthreads();
}
constexpr int MH_A = 0, MH_ABYTES = 32768, MH_B = 65536, MH_BROW = 528, MH_BBYTES = 64 * MH_BROW  ;
__device__ __forceinline__ int mhb_off(int row, int ch) { return MH_BROW * row + 16 * ch; }
__device__ __forceinline__ bf16x8_t mhb_frag(const LAS unsigned char* lbase, int cofs) {
    const s4_t lo = __builtin_amdgcn_ds_read_tr16_b64_v4i16((LAS s4_t*)(lbase + cofs));
    const s4_t hi = __builtin_amdgcn_ds_read_tr16_b64_v4i16((LAS s4_t*)(lbase + cofs + MH_BROW));
    return (bf16x8_t){lo.x, lo.y, lo.z, lo.w, hi.x, hi.y, hi.z, hi.w};
}
__device__ __forceinline__ int moe_pull(const Args& a, unsigned char* lds_g, int w, int x) {
    int* slot = (int*)(lds_g + MG_CUM + 256);
    __syncthreads();
    if (w == 0 && fresh_lane() == 0) *slot = (int)__hip_atomic_fetch_add((unsigned*)(a.ws + WS_CTL) + CW_Q + 64 * x, 1u, __ATOMIC_RELAXED, __HIP_MEMORY_SCOPE_AGENT);
    __syncthreads();
    return __builtin_amdgcn_readfirstlane(*slot);
}
__device__ __forceinline__ unsigned f8pair_lo(unsigned w) { const auto v = __builtin_amdgcn_cvt_pk_f32_fp8((int)w, false); return pk2(v[0], v[1]); }
__device__ __forceinline__ unsigned f8pair_hi(unsigned w) { const auto v = __builtin_amdgcn_cvt_pk_f32_fp8((int)w, true); return pk2(v[0], v[1]); }
template <int MODE>
__device__ __forceinline__ int moe_gemm(const Args& a, unsigned char* lds_g, int tid, int idx0) {
    constexpr int K = MODE == 1 ? D : DE, NT = K / 64;
#define MG_BAR() do { asm volatile("s_waitcnt lgkmcnt(0)" ::: "memory"); __builtin_amdgcn_s_barrier(); asm volatile("" ::: "memory"); } while (0)
    const int w = __builtin_amdgcn_readfirstlane(tid >> 6);
    const int wm = w >> 1, wn = w & 1, hh = wm >> 1, wr = wm & 1;
    const int* cum = (const int*)(lds_g + MG_CUM); const unsigned* ctl = (const unsigned*)(a.ws + WS_CTL);
    const int T = cum[NEXP], x = blockIdx.x & 7;
    const int jl = (int)(blockIdx.x >> 3), nl = (int)(gridDim.x >> 3);
    for (int it = 0;; ++it) {
        int idx;
        if (MODE == 1) idx = jl + nl * it; else idx = moe_pull(a, lds_g, w, x);
        if (idx >= T) return idx;
        const int ti = idx;
        const int nt = x;
        if (MODE == 2) {
            if (w == 0) { unsigned* tc = (unsigned*)(a.ws + WS_CTL) + CW_TC + 64 * ti; unsigned spins = 0;
                while ((unsigned)__builtin_amdgcn_readfirstlane(__hip_atomic_load(tc, __ATOMIC_RELAXED, __HIP_MEMORY_SCOPE_AGENT)) < 64u) {
                    __builtin_amdgcn_s_sleep(2);
                    if (++spins > (1u << 22)) { if (fresh_lane() == 0) __hip_atomic_store((unsigned*)(a.ws + WS_CTL) + 1, 0x900u + (unsigned)ti, __ATOMIC_RELAXED, __HIP_MEMORY_SCOPE_AGENT); break; } }
                __builtin_amdgcn_fence(__ATOMIC_ACQUIRE, "agent");
                asm volatile("s_waitcnt vmcnt(0)" ::: "memory"); }
            __syncthreads();
        }
        const int lane = fresh_lane(), tidu = w * 64 + lane, fr = lane & 15, fq = lane >> 4;
        const int aoff = pg8::lds_byte(wr * 64 + fr, fq * 8);
        const int bk = w, bp = lane;
        int e = 0;
#pragma unroll 1
        for (int q = 1; q < NEXP; ++q) e = (cum[q] <= ti) ? q : e;
        e = __builtin_amdgcn_readfirstlane(e);
        const int mt = __builtin_amdgcn_readfirstlane(ti - cum[e]);
        unsigned aofs[4]; unsigned bofs; int bwr0;
        __amdgpu_buffer_rsrc_t rsA, rsB, rsB3;
        if (MODE == 1) { const int cnt = cum[128 + e];
#pragma unroll
            for (int q = 0; q < 2; ++q) { const int pos = 256 * mt + 128 * q + (tidu >> 2); const int tok = pos < cnt ? ((const int*)(a.ws + WS_LIST))[e * 8192 + pos] : 0;
                aofs[q] = (unsigned)(tok * D + 16 * (tidu & 3)); }
            aofs[2] = aofs[3] = 0u;
            rsA = __builtin_amdgcn_make_buffer_rsrc((void*)(a.ws + WS_H2), 0, 0x7fffffff, 0x00020000);
            rsB = __builtin_amdgcn_make_buffer_rsrc((void*)(a.in[I_W1] + (size_t)e * D * DE), 0, 0x7fffffff, 0x00020000); rsB3 = __builtin_amdgcn_make_buffer_rsrc((void*)(a.in[I_W3] + (size_t)e * D * DE), 0, 0x7fffffff, 0x00020000);
            bofs = (unsigned)((bk + 8 * (bp >> 5)) * DE + 128 * nt + 4 * (bp & 31)) * 4u;
            bwr0 = MH_BROW * (2 * (bk & 3) + (bk >> 2) + 8 * (bp >> 5)) + 2 * (128 * ((bp & 31) >> 4) + 16 * (bp & 3) + 4 * ((bp & 15) >> 2)); }
        else {
#pragma unroll
            for (int q = 0; q < 2; ++q) aofs[q] = (unsigned)((128 * q + (tidu >> 2)) * DE + 16 * (tidu & 3));
            aofs[2] = aofs[3] = 0u;
            rsA = __builtin_amdgcn_make_buffer_rsrc((void*)((const unsigned char*)(a.ws + WS_HM) + (size_t)256 * ti * DE), 0, 0x7fffffff, 0x00020000);
            rsB = __builtin_amdgcn_make_buffer_rsrc((void*)(a.in[I_W2] + (size_t)e * DE * D), 0, 0x7fffffff, 0x00020000); rsB3 = rsB;
            bofs = (unsigned)(bk * D + 256 * nt + 4 * bp) * 4u; bwr0 = MH_BROW * (2 * (bk & 3) + (bk >> 2)) + 2 * (128 * (bp >> 5) + 32 * ((bp & 31) >> 3) + 16 * (bp & 1) + 4 * ((bp >> 1) & 3)); }
        const LAS unsigned char* blane = (const LAS unsigned char*)lds_g + MH_B + mhb_off(16 * (lane >> 5) + 8 * ((lane >> 4) & 1) + 2 * ((lane & 15) >> 2), 16 * wn + ((lane & 3) >> 1)) + 8 * (lane & 1);
        f32x4 acc[4][8];
#pragma unroll
        for (int m = 0; m < 4; ++m)
#pragma unroll
            for (int n = 0; n < 8; ++n) acc[m][n] = (f32x4){0.f, 0.f, 0.f, 0.f};
        v4u ra[4]; f32x4 rb[8];
#define MH_MMAI(buf_, obuf_, xa_, tb_, lda_) do { const LAS unsigned char* Bi_ = blane + (buf_) * MH_BBYTES; \
        bf16x8_t bc0_ = mhb_frag(Bi_, 0), bc1_ = mhb_frag(Bi_, 32); \
        bf16x8_t af_[4], ag_[4]; \
        _Pragma("unroll") for (int m_ = 0; m_ < 4; ++m_) af_[m_] = *(const bf16x8_t*)(lds_g + MH_A + (buf_) * MH_ABYTES + hh * 16384 + aoff + m_ * 2048); \
        _Pragma("unroll") for (int ks_ = 0; ks_ < 2; ++ks_) { \
            _Pragma("unroll") for (int n_ = 0; n_ < 8; n_ += 2) { const int g_ = 4 * ks_ + (n_ >> 1); bf16x8_t bn0_ = bc0_, bn1_ = bc1_; \
                if (g_ == 2) { _Pragma("unroll") for (int m_ = 0; m_ < 4; ++m_) ag_[m_] = *(const bf16x8_t*)(lds_g + MH_A + (buf_) * MH_ABYTES + hh * 16384 + aoff + m_ * 2048 + 1024); } \
                if (n_ + 2 < 8) { bn0_ = mhb_frag(Bi_, 32 * ks_ * MH_BROW + 32 * (n_ + 2)); bn1_ = mhb_frag(Bi_, 32 * ks_ * MH_BROW + 32 * (n_ + 3)); } \
                else if (ks_ == 0) { bn0_ = mhb_frag(Bi_, 32 * MH_BROW); bn1_ = mhb_frag(Bi_, 32 * MH_BROW + 32); } \
                __builtin_amdgcn_sched_barrier(0); \
                _Pragma("unroll") for (int m_ = 0; m_ < 4; ++m_) { acc[m_][n_] = __builtin_amdgcn_mfma_f32_16x16x32_bf16(bc0_, af_[m_], acc[m_][n_], 0, 0, 0); \
                    acc[m_][n_ + 1] = __builtin_amdgcn_mfma_f32_16x16x32_bf16(bc1_, af_[m_], acc[m_][n_ + 1], 0, 0, 0); } \
                { pg8::u32x2 o_; o_.x = pk2(rb[g_].x, rb[g_].y); o_.y = pk2(rb[g_].z, rb[g_].w); \
                  *(pg8::u32x2*)(lds_g + MH_B + (obuf_) * MH_BBYTES + bwr0 + (MODE == 1 ? (g_ >> 1) * 16 * MH_BROW + (g_ & 1) * 128 : g_ * 8 * MH_BROW)) = o_; \
                  rb[g_] = __builtin_bit_cast(f32x4, MODE == 1 ? __builtin_amdgcn_raw_buffer_load_b128((g_ & 1) ? rsB3 : rsB, bofs, (64 * (tb_) + 16 * (g_ >> 1)) * DE * 4, 0) \
                                                             : __builtin_amdgcn_raw_buffer_load_b128(rsB, bofs, (64 * (tb_) + 8 * g_) * D * 4, 0)); } \
                if (g_ < 2) { const v4u p_ = ra[(xa_) + g_]; \
                  *(v4u*)(lds_g + MH_A + (obuf_) * MH_ABYTES + g_ * 16384 + awr) = (v4u){MH_F8(p_.x), MH_F8(p_.y)}; \
                  *(v4u*)(lds_g + MH_A + (obuf_) * MH_ABYTES + g_ * 16384 + awr + 16) = (v4u){MH_F8(p_.z), MH_F8(p_.w)}; } \
                if (g_ == 2) { lda_; } \
                __builtin_amdgcn_sched_barrier(0); bc0_ = bn0_; bc1_ = bn1_; } \
            if (ks_ == 0) { _Pragma("unroll") for (int m_ = 0; m_ < 4; ++m_) af_[m_] = ag_[m_]; } } } while (0)
        {
            const int awr = pg8::lds_byte(tidu >> 2, 16 * (tidu & 3));
#define MH_LDB(t_) do { _Pragma("unroll") for (int j_ = 0; j_ < 8; ++j_) rb[j_] = __builtin_bit_cast(f32x4, MODE == 1 ? __builtin_amdgcn_raw_buffer_load_b128((j_ & 1) ? rsB3 : rsB, bofs, (64 * (t_) + 16 * (j_ >> 1)) * DE * 4, 0) \
                                                                                                   : __builtin_amdgcn_raw_buffer_load_b128(rsB, bofs, (64 * (t_) + 8 * j_) * D * 4, 0)); } while (0)
#define MH_LDA(te_, to_) do { ra[0] = __builtin_amdgcn_raw_buffer_load_b128(rsA, aofs[0], 64 * (te_), 0); ra[1] = __builtin_amdgcn_raw_buffer_load_b128(rsA, aofs[1], 64 * (te_), 0); \
            ra[2] = __builtin_amdgcn_raw_buffer_load_b128(rsA, aofs[0], 64 * (to_), 0); ra[3] = __builtin_amdgcn_raw_buffer_load_b128(rsA, aofs[1], 64 * (to_), 0); } while (0)
#define MH_F8(w_) f8pair_lo(w_), f8pair_hi(w_)
#define MH_STA(buf_, x_) do { _Pragma("unroll") for (int h_ = 0; h_ < 2; ++h_) { const v4u p_ = ra[(x_) + h_]; \
            *(v4u*)(lds_g + MH_A + (buf_) * MH_ABYTES + h_ * 16384 + awr) = (v4u){MH_F8(p_.x), MH_F8(p_.y)}; __builtin_amdgcn_sched_barrier(0); \
            *(v4u*)(lds_g + MH_A + (buf_) * MH_ABYTES + h_ * 16384 + awr + 16) = (v4u){MH_F8(p_.z), MH_F8(p_.w)}; __builtin_amdgcn_sched_barrier(0); } } while (0)
#define MH_STB(buf_) do { _Pragma("unroll") for (int j_ = 0; j_ < 8; ++j_) { pg8::u32x2 o_; o_.x = pk2(rb[j_].x, rb[j_].y); o_.y = pk2(rb[j_].z, rb[j_].w); \
            *(pg8::u32x2*)(lds_g + MH_B + (buf_) * MH_BBYTES + bwr0 + (MODE == 1 ? (j_ >> 1) * 16 * MH_BROW + (j_ & 1) * 128 : j_ * 8 * MH_BROW)) = o_; } } while (0)
            MH_LDA(0, 1); MH_LDB(0);
            MG_BAR();
            MH_STA(0, 0); MH_STB(0);
            MH_LDB(1);
            for (int t = 0; t < NT; t += 2) {
                const int t2 = (t + 2 < NT) ? t + 2 : NT - 1, t3 = (t + 3 < NT) ? t + 3 : NT - 1;
                MG_BAR();
                MH_MMAI(0, 1, 2, t2, MH_LDA(t2, t3));
                MG_BAR();
                MH_MMAI(1, 0, 0, t3, (void)0);
            }
#undef MH_LDB
#undef MH_LDA
#undef MH_F8
#undef MH_STA
#undef MH_STB
        }
#undef MH_MMAI
        const int ln_ = fresh_lane();
        const int efr = ln_ & 15, efq = ln_ >> 4;
        if (MODE == 1) { unsigned char* HM = (unsigned char*)(a.ws + WS_HM) + (size_t)256 * ti * DE + 128 * nt + 64 * wn; const unsigned lo_ = (unsigned)((128 * hh + 64 * wr + efr) * DE + 16 * efq);
#pragma unroll
            for (int m = 0; m < 4; ++m) { v4u o16;
#pragma unroll
                for (int n = 0; n < 4; n += 2) { float hv[8];
#pragma unroll
                    for (int r = 0; r < 4; ++r) { const float a1 = acc[m][n][r], a2 = acc[m][n + 1][r]; hv[r] = a1 * sigmoidf_(a1) * acc[m][n + 4][r]; hv[4 + r] = a2 * sigmoidf_(a2) * acc[m][n + 5][r]; }
                    int w8a = __builtin_amdgcn_cvt_pk_fp8_f32(hv[0], hv[1], 0, false); w8a = __builtin_amdgcn_cvt_pk_fp8_f32(hv[2], hv[3], w8a, true);
                    int w8b = __builtin_amdgcn_cvt_pk_fp8_f32(hv[4], hv[5], 0, false); w8b = __builtin_amdgcn_cvt_pk_fp8_f32(hv[6], hv[7], w8b, true);
                    if (n == 0) { o16.x = (unsigned)w8a; o16.y = (unsigned)w8b; } else { o16.z = (unsigned)w8a; o16.w = (unsigned)w8b; } }
                { void* p_ = (void*)(HM + lo_ + 16 * m * DE); asm volatile("global_store_dwordx4 %0, %1, off sc1\n\ts_nop 1" :: "v"(p_), "v"(o16) : "memory"); } }
            asm volatile("s_waitcnt vmcnt(0)" ::: "memory");
            if (ln_ == 0) __hip_atomic_fetch_add((unsigned*)(a.ws + WS_CTL) + CW_TC + 64 * ti, 1u, __ATOMIC_RELAXED, __HIP_MEMORY_SCOPE_AGENT); }
        else { unsigned char* Y2 = (unsigned char*)(a.ws + WS_Y2) + (size_t)256 * ti * D + 256 * nt + 128 * wn; const unsigned lo_ = (unsigned)((128 * hh + 64 * wr + efr) * D + 8 * efq);
#pragma unroll
            for (int m = 0; m < 4; ++m)
#pragma unroll
                for (int n = 0; n < 8; n += 2) { int w0_ = __builtin_amdgcn_cvt_pk_fp8_f32(acc[m][n][0], acc[m][n][1], 0, false); w0_ = __builtin_amdgcn_cvt_pk_fp8_f32(acc[m][n][2], acc[m][n][3], w0_, true);
                    int w1_ = __builtin_amdgcn_cvt_pk_fp8_f32(acc[m][n + 1][0], acc[m][n + 1][1], 0, false); w1_ = __builtin_amdgcn_cvt_pk_fp8_f32(acc[m][n + 1][2], acc[m][n + 1][3], w1_, true);
                    pg8::u32x2 o; o.x = (unsigned)w0_; o.y = (unsigned)w1_; *(pg8::u32x2*)(Y2 + lo_ + 16 * m * D + 16 * n) = o; } }
    }
#undef MG_BAR
}

__device__ __forceinline__ void phase12(const Args& a, unsigned char* lds_g, int lane, int wave) {
    const int gw = blockIdx.x * NWAVES + wave, NGW = gridDim.x * NWAVES;
    const int* cum = (const int*)(lds_g + MG_CUM);
    const bf16* X1 = (const bf16*)(a.ws + WS_X1); const float* MOD = (const float*)(a.ws + WS_MOD); const float* fg = a.in[I_FG];
    const int4* ASG = (const int4*)(a.ws + WS_ASG); const unsigned char* Y2 = (const unsigned char*)(a.ws + WS_Y2);
    const bool shp = gridDim.x == 256; f32x4* G2S = (f32x4*)lds_g;
    if (shp) { const int t_ = wave * 64 + lane; G2S[t_] = *(const f32x4*)(MOD + ((32 * (int)blockIdx.x) >> 11) * 12288 + 5 * 2048 + 4 * t_); G2S[512 + t_] = *(const f32x4*)(fg + 4 * t_); __syncthreads(); }
    for (int t0 = 4 * gw; t0 < NLAT; t0 += 4 * NGW) {
      const int b = t0 >> 11; f32x4 g2v[8], fgv[8];
      if (shp) {
#pragma unroll
          for (int j = 0; j < 8; ++j) { g2v[j] = G2S[lane + 64 * j]; fgv[j] = G2S[512 + lane + 64 * j]; }
      } else {
#pragma unroll
          for (int j = 0; j < 8; ++j) { g2v[j] = *(const f32x4*)(MOD + b * 12288 + 5 * 2048 + 4 * lane + 256 * j); fgv[j] = *(const f32x4*)(fg + 4 * lane + 256 * j); } }
#pragma unroll 1
      for (int t = t0; t < t0 + 4; ++t) {
        const int4 q0 = ASG[2 * t], q1 = ASG[2 * t + 1];
        const float w0 = __int_as_float(q0.z), w1 = __int_as_float(q1.z);
        const unsigned long long* xr = (const unsigned long long*)(X1 + (size_t)t * D) + lane;
        const unsigned* y0 = (const unsigned*)(Y2 + (size_t)(256 * cum[q0.x] + q0.y) * D) + lane; const unsigned* y1 = (const unsigned*)(Y2 + (size_t)(256 * cum[q1.x] + q1.y) * D) + lane;
        f32x4 v[8]; float s = 0.f;
#pragma unroll
        for (int j = 0; j < 8; ++j) {
            const int c = 4 * lane + 256 * j;
            const f32x4 g2 = g2v[j]; (void)c;
            const unsigned a0 = y0[64 * j], a1 = y1[64 * j];
            const auto l0 = __builtin_amdgcn_cvt_pk_f32_fp8((int)a0, false), h0 = __builtin_amdgcn_cvt_pk_f32_fp8((int)a0, true), l1 = __builtin_amdgcn_cvt_pk_f32_fp8((int)a1, false), h1 = __builtin_amdgcn_cvt_pk_f32_fp8((int)a1, true);
            f32x4 y; y.x = w0 * l0[0] + w1 * l1[0]; y.y = w0 * l0[1] + w1 * l1[1]; y.z = w0 * h0[0] + w1 * h1[0]; y.w = w0 * h0[1] + w1 * h1[1];
            const unsigned long long xw = xr[64 * j];
            v[j] = (f32x4){bflo((unsigned)xw), bfhi((unsigned)xw), bflo((unsigned)(xw >> 32)), bfhi((unsigned)(xw >> 32))} + g2 * y;
            s += (v[j].x * v[j].x + v[j].y * v[j].y) + (v[j].z * v[j].z + v[j].w * v[j].w);
        }
        const float rstd = 1.f / sqrtf(wave_sum(s) * (1.f / D) + EPS);
        f32x4* o = (f32x4*)(a.out + (size_t)t * D) + lane;
#pragma unroll
        for (int j = 0; j < 8; ++j) o[64 * j] = v[j] * rstd * fgv[j];
      }
    }
}

__global__ void __launch_bounds__(NTHR, 2) fwd_kernel(Args args) {
    extern __shared__ __attribute__((aligned(16))) unsigned char lds[];
    LAS unsigned char* ldsl = (LAS unsigned char*)lds;
    volatile LAS unsigned* MISC = (volatile LAS unsigned*)(ldsl + MISC_OFF);
    LAS unsigned* TL = (LAS unsigned*)(ldsl + LDSCTL_OFF);
    const int wave_s = __builtin_amdgcn_readfirstlane(threadIdx.x >> 6);
#define TID() make_tid(wave_s)
    { const int t0 = TID(); for (int u = t0; u < (LDS_BYTES - LDSCTL_OFF) / 4; u += NTHR) ((LAS unsigned*)(ldsl + LDSCTL_OFF))[u] = 0u; }
    __syncthreads();
    unsigned char* ws = args.ws;
    unsigned* ctl = (unsigned*)(ws + WS_CTL);
    XcdBarrier bar; bar.bar = ctl + CW_BAR; bar.x = 0; bar.st = nullptr;
    const bool one_launch = (args.ph_hi - args.ph_lo) > 1;
    if (one_launch) bar = xcd_barrier_post(ctl + CW_BAR, MISC + 8, TID());
    const int lo = args.ph_lo, hi = args.ph_hi;
#define IN(k) (lo <= (k) && (k) < hi)
#define SEAM(k) do { if (IN(k) && IN((k) + 1)) xcd_barrier(bar, TID()); } while (0)
    const int G = gridDim.x, c = blockIdx.x;

#define FRESH() const int tid = TID(), lane = tid & 63, wave = __builtin_amdgcn_readfirstlane(tid >> 6); (void)lane; (void)wave
#ifndef DUP_PHASE
#define DUP_PHASE (-1)
#endif
#define PH(k, ...) if (IN(k)) { _Pragma("unroll") for (int rep_ = 0; rep_ < ((DUP_PHASE) == (k) ? 2 : 1); ++rep_) { if (rep_) xcd_barrier(bar, TID()); __VA_ARGS__ } } SEAM(k);
    PH(0, { FRESH(); phase0(args, lds, tid, lane, wave); mod_wait(args, tid); phase1(args, lds, lane, wave); })
    PH(1, {
        SchedIn S{G, c, (const char*)(ws + WS_H), (const char*)(ws + WS_WIN)}; EpiIn E{ws, args.in[I_BGATES]};
        pg8::gemm_phase<EpiIn, SchedIn>(ldsl, D, S, E, TID());
        { const int R_ = (1492 + G - 1) / G; int fi_ = 1492 - (R_ - 1) * G; if (fi_ >= G) fi_ = 0;
          if (c >= fi_) { FRESH(); late_prep(args, lds, (c - fi_) * NWAVES + wave, (G - fi_) * NWAVES, lane, wave); } } })
    PH(2, { FRESH(); phase3(args, lds, tid); })
    PH(3, { FRESH();
        for (int u = c; u < 256; u += G) ml_out_unit(args, lds, u, tid);
        unsigned psw[2][16];
        if (c < 4 * 32 * 8) { const int q = c >> 3; lru_out_loadps(args, q >> 5, 4 + (q & 31), c & 7, __builtin_amdgcn_readfirstlane(tid >> 6) * 64 + fresh_lane(), psw); }
        for (int u = c; u < 4 * 32 * 8; u += G) { const int blk = u & 7, q = u >> 3; const int un = u + G, qn = un >> 3; const bool hn = un < 4 * 32 * 8;
            lru_out_unit(args, lds, q >> 5, 4 + (q & 31), blk, tid, psw, hn ? qn >> 5 : 0, hn ? 4 + (qn & 31) : -1, un & 7); } })
    PH(4, {
        SchedProj S{G, c, (const char*)(ws + WS_YA), (const char*)(ws + WS_YB), (const char*)(ws + WS_WPA), (const char*)(ws + WS_WPB)};
        EpiProj E{(const bf16*)(ws + WS_GA), (const bf16*)(ws + WS_GB), (bf16*)(ws + WS_PRE)};
        pg8::gemm_phase<EpiProj, SchedProj>(ldsl, 1024, S, E, TID()); })
    PH(5, {
        SchedOut S{G, c, (const char*)(ws + WS_PRE), (const char*)(ws + WS_WOUT)}; EpiOut E{args.in[I_X], (const float*)(ws + WS_MOD), (bf16*)(ws + WS_X1)};
        pg8::gemm_phase<EpiOut, SchedOut>(ldsl, D, S, E, TID()); })
    PH(6, { FRESH(); phase_router(args, lds, tid, lane, wave); })
    PH(7, { FRESH(); moe_tables(args, lds, tid); const int nx_ = moe_gemm<1>(args, lds, tid, -1); { const int tid2_ = TID(); (void)moe_gemm<2>(args, lds, tid2_, nx_); } })
    PH(8, { FRESH(); moe_tables(args, lds, tid); phase12(args, lds, lane, wave); })
#undef PH
#undef IN
#undef SEAM
}

extern "C" void kernel_launch(void* const* d_in, const int* in_sizes, int n_in, void* d_out, int out_size, void* d_ws, size_t ws_size, hipStream_t stream) {
    static int grid = 0;
    if (grid == 0) {
        if (n_in != 27 || out_size != NLAT * D || ws_size < WS_END) { fprintf(stderr, "kernel_launch: unexpected shapes (n_in %d, out %d, ws %zu)\n", n_in, out_size, ws_size); grid = -1; return; }
        int dev = 0, cus = 0, per_cu = 0;
        if (hipGetDevice(&dev) != hipSuccess || hipDeviceGetAttribute(&cus, hipDeviceAttributeMultiprocessorCount, dev) != hipSuccess) { grid = -1; return; }
        if (hipFuncSetAttribute((const void*)fwd_kernel, hipFuncAttributeMaxDynamicSharedMemorySize, LDS_BYTES) != hipSuccess) { fprintf(stderr, "kernel_launch: hipFuncSetAttribute failed\n"); grid = -1; return; }
        if (hipOccupancyMaxActiveBlocksPerMultiprocessor(&per_cu, (const void*)fwd_kernel, NTHR, LDS_BYTES) != hipSuccess || per_cu < 1) fprintf(stderr, "kernel_launch: occupancy query says %d\n", per_cu);
        (void)hipGetLastError();
        grid = cus;
    }
    if (grid < 0) return;
    (void)hipMemsetAsync((char*)d_ws + WS_CTL, 0, CTL_ZERO_BYTES, stream);
    Args a{};
    for (int i = 0; i < 27; ++i) a.in[i] = (const float*)d_in[i];
    a.out = (float*)d_out; a.ws = (unsigned char*)d_ws;
#if MK_ONE_LAUNCH
    a.ph_lo = 0; a.ph_hi = NPHASE;
    hipLaunchKernelGGL(fwd_kernel, dim3(grid), dim3(NTHR), LDS_BYTES, stream, a);
#else
    for (int p = 0; p < NPHASE; ++p) { a.ph_lo = p; a.ph_hi = p + 1; hipLaunchKernelGGL(fwd_kernel, dim3(grid), dim3(NTHR), LDS_BYTES, stream, a); }
#endif
}
```
